# Optimizing an MI355X kernel written in HIP

```python
import math
import jax, jax.numpy as jnp
from jax import lax
import numpy as np

D_MODEL = 4096
BATCH = 4
SEQ = 4096
DEPTH = 2

N_MIXERS = 2
EPS = 1e-6
NEG_INF = -1e30

REL_BUCKETS = 32
REL_MAX_DISTANCE = 128

NSA_HEADS = 64
NSA_KV_GROUPS = 4
NSA_HEADS_PER_GROUP = NSA_HEADS // NSA_KV_GROUPS
NSA_QK_DIM = 192
NSA_V_DIM = 128
CMP_BLOCK = 32
CMP_STRIDE = 16
SEL_BLOCK = 64
SEL_TOPK = 16
WINDOW = 512
NSA_Q_BLOCK = 64
NSA_Q_WIDTH = NSA_HEADS * NSA_QK_DIM
NSA_KV_WIDTH = NSA_KV_GROUPS * (NSA_QK_DIM + NSA_V_DIM)
NSA_Z_WIDTH = NSA_HEADS * NSA_V_DIM
NSA_GATE_WIDTH = 3 * NSA_HEADS
NSA_IN_DIM = NSA_Q_WIDTH + 3 * NSA_KV_WIDTH + 3 * NSA_Z_WIDTH + NSA_GATE_WIDTH

MLA_HEADS = 64
MLA_Q_LORA = 1536
MLA_KV_LORA = 512
MLA_NOPE_DIM = 128
MLA_ROPE_DIM = 64
MLA_V_DIM = 128
MLA_QK_DIM = MLA_NOPE_DIM + MLA_ROPE_DIM
MLA_Z_WIDTH = MLA_HEADS * MLA_V_DIM
MLA_IN_DIM = MLA_Q_LORA + MLA_KV_LORA + MLA_ROPE_DIM + MLA_Z_WIDTH
MLA_Q_BLOCK = 128
ROPE_BASE = 10000.0

kernel_name = "nsa_mla_interleaved_hybrid"


def rms_norm(x, gain):
    xf = x.astype(jnp.float32)
    y = xf * lax.rsqrt(jnp.mean(xf * xf, axis=-1, keepdims=True) + EPS)
    return (y * gain.astype(jnp.float32)).astype(x.dtype)


def t5_bucket(dist):
    n = jnp.maximum(dist, 0)
    max_exact = REL_BUCKETS // 2
    scaled = jnp.log(jnp.maximum(n, max_exact).astype(jnp.float32) / max_exact) / math.log(REL_MAX_DISTANCE / max_exact)
    large = jnp.minimum(max_exact + (scaled * (REL_BUCKETS - max_exact)).astype(jnp.int32), REL_BUCKETS - 1)
    return jnp.where(n < max_exact, n, large)


def masked_softmax(logits, mask):
    p = jax.nn.softmax(jnp.where(mask, logits, NEG_INF), axis=-1)
    return p * jnp.any(mask, axis=-1, keepdims=True)


def rope(x, positions):
    half = MLA_ROPE_DIM // 2
    inv_freq = ROPE_BASE ** (-jnp.arange(half, dtype=jnp.float32) / half)
    ang = positions.astype(jnp.float32)[:, :, None, None] * inv_freq
    cos, sin = jnp.cos(ang), jnp.sin(ang)
    xf = x.astype(jnp.float32)
    x1, x2 = xf[..., :half], xf[..., half:]
    return jnp.concatenate([x1 * cos - x2 * sin, x2 * cos + x1 * sin], axis=-1).astype(x.dtype)


def compress_blocks(x_raw, pe, w1, w2):
    B, S, G, d = x_raw.shape
    n_cmp = (S - CMP_BLOCK) // CMP_STRIDE + 1
    win = CMP_STRIDE * jnp.arange(n_cmp)[:, None] + jnp.arange(CMP_BLOCK)[None, :]
    blocks = x_raw[:, win] + pe[None, None, :, None, :]
    flat = blocks.transpose(0, 1, 3, 2, 4).reshape(B, n_cmp, G, CMP_BLOCK * d)
    return jax.nn.silu(flat @ w1) @ w2


def nsa_mixer(h, w_in, q_norm, k_norm, pe_k, w1_k, w2_k, pe_v, w1_v, w2_v, rel_bias, w_out):
    B, S, _ = h.shape
    H, G, R, dk, dv = NSA_HEADS, NSA_KV_GROUPS, NSA_HEADS_PER_GROUP, NSA_QK_DIM, NSA_V_DIM
    QB = NSA_Q_BLOCK
    sizes = [NSA_Q_WIDTH] + [NSA_KV_WIDTH] * 3 + [NSA_Z_WIDTH] * 3 + [NSA_GATE_WIDTH]
    cuts = [int(c) for c in np.cumsum(sizes)[:-1]]
    q, kv_c, kv_s, kv_w, z_c, z_s, z_w, g = jnp.split(h @ w_in, cuts, axis=-1)

    q = rms_norm(q.reshape(B, S, G, R, dk), q_norm)

    def split_kv(t):
        return t[..., :G * dk].reshape(B, S, G, dk), t[..., G * dk:].reshape(B, S, G, dv)

    kc_raw, vc_raw = split_kv(kv_c)
    ks_raw, vs = split_kv(kv_s)
    kw_raw, vw = split_kv(kv_w)
    kc = rms_norm(compress_blocks(kc_raw, pe_k, w1_k, w2_k), k_norm[0])
    vc = compress_blocks(vc_raw, pe_v, w1_v, w2_v)
    ks = rms_norm(ks_raw, k_norm[1])
    kw = rms_norm(kw_raw, k_norm[2])

    n_cmp = kc.shape[1]
    n_sel = S // SEL_BLOCK
    k_sel = min(SEL_TOPK, n_sel)
    ks_b = ks.reshape(B, n_sel, SEL_BLOCK, G, dk).transpose(0, 3, 1, 2, 4)
    vs_b = vs.reshape(B, n_sel, SEL_BLOCK, G, dv).transpose(0, 3, 1, 2, 4)
    kw_p = jnp.pad(kw, ((0, 0), (WINDOW, 0), (0, 0), (0, 0)))
    vw_p = jnp.pad(vw, ((0, 0), (WINDOW, 0), (0, 0), (0, 0)))

    gates = jax.nn.sigmoid(g).reshape(B, S, 3, G, R)
    a_c = gates[:, :, 0, :, :, None] * jax.nn.silu(z_c).reshape(B, S, G, R, dv)
    a_s = gates[:, :, 1, :, :, None] * jax.nn.silu(z_s).reshape(B, S, G, R, dv)
    a_w = gates[:, :, 2, :, :, None] * jax.nn.silu(z_w).reshape(B, S, G, R, dv)

    tbl = rel_bias.reshape(REL_BUCKETS, G, R)
    cmp_start = CMP_STRIDE * jnp.arange(n_cmp)
    cmp_end = cmp_start + CMP_BLOCK - 1
    sel_start = SEL_BLOCK * jnp.arange(n_sel)
    overlap = ((cmp_start[:, None] < (sel_start + SEL_BLOCK)[None, :])
               & ((cmp_end + 1)[:, None] > sel_start[None, :])).astype(jnp.float32)
    scale = dk ** -0.5
    bi = jnp.arange(B)[:, None, None, None]
    gi = jnp.arange(G)[None, None, :, None]
    blk = jnp.arange(n_sel)
    span = QB + WINDOW

    def block(c):
        t0 = c * QB
        tpos = t0 + jnp.arange(QB)
        qc = lax.dynamic_slice_in_dim(q, t0, QB, axis=1)

        d_c = tpos[:, None] - cmp_end[None, :]
        lg = jnp.einsum('bqgrd,bngd->bqgrn', qc, kc, preferred_element_type=jnp.float32) * scale
        lg = lg + tbl[t5_bucket(d_c)].transpose(0, 2, 3, 1)
        p_c = masked_softmax(lg, (d_c >= 0)[:, None, None, :])
        o_c = jnp.einsum('bqgrn,bngd->bqgrd', p_c.astype(vc.dtype), vc)

        imp = jnp.einsum('bqgrn,nj->bqgj', p_c, overlap)
        cur = (tpos // SEL_BLOCK)[:, None]
        forced = (blk[None, :] == 0) | (blk[None, :] == cur) | (blk[None, :] == cur - 1)
        future = sel_start[None, :] > tpos[:, None]
        imp = jnp.where(forced[:, None, :], jnp.inf, jnp.where(future[:, None, :], -jnp.inf, imp))
        _, idx = lax.top_k(imp, k_sel)
        k_g = ks_b[bi, gi, idx].reshape(B, QB, G, k_sel * SEL_BLOCK, dk)
        v_g = vs_b[bi, gi, idx].reshape(B, QB, G, k_sel * SEL_BLOCK, dv)
        tok = idx[..., None] * SEL_BLOCK + jnp.arange(SEL_BLOCK)
        d_s = tpos[None, :, None, None, None] - tok
        b_s = tbl[t5_bucket(d_s), gi[..., None]]
        b_s = b_s.transpose(0, 1, 2, 5, 3, 4).reshape(B, QB, G, R, k_sel * SEL_BLOCK)
        lg = jnp.einsum('bqgrd,bqgmd->bqgrm', qc, k_g, preferred_element_type=jnp.float32) * scale + b_s
        p_s = masked_softmax(lg, (d_s >= 0).reshape(B, QB, G, 1, k_sel * SEL_BLOCK))
        o_s = jnp.einsum('bqgrm,bqgmd->bqgrd', p_s.astype(v_g.dtype), v_g)

        k_w = lax.dynamic_slice_in_dim(kw_p, t0, span, axis=1)
        v_w = lax.dynamic_slice_in_dim(vw_p, t0, span, axis=1)
        kpos = t0 - WINDOW + jnp.arange(span)
        d_w = tpos[:, None] - kpos[None, :]
        m_w = (d_w >= 0) & (d_w < WINDOW) & (kpos >= 0)[None, :]
        lg = jnp.einsum('bqgrd,blgd->bqgrl', qc, k_w, preferred_element_type=jnp.float32) * scale
        lg = lg + tbl[t5_bucket(d_w)].transpose(0, 2, 3, 1)
        p_w = masked_softmax(lg, m_w[:, None, None, :])
        o_w = jnp.einsum('bqgrl,blgd->bqgrd', p_w.astype(v_w.dtype), v_w)

        o = (o_c * lax.dynamic_slice_in_dim(a_c, t0, QB, axis=1)
             + o_s * lax.dynamic_slice_in_dim(a_s, t0, QB, axis=1)
             + o_w * lax.dynamic_slice_in_dim(a_w, t0, QB, axis=1))
        return o.reshape(B, QB, H * dv)

    out = lax.map(block, jnp.arange(S // QB))
    out = out.transpose(1, 0, 2, 3).reshape(B, S, H * dv)
    return out @ w_out


def mla_mixer(h, positions, w_in, q_a_norm, w_q_b, kv_a_norm, w_kv_b, q_norm, k_norm, w_out):
    B, S, _ = h.shape
    H, QB = MLA_HEADS, MLA_Q_BLOCK
    c_q, c_kv, k_pe, z = jnp.split(h @ w_in, [MLA_Q_LORA, MLA_Q_LORA + MLA_KV_LORA,
                                             MLA_Q_LORA + MLA_KV_LORA + MLA_ROPE_DIM], axis=-1)
    q = (rms_norm(c_q, q_a_norm) @ w_q_b).reshape(B, S, H, MLA_QK_DIM)
    kv = (rms_norm(c_kv, kv_a_norm) @ w_kv_b).reshape(B, S, H, MLA_NOPE_DIM + MLA_V_DIM)
    k_nope, v = kv[..., :MLA_NOPE_DIM], kv[..., MLA_NOPE_DIM:]
    k = jnp.concatenate([k_nope, jnp.broadcast_to(k_pe[:, :, None, :], (B, S, H, MLA_ROPE_DIM))], axis=-1)
    q = rms_norm(q, q_norm)
    k = rms_norm(k, k_norm)
    q = jnp.concatenate([q[..., :MLA_NOPE_DIM], rope(q[..., MLA_NOPE_DIM:], positions)], axis=-1)
    k = jnp.concatenate([k[..., :MLA_NOPE_DIM], rope(k[..., MLA_NOPE_DIM:], positions)], axis=-1)
    scale = MLA_QK_DIM ** -0.5
    outs = []
    for j in range(S // QB):
        lo, hi = j * QB, (j + 1) * QB
        lg = jnp.einsum('bqhd,bkhd->bhqk', q[:, lo:hi], k[:, :hi], preferred_element_type=jnp.float32) * scale
        mask = (lo + jnp.arange(QB))[:, None] >= jnp.arange(hi)[None, :]
        p = jax.nn.softmax(jnp.where(mask, lg, NEG_INF), axis=-1)
        outs.append(jnp.einsum('bhqk,bkhd->bqhd', p.astype(v.dtype), v[:, :hi]))
    o = jnp.concatenate(outs, axis=1) * jax.nn.silu(z).reshape(B, S, H, MLA_V_DIM)
    return o.reshape(B, S, MLA_Z_WIDTH) @ w_out


def setup_inputs(seed: int = 0) -> dict:
    key = jax.random.key(seed)
    ks = iter(jax.random.split(key, 32))
    n_nsa = (DEPTH + N_MIXERS - 1) // N_MIXERS
    n_mla = DEPTH // N_MIXERS
    f32 = jnp.float32

    def nrm(shape, scale):
        return jax.random.normal(next(ks), shape, f32) * scale

    def gain(shape):
        return 1.0 + 0.01 * jax.random.normal(next(ks), shape, f32)

    x = nrm((BATCH, SEQ, D_MODEL), 1.0)
    offset = jax.random.randint(next(ks), (BATCH, 1), 0, 1024, dtype=jnp.int32)
    positions = (offset + jnp.arange(SEQ, dtype=jnp.int32)[None, :]).astype(jnp.int32)
    return {
        "x": x,
        "positions": positions,
        "norm_w": gain((DEPTH, D_MODEL)),
        "rel_bias": nrm((REL_BUCKETS, NSA_HEADS), 0.2),
        "nsa_w_in": nrm((n_nsa, D_MODEL, NSA_IN_DIM), D_MODEL ** -0.5),
        "nsa_q_norm": gain((n_nsa, NSA_QK_DIM)),
        "nsa_k_norm": gain((n_nsa, 3, NSA_QK_DIM)),
        "nsa_cmp_pe_k": nrm((n_nsa, CMP_BLOCK, NSA_QK_DIM), 0.1),
        "nsa_cmp_w1_k": nrm((n_nsa, CMP_BLOCK * NSA_QK_DIM, NSA_QK_DIM), (CMP_BLOCK * NSA_QK_DIM) ** -0.5),
        "nsa_cmp_w2_k": nrm((n_nsa, NSA_QK_DIM, NSA_QK_DIM), NSA_QK_DIM ** -0.5),
        "nsa_cmp_pe_v": nrm((n_nsa, CMP_BLOCK, NSA_V_DIM), 0.1),
        "nsa_cmp_w1_v": nrm((n_nsa, CMP_BLOCK * NSA_V_DIM, NSA_V_DIM), (CMP_BLOCK * NSA_V_DIM) ** -0.5),
        "nsa_cmp_w2_v": nrm((n_nsa, NSA_V_DIM, NSA_V_DIM), NSA_V_DIM ** -0.5),
        "nsa_w_out": nrm((n_nsa, NSA_Z_WIDTH, D_MODEL), NSA_Z_WIDTH ** -0.5),
        "mla_w_in": nrm((n_mla, D_MODEL, MLA_IN_DIM), D_MODEL ** -0.5),
        "mla_q_a_norm": gain((n_mla, MLA_Q_LORA)),
        "mla_w_q_b": nrm((n_mla, MLA_Q_LORA, MLA_HEADS * MLA_QK_DIM), MLA_Q_LORA ** -0.5),
        "mla_kv_a_norm": gain((n_mla, MLA_KV_LORA)),
        "mla_w_kv_b": nrm((n_mla, MLA_KV_LORA, MLA_HEADS * (MLA_NOPE_DIM + MLA_V_DIM)), MLA_KV_LORA ** -0.5),
        "mla_q_norm": gain((n_mla, MLA_QK_DIM)),
        "mla_k_norm": gain((n_mla, MLA_QK_DIM)),
        "mla_w_out": nrm((n_mla, MLA_Z_WIDTH, D_MODEL), MLA_Z_WIDTH ** -0.5),
    }


def reference(x, positions, norm_w, rel_bias, nsa_w_in, nsa_q_norm, nsa_k_norm, nsa_cmp_pe_k, nsa_cmp_w1_k,
              nsa_cmp_w2_k, nsa_cmp_pe_v, nsa_cmp_w1_v, nsa_cmp_w2_v, nsa_w_out, mla_w_in, mla_q_a_norm,
              mla_w_q_b, mla_kv_a_norm, mla_w_kv_b, mla_q_norm, mla_k_norm, mla_w_out):
    for i in range(DEPTH):
        h = rms_norm(x, norm_w[i])
        j = i // N_MIXERS
        if i % N_MIXERS == 0:
            y = nsa_mixer(h, nsa_w_in[j], nsa_q_norm[j], nsa_k_norm[j], nsa_cmp_pe_k[j], nsa_cmp_w1_k[j],
                          nsa_cmp_w2_k[j], nsa_cmp_pe_v[j], nsa_cmp_w1_v[j], nsa_cmp_w2_v[j], rel_bias, nsa_w_out[j])
        else:
            y = mla_mixer(h, positions, mla_w_in[j], mla_q_a_norm[j], mla_w_q_b[j], mla_kv_a_norm[j],
                          mla_w_kv_b[j], mla_q_norm[j], mla_k_norm[j], mla_w_out[j])
        x = x + y
    return x
```

```cpp
#include <hip/hip_runtime.h>
#include <stdint.h>
#include <stddef.h>

#define DI __device__ __forceinline__
#define LAS __attribute__((address_space(3)))
typedef unsigned short bf16_t;
typedef short bf16x8 __attribute__((ext_vector_type(8)));
typedef float f32x4 __attribute__((ext_vector_type(4)));
typedef float f32x16 __attribute__((ext_vector_type(16)));
typedef unsigned u32x4 __attribute__((ext_vector_type(4)));
typedef unsigned u32x2 __attribute__((ext_vector_type(2)));
typedef __bf16 bf2_t __attribute__((ext_vector_type(2)));
typedef float f2_t __attribute__((ext_vector_type(2)));

DI unsigned pk2(float a, float b) { f2_t f = {a, b}; bf2_t v = __builtin_convertvector(f, bf2_t); return __builtin_bit_cast(unsigned, v); }
DI float bflo(unsigned w) { return __uint_as_float(w << 16); }
DI float bfhi(unsigned w) { return __uint_as_float(w & 0xffff0000u); }
DI float bf1(bf16_t h) { return __uint_as_float(((unsigned)h) << 16); }

constexpr int BATCH = 4, SEQ = 4096, DM = 4096, MTOK = BATCH * SEQ;
constexpr int NH = 64, NG = 4, NR = 16, DK = 192, DV = 128;
constexpr int N1 = 40896, N1P = 40960;
constexpr int C_Q = 0, C_KVC = 12288, C_KVS = 13568, C_KVW = 14848, C_ZC = 16128, C_ZS = 24320, C_ZW = 32512, C_G = 40704;
constexpr int N3 = 10304, N3P = 10496;
constexpr int C3_CQ = 0, C3_CKV = 1536, C3_KPE = 2048, C3_Z = 2112;
constexpr int QLORA = 1536, KVLORA = 512;
constexpr int NQB = 12288, NKVB = 16384, ZW8 = 8192;
constexpr float EPSN = 1e-6f;
constexpr float LOG2E = 1.4426950408889634f;
constexpr float QSCALE = 0.07216878364870322f * 1.4426950408889634f;

constexpr size_t SZ_W1T = (size_t)N1P * DM * 2, SZ_W2T = (size_t)DM * ZW8 * 2, SZ_W3T = (size_t)N3P * DM * 2, SZ_W4T = (size_t)NQB * QLORA * 2,
                 SZ_W5T = (size_t)NKVB * KVLORA * 2, SZ_W6T = (size_t)DM * ZW8 * 2;
constexpr size_t OFF_W1T = 0, OFF_W2T = OFF_W1T + SZ_W1T, OFF_W3T = OFF_W2T + SZ_W2T, OFF_W4T = OFF_W3T + SZ_W3T, OFF_W5T = OFF_W4T + SZ_W4T,
                 OFF_W6T = OFF_W5T + SZ_W5T, OFF_W1K = OFF_W6T + SZ_W6T;
constexpr size_t SZ_W1K = (size_t)256 * 6144 * 2, SZ_W1V = (size_t)256 * 4096 * 2;
constexpr size_t OFF_W1V = OFF_W1K + SZ_W1K, OFF_CTL = OFF_W1V + SZ_W1V, OFF_H = OFF_CTL + 65536;
constexpr size_t SZ_H = (size_t)MTOK * DM * 2, SZ_KS = (size_t)BATCH * NG * SEQ * DK * 2, SZ_VTS = (size_t)BATCH * NG * DV * SEQ * 2,
                 SZ_ACK = (size_t)4096 * 6144 * 2, SZ_ACV = (size_t)4096 * 4096 * 2;
constexpr size_t OFF_KS = OFF_H + SZ_H, OFF_KW = OFF_KS + SZ_KS, OFF_VTS = OFF_KW + SZ_KS, OFF_VTW = OFF_VTS + SZ_VTS, OFF_ACK = OFF_VTW + SZ_VTS,
                 OFF_ACV = OFF_ACK + SZ_ACK, OFF_KC = OFF_ACV + SZ_ACV;
constexpr size_t SZ_KC = (size_t)16 * 256 * DK * 2, SZ_VTC = (size_t)16 * DV * 256 * 2, SZ_HID = (size_t)4096 * 256 * 4;
constexpr size_t OFF_VTC = OFF_KC + SZ_KC, OFF_HIDK = OFF_VTC + SZ_VTC, OFF_HIDV = OFF_HIDK + SZ_HID, OFF_Y0 = OFF_HIDV + SZ_HID;
constexpr size_t SZ_Y0 = (size_t)MTOK * N1P * 2, SZ_O = (size_t)MTOK * ZW8 * 2;
constexpr size_t OFF_O = OFF_Y0 + SZ_Y0, WS_END = OFF_O + SZ_O;
constexpr size_t OFF_KM = 0;
constexpr size_t SZ_KM = (size_t)BATCH * NH * SEQ * DK * 2;
static_assert(SZ_KM <= SZ_W1T + SZ_W2T, "KM alias");
constexpr size_t OFF_VTM = OFF_H;
constexpr size_t SZ_VTM = (size_t)BATCH * NH * DV * SEQ * 2;
constexpr size_t OFF_CKVN = OFF_VTM + SZ_VTM;
constexpr size_t SZ_CKVN = (size_t)MTOK * KVLORA * 2;
static_assert(OFF_CKVN + SZ_CKVN <= OFF_KC, "CKVN alias");
constexpr size_t OFF_Y1 = OFF_Y0, SZ_Y1 = (size_t)MTOK * N3P * 2;
constexpr size_t OFF_QM = OFF_Y1 + SZ_Y1, SZ_QM = (size_t)MTOK * NQB * 2;
constexpr size_t OFF_KVM = OFF_QM + SZ_QM, SZ_KVM = (size_t)MTOK * NKVB * 2;
constexpr size_t OFF_CQN = OFF_KVM + SZ_KVM, SZ_CQN = (size_t)MTOK * QLORA * 2;
constexpr size_t OFF_ROPE = OFF_CQN + SZ_CQN, SZ_ROPE = (size_t)MTOK * 64 * 4;
static_assert(OFF_ROPE + SZ_ROPE <= OFF_O, "layer-1 alias region");
static_assert(WS_END <= 2680160256ull, "workspace");

struct Params {
    const float* x; const int* pos; const float* norm_w; const float* rel_bias;
    const float* nsa_w_in; const float* nsa_q_norm; const float* nsa_k_norm; const float* pe_k; const float* w1_k; const float* w2_k;
    const float* pe_v; const float* w1_v; const float* w2_v; const float* nsa_w_out;
    const float* mla_w_in; const float* mla_q_a_norm; const float* mla_w_q_b; const float* mla_kv_a_norm; const float* mla_w_kv_b;
    const float* mla_q_norm; const float* mla_k_norm; const float* mla_w_out;
    float* out; unsigned char* ws;
};
namespace pg8 {
#define PG8_LAS __attribute__((address_space(3)))
typedef unsigned short bf16_t;
typedef short bf16x8 __attribute__((ext_vector_type(8)));
typedef float f32x4 __attribute__((ext_vector_type(4)));
typedef unsigned u32x4 __attribute__((ext_vector_type(4)));
constexpr int BM = 256, BK = 64, HALF = 128, HTB = HALF * BK * 2  , STAGE_BYTES = 8 * HTB, NXCD = 8, WGM = 8;

__host__ __device__ __forceinline__ int lds_byte(int r, int c) { const int st = (r >> 4) * 2 + (c >> 5), rr = r & 15, cc = c & 31, ob = rr * 64 + cc * 2; return st * 1024 + (ob ^ (((ob >> 9) & 1) << 5)); }
__host__ __device__ __forceinline__ void stage_rc(int b, int& R, int& C) { const int st = b / 1024, sb = b % 1024, swz = sb ^ (((sb >> 9) & 1) << 5); R = (st >> 1) * 16 + swz / 64; C = (st & 1) * 32 + (swz % 64) / 2; }
__host__ __device__ __forceinline__ int perm32(int rho) { const int n = rho >> 4, i = rho & 15; return 8 * (i >> 2) + 4 * n + (i & 3); }

struct Unit { int pm, pn; };
struct Gemm { const bf16_t* A; const bf16_t* Bt; int M, N, K; };

struct StaticOrder {
    int nM, nN, nwg, G, c;
    __host__ __device__ void init(int M, int N, int G_, int c_) { nM = M / BM; nN = N / BM; nwg = nM * nN; G = G_; c = c_; }
    __host__ __device__ bool next(int i, Unit& u) const {
        const long L = (long)i * G + c; if (L >= nwg) return false;
        int wgid = (int)L; { const int q = nwg / NXCD, r = nwg % NXCD, xcd = wgid % NXCD, off = wgid / NXCD; wgid = (xcd < r ? xcd * (q + 1) : r * (q + 1) + (xcd - r) * q) + off; }
        const int nig = WGM * nN, gid = wgid / nig, fm = gid * WGM, gsz = (nM - fm) < WGM ? (nM - fm) : WGM;
        u.pm = fm + ((wgid % nig) % gsz); u.pn = (wgid % nig) / gsz; return true;
    }
    __device__ __forceinline__ void a_ready(const Unit&) const {}
    __device__ __forceinline__ void done(const Unit&) const {}
};
struct EpiStoreBf16 {
    static constexpr bool PERM = true, AFTER_DRAIN = false;
    bf16_t* O; int ldc;
    __device__ __forceinline__ void operator()(const f32x4 (&acc)[2][2][4][2], const Unit& u, int wr, int wc, int fr, int fq) const {
        const int row0 = u.pm * BM + wr * 64 + fr; const int col0 = u.pn * BM + wc * 32 + 8 * fq;
#pragma unroll
        for (int ai = 0; ai < 2; ++ai)
#pragma unroll
            for (int m = 0; m < 4; ++m) { bf16_t* rowp = O + (size_t)(row0 + ai * HALF + m * 16) * ldc + col0;
#pragma unroll
                for (int bj = 0; bj < 2; ++bj) { const f32x4 v0 = acc[ai][bj][m][0], v1 = acc[ai][bj][m][1];
                    u32x4 w; w.x = pk2(v0[0], v0[1]); w.y = pk2(v0[2], v0[3]); w.z = pk2(v1[0], v1[1]); w.w = pk2(v1[2], v1[3]);
                    *(u32x4*)(rowp + bj * HALF) = w; } }
    }
};
struct EpiResF32 {
    static constexpr bool PERM = false, AFTER_DRAIN = false;
    const float* base; float* out; int ldc;
    __device__ __forceinline__ void operator()(const f32x4 (&acc)[2][2][4][2], const Unit& u, int wr, int wc, int fr, int fq) const {
        const int row0 = u.pm * BM + wr * 64 + fr, col0 = u.pn * BM + wc * 32 + 4 * fq;
#pragma unroll
        for (int ai = 0; ai < 2; ++ai)
#pragma unroll
            for (int m = 0; m < 4; ++m) { const size_t off = (size_t)(row0 + ai * HALF + m * 16) * ldc + col0;
#pragma unroll
                for (int bj = 0; bj < 2; ++bj)
#pragma unroll
                    for (int n = 0; n < 2; ++n) { const f32x4 bs = *(const f32x4*)(base + off + bj * HALF + n * 16);
                        *(f32x4*)(out + off + bj * HALF + n * 16) = bs + acc[ai][bj][m][n]; } }
    }
};
struct EpiPlainF32 {
    static constexpr bool PERM = false, AFTER_DRAIN = false;
    float* C; int ldc;
    __device__ __forceinline__ void operator()(const f32x4 (&acc)[2][2][4][2], const Unit& u, int wr, int wc, int fr, int fq) const {
        const int row0 = u.pm * BM + wr * 64 + fr, col0 = u.pn * BM + wc * 32 + 4 * fq;
#pragma unroll
        for (int ai = 0; ai < 2; ++ai)
#pragma unroll
            for (int m = 0; m < 4; ++m) { float* rowp = C + (size_t)(row0 + ai * HALF + m * 16) * ldc + col0;
#pragma unroll
                for (int bj = 0; bj < 2; ++bj)
#pragma unroll
                    for (int n = 0; n < 2; ++n) *(f32x4*)(rowp + bj * HALF + n * 16) = acc[ai][bj][m][n]; }
    }
};
template <class Epi, class Sched, bool STAMP = false>
__device__ __forceinline__ void gemm_phase(PG8_LAS unsigned char* lds, const Gemm g, const Sched& S, const Epi& E, unsigned long long* stamps) {
    const int tid = threadIdx.x, wid = __builtin_amdgcn_readfirstlane(tid >> 6), lane = tid & 63, wr = wid >> 2, wc = wid & 3, fr = lane & 15, fq = lane >> 4;
    const int K = g.K, nt = K / BK;
    int ts_lo = 0, ts_hi = 0, nts = 0; const unsigned long long rt_entry = STAMP ? (unsigned long long)wall_clock64() : 0ull;
#define PG8_STAMP() do { if (STAMP && wid == 0 && nts < 64) { const unsigned long long _c = (unsigned long long)clock64(); \
        ts_lo = (lane == nts) ? (int)(unsigned)_c : ts_lo; ts_hi = (lane == nts) ? (int)(unsigned)(_c >> 32) : ts_hi; ++nts; } } while (0)
    PG8_STAMP();
    unsigned voffA[2], voffB[2];
#pragma unroll
    for (int i = 0; i < 2; ++i) { int R, C; stage_rc(tid * 16 + i * 8192, R, C); const int Rb = Epi::PERM ? ((R & ~31) + perm32(R & 31)) : R;
        voffA[i] = (unsigned)(R * K + C) * 2u; voffB[i] = (unsigned)(Rb * K + C) * 2u; }
    const size_t kstep = (size_t)(BK * 2);
    const size_t hstep = (size_t)HALF * K * 2;
    const size_t tstep = 2 * hstep;
    const unsigned ldsw = (unsigned)wid * 1024u;
    const int aoff = lds_byte(wr * 64 + fr, fq * 8), boff = lds_byte(wc * 32 + fr, fq * 8);
#define PG8_SA(b, h) (((b) * 2 + (h)) * HTB)
#define PG8_SB(b, h) ((4 + (b) * 2 + (h)) * HTB)
#define PG8_STAGE(bufoff, gbase, voff) do { _Pragma("unroll") for (int _i = 0; _i < 2; ++_i) \
        __builtin_amdgcn_global_load_lds((const unsigned*)((const char*)(gbase) + (voff)[_i]), (PG8_LAS unsigned*)(lds + (bufoff) + ldsw + _i * 8192), 16, 0, 0); } while (0)
#define PG8_LDA(dst, b, h) do { _Pragma("unroll") for (int m = 0; m < 4; ++m) _Pragma("unroll") for (int k = 0; k < 2; ++k) dst[m][k] = *(const PG8_LAS bf16x8*)(lds + PG8_SA(b, h) + aoff + m * 2048 + k * 1024); } while (0)
#define PG8_LDB(dst, b, h) do { _Pragma("unroll") for (int n = 0; n < 2; ++n) _Pragma("unroll") for (int k = 0; k < 2; ++k) dst[n][k] = *(const PG8_LAS bf16x8*)(lds + PG8_SB(b, h) + boff + n * 2048 + k * 1024); } while (0)
#define PG8_MMA(ai, bj, At, Bt) do { __builtin_amdgcn_s_setprio(1); _Pragma("unroll") for (int m = 0; m < 4; ++m) _Pragma("unroll") for (int n = 0; n < 2; ++n) _Pragma("unroll") for (int k = 0; k < 2; ++k) \
        acc[ai][bj][m][n] = __builtin_amdgcn_mfma_f32_16x16x32_bf16(Bt[n][k], At[m][k], acc[ai][bj][m][n], 0, 0, 0); __builtin_amdgcn_s_setprio(0); } while (0)
#define PG8_WAIT_V(n) asm volatile("s_waitcnt vmcnt(" #n ")" ::: "memory")
#define PG8_WAIT_L(n) asm volatile("s_waitcnt lgkmcnt(" #n ")" ::: "memory")
#define PG8_BAR __builtin_amdgcn_s_barrier()
#define PG8_SCHED __builtin_amdgcn_sched_barrier(0)
    Unit cur, nxt; int ui = 0;
    if (!S.next(0, cur)) return;
    f32x4 acc[2][2][4][2];
#pragma unroll
    for (int a = 0; a < 2; ++a)
#pragma unroll
        for (int b = 0; b < 2; ++b)
#pragma unroll
            for (int m = 0; m < 4; ++m)
#pragma unroll
                for (int n = 0; n < 2; ++n) acc[a][b][m][n] = (f32x4){0.f, 0.f, 0.f, 0.f};
    bf16x8 At[4][2], B0[2][2], B1[2][2];
    const char* cA = (const char*)g.A + (size_t)cur.pm * tstep; const char* cB = (const char*)g.Bt + (size_t)cur.pn * tstep;
    S.a_ready(cur);
    PG8_STAGE(PG8_SB(0, 0), cB, voffB); PG8_STAGE(PG8_SA(0, 0), cA, voffA); PG8_STAGE(PG8_SB(0, 1), cB + hstep, voffB); PG8_STAGE(PG8_SA(0, 1), cA + hstep, voffA);
    if (wr == 1) PG8_BAR;
    PG8_WAIT_V(4); PG8_BAR;
    PG8_STAGE(PG8_SB(1, 0), cB + kstep, voffB); PG8_STAGE(PG8_SA(1, 0), cA + kstep, voffA); PG8_STAGE(PG8_SB(1, 1), cB + hstep + kstep, voffB);
    PG8_WAIT_V(6); PG8_BAR;
    PG8_STAMP();
    for (;;) {
        const bool has_next = S.next(ui + 1, nxt);
        const char* nA = has_next ? (const char*)g.A + (size_t)nxt.pm * tstep : cA; const char* nB = has_next ? (const char*)g.Bt + (size_t)nxt.pn * tstep : cB;
        for (int t = 0; t < nt; t += 2) {
            const bool last = (t == nt - 2);
            const char* a1 = cA + (size_t)(t + 1) * kstep;
            const char* a2 = last ? nA : cA + (size_t)(t + 2) * kstep; const char* b2 = last ? nB : cB + (size_t)(t + 2) * kstep;
            const char* a3 = a2 + kstep; const char* b3 = b2 + kstep;
            if (last && has_next) S.a_ready(nxt);
            PG8_LDB(B0, 0, 0); PG8_SCHED; PG8_LDA(At, 0, 0); PG8_STAGE(PG8_SA(1, 1), a1 + hstep, voffA);
            PG8_WAIT_L(8); PG8_BAR; PG8_WAIT_L(0); PG8_MMA(0, 0, At, B0); PG8_BAR; PG8_SCHED;
            PG8_LDB(B1, 0, 1); PG8_STAGE(PG8_SB(0, 0), b2, voffB);
            PG8_BAR; PG8_WAIT_L(0); PG8_MMA(0, 1, At, B1); PG8_BAR;
            PG8_LDA(At, 0, 1); PG8_STAGE(PG8_SA(0, 0), a2, voffA);
            PG8_BAR; PG8_WAIT_L(0); PG8_MMA(1, 0, At, B0); PG8_BAR; PG8_SCHED;
            PG8_STAGE(PG8_SB(0, 1), b2 + hstep, voffB);
            PG8_WAIT_V(6); PG8_BAR; PG8_MMA(1, 1, At, B1); PG8_BAR;
            PG8_LDB(B0, 1, 0); PG8_SCHED; PG8_LDA(At, 1, 0); PG8_STAGE(PG8_SA(0, 1), a2 + hstep, voffA);
            PG8_WAIT_L(8); PG8_BAR; PG8_WAIT_L(0); PG8_MMA(0, 0, At, B0); PG8_BAR; PG8_SCHED;
            PG8_LDB(B1, 1, 1); PG8_STAGE(PG8_SB(1, 0), b3, voffB);
            PG8_BAR; PG8_WAIT_L(0); PG8_MMA(0, 1, At, B1); PG8_BAR;
            PG8_LDA(At, 1, 1); PG8_STAGE(PG8_SA(1, 0), a3, voffA);
            PG8_BAR; PG8_WAIT_L(0); PG8_MMA(1, 0, At, B0); PG8_BAR; PG8_SCHED;
            PG8_STAGE(PG8_SB(1, 1), b3 + hstep, voffB);
            PG8_WAIT_V(6); PG8_BAR; PG8_MMA(1, 1, At, B1); PG8_BAR;
        }
        PG8_STAMP();
        if constexpr (!Epi::AFTER_DRAIN) { E(acc, cur, wr, wc, fr, fq); S.done(cur); }
        PG8_STAMP();
        if (!has_next) break;
#pragma unroll
        for (int a = 0; a < 2; ++a)
#pragma unroll
            for (int b = 0; b < 2; ++b)
#pragma unroll
                for (int m = 0; m < 4; ++m)
#pragma unroll
                    for (int n = 0; n < 2; ++n) acc[a][b][m][n] = (f32x4){0.f, 0.f, 0.f, 0.f};
        cur = nxt; cA = nA; cB = nB; ++ui;
    }
    PG8_WAIT_V(0);
    if (wr == 0) PG8_BAR;
    PG8_BAR;
    if constexpr (Epi::AFTER_DRAIN) { E.fused(acc, cur, wr, wc, fr, fq, lds, wid, lane); S.done(cur); }
    PG8_STAMP();
    if (STAMP && wid == 0) { stamps[lane] = lane < nts ? (((unsigned long long)(unsigned)ts_hi << 32) | (unsigned)ts_lo) : 0ull;
        if (lane == 62) stamps[62] = rt_entry; if (lane == 63) stamps[63] = (unsigned long long)wall_clock64(); }
#undef PG8_STAMP
#undef PG8_SA
#undef PG8_SB
#undef PG8_STAGE
#undef PG8_LDA
#undef PG8_LDB
#undef PG8_MMA
#undef PG8_WAIT_V
#undef PG8_WAIT_L
#undef PG8_BAR
#undef PG8_SCHED
}
}


DI void phase_wconv(LAS unsigned char* lds, const float* __restrict__ src, bf16_t* __restrict__ dst, int K, int N, int Npad, int bid, int nb) {
    LAS float* tile = (LAS float*)lds;
    const int tid = threadIdx.x;
    const int tk = K / 64, tn = Npad / 64, total = tk * tn;
    for (int t = bid; t < total; t += nb) {
        const int k0 = (t % tk) * 64, n0 = (t / tk) * 64;
        __syncthreads();
        {
            const int ty = tid >> 4, tx = tid & 15;
#pragma unroll
            for (int i = 0; i < 2; ++i) {
                const int k = k0 + ty + 32 * i, n = n0 + tx * 4;
                f32x4 v = {0.f, 0.f, 0.f, 0.f};
                if (n < N) v = *(const f32x4*)(src + (size_t)k * N + n);
                LAS float* p = tile + (ty + 32 * i) * 65 + tx * 4;
                p[0] = v[0]; p[1] = v[1]; p[2] = v[2]; p[3] = v[3];
            }
        }
        __syncthreads();
        {
            const int n = tid >> 3, kc = tid & 7;
            float v[8];
#pragma unroll
            for (int j = 0; j < 8; ++j) v[j] = tile[(kc * 8 + j) * 65 + n];
            u32x4 w; w.x = pk2(v[0], v[1]); w.y = pk2(v[2], v[3]); w.z = pk2(v[4], v[5]); w.w = pk2(v[6], v[7]);
            *(u32x4*)(dst + (size_t)(n0 + n) * K + k0 + kc * 8) = w;
        }
    }
}

DI void phase_rmsnorm(const float* __restrict__ x, const float* __restrict__ gain, bf16_t* __restrict__ h, int bid, int nb) {
    const int lane = threadIdx.x & 63, wid = threadIdx.x >> 6;
    for (int row = bid * 8 + wid; row < MTOK; row += nb * 8) {
        const float* xr = x + (size_t)row * DM;
        f32x4 v[16]; float ss = 0.f;
#pragma unroll
        for (int i = 0; i < 16; ++i) { v[i] = *(const f32x4*)(xr + (i * 64 + lane) * 4); ss += v[i][0] * v[i][0] + v[i][1] * v[i][1] + v[i][2] * v[i][2] + v[i][3] * v[i][3]; }
#pragma unroll
        for (int o = 32; o >= 1; o >>= 1) ss += __shfl_xor(ss, o);
        const float rstd = rsqrtf(ss * (1.0f / DM) + EPSN);
        bf16_t* hr = h + (size_t)row * DM;
#pragma unroll
        for (int i = 0; i < 16; ++i) { const f32x4 g = *(const f32x4*)(gain + (i * 64 + lane) * 4);
            u32x2 w; w.x = pk2(v[i][0] * rstd * g[0], v[i][1] * rstd * g[1]); w.y = pk2(v[i][2] * rstd * g[2], v[i][3] * rstd * g[3]);
            *(u32x2*)(hr + (i * 64 + lane) * 4) = w; }
    }
}

DI void ld192(const bf16_t* p, int j8, float (&v)[24]) {
#pragma unroll
    for (int c = 0; c < 3; ++c) { const u32x4 w = *(const u32x4*)(p + (j8 + 8 * c) * 8);
        v[c * 8 + 0] = bflo(w.x); v[c * 8 + 1] = bfhi(w.x); v[c * 8 + 2] = bflo(w.y); v[c * 8 + 3] = bfhi(w.y);
        v[c * 8 + 4] = bflo(w.z); v[c * 8 + 5] = bfhi(w.z); v[c * 8 + 6] = bflo(w.w); v[c * 8 + 7] = bfhi(w.w); }
}
DI void st192(bf16_t* p, int j8, const float (&v)[24]) {
#pragma unroll
    for (int c = 0; c < 3; ++c) { u32x4 w; w.x = pk2(v[c * 8 + 0], v[c * 8 + 1]); w.y = pk2(v[c * 8 + 2], v[c * 8 + 3]); w.z = pk2(v[c * 8 + 4], v[c * 8 + 5]); w.w = pk2(v[c * 8 + 6], v[c * 8 + 7]);
        *(u32x4*)(p + (j8 + 8 * c) * 8) = w; }
}
DI float sum8(float s) { s += __shfl_xor(s, 1); s += __shfl_xor(s, 2); s += __shfl_xor(s, 4); return s; }

DI void phase_nsa_prep(const Params& P, int bid, int nb) {
    bf16_t* Y0 = (bf16_t*)(P.ws + OFF_Y0);
    bf16_t* KS = (bf16_t*)(P.ws + OFF_KS); bf16_t* KW = (bf16_t*)(P.ws + OFF_KW);
    bf16_t* ACK = (bf16_t*)(P.ws + OFF_ACK); bf16_t* ACV = (bf16_t*)(P.ws + OFF_ACV);
    const int tid = threadIdx.x, grp = tid >> 3, j8 = tid & 7;
    for (int tok = bid; tok < MTOK; tok += nb) {
        const int b = tok / SEQ, s = tok % SEQ;
        bf16_t* yr = Y0 + (size_t)tok * N1P;
        {
            float v[24]; ld192(yr + C_Q + grp * DK, j8, v);
            float ss = 0.f;
#pragma unroll
            for (int i = 0; i < 24; ++i) ss += v[i] * v[i];
            ss = sum8(ss);
            const float rstd = rsqrtf(ss * (1.0f / DK) + EPSN) * QSCALE;
#pragma unroll
            for (int c = 0; c < 3; ++c)
#pragma unroll
                for (int e = 0; e < 8; ++e) v[c * 8 + e] *= rstd * P.nsa_q_norm[(j8 + 8 * c) * 8 + e];
            st192(yr + C_Q + grp * DK, j8, v);
        }
        if (grp < 8) {
            const int g = grp & 3, br = grp >> 2;
            float v[24]; ld192(yr + (br ? C_KVW : C_KVS) + g * DK, j8, v);
            float ss = 0.f;
#pragma unroll
            for (int i = 0; i < 24; ++i) ss += v[i] * v[i];
            ss = sum8(ss);
            const float rstd = rsqrtf(ss * (1.0f / DK) + EPSN);
            const float* kn = P.nsa_k_norm + (br ? 2 : 1) * DK;
#pragma unroll
            for (int c = 0; c < 3; ++c)
#pragma unroll
                for (int e = 0; e < 8; ++e) v[c * 8 + e] *= rstd * kn[(j8 + 8 * c) * 8 + e];
            st192((br ? KW : KS) + ((size_t)(b * NG + g) * SEQ + s) * DK, j8, v);
        } else if (grp < 12) {
            const int g = grp - 8;
            float v[24]; ld192(yr + C_KVC + g * DK, j8, v);
#pragma unroll
            for (int k = 0; k < 2; ++k) {
                const int n = (s >> 4) - k, l = s - 16 * n;
                if (n >= 0 && n <= 254) {
                    float w[24];
#pragma unroll
                    for (int c = 0; c < 3; ++c)
#pragma unroll
                        for (int e = 0; e < 8; ++e) w[c * 8 + e] = v[c * 8 + e] + P.pe_k[l * DK + (j8 + 8 * c) * 8 + e];
                    st192(ACK + ((size_t)((b * NG + g) * 256 + n)) * 6144 + l * DK, j8, w);
                }
            }
        } else if (grp < 16) {
            const int g = grp - 12;
            const bf16_t* src = yr + C_KVC + NG * DK + g * DV;
            float v[16];
#pragma unroll
            for (int c = 0; c < 2; ++c) { const u32x4 w = *(const u32x4*)(src + (j8 + 8 * c) * 8);
                v[c * 8 + 0] = bflo(w.x); v[c * 8 + 1] = bfhi(w.x); v[c * 8 + 2] = bflo(w.y); v[c * 8 + 3] = bfhi(w.y);
                v[c * 8 + 4] = bflo(w.z); v[c * 8 + 5] = bfhi(w.z); v[c * 8 + 6] = bflo(w.w); v[c * 8 + 7] = bfhi(w.w); }
#pragma unroll
            for (int k = 0; k < 2; ++k) {
                const int n = (s >> 4) - k, l = s - 16 * n;
                if (n >= 0 && n <= 254) {
                    bf16_t* dst = ACV + ((size_t)((b * NG + g) * 256 + n)) * 4096 + l * DV;
#pragma unroll
                    for (int c = 0; c < 2; ++c) { float w[8];
#pragma unroll
                        for (int e = 0; e < 8; ++e) w[e] = v[c * 8 + e] + P.pe_v[l * DV + (j8 + 8 * c) * 8 + e];
                        u32x4 o; o.x = pk2(w[0], w[1]); o.y = pk2(w[2], w[3]); o.z = pk2(w[4], w[5]); o.w = pk2(w[6], w[7]);
                        *(u32x4*)(dst + (j8 + 8 * c) * 8) = o; }
                }
            }
        }
    }
    for (int i = bid * 512 + tid; i < 16 * (6144 + 4096) / 8; i += nb * 512) {
        const int per = (6144 + 4096) / 8, bg = i / per, c = i % per;
        const u32x4 z = {0u, 0u, 0u, 0u};
        if (c < 6144 / 8) *(u32x4*)(ACK + ((size_t)(bg * 256 + 255)) * 6144 + c * 8) = z;
        else *(u32x4*)(ACV + ((size_t)(bg * 256 + 255)) * 4096 + (c - 6144 / 8) * 8) = z;
    }
}

DI int swap23(int p) { return (p & ~0xC) | ((p & 4) << 1) | ((p & 8) >> 1); }
DI void phase_vt(LAS unsigned char* lds, const bf16_t* __restrict__ src, size_t src_stride, int col0, int col_step, int nhv, bf16_t* __restrict__ dst, int bid, int nb) {
    LAS bf16_t* tile = (LAS bf16_t*)lds;
    const int tid = threadIdx.x;
    const int ntile = SEQ / 64, total = BATCH * nhv * ntile;
    for (int it = bid; it < total; it += nb) {
        const int mat = it / ntile, tt = it % ntile, b = mat / nhv, hv = mat % nhv;
        __syncthreads();
#pragma unroll
        for (int i = 0; i < 2; ++i) {
            const int q = tid + 512 * i, tok = q >> 4, ch = q & 15;
            const u32x4 w = *(const u32x4*)(src + (size_t)(b * SEQ + tt * 64 + tok) * src_stride + col0 + hv * col_step + ch * 8);
            *(LAS u32x4*)(tile + tok * 136 + ch * 8) = w;
        }
        __syncthreads();
        {
            const int dv = tid >> 2, kq = tid & 3;
            unsigned w[8];
#pragma unroll
            for (int e = 0; e < 8; ++e) {
                const int p0 = kq * 16 + 2 * e, p1 = p0 + 1;
                const int k0 = (p0 & ~15) | swap23(p0 & 15), k1 = (p1 & ~15) | swap23(p1 & 15);
                w[e] = (unsigned)tile[k0 * 136 + dv] | ((unsigned)tile[k1 * 136 + dv] << 16);
            }
            bf16_t* d = dst + ((size_t)mat * DV + dv) * SEQ + tt * 64 + kq * 16;
            u32x4 a = {w[0], w[1], w[2], w[3]}, c = {w[4], w[5], w[6], w[7]};
            *(u32x4*)d = a; *(u32x4*)(d + 8) = c;
        }
    }
}

DI void phase_cmp2(LAS unsigned char* lds, const Params& P, int bid, int nb) {
    LAS float* sk = (LAS float*)lds;
    LAS float* sv = sk + 192;
    LAS float* red = sv + 128;
    const float* HIDK = (const float*)(P.ws + OFF_HIDK); const float* HIDV = (const float*)(P.ws + OFF_HIDV);
    bf16_t* KC = (bf16_t*)(P.ws + OFF_KC); bf16_t* VTC = (bf16_t*)(P.ws + OFF_VTC);
    const int tid = threadIdx.x, lane = tid & 63, wid = tid >> 6;
    for (int m = bid; m < 4096; m += nb) {
        const int n = m & 255, bg = m >> 8;
        __syncthreads();
        if (tid < 192) { const float h = HIDK[(size_t)m * 256 + tid]; sk[tid] = h / (1.0f + __expf(-h)); }
        else if (tid < 320) { const float h = HIDV[(size_t)m * 256 + tid - 192]; sv[tid - 192] = h / (1.0f + __expf(-h)); }
        __syncthreads();
        float acc = 0.f;
        if (tid < 192) { for (int i = 0; i < 192; ++i) acc += sk[i] * P.w2_k[i * 192 + tid]; }
        else if (tid < 320) { const int j = tid - 192; for (int i = 0; i < 128; ++i) acc += sv[i] * P.w2_v[i * 128 + j]; }
        float ss = (tid < 192) ? acc * acc : 0.f;
#pragma unroll
        for (int o = 32; o >= 1; o >>= 1) ss += __shfl_xor(ss, o);
        if (lane == 0) red[wid] = ss;
        __syncthreads();
        const float tot = red[0] + red[1] + red[2];
        const float rstd = rsqrtf(tot * (1.0f / DK) + EPSN);
        if (tid < 192) { const float o = (n == 255) ? 0.f : acc * rstd * P.nsa_k_norm[tid];
            KC[(size_t)m * DK + tid] = (bf16_t)(pk2(o, 0.f) & 0xffffu); }
        else if (tid < 320) { const int j = tid - 192; const float o = (n == 255) ? 0.f : acc;
            const int pn = (n & ~15) | swap23(n & 15);
            VTC[((size_t)bg * DV + j) * 256 + pn] = (bf16_t)(pk2(o, 0.f) & 0xffffu); }
    }
}

DI void phase_mla_prep1(const Params& P, int bid, int nb) {
    const bf16_t* Y1 = (const bf16_t*)(P.ws + OFF_Y1);
    bf16_t* CQN = (bf16_t*)(P.ws + OFF_CQN); bf16_t* CKVN = (bf16_t*)(P.ws + OFF_CKVN); float* ROPE = (float*)(P.ws + OFF_ROPE);
    const int lane = threadIdx.x & 63, wid = threadIdx.x >> 6;
    for (int tok = bid * 8 + wid; tok < MTOK; tok += nb * 8) {
        const bf16_t* yr = Y1 + (size_t)tok * N3P;
        {
            float v[24]; float ss = 0.f;
#pragma unroll
            for (int c = 0; c < 3; ++c) { const u32x4 w = *(const u32x4*)(yr + C3_CQ + (c * 64 + lane) * 8);
                v[c * 8 + 0] = bflo(w.x); v[c * 8 + 1] = bfhi(w.x); v[c * 8 + 2] = bflo(w.y); v[c * 8 + 3] = bfhi(w.y);
                v[c * 8 + 4] = bflo(w.z); v[c * 8 + 5] = bfhi(w.z); v[c * 8 + 6] = bflo(w.w); v[c * 8 + 7] = bfhi(w.w); }
#pragma unroll
            for (int i = 0; i < 24; ++i) ss += v[i] * v[i];
#pragma unroll
            for (int o = 32; o >= 1; o >>= 1) ss += __shfl_xor(ss, o);
            const float rstd = rsqrtf(ss * (1.0f / QLORA) + EPSN);
#pragma unroll
            for (int c = 0; c < 3; ++c) { const float* g = P.mla_q_a_norm + (c * 64 + lane) * 8; u32x4 w;
                w.x = pk2(v[c * 8 + 0] * rstd * g[0], v[c * 8 + 1] * rstd * g[1]); w.y = pk2(v[c * 8 + 2] * rstd * g[2], v[c * 8 + 3] * rstd * g[3]);
                w.z = pk2(v[c * 8 + 4] * rstd * g[4], v[c * 8 + 5] * rstd * g[5]); w.w = pk2(v[c * 8 + 6] * rstd * g[6], v[c * 8 + 7] * rstd * g[7]);
                *(u32x4*)(CQN + (size_t)tok * QLORA + (c * 64 + lane) * 8) = w; }
        }
        {
            float v[8]; float ss = 0.f;
            const u32x4 w0 = *(const u32x4*)(yr + C3_CKV + lane * 8);
            v[0] = bflo(w0.x); v[1] = bfhi(w0.x); v[2] = bflo(w0.y); v[3] = bfhi(w0.y); v[4] = bflo(w0.z); v[5] = bfhi(w0.z); v[6] = bflo(w0.w); v[7] = bfhi(w0.w);
#pragma unroll
            for (int i = 0; i < 8; ++i) ss += v[i] * v[i];
#pragma unroll
            for (int o = 32; o >= 1; o >>= 1) ss += __shfl_xor(ss, o);
            const float rstd = rsqrtf(ss * (1.0f / KVLORA) + EPSN);
            const float* g = P.mla_kv_a_norm + lane * 8; u32x4 w;
            w.x = pk2(v[0] * rstd * g[0], v[1] * rstd * g[1]); w.y = pk2(v[2] * rstd * g[2], v[3] * rstd * g[3]);
            w.z = pk2(v[4] * rstd * g[4], v[5] * rstd * g[5]); w.w = pk2(v[6] * rstd * g[6], v[7] * rstd * g[7]);
            *(u32x4*)(CKVN + (size_t)tok * KVLORA + lane * 8) = w;
        }
        if (lane < 32) {
            const float invf = exp2f(-(float)lane * (13.287712379549449f / 32.0f));
            const float ang = (float)P.pos[tok] * invf;
            float sn, cs; sincosf(ang, &sn, &cs);
            ROPE[(size_t)tok * 64 + lane] = cs; ROPE[(size_t)tok * 64 + 32 + lane] = sn;
        }
    }
}

DI void phase_mla_prep2(const Params& P, int bid, int nb) {
    bf16_t* QM = (bf16_t*)(P.ws + OFF_QM); const bf16_t* KVM = (const bf16_t*)(P.ws + OFF_KVM); const bf16_t* Y1 = (const bf16_t*)(P.ws + OFF_Y1);
    bf16_t* KM = (bf16_t*)(P.ws + OFF_KM); const float* ROPE = (const float*)(P.ws + OFF_ROPE);
    const int tid = threadIdx.x, grp = tid >> 3, j8 = tid & 7;
    for (int tok = bid; tok < MTOK; tok += nb) {
        const int b = tok / SEQ, s = tok % SEQ;
        float cs[8], sn[8];
#pragma unroll
        for (int e = 0; e < 8; ++e) { const int i = (8 * j8 + e) & 31; cs[e] = ROPE[(size_t)tok * 64 + i]; sn[e] = ROPE[(size_t)tok * 64 + 32 + i]; }
        {
            bf16_t* qp = QM + (size_t)tok * NQB + grp * DK;
            float v[24]; ld192(qp, j8, v);
            float ss = 0.f;
#pragma unroll
            for (int i = 0; i < 24; ++i) ss += v[i] * v[i];
            ss = sum8(ss);
            const float rstd = rsqrtf(ss * (1.0f / DK) + EPSN);
#pragma unroll
            for (int c = 0; c < 3; ++c)
#pragma unroll
                for (int e = 0; e < 8; ++e) v[c * 8 + e] *= rstd * P.mla_q_norm[(j8 + 8 * c) * 8 + e];
#pragma unroll
            for (int e = 0; e < 8; ++e) { const float mine = v[16 + e], other = __shfl_xor(mine, 4);
                v[16 + e] = (j8 < 4) ? (mine * cs[e] - other * sn[e]) : (mine * cs[e] + other * sn[e]); }
#pragma unroll
            for (int i = 0; i < 24; ++i) v[i] *= QSCALE;
            st192(qp, j8, v);
        }
        {
            const bf16_t* kn = KVM + (size_t)tok * NKVB + grp * 256;
            const bf16_t* kp = Y1 + (size_t)tok * N3P + C3_KPE;
            float v[24];
#pragma unroll
            for (int c = 0; c < 2; ++c) { const u32x4 w = *(const u32x4*)(kn + (j8 + 8 * c) * 8);
                v[c * 8 + 0] = bflo(w.x); v[c * 8 + 1] = bfhi(w.x); v[c * 8 + 2] = bflo(w.y); v[c * 8 + 3] = bfhi(w.y);
                v[c * 8 + 4] = bflo(w.z); v[c * 8 + 5] = bfhi(w.z); v[c * 8 + 6] = bflo(w.w); v[c * 8 + 7] = bfhi(w.w); }
            { const u32x4 w = *(const u32x4*)(kp + j8 * 8);
                v[16] = bflo(w.x); v[17] = bfhi(w.x); v[18] = bflo(w.y); v[19] = bfhi(w.y); v[20] = bflo(w.z); v[21] = bfhi(w.z); v[22] = bflo(w.w); v[23] = bfhi(w.w); }
            float ss = 0.f;
#pragma unroll
            for (int i = 0; i < 24; ++i) ss += v[i] * v[i];
            ss = sum8(ss);
            const float rstd = rsqrtf(ss * (1.0f / DK) + EPSN);
#pragma unroll
            for (int c = 0; c < 3; ++c)
#pragma unroll
                for (int e = 0; e < 8; ++e) v[c * 8 + e] *= rstd * P.mla_k_norm[(j8 + 8 * c) * 8 + e];
#pragma unroll
            for (int e = 0; e < 8; ++e) { const float mine = v[16 + e], other = __shfl_xor(mine, 4);
                v[16 + e] = (j8 < 4) ? (mine * cs[e] - other * sn[e]) : (mine * cs[e] + other * sn[e]); }
            st192(KM + ((size_t)(b * NH + grp) * SEQ + s) * DK, j8, v);
        }
    }
}
#ifndef NO_CMP1
#define NO_CMP1 0
#endif
#ifndef NO_CMP2
#define NO_CMP2 0
#endif
#ifndef NO_SEL
#define NO_SEL 0
#endif
#ifndef NO_WIN
#define NO_WIN 0
#endif
constexpr int KT_BYTES = 64 * 384, VT_BYTES = 128 * 128;
constexpr int L_K = 0, L_V = 2 * KT_BYTES, L_LUT = L_V + 2 * VT_BYTES, LUT_PITCH = 129, L_QS = L_LUT + 16 * LUT_PITCH * 4 + 16  , L_P3 = L_QS + 16 * 256 * 4, L_END = L_P3 + 16 * 256 * 4;
static_assert(L_END <= 131072, "attention LDS");
enum { MODE_MLA = 0, MODE_CMP1 = 1, MODE_CMP2 = 2, MODE_SEL = 3, MODE_WIN = 4 };

#define MFMA32(a, b, c) __builtin_amdgcn_mfma_f32_32x32x16_bf16((a), (b), (c), 0, 0, 0)

struct AttnLane {
    int tq;
    int tw0, tw1;
    int hi, r32;
    const LAS float* lutrow;
    float lut_far;
    unsigned long long mk0, mk1;
    int tk;
    int curblk;
    float inv_l;
    int tokidx;
};

template <int MODE>
DI void attn_pass(LAS unsigned char* lds, const char* __restrict__ Kc, const char* __restrict__ Vc, int vt_stride, int j_lo, int j_hi,
                  const bf16x8 (&q)[12], f32x16 (&o)[4], float& m_run, float& l_run, const AttnLane& A) {
    if (j_lo >= j_hi) return;
    constexpr bool HASV = (MODE != MODE_CMP1);
    int tid = threadIdx.x; asm volatile("" : "+v"(tid));
    const int lane = tid & 63;
    const int hi = lane >> 5, r32 = lane & 31;
    const int wid_ = __builtin_amdgcn_readfirstlane(tid >> 6);
    unsigned kg[3]; unsigned vg[2];
#pragma unroll
    for (int i = 0; i < 3; ++i) { const int pidx = (wid_ * 3 + i) * 64 + lane, row = pidx / 24, cp = pidx % 24; kg[i] = (unsigned)(row * 384 + ((cp ^ ((row >> 1) & 7)) << 4)); }
#pragma unroll
    for (int i = 0; i < 2; ++i) { const int pidx = (wid_ * 2 + i) * 64 + lane, row = pidx >> 3, cp = pidx & 7; vg[i] = (unsigned)(row * vt_stride * 2 + ((cp ^ ((row >> 1) & 7)) << 4)); }
    int kbase[4], vbase[4];
#pragma unroll
    for (int dd = 0; dd < 4; ++dd) { kbase[dd] = r32 * 384 + (((2 * dd + hi) ^ ((r32 >> 1) & 7)) << 4); vbase[dd] = r32 * 128 + (((2 * dd + hi) ^ ((r32 >> 1) & 7)) << 4); }
#define ST_ISSUE(j, buf) do { const char* kp_ = Kc + (size_t)(j) * KT_BYTES; LAS unsigned char* kb_ = lds + L_K + (buf) * KT_BYTES + wid_ * 3072; \
        _Pragma("unroll") for (int i_ = 0; i_ < 3; ++i_) __builtin_amdgcn_global_load_lds((const unsigned*)(kp_ + kg[i_]), (LAS unsigned*)(kb_ + i_ * 1024), 16, 0, 0); \
        if (HASV) { const char* vp_ = Vc + (size_t)(j) * 128; LAS unsigned char* vb_ = lds + L_V + (buf) * VT_BYTES + wid_ * 2048; \
            _Pragma("unroll") for (int i_ = 0; i_ < 2; ++i_) __builtin_amdgcn_global_load_lds((const unsigned*)(vp_ + vg[i_]), (LAS unsigned*)(vb_ + i_ * 1024), 16, 0, 0); } } while (0)
    ST_ISSUE(j_lo, 0);
    asm volatile("s_waitcnt vmcnt(0)" ::: "memory");
    __syncthreads();
    for (int j = j_lo; j < j_hi; ++j) {
        const int cur = (j - j_lo) & 1;
        const bool more = (j + 1 < j_hi);
        if (more) ST_ISSUE(j + 1, cur ^ 1);
        bool act;
        if (MODE == MODE_MLA) act = (64 * j <= A.tw1);
        else if (MODE == MODE_CMP1 || MODE == MODE_CMP2) act = (1024 * j + 31 <= A.tw1);
        else if (MODE == MODE_SEL) act = (((A.mk0 | A.mk1) >> j) & 1ull) != 0ull;
        else act = (64 * j <= A.tw1) && (64 * j + 63 >= A.tw0 - 511);
        if (act) {
            f32x16 p0, p1;
            if (MODE == MODE_MLA) {
#pragma unroll
                for (int r = 0; r < 16; ++r) { p0[r] = 0.f; p1[r] = 0.f; }
            } else if (MODE == MODE_WIN || MODE == MODE_SEL) {
                const int dq = A.tq - 64 * j - 4 * hi;
                const bool far = (A.tw0 - (64 * j + 63) >= 113);
                if (far) {
#pragma unroll
                    for (int r = 0; r < 16; ++r) { p0[r] = A.lut_far; p1[r] = A.lut_far; }
                } else {
#pragma unroll
                    for (int r = 0; r < 16; ++r) { const int c = (r & 3) + 8 * (r >> 2);
                        int d0_ = dq - c, d1_ = dq - c - 32;
                        d0_ = d0_ < 0 ? 0 : (d0_ > 127 ? 127 : d0_); d1_ = d1_ < 0 ? 0 : (d1_ > 127 ? 127 : d1_);
                        p0[r] = A.lutrow[d0_]; p1[r] = A.lutrow[d1_]; }
                }
            } else {
                const int dq = A.tq - 31 - 1024 * j - 64 * hi;
                const bool far = (A.tw0 - 31 - 16 * (64 * j + 63) >= 113);
                if (far) {
#pragma unroll
                    for (int r = 0; r < 16; ++r) { p0[r] = A.lut_far; p1[r] = A.lut_far; }
                } else {
#pragma unroll
                    for (int r = 0; r < 16; ++r) { const int c = 16 * ((r & 3) + 8 * (r >> 2));
                        int d0_ = dq - c, d1_ = dq - c - 512;
                        d0_ = d0_ < 0 ? 0 : (d0_ > 127 ? 127 : d0_); d1_ = d1_ < 0 ? 0 : (d1_ > 127 ? 127 : d1_);
                        p0[r] = A.lutrow[d0_]; p1[r] = A.lutrow[d1_]; }
                }
            }
            const LAS unsigned char* kb = lds + L_K + cur * KT_BYTES;
#pragma unroll
            for (int d0 = 0; d0 < 12; ++d0) {
                const LAS unsigned char* a = kb + kbase[d0 & 3] + (d0 >> 2) * 128;
                const bf16x8 a0 = *(const LAS bf16x8*)a;
                const bf16x8 a1 = *(const LAS bf16x8*)(a + 32 * 384);
                p0 = MFMA32(a0, q[d0], p0);
                p1 = MFMA32(a1, q[d0], p1);
            }
            const float NEG = -__builtin_inff();
            if (MODE == MODE_MLA) {
                if (64 * j + 63 > A.tw0) {
                    const int dq = A.tq - 64 * j - 4 * hi;
#pragma unroll
                    for (int r = 0; r < 16; ++r) { const int c = (r & 3) + 8 * (r >> 2);
                        if (dq - c < 0) p0[r] = NEG;
                        if (dq - c - 32 < 0) p1[r] = NEG; }
                }
            } else if (MODE == MODE_WIN) {
                const int dq = A.tq - 64 * j - 4 * hi;
#pragma unroll
                for (int r = 0; r < 16; ++r) { const int c = (r & 3) + 8 * (r >> 2);
                    if ((unsigned)(dq - c) >= 512u) p0[r] = NEG;
                    if ((unsigned)(dq - c - 32) >= 512u) p1[r] = NEG; }
            } else if (MODE == MODE_SEL) {
                const int dq = A.tq - 64 * j - 4 * hi;
                const bool s0_ = ((A.mk0 >> j) & 1ull) != 0ull, s1_ = ((A.mk1 >> j) & 1ull) != 0ull; const bool sel = A.tk ? s1_ : s0_;
                const bool diag = (j == A.curblk);
#pragma unroll
                for (int r = 0; r < 16; ++r) { const int c = (r & 3) + 8 * (r >> 2);
                    if (!sel || (diag && dq - c < 0)) p0[r] = NEG;
                    if (!sel || (diag && dq - c - 32 < 0)) p1[r] = NEG; }
            } else {
                const int dq = A.tq - 31 - 1024 * j - 64 * hi;
#pragma unroll
                for (int r = 0; r < 16; ++r) { const int c = 16 * ((r & 3) + 8 * (r >> 2));
                    if (dq - c < 0) p0[r] = NEG;
                    if (dq - c - 512 < 0) p1[r] = NEG; }
            }
            if (MODE == MODE_CMP2) {
                const float mm = m_run, il = A.inv_l;
#pragma unroll
                for (int r = 0; r < 16; ++r) { p0[r] = __builtin_amdgcn_exp2f(p0[r] - mm) * il; p1[r] = __builtin_amdgcn_exp2f(p1[r] - mm) * il; }
                float v[16];
#pragma unroll
                for (int k = 0; k < 4; ++k) { v[k] = (p0[4 * k] + p0[4 * k + 1]) + (p0[4 * k + 2] + p0[4 * k + 3]); v[4 + k] = (p1[4 * k] + p1[4 * k + 1]) + (p1[4 * k + 2] + p1[4 * k + 3]);
                    v[8 + k] = p0[4 * k + 3]; v[12 + k] = p1[4 * k + 3]; }
                { const bool up = (lane & 8) != 0;
#pragma unroll
                  for (int i = 0; i < 8; ++i) { const float send = up ? v[i] : v[i + 8]; const float recv = __shfl_xor(send, 8); const float keep = up ? v[i + 8] : v[i]; v[i] = keep + recv; } }
                { const bool up = (lane & 4) != 0;
#pragma unroll
                  for (int i = 0; i < 4; ++i) { const float send = up ? v[i] : v[i + 4]; const float recv = __shfl_xor(send, 4); const float keep = up ? v[i + 4] : v[i]; v[i] = keep + recv; } }
                { const bool up = (lane & 2) != 0;
#pragma unroll
                  for (int i = 0; i < 2; ++i) { const float send = up ? v[i] : v[i + 2]; const float recv = __shfl_xor(send, 2); const float keep = up ? v[i + 2] : v[i]; v[i] = keep + recv; } }
                { const bool up = (lane & 1) != 0;
                  const float send = up ? v[0] : v[1]; const float recv = __shfl_xor(send, 1); const float keep = up ? v[1] : v[0]; v[0] = keep + recv; }
                { const int idx = lane & 15, half = (idx >> 2) & 1, k = idx & 3, isp3 = idx >> 3;
                  const int quad = 16 * j + 8 * half + 2 * k + hi;
                  LAS float* dst = (LAS float*)(lds + (isp3 ? L_P3 : L_QS)) + A.tokidx * 256 + quad;
                  *dst = v[0]; }
            } else {
                float mx = p0[0];
#pragma unroll
                for (int r = 1; r < 16; ++r) mx = fmaxf(mx, p0[r]);
#pragma unroll
                for (int r = 0; r < 16; ++r) mx = fmaxf(mx, p1[r]);
                mx = fmaxf(mx, __shfl_xor(mx, 32));
                const float mnew = fmaxf(m_run, mx);
                const float alpha = __builtin_amdgcn_exp2f(m_run - mnew);
                m_run = mnew;
                float ps = 0.f;
#pragma unroll
                for (int r = 0; r < 16; ++r) { p0[r] = __builtin_amdgcn_exp2f(p0[r] - mnew); p1[r] = __builtin_amdgcn_exp2f(p1[r] - mnew); ps += p0[r] + p1[r]; }
                l_run = l_run * alpha + ps;
                if (HASV) {
                    if (__any(alpha != 1.0f)) {
#pragma unroll
                        for (int d = 0; d < 4; ++d)
#pragma unroll
                            for (int r = 0; r < 16; ++r) o[d][r] *= alpha;
                    }
                }
            }
            if (HASV) {
                const LAS unsigned char* vb = lds + L_V + cur * VT_BYTES;
#pragma unroll
                for (int ks = 0; ks < 4; ++ks) {
                    u32x4 w;
                    if (ks == 0) { w.x = pk2(p0[0], p0[1]); w.y = pk2(p0[2], p0[3]); w.z = pk2(p0[4], p0[5]); w.w = pk2(p0[6], p0[7]); }
                    else if (ks == 1) { w.x = pk2(p0[8], p0[9]); w.y = pk2(p0[10], p0[11]); w.z = pk2(p0[12], p0[13]); w.w = pk2(p0[14], p0[15]); }
                    else if (ks == 2) { w.x = pk2(p1[0], p1[1]); w.y = pk2(p1[2], p1[3]); w.z = pk2(p1[4], p1[5]); w.w = pk2(p1[6], p1[7]); }
                    else { w.x = pk2(p1[8], p1[9]); w.y = pk2(p1[10], p1[11]); w.z = pk2(p1[12], p1[13]); w.w = pk2(p1[14], p1[15]); }
                    const bf16x8 pb = __builtin_bit_cast(bf16x8, w);
#pragma unroll
                    for (int d = 0; d < 4; ++d) {
                        const bf16x8 va = *(const LAS bf16x8*)(vb + vbase[ks] + d * (32 * 128));
                        o[d] = MFMA32(va, pb, o[d]);
                    }
                }
            }
        }
        asm volatile("s_waitcnt vmcnt(0)" ::: "memory");
        __syncthreads();
    }
#undef ST_ISSUE
}

DI int t5_bucket(int n) {
    if (n < 16) return n;
    return 16 + (n >= 19) + (n >= 21) + (n >= 24) + (n >= 27) + (n >= 31) + (n >= 35) + (n >= 40) + (n >= 46) + (n >= 52) + (n >= 59) + (n >= 67) + (n >= 77) + (n >= 87) + (n >= 99) + (n >= 113);
}
DI float silu_f(float z) { return z / (1.0f + __expf(-z)); }

template <bool RMW>
DI void attn_epilogue(const f32x16 (&o)[4], float scale, const char* __restrict__ zbase, unsigned zoff, char* __restrict__ obase, unsigned ooff, int hi) {
#pragma unroll
    for (int d = 0; d < 4; ++d)
#pragma unroll
        for (int kq = 0; kq < 4; ++kq) {
            const unsigned dvb = (unsigned)(32 * d + 8 * kq + 4 * hi) * 2u;
            const u32x2 zw = *(const u32x2*)(zbase + (zoff + dvb));
            float v0 = o[d][4 * kq + 0] * scale * silu_f(bflo(zw.x)), v1 = o[d][4 * kq + 1] * scale * silu_f(bfhi(zw.x));
            float v2 = o[d][4 * kq + 2] * scale * silu_f(bflo(zw.y)), v3 = o[d][4 * kq + 3] * scale * silu_f(bfhi(zw.y));
            if (RMW) { const u32x2 pw = *(const u32x2*)(obase + (ooff + dvb)); v0 += bflo(pw.x); v1 += bfhi(pw.x); v2 += bflo(pw.y); v3 += bfhi(pw.y); }
            u32x2 w; w.x = pk2(v0, v1); w.y = pk2(v2, v3);
            *(u32x2*)(obase + (ooff + dvb)) = w;
        }
}

DI void phase_nsa_attn(LAS unsigned char* lds, const Params& P, int bid, int nb) {
    const char* Y0c = (const char*)(P.ws + OFF_Y0);
    const char* KSc = (const char*)(P.ws + OFF_KS); const char* KWc = (const char*)(P.ws + OFF_KW);
    const char* VTSc = (const char*)(P.ws + OFF_VTS); const char* VTWc = (const char*)(P.ws + OFF_VTW);
    const char* KCc = (const char*)(P.ws + OFF_KC); const char* VTCc = (const char*)(P.ws + OFF_VTC);
    char* ONc = (char*)(P.ws + OFF_O);
    LAS float* lut = (LAS float*)(lds + L_LUT);
    const int total = BATCH * NG * 256;
    for (int u = bid; u < total; u += nb) {
        int tid = threadIdx.x; asm volatile("" : "+v"(tid));
        const int lane = tid & 63, wid = __builtin_amdgcn_readfirstlane(tid >> 6);
        const int pair = u >> 8; int c = u & 255; if (pair & 1) c = 255 - c;
        const int b = pair >> 2, g = pair & 3, t0 = c * 16;
        __syncthreads();
        for (int i = tid; i < 16 * 128; i += 512) { const int r = i >> 7, d = i & 127; lut[r * LUT_PITCH + d] = P.rel_bias[t5_bucket(d) * NH + g * NR + r] * LOG2E; }
        __syncthreads();
        AttnLane A;
        A.hi = lane >> 5; A.r32 = lane & 31;
        const int r = lane & 15;
        A.tk = (lane >> 4) & 1;
        A.tw0 = t0 + 2 * wid; A.tw1 = A.tw0 + 1; A.tq = A.tw0 + A.tk;
        A.lutrow = lut + r * LUT_PITCH; A.lut_far = A.lutrow[127];
        A.curblk = t0 >> 6; A.tokidx = 2 * wid + A.tk; A.mk0 = 0ull; A.mk1 = 0ull; A.inv_l = 0.f;
        const int hh = g * NR + r;
        const unsigned yoff = (unsigned)(b * SEQ + A.tq) * (unsigned)(N1P * 2);
        const unsigned ooff = ((unsigned)(b * SEQ + A.tq) * (unsigned)ZW8 + (unsigned)(hh * DV)) * 2u;
        bf16x8 q[12];
        { const unsigned qo = yoff + (unsigned)((C_Q + hh * DK + 8 * A.hi) * 2);
#pragma unroll
          for (int d0 = 0; d0 < 12; ++d0) q[d0] = *(const bf16x8*)(Y0c + (qo + 32u * d0)); }
        const int bg = b * NG + g;
        f32x16 o[4]; float m_run, l_run;
#define RESET_STATE() do { _Pragma("unroll") for (int d_ = 0; d_ < 4; ++d_) _Pragma("unroll") for (int r_ = 0; r_ < 16; ++r_) o[d_][r_] = 0.f; m_run = -1e30f; l_run = 0.f; } while (0)
        const int nct = (t0 + 15 >= 31) ? (((t0 + 15 - 31) >> 4) / 64 + 1) : 0;
        RESET_STATE();
        if (!NO_CMP1) attn_pass<MODE_CMP1>(lds, KCc + (size_t)bg * 256 * DK * 2, nullptr, 0, 0, nct, q, o, m_run, l_run, A);
        { const float lt = l_run + __shfl_xor(l_run, 32); A.inv_l = lt > 0.f ? 1.0f / lt : 0.f; }
        if (!NO_CMP2) attn_pass<MODE_CMP2>(lds, KCc + (size_t)bg * 256 * DK * 2, VTCc + (size_t)bg * DV * 256 * 2, 256, 0, nct, q, o, m_run, l_run, A);
        { const float gv = bf1(*(const bf16_t*)(Y0c + (yoff + (unsigned)((C_G + 0 * NH + hh) * 2)))); const float sg = 1.0f / (1.0f + __expf(-gv));
          attn_epilogue<false>(o, sg, Y0c, yoff + (unsigned)((C_ZC + hh * DV) * 2), ONc, ooff, A.hi); }
        __syncthreads();
        {
            const int cur = A.curblk;
            unsigned long long mk[2];
#pragma unroll
            for (int t = 0; t < 2; ++t) {
                const LAS float* QS = (const LAS float*)(lds + L_QS) + (2 * wid + t) * 256;
                const LAS float* P3 = (const LAS float*)(lds + L_P3) + (2 * wid + t) * 256;
                const bool forced = (lane == 0) || (lane == cur) || (lane == cur - 1);
                const bool future = lane > cur;
                float v = 0.f;
                if (!forced && !future) v = QS[lane] + P3[lane - 1];
                unsigned key = (__float_as_uint(v) & ~63u);
                if (forced) key = 0x7f800000u; else if (future) key = 0u;
                key |= (unsigned)(63 - lane);
                int rank = 0;
#pragma unroll
                for (int jp = 0; jp < 64; ++jp) { const unsigned kj = (unsigned)__builtin_amdgcn_readlane((int)key, jp); rank += (kj > key) ? 1 : 0; }
                mk[t] = __ballot(rank < 16 && !future);
            }
            A.mk0 = mk[0]; A.mk1 = mk[1];
        }
        RESET_STATE();
        if (!NO_SEL) attn_pass<MODE_SEL>(lds, KSc + (size_t)bg * SEQ * DK * 2, VTSc + (size_t)bg * DV * SEQ * 2, SEQ, 0, A.curblk + 1, q, o, m_run, l_run, A);
        { const float lt = l_run + __shfl_xor(l_run, 32); const float gv = bf1(*(const bf16_t*)(Y0c + (yoff + (unsigned)((C_G + 1 * NH + hh) * 2)))); const float sg = 1.0f / (1.0f + __expf(-gv));
          attn_epilogue<true>(o, sg / lt, Y0c, yoff + (unsigned)((C_ZS + hh * DV) * 2), ONc, ooff, A.hi); }
        RESET_STATE();
        { const int jl = (t0 - 511) > 0 ? (t0 - 511) >> 6 : 0, jh = ((t0 + 15) >> 6) + 1;
          if (!NO_WIN) attn_pass<MODE_WIN>(lds, KWc + (size_t)bg * SEQ * DK * 2, VTWc + (size_t)bg * DV * SEQ * 2, SEQ, jl, jh, q, o, m_run, l_run, A); }
        { const float lt = l_run + __shfl_xor(l_run, 32); const float gv = bf1(*(const bf16_t*)(Y0c + (yoff + (unsigned)((C_G + 2 * NH + hh) * 2)))); const float sg = 1.0f / (1.0f + __expf(-gv));
          attn_epilogue<true>(o, sg / lt, Y0c, yoff + (unsigned)((C_ZW + hh * DV) * 2), ONc, ooff, A.hi); }
#undef RESET_STATE
    }
}

DI void phase_mla_attn(LAS unsigned char* lds, const Params& P, int bid, int nb) {
    const char* QMc = (const char*)(P.ws + OFF_QM); const char* KMc = (const char*)(P.ws + OFF_KM); const char* VTMc = (const char*)(P.ws + OFF_VTM);
    const char* Y1c = (const char*)(P.ws + OFF_Y1); char* OMc = (char*)(P.ws + OFF_O);
    const int total = BATCH * NH * 16;
    for (int u = bid; u < total; u += nb) {
        int tid = threadIdx.x; asm volatile("" : "+v"(tid));
        const int lane = tid & 63, wid = __builtin_amdgcn_readfirstlane(tid >> 6);
        const int bh = u & 255, qb = 15 - (u >> 8), b = bh >> 6, h = bh & 63, t0 = qb * 256;
        AttnLane A;
        A.hi = lane >> 5; A.r32 = lane & 31; A.tk = 0;
        A.tw0 = t0 + 32 * wid; A.tw1 = A.tw0 + 31; A.tq = A.tw0 + A.r32;
        A.lutrow = nullptr; A.lut_far = 0.f; A.curblk = 0; A.tokidx = 0; A.mk0 = 0ull; A.mk1 = 0ull; A.inv_l = 0.f;
        const unsigned trow = (unsigned)(b * SEQ + A.tq);
        bf16x8 q[12];
        { const unsigned qo = (trow * (unsigned)NQB + (unsigned)(h * DK + 8 * A.hi)) * 2u;
#pragma unroll
          for (int d0 = 0; d0 < 12; ++d0) q[d0] = *(const bf16x8*)(QMc + (qo + 32u * d0)); }
        f32x16 o[4]; float m_run = -1e30f, l_run = 0.f;
#pragma unroll
        for (int d = 0; d < 4; ++d)
#pragma unroll
            for (int r = 0; r < 16; ++r) o[d][r] = 0.f;
        attn_pass<MODE_MLA>(lds, KMc + (size_t)bh * SEQ * DK * 2, VTMc + (size_t)bh * DV * SEQ * 2, SEQ, 0, 4 * qb + 4, q, o, m_run, l_run, A);
        const float lt = l_run + __shfl_xor(l_run, 32);
        attn_epilogue<false>(o, 1.0f / lt, Y1c, (trow * (unsigned)N3P + (unsigned)(C3_Z + h * DV)) * 2u, OMc, (trow * (unsigned)ZW8 + (unsigned)(h * DV)) * 2u, A.hi);
    }
}
constexpr int LDS_BYTES = 131072;
constexpr int NPHASE = 14;

template <int PH>
DI void run_phase(const Params& P, LAS unsigned char* lds, int bid, int nb) {
    unsigned char* ws = P.ws;
    if constexpr (PH == 0) {
        phase_wconv(lds, P.nsa_w_in, (bf16_t*)(ws + OFF_W1T), DM, N1, N1P, bid, nb);
        phase_wconv(lds, P.nsa_w_out, (bf16_t*)(ws + OFF_W2T), ZW8, DM, DM, bid, nb);
        phase_wconv(lds, P.mla_w_in, (bf16_t*)(ws + OFF_W3T), DM, N3, N3P, bid, nb);
        phase_wconv(lds, P.mla_w_q_b, (bf16_t*)(ws + OFF_W4T), QLORA, NQB, NQB, bid, nb);
        phase_wconv(lds, P.mla_w_kv_b, (bf16_t*)(ws + OFF_W5T), KVLORA, NKVB, NKVB, bid, nb);
        phase_wconv(lds, P.mla_w_out, (bf16_t*)(ws + OFF_W6T), ZW8, DM, DM, bid, nb);
        phase_wconv(lds, P.w1_k, (bf16_t*)(ws + OFF_W1K), 6144, 192, 256, bid, nb);
        phase_wconv(lds, P.w1_v, (bf16_t*)(ws + OFF_W1V), 4096, 128, 256, bid, nb);
        phase_rmsnorm(P.x, P.norm_w, (bf16_t*)(ws + OFF_H), bid, nb);
    } else if constexpr (PH == 1) {
        pg8::Gemm g{(const bf16_t*)(ws + OFF_H), (const bf16_t*)(ws + OFF_W1T), MTOK, N1P, DM};
        pg8::StaticOrder S; S.init(g.M, g.N, nb, bid);
        pg8::EpiStoreBf16 E{(bf16_t*)(ws + OFF_Y0), N1P};
        pg8::gemm_phase<pg8::EpiStoreBf16, pg8::StaticOrder, false>(lds, g, S, E, nullptr);
    } else if constexpr (PH == 2) {
        phase_nsa_prep(P, bid, nb);
        phase_vt(lds, (const bf16_t*)(ws + OFF_Y0), N1P, C_KVS + NG * DK, DV, NG, (bf16_t*)(ws + OFF_VTS), bid, nb);
        phase_vt(lds, (const bf16_t*)(ws + OFF_Y0), N1P, C_KVW + NG * DK, DV, NG, (bf16_t*)(ws + OFF_VTW), bid, nb);
    } else if constexpr (PH == 3) {
        if (bid < 16) {
            pg8::Gemm g{(const bf16_t*)(ws + OFF_ACK), (const bf16_t*)(ws + OFF_W1K), 4096, 256, 6144};
            pg8::StaticOrder S; S.init(g.M, g.N, 16, bid);
            pg8::EpiPlainF32 E{(float*)(ws + OFF_HIDK), 256};
            pg8::gemm_phase<pg8::EpiPlainF32, pg8::StaticOrder, false>(lds, g, S, E, nullptr);
        } else if (bid < 32) {
            pg8::Gemm g{(const bf16_t*)(ws + OFF_ACV), (const bf16_t*)(ws + OFF_W1V), 4096, 256, 4096};
            pg8::StaticOrder S; S.init(g.M, g.N, 16, bid - 16);
            pg8::EpiPlainF32 E{(float*)(ws + OFF_HIDV), 256};
            pg8::gemm_phase<pg8::EpiPlainF32, pg8::StaticOrder, false>(lds, g, S, E, nullptr);
        }
    } else if constexpr (PH == 4) {
        phase_cmp2(lds, P, bid, nb);
    } else if constexpr (PH == 5) {
        phase_nsa_attn(lds, P, bid, nb);
    } else if constexpr (PH == 6) {
        pg8::Gemm g{(const bf16_t*)(ws + OFF_O), (const bf16_t*)(ws + OFF_W2T), MTOK, DM, ZW8};
        pg8::StaticOrder S; S.init(g.M, g.N, nb, bid);
        pg8::EpiResF32 E{P.x, P.out, DM};
        pg8::gemm_phase<pg8::EpiResF32, pg8::StaticOrder, false>(lds, g, S, E, nullptr);
    } else if constexpr (PH == 7) {
        phase_rmsnorm(P.out, P.norm_w + DM, (bf16_t*)(ws + OFF_H), bid, nb);
    } else if constexpr (PH == 8) {
        pg8::Gemm g{(const bf16_t*)(ws + OFF_H), (const bf16_t*)(ws + OFF_W3T), MTOK, N3P, DM};
        pg8::StaticOrder S; S.init(g.M, g.N, nb, bid);
        pg8::EpiStoreBf16 E{(bf16_t*)(ws + OFF_Y1), N3P};
        pg8::gemm_phase<pg8::EpiStoreBf16, pg8::StaticOrder, false>(lds, g, S, E, nullptr);
    } else if constexpr (PH == 9) {
        phase_mla_prep1(P, bid, nb);
    } else if constexpr (PH == 10) {
        {
            pg8::Gemm g{(const bf16_t*)(ws + OFF_CQN), (const bf16_t*)(ws + OFF_W4T), MTOK, NQB, QLORA};
            pg8::StaticOrder S; S.init(g.M, g.N, nb, bid);
            pg8::EpiStoreBf16 E{(bf16_t*)(ws + OFF_QM), NQB};
            pg8::gemm_phase<pg8::EpiStoreBf16, pg8::StaticOrder, false>(lds, g, S, E, nullptr);
        }
        __syncthreads();
        {
            pg8::Gemm g{(const bf16_t*)(ws + OFF_CKVN), (const bf16_t*)(ws + OFF_W5T), MTOK, NKVB, KVLORA};
            pg8::StaticOrder S; S.init(g.M, g.N, nb, bid);
            pg8::EpiStoreBf16 E{(bf16_t*)(ws + OFF_KVM), NKVB};
            pg8::gemm_phase<pg8::EpiStoreBf16, pg8::StaticOrder, false>(lds, g, S, E, nullptr);
        }
    } else if constexpr (PH == 11) {
        phase_mla_prep2(P, bid, nb);
        phase_vt(lds, (const bf16_t*)(ws + OFF_KVM), NKVB, 128, 256, NH, (bf16_t*)(ws + OFF_VTM), bid, nb);
    } else if constexpr (PH == 12) {
        phase_mla_attn(lds, P, bid, nb);
    } else if constexpr (PH == 13) {
        pg8::Gemm g{(const bf16_t*)(ws + OFF_O), (const bf16_t*)(ws + OFF_W6T), MTOK, DM, ZW8};
        pg8::StaticOrder S; S.init(g.M, g.N, nb, bid);
        pg8::EpiResF32 E{P.out, P.out, DM};
        pg8::gemm_phase<pg8::EpiResF32, pg8::StaticOrder, false>(lds, g, S, E, nullptr);
    }
}

template <int PH> __global__ __launch_bounds__(512, 2) void k_phase(Params P) {
    extern __shared__ __attribute__((aligned(16))) unsigned char shm[];
    run_phase<PH>(P, (LAS unsigned char*)shm, (int)blockIdx.x, (int)gridDim.x);
}

template <int PH> static void launch_phase(const Params& P, int grid, hipStream_t stream) {
    static bool attr = false;
    if (!attr) { (void)hipFuncSetAttribute((const void*)k_phase<PH>, hipFuncAttributeMaxDynamicSharedMemorySize, LDS_BYTES); attr = true; }
    hipLaunchKernelGGL((k_phase<PH>), dim3(grid), dim3(512), LDS_BYTES, stream, P);
}

extern "C" void kernel_launch(void* const* d_in, const int* in_sizes, int n_in, void* d_out, int out_size, void* d_ws, size_t ws_size, hipStream_t stream) {
    (void)in_sizes; (void)n_in; (void)out_size;
    if (ws_size < WS_END) return;
    Params P{};
    P.x = (const float*)d_in[0]; P.pos = (const int*)d_in[1]; P.norm_w = (const float*)d_in[2]; P.rel_bias = (const float*)d_in[3];
    P.nsa_w_in = (const float*)d_in[4]; P.nsa_q_norm = (const float*)d_in[5]; P.nsa_k_norm = (const float*)d_in[6]; P.pe_k = (const float*)d_in[7];
    P.w1_k = (const float*)d_in[8]; P.w2_k = (const float*)d_in[9]; P.pe_v = (const float*)d_in[10]; P.w1_v = (const float*)d_in[11]; P.w2_v = (const float*)d_in[12];
    P.nsa_w_out = (const float*)d_in[13]; P.mla_w_in = (const float*)d_in[14]; P.mla_q_a_norm = (const float*)d_in[15]; P.mla_w_q_b = (const float*)d_in[16];
    P.mla_kv_a_norm = (const float*)d_in[17]; P.mla_w_kv_b = (const float*)d_in[18]; P.mla_q_norm = (const float*)d_in[19]; P.mla_k_norm = (const float*)d_in[20];
    P.mla_w_out = (const float*)d_in[21];
    P.out = (float*)d_out; P.ws = (unsigned char*)d_ws;
    static int grid = 0;
    if (!grid) { int dev = 0, cus = 0; (void)hipGetDevice(&dev); if (hipDeviceGetAttribute(&cus, hipDeviceAttributeMultiprocessorCount, dev) != hipSuccess || cus <= 0) cus = 256; grid = cus; }
    launch_phase<0>(P, grid, stream); launch_phase<1>(P, grid, stream); launch_phase<2>(P, grid, stream); launch_phase<3>(P, grid, stream);
    launch_phase<4>(P, grid, stream); launch_phase<5>(P, grid, stream); launch_phase<6>(P, grid, stream); launch_phase<7>(P, grid, stream);
    launch_phase<8>(P, grid, stream); launch_phase<9>(P, grid, stream); launch_phase<10>(P, grid, stream); launch_phase<11>(P, grid, stream);
    launch_phase<12>(P, grid, stream); launch_phase<13>(P, grid, stream);
}
```

```cpp
#include <hip/hip_runtime.h>
#include <stdint.h>
#include <stddef.h>

#define DI __device__ __forceinline__
#define LAS __attribute__((address_space(3)))
typedef unsigned short bf16_t;
typedef short bf16x8 __attribute__((ext_vector_type(8)));
typedef float f32x4 __attribute__((ext_vector_type(4)));
typedef float f32x16 __attribute__((ext_vector_type(16)));
typedef unsigned u32x4 __attribute__((ext_vector_type(4)));
typedef unsigned u32x2 __attribute__((ext_vector_type(2)));
typedef __bf16 bf2_t __attribute__((ext_vector_type(2)));
typedef float f2_t __attribute__((ext_vector_type(2)));

DI int tid_opaque() { int t = (int)threadIdx.x; asm volatile("" : "+v"(t)); return t; }
DI unsigned pk2(float a, float b) { f2_t f = {a, b}; bf2_t v = __builtin_convertvector(f, bf2_t); return __builtin_bit_cast(unsigned, v); }
DI float bflo(unsigned w) { return __uint_as_float(w << 16); }
DI float bfhi(unsigned w) { return __uint_as_float(w & 0xffff0000u); }
DI float bf1(bf16_t h) { return __uint_as_float(((unsigned)h) << 16); }

constexpr int BATCH = 4, SEQ = 4096, DM = 4096, MTOK = BATCH * SEQ;
constexpr int NH = 64, NG = 4, NR = 16, DK = 192, DV = 128;
constexpr int N1 = 40896, N1P = 40960;
constexpr int C_Q = 0, C_KVC = 12288, C_KVS = 13568, C_KVW = 14848, C_ZC = 16128, C_ZS = 24320, C_ZW = 32512, C_G = 40704;
constexpr int N3 = 10304, N3P = 10496;
constexpr int C3_CQ = 0, C3_CKV = 1536, C3_KPE = 2048, C3_Z = 2112;
constexpr int QLORA = 1536, KVLORA = 512;
constexpr int NQB = 12288, NKVB = 16384, ZW8 = 8192;
constexpr float EPSN = 1e-6f;
constexpr float LOG2E = 1.4426950408889634f;
constexpr float QSCALE = 0.07216878364870322f * 1.4426950408889634f;

constexpr size_t SZ_W1T = (size_t)N1P * DM * 2, SZ_W2T = (size_t)DM * ZW8 * 2, SZ_W3T = (size_t)N3P * DM * 2, SZ_W4T = (size_t)NQB * QLORA * 2,
                 SZ_W5T = (size_t)NKVB * KVLORA * 2, SZ_W6T = (size_t)DM * ZW8 * 2;
constexpr size_t OFF_W1T = 0, OFF_W2T = OFF_W1T + SZ_W1T, OFF_W3T = OFF_W2T + SZ_W2T, OFF_W4T = OFF_W3T + SZ_W3T, OFF_W5T = OFF_W4T + SZ_W4T,
                 OFF_W6T = OFF_W5T + SZ_W5T, OFF_W1K = OFF_W6T + SZ_W6T;
constexpr size_t SZ_W1K = (size_t)256 * 6144 * 2, SZ_W1V = (size_t)256 * 4096 * 2;
constexpr size_t OFF_W1V = OFF_W1K + SZ_W1K, OFF_CTL = OFF_W1V + SZ_W1V, OFF_H = OFF_CTL + 65536;
constexpr size_t SZ_H = (size_t)MTOK * DM * 2, SZ_KS = (size_t)BATCH * NG * SEQ * DK * 2, SZ_VTS = (size_t)BATCH * NG * DV * SEQ * 2,
                 SZ_ACK = (size_t)4096 * 6144 * 2, SZ_ACV = (size_t)4096 * 4096 * 2;
constexpr size_t OFF_KS = OFF_H + SZ_H, OFF_KW = OFF_KS + SZ_KS, OFF_VTS = OFF_KW + SZ_KS, OFF_VTW = OFF_VTS + SZ_VTS, OFF_ACK = OFF_VTW + SZ_VTS,
                 OFF_ACV = OFF_ACK + SZ_ACK, OFF_KC = OFF_ACV + SZ_ACV;
constexpr size_t SZ_KC = (size_t)16 * 256 * DK * 2, SZ_VTC = (size_t)16 * DV * 256 * 2, SZ_HID = (size_t)4096 * 256 * 4;
constexpr size_t OFF_VTC = OFF_KC + SZ_KC, OFF_HIDK = OFF_VTC + SZ_VTC, OFF_HIDV = OFF_HIDK + SZ_HID, OFF_Y0 = OFF_HIDV + SZ_HID;
constexpr size_t SZ_Y0 = (size_t)MTOK * N1P * 2, SZ_O = (size_t)MTOK * ZW8 * 2;
constexpr size_t OFF_O = OFF_Y0 + SZ_Y0, WS_END = OFF_O + SZ_O;
constexpr size_t OFF_KM = 0;
constexpr size_t SZ_KM = (size_t)BATCH * NH * SEQ * DK * 2;
static_assert(SZ_KM <= SZ_W1T + SZ_W2T, "KM alias");
constexpr size_t OFF_VTM = OFF_H;
constexpr size_t SZ_VTM = (size_t)BATCH * NH * DV * SEQ * 2;
constexpr size_t OFF_CKVN = OFF_VTM + SZ_VTM;
constexpr size_t SZ_CKVN = (size_t)MTOK * KVLORA * 2;
static_assert(OFF_CKVN + SZ_CKVN <= OFF_KC, "CKVN alias");
constexpr size_t OFF_Y1 = OFF_Y0, SZ_Y1 = (size_t)MTOK * N3P * 2;
constexpr size_t OFF_QM = OFF_Y1 + SZ_Y1, SZ_QM = (size_t)MTOK * NQB * 2;
constexpr size_t OFF_KVM = OFF_QM + SZ_QM, SZ_KVM = (size_t)MTOK * NKVB * 2;
constexpr size_t OFF_CQN = OFF_KVM + SZ_KVM, SZ_CQN = (size_t)MTOK * QLORA * 2;
constexpr size_t OFF_ROPE = OFF_CQN + SZ_CQN, SZ_ROPE = (size_t)MTOK * 64 * 4;
static_assert(OFF_ROPE + SZ_ROPE <= OFF_O, "layer-1 alias region");
static_assert(WS_END <= 2680160256ull, "workspace");

struct Params {
    const float* x; const int* pos; const float* norm_w; const float* rel_bias;
    const float* nsa_w_in; const float* nsa_q_norm; const float* nsa_k_norm; const float* pe_k; const float* w1_k; const float* w2_k;
    const float* pe_v; const float* w1_v; const float* w2_v; const float* nsa_w_out;
    const float* mla_w_in; const float* mla_q_a_norm; const float* mla_w_q_b; const float* mla_kv_a_norm; const float* mla_w_kv_b;
    const float* mla_q_norm; const float* mla_k_norm; const float* mla_w_out;
    float* out; unsigned char* ws;
};

#define XB_TMO      128
#define XB_XCNT(j)  (256  + 64 * (j))
#define XB_XSUB(j)  (1280 + 64 * (j))
#define XB_XGEN(j)  (2304 + 64 * (j))
#define XB_TOP      3328
#define XB_TOPGEN   3392
#define XCD_BAR_WORDS 3456
#define XB_SPIN_CAP (1u << 18)

__device__ __forceinline__ unsigned xb_ld(unsigned* p)              { return __hip_atomic_load(p, __ATOMIC_RELAXED, __HIP_MEMORY_SCOPE_AGENT); }
__device__ __forceinline__ unsigned xb_add(unsigned* p, unsigned v) { return __hip_atomic_fetch_add(p, v, __ATOMIC_RELAXED, __HIP_MEMORY_SCOPE_AGENT); }
__device__ __forceinline__ unsigned xb_xcc_id() { return (unsigned)__builtin_amdgcn_s_getreg((3 << 11) | 20) & 0xFu; }
#define XB_SPIN(cond, bar) do { unsigned _sp = 0; while (cond) { __builtin_amdgcn_s_sleep(1); \
    if ((++_sp & 255u) == 0u) { if (xb_ld(&(bar)[XB_TMO])) break; if (_sp > XB_SPIN_CAP) { atomicAdd(&(bar)[XB_TMO], 1u); break; } } } } while (0)

struct XcdBarrier {
    unsigned* bar; unsigned x;
    volatile LAS unsigned* st;
};

__device__ __forceinline__ XcdBarrier xcd_barrier_post(unsigned* bar, volatile LAS unsigned* st) {
    XcdBarrier b; b.bar = bar; b.x = xb_xcc_id(); b.st = st;
    if (threadIdx.x == 0) (void)xb_add(&bar[XB_XCNT(b.x)], 1u);
    return b;
}
__device__ __forceinline__ void xcd_barrier_complete(unsigned* bar, unsigned x, unsigned& nloc, unsigned& nx) {
    const unsigned G = gridDim.x * gridDim.y * gridDim.z;
    unsigned sum, cnt, mine, sp = 0u;
    for (;;) {
        sum = 0u; cnt = 0u; mine = 0u;
#pragma unroll
        for (unsigned j = 0; j < 16; ++j) { const unsigned c = xb_ld(&bar[XB_XCNT(j)]); sum += c; cnt += (c > 0u) ? 1u : 0u; mine = (j == x) ? c : mine; }
        if (sum == G) break;
        __builtin_amdgcn_s_sleep(1);
        if ((++sp & 255u) == 0u) { if (xb_ld(&bar[XB_TMO])) break; if (sp > XB_SPIN_CAP) { atomicAdd(&bar[XB_TMO], 1u); break; } }
    }
    nloc = mine > 0u ? mine : 1u; nx = cnt > 0u ? cnt : 1u;
}

__device__ __forceinline__ void xcd_barrier(const XcdBarrier& b) {
    asm volatile("s_waitcnt vmcnt(0)" ::: "memory");
    __syncthreads();
    if (threadIdx.x == 0) {
        unsigned* bar = b.bar;
        __builtin_amdgcn_s_waitcnt(0);
        unsigned nloc = b.st[0], nx = b.st[1];
        if (nloc == 0u) { xcd_barrier_complete(bar, b.x, nloc, nx); b.st[0] = nloc; b.st[1] = nx; }
        const unsigned old = xb_add(&bar[XB_XSUB(b.x)], 1u);
        const unsigned gen = old / nloc;
        if (old + 1u == (gen + 1u) * nloc) {
            __builtin_amdgcn_fence(__ATOMIC_RELEASE, "agent");
            asm volatile("s_waitcnt vmcnt(0)" ::: "memory");
            const unsigned og = xb_add(&bar[XB_TOP], 1u);
            const unsigned tg = og / nx;
            if (og + 1u == (tg + 1u) * nx) xb_add(&bar[XB_TOPGEN], 1u);
            else XB_SPIN(xb_ld(&bar[XB_TOPGEN]) == tg, bar);
            __builtin_amdgcn_fence(__ATOMIC_ACQUIRE, "agent");
            xb_add(&bar[XB_XGEN(b.x)], 1u);
            asm volatile("s_waitcnt vmcnt(0)" ::: "memory");
        } else {
            XB_SPIN(xb_ld(&bar[XB_XGEN(b.x)]) == gen, bar);
            __builtin_amdgcn_fence(__ATOMIC_ACQUIRE, "agent");
            asm volatile("s_waitcnt vmcnt(0)" ::: "memory");
        }
    }
    __syncthreads();
}

namespace pg8 {
#define PG8_LAS __attribute__((address_space(3)))
typedef unsigned short bf16_t;
typedef short bf16x8 __attribute__((ext_vector_type(8)));
typedef float f32x4 __attribute__((ext_vector_type(4)));
typedef unsigned u32x4 __attribute__((ext_vector_type(4)));
constexpr int BM = 256, BK = 64, HALF = 128, HTB = HALF * BK * 2  , STAGE_BYTES = 8 * HTB, NXCD = 8, WGM = 8;

__host__ __device__ __forceinline__ int lds_byte(int r, int c) { const int st = (r >> 4) * 2 + (c >> 5), rr = r & 15, cc = c & 31, ob = rr * 64 + cc * 2; return st * 1024 + (ob ^ (((ob >> 9) & 1) << 5)); }
__host__ __device__ __forceinline__ void stage_rc(int b, int& R, int& C) { const int st = b / 1024, sb = b % 1024, swz = sb ^ (((sb >> 9) & 1) << 5); R = (st >> 1) * 16 + swz / 64; C = (st & 1) * 32 + (swz % 64) / 2; }
__host__ __device__ __forceinline__ int perm32(int rho) { const int n = rho >> 4, i = rho & 15; return 8 * (i >> 2) + 4 * n + (i & 3); }

struct Unit { int pm, pn; };
struct Gemm { const bf16_t* A; const bf16_t* Bt; int M, N, K; };

struct StaticOrder {
    int nM, nN, nwg, G, c;
    __host__ __device__ void init(int M, int N, int G_, int c_) { nM = M / BM; nN = N / BM; nwg = nM * nN; G = G_; c = c_; }
    __host__ __device__ bool next(int i, Unit& u) const {
        const long L = (long)i * G + c; if (L >= nwg) return false;
        int wgid = (int)L; { const int q = nwg / NXCD, r = nwg % NXCD, xcd = wgid % NXCD, off = wgid / NXCD; wgid = (xcd < r ? xcd * (q + 1) : r * (q + 1) + (xcd - r) * q) + off; }
        const int nig = WGM * nN, gid = wgid / nig, fm = gid * WGM, gsz = (nM - fm) < WGM ? (nM - fm) : WGM;
        u.pm = fm + ((wgid % nig) % gsz); u.pn = (wgid % nig) / gsz; return true;
    }
    __device__ __forceinline__ void a_ready(const Unit&) const {}
    __device__ __forceinline__ void done(const Unit&) const {}
};
struct EpiStoreBf16 {
    static constexpr bool PERM = true, AFTER_DRAIN = false;
    bf16_t* O; int ldc;
    __device__ __forceinline__ void operator()(const f32x4 (&acc)[2][2][4][2], const Unit& u, int wr, int wc, int fr, int fq) const {
        const int row0 = u.pm * BM + wr * 64 + fr; const int col0 = u.pn * BM + wc * 32 + 8 * fq;
#pragma unroll
        for (int ai = 0; ai < 2; ++ai)
#pragma unroll
            for (int m = 0; m < 4; ++m) { bf16_t* rowp = O + (size_t)(row0 + ai * HALF + m * 16) * ldc + col0;
#pragma unroll
                for (int bj = 0; bj < 2; ++bj) { const f32x4 v0 = acc[ai][bj][m][0], v1 = acc[ai][bj][m][1];
                    u32x4 w; w.x = pk2(v0[0], v0[1]); w.y = pk2(v0[2], v0[3]); w.z = pk2(v1[0], v1[1]); w.w = pk2(v1[2], v1[3]);
                    *(u32x4*)(rowp + bj * HALF) = w; } }
    }
};
struct EpiResF32 {
    static constexpr bool PERM = false, AFTER_DRAIN = false;
    const float* base; float* out; int ldc;
    __device__ __forceinline__ void operator()(const f32x4 (&acc)[2][2][4][2], const Unit& u, int wr, int wc, int fr, int fq) const {
        const int row0 = u.pm * BM + wr * 64 + fr, col0 = u.pn * BM + wc * 32 + 4 * fq;
#pragma unroll
        for (int ai = 0; ai < 2; ++ai)
#pragma unroll
            for (int m = 0; m < 4; ++m) { const size_t off = (size_t)(row0 + ai * HALF + m * 16) * ldc + col0;
#pragma unroll
                for (int bj = 0; bj < 2; ++bj)
#pragma unroll
                    for (int n = 0; n < 2; ++n) { const f32x4 bs = *(const f32x4*)(base + off + bj * HALF + n * 16);
                        *(f32x4*)(out + off + bj * HALF + n * 16) = bs + acc[ai][bj][m][n]; } }
    }
};
struct EpiPlainF32 {
    static constexpr bool PERM = false, AFTER_DRAIN = false;
    float* C; int ldc;
    __device__ __forceinline__ void operator()(const f32x4 (&acc)[2][2][4][2], const Unit& u, int wr, int wc, int fr, int fq) const {
        const int row0 = u.pm * BM + wr * 64 + fr, col0 = u.pn * BM + wc * 32 + 4 * fq;
#pragma unroll
        for (int ai = 0; ai < 2; ++ai)
#pragma unroll
            for (int m = 0; m < 4; ++m) { float* rowp = C + (size_t)(row0 + ai * HALF + m * 16) * ldc + col0;
#pragma unroll
                for (int bj = 0; bj < 2; ++bj)
#pragma unroll
                    for (int n = 0; n < 2; ++n) *(f32x4*)(rowp + bj * HALF + n * 16) = acc[ai][bj][m][n]; }
    }
};
template <class Epi, class Sched, bool STAMP = false>
__device__ __forceinline__ void gemm_phase(PG8_LAS unsigned char* lds, const Gemm g, const Sched& S, const Epi& E, unsigned long long* stamps) {
    const int tid = tid_opaque(), wid = __builtin_amdgcn_readfirstlane(tid >> 6), lane = tid & 63, wr = wid >> 2, wc = wid & 3, fr = lane & 15, fq = lane >> 4;
    const int K = g.K, nt = K / BK;
    int ts_lo = 0, ts_hi = 0, nts = 0; const unsigned long long rt_entry = STAMP ? (unsigned long long)wall_clock64() : 0ull;
#define PG8_STAMP() do { if (STAMP && wid == 0 && nts < 64) { const unsigned long long _c = (unsigned long long)clock64(); \
        ts_lo = (lane == nts) ? (int)(unsigned)_c : ts_lo; ts_hi = (lane == nts) ? (int)(unsigned)(_c >> 32) : ts_hi; ++nts; } } while (0)
    PG8_STAMP();
    unsigned voffA[2], voffB[2];
#pragma unroll
    for (int i = 0; i < 2; ++i) { int R, C; stage_rc(tid * 16 + i * 8192, R, C); const int Rb = Epi::PERM ? ((R & ~31) + perm32(R & 31)) : R;
        voffA[i] = (unsigned)(R * K + C) * 2u; voffB[i] = (unsigned)(Rb * K + C) * 2u; }
    const size_t kstep = (size_t)(BK * 2);
    const size_t hstep = (size_t)HALF * K * 2;
    const size_t tstep = 2 * hstep;
    const unsigned ldsw = (unsigned)wid * 1024u;
    const int aoff = lds_byte(wr * 64 + fr, fq * 8), boff = lds_byte(wc * 32 + fr, fq * 8);
#define PG8_SA(b, h) (((b) * 2 + (h)) * HTB)
#define PG8_SB(b, h) ((4 + (b) * 2 + (h)) * HTB)
#define PG8_STAGE(bufoff, gbase, voff) do { _Pragma("unroll") for (int _i = 0; _i < 2; ++_i) \
        __builtin_amdgcn_global_load_lds((const unsigned*)((const char*)(gbase) + (voff)[_i]), (PG8_LAS unsigned*)(lds + (bufoff) + ldsw + _i * 8192), 16, 0, 0); } while (0)
#define PG8_LDA(dst, b, h) do { _Pragma("unroll") for (int m = 0; m < 4; ++m) _Pragma("unroll") for (int k = 0; k < 2; ++k) dst[m][k] = *(const PG8_LAS bf16x8*)(lds + PG8_SA(b, h) + aoff + m * 2048 + k * 1024); } while (0)
#define PG8_LDB(dst, b, h) do { _Pragma("unroll") for (int n = 0; n < 2; ++n) _Pragma("unroll") for (int k = 0; k < 2; ++k) dst[n][k] = *(const PG8_LAS bf16x8*)(lds + PG8_SB(b, h) + boff + n * 2048 + k * 1024); } while (0)
#define PG8_MMA(ai, bj, At, Bt) do { __builtin_amdgcn_s_setprio(1); _Pragma("unroll") for (int m = 0; m < 4; ++m) _Pragma("unroll") for (int n = 0; n < 2; ++n) _Pragma("unroll") for (int k = 0; k < 2; ++k) \
        acc[ai][bj][m][n] = __builtin_amdgcn_mfma_f32_16x16x32_bf16(Bt[n][k], At[m][k], acc[ai][bj][m][n], 0, 0, 0); __builtin_amdgcn_s_setprio(0); } while (0)
#define PG8_WAIT_V(n) asm volatile("s_waitcnt vmcnt(" #n ")" ::: "memory")
#define PG8_WAIT_L(n) asm volatile("s_waitcnt lgkmcnt(" #n ")" ::: "memory")
#define PG8_BAR __builtin_amdgcn_s_barrier()
#define PG8_SCHED __builtin_amdgcn_sched_barrier(0)
    Unit cur, nxt; int ui = 0;
    if (!S.next(0, cur)) return;
    f32x4 acc[2][2][4][2];
#pragma unroll
    for (int a = 0; a < 2; ++a)
#pragma unroll
        for (int b = 0; b < 2; ++b)
#pragma unroll
            for (int m = 0; m < 4; ++m)
#pragma unroll
                for (int n = 0; n < 2; ++n) acc[a][b][m][n] = (f32x4){0.f, 0.f, 0.f, 0.f};
    bf16x8 At[4][2], B0[2][2], B1[2][2];
    const char* cA = (const char*)g.A + (size_t)cur.pm * tstep; const char* cB = (const char*)g.Bt + (size_t)cur.pn * tstep;
    S.a_ready(cur);
    PG8_STAGE(PG8_SB(0, 0), cB, voffB); PG8_STAGE(PG8_SA(0, 0), cA, voffA); PG8_STAGE(PG8_SB(0, 1), cB + hstep, voffB); PG8_STAGE(PG8_SA(0, 1), cA + hstep, voffA);
    if (wr == 1) PG8_BAR;
    PG8_WAIT_V(4); PG8_BAR;
    PG8_STAGE(PG8_SB(1, 0), cB + kstep, voffB); PG8_STAGE(PG8_SA(1, 0), cA + kstep, voffA); PG8_STAGE(PG8_SB(1, 1), cB + hstep + kstep, voffB);
    PG8_WAIT_V(6); PG8_BAR;
    PG8_STAMP();
    for (;;) {
        const bool has_next = S.next(ui + 1, nxt);
        const char* nA = has_next ? (const char*)g.A + (size_t)nxt.pm * tstep : cA; const char* nB = has_next ? (const char*)g.Bt + (size_t)nxt.pn * tstep : cB;
        for (int t = 0; t < nt; t += 2) {
            const bool last = (t == nt - 2);
            const char* a1 = cA + (size_t)(t + 1) * kstep;
            const char* a2 = last ? nA : cA + (size_t)(t + 2) * kstep; const char* b2 = last ? nB : cB + (size_t)(t + 2) * kstep;
            const char* a3 = a2 + kstep; const char* b3 = b2 + kstep;
            if (last && has_next) S.a_ready(nxt);
            PG8_LDB(B0, 0, 0); PG8_SCHED; PG8_LDA(At, 0, 0); PG8_STAGE(PG8_SA(1, 1), a1 + hstep, voffA);
            PG8_WAIT_L(8); PG8_BAR; PG8_WAIT_L(0); PG8_MMA(0, 0, At, B0); PG8_BAR; PG8_SCHED;
            PG8_LDB(B1, 0, 1); PG8_STAGE(PG8_SB(0, 0), b2, voffB);
            PG8_BAR; PG8_WAIT_L(0); PG8_MMA(0, 1, At, B1); PG8_BAR;
            PG8_LDA(At, 0, 1); PG8_STAGE(PG8_SA(0, 0), a2, voffA);
            PG8_BAR; PG8_WAIT_L(0); PG8_MMA(1, 0, At, B0); PG8_BAR; PG8_SCHED;
            PG8_STAGE(PG8_SB(0, 1), b2 + hstep, voffB);
            PG8_WAIT_V(6); PG8_BAR; PG8_MMA(1, 1, At, B1); PG8_BAR;
            PG8_LDB(B0, 1, 0); PG8_SCHED; PG8_LDA(At, 1, 0); PG8_STAGE(PG8_SA(0, 1), a2 + hstep, voffA);
            PG8_WAIT_L(8); PG8_BAR; PG8_WAIT_L(0); PG8_MMA(0, 0, At, B0); PG8_BAR; PG8_SCHED;
            PG8_LDB(B1, 1, 1); PG8_STAGE(PG8_SB(1, 0), b3, voffB);
            PG8_BAR; PG8_WAIT_L(0); PG8_MMA(0, 1, At, B1); PG8_BAR;
            PG8_LDA(At, 1, 1); PG8_STAGE(PG8_SA(1, 0), a3, voffA);
            PG8_BAR; PG8_WAIT_L(0); PG8_MMA(1, 0, At, B0); PG8_BAR; PG8_SCHED;
            PG8_STAGE(PG8_SB(1, 1), b3 + hstep, voffB);
            PG8_WAIT_V(6); PG8_BAR; PG8_MMA(1, 1, At, B1); PG8_BAR;
        }
        PG8_STAMP();
        if constexpr (!Epi::AFTER_DRAIN) { E(acc, cur, wr, wc, fr, fq); S.done(cur); }
        PG8_STAMP();
        if (!has_next) break;
#pragma unroll
        for (int a = 0; a < 2; ++a)
#pragma unroll
            for (int b = 0; b < 2; ++b)
#pragma unroll
                for (int m = 0; m < 4; ++m)
#pragma unroll
                    for (int n = 0; n < 2; ++n) acc[a][b][m][n] = (f32x4){0.f, 0.f, 0.f, 0.f};
        cur = nxt; cA = nA; cB = nB; ++ui;
    }
    PG8_WAIT_V(0);
    if (wr == 0) PG8_BAR;
    PG8_BAR;
    if constexpr (Epi::AFTER_DRAIN) { E.fused(acc, cur, wr, wc, fr, fq, lds, wid, lane); S.done(cur); }
    PG8_STAMP();
    if (STAMP && wid == 0) { stamps[lane] = lane < nts ? (((unsigned long long)(unsigned)ts_hi << 32) | (unsigned)ts_lo) : 0ull;
        if (lane == 62) stamps[62] = rt_entry; if (lane == 63) stamps[63] = (unsigned long long)wall_clock64(); }
#undef PG8_STAMP
#undef PG8_SA
#undef PG8_SB
#undef PG8_STAGE
#undef PG8_LDA
#undef PG8_LDB
#undef PG8_MMA
#undef PG8_WAIT_V
#undef PG8_WAIT_L
#undef PG8_BAR
#undef PG8_SCHED
}
}


DI void phase_wconv(LAS unsigned char* lds, const float* __restrict__ src, bf16_t* __restrict__ dst, int K, int N, int Npad, int bid, int nb) {
    LAS float* tile = (LAS float*)lds;
    const int tid = tid_opaque();
    const int tk = K / 64, tn = Npad / 64, total = tk * tn;
    for (int t = bid; t < total; t += nb) {
        const int k0 = (t % tk) * 64, n0 = (t / tk) * 64;
        __syncthreads();
        {
            const int ty = tid >> 4, tx = tid & 15;
#pragma unroll
            for (int i = 0; i < 2; ++i) {
                const int k = k0 + ty + 32 * i, n = n0 + tx * 4;
                f32x4 v = {0.f, 0.f, 0.f, 0.f};
                if (n < N) v = *(const f32x4*)(src + (size_t)k * N + n);
                LAS float* p = tile + (ty + 32 * i) * 65 + tx * 4;
                p[0] = v[0]; p[1] = v[1]; p[2] = v[2]; p[3] = v[3];
            }
        }
        __syncthreads();
        {
            const int n = tid >> 3, kc = tid & 7;
            float v[8];
#pragma unroll
            for (int j = 0; j < 8; ++j) v[j] = tile[(kc * 8 + j) * 65 + n];
            u32x4 w; w.x = pk2(v[0], v[1]); w.y = pk2(v[2], v[3]); w.z = pk2(v[4], v[5]); w.w = pk2(v[6], v[7]);
            *(u32x4*)(dst + (size_t)(n0 + n) * K + k0 + kc * 8) = w;
        }
    }
}

DI void phase_rmsnorm(const float* __restrict__ x, const float* __restrict__ gain, bf16_t* __restrict__ h, int bid, int nb) {
    const int tid = tid_opaque(); const int lane = tid & 63, wid = tid >> 6;
    for (int row = bid * 8 + wid; row < MTOK; row += nb * 8) {
        const float* xr = x + (size_t)row * DM;
        f32x4 v[16]; float ss = 0.f;
#pragma unroll
        for (int i = 0; i < 16; ++i) { v[i] = *(const f32x4*)(xr + (i * 64 + lane) * 4); ss += v[i][0] * v[i][0] + v[i][1] * v[i][1] + v[i][2] * v[i][2] + v[i][3] * v[i][3]; }
#pragma unroll
        for (int o = 32; o >= 1; o >>= 1) ss += __shfl_xor(ss, o);
        const float rstd = rsqrtf(ss * (1.0f / DM) + EPSN);
        bf16_t* hr = h + (size_t)row * DM;
#pragma unroll
        for (int i = 0; i < 16; ++i) { const f32x4 g = *(const f32x4*)(gain + (i * 64 + lane) * 4);
            u32x2 w; w.x = pk2(v[i][0] * rstd * g[0], v[i][1] * rstd * g[1]); w.y = pk2(v[i][2] * rstd * g[2], v[i][3] * rstd * g[3]);
            *(u32x2*)(hr + (i * 64 + lane) * 4) = w; }
    }
}

DI void ld192(const bf16_t* p, int j8, float (&v)[24]) {
#pragma unroll
    for (int c = 0; c < 3; ++c) { const u32x4 w = *(const u32x4*)(p + (j8 + 8 * c) * 8);
        v[c * 8 + 0] = bflo(w.x); v[c * 8 + 1] = bfhi(w.x); v[c * 8 + 2] = bflo(w.y); v[c * 8 + 3] = bfhi(w.y);
        v[c * 8 + 4] = bflo(w.z); v[c * 8 + 5] = bfhi(w.z); v[c * 8 + 6] = bflo(w.w); v[c * 8 + 7] = bfhi(w.w); }
}
DI void st192(bf16_t* p, int j8, const float (&v)[24]) {
#pragma unroll
    for (int c = 0; c < 3; ++c) { u32x4 w; w.x = pk2(v[c * 8 + 0], v[c * 8 + 1]); w.y = pk2(v[c * 8 + 2], v[c * 8 + 3]); w.z = pk2(v[c * 8 + 4], v[c * 8 + 5]); w.w = pk2(v[c * 8 + 6], v[c * 8 + 7]);
        *(u32x4*)(p + (j8 + 8 * c) * 8) = w; }
}
DI float sum8(float s) { s += __shfl_xor(s, 1); s += __shfl_xor(s, 2); s += __shfl_xor(s, 4); return s; }

DI void phase_nsa_prep(const Params& P, int bid, int nb) {
    bf16_t* Y0 = (bf16_t*)(P.ws + OFF_Y0);
    bf16_t* KS = (bf16_t*)(P.ws + OFF_KS); bf16_t* KW = (bf16_t*)(P.ws + OFF_KW);
    bf16_t* ACK = (bf16_t*)(P.ws + OFF_ACK); bf16_t* ACV = (bf16_t*)(P.ws + OFF_ACV);
    const int tid = tid_opaque(), grp = tid >> 3, j8 = tid & 7;
    for (int tok = bid; tok < MTOK; tok += nb) {
        const int b = tok / SEQ, s = tok % SEQ;
        bf16_t* yr = Y0 + (size_t)tok * N1P;
        {
            float v[24]; ld192(yr + C_Q + grp * DK, j8, v);
            float ss = 0.f;
#pragma unroll
            for (int i = 0; i < 24; ++i) ss += v[i] * v[i];
            ss = sum8(ss);
            const float rstd = rsqrtf(ss * (1.0f / DK) + EPSN) * QSCALE;
#pragma unroll
            for (int c = 0; c < 3; ++c)
#pragma unroll
                for (int e = 0; e < 8; ++e) v[c * 8 + e] *= rstd * P.nsa_q_norm[(j8 + 8 * c) * 8 + e];
            st192(yr + C_Q + grp * DK, j8, v);
        }
        if (grp < 8) {
            const int g = grp & 3, br = grp >> 2;
            float v[24]; ld192(yr + (br ? C_KVW : C_KVS) + g * DK, j8, v);
            float ss = 0.f;
#pragma unroll
            for (int i = 0; i < 24; ++i) ss += v[i] * v[i];
            ss = sum8(ss);
            const float rstd = rsqrtf(ss * (1.0f / DK) + EPSN);
            const float* kn = P.nsa_k_norm + (br ? 2 : 1) * DK;
#pragma unroll
            for (int c = 0; c < 3; ++c)
#pragma unroll
                for (int e = 0; e < 8; ++e) v[c * 8 + e] *= rstd * kn[(j8 + 8 * c) * 8 + e];
            st192((br ? KW : KS) + ((size_t)(b * NG + g) * SEQ + s) * DK, j8, v);
        } else if (grp < 12) {
            const int g = grp - 8;
            float v[24]; ld192(yr + C_KVC + g * DK, j8, v);
#pragma unroll
            for (int k = 0; k < 2; ++k) {
                const int n = (s >> 4) - k, l = s - 16 * n;
                if (n >= 0 && n <= 254) {
                    float w[24];
#pragma unroll
                    for (int c = 0; c < 3; ++c)
#pragma unroll
                        for (int e = 0; e < 8; ++e) w[c * 8 + e] = v[c * 8 + e] + P.pe_k[l * DK + (j8 + 8 * c) * 8 + e];
                    st192(ACK + ((size_t)((b * NG + g) * 256 + n)) * 6144 + l * DK, j8, w);
                }
            }
        } else if (grp < 16) {
            const int g = grp - 12;
            const bf16_t* src = yr + C_KVC + NG * DK + g * DV;
            float v[16];
#pragma unroll
            for (int c = 0; c < 2; ++c) { const u32x4 w = *(const u32x4*)(src + (j8 + 8 * c) * 8);
                v[c * 8 + 0] = bflo(w.x); v[c * 8 + 1] = bfhi(w.x); v[c * 8 + 2] = bflo(w.y); v[c * 8 + 3] = bfhi(w.y);
                v[c * 8 + 4] = bflo(w.z); v[c * 8 + 5] = bfhi(w.z); v[c * 8 + 6] = bflo(w.w); v[c * 8 + 7] = bfhi(w.w); }
#pragma unroll
            for (int k = 0; k < 2; ++k) {
                const int n = (s >> 4) - k, l = s - 16 * n;
                if (n >= 0 && n <= 254) {
                    bf16_t* dst = ACV + ((size_t)((b * NG + g) * 256 + n)) * 4096 + l * DV;
#pragma unroll
                    for (int c = 0; c < 2; ++c) { float w[8];
#pragma unroll
                        for (int e = 0; e < 8; ++e) w[e] = v[c * 8 + e] + P.pe_v[l * DV + (j8 + 8 * c) * 8 + e];
                        u32x4 o; o.x = pk2(w[0], w[1]); o.y = pk2(w[2], w[3]); o.z = pk2(w[4], w[5]); o.w = pk2(w[6], w[7]);
                        *(u32x4*)(dst + (j8 + 8 * c) * 8) = o; }
                }
            }
        }
    }
    for (int i = bid * 512 + tid; i < 16 * (6144 + 4096) / 8; i += nb * 512) {
        const int per = (6144 + 4096) / 8, bg = i / per, c = i % per;
        const u32x4 z = {0u, 0u, 0u, 0u};
        if (c < 6144 / 8) *(u32x4*)(ACK + ((size_t)(bg * 256 + 255)) * 6144 + c * 8) = z;
        else *(u32x4*)(ACV + ((size_t)(bg * 256 + 255)) * 4096 + (c - 6144 / 8) * 8) = z;
    }
}

DI int swap23(int p) { return (p & ~0xC) | ((p & 4) << 1) | ((p & 8) >> 1); }
DI void phase_vt(LAS unsigned char* lds, const bf16_t* __restrict__ src, size_t src_stride, int col0, int col_step, int nhv, bf16_t* __restrict__ dst, int bid, int nb) {
    LAS bf16_t* tile = (LAS bf16_t*)lds;
    const int tid = tid_opaque();
    const int ntile = SEQ / 64, total = BATCH * nhv * ntile;
    for (int it = bid; it < total; it += nb) {
        const int mat = it / ntile, tt = it % ntile, b = mat / nhv, hv = mat % nhv;
        __syncthreads();
#pragma unroll
        for (int i = 0; i < 2; ++i) {
            const int q = tid + 512 * i, tok = q >> 4, ch = q & 15;
            const u32x4 w = *(const u32x4*)(src + (size_t)(b * SEQ + tt * 64 + tok) * src_stride + col0 + hv * col_step + ch * 8);
            *(LAS u32x4*)(tile + tok * 136 + ch * 8) = w;
        }
        __syncthreads();
        {
            const int dv = tid >> 2, kq = tid & 3;
            unsigned w[8];
#pragma unroll
            for (int e = 0; e < 8; ++e) {
                const int p0 = kq * 16 + 2 * e, p1 = p0 + 1;
                const int k0 = (p0 & ~15) | swap23(p0 & 15), k1 = (p1 & ~15) | swap23(p1 & 15);
                w[e] = (unsigned)tile[k0 * 136 + dv] | ((unsigned)tile[k1 * 136 + dv] << 16);
            }
            bf16_t* d = dst + ((size_t)mat * DV + dv) * SEQ + tt * 64 + kq * 16;
            u32x4 a = {w[0], w[1], w[2], w[3]}, c = {w[4], w[5], w[6], w[7]};
            *(u32x4*)d = a; *(u32x4*)(d + 8) = c;
        }
    }
}

DI void phase_cmp2(LAS unsigned char* lds, const Params& P, int bid, int nb) {
    LAS float* sk = (LAS float*)lds;
    LAS float* sv = sk + 192;
    LAS float* red = sv + 128;
    const float* HIDK = (const float*)(P.ws + OFF_HIDK); const float* HIDV = (const float*)(P.ws + OFF_HIDV);
    bf16_t* KC = (bf16_t*)(P.ws + OFF_KC); bf16_t* VTC = (bf16_t*)(P.ws + OFF_VTC);
    const int tid = tid_opaque(), lane = tid & 63, wid = tid >> 6;
    for (int m = bid; m < 4096; m += nb) {
        const int n = m & 255, bg = m >> 8;
        __syncthreads();
        if (tid < 192) { const float h = HIDK[(size_t)m * 256 + tid]; sk[tid] = h / (1.0f + __expf(-h)); }
        else if (tid < 320) { const float h = HIDV[(size_t)m * 256 + tid - 192]; sv[tid - 192] = h / (1.0f + __expf(-h)); }
        __syncthreads();
        float acc = 0.f;
        if (tid < 192) { for (int i = 0; i < 192; ++i) acc += sk[i] * P.w2_k[i * 192 + tid]; }
        else if (tid < 320) { const int j = tid - 192; for (int i = 0; i < 128; ++i) acc += sv[i] * P.w2_v[i * 128 + j]; }
        float ss = (tid < 192) ? acc * acc : 0.f;
#pragma unroll
        for (int o = 32; o >= 1; o >>= 1) ss += __shfl_xor(ss, o);
        if (lane == 0) red[wid] = ss;
        __syncthreads();
        const float tot = red[0] + red[1] + red[2];
        const float rstd = rsqrtf(tot * (1.0f / DK) + EPSN);
        if (tid < 192) { const float o = (n == 255) ? 0.f : acc * rstd * P.nsa_k_norm[tid];
            KC[(size_t)m * DK + tid] = (bf16_t)(pk2(o, 0.f) & 0xffffu); }
        else if (tid < 320) { const int j = tid - 192; const float o = (n == 255) ? 0.f : acc;
            const int pn = (n & ~15) | swap23(n & 15);
            VTC[((size_t)bg * DV + j) * 256 + pn] = (bf16_t)(pk2(o, 0.f) & 0xffffu); }
    }
}

DI void phase_mla_prep1(const Params& P, int bid, int nb) {
    const bf16_t* Y1 = (const bf16_t*)(P.ws + OFF_Y1);
    bf16_t* CQN = (bf16_t*)(P.ws + OFF_CQN); bf16_t* CKVN = (bf16_t*)(P.ws + OFF_CKVN); float* ROPE = (float*)(P.ws + OFF_ROPE);
    const int tid = tid_opaque(); const int lane = tid & 63, wid = tid >> 6;
    for (int tok = bid * 8 + wid; tok < MTOK; tok += nb * 8) {
        const bf16_t* yr = Y1 + (size_t)tok * N3P;
        {
            float v[24]; float ss = 0.f;
#pragma unroll
            for (int c = 0; c < 3; ++c) { const u32x4 w = *(const u32x4*)(yr + C3_CQ + (c * 64 + lane) * 8);
                v[c * 8 + 0] = bflo(w.x); v[c * 8 + 1] = bfhi(w.x); v[c * 8 + 2] = bflo(w.y); v[c * 8 + 3] = bfhi(w.y);
                v[c * 8 + 4] = bflo(w.z); v[c * 8 + 5] = bfhi(w.z); v[c * 8 + 6] = bflo(w.w); v[c * 8 + 7] = bfhi(w.w); }
#pragma unroll
            for (int i = 0; i < 24; ++i) ss += v[i] * v[i];
#pragma unroll
            for (int o = 32; o >= 1; o >>= 1) ss += __shfl_xor(ss, o);
            const float rstd = rsqrtf(ss * (1.0f / QLORA) + EPSN);
#pragma unroll
            for (int c = 0; c < 3; ++c) { const float* g = P.mla_q_a_norm + (c * 64 + lane) * 8; u32x4 w;
                w.x = pk2(v[c * 8 + 0] * rstd * g[0], v[c * 8 + 1] * rstd * g[1]); w.y = pk2(v[c * 8 + 2] * rstd * g[2], v[c * 8 + 3] * rstd * g[3]);
                w.z = pk2(v[c * 8 + 4] * rstd * g[4], v[c * 8 + 5] * rstd * g[5]); w.w = pk2(v[c * 8 + 6] * rstd * g[6], v[c * 8 + 7] * rstd * g[7]);
                *(u32x4*)(CQN + (size_t)tok * QLORA + (c * 64 + lane) * 8) = w; }
        }
        {
            float v[8]; float ss = 0.f;
            const u32x4 w0 = *(const u32x4*)(yr + C3_CKV + lane * 8);
            v[0] = bflo(w0.x); v[1] = bfhi(w0.x); v[2] = bflo(w0.y); v[3] = bfhi(w0.y); v[4] = bflo(w0.z); v[5] = bfhi(w0.z); v[6] = bflo(w0.w); v[7] = bfhi(w0.w);
#pragma unroll
            for (int i = 0; i < 8; ++i) ss += v[i] * v[i];
#pragma unroll
            for (int o = 32; o >= 1; o >>= 1) ss += __shfl_xor(ss, o);
            const float rstd = rsqrtf(ss * (1.0f / KVLORA) + EPSN);
            const float* g = P.mla_kv_a_norm + lane * 8; u32x4 w;
            w.x = pk2(v[0] * rstd * g[0], v[1] * rstd * g[1]); w.y = pk2(v[2] * rstd * g[2], v[3] * rstd * g[3]);
            w.z = pk2(v[4] * rstd * g[4], v[5] * rstd * g[5]); w.w = pk2(v[6] * rstd * g[6], v[7] * rstd * g[7]);
            *(u32x4*)(CKVN + (size_t)tok * KVLORA + lane * 8) = w;
        }
        if (lane < 32) {
            const float invf = exp2f(-(float)lane * (13.287712379549449f / 32.0f));
            const float ang = (float)P.pos[tok] * invf;
            float sn, cs; sincosf(ang, &sn, &cs);
            ROPE[(size_t)tok * 64 + lane] = cs; ROPE[(size_t)tok * 64 + 32 + lane] = sn;
        }
    }
}

DI void phase_mla_prep2(const Params& P, int bid, int nb) {
    bf16_t* QM = (bf16_t*)(P.ws + OFF_QM); const bf16_t* KVM = (const bf16_t*)(P.ws + OFF_KVM); const bf16_t* Y1 = (const bf16_t*)(P.ws + OFF_Y1);
    bf16_t* KM = (bf16_t*)(P.ws + OFF_KM); const float* ROPE = (const float*)(P.ws + OFF_ROPE);
    const int tid = tid_opaque(), grp = tid >> 3, j8 = tid & 7;
    for (int tok = bid; tok < MTOK; tok += nb) {
        const int b = tok / SEQ, s = tok % SEQ;
        float cs[8], sn[8];
#pragma unroll
        for (int e = 0; e < 8; ++e) { const int i = (8 * j8 + e) & 31; cs[e] = ROPE[(size_t)tok * 64 + i]; sn[e] = ROPE[(size_t)tok * 64 + 32 + i]; }
        {
            bf16_t* qp = QM + (size_t)tok * NQB + grp * DK;
            float v[24]; ld192(qp, j8, v);
            float ss = 0.f;
#pragma unroll
            for (int i = 0; i < 24; ++i) ss += v[i] * v[i];
            ss = sum8(ss);
            const float rstd = rsqrtf(ss * (1.0f / DK) + EPSN);
#pragma unroll
            for (int c = 0; c < 3; ++c)
#pragma unroll
                for (int e = 0; e < 8; ++e) v[c * 8 + e] *= rstd * P.mla_q_norm[(j8 + 8 * c) * 8 + e];
#pragma unroll
            for (int e = 0; e < 8; ++e) { const float mine = v[16 + e], other = __shfl_xor(mine, 4);
                v[16 + e] = (j8 < 4) ? (mine * cs[e] - other * sn[e]) : (mine * cs[e] + other * sn[e]); }
#pragma unroll
            for (int i = 0; i < 24; ++i) v[i] *= QSCALE;
            st192(qp, j8, v);
        }
        {
            const bf16_t* kn = KVM + (size_t)tok * NKVB + grp * 256;
            const bf16_t* kp = Y1 + (size_t)tok * N3P + C3_KPE;
            float v[24];
#pragma unroll
            for (int c = 0; c < 2; ++c) { const u32x4 w = *(const u32x4*)(kn + (j8 + 8 * c) * 8);
                v[c * 8 + 0] = bflo(w.x); v[c * 8 + 1] = bfhi(w.x); v[c * 8 + 2] = bflo(w.y); v[c * 8 + 3] = bfhi(w.y);
                v[c * 8 + 4] = bflo(w.z); v[c * 8 + 5] = bfhi(w.z); v[c * 8 + 6] = bflo(w.w); v[c * 8 + 7] = bfhi(w.w); }
            { const u32x4 w = *(const u32x4*)(kp + j8 * 8);
                v[16] = bflo(w.x); v[17] = bfhi(w.x); v[18] = bflo(w.y); v[19] = bfhi(w.y); v[20] = bflo(w.z); v[21] = bfhi(w.z); v[22] = bflo(w.w); v[23] = bfhi(w.w); }
            float ss = 0.f;
#pragma unroll
            for (int i = 0; i < 24; ++i) ss += v[i] * v[i];
            ss = sum8(ss);
            const float rstd = rsqrtf(ss * (1.0f / DK) + EPSN);
#pragma unroll
            for (int c = 0; c < 3; ++c)
#pragma unroll
                for (int e = 0; e < 8; ++e) v[c * 8 + e] *= rstd * P.mla_k_norm[(j8 + 8 * c) * 8 + e];
#pragma unroll
            for (int e = 0; e < 8; ++e) { const float mine = v[16 + e], other = __shfl_xor(mine, 4);
                v[16 + e] = (j8 < 4) ? (mine * cs[e] - other * sn[e]) : (mine * cs[e] + other * sn[e]); }
            st192(KM + ((size_t)(b * NH + grp) * SEQ + s) * DK, j8, v);
        }
    }
}
#ifndef NO_CMP1
#define NO_CMP1 0
#endif
#ifndef NO_CMP2
#define NO_CMP2 0
#endif
#ifndef NO_SEL
#define NO_SEL 0
#endif
#ifndef NO_WIN
#define NO_WIN 0
#endif
constexpr int KT_BYTES = 64 * 384, VT_BYTES = 128 * 128;
constexpr int L_K = 0, L_V = 2 * KT_BYTES, L_LUT = L_V + 2 * VT_BYTES, LUT_PITCH = 129, L_QS = L_LUT + 16 * LUT_PITCH * 4 + 16  , L_P3 = L_QS + 16 * 256 * 4, L_END = L_P3 + 16 * 256 * 4;
static_assert(L_END <= 131072, "attention LDS");
enum { MODE_MLA = 0, MODE_CMP1 = 1, MODE_CMP2 = 2, MODE_SEL = 3, MODE_WIN = 4 };

#define MFMA32(a, b, c) __builtin_amdgcn_mfma_f32_32x32x16_bf16((a), (b), (c), 0, 0, 0)

struct AttnLane {
    int tq;
    int tw0, tw1;
    int hi, r32;
    const LAS float* lutrow;
    float lut_far;
    unsigned long long mk0, mk1;
    int tk;
    int curblk;
    float inv_l;
    int tokidx;
};

template <int MODE>
DI void attn_pass(LAS unsigned char* lds, const char* __restrict__ Kc, const char* __restrict__ Vc, int vt_stride, int j_lo, int j_hi,
                  const bf16x8 (&q)[12], f32x16 (&o)[4], float& m_run, float& l_run, const AttnLane& A) {
    if (j_lo >= j_hi) return;
    constexpr bool HASV = (MODE != MODE_CMP1);
    int tid = threadIdx.x; asm volatile("" : "+v"(tid));
    const int lane = tid & 63;
    const int hi = lane >> 5, r32 = lane & 31;
    const int wid_ = __builtin_amdgcn_readfirstlane(tid >> 6);
    unsigned kg[3]; unsigned vg[2];
#pragma unroll
    for (int i = 0; i < 3; ++i) { const int pidx = (wid_ * 3 + i) * 64 + lane, row = pidx / 24, cp = pidx % 24; kg[i] = (unsigned)(row * 384 + ((cp ^ ((row >> 1) & 7)) << 4)); }
#pragma unroll
    for (int i = 0; i < 2; ++i) { const int pidx = (wid_ * 2 + i) * 64 + lane, row = pidx >> 3, cp = pidx & 7; vg[i] = (unsigned)(row * vt_stride * 2 + ((cp ^ ((row >> 1) & 7)) << 4)); }
    int kbase[4], vbase[4];
#pragma unroll
    for (int dd = 0; dd < 4; ++dd) { kbase[dd] = r32 * 384 + (((2 * dd + hi) ^ ((r32 >> 1) & 7)) << 4); vbase[dd] = r32 * 128 + (((2 * dd + hi) ^ ((r32 >> 1) & 7)) << 4); }
#define ST_ISSUE(j, buf) do { const char* kp_ = Kc + (size_t)(j) * KT_BYTES; LAS unsigned char* kb_ = lds + L_K + (buf) * KT_BYTES + wid_ * 3072; \
        _Pragma("unroll") for (int i_ = 0; i_ < 3; ++i_) __builtin_amdgcn_global_load_lds((const unsigned*)(kp_ + kg[i_]), (LAS unsigned*)(kb_ + i_ * 1024), 16, 0, 0); \
        if (HASV) { const char* vp_ = Vc + (size_t)(j) * 128; LAS unsigned char* vb_ = lds + L_V + (buf) * VT_BYTES + wid_ * 2048; \
            _Pragma("unroll") for (int i_ = 0; i_ < 2; ++i_) __builtin_amdgcn_global_load_lds((const unsigned*)(vp_ + vg[i_]), (LAS unsigned*)(vb_ + i_ * 1024), 16, 0, 0); } } while (0)
    ST_ISSUE(j_lo, 0);
    asm volatile("s_waitcnt vmcnt(0)" ::: "memory");
    __syncthreads();
    for (int j = j_lo; j < j_hi; ++j) {
        const int cur = (j - j_lo) & 1;
        const bool more = (j + 1 < j_hi);
        if (more) ST_ISSUE(j + 1, cur ^ 1);
        bool act;
        if (MODE == MODE_MLA) act = (64 * j <= A.tw1);
        else if (MODE == MODE_CMP1 || MODE == MODE_CMP2) act = (1024 * j + 31 <= A.tw1);
        else if (MODE == MODE_SEL) act = (((A.mk0 | A.mk1) >> j) & 1ull) != 0ull;
        else act = (64 * j <= A.tw1) && (64 * j + 63 >= A.tw0 - 511);
        if (act) {
            f32x16 p0, p1;
            if (MODE == MODE_MLA) {
#pragma unroll
                for (int r = 0; r < 16; ++r) { p0[r] = 0.f; p1[r] = 0.f; }
            } else if (MODE == MODE_WIN || MODE == MODE_SEL) {
                const int dq = A.tq - 64 * j - 4 * hi;
                const bool far = (A.tw0 - (64 * j + 63) >= 113);
                if (far) {
#pragma unroll
                    for (int r = 0; r < 16; ++r) { p0[r] = A.lut_far; p1[r] = A.lut_far; }
                } else {
#pragma unroll
                    for (int r = 0; r < 16; ++r) { const int c = (r & 3) + 8 * (r >> 2);
                        int d0_ = dq - c, d1_ = dq - c - 32;
                        d0_ = d0_ < 0 ? 0 : (d0_ > 127 ? 127 : d0_); d1_ = d1_ < 0 ? 0 : (d1_ > 127 ? 127 : d1_);
                        p0[r] = A.lutrow[d0_]; p1[r] = A.lutrow[d1_]; }
                }
            } else {
                const int dq = A.tq - 31 - 1024 * j - 64 * hi;
                const bool far = (A.tw0 - 31 - 16 * (64 * j + 63) >= 113);
                if (far) {
#pragma unroll
                    for (int r = 0; r < 16; ++r) { p0[r] = A.lut_far; p1[r] = A.lut_far; }
                } else {
#pragma unroll
                    for (int r = 0; r < 16; ++r) { const int c = 16 * ((r & 3) + 8 * (r >> 2));
                        int d0_ = dq - c, d1_ = dq - c - 512;
                        d0_ = d0_ < 0 ? 0 : (d0_ > 127 ? 127 : d0_); d1_ = d1_ < 0 ? 0 : (d1_ > 127 ? 127 : d1_);
                        p0[r] = A.lutrow[d0_]; p1[r] = A.lutrow[d1_]; }
                }
            }
            const LAS unsigned char* kb = lds + L_K + cur * KT_BYTES;
#pragma unroll
            for (int d0 = 0; d0 < 12; ++d0) {
                const LAS unsigned char* a = kb + kbase[d0 & 3] + (d0 >> 2) * 128;
                const bf16x8 a0 = *(const LAS bf16x8*)a;
                const bf16x8 a1 = *(const LAS bf16x8*)(a + 32 * 384);
                p0 = MFMA32(a0, q[d0], p0);
                p1 = MFMA32(a1, q[d0], p1);
            }
            const float NEG = -__builtin_inff();
            if (MODE == MODE_MLA) {
                if (64 * j + 63 > A.tw0) {
                    const int dq = A.tq - 64 * j - 4 * hi;
#pragma unroll
                    for (int r = 0; r < 16; ++r) { const int c = (r & 3) + 8 * (r >> 2);
                        if (dq - c < 0) p0[r] = NEG;
                        if (dq - c - 32 < 0) p1[r] = NEG; }
                }
            } else if (MODE == MODE_WIN) {
                const int dq = A.tq - 64 * j - 4 * hi;
#pragma unroll
                for (int r = 0; r < 16; ++r) { const int c = (r & 3) + 8 * (r >> 2);
                    if ((unsigned)(dq - c) >= 512u) p0[r] = NEG;
                    if ((unsigned)(dq - c - 32) >= 512u) p1[r] = NEG; }
            } else if (MODE == MODE_SEL) {
                const int dq = A.tq - 64 * j - 4 * hi;
                const bool s0_ = ((A.mk0 >> j) & 1ull) != 0ull, s1_ = ((A.mk1 >> j) & 1ull) != 0ull; const bool sel = A.tk ? s1_ : s0_;
                const bool diag = (j == A.curblk);
#pragma unroll
                for (int r = 0; r < 16; ++r) { const int c = (r & 3) + 8 * (r >> 2);
                    if (!sel || (diag && dq - c < 0)) p0[r] = NEG;
                    if (!sel || (diag && dq - c - 32 < 0)) p1[r] = NEG; }
            } else {
                const int dq = A.tq - 31 - 1024 * j - 64 * hi;
#pragma unroll
                for (int r = 0; r < 16; ++r) { const int c = 16 * ((r & 3) + 8 * (r >> 2));
                    if (dq - c < 0) p0[r] = NEG;
                    if (dq - c - 512 < 0) p1[r] = NEG; }
            }
            if (MODE == MODE_CMP2) {
                const float mm = m_run, il = A.inv_l;
#pragma unroll
                for (int r = 0; r < 16; ++r) { p0[r] = __builtin_amdgcn_exp2f(p0[r] - mm) * il; p1[r] = __builtin_amdgcn_exp2f(p1[r] - mm) * il; }
                float v[16];
#pragma unroll
                for (int k = 0; k < 4; ++k) { v[k] = (p0[4 * k] + p0[4 * k + 1]) + (p0[4 * k + 2] + p0[4 * k + 3]); v[4 + k] = (p1[4 * k] + p1[4 * k + 1]) + (p1[4 * k + 2] + p1[4 * k + 3]);
                    v[8 + k] = p0[4 * k + 3]; v[12 + k] = p1[4 * k + 3]; }
                { const bool up = (lane & 8) != 0;
#pragma unroll
                  for (int i = 0; i < 8; ++i) { const float send = up ? v[i] : v[i + 8]; const float recv = __shfl_xor(send, 8); const float keep = up ? v[i + 8] : v[i]; v[i] = keep + recv; } }
                { const bool up = (lane & 4) != 0;
#pragma unroll
                  for (int i = 0; i < 4; ++i) { const float send = up ? v[i] : v[i + 4]; const float recv = __shfl_xor(send, 4); const float keep = up ? v[i + 4] : v[i]; v[i] = keep + recv; } }
                { const bool up = (lane & 2) != 0;
#pragma unroll
                  for (int i = 0; i < 2; ++i) { const float send = up ? v[i] : v[i + 2]; const float recv = __shfl_xor(send, 2); const float keep = up ? v[i + 2] : v[i]; v[i] = keep + recv; } }
                { const bool up = (lane & 1) != 0;
                  const float send = up ? v[0] : v[1]; const float recv = __shfl_xor(send, 1); const float keep = up ? v[1] : v[0]; v[0] = keep + recv; }
                { const int idx = lane & 15, half = (idx >> 2) & 1, k = idx & 3, isp3 = idx >> 3;
                  const int quad = 16 * j + 8 * half + 2 * k + hi;
                  LAS float* dst = (LAS float*)(lds + (isp3 ? L_P3 : L_QS)) + A.tokidx * 256 + quad;
                  *dst = v[0]; }
            } else {
                float mx = p0[0];
#pragma unroll
                for (int r = 1; r < 16; ++r) mx = fmaxf(mx, p0[r]);
#pragma unroll
                for (int r = 0; r < 16; ++r) mx = fmaxf(mx, p1[r]);
                mx = fmaxf(mx, __shfl_xor(mx, 32));
                const float mnew = fmaxf(m_run, mx);
                const float alpha = __builtin_amdgcn_exp2f(m_run - mnew);
                m_run = mnew;
                float ps = 0.f;
#pragma unroll
                for (int r = 0; r < 16; ++r) { p0[r] = __builtin_amdgcn_exp2f(p0[r] - mnew); p1[r] = __builtin_amdgcn_exp2f(p1[r] - mnew); ps += p0[r] + p1[r]; }
                l_run = l_run * alpha + ps;
                if (HASV) {
                    if (__any(alpha != 1.0f)) {
#pragma unroll
                        for (int d = 0; d < 4; ++d)
#pragma unroll
                            for (int r = 0; r < 16; ++r) o[d][r] *= alpha;
                    }
                }
            }
            if (HASV) {
                const LAS unsigned char* vb = lds + L_V + cur * VT_BYTES;
#pragma unroll
                for (int ks = 0; ks < 4; ++ks) {
                    u32x4 w;
                    if (ks == 0) { w.x = pk2(p0[0], p0[1]); w.y = pk2(p0[2], p0[3]); w.z = pk2(p0[4], p0[5]); w.w = pk2(p0[6], p0[7]); }
                    else if (ks == 1) { w.x = pk2(p0[8], p0[9]); w.y = pk2(p0[10], p0[11]); w.z = pk2(p0[12], p0[13]); w.w = pk2(p0[14], p0[15]); }
                    else if (ks == 2) { w.x = pk2(p1[0], p1[1]); w.y = pk2(p1[2], p1[3]); w.z = pk2(p1[4], p1[5]); w.w = pk2(p1[6], p1[7]); }
                    else { w.x = pk2(p1[8], p1[9]); w.y = pk2(p1[10], p1[11]); w.z = pk2(p1[12], p1[13]); w.w = pk2(p1[14], p1[15]); }
                    const bf16x8 pb = __builtin_bit_cast(bf16x8, w);
#pragma unroll
                    for (int d = 0; d < 4; ++d) {
                        const bf16x8 va = *(const LAS bf16x8*)(vb + vbase[ks] + d * (32 * 128));
                        o[d] = MFMA32(va, pb, o[d]);
                    }
                }
            }
        }
        asm volatile("s_waitcnt vmcnt(0)" ::: "memory");
        __syncthreads();
    }
#undef ST_ISSUE
}

DI int t5_bucket(int n) {
    if (n < 16) return n;
    return 16 + (n >= 19) + (n >= 21) + (n >= 24) + (n >= 27) + (n >= 31) + (n >= 35) + (n >= 40) + (n >= 46) + (n >= 52) + (n >= 59) + (n >= 67) + (n >= 77) + (n >= 87) + (n >= 99) + (n >= 113);
}
DI float silu_f(float z) { return z / (1.0f + __expf(-z)); }

template <bool RMW>
DI void attn_epilogue(const f32x16 (&o)[4], float scale, const char* __restrict__ zbase, unsigned zoff, char* __restrict__ obase, unsigned ooff, int hi) {
#pragma unroll
    for (int d = 0; d < 4; ++d)
#pragma unroll
        for (int kq = 0; kq < 4; ++kq) {
            const unsigned dvb = (unsigned)(32 * d + 8 * kq + 4 * hi) * 2u;
            const u32x2 zw = *(const u32x2*)(zbase + (zoff + dvb));
            float v0 = o[d][4 * kq + 0] * scale * silu_f(bflo(zw.x)), v1 = o[d][4 * kq + 1] * scale * silu_f(bfhi(zw.x));
            float v2 = o[d][4 * kq + 2] * scale * silu_f(bflo(zw.y)), v3 = o[d][4 * kq + 3] * scale * silu_f(bfhi(zw.y));
            if (RMW) { const u32x2 pw = *(const u32x2*)(obase + (ooff + dvb)); v0 += bflo(pw.x); v1 += bfhi(pw.x); v2 += bflo(pw.y); v3 += bfhi(pw.y); }
            u32x2 w; w.x = pk2(v0, v1); w.y = pk2(v2, v3);
            *(u32x2*)(obase + (ooff + dvb)) = w;
        }
}

DI void phase_nsa_attn(LAS unsigned char* lds, const Params& P, int bid, int nb) {
    const char* Y0c = (const char*)(P.ws + OFF_Y0);
    const char* KSc = (const char*)(P.ws + OFF_KS); const char* KWc = (const char*)(P.ws + OFF_KW);
    const char* VTSc = (const char*)(P.ws + OFF_VTS); const char* VTWc = (const char*)(P.ws + OFF_VTW);
    const char* KCc = (const char*)(P.ws + OFF_KC); const char* VTCc = (const char*)(P.ws + OFF_VTC);
    char* ONc = (char*)(P.ws + OFF_O);
    LAS float* lut = (LAS float*)(lds + L_LUT);
    const int total = BATCH * NG * 256;
    for (int u = bid; u < total; u += nb) {
        int tid = threadIdx.x; asm volatile("" : "+v"(tid));
        const int lane = tid & 63, wid = __builtin_amdgcn_readfirstlane(tid >> 6);
        const int pair = u >> 8; int c = u & 255; if (pair & 1) c = 255 - c;
        const int b = pair >> 2, g = pair & 3, t0 = c * 16;
        __syncthreads();
        for (int i = tid; i < 16 * 128; i += 512) { const int r = i >> 7, d = i & 127; lut[r * LUT_PITCH + d] = P.rel_bias[t5_bucket(d) * NH + g * NR + r] * LOG2E; }
        __syncthreads();
        AttnLane A;
        A.hi = lane >> 5; A.r32 = lane & 31;
        const int r = lane & 15;
        A.tk = (lane >> 4) & 1;
        A.tw0 = t0 + 2 * wid; A.tw1 = A.tw0 + 1; A.tq = A.tw0 + A.tk;
        A.lutrow = lut + r * LUT_PITCH; A.lut_far = A.lutrow[127];
        A.curblk = t0 >> 6; A.tokidx = 2 * wid + A.tk; A.mk0 = 0ull; A.mk1 = 0ull; A.inv_l = 0.f;
        const int hh = g * NR + r;
        const unsigned yoff = (unsigned)(b * SEQ + A.tq) * (unsigned)(N1P * 2);
        const unsigned ooff = ((unsigned)(b * SEQ + A.tq) * (unsigned)ZW8 + (unsigned)(hh * DV)) * 2u;
        bf16x8 q[12];
        { const unsigned qo = yoff + (unsigned)((C_Q + hh * DK + 8 * A.hi) * 2);
#pragma unroll
          for (int d0 = 0; d0 < 12; ++d0) q[d0] = *(const bf16x8*)(Y0c + (qo + 32u * d0)); }
        const int bg = b * NG + g;
        f32x16 o[4]; float m_run, l_run;
#define RESET_STATE() do { _Pragma("unroll") for (int d_ = 0; d_ < 4; ++d_) _Pragma("unroll") for (int r_ = 0; r_ < 16; ++r_) o[d_][r_] = 0.f; m_run = -1e30f; l_run = 0.f; } while (0)
        const int nct = (t0 + 15 >= 31) ? (((t0 + 15 - 31) >> 4) / 64 + 1) : 0;
        RESET_STATE();
        if (!NO_CMP1) attn_pass<MODE_CMP1>(lds, KCc + (size_t)bg * 256 * DK * 2, nullptr, 0, 0, nct, q, o, m_run, l_run, A);
        { const float lt = l_run + __shfl_xor(l_run, 32); A.inv_l = lt > 0.f ? 1.0f / lt : 0.f; }
        if (!NO_CMP2) attn_pass<MODE_CMP2>(lds, KCc + (size_t)bg * 256 * DK * 2, VTCc + (size_t)bg * DV * 256 * 2, 256, 0, nct, q, o, m_run, l_run, A);
        { const float gv = bf1(*(const bf16_t*)(Y0c + (yoff + (unsigned)((C_G + 0 * NH + hh) * 2)))); const float sg = 1.0f / (1.0f + __expf(-gv));
          attn_epilogue<false>(o, sg, Y0c, yoff + (unsigned)((C_ZC + hh * DV) * 2), ONc, ooff, A.hi); }
        __syncthreads();
        {
            const int cur = A.curblk;
            unsigned long long mk[2];
#pragma unroll
            for (int t = 0; t < 2; ++t) {
                const LAS float* QS = (const LAS float*)(lds + L_QS) + (2 * wid + t) * 256;
                const LAS float* P3 = (const LAS float*)(lds + L_P3) + (2 * wid + t) * 256;
                const bool forced = (lane == 0) || (lane == cur) || (lane == cur - 1);
                const bool future = lane > cur;
                float v = 0.f;
                if (!forced && !future) v = QS[lane] + P3[lane - 1];
                unsigned key = (__float_as_uint(v) & ~63u);
                if (forced) key = 0x7f800000u; else if (future) key = 0u;
                key |= (unsigned)(63 - lane);
                int rank = 0;
#pragma unroll
                for (int jp = 0; jp < 64; ++jp) { const unsigned kj = (unsigned)__builtin_amdgcn_readlane((int)key, jp); rank += (kj > key) ? 1 : 0; }
                mk[t] = __ballot(rank < 16 && !future);
            }
            A.mk0 = mk[0]; A.mk1 = mk[1];
        }
        RESET_STATE();
        if (!NO_SEL) attn_pass<MODE_SEL>(lds, KSc + (size_t)bg * SEQ * DK * 2, VTSc + (size_t)bg * DV * SEQ * 2, SEQ, 0, A.curblk + 1, q, o, m_run, l_run, A);
        { const float lt = l_run + __shfl_xor(l_run, 32); const float gv = bf1(*(const bf16_t*)(Y0c + (yoff + (unsigned)((C_G + 1 * NH + hh) * 2)))); const float sg = 1.0f / (1.0f + __expf(-gv));
          attn_epilogue<true>(o, sg / lt, Y0c, yoff + (unsigned)((C_ZS + hh * DV) * 2), ONc, ooff, A.hi); }
        RESET_STATE();
        { const int jl = (t0 - 511) > 0 ? (t0 - 511) >> 6 : 0, jh = ((t0 + 15) >> 6) + 1;
          if (!NO_WIN) attn_pass<MODE_WIN>(lds, KWc + (size_t)bg * SEQ * DK * 2, VTWc + (size_t)bg * DV * SEQ * 2, SEQ, jl, jh, q, o, m_run, l_run, A); }
        { const float lt = l_run + __shfl_xor(l_run, 32); const float gv = bf1(*(const bf16_t*)(Y0c + (yoff + (unsigned)((C_G + 2 * NH + hh) * 2)))); const float sg = 1.0f / (1.0f + __expf(-gv));
          attn_epilogue<true>(o, sg / lt, Y0c, yoff + (unsigned)((C_ZW + hh * DV) * 2), ONc, ooff, A.hi); }
#undef RESET_STATE
    }
}

DI void phase_mla_attn(LAS unsigned char* lds, const Params& P, int bid, int nb) {
    const char* QMc = (const char*)(P.ws + OFF_QM); const char* KMc = (const char*)(P.ws + OFF_KM); const char* VTMc = (const char*)(P.ws + OFF_VTM);
    const char* Y1c = (const char*)(P.ws + OFF_Y1); char* OMc = (char*)(P.ws + OFF_O);
    const int total = BATCH * NH * 16;
    for (int u = bid; u < total; u += nb) {
        int tid = threadIdx.x; asm volatile("" : "+v"(tid));
        const int lane = tid & 63, wid = __builtin_amdgcn_readfirstlane(tid >> 6);
        const int bh = u & 255, qb = 15 - (u >> 8), b = bh >> 6, h = bh & 63, t0 = qb * 256;
        AttnLane A;
        A.hi = lane >> 5; A.r32 = lane & 31; A.tk = 0;
        A.tw0 = t0 + 32 * wid; A.tw1 = A.tw0 + 31; A.tq = A.tw0 + A.r32;
        A.lutrow = nullptr; A.lut_far = 0.f; A.curblk = 0; A.tokidx = 0; A.mk0 = 0ull; A.mk1 = 0ull; A.inv_l = 0.f;
        const unsigned trow = (unsigned)(b * SEQ + A.tq);
        bf16x8 q[12];
        { const unsigned qo = (trow * (unsigned)NQB + (unsigned)(h * DK + 8 * A.hi)) * 2u;
#pragma unroll
          for (int d0 = 0; d0 < 12; ++d0) q[d0] = *(const bf16x8*)(QMc + (qo + 32u * d0)); }
        f32x16 o[4]; float m_run = -1e30f, l_run = 0.f;
#pragma unroll
        for (int d = 0; d < 4; ++d)
#pragma unroll
            for (int r = 0; r < 16; ++r) o[d][r] = 0.f;
        attn_pass<MODE_MLA>(lds, KMc + (size_t)bh * SEQ * DK * 2, VTMc + (size_t)bh * DV * SEQ * 2, SEQ, 0, 4 * qb + 4, q, o, m_run, l_run, A);
        const float lt = l_run + __shfl_xor(l_run, 32);
        attn_epilogue<false>(o, 1.0f / lt, Y1c, (trow * (unsigned)N3P + (unsigned)(C3_Z + h * DV)) * 2u, OMc, (trow * (unsigned)ZW8 + (unsigned)(h * DV)) * 2u, A.hi);
    }
}
constexpr int LDS_BYTES = 131072 + 16;
constexpr int NPHASE = 14;

template <int PH>
DI void run_phase(const Params& P, LAS unsigned char* lds, int bid, int nb) {
    unsigned char* ws = P.ws;
    if constexpr (PH == 0) {
        phase_wconv(lds, P.nsa_w_in, (bf16_t*)(ws + OFF_W1T), DM, N1, N1P, bid, nb);
        phase_wconv(lds, P.nsa_w_out, (bf16_t*)(ws + OFF_W2T), ZW8, DM, DM, bid, nb);
        phase_wconv(lds, P.mla_w_in, (bf16_t*)(ws + OFF_W3T), DM, N3, N3P, bid, nb);
        phase_wconv(lds, P.mla_w_q_b, (bf16_t*)(ws + OFF_W4T), QLORA, NQB, NQB, bid, nb);
        phase_wconv(lds, P.mla_w_kv_b, (bf16_t*)(ws + OFF_W5T), KVLORA, NKVB, NKVB, bid, nb);
        phase_wconv(lds, P.mla_w_out, (bf16_t*)(ws + OFF_W6T), ZW8, DM, DM, bid, nb);
        phase_wconv(lds, P.w1_k, (bf16_t*)(ws + OFF_W1K), 6144, 192, 256, bid, nb);
        phase_wconv(lds, P.w1_v, (bf16_t*)(ws + OFF_W1V), 4096, 128, 256, bid, nb);
        phase_rmsnorm(P.x, P.norm_w, (bf16_t*)(ws + OFF_H), bid, nb);
    } else if constexpr (PH == 1) {
        pg8::Gemm g{(const bf16_t*)(ws + OFF_H), (const bf16_t*)(ws + OFF_W1T), MTOK, N1P, DM};
        pg8::StaticOrder S; S.init(g.M, g.N, nb, bid);
        pg8::EpiStoreBf16 E{(bf16_t*)(ws + OFF_Y0), N1P};
        pg8::gemm_phase<pg8::EpiStoreBf16, pg8::StaticOrder, false>(lds, g, S, E, nullptr);
    } else if constexpr (PH == 2) {
        phase_nsa_prep(P, bid, nb);
        phase_vt(lds, (const bf16_t*)(ws + OFF_Y0), N1P, C_KVS + NG * DK, DV, NG, (bf16_t*)(ws + OFF_VTS), bid, nb);
        phase_vt(lds, (const bf16_t*)(ws + OFF_Y0), N1P, C_KVW + NG * DK, DV, NG, (bf16_t*)(ws + OFF_VTW), bid, nb);
    } else if constexpr (PH == 3) {
        if (bid < 16) {
            pg8::Gemm g{(const bf16_t*)(ws + OFF_ACK), (const bf16_t*)(ws + OFF_W1K), 4096, 256, 6144};
            pg8::StaticOrder S; S.init(g.M, g.N, 16, bid);
            pg8::EpiPlainF32 E{(float*)(ws + OFF_HIDK), 256};
            pg8::gemm_phase<pg8::EpiPlainF32, pg8::StaticOrder, false>(lds, g, S, E, nullptr);
        } else if (bid < 32) {
            pg8::Gemm g{(const bf16_t*)(ws + OFF_ACV), (const bf16_t*)(ws + OFF_W1V), 4096, 256, 4096};
            pg8::StaticOrder S; S.init(g.M, g.N, 16, bid - 16);
            pg8::EpiPlainF32 E{(float*)(ws + OFF_HIDV), 256};
            pg8::gemm_phase<pg8::EpiPlainF32, pg8::StaticOrder, false>(lds, g, S, E, nullptr);
        }
    } else if constexpr (PH == 4) {
        phase_cmp2(lds, P, bid, nb);
    } else if constexpr (PH == 5) {
        phase_nsa_attn(lds, P, bid, nb);
    } else if constexpr (PH == 6) {
        pg8::Gemm g{(const bf16_t*)(ws + OFF_O), (const bf16_t*)(ws + OFF_W2T), MTOK, DM, ZW8};
        pg8::StaticOrder S; S.init(g.M, g.N, nb, bid);
        pg8::EpiResF32 E{P.x, P.out, DM};
        pg8::gemm_phase<pg8::EpiResF32, pg8::StaticOrder, false>(lds, g, S, E, nullptr);
    } else if constexpr (PH == 7) {
        phase_rmsnorm(P.out, P.norm_w + DM, (bf16_t*)(ws + OFF_H), bid, nb);
    } else if constexpr (PH == 8) {
        pg8::Gemm g{(const bf16_t*)(ws + OFF_H), (const bf16_t*)(ws + OFF_W3T), MTOK, N3P, DM};
        pg8::StaticOrder S; S.init(g.M, g.N, nb, bid);
        pg8::EpiStoreBf16 E{(bf16_t*)(ws + OFF_Y1), N3P};
        pg8::gemm_phase<pg8::EpiStoreBf16, pg8::StaticOrder, false>(lds, g, S, E, nullptr);
    } else if constexpr (PH == 9) {
        phase_mla_prep1(P, bid, nb);
    } else if constexpr (PH == 10) {
        {
            pg8::Gemm g{(const bf16_t*)(ws + OFF_CQN), (const bf16_t*)(ws + OFF_W4T), MTOK, NQB, QLORA};
            pg8::StaticOrder S; S.init(g.M, g.N, nb, bid);
            pg8::EpiStoreBf16 E{(bf16_t*)(ws + OFF_QM), NQB};
            pg8::gemm_phase<pg8::EpiStoreBf16, pg8::StaticOrder, false>(lds, g, S, E, nullptr);
        }
        __syncthreads();
        {
            pg8::Gemm g{(const bf16_t*)(ws + OFF_CKVN), (const bf16_t*)(ws + OFF_W5T), MTOK, NKVB, KVLORA};
            pg8::StaticOrder S; S.init(g.M, g.N, nb, bid);
            pg8::EpiStoreBf16 E{(bf16_t*)(ws + OFF_KVM), NKVB};
            pg8::gemm_phase<pg8::EpiStoreBf16, pg8::StaticOrder, false>(lds, g, S, E, nullptr);
        }
    } else if constexpr (PH == 11) {
        phase_mla_prep2(P, bid, nb);
        phase_vt(lds, (const bf16_t*)(ws + OFF_KVM), NKVB, 128, 256, NH, (bf16_t*)(ws + OFF_VTM), bid, nb);
    } else if constexpr (PH == 12) {
        phase_mla_attn(lds, P, bid, nb);
    } else if constexpr (PH == 13) {
        pg8::Gemm g{(const bf16_t*)(ws + OFF_O), (const bf16_t*)(ws + OFF_W6T), MTOK, DM, ZW8};
        pg8::StaticOrder S; S.init(g.M, g.N, nb, bid);
        pg8::EpiResF32 E{P.out, P.out, DM};
        pg8::gemm_phase<pg8::EpiResF32, pg8::StaticOrder, false>(lds, g, S, E, nullptr);
    }
}


__global__ __launch_bounds__(512, 2) void k_mega(Params P) {
    extern __shared__ __attribute__((aligned(16))) unsigned char shm[];
    LAS unsigned char* lds = (LAS unsigned char*)shm;
    volatile LAS unsigned* st = (volatile LAS unsigned*)(lds + 131072);
    if (threadIdx.x == 0) { st[0] = 0u; st[1] = 0u; st[2] = 0u; st[3] = 0u; }
    __syncthreads();
    XcdBarrier bar = xcd_barrier_post((unsigned*)(P.ws + OFF_CTL), st);
    const int bid = (int)blockIdx.x, nb = (int)gridDim.x;
    run_phase<0>(P, lds, bid, nb);  xcd_barrier(bar);
    run_phase<1>(P, lds, bid, nb);  xcd_barrier(bar);
    run_phase<2>(P, lds, bid, nb);  xcd_barrier(bar);
    run_phase<3>(P, lds, bid, nb);  xcd_barrier(bar);
    run_phase<4>(P, lds, bid, nb);  xcd_barrier(bar);
    run_phase<5>(P, lds, bid, nb);  xcd_barrier(bar);
    run_phase<6>(P, lds, bid, nb);  xcd_barrier(bar);
    run_phase<7>(P, lds, bid, nb);  xcd_barrier(bar);
    run_phase<8>(P, lds, bid, nb);  xcd_barrier(bar);
    run_phase<9>(P, lds, bid, nb);  xcd_barrier(bar);
    run_phase<10>(P, lds, bid, nb); xcd_barrier(bar);
    run_phase<11>(P, lds, bid, nb); xcd_barrier(bar);
    run_phase<12>(P, lds, bid, nb); xcd_barrier(bar);
    run_phase<13>(P, lds, bid, nb);
}

extern "C" void kernel_launch(void* const* d_in, const int* in_sizes, int n_in, void* d_out, int out_size, void* d_ws, size_t ws_size, hipStream_t stream) {
    (void)in_sizes; (void)n_in; (void)out_size;
    if (ws_size < WS_END) return;
    Params P{};
    P.x = (const float*)d_in[0]; P.pos = (const int*)d_in[1]; P.norm_w = (const float*)d_in[2]; P.rel_bias = (const float*)d_in[3];
    P.nsa_w_in = (const float*)d_in[4]; P.nsa_q_norm = (const float*)d_in[5]; P.nsa_k_norm = (const float*)d_in[6]; P.pe_k = (const float*)d_in[7];
    P.w1_k = (const float*)d_in[8]; P.w2_k = (const float*)d_in[9]; P.pe_v = (const float*)d_in[10]; P.w1_v = (const float*)d_in[11]; P.w2_v = (const float*)d_in[12];
    P.nsa_w_out = (const float*)d_in[13]; P.mla_w_in = (const float*)d_in[14]; P.mla_q_a_norm = (const float*)d_in[15]; P.mla_w_q_b = (const float*)d_in[16];
    P.mla_kv_a_norm = (const float*)d_in[17]; P.mla_w_kv_b = (const float*)d_in[18]; P.mla_q_norm = (const float*)d_in[19]; P.mla_k_norm = (const float*)d_in[20];
    P.mla_w_out = (const float*)d_in[21];
    P.out = (float*)d_out; P.ws = (unsigned char*)d_ws;
    static int grid = 0;
    if (!grid) {
        int dev = 0, cus = 0, per_cu = 0; (void)hipGetDevice(&dev);
        if (hipDeviceGetAttribute(&cus, hipDeviceAttributeMultiprocessorCount, dev) != hipSuccess || cus <= 0) cus = 256;
        (void)hipFuncSetAttribute((const void*)k_mega, hipFuncAttributeMaxDynamicSharedMemorySize, LDS_BYTES);
        if (hipOccupancyMaxActiveBlocksPerMultiprocessor(&per_cu, k_mega, 512, LDS_BYTES) != hipSuccess || per_cu < 1) per_cu = 1;
        grid = cus;
    }
    (void)hipMemsetAsync((unsigned char*)d_ws + OFF_CTL, 0, XCD_BAR_WORDS * sizeof(unsigned), stream);
    hipLaunchKernelGGL(k_mega, dim3(grid), dim3(512), LDS_BYTES, stream, P);
}
```

```cpp
#include <hip/hip_runtime.h>
#include <stdint.h>
#include <stddef.h>

#define DI __device__ __forceinline__
#define LAS __attribute__((address_space(3)))
typedef unsigned short bf16_t;
typedef short bf16x8 __attribute__((ext_vector_type(8)));
typedef float f32x4 __attribute__((ext_vector_type(4)));
typedef float f32x16 __attribute__((ext_vector_type(16)));
typedef unsigned u32x4 __attribute__((ext_vector_type(4)));
typedef unsigned u32x2 __attribute__((ext_vector_type(2)));
typedef __bf16 bf2_t __attribute__((ext_vector_type(2)));
typedef float f2_t __attribute__((ext_vector_type(2)));

DI int tid_opaque() { int t = (int)threadIdx.x; asm volatile("" : "+v"(t)); return t; }
DI unsigned pk2(float a, float b) { f2_t f = {a, b}; bf2_t v = __builtin_convertvector(f, bf2_t); return __builtin_bit_cast(unsigned, v); }
DI float bflo(unsigned w) { return __uint_as_float(w << 16); }
DI float bfhi(unsigned w) { return __uint_as_float(w & 0xffff0000u); }
#ifndef FP8EMU
#define FP8EMU 0
#endif
DI float emu_q8(float x, float s) { float y = x * s; const float ay = fabsf(y);
    if (ay < 0.015625f) y = rintf(y * 512.0f) * (1.0f / 512.0f);
    else { unsigned u = __float_as_uint(y); u = (u + 0x0007FFFFu + ((u >> 20) & 1u)) & 0xFFF00000u; y = __uint_as_float(u); }
    y = fminf(fmaxf(y, -448.0f), 448.0f); return y / s; }
DI float bf1(bf16_t h) { return __uint_as_float(((unsigned)h) << 16); }

constexpr int BATCH = 4, SEQ = 4096, DM = 4096, MTOK = BATCH * SEQ;
constexpr int NH = 64, NG = 4, NR = 16, DK = 192, DV = 128;
constexpr int N1 = 40896, N1P = 40960;
constexpr int C_Q = 0, C_KVC = 12288, C_KVS = 13568, C_KVW = 14848, C_ZC = 16128, C_ZS = 24320, C_ZW = 32512, C_G = 40704;
constexpr int N3 = 10304, N3P = 10496;
constexpr int C3_CQ = 0, C3_CKV = 1536, C3_KPE = 2048, C3_Z = 2112;
constexpr int QLORA = 1536, KVLORA = 512;
constexpr int NQB = 12288, NKVB = 16384, ZW8 = 8192;
constexpr float EPSN = 1e-6f;
constexpr float LOG2E = 1.4426950408889634f;
constexpr float QSCALE = 0.07216878364870322f * 1.4426950408889634f;

constexpr size_t SZ_W1T = (size_t)N1P * DM * 2, SZ_W2T = (size_t)DM * ZW8 * 2, SZ_W3T = (size_t)N3P * DM * 2, SZ_W4T = (size_t)NQB * QLORA * 2,
                 SZ_W5T = (size_t)NKVB * KVLORA * 2, SZ_W6T = (size_t)DM * ZW8 * 2;
constexpr size_t OFF_W1T = 0, OFF_W2T = OFF_W1T + SZ_W1T, OFF_W3T = OFF_W2T + SZ_W2T, OFF_W4T = OFF_W3T + SZ_W3T, OFF_W5T = OFF_W4T + SZ_W4T,
                 OFF_W6T = OFF_W5T + SZ_W5T, OFF_W1K = OFF_W6T + SZ_W6T;
constexpr size_t SZ_W1K = (size_t)256 * 6144 * 2, SZ_W1V = (size_t)256 * 4096 * 2;
constexpr size_t OFF_W1V = OFF_W1K + SZ_W1K, OFF_CTL = OFF_W1V + SZ_W1V, OFF_H = OFF_CTL + 65536;
constexpr size_t SZ_H = (size_t)MTOK * DM * 2, SZ_KS = (size_t)BATCH * NG * SEQ * DK * 2, SZ_VTS = (size_t)BATCH * NG * DV * SEQ * 2,
                 SZ_ACK = (size_t)4096 * 6144 * 2, SZ_ACV = (size_t)4096 * 4096 * 2;
constexpr size_t OFF_KS = OFF_H + SZ_H, OFF_KW = OFF_KS + SZ_KS, OFF_VTS = OFF_KW + SZ_KS, OFF_VTW = OFF_VTS + SZ_VTS, OFF_ACK = OFF_VTW + SZ_VTS,
                 OFF_ACV = OFF_ACK + SZ_ACK, OFF_KC = OFF_ACV + SZ_ACV;
constexpr size_t SZ_KC = (size_t)16 * 256 * DK * 2, SZ_VTC = (size_t)16 * DV * 256 * 2, SZ_HID = (size_t)4096 * 256 * 4;
constexpr size_t OFF_VTC = OFF_KC + SZ_KC, OFF_HIDK = OFF_VTC + SZ_VTC, OFF_HIDV = OFF_HIDK + SZ_HID, OFF_Y0 = OFF_HIDV + SZ_HID;
constexpr size_t SZ_Y0 = (size_t)MTOK * N1P * 2, SZ_O = (size_t)MTOK * ZW8 * 2;
constexpr size_t OFF_O = OFF_Y0 + SZ_Y0, WS_END = OFF_O + SZ_O;
constexpr size_t OFF_KM = 0;
constexpr size_t SZ_KM = (size_t)BATCH * NH * SEQ * DK * 2;
static_assert(SZ_KM <= SZ_W1T + SZ_W2T, "KM alias");
constexpr size_t OFF_VTM = OFF_H;
constexpr size_t SZ_VTM = (size_t)BATCH * NH * DV * SEQ * 2;
constexpr size_t OFF_CKVN = OFF_VTM + SZ_VTM;
constexpr size_t SZ_CKVN = (size_t)MTOK * KVLORA * 2;
static_assert(OFF_CKVN + SZ_CKVN <= OFF_KC, "CKVN alias");
constexpr size_t OFF_Y1 = OFF_Y0, SZ_Y1 = (size_t)MTOK * N3P * 2;
constexpr size_t OFF_QM = OFF_Y1 + SZ_Y1, SZ_QM = (size_t)MTOK * NQB * 2;
constexpr size_t OFF_KVM = OFF_QM + SZ_QM, SZ_KVM = (size_t)MTOK * NKVB * 2;
constexpr size_t OFF_CQN = OFF_KVM + SZ_KVM, SZ_CQN = (size_t)MTOK * QLORA * 2;
constexpr size_t OFF_ROPE = OFF_CQN + SZ_CQN, SZ_ROPE = (size_t)MTOK * 64 * 4;
static_assert(OFF_ROPE + SZ_ROPE <= OFF_O, "layer-1 alias region");
static_assert(WS_END <= 2680160256ull, "workspace");

struct Params {
    const float* x; const int* pos; const float* norm_w; const float* rel_bias;
    const float* nsa_w_in; const float* nsa_q_norm; const float* nsa_k_norm; const float* pe_k; const float* w1_k; const float* w2_k;
    const float* pe_v; const float* w1_v; const float* w2_v; const float* nsa_w_out;
    const float* mla_w_in; const float* mla_q_a_norm; const float* mla_w_q_b; const float* mla_kv_a_norm; const float* mla_w_kv_b;
    const float* mla_q_norm; const float* mla_k_norm; const float* mla_w_out;
    float* out; unsigned char* ws;
};

#define XB_TMO      128
#define XB_XCNT(j)  (256  + 64 * (j))
#define XB_XSUB(j)  (1280 + 64 * (j))
#define XB_XGEN(j)  (2304 + 64 * (j))
#define XB_TOP      3328
#define XB_TOPGEN   3392
#define XCD_BAR_WORDS 3456
#define XB_SPIN_CAP (1u << 18)

__device__ __forceinline__ unsigned xb_ld(unsigned* p)              { return __hip_atomic_load(p, __ATOMIC_RELAXED, __HIP_MEMORY_SCOPE_AGENT); }
__device__ __forceinline__ unsigned xb_add(unsigned* p, unsigned v) { return __hip_atomic_fetch_add(p, v, __ATOMIC_RELAXED, __HIP_MEMORY_SCOPE_AGENT); }
__device__ __forceinline__ unsigned xb_xcc_id() { return (unsigned)__builtin_amdgcn_s_getreg((3 << 11) | 20) & 0xFu; }
#define XB_SPIN(cond, bar) do { unsigned _sp = 0; while (cond) { __builtin_amdgcn_s_sleep(1); \
    if ((++_sp & 255u) == 0u) { if (xb_ld(&(bar)[XB_TMO])) break; if (_sp > XB_SPIN_CAP) { atomicAdd(&(bar)[XB_TMO], 1u); break; } } } } while (0)

struct XcdBarrier {
    unsigned* bar; unsigned x;
    volatile LAS unsigned* st;
};

__device__ __forceinline__ XcdBarrier xcd_barrier_post(unsigned* bar, volatile LAS unsigned* st) {
    XcdBarrier b; b.bar = bar; b.x = xb_xcc_id(); b.st = st;
    if (threadIdx.x == 0) (void)xb_add(&bar[XB_XCNT(b.x)], 1u);
    return b;
}
__device__ __forceinline__ void xcd_barrier_complete(unsigned* bar, unsigned x, unsigned& nloc, unsigned& nx) {
    const unsigned G = gridDim.x * gridDim.y * gridDim.z;
    unsigned sum, cnt, mine, sp = 0u;
    for (;;) {
        sum = 0u; cnt = 0u; mine = 0u;
#pragma unroll
        for (unsigned j = 0; j < 16; ++j) { const unsigned c = xb_ld(&bar[XB_XCNT(j)]); sum += c; cnt += (c > 0u) ? 1u : 0u; mine = (j == x) ? c : mine; }
        if (sum == G) break;
        __builtin_amdgcn_s_sleep(1);
        if ((++sp & 255u) == 0u) { if (xb_ld(&bar[XB_TMO])) break; if (sp > XB_SPIN_CAP) { atomicAdd(&bar[XB_TMO], 1u); break; } }
    }
    nloc = mine > 0u ? mine : 1u; nx = cnt > 0u ? cnt : 1u;
}

__device__ __forceinline__ void xcd_barrier(const XcdBarrier& b) {
    asm volatile("s_waitcnt vmcnt(0)" ::: "memory");
    __syncthreads();
    if (threadIdx.x == 0) {
        unsigned* bar = b.bar;
        __builtin_amdgcn_s_waitcnt(0);
        unsigned nloc = b.st[0], nx = b.st[1];
        if (nloc == 0u) { xcd_barrier_complete(bar, b.x, nloc, nx); b.st[0] = nloc; b.st[1] = nx; }
        const unsigned old = xb_add(&bar[XB_XSUB(b.x)], 1u);
        const unsigned gen = old / nloc;
        if (old + 1u == (gen + 1u) * nloc) {
            __builtin_amdgcn_fence(__ATOMIC_RELEASE, "agent");
            asm volatile("s_waitcnt vmcnt(0)" ::: "memory");
            const unsigned og = xb_add(&bar[XB_TOP], 1u);
            const unsigned tg = og / nx;
            if (og + 1u == (tg + 1u) * nx) xb_add(&bar[XB_TOPGEN], 1u);
            else XB_SPIN(xb_ld(&bar[XB_TOPGEN]) == tg, bar);
            __builtin_amdgcn_fence(__ATOMIC_ACQUIRE, "agent");
            xb_add(&bar[XB_XGEN(b.x)], 1u);
            asm volatile("s_waitcnt vmcnt(0)" ::: "memory");
        } else {
            XB_SPIN(xb_ld(&bar[XB_XGEN(b.x)]) == gen, bar);
            __builtin_amdgcn_fence(__ATOMIC_ACQUIRE, "agent");
            asm volatile("s_waitcnt vmcnt(0)" ::: "memory");
        }
    }
    __syncthreads();
}

namespace pg8 {
#define PG8_LAS __attribute__((address_space(3)))
typedef unsigned short bf16_t;
typedef short bf16x8 __attribute__((ext_vector_type(8)));
typedef float f32x4 __attribute__((ext_vector_type(4)));
typedef unsigned u32x4 __attribute__((ext_vector_type(4)));
constexpr int BM = 256, BK = 64, HALF = 128, HTB = HALF * BK * 2  , STAGE_BYTES = 8 * HTB, NXCD = 8, WGM = 8;

__host__ __device__ __forceinline__ int lds_byte(int r, int c) { const int st = (r >> 4) * 2 + (c >> 5), rr = r & 15, cc = c & 31, ob = rr * 64 + cc * 2; return st * 1024 + (ob ^ (((ob >> 9) & 1) << 5)); }
__host__ __device__ __forceinline__ void stage_rc(int b, int& R, int& C) { const int st = b / 1024, sb = b % 1024, swz = sb ^ (((sb >> 9) & 1) << 5); R = (st >> 1) * 16 + swz / 64; C = (st & 1) * 32 + (swz % 64) / 2; }
__host__ __device__ __forceinline__ int perm32(int rho) { const int n = rho >> 4, i = rho & 15; return 8 * (i >> 2) + 4 * n + (i & 3); }

struct Unit { int pm, pn; };
struct Gemm { const bf16_t* A; const bf16_t* Bt; int M, N, K; };

struct StaticOrder {
    int nM, nN, nwg, G, c;
    __host__ __device__ void init(int M, int N, int G_, int c_) { nM = M / BM; nN = N / BM; nwg = nM * nN; G = G_; c = c_; }
    __host__ __device__ bool next(int i, Unit& u) const {
        const long L = (long)i * G + c; if (L >= nwg) return false;
        int wgid = (int)L; { const int q = nwg / NXCD, r = nwg % NXCD, xcd = wgid % NXCD, off = wgid / NXCD; wgid = (xcd < r ? xcd * (q + 1) : r * (q + 1) + (xcd - r) * q) + off; }
        const int nig = WGM * nN, gid = wgid / nig, fm = gid * WGM, gsz = (nM - fm) < WGM ? (nM - fm) : WGM;
        u.pm = fm + ((wgid % nig) % gsz); u.pn = (wgid % nig) / gsz; return true;
    }
    __device__ __forceinline__ void a_ready(const Unit&) const {}
    __device__ __forceinline__ void done(const Unit&) const {}
};
struct EpiStoreBf16 {
    static constexpr bool PERM = true, AFTER_DRAIN = false;
    bf16_t* O; int ldc;
    __device__ __forceinline__ void operator()(const f32x4 (&acc)[2][2][4][2], const Unit& u, int wr, int wc, int fr, int fq) const {
        const int row0 = u.pm * BM + wr * 64 + fr; const int col0 = u.pn * BM + wc * 32 + 8 * fq;
#pragma unroll
        for (int ai = 0; ai < 2; ++ai)
#pragma unroll
            for (int m = 0; m < 4; ++m) { bf16_t* rowp = O + (size_t)(row0 + ai * HALF + m * 16) * ldc + col0;
#pragma unroll
                for (int bj = 0; bj < 2; ++bj) { const f32x4 v0 = acc[ai][bj][m][0], v1 = acc[ai][bj][m][1];
                    u32x4 w; w.x = pk2(v0[0], v0[1]); w.y = pk2(v0[2], v0[3]); w.z = pk2(v1[0], v1[1]); w.w = pk2(v1[2], v1[3]);
                    *(u32x4*)(rowp + bj * HALF) = w; } }
    }
};
struct EpiResF32 {
    static constexpr bool PERM = false, AFTER_DRAIN = false;
    const float* base; float* out; int ldc;
    __device__ __forceinline__ void operator()(const f32x4 (&acc)[2][2][4][2], const Unit& u, int wr, int wc, int fr, int fq) const {
        const int row0 = u.pm * BM + wr * 64 + fr, col0 = u.pn * BM + wc * 32 + 4 * fq;
#pragma unroll
        for (int ai = 0; ai < 2; ++ai)
#pragma unroll
            for (int m = 0; m < 4; ++m) { const size_t off = (size_t)(row0 + ai * HALF + m * 16) * ldc + col0;
#pragma unroll
                for (int bj = 0; bj < 2; ++bj)
#pragma unroll
                    for (int n = 0; n < 2; ++n) { const f32x4 bs = *(const f32x4*)(base + off + bj * HALF + n * 16);
                        *(f32x4*)(out + off + bj * HALF + n * 16) = bs + acc[ai][bj][m][n]; } }
    }
};
struct EpiPlainF32 {
    static constexpr bool PERM = false, AFTER_DRAIN = false;
    float* C; int ldc;
    __device__ __forceinline__ void operator()(const f32x4 (&acc)[2][2][4][2], const Unit& u, int wr, int wc, int fr, int fq) const {
        const int row0 = u.pm * BM + wr * 64 + fr, col0 = u.pn * BM + wc * 32 + 4 * fq;
#pragma unroll
        for (int ai = 0; ai < 2; ++ai)
#pragma unroll
            for (int m = 0; m < 4; ++m) { float* rowp = C + (size_t)(row0 + ai * HALF + m * 16) * ldc + col0;
#pragma unroll
                for (int bj = 0; bj < 2; ++bj)
#pragma unroll
                    for (int n = 0; n < 2; ++n) *(f32x4*)(rowp + bj * HALF + n * 16) = acc[ai][bj][m][n]; }
    }
};
template <class Epi, class Sched, bool STAMP = false>
__device__ __forceinline__ void gemm_phase(PG8_LAS unsigned char* lds, const Gemm g, const Sched& S, const Epi& E, unsigned long long* stamps) {
    const int tid = tid_opaque(), wid = __builtin_amdgcn_readfirstlane(tid >> 6), lane = tid & 63, wr = wid >> 2, wc = wid & 3, fr = lane & 15, fq = lane >> 4;
    const int K = g.K, nt = K / BK;
    int ts_lo = 0, ts_hi = 0, nts = 0; const unsigned long long rt_entry = STAMP ? (unsigned long long)wall_clock64() : 0ull;
#define PG8_STAMP() do { if (STAMP && wid == 0 && nts < 64) { const unsigned long long _c = (unsigned long long)clock64(); \
        ts_lo = (lane == nts) ? (int)(unsigned)_c : ts_lo; ts_hi = (lane == nts) ? (int)(unsigned)(_c >> 32) : ts_hi; ++nts; } } while (0)
    PG8_STAMP();
    unsigned voffA[2], voffB[2];
#pragma unroll
    for (int i = 0; i < 2; ++i) { int R, C; stage_rc(tid * 16 + i * 8192, R, C); const int Rb = Epi::PERM ? ((R & ~31) + perm32(R & 31)) : R;
        voffA[i] = (unsigned)(R * K + C) * 2u; voffB[i] = (unsigned)(Rb * K + C) * 2u; }
    const size_t kstep = (size_t)(BK * 2);
    const size_t hstep = (size_t)HALF * K * 2;
    const size_t tstep = 2 * hstep;
    const unsigned ldsw = (unsigned)wid * 1024u;
    const int aoff = lds_byte(wr * 64 + fr, fq * 8), boff = lds_byte(wc * 32 + fr, fq * 8);
#define PG8_SA(b, h) (((b) * 2 + (h)) * HTB)
#define PG8_SB(b, h) ((4 + (b) * 2 + (h)) * HTB)
#define PG8_STAGE(bufoff, gbase, voff) do { _Pragma("unroll") for (int _i = 0; _i < 2; ++_i) \
        __builtin_amdgcn_global_load_lds((const unsigned*)((const char*)(gbase) + (voff)[_i]), (PG8_LAS unsigned*)(lds + (bufoff) + ldsw + _i * 8192), 16, 0, 0); } while (0)
#define PG8_LDA(dst, b, h) do { _Pragma("unroll") for (int m = 0; m < 4; ++m) _Pragma("unroll") for (int k = 0; k < 2; ++k) dst[m][k] = *(const PG8_LAS bf16x8*)(lds + PG8_SA(b, h) + aoff + m * 2048 + k * 1024); } while (0)
#define PG8_LDB(dst, b, h) do { _Pragma("unroll") for (int n = 0; n < 2; ++n) _Pragma("unroll") for (int k = 0; k < 2; ++k) dst[n][k] = *(const PG8_LAS bf16x8*)(lds + PG8_SB(b, h) + boff + n * 2048 + k * 1024); } while (0)
#define PG8_MMA(ai, bj, At, Bt) do { __builtin_amdgcn_s_setprio(1); _Pragma("unroll") for (int m = 0; m < 4; ++m) _Pragma("unroll") for (int n = 0; n < 2; ++n) _Pragma("unroll") for (int k = 0; k < 2; ++k) \
        acc[ai][bj][m][n] = __builtin_amdgcn_mfma_f32_16x16x32_bf16(Bt[n][k], At[m][k], acc[ai][bj][m][n], 0, 0, 0); __builtin_amdgcn_s_setprio(0); } while (0)
#define PG8_WAIT_V(n) asm volatile("s_waitcnt vmcnt(" #n ")" ::: "memory")
#define PG8_WAIT_L(n) asm volatile("s_waitcnt lgkmcnt(" #n ")" ::: "memory")
#define PG8_BAR __builtin_amdgcn_s_barrier()
#define PG8_SCHED __builtin_amdgcn_sched_barrier(0)
    Unit cur, nxt; int ui = 0;
    if (!S.next(0, cur)) return;
    f32x4 acc[2][2][4][2];
#pragma unroll
    for (int a = 0; a < 2; ++a)
#pragma unroll
        for (int b = 0; b < 2; ++b)
#pragma unroll
            for (int m = 0; m < 4; ++m)
#pragma unroll
                for (int n = 0; n < 2; ++n) acc[a][b][m][n] = (f32x4){0.f, 0.f, 0.f, 0.f};
    bf16x8 At[4][2], B0[2][2], B1[2][2];
    const char* cA = (const char*)g.A + (size_t)cur.pm * tstep; const char* cB = (const char*)g.Bt + (size_t)cur.pn * tstep;
    S.a_ready(cur);
    PG8_STAGE(PG8_SB(0, 0), cB, voffB); PG8_STAGE(PG8_SA(0, 0), cA, voffA); PG8_STAGE(PG8_SB(0, 1), cB + hstep, voffB); PG8_STAGE(PG8_SA(0, 1), cA + hstep, voffA);
    if (wr == 1) PG8_BAR;
    PG8_WAIT_V(4); PG8_BAR;
    PG8_STAGE(PG8_SB(1, 0), cB + kstep, voffB); PG8_STAGE(PG8_SA(1, 0), cA + kstep, voffA); PG8_STAGE(PG8_SB(1, 1), cB + hstep + kstep, voffB);
    PG8_WAIT_V(6); PG8_BAR;
    PG8_STAMP();
    for (;;) {
        const bool has_next = S.next(ui + 1, nxt);
        const char* nA = has_next ? (const char*)g.A + (size_t)nxt.pm * tstep : cA; const char* nB = has_next ? (const char*)g.Bt + (size_t)nxt.pn * tstep : cB;
        for (int t = 0; t < nt; t += 2) {
            const bool last = (t == nt - 2);
            const char* a1 = cA + (size_t)(t + 1) * kstep;
            const char* a2 = last ? nA : cA + (size_t)(t + 2) * kstep; const char* b2 = last ? nB : cB + (size_t)(t + 2) * kstep;
            const char* a3 = a2 + kstep; const char* b3 = b2 + kstep;
            if (last && has_next) S.a_ready(nxt);
            PG8_LDB(B0, 0, 0); PG8_SCHED; PG8_LDA(At, 0, 0); PG8_STAGE(PG8_SA(1, 1), a1 + hstep, voffA);
            PG8_WAIT_L(8); PG8_BAR; PG8_WAIT_L(0); PG8_MMA(0, 0, At, B0); PG8_BAR; PG8_SCHED;
            PG8_LDB(B1, 0, 1); PG8_STAGE(PG8_SB(0, 0), b2, voffB);
            PG8_BAR; PG8_WAIT_L(0); PG8_MMA(0, 1, At, B1); PG8_BAR;
            PG8_LDA(At, 0, 1); PG8_STAGE(PG8_SA(0, 0), a2, voffA);
            PG8_BAR; PG8_WAIT_L(0); PG8_MMA(1, 0, At, B0); PG8_BAR; PG8_SCHED;
            PG8_STAGE(PG8_SB(0, 1), b2 + hstep, voffB);
            PG8_WAIT_V(6); PG8_BAR; PG8_MMA(1, 1, At, B1); PG8_BAR;
            PG8_LDB(B0, 1, 0); PG8_SCHED; PG8_LDA(At, 1, 0); PG8_STAGE(PG8_SA(0, 1), a2 + hstep, voffA);
            PG8_WAIT_L(8); PG8_BAR; PG8_WAIT_L(0); PG8_MMA(0, 0, At, B0); PG8_BAR; PG8_SCHED;
            PG8_LDB(B1, 1, 1); PG8_STAGE(PG8_SB(1, 0), b3, voffB);
            PG8_BAR; PG8_WAIT_L(0); PG8_MMA(0, 1, At, B1); PG8_BAR;
            PG8_LDA(At, 1, 1); PG8_STAGE(PG8_SA(1, 0), a3, voffA);
            PG8_BAR; PG8_WAIT_L(0); PG8_MMA(1, 0, At, B0); PG8_BAR; PG8_SCHED;
            PG8_STAGE(PG8_SB(1, 1), b3 + hstep, voffB);
            PG8_WAIT_V(6); PG8_BAR; PG8_MMA(1, 1, At, B1); PG8_BAR;
        }
        PG8_STAMP();
        if constexpr (!Epi::AFTER_DRAIN) { E(acc, cur, wr, wc, fr, fq); S.done(cur); }
        PG8_STAMP();
        if (!has_next) break;
#pragma unroll
        for (int a = 0; a < 2; ++a)
#pragma unroll
            for (int b = 0; b < 2; ++b)
#pragma unroll
                for (int m = 0; m < 4; ++m)
#pragma unroll
                    for (int n = 0; n < 2; ++n) acc[a][b][m][n] = (f32x4){0.f, 0.f, 0.f, 0.f};
        cur = nxt; cA = nA; cB = nB; ++ui;
    }
    PG8_WAIT_V(0);
    if (wr == 0) PG8_BAR;
    PG8_BAR;
    if constexpr (Epi::AFTER_DRAIN) { E.fused(acc, cur, wr, wc, fr, fq, lds, wid, lane); S.done(cur); }
    PG8_STAMP();
    if (STAMP && wid == 0) { stamps[lane] = lane < nts ? (((unsigned long long)(unsigned)ts_hi << 32) | (unsigned)ts_lo) : 0ull;
        if (lane == 62) stamps[62] = rt_entry; if (lane == 63) stamps[63] = (unsigned long long)wall_clock64(); }
#undef PG8_STAMP
#undef PG8_SA
#undef PG8_SB
#undef PG8_STAGE
#undef PG8_LDA
#undef PG8_LDB
#undef PG8_MMA
#undef PG8_WAIT_V
#undef PG8_WAIT_L
#undef PG8_BAR
#undef PG8_SCHED
}
}


DI void phase_wconv(LAS unsigned char* lds, const float* __restrict__ src, bf16_t* __restrict__ dst, int K, int N, int Npad, int bid, int nb, float q8s = 0.f) {
    LAS float* tile = (LAS float*)lds;
    const int tid = tid_opaque();
    const int tk = K / 64, tn = Npad / 64, total = tk * tn;
    for (int t = bid; t < total; t += nb) {
        const int k0 = (t % tk) * 64, n0 = (t / tk) * 64;
        __syncthreads();
        {
            const int ty = tid >> 4, tx = tid & 15;
#pragma unroll
            for (int i = 0; i < 2; ++i) {
                const int k = k0 + ty + 32 * i, n = n0 + tx * 4;
                f32x4 v = {0.f, 0.f, 0.f, 0.f};
                if (n < N) v = *(const f32x4*)(src + (size_t)k * N + n);
                LAS float* p = tile + (ty + 32 * i) * 65 + tx * 4;
                p[0] = v[0]; p[1] = v[1]; p[2] = v[2]; p[3] = v[3];
            }
        }
        __syncthreads();
        {
            const int n = tid >> 3, kc = tid & 7;
            float v[8];
#pragma unroll
            for (int j = 0; j < 8; ++j) { v[j] = tile[(kc * 8 + j) * 65 + n]; if (q8s != 0.f) v[j] = emu_q8(v[j], q8s); }
            u32x4 w; w.x = pk2(v[0], v[1]); w.y = pk2(v[2], v[3]); w.z = pk2(v[4], v[5]); w.w = pk2(v[6], v[7]);
            *(u32x4*)(dst + (size_t)(n0 + n) * K + k0 + kc * 8) = w;
        }
    }
}

DI void phase_rmsnorm(const float* __restrict__ x, const float* __restrict__ gain, bf16_t* __restrict__ h, int bid, int nb, float q8s = 0.f) {
    const int tid = tid_opaque(); const int lane = tid & 63, wid = tid >> 6;
    for (int row = bid * 8 + wid; row < MTOK; row += nb * 8) {
        const float* xr = x + (size_t)row * DM;
        f32x4 v[16]; float ss = 0.f;
#pragma unroll
        for (int i = 0; i < 16; ++i) { v[i] = *(const f32x4*)(xr + (i * 64 + lane) * 4); ss += v[i][0] * v[i][0] + v[i][1] * v[i][1] + v[i][2] * v[i][2] + v[i][3] * v[i][3]; }
#pragma unroll
        for (int o = 32; o >= 1; o >>= 1) ss += __shfl_xor(ss, o);
        const float rstd = rsqrtf(ss * (1.0f / DM) + EPSN);
        bf16_t* hr = h + (size_t)row * DM;
#pragma unroll
        for (int i = 0; i < 16; ++i) { const f32x4 g = *(const f32x4*)(gain + (i * 64 + lane) * 4);
            float y0 = v[i][0] * rstd * g[0], y1 = v[i][1] * rstd * g[1], y2 = v[i][2] * rstd * g[2], y3 = v[i][3] * rstd * g[3];
            if (q8s != 0.f) { y0 = emu_q8(y0, q8s); y1 = emu_q8(y1, q8s); y2 = emu_q8(y2, q8s); y3 = emu_q8(y3, q8s); }
            u32x2 w; w.x = pk2(y0, y1); w.y = pk2(y2, y3);
            *(u32x2*)(hr + (i * 64 + lane) * 4) = w; }
    }
}

DI void ld192(const bf16_t* p, int j8, float (&v)[24]) {
#pragma unroll
    for (int c = 0; c < 3; ++c) { const u32x4 w = *(const u32x4*)(p + (j8 + 8 * c) * 8);
        v[c * 8 + 0] = bflo(w.x); v[c * 8 + 1] = bfhi(w.x); v[c * 8 + 2] = bflo(w.y); v[c * 8 + 3] = bfhi(w.y);
        v[c * 8 + 4] = bflo(w.z); v[c * 8 + 5] = bfhi(w.z); v[c * 8 + 6] = bflo(w.w); v[c * 8 + 7] = bfhi(w.w); }
}
DI void st192(bf16_t* p, int j8, const float (&v)[24]) {
#pragma unroll
    for (int c = 0; c < 3; ++c) { u32x4 w; w.x = pk2(v[c * 8 + 0], v[c * 8 + 1]); w.y = pk2(v[c * 8 + 2], v[c * 8 + 3]); w.z = pk2(v[c * 8 + 4], v[c * 8 + 5]); w.w = pk2(v[c * 8 + 6], v[c * 8 + 7]);
        *(u32x4*)(p + (j8 + 8 * c) * 8) = w; }
}
DI float sum8(float s) { s += __shfl_xor(s, 1); s += __shfl_xor(s, 2); s += __shfl_xor(s, 4); return s; }

DI void phase_nsa_prep(const Params& P, int bid, int nb) {
    bf16_t* Y0 = (bf16_t*)(P.ws + OFF_Y0);
    bf16_t* KS = (bf16_t*)(P.ws + OFF_KS); bf16_t* KW = (bf16_t*)(P.ws + OFF_KW);
    bf16_t* ACK = (bf16_t*)(P.ws + OFF_ACK); bf16_t* ACV = (bf16_t*)(P.ws + OFF_ACV);
    const int tid = tid_opaque(), grp = tid >> 3, j8 = tid & 7;
    for (int tok = bid; tok < MTOK; tok += nb) {
        const int b = tok / SEQ, s = tok % SEQ;
        bf16_t* yr = Y0 + (size_t)tok * N1P;
        if (grp < 8) {
            const int g = grp & 3, br = grp >> 2;
            float v[24]; ld192(yr + (br ? C_KVW : C_KVS) + g * DK, j8, v);
            float ss = 0.f;
#pragma unroll
            for (int i = 0; i < 24; ++i) ss += v[i] * v[i];
            ss = sum8(ss);
            const float rstd = rsqrtf(ss * (1.0f / DK) + EPSN);
            const float* kn = P.nsa_k_norm + (br ? 2 : 1) * DK;
#pragma unroll
            for (int c = 0; c < 3; ++c)
#pragma unroll
                for (int e = 0; e < 8; ++e) v[c * 8 + e] *= rstd * kn[(j8 + 8 * c) * 8 + e];
            st192((br ? KW : KS) + ((size_t)(b * NG + g) * SEQ + s) * DK, j8, v);
        } else if (grp < 12) {
            const int g = grp - 8;
            float v[24]; ld192(yr + C_KVC + g * DK, j8, v);
#pragma unroll
            for (int k = 0; k < 2; ++k) {
                const int n = (s >> 4) - k, l = s - 16 * n;
                if (n >= 0 && n <= 254) {
                    float w[24];
#pragma unroll
                    for (int c = 0; c < 3; ++c)
#pragma unroll
                        for (int e = 0; e < 8; ++e) w[c * 8 + e] = v[c * 8 + e] + P.pe_k[l * DK + (j8 + 8 * c) * 8 + e];
                    st192(ACK + ((size_t)((b * NG + g) * 256 + n)) * 6144 + l * DK, j8, w);
                }
            }
        } else if (grp < 16) {
            const int g = grp - 12;
            const bf16_t* src = yr + C_KVC + NG * DK + g * DV;
            float v[16];
#pragma unroll
            for (int c = 0; c < 2; ++c) { const u32x4 w = *(const u32x4*)(src + (j8 + 8 * c) * 8);
                v[c * 8 + 0] = bflo(w.x); v[c * 8 + 1] = bfhi(w.x); v[c * 8 + 2] = bflo(w.y); v[c * 8 + 3] = bfhi(w.y);
                v[c * 8 + 4] = bflo(w.z); v[c * 8 + 5] = bfhi(w.z); v[c * 8 + 6] = bflo(w.w); v[c * 8 + 7] = bfhi(w.w); }
#pragma unroll
            for (int k = 0; k < 2; ++k) {
                const int n = (s >> 4) - k, l = s - 16 * n;
                if (n >= 0 && n <= 254) {
                    bf16_t* dst = ACV + ((size_t)((b * NG + g) * 256 + n)) * 4096 + l * DV;
#pragma unroll
                    for (int c = 0; c < 2; ++c) { float w[8];
#pragma unroll
                        for (int e = 0; e < 8; ++e) w[e] = v[c * 8 + e] + P.pe_v[l * DV + (j8 + 8 * c) * 8 + e];
                        u32x4 o; o.x = pk2(w[0], w[1]); o.y = pk2(w[2], w[3]); o.z = pk2(w[4], w[5]); o.w = pk2(w[6], w[7]);
                        *(u32x4*)(dst + (j8 + 8 * c) * 8) = o; }
                }
            }
        }
    }
    for (int i = bid * 512 + tid; i < 16 * (6144 + 4096) / 8; i += nb * 512) {
        const int per = (6144 + 4096) / 8, bg = i / per, c = i % per;
        const u32x4 z = {0u, 0u, 0u, 0u};
        if (c < 6144 / 8) *(u32x4*)(ACK + ((size_t)(bg * 256 + 255)) * 6144 + c * 8) = z;
        else *(u32x4*)(ACV + ((size_t)(bg * 256 + 255)) * 4096 + (c - 6144 / 8) * 8) = z;
    }
}

DI int swap23(int p) { return (p & ~0xC) | ((p & 4) << 1) | ((p & 8) >> 1); }
DI void phase_vt(LAS unsigned char* lds, const bf16_t* __restrict__ src, size_t src_stride, int col0, int col_step, int nhv, bf16_t* __restrict__ dst, int bid, int nb) {
    LAS bf16_t* tile = (LAS bf16_t*)lds;
    const int tid = tid_opaque();
    const int ntile = SEQ / 64, total = BATCH * nhv * ntile;
    for (int it = bid; it < total; it += nb) {
        const int mat = it / ntile, tt = it % ntile, b = mat / nhv, hv = mat % nhv;
        __syncthreads();
#pragma unroll
        for (int i = 0; i < 2; ++i) {
            const int q = tid + 512 * i, tok = q >> 4, ch = q & 15;
            const u32x4 w = *(const u32x4*)(src + (size_t)(b * SEQ + tt * 64 + tok) * src_stride + col0 + hv * col_step + ch * 8);
            *(LAS u32x4*)(tile + tok * 136 + ch * 8) = w;
        }
        __syncthreads();
        {
            const int dv = tid >> 2, kq = tid & 3;
            unsigned w[8];
#pragma unroll
            for (int e = 0; e < 8; ++e) {
                const int p0 = kq * 16 + 2 * e, p1 = p0 + 1;
                const int k0 = (p0 & ~15) | swap23(p0 & 15), k1 = (p1 & ~15) | swap23(p1 & 15);
                w[e] = (unsigned)tile[k0 * 136 + dv] | ((unsigned)tile[k1 * 136 + dv] << 16);
            }
            bf16_t* d = dst + ((size_t)mat * DV + dv) * SEQ + tt * 64 + kq * 16;
            u32x4 a = {w[0], w[1], w[2], w[3]}, c = {w[4], w[5], w[6], w[7]};
            *(u32x4*)d = a; *(u32x4*)(d + 8) = c;
        }
    }
}

DI void phase_cmp2(LAS unsigned char* lds, const Params& P, int bid, int nb) {
    LAS float* sk = (LAS float*)lds;
    LAS float* sv = sk + 192;
    LAS float* red = sv + 128;
    const float* HIDK = (const float*)(P.ws + OFF_HIDK); const float* HIDV = (const float*)(P.ws + OFF_HIDV);
    bf16_t* KC = (bf16_t*)(P.ws + OFF_KC); bf16_t* VTC = (bf16_t*)(P.ws + OFF_VTC);
    const int tid = tid_opaque(), lane = tid & 63, wid = tid >> 6;
    for (int m = bid; m < 4096; m += nb) {
        const int n = m & 255, bg = m >> 8;
        __syncthreads();
        if (tid < 192) { const float h = HIDK[(size_t)m * 256 + tid]; sk[tid] = h / (1.0f + __expf(-h)); }
        else if (tid < 320) { const float h = HIDV[(size_t)m * 256 + tid - 192]; sv[tid - 192] = h / (1.0f + __expf(-h)); }
        __syncthreads();
        float acc = 0.f;
        if (tid < 192) { for (int i = 0; i < 192; ++i) acc += sk[i] * P.w2_k[i * 192 + tid]; }
        else if (tid < 320) { const int j = tid - 192; for (int i = 0; i < 128; ++i) acc += sv[i] * P.w2_v[i * 128 + j]; }
        float ss = (tid < 192) ? acc * acc : 0.f;
#pragma unroll
        for (int o = 32; o >= 1; o >>= 1) ss += __shfl_xor(ss, o);
        if (lane == 0) red[wid] = ss;
        __syncthreads();
        const float tot = red[0] + red[1] + red[2];
        const float rstd = rsqrtf(tot * (1.0f / DK) + EPSN);
        if (tid < 192) { const float o = (n == 255) ? 0.f : acc * rstd * P.nsa_k_norm[tid];
            KC[(size_t)m * DK + tid] = (bf16_t)(pk2(o, 0.f) & 0xffffu); }
        else if (tid < 320) { const int j = tid - 192; const float o = (n == 255) ? 0.f : acc;
            const int pn = (n & ~15) | swap23(n & 15);
            VTC[((size_t)bg * DV + j) * 256 + pn] = (bf16_t)(pk2(o, 0.f) & 0xffffu); }
    }
}

DI void phase_mla_prep1(const Params& P, int bid, int nb) {
    const bf16_t* Y1 = (const bf16_t*)(P.ws + OFF_Y1);
    bf16_t* CQN = (bf16_t*)(P.ws + OFF_CQN); bf16_t* CKVN = (bf16_t*)(P.ws + OFF_CKVN); float* ROPE = (float*)(P.ws + OFF_ROPE);
    const int tid = tid_opaque(); const int lane = tid & 63, wid = tid >> 6;
    for (int tok = bid * 8 + wid; tok < MTOK; tok += nb * 8) {
        const bf16_t* yr = Y1 + (size_t)tok * N3P;
        {
            float v[24]; float ss = 0.f;
#pragma unroll
            for (int c = 0; c < 3; ++c) { const u32x4 w = *(const u32x4*)(yr + C3_CQ + (c * 64 + lane) * 8);
                v[c * 8 + 0] = bflo(w.x); v[c * 8 + 1] = bfhi(w.x); v[c * 8 + 2] = bflo(w.y); v[c * 8 + 3] = bfhi(w.y);
                v[c * 8 + 4] = bflo(w.z); v[c * 8 + 5] = bfhi(w.z); v[c * 8 + 6] = bflo(w.w); v[c * 8 + 7] = bfhi(w.w); }
#pragma unroll
            for (int i = 0; i < 24; ++i) ss += v[i] * v[i];
#pragma unroll
            for (int o = 32; o >= 1; o >>= 1) ss += __shfl_xor(ss, o);
            const float rstd = rsqrtf(ss * (1.0f / QLORA) + EPSN);
#pragma unroll
            for (int c = 0; c < 3; ++c) { const float* g = P.mla_q_a_norm + (c * 64 + lane) * 8; u32x4 w;
                w.x = pk2(v[c * 8 + 0] * rstd * g[0], v[c * 8 + 1] * rstd * g[1]); w.y = pk2(v[c * 8 + 2] * rstd * g[2], v[c * 8 + 3] * rstd * g[3]);
                w.z = pk2(v[c * 8 + 4] * rstd * g[4], v[c * 8 + 5] * rstd * g[5]); w.w = pk2(v[c * 8 + 6] * rstd * g[6], v[c * 8 + 7] * rstd * g[7]);
                *(u32x4*)(CQN + (size_t)tok * QLORA + (c * 64 + lane) * 8) = w; }
        }
        {
            float v[8]; float ss = 0.f;
            const u32x4 w0 = *(const u32x4*)(yr + C3_CKV + lane * 8);
            v[0] = bflo(w0.x); v[1] = bfhi(w0.x); v[2] = bflo(w0.y); v[3] = bfhi(w0.y); v[4] = bflo(w0.z); v[5] = bfhi(w0.z); v[6] = bflo(w0.w); v[7] = bfhi(w0.w);
#pragma unroll
            for (int i = 0; i < 8; ++i) ss += v[i] * v[i];
#pragma unroll
            for (int o = 32; o >= 1; o >>= 1) ss += __shfl_xor(ss, o);
            const float rstd = rsqrtf(ss * (1.0f / KVLORA) + EPSN);
            const float* g = P.mla_kv_a_norm + lane * 8; u32x4 w;
            w.x = pk2(v[0] * rstd * g[0], v[1] * rstd * g[1]); w.y = pk2(v[2] * rstd * g[2], v[3] * rstd * g[3]);
            w.z = pk2(v[4] * rstd * g[4], v[5] * rstd * g[5]); w.w = pk2(v[6] * rstd * g[6], v[7] * rstd * g[7]);
            *(u32x4*)(CKVN + (size_t)tok * KVLORA + lane * 8) = w;
        }
        if (lane < 32) {
            const float invf = exp2f(-(float)lane * (13.287712379549449f / 32.0f));
            const float ang = (float)P.pos[tok] * invf;
            float sn, cs; sincosf(ang, &sn, &cs);
            ROPE[(size_t)tok * 64 + lane] = cs; ROPE[(size_t)tok * 64 + 32 + lane] = sn;
        }
    }
}

DI void phase_mla_prep2(const Params& P, int bid, int nb) {
    bf16_t* QM = (bf16_t*)(P.ws + OFF_QM); const bf16_t* KVM = (const bf16_t*)(P.ws + OFF_KVM); const bf16_t* Y1 = (const bf16_t*)(P.ws + OFF_Y1);
    bf16_t* KM = (bf16_t*)(P.ws + OFF_KM); const float* ROPE = (const float*)(P.ws + OFF_ROPE);
    const int tid = tid_opaque(), grp = tid >> 3, j8 = tid & 7;
    for (int tok = bid; tok < MTOK; tok += nb) {
        const int b = tok / SEQ, s = tok % SEQ;
        float cs[8], sn[8];
#pragma unroll
        for (int e = 0; e < 8; ++e) { const int i = (8 * j8 + e) & 31; cs[e] = ROPE[(size_t)tok * 64 + i]; sn[e] = ROPE[(size_t)tok * 64 + 32 + i]; }
        {
            const bf16_t* kn = KVM + (size_t)tok * NKVB + grp * 256;
            const bf16_t* kp = Y1 + (size_t)tok * N3P + C3_KPE;
            float v[24];
#pragma unroll
            for (int c = 0; c < 2; ++c) { const u32x4 w = *(const u32x4*)(kn + (j8 + 8 * c) * 8);
                v[c * 8 + 0] = bflo(w.x); v[c * 8 + 1] = bfhi(w.x); v[c * 8 + 2] = bflo(w.y); v[c * 8 + 3] = bfhi(w.y);
                v[c * 8 + 4] = bflo(w.z); v[c * 8 + 5] = bfhi(w.z); v[c * 8 + 6] = bflo(w.w); v[c * 8 + 7] = bfhi(w.w); }
            { const u32x4 w = *(const u32x4*)(kp + j8 * 8);
                v[16] = bflo(w.x); v[17] = bfhi(w.x); v[18] = bflo(w.y); v[19] = bfhi(w.y); v[20] = bflo(w.z); v[21] = bfhi(w.z); v[22] = bflo(w.w); v[23] = bfhi(w.w); }
            float ss = 0.f;
#pragma unroll
            for (int i = 0; i < 24; ++i) ss += v[i] * v[i];
            ss = sum8(ss);
            const float rstd = rsqrtf(ss * (1.0f / DK) + EPSN);
#pragma unroll
            for (int c = 0; c < 3; ++c)
#pragma unroll
                for (int e = 0; e < 8; ++e) v[c * 8 + e] *= rstd * P.mla_k_norm[(j8 + 8 * c) * 8 + e];
#pragma unroll
            for (int e = 0; e < 8; ++e) { const float mine = v[16 + e], other = __shfl_xor(mine, 4);
                v[16 + e] = (j8 < 4) ? (mine * cs[e] - other * sn[e]) : (mine * cs[e] + other * sn[e]); }
            st192(KM + ((size_t)(b * NH + grp) * SEQ + s) * DK, j8, v);
        }
    }
}
#ifndef PROBE_SEL2
#define PROBE_SEL2 0
#endif
#ifndef PROBE_WIN2
#define PROBE_WIN2 0
#endif
#ifndef SCHED_QK
#define SCHED_QK 1
#endif
#ifndef SCHED_PV
#define SCHED_PV 1
#endif
#ifndef NO_CMP1
#define NO_CMP1 0
#endif
#ifndef NO_CMP2
#define NO_CMP2 0
#endif
#ifndef NO_SEL
#define NO_SEL 0
#endif
#ifndef NO_WIN
#define NO_WIN 0
#endif
constexpr int KT_BYTES = 64 * 384, VT_BYTES = 128 * 128;
constexpr int L_K = 0, L_V = 2 * KT_BYTES, L_LUT = L_V + 2 * VT_BYTES, LUT_PITCH = 129, L_QS = L_LUT + 16 * LUT_PITCH * 4 + 16  , L_P3 = L_QS + 16 * 64 * 4, L_Q = L_P3 + 16 * 64 * 4, L_END = L_Q + 8 * 4096;
static_assert(L_END <= 135168, "attention LDS");
enum { MODE_MLA = 0, MODE_CMP1 = 1, MODE_CMP2 = 2, MODE_SEL = 3, MODE_WIN = 4 };

#define MFMA32(a, b, c) __builtin_amdgcn_mfma_f32_32x32x16_bf16((a), (b), (c), 0, 0, 0)

struct AttnLane {
    int tq;
    int tw0, tw1;
    int hi, r32;
    const LAS float* lutrow;
    float lut_far;
    unsigned long long mk0, mk1;
    int tk;
    int curblk;
    float inv_l;
    int tokidx;
    const LAS unsigned char* qlds;
};

template <int MODE> DI bool tile_act(int j, const AttnLane& A) {
    if (MODE == MODE_MLA) return 64 * j <= A.tw1;
    else if (MODE == MODE_CMP1 || MODE == MODE_CMP2) return 1024 * j + 31 <= A.tw1;
    else if (MODE == MODE_SEL) return (((A.mk0 | A.mk1) >> j) & 1ull) != 0ull;
    else return (64 * j <= A.tw1) && (64 * j + 63 >= A.tw0 - 511);
}

template <int MODE>
DI void attn_stage_a(const LAS unsigned char* kb, const LAS unsigned char* lds, int j, int lane, const bf16x8 (&q)[(MODE == MODE_MLA) ? 12 : 8], f32x16& p0, f32x16& p1, const AttnLane& A) {
    constexpr int NQR = (MODE == MODE_MLA) ? 12 : 8;
    const int hi = lane >> 5, r32 = lane & 31;
    int kbase[4];
#pragma unroll
    for (int dd = 0; dd < 4; ++dd) kbase[dd] = r32 * 384 + (((2 * dd + hi) ^ ((r32 >> 1) & 7)) << 4);
    if (MODE == MODE_MLA) {
#pragma unroll
        for (int r = 0; r < 16; ++r) { p0[r] = 0.f; p1[r] = 0.f; }
    } else if (MODE == MODE_WIN || MODE == MODE_SEL) {
        const int dq = A.tq - 64 * j - 4 * hi;
        const bool far = (A.tw0 - (64 * j + 63) >= 113);
        if (far) {
#pragma unroll
            for (int r = 0; r < 16; ++r) { p0[r] = A.lut_far; p1[r] = A.lut_far; }
        } else {
#pragma unroll
            for (int r = 0; r < 16; ++r) { const int c = (r & 3) + 8 * (r >> 2);
                int d0_ = dq - c, d1_ = dq - c - 32;
                d0_ = d0_ < 0 ? 0 : (d0_ > 127 ? 127 : d0_); d1_ = d1_ < 0 ? 0 : (d1_ > 127 ? 127 : d1_);
                p0[r] = A.lutrow[d0_]; p1[r] = A.lutrow[d1_]; }
        }
    } else {
        const int dq = A.tq - 31 - 1024 * j - 64 * hi;
        const bool far = (A.tw0 - 31 - 16 * (64 * j + 63) >= 113);
        if (far) {
#pragma unroll
            for (int r = 0; r < 16; ++r) { p0[r] = A.lut_far; p1[r] = A.lut_far; }
        } else {
#pragma unroll
            for (int r = 0; r < 16; ++r) { const int c = 16 * ((r & 3) + 8 * (r >> 2));
                int d0_ = dq - c, d1_ = dq - c - 512;
                d0_ = d0_ < 0 ? 0 : (d0_ > 127 ? 127 : d0_); d1_ = d1_ < 0 ? 0 : (d1_ > 127 ? 127 : d1_);
                p0[r] = A.lutrow[d0_]; p1[r] = A.lutrow[d1_]; }
        }
    }
    {
        constexpr int KA = (MODE == MODE_MLA) ? 3 : 1;
        bf16x8 fa[KA + 1], fb[KA + 1];
#pragma unroll
        for (int d0 = 0; d0 < KA; ++d0) { const LAS unsigned char* a = kb + kbase[d0 & 3] + (d0 >> 2) * 128; fa[d0] = *(const LAS bf16x8*)a; fb[d0] = *(const LAS bf16x8*)(a + 32 * 384); }
        __builtin_amdgcn_sched_barrier(0);
#pragma unroll
        for (int d0 = 0; d0 < 12; ++d0) {
            if (d0 + KA < 12) { const int dn = d0 + KA; const LAS unsigned char* a = kb + kbase[dn & 3] + (dn >> 2) * 128;
                fa[dn % (KA + 1)] = *(const LAS bf16x8*)a; fb[dn % (KA + 1)] = *(const LAS bf16x8*)(a + 32 * 384); }
            bf16x8 qf;
            if (d0 < NQR) qf = q[d0 < NQR ? d0 : 0]; else qf = *(const LAS bf16x8*)(A.qlds + (d0 - NQR) * 1024);
            __builtin_amdgcn_sched_barrier(0);
            p0 = MFMA32(fa[d0 % (KA + 1)], qf, p0);
            p1 = MFMA32(fb[d0 % (KA + 1)], qf, p1);
            __builtin_amdgcn_sched_barrier(0);
        }
    }
    const float NEG = -__builtin_inff();
    if (MODE == MODE_MLA) {
        if (64 * j + 63 > A.tw0) {
            const int dq = A.tq - 64 * j - 4 * hi;
#pragma unroll
            for (int r = 0; r < 16; ++r) { const int c = (r & 3) + 8 * (r >> 2);
                if (dq - c < 0) p0[r] = NEG;
                if (dq - c - 32 < 0) p1[r] = NEG; }
        }
    } else if (MODE == MODE_WIN) {
        const int dq = A.tq - 64 * j - 4 * hi;
#pragma unroll
        for (int r = 0; r < 16; ++r) { const int c = (r & 3) + 8 * (r >> 2);
            if ((unsigned)(dq - c) >= 512u) p0[r] = NEG;
            if ((unsigned)(dq - c - 32) >= 512u) p1[r] = NEG; }
    } else if (MODE == MODE_SEL) {
        const int dq = A.tq - 64 * j - 4 * hi;
        const bool s0_ = ((A.mk0 >> j) & 1ull) != 0ull, s1_ = ((A.mk1 >> j) & 1ull) != 0ull; const bool sel = A.tk ? s1_ : s0_;
        const bool diag = (j == A.curblk);
#pragma unroll
        for (int r = 0; r < 16; ++r) { const int c = (r & 3) + 8 * (r >> 2);
            if (!sel || (diag && dq - c < 0)) p0[r] = NEG;
            if (!sel || (diag && dq - c - 32 < 0)) p1[r] = NEG; }
    } else {
        const int dq = A.tq - 31 - 1024 * j - 64 * hi;
#pragma unroll
        for (int r = 0; r < 16; ++r) { const int c = 16 * ((r & 3) + 8 * (r >> 2));
            if (dq - c < 0) p0[r] = NEG;
            if (dq - c - 512 < 0) p1[r] = NEG; }
    }
}

template <int MODE>
DI void attn_stage_b(const LAS unsigned char* vb, LAS unsigned char* lds, int j, int lane, f32x16& p0, f32x16& p1, f32x16 (&o)[4], float& m_run, float& l_run, const AttnLane& A) {
    constexpr bool HASV = (MODE != MODE_CMP1);
    const int hi = lane >> 5, r32 = lane & 31;
    if (MODE == MODE_CMP2) {
        const float mm = m_run, il = A.inv_l;
#pragma unroll
        for (int r = 0; r < 16; ++r) { p0[r] = __builtin_amdgcn_exp2f(p0[r] - mm) * il; p1[r] = __builtin_amdgcn_exp2f(p1[r] - mm) * il; }
        float v[16];
#pragma unroll
        for (int k = 0; k < 4; ++k) { v[k] = (p0[4 * k] + p0[4 * k + 1]) + (p0[4 * k + 2] + p0[4 * k + 3]); v[4 + k] = (p1[4 * k] + p1[4 * k + 1]) + (p1[4 * k + 2] + p1[4 * k + 3]);
            v[8 + k] = p0[4 * k + 3]; v[12 + k] = p1[4 * k + 3]; }
        { const bool up = (lane & 8) != 0;
#pragma unroll
          for (int i = 0; i < 8; ++i) { const float send = up ? v[i] : v[i + 8]; const float recv = __shfl_xor(send, 8); const float keep = up ? v[i + 8] : v[i]; v[i] = keep + recv; } }
        { const bool up = (lane & 4) != 0;
#pragma unroll
          for (int i = 0; i < 4; ++i) { const float send = up ? v[i] : v[i + 4]; const float recv = __shfl_xor(send, 4); const float keep = up ? v[i + 4] : v[i]; v[i] = keep + recv; } }
        { const bool up = (lane & 2) != 0;
#pragma unroll
          for (int i = 0; i < 2; ++i) { const float send = up ? v[i] : v[i + 2]; const float recv = __shfl_xor(send, 2); const float keep = up ? v[i + 2] : v[i]; v[i] = keep + recv; } }
        { const bool up = (lane & 1) != 0;
          const float send = up ? v[0] : v[1]; const float recv = __shfl_xor(send, 1); const float keep = up ? v[1] : v[0]; v[0] = keep + recv; }
        { const int idx = lane & 15, half = (idx >> 2) & 1, k = idx & 3, isp3 = idx >> 3;
          const int quad = 16 * j + 8 * half + 2 * k + hi;
          LAS float* dst = (LAS float*)(lds + (isp3 ? L_P3 : L_QS)) + A.tokidx * 64 + quad;
          *dst = v[0]; }
    } else {
        float mx = p0[0];
#pragma unroll
        for (int r = 1; r < 16; ++r) mx = fmaxf(mx, p0[r]);
#pragma unroll
        for (int r = 0; r < 16; ++r) mx = fmaxf(mx, p1[r]);
        mx = fmaxf(mx, __shfl_xor(mx, 32));
        const float mnew = fmaxf(m_run, mx);
        const float alpha = __builtin_amdgcn_exp2f(m_run - mnew);
        m_run = mnew;
        float ps = 0.f;
#pragma unroll
        for (int r = 0; r < 16; ++r) { p0[r] = __builtin_amdgcn_exp2f(p0[r] - mnew); p1[r] = __builtin_amdgcn_exp2f(p1[r] - mnew); ps += p0[r] + p1[r]; }
        l_run = l_run * alpha + ps;
        if (HASV) {
            if (__any(alpha != 1.0f)) {
#pragma unroll
                for (int d = 0; d < 4; ++d)
#pragma unroll
                    for (int r = 0; r < 16; ++r) o[d][r] *= alpha;
            }
        }
    }
    if (HASV) {
        int vbase[4];
#pragma unroll
        for (int dd = 0; dd < 4; ++dd) vbase[dd] = r32 * 128 + (((2 * dd + hi) ^ ((r32 >> 1) & 7)) << 4);
        constexpr int VA = (MODE == MODE_MLA) ? 6 : 2;
        bf16x8 fv[VA + 1]; bf16x8 pbc;
#pragma unroll
        for (int i = 0; i < VA; ++i) fv[i] = *(const LAS bf16x8*)(vb + vbase[i >> 2] + (i & 3) * (32 * 128));
        __builtin_amdgcn_sched_barrier(0);
#pragma unroll
        for (int i = 0; i < 16; ++i) {
            if (i + VA < 16) { const int in_ = i + VA; fv[in_ % (VA + 1)] = *(const LAS bf16x8*)(vb + vbase[in_ >> 2] + (in_ & 3) * (32 * 128)); }
            if ((i & 3) == 0) { u32x4 w;
                if (i == 0) { w.x = pk2(p0[0], p0[1]); w.y = pk2(p0[2], p0[3]); w.z = pk2(p0[4], p0[5]); w.w = pk2(p0[6], p0[7]); }
                else if (i == 4) { w.x = pk2(p0[8], p0[9]); w.y = pk2(p0[10], p0[11]); w.z = pk2(p0[12], p0[13]); w.w = pk2(p0[14], p0[15]); }
                else if (i == 8) { w.x = pk2(p1[0], p1[1]); w.y = pk2(p1[2], p1[3]); w.z = pk2(p1[4], p1[5]); w.w = pk2(p1[6], p1[7]); }
                else { w.x = pk2(p1[8], p1[9]); w.y = pk2(p1[10], p1[11]); w.z = pk2(p1[12], p1[13]); w.w = pk2(p1[14], p1[15]); }
                pbc = __builtin_bit_cast(bf16x8, w); }
            __builtin_amdgcn_sched_barrier(0);
            o[i & 3] = MFMA32(fv[i % (VA + 1)], pbc, o[i & 3]);
            __builtin_amdgcn_sched_barrier(0);
        }
    }
}

template <int MODE>
DI void attn_pass(LAS unsigned char* lds, const char* __restrict__ Kc, const char* __restrict__ Vc, int vt_stride, int j_lo, int j_hi,
                  const bf16x8 (&q)[(MODE == MODE_MLA) ? 12 : 8], f32x16 (&o)[4], float& m_run, float& l_run, const AttnLane& A) {
    if (j_lo >= j_hi) return;
    constexpr bool HASV = (MODE != MODE_CMP1);
    int tid = threadIdx.x; asm volatile("" : "+v"(tid));
    const int lane = tid & 63;
    const int wid_ = __builtin_amdgcn_readfirstlane(tid >> 6);
    const bool lead = wid_ < 4;
    const int T = j_hi - j_lo;
#define ST_ISSUE_K(j, buf) do { int ln_ = lane; asm volatile("" : "+v"(ln_)); \
        const char* kp_ = Kc + (size_t)(j) * KT_BYTES; LAS unsigned char* kb_ = lds + L_K + (buf) * KT_BYTES + wid_ * 3072; \
        _Pragma("unroll") for (int i_ = 0; i_ < 3; ++i_) { const int pidx_ = (wid_ * 3 + i_) * 64 + ln_, row_ = pidx_ / 24, cp_ = pidx_ % 24; \
            __builtin_amdgcn_global_load_lds((const unsigned*)(kp_ + (unsigned)(row_ * 384 + ((cp_ ^ ((row_ >> 1) & 7)) << 4))), (LAS unsigned*)(kb_ + i_ * 1024), 16, 0, 0); } } while (0)
#define ST_ISSUE_V(j, buf) do { if (HASV) { int ln_ = lane; asm volatile("" : "+v"(ln_)); \
        const char* vp_ = Vc + (size_t)(j) * 128; LAS unsigned char* vb_ = lds + L_V + (buf) * VT_BYTES + wid_ * 2048; \
        _Pragma("unroll") for (int i_ = 0; i_ < 2; ++i_) { const int pidx_ = (wid_ * 2 + i_) * 64 + ln_, row_ = pidx_ >> 3, cp_ = pidx_ & 7; \
            __builtin_amdgcn_global_load_lds((const unsigned*)(vp_ + (unsigned)(row_ * vt_stride * 2 + ((cp_ ^ ((row_ >> 1) & 7)) << 4))), (LAS unsigned*)(vb_ + i_ * 1024), 16, 0, 0); } } } while (0)
#define WAIT_VM(n) asm volatile("s_waitcnt vmcnt(" #n ")" ::: "memory")
#define WG_BAR() do { asm volatile("" ::: "memory"); __builtin_amdgcn_s_barrier(); asm volatile("" ::: "memory"); } while (0)
    ST_ISSUE_K(j_lo, 0); ST_ISSUE_V(j_lo, 0);
    WAIT_VM(0); WG_BAR();
    if (!lead) { if (T > 1) ST_ISSUE_K(j_lo + 1, 1); WG_BAR(); }
    f32x16 p0, p1;
    for (int t = 0; t < T; ++t) {
        const int j = j_lo + t, cur = t & 1;
        const bool act = tile_act<MODE>(j, A);
        const bool more1 = (t + 1 < T);
        if (lead) { if (more1) ST_ISSUE_K(j + 1, cur ^ 1); } else { if (more1) ST_ISSUE_V(j + 1, cur ^ 1); }
        if (act) attn_stage_a<MODE>(lds + L_K + cur * KT_BYTES, lds, j, lane, q, p0, p1, A);
        if (lead) { if (more1) WAIT_VM(3); else WAIT_VM(0); }
        else      { if (more1 && HASV) WAIT_VM(2); else WAIT_VM(0); }
        WG_BAR();
        const bool more2 = (t + 2 < T);
        if (lead) { if (more1) ST_ISSUE_V(j + 1, cur ^ 1); } else { if (more2) ST_ISSUE_K(j + 2, cur); }
        if (act) attn_stage_b<MODE>(lds + L_V + cur * VT_BYTES, lds, j, lane, p0, p1, o, m_run, l_run, A);
        if (lead) { if (more1 && HASV) WAIT_VM(2); else WAIT_VM(0); }
        else      { if (more2) WAIT_VM(3); else WAIT_VM(0); }
        WG_BAR();
    }
    if (lead) WG_BAR();
#undef ST_ISSUE_K
#undef ST_ISSUE_V
#undef WAIT_VM
#undef WG_BAR
}

template <int MODE>
DI void attn_pass_simple(LAS unsigned char* lds, const char* __restrict__ Kc, const char* __restrict__ Vc, int vt_stride, int j_lo, int j_hi,
                  const bf16x8 (&q)[12], f32x16 (&o)[4], float& m_run, float& l_run, const AttnLane& A) {
    if (j_lo >= j_hi) return;
    constexpr bool HASV = (MODE != MODE_CMP1);
    int tid = threadIdx.x; asm volatile("" : "+v"(tid));
    const int lane = tid & 63;
    const int hi = lane >> 5, r32 = lane & 31;
    const int wid_ = __builtin_amdgcn_readfirstlane(tid >> 6);
    int kbase[4], vbase[4];
#pragma unroll
    for (int dd = 0; dd < 4; ++dd) { kbase[dd] = r32 * 384 + (((2 * dd + hi) ^ ((r32 >> 1) & 7)) << 4); vbase[dd] = r32 * 128 + (((2 * dd + hi) ^ ((r32 >> 1) & 7)) << 4); }
#define ST_ISSUE(j, buf) do { int ln_ = lane; asm volatile("" : "+v"(ln_)); \
        const char* kp_ = Kc + (size_t)(j) * KT_BYTES; LAS unsigned char* kb_ = lds + L_K + (buf) * KT_BYTES + wid_ * 3072; \
        _Pragma("unroll") for (int i_ = 0; i_ < 3; ++i_) { const int pidx_ = (wid_ * 3 + i_) * 64 + ln_, row_ = pidx_ / 24, cp_ = pidx_ % 24; \
            __builtin_amdgcn_global_load_lds((const unsigned*)(kp_ + (unsigned)(row_ * 384 + ((cp_ ^ ((row_ >> 1) & 7)) << 4))), (LAS unsigned*)(kb_ + i_ * 1024), 16, 0, 0); } \
        if (HASV) { const char* vp_ = Vc + (size_t)(j) * 128; LAS unsigned char* vb_ = lds + L_V + (buf) * VT_BYTES + wid_ * 2048; \
            _Pragma("unroll") for (int i_ = 0; i_ < 2; ++i_) { const int pidx_ = (wid_ * 2 + i_) * 64 + ln_, row_ = pidx_ >> 3, cp_ = pidx_ & 7; \
                __builtin_amdgcn_global_load_lds((const unsigned*)(vp_ + (unsigned)(row_ * vt_stride * 2 + ((cp_ ^ ((row_ >> 1) & 7)) << 4))), (LAS unsigned*)(vb_ + i_ * 1024), 16, 0, 0); } } } while (0)
    ST_ISSUE(j_lo, 0);
    asm volatile("s_waitcnt vmcnt(0)" ::: "memory");
    __syncthreads();
    for (int j = j_lo; j < j_hi; ++j) {
        const int cur = (j - j_lo) & 1;
        const bool more = (j + 1 < j_hi);
        if (more) ST_ISSUE(j + 1, cur ^ 1);
        bool act;
        if (MODE == MODE_MLA) act = (64 * j <= A.tw1);
        else if (MODE == MODE_CMP1 || MODE == MODE_CMP2) act = (1024 * j + 31 <= A.tw1);
        else if (MODE == MODE_SEL) act = (((A.mk0 | A.mk1) >> j) & 1ull) != 0ull;
        else act = (64 * j <= A.tw1) && (64 * j + 63 >= A.tw0 - 511);
        if (act) {
            f32x16 p0, p1;
            if (MODE == MODE_MLA) {
#pragma unroll
                for (int r = 0; r < 16; ++r) { p0[r] = 0.f; p1[r] = 0.f; }
            } else if (MODE == MODE_WIN || MODE == MODE_SEL) {
                const int dq = A.tq - 64 * j - 4 * hi;
                const bool far = (A.tw0 - (64 * j + 63) >= 113);
                if (far) {
#pragma unroll
                    for (int r = 0; r < 16; ++r) { p0[r] = A.lut_far; p1[r] = A.lut_far; }
                } else {
#pragma unroll
                    for (int r = 0; r < 16; ++r) { const int c = (r & 3) + 8 * (r >> 2);
                        int d0_ = dq - c, d1_ = dq - c - 32;
                        d0_ = d0_ < 0 ? 0 : (d0_ > 127 ? 127 : d0_); d1_ = d1_ < 0 ? 0 : (d1_ > 127 ? 127 : d1_);
                        p0[r] = A.lutrow[d0_]; p1[r] = A.lutrow[d1_]; }
                }
            } else {
                const int dq = A.tq - 31 - 1024 * j - 64 * hi;
                const bool far = (A.tw0 - 31 - 16 * (64 * j + 63) >= 113);
                if (far) {
#pragma unroll
                    for (int r = 0; r < 16; ++r) { p0[r] = A.lut_far; p1[r] = A.lut_far; }
                } else {
#pragma unroll
                    for (int r = 0; r < 16; ++r) { const int c = 16 * ((r & 3) + 8 * (r >> 2));
                        int d0_ = dq - c, d1_ = dq - c - 512;
                        d0_ = d0_ < 0 ? 0 : (d0_ > 127 ? 127 : d0_); d1_ = d1_ < 0 ? 0 : (d1_ > 127 ? 127 : d1_);
                        p0[r] = A.lutrow[d0_]; p1[r] = A.lutrow[d1_]; }
                }
            }
            const LAS unsigned char* kb = lds + L_K + cur * KT_BYTES;
            {
                constexpr int KA = (MODE == MODE_MLA) ? 3 : 1;
                bf16x8 fa[KA + 1], fb[KA + 1];
#pragma unroll
                for (int d0 = 0; d0 < KA; ++d0) { const LAS unsigned char* a = kb + kbase[d0 & 3] + (d0 >> 2) * 128; fa[d0] = *(const LAS bf16x8*)a; fb[d0] = *(const LAS bf16x8*)(a + 32 * 384); }
                __builtin_amdgcn_sched_barrier(0);
#pragma unroll
                for (int d0 = 0; d0 < 12; ++d0) {
                    if (d0 + KA < 12) { const int dn = d0 + KA; const LAS unsigned char* a = kb + kbase[dn & 3] + (dn >> 2) * 128;
                        fa[dn % (KA + 1)] = *(const LAS bf16x8*)a; fb[dn % (KA + 1)] = *(const LAS bf16x8*)(a + 32 * 384); }
                    __builtin_amdgcn_sched_barrier(0);
                    p0 = MFMA32(fa[d0 % (KA + 1)], q[d0], p0);
                    p1 = MFMA32(fb[d0 % (KA + 1)], q[d0], p1);
                    __builtin_amdgcn_sched_barrier(0);
                }
            }
            const float NEG = -__builtin_inff();
            if (MODE == MODE_MLA) {
                if (64 * j + 63 > A.tw0) {
                    const int dq = A.tq - 64 * j - 4 * hi;
#pragma unroll
                    for (int r = 0; r < 16; ++r) { const int c = (r & 3) + 8 * (r >> 2);
                        if (dq - c < 0) p0[r] = NEG;
                        if (dq - c - 32 < 0) p1[r] = NEG; }
                }
            } else if (MODE == MODE_WIN) {
                const int dq = A.tq - 64 * j - 4 * hi;
#pragma unroll
                for (int r = 0; r < 16; ++r) { const int c = (r & 3) + 8 * (r >> 2);
                    if ((unsigned)(dq - c) >= 512u) p0[r] = NEG;
                    if ((unsigned)(dq - c - 32) >= 512u) p1[r] = NEG; }
            } else if (MODE == MODE_SEL) {
                const int dq = A.tq - 64 * j - 4 * hi;
                const bool s0_ = ((A.mk0 >> j) & 1ull) != 0ull, s1_ = ((A.mk1 >> j) & 1ull) != 0ull; const bool sel = A.tk ? s1_ : s0_;
                const bool diag = (j == A.curblk);
#pragma unroll
                for (int r = 0; r < 16; ++r) { const int c = (r & 3) + 8 * (r >> 2);
                    if (!sel || (diag && dq - c < 0)) p0[r] = NEG;
                    if (!sel || (diag && dq - c - 32 < 0)) p1[r] = NEG; }
            } else {
                const int dq = A.tq - 31 - 1024 * j - 64 * hi;
#pragma unroll
                for (int r = 0; r < 16; ++r) { const int c = 16 * ((r & 3) + 8 * (r >> 2));
                    if (dq - c < 0) p0[r] = NEG;
                    if (dq - c - 512 < 0) p1[r] = NEG; }
            }
            if (MODE == MODE_CMP2) {
                const float mm = m_run, il = A.inv_l;
#pragma unroll
                for (int r = 0; r < 16; ++r) { p0[r] = __builtin_amdgcn_exp2f(p0[r] - mm) * il; p1[r] = __builtin_amdgcn_exp2f(p1[r] - mm) * il; }
                float v[16];
#pragma unroll
                for (int k = 0; k < 4; ++k) { v[k] = (p0[4 * k] + p0[4 * k + 1]) + (p0[4 * k + 2] + p0[4 * k + 3]); v[4 + k] = (p1[4 * k] + p1[4 * k + 1]) + (p1[4 * k + 2] + p1[4 * k + 3]);
                    v[8 + k] = p0[4 * k + 3]; v[12 + k] = p1[4 * k + 3]; }
                { const bool up = (lane & 8) != 0;
#pragma unroll
                  for (int i = 0; i < 8; ++i) { const float send = up ? v[i] : v[i + 8]; const float recv = __shfl_xor(send, 8); const float keep = up ? v[i + 8] : v[i]; v[i] = keep + recv; } }
                { const bool up = (lane & 4) != 0;
#pragma unroll
                  for (int i = 0; i < 4; ++i) { const float send = up ? v[i] : v[i + 4]; const float recv = __shfl_xor(send, 4); const float keep = up ? v[i + 4] : v[i]; v[i] = keep + recv; } }
                { const bool up = (lane & 2) != 0;
#pragma unroll
                  for (int i = 0; i < 2; ++i) { const float send = up ? v[i] : v[i + 2]; const float recv = __shfl_xor(send, 2); const float keep = up ? v[i + 2] : v[i]; v[i] = keep + recv; } }
                { const bool up = (lane & 1) != 0;
                  const float send = up ? v[0] : v[1]; const float recv = __shfl_xor(send, 1); const float keep = up ? v[1] : v[0]; v[0] = keep + recv; }
                { const int idx = lane & 15, half = (idx >> 2) & 1, k = idx & 3, isp3 = idx >> 3;
                  const int quad = 16 * j + 8 * half + 2 * k + hi;
                  LAS float* dst = (LAS float*)(lds + (isp3 ? L_P3 : L_QS)) + A.tokidx * 64 + quad;
                  *dst = v[0]; }
            } else {
                float mx = p0[0];
#pragma unroll
                for (int r = 1; r < 16; ++r) mx = fmaxf(mx, p0[r]);
#pragma unroll
                for (int r = 0; r < 16; ++r) mx = fmaxf(mx, p1[r]);
                mx = fmaxf(mx, __shfl_xor(mx, 32));
                const float mnew = fmaxf(m_run, mx);
                const float alpha = __builtin_amdgcn_exp2f(m_run - mnew);
                m_run = mnew;
                float ps = 0.f;
#pragma unroll
                for (int r = 0; r < 16; ++r) { p0[r] = __builtin_amdgcn_exp2f(p0[r] - mnew); p1[r] = __builtin_amdgcn_exp2f(p1[r] - mnew); ps += p0[r] + p1[r]; }
                l_run = l_run * alpha + ps;
                if (HASV) {
                    if (__any(alpha != 1.0f)) {
#pragma unroll
                        for (int d = 0; d < 4; ++d)
#pragma unroll
                            for (int r = 0; r < 16; ++r) o[d][r] *= alpha;
                    }
                }
            }
            if (HASV) {
                const LAS unsigned char* vb = lds + L_V + cur * VT_BYTES;
                constexpr int VA = (MODE == MODE_MLA) ? 6 : 2;
                bf16x8 fv[VA + 1]; bf16x8 pbc;
#pragma unroll
                for (int i = 0; i < VA; ++i) fv[i] = *(const LAS bf16x8*)(vb + vbase[i >> 2] + (i & 3) * (32 * 128));
                __builtin_amdgcn_sched_barrier(0);
#pragma unroll
                for (int i = 0; i < 16; ++i) {
                    if (i + VA < 16) { const int in_ = i + VA; fv[in_ % (VA + 1)] = *(const LAS bf16x8*)(vb + vbase[in_ >> 2] + (in_ & 3) * (32 * 128)); }
                    if ((i & 3) == 0) { u32x4 w;
                        if (i == 0) { w.x = pk2(p0[0], p0[1]); w.y = pk2(p0[2], p0[3]); w.z = pk2(p0[4], p0[5]); w.w = pk2(p0[6], p0[7]); }
                        else if (i == 4) { w.x = pk2(p0[8], p0[9]); w.y = pk2(p0[10], p0[11]); w.z = pk2(p0[12], p0[13]); w.w = pk2(p0[14], p0[15]); }
                        else if (i == 8) { w.x = pk2(p1[0], p1[1]); w.y = pk2(p1[2], p1[3]); w.z = pk2(p1[4], p1[5]); w.w = pk2(p1[6], p1[7]); }
                        else { w.x = pk2(p1[8], p1[9]); w.y = pk2(p1[10], p1[11]); w.z = pk2(p1[12], p1[13]); w.w = pk2(p1[14], p1[15]); }
                        pbc = __builtin_bit_cast(bf16x8, w); }
                    __builtin_amdgcn_sched_barrier(0);
                    o[i & 3] = MFMA32(fv[i % (VA + 1)], pbc, o[i & 3]);
                    __builtin_amdgcn_sched_barrier(0);
                }
            }
        }
        asm volatile("s_waitcnt vmcnt(0)" ::: "memory");
        __syncthreads();
    }
#undef ST_ISSUE
}

constexpr int L3_K = 0, L3_V = 3 * KT_BYTES;
template <int MODE>
DI void attn_pass3(LAS unsigned char* lds, const char* __restrict__ Kc, const char* __restrict__ Vc, int vt_stride, int j_lo, int j_hi,
                   const bf16x8 (&q)[(MODE == MODE_MLA) ? 12 : 8], f32x16 (&o)[4], float& m_run, float& l_run, const AttnLane& A) {
    if (j_lo >= j_hi) return;
    constexpr bool HASV = (MODE != MODE_CMP1);
    int tid = threadIdx.x; asm volatile("" : "+v"(tid));
    const int lane = tid & 63;
    const int wid_ = __builtin_amdgcn_readfirstlane(tid >> 6);
    const int T = j_hi - j_lo;
#define ST3_ISSUE(j, slot) do { int ln_ = lane; asm volatile("" : "+v"(ln_)); \
        const char* kp_ = Kc + (size_t)(j) * KT_BYTES; LAS unsigned char* kb_ = lds + L3_K + (slot) * KT_BYTES + wid_ * 3072; \
        _Pragma("unroll") for (int i_ = 0; i_ < 3; ++i_) { const int pidx_ = (wid_ * 3 + i_) * 64 + ln_, row_ = pidx_ / 24, cp_ = pidx_ % 24; \
            __builtin_amdgcn_global_load_lds((const unsigned*)(kp_ + (unsigned)(row_ * 384 + ((cp_ ^ ((row_ >> 1) & 7)) << 4))), (LAS unsigned*)(kb_ + i_ * 1024), 16, 0, 0); } \
        if (HASV) { const char* vp_ = Vc + (size_t)(j) * 128; LAS unsigned char* vb_ = lds + L3_V + (slot) * VT_BYTES + wid_ * 2048; \
            _Pragma("unroll") for (int i_ = 0; i_ < 2; ++i_) { const int pidx_ = (wid_ * 2 + i_) * 64 + ln_, row_ = pidx_ >> 3, cp_ = pidx_ & 7; \
                __builtin_amdgcn_global_load_lds((const unsigned*)(vp_ + (unsigned)(row_ * vt_stride * 2 + ((cp_ ^ ((row_ >> 1) & 7)) << 4))), (LAS unsigned*)(vb_ + i_ * 1024), 16, 0, 0); } } } while (0)
    ST3_ISSUE(j_lo, 0);
    if (T > 1) ST3_ISSUE(j_lo + 1, 1);
    f32x16 p0, p1;
    int slot = 0;
    for (int t = 0; t < T; ++t) {
        const int j = j_lo + t;
        if (t + 1 < T) { if (HASV) asm volatile("s_waitcnt vmcnt(5)" ::: "memory"); else asm volatile("s_waitcnt vmcnt(3)" ::: "memory"); }
        else asm volatile("s_waitcnt vmcnt(0)" ::: "memory");
        asm volatile("" ::: "memory"); __builtin_amdgcn_s_barrier(); asm volatile("" ::: "memory");
        if (t + 2 < T) { const int s2 = (slot >= 1) ? slot - 1 : 2; ST3_ISSUE(j + 2, s2); }
        if (tile_act<MODE>(j, A)) {
            attn_stage_a<MODE>(lds + L3_K + slot * KT_BYTES, lds, j, lane, q, p0, p1, A);
            attn_stage_b<MODE>(lds + L3_V + slot * VT_BYTES, lds, j, lane, p0, p1, o, m_run, l_run, A);
        }
        slot = (slot == 2) ? 0 : slot + 1;
    }
    asm volatile("" ::: "memory"); __builtin_amdgcn_s_barrier(); asm volatile("" ::: "memory");
#undef ST3_ISSUE
}

DI int t5_bucket(int n) {
    if (n < 16) return n;
    return 16 + (n >= 19) + (n >= 21) + (n >= 24) + (n >= 27) + (n >= 31) + (n >= 35) + (n >= 40) + (n >= 46) + (n >= 52) + (n >= 59) + (n >= 67) + (n >= 77) + (n >= 87) + (n >= 99) + (n >= 113);
}
DI float silu_f(float z) { return z * __builtin_amdgcn_rcpf(1.0f + __builtin_amdgcn_exp2f(-1.4426950408889634f * z)); }

template <bool RMW, int Q8 = 0>
DI void attn_epilogue(const f32x16 (&o)[4], float scale, const char* __restrict__ zbase, unsigned zoff, char* __restrict__ obase, unsigned ooff, int hi) {
#pragma unroll
    for (int d = 0; d < 4; ++d)
#pragma unroll
        for (int kq = 0; kq < 4; ++kq) {
            const unsigned dvb = (unsigned)(32 * d + 8 * kq + 4 * hi) * 2u;
            const u32x2 zw = *(const u32x2*)(zbase + (zoff + dvb));
            float v0 = o[d][4 * kq + 0] * scale * silu_f(bflo(zw.x)), v1 = o[d][4 * kq + 1] * scale * silu_f(bfhi(zw.x));
            float v2 = o[d][4 * kq + 2] * scale * silu_f(bflo(zw.y)), v3 = o[d][4 * kq + 3] * scale * silu_f(bfhi(zw.y));
            if (RMW) { const u32x2 pw = *(const u32x2*)(obase + (ooff + dvb)); v0 += bflo(pw.x); v1 += bfhi(pw.x); v2 += bflo(pw.y); v3 += bfhi(pw.y); }
            if (Q8) { v0 = emu_q8(v0, 64.0f); v1 = emu_q8(v1, 64.0f); v2 = emu_q8(v2, 64.0f); v3 = emu_q8(v3, 64.0f); }
            u32x2 w; w.x = pk2(v0, v1); w.y = pk2(v2, v3);
            *(u32x2*)(obase + (ooff + dvb)) = w;
        }
}

constexpr int EPI_PITCH = 272, EPI_WAVE_BYTES = 32 * EPI_PITCH;
template <bool RMW, bool NSA, int Q8>
DI void attn_epilogue_t(LAS unsigned char* lds, int lane, int wid, const f32x16 (&o)[4], float scale,
                        const char* __restrict__ zbase, unsigned z0, char* __restrict__ obase, unsigned o0) {
    LAS unsigned char* sc = lds + wid * EPI_WAVE_BYTES;
    const int r32 = lane & 31, hi = lane >> 5;
#pragma unroll
    for (int h = 0; h < 2; ++h) {
#pragma unroll
        for (int dd = 0; dd < 2; ++dd)
#pragma unroll
            for (int kq = 0; kq < 4; ++kq) {
                f32x4 v; v[0] = o[2 * h + dd][4 * kq + 0] * scale; v[1] = o[2 * h + dd][4 * kq + 1] * scale; v[2] = o[2 * h + dd][4 * kq + 2] * scale; v[3] = o[2 * h + dd][4 * kq + 3] * scale;
                *(LAS f32x4*)(sc + r32 * EPI_PITCH + (32 * dd + 8 * kq + 4 * hi) * 4) = v;
            }
        asm volatile("" ::: "memory");
#pragma unroll
        for (int i = 0; i < 4; ++i) {
            const int rr = 8 * i + (lane >> 3), c8 = lane & 7;
            const f32x4 a = *(const LAS f32x4*)(sc + rr * EPI_PITCH + c8 * 32);
            const f32x4 b = *(const LAS f32x4*)(sc + rr * EPI_PITCH + c8 * 32 + 16);
            unsigned zoff, ooff;
            if (NSA) { zoff = z0 + (unsigned)((rr >> 4) * (N1P * 2) + (rr & 15) * 256); ooff = o0 + (unsigned)((rr >> 4) * (ZW8 * 2) + (rr & 15) * 256); }
            else     { zoff = z0 + (unsigned)(rr * (N3P * 2)); ooff = o0 + (unsigned)(rr * (ZW8 * 2)); }
            const unsigned cb = (unsigned)((64 * h + 8 * c8) * 2);
            const u32x4 zw = *(const u32x4*)(zbase + (zoff + cb));
            float v0 = a[0] * silu_f(bflo(zw.x)), v1 = a[1] * silu_f(bfhi(zw.x)), v2 = a[2] * silu_f(bflo(zw.y)), v3 = a[3] * silu_f(bfhi(zw.y));
            float v4 = b[0] * silu_f(bflo(zw.z)), v5 = b[1] * silu_f(bfhi(zw.z)), v6 = b[2] * silu_f(bflo(zw.w)), v7 = b[3] * silu_f(bfhi(zw.w));
            if (RMW) { const u32x4 pw = *(const u32x4*)(obase + (ooff + cb));
                v0 += bflo(pw.x); v1 += bfhi(pw.x); v2 += bflo(pw.y); v3 += bfhi(pw.y); v4 += bflo(pw.z); v5 += bfhi(pw.z); v6 += bflo(pw.w); v7 += bfhi(pw.w); }
            if (Q8) { v0 = emu_q8(v0, 64.0f); v1 = emu_q8(v1, 64.0f); v2 = emu_q8(v2, 64.0f); v3 = emu_q8(v3, 64.0f); v4 = emu_q8(v4, 64.0f); v5 = emu_q8(v5, 64.0f); v6 = emu_q8(v6, 64.0f); v7 = emu_q8(v7, 64.0f); }
            u32x4 w; w.x = pk2(v0, v1); w.y = pk2(v2, v3); w.z = pk2(v4, v5); w.w = pk2(v6, v7);
            *(u32x4*)(obase + (ooff + cb)) = w;
        }
        asm volatile("" ::: "memory");
    }
}

DI void phase_nsa_attn(LAS unsigned char* lds, const Params& P, int bid, int nb) {
    const char* Y0c = (const char*)(P.ws + OFF_Y0);
    const char* KSc = (const char*)(P.ws + OFF_KS); const char* KWc = (const char*)(P.ws + OFF_KW);
    const char* VTSc = (const char*)(P.ws + OFF_VTS); const char* VTWc = (const char*)(P.ws + OFF_VTW);
    const char* KCc = (const char*)(P.ws + OFF_KC); const char* VTCc = (const char*)(P.ws + OFF_VTC);
    char* ONc = (char*)(P.ws + OFF_O);
    LAS float* lut = (LAS float*)(lds + L_LUT);
    const int total = BATCH * NG * 256;
    for (int u = bid; u < total; u += nb) {
        int tid = threadIdx.x; asm volatile("" : "+v"(tid));
        const int lane = tid & 63, wid = __builtin_amdgcn_readfirstlane(tid >> 6);
        const int pair = u >> 8; int c = u & 255; if (pair & 1) c = 255 - c;
        const int b = pair >> 2, g = pair & 3, t0 = c * 16;
        __syncthreads();
        for (int i = tid; i < 16 * 128; i += 512) { const int r = i >> 7, d = i & 127; lut[r * LUT_PITCH + d] = P.rel_bias[t5_bucket(d) * NH + g * NR + r] * LOG2E; }
        __syncthreads();
        AttnLane A;
        A.hi = lane >> 5; A.r32 = lane & 31;
        const int r = lane & 15;
        A.tk = (lane >> 4) & 1;
        A.tw0 = t0 + 2 * wid; A.tw1 = A.tw0 + 1; A.tq = A.tw0 + A.tk;
        A.lutrow = lut + r * LUT_PITCH; A.lut_far = A.lutrow[127];
        A.curblk = t0 >> 6; A.tokidx = 2 * wid + A.tk; A.mk0 = 0ull; A.mk1 = 0ull; A.inv_l = 0.f;
        const int hh = g * NR + r;
        const unsigned yoff = (unsigned)(b * SEQ + A.tq) * (unsigned)(N1P * 2);
        const unsigned ytok0 = (unsigned)(b * SEQ + A.tw0) * (unsigned)(N1P * 2);
        const unsigned otok0 = ((unsigned)(b * SEQ + A.tw0) * (unsigned)ZW8 + (unsigned)(g * NR * DV)) * 2u;
        bf16x8 q[12];
        A.qlds = nullptr;
        {
            const unsigned qo = yoff + (unsigned)((C_Q + hh * DK + 8 * A.hi) * 2);
            float ss = 0.f;
#pragma unroll
            for (int d0 = 0; d0 < 12; ++d0) { q[d0] = *(const bf16x8*)(Y0c + (qo + 32u * d0));
                const u32x4 w = __builtin_bit_cast(u32x4, q[d0]);
                const float a0 = bflo(w.x), a1 = bfhi(w.x), a2 = bflo(w.y), a3 = bfhi(w.y), a4 = bflo(w.z), a5 = bfhi(w.z), a6 = bflo(w.w), a7 = bfhi(w.w);
                ss += (a0 * a0 + a1 * a1) + (a2 * a2 + a3 * a3) + (a4 * a4 + a5 * a5) + (a6 * a6 + a7 * a7); }
            ss += __shfl_xor(ss, 32);
            const float rstd = rsqrtf(ss * (1.0f / DK) + EPSN) * QSCALE;
#pragma unroll
            for (int d0 = 0; d0 < 12; ++d0) { const float* gn = P.nsa_q_norm + 16 * d0 + 8 * A.hi; const f32x4 g0 = *(const f32x4*)gn, g1 = *(const f32x4*)(gn + 4);
                u32x4 w = __builtin_bit_cast(u32x4, q[d0]);
                w.x = pk2(bflo(w.x) * rstd * g0[0], bfhi(w.x) * rstd * g0[1]); w.y = pk2(bflo(w.y) * rstd * g0[2], bfhi(w.y) * rstd * g0[3]);
                w.z = pk2(bflo(w.z) * rstd * g1[0], bfhi(w.z) * rstd * g1[1]); w.w = pk2(bflo(w.w) * rstd * g1[2], bfhi(w.w) * rstd * g1[3]);
                q[d0] = __builtin_bit_cast(bf16x8, w); }
        }
        const int bg = b * NG + g;
        f32x16 o[4]; float m_run, l_run;
#define RESET_STATE() do { _Pragma("unroll") for (int d_ = 0; d_ < 4; ++d_) _Pragma("unroll") for (int r_ = 0; r_ < 16; ++r_) o[d_][r_] = 0.f; m_run = -1e30f; l_run = 0.f; } while (0)
        const int nct = (t0 + 15 >= 31) ? (((t0 + 15 - 31) >> 4) / 64 + 1) : 0;
        RESET_STATE();
        if (!NO_CMP1) attn_pass_simple<MODE_CMP1>(lds, KCc + (size_t)bg * 256 * DK * 2, nullptr, 0, 0, nct, q, o, m_run, l_run, A);
        { const float lt = l_run + __shfl_xor(l_run, 32); A.inv_l = lt > 0.f ? 1.0f / lt : 0.f; }
        if (!NO_CMP2) attn_pass_simple<MODE_CMP2>(lds, KCc + (size_t)bg * 256 * DK * 2, VTCc + (size_t)bg * DV * 256 * 2, 256, 0, nct, q, o, m_run, l_run, A);
        { const float gv = bf1(*(const bf16_t*)(Y0c + (yoff + (unsigned)((C_G + 0 * NH + hh) * 2)))); const float sg = 1.0f / (1.0f + __expf(-gv));
          attn_epilogue_t<false, true, 0>(lds, lane, wid, o, sg, Y0c, ytok0 + (unsigned)((C_ZC + g * NR * DV) * 2), ONc, otok0); }
        __syncthreads();
        {
            const int cur = A.curblk;
            unsigned long long mk[2];
#pragma unroll
            for (int t = 0; t < 2; ++t) {
                const LAS float* QS = (const LAS float*)(lds + L_QS) + (2 * wid + t) * 64;
                const LAS float* P3 = (const LAS float*)(lds + L_P3) + (2 * wid + t) * 64;
                const bool forced = (lane == 0) || (lane == cur) || (lane == cur - 1);
                const bool future = lane > cur;
                float v = 0.f;
                if (!forced && !future) v = QS[lane] + P3[lane - 1];
                unsigned key = (__float_as_uint(v) & ~63u);
                if (forced) key = 0x7f800000u; else if (future) key = 0u;
                key |= (unsigned)(63 - lane);
                int rank = 0;
#pragma unroll
                for (int jp = 0; jp < 64; ++jp) { const unsigned kj = (unsigned)__builtin_amdgcn_readlane((int)key, jp); rank += (kj > key) ? 1 : 0; }
                mk[t] = __ballot(rank < 16 && !future);
            }
            A.mk0 = mk[0]; A.mk1 = mk[1];
        }
        RESET_STATE();
#if PROBE_SEL2
        attn_pass_simple<MODE_SEL>(lds, KSc + (size_t)bg * SEQ * DK * 2, VTSc + (size_t)bg * DV * SEQ * 2, SEQ, 0, A.curblk + 1, q, o, m_run, l_run, A);
#endif
        if (!NO_SEL) attn_pass_simple<MODE_SEL>(lds, KSc + (size_t)bg * SEQ * DK * 2, VTSc + (size_t)bg * DV * SEQ * 2, SEQ, 0, A.curblk + 1, q, o, m_run, l_run, A);
        { const float lt = l_run + __shfl_xor(l_run, 32); const float gv = bf1(*(const bf16_t*)(Y0c + (yoff + (unsigned)((C_G + 1 * NH + hh) * 2)))); const float sg = 1.0f / (1.0f + __expf(-gv));
          attn_epilogue_t<true, true, 0>(lds, lane, wid, o, sg / lt, Y0c, ytok0 + (unsigned)((C_ZS + g * NR * DV) * 2), ONc, otok0); }
        __syncthreads();
        RESET_STATE();
        { const int jl = (t0 - 511) > 0 ? (t0 - 511) >> 6 : 0, jh = ((t0 + 15) >> 6) + 1;
#if PROBE_WIN2
          attn_pass_simple<MODE_WIN>(lds, KWc + (size_t)bg * SEQ * DK * 2, VTWc + (size_t)bg * DV * SEQ * 2, SEQ, jl, jh, q, o, m_run, l_run, A);
#endif
          if (!NO_WIN) attn_pass_simple<MODE_WIN>(lds, KWc + (size_t)bg * SEQ * DK * 2, VTWc + (size_t)bg * DV * SEQ * 2, SEQ, jl, jh, q, o, m_run, l_run, A); }
        { const float lt = l_run + __shfl_xor(l_run, 32); const float gv = bf1(*(const bf16_t*)(Y0c + (yoff + (unsigned)((C_G + 2 * NH + hh) * 2)))); const float sg = 1.0f / (1.0f + __expf(-gv));
          attn_epilogue_t<true, true, (FP8EMU & 1)>(lds, lane, wid, o, sg / lt, Y0c, ytok0 + (unsigned)((C_ZW + g * NR * DV) * 2), ONc, otok0); }
#undef RESET_STATE
    }
}

DI void phase_mla_attn(LAS unsigned char* lds, const Params& P, int bid, int nb) {
    const char* QMc = (const char*)(P.ws + OFF_QM); const char* KMc = (const char*)(P.ws + OFF_KM); const char* VTMc = (const char*)(P.ws + OFF_VTM);
    const char* Y1c = (const char*)(P.ws + OFF_Y1); char* OMc = (char*)(P.ws + OFF_O);
    const int total = BATCH * NH * 16;
    for (int uu = 0; bid + (uu >> 1) * nb < total / 2; ++uu) {
        int tid = threadIdx.x; asm volatile("" : "+v"(tid));
        const int lane = tid & 63, wid = __builtin_amdgcn_readfirstlane(tid >> 6);
        const int item = bid + (uu >> 1) * nb, second = uu & 1;
        const int xcd = item & 7, tt = item >> 3, p = tt & 7, hl = (tt >> 3) & 3, rnd = tt >> 5;
        const int bh = rnd * 32 + xcd * 4 + hl, qb = second ? p : 15 - p, b = bh >> 6, h = bh & 63, t0 = qb * 256;
        AttnLane A;
        A.hi = lane >> 5; A.r32 = lane & 31; A.tk = 0;
        A.tw0 = t0 + 32 * wid; A.tw1 = A.tw0 + 31; A.tq = A.tw0 + A.r32;
        A.lutrow = nullptr; A.lut_far = 0.f; A.curblk = 0; A.tokidx = 0; A.mk0 = 0ull; A.mk1 = 0ull; A.inv_l = 0.f; A.qlds = nullptr;
        const unsigned trow = (unsigned)(b * SEQ + A.tq);
        bf16x8 q[12];
        {
            const unsigned qo = (trow * (unsigned)NQB + (unsigned)(h * DK + 8 * A.hi)) * 2u;
            float ss = 0.f;
#pragma unroll
            for (int d0 = 0; d0 < 12; ++d0) { q[d0] = *(const bf16x8*)(QMc + (qo + 32u * d0));
                const u32x4 w = __builtin_bit_cast(u32x4, q[d0]);
                const float a0 = bflo(w.x), a1 = bfhi(w.x), a2 = bflo(w.y), a3 = bfhi(w.y), a4 = bflo(w.z), a5 = bfhi(w.z), a6 = bflo(w.w), a7 = bfhi(w.w);
                ss += (a0 * a0 + a1 * a1) + (a2 * a2 + a3 * a3) + (a4 * a4 + a5 * a5) + (a6 * a6 + a7 * a7); }
            ss += __shfl_xor(ss, 32);
            const float rstd = rsqrtf(ss * (1.0f / DK) + EPSN);
            const float* ropep = (const float*)(P.ws + OFF_ROPE) + (size_t)trow * 64;
#pragma unroll
            for (int d0 = 0; d0 < 8; ++d0) { const float* gn = P.mla_q_norm + 16 * d0 + 8 * A.hi; const f32x4 g0 = *(const f32x4*)gn, g1 = *(const f32x4*)(gn + 4);
                const float sc = rstd * QSCALE;
                u32x4 w = __builtin_bit_cast(u32x4, q[d0]);
                w.x = pk2(bflo(w.x) * sc * g0[0], bfhi(w.x) * sc * g0[1]); w.y = pk2(bflo(w.y) * sc * g0[2], bfhi(w.y) * sc * g0[3]);
                w.z = pk2(bflo(w.z) * sc * g1[0], bfhi(w.z) * sc * g1[1]); w.w = pk2(bflo(w.w) * sc * g1[2], bfhi(w.w) * sc * g1[3]);
                q[d0] = __builtin_bit_cast(bf16x8, w); }
#pragma unroll
            for (int pr = 0; pr < 2; ++pr) {
                const int i0 = 16 * pr + 8 * A.hi;
                const float* g1p = P.mla_q_norm + 128 + i0; const float* g2p = P.mla_q_norm + 160 + i0;
                const u32x4 w1 = __builtin_bit_cast(u32x4, q[8 + pr]), w2 = __builtin_bit_cast(u32x4, q[10 + pr]);
                float x1[8] = {bflo(w1.x), bfhi(w1.x), bflo(w1.y), bfhi(w1.y), bflo(w1.z), bfhi(w1.z), bflo(w1.w), bfhi(w1.w)};
                float x2[8] = {bflo(w2.x), bfhi(w2.x), bflo(w2.y), bfhi(w2.y), bflo(w2.z), bfhi(w2.z), bflo(w2.w), bfhi(w2.w)};
                float y1[8], y2[8];
#pragma unroll
                for (int e = 0; e < 8; ++e) { const float cs = ropep[i0 + e], sn = ropep[32 + i0 + e];
                    const float a = x1[e] * rstd * g1p[e], c = x2[e] * rstd * g2p[e];
                    y1[e] = (a * cs - c * sn) * QSCALE; y2[e] = (c * cs + a * sn) * QSCALE; }
                u32x4 o1, o2;
                o1.x = pk2(y1[0], y1[1]); o1.y = pk2(y1[2], y1[3]); o1.z = pk2(y1[4], y1[5]); o1.w = pk2(y1[6], y1[7]);
                o2.x = pk2(y2[0], y2[1]); o2.y = pk2(y2[2], y2[3]); o2.z = pk2(y2[4], y2[5]); o2.w = pk2(y2[6], y2[7]);
                q[8 + pr] = __builtin_bit_cast(bf16x8, o1); q[10 + pr] = __builtin_bit_cast(bf16x8, o2);
            }
        }
        f32x16 o[4]; float m_run = -1e30f, l_run = 0.f;
#pragma unroll
        for (int d = 0; d < 4; ++d)
#pragma unroll
            for (int r = 0; r < 16; ++r) o[d][r] = 0.f;
        attn_pass3<MODE_MLA>(lds, KMc + (size_t)bh * SEQ * DK * 2, VTMc + (size_t)bh * DV * SEQ * 2, SEQ, 0, 4 * qb + 4, q, o, m_run, l_run, A);
        const float lt = l_run + __shfl_xor(l_run, 32);
        { const unsigned t0w = (unsigned)(b * SEQ + A.tw0);
          attn_epilogue_t<false, false, (FP8EMU & 2) ? 1 : 0>(lds, lane, wid, o, 1.0f / lt, Y1c, (t0w * (unsigned)N3P + (unsigned)(C3_Z + h * DV)) * 2u, OMc, (t0w * (unsigned)ZW8 + (unsigned)(h * DV)) * 2u); }
        __syncthreads();
    }
}
constexpr int LDS_ST_OFF = 135168, LDS_BYTES = LDS_ST_OFF + 16;
constexpr int NPHASE = 14;

template <int PH>
DI void run_phase(const Params& P, LAS unsigned char* lds, int bid, int nb) {
    unsigned char* ws = P.ws;
    if constexpr (PH == 0) {
        phase_wconv(lds, P.nsa_w_in, (bf16_t*)(ws + OFF_W1T), DM, N1, N1P, bid, nb, (FP8EMU & 4) ? 64.0f : 0.f);
        phase_wconv(lds, P.nsa_w_out, (bf16_t*)(ws + OFF_W2T), ZW8, DM, DM, bid, nb, (FP8EMU & 1) ? 64.0f : 0.f);
        phase_wconv(lds, P.mla_w_in, (bf16_t*)(ws + OFF_W3T), DM, N3, N3P, bid, nb, (FP8EMU & 8) ? 64.0f : 0.f);
        phase_wconv(lds, P.mla_w_q_b, (bf16_t*)(ws + OFF_W4T), QLORA, NQB, NQB, bid, nb);
        phase_wconv(lds, P.mla_w_kv_b, (bf16_t*)(ws + OFF_W5T), KVLORA, NKVB, NKVB, bid, nb);
        phase_wconv(lds, P.mla_w_out, (bf16_t*)(ws + OFF_W6T), ZW8, DM, DM, bid, nb, (FP8EMU & 2) ? 64.0f : 0.f);
        phase_wconv(lds, P.w1_k, (bf16_t*)(ws + OFF_W1K), 6144, 192, 256, bid, nb);
        phase_wconv(lds, P.w1_v, (bf16_t*)(ws + OFF_W1V), 4096, 128, 256, bid, nb);
        phase_rmsnorm(P.x, P.norm_w, (bf16_t*)(ws + OFF_H), bid, nb, (FP8EMU & 4) ? 16.0f : 0.f);
    } else if constexpr (PH == 1) {
        pg8::Gemm g{(const bf16_t*)(ws + OFF_H), (const bf16_t*)(ws + OFF_W1T), MTOK, N1P, DM};
        pg8::StaticOrder S; S.init(g.M, g.N, nb, bid);
        pg8::EpiStoreBf16 E{(bf16_t*)(ws + OFF_Y0), N1P};
        pg8::gemm_phase<pg8::EpiStoreBf16, pg8::StaticOrder, false>(lds, g, S, E, nullptr);
    } else if constexpr (PH == 2) {
        phase_nsa_prep(P, bid, nb);
        phase_vt(lds, (const bf16_t*)(ws + OFF_Y0), N1P, C_KVS + NG * DK, DV, NG, (bf16_t*)(ws + OFF_VTS), bid, nb);
        phase_vt(lds, (const bf16_t*)(ws + OFF_Y0), N1P, C_KVW + NG * DK, DV, NG, (bf16_t*)(ws + OFF_VTW), bid, nb);
    } else if constexpr (PH == 3) {
        if (bid < 16) {
            pg8::Gemm g{(const bf16_t*)(ws + OFF_ACK), (const bf16_t*)(ws + OFF_W1K), 4096, 256, 6144};
            pg8::StaticOrder S; S.init(g.M, g.N, 16, bid);
            pg8::EpiPlainF32 E{(float*)(ws + OFF_HIDK), 256};
            pg8::gemm_phase<pg8::EpiPlainF32, pg8::StaticOrder, false>(lds, g, S, E, nullptr);
        } else if (bid < 32) {
            pg8::Gemm g{(const bf16_t*)(ws + OFF_ACV), (const bf16_t*)(ws + OFF_W1V), 4096, 256, 4096};
            pg8::StaticOrder S; S.init(g.M, g.N, 16, bid - 16);
            pg8::EpiPlainF32 E{(float*)(ws + OFF_HIDV), 256};
            pg8::gemm_phase<pg8::EpiPlainF32, pg8::StaticOrder, false>(lds, g, S, E, nullptr);
        }
    } else if constexpr (PH == 4) {
        phase_cmp2(lds, P, bid, nb);
    } else if constexpr (PH == 5) {
        phase_nsa_attn(lds, P, bid, nb);
    } else if constexpr (PH == 6) {
        pg8::Gemm g{(const bf16_t*)(ws + OFF_O), (const bf16_t*)(ws + OFF_W2T), MTOK, DM, ZW8};
        pg8::StaticOrder S; S.init(g.M, g.N, nb, bid);
        pg8::EpiResF32 E{P.x, P.out, DM};
        pg8::gemm_phase<pg8::EpiResF32, pg8::StaticOrder, false>(lds, g, S, E, nullptr);
    } else if constexpr (PH == 7) {
        phase_rmsnorm(P.out, P.norm_w + DM, (bf16_t*)(ws + OFF_H), bid, nb, (FP8EMU & 8) ? 16.0f : 0.f);
    } else if constexpr (PH == 8) {
        pg8::Gemm g{(const bf16_t*)(ws + OFF_H), (const bf16_t*)(ws + OFF_W3T), MTOK, N3P, DM};
        pg8::StaticOrder S; S.init(g.M, g.N, nb, bid);
        pg8::EpiStoreBf16 E{(bf16_t*)(ws + OFF_Y1), N3P};
        pg8::gemm_phase<pg8::EpiStoreBf16, pg8::StaticOrder, false>(lds, g, S, E, nullptr);
    } else if constexpr (PH == 9) {
        phase_mla_prep1(P, bid, nb);
    } else if constexpr (PH == 10) {
        {
            pg8::Gemm g{(const bf16_t*)(ws + OFF_CQN), (const bf16_t*)(ws + OFF_W4T), MTOK, NQB, QLORA};
            pg8::StaticOrder S; S.init(g.M, g.N, nb, bid);
            pg8::EpiStoreBf16 E{(bf16_t*)(ws + OFF_QM), NQB};
            pg8::gemm_phase<pg8::EpiStoreBf16, pg8::StaticOrder, false>(lds, g, S, E, nullptr);
        }
        __syncthreads();
        {
            pg8::Gemm g{(const bf16_t*)(ws + OFF_CKVN), (const bf16_t*)(ws + OFF_W5T), MTOK, NKVB, KVLORA};
            pg8::StaticOrder S; S.init(g.M, g.N, nb, bid);
            pg8::EpiStoreBf16 E{(bf16_t*)(ws + OFF_KVM), NKVB};
            pg8::gemm_phase<pg8::EpiStoreBf16, pg8::StaticOrder, false>(lds, g, S, E, nullptr);
        }
    } else if constexpr (PH == 11) {
        phase_mla_prep2(P, bid, nb);
        phase_vt(lds, (const bf16_t*)(ws + OFF_KVM), NKVB, 128, 256, NH, (bf16_t*)(ws + OFF_VTM), bid, nb);
    } else if constexpr (PH == 12) {
        phase_mla_attn(lds, P, bid, nb);
    } else if constexpr (PH == 13) {
        pg8::Gemm g{(const bf16_t*)(ws + OFF_O), (const bf16_t*)(ws + OFF_W6T), MTOK, DM, ZW8};
        pg8::StaticOrder S; S.init(g.M, g.N, nb, bid);
        pg8::EpiResF32 E{P.out, P.out, DM};
        pg8::gemm_phase<pg8::EpiResF32, pg8::StaticOrder, false>(lds, g, S, E, nullptr);
    }
}

#ifndef REP0
#define REP0 1
#endif
#ifndef REP1
#define REP1 1
#endif
#ifndef REP2
#define REP2 1
#endif
#ifndef REP3
#define REP3 1
#endif
#ifndef REP4
#define REP4 1
#endif
#ifndef REP5
#define REP5 1
#endif
#ifndef REP6
#define REP6 1
#endif
#ifndef REP7
#define REP7 1
#endif
#ifndef REP8
#define REP8 1
#endif
#ifndef REP9
#define REP9 1
#endif
#ifndef REP10
#define REP10 1
#endif
#ifndef REP11
#define REP11 1
#endif
#ifndef REP12
#define REP12 1
#endif
#ifndef REP13
#define REP13 1
#endif

__global__ __launch_bounds__(512, 2) void k_mega(Params P) {
    extern __shared__ __attribute__((aligned(16))) unsigned char shm[];
    LAS unsigned char* lds = (LAS unsigned char*)shm;
    volatile LAS unsigned* st = (volatile LAS unsigned*)(lds + LDS_ST_OFF);
    if (threadIdx.x == 0) { st[0] = 0u; st[1] = 0u; st[2] = 0u; st[3] = 0u; }
    __syncthreads();
    XcdBarrier bar = xcd_barrier_post((unsigned*)(P.ws + OFF_CTL), st);
    const int bid = (int)blockIdx.x, nb = (int)gridDim.x;
    for (int rep_ = 0; rep_ < REP0; ++rep_) run_phase<0>(P, lds, bid, nb);  xcd_barrier(bar);
    for (int rep_ = 0; rep_ < REP1; ++rep_) run_phase<1>(P, lds, bid, nb);  xcd_barrier(bar);
    for (int rep_ = 0; rep_ < REP2; ++rep_) run_phase<2>(P, lds, bid, nb);  xcd_barrier(bar);
    for (int rep_ = 0; rep_ < REP3; ++rep_) run_phase<3>(P, lds, bid, nb);  xcd_barrier(bar);
    for (int rep_ = 0; rep_ < REP4; ++rep_) run_phase<4>(P, lds, bid, nb);  xcd_barrier(bar);
    for (int rep_ = 0; rep_ < REP5; ++rep_) run_phase<5>(P, lds, bid, nb);  xcd_barrier(bar);
    for (int rep_ = 0; rep_ < REP6; ++rep_) run_phase<6>(P, lds, bid, nb);  xcd_barrier(bar);
    for (int rep_ = 0; rep_ < REP7; ++rep_) run_phase<7>(P, lds, bid, nb);  xcd_barrier(bar);
    for (int rep_ = 0; rep_ < REP8; ++rep_) run_phase<8>(P, lds, bid, nb);  xcd_barrier(bar);
    for (int rep_ = 0; rep_ < REP9; ++rep_) run_phase<9>(P, lds, bid, nb);  xcd_barrier(bar);
    for (int rep_ = 0; rep_ < REP10; ++rep_) run_phase<10>(P, lds, bid, nb); xcd_barrier(bar);
    for (int rep_ = 0; rep_ < REP11; ++rep_) run_phase<11>(P, lds, bid, nb); xcd_barrier(bar);
    for (int rep_ = 0; rep_ < REP12; ++rep_) run_phase<12>(P, lds, bid, nb); xcd_barrier(bar);
    for (int rep_ = 0; rep_ < REP13; ++rep_) run_phase<13>(P, lds, bid, nb);
}

extern "C" void kernel_launch(void* const* d_in, const int* in_sizes, int n_in, void* d_out, int out_size, void* d_ws, size_t ws_size, hipStream_t stream) {
    (void)in_sizes; (void)n_in; (void)out_size;
    if (ws_size < WS_END) return;
    Params P{};
    P.x = (const float*)d_in[0]; P.pos = (const int*)d_in[1]; P.norm_w = (const float*)d_in[2]; P.rel_bias = (const float*)d_in[3];
    P.nsa_w_in = (const float*)d_in[4]; P.nsa_q_norm = (const float*)d_in[5]; P.nsa_k_norm = (const float*)d_in[6]; P.pe_k = (const float*)d_in[7];
    P.w1_k = (const float*)d_in[8]; P.w2_k = (const float*)d_in[9]; P.pe_v = (const float*)d_in[10]; P.w1_v = (const float*)d_in[11]; P.w2_v = (const float*)d_in[12];
    P.nsa_w_out = (const float*)d_in[13]; P.mla_w_in = (const float*)d_in[14]; P.mla_q_a_norm = (const float*)d_in[15]; P.mla_w_q_b = (const float*)d_in[16];
    P.mla_kv_a_norm = (const float*)d_in[17]; P.mla_w_kv_b = (const float*)d_in[18]; P.mla_q_norm = (const float*)d_in[19]; P.mla_k_norm = (const float*)d_in[20];
    P.mla_w_out = (const float*)d_in[21];
    P.out = (float*)d_out; P.ws = (unsigned char*)d_ws;
    static int grid = 0;
    if (!grid) {
        int dev = 0, cus = 0, per_cu = 0; (void)hipGetDevice(&dev);
        if (hipDeviceGetAttribute(&cus, hipDeviceAttributeMultiprocessorCount, dev) != hipSuccess || cus <= 0) cus = 256;
        (void)hipFuncSetAttribute((const void*)k_mega, hipFuncAttributeMaxDynamicSharedMemorySize, LDS_BYTES);
        if (hipOccupancyMaxActiveBlocksPerMultiprocessor(&per_cu, k_mega, 512, LDS_BYTES) != hipSuccess || per_cu < 1) per_cu = 1;
        grid = cus;
    }
    (void)hipMemsetAsync((unsigned char*)d_ws + OFF_CTL, 0, XCD_BAR_WORDS * sizeof(unsigned), stream);
    hipLaunchKernelGGL(k_mega, dim3(grid), dim3(512), LDS_BYTES, stream, P);
}
```

```cpp
#include <hip/hip_runtime.h>
#include <stdint.h>
#include <stddef.h>

#define DI __device__ __forceinline__
#define LAS __attribute__((address_space(3)))
typedef unsigned short bf16_t;
typedef short bf16x8 __attribute__((ext_vector_type(8)));
typedef float f32x4 __attribute__((ext_vector_type(4)));
typedef float f32x16 __attribute__((ext_vector_type(16)));
typedef unsigned u32x4 __attribute__((ext_vector_type(4)));
typedef unsigned u32x2 __attribute__((ext_vector_type(2)));
typedef __bf16 bf2_t __attribute__((ext_vector_type(2)));
typedef float f2_t __attribute__((ext_vector_type(2)));

DI int tid_opaque() { int t = (int)threadIdx.x; asm volatile("" : "+v"(t)); return t; }
DI unsigned pk2(float a, float b) { f2_t f = {a, b}; bf2_t v = __builtin_convertvector(f, bf2_t); return __builtin_bit_cast(unsigned, v); }
DI float bflo(unsigned w) { return __uint_as_float(w << 16); }
DI float bfhi(unsigned w) { return __uint_as_float(w & 0xffff0000u); }
#ifndef FP8EMU
#define FP8EMU 0
#endif
DI float emu_q8(float x, float s) { float y = x * s; const float ay = fabsf(y);
    if (ay < 0.015625f) y = rintf(y * 512.0f) * (1.0f / 512.0f);
    else { unsigned u = __float_as_uint(y); u = (u + 0x0007FFFFu + ((u >> 20) & 1u)) & 0xFFF00000u; y = __uint_as_float(u); }
    y = fminf(fmaxf(y, -448.0f), 448.0f); return y / s; }
DI float bf1(bf16_t h) { return __uint_as_float(((unsigned)h) << 16); }

constexpr int BATCH = 4, SEQ = 4096, DM = 4096, MTOK = BATCH * SEQ;
constexpr int NH = 64, NG = 4, NR = 16, DK = 192, DV = 128;
constexpr int N1 = 40896, N1P = 40960;
constexpr int C_Q = 0, C_KVC = 12288, C_KVS = 13568, C_KVW = 14848, C_ZC = 16128, C_ZS = 24320, C_ZW = 32512, C_G = 40704;
constexpr int N3 = 10304, N3P = 10496;
constexpr int C3_CQ = 0, C3_CKV = 1536, C3_KPE = 2048, C3_Z = 2112;
constexpr int QLORA = 1536, KVLORA = 512;
constexpr int NQB = 12288, NKVB = 16384, ZW8 = 8192;
constexpr float EPSN = 1e-6f;
constexpr float LOG2E = 1.4426950408889634f;
constexpr float QSCALE = 0.07216878364870322f * 1.4426950408889634f;

constexpr size_t SZ_W1T = (size_t)N1P * DM * 2, SZ_W2T = (size_t)DM * ZW8 * 2, SZ_W3T = (size_t)N3P * DM * 2, SZ_W4T = (size_t)NQB * QLORA * 2,
                 SZ_W5T = (size_t)NKVB * KVLORA * 2, SZ_W6T = (size_t)DM * ZW8 * 2;
constexpr size_t OFF_W1T = 0, OFF_W2T = OFF_W1T + SZ_W1T, OFF_W3T = OFF_W2T + SZ_W2T, OFF_W4T = OFF_W3T + SZ_W3T, OFF_W5T = OFF_W4T + SZ_W4T,
                 OFF_W6T = OFF_W5T + SZ_W5T, OFF_W1K = OFF_W6T + SZ_W6T;
constexpr size_t OFF_W5K = OFF_W5T, OFF_W5V = OFF_W5T + SZ_W5T / 2;
constexpr size_t SZ_W1K = (size_t)256 * 6144 * 2, SZ_W1V = (size_t)256 * 4096 * 2;
constexpr size_t OFF_W1V = OFF_W1K + SZ_W1K, OFF_CTL = OFF_W1V + SZ_W1V, OFF_H = OFF_CTL + 65536;
constexpr size_t SZ_H = (size_t)MTOK * DM * 2, SZ_KS = (size_t)BATCH * NG * SEQ * DK * 2, SZ_VTS = (size_t)BATCH * NG * DV * SEQ * 2,
                 SZ_ACK = (size_t)4096 * 6144 * 2, SZ_ACV = (size_t)4096 * 4096 * 2;
constexpr size_t OFF_KS = OFF_H + SZ_H, OFF_KW = OFF_KS + SZ_KS, OFF_VTS = OFF_KW + SZ_KS, OFF_VTW = OFF_VTS + SZ_VTS, OFF_ACK = OFF_VTW + SZ_VTS,
                 OFF_ACV = OFF_ACK + SZ_ACK, OFF_KC = OFF_ACV + SZ_ACV;
constexpr size_t SZ_KC = (size_t)16 * 256 * DK * 2, SZ_VTC = (size_t)16 * DV * 256 * 2, SZ_HID = (size_t)4096 * 256 * 4;
constexpr size_t OFF_VTC = OFF_KC + SZ_KC, OFF_HIDK = OFF_VTC + SZ_VTC, OFF_HIDV = OFF_HIDK + SZ_HID, OFF_Y0 = OFF_HIDV + SZ_HID;
constexpr size_t SZ_Y0 = (size_t)MTOK * N1P * 2, SZ_O = (size_t)MTOK * ZW8 * 2;
constexpr size_t OFF_O = OFF_Y0 + SZ_Y0, WS_END = OFF_O + SZ_O;
constexpr size_t OFF_SS1 = OFF_HIDK;
constexpr size_t OFF_KM = 0;
constexpr size_t SZ_KM = (size_t)BATCH * NH * SEQ * DK * 2;
static_assert(SZ_KM <= SZ_W1T + SZ_W2T, "KM alias");
constexpr size_t OFF_VTM = OFF_H;
constexpr size_t SZ_VTM = (size_t)BATCH * NH * DV * SEQ * 2;
constexpr size_t OFF_CKVN = OFF_VTM + SZ_VTM;
constexpr size_t SZ_CKVN = (size_t)MTOK * KVLORA * 2;
static_assert(OFF_CKVN + SZ_CKVN <= OFF_KC, "CKVN alias");
constexpr size_t OFF_Y1 = OFF_Y0, SZ_Y1 = (size_t)MTOK * N3P * 2;
constexpr size_t OFF_QM = OFF_Y1 + SZ_Y1, SZ_QM = (size_t)MTOK * NQB * 2;
constexpr size_t OFF_KVM = OFF_QM + SZ_QM, SZ_KVM = (size_t)MTOK * NKVB * 2;
constexpr size_t OFF_KNM = OFF_KVM;
constexpr size_t OFF_KPER = OFF_KVM, OFF_SSPE = OFF_KVM + (size_t)MTOK * 64 * 4;
constexpr size_t OFF_CQN = OFF_KVM + SZ_KVM, SZ_CQN = (size_t)MTOK * QLORA * 2;
constexpr size_t OFF_ROPE = OFF_CQN + SZ_CQN, SZ_ROPE = (size_t)MTOK * 64 * 4;
static_assert(OFF_ROPE + SZ_ROPE <= OFF_O, "layer-1 alias region");
static_assert(WS_END <= 2680160256ull, "workspace");

struct Params {
    const float* x; const int* pos; const float* norm_w; const float* rel_bias;
    const float* nsa_w_in; const float* nsa_q_norm; const float* nsa_k_norm; const float* pe_k; const float* w1_k; const float* w2_k;
    const float* pe_v; const float* w1_v; const float* w2_v; const float* nsa_w_out;
    const float* mla_w_in; const float* mla_q_a_norm; const float* mla_w_q_b; const float* mla_kv_a_norm; const float* mla_w_kv_b;
    const float* mla_q_norm; const float* mla_k_norm; const float* mla_w_out;
    float* out; unsigned char* ws;
};

#define XB_TMO      128
#define XB_XCNT(j)  (256  + 64 * (j))
#define XB_XSUB(j)  (1280 + 64 * (j))
#define XB_XGEN(j)  (2304 + 64 * (j))
#define XB_TOP      3328
#define XB_TOPGEN   3392
#define XCD_BAR_WORDS 3456
#define XB_SPIN_CAP (1u << 18)

__device__ __forceinline__ unsigned xb_ld(unsigned* p)              { return __hip_atomic_load(p, __ATOMIC_RELAXED, __HIP_MEMORY_SCOPE_AGENT); }
__device__ __forceinline__ unsigned xb_add(unsigned* p, unsigned v) { return __hip_atomic_fetch_add(p, v, __ATOMIC_RELAXED, __HIP_MEMORY_SCOPE_AGENT); }
__device__ __forceinline__ unsigned xb_xcc_id() { return (unsigned)__builtin_amdgcn_s_getreg((3 << 11) | 20) & 0xFu; }
#define XB_SPIN(cond, bar) do { unsigned _sp = 0; while (cond) { __builtin_amdgcn_s_sleep(1); \
    if ((++_sp & 255u) == 0u) { if (xb_ld(&(bar)[XB_TMO])) break; if (_sp > XB_SPIN_CAP) { atomicAdd(&(bar)[XB_TMO], 1u); break; } } } } while (0)

struct XcdBarrier {
    unsigned* bar; unsigned x;
    volatile LAS unsigned* st;
};

__device__ __forceinline__ XcdBarrier xcd_barrier_post(unsigned* bar, volatile LAS unsigned* st) {
    XcdBarrier b; b.bar = bar; b.x = xb_xcc_id(); b.st = st;
    if (threadIdx.x == 0) (void)xb_add(&bar[XB_XCNT(b.x)], 1u);
    return b;
}
__device__ __forceinline__ void xcd_barrier_complete(unsigned* bar, unsigned x, unsigned& nloc, unsigned& nx) {
    const unsigned G = gridDim.x * gridDim.y * gridDim.z;
    unsigned sum, cnt, mine, sp = 0u;
    for (;;) {
        sum = 0u; cnt = 0u; mine = 0u;
#pragma unroll
        for (unsigned j = 0; j < 16; ++j) { const unsigned c = xb_ld(&bar[XB_XCNT(j)]); sum += c; cnt += (c > 0u) ? 1u : 0u; mine = (j == x) ? c : mine; }
        if (sum == G) break;
        __builtin_amdgcn_s_sleep(1);
        if ((++sp & 255u) == 0u) { if (xb_ld(&bar[XB_TMO])) break; if (sp > XB_SPIN_CAP) { atomicAdd(&bar[XB_TMO], 1u); break; } }
    }
    nloc = mine > 0u ? mine : 1u; nx = cnt > 0u ? cnt : 1u;
}

__device__ __forceinline__ void xcd_barrier(const XcdBarrier& b) {
    asm volatile("s_waitcnt vmcnt(0)" ::: "memory");
    __syncthreads();
    if (threadIdx.x == 0) {
        unsigned* bar = b.bar;
        __builtin_amdgcn_s_waitcnt(0);
        unsigned nloc = b.st[0], nx = b.st[1];
        if (nloc == 0u) { xcd_barrier_complete(bar, b.x, nloc, nx); b.st[0] = nloc; b.st[1] = nx; }
        const unsigned old = xb_add(&bar[XB_XSUB(b.x)], 1u);
        const unsigned gen = old / nloc;
        if (old + 1u == (gen + 1u) * nloc) {
            __builtin_amdgcn_fence(__ATOMIC_RELEASE, "agent");
            asm volatile("s_waitcnt vmcnt(0)" ::: "memory");
            const unsigned og = xb_add(&bar[XB_TOP], 1u);
            const unsigned tg = og / nx;
            if (og + 1u == (tg + 1u) * nx) xb_add(&bar[XB_TOPGEN], 1u);
            else XB_SPIN(xb_ld(&bar[XB_TOPGEN]) == tg, bar);
            __builtin_amdgcn_fence(__ATOMIC_ACQUIRE, "agent");
            xb_add(&bar[XB_XGEN(b.x)], 1u);
            asm volatile("s_waitcnt vmcnt(0)" ::: "memory");
        } else {
            XB_SPIN(xb_ld(&bar[XB_XGEN(b.x)]) == gen, bar);
            __builtin_amdgcn_fence(__ATOMIC_ACQUIRE, "agent");
            asm volatile("s_waitcnt vmcnt(0)" ::: "memory");
        }
    }
    __syncthreads();
}

namespace pg8 {
#define PG8_LAS __attribute__((address_space(3)))
typedef unsigned short bf16_t;
typedef short bf16x8 __attribute__((ext_vector_type(8)));
typedef float f32x4 __attribute__((ext_vector_type(4)));
typedef unsigned u32x4 __attribute__((ext_vector_type(4)));
constexpr int BM = 256, BK = 64, HALF = 128, HTB = HALF * BK * 2  , STAGE_BYTES = 8 * HTB, NXCD = 8, WGM = 8;

__host__ __device__ __forceinline__ int lds_byte(int r, int c) { const int st = (r >> 4) * 2 + (c >> 5), rr = r & 15, cc = c & 31, ob = rr * 64 + cc * 2; return st * 1024 + (ob ^ (((ob >> 9) & 1) << 5)); }
__host__ __device__ __forceinline__ void stage_rc(int b, int& R, int& C) { const int st = b / 1024, sb = b % 1024, swz = sb ^ (((sb >> 9) & 1) << 5); R = (st >> 1) * 16 + swz / 64; C = (st & 1) * 32 + (swz % 64) / 2; }
__host__ __device__ __forceinline__ int perm32(int rho) { const int n = rho >> 4, i = rho & 15; return 8 * (i >> 2) + 4 * n + (i & 3); }

struct Unit { int pm, pn; };
struct Gemm { const bf16_t* A; const bf16_t* Bt; int M, N, K; };

struct StaticOrder {
    int nM, nN, nwg, G, c;
    __host__ __device__ void init(int M, int N, int G_, int c_) { nM = M / BM; nN = N / BM; nwg = nM * nN; G = G_; c = c_; }
    __host__ __device__ bool next(int i, Unit& u) const {
        const long L = (long)i * G + c; if (L >= nwg) return false;
        int wgid = (int)L; { const int q = nwg / NXCD, r = nwg % NXCD, xcd = wgid % NXCD, off = wgid / NXCD; wgid = (xcd < r ? xcd * (q + 1) : r * (q + 1) + (xcd - r) * q) + off; }
        const int nig = WGM * nN, gid = wgid / nig, fm = gid * WGM, gsz = (nM - fm) < WGM ? (nM - fm) : WGM;
        u.pm = fm + ((wgid % nig) % gsz); u.pn = (wgid % nig) / gsz; return true;
    }
    __device__ __forceinline__ void a_ready(const Unit&) const {}
    __device__ __forceinline__ void done(const Unit&) const {}
};
struct EpiStoreBf16 {
    static constexpr bool PERM = true, AFTER_DRAIN = false, SWAP23 = false;
    bf16_t* O; int ldc;
    __device__ __forceinline__ void operator()(const f32x4 (&acc)[2][2][4][2], const Unit& u, int wr, int wc, int fr, int fq) const {
        const int row0 = u.pm * BM + wr * 64 + fr; const int col0 = u.pn * BM + wc * 32 + 8 * fq;
#pragma unroll
        for (int ai = 0; ai < 2; ++ai)
#pragma unroll
            for (int m = 0; m < 4; ++m) { bf16_t* rowp = O + (size_t)(row0 + ai * HALF + m * 16) * ldc + col0;
#pragma unroll
                for (int bj = 0; bj < 2; ++bj) { const f32x4 v0 = acc[ai][bj][m][0], v1 = acc[ai][bj][m][1];
                    u32x4 w; w.x = pk2(v0[0], v0[1]); w.y = pk2(v0[2], v0[3]); w.z = pk2(v1[0], v1[1]); w.w = pk2(v1[2], v1[3]);
                    *(u32x4*)(rowp + bj * HALF) = w; } }
    }
};
struct EpiResF32 {
    static constexpr bool PERM = false, AFTER_DRAIN = false, SWAP23 = false;
    const float* base; float* out; int ldc;
    __device__ __forceinline__ void operator()(const f32x4 (&acc)[2][2][4][2], const Unit& u, int wr, int wc, int fr, int fq) const {
        const int row0 = u.pm * BM + wr * 64 + fr, col0 = u.pn * BM + wc * 32 + 4 * fq;
#pragma unroll
        for (int ai = 0; ai < 2; ++ai)
#pragma unroll
            for (int m = 0; m < 4; ++m) { const size_t off = (size_t)(row0 + ai * HALF + m * 16) * ldc + col0;
#pragma unroll
                for (int bj = 0; bj < 2; ++bj)
#pragma unroll
                    for (int n = 0; n < 2; ++n) { const f32x4 bs = *(const f32x4*)(base + off + bj * HALF + n * 16);
                        *(f32x4*)(out + off + bj * HALF + n * 16) = bs + acc[ai][bj][m][n]; } }
    }
};
struct EpiPlainF32 {
    static constexpr bool PERM = false, AFTER_DRAIN = false, SWAP23 = false;
    float* C; int ldc;
    __device__ __forceinline__ void operator()(const f32x4 (&acc)[2][2][4][2], const Unit& u, int wr, int wc, int fr, int fq) const {
        const int row0 = u.pm * BM + wr * 64 + fr, col0 = u.pn * BM + wc * 32 + 4 * fq;
#pragma unroll
        for (int ai = 0; ai < 2; ++ai)
#pragma unroll
            for (int m = 0; m < 4; ++m) { float* rowp = C + (size_t)(row0 + ai * HALF + m * 16) * ldc + col0;
#pragma unroll
                for (int bj = 0; bj < 2; ++bj)
#pragma unroll
                    for (int n = 0; n < 2; ++n) *(f32x4*)(rowp + bj * HALF + n * 16) = acc[ai][bj][m][n]; }
    }
};

struct EpiVT {
    static constexpr bool PERM = true, AFTER_DRAIN = false, SWAP23 = true;
    bf16_t* O;
    __device__ __forceinline__ void operator()(const f32x4 (&acc)[2][2][4][2], const Unit& u, int wr, int wc, int fr, int fq) const {
        const int row0 = u.pm * BM + wr * 64 + fr; const int colt = u.pn * BM; const int b = colt >> 12, pos0 = (colt & 4095) + wc * 32 + 8 * fq;
        bf16_t* base = O + (size_t)b * 8192 * 4096 + pos0;
#pragma unroll
        for (int ai = 0; ai < 2; ++ai)
#pragma unroll
            for (int m = 0; m < 4; ++m) { bf16_t* rowp = base + (size_t)(row0 + ai * HALF + m * 16) * 4096;
#pragma unroll
                for (int bj = 0; bj < 2; ++bj) { const f32x4 v0 = acc[ai][bj][m][0], v1 = acc[ai][bj][m][1];
                    u32x4 w; w.x = pk2(v0[0], v0[1]); w.y = pk2(v0[2], v0[3]); w.z = pk2(v1[0], v1[1]); w.w = pk2(v1[2], v1[3]);
                    *(u32x4*)(rowp + bj * HALF) = w; } }
    }
};

struct EpiKNorm {
    static constexpr bool PERM = true, AFTER_DRAIN = false, SWAP23 = false;
    bf16_t* KM; const float* sspe; const float* kper; const float* gain; PG8_LAS float* tab; mutable unsigned par;
    __device__ __forceinline__ void operator()(const f32x4 (&acc)[2][2][4][2], const Unit& u, int wr, int wc, int fr, int fq) const {
        PG8_LAS float* T = tab + par * 2048;
#pragma unroll
        for (int ai = 0; ai < 2; ++ai)
#pragma unroll
            for (int m = 0; m < 4; ++m) { const int row = ai * HALF + wr * 64 + m * 16 + fr;
#pragma unroll
                for (int bj = 0; bj < 2; ++bj) { const f32x4 x = acc[ai][bj][m][0], y = acc[ai][bj][m][1];
                    float ss = (x[0] * x[0] + x[1] * x[1]) + (x[2] * x[2] + x[3] * x[3]) + (y[0] * y[0] + y[1] * y[1]) + (y[2] * y[2] + y[3] * y[3]);
                    ss += __shfl_xor(ss, 16); ss += __shfl_xor(ss, 32);
                    if (fq == 0) T[row * 8 + bj * 4 + wc] = ss; } }
        asm volatile("s_waitcnt lgkmcnt(0)" ::: "memory"); __builtin_amdgcn_s_barrier(); asm volatile("" ::: "memory");
        const f32x4 g0 = *(const f32x4*)(gain + wc * 32 + 8 * fq), g1 = *(const f32x4*)(gain + wc * 32 + 8 * fq + 4);
        const int tok0 = u.pm * BM, b = tok0 >> 12;
#pragma unroll
        for (int ai = 0; ai < 2; ++ai)
#pragma unroll
            for (int m = 0; m < 4; ++m) { const int row = ai * HALF + wr * 64 + m * 16 + fr, tok = tok0 + row, s = tok & 4095;
                const float sp = sspe[tok]; const f32x4 kp = *(const f32x4*)(kper + (size_t)tok * 64 + wc * 16 + 4 * fq);
#pragma unroll
                for (int bj = 0; bj < 2; ++bj) { const f32x4 t = *(const PG8_LAS f32x4*)(T + row * 8 + bj * 4);
                    const float rstd = rsqrtf(((t[0] + t[1]) + (t[2] + t[3]) + sp) * (1.0f / 192.0f) + 1e-6f);
                    const int hd = 2 * u.pn + bj;
                    bf16_t* kb = KM + ((size_t)(b * 64 + hd) * 4096 + s) * 192;
                    const f32x4 x = acc[ai][bj][m][0], y = acc[ai][bj][m][1];
                    u32x4 w; w.x = pk2(x[0] * rstd * g0[0], x[1] * rstd * g0[1]); w.y = pk2(x[2] * rstd * g0[2], x[3] * rstd * g0[3]);
                    w.z = pk2(y[0] * rstd * g1[0], y[1] * rstd * g1[1]); w.w = pk2(y[2] * rstd * g1[2], y[3] * rstd * g1[3]);
                    *(u32x4*)(kb + wc * 32 + 8 * fq) = w;
                    u32x2 r; r.x = pk2(kp[0] * rstd, kp[1] * rstd); r.y = pk2(kp[2] * rstd, kp[3] * rstd);
                    *(u32x2*)(kb + 128 + wc * 16 + 4 * fq) = r; } }
        par ^= 1u;
    }
};

struct EpiResNorm {
    static constexpr bool PERM = false, AFTER_DRAIN = false, SWAP23 = false;
    const float* base; float* out; int ldc; const float* gain; bf16_t* xg; float* ss;
    __device__ __forceinline__ void operator()(const f32x4 (&acc)[2][2][4][2], const Unit& u, int wr, int wc, int fr, int fq) const {
        const int row0 = u.pm * BM + wr * 64 + fr, col0 = u.pn * BM + wc * 32 + 4 * fq;
        f32x4 gv[2][2];
#pragma unroll
        for (int bj = 0; bj < 2; ++bj)
#pragma unroll
            for (int n = 0; n < 2; ++n) gv[bj][n] = *(const f32x4*)(gain + col0 + bj * HALF + n * 16);
#pragma unroll
        for (int ai = 0; ai < 2; ++ai)
#pragma unroll
            for (int m = 0; m < 4; ++m) { const int row = row0 + ai * HALF + m * 16; const size_t off = (size_t)row * ldc + col0; float sq = 0.f;
#pragma unroll
                for (int bj = 0; bj < 2; ++bj)
#pragma unroll
                    for (int n = 0; n < 2; ++n) { const f32x4 bs = *(const f32x4*)(base + off + bj * HALF + n * 16); const f32x4 v = bs + acc[ai][bj][m][n];
                        *(f32x4*)(out + off + bj * HALF + n * 16) = v;
                        sq += (v[0] * v[0] + v[1] * v[1]) + (v[2] * v[2] + v[3] * v[3]);
                        const f32x4 g = gv[bj][n]; u32x2 w; w.x = pk2(v[0] * g[0], v[1] * g[1]); w.y = pk2(v[2] * g[2], v[3] * g[3]);
                        *(u32x2*)(xg + off + bj * HALF + n * 16) = w; }
                sq += __shfl_xor(sq, 16); sq += __shfl_xor(sq, 32);
                if (fq == 0) atomicAdd(ss + row, sq); }
    }
};
struct EpiStoreBf16RowScale {
    static constexpr bool PERM = true, AFTER_DRAIN = false, SWAP23 = false;
    bf16_t* O; int ldc; const float* ss; float inv_dim;
    __device__ __forceinline__ void operator()(const f32x4 (&acc)[2][2][4][2], const Unit& u, int wr, int wc, int fr, int fq) const {
        const int row0 = u.pm * BM + wr * 64 + fr; const int col0 = u.pn * BM + wc * 32 + 8 * fq;
#pragma unroll
        for (int ai = 0; ai < 2; ++ai)
#pragma unroll
            for (int m = 0; m < 4; ++m) { const int row = row0 + ai * HALF + m * 16; const float rs = rsqrtf(ss[row] * inv_dim + 1e-6f);
                bf16_t* rowp = O + (size_t)row * ldc + col0;
#pragma unroll
                for (int bj = 0; bj < 2; ++bj) { const f32x4 v0 = acc[ai][bj][m][0] * rs, v1 = acc[ai][bj][m][1] * rs;
                    u32x4 w; w.x = pk2(v0[0], v0[1]); w.y = pk2(v0[2], v0[3]); w.z = pk2(v1[0], v1[1]); w.w = pk2(v1[2], v1[3]);
                    *(u32x4*)(rowp + bj * HALF) = w; } }
    }
};
template <class Epi, class Sched, bool STAMP = false>
__device__ __forceinline__ void gemm_phase(PG8_LAS unsigned char* lds, const Gemm g, const Sched& S, const Epi& E, unsigned long long* stamps) {
    const int tid = tid_opaque(), wid = __builtin_amdgcn_readfirstlane(tid >> 6), lane = tid & 63, wr = wid >> 2, wc = wid & 3, fr = lane & 15, fq = lane >> 4;
    const int K = g.K, nt = K / BK;
    int ts_lo = 0, ts_hi = 0, nts = 0; const unsigned long long rt_entry = STAMP ? (unsigned long long)wall_clock64() : 0ull;
#define PG8_STAMP() do { if (STAMP && wid == 0 && nts < 64) { const unsigned long long _c = (unsigned long long)clock64(); \
        ts_lo = (lane == nts) ? (int)(unsigned)_c : ts_lo; ts_hi = (lane == nts) ? (int)(unsigned)(_c >> 32) : ts_hi; ++nts; } } while (0)
    PG8_STAMP();
    unsigned voffA[2], voffB[2];
#pragma unroll
    for (int i = 0; i < 2; ++i) { int R, C; stage_rc(tid * 16 + i * 8192, R, C); int Rb = Epi::PERM ? ((R & ~31) + perm32(R & 31)) : R; if (Epi::SWAP23) Rb = (Rb & ~15) | ((Rb & 3) | ((Rb & 4) << 1) | ((Rb & 8) >> 1));
        voffA[i] = (unsigned)(R * K + C) * 2u; voffB[i] = (unsigned)(Rb * K + C) * 2u; }
    const size_t kstep = (size_t)(BK * 2);
    const size_t hstep = (size_t)HALF * K * 2;
    const size_t tstep = 2 * hstep;
    const unsigned ldsw = (unsigned)wid * 1024u;
    const int aoff = lds_byte(wr * 64 + fr, fq * 8), boff = lds_byte(wc * 32 + fr, fq * 8);
#define PG8_SA(b, h) (((b) * 2 + (h)) * HTB)
#define PG8_SB(b, h) ((4 + (b) * 2 + (h)) * HTB)
#define PG8_STAGE(bufoff, gbase, voff) do { _Pragma("unroll") for (int _i = 0; _i < 2; ++_i) \
        __builtin_amdgcn_global_load_lds((const unsigned*)((const char*)(gbase) + (voff)[_i]), (PG8_LAS unsigned*)(lds + (bufoff) + ldsw + _i * 8192), 16, 0, 0); } while (0)
#define PG8_LDA(dst, b, h) do { _Pragma("unroll") for (int m = 0; m < 4; ++m) _Pragma("unroll") for (int k = 0; k < 2; ++k) dst[m][k] = *(const PG8_LAS bf16x8*)(lds + PG8_SA(b, h) + aoff + m * 2048 + k * 1024); } while (0)
#define PG8_LDB(dst, b, h) do { _Pragma("unroll") for (int n = 0; n < 2; ++n) _Pragma("unroll") for (int k = 0; k < 2; ++k) dst[n][k] = *(const PG8_LAS bf16x8*)(lds + PG8_SB(b, h) + boff + n * 2048 + k * 1024); } while (0)
#define PG8_MMA(ai, bj, At, Bt) do { __builtin_amdgcn_s_setprio(1); _Pragma("unroll") for (int m = 0; m < 4; ++m) _Pragma("unroll") for (int n = 0; n < 2; ++n) _Pragma("unroll") for (int k = 0; k < 2; ++k) \
        acc[ai][bj][m][n] = __builtin_amdgcn_mfma_f32_16x16x32_bf16(Bt[n][k], At[m][k], acc[ai][bj][m][n], 0, 0, 0); __builtin_amdgcn_s_setprio(0); } while (0)
#define PG8_WAIT_V(n) asm volatile("s_waitcnt vmcnt(" #n ")" ::: "memory")
#define PG8_WAIT_L(n) asm volatile("s_waitcnt lgkmcnt(" #n ")" ::: "memory")
#define PG8_BAR __builtin_amdgcn_s_barrier()
#define PG8_SCHED __builtin_amdgcn_sched_barrier(0)
    Unit cur, nxt; int ui = 0;
    if (!S.next(0, cur)) return;
    f32x4 acc[2][2][4][2];
#pragma unroll
    for (int a = 0; a < 2; ++a)
#pragma unroll
        for (int b = 0; b < 2; ++b)
#pragma unroll
            for (int m = 0; m < 4; ++m)
#pragma unroll
                for (int n = 0; n < 2; ++n) acc[a][b][m][n] = (f32x4){0.f, 0.f, 0.f, 0.f};
    bf16x8 At[4][2], B0[2][2], B1[2][2];
    const char* cA = (const char*)g.A + (size_t)cur.pm * tstep; const char* cB = (const char*)g.Bt + (size_t)cur.pn * tstep;
    S.a_ready(cur);
    PG8_STAGE(PG8_SB(0, 0), cB, voffB); PG8_STAGE(PG8_SA(0, 0), cA, voffA); PG8_STAGE(PG8_SB(0, 1), cB + hstep, voffB); PG8_STAGE(PG8_SA(0, 1), cA + hstep, voffA);
    if (wr == 1) PG8_BAR;
    PG8_WAIT_V(4); PG8_BAR;
    PG8_STAGE(PG8_SB(1, 0), cB + kstep, voffB); PG8_STAGE(PG8_SA(1, 0), cA + kstep, voffA); PG8_STAGE(PG8_SB(1, 1), cB + hstep + kstep, voffB);
    PG8_WAIT_V(6); PG8_BAR;
    PG8_STAMP();
    for (;;) {
        const bool has_next = S.next(ui + 1, nxt);
        const char* nA = has_next ? (const char*)g.A + (size_t)nxt.pm * tstep : cA; const char* nB = has_next ? (const char*)g.Bt + (size_t)nxt.pn * tstep : cB;
        for (int t = 0; t < nt; t += 2) {
            const bool last = (t == nt - 2);
            const char* a1 = cA + (size_t)(t + 1) * kstep;
            const char* a2 = last ? nA : cA + (size_t)(t + 2) * kstep; const char* b2 = last ? nB : cB + (size_t)(t + 2) * kstep;
            const char* a3 = a2 + kstep; const char* b3 = b2 + kstep;
            if (last && has_next) S.a_ready(nxt);
            PG8_LDB(B0, 0, 0); PG8_SCHED; PG8_LDA(At, 0, 0); PG8_STAGE(PG8_SA(1, 1), a1 + hstep, voffA);
            PG8_WAIT_L(8); PG8_BAR; PG8_WAIT_L(0); PG8_MMA(0, 0, At, B0); PG8_BAR; PG8_SCHED;
            PG8_LDB(B1, 0, 1); PG8_STAGE(PG8_SB(0, 0), b2, voffB);
            PG8_BAR; PG8_WAIT_L(0); PG8_MMA(0, 1, At, B1); PG8_BAR;
            PG8_LDA(At, 0, 1); PG8_STAGE(PG8_SA(0, 0), a2, voffA);
            PG8_BAR; PG8_WAIT_L(0); PG8_MMA(1, 0, At, B0); PG8_BAR; PG8_SCHED;
            PG8_STAGE(PG8_SB(0, 1), b2 + hstep, voffB);
            PG8_WAIT_V(6); PG8_BAR; PG8_MMA(1, 1, At, B1); PG8_BAR;
            PG8_LDB(B0, 1, 0); PG8_SCHED; PG8_LDA(At, 1, 0); PG8_STAGE(PG8_SA(0, 1), a2 + hstep, voffA);
            PG8_WAIT_L(8); PG8_BAR; PG8_WAIT_L(0); PG8_MMA(0, 0, At, B0); PG8_BAR; PG8_SCHED;
            PG8_LDB(B1, 1, 1); PG8_STAGE(PG8_SB(1, 0), b3, voffB);
            PG8_BAR; PG8_WAIT_L(0); PG8_MMA(0, 1, At, B1); PG8_BAR;
            PG8_LDA(At, 1, 1); PG8_STAGE(PG8_SA(1, 0), a3, voffA);
            PG8_BAR; PG8_WAIT_L(0); PG8_MMA(1, 0, At, B0); PG8_BAR; PG8_SCHED;
            PG8_STAGE(PG8_SB(1, 1), b3 + hstep, voffB);
            PG8_WAIT_V(6); PG8_BAR; PG8_MMA(1, 1, At, B1); PG8_BAR;
        }
        PG8_STAMP();
        if constexpr (!Epi::AFTER_DRAIN) { E(acc, cur, wr, wc, fr, fq); S.done(cur); }
        PG8_STAMP();
        if (!has_next) break;
#pragma unroll
        for (int a = 0; a < 2; ++a)
#pragma unroll
            for (int b = 0; b < 2; ++b)
#pragma unroll
                for (int m = 0; m < 4; ++m)
#pragma unroll
                    for (int n = 0; n < 2; ++n) acc[a][b][m][n] = (f32x4){0.f, 0.f, 0.f, 0.f};
        cur = nxt; cA = nA; cB = nB; ++ui;
    }
    PG8_WAIT_V(0);
    if (wr == 0) PG8_BAR;
    PG8_BAR;
    if constexpr (Epi::AFTER_DRAIN) { E.fused(acc, cur, wr, wc, fr, fq, lds, wid, lane); S.done(cur); }
    PG8_STAMP();
    if (STAMP && wid == 0) { stamps[lane] = lane < nts ? (((unsigned long long)(unsigned)ts_hi << 32) | (unsigned)ts_lo) : 0ull;
        if (lane == 62) stamps[62] = rt_entry; if (lane == 63) stamps[63] = (unsigned long long)wall_clock64(); }
#undef PG8_STAMP
#undef PG8_SA
#undef PG8_SB
#undef PG8_STAGE
#undef PG8_LDA
#undef PG8_LDB
#undef PG8_MMA
#undef PG8_WAIT_V
#undef PG8_WAIT_L
#undef PG8_BAR
#undef PG8_SCHED
}
}


DI void phase_wconv(LAS unsigned char* lds, const float* __restrict__ src, bf16_t* __restrict__ dst, int K, int N, int Npad, int bid, int nb, float q8s = 0.f, int colmap = 0) {
    LAS float* tile = (LAS float*)lds;
    const int tid = tid_opaque();
    const int tk = K / 64, tn = Npad / 64, total = tk * tn;
    for (int t = bid; t < total; t += nb) {
        const int k0 = (t % tk) * 64, n0 = (t / tk) * 64;
        __syncthreads();
        {
            const int ty = tid >> 4, tx = tid & 15;
#pragma unroll
            for (int i = 0; i < 2; ++i) {
                const int k = k0 + ty + 32 * i, n = n0 + tx * 4;
                f32x4 v = {0.f, 0.f, 0.f, 0.f};
                if (colmap) { const int ns = (n >> 7) * 256 + (colmap == 1 ? 128 : 0) + (n & 127); v = *(const f32x4*)(src + (size_t)k * (2 * N) + ns); }
                else if (n < N) v = *(const f32x4*)(src + (size_t)k * N + n);
                LAS float* p = tile + (ty + 32 * i) * 65 + tx * 4;
                p[0] = v[0]; p[1] = v[1]; p[2] = v[2]; p[3] = v[3];
            }
        }
        __syncthreads();
        {
            const int n = tid >> 3, kc = tid & 7;
            float v[8];
#pragma unroll
            for (int j = 0; j < 8; ++j) { v[j] = tile[(kc * 8 + j) * 65 + n]; if (q8s != 0.f) v[j] = emu_q8(v[j], q8s); }
            u32x4 w; w.x = pk2(v[0], v[1]); w.y = pk2(v[2], v[3]); w.z = pk2(v[4], v[5]); w.w = pk2(v[6], v[7]);
            *(u32x4*)(dst + (size_t)(n0 + n) * K + k0 + kc * 8) = w;
        }
    }
}

DI void phase_rmsnorm(const float* __restrict__ x, const float* __restrict__ gain, bf16_t* __restrict__ h, int bid, int nb, float q8s = 0.f) {
    const int tid = tid_opaque(); const int lane = tid & 63, wid = tid >> 6;
    for (int row = bid * 8 + wid; row < MTOK; row += nb * 8) {
        const float* xr = x + (size_t)row * DM;
        f32x4 v[16]; float ss = 0.f;
#pragma unroll
        for (int i = 0; i < 16; ++i) { v[i] = *(const f32x4*)(xr + (i * 64 + lane) * 4); ss += v[i][0] * v[i][0] + v[i][1] * v[i][1] + v[i][2] * v[i][2] + v[i][3] * v[i][3]; }
#pragma unroll
        for (int o = 32; o >= 1; o >>= 1) ss += __shfl_xor(ss, o);
        const float rstd = rsqrtf(ss * (1.0f / DM) + EPSN);
        bf16_t* hr = h + (size_t)row * DM;
#pragma unroll
        for (int i = 0; i < 16; ++i) { const f32x4 g = *(const f32x4*)(gain + (i * 64 + lane) * 4);
            float y0 = v[i][0] * rstd * g[0], y1 = v[i][1] * rstd * g[1], y2 = v[i][2] * rstd * g[2], y3 = v[i][3] * rstd * g[3];
            if (q8s != 0.f) { y0 = emu_q8(y0, q8s); y1 = emu_q8(y1, q8s); y2 = emu_q8(y2, q8s); y3 = emu_q8(y3, q8s); }
            u32x2 w; w.x = pk2(y0, y1); w.y = pk2(y2, y3);
            *(u32x2*)(hr + (i * 64 + lane) * 4) = w; }
    }
}

DI void ld192(const bf16_t* p, int j8, float (&v)[24]) {
#pragma unroll
    for (int c = 0; c < 3; ++c) { const u32x4 w = *(const u32x4*)(p + (j8 + 8 * c) * 8);
        v[c * 8 + 0] = bflo(w.x); v[c * 8 + 1] = bfhi(w.x); v[c * 8 + 2] = bflo(w.y); v[c * 8 + 3] = bfhi(w.y);
        v[c * 8 + 4] = bflo(w.z); v[c * 8 + 5] = bfhi(w.z); v[c * 8 + 6] = bflo(w.w); v[c * 8 + 7] = bfhi(w.w); }
}
DI void st192(bf16_t* p, int j8, const float (&v)[24]) {
#pragma unroll
    for (int c = 0; c < 3; ++c) { u32x4 w; w.x = pk2(v[c * 8 + 0], v[c * 8 + 1]); w.y = pk2(v[c * 8 + 2], v[c * 8 + 3]); w.z = pk2(v[c * 8 + 4], v[c * 8 + 5]); w.w = pk2(v[c * 8 + 6], v[c * 8 + 7]);
        *(u32x4*)(p + (j8 + 8 * c) * 8) = w; }
}
DI float sum8(float s) { s += __shfl_xor(s, 1); s += __shfl_xor(s, 2); s += __shfl_xor(s, 4); return s; }

DI void phase_nsa_prep(const Params& P, int bid, int nb) {
    bf16_t* Y0 = (bf16_t*)(P.ws + OFF_Y0);
    bf16_t* KS = (bf16_t*)(P.ws + OFF_KS); bf16_t* KW = (bf16_t*)(P.ws + OFF_KW);
    bf16_t* ACK = (bf16_t*)(P.ws + OFF_ACK); bf16_t* ACV = (bf16_t*)(P.ws + OFF_ACV);
    const int tid = tid_opaque(), grp = (tid >> 3) & 15, j8 = tid & 7;
    for (int tok = bid * 4 + (tid >> 7); tok < MTOK; tok += nb * 4) {
        const int b = tok / SEQ, s = tok % SEQ;
        bf16_t* yr = Y0 + (size_t)tok * N1P;
        if (grp < 8) {
            const int g = grp & 3, br = grp >> 2;
            float v[24]; ld192(yr + (br ? C_KVW : C_KVS) + g * DK, j8, v);
            float ss = 0.f;
#pragma unroll
            for (int i = 0; i < 24; ++i) ss += v[i] * v[i];
            ss = sum8(ss);
            const float rstd = rsqrtf(ss * (1.0f / DK) + EPSN);
            const float* kn = P.nsa_k_norm + (br ? 2 : 1) * DK;
#pragma unroll
            for (int c = 0; c < 3; ++c)
#pragma unroll
                for (int e = 0; e < 8; ++e) v[c * 8 + e] *= rstd * kn[(j8 + 8 * c) * 8 + e];
            st192((br ? KW : KS) + ((size_t)(b * NG + g) * SEQ + s) * DK, j8, v);
        } else if (grp < 12) {
            const int g = grp - 8;
            float v[24]; ld192(yr + C_KVC + g * DK, j8, v);
#pragma unroll
            for (int k = 0; k < 2; ++k) {
                const int n = (s >> 4) - k, l = s - 16 * n;
                if (n >= 0 && n <= 254) {
                    float w[24];
#pragma unroll
                    for (int c = 0; c < 3; ++c)
#pragma unroll
                        for (int e = 0; e < 8; ++e) w[c * 8 + e] = v[c * 8 + e] + P.pe_k[l * DK + (j8 + 8 * c) * 8 + e];
                    st192(ACK + ((size_t)((b * NG + g) * 256 + n)) * 6144 + l * DK, j8, w);
                }
            }
        } else if (grp < 16) {
            const int g = grp - 12;
            const bf16_t* src = yr + C_KVC + NG * DK + g * DV;
            float v[16];
#pragma unroll
            for (int c = 0; c < 2; ++c) { const u32x4 w = *(const u32x4*)(src + (j8 + 8 * c) * 8);
                v[c * 8 + 0] = bflo(w.x); v[c * 8 + 1] = bfhi(w.x); v[c * 8 + 2] = bflo(w.y); v[c * 8 + 3] = bfhi(w.y);
                v[c * 8 + 4] = bflo(w.z); v[c * 8 + 5] = bfhi(w.z); v[c * 8 + 6] = bflo(w.w); v[c * 8 + 7] = bfhi(w.w); }
#pragma unroll
            for (int k = 0; k < 2; ++k) {
                const int n = (s >> 4) - k, l = s - 16 * n;
                if (n >= 0 && n <= 254) {
                    bf16_t* dst = ACV + ((size_t)((b * NG + g) * 256 + n)) * 4096 + l * DV;
#pragma unroll
                    for (int c = 0; c < 2; ++c) { float w[8];
#pragma unroll
                        for (int e = 0; e < 8; ++e) w[e] = v[c * 8 + e] + P.pe_v[l * DV + (j8 + 8 * c) * 8 + e];
                        u32x4 o; o.x = pk2(w[0], w[1]); o.y = pk2(w[2], w[3]); o.z = pk2(w[4], w[5]); o.w = pk2(w[6], w[7]);
                        *(u32x4*)(dst + (j8 + 8 * c) * 8) = o; }
                }
            }
        }
    }
    for (int i = bid * 512 + tid; i < 16 * (6144 + 4096) / 8; i += nb * 512) {
        const int per = (6144 + 4096) / 8, bg = i / per, c = i % per;
        const u32x4 z = {0u, 0u, 0u, 0u};
        if (c < 6144 / 8) *(u32x4*)(ACK + ((size_t)(bg * 256 + 255)) * 6144 + c * 8) = z;
        else *(u32x4*)(ACV + ((size_t)(bg * 256 + 255)) * 4096 + (c - 6144 / 8) * 8) = z;
    }
}

DI int swap23(int p) { return (p & ~0xC) | ((p & 4) << 1) | ((p & 8) >> 1); }
DI void phase_vt(LAS unsigned char* lds, const bf16_t* __restrict__ src, size_t src_stride, int col0, int col_step, int nhv, bf16_t* __restrict__ dst, int bid, int nb) {
    LAS bf16_t* tile = (LAS bf16_t*)lds;
    const int tid = tid_opaque();
    const int ntile = SEQ / 64, total = BATCH * nhv * ntile;
    for (int it = bid; it < total; it += nb) {
        const int mat = it / ntile, tt = it % ntile, b = mat / nhv, hv = mat % nhv;
        __syncthreads();
#pragma unroll
        for (int i = 0; i < 2; ++i) {
            const int q = tid + 512 * i, tok = q >> 4, ch = q & 15;
            const u32x4 w = *(const u32x4*)(src + (size_t)(b * SEQ + tt * 64 + tok) * src_stride + col0 + hv * col_step + ch * 8);
            *(LAS u32x4*)(tile + tok * 136 + ch * 8) = w;
        }
        __syncthreads();
        {
            const int dv = tid >> 2, kq = tid & 3;
            unsigned w[8];
#pragma unroll
            for (int e = 0; e < 8; ++e) {
                const int p0 = kq * 16 + 2 * e, p1 = p0 + 1;
                const int k0 = (p0 & ~15) | swap23(p0 & 15), k1 = (p1 & ~15) | swap23(p1 & 15);
                w[e] = (unsigned)tile[k0 * 136 + dv] | ((unsigned)tile[k1 * 136 + dv] << 16);
            }
            bf16_t* d = dst + ((size_t)mat * DV + dv) * SEQ + tt * 64 + kq * 16;
            u32x4 a = {w[0], w[1], w[2], w[3]}, c = {w[4], w[5], w[6], w[7]};
            *(u32x4*)d = a; *(u32x4*)(d + 8) = c;
        }
    }
}

DI void phase_cmp2(LAS unsigned char* lds, const Params& P, int bid, int nb) {
    LAS float* sk = (LAS float*)lds;
    LAS float* sv = sk + 192;
    LAS float* red = sv + 128;
    const float* HIDK = (const float*)(P.ws + OFF_HIDK); const float* HIDV = (const float*)(P.ws + OFF_HIDV);
    bf16_t* KC = (bf16_t*)(P.ws + OFF_KC); bf16_t* VTC = (bf16_t*)(P.ws + OFF_VTC);
    const int tid = tid_opaque(), lane = tid & 63, wid = tid >> 6;
    for (int m = bid; m < 4096; m += nb) {
        const int n = m & 255, bg = m >> 8;
        __syncthreads();
        if (tid < 192) { const float h = HIDK[(size_t)m * 256 + tid]; sk[tid] = h / (1.0f + __expf(-h)); }
        else if (tid < 320) { const float h = HIDV[(size_t)m * 256 + tid - 192]; sv[tid - 192] = h / (1.0f + __expf(-h)); }
        __syncthreads();
        float acc = 0.f;
        if (tid < 192) { for (int i = 0; i < 192; ++i) acc += sk[i] * P.w2_k[i * 192 + tid]; }
        else if (tid < 320) { const int j = tid - 192; for (int i = 0; i < 128; ++i) acc += sv[i] * P.w2_v[i * 128 + j]; }
        float ss = (tid < 192) ? acc * acc : 0.f;
#pragma unroll
        for (int o = 32; o >= 1; o >>= 1) ss += __shfl_xor(ss, o);
        if (lane == 0) red[wid] = ss;
        __syncthreads();
        const float tot = red[0] + red[1] + red[2];
        const float rstd = rsqrtf(tot * (1.0f / DK) + EPSN);
        if (tid < 192) { const float o = (n == 255) ? 0.f : acc * rstd * P.nsa_k_norm[tid];
            KC[(size_t)m * DK + tid] = (bf16_t)(pk2(o, 0.f) & 0xffffu); }
        else if (tid < 320) { const int j = tid - 192; const float o = (n == 255) ? 0.f : acc;
            const int pn = (n & ~15) | swap23(n & 15);
            VTC[((size_t)bg * DV + j) * 256 + pn] = (bf16_t)(pk2(o, 0.f) & 0xffffu); }
    }
}

DI void phase_mla_prep1(const Params& P, int bid, int nb) {
    const bf16_t* Y1 = (const bf16_t*)(P.ws + OFF_Y1);
    bf16_t* CQN = (bf16_t*)(P.ws + OFF_CQN); bf16_t* CKVN = (bf16_t*)(P.ws + OFF_CKVN); float* ROPE = (float*)(P.ws + OFF_ROPE);
    const int tid = tid_opaque(); const int lane = tid & 63, wid = tid >> 6;
    for (int tok = bid * 8 + wid; tok < MTOK; tok += nb * 8) {
        const bf16_t* yr = Y1 + (size_t)tok * N3P;
        {
            float v[24]; float ss = 0.f;
#pragma unroll
            for (int c = 0; c < 3; ++c) { const u32x4 w = *(const u32x4*)(yr + C3_CQ + (c * 64 + lane) * 8);
                v[c * 8 + 0] = bflo(w.x); v[c * 8 + 1] = bfhi(w.x); v[c * 8 + 2] = bflo(w.y); v[c * 8 + 3] = bfhi(w.y);
                v[c * 8 + 4] = bflo(w.z); v[c * 8 + 5] = bfhi(w.z); v[c * 8 + 6] = bflo(w.w); v[c * 8 + 7] = bfhi(w.w); }
#pragma unroll
            for (int i = 0; i < 24; ++i) ss += v[i] * v[i];
#pragma unroll
            for (int o = 32; o >= 1; o >>= 1) ss += __shfl_xor(ss, o);
            const float rstd = rsqrtf(ss * (1.0f / QLORA) + EPSN);
#pragma unroll
            for (int c = 0; c < 3; ++c) { const float* g = P.mla_q_a_norm + (c * 64 + lane) * 8; u32x4 w;
                w.x = pk2(v[c * 8 + 0] * rstd * g[0], v[c * 8 + 1] * rstd * g[1]); w.y = pk2(v[c * 8 + 2] * rstd * g[2], v[c * 8 + 3] * rstd * g[3]);
                w.z = pk2(v[c * 8 + 4] * rstd * g[4], v[c * 8 + 5] * rstd * g[5]); w.w = pk2(v[c * 8 + 6] * rstd * g[6], v[c * 8 + 7] * rstd * g[7]);
                *(u32x4*)(CQN + (size_t)tok * QLORA + (c * 64 + lane) * 8) = w; }
        }
        {
            float v[8]; float ss = 0.f;
            const u32x4 w0 = *(const u32x4*)(yr + C3_CKV + lane * 8);
            v[0] = bflo(w0.x); v[1] = bfhi(w0.x); v[2] = bflo(w0.y); v[3] = bfhi(w0.y); v[4] = bflo(w0.z); v[5] = bfhi(w0.z); v[6] = bflo(w0.w); v[7] = bfhi(w0.w);
#pragma unroll
            for (int i = 0; i < 8; ++i) ss += v[i] * v[i];
#pragma unroll
            for (int o = 32; o >= 1; o >>= 1) ss += __shfl_xor(ss, o);
            const float rstd = rsqrtf(ss * (1.0f / KVLORA) + EPSN);
            const float* g = P.mla_kv_a_norm + lane * 8; u32x4 w;
            w.x = pk2(v[0] * rstd * g[0], v[1] * rstd * g[1]); w.y = pk2(v[2] * rstd * g[2], v[3] * rstd * g[3]);
            w.z = pk2(v[4] * rstd * g[4], v[5] * rstd * g[5]); w.w = pk2(v[6] * rstd * g[6], v[7] * rstd * g[7]);
            *(u32x4*)(CKVN + (size_t)tok * KVLORA + lane * 8) = w;
        }
        if (lane < 32) {
            const float invf = exp2f(-(float)lane * (13.287712379549449f / 32.0f));
            const float ang = (float)P.pos[tok] * invf;
            float sn, cs; sincosf(ang, &sn, &cs);
            ROPE[(size_t)tok * 64 + lane] = cs; ROPE[(size_t)tok * 64 + 32 + lane] = sn;
            const float x1 = bf1(yr[C3_KPE + lane]), x2 = bf1(yr[C3_KPE + 32 + lane]);
            float ssp = x1 * x1 + x2 * x2;
#pragma unroll
            for (int o = 16; o >= 1; o >>= 1) ssp += __shfl_xor(ssp, o);
            const float a = x1 * P.mla_k_norm[128 + lane], c = x2 * P.mla_k_norm[160 + lane];
            float* KPER = (float*)(P.ws + OFF_KPER); float* SSPE = (float*)(P.ws + OFF_SSPE);
            KPER[(size_t)tok * 64 + lane] = a * cs - c * sn; KPER[(size_t)tok * 64 + 32 + lane] = c * cs + a * sn;
            if (lane == 0) SSPE[tok] = ssp;
        }
    }
}

DI void phase_mla_prep2(const Params& P, int bid, int nb) {
    const bf16_t* KNM = (const bf16_t*)(P.ws + OFF_KNM); const bf16_t* Y1 = (const bf16_t*)(P.ws + OFF_Y1);
    bf16_t* KM = (bf16_t*)(P.ws + OFF_KM); const float* ROPE = (const float*)(P.ws + OFF_ROPE);
    const int tid = tid_opaque(), grp = tid >> 3, j8 = tid & 7;
    for (int tok = bid; tok < MTOK; tok += nb) {
        const int b = tok / SEQ, s = tok % SEQ;
        float cs[8], sn[8];
#pragma unroll
        for (int e = 0; e < 8; ++e) { const int i = (8 * j8 + e) & 31; cs[e] = ROPE[(size_t)tok * 64 + i]; sn[e] = ROPE[(size_t)tok * 64 + 32 + i]; }
        {
            const bf16_t* kn = KNM + (size_t)tok * (NH * 128) + grp * 128;
            const bf16_t* kp = Y1 + (size_t)tok * N3P + C3_KPE;
            float v[24];
#pragma unroll
            for (int c = 0; c < 2; ++c) { const u32x4 w = *(const u32x4*)(kn + (j8 + 8 * c) * 8);
                v[c * 8 + 0] = bflo(w.x); v[c * 8 + 1] = bfhi(w.x); v[c * 8 + 2] = bflo(w.y); v[c * 8 + 3] = bfhi(w.y);
                v[c * 8 + 4] = bflo(w.z); v[c * 8 + 5] = bfhi(w.z); v[c * 8 + 6] = bflo(w.w); v[c * 8 + 7] = bfhi(w.w); }
            { const u32x4 w = *(const u32x4*)(kp + j8 * 8);
                v[16] = bflo(w.x); v[17] = bfhi(w.x); v[18] = bflo(w.y); v[19] = bfhi(w.y); v[20] = bflo(w.z); v[21] = bfhi(w.z); v[22] = bflo(w.w); v[23] = bfhi(w.w); }
            float ss = 0.f;
#pragma unroll
            for (int i = 0; i < 24; ++i) ss += v[i] * v[i];
            ss = sum8(ss);
            const float rstd = rsqrtf(ss * (1.0f / DK) + EPSN);
#pragma unroll
            for (int c = 0; c < 3; ++c)
#pragma unroll
                for (int e = 0; e < 8; ++e) v[c * 8 + e] *= rstd * P.mla_k_norm[(j8 + 8 * c) * 8 + e];
#pragma unroll
            for (int e = 0; e < 8; ++e) { const float mine = v[16 + e], other = __shfl_xor(mine, 4);
                v[16 + e] = (j8 < 4) ? (mine * cs[e] - other * sn[e]) : (mine * cs[e] + other * sn[e]); }
            st192(KM + ((size_t)(b * NH + grp) * SEQ + s) * DK, j8, v);
        }
    }
}
#ifndef NO_CMP1
#define NO_CMP1 0
#endif
#ifndef NO_CMP2
#define NO_CMP2 0
#endif
#ifndef NO_SEL
#define NO_SEL 0
#endif
#ifndef NO_WIN
#define NO_WIN 0
#endif
#ifndef PROBE_SEL2
#define PROBE_SEL2 0
#endif
#ifndef PROBE_WIN2
#define PROBE_WIN2 0
#endif
#ifndef ATT_THR
#define ATT_THR 30.0f
#endif
#ifndef ATT_DEP_MLA
#define ATT_DEP_MLA 5
#endif
#ifndef ATT_DEP_NSA
#define ATT_DEP_NSA 4
#endif
#ifndef ATT_SPLIT_NSA
#define ATT_SPLIT_NSA 0
#endif
#ifndef ATT_KA_NSA
#define ATT_KA_NSA 2
#endif
constexpr int KT_BYTES = 64 * 384, VT_BYTES = 128 * 128;
constexpr int L_K = 0, L_V = 2 * KT_BYTES, L_LUT = L_V + 2 * VT_BYTES, LUT_PITCH = 129, L_QS = L_LUT + 64 * LUT_PITCH * 4 + 16  , L_P3 = L_QS + 16 * 64 * 4, L_END = L_P3 + 16 * 64 * 4;
static_assert(L_END <= 131072, "attention LDS");
enum { MODE_MLA = 0, MODE_CMP1 = 1, MODE_CMP2 = 2, MODE_SEL = 3, MODE_WIN = 4 };
#define MFMA32(a, b, c) __builtin_amdgcn_mfma_f32_32x32x16_bf16((a), (b), (c), 0, 0, 0)

struct AttnLane {
    int tq;
    int tw0, tw1;
    const LAS float* lutrow;
    float lut_far;
    unsigned long long mk0, mk1;
    int tk;
    int curblk;
    float inv_l;
    int tokidx;
};

template <int MODE> DI bool tile_act(int j, const AttnLane& A) {
    if (MODE == MODE_MLA) return 64 * j <= A.tw1;
    else if (MODE == MODE_CMP1 || MODE == MODE_CMP2) return 1024 * j + 31 <= A.tw1;
    else if (MODE == MODE_SEL) return (((A.mk0 | A.mk1) >> j) & 1ull) != 0ull;
    else return (64 * j <= A.tw1) && (64 * j + 63 >= A.tw0 - 511);
}

template <int MODE, int H>
DI void half_init(f32x16& p, int j, int hi, float m_run, const AttnLane& A) {
    if (MODE == MODE_MLA) {
        const float v = -m_run;
#pragma unroll
        for (int r = 0; r < 16; ++r) p[r] = v;
    } else if (MODE == MODE_WIN || MODE == MODE_SEL) {
        const int dq = A.tq - 64 * j - 32 * H - 4 * hi;
        const bool far = (A.tw0 - (64 * j + 32 * H + 31) >= 113);
        if (far) { const float v = A.lut_far - m_run;
#pragma unroll
            for (int r = 0; r < 16; ++r) p[r] = v;
        } else {
#pragma unroll
            for (int r = 0; r < 16; ++r) { int d = dq - ((r & 3) + 8 * (r >> 2)); d = d < 0 ? 0 : (d > 127 ? 127 : d); p[r] = A.lutrow[d] - m_run; }
        }
    } else {
        const int dq = A.tq - 31 - 1024 * j - 512 * H - 64 * hi;
        const bool far = (A.tw0 - 31 - 16 * (64 * j + 32 * H + 31) >= 113);
        if (far) { const float v = A.lut_far - m_run;
#pragma unroll
            for (int r = 0; r < 16; ++r) p[r] = v;
        } else {
#pragma unroll
            for (int r = 0; r < 16; ++r) { int d = dq - 16 * ((r & 3) + 8 * (r >> 2)); d = d < 0 ? 0 : (d > 127 ? 127 : d); p[r] = A.lutrow[d] - m_run; }
        }
    }
}
template <int MODE, int H>
DI void half_mask(f32x16& p, int j, int hi, const AttnLane& A) {
    const float NEG = -__builtin_inff();
    if (MODE == MODE_MLA) {
        if (64 * j + 32 * H + 31 > A.tw0) {
            const int dq = A.tq - 64 * j - 32 * H - 4 * hi;
#pragma unroll
            for (int r = 0; r < 16; ++r) p[r] = (dq - ((r & 3) + 8 * (r >> 2)) < 0) ? NEG : p[r];
        }
    } else if (MODE == MODE_WIN) {
        const int dq = A.tq - 64 * j - 32 * H - 4 * hi;
#pragma unroll
        for (int r = 0; r < 16; ++r) p[r] = ((unsigned)(dq - ((r & 3) + 8 * (r >> 2))) >= 512u) ? NEG : p[r];
    } else if (MODE == MODE_SEL) {
        const int dq = A.tq - 64 * j - 32 * H - 4 * hi;
        const bool s0_ = ((A.mk0 >> j) & 1ull) != 0ull, s1_ = ((A.mk1 >> j) & 1ull) != 0ull; const bool sel = A.tk ? s1_ : s0_;
        const int lim = !sel ? -1 : ((j == A.curblk) ? dq : 4096);
#pragma unroll
        for (int r = 0; r < 16; ++r) p[r] = (lim - ((r & 3) + 8 * (r >> 2)) < 0) ? NEG : p[r];
    } else {
        const int dq = A.tq - 31 - 1024 * j - 512 * H - 64 * hi;
#pragma unroll
        for (int r = 0; r < 16; ++r) p[r] = (dq - 16 * ((r & 3) + 8 * (r >> 2)) < 0) ? NEG : p[r];
    }
}
template <int H, int DEP>
DI void half_qk(f32x16& p, const LAS unsigned char* kb, const int (&kbase)[4], const bf16x8 (&q)[12]) {
    bf16x8 f[DEP + 1];
#pragma unroll
    for (int d0 = 0; d0 < DEP; ++d0) f[d0] = *(const LAS bf16x8*)(kb + kbase[d0 & 3] + (d0 >> 2) * 128 + H * (32 * 384));
    __builtin_amdgcn_sched_barrier(0);
#pragma unroll
    for (int d0 = 0; d0 < 12; ++d0) {
        if (d0 + DEP < 12) { const int dn = d0 + DEP; f[dn % (DEP + 1)] = *(const LAS bf16x8*)(kb + kbase[dn & 3] + (dn >> 2) * 128 + H * (32 * 384)); }
        __builtin_amdgcn_sched_barrier(0);
        p = MFMA32(f[d0 % (DEP + 1)], q[d0], p);
        __builtin_amdgcn_sched_barrier(0);
    }
}
DI unsigned sm_pair(const f32x16& p, int e0, float& ps, float& mx) {
    const float a = __builtin_amdgcn_exp2f(p[e0]), b = __builtin_amdgcn_exp2f(p[e0 + 1]);
    ps += a + b; mx = fmaxf(mx, fmaxf(p[e0], p[e0 + 1]));
    return pk2(a, b);
}
template <bool HASV>
DI void half_exact(f32x16& p, f32x16* pend, f32x16 (&o)[4], float& m_run, float& l_run, u32x4& wa, u32x4& wb, float& ps) {
    float mx = p[0];
#pragma unroll
    for (int r = 1; r < 16; ++r) mx = fmaxf(mx, p[r]);
    mx = fmaxf(mx, __shfl_xor(mx, 32));
    const float dl = fmaxf(mx, 0.f);
    const float alpha = __builtin_amdgcn_exp2f(-dl);
    m_run += dl; l_run *= alpha;
    if (HASV) {
#pragma unroll
        for (int d = 0; d < 4; ++d)
#pragma unroll
            for (int r = 0; r < 16; ++r) o[d][r] *= alpha;
    }
    if (pend) {
#pragma unroll
        for (int r = 0; r < 16; ++r) (*pend)[r] -= dl;
    }
    ps = 0.f; float dm = 0.f;
#pragma unroll
    for (int r = 0; r < 16; ++r) p[r] -= dl;
    wa.x = sm_pair(p, 0, ps, dm); wa.y = sm_pair(p, 2, ps, dm); wa.z = sm_pair(p, 4, ps, dm); wa.w = sm_pair(p, 6, ps, dm);
    wb.x = sm_pair(p, 8, ps, dm); wb.y = sm_pair(p, 10, ps, dm); wb.z = sm_pair(p, 12, ps, dm); wb.w = sm_pair(p, 14, ps, dm);
}

template <int MODE>
DI void attn_tile2(const LAS unsigned char* kb, const LAS unsigned char* vb, LAS unsigned char* lds, int j, int lane, const bf16x8 (&q)[12],
                   f32x16 (&o)[4], float& m_run, float& l_run, const AttnLane& A) {
    constexpr bool HASV = (MODE != MODE_CMP1);
    constexpr int DEP = (MODE == MODE_MLA) ? ATT_DEP_MLA : ATT_DEP_NSA;
    const int hi = lane >> 5, r32 = lane & 31;
    int kbase[4], vbase[4];
#pragma unroll
    for (int dd = 0; dd < 4; ++dd) { kbase[dd] = r32 * 384 + (((2 * dd + hi) ^ ((r32 >> 1) & 7)) << 4); vbase[dd] = r32 * 128 + (((2 * dd + hi) ^ ((r32 >> 1) & 7)) << 4); }
    f32x16 p0, p1;
    if (MODE == MODE_CMP2) {
        half_init<MODE, 0>(p0, j, hi, m_run, A); half_qk<0, DEP>(p0, kb, kbase, q); half_mask<MODE, 0>(p0, j, hi, A);
        half_init<MODE, 1>(p1, j, hi, m_run, A); half_qk<1, DEP>(p1, kb, kbase, q); half_mask<MODE, 1>(p1, j, hi, A);
        const float il = A.inv_l;
#pragma unroll
        for (int r = 0; r < 16; ++r) { p0[r] = __builtin_amdgcn_exp2f(p0[r]) * il; p1[r] = __builtin_amdgcn_exp2f(p1[r]) * il; }
        float v[16];
#pragma unroll
        for (int k = 0; k < 4; ++k) { v[k] = (p0[4 * k] + p0[4 * k + 1]) + (p0[4 * k + 2] + p0[4 * k + 3]); v[4 + k] = (p1[4 * k] + p1[4 * k + 1]) + (p1[4 * k + 2] + p1[4 * k + 3]);
            v[8 + k] = p0[4 * k + 3]; v[12 + k] = p1[4 * k + 3]; }
        { const bool up = (lane & 8) != 0;
#pragma unroll
          for (int i = 0; i < 8; ++i) { const float send = up ? v[i] : v[i + 8]; const float recv = __shfl_xor(send, 8); const float keep = up ? v[i + 8] : v[i]; v[i] = keep + recv; } }
        { const bool up = (lane & 4) != 0;
#pragma unroll
          for (int i = 0; i < 4; ++i) { const float send = up ? v[i] : v[i + 4]; const float recv = __shfl_xor(send, 4); const float keep = up ? v[i + 4] : v[i]; v[i] = keep + recv; } }
        { const bool up = (lane & 2) != 0;
#pragma unroll
          for (int i = 0; i < 2; ++i) { const float send = up ? v[i] : v[i + 2]; const float recv = __shfl_xor(send, 2); const float keep = up ? v[i + 2] : v[i]; v[i] = keep + recv; } }
        { const bool up = (lane & 1) != 0;
          const float send = up ? v[0] : v[1]; const float recv = __shfl_xor(send, 1); const float keep = up ? v[1] : v[0]; v[0] = keep + recv; }
        { const int idx = lane & 15, half = (idx >> 2) & 1, k = idx & 3, isp3 = idx >> 3;
          const int quad = 16 * j + 8 * half + 2 * k + hi;
          LAS float* dst = (LAS float*)(lds + (isp3 ? L_P3 : L_QS)) + A.tokidx * 64 + quad;
          *dst = v[0]; }
#pragma unroll
        for (int ks = 0; ks < 4; ++ks) {
            u32x4 w;
            if (ks == 0) { w.x = pk2(p0[0], p0[1]); w.y = pk2(p0[2], p0[3]); w.z = pk2(p0[4], p0[5]); w.w = pk2(p0[6], p0[7]); }
            else if (ks == 1) { w.x = pk2(p0[8], p0[9]); w.y = pk2(p0[10], p0[11]); w.z = pk2(p0[12], p0[13]); w.w = pk2(p0[14], p0[15]); }
            else if (ks == 2) { w.x = pk2(p1[0], p1[1]); w.y = pk2(p1[2], p1[3]); w.z = pk2(p1[4], p1[5]); w.w = pk2(p1[6], p1[7]); }
            else { w.x = pk2(p1[8], p1[9]); w.y = pk2(p1[10], p1[11]); w.z = pk2(p1[12], p1[13]); w.w = pk2(p1[14], p1[15]); }
            const bf16x8 pb = __builtin_bit_cast(bf16x8, w);
#pragma unroll
            for (int d = 0; d < 4; ++d) { const bf16x8 va = *(const LAS bf16x8*)(vb + vbase[ks] + d * (32 * 128)); o[d] = MFMA32(va, pb, o[d]); }
        }
        return;
    }
    u32x4 wa, wb; float ps = 0.f, mx = -__builtin_inff();
    if (MODE == MODE_MLA || ATT_SPLIT_NSA) {
    half_init<MODE, 0>(p0, j, hi, m_run, A);
    half_qk<0, DEP>(p0, kb, kbase, q);
    half_mask<MODE, 0>(p0, j, hi, A);
    half_init<MODE, 1>(p1, j, hi, m_run, A);
    {
        bf16x8 f[DEP + 1];
#pragma unroll
        for (int d0 = 0; d0 < DEP; ++d0) f[d0] = *(const LAS bf16x8*)(kb + kbase[d0 & 3] + (d0 >> 2) * 128 + 32 * 384);
        __builtin_amdgcn_sched_barrier(0);
#pragma unroll
        for (int d0 = 0; d0 < 12; ++d0) {
            if (d0 + DEP < 12) { const int dn = d0 + DEP; f[dn % (DEP + 1)] = *(const LAS bf16x8*)(kb + kbase[dn & 3] + (dn >> 2) * 128 + 32 * 384); }
            __builtin_amdgcn_sched_barrier(0);
            p1 = MFMA32(f[d0 % (DEP + 1)], q[d0], p1);
            if (d0 == 0) wa.x = sm_pair(p0, 0, ps, mx); else if (d0 == 1) wa.y = sm_pair(p0, 2, ps, mx); else if (d0 == 2) wa.z = sm_pair(p0, 4, ps, mx); else if (d0 == 3) wa.w = sm_pair(p0, 6, ps, mx);
            else if (d0 == 4) wb.x = sm_pair(p0, 8, ps, mx); else if (d0 == 5) wb.y = sm_pair(p0, 10, ps, mx); else if (d0 == 6) wb.z = sm_pair(p0, 12, ps, mx); else if (d0 == 7) wb.w = sm_pair(p0, 14, ps, mx);
            __builtin_amdgcn_sched_barrier(0);
        }
    }
    } else {
    half_init<MODE, 0>(p0, j, hi, m_run, A);
    half_init<MODE, 1>(p1, j, hi, m_run, A);
    {
        constexpr int KA = ATT_KA_NSA;
        bf16x8 fa[KA + 1], fb[KA + 1];
#pragma unroll
        for (int d0 = 0; d0 < KA; ++d0) { const LAS unsigned char* a_ = kb + kbase[d0 & 3] + (d0 >> 2) * 128; fa[d0] = *(const LAS bf16x8*)a_; fb[d0] = *(const LAS bf16x8*)(a_ + 32 * 384); }
        __builtin_amdgcn_sched_barrier(0);
#pragma unroll
        for (int d0 = 0; d0 < 12; ++d0) {
            if (d0 + KA < 12) { const int dn = d0 + KA; const LAS unsigned char* a_ = kb + kbase[dn & 3] + (dn >> 2) * 128;
                fa[dn % (KA + 1)] = *(const LAS bf16x8*)a_; fb[dn % (KA + 1)] = *(const LAS bf16x8*)(a_ + 32 * 384); }
            __builtin_amdgcn_sched_barrier(0);
            p0 = MFMA32(fa[d0 % (KA + 1)], q[d0], p0);
            p1 = MFMA32(fb[d0 % (KA + 1)], q[d0], p1);
            __builtin_amdgcn_sched_barrier(0);
        }
    }
    half_mask<MODE, 0>(p0, j, hi, A);
    wa.x = sm_pair(p0, 0, ps, mx); wa.y = sm_pair(p0, 2, ps, mx); wa.z = sm_pair(p0, 4, ps, mx); wa.w = sm_pair(p0, 6, ps, mx);
    wb.x = sm_pair(p0, 8, ps, mx); wb.y = sm_pair(p0, 10, ps, mx); wb.z = sm_pair(p0, 12, ps, mx); wb.w = sm_pair(p0, 14, ps, mx);
    }
    half_mask<MODE, 1>(p1, j, hi, A);
    if (__any(mx > ATT_THR)) {
        half_exact<HASV>(p0, &p1, o, m_run, l_run, wa, wb, ps);
    }
    l_run += ps;
    u32x4 wc, wd; float ps1 = 0.f, mx1 = -__builtin_inff();
    if (HASV) {
        const bf16x8 pba = __builtin_bit_cast(bf16x8, wa), pbb = __builtin_bit_cast(bf16x8, wb);
        bf16x8 f[DEP + 1];
#pragma unroll
        for (int i = 0; i < DEP; ++i) f[i] = *(const LAS bf16x8*)(vb + vbase[i >> 2] + (i & 3) * (32 * 128));
        __builtin_amdgcn_sched_barrier(0);
#pragma unroll
        for (int i = 0; i < 8; ++i) {
            if (i + DEP < 8) { const int in_ = i + DEP; f[in_ % (DEP + 1)] = *(const LAS bf16x8*)(vb + vbase[in_ >> 2] + (in_ & 3) * (32 * 128)); }
            __builtin_amdgcn_sched_barrier(0);
            o[i & 3] = MFMA32(f[i % (DEP + 1)], (i < 4) ? pba : pbb, o[i & 3]);
            if (i == 0) wc.x = sm_pair(p1, 0, ps1, mx1); else if (i == 1) wc.y = sm_pair(p1, 2, ps1, mx1); else if (i == 2) wc.z = sm_pair(p1, 4, ps1, mx1); else if (i == 3) wc.w = sm_pair(p1, 6, ps1, mx1);
            else if (i == 4) wd.x = sm_pair(p1, 8, ps1, mx1); else if (i == 5) wd.y = sm_pair(p1, 10, ps1, mx1); else if (i == 6) wd.z = sm_pair(p1, 12, ps1, mx1); else wd.w = sm_pair(p1, 14, ps1, mx1);
            __builtin_amdgcn_sched_barrier(0);
        }
    } else {
        wc.x = sm_pair(p1, 0, ps1, mx1); wc.y = sm_pair(p1, 2, ps1, mx1); wc.z = sm_pair(p1, 4, ps1, mx1); wc.w = sm_pair(p1, 6, ps1, mx1);
        wd.x = sm_pair(p1, 8, ps1, mx1); wd.y = sm_pair(p1, 10, ps1, mx1); wd.z = sm_pair(p1, 12, ps1, mx1); wd.w = sm_pair(p1, 14, ps1, mx1);
    }
    if (__any(mx1 > ATT_THR)) {
        half_exact<HASV>(p1, nullptr, o, m_run, l_run, wc, wd, ps1);
    }
    l_run += ps1;
    if (HASV) {
        const bf16x8 pbc = __builtin_bit_cast(bf16x8, wc), pbd = __builtin_bit_cast(bf16x8, wd);
        bf16x8 f[DEP + 1];
#pragma unroll
        for (int i = 0; i < DEP; ++i) f[i] = *(const LAS bf16x8*)(vb + vbase[2 + (i >> 2)] + (i & 3) * (32 * 128));
        __builtin_amdgcn_sched_barrier(0);
#pragma unroll
        for (int i = 0; i < 8; ++i) {
            if (i + DEP < 8) { const int in_ = i + DEP; f[in_ % (DEP + 1)] = *(const LAS bf16x8*)(vb + vbase[2 + (in_ >> 2)] + (in_ & 3) * (32 * 128)); }
            __builtin_amdgcn_sched_barrier(0);
            o[i & 3] = MFMA32(f[i % (DEP + 1)], (i < 4) ? pbc : pbd, o[i & 3]);
            __builtin_amdgcn_sched_barrier(0);
        }
    }
}

template <int MODE>
DI void attn_pass2(LAS unsigned char* lds, const char* __restrict__ Kc, const char* __restrict__ Vc, int vt_stride, int j_lo, int j_hi,
                   const bf16x8 (&q)[12], f32x16 (&o)[4], float& m_run, float& l_run, const AttnLane& A) {
    if (j_lo >= j_hi) return;
    constexpr bool HASV = (MODE != MODE_CMP1);
    int tid = threadIdx.x; asm volatile("" : "+v"(tid));
    const int lane = tid & 63;
    const int wid_ = __builtin_amdgcn_readfirstlane(tid >> 6);
#define ST_ISSUE(j, buf) do { int ln_ = lane; asm volatile("" : "+v"(ln_)); \
        const char* kp_ = Kc + (size_t)(j) * KT_BYTES; LAS unsigned char* kb_ = lds + L_K + (buf) * KT_BYTES + wid_ * 3072; \
        _Pragma("unroll") for (int i_ = 0; i_ < 3; ++i_) { const int pidx_ = (wid_ * 3 + i_) * 64 + ln_, row_ = pidx_ / 24, cp_ = pidx_ % 24; \
            __builtin_amdgcn_global_load_lds((const unsigned*)(kp_ + (unsigned)(row_ * 384 + ((cp_ ^ ((row_ >> 1) & 7)) << 4))), (LAS unsigned*)(kb_ + i_ * 1024), 16, 0, 0); } \
        if (HASV) { const char* vp_ = Vc + (size_t)(j) * 128; LAS unsigned char* vb_ = lds + L_V + (buf) * VT_BYTES + wid_ * 2048; \
            _Pragma("unroll") for (int i_ = 0; i_ < 2; ++i_) { const int pidx_ = (wid_ * 2 + i_) * 64 + ln_, row_ = pidx_ >> 3, cp_ = pidx_ & 7; \
                __builtin_amdgcn_global_load_lds((const unsigned*)(vp_ + (unsigned)(row_ * vt_stride * 2 + ((cp_ ^ ((row_ >> 1) & 7)) << 4))), (LAS unsigned*)(vb_ + i_ * 1024), 16, 0, 0); } } } while (0)
    ST_ISSUE(j_lo, 0);
    asm volatile("s_waitcnt vmcnt(0)" ::: "memory");
    __syncthreads();
    for (int j = j_lo; j < j_hi; ++j) {
        const int cur = (j - j_lo) & 1;
        if (j + 1 < j_hi) ST_ISSUE(j + 1, cur ^ 1);
        if (tile_act<MODE>(j, A)) attn_tile2<MODE>(lds + L_K + cur * KT_BYTES, lds + L_V + cur * VT_BYTES, lds, j, lane, q, o, m_run, l_run, A);
        asm volatile("s_waitcnt vmcnt(0)" ::: "memory");
        __syncthreads();
    }
#undef ST_ISSUE
}

template <int MODE>
DI void attn_pass3(LAS unsigned char* lds, const char* __restrict__ Kc, const char* __restrict__ Vc, int vt_stride, int j_lo, int j_hi,
                   const bf16x8 (&q)[12], f32x16 (&o)[4], float& m_run, float& l_run, const AttnLane& A) {
    if (j_lo >= j_hi) return;
    constexpr bool HASV = (MODE != MODE_CMP1);
    constexpr int L3_V = 3 * KT_BYTES;
    int tid = threadIdx.x; asm volatile("" : "+v"(tid));
    const int lane = tid & 63;
    const int wid_ = __builtin_amdgcn_readfirstlane(tid >> 6);
    const int T = j_hi - j_lo;
#define ST3_ISSUE(j, slot) do { int ln_ = lane; asm volatile("" : "+v"(ln_)); \
        const char* kp_ = Kc + (size_t)(j) * KT_BYTES; LAS unsigned char* kb_ = lds + (slot) * KT_BYTES + wid_ * 3072; \
        _Pragma("unroll") for (int i_ = 0; i_ < 3; ++i_) { const int pidx_ = (wid_ * 3 + i_) * 64 + ln_, row_ = pidx_ / 24, cp_ = pidx_ % 24; \
            __builtin_amdgcn_global_load_lds((const unsigned*)(kp_ + (unsigned)(row_ * 384 + ((cp_ ^ ((row_ >> 1) & 7)) << 4))), (LAS unsigned*)(kb_ + i_ * 1024), 16, 0, 0); } \
        if (HASV) { const char* vp_ = Vc + (size_t)(j) * 128; LAS unsigned char* vb_ = lds + L3_V + (slot) * VT_BYTES + wid_ * 2048; \
            _Pragma("unroll") for (int i_ = 0; i_ < 2; ++i_) { const int pidx_ = (wid_ * 2 + i_) * 64 + ln_, row_ = pidx_ >> 3, cp_ = pidx_ & 7; \
                __builtin_amdgcn_global_load_lds((const unsigned*)(vp_ + (unsigned)(row_ * vt_stride * 2 + ((cp_ ^ ((row_ >> 1) & 7)) << 4))), (LAS unsigned*)(vb_ + i_ * 1024), 16, 0, 0); } } } while (0)
    ST3_ISSUE(j_lo, 0);
    if (T > 1) ST3_ISSUE(j_lo + 1, 1);
    int slot = 0;
    for (int t = 0; t < T; ++t) {
        const int j = j_lo + t;
        if (t + 1 < T) { if (HASV) asm volatile("s_waitcnt vmcnt(5)" ::: "memory"); else asm volatile("s_waitcnt vmcnt(3)" ::: "memory"); }
        else asm volatile("s_waitcnt vmcnt(0)" ::: "memory");
        asm volatile("" ::: "memory"); __builtin_amdgcn_s_barrier(); asm volatile("" ::: "memory");
        if (t + 2 < T) { const int s2 = (slot >= 1) ? slot - 1 : 2; ST3_ISSUE(j + 2, s2); }
        if (tile_act<MODE>(j, A)) attn_tile2<MODE>(lds + slot * KT_BYTES, lds + L3_V + slot * VT_BYTES, lds, j, lane, q, o, m_run, l_run, A);
        slot = (slot == 2) ? 0 : slot + 1;
    }
    asm volatile("" ::: "memory"); __builtin_amdgcn_s_barrier(); asm volatile("" ::: "memory");
#undef ST3_ISSUE
}

DI int t5_bucket(int n) {
    if (n < 16) return n;
    return 16 + (n >= 19) + (n >= 21) + (n >= 24) + (n >= 27) + (n >= 31) + (n >= 35) + (n >= 40) + (n >= 46) + (n >= 52) + (n >= 59) + (n >= 67) + (n >= 77) + (n >= 87) + (n >= 99) + (n >= 113);
}
DI float silu_f(float z) { return z * __builtin_amdgcn_rcpf(1.0f + __builtin_amdgcn_exp2f(-1.4426950408889634f * z)); }

constexpr int EPI_PITCH = 272, EPI_WAVE_BYTES = 32 * EPI_PITCH;
template <bool RMW, bool NSA, int Q8>
DI void attn_epilogue_t(LAS unsigned char* lds, int lane, int wid, const f32x16 (&o)[4], float scale,
                        const char* __restrict__ zbase, unsigned z0, char* __restrict__ obase, unsigned o0) {
    LAS unsigned char* sc = lds + wid * EPI_WAVE_BYTES;
    const int r32 = lane & 31, hi = lane >> 5;
#pragma unroll
    for (int h = 0; h < 2; ++h) {
#pragma unroll
        for (int dd = 0; dd < 2; ++dd)
#pragma unroll
            for (int kq = 0; kq < 4; ++kq) {
                f32x4 v; v[0] = o[2 * h + dd][4 * kq + 0] * scale; v[1] = o[2 * h + dd][4 * kq + 1] * scale; v[2] = o[2 * h + dd][4 * kq + 2] * scale; v[3] = o[2 * h + dd][4 * kq + 3] * scale;
                *(LAS f32x4*)(sc + r32 * EPI_PITCH + (32 * dd + 8 * kq + 4 * hi) * 4) = v;
            }
        asm volatile("" ::: "memory");
#pragma unroll
        for (int i = 0; i < 4; ++i) {
            const int rr = 8 * i + (lane >> 3), c8 = lane & 7;
            const f32x4 a = *(const LAS f32x4*)(sc + rr * EPI_PITCH + c8 * 32);
            const f32x4 b = *(const LAS f32x4*)(sc + rr * EPI_PITCH + c8 * 32 + 16);
            unsigned zoff, ooff;
            if (NSA) { zoff = z0 + (unsigned)((rr >> 4) * (N1P * 2) + (rr & 15) * 256); ooff = o0 + (unsigned)((rr >> 4) * (ZW8 * 2) + (rr & 15) * 256); }
            else     { zoff = z0 + (unsigned)(rr * (N3P * 2)); ooff = o0 + (unsigned)(rr * (ZW8 * 2)); }
            const unsigned cb = (unsigned)((64 * h + 8 * c8) * 2);
            const u32x4 zw = *(const u32x4*)(zbase + (zoff + cb));
            float v0 = a[0] * silu_f(bflo(zw.x)), v1 = a[1] * silu_f(bfhi(zw.x)), v2 = a[2] * silu_f(bflo(zw.y)), v3 = a[3] * silu_f(bfhi(zw.y));
            float v4 = b[0] * silu_f(bflo(zw.z)), v5 = b[1] * silu_f(bfhi(zw.z)), v6 = b[2] * silu_f(bflo(zw.w)), v7 = b[3] * silu_f(bfhi(zw.w));
            if (RMW) { const u32x4 pw = *(const u32x4*)(obase + (ooff + cb));
                v0 += bflo(pw.x); v1 += bfhi(pw.x); v2 += bflo(pw.y); v3 += bfhi(pw.y); v4 += bflo(pw.z); v5 += bfhi(pw.z); v6 += bflo(pw.w); v7 += bfhi(pw.w); }
            if (Q8) { v0 = emu_q8(v0, 64.0f); v1 = emu_q8(v1, 64.0f); v2 = emu_q8(v2, 64.0f); v3 = emu_q8(v3, 64.0f); v4 = emu_q8(v4, 64.0f); v5 = emu_q8(v5, 64.0f); v6 = emu_q8(v6, 64.0f); v7 = emu_q8(v7, 64.0f); }
            u32x4 w; w.x = pk2(v0, v1); w.y = pk2(v2, v3); w.z = pk2(v4, v5); w.w = pk2(v6, v7);
            *(u32x4*)(obase + (ooff + cb)) = w;
        }
        asm volatile("" ::: "memory");
    }
}

DI void phase_nsa_attn(LAS unsigned char* lds, const Params& P, int bid, int nb) {
    const char* Y0c = (const char*)(P.ws + OFF_Y0);
    const char* KSc = (const char*)(P.ws + OFF_KS); const char* KWc = (const char*)(P.ws + OFF_KW);
    const char* VTSc = (const char*)(P.ws + OFF_VTS); const char* VTWc = (const char*)(P.ws + OFF_VTW);
    const char* KCc = (const char*)(P.ws + OFF_KC); const char* VTCc = (const char*)(P.ws + OFF_VTC);
    char* ONc = (char*)(P.ws + OFF_O);
    LAS float* lut = (LAS float*)(lds + L_LUT);
    const int total = BATCH * NG * 256;
    {
        const int tid0 = tid_opaque();
        __syncthreads();
        for (int i = tid0; i < 64 * 128; i += 512) { const int hd = i >> 7, d = i & 127; lut[hd * LUT_PITCH + d] = P.rel_bias[t5_bucket(d) * NH + hd] * LOG2E; }
        __syncthreads();
    }
    for (int u = bid; u < total; u += nb) {
        int tid = threadIdx.x; asm volatile("" : "+v"(tid));
        const int lane = tid & 63, wid = __builtin_amdgcn_readfirstlane(tid >> 6);
        const int pair = u >> 8; int c = u & 255; if (pair & 1) c = 255 - c;
        const int b = pair >> 2, g = pair & 3, t0 = c * 16;
        __syncthreads();
        AttnLane A;
                const int r = lane & 15;
        A.tk = (lane >> 4) & 1;
        A.tw0 = t0 + 2 * wid; A.tw1 = A.tw0 + 1; A.tq = A.tw0 + A.tk;
        A.lutrow = lut + (g * NR + r) * LUT_PITCH; A.lut_far = A.lutrow[127];
        A.curblk = t0 >> 6; A.tokidx = 2 * wid + A.tk; A.mk0 = 0ull; A.mk1 = 0ull; A.inv_l = 0.f;
        const int hh = g * NR + r;
        const unsigned yoff = (unsigned)(b * SEQ + A.tq) * (unsigned)(N1P * 2);
        const unsigned ytok0 = (unsigned)(b * SEQ + A.tw0) * (unsigned)(N1P * 2);
        const unsigned otok0 = ((unsigned)(b * SEQ + A.tw0) * (unsigned)ZW8 + (unsigned)(g * NR * DV)) * 2u;
        bf16x8 q[12];
                {
            const unsigned qo = yoff + (unsigned)((C_Q + hh * DK + 8 * (lane >> 5)) * 2);
            float ss = 0.f;
#pragma unroll
            for (int d0 = 0; d0 < 12; ++d0) { q[d0] = *(const bf16x8*)(Y0c + (qo + 32u * d0));
                const u32x4 w = __builtin_bit_cast(u32x4, q[d0]);
                const float a0 = bflo(w.x), a1 = bfhi(w.x), a2 = bflo(w.y), a3 = bfhi(w.y), a4 = bflo(w.z), a5 = bfhi(w.z), a6 = bflo(w.w), a7 = bfhi(w.w);
                ss += (a0 * a0 + a1 * a1) + (a2 * a2 + a3 * a3) + (a4 * a4 + a5 * a5) + (a6 * a6 + a7 * a7); }
            ss += __shfl_xor(ss, 32);
            const float rstd = rsqrtf(ss * (1.0f / DK) + EPSN) * QSCALE;
#pragma unroll
            for (int d0 = 0; d0 < 12; ++d0) { const float* gn = P.nsa_q_norm + 16 * d0 + 8 * (lane >> 5); const f32x4 g0 = *(const f32x4*)gn, g1 = *(const f32x4*)(gn + 4);
                u32x4 w = __builtin_bit_cast(u32x4, q[d0]);
                w.x = pk2(bflo(w.x) * rstd * g0[0], bfhi(w.x) * rstd * g0[1]); w.y = pk2(bflo(w.y) * rstd * g0[2], bfhi(w.y) * rstd * g0[3]);
                w.z = pk2(bflo(w.z) * rstd * g1[0], bfhi(w.z) * rstd * g1[1]); w.w = pk2(bflo(w.w) * rstd * g1[2], bfhi(w.w) * rstd * g1[3]);
                q[d0] = __builtin_bit_cast(bf16x8, w); }
        }
        const int bg = b * NG + g;
        f32x16 o[4]; float m_run, l_run;
#define RESET_STATE() do { _Pragma("unroll") for (int d_ = 0; d_ < 4; ++d_) _Pragma("unroll") for (int r_ = 0; r_ < 16; ++r_) o[d_][r_] = 0.f; m_run = 0.f; l_run = 0.f; } while (0)
        const int nct = (t0 + 15 >= 31) ? (((t0 + 15 - 31) >> 4) / 64 + 1) : 0;
        RESET_STATE();
        if (!NO_CMP1) attn_pass2<MODE_CMP1>(lds, KCc + (size_t)bg * 256 * DK * 2, nullptr, 0, 0, nct, q, o, m_run, l_run, A);
        { const float lt = l_run + __shfl_xor(l_run, 32); A.inv_l = lt > 0.f ? 1.0f / lt : 0.f; }
        if (!NO_CMP2) attn_pass2<MODE_CMP2>(lds, KCc + (size_t)bg * 256 * DK * 2, VTCc + (size_t)bg * DV * 256 * 2, 256, 0, nct, q, o, m_run, l_run, A);
        { const float gv = bf1(*(const bf16_t*)(Y0c + (yoff + (unsigned)((C_G + 0 * NH + hh) * 2)))); const float sg = 1.0f / (1.0f + __expf(-gv));
          attn_epilogue_t<false, true, 0>(lds, lane, wid, o, sg, Y0c, ytok0 + (unsigned)((C_ZC + g * NR * DV) * 2), ONc, otok0); }
        __syncthreads();
        {
            const int cur = A.curblk;
            unsigned long long mk[2];
#pragma unroll
            for (int t = 0; t < 2; ++t) {
                const LAS float* QS = (const LAS float*)(lds + L_QS) + (2 * wid + t) * 64;
                const LAS float* P3 = (const LAS float*)(lds + L_P3) + (2 * wid + t) * 64;
                const bool forced = (lane == 0) || (lane == cur) || (lane == cur - 1);
                const bool future = lane > cur;
                float v = 0.f;
                if (!forced && !future) v = QS[lane] + P3[lane - 1];
                unsigned key = (__float_as_uint(v) & ~63u);
                if (forced) key = 0x7f800000u; else if (future) key = 0u;
                key |= (unsigned)(63 - lane);
                int rank = 0;
#pragma unroll
                for (int jp = 0; jp < 64; ++jp) { const unsigned kj = (unsigned)__builtin_amdgcn_readlane((int)key, jp); rank += (kj > key) ? 1 : 0; }
                mk[t] = __ballot(rank < 16 && !future);
            }
            A.mk0 = mk[0]; A.mk1 = mk[1];
        }
        RESET_STATE();
#if PROBE_SEL2
        attn_pass2<MODE_SEL>(lds, KSc + (size_t)bg * SEQ * DK * 2, VTSc + (size_t)bg * DV * SEQ * 2, SEQ, 0, A.curblk + 1, q, o, m_run, l_run, A);
#endif
        if (!NO_SEL) attn_pass2<MODE_SEL>(lds, KSc + (size_t)bg * SEQ * DK * 2, VTSc + (size_t)bg * DV * SEQ * 2, SEQ, 0, A.curblk + 1, q, o, m_run, l_run, A);
        { const float lt = l_run + __shfl_xor(l_run, 32); const float gv = bf1(*(const bf16_t*)(Y0c + (yoff + (unsigned)((C_G + 1 * NH + hh) * 2)))); const float sg = 1.0f / (1.0f + __expf(-gv));
          attn_epilogue_t<true, true, 0>(lds, lane, wid, o, sg / lt, Y0c, ytok0 + (unsigned)((C_ZS + g * NR * DV) * 2), ONc, otok0); }
        __syncthreads();
        RESET_STATE();
        { const int jl = (t0 - 511) > 0 ? (t0 - 511) >> 6 : 0, jh = ((t0 + 15) >> 6) + 1;
#if PROBE_WIN2
          attn_pass2<MODE_WIN>(lds, KWc + (size_t)bg * SEQ * DK * 2, VTWc + (size_t)bg * DV * SEQ * 2, SEQ, jl, jh, q, o, m_run, l_run, A);
#endif
          if (!NO_WIN) attn_pass2<MODE_WIN>(lds, KWc + (size_t)bg * SEQ * DK * 2, VTWc + (size_t)bg * DV * SEQ * 2, SEQ, jl, jh, q, o, m_run, l_run, A); }
        { const float lt = l_run + __shfl_xor(l_run, 32); const float gv = bf1(*(const bf16_t*)(Y0c + (yoff + (unsigned)((C_G + 2 * NH + hh) * 2)))); const float sg = 1.0f / (1.0f + __expf(-gv));
          attn_epilogue_t<true, true, (FP8EMU & 1)>(lds, lane, wid, o, sg / lt, Y0c, ytok0 + (unsigned)((C_ZW + g * NR * DV) * 2), ONc, otok0); }
#undef RESET_STATE
    }
}

DI void phase_mla_attn(LAS unsigned char* lds, const Params& P, int bid, int nb) {
    const char* QMc = (const char*)(P.ws + OFF_QM); const char* KMc = (const char*)(P.ws + OFF_KM); const char* VTMc = (const char*)(P.ws + OFF_VTM);
    const char* Y1c = (const char*)(P.ws + OFF_Y1); char* OMc = (char*)(P.ws + OFF_O);
    const int total = BATCH * NH * 16;
    for (int uu = 0; bid + (uu >> 1) * nb < total / 2; ++uu) {
        int tid = threadIdx.x; asm volatile("" : "+v"(tid));
        const int lane = tid & 63, wid = __builtin_amdgcn_readfirstlane(tid >> 6);
        const int item = bid + (uu >> 1) * nb, second = uu & 1;
        const int xcd = item & 7, tt = item >> 3, p = tt & 7, hl = (tt >> 3) & 3, rnd = tt >> 5;
        const int bh = rnd * 32 + xcd * 4 + hl, qb = second ? p : 15 - p, b = bh >> 6, h = bh & 63, t0 = qb * 256;
        AttnLane A;
        A.tk = 0;
        A.tw0 = t0 + 32 * wid; A.tw1 = A.tw0 + 31; A.tq = A.tw0 + (lane & 31);
        A.lutrow = nullptr; A.lut_far = 0.f; A.curblk = 0; A.tokidx = 0; A.mk0 = 0ull; A.mk1 = 0ull; A.inv_l = 0.f;         const unsigned trow = (unsigned)(b * SEQ + A.tq);
        bf16x8 q[12];
        {
            const unsigned qo = (trow * (unsigned)NQB + (unsigned)(h * DK + 8 * (lane >> 5))) * 2u;
            float ss = 0.f;
#pragma unroll
            for (int d0 = 0; d0 < 12; ++d0) { q[d0] = *(const bf16x8*)(QMc + (qo + 32u * d0));
                const u32x4 w = __builtin_bit_cast(u32x4, q[d0]);
                const float a0 = bflo(w.x), a1 = bfhi(w.x), a2 = bflo(w.y), a3 = bfhi(w.y), a4 = bflo(w.z), a5 = bfhi(w.z), a6 = bflo(w.w), a7 = bfhi(w.w);
                ss += (a0 * a0 + a1 * a1) + (a2 * a2 + a3 * a3) + (a4 * a4 + a5 * a5) + (a6 * a6 + a7 * a7); }
            ss += __shfl_xor(ss, 32);
            const float rstd = rsqrtf(ss * (1.0f / DK) + EPSN);
            const float* ropep = (const float*)(P.ws + OFF_ROPE) + (size_t)trow * 64;
#pragma unroll
            for (int d0 = 0; d0 < 8; ++d0) { const float* gn = P.mla_q_norm + 16 * d0 + 8 * (lane >> 5); const f32x4 g0 = *(const f32x4*)gn, g1 = *(const f32x4*)(gn + 4);
                const float sc = rstd * QSCALE;
                u32x4 w = __builtin_bit_cast(u32x4, q[d0]);
                w.x = pk2(bflo(w.x) * sc * g0[0], bfhi(w.x) * sc * g0[1]); w.y = pk2(bflo(w.y) * sc * g0[2], bfhi(w.y) * sc * g0[3]);
                w.z = pk2(bflo(w.z) * sc * g1[0], bfhi(w.z) * sc * g1[1]); w.w = pk2(bflo(w.w) * sc * g1[2], bfhi(w.w) * sc * g1[3]);
                q[d0] = __builtin_bit_cast(bf16x8, w); }
#pragma unroll
            for (int pr = 0; pr < 2; ++pr) {
                const int i0 = 16 * pr + 8 * (lane >> 5);
                const float* g1p = P.mla_q_norm + 128 + i0; const float* g2p = P.mla_q_norm + 160 + i0;
                const u32x4 w1 = __builtin_bit_cast(u32x4, q[8 + pr]), w2 = __builtin_bit_cast(u32x4, q[10 + pr]);
                float x1[8] = {bflo(w1.x), bfhi(w1.x), bflo(w1.y), bfhi(w1.y), bflo(w1.z), bfhi(w1.z), bflo(w1.w), bfhi(w1.w)};
                float x2[8] = {bflo(w2.x), bfhi(w2.x), bflo(w2.y), bfhi(w2.y), bflo(w2.z), bfhi(w2.z), bflo(w2.w), bfhi(w2.w)};
                float y1[8], y2[8];
#pragma unroll
                for (int e = 0; e < 8; ++e) { const float cs = ropep[i0 + e], sn = ropep[32 + i0 + e];
                    const float a = x1[e] * rstd * g1p[e], c = x2[e] * rstd * g2p[e];
                    y1[e] = (a * cs - c * sn) * QSCALE; y2[e] = (c * cs + a * sn) * QSCALE; }
                u32x4 o1, o2;
                o1.x = pk2(y1[0], y1[1]); o1.y = pk2(y1[2], y1[3]); o1.z = pk2(y1[4], y1[5]); o1.w = pk2(y1[6], y1[7]);
                o2.x = pk2(y2[0], y2[1]); o2.y = pk2(y2[2], y2[3]); o2.z = pk2(y2[4], y2[5]); o2.w = pk2(y2[6], y2[7]);
                q[8 + pr] = __builtin_bit_cast(bf16x8, o1); q[10 + pr] = __builtin_bit_cast(bf16x8, o2);
            }
        }
        f32x16 o[4]; float m_run = 0.f, l_run = 0.f;
#pragma unroll
        for (int d = 0; d < 4; ++d)
#pragma unroll
            for (int r = 0; r < 16; ++r) o[d][r] = 0.f;
        attn_pass2<MODE_MLA>(lds, KMc + (size_t)bh * SEQ * DK * 2, VTMc + (size_t)bh * DV * SEQ * 2, SEQ, 0, 4 * qb + 4, q, o, m_run, l_run, A);
        const float lt = l_run + __shfl_xor(l_run, 32);
        { const unsigned t0w = (unsigned)(b * SEQ + A.tw0);
          attn_epilogue_t<false, false, (FP8EMU & 2) ? 1 : 0>(lds, lane, wid, o, 1.0f / lt, Y1c, (t0w * (unsigned)N3P + (unsigned)(C3_Z + h * DV)) * 2u, OMc, (t0w * (unsigned)ZW8 + (unsigned)(h * DV)) * 2u); }
        __syncthreads();
    }
}
constexpr int LDS_KN_OFF = 135168, LDS_ST_OFF = LDS_KN_OFF + 16384, LDS_BYTES = LDS_ST_OFF + 16;
constexpr int NPHASE = 14;

template <int PH>
DI void run_phase(const Params& P, LAS unsigned char* lds, int bid, int nb) {
    unsigned char* ws = P.ws;
    if constexpr (PH == 0) {
        phase_wconv(lds, P.nsa_w_in, (bf16_t*)(ws + OFF_W1T), DM, N1, N1P, bid, nb, (FP8EMU & 4) ? 64.0f : 0.f);
        phase_wconv(lds, P.w1_k, (bf16_t*)(ws + OFF_W1K), 6144, 192, 256, bid, nb);
        phase_wconv(lds, P.w1_v, (bf16_t*)(ws + OFF_W1V), 4096, 128, 256, bid, nb);
        phase_rmsnorm(P.x, P.norm_w, (bf16_t*)(ws + OFF_H), bid, nb, (FP8EMU & 4) ? 16.0f : 0.f);
    } else if constexpr (PH == 1) {
        pg8::Gemm g{(const bf16_t*)(ws + OFF_H), (const bf16_t*)(ws + OFF_W1T), MTOK, N1P, DM};
        pg8::StaticOrder S; S.init(g.M, g.N, nb, bid);
        pg8::EpiStoreBf16 E{(bf16_t*)(ws + OFF_Y0), N1P};
        pg8::gemm_phase<pg8::EpiStoreBf16, pg8::StaticOrder, false>(lds, g, S, E, nullptr);
    } else if constexpr (PH == 2) {
        phase_nsa_prep(P, bid, nb);
        phase_vt(lds, (const bf16_t*)(ws + OFF_Y0), N1P, C_KVS + NG * DK, DV, NG, (bf16_t*)(ws + OFF_VTS), bid, nb);
        phase_vt(lds, (const bf16_t*)(ws + OFF_Y0), N1P, C_KVW + NG * DK, DV, NG, (bf16_t*)(ws + OFF_VTW), bid, nb);
    } else if constexpr (PH == 3) {
        if (bid < 16) {
            pg8::Gemm g{(const bf16_t*)(ws + OFF_ACK), (const bf16_t*)(ws + OFF_W1K), 4096, 256, 6144};
            pg8::StaticOrder S; S.init(g.M, g.N, 16, bid);
            pg8::EpiPlainF32 E{(float*)(ws + OFF_HIDK), 256};
            pg8::gemm_phase<pg8::EpiPlainF32, pg8::StaticOrder, false>(lds, g, S, E, nullptr);
        } else if (bid < 32) {
            pg8::Gemm g{(const bf16_t*)(ws + OFF_ACV), (const bf16_t*)(ws + OFF_W1V), 4096, 256, 4096};
            pg8::StaticOrder S; S.init(g.M, g.N, 16, bid - 16);
            pg8::EpiPlainF32 E{(float*)(ws + OFF_HIDV), 256};
            pg8::gemm_phase<pg8::EpiPlainF32, pg8::StaticOrder, false>(lds, g, S, E, nullptr);
        } else {
            phase_wconv(lds, P.nsa_w_out, (bf16_t*)(ws + OFF_W2T), ZW8, DM, DM, bid - 32, nb - 32, (FP8EMU & 1) ? 64.0f : 0.f);
            phase_wconv(lds, P.mla_w_in, (bf16_t*)(ws + OFF_W3T), DM, N3, N3P, bid - 32, nb - 32, (FP8EMU & 8) ? 64.0f : 0.f);
        }
    } else if constexpr (PH == 4) {
        phase_cmp2(lds, P, bid, nb);
    } else if constexpr (PH == 5) {
        { float* ss1 = (float*)(ws + OFF_SS1); for (int i = bid * 512 + (int)threadIdx.x; i < MTOK; i += nb * 512) ss1[i] = 0.f; }
        phase_nsa_attn(lds, P, bid, nb);
    } else if constexpr (PH == 6) {
        pg8::Gemm g{(const bf16_t*)(ws + OFF_O), (const bf16_t*)(ws + OFF_W2T), MTOK, DM, ZW8};
        pg8::StaticOrder S; S.init(g.M, g.N, nb, bid);
        pg8::EpiResNorm E{P.x, P.out, DM, P.norm_w + DM, (bf16_t*)(ws + OFF_H), (float*)(ws + OFF_SS1)};
        pg8::gemm_phase<pg8::EpiResNorm, pg8::StaticOrder, false>(lds, g, S, E, nullptr);
    } else if constexpr (PH == 7) {
        phase_rmsnorm(P.out, P.norm_w + DM, (bf16_t*)(ws + OFF_H), bid, nb, (FP8EMU & 8) ? 16.0f : 0.f);
    } else if constexpr (PH == 8) {
        pg8::Gemm g{(const bf16_t*)(ws + OFF_H), (const bf16_t*)(ws + OFF_W3T), MTOK, N3P, DM};
        pg8::StaticOrder S; S.init(g.M, g.N, nb, bid);
        pg8::EpiStoreBf16RowScale E{(bf16_t*)(ws + OFF_Y1), N3P, (const float*)(ws + OFF_SS1), 1.0f / DM};
        pg8::gemm_phase<pg8::EpiStoreBf16RowScale, pg8::StaticOrder, false>(lds, g, S, E, nullptr);
        __syncthreads();
        if (bid >= 64 && nb > 64) {
            phase_wconv(lds, P.mla_w_q_b, (bf16_t*)(ws + OFF_W4T), QLORA, NQB, NQB, bid - 64, nb - 64);
            phase_wconv(lds, P.mla_w_kv_b, (bf16_t*)(ws + OFF_W5K), KVLORA, NKVB / 2, NKVB / 2, bid - 64, nb - 64, 0.f, 2);
            phase_wconv(lds, P.mla_w_kv_b, (bf16_t*)(ws + OFF_W5V), KVLORA, NKVB / 2, NKVB / 2, bid - 64, nb - 64, 0.f, 1);
            phase_wconv(lds, P.mla_w_out, (bf16_t*)(ws + OFF_W6T), ZW8, DM, DM, bid - 64, nb - 64, (FP8EMU & 2) ? 64.0f : 0.f);
        } else if (nb <= 64) {
            phase_wconv(lds, P.mla_w_q_b, (bf16_t*)(ws + OFF_W4T), QLORA, NQB, NQB, bid, nb);
            phase_wconv(lds, P.mla_w_kv_b, (bf16_t*)(ws + OFF_W5K), KVLORA, NKVB / 2, NKVB / 2, bid, nb, 0.f, 2);
            phase_wconv(lds, P.mla_w_kv_b, (bf16_t*)(ws + OFF_W5V), KVLORA, NKVB / 2, NKVB / 2, bid, nb, 0.f, 1);
            phase_wconv(lds, P.mla_w_out, (bf16_t*)(ws + OFF_W6T), ZW8, DM, DM, bid, nb, (FP8EMU & 2) ? 64.0f : 0.f);
        }
    } else if constexpr (PH == 9) {
        phase_mla_prep1(P, bid, nb);
    } else if constexpr (PH == 10) {
        {
            pg8::Gemm g{(const bf16_t*)(ws + OFF_CQN), (const bf16_t*)(ws + OFF_W4T), MTOK, NQB, QLORA};
            pg8::StaticOrder S; S.init(g.M, g.N, nb, bid);
            pg8::EpiStoreBf16 E{(bf16_t*)(ws + OFF_QM), NQB};
            pg8::gemm_phase<pg8::EpiStoreBf16, pg8::StaticOrder, false>(lds, g, S, E, nullptr);
        }
        __syncthreads();
        {
            pg8::Gemm g{(const bf16_t*)(ws + OFF_CKVN), (const bf16_t*)(ws + OFF_W5K), MTOK, NKVB / 2, KVLORA};
            pg8::StaticOrder S; S.init(g.M, g.N, nb, bid);
            pg8::EpiKNorm E{(bf16_t*)(ws + OFF_KM), (const float*)(ws + OFF_SSPE), (const float*)(ws + OFF_KPER), P.mla_k_norm, (LAS float*)(lds + LDS_KN_OFF), 0u};
            pg8::gemm_phase<pg8::EpiKNorm, pg8::StaticOrder, false>(lds, g, S, E, nullptr);
        }
        __syncthreads();
        {
            pg8::Gemm g{(const bf16_t*)(ws + OFF_W5V), (const bf16_t*)(ws + OFF_CKVN), NKVB / 2, MTOK, KVLORA};
            pg8::StaticOrder S; S.init(g.M, g.N, nb, bid);
            pg8::EpiVT E{(bf16_t*)(ws + OFF_VTM)};
            pg8::gemm_phase<pg8::EpiVT, pg8::StaticOrder, false>(lds, g, S, E, nullptr);
        }
    } else if constexpr (PH == 11) {
    } else if constexpr (PH == 12) {
        phase_mla_attn(lds, P, bid, nb);
    } else if constexpr (PH == 13) {
        pg8::Gemm g{(const bf16_t*)(ws + OFF_O), (const bf16_t*)(ws + OFF_W6T), MTOK, DM, ZW8};
        pg8::StaticOrder S; S.init(g.M, g.N, nb, bid);
        pg8::EpiResF32 E{P.out, P.out, DM};
        pg8::gemm_phase<pg8::EpiResF32, pg8::StaticOrder, false>(lds, g, S, E, nullptr);
    }
}

#ifndef REP0
#define REP0 1
#endif
#ifndef REP1
#define REP1 1
#endif
#ifndef REP2
#define REP2 1
#endif
#ifndef REP3
#define REP3 1
#endif
#ifndef REP4
#define REP4 1
#endif
#ifndef REP5
#define REP5 1
#endif
#ifndef REP6
#define REP6 1
#endif
#ifndef REP7
#define REP7 1
#endif
#ifndef REP8
#define REP8 1
#endif
#ifndef REP9
#define REP9 1
#endif
#ifndef REP10
#define REP10 1
#endif
#ifndef REP11
#define REP11 1
#endif
#ifndef REP12
#define REP12 1
#endif
#ifndef REP13
#define REP13 1
#endif

__global__ __launch_bounds__(512, 2) void k_mega(Params P) {
    extern __shared__ __attribute__((aligned(16))) unsigned char shm[];
    LAS unsigned char* lds = (LAS unsigned char*)shm;
    volatile LAS unsigned* st = (volatile LAS unsigned*)(lds + LDS_ST_OFF);
    if (threadIdx.x == 0) { st[0] = 0u; st[1] = 0u; st[2] = 0u; st[3] = 0u; }
    __syncthreads();
    XcdBarrier bar = xcd_barrier_post((unsigned*)(P.ws + OFF_CTL), st);
    const int bid = (int)blockIdx.x, nb = (int)gridDim.x;
    for (int rep_ = 0; rep_ < REP0; ++rep_) run_phase<0>(P, lds, bid, nb);  xcd_barrier(bar);
    for (int rep_ = 0; rep_ < REP1; ++rep_) run_phase<1>(P, lds, bid, nb);  xcd_barrier(bar);
    for (int rep_ = 0; rep_ < REP2; ++rep_) run_phase<2>(P, lds, bid, nb);  xcd_barrier(bar);
    for (int rep_ = 0; rep_ < REP3; ++rep_) run_phase<3>(P, lds, bid, nb);  xcd_barrier(bar);
    for (int rep_ = 0; rep_ < REP4; ++rep_) run_phase<4>(P, lds, bid, nb);  xcd_barrier(bar);
    for (int rep_ = 0; rep_ < REP5; ++rep_) run_phase<5>(P, lds, bid, nb);  xcd_barrier(bar);
    for (int rep_ = 0; rep_ < REP6; ++rep_) run_phase<6>(P, lds, bid, nb);  xcd_barrier(bar);
    for (int rep_ = 0; rep_ < REP8; ++rep_) run_phase<8>(P, lds, bid, nb);  xcd_barrier(bar);
    for (int rep_ = 0; rep_ < REP9; ++rep_) run_phase<9>(P, lds, bid, nb);  xcd_barrier(bar);
    for (int rep_ = 0; rep_ < REP10; ++rep_) run_phase<10>(P, lds, bid, nb); xcd_barrier(bar);
    for (int rep_ = 0; rep_ < REP12; ++rep_) run_phase<12>(P, lds, bid, nb); xcd_barrier(bar);
    for (int rep_ = 0; rep_ < REP13; ++rep_) run_phase<13>(P, lds, bid, nb);
}

extern "C" void kernel_launch(void* const* d_in, const int* in_sizes, int n_in, void* d_out, int out_size, void* d_ws, size_t ws_size, hipStream_t stream) {
    (void)in_sizes; (void)n_in; (void)out_size;
    if (ws_size < WS_END) return;
    Params P{};
    P.x = (const float*)d_in[0]; P.pos = (const int*)d_in[1]; P.norm_w = (const float*)d_in[2]; P.rel_bias = (const float*)d_in[3];
    P.nsa_w_in = (const float*)d_in[4]; P.nsa_q_norm = (const float*)d_in[5]; P.nsa_k_norm = (const float*)d_in[6]; P.pe_k = (const float*)d_in[7];
    P.w1_k = (const float*)d_in[8]; P.w2_k = (const float*)d_in[9]; P.pe_v = (const float*)d_in[10]; P.w1_v = (const float*)d_in[11]; P.w2_v = (const float*)d_in[12];
    P.nsa_w_out = (const float*)d_in[13]; P.mla_w_in = (const float*)d_in[14]; P.mla_q_a_norm = (const float*)d_in[15]; P.mla_w_q_b = (const float*)d_in[16];
    P.mla_kv_a_norm = (const float*)d_in[17]; P.mla_w_kv_b = (const float*)d_in[18]; P.mla_q_norm = (const float*)d_in[19]; P.mla_k_norm = (const float*)d_in[20];
    P.mla_w_out = (const float*)d_in[21];
    P.out = (float*)d_out; P.ws = (unsigned char*)d_ws;
    static int grid = 0;
    if (!grid) {
        int dev = 0, cus = 0, per_cu = 0; (void)hipGetDevice(&dev);
        if (hipDeviceGetAttribute(&cus, hipDeviceAttributeMultiprocessorCount, dev) != hipSuccess || cus <= 0) cus = 256;
        (void)hipFuncSetAttribute((const void*)k_mega, hipFuncAttributeMaxDynamicSharedMemorySize, LDS_BYTES);
        if (hipOccupancyMaxActiveBlocksPerMultiprocessor(&per_cu, k_mega, 512, LDS_BYTES) != hipSuccess || per_cu < 1) per_cu = 1;
        grid = cus;
    }
    (void)hipMemsetAsync((unsigned char*)d_ws + OFF_CTL, 0, XCD_BAR_WORDS * sizeof(unsigned), stream);
    hipLaunchKernelGGL(k_mega, dim3(grid), dim3(512), LDS_BYTES, stream, P);
}
```

```cpp
#include <hip/hip_runtime.h>
#include <stdint.h>
#include <stddef.h>

#define DI __device__ __forceinline__
#define LAS __attribute__((address_space(3)))
typedef unsigned short bf16_t;
typedef short bf16x8 __attribute__((ext_vector_type(8)));
typedef float f32x4 __attribute__((ext_vector_type(4)));
typedef float f32x16 __attribute__((ext_vector_type(16)));
typedef unsigned u32x4 __attribute__((ext_vector_type(4)));
typedef unsigned u32x2 __attribute__((ext_vector_type(2)));
typedef __bf16 bf2_t __attribute__((ext_vector_type(2)));
typedef float f2_t __attribute__((ext_vector_type(2)));

DI int tid_opaque() { int t = (int)threadIdx.x; asm volatile("" : "+v"(t)); return t; }
DI unsigned pk2(float a, float b) { f2_t f = {a, b}; bf2_t v = __builtin_convertvector(f, bf2_t); return __builtin_bit_cast(unsigned, v); }
DI float bflo(unsigned w) { return __uint_as_float(w << 16); }
DI float bfhi(unsigned w) { return __uint_as_float(w & 0xffff0000u); }
#ifndef FP8EMU
#define FP8EMU 0
#endif
DI float emu_q8(float x, float s) { float y = x * s; const float ay = fabsf(y);
    if (ay < 0.015625f) y = rintf(y * 512.0f) * (1.0f / 512.0f);
    else { unsigned u = __float_as_uint(y); u = (u + 0x0007FFFFu + ((u >> 20) & 1u)) & 0xFFF00000u; y = __uint_as_float(u); }
    y = fminf(fmaxf(y, -448.0f), 448.0f); return y / s; }
DI float bf1(bf16_t h) { return __uint_as_float(((unsigned)h) << 16); }

constexpr int BATCH = 4, SEQ = 4096, DM = 4096, MTOK = BATCH * SEQ;
constexpr int NH = 64, NG = 4, NR = 16, DK = 192, DV = 128;
constexpr int N1 = 40896, N1P = 40960;
constexpr int C_Q = 0, C_KVC = 12288, C_KVS = 13568, C_KVW = 14848, C_ZC = 16128, C_ZS = 24320, C_ZW = 32512, C_G = 40704;
constexpr int N3 = 10304, N3P = 10496;
constexpr int C3_CQ = 0, C3_CKV = 1536, C3_KPE = 2048, C3_Z = 2112;
constexpr int QLORA = 1536, KVLORA = 512;
constexpr int NQB = 12288, NKVB = 16384, ZW8 = 8192;
constexpr float EPSN = 1e-6f;
constexpr float LOG2E = 1.4426950408889634f;
constexpr float QSCALE = 0.07216878364870322f * 1.4426950408889634f;

constexpr size_t SZ_W1T = (size_t)N1P * DM * 2, SZ_W2T = (size_t)DM * ZW8 * 2, SZ_W3T = (size_t)N3P * DM * 2, SZ_W4T = (size_t)NQB * QLORA * 2,
                 SZ_W5T = (size_t)NKVB * KVLORA * 2, SZ_W6T = (size_t)DM * ZW8 * 2;
constexpr size_t OFF_W1T = 0, OFF_W2T = OFF_W1T + SZ_W1T, OFF_W3T = OFF_W2T + SZ_W2T, OFF_W4T = OFF_W3T + SZ_W3T, OFF_W5T = OFF_W4T + SZ_W4T,
                 OFF_W6T = OFF_W5T + SZ_W5T, OFF_W1K = OFF_W6T + SZ_W6T;
constexpr size_t OFF_W5K = OFF_W5T, OFF_W5V = OFF_W5T + SZ_W5T / 2;
constexpr size_t SZ_W1K = (size_t)256 * 6144 * 2, SZ_W1V = (size_t)256 * 4096 * 2;
constexpr size_t OFF_W1V = OFF_W1K + SZ_W1K, OFF_CTL = OFF_W1V + SZ_W1V, OFF_H = OFF_CTL + 65536;
constexpr size_t SZ_H = (size_t)MTOK * DM * 2, SZ_KS = (size_t)BATCH * NG * SEQ * DK * 2, SZ_VTS = (size_t)BATCH * NG * DV * SEQ * 2,
                 SZ_ACK = (size_t)4096 * 6144 * 2, SZ_ACV = (size_t)4096 * 4096 * 2;
constexpr size_t OFF_KS = OFF_H + SZ_H, OFF_KW = OFF_KS + SZ_KS, OFF_VTS = OFF_KW + SZ_KS, OFF_VTW = OFF_VTS + SZ_VTS, OFF_ACK = OFF_VTW + SZ_VTS,
                 OFF_ACV = OFF_ACK + SZ_ACK, OFF_KC = OFF_ACV + SZ_ACV;
constexpr size_t SZ_KC = (size_t)16 * 256 * DK * 2, SZ_VTC = (size_t)16 * DV * 256 * 2, SZ_HID = (size_t)4096 * 256 * 4;
constexpr size_t OFF_VTC = OFF_KC + SZ_KC, OFF_HIDK = OFF_VTC + SZ_VTC, OFF_HIDV = OFF_HIDK + SZ_HID, OFF_Y0 = OFF_HIDV + SZ_HID;
constexpr size_t SZ_Y0 = (size_t)MTOK * N1P * 2, SZ_O = (size_t)MTOK * ZW8 * 2;
constexpr size_t OFF_O = OFF_Y0 + SZ_Y0, WS_END = OFF_O + SZ_O;
constexpr size_t OFF_SS1 = OFF_HIDK;
constexpr size_t OFF_KM = 0;
constexpr size_t SZ_KM = (size_t)BATCH * NH * SEQ * DK * 2;
static_assert(SZ_KM <= SZ_W1T + SZ_W2T, "KM alias");
constexpr size_t OFF_VTM = OFF_H;
constexpr size_t SZ_VTM = (size_t)BATCH * NH * DV * SEQ * 2;
constexpr size_t OFF_CKVN = OFF_VTM + SZ_VTM;
constexpr size_t SZ_CKVN = (size_t)MTOK * KVLORA * 2;
static_assert(OFF_CKVN + SZ_CKVN <= OFF_KC, "CKVN alias");
constexpr size_t OFF_Y1 = OFF_Y0, SZ_Y1 = (size_t)MTOK * N3P * 2;
constexpr size_t OFF_QM = OFF_Y1 + SZ_Y1, SZ_QM = (size_t)MTOK * NQB * 2;
constexpr size_t OFF_KVM = OFF_QM + SZ_QM, SZ_KVM = (size_t)MTOK * NKVB * 2;
constexpr size_t OFF_KNM = OFF_KVM;
constexpr size_t OFF_KPER = OFF_KVM, OFF_SSPE = OFF_KVM + (size_t)MTOK * 64 * 4;
constexpr size_t OFF_CQN = OFF_KVM + SZ_KVM, SZ_CQN = (size_t)MTOK * QLORA * 2;
constexpr size_t OFF_ROPE = OFF_CQN + SZ_CQN, SZ_ROPE = (size_t)MTOK * 64 * 4;
static_assert(OFF_ROPE + SZ_ROPE <= OFF_O, "layer-1 alias region");
static_assert(WS_END <= 2680160256ull, "workspace");

struct Params {
    const float* x; const int* pos; const float* norm_w; const float* rel_bias;
    const float* nsa_w_in; const float* nsa_q_norm; const float* nsa_k_norm; const float* pe_k; const float* w1_k; const float* w2_k;
    const float* pe_v; const float* w1_v; const float* w2_v; const float* nsa_w_out;
    const float* mla_w_in; const float* mla_q_a_norm; const float* mla_w_q_b; const float* mla_kv_a_norm; const float* mla_w_kv_b;
    const float* mla_q_norm; const float* mla_k_norm; const float* mla_w_out;
    float* out; unsigned char* ws;
};

#define XB_TMO      128
#define XB_XCNT(j)  (256  + 64 * (j))
#define XB_XSUB(j)  (1280 + 64 * (j))
#define XB_XGEN(j)  (2304 + 64 * (j))
#define XB_TOP      3328
#define XB_TOPGEN   3392
#define XCD_BAR_WORDS 3456
#define XB_SPIN_CAP (1u << 18)

__device__ __forceinline__ unsigned xb_ld(unsigned* p)              { return __hip_atomic_load(p, __ATOMIC_RELAXED, __HIP_MEMORY_SCOPE_AGENT); }
__device__ __forceinline__ unsigned xb_add(unsigned* p, unsigned v) { return __hip_atomic_fetch_add(p, v, __ATOMIC_RELAXED, __HIP_MEMORY_SCOPE_AGENT); }
__device__ __forceinline__ unsigned xb_xcc_id() { return (unsigned)__builtin_amdgcn_s_getreg((3 << 11) | 20) & 0xFu; }
#define XB_SPIN(cond, bar) do { unsigned _sp = 0; while (cond) { __builtin_amdgcn_s_sleep(1); \
    if ((++_sp & 255u) == 0u) { if (xb_ld(&(bar)[XB_TMO])) break; if (_sp > XB_SPIN_CAP) { atomicAdd(&(bar)[XB_TMO], 1u); break; } } } } while (0)

struct XcdBarrier {
    unsigned* bar; unsigned x;
    volatile LAS unsigned* st;
};

__device__ __forceinline__ XcdBarrier xcd_barrier_post(unsigned* bar, volatile LAS unsigned* st) {
    XcdBarrier b; b.bar = bar; b.x = xb_xcc_id(); b.st = st;
    if (threadIdx.x == 0) (void)xb_add(&bar[XB_XCNT(b.x)], 1u);
    return b;
}
__device__ __forceinline__ void xcd_barrier_complete(unsigned* bar, unsigned x, unsigned& nloc, unsigned& nx) {
    const unsigned G = gridDim.x * gridDim.y * gridDim.z;
    unsigned sum, cnt, mine, sp = 0u;
    for (;;) {
        sum = 0u; cnt = 0u; mine = 0u;
#pragma unroll
        for (unsigned j = 0; j < 16; ++j) { const unsigned c = xb_ld(&bar[XB_XCNT(j)]); sum += c; cnt += (c > 0u) ? 1u : 0u; mine = (j == x) ? c : mine; }
        if (sum == G) break;
        __builtin_amdgcn_s_sleep(1);
        if ((++sp & 255u) == 0u) { if (xb_ld(&bar[XB_TMO])) break; if (sp > XB_SPIN_CAP) { atomicAdd(&bar[XB_TMO], 1u); break; } }
    }
    nloc = mine > 0u ? mine : 1u; nx = cnt > 0u ? cnt : 1u;
}

__device__ __forceinline__ void xcd_barrier(const XcdBarrier& b) {
    asm volatile("s_waitcnt vmcnt(0)" ::: "memory");
    __syncthreads();
    if (threadIdx.x == 0) {
        unsigned* bar = b.bar;
        __builtin_amdgcn_s_waitcnt(0);
        unsigned nloc = b.st[0], nx = b.st[1];
        if (nloc == 0u) { xcd_barrier_complete(bar, b.x, nloc, nx); b.st[0] = nloc; b.st[1] = nx; }
        const unsigned old = xb_add(&bar[XB_XSUB(b.x)], 1u);
        const unsigned gen = old / nloc;
        if (old + 1u == (gen + 1u) * nloc) {
            __builtin_amdgcn_fence(__ATOMIC_RELEASE, "agent");
            asm volatile("s_waitcnt vmcnt(0)" ::: "memory");
            const unsigned og = xb_add(&bar[XB_TOP], 1u);
            const unsigned tg = og / nx;
            if (og + 1u == (tg + 1u) * nx) xb_add(&bar[XB_TOPGEN], 1u);
            else XB_SPIN(xb_ld(&bar[XB_TOPGEN]) == tg, bar);
            __builtin_amdgcn_fence(__ATOMIC_ACQUIRE, "agent");
            xb_add(&bar[XB_XGEN(b.x)], 1u);
            asm volatile("s_waitcnt vmcnt(0)" ::: "memory");
        } else {
            XB_SPIN(xb_ld(&bar[XB_XGEN(b.x)]) == gen, bar);
            __builtin_amdgcn_fence(__ATOMIC_ACQUIRE, "agent");
            asm volatile("s_waitcnt vmcnt(0)" ::: "memory");
        }
    }
    __syncthreads();
}

namespace pg8 {
#define PG8_LAS __attribute__((address_space(3)))
typedef unsigned short bf16_t;
typedef short bf16x8 __attribute__((ext_vector_type(8)));
typedef float f32x4 __attribute__((ext_vector_type(4)));
typedef unsigned u32x4 __attribute__((ext_vector_type(4)));
constexpr int BM = 256, BK = 64, HALF = 128, HTB = HALF * BK * 2  , STAGE_BYTES = 8 * HTB, NXCD = 8, WGM = 8;

__host__ __device__ __forceinline__ int lds_byte(int r, int c) { const int st = (r >> 4) * 2 + (c >> 5), rr = r & 15, cc = c & 31, ob = rr * 64 + cc * 2; return st * 1024 + (ob ^ (((ob >> 9) & 1) << 5)); }
__host__ __device__ __forceinline__ void stage_rc(int b, int& R, int& C) { const int st = b / 1024, sb = b % 1024, swz = sb ^ (((sb >> 9) & 1) << 5); R = (st >> 1) * 16 + swz / 64; C = (st & 1) * 32 + (swz % 64) / 2; }
__host__ __device__ __forceinline__ int perm32(int rho) { const int n = rho >> 4, i = rho & 15; return 8 * (i >> 2) + 4 * n + (i & 3); }

struct Unit { int pm, pn; };
struct Gemm { const bf16_t* A; const bf16_t* Bt; int M, N, K; };

struct StaticOrder {
    int nM, nN, nwg, G, c;
    __host__ __device__ void init(int M, int N, int G_, int c_) { nM = M / BM; nN = N / BM; nwg = nM * nN; G = G_; c = c_; }
    __host__ __device__ bool next(int i, Unit& u) const {
        const long L = (long)i * G + c; if (L >= nwg) return false;
        int wgid = (int)L; { const int q = nwg / NXCD, r = nwg % NXCD, xcd = wgid % NXCD, off = wgid / NXCD; wgid = (xcd < r ? xcd * (q + 1) : r * (q + 1) + (xcd - r) * q) + off; }
        const int nig = WGM * nN, gid = wgid / nig, fm = gid * WGM, gsz = (nM - fm) < WGM ? (nM - fm) : WGM;
        u.pm = fm + ((wgid % nig) % gsz); u.pn = (wgid % nig) / gsz; return true;
    }
    __device__ __forceinline__ void a_ready(const Unit&) const {}
    __device__ __forceinline__ void done(const Unit&) const {}
};
struct EpiStoreBf16 {
    static constexpr bool PERM = true, AFTER_DRAIN = false, SWAP23 = false;
    bf16_t* O; int ldc;
    __device__ __forceinline__ void operator()(const f32x4 (&acc)[2][2][4][2], const Unit& u, int wr, int wc, int fr, int fq) const {
        const int row0 = u.pm * BM + wr * 64 + fr; const int col0 = u.pn * BM + wc * 32 + 8 * fq;
#pragma unroll
        for (int ai = 0; ai < 2; ++ai)
#pragma unroll
            for (int m = 0; m < 4; ++m) { bf16_t* rowp = O + (size_t)(row0 + ai * HALF + m * 16) * ldc + col0;
#pragma unroll
                for (int bj = 0; bj < 2; ++bj) { const f32x4 v0 = acc[ai][bj][m][0], v1 = acc[ai][bj][m][1];
                    u32x4 w; w.x = pk2(v0[0], v0[1]); w.y = pk2(v0[2], v0[3]); w.z = pk2(v1[0], v1[1]); w.w = pk2(v1[2], v1[3]);
                    *(u32x4*)(rowp + bj * HALF) = w; } }
    }
};
struct EpiResF32 {
    static constexpr bool PERM = false, AFTER_DRAIN = false, SWAP23 = false;
    const float* base; float* out; int ldc;
    __device__ __forceinline__ void operator()(const f32x4 (&acc)[2][2][4][2], const Unit& u, int wr, int wc, int fr, int fq) const {
        const int row0 = u.pm * BM + wr * 64 + fr, col0 = u.pn * BM + wc * 32 + 4 * fq;
#pragma unroll
        for (int ai = 0; ai < 2; ++ai)
#pragma unroll
            for (int m = 0; m < 4; ++m) { const size_t off = (size_t)(row0 + ai * HALF + m * 16) * ldc + col0;
#pragma unroll
                for (int bj = 0; bj < 2; ++bj)
#pragma unroll
                    for (int n = 0; n < 2; ++n) { const f32x4 bs = *(const f32x4*)(base + off + bj * HALF + n * 16);
                        *(f32x4*)(out + off + bj * HALF + n * 16) = bs + acc[ai][bj][m][n]; } }
    }
};
struct EpiPlainF32 {
    static constexpr bool PERM = false, AFTER_DRAIN = false, SWAP23 = false;
    float* C; int ldc;
    __device__ __forceinline__ void operator()(const f32x4 (&acc)[2][2][4][2], const Unit& u, int wr, int wc, int fr, int fq) const {
        const int row0 = u.pm * BM + wr * 64 + fr, col0 = u.pn * BM + wc * 32 + 4 * fq;
#pragma unroll
        for (int ai = 0; ai < 2; ++ai)
#pragma unroll
            for (int m = 0; m < 4; ++m) { float* rowp = C + (size_t)(row0 + ai * HALF + m * 16) * ldc + col0;
#pragma unroll
                for (int bj = 0; bj < 2; ++bj)
#pragma unroll
                    for (int n = 0; n < 2; ++n) *(f32x4*)(rowp + bj * HALF + n * 16) = acc[ai][bj][m][n]; }
    }
};

struct EpiVT {
    static constexpr bool PERM = true, AFTER_DRAIN = false, SWAP23 = true;
    bf16_t* O;
    __device__ __forceinline__ void operator()(const f32x4 (&acc)[2][2][4][2], const Unit& u, int wr, int wc, int fr, int fq) const {
        const int row0 = u.pm * BM + wr * 64 + fr; const int colt = u.pn * BM; const int b = colt >> 12, pos0 = (colt & 4095) + wc * 32 + 8 * fq;
        bf16_t* base = O + (size_t)b * 8192 * 4096 + pos0;
#pragma unroll
        for (int ai = 0; ai < 2; ++ai)
#pragma unroll
            for (int m = 0; m < 4; ++m) { bf16_t* rowp = base + (size_t)(row0 + ai * HALF + m * 16) * 4096;
#pragma unroll
                for (int bj = 0; bj < 2; ++bj) { const f32x4 v0 = acc[ai][bj][m][0], v1 = acc[ai][bj][m][1];
                    u32x4 w; w.x = pk2(v0[0], v0[1]); w.y = pk2(v0[2], v0[3]); w.z = pk2(v1[0], v1[1]); w.w = pk2(v1[2], v1[3]);
                    *(u32x4*)(rowp + bj * HALF) = w; } }
    }
};

struct EpiKNorm {
    static constexpr bool PERM = true, AFTER_DRAIN = false, SWAP23 = false;
    bf16_t* KM; const float* sspe; const float* kper; const float* gain; PG8_LAS float* tab; mutable unsigned par;
    __device__ __forceinline__ void operator()(const f32x4 (&acc)[2][2][4][2], const Unit& u, int wr, int wc, int fr, int fq) const {
        PG8_LAS float* T = tab + par * 2048;
#pragma unroll
        for (int ai = 0; ai < 2; ++ai)
#pragma unroll
            for (int m = 0; m < 4; ++m) { const int row = ai * HALF + wr * 64 + m * 16 + fr;
#pragma unroll
                for (int bj = 0; bj < 2; ++bj) { const f32x4 x = acc[ai][bj][m][0], y = acc[ai][bj][m][1];
                    float ss = (x[0] * x[0] + x[1] * x[1]) + (x[2] * x[2] + x[3] * x[3]) + (y[0] * y[0] + y[1] * y[1]) + (y[2] * y[2] + y[3] * y[3]);
                    ss += __shfl_xor(ss, 16); ss += __shfl_xor(ss, 32);
                    if (fq == 0) T[row * 8 + bj * 4 + wc] = ss; } }
        asm volatile("s_waitcnt lgkmcnt(0)" ::: "memory"); __builtin_amdgcn_s_barrier(); asm volatile("" ::: "memory");
        const f32x4 g0 = *(const f32x4*)(gain + wc * 32 + 8 * fq), g1 = *(const f32x4*)(gain + wc * 32 + 8 * fq + 4);
        const int tok0 = u.pm * BM, b = tok0 >> 12;
#pragma unroll
        for (int ai = 0; ai < 2; ++ai)
#pragma unroll
            for (int m = 0; m < 4; ++m) { const int row = ai * HALF + wr * 64 + m * 16 + fr, tok = tok0 + row, s = tok & 4095;
                const float sp = sspe[tok]; const f32x4 kp = *(const f32x4*)(kper + (size_t)tok * 64 + wc * 16 + 4 * fq);
#pragma unroll
                for (int bj = 0; bj < 2; ++bj) { const f32x4 t = *(const PG8_LAS f32x4*)(T + row * 8 + bj * 4);
                    const float rstd = rsqrtf(((t[0] + t[1]) + (t[2] + t[3]) + sp) * (1.0f / 192.0f) + 1e-6f);
                    const int hd = 2 * u.pn + bj;
                    bf16_t* kb = KM + ((size_t)(b * 64 + hd) * 4096 + s) * 192;
                    const f32x4 x = acc[ai][bj][m][0], y = acc[ai][bj][m][1];
                    u32x4 w; w.x = pk2(x[0] * rstd * g0[0], x[1] * rstd * g0[1]); w.y = pk2(x[2] * rstd * g0[2], x[3] * rstd * g0[3]);
                    w.z = pk2(y[0] * rstd * g1[0], y[1] * rstd * g1[1]); w.w = pk2(y[2] * rstd * g1[2], y[3] * rstd * g1[3]);
                    *(u32x4*)(kb + wc * 32 + 8 * fq) = w;
                    u32x2 r; r.x = pk2(kp[0] * rstd, kp[1] * rstd); r.y = pk2(kp[2] * rstd, kp[3] * rstd);
                    *(u32x2*)(kb + 128 + wc * 16 + 4 * fq) = r; } }
        par ^= 1u;
    }
};

struct EpiResNorm {
    static constexpr bool PERM = false, AFTER_DRAIN = false, SWAP23 = false;
    const float* base; float* out; int ldc; const float* gain; bf16_t* xg; float* ss;
    __device__ __forceinline__ void operator()(const f32x4 (&acc)[2][2][4][2], const Unit& u, int wr, int wc, int fr, int fq) const {
        const int row0 = u.pm * BM + wr * 64 + fr, col0 = u.pn * BM + wc * 32 + 4 * fq;
        f32x4 gv[2][2];
#pragma unroll
        for (int bj = 0; bj < 2; ++bj)
#pragma unroll
            for (int n = 0; n < 2; ++n) gv[bj][n] = *(const f32x4*)(gain + col0 + bj * HALF + n * 16);
#pragma unroll
        for (int ai = 0; ai < 2; ++ai)
#pragma unroll
            for (int m = 0; m < 4; ++m) { const int row = row0 + ai * HALF + m * 16; const size_t off = (size_t)row * ldc + col0; float sq = 0.f;
#pragma unroll
                for (int bj = 0; bj < 2; ++bj)
#pragma unroll
                    for (int n = 0; n < 2; ++n) { const f32x4 bs = *(const f32x4*)(base + off + bj * HALF + n * 16); const f32x4 v = bs + acc[ai][bj][m][n];
                        *(f32x4*)(out + off + bj * HALF + n * 16) = v;
                        sq += (v[0] * v[0] + v[1] * v[1]) + (v[2] * v[2] + v[3] * v[3]);
                        const f32x4 g = gv[bj][n]; u32x2 w; w.x = pk2(v[0] * g[0], v[1] * g[1]); w.y = pk2(v[2] * g[2], v[3] * g[3]);
                        *(u32x2*)(xg + off + bj * HALF + n * 16) = w; }
                sq += __shfl_xor(sq, 16); sq += __shfl_xor(sq, 32);
                if (fq == 0) atomicAdd(ss + row, sq); }
    }
};
struct EpiStoreBf16RowScale {
    static constexpr bool PERM = true, AFTER_DRAIN = false, SWAP23 = false;
    bf16_t* O; int ldc; const float* ss; float inv_dim;
    __device__ __forceinline__ void operator()(const f32x4 (&acc)[2][2][4][2], const Unit& u, int wr, int wc, int fr, int fq) const {
        const int row0 = u.pm * BM + wr * 64 + fr; const int col0 = u.pn * BM + wc * 32 + 8 * fq;
#pragma unroll
        for (int ai = 0; ai < 2; ++ai)
#pragma unroll
            for (int m = 0; m < 4; ++m) { const int row = row0 + ai * HALF + m * 16; const float rs = rsqrtf(ss[row] * inv_dim + 1e-6f);
                bf16_t* rowp = O + (size_t)row * ldc + col0;
#pragma unroll
                for (int bj = 0; bj < 2; ++bj) { const f32x4 v0 = acc[ai][bj][m][0] * rs, v1 = acc[ai][bj][m][1] * rs;
                    u32x4 w; w.x = pk2(v0[0], v0[1]); w.y = pk2(v0[2], v0[3]); w.z = pk2(v1[0], v1[1]); w.w = pk2(v1[2], v1[3]);
                    *(u32x4*)(rowp + bj * HALF) = w; } }
    }
};
template <class Epi, class Sched, bool STAMP = false>
__device__ __forceinline__ void gemm_phase(PG8_LAS unsigned char* lds, const Gemm g, const Sched& S, const Epi& E, unsigned long long* stamps) {
    const int tid = tid_opaque(), wid = __builtin_amdgcn_readfirstlane(tid >> 6), lane = tid & 63, wr = wid >> 2, wc = wid & 3, fr = lane & 15, fq = lane >> 4;
    const int K = g.K, nt = K / BK;
    int ts_lo = 0, ts_hi = 0, nts = 0; const unsigned long long rt_entry = STAMP ? (unsigned long long)wall_clock64() : 0ull;
#define PG8_STAMP() do { if (STAMP && wid == 0 && nts < 64) { const unsigned long long _c = (unsigned long long)clock64(); \
        ts_lo = (lane == nts) ? (int)(unsigned)_c : ts_lo; ts_hi = (lane == nts) ? (int)(unsigned)(_c >> 32) : ts_hi; ++nts; } } while (0)
    PG8_STAMP();
    unsigned voffA[2], voffB[2];
#pragma unroll
    for (int i = 0; i < 2; ++i) { int R, C; stage_rc(tid * 16 + i * 8192, R, C); int Rb = Epi::PERM ? ((R & ~31) + perm32(R & 31)) : R; if (Epi::SWAP23) Rb = (Rb & ~15) | ((Rb & 3) | ((Rb & 4) << 1) | ((Rb & 8) >> 1));
        voffA[i] = (unsigned)(R * K + C) * 2u; voffB[i] = (unsigned)(Rb * K + C) * 2u; }
    const size_t kstep = (size_t)(BK * 2);
    const size_t hstep = (size_t)HALF * K * 2;
    const size_t tstep = 2 * hstep;
    const unsigned ldsw = (unsigned)wid * 1024u;
    const int aoff = lds_byte(wr * 64 + fr, fq * 8), boff = lds_byte(wc * 32 + fr, fq * 8);
#define PG8_SA(b, h) (((b) * 2 + (h)) * HTB)
#define PG8_SB(b, h) ((4 + (b) * 2 + (h)) * HTB)
#define PG8_STAGE(bufoff, gbase, voff) do { _Pragma("unroll") for (int _i = 0; _i < 2; ++_i) \
        __builtin_amdgcn_global_load_lds((const unsigned*)((const char*)(gbase) + (voff)[_i]), (PG8_LAS unsigned*)(lds + (bufoff) + ldsw + _i * 8192), 16, 0, 0); } while (0)
#define PG8_LDA(dst, b, h) do { _Pragma("unroll") for (int m = 0; m < 4; ++m) _Pragma("unroll") for (int k = 0; k < 2; ++k) dst[m][k] = *(const PG8_LAS bf16x8*)(lds + PG8_SA(b, h) + aoff + m * 2048 + k * 1024); } while (0)
#define PG8_LDB(dst, b, h) do { _Pragma("unroll") for (int n = 0; n < 2; ++n) _Pragma("unroll") for (int k = 0; k < 2; ++k) dst[n][k] = *(const PG8_LAS bf16x8*)(lds + PG8_SB(b, h) + boff + n * 2048 + k * 1024); } while (0)
#define PG8_MMA(ai, bj, At, Bt) do { __builtin_amdgcn_s_setprio(1); _Pragma("unroll") for (int m = 0; m < 4; ++m) _Pragma("unroll") for (int n = 0; n < 2; ++n) _Pragma("unroll") for (int k = 0; k < 2; ++k) \
        acc[ai][bj][m][n] = __builtin_amdgcn_mfma_f32_16x16x32_bf16(Bt[n][k], At[m][k], acc[ai][bj][m][n], 0, 0, 0); __builtin_amdgcn_s_setprio(0); } while (0)
#define PG8_WAIT_V(n) asm volatile("s_waitcnt vmcnt(" #n ")" ::: "memory")
#define PG8_WAIT_L(n) asm volatile("s_waitcnt lgkmcnt(" #n ")" ::: "memory")
#define PG8_BAR __builtin_amdgcn_s_barrier()
#define PG8_SCHED __builtin_amdgcn_sched_barrier(0)
    Unit cur, nxt; int ui = 0;
    if (!S.next(0, cur)) return;
    f32x4 acc[2][2][4][2];
#pragma unroll
    for (int a = 0; a < 2; ++a)
#pragma unroll
        for (int b = 0; b < 2; ++b)
#pragma unroll
            for (int m = 0; m < 4; ++m)
#pragma unroll
                for (int n = 0; n < 2; ++n) acc[a][b][m][n] = (f32x4){0.f, 0.f, 0.f, 0.f};
    bf16x8 At[4][2], B0[2][2], B1[2][2];
    const char* cA = (const char*)g.A + (size_t)cur.pm * tstep; const char* cB = (const char*)g.Bt + (size_t)cur.pn * tstep;
    S.a_ready(cur);
    PG8_STAGE(PG8_SB(0, 0), cB, voffB); PG8_STAGE(PG8_SA(0, 0), cA, voffA); PG8_STAGE(PG8_SB(0, 1), cB + hstep, voffB); PG8_STAGE(PG8_SA(0, 1), cA + hstep, voffA);
    if (wr == 1) PG8_BAR;
    PG8_WAIT_V(4); PG8_BAR;
    PG8_STAGE(PG8_SB(1, 0), cB + kstep, voffB); PG8_STAGE(PG8_SA(1, 0), cA + kstep, voffA); PG8_STAGE(PG8_SB(1, 1), cB + hstep + kstep, voffB);
    PG8_WAIT_V(6); PG8_BAR;
    PG8_STAMP();
    for (;;) {
        const bool has_next = S.next(ui + 1, nxt);
        const char* nA = has_next ? (const char*)g.A + (size_t)nxt.pm * tstep : cA; const char* nB = has_next ? (const char*)g.Bt + (size_t)nxt.pn * tstep : cB;
        for (int t = 0; t < nt; t += 2) {
            const bool last = (t == nt - 2);
            const char* a1 = cA + (size_t)(t + 1) * kstep;
            const char* a2 = last ? nA : cA + (size_t)(t + 2) * kstep; const char* b2 = last ? nB : cB + (size_t)(t + 2) * kstep;
            const char* a3 = a2 + kstep; const char* b3 = b2 + kstep;
            if (last && has_next) S.a_ready(nxt);
            PG8_LDB(B0, 0, 0); PG8_SCHED; PG8_LDA(At, 0, 0); PG8_STAGE(PG8_SA(1, 1), a1 + hstep, voffA);
            PG8_WAIT_L(8); PG8_BAR; PG8_WAIT_L(0); PG8_MMA(0, 0, At, B0); PG8_BAR; PG8_SCHED;
            PG8_LDB(B1, 0, 1); PG8_STAGE(PG8_SB(0, 0), b2, voffB);
            PG8_BAR; PG8_WAIT_L(0); PG8_MMA(0, 1, At, B1); PG8_BAR;
            PG8_LDA(At, 0, 1); PG8_STAGE(PG8_SA(0, 0), a2, voffA);
            PG8_BAR; PG8_WAIT_L(0); PG8_MMA(1, 0, At, B0); PG8_BAR; PG8_SCHED;
            PG8_STAGE(PG8_SB(0, 1), b2 + hstep, voffB);
            PG8_WAIT_V(6); PG8_BAR; PG8_MMA(1, 1, At, B1); PG8_BAR;
            PG8_LDB(B0, 1, 0); PG8_SCHED; PG8_LDA(At, 1, 0); PG8_STAGE(PG8_SA(0, 1), a2 + hstep, voffA);
            PG8_WAIT_L(8); PG8_BAR; PG8_WAIT_L(0); PG8_MMA(0, 0, At, B0); PG8_BAR; PG8_SCHED;
            PG8_LDB(B1, 1, 1); PG8_STAGE(PG8_SB(1, 0), b3, voffB);
            PG8_BAR; PG8_WAIT_L(0); PG8_MMA(0, 1, At, B1); PG8_BAR;
            PG8_LDA(At, 1, 1); PG8_STAGE(PG8_SA(1, 0), a3, voffA);
            PG8_BAR; PG8_WAIT_L(0); PG8_MMA(1, 0, At, B0); PG8_BAR; PG8_SCHED;
            PG8_STAGE(PG8_SB(1, 1), b3 + hstep, voffB);
            PG8_WAIT_V(6); PG8_BAR; PG8_MMA(1, 1, At, B1); PG8_BAR;
        }
        PG8_STAMP();
        if constexpr (!Epi::AFTER_DRAIN) { E(acc, cur, wr, wc, fr, fq); S.done(cur); }
        PG8_STAMP();
        if (!has_next) break;
#pragma unroll
        for (int a = 0; a < 2; ++a)
#pragma unroll
            for (int b = 0; b < 2; ++b)
#pragma unroll
                for (int m = 0; m < 4; ++m)
#pragma unroll
                    for (int n = 0; n < 2; ++n) acc[a][b][m][n] = (f32x4){0.f, 0.f, 0.f, 0.f};
        cur = nxt; cA = nA; cB = nB; ++ui;
    }
    PG8_WAIT_V(0);
    if (wr == 0) PG8_BAR;
    PG8_BAR;
    if constexpr (Epi::AFTER_DRAIN) { E.fused(acc, cur, wr, wc, fr, fq, lds, wid, lane); S.done(cur); }
    PG8_STAMP();
    if (STAMP && wid == 0) { stamps[lane] = lane < nts ? (((unsigned long long)(unsigned)ts_hi << 32) | (unsigned)ts_lo) : 0ull;
        if (lane == 62) stamps[62] = rt_entry; if (lane == 63) stamps[63] = (unsigned long long)wall_clock64(); }
#undef PG8_STAMP
#undef PG8_SA
#undef PG8_SB
#undef PG8_STAGE
#undef PG8_LDA
#undef PG8_LDB
#undef PG8_MMA
#undef PG8_WAIT_V
#undef PG8_WAIT_L
#undef PG8_BAR
#undef PG8_SCHED
}
}


DI void phase_wconv(LAS unsigned char* lds, const float* __restrict__ src, bf16_t* __restrict__ dst, int K, int N, int Npad, int bid, int nb, float q8s = 0.f, int colmap = 0) {
    LAS float* tile = (LAS float*)lds;
    const int tid = tid_opaque();
    const int tk = K / 64, tn = Npad / 64, total = tk * tn;
    for (int t = bid; t < total; t += nb) {
        const int k0 = (t % tk) * 64, n0 = (t / tk) * 64;
        __syncthreads();
        {
            const int ty = tid >> 4, tx = tid & 15;
#pragma unroll
            for (int i = 0; i < 2; ++i) {
                const int k = k0 + ty + 32 * i, n = n0 + tx * 4;
                f32x4 v = {0.f, 0.f, 0.f, 0.f};
                if (colmap) { const int ns = (n >> 7) * 256 + (colmap == 1 ? 128 : 0) + (n & 127); v = *(const f32x4*)(src + (size_t)k * (2 * N) + ns); }
                else if (n < N) v = *(const f32x4*)(src + (size_t)k * N + n);
                LAS float* p = tile + (ty + 32 * i) * 65 + tx * 4;
                p[0] = v[0]; p[1] = v[1]; p[2] = v[2]; p[3] = v[3];
            }
        }
        __syncthreads();
        {
            const int n = tid >> 3, kc = tid & 7;
            float v[8];
#pragma unroll
            for (int j = 0; j < 8; ++j) { v[j] = tile[(kc * 8 + j) * 65 + n]; if (q8s != 0.f) v[j] = emu_q8(v[j], q8s); }
            u32x4 w; w.x = pk2(v[0], v[1]); w.y = pk2(v[2], v[3]); w.z = pk2(v[4], v[5]); w.w = pk2(v[6], v[7]);
            *(u32x4*)(dst + (size_t)(n0 + n) * K + k0 + kc * 8) = w;
        }
    }
}

DI void phase_rmsnorm(const float* __restrict__ x, const float* __restrict__ gain, bf16_t* __restrict__ h, int bid, int nb, float q8s = 0.f) {
    const int tid = tid_opaque(); const int lane = tid & 63, wid = tid >> 6;
    for (int row = bid * 8 + wid; row < MTOK; row += nb * 8) {
        const float* xr = x + (size_t)row * DM;
        f32x4 v[16]; float ss = 0.f;
#pragma unroll
        for (int i = 0; i < 16; ++i) { v[i] = *(const f32x4*)(xr + (i * 64 + lane) * 4); ss += v[i][0] * v[i][0] + v[i][1] * v[i][1] + v[i][2] * v[i][2] + v[i][3] * v[i][3]; }
#pragma unroll
        for (int o = 32; o >= 1; o >>= 1) ss += __shfl_xor(ss, o);
        const float rstd = rsqrtf(ss * (1.0f / DM) + EPSN);
        bf16_t* hr = h + (size_t)row * DM;
#pragma unroll
        for (int i = 0; i < 16; ++i) { const f32x4 g = *(const f32x4*)(gain + (i * 64 + lane) * 4);
            float y0 = v[i][0] * rstd * g[0], y1 = v[i][1] * rstd * g[1], y2 = v[i][2] * rstd * g[2], y3 = v[i][3] * rstd * g[3];
            if (q8s != 0.f) { y0 = emu_q8(y0, q8s); y1 = emu_q8(y1, q8s); y2 = emu_q8(y2, q8s); y3 = emu_q8(y3, q8s); }
            u32x2 w; w.x = pk2(y0, y1); w.y = pk2(y2, y3);
            *(u32x2*)(hr + (i * 64 + lane) * 4) = w; }
    }
}

DI void ld192(const bf16_t* p, int j8, float (&v)[24]) {
#pragma unroll
    for (int c = 0; c < 3; ++c) { const u32x4 w = *(const u32x4*)(p + (j8 + 8 * c) * 8);
        v[c * 8 + 0] = bflo(w.x); v[c * 8 + 1] = bfhi(w.x); v[c * 8 + 2] = bflo(w.y); v[c * 8 + 3] = bfhi(w.y);
        v[c * 8 + 4] = bflo(w.z); v[c * 8 + 5] = bfhi(w.z); v[c * 8 + 6] = bflo(w.w); v[c * 8 + 7] = bfhi(w.w); }
}
DI void st192(bf16_t* p, int j8, const float (&v)[24]) {
#pragma unroll
    for (int c = 0; c < 3; ++c) { u32x4 w; w.x = pk2(v[c * 8 + 0], v[c * 8 + 1]); w.y = pk2(v[c * 8 + 2], v[c * 8 + 3]); w.z = pk2(v[c * 8 + 4], v[c * 8 + 5]); w.w = pk2(v[c * 8 + 6], v[c * 8 + 7]);
        *(u32x4*)(p + (j8 + 8 * c) * 8) = w; }
}
DI float sum8(float s) { s += __shfl_xor(s, 1); s += __shfl_xor(s, 2); s += __shfl_xor(s, 4); return s; }

DI void phase_nsa_prep(const Params& P, int bid, int nb) {
    bf16_t* Y0 = (bf16_t*)(P.ws + OFF_Y0);
    bf16_t* KS = (bf16_t*)(P.ws + OFF_KS); bf16_t* KW = (bf16_t*)(P.ws + OFF_KW);
    bf16_t* ACK = (bf16_t*)(P.ws + OFF_ACK); bf16_t* ACV = (bf16_t*)(P.ws + OFF_ACV);
    const int tid = tid_opaque(), grp = (tid >> 3) & 15, j8 = tid & 7;
    for (int tok = bid * 4 + (tid >> 7); tok < MTOK; tok += nb * 4) {
        const int b = tok / SEQ, s = tok % SEQ;
        bf16_t* yr = Y0 + (size_t)tok * N1P;
        if (grp < 8) {
            const int g = grp & 3, br = grp >> 2;
            float v[24]; ld192(yr + (br ? C_KVW : C_KVS) + g * DK, j8, v);
            float ss = 0.f;
#pragma unroll
            for (int i = 0; i < 24; ++i) ss += v[i] * v[i];
            ss = sum8(ss);
            const float rstd = rsqrtf(ss * (1.0f / DK) + EPSN);
            const float* kn = P.nsa_k_norm + (br ? 2 : 1) * DK;
#pragma unroll
            for (int c = 0; c < 3; ++c)
#pragma unroll
                for (int e = 0; e < 8; ++e) v[c * 8 + e] *= rstd * kn[(j8 + 8 * c) * 8 + e];
            st192((br ? KW : KS) + ((size_t)(b * NG + g) * SEQ + s) * DK, j8, v);
        } else if (grp < 12) {
            const int g = grp - 8;
            float v[24]; ld192(yr + C_KVC + g * DK, j8, v);
#pragma unroll
            for (int k = 0; k < 2; ++k) {
                const int n = (s >> 4) - k, l = s - 16 * n;
                if (n >= 0 && n <= 254) {
                    float w[24];
#pragma unroll
                    for (int c = 0; c < 3; ++c)
#pragma unroll
                        for (int e = 0; e < 8; ++e) w[c * 8 + e] = v[c * 8 + e] + P.pe_k[l * DK + (j8 + 8 * c) * 8 + e];
                    st192(ACK + ((size_t)((b * NG + g) * 256 + n)) * 6144 + l * DK, j8, w);
                }
            }
        } else if (grp < 16) {
            const int g = grp - 12;
            const bf16_t* src = yr + C_KVC + NG * DK + g * DV;
            float v[16];
#pragma unroll
            for (int c = 0; c < 2; ++c) { const u32x4 w = *(const u32x4*)(src + (j8 + 8 * c) * 8);
                v[c * 8 + 0] = bflo(w.x); v[c * 8 + 1] = bfhi(w.x); v[c * 8 + 2] = bflo(w.y); v[c * 8 + 3] = bfhi(w.y);
                v[c * 8 + 4] = bflo(w.z); v[c * 8 + 5] = bfhi(w.z); v[c * 8 + 6] = bflo(w.w); v[c * 8 + 7] = bfhi(w.w); }
#pragma unroll
            for (int k = 0; k < 2; ++k) {
                const int n = (s >> 4) - k, l = s - 16 * n;
                if (n >= 0 && n <= 254) {
                    bf16_t* dst = ACV + ((size_t)((b * NG + g) * 256 + n)) * 4096 + l * DV;
#pragma unroll
                    for (int c = 0; c < 2; ++c) { float w[8];
#pragma unroll
                        for (int e = 0; e < 8; ++e) w[e] = v[c * 8 + e] + P.pe_v[l * DV + (j8 + 8 * c) * 8 + e];
                        u32x4 o; o.x = pk2(w[0], w[1]); o.y = pk2(w[2], w[3]); o.z = pk2(w[4], w[5]); o.w = pk2(w[6], w[7]);
                        *(u32x4*)(dst + (j8 + 8 * c) * 8) = o; }
                }
            }
        }
    }
    for (int i = bid * 512 + tid; i < 16 * (6144 + 4096) / 8; i += nb * 512) {
        const int per = (6144 + 4096) / 8, bg = i / per, c = i % per;
        const u32x4 z = {0u, 0u, 0u, 0u};
        if (c < 6144 / 8) *(u32x4*)(ACK + ((size_t)(bg * 256 + 255)) * 6144 + c * 8) = z;
        else *(u32x4*)(ACV + ((size_t)(bg * 256 + 255)) * 4096 + (c - 6144 / 8) * 8) = z;
    }
}

DI int swap23(int p) { return (p & ~0xC) | ((p & 4) << 1) | ((p & 8) >> 1); }
DI void phase_vt(LAS unsigned char* lds, const bf16_t* __restrict__ src, size_t src_stride, int col0, int col_step, int nhv, bf16_t* __restrict__ dst, int bid, int nb) {
    LAS bf16_t* tile = (LAS bf16_t*)lds;
    const int tid = tid_opaque();
    const int ntile = SEQ / 64, total = BATCH * nhv * ntile;
    for (int it = bid; it < total; it += nb) {
        const int mat = it / ntile, tt = it % ntile, b = mat / nhv, hv = mat % nhv;
        __syncthreads();
#pragma unroll
        for (int i = 0; i < 2; ++i) {
            const int q = tid + 512 * i, tok = q >> 4, ch = q & 15;
            const u32x4 w = *(const u32x4*)(src + (size_t)(b * SEQ + tt * 64 + tok) * src_stride + col0 + hv * col_step + ch * 8);
            *(LAS u32x4*)(tile + tok * 136 + ch * 8) = w;
        }
        __syncthreads();
        {
            const int dv = tid >> 2, kq = tid & 3;
            unsigned w[8];
#pragma unroll
            for (int e = 0; e < 8; ++e) {
                const int p0 = kq * 16 + 2 * e, p1 = p0 + 1;
                const int k0 = (p0 & ~15) | swap23(p0 & 15), k1 = (p1 & ~15) | swap23(p1 & 15);
                w[e] = (unsigned)tile[k0 * 136 + dv] | ((unsigned)tile[k1 * 136 + dv] << 16);
            }
            bf16_t* d = dst + ((size_t)mat * DV + dv) * SEQ + tt * 64 + kq * 16;
            u32x4 a = {w[0], w[1], w[2], w[3]}, c = {w[4], w[5], w[6], w[7]};
            *(u32x4*)d = a; *(u32x4*)(d + 8) = c;
        }
    }
}

DI void phase_cmp2(LAS unsigned char* lds, const Params& P, int bid, int nb) {
    LAS float* sk = (LAS float*)lds;
    LAS float* sv = sk + 192;
    LAS float* red = sv + 128;
    const float* HIDK = (const float*)(P.ws + OFF_HIDK); const float* HIDV = (const float*)(P.ws + OFF_HIDV);
    bf16_t* KC = (bf16_t*)(P.ws + OFF_KC); bf16_t* VTC = (bf16_t*)(P.ws + OFF_VTC);
    const int tid = tid_opaque(), lane = tid & 63, wid = tid >> 6;
    for (int m = bid; m < 4096; m += nb) {
        const int n = m & 255, bg = m >> 8;
        __syncthreads();
        if (tid < 192) { const float h = HIDK[(size_t)m * 256 + tid]; sk[tid] = h / (1.0f + __expf(-h)); }
        else if (tid < 320) { const float h = HIDV[(size_t)m * 256 + tid - 192]; sv[tid - 192] = h / (1.0f + __expf(-h)); }
        __syncthreads();
        float acc = 0.f;
        if (tid < 192) { for (int i = 0; i < 192; ++i) acc += sk[i] * P.w2_k[i * 192 + tid]; }
        else if (tid < 320) { const int j = tid - 192; for (int i = 0; i < 128; ++i) acc += sv[i] * P.w2_v[i * 128 + j]; }
        float ss = (tid < 192) ? acc * acc : 0.f;
#pragma unroll
        for (int o = 32; o >= 1; o >>= 1) ss += __shfl_xor(ss, o);
        if (lane == 0) red[wid] = ss;
        __syncthreads();
        const float tot = red[0] + red[1] + red[2];
        const float rstd = rsqrtf(tot * (1.0f / DK) + EPSN);
        if (tid < 192) { const float o = (n == 255) ? 0.f : acc * rstd * P.nsa_k_norm[tid];
            KC[(size_t)m * DK + tid] = (bf16_t)(pk2(o, 0.f) & 0xffffu); }
        else if (tid < 320) { const int j = tid - 192; const float o = (n == 255) ? 0.f : acc;
            const int pn = (n & ~15) | swap23(n & 15);
            VTC[((size_t)bg * DV + j) * 256 + pn] = (bf16_t)(pk2(o, 0.f) & 0xffffu); }
    }
}

DI void phase_mla_prep1(const Params& P, int bid, int nb) {
    const bf16_t* Y1 = (const bf16_t*)(P.ws + OFF_Y1);
    bf16_t* CQN = (bf16_t*)(P.ws + OFF_CQN); bf16_t* CKVN = (bf16_t*)(P.ws + OFF_CKVN); float* ROPE = (float*)(P.ws + OFF_ROPE);
    const int tid = tid_opaque(); const int lane = tid & 63, wid = tid >> 6;
    for (int tok = bid * 8 + wid; tok < MTOK; tok += nb * 8) {
        const bf16_t* yr = Y1 + (size_t)tok * N3P;
        {
            float v[24]; float ss = 0.f;
#pragma unroll
            for (int c = 0; c < 3; ++c) { const u32x4 w = *(const u32x4*)(yr + C3_CQ + (c * 64 + lane) * 8);
                v[c * 8 + 0] = bflo(w.x); v[c * 8 + 1] = bfhi(w.x); v[c * 8 + 2] = bflo(w.y); v[c * 8 + 3] = bfhi(w.y);
                v[c * 8 + 4] = bflo(w.z); v[c * 8 + 5] = bfhi(w.z); v[c * 8 + 6] = bflo(w.w); v[c * 8 + 7] = bfhi(w.w); }
#pragma unroll
            for (int i = 0; i < 24; ++i) ss += v[i] * v[i];
#pragma unroll
            for (int o = 32; o >= 1; o >>= 1) ss += __shfl_xor(ss, o);
            const float rstd = rsqrtf(ss * (1.0f / QLORA) + EPSN);
#pragma unroll
            for (int c = 0; c < 3; ++c) { const float* g = P.mla_q_a_norm + (c * 64 + lane) * 8; u32x4 w;
                w.x = pk2(v[c * 8 + 0] * rstd * g[0], v[c * 8 + 1] * rstd * g[1]); w.y = pk2(v[c * 8 + 2] * rstd * g[2], v[c * 8 + 3] * rstd * g[3]);
                w.z = pk2(v[c * 8 + 4] * rstd * g[4], v[c * 8 + 5] * rstd * g[5]); w.w = pk2(v[c * 8 + 6] * rstd * g[6], v[c * 8 + 7] * rstd * g[7]);
                *(u32x4*)(CQN + (size_t)tok * QLORA + (c * 64 + lane) * 8) = w; }
        }
        {
            float v[8]; float ss = 0.f;
            const u32x4 w0 = *(const u32x4*)(yr + C3_CKV + lane * 8);
            v[0] = bflo(w0.x); v[1] = bfhi(w0.x); v[2] = bflo(w0.y); v[3] = bfhi(w0.y); v[4] = bflo(w0.z); v[5] = bfhi(w0.z); v[6] = bflo(w0.w); v[7] = bfhi(w0.w);
#pragma unroll
            for (int i = 0; i < 8; ++i) ss += v[i] * v[i];
#pragma unroll
            for (int o = 32; o >= 1; o >>= 1) ss += __shfl_xor(ss, o);
            const float rstd = rsqrtf(ss * (1.0f / KVLORA) + EPSN);
            const float* g = P.mla_kv_a_norm + lane * 8; u32x4 w;
            w.x = pk2(v[0] * rstd * g[0], v[1] * rstd * g[1]); w.y = pk2(v[2] * rstd * g[2], v[3] * rstd * g[3]);
            w.z = pk2(v[4] * rstd * g[4], v[5] * rstd * g[5]); w.w = pk2(v[6] * rstd * g[6], v[7] * rstd * g[7]);
            *(u32x4*)(CKVN + (size_t)tok * KVLORA + lane * 8) = w;
        }
        if (lane < 32) {
            const float invf = exp2f(-(float)lane * (13.287712379549449f / 32.0f));
            const float ang = (float)P.pos[tok] * invf;
            float sn, cs; sincosf(ang, &sn, &cs);
            ROPE[(size_t)tok * 64 + lane] = cs; ROPE[(size_t)tok * 64 + 32 + lane] = sn;
            const float x1 = bf1(yr[C3_KPE + lane]), x2 = bf1(yr[C3_KPE + 32 + lane]);
            float ssp = x1 * x1 + x2 * x2;
#pragma unroll
            for (int o = 16; o >= 1; o >>= 1) ssp += __shfl_xor(ssp, o);
            const float a = x1 * P.mla_k_norm[128 + lane], c = x2 * P.mla_k_norm[160 + lane];
            float* KPER = (float*)(P.ws + OFF_KPER); float* SSPE = (float*)(P.ws + OFF_SSPE);
            KPER[(size_t)tok * 64 + lane] = a * cs - c * sn; KPER[(size_t)tok * 64 + 32 + lane] = c * cs + a * sn;
            if (lane == 0) SSPE[tok] = ssp;
        }
    }
}

DI void phase_mla_prep2(const Params& P, int bid, int nb) {
    const bf16_t* KNM = (const bf16_t*)(P.ws + OFF_KNM); const bf16_t* Y1 = (const bf16_t*)(P.ws + OFF_Y1);
    bf16_t* KM = (bf16_t*)(P.ws + OFF_KM); const float* ROPE = (const float*)(P.ws + OFF_ROPE);
    const int tid = tid_opaque(), grp = tid >> 3, j8 = tid & 7;
    for (int tok = bid; tok < MTOK; tok += nb) {
        const int b = tok / SEQ, s = tok % SEQ;
        float cs[8], sn[8];
#pragma unroll
        for (int e = 0; e < 8; ++e) { const int i = (8 * j8 + e) & 31; cs[e] = ROPE[(size_t)tok * 64 + i]; sn[e] = ROPE[(size_t)tok * 64 + 32 + i]; }
        {
            const bf16_t* kn = KNM + (size_t)tok * (NH * 128) + grp * 128;
            const bf16_t* kp = Y1 + (size_t)tok * N3P + C3_KPE;
            float v[24];
#pragma unroll
            for (int c = 0; c < 2; ++c) { const u32x4 w = *(const u32x4*)(kn + (j8 + 8 * c) * 8);
                v[c * 8 + 0] = bflo(w.x); v[c * 8 + 1] = bfhi(w.x); v[c * 8 + 2] = bflo(w.y); v[c * 8 + 3] = bfhi(w.y);
                v[c * 8 + 4] = bflo(w.z); v[c * 8 + 5] = bfhi(w.z); v[c * 8 + 6] = bflo(w.w); v[c * 8 + 7] = bfhi(w.w); }
            { const u32x4 w = *(const u32x4*)(kp + j8 * 8);
                v[16] = bflo(w.x); v[17] = bfhi(w.x); v[18] = bflo(w.y); v[19] = bfhi(w.y); v[20] = bflo(w.z); v[21] = bfhi(w.z); v[22] = bflo(w.w); v[23] = bfhi(w.w); }
            float ss = 0.f;
#pragma unroll
            for (int i = 0; i < 24; ++i) ss += v[i] * v[i];
            ss = sum8(ss);
            const float rstd = rsqrtf(ss * (1.0f / DK) + EPSN);
#pragma unroll
            for (int c = 0; c < 3; ++c)
#pragma unroll
                for (int e = 0; e < 8; ++e) v[c * 8 + e] *= rstd * P.mla_k_norm[(j8 + 8 * c) * 8 + e];
#pragma unroll
            for (int e = 0; e < 8; ++e) { const float mine = v[16 + e], other = __shfl_xor(mine, 4);
                v[16 + e] = (j8 < 4) ? (mine * cs[e] - other * sn[e]) : (mine * cs[e] + other * sn[e]); }
            st192(KM + ((size_t)(b * NH + grp) * SEQ + s) * DK, j8, v);
        }
    }
}
#ifndef PROBE_TOPK
#define PROBE_TOPK 1
#endif
#ifndef PROBE_EPI
#define PROBE_EPI 1
#endif
#ifndef NO_CMP1
#define NO_CMP1 0
#endif
#ifndef NO_CMP2
#define NO_CMP2 0
#endif
#ifndef NO_SEL
#define NO_SEL 0
#endif
#ifndef NO_WIN
#define NO_WIN 0
#endif
#ifndef PROBE_SEL2
#define PROBE_SEL2 0
#endif
#ifndef PROBE_WIN2
#define PROBE_WIN2 0
#endif
#ifndef ATT_THR
#define ATT_THR 30.0f
#endif
#ifndef ATT_PS_LIMIT
#define ATT_PS_LIMIT (16.0f * 1073741824.0f)
#endif
#ifndef ATT_DEP_MLA
#define ATT_DEP_MLA 5
#endif
#ifndef ATT_DEP_NSA
#define ATT_DEP_NSA 4
#endif
#ifndef ATT_SPLIT_MLA
#define ATT_SPLIT_MLA 0
#endif
#ifndef ATT_SPLIT_NSA
#define ATT_SPLIT_NSA 0
#endif
#ifndef ATT_KA_NSA
#define ATT_KA_NSA 2
#endif
constexpr int KT_BYTES = 64 * 384, VT_BYTES = 128 * 128;
constexpr int L_K = 0, L_V = 2 * KT_BYTES, L_LUT = L_V + 2 * VT_BYTES, LUT_PITCH = 129, L_X = L_LUT + 64 * LUT_PITCH * 4 + 16  , L_IL = L_X + 16 * 16 * 64 * 2, L_END = L_IL + 16 * 16 * 4, L_QS = L_X, L_P3 = L_X + 16 * 64 * 4;
static_assert(L_END <= 151552, "attention LDS");
enum { MODE_MLA = 0, MODE_CMP1 = 1, MODE_CMP2 = 2, MODE_SEL = 3, MODE_WIN = 4, MODE_CMPX = 5 };
#define MFMA32(a, b, c) __builtin_amdgcn_mfma_f32_32x32x16_bf16((a), (b), (c), 0, 0, 0)

struct AttnLane {
    int tq;
    int tw0, tw1;
    const LAS float* lutrow;
    float lut_far;
    unsigned long long mk0, mk1;
    int tk;
    int curblk;
    float inv_l;
    int tokidx;
    mutable float carry;
};

template <int MODE> DI bool tile_act(int j, const AttnLane& A) {
    if (MODE == MODE_MLA) return 64 * j <= A.tw1;
    else if (MODE == MODE_CMP1 || MODE == MODE_CMP2 || MODE == MODE_CMPX) return 1024 * j + 31 <= A.tw1;
    else if (MODE == MODE_SEL) return (((A.mk0 | A.mk1) >> j) & 1ull) != 0ull;
    else return (64 * j <= A.tw1) && (64 * j + 63 >= A.tw0 - 511);
}

template <int MODE, int H>
DI bool half_init(f32x16& p, int j, int hi, float m_run, const AttnLane& A) {
    if (MODE == MODE_MLA) {
#pragma unroll
        for (int r = 0; r < 16; ++r) p[r] = 0.f;
        return true;
    } else if (MODE == MODE_WIN || MODE == MODE_SEL) {
        const int dq = A.tq - 64 * j - 32 * H - 4 * hi;
        const bool far = (A.tw0 - (64 * j + 32 * H + 31) >= 113);
        if (far) {
#pragma unroll
            for (int r = 0; r < 16; ++r) p[r] = 0.f;
            return true;
        } else {
#pragma unroll
            for (int r = 0; r < 16; ++r) { int d = dq - ((r & 3) + 8 * (r >> 2)); d = d < 0 ? 0 : (d > 127 ? 127 : d); p[r] = A.lutrow[d] - m_run; }
            return false;
        }
    } else {
        const int dq = A.tq - 31 - 1024 * j - 512 * H - 64 * hi;
        const bool far = (A.tw0 - 31 - 16 * (64 * j + 32 * H + 31) >= 113);
        if (far) {
#pragma unroll
            for (int r = 0; r < 16; ++r) p[r] = 0.f;
            return true;
        } else {
#pragma unroll
            for (int r = 0; r < 16; ++r) { int d = dq - 16 * ((r & 3) + 8 * (r >> 2)); d = d < 0 ? 0 : (d > 127 ? 127 : d); p[r] = A.lutrow[d] - m_run; }
            return false;
        }
    }
}
DI void half_fix(f32x16& p, bool zero_init, float m_run) {
    if (zero_init && __any(m_run != 0.f)) {
#pragma unroll
        for (int r = 0; r < 16; ++r) p[r] -= m_run;
    }
}
template <int MODE, int H>
DI void half_mask(f32x16& p, int j, int hi, const AttnLane& A) {
    const float NEG = -__builtin_inff();
    if (MODE == MODE_MLA) {
        if (64 * j + 32 * H + 31 > A.tw0) {
            const int dq = A.tq - 64 * j - 32 * H - 4 * hi;
#pragma unroll
            for (int r = 0; r < 16; ++r) p[r] = (dq - ((r & 3) + 8 * (r >> 2)) < 0) ? NEG : p[r];
        }
    } else if (MODE == MODE_WIN) {
        const int k0 = 64 * j + 32 * H;
        if (!(k0 + 31 <= A.tw0 && k0 >= A.tw1 - 511)) {
            const int dq = A.tq - k0 - 4 * hi;
#pragma unroll
            for (int r = 0; r < 16; ++r) p[r] = ((unsigned)(dq - ((r & 3) + 8 * (r >> 2))) >= 512u) ? NEG : p[r];
        }
    } else if (MODE == MODE_SEL) {
        if (j == A.curblk) {
            const int dq = A.tq - 64 * j - 32 * H - 4 * hi;
#pragma unroll
            for (int r = 0; r < 16; ++r) p[r] = (dq - ((r & 3) + 8 * (r >> 2)) < 0) ? NEG : p[r];
        }
    } else {
        if (A.tw0 - 31 - 16 * (64 * j + 32 * H + 31) < 0) {
            const int dq = A.tq - 31 - 1024 * j - 512 * H - 64 * hi;
#pragma unroll
            for (int r = 0; r < 16; ++r) p[r] = (dq - 16 * ((r & 3) + 8 * (r >> 2)) < 0) ? NEG : p[r];
        }
    }
}
template <int MODE>
DI void sel_zero(u32x4& wa, u32x4& wb, float& ps, int j, const AttnLane& A) {
    if (MODE == MODE_SEL) {
        const bool s0_ = ((A.mk0 >> j) & 1ull) != 0ull, s1_ = ((A.mk1 >> j) & 1ull) != 0ull; const bool sel = A.tk ? s1_ : s0_;
        const unsigned msk = sel ? 0xffffffffu : 0u;
        wa.x &= msk; wa.y &= msk; wa.z &= msk; wa.w &= msk; wb.x &= msk; wb.y &= msk; wb.z &= msk; wb.w &= msk;
        ps = sel ? ps : 0.f;
    }
}
template <int H, int DEP>
DI void half_qk(f32x16& p, const LAS unsigned char* kb, const int (&kbase)[4], const bf16x8 (&q)[12]) {
    bf16x8 f[DEP + 1];
#pragma unroll
    for (int d0 = 0; d0 < DEP; ++d0) f[d0] = *(const LAS bf16x8*)(kb + kbase[d0 & 3] + (d0 >> 2) * 128 + H * (32 * 384));
    __builtin_amdgcn_sched_barrier(0);
#pragma unroll
    for (int d0 = 0; d0 < 12; ++d0) {
        if (d0 + DEP < 12) { const int dn = d0 + DEP; f[dn % (DEP + 1)] = *(const LAS bf16x8*)(kb + kbase[dn & 3] + (dn >> 2) * 128 + H * (32 * 384)); }
        __builtin_amdgcn_sched_barrier(0);
        p = MFMA32(f[d0 % (DEP + 1)], q[d0], p);
        __builtin_amdgcn_sched_barrier(0);
    }
}
DI unsigned sm_pair(const f32x16& p, int e0, float& ps, float& mx) {
    const float a = __builtin_amdgcn_exp2f(p[e0]), b = __builtin_amdgcn_exp2f(p[e0 + 1]);
    ps += a + b; (void)mx;
    return pk2(a, b);
}
template <bool HASV>
DI void half_exact(f32x16& p, f32x16* pend, f32x16 (&o)[4], float& m_run, float& l_run, u32x4& wa, u32x4& wb, float& ps) {
    float mx = p[0];
#pragma unroll
    for (int r = 1; r < 16; ++r) mx = fmaxf(mx, p[r]);
    mx = fmaxf(mx, __shfl_xor(mx, 32));
    const float dl = fmaxf(mx, 0.f);
    const float alpha = __builtin_amdgcn_exp2f(-dl);
    m_run += dl; l_run *= alpha;
    if (HASV) {
#pragma unroll
        for (int d = 0; d < 4; ++d)
#pragma unroll
            for (int r = 0; r < 16; ++r) o[d][r] *= alpha;
    }
    if (pend) {
#pragma unroll
        for (int r = 0; r < 16; ++r) (*pend)[r] -= dl;
    }
    ps = 0.f; float dm = 0.f;
#pragma unroll
    for (int r = 0; r < 16; ++r) p[r] -= dl;
    wa.x = sm_pair(p, 0, ps, dm); wa.y = sm_pair(p, 2, ps, dm); wa.z = sm_pair(p, 4, ps, dm); wa.w = sm_pair(p, 6, ps, dm);
    wb.x = sm_pair(p, 8, ps, dm); wb.y = sm_pair(p, 10, ps, dm); wb.z = sm_pair(p, 12, ps, dm); wb.w = sm_pair(p, 14, ps, dm);
}

template <int MODE>
DI void attn_tile2(const LAS unsigned char* kb, const LAS unsigned char* vb, LAS unsigned char* lds, int j, int lane, const bf16x8 (&q)[12],
                   f32x16 (&o)[4], float& m_run, float& l_run, const AttnLane& A) {
    constexpr bool HASV = (MODE != MODE_CMP1);
    constexpr int DEP = (MODE == MODE_MLA) ? ATT_DEP_MLA : ATT_DEP_NSA;
    const int hi = lane >> 5, r32 = lane & 31;
    int kbase[4], vbase[4];
#pragma unroll
    for (int dd = 0; dd < 4; ++dd) { kbase[dd] = r32 * 384 + (((2 * dd + hi) ^ ((r32 >> 1) & 7)) << 4); vbase[dd] = r32 * 128 + (((2 * dd + hi) ^ ((r32 >> 1) & 7)) << 4); }
    f32x16 p0, p1;
    if (MODE == MODE_CMPX) {
        const bool z0_ = half_init<MODE, 0>(p0, j, hi, m_run, A), z1_ = half_init<MODE, 1>(p1, j, hi, m_run, A);
        {
            constexpr int KA = ATT_KA_NSA;
            bf16x8 fa[KA + 1], fb[KA + 1];
#pragma unroll
            for (int d0 = 0; d0 < KA; ++d0) { const LAS unsigned char* a_ = kb + kbase[d0 & 3] + (d0 >> 2) * 128; fa[d0] = *(const LAS bf16x8*)a_; fb[d0] = *(const LAS bf16x8*)(a_ + 32 * 384); }
            __builtin_amdgcn_sched_barrier(0);
#pragma unroll
            for (int d0 = 0; d0 < 12; ++d0) {
                if (d0 + KA < 12) { const int dn = d0 + KA; const LAS unsigned char* a_ = kb + kbase[dn & 3] + (dn >> 2) * 128;
                    fa[dn % (KA + 1)] = *(const LAS bf16x8*)a_; fb[dn % (KA + 1)] = *(const LAS bf16x8*)(a_ + 32 * 384); }
                __builtin_amdgcn_sched_barrier(0);
                p0 = MFMA32(fa[d0 % (KA + 1)], q[d0], p0);
                p1 = MFMA32(fb[d0 % (KA + 1)], q[d0], p1);
                __builtin_amdgcn_sched_barrier(0);
            }
        }
        half_fix(p0, z0_, m_run); half_fix(p1, z1_, m_run);
        half_mask<MODE, 0>(p0, j, hi, A); half_mask<MODE, 1>(p1, j, hi, A);
        LAS bf16_t* X = (LAS bf16_t*)(lds + L_X) + (A.tokidx * 16 + (lane & 15)) * 64;
#pragma unroll
        for (int h = 0; h < 2; ++h) {
            f32x16& p = h ? p1 : p0;
            float lmx = p[0];
#pragma unroll
            for (int r = 1; r < 16; ++r) lmx = fmaxf(lmx, p[r]);
            if (__any(lmx > ATT_THR)) {
                const float mx = fmaxf(lmx, __shfl_xor(lmx, 32));
                const float dl = fmaxf(mx, 0.f), alpha = __builtin_amdgcn_exp2f(-dl);
                m_run += dl; l_run *= alpha; A.carry *= alpha;
#pragma unroll
                for (int d = 0; d < 4; ++d)
#pragma unroll
                    for (int r = 0; r < 16; ++r) o[d][r] *= alpha;
#pragma unroll
                for (int r = 0; r < 16; ++r) p[r] -= dl;
                if (h == 0) {
#pragma unroll
                    for (int r = 0; r < 16; ++r) p1[r] -= dl;
                }
                const int qb = 16 * j + 8 * h;
                for (int a = hi; a < qb; a += 2) X[a] = (bf16_t)(pk2(bf1(X[a]) * alpha, 0.f) & 0xffffu);
            }
            float e[16]; float ps = 0.f;
#pragma unroll
            for (int r = 0; r < 16; ++r) { e[r] = __builtin_amdgcn_exp2f(p[r]); ps += e[r]; }
            l_run += ps;
            float y[4];
#pragma unroll
            for (int k = 0; k < 4; ++k) y[k] = __shfl_xor(e[4 * k + 3], 32);
#pragma unroll
            for (int k = 0; k < 4; ++k) { const float prev = hi ? y[k] : (k ? y[k > 0 ? k - 1 : 0] : A.carry);
                const float sblk = (e[4 * k] + e[4 * k + 1]) + (e[4 * k + 2] + e[4 * k + 3]) + prev;
                X[16 * j + 8 * h + 2 * k + hi] = (bf16_t)(pk2(sblk, 0.f) & 0xffffu); }
            if (!hi) A.carry = y[3];
            u32x4 wa, wb;
            wa.x = pk2(e[0], e[1]); wa.y = pk2(e[2], e[3]); wa.z = pk2(e[4], e[5]); wa.w = pk2(e[6], e[7]);
            wb.x = pk2(e[8], e[9]); wb.y = pk2(e[10], e[11]); wb.z = pk2(e[12], e[13]); wb.w = pk2(e[14], e[15]);
            const bf16x8 pba = __builtin_bit_cast(bf16x8, wa), pbb = __builtin_bit_cast(bf16x8, wb);
#pragma unroll
            for (int i = 0; i < 8; ++i) { const bf16x8 va = *(const LAS bf16x8*)(vb + vbase[2 * h + (i >> 2)] + (i & 3) * (32 * 128)); o[i & 3] = MFMA32(va, (i < 4) ? pba : pbb, o[i & 3]); }
        }
        return;
    }
    if (MODE == MODE_CMP2) {
        { const bool z_ = half_init<MODE, 0>(p0, j, hi, m_run, A); half_qk<0, DEP>(p0, kb, kbase, q); half_fix(p0, z_, m_run); half_mask<MODE, 0>(p0, j, hi, A); }
        { const bool z_ = half_init<MODE, 1>(p1, j, hi, m_run, A); half_qk<1, DEP>(p1, kb, kbase, q); half_fix(p1, z_, m_run); half_mask<MODE, 1>(p1, j, hi, A); }
        const float il = A.inv_l;
#pragma unroll
        for (int r = 0; r < 16; ++r) { p0[r] = __builtin_amdgcn_exp2f(p0[r]) * il; p1[r] = __builtin_amdgcn_exp2f(p1[r]) * il; }
        float v[16];
#pragma unroll
        for (int k = 0; k < 4; ++k) { v[k] = (p0[4 * k] + p0[4 * k + 1]) + (p0[4 * k + 2] + p0[4 * k + 3]); v[4 + k] = (p1[4 * k] + p1[4 * k + 1]) + (p1[4 * k + 2] + p1[4 * k + 3]);
            v[8 + k] = p0[4 * k + 3]; v[12 + k] = p1[4 * k + 3]; }
        { const bool up = (lane & 8) != 0;
#pragma unroll
          for (int i = 0; i < 8; ++i) { const float send = up ? v[i] : v[i + 8]; const float recv = __shfl_xor(send, 8); const float keep = up ? v[i + 8] : v[i]; v[i] = keep + recv; } }
        { const bool up = (lane & 4) != 0;
#pragma unroll
          for (int i = 0; i < 4; ++i) { const float send = up ? v[i] : v[i + 4]; const float recv = __shfl_xor(send, 4); const float keep = up ? v[i + 4] : v[i]; v[i] = keep + recv; } }
        { const bool up = (lane & 2) != 0;
#pragma unroll
          for (int i = 0; i < 2; ++i) { const float send = up ? v[i] : v[i + 2]; const float recv = __shfl_xor(send, 2); const float keep = up ? v[i + 2] : v[i]; v[i] = keep + recv; } }
        { const bool up = (lane & 1) != 0;
          const float send = up ? v[0] : v[1]; const float recv = __shfl_xor(send, 1); const float keep = up ? v[1] : v[0]; v[0] = keep + recv; }
        { const int idx = lane & 15, half = (idx >> 2) & 1, k = idx & 3, isp3 = idx >> 3;
          const int quad = 16 * j + 8 * half + 2 * k + hi;
          LAS float* dst = (LAS float*)(lds + (isp3 ? L_P3 : L_QS)) + A.tokidx * 64 + quad;
          *dst = v[0]; }
#pragma unroll
        for (int ks = 0; ks < 4; ++ks) {
            u32x4 w;
            if (ks == 0) { w.x = pk2(p0[0], p0[1]); w.y = pk2(p0[2], p0[3]); w.z = pk2(p0[4], p0[5]); w.w = pk2(p0[6], p0[7]); }
            else if (ks == 1) { w.x = pk2(p0[8], p0[9]); w.y = pk2(p0[10], p0[11]); w.z = pk2(p0[12], p0[13]); w.w = pk2(p0[14], p0[15]); }
            else if (ks == 2) { w.x = pk2(p1[0], p1[1]); w.y = pk2(p1[2], p1[3]); w.z = pk2(p1[4], p1[5]); w.w = pk2(p1[6], p1[7]); }
            else { w.x = pk2(p1[8], p1[9]); w.y = pk2(p1[10], p1[11]); w.z = pk2(p1[12], p1[13]); w.w = pk2(p1[14], p1[15]); }
            const bf16x8 pb = __builtin_bit_cast(bf16x8, w);
#pragma unroll
            for (int d = 0; d < 4; ++d) { const bf16x8 va = *(const LAS bf16x8*)(vb + vbase[ks] + d * (32 * 128)); o[d] = MFMA32(va, pb, o[d]); }
        }
        return;
    }
    u32x4 wa, wb; float ps = 0.f, mx = -__builtin_inff();
    if ((MODE == MODE_MLA && ATT_SPLIT_MLA) || (MODE != MODE_MLA && ATT_SPLIT_NSA)) {
    { const bool z_ = half_init<MODE, 0>(p0, j, hi, m_run, A);
    half_qk<0, DEP>(p0, kb, kbase, q);
    half_fix(p0, z_, m_run); }
    half_mask<MODE, 0>(p0, j, hi, A);
    const bool zs1_ = half_init<MODE, 1>(p1, j, hi, m_run, A);
    {
        bf16x8 f[DEP + 1];
#pragma unroll
        for (int d0 = 0; d0 < DEP; ++d0) f[d0] = *(const LAS bf16x8*)(kb + kbase[d0 & 3] + (d0 >> 2) * 128 + 32 * 384);
        __builtin_amdgcn_sched_barrier(0);
#pragma unroll
        for (int d0 = 0; d0 < 12; ++d0) {
            if (d0 + DEP < 12) { const int dn = d0 + DEP; f[dn % (DEP + 1)] = *(const LAS bf16x8*)(kb + kbase[dn & 3] + (dn >> 2) * 128 + 32 * 384); }
            __builtin_amdgcn_sched_barrier(0);
            p1 = MFMA32(f[d0 % (DEP + 1)], q[d0], p1);
            if (d0 == 0) wa.x = sm_pair(p0, 0, ps, mx); else if (d0 == 1) wa.y = sm_pair(p0, 2, ps, mx); else if (d0 == 2) wa.z = sm_pair(p0, 4, ps, mx); else if (d0 == 3) wa.w = sm_pair(p0, 6, ps, mx);
            else if (d0 == 4) wb.x = sm_pair(p0, 8, ps, mx); else if (d0 == 5) wb.y = sm_pair(p0, 10, ps, mx); else if (d0 == 6) wb.z = sm_pair(p0, 12, ps, mx); else if (d0 == 7) wb.w = sm_pair(p0, 14, ps, mx);
            __builtin_amdgcn_sched_barrier(0);
        }
    }
    half_fix(p1, zs1_, m_run);
    } else {
    const bool zc0_ = half_init<MODE, 0>(p0, j, hi, m_run, A);
    const bool zc1_ = half_init<MODE, 1>(p1, j, hi, m_run, A);
    {
        constexpr int KA = ATT_KA_NSA;
        bf16x8 fa[KA + 1], fb[KA + 1];
#pragma unroll
        for (int d0 = 0; d0 < KA; ++d0) { const LAS unsigned char* a_ = kb + kbase[d0 & 3] + (d0 >> 2) * 128; fa[d0] = *(const LAS bf16x8*)a_; fb[d0] = *(const LAS bf16x8*)(a_ + 32 * 384); }
        __builtin_amdgcn_sched_barrier(0);
#pragma unroll
        for (int d0 = 0; d0 < 12; ++d0) {
            if (d0 + KA < 12) { const int dn = d0 + KA; const LAS unsigned char* a_ = kb + kbase[dn & 3] + (dn >> 2) * 128;
                fa[dn % (KA + 1)] = *(const LAS bf16x8*)a_; fb[dn % (KA + 1)] = *(const LAS bf16x8*)(a_ + 32 * 384); }
            __builtin_amdgcn_sched_barrier(0);
            p0 = MFMA32(fa[d0 % (KA + 1)], q[d0], p0);
            p1 = MFMA32(fb[d0 % (KA + 1)], q[d0], p1);
            __builtin_amdgcn_sched_barrier(0);
        }
    }
    half_fix(p0, zc0_, m_run); half_fix(p1, zc1_, m_run);
    half_mask<MODE, 0>(p0, j, hi, A);
    wa.x = sm_pair(p0, 0, ps, mx); wa.y = sm_pair(p0, 2, ps, mx); wa.z = sm_pair(p0, 4, ps, mx); wa.w = sm_pair(p0, 6, ps, mx);
    wb.x = sm_pair(p0, 8, ps, mx); wb.y = sm_pair(p0, 10, ps, mx); wb.z = sm_pair(p0, 12, ps, mx); wb.w = sm_pair(p0, 14, ps, mx);
    }
    half_mask<MODE, 1>(p1, j, hi, A);
    if (__any(!(ps <= ATT_PS_LIMIT))) {
        half_exact<HASV>(p0, &p1, o, m_run, l_run, wa, wb, ps);
    }
    sel_zero<MODE>(wa, wb, ps, j, A);
    l_run += ps;
    u32x4 wc, wd; float ps1 = 0.f, mx1 = -__builtin_inff();
    if (HASV) {
        const bf16x8 pba = __builtin_bit_cast(bf16x8, wa), pbb = __builtin_bit_cast(bf16x8, wb);
        bf16x8 f[DEP + 1];
#pragma unroll
        for (int i = 0; i < DEP; ++i) f[i] = *(const LAS bf16x8*)(vb + vbase[i >> 2] + (i & 3) * (32 * 128));
        __builtin_amdgcn_sched_barrier(0);
#pragma unroll
        for (int i = 0; i < 8; ++i) {
            if (i + DEP < 8) { const int in_ = i + DEP; f[in_ % (DEP + 1)] = *(const LAS bf16x8*)(vb + vbase[in_ >> 2] + (in_ & 3) * (32 * 128)); }
            __builtin_amdgcn_sched_barrier(0);
            o[i & 3] = MFMA32(f[i % (DEP + 1)], (i < 4) ? pba : pbb, o[i & 3]);
            if (i == 0) wc.x = sm_pair(p1, 0, ps1, mx1); else if (i == 1) wc.y = sm_pair(p1, 2, ps1, mx1); else if (i == 2) wc.z = sm_pair(p1, 4, ps1, mx1); else if (i == 3) wc.w = sm_pair(p1, 6, ps1, mx1);
            else if (i == 4) wd.x = sm_pair(p1, 8, ps1, mx1); else if (i == 5) wd.y = sm_pair(p1, 10, ps1, mx1); else if (i == 6) wd.z = sm_pair(p1, 12, ps1, mx1); else wd.w = sm_pair(p1, 14, ps1, mx1);
            __builtin_amdgcn_sched_barrier(0);
        }
    } else {
        wc.x = sm_pair(p1, 0, ps1, mx1); wc.y = sm_pair(p1, 2, ps1, mx1); wc.z = sm_pair(p1, 4, ps1, mx1); wc.w = sm_pair(p1, 6, ps1, mx1);
        wd.x = sm_pair(p1, 8, ps1, mx1); wd.y = sm_pair(p1, 10, ps1, mx1); wd.z = sm_pair(p1, 12, ps1, mx1); wd.w = sm_pair(p1, 14, ps1, mx1);
    }
    if (__any(!(ps1 <= ATT_PS_LIMIT))) {
        half_exact<HASV>(p1, nullptr, o, m_run, l_run, wc, wd, ps1);
    }
    sel_zero<MODE>(wc, wd, ps1, j, A);
    l_run += ps1;
    if (HASV) {
        const bf16x8 pbc = __builtin_bit_cast(bf16x8, wc), pbd = __builtin_bit_cast(bf16x8, wd);
        bf16x8 f[DEP + 1];
#pragma unroll
        for (int i = 0; i < DEP; ++i) f[i] = *(const LAS bf16x8*)(vb + vbase[2 + (i >> 2)] + (i & 3) * (32 * 128));
        __builtin_amdgcn_sched_barrier(0);
#pragma unroll
        for (int i = 0; i < 8; ++i) {
            if (i + DEP < 8) { const int in_ = i + DEP; f[in_ % (DEP + 1)] = *(const LAS bf16x8*)(vb + vbase[2 + (in_ >> 2)] + (in_ & 3) * (32 * 128)); }
            __builtin_amdgcn_sched_barrier(0);
            o[i & 3] = MFMA32(f[i % (DEP + 1)], (i < 4) ? pbc : pbd, o[i & 3]);
            __builtin_amdgcn_sched_barrier(0);
        }
    }
}

template <int MODE>
DI void attn_pass2(LAS unsigned char* lds, const char* __restrict__ Kc, const char* __restrict__ Vc, int vt_stride, int j_lo, int j_hi,
                   const bf16x8 (&q)[12], f32x16 (&o)[4], float& m_run, float& l_run, const AttnLane& A) {
    if (j_lo >= j_hi) return;
    constexpr bool HASV = (MODE != MODE_CMP1);
    int tid = threadIdx.x; asm volatile("" : "+v"(tid));
    const int lane = tid & 63;
    const int wid_ = __builtin_amdgcn_readfirstlane(tid >> 6);
#define ST_ISSUE(j, buf) do { int ln_ = lane; asm volatile("" : "+v"(ln_)); \
        const char* kp_ = Kc + (size_t)(j) * KT_BYTES; LAS unsigned char* kb_ = lds + L_K + (buf) * KT_BYTES + wid_ * 3072; \
        _Pragma("unroll") for (int i_ = 0; i_ < 3; ++i_) { const int pidx_ = (wid_ * 3 + i_) * 64 + ln_, row_ = pidx_ / 24, cp_ = pidx_ % 24; \
            __builtin_amdgcn_global_load_lds((const unsigned*)(kp_ + (unsigned)(row_ * 384 + ((cp_ ^ ((row_ >> 1) & 7)) << 4))), (LAS unsigned*)(kb_ + i_ * 1024), 16, 0, 0); } \
        if (HASV) { const char* vp_ = Vc + (size_t)(j) * 128; LAS unsigned char* vb_ = lds + L_V + (buf) * VT_BYTES + wid_ * 2048; \
            _Pragma("unroll") for (int i_ = 0; i_ < 2; ++i_) { const int pidx_ = (wid_ * 2 + i_) * 64 + ln_, row_ = pidx_ >> 3, cp_ = pidx_ & 7; \
                __builtin_amdgcn_global_load_lds((const unsigned*)(vp_ + (unsigned)(row_ * vt_stride * 2 + ((cp_ ^ ((row_ >> 1) & 7)) << 4))), (LAS unsigned*)(vb_ + i_ * 1024), 16, 0, 0); } } } while (0)
    ST_ISSUE(j_lo, 0);
    asm volatile("s_waitcnt vmcnt(0)" ::: "memory");
    __syncthreads();
    for (int j = j_lo; j < j_hi; ++j) {
        const int cur = (j - j_lo) & 1;
        if (j + 1 < j_hi) ST_ISSUE(j + 1, cur ^ 1);
        if (tile_act<MODE>(j, A)) attn_tile2<MODE>(lds + L_K + cur * KT_BYTES, lds + L_V + cur * VT_BYTES, lds, j, lane, q, o, m_run, l_run, A);
        asm volatile("s_waitcnt vmcnt(0)" ::: "memory");
        __syncthreads();
    }
#undef ST_ISSUE
}

template <int MODE>
DI void attn_pass3(LAS unsigned char* lds, const char* __restrict__ Kc, const char* __restrict__ Vc, int vt_stride, int j_lo, int j_hi,
                   const bf16x8 (&q)[12], f32x16 (&o)[4], float& m_run, float& l_run, const AttnLane& A) {
    if (j_lo >= j_hi) return;
    constexpr bool HASV = (MODE != MODE_CMP1);
    constexpr int L3_V = 3 * KT_BYTES;
    int tid = threadIdx.x; asm volatile("" : "+v"(tid));
    const int lane = tid & 63;
    const int wid_ = __builtin_amdgcn_readfirstlane(tid >> 6);
    const int T = j_hi - j_lo;
#define ST3_ISSUE(j, slot) do { int ln_ = lane; asm volatile("" : "+v"(ln_)); \
        const char* kp_ = Kc + (size_t)(j) * KT_BYTES; LAS unsigned char* kb_ = lds + (slot) * KT_BYTES + wid_ * 3072; \
        _Pragma("unroll") for (int i_ = 0; i_ < 3; ++i_) { const int pidx_ = (wid_ * 3 + i_) * 64 + ln_, row_ = pidx_ / 24, cp_ = pidx_ % 24; \
            __builtin_amdgcn_global_load_lds((const unsigned*)(kp_ + (unsigned)(row_ * 384 + ((cp_ ^ ((row_ >> 1) & 7)) << 4))), (LAS unsigned*)(kb_ + i_ * 1024), 16, 0, 0); } \
        if (HASV) { const char* vp_ = Vc + (size_t)(j) * 128; LAS unsigned char* vb_ = lds + L3_V + (slot) * VT_BYTES + wid_ * 2048; \
            _Pragma("unroll") for (int i_ = 0; i_ < 2; ++i_) { const int pidx_ = (wid_ * 2 + i_) * 64 + ln_, row_ = pidx_ >> 3, cp_ = pidx_ & 7; \
                __builtin_amdgcn_global_load_lds((const unsigned*)(vp_ + (unsigned)(row_ * vt_stride * 2 + ((cp_ ^ ((row_ >> 1) & 7)) << 4))), (LAS unsigned*)(vb_ + i_ * 1024), 16, 0, 0); } } } while (0)
    ST3_ISSUE(j_lo, 0);
    if (T > 1) ST3_ISSUE(j_lo + 1, 1);
    int slot = 0;
    for (int t = 0; t < T; ++t) {
        const int j = j_lo + t;
        if (t + 1 < T) { if (HASV) asm volatile("s_waitcnt vmcnt(5)" ::: "memory"); else asm volatile("s_waitcnt vmcnt(3)" ::: "memory"); }
        else asm volatile("s_waitcnt vmcnt(0)" ::: "memory");
        asm volatile("" ::: "memory"); __builtin_amdgcn_s_barrier(); asm volatile("" ::: "memory");
        if (t + 2 < T) { const int s2 = (slot >= 1) ? slot - 1 : 2; ST3_ISSUE(j + 2, s2); }
        if (tile_act<MODE>(j, A)) attn_tile2<MODE>(lds + slot * KT_BYTES, lds + L3_V + slot * VT_BYTES, lds, j, lane, q, o, m_run, l_run, A);
        slot = (slot == 2) ? 0 : slot + 1;
    }
    asm volatile("" ::: "memory"); __builtin_amdgcn_s_barrier(); asm volatile("" ::: "memory");
#undef ST3_ISSUE
}

DI int t5_bucket(int n) {
    if (n < 16) return n;
    return 16 + (n >= 19) + (n >= 21) + (n >= 24) + (n >= 27) + (n >= 31) + (n >= 35) + (n >= 40) + (n >= 46) + (n >= 52) + (n >= 59) + (n >= 67) + (n >= 77) + (n >= 87) + (n >= 99) + (n >= 113);
}
DI float silu_f(float z) { return z * __builtin_amdgcn_rcpf(1.0f + __builtin_amdgcn_exp2f(-1.4426950408889634f * z)); }

constexpr int EPI_PITCH = 272, EPI_WAVE_BYTES = 32 * EPI_PITCH;
template <bool RMW, bool NSA, int Q8>
DI void attn_epilogue_t(LAS unsigned char* lds, int lane, int wid, const f32x16 (&o)[4], float scale,
                        const char* __restrict__ zbase, unsigned z0, char* __restrict__ obase, unsigned o0) {
    LAS unsigned char* sc = lds + wid * EPI_WAVE_BYTES;
    const int r32 = lane & 31, hi = lane >> 5;
#pragma unroll
    for (int h = 0; h < 2; ++h) {
#pragma unroll
        for (int dd = 0; dd < 2; ++dd)
#pragma unroll
            for (int kq = 0; kq < 4; ++kq) {
                f32x4 v; v[0] = o[2 * h + dd][4 * kq + 0] * scale; v[1] = o[2 * h + dd][4 * kq + 1] * scale; v[2] = o[2 * h + dd][4 * kq + 2] * scale; v[3] = o[2 * h + dd][4 * kq + 3] * scale;
                *(LAS f32x4*)(sc + r32 * EPI_PITCH + (32 * dd + 8 * kq + 4 * hi) * 4) = v;
            }
        asm volatile("" ::: "memory");
#pragma unroll
        for (int i = 0; i < 4; ++i) {
            const int rr = 8 * i + (lane >> 3), c8 = lane & 7;
            const f32x4 a = *(const LAS f32x4*)(sc + rr * EPI_PITCH + c8 * 32);
            const f32x4 b = *(const LAS f32x4*)(sc + rr * EPI_PITCH + c8 * 32 + 16);
            unsigned zoff, ooff;
            if (NSA) { zoff = z0 + (unsigned)((rr >> 4) * (N1P * 2) + (rr & 15) * 256); ooff = o0 + (unsigned)((rr >> 4) * (ZW8 * 2) + (rr & 15) * 256); }
            else     { zoff = z0 + (unsigned)(rr * (N3P * 2)); ooff = o0 + (unsigned)(rr * (ZW8 * 2)); }
            const unsigned cb = (unsigned)((64 * h + 8 * c8) * 2);
            const u32x4 zw = *(const u32x4*)(zbase + (zoff + cb));
            float v0 = a[0] * silu_f(bflo(zw.x)), v1 = a[1] * silu_f(bfhi(zw.x)), v2 = a[2] * silu_f(bflo(zw.y)), v3 = a[3] * silu_f(bfhi(zw.y));
            float v4 = b[0] * silu_f(bflo(zw.z)), v5 = b[1] * silu_f(bfhi(zw.z)), v6 = b[2] * silu_f(bflo(zw.w)), v7 = b[3] * silu_f(bfhi(zw.w));
            if (RMW) { const u32x4 pw = *(const u32x4*)(obase + (ooff + cb));
                v0 += bflo(pw.x); v1 += bfhi(pw.x); v2 += bflo(pw.y); v3 += bfhi(pw.y); v4 += bflo(pw.z); v5 += bfhi(pw.z); v6 += bflo(pw.w); v7 += bfhi(pw.w); }
            if (Q8) { v0 = emu_q8(v0, 64.0f); v1 = emu_q8(v1, 64.0f); v2 = emu_q8(v2, 64.0f); v3 = emu_q8(v3, 64.0f); v4 = emu_q8(v4, 64.0f); v5 = emu_q8(v5, 64.0f); v6 = emu_q8(v6, 64.0f); v7 = emu_q8(v7, 64.0f); }
            u32x4 w; w.x = pk2(v0, v1); w.y = pk2(v2, v3); w.z = pk2(v4, v5); w.w = pk2(v6, v7);
            *(u32x4*)(obase + (ooff + cb)) = w;
        }
        asm volatile("" ::: "memory");
    }
}

DI void phase_nsa_attn(LAS unsigned char* lds, const Params& P, int bid, int nb) {
    const char* Y0c = (const char*)(P.ws + OFF_Y0);
    const char* KSc = (const char*)(P.ws + OFF_KS); const char* KWc = (const char*)(P.ws + OFF_KW);
    const char* VTSc = (const char*)(P.ws + OFF_VTS); const char* VTWc = (const char*)(P.ws + OFF_VTW);
    const char* KCc = (const char*)(P.ws + OFF_KC); const char* VTCc = (const char*)(P.ws + OFF_VTC);
    char* ONc = (char*)(P.ws + OFF_O);
    LAS float* lut = (LAS float*)(lds + L_LUT);
    const int total = BATCH * NG * 256;
    {
        const int tid0 = tid_opaque();
        __syncthreads();
        for (int i = tid0; i < 64 * 128; i += 512) { const int hd = i >> 7, d = i & 127; lut[hd * LUT_PITCH + d] = (P.rel_bias[t5_bucket(d) * NH + hd] - P.rel_bias[31 * NH + hd]) * LOG2E; }
        __syncthreads();
    }
    for (int u = bid; u < total; u += nb) {
        int tid = threadIdx.x; asm volatile("" : "+v"(tid));
        const int lane = tid & 63, wid = __builtin_amdgcn_readfirstlane(tid >> 6);
        const int pair = u >> 8; int c = u & 255; if (pair & 1) c = 255 - c;
        const int b = pair >> 2, g = pair & 3, t0 = c * 16;
        __syncthreads();
        AttnLane A;
                const int r = lane & 15;
        A.tk = (lane >> 4) & 1;
        A.tw0 = t0 + 2 * wid; A.tw1 = A.tw0 + 1; A.tq = A.tw0 + A.tk;
        A.lutrow = lut + (g * NR + r) * LUT_PITCH; A.lut_far = A.lutrow[127];
        A.curblk = t0 >> 6; A.tokidx = 2 * wid + A.tk; A.mk0 = 0ull; A.mk1 = 0ull; A.inv_l = 0.f;
        const int hh = g * NR + r;
        const unsigned yoff = (unsigned)(b * SEQ + A.tq) * (unsigned)(N1P * 2);
        const unsigned ytok0 = (unsigned)(b * SEQ + A.tw0) * (unsigned)(N1P * 2);
        const unsigned otok0 = ((unsigned)(b * SEQ + A.tw0) * (unsigned)ZW8 + (unsigned)(g * NR * DV)) * 2u;
        bf16x8 q[12];
                {
            const unsigned qo = yoff + (unsigned)((C_Q + hh * DK + 8 * (lane >> 5)) * 2);
            float ss = 0.f;
#pragma unroll
            for (int d0 = 0; d0 < 12; ++d0) { q[d0] = *(const bf16x8*)(Y0c + (qo + 32u * d0));
                const u32x4 w = __builtin_bit_cast(u32x4, q[d0]);
                const float a0 = bflo(w.x), a1 = bfhi(w.x), a2 = bflo(w.y), a3 = bfhi(w.y), a4 = bflo(w.z), a5 = bfhi(w.z), a6 = bflo(w.w), a7 = bfhi(w.w);
                ss += (a0 * a0 + a1 * a1) + (a2 * a2 + a3 * a3) + (a4 * a4 + a5 * a5) + (a6 * a6 + a7 * a7); }
            ss += __shfl_xor(ss, 32);
            const float rstd = rsqrtf(ss * (1.0f / DK) + EPSN) * QSCALE;
#pragma unroll
            for (int d0 = 0; d0 < 12; ++d0) { const float* gn = P.nsa_q_norm + 16 * d0 + 8 * (lane >> 5); const f32x4 g0 = *(const f32x4*)gn, g1 = *(const f32x4*)(gn + 4);
                u32x4 w = __builtin_bit_cast(u32x4, q[d0]);
                w.x = pk2(bflo(w.x) * rstd * g0[0], bfhi(w.x) * rstd * g0[1]); w.y = pk2(bflo(w.y) * rstd * g0[2], bfhi(w.y) * rstd * g0[3]);
                w.z = pk2(bflo(w.z) * rstd * g1[0], bfhi(w.z) * rstd * g1[1]); w.w = pk2(bflo(w.w) * rstd * g1[2], bfhi(w.w) * rstd * g1[3]);
                q[d0] = __builtin_bit_cast(bf16x8, w); }
        }
        const int bg = b * NG + g;
        f32x16 o[4]; float m_run, l_run;
#define RESET_STATE() do { _Pragma("unroll") for (int d_ = 0; d_ < 4; ++d_) _Pragma("unroll") for (int r_ = 0; r_ < 16; ++r_) o[d_][r_] = 0.f; m_run = 0.f; l_run = 0.f; } while (0)
        const int nct = (t0 + 15 >= 31) ? (((t0 + 15 - 31) >> 4) / 64 + 1) : 0;
        RESET_STATE();
        A.carry = 0.f;
        if (!NO_CMP1) attn_pass2<MODE_CMPX>(lds, KCc + (size_t)bg * 256 * DK * 2, VTCc + (size_t)bg * DV * 256 * 2, 256, 0, nct, q, o, m_run, l_run, A);
        { const float lt = l_run + __shfl_xor(l_run, 32); const float il = lt > 0.f ? 1.0f / lt : 0.f;
          if (lane < 32) ((LAS float*)(lds + L_IL))[A.tokidx * 16 + r] = il;
          const float gv = bf1(*(const bf16_t*)(Y0c + (yoff + (unsigned)((C_G + 0 * NH + hh) * 2)))); const float sg = 1.0f / (1.0f + __expf(-gv));
          for (int prb_ = 0; prb_ < PROBE_EPI; ++prb_) { asm volatile("" ::: "memory"); attn_epilogue_t<false, true, 0>(lds, lane, wid, o, sg * il, Y0c, ytok0 + (unsigned)((C_ZC + g * NR * DV) * 2), ONc, otok0); } }
        __syncthreads();
        for (int prb_ = 0; prb_ < PROBE_TOPK; ++prb_) { asm volatile("" ::: "memory");
            const int cur = A.curblk;
            unsigned long long mk[2];
#pragma unroll
            for (int t = 0; t < 2; ++t) {
                const LAS bf16_t* X = (const LAS bf16_t*)(lds + L_X) + (2 * wid + t) * 16 * 64;
                const LAS float* IL = (const LAS float*)(lds + L_IL) + (2 * wid + t) * 16;
                const bool forced = (lane == 0) || (lane == cur) || (lane == cur - 1);
                const bool future = lane > cur;
                float v = 0.f;
                if (!forced && !future) {
#pragma unroll
                    for (int rr = 0; rr < 16; ++rr) v += IL[rr] * bf1(X[rr * 64 + lane]); }
                unsigned key = (__float_as_uint(v) & ~63u);
                if (forced) key = 0x7f800000u; else if (future) key = 0u;
                key |= (unsigned)(63 - lane);
                int rank = 0;
#pragma unroll
                for (int jp = 0; jp < 64; ++jp) { const unsigned kj = (unsigned)__builtin_amdgcn_readlane((int)key, jp); rank += (kj > key) ? 1 : 0; }
                mk[t] = __ballot(rank < 16 && !future);
            }
            A.mk0 = mk[0]; A.mk1 = mk[1];
        }
        RESET_STATE();
#if PROBE_SEL2
        attn_pass2<MODE_SEL>(lds, KSc + (size_t)bg * SEQ * DK * 2, VTSc + (size_t)bg * DV * SEQ * 2, SEQ, 0, A.curblk + 1, q, o, m_run, l_run, A);
#endif
        if (!NO_SEL) attn_pass2<MODE_SEL>(lds, KSc + (size_t)bg * SEQ * DK * 2, VTSc + (size_t)bg * DV * SEQ * 2, SEQ, 0, A.curblk + 1, q, o, m_run, l_run, A);
        { const float lt = l_run + __shfl_xor(l_run, 32); const float gv = bf1(*(const bf16_t*)(Y0c + (yoff + (unsigned)((C_G + 1 * NH + hh) * 2)))); const float sg = 1.0f / (1.0f + __expf(-gv));
          attn_epilogue_t<true, true, 0>(lds, lane, wid, o, sg / lt, Y0c, ytok0 + (unsigned)((C_ZS + g * NR * DV) * 2), ONc, otok0); }
        __syncthreads();
        RESET_STATE();
        { const int jl = (t0 - 511) > 0 ? (t0 - 511) >> 6 : 0, jh = ((t0 + 15) >> 6) + 1;
#if PROBE_WIN2
          attn_pass2<MODE_WIN>(lds, KWc + (size_t)bg * SEQ * DK * 2, VTWc + (size_t)bg * DV * SEQ * 2, SEQ, jl, jh, q, o, m_run, l_run, A);
#endif
          if (!NO_WIN) attn_pass2<MODE_WIN>(lds, KWc + (size_t)bg * SEQ * DK * 2, VTWc + (size_t)bg * DV * SEQ * 2, SEQ, jl, jh, q, o, m_run, l_run, A); }
        { const float lt = l_run + __shfl_xor(l_run, 32); const float gv = bf1(*(const bf16_t*)(Y0c + (yoff + (unsigned)((C_G + 2 * NH + hh) * 2)))); const float sg = 1.0f / (1.0f + __expf(-gv));
          attn_epilogue_t<true, true, (FP8EMU & 1)>(lds, lane, wid, o, sg / lt, Y0c, ytok0 + (unsigned)((C_ZW + g * NR * DV) * 2), ONc, otok0); }
#undef RESET_STATE
    }
}

DI void phase_mla_attn(LAS unsigned char* lds, const Params& P, int bid, int nb) {
    const char* QMc = (const char*)(P.ws + OFF_QM); const char* KMc = (const char*)(P.ws + OFF_KM); const char* VTMc = (const char*)(P.ws + OFF_VTM);
    const char* Y1c = (const char*)(P.ws + OFF_Y1); char* OMc = (char*)(P.ws + OFF_O);
    const int total = BATCH * NH * 16;
    for (int uu = 0; bid + (uu >> 1) * nb < total / 2; ++uu) {
        int tid = threadIdx.x; asm volatile("" : "+v"(tid));
        const int lane = tid & 63, wid = __builtin_amdgcn_readfirstlane(tid >> 6);
        const int item = bid + (uu >> 1) * nb, second = uu & 1;
        const int xcd = item & 7, tt = item >> 3, p = tt & 7, hl = (tt >> 3) & 3, rnd = tt >> 5;
        const int bh = rnd * 32 + xcd * 4 + hl, qb = second ? p : 15 - p, b = bh >> 6, h = bh & 63, t0 = qb * 256;
        AttnLane A;
        A.tk = 0;
        A.tw0 = t0 + 32 * wid; A.tw1 = A.tw0 + 31; A.tq = A.tw0 + (lane & 31);
        A.lutrow = nullptr; A.lut_far = 0.f; A.curblk = 0; A.tokidx = 0; A.mk0 = 0ull; A.mk1 = 0ull; A.inv_l = 0.f;         const unsigned trow = (unsigned)(b * SEQ + A.tq);
        bf16x8 q[12];
        {
            const unsigned qo = (trow * (unsigned)NQB + (unsigned)(h * DK + 8 * (lane >> 5))) * 2u;
            float ss = 0.f;
#pragma unroll
            for (int d0 = 0; d0 < 12; ++d0) { q[d0] = *(const bf16x8*)(QMc + (qo + 32u * d0));
                const u32x4 w = __builtin_bit_cast(u32x4, q[d0]);
                const float a0 = bflo(w.x), a1 = bfhi(w.x), a2 = bflo(w.y), a3 = bfhi(w.y), a4 = bflo(w.z), a5 = bfhi(w.z), a6 = bflo(w.w), a7 = bfhi(w.w);
                ss += (a0 * a0 + a1 * a1) + (a2 * a2 + a3 * a3) + (a4 * a4 + a5 * a5) + (a6 * a6 + a7 * a7); }
            ss += __shfl_xor(ss, 32);
            const float rstd = rsqrtf(ss * (1.0f / DK) + EPSN);
            const float* ropep = (const float*)(P.ws + OFF_ROPE) + (size_t)trow * 64;
#pragma unroll
            for (int d0 = 0; d0 < 8; ++d0) { const float* gn = P.mla_q_norm + 16 * d0 + 8 * (lane >> 5); const f32x4 g0 = *(const f32x4*)gn, g1 = *(const f32x4*)(gn + 4);
                const float sc = rstd * QSCALE;
                u32x4 w = __builtin_bit_cast(u32x4, q[d0]);
                w.x = pk2(bflo(w.x) * sc * g0[0], bfhi(w.x) * sc * g0[1]); w.y = pk2(bflo(w.y) * sc * g0[2], bfhi(w.y) * sc * g0[3]);
                w.z = pk2(bflo(w.z) * sc * g1[0], bfhi(w.z) * sc * g1[1]); w.w = pk2(bflo(w.w) * sc * g1[2], bfhi(w.w) * sc * g1[3]);
                q[d0] = __builtin_bit_cast(bf16x8, w); }
#pragma unroll
            for (int pr = 0; pr < 2; ++pr) {
                const int i0 = 16 * pr + 8 * (lane >> 5);
                const float* g1p = P.mla_q_norm + 128 + i0; const float* g2p = P.mla_q_norm + 160 + i0;
                const u32x4 w1 = __builtin_bit_cast(u32x4, q[8 + pr]), w2 = __builtin_bit_cast(u32x4, q[10 + pr]);
                float x1[8] = {bflo(w1.x), bfhi(w1.x), bflo(w1.y), bfhi(w1.y), bflo(w1.z), bfhi(w1.z), bflo(w1.w), bfhi(w1.w)};
                float x2[8] = {bflo(w2.x), bfhi(w2.x), bflo(w2.y), bfhi(w2.y), bflo(w2.z), bfhi(w2.z), bflo(w2.w), bfhi(w2.w)};
                float y1[8], y2[8];
#pragma unroll
                for (int e = 0; e < 8; ++e) { const float cs = ropep[i0 + e], sn = ropep[32 + i0 + e];
                    const float a = x1[e] * rstd * g1p[e], c = x2[e] * rstd * g2p[e];
                    y1[e] = (a * cs - c * sn) * QSCALE; y2[e] = (c * cs + a * sn) * QSCALE; }
                u32x4 o1, o2;
                o1.x = pk2(y1[0], y1[1]); o1.y = pk2(y1[2], y1[3]); o1.z = pk2(y1[4], y1[5]); o1.w = pk2(y1[6], y1[7]);
                o2.x = pk2(y2[0], y2[1]); o2.y = pk2(y2[2], y2[3]); o2.z = pk2(y2[4], y2[5]); o2.w = pk2(y2[6], y2[7]);
                q[8 + pr] = __builtin_bit_cast(bf16x8, o1); q[10 + pr] = __builtin_bit_cast(bf16x8, o2);
            }
        }
        f32x16 o[4]; float m_run = 0.f, l_run = 0.f;
#pragma unroll
        for (int d = 0; d < 4; ++d)
#pragma unroll
            for (int r = 0; r < 16; ++r) o[d][r] = 0.f;
        attn_pass2<MODE_MLA>(lds, KMc + (size_t)bh * SEQ * DK * 2, VTMc + (size_t)bh * DV * SEQ * 2, SEQ, 0, 4 * qb + 4, q, o, m_run, l_run, A);
        const float lt = l_run + __shfl_xor(l_run, 32);
        { const unsigned t0w = (unsigned)(b * SEQ + A.tw0);
          attn_epilogue_t<false, false, (FP8EMU & 2) ? 1 : 0>(lds, lane, wid, o, 1.0f / lt, Y1c, (t0w * (unsigned)N3P + (unsigned)(C3_Z + h * DV)) * 2u, OMc, (t0w * (unsigned)ZW8 + (unsigned)(h * DV)) * 2u); }
        __syncthreads();
    }
}
constexpr int LDS_KN_OFF = 135168, LDS_ST_OFF = LDS_KN_OFF + 16384, LDS_BYTES = LDS_ST_OFF + 16;
constexpr int NPHASE = 14;

template <int PH>
DI void run_phase(const Params& P, LAS unsigned char* lds, int bid, int nb) {
    unsigned char* ws = P.ws;
    if constexpr (PH == 0) {
        phase_wconv(lds, P.nsa_w_in, (bf16_t*)(ws + OFF_W1T), DM, N1, N1P, bid, nb, (FP8EMU & 4) ? 64.0f : 0.f);
        phase_wconv(lds, P.w1_k, (bf16_t*)(ws + OFF_W1K), 6144, 192, 256, bid, nb);
        phase_wconv(lds, P.w1_v, (bf16_t*)(ws + OFF_W1V), 4096, 128, 256, bid, nb);
        phase_rmsnorm(P.x, P.norm_w, (bf16_t*)(ws + OFF_H), bid, nb, (FP8EMU & 4) ? 16.0f : 0.f);
    } else if constexpr (PH == 1) {
        pg8::Gemm g{(const bf16_t*)(ws + OFF_H), (const bf16_t*)(ws + OFF_W1T), MTOK, N1P, DM};
        pg8::StaticOrder S; S.init(g.M, g.N, nb, bid);
        pg8::EpiStoreBf16 E{(bf16_t*)(ws + OFF_Y0), N1P};
        pg8::gemm_phase<pg8::EpiStoreBf16, pg8::StaticOrder, false>(lds, g, S, E, nullptr);
    } else if constexpr (PH == 2) {
        phase_nsa_prep(P, bid, nb);
        phase_vt(lds, (const bf16_t*)(ws + OFF_Y0), N1P, C_KVS + NG * DK, DV, NG, (bf16_t*)(ws + OFF_VTS), bid, nb);
        phase_vt(lds, (const bf16_t*)(ws + OFF_Y0), N1P, C_KVW + NG * DK, DV, NG, (bf16_t*)(ws + OFF_VTW), bid, nb);
    } else if constexpr (PH == 3) {
        if (bid < 16) {
            pg8::Gemm g{(const bf16_t*)(ws + OFF_ACK), (const bf16_t*)(ws + OFF_W1K), 4096, 256, 6144};
            pg8::StaticOrder S; S.init(g.M, g.N, 16, bid);
            pg8::EpiPlainF32 E{(float*)(ws + OFF_HIDK), 256};
            pg8::gemm_phase<pg8::EpiPlainF32, pg8::StaticOrder, false>(lds, g, S, E, nullptr);
        } else if (bid < 32) {
            pg8::Gemm g{(const bf16_t*)(ws + OFF_ACV), (const bf16_t*)(ws + OFF_W1V), 4096, 256, 4096};
            pg8::StaticOrder S; S.init(g.M, g.N, 16, bid - 16);
            pg8::EpiPlainF32 E{(float*)(ws + OFF_HIDV), 256};
            pg8::gemm_phase<pg8::EpiPlainF32, pg8::StaticOrder, false>(lds, g, S, E, nullptr);
        } else {
            phase_wconv(lds, P.nsa_w_out, (bf16_t*)(ws + OFF_W2T), ZW8, DM, DM, bid - 32, nb - 32, (FP8EMU & 1) ? 64.0f : 0.f);
            phase_wconv(lds, P.mla_w_in, (bf16_t*)(ws + OFF_W3T), DM, N3, N3P, bid - 32, nb - 32, (FP8EMU & 8) ? 64.0f : 0.f);
        }
    } else if constexpr (PH == 4) {
        phase_cmp2(lds, P, bid, nb);
    } else if constexpr (PH == 5) {
        { float* ss1 = (float*)(ws + OFF_SS1); for (int i = bid * 512 + (int)threadIdx.x; i < MTOK; i += nb * 512) ss1[i] = 0.f; }
        phase_nsa_attn(lds, P, bid, nb);
    } else if constexpr (PH == 6) {
        pg8::Gemm g{(const bf16_t*)(ws + OFF_O), (const bf16_t*)(ws + OFF_W2T), MTOK, DM, ZW8};
        pg8::StaticOrder S; S.init(g.M, g.N, nb, bid);
        pg8::EpiResNorm E{P.x, P.out, DM, P.norm_w + DM, (bf16_t*)(ws + OFF_H), (float*)(ws + OFF_SS1)};
        pg8::gemm_phase<pg8::EpiResNorm, pg8::StaticOrder, false>(lds, g, S, E, nullptr);
    } else if constexpr (PH == 7) {
        phase_rmsnorm(P.out, P.norm_w + DM, (bf16_t*)(ws + OFF_H), bid, nb, (FP8EMU & 8) ? 16.0f : 0.f);
    } else if constexpr (PH == 8) {
        pg8::Gemm g{(const bf16_t*)(ws + OFF_H), (const bf16_t*)(ws + OFF_W3T), MTOK, N3P, DM};
        pg8::StaticOrder S; S.init(g.M, g.N, nb, bid);
        pg8::EpiStoreBf16RowScale E{(bf16_t*)(ws + OFF_Y1), N3P, (const float*)(ws + OFF_SS1), 1.0f / DM};
        pg8::gemm_phase<pg8::EpiStoreBf16RowScale, pg8::StaticOrder, false>(lds, g, S, E, nullptr);
        __syncthreads();
        if (bid >= 64 && nb > 64) {
            phase_wconv(lds, P.mla_w_q_b, (bf16_t*)(ws + OFF_W4T), QLORA, NQB, NQB, bid - 64, nb - 64);
            phase_wconv(lds, P.mla_w_kv_b, (bf16_t*)(ws + OFF_W5K), KVLORA, NKVB / 2, NKVB / 2, bid - 64, nb - 64, 0.f, 2);
            phase_wconv(lds, P.mla_w_kv_b, (bf16_t*)(ws + OFF_W5V), KVLORA, NKVB / 2, NKVB / 2, bid - 64, nb - 64, 0.f, 1);
            phase_wconv(lds, P.mla_w_out, (bf16_t*)(ws + OFF_W6T), ZW8, DM, DM, bid - 64, nb - 64, (FP8EMU & 2) ? 64.0f : 0.f);
        } else if (nb <= 64) {
            phase_wconv(lds, P.mla_w_q_b, (bf16_t*)(ws + OFF_W4T), QLORA, NQB, NQB, bid, nb);
            phase_wconv(lds, P.mla_w_kv_b, (bf16_t*)(ws + OFF_W5K), KVLORA, NKVB / 2, NKVB / 2, bid, nb, 0.f, 2);
            phase_wconv(lds, P.mla_w_kv_b, (bf16_t*)(ws + OFF_W5V), KVLORA, NKVB / 2, NKVB / 2, bid, nb, 0.f, 1);
            phase_wconv(lds, P.mla_w_out, (bf16_t*)(ws + OFF_W6T), ZW8, DM, DM, bid, nb, (FP8EMU & 2) ? 64.0f : 0.f);
        }
    } else if constexpr (PH == 9) {
        phase_mla_prep1(P, bid, nb);
    } else if constexpr (PH == 10) {
        {
            pg8::Gemm g{(const bf16_t*)(ws + OFF_CQN), (const bf16_t*)(ws + OFF_W4T), MTOK, NQB, QLORA};
            pg8::StaticOrder S; S.init(g.M, g.N, nb, bid);
            pg8::EpiStoreBf16 E{(bf16_t*)(ws + OFF_QM), NQB};
            pg8::gemm_phase<pg8::EpiStoreBf16, pg8::StaticOrder, false>(lds, g, S, E, nullptr);
        }
        __syncthreads();
        {
            pg8::Gemm g{(const bf16_t*)(ws + OFF_CKVN), (const bf16_t*)(ws + OFF_W5K), MTOK, NKVB / 2, KVLORA};
            pg8::StaticOrder S; S.init(g.M, g.N, nb, bid);
            pg8::EpiKNorm E{(bf16_t*)(ws + OFF_KM), (const float*)(ws + OFF_SSPE), (const float*)(ws + OFF_KPER), P.mla_k_norm, (LAS float*)(lds + LDS_KN_OFF), 0u};
            pg8::gemm_phase<pg8::EpiKNorm, pg8::StaticOrder, false>(lds, g, S, E, nullptr);
        }
        __syncthreads();
        {
            pg8::Gemm g{(const bf16_t*)(ws + OFF_W5V), (const bf16_t*)(ws + OFF_CKVN), NKVB / 2, MTOK, KVLORA};
            pg8::StaticOrder S; S.init(g.M, g.N, nb, bid);
            pg8::EpiVT E{(bf16_t*)(ws + OFF_VTM)};
            pg8::gemm_phase<pg8::EpiVT, pg8::StaticOrder, false>(lds, g, S, E, nullptr);
        }
    } else if constexpr (PH == 11) {
    } else if constexpr (PH == 12) {
        phase_mla_attn(lds, P, bid, nb);
    } else if constexpr (PH == 13) {
        pg8::Gemm g{(const bf16_t*)(ws + OFF_O), (const bf16_t*)(ws + OFF_W6T), MTOK, DM, ZW8};
        pg8::StaticOrder S; S.init(g.M, g.N, nb, bid);
        pg8::EpiResF32 E{P.out, P.out, DM};
        pg8::gemm_phase<pg8::EpiResF32, pg8::StaticOrder, false>(lds, g, S, E, nullptr);
    }
}

#ifndef REP0
#define REP0 1
#endif
#ifndef REP1
#define REP1 1
#endif
#ifndef REP2
#define REP2 1
#endif
#ifndef REP3
#define REP3 1
#endif
#ifndef REP4
#define REP4 1
#endif
#ifndef REP5
#define REP5 1
#endif
#ifndef REP6
#define REP6 1
#endif
#ifndef REP7
#define REP7 1
#endif
#ifndef REP8
#define REP8 1
#endif
#ifndef REP9
#define REP9 1
#endif
#ifndef REP10
#define REP10 1
#endif
#ifndef REP11
#define REP11 1
#endif
#ifndef REP12
#define REP12 1
#endif
#ifndef REP13
#define REP13 1
#endif

__global__ __launch_bounds__(512, 2) void k_mega(Params P) {
    extern __shared__ __attribute__((aligned(16))) unsigned char shm[];
    LAS unsigned char* lds = (LAS unsigned char*)shm;
    volatile LAS unsigned* st = (volatile LAS unsigned*)(lds + LDS_ST_OFF);
    if (threadIdx.x == 0) { st[0] = 0u; st[1] = 0u; st[2] = 0u; st[3] = 0u; }
    __syncthreads();
    XcdBarrier bar = xcd_barrier_post((unsigned*)(P.ws + OFF_CTL), st);
    const int bid = (int)blockIdx.x, nb = (int)gridDim.x;
    for (int rep_ = 0; rep_ < REP0; ++rep_) run_phase<0>(P, lds, bid, nb);  xcd_barrier(bar);
    for (int rep_ = 0; rep_ < REP1; ++rep_) run_phase<1>(P, lds, bid, nb);  xcd_barrier(bar);
    for (int rep_ = 0; rep_ < REP2; ++rep_) run_phase<2>(P, lds, bid, nb);  xcd_barrier(bar);
    for (int rep_ = 0; rep_ < REP3; ++rep_) run_phase<3>(P, lds, bid, nb);  xcd_barrier(bar);
    for (int rep_ = 0; rep_ < REP4; ++rep_) run_phase<4>(P, lds, bid, nb);  xcd_barrier(bar);
    for (int rep_ = 0; rep_ < REP5; ++rep_) run_phase<5>(P, lds, bid, nb);  xcd_barrier(bar);
    for (int rep_ = 0; rep_ < REP6; ++rep_) run_phase<6>(P, lds, bid, nb);  xcd_barrier(bar);
    for (int rep_ = 0; rep_ < REP8; ++rep_) run_phase<8>(P, lds, bid, nb);  xcd_barrier(bar);
    for (int rep_ = 0; rep_ < REP9; ++rep_) run_phase<9>(P, lds, bid, nb);  xcd_barrier(bar);
    for (int rep_ = 0; rep_ < REP10; ++rep_) run_phase<10>(P, lds, bid, nb); xcd_barrier(bar);
    for (int rep_ = 0; rep_ < REP12; ++rep_) run_phase<12>(P, lds, bid, nb); xcd_barrier(bar);
    for (int rep_ = 0; rep_ < REP13; ++rep_) run_phase<13>(P, lds, bid, nb);
}

extern "C" void kernel_launch(void* const* d_in, const int* in_sizes, int n_in, void* d_out, int out_size, void* d_ws, size_t ws_size, hipStream_t stream) {
    (void)in_sizes; (void)n_in; (void)out_size;
    if (ws_size < WS_END) return;
    Params P{};
    P.x = (const float*)d_in[0]; P.pos = (const int*)d_in[1]; P.norm_w = (const float*)d_in[2]; P.rel_bias = (const float*)d_in[3];
    P.nsa_w_in = (const float*)d_in[4]; P.nsa_q_norm = (const float*)d_in[5]; P.nsa_k_norm = (const float*)d_in[6]; P.pe_k = (const float*)d_in[7];
    P.w1_k = (const float*)d_in[8]; P.w2_k = (const float*)d_in[9]; P.pe_v = (const float*)d_in[10]; P.w1_v = (const float*)d_in[11]; P.w2_v = (const float*)d_in[12];
    P.nsa_w_out = (const float*)d_in[13]; P.mla_w_in = (const float*)d_in[14]; P.mla_q_a_norm = (const float*)d_in[15]; P.mla_w_q_b = (const float*)d_in[16];
    P.mla_kv_a_norm = (const float*)d_in[17]; P.mla_w_kv_b = (const float*)d_in[18]; P.mla_q_norm = (const float*)d_in[19]; P.mla_k_norm = (const float*)d_in[20];
    P.mla_w_out = (const float*)d_in[21];
    P.out = (float*)d_out; P.ws = (unsigned char*)d_ws;
    static int grid = 0;
    if (!grid) {
        int dev = 0, cus = 0, per_cu = 0; (void)hipGetDevice(&dev);
        if (hipDeviceGetAttribute(&cus, hipDeviceAttributeMultiprocessorCount, dev) != hipSuccess || cus <= 0) cus = 256;
        (void)hipFuncSetAttribute((const void*)k_mega, hipFuncAttributeMaxDynamicSharedMemorySize, LDS_BYTES);
        if (hipOccupancyMaxActiveBlocksPerMultiprocessor(&per_cu, k_mega, 512, LDS_BYTES) != hipSuccess || per_cu < 1) per_cu = 1;
        grid = cus;
    }
    (void)hipMemsetAsync((unsigned char*)d_ws + OFF_CTL, 0, XCD_BAR_WORDS * sizeof(unsigned), stream);
    hipLaunchKernelGGL(k_mega, dim3(grid), dim3(512), LDS_BYTES, stream, P);
}
```

```cpp
#include <hip/hip_runtime.h>
#include <stdint.h>
#include <stddef.h>

#define DI __device__ __forceinline__
#define LAS __attribute__((address_space(3)))
typedef unsigned short bf16_t;
typedef short bf16x8 __attribute__((ext_vector_type(8)));
typedef float f32x4 __attribute__((ext_vector_type(4)));
typedef float f32x16 __attribute__((ext_vector_type(16)));
typedef unsigned u32x4 __attribute__((ext_vector_type(4)));
typedef unsigned u32x2 __attribute__((ext_vector_type(2)));
typedef __bf16 bf2_t __attribute__((ext_vector_type(2)));
typedef float f2_t __attribute__((ext_vector_type(2)));

DI int tid_opaque() { int t = (int)threadIdx.x; asm volatile("" : "+v"(t)); return t; }
DI unsigned pk2(float a, float b) { f2_t f = {a, b}; bf2_t v = __builtin_convertvector(f, bf2_t); return __builtin_bit_cast(unsigned, v); }
DI float bflo(unsigned w) { return __uint_as_float(w << 16); }
DI float bfhi(unsigned w) { return __uint_as_float(w & 0xffff0000u); }
#ifndef FP8EMU
#define FP8EMU 0
#endif
DI float emu_q8(float x, float s) { float y = x * s; const float ay = fabsf(y);
    if (ay < 0.015625f) y = rintf(y * 512.0f) * (1.0f / 512.0f);
    else { unsigned u = __float_as_uint(y); u = (u + 0x0007FFFFu + ((u >> 20) & 1u)) & 0xFFF00000u; y = __uint_as_float(u); }
    y = fminf(fmaxf(y, -448.0f), 448.0f); return y / s; }
DI float bf1(bf16_t h) { return __uint_as_float(((unsigned)h) << 16); }

constexpr int BATCH = 4, SEQ = 4096, DM = 4096, MTOK = BATCH * SEQ;
constexpr int NH = 64, NG = 4, NR = 16, DK = 192, DV = 128;
constexpr int N1 = 40896, N1P = 40960;
constexpr int C_Q = 0, C_KVC = 12288, C_KVS = 13568, C_KVW = 14848, C_ZC = 16128, C_ZS = 24320, C_ZW = 32512, C_G = 40704;
constexpr int N3 = 10304, N3P = 10496;
constexpr int C3_CQ = 0, C3_CKV = 1536, C3_KPE = 2048, C3_Z = 2112;
constexpr int QLORA = 1536, KVLORA = 512;
constexpr int NQB = 12288, NKVB = 16384, ZW8 = 8192;
constexpr float EPSN = 1e-6f;
constexpr float LOG2E = 1.4426950408889634f;
constexpr float QSCALE = 0.07216878364870322f * 1.4426950408889634f;

constexpr size_t SZ_W1T = (size_t)N1P * DM * 2, SZ_W2T = (size_t)DM * ZW8 * 2, SZ_W3T = (size_t)N3P * DM * 2, SZ_W4T = (size_t)NQB * QLORA * 2,
                 SZ_W5T = (size_t)NKVB * KVLORA * 2, SZ_W6T = (size_t)DM * ZW8 * 2;
constexpr size_t OFF_W1T = 0, OFF_W2T = OFF_W1T + SZ_W1T, OFF_W3T = OFF_W2T + SZ_W2T, OFF_W4T = OFF_W3T + SZ_W3T, OFF_W5T = OFF_W4T + SZ_W4T,
                 OFF_W6T = OFF_W5T + SZ_W5T, OFF_W1K = OFF_W6T + SZ_W6T;
constexpr size_t OFF_W5K = OFF_W5T, OFF_W5V = OFF_W5T + SZ_W5T / 2;
constexpr size_t SZ_W1K = (size_t)256 * 6144 * 2, SZ_W1V = (size_t)256 * 4096 * 2;
constexpr size_t OFF_W1V = OFF_W1K + SZ_W1K, OFF_CTL = OFF_W1V + SZ_W1V, OFF_H = OFF_CTL + 65536;
constexpr size_t SZ_H = (size_t)MTOK * DM * 2, SZ_KS = (size_t)BATCH * NG * SEQ * DK * 2, SZ_VTS = (size_t)BATCH * NG * DV * SEQ * 2,
                 SZ_ACK = (size_t)4096 * 6144 * 2, SZ_ACV = (size_t)4096 * 4096 * 2;
constexpr size_t OFF_KS = OFF_H + SZ_H, OFF_KW = OFF_KS + SZ_KS, OFF_VTS = OFF_KW + SZ_KS, OFF_VTW = OFF_VTS + SZ_VTS, OFF_ACK = OFF_VTW + SZ_VTS,
                 OFF_ACV = OFF_ACK + SZ_ACK, OFF_KC = OFF_ACV + SZ_ACV;
constexpr size_t SZ_KC = (size_t)16 * 256 * DK * 2, SZ_VTC = (size_t)16 * DV * 256 * 2, SZ_HID = (size_t)4096 * 256 * 4;
constexpr size_t OFF_VTC = OFF_KC + SZ_KC, OFF_HIDK = OFF_VTC + SZ_VTC, OFF_HIDV = OFF_HIDK + SZ_HID, OFF_Y0 = OFF_HIDV + SZ_HID;
constexpr size_t SZ_Y0 = (size_t)MTOK * N1P * 2, SZ_O = (size_t)MTOK * ZW8 * 2;
constexpr size_t OFF_O = OFF_Y0 + SZ_Y0, WS_END = OFF_O + SZ_O;
constexpr size_t OFF_SS1 = OFF_HIDK;
constexpr size_t OFF_HIDP = OFF_O;
constexpr size_t OFF_KM = 0;
constexpr size_t SZ_KM = (size_t)BATCH * NH * SEQ * DK * 2;
static_assert(SZ_KM <= SZ_W1T + SZ_W2T, "KM alias");
constexpr size_t OFF_VTM = OFF_H;
constexpr size_t SZ_VTM = (size_t)BATCH * NH * DV * SEQ * 2;
constexpr size_t OFF_CKVN = OFF_VTM + SZ_VTM;
constexpr size_t SZ_CKVN = (size_t)MTOK * KVLORA * 2;
static_assert(OFF_CKVN + SZ_CKVN <= OFF_KC, "CKVN alias");
constexpr size_t OFF_Y1 = OFF_Y0, SZ_Y1 = (size_t)MTOK * N3P * 2;
constexpr size_t OFF_QM = OFF_Y1 + SZ_Y1, SZ_QM = (size_t)MTOK * NQB * 2;
constexpr size_t OFF_KVM = OFF_QM + SZ_QM, SZ_KVM = (size_t)MTOK * NKVB * 2;
constexpr size_t OFF_KNM = OFF_KVM;
constexpr size_t OFF_KPER = OFF_KVM, OFF_SSPE = OFF_KVM + (size_t)MTOK * 64 * 4;
constexpr size_t OFF_CQN = OFF_KVM + SZ_KVM, SZ_CQN = (size_t)MTOK * QLORA * 2;
constexpr size_t OFF_ROPE = OFF_CQN + SZ_CQN, SZ_ROPE = (size_t)MTOK * 64 * 4;
static_assert(OFF_ROPE + SZ_ROPE <= OFF_O, "layer-1 alias region");
static_assert(WS_END <= 2680160256ull, "workspace");

struct Params {
    const float* x; const int* pos; const float* norm_w; const float* rel_bias;
    const float* nsa_w_in; const float* nsa_q_norm; const float* nsa_k_norm; const float* pe_k; const float* w1_k; const float* w2_k;
    const float* pe_v; const float* w1_v; const float* w2_v; const float* nsa_w_out;
    const float* mla_w_in; const float* mla_q_a_norm; const float* mla_w_q_b; const float* mla_kv_a_norm; const float* mla_w_kv_b;
    const float* mla_q_norm; const float* mla_k_norm; const float* mla_w_out;
    float* out; unsigned char* ws;
};

#define XB_TMO      128
#define XB_XCNT(j)  (256  + 64 * (j))
#define XB_XSUB(j)  (1280 + 64 * (j))
#define XB_XGEN(j)  (2304 + 64 * (j))
#define XB_TOP      3328
#define XB_TOPGEN   3392
#define XCD_BAR_WORDS 3456
#define XB_SPIN_CAP (1u << 18)

__device__ __forceinline__ unsigned xb_ld(unsigned* p)              { return __hip_atomic_load(p, __ATOMIC_RELAXED, __HIP_MEMORY_SCOPE_AGENT); }
__device__ __forceinline__ unsigned xb_add(unsigned* p, unsigned v) { return __hip_atomic_fetch_add(p, v, __ATOMIC_RELAXED, __HIP_MEMORY_SCOPE_AGENT); }
__device__ __forceinline__ unsigned xb_xcc_id() { return (unsigned)__builtin_amdgcn_s_getreg((3 << 11) | 20) & 0xFu; }
#define XB_SPIN(cond, bar) do { unsigned _sp = 0; while (cond) { __builtin_amdgcn_s_sleep(1); \
    if ((++_sp & 255u) == 0u) { if (xb_ld(&(bar)[XB_TMO])) break; if (_sp > XB_SPIN_CAP) { atomicAdd(&(bar)[XB_TMO], 1u); break; } } } } while (0)

struct XcdBarrier {
    unsigned* bar; unsigned x;
    volatile LAS unsigned* st;
};

__device__ __forceinline__ XcdBarrier xcd_barrier_post(unsigned* bar, volatile LAS unsigned* st) {
    XcdBarrier b; b.bar = bar; b.x = xb_xcc_id(); b.st = st;
    if (threadIdx.x == 0) (void)xb_add(&bar[XB_XCNT(b.x)], 1u);
    return b;
}
__device__ __forceinline__ void xcd_barrier_complete(unsigned* bar, unsigned x, unsigned& nloc, unsigned& nx) {
    const unsigned G = gridDim.x * gridDim.y * gridDim.z;
    unsigned sum, cnt, mine, sp = 0u;
    for (;;) {
        sum = 0u; cnt = 0u; mine = 0u;
#pragma unroll
        for (unsigned j = 0; j < 16; ++j) { const unsigned c = xb_ld(&bar[XB_XCNT(j)]); sum += c; cnt += (c > 0u) ? 1u : 0u; mine = (j == x) ? c : mine; }
        if (sum == G) break;
        __builtin_amdgcn_s_sleep(1);
        if ((++sp & 255u) == 0u) { if (xb_ld(&bar[XB_TMO])) break; if (sp > XB_SPIN_CAP) { atomicAdd(&bar[XB_TMO], 1u); break; } }
    }
    nloc = mine > 0u ? mine : 1u; nx = cnt > 0u ? cnt : 1u;
}

__device__ __forceinline__ void xcd_barrier(const XcdBarrier& b) {
    asm volatile("s_waitcnt vmcnt(0)" ::: "memory");
    __syncthreads();
    if (threadIdx.x == 0) {
        unsigned* bar = b.bar;
        __builtin_amdgcn_s_waitcnt(0);
        unsigned nloc = b.st[0], nx = b.st[1];
        if (nloc == 0u) { xcd_barrier_complete(bar, b.x, nloc, nx); b.st[0] = nloc; b.st[1] = nx; }
        const unsigned old = xb_add(&bar[XB_XSUB(b.x)], 1u);
        const unsigned gen = old / nloc;
        if (old + 1u == (gen + 1u) * nloc) {
            __builtin_amdgcn_fence(__ATOMIC_RELEASE, "agent");
            asm volatile("s_waitcnt vmcnt(0)" ::: "memory");
            const unsigned og = xb_add(&bar[XB_TOP], 1u);
            const unsigned tg = og / nx;
            if (og + 1u == (tg + 1u) * nx) xb_add(&bar[XB_TOPGEN], 1u);
            else XB_SPIN(xb_ld(&bar[XB_TOPGEN]) == tg, bar);
            __builtin_amdgcn_fence(__ATOMIC_ACQUIRE, "agent");
            xb_add(&bar[XB_XGEN(b.x)], 1u);
            asm volatile("s_waitcnt vmcnt(0)" ::: "memory");
        } else {
            XB_SPIN(xb_ld(&bar[XB_XGEN(b.x)]) == gen, bar);
            __builtin_amdgcn_fence(__ATOMIC_ACQUIRE, "agent");
            asm volatile("s_waitcnt vmcnt(0)" ::: "memory");
        }
    }
    __syncthreads();
}

namespace pg8 {
#define PG8_LAS __attribute__((address_space(3)))
typedef unsigned short bf16_t;
typedef short bf16x8 __attribute__((ext_vector_type(8)));
typedef float f32x4 __attribute__((ext_vector_type(4)));
typedef unsigned u32x4 __attribute__((ext_vector_type(4)));
constexpr int BM = 256, BK = 64, HALF = 128, HTB = HALF * BK * 2  , STAGE_BYTES = 8 * HTB, NXCD = 8, WGM = 8;

__host__ __device__ __forceinline__ int lds_byte(int r, int c) { const int st = (r >> 4) * 2 + (c >> 5), rr = r & 15, cc = c & 31, ob = rr * 64 + cc * 2; return st * 1024 + (ob ^ (((ob >> 9) & 1) << 5)); }
__host__ __device__ __forceinline__ void stage_rc(int b, int& R, int& C) { const int st = b / 1024, sb = b % 1024, swz = sb ^ (((sb >> 9) & 1) << 5); R = (st >> 1) * 16 + swz / 64; C = (st & 1) * 32 + (swz % 64) / 2; }
__host__ __device__ __forceinline__ int perm32(int rho) { const int n = rho >> 4, i = rho & 15; return 8 * (i >> 2) + 4 * n + (i & 3); }

struct Unit { int pm, pn; };
struct Gemm { const bf16_t* A; const bf16_t* Bt; int M, N, K; };

struct StaticOrder {
    int nM, nN, nwg, G, c;
    __host__ __device__ void init(int M, int N, int G_, int c_) { nM = M / BM; nN = N / BM; nwg = nM * nN; G = G_; c = c_; }
    __host__ __device__ bool next(int i, Unit& u) const {
        const long L = (long)i * G + c; if (L >= nwg) return false;
        int wgid = (int)L; { const int q = nwg / NXCD, r = nwg % NXCD, xcd = wgid % NXCD, off = wgid / NXCD; wgid = (xcd < r ? xcd * (q + 1) : r * (q + 1) + (xcd - r) * q) + off; }
        const int nig = WGM * nN, gid = wgid / nig, fm = gid * WGM, gsz = (nM - fm) < WGM ? (nM - fm) : WGM;
        u.pm = fm + ((wgid % nig) % gsz); u.pn = (wgid % nig) / gsz; return true;
    }
    __device__ __forceinline__ void a_ready(const Unit&) const {}
    __device__ __forceinline__ void done(const Unit&) const {}
};
struct EpiStoreBf16 {
    static constexpr bool PERM = true, AFTER_DRAIN = false, SWAP23 = false;
    bf16_t* O; int ldc;
    __device__ __forceinline__ void operator()(const f32x4 (&acc)[2][2][4][2], const Unit& u, int wr, int wc, int fr, int fq) const {
        const int row0 = u.pm * BM + wr * 64 + fr; const int col0 = u.pn * BM + wc * 32 + 8 * fq;
#pragma unroll
        for (int ai = 0; ai < 2; ++ai)
#pragma unroll
            for (int m = 0; m < 4; ++m) { bf16_t* rowp = O + (size_t)(row0 + ai * HALF + m * 16) * ldc + col0;
#pragma unroll
                for (int bj = 0; bj < 2; ++bj) { const f32x4 v0 = acc[ai][bj][m][0], v1 = acc[ai][bj][m][1];
                    u32x4 w; w.x = pk2(v0[0], v0[1]); w.y = pk2(v0[2], v0[3]); w.z = pk2(v1[0], v1[1]); w.w = pk2(v1[2], v1[3]);
                    *(u32x4*)(rowp + bj * HALF) = w; } }
    }
};
struct EpiResF32 {
    static constexpr bool PERM = false, AFTER_DRAIN = false, SWAP23 = false;
    const float* base; float* out; int ldc;
    __device__ __forceinline__ void operator()(const f32x4 (&acc)[2][2][4][2], const Unit& u, int wr, int wc, int fr, int fq) const {
        const int row0 = u.pm * BM + wr * 64 + fr, col0 = u.pn * BM + wc * 32 + 4 * fq;
#pragma unroll
        for (int ai = 0; ai < 2; ++ai)
#pragma unroll
            for (int m = 0; m < 4; ++m) { const size_t off = (size_t)(row0 + ai * HALF + m * 16) * ldc + col0;
#pragma unroll
                for (int bj = 0; bj < 2; ++bj)
#pragma unroll
                    for (int n = 0; n < 2; ++n) { const f32x4 bs = *(const f32x4*)(base + off + bj * HALF + n * 16);
                        *(f32x4*)(out + off + bj * HALF + n * 16) = bs + acc[ai][bj][m][n]; } }
    }
};
struct EpiPlainF32 {
    static constexpr bool PERM = false, AFTER_DRAIN = false, SWAP23 = false;
    float* C; int ldc;
    __device__ __forceinline__ void operator()(const f32x4 (&acc)[2][2][4][2], const Unit& u, int wr, int wc, int fr, int fq) const {
        const int row0 = u.pm * BM + wr * 64 + fr, col0 = u.pn * BM + wc * 32 + 4 * fq;
#pragma unroll
        for (int ai = 0; ai < 2; ++ai)
#pragma unroll
            for (int m = 0; m < 4; ++m) { float* rowp = C + (size_t)(row0 + ai * HALF + m * 16) * ldc + col0;
#pragma unroll
                for (int bj = 0; bj < 2; ++bj)
#pragma unroll
                    for (int n = 0; n < 2; ++n) *(f32x4*)(rowp + bj * HALF + n * 16) = acc[ai][bj][m][n]; }
    }
};

struct EpiVT {
    static constexpr bool PERM = true, AFTER_DRAIN = false, SWAP23 = true;
    bf16_t* O;
    __device__ __forceinline__ void operator()(const f32x4 (&acc)[2][2][4][2], const Unit& u, int wr, int wc, int fr, int fq) const {
        const int row0 = u.pm * BM + wr * 64 + fr; const int colt = u.pn * BM; const int b = colt >> 12, pos0 = (colt & 4095) + wc * 32 + 8 * fq;
        bf16_t* base = O + (size_t)b * 8192 * 4096 + pos0;
#pragma unroll
        for (int ai = 0; ai < 2; ++ai)
#pragma unroll
            for (int m = 0; m < 4; ++m) { bf16_t* rowp = base + (size_t)(row0 + ai * HALF + m * 16) * 4096;
#pragma unroll
                for (int bj = 0; bj < 2; ++bj) { const f32x4 v0 = acc[ai][bj][m][0], v1 = acc[ai][bj][m][1];
                    u32x4 w; w.x = pk2(v0[0], v0[1]); w.y = pk2(v0[2], v0[3]); w.z = pk2(v1[0], v1[1]); w.w = pk2(v1[2], v1[3]);
                    *(u32x4*)(rowp + bj * HALF) = w; } }
    }
};

struct EpiKNorm {
    static constexpr bool PERM = true, AFTER_DRAIN = false, SWAP23 = false;
    bf16_t* KM; const float* sspe; const float* kper; const float* gain; PG8_LAS float* tab; mutable unsigned par;
    __device__ __forceinline__ void operator()(const f32x4 (&acc)[2][2][4][2], const Unit& u, int wr, int wc, int fr, int fq) const {
        PG8_LAS float* T = tab + par * 2048;
#pragma unroll
        for (int ai = 0; ai < 2; ++ai)
#pragma unroll
            for (int m = 0; m < 4; ++m) { const int row = ai * HALF + wr * 64 + m * 16 + fr;
#pragma unroll
                for (int bj = 0; bj < 2; ++bj) { const f32x4 x = acc[ai][bj][m][0], y = acc[ai][bj][m][1];
                    float ss = (x[0] * x[0] + x[1] * x[1]) + (x[2] * x[2] + x[3] * x[3]) + (y[0] * y[0] + y[1] * y[1]) + (y[2] * y[2] + y[3] * y[3]);
                    ss += __shfl_xor(ss, 16); ss += __shfl_xor(ss, 32);
                    if (fq == 0) T[row * 8 + bj * 4 + wc] = ss; } }
        asm volatile("s_waitcnt lgkmcnt(0)" ::: "memory"); __builtin_amdgcn_s_barrier(); asm volatile("" ::: "memory");
        const f32x4 g0 = *(const f32x4*)(gain + wc * 32 + 8 * fq), g1 = *(const f32x4*)(gain + wc * 32 + 8 * fq + 4);
        const int tok0 = u.pm * BM, b = tok0 >> 12;
#pragma unroll
        for (int ai = 0; ai < 2; ++ai)
#pragma unroll
            for (int m = 0; m < 4; ++m) { const int row = ai * HALF + wr * 64 + m * 16 + fr, tok = tok0 + row, s = tok & 4095;
                const float sp = sspe[tok]; const f32x4 kp = *(const f32x4*)(kper + (size_t)tok * 64 + wc * 16 + 4 * fq);
#pragma unroll
                for (int bj = 0; bj < 2; ++bj) { const f32x4 t = *(const PG8_LAS f32x4*)(T + row * 8 + bj * 4);
                    const float rstd = rsqrtf(((t[0] + t[1]) + (t[2] + t[3]) + sp) * (1.0f / 192.0f) + 1e-6f);
                    const int hd = 2 * u.pn + bj;
                    bf16_t* kb = KM + ((size_t)(b * 64 + hd) * 4096 + s) * 192;
                    const f32x4 x = acc[ai][bj][m][0], y = acc[ai][bj][m][1];
                    u32x4 w; w.x = pk2(x[0] * rstd * g0[0], x[1] * rstd * g0[1]); w.y = pk2(x[2] * rstd * g0[2], x[3] * rstd * g0[3]);
                    w.z = pk2(y[0] * rstd * g1[0], y[1] * rstd * g1[1]); w.w = pk2(y[2] * rstd * g1[2], y[3] * rstd * g1[3]);
                    *(u32x4*)(kb + wc * 32 + 8 * fq) = w;
                    u32x2 r; r.x = pk2(kp[0] * rstd, kp[1] * rstd); r.y = pk2(kp[2] * rstd, kp[3] * rstd);
                    *(u32x2*)(kb + 128 + wc * 16 + 4 * fq) = r; } }
        par ^= 1u;
    }
};

struct EpiResNorm {
    static constexpr bool PERM = false, AFTER_DRAIN = false, SWAP23 = false;
    const float* base; float* out; int ldc; const float* gain; bf16_t* xg; float* ss;
    __device__ __forceinline__ void operator()(const f32x4 (&acc)[2][2][4][2], const Unit& u, int wr, int wc, int fr, int fq) const {
        const int row0 = u.pm * BM + wr * 64 + fr, col0 = u.pn * BM + wc * 32 + 4 * fq;
        f32x4 gv[2][2];
#pragma unroll
        for (int bj = 0; bj < 2; ++bj)
#pragma unroll
            for (int n = 0; n < 2; ++n) gv[bj][n] = *(const f32x4*)(gain + col0 + bj * HALF + n * 16);
#pragma unroll
        for (int ai = 0; ai < 2; ++ai)
#pragma unroll
            for (int m = 0; m < 4; ++m) { const int row = row0 + ai * HALF + m * 16; const size_t off = (size_t)row * ldc + col0; float sq = 0.f;
#pragma unroll
                for (int bj = 0; bj < 2; ++bj)
#pragma unroll
                    for (int n = 0; n < 2; ++n) { const f32x4 bs = *(const f32x4*)(base + off + bj * HALF + n * 16); const f32x4 v = bs + acc[ai][bj][m][n];
                        *(f32x4*)(out + off + bj * HALF + n * 16) = v;
                        sq += (v[0] * v[0] + v[1] * v[1]) + (v[2] * v[2] + v[3] * v[3]);
                        const f32x4 g = gv[bj][n]; u32x2 w; w.x = pk2(v[0] * g[0], v[1] * g[1]); w.y = pk2(v[2] * g[2], v[3] * g[3]);
                        *(u32x2*)(xg + off + bj * HALF + n * 16) = w; }
                sq += __shfl_xor(sq, 16); sq += __shfl_xor(sq, 32);
                if (fq == 0) atomicAdd(ss + row, sq); }
    }
};
struct EpiStoreBf16RowScale {
    static constexpr bool PERM = true, AFTER_DRAIN = false, SWAP23 = false;
    bf16_t* O; int ldc; const float* ss; float inv_dim;
    __device__ __forceinline__ void operator()(const f32x4 (&acc)[2][2][4][2], const Unit& u, int wr, int wc, int fr, int fq) const {
        const int row0 = u.pm * BM + wr * 64 + fr; const int col0 = u.pn * BM + wc * 32 + 8 * fq;
#pragma unroll
        for (int ai = 0; ai < 2; ++ai)
#pragma unroll
            for (int m = 0; m < 4; ++m) { const int row = row0 + ai * HALF + m * 16; const float rs = rsqrtf(ss[row] * inv_dim + 1e-6f);
                bf16_t* rowp = O + (size_t)row * ldc + col0;
#pragma unroll
                for (int bj = 0; bj < 2; ++bj) { const f32x4 v0 = acc[ai][bj][m][0] * rs, v1 = acc[ai][bj][m][1] * rs;
                    u32x4 w; w.x = pk2(v0[0], v0[1]); w.y = pk2(v0[2], v0[3]); w.z = pk2(v1[0], v1[1]); w.w = pk2(v1[2], v1[3]);
                    *(u32x4*)(rowp + bj * HALF) = w; } }
    }
};
template <class Epi, class Sched, bool STAMP = false>
__device__ __forceinline__ void gemm_phase(PG8_LAS unsigned char* lds, const Gemm g, const Sched& S, const Epi& E, unsigned long long* stamps) {
    const int tid = tid_opaque(), wid = __builtin_amdgcn_readfirstlane(tid >> 6), lane = tid & 63, wr = wid >> 2, wc = wid & 3, fr = lane & 15, fq = lane >> 4;
    const int K = g.K, nt = K / BK;
    int ts_lo = 0, ts_hi = 0, nts = 0; const unsigned long long rt_entry = STAMP ? (unsigned long long)wall_clock64() : 0ull;
#define PG8_STAMP() do { if (STAMP && wid == 0 && nts < 64) { const unsigned long long _c = (unsigned long long)clock64(); \
        ts_lo = (lane == nts) ? (int)(unsigned)_c : ts_lo; ts_hi = (lane == nts) ? (int)(unsigned)(_c >> 32) : ts_hi; ++nts; } } while (0)
    PG8_STAMP();
    unsigned voffA[2], voffB[2];
#pragma unroll
    for (int i = 0; i < 2; ++i) { int R, C; stage_rc(tid * 16 + i * 8192, R, C); int Rb = Epi::PERM ? ((R & ~31) + perm32(R & 31)) : R; if (Epi::SWAP23) Rb = (Rb & ~15) | ((Rb & 3) | ((Rb & 4) << 1) | ((Rb & 8) >> 1));
        voffA[i] = (unsigned)(R * K + C) * 2u; voffB[i] = (unsigned)(Rb * K + C) * 2u; }
    const size_t kstep = (size_t)(BK * 2);
    const size_t hstep = (size_t)HALF * K * 2;
    const size_t tstep = 2 * hstep;
    const unsigned ldsw = (unsigned)wid * 1024u;
    const int aoff = lds_byte(wr * 64 + fr, fq * 8), boff = lds_byte(wc * 32 + fr, fq * 8);
#define PG8_SA(b, h) (((b) * 2 + (h)) * HTB)
#define PG8_SB(b, h) ((4 + (b) * 2 + (h)) * HTB)
#define PG8_STAGE(bufoff, gbase, voff) do { _Pragma("unroll") for (int _i = 0; _i < 2; ++_i) \
        __builtin_amdgcn_global_load_lds((const unsigned*)((const char*)(gbase) + (voff)[_i]), (PG8_LAS unsigned*)(lds + (bufoff) + ldsw + _i * 8192), 16, 0, 0); } while (0)
#define PG8_LDA(dst, b, h) do { _Pragma("unroll") for (int m = 0; m < 4; ++m) _Pragma("unroll") for (int k = 0; k < 2; ++k) dst[m][k] = *(const PG8_LAS bf16x8*)(lds + PG8_SA(b, h) + aoff + m * 2048 + k * 1024); } while (0)
#define PG8_LDB(dst, b, h) do { _Pragma("unroll") for (int n = 0; n < 2; ++n) _Pragma("unroll") for (int k = 0; k < 2; ++k) dst[n][k] = *(const PG8_LAS bf16x8*)(lds + PG8_SB(b, h) + boff + n * 2048 + k * 1024); } while (0)
#define PG8_MMA(ai, bj, At, Bt) do { __builtin_amdgcn_s_setprio(1); _Pragma("unroll") for (int m = 0; m < 4; ++m) _Pragma("unroll") for (int n = 0; n < 2; ++n) _Pragma("unroll") for (int k = 0; k < 2; ++k) \
        acc[ai][bj][m][n] = __builtin_amdgcn_mfma_f32_16x16x32_bf16(Bt[n][k], At[m][k], acc[ai][bj][m][n], 0, 0, 0); __builtin_amdgcn_s_setprio(0); } while (0)
#define PG8_WAIT_V(n) asm volatile("s_waitcnt vmcnt(" #n ")" ::: "memory")
#define PG8_WAIT_L(n) asm volatile("s_waitcnt lgkmcnt(" #n ")" ::: "memory")
#define PG8_BAR __builtin_amdgcn_s_barrier()
#define PG8_SCHED __builtin_amdgcn_sched_barrier(0)
    Unit cur, nxt; int ui = 0;
    if (!S.next(0, cur)) return;
    f32x4 acc[2][2][4][2];
#pragma unroll
    for (int a = 0; a < 2; ++a)
#pragma unroll
        for (int b = 0; b < 2; ++b)
#pragma unroll
            for (int m = 0; m < 4; ++m)
#pragma unroll
                for (int n = 0; n < 2; ++n) acc[a][b][m][n] = (f32x4){0.f, 0.f, 0.f, 0.f};
    bf16x8 At[4][2], B0[2][2], B1[2][2];
    const char* cA = (const char*)g.A + (size_t)cur.pm * tstep; const char* cB = (const char*)g.Bt + (size_t)cur.pn * tstep;
    S.a_ready(cur);
    PG8_STAGE(PG8_SB(0, 0), cB, voffB); PG8_STAGE(PG8_SA(0, 0), cA, voffA); PG8_STAGE(PG8_SB(0, 1), cB + hstep, voffB); PG8_STAGE(PG8_SA(0, 1), cA + hstep, voffA);
    if (wr == 1) PG8_BAR;
    PG8_WAIT_V(4); PG8_BAR;
    PG8_STAGE(PG8_SB(1, 0), cB + kstep, voffB); PG8_STAGE(PG8_SA(1, 0), cA + kstep, voffA); PG8_STAGE(PG8_SB(1, 1), cB + hstep + kstep, voffB);
    PG8_WAIT_V(6); PG8_BAR;
    PG8_STAMP();
    for (;;) {
        const bool has_next = S.next(ui + 1, nxt);
        const char* nA = has_next ? (const char*)g.A + (size_t)nxt.pm * tstep : cA; const char* nB = has_next ? (const char*)g.Bt + (size_t)nxt.pn * tstep : cB;
        for (int t = 0; t < nt; t += 2) {
            const bool last = (t == nt - 2);
            const char* a1 = cA + (size_t)(t + 1) * kstep;
            const char* a2 = last ? nA : cA + (size_t)(t + 2) * kstep; const char* b2 = last ? nB : cB + (size_t)(t + 2) * kstep;
            const char* a3 = a2 + kstep; const char* b3 = b2 + kstep;
            if (last && has_next) S.a_ready(nxt);
            PG8_LDB(B0, 0, 0); PG8_SCHED; PG8_LDA(At, 0, 0); PG8_STAGE(PG8_SA(1, 1), a1 + hstep, voffA);
            PG8_WAIT_L(8); PG8_BAR; PG8_WAIT_L(0); PG8_MMA(0, 0, At, B0); PG8_BAR; PG8_SCHED;
            PG8_LDB(B1, 0, 1); PG8_STAGE(PG8_SB(0, 0), b2, voffB);
            PG8_BAR; PG8_WAIT_L(0); PG8_MMA(0, 1, At, B1); PG8_BAR;
            PG8_LDA(At, 0, 1); PG8_STAGE(PG8_SA(0, 0), a2, voffA);
            PG8_BAR; PG8_WAIT_L(0); PG8_MMA(1, 0, At, B0); PG8_BAR; PG8_SCHED;
            PG8_STAGE(PG8_SB(0, 1), b2 + hstep, voffB);
            PG8_WAIT_V(6); PG8_BAR; PG8_MMA(1, 1, At, B1); PG8_BAR;
            PG8_LDB(B0, 1, 0); PG8_SCHED; PG8_LDA(At, 1, 0); PG8_STAGE(PG8_SA(0, 1), a2 + hstep, voffA);
            PG8_WAIT_L(8); PG8_BAR; PG8_WAIT_L(0); PG8_MMA(0, 0, At, B0); PG8_BAR; PG8_SCHED;
            PG8_LDB(B1, 1, 1); PG8_STAGE(PG8_SB(1, 0), b3, voffB);
            PG8_BAR; PG8_WAIT_L(0); PG8_MMA(0, 1, At, B1); PG8_BAR;
            PG8_LDA(At, 1, 1); PG8_STAGE(PG8_SA(1, 0), a3, voffA);
            PG8_BAR; PG8_WAIT_L(0); PG8_MMA(1, 0, At, B0); PG8_BAR; PG8_SCHED;
            PG8_STAGE(PG8_SB(1, 1), b3 + hstep, voffB);
            PG8_WAIT_V(6); PG8_BAR; PG8_MMA(1, 1, At, B1); PG8_BAR;
        }
        PG8_STAMP();
        if constexpr (!Epi::AFTER_DRAIN) { E(acc, cur, wr, wc, fr, fq); S.done(cur); }
        PG8_STAMP();
        if (!has_next) break;
#pragma unroll
        for (int a = 0; a < 2; ++a)
#pragma unroll
            for (int b = 0; b < 2; ++b)
#pragma unroll
                for (int m = 0; m < 4; ++m)
#pragma unroll
                    for (int n = 0; n < 2; ++n) acc[a][b][m][n] = (f32x4){0.f, 0.f, 0.f, 0.f};
        cur = nxt; cA = nA; cB = nB; ++ui;
    }
    PG8_WAIT_V(0);
    if (wr == 0) PG8_BAR;
    PG8_BAR;
    if constexpr (Epi::AFTER_DRAIN) { E.fused(acc, cur, wr, wc, fr, fq, lds, wid, lane); S.done(cur); }
    PG8_STAMP();
    if (STAMP && wid == 0) { stamps[lane] = lane < nts ? (((unsigned long long)(unsigned)ts_hi << 32) | (unsigned)ts_lo) : 0ull;
        if (lane == 62) stamps[62] = rt_entry; if (lane == 63) stamps[63] = (unsigned long long)wall_clock64(); }
#undef PG8_STAMP
#undef PG8_SA
#undef PG8_SB
#undef PG8_STAGE
#undef PG8_LDA
#undef PG8_LDB
#undef PG8_MMA
#undef PG8_WAIT_V
#undef PG8_WAIT_L
#undef PG8_BAR
#undef PG8_SCHED
}
}


DI void phase_wconv(LAS unsigned char* lds, const float* __restrict__ src, bf16_t* __restrict__ dst, int K, int N, int Npad, int bid, int nb, float q8s = 0.f, int colmap = 0) {
    LAS float* tile = (LAS float*)lds;
    const int tid = tid_opaque();
    const int tk = K / 64, tn = Npad / 256, total = tk * tn;
    for (int t = bid; t < total; t += nb) {
        const int k0 = (t % tk) * 64, n0 = (t / tk) * 256;
        __syncthreads();
        {
            const int ty = tid >> 6, tx = tid & 63, n = n0 + tx * 4;
            f32x4 v[8];
#pragma unroll
            for (int i = 0; i < 8; ++i) {
                const int k = k0 + ty + 8 * i;
                v[i] = (f32x4){0.f, 0.f, 0.f, 0.f};
                if (colmap) { const int ns = (n >> 7) * 256 + (colmap == 1 ? 128 : 0) + (n & 127); v[i] = *(const f32x4*)(src + (size_t)k * (2 * N) + ns); }
                else if (n < N) v[i] = *(const f32x4*)(src + (size_t)k * N + n);
            }
#pragma unroll
            for (int i = 0; i < 8; ++i) { LAS float* pp = tile + (ty + 8 * i) * 257 + tx * 4; pp[0] = v[i][0]; pp[1] = v[i][1]; pp[2] = v[i][2]; pp[3] = v[i][3]; }
        }
        __syncthreads();
#pragma unroll
        for (int ps_ = 0; ps_ < 4; ++ps_) {
            const int n = (tid >> 3) + 64 * ps_, kc = tid & 7;
            float v[8];
#pragma unroll
            for (int j = 0; j < 8; ++j) { v[j] = tile[(kc * 8 + j) * 257 + n]; if (q8s != 0.f) v[j] = emu_q8(v[j], q8s); }
            u32x4 w; w.x = pk2(v[0], v[1]); w.y = pk2(v[2], v[3]); w.z = pk2(v[4], v[5]); w.w = pk2(v[6], v[7]);
            *(u32x4*)(dst + (size_t)(n0 + n) * K + k0 + kc * 8) = w;
        }
    }
}

DI void phase_rmsnorm(const float* __restrict__ x, const float* __restrict__ gain, bf16_t* __restrict__ h, int bid, int nb, float q8s = 0.f) {
    const int tid = tid_opaque(); const int lane = tid & 63, wid = tid >> 6;
    for (int row = bid * 8 + wid; row < MTOK; row += nb * 8) {
        const float* xr = x + (size_t)row * DM;
        f32x4 v[16]; float ss = 0.f;
#pragma unroll
        for (int i = 0; i < 16; ++i) { v[i] = *(const f32x4*)(xr + (i * 64 + lane) * 4); ss += v[i][0] * v[i][0] + v[i][1] * v[i][1] + v[i][2] * v[i][2] + v[i][3] * v[i][3]; }
#pragma unroll
        for (int o = 32; o >= 1; o >>= 1) ss += __shfl_xor(ss, o);
        const float rstd = rsqrtf(ss * (1.0f / DM) + EPSN);
        bf16_t* hr = h + (size_t)row * DM;
#pragma unroll
        for (int i = 0; i < 16; ++i) { const f32x4 g = *(const f32x4*)(gain + (i * 64 + lane) * 4);
            float y0 = v[i][0] * rstd * g[0], y1 = v[i][1] * rstd * g[1], y2 = v[i][2] * rstd * g[2], y3 = v[i][3] * rstd * g[3];
            if (q8s != 0.f) { y0 = emu_q8(y0, q8s); y1 = emu_q8(y1, q8s); y2 = emu_q8(y2, q8s); y3 = emu_q8(y3, q8s); }
            u32x2 w; w.x = pk2(y0, y1); w.y = pk2(y2, y3);
            *(u32x2*)(hr + (i * 64 + lane) * 4) = w; }
    }
}

DI void ld192(const bf16_t* p, int j8, float (&v)[24]) {
#pragma unroll
    for (int c = 0; c < 3; ++c) { const u32x4 w = *(const u32x4*)(p + (j8 + 8 * c) * 8);
        v[c * 8 + 0] = bflo(w.x); v[c * 8 + 1] = bfhi(w.x); v[c * 8 + 2] = bflo(w.y); v[c * 8 + 3] = bfhi(w.y);
        v[c * 8 + 4] = bflo(w.z); v[c * 8 + 5] = bfhi(w.z); v[c * 8 + 6] = bflo(w.w); v[c * 8 + 7] = bfhi(w.w); }
}
DI void st192(bf16_t* p, int j8, const float (&v)[24]) {
#pragma unroll
    for (int c = 0; c < 3; ++c) { u32x4 w; w.x = pk2(v[c * 8 + 0], v[c * 8 + 1]); w.y = pk2(v[c * 8 + 2], v[c * 8 + 3]); w.z = pk2(v[c * 8 + 4], v[c * 8 + 5]); w.w = pk2(v[c * 8 + 6], v[c * 8 + 7]);
        *(u32x4*)(p + (j8 + 8 * c) * 8) = w; }
}
DI float sum8(float s) { s += __shfl_xor(s, 1); s += __shfl_xor(s, 2); s += __shfl_xor(s, 4); return s; }

DI void phase_nsa_prep(const Params& P, int bid, int nb) {
    bf16_t* Y0 = (bf16_t*)(P.ws + OFF_Y0);
    bf16_t* KS = (bf16_t*)(P.ws + OFF_KS); bf16_t* KW = (bf16_t*)(P.ws + OFF_KW);
    bf16_t* ACK = (bf16_t*)(P.ws + OFF_ACK); bf16_t* ACV = (bf16_t*)(P.ws + OFF_ACV);
    const int tid = tid_opaque(), grp = (tid >> 3) & 15, j8 = tid & 7;
    for (int tok = bid * 4 + (tid >> 7); tok < MTOK; tok += nb * 4) {
        const int b = tok / SEQ, s = tok % SEQ;
        bf16_t* yr = Y0 + (size_t)tok * N1P;
        if (grp < 8) {
            const int g = grp & 3, br = grp >> 2;
            float v[24]; ld192(yr + (br ? C_KVW : C_KVS) + g * DK, j8, v);
            float ss = 0.f;
#pragma unroll
            for (int i = 0; i < 24; ++i) ss += v[i] * v[i];
            ss = sum8(ss);
            const float rstd = rsqrtf(ss * (1.0f / DK) + EPSN);
            const float* kn = P.nsa_k_norm + (br ? 2 : 1) * DK;
#pragma unroll
            for (int c = 0; c < 3; ++c)
#pragma unroll
                for (int e = 0; e < 8; ++e) v[c * 8 + e] *= rstd * kn[(j8 + 8 * c) * 8 + e];
            st192((br ? KW : KS) + ((size_t)(b * NG + g) * SEQ + s) * DK, j8, v);
        } else if (grp < 12) {
            const int g = grp - 8;
            float v[24]; ld192(yr + C_KVC + g * DK, j8, v);
#pragma unroll
            for (int k = 0; k < 2; ++k) {
                const int n = (s >> 4) - k, l = s - 16 * n;
                if (n >= 0 && n <= 254) {
                    float w[24];
#pragma unroll
                    for (int c = 0; c < 3; ++c)
#pragma unroll
                        for (int e = 0; e < 8; ++e) w[c * 8 + e] = v[c * 8 + e] + P.pe_k[l * DK + (j8 + 8 * c) * 8 + e];
                    st192(ACK + ((size_t)((b * NG + g) * 256 + n)) * 6144 + l * DK, j8, w);
                }
            }
        } else if (grp < 16) {
            const int g = grp - 12;
            const bf16_t* src = yr + C_KVC + NG * DK + g * DV;
            float v[16];
#pragma unroll
            for (int c = 0; c < 2; ++c) { const u32x4 w = *(const u32x4*)(src + (j8 + 8 * c) * 8);
                v[c * 8 + 0] = bflo(w.x); v[c * 8 + 1] = bfhi(w.x); v[c * 8 + 2] = bflo(w.y); v[c * 8 + 3] = bfhi(w.y);
                v[c * 8 + 4] = bflo(w.z); v[c * 8 + 5] = bfhi(w.z); v[c * 8 + 6] = bflo(w.w); v[c * 8 + 7] = bfhi(w.w); }
#pragma unroll
            for (int k = 0; k < 2; ++k) {
                const int n = (s >> 4) - k, l = s - 16 * n;
                if (n >= 0 && n <= 254) {
                    bf16_t* dst = ACV + ((size_t)((b * NG + g) * 256 + n)) * 4096 + l * DV;
#pragma unroll
                    for (int c = 0; c < 2; ++c) { float w[8];
#pragma unroll
                        for (int e = 0; e < 8; ++e) w[e] = v[c * 8 + e] + P.pe_v[l * DV + (j8 + 8 * c) * 8 + e];
                        u32x4 o; o.x = pk2(w[0], w[1]); o.y = pk2(w[2], w[3]); o.z = pk2(w[4], w[5]); o.w = pk2(w[6], w[7]);
                        *(u32x4*)(dst + (j8 + 8 * c) * 8) = o; }
                }
            }
        }
    }
    for (int i = bid * 512 + tid; i < 16 * (6144 + 4096) / 8; i += nb * 512) {
        const int per = (6144 + 4096) / 8, bg = i / per, c = i % per;
        const u32x4 z = {0u, 0u, 0u, 0u};
        if (c < 6144 / 8) *(u32x4*)(ACK + ((size_t)(bg * 256 + 255)) * 6144 + c * 8) = z;
        else *(u32x4*)(ACV + ((size_t)(bg * 256 + 255)) * 4096 + (c - 6144 / 8) * 8) = z;
    }
}

DI int swap23(int p) { return (p & ~0xC) | ((p & 4) << 1) | ((p & 8) >> 1); }
DI void phase_vt(LAS unsigned char* lds, const bf16_t* __restrict__ src, size_t src_stride, int col0, int col_step, int nhv, bf16_t* __restrict__ dst, int bid, int nb) {
    LAS bf16_t* tile = (LAS bf16_t*)lds;
    const int tid = tid_opaque();
    const int ntile = SEQ / 64, total = BATCH * nhv * ntile;
    for (int it = bid; it < total; it += nb) {
        const int mat = it / ntile, tt = it % ntile, b = mat / nhv, hv = mat % nhv;
        __syncthreads();
#pragma unroll
        for (int i = 0; i < 2; ++i) {
            const int q = tid + 512 * i, tok = q >> 4, ch = q & 15;
            const u32x4 w = *(const u32x4*)(src + (size_t)(b * SEQ + tt * 64 + tok) * src_stride + col0 + hv * col_step + ch * 8);
            *(LAS u32x4*)(tile + tok * 136 + ch * 8) = w;
        }
        __syncthreads();
        {
            const int dv = tid >> 2, kq = tid & 3;
            unsigned w[8];
#pragma unroll
            for (int e = 0; e < 8; ++e) {
                const int p0 = kq * 16 + 2 * e, p1 = p0 + 1;
                const int k0 = (p0 & ~15) | swap23(p0 & 15), k1 = (p1 & ~15) | swap23(p1 & 15);
                w[e] = (unsigned)tile[k0 * 136 + dv] | ((unsigned)tile[k1 * 136 + dv] << 16);
            }
            bf16_t* d = dst + ((size_t)mat * DV + dv) * SEQ + tt * 64 + kq * 16;
            u32x4 a = {w[0], w[1], w[2], w[3]}, c = {w[4], w[5], w[6], w[7]};
            *(u32x4*)d = a; *(u32x4*)(d + 8) = c;
        }
    }
}

DI void phase_cmp2(LAS unsigned char* lds, const Params& P, int bid, int nb) {
    LAS float* sk = (LAS float*)lds;
    LAS float* sv = sk + 192;
    LAS float* red = sv + 128;
    const float* HIDK = (const float*)(P.ws + OFF_HIDK); const float* HIDV = (const float*)(P.ws + OFF_HIDV);
    bf16_t* KC = (bf16_t*)(P.ws + OFF_KC); bf16_t* VTC = (bf16_t*)(P.ws + OFF_VTC);
    const int tid = tid_opaque(), lane = tid & 63, wid = tid >> 6;
    for (int m = bid; m < 4096; m += nb) {
        const int n = m & 255, bg = m >> 8;
        __syncthreads();
        if (tid < 192) { const float h = HIDK[(size_t)m * 256 + tid]; sk[tid] = h / (1.0f + __expf(-h)); }
        else if (tid < 320) { const float h = HIDV[(size_t)m * 256 + tid - 192]; sv[tid - 192] = h / (1.0f + __expf(-h)); }
        __syncthreads();
        float acc = 0.f;
        if (tid < 192) { for (int i = 0; i < 192; ++i) acc += sk[i] * P.w2_k[i * 192 + tid]; }
        else if (tid < 320) { const int j = tid - 192; for (int i = 0; i < 128; ++i) acc += sv[i] * P.w2_v[i * 128 + j]; }
        float ss = (tid < 192) ? acc * acc : 0.f;
#pragma unroll
        for (int o = 32; o >= 1; o >>= 1) ss += __shfl_xor(ss, o);
        if (lane == 0) red[wid] = ss;
        __syncthreads();
        const float tot = red[0] + red[1] + red[2];
        const float rstd = rsqrtf(tot * (1.0f / DK) + EPSN);
        if (tid < 192) { const float o = (n == 255) ? 0.f : acc * rstd * P.nsa_k_norm[tid];
            KC[(size_t)m * DK + tid] = (bf16_t)(pk2(o, 0.f) & 0xffffu); }
        else if (tid < 320) { const int j = tid - 192; const float o = (n == 255) ? 0.f : acc;
            const int pn = (n & ~15) | swap23(n & 15);
            VTC[((size_t)bg * DV + j) * 256 + pn] = (bf16_t)(pk2(o, 0.f) & 0xffffu); }
    }
}

DI void phase_mla_prep1(const Params& P, int bid, int nb) {
    const bf16_t* Y1 = (const bf16_t*)(P.ws + OFF_Y1);
    bf16_t* CQN = (bf16_t*)(P.ws + OFF_CQN); bf16_t* CKVN = (bf16_t*)(P.ws + OFF_CKVN); float* ROPE = (float*)(P.ws + OFF_ROPE);
    float* KPER = (float*)(P.ws + OFF_KPER); float* SSPE = (float*)(P.ws + OFF_SSPE);
    const int tid = tid_opaque(); const int lane = tid & 63, wid = tid >> 6;
    constexpr int TU = 4;
    for (int tok0 = (bid * 8 + wid) * TU; tok0 < MTOK; tok0 += nb * 8 * TU) {
        u32x4 wq[TU][3], wk[TU]; int pos[TU]; bf16_t kp1[TU], kp2[TU];
#pragma unroll
        for (int t = 0; t < TU; ++t) { const bf16_t* yr = Y1 + (size_t)(tok0 + t) * N3P;
#pragma unroll
            for (int c = 0; c < 3; ++c) wq[t][c] = *(const u32x4*)(yr + C3_CQ + (c * 64 + lane) * 8);
            wk[t] = *(const u32x4*)(yr + C3_CKV + lane * 8);
            pos[t] = P.pos[tok0 + t]; kp1[t] = yr[C3_KPE + (lane & 31)]; kp2[t] = yr[C3_KPE + 32 + (lane & 31)]; }
#pragma unroll
        for (int t = 0; t < TU; ++t) { const int tok = tok0 + t;
            {
                float v[24]; float ss = 0.f;
#pragma unroll
                for (int c = 0; c < 3; ++c) { const u32x4 w = wq[t][c];
                    v[c * 8 + 0] = bflo(w.x); v[c * 8 + 1] = bfhi(w.x); v[c * 8 + 2] = bflo(w.y); v[c * 8 + 3] = bfhi(w.y);
                    v[c * 8 + 4] = bflo(w.z); v[c * 8 + 5] = bfhi(w.z); v[c * 8 + 6] = bflo(w.w); v[c * 8 + 7] = bfhi(w.w); }
#pragma unroll
                for (int i = 0; i < 24; ++i) ss += v[i] * v[i];
#pragma unroll
                for (int o = 32; o >= 1; o >>= 1) ss += __shfl_xor(ss, o);
                const float rstd = rsqrtf(ss * (1.0f / QLORA) + EPSN);
#pragma unroll
                for (int c = 0; c < 3; ++c) { const float* g = P.mla_q_a_norm + (c * 64 + lane) * 8; const f32x4 g0 = *(const f32x4*)g, g1 = *(const f32x4*)(g + 4); u32x4 w;
                    w.x = pk2(v[c * 8 + 0] * rstd * g0[0], v[c * 8 + 1] * rstd * g0[1]); w.y = pk2(v[c * 8 + 2] * rstd * g0[2], v[c * 8 + 3] * rstd * g0[3]);
                    w.z = pk2(v[c * 8 + 4] * rstd * g1[0], v[c * 8 + 5] * rstd * g1[1]); w.w = pk2(v[c * 8 + 6] * rstd * g1[2], v[c * 8 + 7] * rstd * g1[3]);
                    *(u32x4*)(CQN + (size_t)tok * QLORA + (c * 64 + lane) * 8) = w; }
            }
            {
                float v[8]; float ss = 0.f; const u32x4 w0 = wk[t];
                v[0] = bflo(w0.x); v[1] = bfhi(w0.x); v[2] = bflo(w0.y); v[3] = bfhi(w0.y); v[4] = bflo(w0.z); v[5] = bfhi(w0.z); v[6] = bflo(w0.w); v[7] = bfhi(w0.w);
#pragma unroll
                for (int i = 0; i < 8; ++i) ss += v[i] * v[i];
#pragma unroll
                for (int o = 32; o >= 1; o >>= 1) ss += __shfl_xor(ss, o);
                const float rstd = rsqrtf(ss * (1.0f / KVLORA) + EPSN);
                const float* g = P.mla_kv_a_norm + lane * 8; const f32x4 g0 = *(const f32x4*)g, g1 = *(const f32x4*)(g + 4); u32x4 w;
                w.x = pk2(v[0] * rstd * g0[0], v[1] * rstd * g0[1]); w.y = pk2(v[2] * rstd * g0[2], v[3] * rstd * g0[3]);
                w.z = pk2(v[4] * rstd * g1[0], v[5] * rstd * g1[1]); w.w = pk2(v[6] * rstd * g1[2], v[7] * rstd * g1[3]);
                *(u32x4*)(CKVN + (size_t)tok * KVLORA + lane * 8) = w;
            }
            {
                const int i = lane & 31;
                const float invf = exp2f(-(float)i * (13.287712379549449f / 32.0f));
                const float ang = (float)pos[t] * invf;
                const double rev = (double)ang * 0.15915494309189533576888;
                const float fr = (float)(rev - __builtin_rint(rev));
                const float sn = __builtin_amdgcn_sinf(fr), cs = __builtin_amdgcn_cosf(fr);
                const float x1 = bf1(kp1[t]), x2 = bf1(kp2[t]);
                float ssp = x1 * x1 + x2 * x2;
#pragma unroll
                for (int o = 16; o >= 1; o >>= 1) ssp += __shfl_xor(ssp, o);
                const float a = x1 * P.mla_k_norm[128 + i], c = x2 * P.mla_k_norm[160 + i];
                if (lane < 32) { ROPE[(size_t)tok * 64 + i] = cs; ROPE[(size_t)tok * 64 + 32 + i] = sn;
                    KPER[(size_t)tok * 64 + i] = a * cs - c * sn; KPER[(size_t)tok * 64 + 32 + i] = c * cs + a * sn;
                    if (lane == 0) SSPE[tok] = ssp; }
            }
        }
    }
}

DI void phase_mla_prep2(const Params& P, int bid, int nb) {
    const bf16_t* KNM = (const bf16_t*)(P.ws + OFF_KNM); const bf16_t* Y1 = (const bf16_t*)(P.ws + OFF_Y1);
    bf16_t* KM = (bf16_t*)(P.ws + OFF_KM); const float* ROPE = (const float*)(P.ws + OFF_ROPE);
    const int tid = tid_opaque(), grp = tid >> 3, j8 = tid & 7;
    for (int tok = bid; tok < MTOK; tok += nb) {
        const int b = tok / SEQ, s = tok % SEQ;
        float cs[8], sn[8];
#pragma unroll
        for (int e = 0; e < 8; ++e) { const int i = (8 * j8 + e) & 31; cs[e] = ROPE[(size_t)tok * 64 + i]; sn[e] = ROPE[(size_t)tok * 64 + 32 + i]; }
        {
            const bf16_t* kn = KNM + (size_t)tok * (NH * 128) + grp * 128;
            const bf16_t* kp = Y1 + (size_t)tok * N3P + C3_KPE;
            float v[24];
#pragma unroll
            for (int c = 0; c < 2; ++c) { const u32x4 w = *(const u32x4*)(kn + (j8 + 8 * c) * 8);
                v[c * 8 + 0] = bflo(w.x); v[c * 8 + 1] = bfhi(w.x); v[c * 8 + 2] = bflo(w.y); v[c * 8 + 3] = bfhi(w.y);
                v[c * 8 + 4] = bflo(w.z); v[c * 8 + 5] = bfhi(w.z); v[c * 8 + 6] = bflo(w.w); v[c * 8 + 7] = bfhi(w.w); }
            { const u32x4 w = *(const u32x4*)(kp + j8 * 8);
                v[16] = bflo(w.x); v[17] = bfhi(w.x); v[18] = bflo(w.y); v[19] = bfhi(w.y); v[20] = bflo(w.z); v[21] = bfhi(w.z); v[22] = bflo(w.w); v[23] = bfhi(w.w); }
            float ss = 0.f;
#pragma unroll
            for (int i = 0; i < 24; ++i) ss += v[i] * v[i];
            ss = sum8(ss);
            const float rstd = rsqrtf(ss * (1.0f / DK) + EPSN);
#pragma unroll
            for (int c = 0; c < 3; ++c)
#pragma unroll
                for (int e = 0; e < 8; ++e) v[c * 8 + e] *= rstd * P.mla_k_norm[(j8 + 8 * c) * 8 + e];
#pragma unroll
            for (int e = 0; e < 8; ++e) { const float mine = v[16 + e], other = __shfl_xor(mine, 4);
                v[16 + e] = (j8 < 4) ? (mine * cs[e] - other * sn[e]) : (mine * cs[e] + other * sn[e]); }
            st192(KM + ((size_t)(b * NH + grp) * SEQ + s) * DK, j8, v);
        }
    }
}
#ifndef PROBE_TOPK
#define PROBE_TOPK 1
#endif
#ifndef PROBE_EPI
#define PROBE_EPI 1
#endif
#ifndef NO_CMP1
#define NO_CMP1 0
#endif
#ifndef NO_CMP2
#define NO_CMP2 0
#endif
#ifndef NO_SEL
#define NO_SEL 0
#endif
#ifndef NO_WIN
#define NO_WIN 0
#endif
#ifndef PROBE_SEL2
#define PROBE_SEL2 0
#endif
#ifndef PROBE_WIN2
#define PROBE_WIN2 0
#endif
#ifndef ATT_THR
#define ATT_THR 30.0f
#endif
#ifndef ATT_PS_LIMIT
#define ATT_PS_LIMIT (16.0f * 1073741824.0f)
#endif
#ifndef ATT_DEP_MLA
#define ATT_DEP_MLA 5
#endif
#ifndef ATT_DEP_NSA
#define ATT_DEP_NSA 4
#endif
#ifndef ATT_SPLIT_MLA
#define ATT_SPLIT_MLA 0
#endif
#ifndef ATT_SPLIT_NSA
#define ATT_SPLIT_NSA 0
#endif
#ifndef ATT_KA_NSA
#define ATT_KA_NSA 2
#endif
constexpr int KT_BYTES = 64 * 384, VT_BYTES = 128 * 128;
constexpr int L_K = 0, L_V = 2 * KT_BYTES, L_LUT = L_V + 2 * VT_BYTES, LUT_PITCH = 129, L_X = L_LUT + 64 * LUT_PITCH * 4 + 16  , L_IL = L_X + 16 * 16 * 64 * 2, L_END = L_IL + 16 * 16 * 4, L_QS = L_X, L_P3 = L_X + 16 * 64 * 4;
static_assert(L_END <= 151552, "attention LDS");
enum { MODE_MLA = 0, MODE_CMP1 = 1, MODE_CMP2 = 2, MODE_SEL = 3, MODE_WIN = 4, MODE_CMPX = 5 };
#define MFMA32(a, b, c) __builtin_amdgcn_mfma_f32_32x32x16_bf16((a), (b), (c), 0, 0, 0)

struct AttnLane {
    int tq;
    int tw0, tw1;
    const LAS float* lutrow;
    float lut_far;
    unsigned long long mk0, mk1;
    int tk;
    int curblk;
    float inv_l;
    int tokidx;
    mutable float carry;
};

template <int MODE> DI bool tile_act(int j, const AttnLane& A) {
    if (MODE == MODE_MLA) return 64 * j <= A.tw1;
    else if (MODE == MODE_CMP1 || MODE == MODE_CMP2 || MODE == MODE_CMPX) return 1024 * j + 31 <= A.tw1;
    else if (MODE == MODE_SEL) return (((A.mk0 | A.mk1) >> j) & 1ull) != 0ull;
    else return (64 * j <= A.tw1) && (64 * j + 63 >= A.tw0 - 511);
}

template <int MODE, int H>
DI bool half_init(f32x16& p, int j, int hi, float m_run, const AttnLane& A) {
    if (MODE == MODE_MLA) {
#pragma unroll
        for (int r = 0; r < 16; ++r) p[r] = 0.f;
        return true;
    } else if (MODE == MODE_WIN || MODE == MODE_SEL) {
        const int dq = A.tq - 64 * j - 32 * H - 4 * hi;
        const bool far = (A.tw0 - (64 * j + 32 * H + 31) >= 113);
        if (far) {
#pragma unroll
            for (int r = 0; r < 16; ++r) p[r] = 0.f;
            return true;
        } else {
#pragma unroll
            for (int r = 0; r < 16; ++r) { int d = dq - ((r & 3) + 8 * (r >> 2)); d = d < 0 ? 0 : (d > 127 ? 127 : d); p[r] = A.lutrow[d] - m_run; }
            return false;
        }
    } else {
        const int dq = A.tq - 31 - 1024 * j - 512 * H - 64 * hi;
        const bool far = (A.tw0 - 31 - 16 * (64 * j + 32 * H + 31) >= 113);
        if (far) {
#pragma unroll
            for (int r = 0; r < 16; ++r) p[r] = 0.f;
            return true;
        } else {
#pragma unroll
            for (int r = 0; r < 16; ++r) { int d = dq - 16 * ((r & 3) + 8 * (r >> 2)); d = d < 0 ? 0 : (d > 127 ? 127 : d); p[r] = A.lutrow[d] - m_run; }
            return false;
        }
    }
}
DI void half_fix(f32x16& p, bool zero_init, float m_run) {
    if (zero_init && __any(m_run != 0.f)) {
#pragma unroll
        for (int r = 0; r < 16; ++r) p[r] -= m_run;
    }
}
template <int MODE, int H>
DI void half_mask(f32x16& p, int j, int hi, const AttnLane& A) {
    const float NEG = -__builtin_inff();
    if (MODE == MODE_MLA) {
        if (64 * j + 32 * H + 31 > A.tw0) {
            const int dq = A.tq - 64 * j - 32 * H - 4 * hi;
#pragma unroll
            for (int r = 0; r < 16; ++r) p[r] = (dq - ((r & 3) + 8 * (r >> 2)) < 0) ? NEG : p[r];
        }
    } else if (MODE == MODE_WIN) {
        const int k0 = 64 * j + 32 * H;
        if (!(k0 + 31 <= A.tw0 && k0 >= A.tw1 - 511)) {
            const int dq = A.tq - k0 - 4 * hi;
#pragma unroll
            for (int r = 0; r < 16; ++r) p[r] = ((unsigned)(dq - ((r & 3) + 8 * (r >> 2))) >= 512u) ? NEG : p[r];
        }
    } else if (MODE == MODE_SEL) {
        if (j == A.curblk) {
            const int dq = A.tq - 64 * j - 32 * H - 4 * hi;
#pragma unroll
            for (int r = 0; r < 16; ++r) p[r] = (dq - ((r & 3) + 8 * (r >> 2)) < 0) ? NEG : p[r];
        }
    } else {
        if (A.tw0 - 31 - 16 * (64 * j + 32 * H + 31) < 0) {
            const int dq = A.tq - 31 - 1024 * j - 512 * H - 64 * hi;
#pragma unroll
            for (int r = 0; r < 16; ++r) p[r] = (dq - 16 * ((r & 3) + 8 * (r >> 2)) < 0) ? NEG : p[r];
        }
    }
}
template <int MODE>
DI void sel_zero(u32x4& wa, u32x4& wb, float& ps, int j, const AttnLane& A) {
    if (MODE == MODE_SEL) {
        const bool s0_ = ((A.mk0 >> j) & 1ull) != 0ull, s1_ = ((A.mk1 >> j) & 1ull) != 0ull; const bool sel = A.tk ? s1_ : s0_;
        const unsigned msk = sel ? 0xffffffffu : 0u;
        wa.x &= msk; wa.y &= msk; wa.z &= msk; wa.w &= msk; wb.x &= msk; wb.y &= msk; wb.z &= msk; wb.w &= msk;
        ps = sel ? ps : 0.f;
    }
}
template <int H, int DEP>
DI void half_qk(f32x16& p, const LAS unsigned char* kb, const int (&kbase)[4], const bf16x8 (&q)[12]) {
    bf16x8 f[DEP + 1];
#pragma unroll
    for (int d0 = 0; d0 < DEP; ++d0) f[d0] = *(const LAS bf16x8*)(kb + kbase[d0 & 3] + (d0 >> 2) * 128 + H * (32 * 384));
    __builtin_amdgcn_sched_barrier(0);
#pragma unroll
    for (int d0 = 0; d0 < 12; ++d0) {
        if (d0 + DEP < 12) { const int dn = d0 + DEP; f[dn % (DEP + 1)] = *(const LAS bf16x8*)(kb + kbase[dn & 3] + (dn >> 2) * 128 + H * (32 * 384)); }
        __builtin_amdgcn_sched_barrier(0);
        p = MFMA32(f[d0 % (DEP + 1)], q[d0], p);
        __builtin_amdgcn_sched_barrier(0);
    }
}
DI unsigned sm_pair(const f32x16& p, int e0, float& ps, float& mx) {
    const float a = __builtin_amdgcn_exp2f(p[e0]), b = __builtin_amdgcn_exp2f(p[e0 + 1]);
    ps += a + b; (void)mx;
    return pk2(a, b);
}
template <bool HASV>
DI void half_exact(f32x16& p, f32x16* pend, f32x16 (&o)[4], float& m_run, float& l_run, u32x4& wa, u32x4& wb, float& ps) {
    float mx = p[0];
#pragma unroll
    for (int r = 1; r < 16; ++r) mx = fmaxf(mx, p[r]);
    mx = fmaxf(mx, __shfl_xor(mx, 32));
    const float dl = fmaxf(mx, 0.f);
    const float alpha = __builtin_amdgcn_exp2f(-dl);
    m_run += dl; l_run *= alpha;
    if (HASV) {
#pragma unroll
        for (int d = 0; d < 4; ++d)
#pragma unroll
            for (int r = 0; r < 16; ++r) o[d][r] *= alpha;
    }
    if (pend) {
#pragma unroll
        for (int r = 0; r < 16; ++r) (*pend)[r] -= dl;
    }
    ps = 0.f; float dm = 0.f;
#pragma unroll
    for (int r = 0; r < 16; ++r) p[r] -= dl;
    wa.x = sm_pair(p, 0, ps, dm); wa.y = sm_pair(p, 2, ps, dm); wa.z = sm_pair(p, 4, ps, dm); wa.w = sm_pair(p, 6, ps, dm);
    wb.x = sm_pair(p, 8, ps, dm); wb.y = sm_pair(p, 10, ps, dm); wb.z = sm_pair(p, 12, ps, dm); wb.w = sm_pair(p, 14, ps, dm);
}

template <int MODE>
DI void attn_tile2(const LAS unsigned char* kb, const LAS unsigned char* vb, LAS unsigned char* lds, int j, int lane, const bf16x8 (&q)[12],
                   f32x16 (&o)[4], float& m_run, float& l_run, const AttnLane& A) {
    constexpr bool HASV = (MODE != MODE_CMP1);
    constexpr int DEP = (MODE == MODE_MLA) ? ATT_DEP_MLA : ATT_DEP_NSA;
    const int hi = lane >> 5, r32 = lane & 31;
    int kbase[4], vbase[4];
#pragma unroll
    for (int dd = 0; dd < 4; ++dd) { kbase[dd] = r32 * 384 + (((2 * dd + hi) ^ ((r32 >> 1) & 7)) << 4); vbase[dd] = r32 * 128 + (((2 * dd + hi) ^ ((r32 >> 1) & 7)) << 4); }
    f32x16 p0, p1;
    if (MODE == MODE_CMPX) {
        const bool z0_ = half_init<MODE, 0>(p0, j, hi, m_run, A), z1_ = half_init<MODE, 1>(p1, j, hi, m_run, A);
        {
            constexpr int KA = ATT_KA_NSA;
            bf16x8 fa[KA + 1], fb[KA + 1];
#pragma unroll
            for (int d0 = 0; d0 < KA; ++d0) { const LAS unsigned char* a_ = kb + kbase[d0 & 3] + (d0 >> 2) * 128; fa[d0] = *(const LAS bf16x8*)a_; fb[d0] = *(const LAS bf16x8*)(a_ + 32 * 384); }
            __builtin_amdgcn_sched_barrier(0);
#pragma unroll
            for (int d0 = 0; d0 < 12; ++d0) {
                if (d0 + KA < 12) { const int dn = d0 + KA; const LAS unsigned char* a_ = kb + kbase[dn & 3] + (dn >> 2) * 128;
                    fa[dn % (KA + 1)] = *(const LAS bf16x8*)a_; fb[dn % (KA + 1)] = *(const LAS bf16x8*)(a_ + 32 * 384); }
                __builtin_amdgcn_sched_barrier(0);
                p0 = MFMA32(fa[d0 % (KA + 1)], q[d0], p0);
                p1 = MFMA32(fb[d0 % (KA + 1)], q[d0], p1);
                __builtin_amdgcn_sched_barrier(0);
            }
        }
        half_fix(p0, z0_, m_run); half_fix(p1, z1_, m_run);
        half_mask<MODE, 0>(p0, j, hi, A); half_mask<MODE, 1>(p1, j, hi, A);
        LAS bf16_t* X = (LAS bf16_t*)(lds + L_X) + (A.tokidx * 16 + (lane & 15)) * 64;
#pragma unroll
        for (int h = 0; h < 2; ++h) {
            f32x16& p = h ? p1 : p0;
            float lmx = p[0];
#pragma unroll
            for (int r = 1; r < 16; ++r) lmx = fmaxf(lmx, p[r]);
            if (__any(lmx > ATT_THR)) {
                const float mx = fmaxf(lmx, __shfl_xor(lmx, 32));
                const float dl = fmaxf(mx, 0.f), alpha = __builtin_amdgcn_exp2f(-dl);
                m_run += dl; l_run *= alpha; A.carry *= alpha;
#pragma unroll
                for (int d = 0; d < 4; ++d)
#pragma unroll
                    for (int r = 0; r < 16; ++r) o[d][r] *= alpha;
#pragma unroll
                for (int r = 0; r < 16; ++r) p[r] -= dl;
                if (h == 0) {
#pragma unroll
                    for (int r = 0; r < 16; ++r) p1[r] -= dl;
                }
                const int qb = 16 * j + 8 * h;
                for (int a = hi; a < qb; a += 2) X[a] = (bf16_t)(pk2(bf1(X[a]) * alpha, 0.f) & 0xffffu);
            }
            float e[16]; float ps = 0.f;
#pragma unroll
            for (int r = 0; r < 16; ++r) { e[r] = __builtin_amdgcn_exp2f(p[r]); ps += e[r]; }
            l_run += ps;
            float y[4];
#pragma unroll
            for (int k = 0; k < 4; ++k) y[k] = __shfl_xor(e[4 * k + 3], 32);
#pragma unroll
            for (int k = 0; k < 4; ++k) { const float prev = hi ? y[k] : (k ? y[k > 0 ? k - 1 : 0] : A.carry);
                const float sblk = (e[4 * k] + e[4 * k + 1]) + (e[4 * k + 2] + e[4 * k + 3]) + prev;
                X[16 * j + 8 * h + 2 * k + hi] = (bf16_t)(pk2(sblk, 0.f) & 0xffffu); }
            if (!hi) A.carry = y[3];
            u32x4 wa, wb;
            wa.x = pk2(e[0], e[1]); wa.y = pk2(e[2], e[3]); wa.z = pk2(e[4], e[5]); wa.w = pk2(e[6], e[7]);
            wb.x = pk2(e[8], e[9]); wb.y = pk2(e[10], e[11]); wb.z = pk2(e[12], e[13]); wb.w = pk2(e[14], e[15]);
            const bf16x8 pba = __builtin_bit_cast(bf16x8, wa), pbb = __builtin_bit_cast(bf16x8, wb);
#pragma unroll
            for (int i = 0; i < 8; ++i) { const bf16x8 va = *(const LAS bf16x8*)(vb + vbase[2 * h + (i >> 2)] + (i & 3) * (32 * 128)); o[i & 3] = MFMA32(va, (i < 4) ? pba : pbb, o[i & 3]); }
        }
        return;
    }
    if (MODE == MODE_CMP2) {
        { const bool z_ = half_init<MODE, 0>(p0, j, hi, m_run, A); half_qk<0, DEP>(p0, kb, kbase, q); half_fix(p0, z_, m_run); half_mask<MODE, 0>(p0, j, hi, A); }
        { const bool z_ = half_init<MODE, 1>(p1, j, hi, m_run, A); half_qk<1, DEP>(p1, kb, kbase, q); half_fix(p1, z_, m_run); half_mask<MODE, 1>(p1, j, hi, A); }
        const float il = A.inv_l;
#pragma unroll
        for (int r = 0; r < 16; ++r) { p0[r] = __builtin_amdgcn_exp2f(p0[r]) * il; p1[r] = __builtin_amdgcn_exp2f(p1[r]) * il; }
        float v[16];
#pragma unroll
        for (int k = 0; k < 4; ++k) { v[k] = (p0[4 * k] + p0[4 * k + 1]) + (p0[4 * k + 2] + p0[4 * k + 3]); v[4 + k] = (p1[4 * k] + p1[4 * k + 1]) + (p1[4 * k + 2] + p1[4 * k + 3]);
            v[8 + k] = p0[4 * k + 3]; v[12 + k] = p1[4 * k + 3]; }
        { const bool up = (lane & 8) != 0;
#pragma unroll
          for (int i = 0; i < 8; ++i) { const float send = up ? v[i] : v[i + 8]; const float recv = __shfl_xor(send, 8); const float keep = up ? v[i + 8] : v[i]; v[i] = keep + recv; } }
        { const bool up = (lane & 4) != 0;
#pragma unroll
          for (int i = 0; i < 4; ++i) { const float send = up ? v[i] : v[i + 4]; const float recv = __shfl_xor(send, 4); const float keep = up ? v[i + 4] : v[i]; v[i] = keep + recv; } }
        { const bool up = (lane & 2) != 0;
#pragma unroll
          for (int i = 0; i < 2; ++i) { const float send = up ? v[i] : v[i + 2]; const float recv = __shfl_xor(send, 2); const float keep = up ? v[i + 2] : v[i]; v[i] = keep + recv; } }
        { const bool up = (lane & 1) != 0;
          const float send = up ? v[0] : v[1]; const float recv = __shfl_xor(send, 1); const float keep = up ? v[1] : v[0]; v[0] = keep + recv; }
        { const int idx = lane & 15, half = (idx >> 2) & 1, k = idx & 3, isp3 = idx >> 3;
          const int quad = 16 * j + 8 * half + 2 * k + hi;
          LAS float* dst = (LAS float*)(lds + (isp3 ? L_P3 : L_QS)) + A.tokidx * 64 + quad;
          *dst = v[0]; }
#pragma unroll
        for (int ks = 0; ks < 4; ++ks) {
            u32x4 w;
            if (ks == 0) { w.x = pk2(p0[0], p0[1]); w.y = pk2(p0[2], p0[3]); w.z = pk2(p0[4], p0[5]); w.w = pk2(p0[6], p0[7]); }
            else if (ks == 1) { w.x = pk2(p0[8], p0[9]); w.y = pk2(p0[10], p0[11]); w.z = pk2(p0[12], p0[13]); w.w = pk2(p0[14], p0[15]); }
            else if (ks == 2) { w.x = pk2(p1[0], p1[1]); w.y = pk2(p1[2], p1[3]); w.z = pk2(p1[4], p1[5]); w.w = pk2(p1[6], p1[7]); }
            else { w.x = pk2(p1[8], p1[9]); w.y = pk2(p1[10], p1[11]); w.z = pk2(p1[12], p1[13]); w.w = pk2(p1[14], p1[15]); }
            const bf16x8 pb = __builtin_bit_cast(bf16x8, w);
#pragma unroll
            for (int d = 0; d < 4; ++d) { const bf16x8 va = *(const LAS bf16x8*)(vb + vbase[ks] + d * (32 * 128)); o[d] = MFMA32(va, pb, o[d]); }
        }
        return;
    }
    u32x4 wa, wb; float ps = 0.f, mx = -__builtin_inff();
    if ((MODE == MODE_MLA && ATT_SPLIT_MLA) || (MODE != MODE_MLA && ATT_SPLIT_NSA)) {
    { const bool z_ = half_init<MODE, 0>(p0, j, hi, m_run, A);
    half_qk<0, DEP>(p0, kb, kbase, q);
    half_fix(p0, z_, m_run); }
    half_mask<MODE, 0>(p0, j, hi, A);
    const bool zs1_ = half_init<MODE, 1>(p1, j, hi, m_run, A);
    {
        bf16x8 f[DEP + 1];
#pragma unroll
        for (int d0 = 0; d0 < DEP; ++d0) f[d0] = *(const LAS bf16x8*)(kb + kbase[d0 & 3] + (d0 >> 2) * 128 + 32 * 384);
        __builtin_amdgcn_sched_barrier(0);
#pragma unroll
        for (int d0 = 0; d0 < 12; ++d0) {
            if (d0 + DEP < 12) { const int dn = d0 + DEP; f[dn % (DEP + 1)] = *(const LAS bf16x8*)(kb + kbase[dn & 3] + (dn >> 2) * 128 + 32 * 384); }
            __builtin_amdgcn_sched_barrier(0);
            p1 = MFMA32(f[d0 % (DEP + 1)], q[d0], p1);
            if (d0 == 0) wa.x = sm_pair(p0, 0, ps, mx); else if (d0 == 1) wa.y = sm_pair(p0, 2, ps, mx); else if (d0 == 2) wa.z = sm_pair(p0, 4, ps, mx); else if (d0 == 3) wa.w = sm_pair(p0, 6, ps, mx);
            else if (d0 == 4) wb.x = sm_pair(p0, 8, ps, mx); else if (d0 == 5) wb.y = sm_pair(p0, 10, ps, mx); else if (d0 == 6) wb.z = sm_pair(p0, 12, ps, mx); else if (d0 == 7) wb.w = sm_pair(p0, 14, ps, mx);
            __builtin_amdgcn_sched_barrier(0);
        }
    }
    half_fix(p1, zs1_, m_run);
    } else {
    const bool zc0_ = half_init<MODE, 0>(p0, j, hi, m_run, A);
    const bool zc1_ = half_init<MODE, 1>(p1, j, hi, m_run, A);
    {
        constexpr int KA = ATT_KA_NSA;
        bf16x8 fa[KA + 1], fb[KA + 1];
#pragma unroll
        for (int d0 = 0; d0 < KA; ++d0) { const LAS unsigned char* a_ = kb + kbase[d0 & 3] + (d0 >> 2) * 128; fa[d0] = *(const LAS bf16x8*)a_; fb[d0] = *(const LAS bf16x8*)(a_ + 32 * 384); }
        __builtin_amdgcn_sched_barrier(0);
#pragma unroll
        for (int d0 = 0; d0 < 12; ++d0) {
            if (d0 + KA < 12) { const int dn = d0 + KA; const LAS unsigned char* a_ = kb + kbase[dn & 3] + (dn >> 2) * 128;
                fa[dn % (KA + 1)] = *(const LAS bf16x8*)a_; fb[dn % (KA + 1)] = *(const LAS bf16x8*)(a_ + 32 * 384); }
            __builtin_amdgcn_sched_barrier(0);
            p0 = MFMA32(fa[d0 % (KA + 1)], q[d0], p0);
            p1 = MFMA32(fb[d0 % (KA + 1)], q[d0], p1);
            __builtin_amdgcn_sched_barrier(0);
        }
    }
    half_fix(p0, zc0_, m_run); half_fix(p1, zc1_, m_run);
    half_mask<MODE, 0>(p0, j, hi, A);
    wa.x = sm_pair(p0, 0, ps, mx); wa.y = sm_pair(p0, 2, ps, mx); wa.z = sm_pair(p0, 4, ps, mx); wa.w = sm_pair(p0, 6, ps, mx);
    wb.x = sm_pair(p0, 8, ps, mx); wb.y = sm_pair(p0, 10, ps, mx); wb.z = sm_pair(p0, 12, ps, mx); wb.w = sm_pair(p0, 14, ps, mx);
    }
    half_mask<MODE, 1>(p1, j, hi, A);
    if (__any(!(ps <= ATT_PS_LIMIT))) {
        half_exact<HASV>(p0, &p1, o, m_run, l_run, wa, wb, ps);
    }
    sel_zero<MODE>(wa, wb, ps, j, A);
    l_run += ps;
    u32x4 wc, wd; float ps1 = 0.f, mx1 = -__builtin_inff();
    if (HASV) {
        const bf16x8 pba = __builtin_bit_cast(bf16x8, wa), pbb = __builtin_bit_cast(bf16x8, wb);
        bf16x8 f[DEP + 1];
#pragma unroll
        for (int i = 0; i < DEP; ++i) f[i] = *(const LAS bf16x8*)(vb + vbase[i >> 2] + (i & 3) * (32 * 128));
        __builtin_amdgcn_sched_barrier(0);
#pragma unroll
        for (int i = 0; i < 8; ++i) {
            if (i + DEP < 8) { const int in_ = i + DEP; f[in_ % (DEP + 1)] = *(const LAS bf16x8*)(vb + vbase[in_ >> 2] + (in_ & 3) * (32 * 128)); }
            __builtin_amdgcn_sched_barrier(0);
            o[i & 3] = MFMA32(f[i % (DEP + 1)], (i < 4) ? pba : pbb, o[i & 3]);
            if (i == 0) wc.x = sm_pair(p1, 0, ps1, mx1); else if (i == 1) wc.y = sm_pair(p1, 2, ps1, mx1); else if (i == 2) wc.z = sm_pair(p1, 4, ps1, mx1); else if (i == 3) wc.w = sm_pair(p1, 6, ps1, mx1);
            else if (i == 4) wd.x = sm_pair(p1, 8, ps1, mx1); else if (i == 5) wd.y = sm_pair(p1, 10, ps1, mx1); else if (i == 6) wd.z = sm_pair(p1, 12, ps1, mx1); else wd.w = sm_pair(p1, 14, ps1, mx1);
            __builtin_amdgcn_sched_barrier(0);
        }
    } else {
        wc.x = sm_pair(p1, 0, ps1, mx1); wc.y = sm_pair(p1, 2, ps1, mx1); wc.z = sm_pair(p1, 4, ps1, mx1); wc.w = sm_pair(p1, 6, ps1, mx1);
        wd.x = sm_pair(p1, 8, ps1, mx1); wd.y = sm_pair(p1, 10, ps1, mx1); wd.z = sm_pair(p1, 12, ps1, mx1); wd.w = sm_pair(p1, 14, ps1, mx1);
    }
    if (__any(!(ps1 <= ATT_PS_LIMIT))) {
        half_exact<HASV>(p1, nullptr, o, m_run, l_run, wc, wd, ps1);
    }
    sel_zero<MODE>(wc, wd, ps1, j, A);
    l_run += ps1;
    if (HASV) {
        const bf16x8 pbc = __builtin_bit_cast(bf16x8, wc), pbd = __builtin_bit_cast(bf16x8, wd);
        bf16x8 f[DEP + 1];
#pragma unroll
        for (int i = 0; i < DEP; ++i) f[i] = *(const LAS bf16x8*)(vb + vbase[2 + (i >> 2)] + (i & 3) * (32 * 128));
        __builtin_amdgcn_sched_barrier(0);
#pragma unroll
        for (int i = 0; i < 8; ++i) {
            if (i + DEP < 8) { const int in_ = i + DEP; f[in_ % (DEP + 1)] = *(const LAS bf16x8*)(vb + vbase[2 + (in_ >> 2)] + (in_ & 3) * (32 * 128)); }
            __builtin_amdgcn_sched_barrier(0);
            o[i & 3] = MFMA32(f[i % (DEP + 1)], (i < 4) ? pbc : pbd, o[i & 3]);
            __builtin_amdgcn_sched_barrier(0);
        }
    }
}

template <int MODE>
DI void attn_pass2(LAS unsigned char* lds, const char* __restrict__ Kc, const char* __restrict__ Vc, int vt_stride, int j_lo, int j_hi,
                   const bf16x8 (&q)[12], f32x16 (&o)[4], float& m_run, float& l_run, const AttnLane& A) {
    if (j_lo >= j_hi) return;
    constexpr bool HASV = (MODE != MODE_CMP1);
    int tid = threadIdx.x; asm volatile("" : "+v"(tid));
    const int lane = tid & 63;
    const int wid_ = __builtin_amdgcn_readfirstlane(tid >> 6);
#define ST_ISSUE(j, buf) do { int ln_ = lane; asm volatile("" : "+v"(ln_)); \
        const char* kp_ = Kc + (size_t)(j) * KT_BYTES; LAS unsigned char* kb_ = lds + L_K + (buf) * KT_BYTES + wid_ * 3072; \
        _Pragma("unroll") for (int i_ = 0; i_ < 3; ++i_) { const int pidx_ = (wid_ * 3 + i_) * 64 + ln_, row_ = pidx_ / 24, cp_ = pidx_ % 24; \
            __builtin_amdgcn_global_load_lds((const unsigned*)(kp_ + (unsigned)(row_ * 384 + ((cp_ ^ ((row_ >> 1) & 7)) << 4))), (LAS unsigned*)(kb_ + i_ * 1024), 16, 0, 0); } \
        if (HASV) { const char* vp_ = Vc + (size_t)(j) * 128; LAS unsigned char* vb_ = lds + L_V + (buf) * VT_BYTES + wid_ * 2048; \
            _Pragma("unroll") for (int i_ = 0; i_ < 2; ++i_) { const int pidx_ = (wid_ * 2 + i_) * 64 + ln_, row_ = pidx_ >> 3, cp_ = pidx_ & 7; \
                __builtin_amdgcn_global_load_lds((const unsigned*)(vp_ + (unsigned)(row_ * vt_stride * 2 + ((cp_ ^ ((row_ >> 1) & 7)) << 4))), (LAS unsigned*)(vb_ + i_ * 1024), 16, 0, 0); } } } while (0)
    ST_ISSUE(j_lo, 0);
    asm volatile("s_waitcnt vmcnt(0)" ::: "memory");
    __syncthreads();
    for (int j = j_lo; j < j_hi; ++j) {
        const int cur = (j - j_lo) & 1;
        if (j + 1 < j_hi) ST_ISSUE(j + 1, cur ^ 1);
        if (tile_act<MODE>(j, A)) attn_tile2<MODE>(lds + L_K + cur * KT_BYTES, lds + L_V + cur * VT_BYTES, lds, j, lane, q, o, m_run, l_run, A);
        asm volatile("s_waitcnt vmcnt(0)" ::: "memory");
        __syncthreads();
    }
#undef ST_ISSUE
}

template <int MODE>
DI void attn_pass3(LAS unsigned char* lds, const char* __restrict__ Kc, const char* __restrict__ Vc, int vt_stride, int j_lo, int j_hi,
                   const bf16x8 (&q)[12], f32x16 (&o)[4], float& m_run, float& l_run, const AttnLane& A) {
    if (j_lo >= j_hi) return;
    constexpr bool HASV = (MODE != MODE_CMP1);
    constexpr int L3_V = 3 * KT_BYTES;
    int tid = threadIdx.x; asm volatile("" : "+v"(tid));
    const int lane = tid & 63;
    const int wid_ = __builtin_amdgcn_readfirstlane(tid >> 6);
    const int T = j_hi - j_lo;
#define ST3_ISSUE(j, slot) do { int ln_ = lane; asm volatile("" : "+v"(ln_)); \
        const char* kp_ = Kc + (size_t)(j) * KT_BYTES; LAS unsigned char* kb_ = lds + (slot) * KT_BYTES + wid_ * 3072; \
        _Pragma("unroll") for (int i_ = 0; i_ < 3; ++i_) { const int pidx_ = (wid_ * 3 + i_) * 64 + ln_, row_ = pidx_ / 24, cp_ = pidx_ % 24; \
            __builtin_amdgcn_global_load_lds((const unsigned*)(kp_ + (unsigned)(row_ * 384 + ((cp_ ^ ((row_ >> 1) & 7)) << 4))), (LAS unsigned*)(kb_ + i_ * 1024), 16, 0, 0); } \
        if (HASV) { const char* vp_ = Vc + (size_t)(j) * 128; LAS unsigned char* vb_ = lds + L3_V + (slot) * VT_BYTES + wid_ * 2048; \
            _Pragma("unroll") for (int i_ = 0; i_ < 2; ++i_) { const int pidx_ = (wid_ * 2 + i_) * 64 + ln_, row_ = pidx_ >> 3, cp_ = pidx_ & 7; \
                __builtin_amdgcn_global_load_lds((const unsigned*)(vp_ + (unsigned)(row_ * vt_stride * 2 + ((cp_ ^ ((row_ >> 1) & 7)) << 4))), (LAS unsigned*)(vb_ + i_ * 1024), 16, 0, 0); } } } while (0)
    ST3_ISSUE(j_lo, 0);
    if (T > 1) ST3_ISSUE(j_lo + 1, 1);
    int slot = 0;
    for (int t = 0; t < T; ++t) {
        const int j = j_lo + t;
        if (t + 1 < T) { if (HASV) asm volatile("s_waitcnt vmcnt(5)" ::: "memory"); else asm volatile("s_waitcnt vmcnt(3)" ::: "memory"); }
        else asm volatile("s_waitcnt vmcnt(0)" ::: "memory");
        asm volatile("" ::: "memory"); __builtin_amdgcn_s_barrier(); asm volatile("" ::: "memory");
        if (t + 2 < T) { const int s2 = (slot >= 1) ? slot - 1 : 2; ST3_ISSUE(j + 2, s2); }
        if (tile_act<MODE>(j, A)) attn_tile2<MODE>(lds + slot * KT_BYTES, lds + L3_V + slot * VT_BYTES, lds, j, lane, q, o, m_run, l_run, A);
        slot = (slot == 2) ? 0 : slot + 1;
    }
    asm volatile("" ::: "memory"); __builtin_amdgcn_s_barrier(); asm volatile("" ::: "memory");
#undef ST3_ISSUE
}

DI int t5_bucket(int n) {
    if (n < 16) return n;
    return 16 + (n >= 19) + (n >= 21) + (n >= 24) + (n >= 27) + (n >= 31) + (n >= 35) + (n >= 40) + (n >= 46) + (n >= 52) + (n >= 59) + (n >= 67) + (n >= 77) + (n >= 87) + (n >= 99) + (n >= 113);
}
DI float silu_f(float z) { return z * __builtin_amdgcn_rcpf(1.0f + __builtin_amdgcn_exp2f(-1.4426950408889634f * z)); }

constexpr int EPI_PITCH = 272, EPI_WAVE_BYTES = 32 * EPI_PITCH;
template <bool RMW, bool NSA, int Q8>
DI void attn_epilogue_t(LAS unsigned char* lds, int lane, int wid, const f32x16 (&o)[4], float scale,
                        const char* __restrict__ zbase, unsigned z0, char* __restrict__ obase, unsigned o0) {
    LAS unsigned char* sc = lds + wid * EPI_WAVE_BYTES;
    const int r32 = lane & 31, hi = lane >> 5;
#pragma unroll
    for (int h = 0; h < 2; ++h) {
#pragma unroll
        for (int dd = 0; dd < 2; ++dd)
#pragma unroll
            for (int kq = 0; kq < 4; ++kq) {
                f32x4 v; v[0] = o[2 * h + dd][4 * kq + 0] * scale; v[1] = o[2 * h + dd][4 * kq + 1] * scale; v[2] = o[2 * h + dd][4 * kq + 2] * scale; v[3] = o[2 * h + dd][4 * kq + 3] * scale;
                *(LAS f32x4*)(sc + r32 * EPI_PITCH + (32 * dd + 8 * kq + 4 * hi) * 4) = v;
            }
        asm volatile("" ::: "memory");
#pragma unroll
        for (int i = 0; i < 4; ++i) {
            const int rr = 8 * i + (lane >> 3), c8 = lane & 7;
            const f32x4 a = *(const LAS f32x4*)(sc + rr * EPI_PITCH + c8 * 32);
            const f32x4 b = *(const LAS f32x4*)(sc + rr * EPI_PITCH + c8 * 32 + 16);
            unsigned zoff, ooff;
            if (NSA) { zoff = z0 + (unsigned)((rr >> 4) * (N1P * 2) + (rr & 15) * 256); ooff = o0 + (unsigned)((rr >> 4) * (ZW8 * 2) + (rr & 15) * 256); }
            else     { zoff = z0 + (unsigned)(rr * (N3P * 2)); ooff = o0 + (unsigned)(rr * (ZW8 * 2)); }
            const unsigned cb = (unsigned)((64 * h + 8 * c8) * 2);
            const u32x4 zw = *(const u32x4*)(zbase + (zoff + cb));
            float v0 = a[0] * silu_f(bflo(zw.x)), v1 = a[1] * silu_f(bfhi(zw.x)), v2 = a[2] * silu_f(bflo(zw.y)), v3 = a[3] * silu_f(bfhi(zw.y));
            float v4 = b[0] * silu_f(bflo(zw.z)), v5 = b[1] * silu_f(bfhi(zw.z)), v6 = b[2] * silu_f(bflo(zw.w)), v7 = b[3] * silu_f(bfhi(zw.w));
            if (RMW) { const u32x4 pw = *(const u32x4*)(obase + (ooff + cb));
                v0 += bflo(pw.x); v1 += bfhi(pw.x); v2 += bflo(pw.y); v3 += bfhi(pw.y); v4 += bflo(pw.z); v5 += bfhi(pw.z); v6 += bflo(pw.w); v7 += bfhi(pw.w); }
            if (Q8) { v0 = emu_q8(v0, 64.0f); v1 = emu_q8(v1, 64.0f); v2 = emu_q8(v2, 64.0f); v3 = emu_q8(v3, 64.0f); v4 = emu_q8(v4, 64.0f); v5 = emu_q8(v5, 64.0f); v6 = emu_q8(v6, 64.0f); v7 = emu_q8(v7, 64.0f); }
            u32x4 w; w.x = pk2(v0, v1); w.y = pk2(v2, v3); w.z = pk2(v4, v5); w.w = pk2(v6, v7);
            *(u32x4*)(obase + (ooff + cb)) = w;
        }
        asm volatile("" ::: "memory");
    }
}

DI void phase_nsa_attn(LAS unsigned char* lds, const Params& P, int bid, int nb) {
    const char* Y0c = (const char*)(P.ws + OFF_Y0);
    const char* KSc = (const char*)(P.ws + OFF_KS); const char* KWc = (const char*)(P.ws + OFF_KW);
    const char* VTSc = (const char*)(P.ws + OFF_VTS); const char* VTWc = (const char*)(P.ws + OFF_VTW);
    const char* KCc = (const char*)(P.ws + OFF_KC); const char* VTCc = (const char*)(P.ws + OFF_VTC);
    char* ONc = (char*)(P.ws + OFF_O);
    LAS float* lut = (LAS float*)(lds + L_LUT);
    const int total = BATCH * NG * 256;
    {
        const int tid0 = tid_opaque();
        __syncthreads();
        for (int i = tid0; i < 64 * 128; i += 512) { const int hd = i >> 7, d = i & 127; lut[hd * LUT_PITCH + d] = (P.rel_bias[t5_bucket(d) * NH + hd] - P.rel_bias[31 * NH + hd]) * LOG2E; }
        __syncthreads();
    }
    for (int u = bid; u < total; u += nb) {
        int tid = threadIdx.x; asm volatile("" : "+v"(tid));
        const int lane = tid & 63, wid = __builtin_amdgcn_readfirstlane(tid >> 6);
        const int pair = u >> 8; int c = u & 255; if (pair & 1) c = 255 - c;
        const int b = pair >> 2, g = pair & 3, t0 = c * 16;
        __syncthreads();
        AttnLane A;
                const int r = lane & 15;
        A.tk = (lane >> 4) & 1;
        A.tw0 = t0 + 2 * wid; A.tw1 = A.tw0 + 1; A.tq = A.tw0 + A.tk;
        A.lutrow = lut + (g * NR + r) * LUT_PITCH; A.lut_far = A.lutrow[127];
        A.curblk = t0 >> 6; A.tokidx = 2 * wid + A.tk; A.mk0 = 0ull; A.mk1 = 0ull; A.inv_l = 0.f;
        const int hh = g * NR + r;
        const unsigned yoff = (unsigned)(b * SEQ + A.tq) * (unsigned)(N1P * 2);
        const unsigned ytok0 = (unsigned)(b * SEQ + A.tw0) * (unsigned)(N1P * 2);
        const unsigned otok0 = ((unsigned)(b * SEQ + A.tw0) * (unsigned)ZW8 + (unsigned)(g * NR * DV)) * 2u;
        bf16x8 q[12];
                {
            const unsigned qo = yoff + (unsigned)((C_Q + hh * DK + 8 * (lane >> 5)) * 2);
            float ss = 0.f;
#pragma unroll
            for (int d0 = 0; d0 < 12; ++d0) { q[d0] = *(const bf16x8*)(Y0c + (qo + 32u * d0));
                const u32x4 w = __builtin_bit_cast(u32x4, q[d0]);
                const float a0 = bflo(w.x), a1 = bfhi(w.x), a2 = bflo(w.y), a3 = bfhi(w.y), a4 = bflo(w.z), a5 = bfhi(w.z), a6 = bflo(w.w), a7 = bfhi(w.w);
                ss += (a0 * a0 + a1 * a1) + (a2 * a2 + a3 * a3) + (a4 * a4 + a5 * a5) + (a6 * a6 + a7 * a7); }
            ss += __shfl_xor(ss, 32);
            const float rstd = rsqrtf(ss * (1.0f / DK) + EPSN) * QSCALE;
#pragma unroll
            for (int d0 = 0; d0 < 12; ++d0) { const float* gn = P.nsa_q_norm + 16 * d0 + 8 * (lane >> 5); const f32x4 g0 = *(const f32x4*)gn, g1 = *(const f32x4*)(gn + 4);
                u32x4 w = __builtin_bit_cast(u32x4, q[d0]);
                w.x = pk2(bflo(w.x) * rstd * g0[0], bfhi(w.x) * rstd * g0[1]); w.y = pk2(bflo(w.y) * rstd * g0[2], bfhi(w.y) * rstd * g0[3]);
                w.z = pk2(bflo(w.z) * rstd * g1[0], bfhi(w.z) * rstd * g1[1]); w.w = pk2(bflo(w.w) * rstd * g1[2], bfhi(w.w) * rstd * g1[3]);
                q[d0] = __builtin_bit_cast(bf16x8, w); }
        }
        const int bg = b * NG + g;
        f32x16 o[4]; float m_run, l_run;
#define RESET_STATE() do { _Pragma("unroll") for (int d_ = 0; d_ < 4; ++d_) _Pragma("unroll") for (int r_ = 0; r_ < 16; ++r_) o[d_][r_] = 0.f; m_run = 0.f; l_run = 0.f; } while (0)
        const int nct = (t0 + 15 >= 31) ? (((t0 + 15 - 31) >> 4) / 64 + 1) : 0;
        RESET_STATE();
        A.carry = 0.f;
        if (!NO_CMP1) attn_pass2<MODE_CMPX>(lds, KCc + (size_t)bg * 256 * DK * 2, VTCc + (size_t)bg * DV * 256 * 2, 256, 0, nct, q, o, m_run, l_run, A);
        { const float lt = l_run + __shfl_xor(l_run, 32); const float il = lt > 0.f ? 1.0f / lt : 0.f;
          if (lane < 32) ((LAS float*)(lds + L_IL))[A.tokidx * 16 + r] = il;
          const float gv = bf1(*(const bf16_t*)(Y0c + (yoff + (unsigned)((C_G + 0 * NH + hh) * 2)))); const float sg = 1.0f / (1.0f + __expf(-gv));
          for (int prb_ = 0; prb_ < PROBE_EPI; ++prb_) { asm volatile("" ::: "memory"); attn_epilogue_t<false, true, 0>(lds, lane, wid, o, sg * il, Y0c, ytok0 + (unsigned)((C_ZC + g * NR * DV) * 2), ONc, otok0); } }
        __syncthreads();
        for (int prb_ = 0; prb_ < PROBE_TOPK; ++prb_) { asm volatile("" ::: "memory");
            const int cur = A.curblk;
            unsigned long long mk[2];
#pragma unroll
            for (int t = 0; t < 2; ++t) {
                const LAS bf16_t* X = (const LAS bf16_t*)(lds + L_X) + (2 * wid + t) * 16 * 64;
                const LAS float* IL = (const LAS float*)(lds + L_IL) + (2 * wid + t) * 16;
                const bool forced = (lane == 0) || (lane == cur) || (lane == cur - 1);
                const bool future = lane > cur;
                float v = 0.f;
                if (!forced && !future) {
#pragma unroll
                    for (int rr = 0; rr < 16; ++rr) v += IL[rr] * bf1(X[rr * 64 + lane]); }
                unsigned key = (__float_as_uint(v) & ~63u);
                if (forced) key = 0x7f800000u; else if (future) key = 0u;
                key |= (unsigned)(63 - lane);
                int rank = 0;
#pragma unroll
                for (int jp = 0; jp < 64; ++jp) { const unsigned kj = (unsigned)__builtin_amdgcn_readlane((int)key, jp); rank += (kj > key) ? 1 : 0; }
                mk[t] = __ballot(rank < 16 && !future);
            }
            A.mk0 = mk[0]; A.mk1 = mk[1];
        }
        RESET_STATE();
#if PROBE_SEL2
        attn_pass2<MODE_SEL>(lds, KSc + (size_t)bg * SEQ * DK * 2, VTSc + (size_t)bg * DV * SEQ * 2, SEQ, 0, A.curblk + 1, q, o, m_run, l_run, A);
#endif
        if (!NO_SEL) attn_pass2<MODE_SEL>(lds, KSc + (size_t)bg * SEQ * DK * 2, VTSc + (size_t)bg * DV * SEQ * 2, SEQ, 0, A.curblk + 1, q, o, m_run, l_run, A);
        { const float lt = l_run + __shfl_xor(l_run, 32); const float gv = bf1(*(const bf16_t*)(Y0c + (yoff + (unsigned)((C_G + 1 * NH + hh) * 2)))); const float sg = 1.0f / (1.0f + __expf(-gv));
          attn_epilogue_t<true, true, 0>(lds, lane, wid, o, sg / lt, Y0c, ytok0 + (unsigned)((C_ZS + g * NR * DV) * 2), ONc, otok0); }
        __syncthreads();
        RESET_STATE();
        { const int jl = (t0 - 511) > 0 ? (t0 - 511) >> 6 : 0, jh = ((t0 + 15) >> 6) + 1;
#if PROBE_WIN2
          attn_pass2<MODE_WIN>(lds, KWc + (size_t)bg * SEQ * DK * 2, VTWc + (size_t)bg * DV * SEQ * 2, SEQ, jl, jh, q, o, m_run, l_run, A);
#endif
          if (!NO_WIN) attn_pass2<MODE_WIN>(lds, KWc + (size_t)bg * SEQ * DK * 2, VTWc + (size_t)bg * DV * SEQ * 2, SEQ, jl, jh, q, o, m_run, l_run, A); }
        { const float lt = l_run + __shfl_xor(l_run, 32); const float gv = bf1(*(const bf16_t*)(Y0c + (yoff + (unsigned)((C_G + 2 * NH + hh) * 2)))); const float sg = 1.0f / (1.0f + __expf(-gv));
          attn_epilogue_t<true, true, (FP8EMU & 1)>(lds, lane, wid, o, sg / lt, Y0c, ytok0 + (unsigned)((C_ZW + g * NR * DV) * 2), ONc, otok0); }
#undef RESET_STATE
    }
}

DI void phase_mla_attn(LAS unsigned char* lds, const Params& P, int bid, int nb) {
    const char* QMc = (const char*)(P.ws + OFF_QM); const char* KMc = (const char*)(P.ws + OFF_KM); const char* VTMc = (const char*)(P.ws + OFF_VTM);
    const char* Y1c = (const char*)(P.ws + OFF_Y1); char* OMc = (char*)(P.ws + OFF_O);
    const int total = BATCH * NH * 16;
    for (int uu = 0; bid + (uu >> 1) * nb < total / 2; ++uu) {
        int tid = threadIdx.x; asm volatile("" : "+v"(tid));
        const int lane = tid & 63, wid = __builtin_amdgcn_readfirstlane(tid >> 6);
        const int item = bid + (uu >> 1) * nb, second = uu & 1;
        const int xcd = item & 7, tt = item >> 3, p = tt & 7, hl = (tt >> 3) & 3, rnd = tt >> 5;
        const int bh = rnd * 32 + xcd * 4 + hl, qb = second ? p : 15 - p, b = bh >> 6, h = bh & 63, t0 = qb * 256;
        AttnLane A;
        A.tk = 0;
        A.tw0 = t0 + 32 * wid; A.tw1 = A.tw0 + 31; A.tq = A.tw0 + (lane & 31);
        A.lutrow = nullptr; A.lut_far = 0.f; A.curblk = 0; A.tokidx = 0; A.mk0 = 0ull; A.mk1 = 0ull; A.inv_l = 0.f;         const unsigned trow = (unsigned)(b * SEQ + A.tq);
        bf16x8 q[12];
        {
            const unsigned qo = (trow * (unsigned)NQB + (unsigned)(h * DK + 8 * (lane >> 5))) * 2u;
            float ss = 0.f;
#pragma unroll
            for (int d0 = 0; d0 < 12; ++d0) { q[d0] = *(const bf16x8*)(QMc + (qo + 32u * d0));
                const u32x4 w = __builtin_bit_cast(u32x4, q[d0]);
                const float a0 = bflo(w.x), a1 = bfhi(w.x), a2 = bflo(w.y), a3 = bfhi(w.y), a4 = bflo(w.z), a5 = bfhi(w.z), a6 = bflo(w.w), a7 = bfhi(w.w);
                ss += (a0 * a0 + a1 * a1) + (a2 * a2 + a3 * a3) + (a4 * a4 + a5 * a5) + (a6 * a6 + a7 * a7); }
            ss += __shfl_xor(ss, 32);
            const float rstd = rsqrtf(ss * (1.0f / DK) + EPSN);
            const float* ropep = (const float*)(P.ws + OFF_ROPE) + (size_t)trow * 64;
#pragma unroll
            for (int d0 = 0; d0 < 8; ++d0) { const float* gn = P.mla_q_norm + 16 * d0 + 8 * (lane >> 5); const f32x4 g0 = *(const f32x4*)gn, g1 = *(const f32x4*)(gn + 4);
                const float sc = rstd * QSCALE;
                u32x4 w = __builtin_bit_cast(u32x4, q[d0]);
                w.x = pk2(bflo(w.x) * sc * g0[0], bfhi(w.x) * sc * g0[1]); w.y = pk2(bflo(w.y) * sc * g0[2], bfhi(w.y) * sc * g0[3]);
                w.z = pk2(bflo(w.z) * sc * g1[0], bfhi(w.z) * sc * g1[1]); w.w = pk2(bflo(w.w) * sc * g1[2], bfhi(w.w) * sc * g1[3]);
                q[d0] = __builtin_bit_cast(bf16x8, w); }
#pragma unroll
            for (int pr = 0; pr < 2; ++pr) {
                const int i0 = 16 * pr + 8 * (lane >> 5);
                const float* g1p = P.mla_q_norm + 128 + i0; const float* g2p = P.mla_q_norm + 160 + i0;
                const u32x4 w1 = __builtin_bit_cast(u32x4, q[8 + pr]), w2 = __builtin_bit_cast(u32x4, q[10 + pr]);
                float x1[8] = {bflo(w1.x), bfhi(w1.x), bflo(w1.y), bfhi(w1.y), bflo(w1.z), bfhi(w1.z), bflo(w1.w), bfhi(w1.w)};
                float x2[8] = {bflo(w2.x), bfhi(w2.x), bflo(w2.y), bfhi(w2.y), bflo(w2.z), bfhi(w2.z), bflo(w2.w), bfhi(w2.w)};
                float y1[8], y2[8];
#pragma unroll
                for (int e = 0; e < 8; ++e) { const float cs = ropep[i0 + e], sn = ropep[32 + i0 + e];
                    const float a = x1[e] * rstd * g1p[e], c = x2[e] * rstd * g2p[e];
                    y1[e] = (a * cs - c * sn) * QSCALE; y2[e] = (c * cs + a * sn) * QSCALE; }
                u32x4 o1, o2;
                o1.x = pk2(y1[0], y1[1]); o1.y = pk2(y1[2], y1[3]); o1.z = pk2(y1[4], y1[5]); o1.w = pk2(y1[6], y1[7]);
                o2.x = pk2(y2[0], y2[1]); o2.y = pk2(y2[2], y2[3]); o2.z = pk2(y2[4], y2[5]); o2.w = pk2(y2[6], y2[7]);
                q[8 + pr] = __builtin_bit_cast(bf16x8, o1); q[10 + pr] = __builtin_bit_cast(bf16x8, o2);
            }
        }
        f32x16 o[4]; float m_run = 0.f, l_run = 0.f;
#pragma unroll
        for (int d = 0; d < 4; ++d)
#pragma unroll
            for (int r = 0; r < 16; ++r) o[d][r] = 0.f;
        attn_pass2<MODE_MLA>(lds, KMc + (size_t)bh * SEQ * DK * 2, VTMc + (size_t)bh * DV * SEQ * 2, SEQ, 0, 4 * qb + 4, q, o, m_run, l_run, A);
        const float lt = l_run + __shfl_xor(l_run, 32);
        { const unsigned t0w = (unsigned)(b * SEQ + A.tw0);
          attn_epilogue_t<false, false, (FP8EMU & 2) ? 1 : 0>(lds, lane, wid, o, 1.0f / lt, Y1c, (t0w * (unsigned)N3P + (unsigned)(C3_Z + h * DV)) * 2u, OMc, (t0w * (unsigned)ZW8 + (unsigned)(h * DV)) * 2u); }
        __syncthreads();
    }
}
constexpr int LDS_KN_OFF = 135168, LDS_ST_OFF = LDS_KN_OFF + 16384, LDS_BYTES = LDS_ST_OFF + 16;
constexpr int NPHASE = 14;

template <int PH>
DI void run_phase(const Params& P, LAS unsigned char* lds, int bid, int nb) {
    unsigned char* ws = P.ws;
    if constexpr (PH == 0) {
        phase_wconv(lds, P.nsa_w_in, (bf16_t*)(ws + OFF_W1T), DM, N1, N1P, bid, nb, (FP8EMU & 4) ? 64.0f : 0.f);
        phase_wconv(lds, P.w1_k, (bf16_t*)(ws + OFF_W1K), 6144, 192, 256, bid, nb);
        phase_wconv(lds, P.w1_v, (bf16_t*)(ws + OFF_W1V), 4096, 128, 256, bid, nb);
        phase_rmsnorm(P.x, P.norm_w, (bf16_t*)(ws + OFF_H), bid, nb, (FP8EMU & 4) ? 16.0f : 0.f);
    } else if constexpr (PH == 1) {
        pg8::Gemm g{(const bf16_t*)(ws + OFF_H), (const bf16_t*)(ws + OFF_W1T), MTOK, N1P, DM};
        pg8::StaticOrder S; S.init(g.M, g.N, nb, bid);
        pg8::EpiStoreBf16 E{(bf16_t*)(ws + OFF_Y0), N1P};
        pg8::gemm_phase<pg8::EpiStoreBf16, pg8::StaticOrder, false>(lds, g, S, E, nullptr);
    } else if constexpr (PH == 2) {
        phase_nsa_prep(P, bid, nb);
        phase_vt(lds, (const bf16_t*)(ws + OFF_Y0), N1P, C_KVS + NG * DK, DV, NG, (bf16_t*)(ws + OFF_VTS), bid, nb);
        phase_vt(lds, (const bf16_t*)(ws + OFF_Y0), N1P, C_KVW + NG * DK, DV, NG, (bf16_t*)(ws + OFF_VTW), bid, nb);
    } else if constexpr (PH == 3) {
        if (bid < 16) {
            pg8::Gemm g{(const bf16_t*)(ws + OFF_ACK), (const bf16_t*)(ws + OFF_W1K), 4096, 256, 6144};
            pg8::StaticOrder S; S.init(g.M, g.N, 16, bid);
            pg8::EpiPlainF32 E{(float*)(ws + OFF_HIDK), 256};
            pg8::gemm_phase<pg8::EpiPlainF32, pg8::StaticOrder, false>(lds, g, S, E, nullptr);
        } else if (bid < 32) {
            pg8::Gemm g{(const bf16_t*)(ws + OFF_ACV), (const bf16_t*)(ws + OFF_W1V), 4096, 256, 4096};
            pg8::StaticOrder S; S.init(g.M, g.N, 16, bid - 16);
            pg8::EpiPlainF32 E{(float*)(ws + OFF_HIDV), 256};
            pg8::gemm_phase<pg8::EpiPlainF32, pg8::StaticOrder, false>(lds, g, S, E, nullptr);
        } else {
            phase_wconv(lds, P.nsa_w_out, (bf16_t*)(ws + OFF_W2T), ZW8, DM, DM, bid - 32, nb - 32, (FP8EMU & 1) ? 64.0f : 0.f);
            phase_wconv(lds, P.mla_w_in, (bf16_t*)(ws + OFF_W3T), DM, N3, N3P, bid - 32, nb - 32, (FP8EMU & 8) ? 64.0f : 0.f);
        }
    } else if constexpr (PH == 4) {
        phase_cmp2(lds, P, bid, nb);
    } else if constexpr (PH == 5) {
        { float* ss1 = (float*)(ws + OFF_SS1); for (int i = bid * 512 + (int)threadIdx.x; i < MTOK; i += nb * 512) ss1[i] = 0.f; }
        phase_nsa_attn(lds, P, bid, nb);
    } else if constexpr (PH == 6) {
        pg8::Gemm g{(const bf16_t*)(ws + OFF_O), (const bf16_t*)(ws + OFF_W2T), MTOK, DM, ZW8};
        pg8::StaticOrder S; S.init(g.M, g.N, nb, bid);
        pg8::EpiResNorm E{P.x, P.out, DM, P.norm_w + DM, (bf16_t*)(ws + OFF_H), (float*)(ws + OFF_SS1)};
        pg8::gemm_phase<pg8::EpiResNorm, pg8::StaticOrder, false>(lds, g, S, E, nullptr);
    } else if constexpr (PH == 7) {
        phase_rmsnorm(P.out, P.norm_w + DM, (bf16_t*)(ws + OFF_H), bid, nb, (FP8EMU & 8) ? 16.0f : 0.f);
    } else if constexpr (PH == 8) {
        pg8::Gemm g{(const bf16_t*)(ws + OFF_H), (const bf16_t*)(ws + OFF_W3T), MTOK, N3P, DM};
        pg8::StaticOrder S; S.init(g.M, g.N, nb, bid);
        pg8::EpiStoreBf16RowScale E{(bf16_t*)(ws + OFF_Y1), N3P, (const float*)(ws + OFF_SS1), 1.0f / DM};
        pg8::gemm_phase<pg8::EpiStoreBf16RowScale, pg8::StaticOrder, false>(lds, g, S, E, nullptr);
        __syncthreads();
        if (bid >= 64 && nb > 64) {
            phase_wconv(lds, P.mla_w_q_b, (bf16_t*)(ws + OFF_W4T), QLORA, NQB, NQB, bid - 64, nb - 64);
            phase_wconv(lds, P.mla_w_kv_b, (bf16_t*)(ws + OFF_W5K), KVLORA, NKVB / 2, NKVB / 2, bid - 64, nb - 64, 0.f, 2);
            phase_wconv(lds, P.mla_w_kv_b, (bf16_t*)(ws + OFF_W5V), KVLORA, NKVB / 2, NKVB / 2, bid - 64, nb - 64, 0.f, 1);
            phase_wconv(lds, P.mla_w_out, (bf16_t*)(ws + OFF_W6T), ZW8, DM, DM, bid - 64, nb - 64, (FP8EMU & 2) ? 64.0f : 0.f);
        } else if (nb <= 64) {
            phase_wconv(lds, P.mla_w_q_b, (bf16_t*)(ws + OFF_W4T), QLORA, NQB, NQB, bid, nb);
            phase_wconv(lds, P.mla_w_kv_b, (bf16_t*)(ws + OFF_W5K), KVLORA, NKVB / 2, NKVB / 2, bid, nb, 0.f, 2);
            phase_wconv(lds, P.mla_w_kv_b, (bf16_t*)(ws + OFF_W5V), KVLORA, NKVB / 2, NKVB / 2, bid, nb, 0.f, 1);
            phase_wconv(lds, P.mla_w_out, (bf16_t*)(ws + OFF_W6T), ZW8, DM, DM, bid, nb, (FP8EMU & 2) ? 64.0f : 0.f);
        }
    } else if constexpr (PH == 9) {
        phase_mla_prep1(P, bid, nb);
    } else if constexpr (PH == 10) {
        {
            pg8::Gemm g{(const bf16_t*)(ws + OFF_CQN), (const bf16_t*)(ws + OFF_W4T), MTOK, NQB, QLORA};
            pg8::StaticOrder S; S.init(g.M, g.N, nb, bid);
            pg8::EpiStoreBf16 E{(bf16_t*)(ws + OFF_QM), NQB};
            pg8::gemm_phase<pg8::EpiStoreBf16, pg8::StaticOrder, false>(lds, g, S, E, nullptr);
        }
        __syncthreads();
        {
            pg8::Gemm g{(const bf16_t*)(ws + OFF_CKVN), (const bf16_t*)(ws + OFF_W5K), MTOK, NKVB / 2, KVLORA};
            pg8::StaticOrder S; S.init(g.M, g.N, nb, bid);
            pg8::EpiKNorm E{(bf16_t*)(ws + OFF_KM), (const float*)(ws + OFF_SSPE), (const float*)(ws + OFF_KPER), P.mla_k_norm, (LAS float*)(lds + LDS_KN_OFF), 0u};
            pg8::gemm_phase<pg8::EpiKNorm, pg8::StaticOrder, false>(lds, g, S, E, nullptr);
        }
        __syncthreads();
        {
            pg8::Gemm g{(const bf16_t*)(ws + OFF_W5V), (const bf16_t*)(ws + OFF_CKVN), NKVB / 2, MTOK, KVLORA};
            pg8::StaticOrder S; S.init(g.M, g.N, nb, bid);
            pg8::EpiVT E{(bf16_t*)(ws + OFF_VTM)};
            pg8::gemm_phase<pg8::EpiVT, pg8::StaticOrder, false>(lds, g, S, E, nullptr);
        }
    } else if constexpr (PH == 11) {
    } else if constexpr (PH == 12) {
        phase_mla_attn(lds, P, bid, nb);
    } else if constexpr (PH == 13) {
        pg8::Gemm g{(const bf16_t*)(ws + OFF_O), (const bf16_t*)(ws + OFF_W6T), MTOK, DM, ZW8};
        pg8::StaticOrder S; S.init(g.M, g.N, nb, bid);
        pg8::EpiResF32 E{P.out, P.out, DM};
        pg8::gemm_phase<pg8::EpiResF32, pg8::StaticOrder, false>(lds, g, S, E, nullptr);
    }
}

#ifndef REP0
#define REP0 1
#endif
#ifndef REP1
#define REP1 1
#endif
#ifndef REP2
#define REP2 1
#endif
#ifndef REP3
#define REP3 1
#endif
#ifndef REP4
#define REP4 1
#endif
#ifndef REP5
#define REP5 1
#endif
#ifndef REP6
#define REP6 1
#endif
#ifndef REP7
#define REP7 1
#endif
#ifndef REP8
#define REP8 1
#endif
#ifndef REP9
#define REP9 1
#endif
#ifndef REP10
#define REP10 1
#endif
#ifndef REP11
#define REP11 1
#endif
#ifndef REP12
#define REP12 1
#endif
#ifndef REP13
#define REP13 1
#endif

__global__ __launch_bounds__(512, 2) void k_mega(Params P) {
    extern __shared__ __attribute__((aligned(16))) unsigned char shm[];
    LAS unsigned char* lds = (LAS unsigned char*)shm;
    volatile LAS unsigned* st = (volatile LAS unsigned*)(lds + LDS_ST_OFF);
    if (threadIdx.x == 0) { st[0] = 0u; st[1] = 0u; st[2] = 0u; st[3] = 0u; }
    __syncthreads();
    XcdBarrier bar = xcd_barrier_post((unsigned*)(P.ws + OFF_CTL), st);
    const int bid = (int)blockIdx.x, nb = (int)gridDim.x;
    for (int rep_ = 0; rep_ < REP0; ++rep_) run_phase<0>(P, lds, bid, nb);  xcd_barrier(bar);
    for (int rep_ = 0; rep_ < REP1; ++rep_) run_phase<1>(P, lds, bid, nb);  xcd_barrier(bar);
    for (int rep_ = 0; rep_ < REP2; ++rep_) run_phase<2>(P, lds, bid, nb);  xcd_barrier(bar);
    for (int rep_ = 0; rep_ < REP3; ++rep_) run_phase<3>(P, lds, bid, nb);  xcd_barrier(bar);
    for (int rep_ = 0; rep_ < REP4; ++rep_) run_phase<4>(P, lds, bid, nb);  xcd_barrier(bar);
    for (int rep_ = 0; rep_ < REP5; ++rep_) run_phase<5>(P, lds, bid, nb);  xcd_barrier(bar);
    for (int rep_ = 0; rep_ < REP6; ++rep_) run_phase<6>(P, lds, bid, nb);  xcd_barrier(bar);
    for (int rep_ = 0; rep_ < REP8; ++rep_) run_phase<8>(P, lds, bid, nb);  xcd_barrier(bar);
    for (int rep_ = 0; rep_ < REP9; ++rep_) run_phase<9>(P, lds, bid, nb);  xcd_barrier(bar);
    for (int rep_ = 0; rep_ < REP10; ++rep_) run_phase<10>(P, lds, bid, nb); xcd_barrier(bar);
    for (int rep_ = 0; rep_ < REP12; ++rep_) run_phase<12>(P, lds, bid, nb); xcd_barrier(bar);
    for (int rep_ = 0; rep_ < REP13; ++rep_) run_phase<13>(P, lds, bid, nb);
}

extern "C" void kernel_launch(void* const* d_in, const int* in_sizes, int n_in, void* d_out, int out_size, void* d_ws, size_t ws_size, hipStream_t stream) {
    (void)in_sizes; (void)n_in; (void)out_size;
    if (ws_size < WS_END) return;
    Params P{};
    P.x = (const float*)d_in[0]; P.pos = (const int*)d_in[1]; P.norm_w = (const float*)d_in[2]; P.rel_bias = (const float*)d_in[3];
    P.nsa_w_in = (const float*)d_in[4]; P.nsa_q_norm = (const float*)d_in[5]; P.nsa_k_norm = (const float*)d_in[6]; P.pe_k = (const float*)d_in[7];
    P.w1_k = (const float*)d_in[8]; P.w2_k = (const float*)d_in[9]; P.pe_v = (const float*)d_in[10]; P.w1_v = (const float*)d_in[11]; P.w2_v = (const float*)d_in[12];
    P.nsa_w_out = (const float*)d_in[13]; P.mla_w_in = (const float*)d_in[14]; P.mla_q_a_norm = (const float*)d_in[15]; P.mla_w_q_b = (const float*)d_in[16];
    P.mla_kv_a_norm = (const float*)d_in[17]; P.mla_w_kv_b = (const float*)d_in[18]; P.mla_q_norm = (const float*)d_in[19]; P.mla_k_norm = (const float*)d_in[20];
    P.mla_w_out = (const float*)d_in[21];
    P.out = (float*)d_out; P.ws = (unsigned char*)d_ws;
    static int grid = 0;
    if (!grid) {
        int dev = 0, cus = 0, per_cu = 0; (void)hipGetDevice(&dev);
        if (hipDeviceGetAttribute(&cus, hipDeviceAttributeMultiprocessorCount, dev) != hipSuccess || cus <= 0) cus = 256;
        (void)hipFuncSetAttribute((const void*)k_mega, hipFuncAttributeMaxDynamicSharedMemorySize, LDS_BYTES);
        if (hipOccupancyMaxActiveBlocksPerMultiprocessor(&per_cu, k_mega, 512, LDS_BYTES) != hipSuccess || per_cu < 1) per_cu = 1;
        grid = cus;
    }
    (void)hipMemsetAsync((unsigned char*)d_ws + OFF_CTL, 0, XCD_BAR_WORDS * sizeof(unsigned), stream);
    hipLaunchKernelGGL(k_mega, dim3(grid), dim3(512), LDS_BYTES, stream, P);
}
```

```cpp
#include <hip/hip_runtime.h>
#include <stdint.h>
#include <stddef.h>

#define DI __device__ __forceinline__
#define LAS __attribute__((address_space(3)))
typedef unsigned short bf16_t;
typedef short bf16x8 __attribute__((ext_vector_type(8)));
typedef float f32x4 __attribute__((ext_vector_type(4)));
typedef float f32x16 __attribute__((ext_vector_type(16)));
typedef unsigned u32x4 __attribute__((ext_vector_type(4)));
typedef unsigned u32x2 __attribute__((ext_vector_type(2)));
typedef __bf16 bf2_t __attribute__((ext_vector_type(2)));
typedef float f2_t __attribute__((ext_vector_type(2)));

DI int tid_opaque() { int t = (int)threadIdx.x; asm volatile("" : "+v"(t)); return t; }
DI unsigned pk2(float a, float b) { f2_t f = {a, b}; bf2_t v = __builtin_convertvector(f, bf2_t); return __builtin_bit_cast(unsigned, v); }
DI float bflo(unsigned w) { return __uint_as_float(w << 16); }
DI float bfhi(unsigned w) { return __uint_as_float(w & 0xffff0000u); }
#ifndef FP8EMU
#define FP8EMU 0
#endif
DI float emu_q8(float x, float s) { float y = x * s; const float ay = fabsf(y);
    if (ay < 0.015625f) y = rintf(y * 512.0f) * (1.0f / 512.0f);
    else { unsigned u = __float_as_uint(y); u = (u + 0x0007FFFFu + ((u >> 20) & 1u)) & 0xFFF00000u; y = __uint_as_float(u); }
    y = fminf(fmaxf(y, -448.0f), 448.0f); return y / s; }
DI float bf1(bf16_t h) { return __uint_as_float(((unsigned)h) << 16); }

constexpr int BATCH = 4, SEQ = 4096, DM = 4096, MTOK = BATCH * SEQ;
constexpr int NH = 64, NG = 4, NR = 16, DK = 192, DV = 128;
constexpr int N1 = 40896, N1P = 40960;
constexpr int C_Q = 0, C_KVC = 12288, C_KVS = 13568, C_KVW = 14848, C_ZC = 16128, C_ZS = 24320, C_ZW = 32512, C_G = 40704;
constexpr int N3 = 10304, N3P = 10496;
constexpr int C3_CQ = 0, C3_CKV = 1536, C3_KPE = 2048, C3_Z = 2112;
constexpr int QLORA = 1536, KVLORA = 512;
constexpr int NQB = 12288, NKVB = 16384, ZW8 = 8192;
constexpr float EPSN = 1e-6f;
constexpr float LOG2E = 1.4426950408889634f;
constexpr float QSCALE = 0.07216878364870322f * 1.4426950408889634f;

constexpr size_t SZ_W1T = (size_t)N1P * DM * 2, SZ_W2T = (size_t)DM * ZW8 * 2, SZ_W3T = (size_t)N3P * DM * 2, SZ_W4T = (size_t)NQB * QLORA * 2,
                 SZ_W5T = (size_t)NKVB * KVLORA * 2, SZ_W6T = (size_t)DM * ZW8 * 2;
constexpr size_t OFF_W1T = 0, OFF_W2T = OFF_W1T + SZ_W1T, OFF_W3T = OFF_W2T + SZ_W2T, OFF_W4T = OFF_W3T + SZ_W3T, OFF_W5T = OFF_W4T + SZ_W4T,
                 OFF_W6T = OFF_W5T + SZ_W5T, OFF_W1K = OFF_W6T + SZ_W6T;
constexpr size_t OFF_W5K = OFF_W5T, OFF_W5V = OFF_W5T + SZ_W5T / 2;
constexpr size_t SZ_W1K = (size_t)256 * 6144 * 2, SZ_W1V = (size_t)256 * 4096 * 2;
constexpr size_t OFF_W1V = OFF_W1K + SZ_W1K, OFF_CTL = OFF_W1V + SZ_W1V, OFF_H = OFF_CTL + 65536;
constexpr size_t SZ_H = (size_t)MTOK * DM * 2, SZ_KS = (size_t)BATCH * NG * SEQ * DK * 2, SZ_VTS = (size_t)BATCH * NG * DV * SEQ * 2,
                 SZ_ACK = (size_t)4096 * 6144 * 2, SZ_ACV = (size_t)4096 * 4096 * 2;
constexpr size_t OFF_KS = OFF_H + SZ_H, OFF_KW = OFF_KS + SZ_KS, OFF_VTS = OFF_KW + SZ_KS, OFF_VTW = OFF_VTS + SZ_VTS, OFF_ACK = OFF_VTW + SZ_VTS,
                 OFF_ACV = OFF_ACK + SZ_ACK, OFF_KC = OFF_ACV + SZ_ACV;
constexpr size_t SZ_KC = (size_t)16 * 256 * DK * 2, SZ_VTC = (size_t)16 * DV * 256 * 2, SZ_HID = (size_t)4096 * 256 * 4;
constexpr size_t OFF_VTC = OFF_KC + SZ_KC, OFF_HIDK = OFF_VTC + SZ_VTC, OFF_HIDV = OFF_HIDK + SZ_HID, OFF_Y0 = OFF_HIDV + SZ_HID;
constexpr size_t SZ_Y0 = (size_t)MTOK * N1P * 2, SZ_O = (size_t)MTOK * ZW8 * 2;
constexpr size_t OFF_O = OFF_Y0 + SZ_Y0, WS_END = OFF_O + SZ_O;
constexpr size_t OFF_SS1 = OFF_HIDK;
constexpr size_t OFF_KM = 0;
constexpr size_t SZ_KM = (size_t)BATCH * NH * SEQ * DK * 2;
static_assert(SZ_KM <= SZ_W1T + SZ_W2T, "KM alias");
constexpr size_t OFF_VTM = OFF_H;
constexpr size_t SZ_VTM = (size_t)BATCH * NH * DV * SEQ * 2;
constexpr size_t OFF_CKVN = OFF_VTM + SZ_VTM;
constexpr size_t SZ_CKVN = (size_t)MTOK * KVLORA * 2;
static_assert(OFF_CKVN + SZ_CKVN <= OFF_KC, "CKVN alias");
constexpr size_t OFF_Y1 = OFF_Y0, SZ_Y1 = (size_t)MTOK * N3P * 2;
constexpr size_t OFF_QM = OFF_Y1 + SZ_Y1, SZ_QM = (size_t)MTOK * NQB * 2;
constexpr size_t OFF_KVM = OFF_QM + SZ_QM, SZ_KVM = (size_t)MTOK * NKVB * 2;
constexpr size_t OFF_KNM = OFF_KVM;
constexpr size_t OFF_KPER = OFF_KVM, OFF_SSPE = OFF_KVM + (size_t)MTOK * 64 * 4;
constexpr size_t OFF_CQN = OFF_KVM + SZ_KVM, SZ_CQN = (size_t)MTOK * QLORA * 2;
constexpr size_t OFF_ROPE = OFF_CQN + SZ_CQN, SZ_ROPE = (size_t)MTOK * 64 * 4;
static_assert(OFF_ROPE + SZ_ROPE <= OFF_O, "layer-1 alias region");
static_assert(WS_END <= 2680160256ull, "workspace");

struct Params {
    const float* x; const int* pos; const float* norm_w; const float* rel_bias;
    const float* nsa_w_in; const float* nsa_q_norm; const float* nsa_k_norm; const float* pe_k; const float* w1_k; const float* w2_k;
    const float* pe_v; const float* w1_v; const float* w2_v; const float* nsa_w_out;
    const float* mla_w_in; const float* mla_q_a_norm; const float* mla_w_q_b; const float* mla_kv_a_norm; const float* mla_w_kv_b;
    const float* mla_q_norm; const float* mla_k_norm; const float* mla_w_out;
    float* out; unsigned char* ws;
};

#define XB_TMO      128
#define XB_XCNT(j)  (256  + 64 * (j))
#define XB_XSUB(j)  (1280 + 64 * (j))
#define XB_XGEN(j)  (2304 + 64 * (j))
#define XB_TOP      3328
#define XB_TOPGEN   3392
#define XCD_BAR_WORDS 3456
#define XB_SPIN_CAP (1u << 18)

__device__ __forceinline__ unsigned xb_ld(unsigned* p)              { return __hip_atomic_load(p, __ATOMIC_RELAXED, __HIP_MEMORY_SCOPE_AGENT); }
__device__ __forceinline__ unsigned xb_add(unsigned* p, unsigned v) { return __hip_atomic_fetch_add(p, v, __ATOMIC_RELAXED, __HIP_MEMORY_SCOPE_AGENT); }
__device__ __forceinline__ unsigned xb_xcc_id() { return (unsigned)__builtin_amdgcn_s_getreg((3 << 11) | 20) & 0xFu; }
#define XB_SPIN(cond, bar) do { unsigned _sp = 0; while (cond) { __builtin_amdgcn_s_sleep(1); \
    if ((++_sp & 255u) == 0u) { if (xb_ld(&(bar)[XB_TMO])) break; if (_sp > XB_SPIN_CAP) { atomicAdd(&(bar)[XB_TMO], 1u); break; } } } } while (0)

struct XcdBarrier {
    unsigned* bar; unsigned x;
    volatile LAS unsigned* st;
};

__device__ __forceinline__ XcdBarrier xcd_barrier_post(unsigned* bar, volatile LAS unsigned* st) {
    XcdBarrier b; b.bar = bar; b.x = xb_xcc_id(); b.st = st;
    if (threadIdx.x == 0) (void)xb_add(&bar[XB_XCNT(b.x)], 1u);
    return b;
}
__device__ __forceinline__ void xcd_barrier_complete(unsigned* bar, unsigned x, unsigned& nloc, unsigned& nx) {
    const unsigned G = gridDim.x * gridDim.y * gridDim.z;
    unsigned sum, cnt, mine, sp = 0u;
    for (;;) {
        sum = 0u; cnt = 0u; mine = 0u;
#pragma unroll
        for (unsigned j = 0; j < 16; ++j) { const unsigned c = xb_ld(&bar[XB_XCNT(j)]); sum += c; cnt += (c > 0u) ? 1u : 0u; mine = (j == x) ? c : mine; }
        if (sum == G) break;
        __builtin_amdgcn_s_sleep(1);
        if ((++sp & 255u) == 0u) { if (xb_ld(&bar[XB_TMO])) break; if (sp > XB_SPIN_CAP) { atomicAdd(&bar[XB_TMO], 1u); break; } }
    }
    nloc = mine > 0u ? mine : 1u; nx = cnt > 0u ? cnt : 1u;
}

__device__ __forceinline__ void xcd_barrier(const XcdBarrier& b) {
    asm volatile("s_waitcnt vmcnt(0)" ::: "memory");
    __syncthreads();
    if (threadIdx.x == 0) {
        unsigned* bar = b.bar;
        __builtin_amdgcn_s_waitcnt(0);
        unsigned nloc = b.st[0], nx = b.st[1];
        if (nloc == 0u) { xcd_barrier_complete(bar, b.x, nloc, nx); b.st[0] = nloc; b.st[1] = nx; }
        const unsigned old = xb_add(&bar[XB_XSUB(b.x)], 1u);
        const unsigned gen = old / nloc;
        if (old + 1u == (gen + 1u) * nloc) {
            __builtin_amdgcn_fence(__ATOMIC_RELEASE, "agent");
            asm volatile("s_waitcnt vmcnt(0)" ::: "memory");
            const unsigned og = xb_add(&bar[XB_TOP], 1u);
            const unsigned tg = og / nx;
            if (og + 1u == (tg + 1u) * nx) xb_add(&bar[XB_TOPGEN], 1u);
            else XB_SPIN(xb_ld(&bar[XB_TOPGEN]) == tg, bar);
            __builtin_amdgcn_fence(__ATOMIC_ACQUIRE, "agent");
            xb_add(&bar[XB_XGEN(b.x)], 1u);
            asm volatile("s_waitcnt vmcnt(0)" ::: "memory");
        } else {
            XB_SPIN(xb_ld(&bar[XB_XGEN(b.x)]) == gen, bar);
            __builtin_amdgcn_fence(__ATOMIC_ACQUIRE, "agent");
            asm volatile("s_waitcnt vmcnt(0)" ::: "memory");
        }
    }
    __syncthreads();
}

namespace pg8 {
#define PG8_LAS __attribute__((address_space(3)))
typedef unsigned short bf16_t;
typedef short bf16x8 __attribute__((ext_vector_type(8)));
typedef float f32x4 __attribute__((ext_vector_type(4)));
typedef unsigned u32x4 __attribute__((ext_vector_type(4)));
constexpr int BM = 256, BK = 64, HALF = 128, HTB = HALF * BK * 2  , STAGE_BYTES = 8 * HTB, NXCD = 8, WGM = 8;

__host__ __device__ __forceinline__ int lds_byte(int r, int c) { const int st = (r >> 4) * 2 + (c >> 5), rr = r & 15, cc = c & 31, ob = rr * 64 + cc * 2; return st * 1024 + (ob ^ (((ob >> 9) & 1) << 5)); }
__host__ __device__ __forceinline__ void stage_rc(int b, int& R, int& C) { const int st = b / 1024, sb = b % 1024, swz = sb ^ (((sb >> 9) & 1) << 5); R = (st >> 1) * 16 + swz / 64; C = (st & 1) * 32 + (swz % 64) / 2; }
__host__ __device__ __forceinline__ int perm32(int rho) { const int n = rho >> 4, i = rho & 15; return 8 * (i >> 2) + 4 * n + (i & 3); }

struct Unit { int pm, pn; };
struct Gemm { const bf16_t* A; const bf16_t* Bt; int M, N, K; };

struct StaticOrder {
    int nM, nN, nwg, G, c;
    __host__ __device__ void init(int M, int N, int G_, int c_) { nM = M / BM; nN = N / BM; nwg = nM * nN; G = G_; c = c_; }
    __host__ __device__ bool next(int i, Unit& u) const {
        const long L = (long)i * G + c; if (L >= nwg) return false;
        int wgid = (int)L; { const int q = nwg / NXCD, r = nwg % NXCD, xcd = wgid % NXCD, off = wgid / NXCD; wgid = (xcd < r ? xcd * (q + 1) : r * (q + 1) + (xcd - r) * q) + off; }
        const int nig = WGM * nN, gid = wgid / nig, fm = gid * WGM, gsz = (nM - fm) < WGM ? (nM - fm) : WGM;
        u.pm = fm + ((wgid % nig) % gsz); u.pn = (wgid % nig) / gsz; return true;
    }
    __device__ __forceinline__ void a_ready(const Unit&) const {}
    __device__ __forceinline__ void done(const Unit&) const {}
};
struct EpiStoreBf16 {
    static constexpr bool PERM = true, AFTER_DRAIN = false, SWAP23 = false;
    bf16_t* O; int ldc;
    __device__ __forceinline__ void operator()(const f32x4 (&acc)[2][2][4][2], const Unit& u, int wr, int wc, int fr, int fq) const {
        const int row0 = u.pm * BM + wr * 64 + fr; const int col0 = u.pn * BM + wc * 32 + 8 * fq;
#pragma unroll
        for (int ai = 0; ai < 2; ++ai)
#pragma unroll
            for (int m = 0; m < 4; ++m) { bf16_t* rowp = O + (size_t)(row0 + ai * HALF + m * 16) * ldc + col0;
#pragma unroll
                for (int bj = 0; bj < 2; ++bj) { const f32x4 v0 = acc[ai][bj][m][0], v1 = acc[ai][bj][m][1];
                    u32x4 w; w.x = pk2(v0[0], v0[1]); w.y = pk2(v0[2], v0[3]); w.z = pk2(v1[0], v1[1]); w.w = pk2(v1[2], v1[3]);
                    *(u32x4*)(rowp + bj * HALF) = w; } }
    }
};
struct EpiResF32 {
    static constexpr bool PERM = false, AFTER_DRAIN = false, SWAP23 = false;
    const float* base; float* out; int ldc;
    __device__ __forceinline__ void operator()(const f32x4 (&acc)[2][2][4][2], const Unit& u, int wr, int wc, int fr, int fq) const {
        const int row0 = u.pm * BM + wr * 64 + fr, col0 = u.pn * BM + wc * 32 + 4 * fq;
#pragma unroll
        for (int ai = 0; ai < 2; ++ai)
#pragma unroll
            for (int m = 0; m < 4; ++m) { const size_t off = (size_t)(row0 + ai * HALF + m * 16) * ldc + col0;
#pragma unroll
                for (int bj = 0; bj < 2; ++bj)
#pragma unroll
                    for (int n = 0; n < 2; ++n) { const f32x4 bs = *(const f32x4*)(base + off + bj * HALF + n * 16);
                        *(f32x4*)(out + off + bj * HALF + n * 16) = bs + acc[ai][bj][m][n]; } }
    }
};
struct EpiPlainF32 {
    static constexpr bool PERM = false, AFTER_DRAIN = false, SWAP23 = false;
    float* C; int ldc;
    __device__ __forceinline__ void operator()(const f32x4 (&acc)[2][2][4][2], const Unit& u, int wr, int wc, int fr, int fq) const {
        const int row0 = u.pm * BM + wr * 64 + fr, col0 = u.pn * BM + wc * 32 + 4 * fq;
#pragma unroll
        for (int ai = 0; ai < 2; ++ai)
#pragma unroll
            for (int m = 0; m < 4; ++m) { float* rowp = C + (size_t)(row0 + ai * HALF + m * 16) * ldc + col0;
#pragma unroll
                for (int bj = 0; bj < 2; ++bj)
#pragma unroll
                    for (int n = 0; n < 2; ++n) *(f32x4*)(rowp + bj * HALF + n * 16) = acc[ai][bj][m][n]; }
    }
};

struct EpiVT {
    static constexpr bool PERM = true, AFTER_DRAIN = false, SWAP23 = true;
    bf16_t* O;
    __device__ __forceinline__ void operator()(const f32x4 (&acc)[2][2][4][2], const Unit& u, int wr, int wc, int fr, int fq) const {
        const int row0 = u.pm * BM + wr * 64 + fr; const int colt = u.pn * BM; const int b = colt >> 12, pos0 = (colt & 4095) + wc * 32 + 8 * fq;
        bf16_t* base = O + (size_t)b * 8192 * 4096 + pos0;
#pragma unroll
        for (int ai = 0; ai < 2; ++ai)
#pragma unroll
            for (int m = 0; m < 4; ++m) { bf16_t* rowp = base + (size_t)(row0 + ai * HALF + m * 16) * 4096;
#pragma unroll
                for (int bj = 0; bj < 2; ++bj) { const f32x4 v0 = acc[ai][bj][m][0], v1 = acc[ai][bj][m][1];
                    u32x4 w; w.x = pk2(v0[0], v0[1]); w.y = pk2(v0[2], v0[3]); w.z = pk2(v1[0], v1[1]); w.w = pk2(v1[2], v1[3]);
                    *(u32x4*)(rowp + bj * HALF) = w; } }
    }
};

struct EpiKNorm {
    static constexpr bool PERM = true, AFTER_DRAIN = false, SWAP23 = false;
    bf16_t* KM; const float* sspe; const float* kper; const float* gain; PG8_LAS float* tab; mutable unsigned par;
    __device__ __forceinline__ void operator()(const f32x4 (&acc)[2][2][4][2], const Unit& u, int wr, int wc, int fr, int fq) const {
        PG8_LAS float* T = tab + par * 2048;
#pragma unroll
        for (int ai = 0; ai < 2; ++ai)
#pragma unroll
            for (int m = 0; m < 4; ++m) { const int row = ai * HALF + wr * 64 + m * 16 + fr;
#pragma unroll
                for (int bj = 0; bj < 2; ++bj) { const f32x4 x = acc[ai][bj][m][0], y = acc[ai][bj][m][1];
                    float ss = (x[0] * x[0] + x[1] * x[1]) + (x[2] * x[2] + x[3] * x[3]) + (y[0] * y[0] + y[1] * y[1]) + (y[2] * y[2] + y[3] * y[3]);
                    ss += __shfl_xor(ss, 16); ss += __shfl_xor(ss, 32);
                    if (fq == 0) T[row * 8 + bj * 4 + wc] = ss; } }
        asm volatile("s_waitcnt lgkmcnt(0)" ::: "memory"); __builtin_amdgcn_s_barrier(); asm volatile("" ::: "memory");
        const f32x4 g0 = *(const f32x4*)(gain + wc * 32 + 8 * fq), g1 = *(const f32x4*)(gain + wc * 32 + 8 * fq + 4);
        const int tok0 = u.pm * BM, b = tok0 >> 12;
#pragma unroll
        for (int ai = 0; ai < 2; ++ai)
#pragma unroll
            for (int m = 0; m < 4; ++m) { const int row = ai * HALF + wr * 64 + m * 16 + fr, tok = tok0 + row, s = tok & 4095;
                const float sp = sspe[tok]; const f32x4 kp = *(const f32x4*)(kper + (size_t)tok * 64 + wc * 16 + 4 * fq);
#pragma unroll
                for (int bj = 0; bj < 2; ++bj) { const f32x4 t = *(const PG8_LAS f32x4*)(T + row * 8 + bj * 4);
                    const float rstd = rsqrtf(((t[0] + t[1]) + (t[2] + t[3]) + sp) * (1.0f / 192.0f) + 1e-6f);
                    const int hd = 2 * u.pn + bj;
                    bf16_t* kb = KM + ((size_t)(b * 64 + hd) * 4096 + s) * 192;
                    const f32x4 x = acc[ai][bj][m][0], y = acc[ai][bj][m][1];
                    u32x4 w; w.x = pk2(x[0] * rstd * g0[0], x[1] * rstd * g0[1]); w.y = pk2(x[2] * rstd * g0[2], x[3] * rstd * g0[3]);
                    w.z = pk2(y[0] * rstd * g1[0], y[1] * rstd * g1[1]); w.w = pk2(y[2] * rstd * g1[2], y[3] * rstd * g1[3]);
                    *(u32x4*)(kb + wc * 32 + 8 * fq) = w;
                    u32x2 r; r.x = pk2(kp[0] * rstd, kp[1] * rstd); r.y = pk2(kp[2] * rstd, kp[3] * rstd);
                    *(u32x2*)(kb + 128 + wc * 16 + 4 * fq) = r; } }
        par ^= 1u;
    }
};

struct EpiResNorm {
    static constexpr bool PERM = false, AFTER_DRAIN = false, SWAP23 = false;
    const float* base; float* out; int ldc; const float* gain; bf16_t* xg; float* ss;
    __device__ __forceinline__ void operator()(const f32x4 (&acc)[2][2][4][2], const Unit& u, int wr, int wc, int fr, int fq) const {
        const int row0 = u.pm * BM + wr * 64 + fr, col0 = u.pn * BM + wc * 32 + 4 * fq;
        f32x4 gv[2][2];
#pragma unroll
        for (int bj = 0; bj < 2; ++bj)
#pragma unroll
            for (int n = 0; n < 2; ++n) gv[bj][n] = *(const f32x4*)(gain + col0 + bj * HALF + n * 16);
#pragma unroll
        for (int ai = 0; ai < 2; ++ai)
#pragma unroll
            for (int m = 0; m < 4; ++m) { const int row = row0 + ai * HALF + m * 16; const size_t off = (size_t)row * ldc + col0; float sq = 0.f;
#pragma unroll
                for (int bj = 0; bj < 2; ++bj)
#pragma unroll
                    for (int n = 0; n < 2; ++n) { const f32x4 bs = *(const f32x4*)(base + off + bj * HALF + n * 16); const f32x4 v = bs + acc[ai][bj][m][n];
                        *(f32x4*)(out + off + bj * HALF + n * 16) = v;
                        sq += (v[0] * v[0] + v[1] * v[1]) + (v[2] * v[2] + v[3] * v[3]);
                        const f32x4 g = gv[bj][n]; u32x2 w; w.x = pk2(v[0] * g[0], v[1] * g[1]); w.y = pk2(v[2] * g[2], v[3] * g[3]);
                        *(u32x2*)(xg + off + bj * HALF + n * 16) = w; }
                sq += __shfl_xor(sq, 16); sq += __shfl_xor(sq, 32);
                if (fq == 0) atomicAdd(ss + row, sq); }
    }
};
struct EpiStoreBf16RowScale {
    static constexpr bool PERM = true, AFTER_DRAIN = false, SWAP23 = false;
    bf16_t* O; int ldc; const float* ss; float inv_dim;
    __device__ __forceinline__ void operator()(const f32x4 (&acc)[2][2][4][2], const Unit& u, int wr, int wc, int fr, int fq) const {
        const int row0 = u.pm * BM + wr * 64 + fr; const int col0 = u.pn * BM + wc * 32 + 8 * fq;
#pragma unroll
        for (int ai = 0; ai < 2; ++ai)
#pragma unroll
            for (int m = 0; m < 4; ++m) { const int row = row0 + ai * HALF + m * 16; const float rs = rsqrtf(ss[row] * inv_dim + 1e-6f);
                bf16_t* rowp = O + (size_t)row * ldc + col0;
#pragma unroll
                for (int bj = 0; bj < 2; ++bj) { const f32x4 v0 = acc[ai][bj][m][0] * rs, v1 = acc[ai][bj][m][1] * rs;
                    u32x4 w; w.x = pk2(v0[0], v0[1]); w.y = pk2(v0[2], v0[3]); w.z = pk2(v1[0], v1[1]); w.w = pk2(v1[2], v1[3]);
                    *(u32x4*)(rowp + bj * HALF) = w; } }
    }
};
template <class Epi, class Sched, bool STAMP = false>
__device__ __forceinline__ void gemm_phase(PG8_LAS unsigned char* lds, const Gemm g, const Sched& S, const Epi& E, unsigned long long* stamps) {
    const int tid = tid_opaque(), wid = __builtin_amdgcn_readfirstlane(tid >> 6), lane = tid & 63, wr = wid >> 2, wc = wid & 3, fr = lane & 15, fq = lane >> 4;
    const int K = g.K, nt = K / BK;
    int ts_lo = 0, ts_hi = 0, nts = 0; const unsigned long long rt_entry = STAMP ? (unsigned long long)wall_clock64() : 0ull;
#define PG8_STAMP() do { if (STAMP && wid == 0 && nts < 64) { const unsigned long long _c = (unsigned long long)clock64(); \
        ts_lo = (lane == nts) ? (int)(unsigned)_c : ts_lo; ts_hi = (lane == nts) ? (int)(unsigned)(_c >> 32) : ts_hi; ++nts; } } while (0)
    PG8_STAMP();
    unsigned voffA[2], voffB[2];
#pragma unroll
    for (int i = 0; i < 2; ++i) { int R, C; stage_rc(tid * 16 + i * 8192, R, C); int Rb = Epi::PERM ? ((R & ~31) + perm32(R & 31)) : R; if (Epi::SWAP23) Rb = (Rb & ~15) | ((Rb & 3) | ((Rb & 4) << 1) | ((Rb & 8) >> 1));
        voffA[i] = (unsigned)(R * K + C) * 2u; voffB[i] = (unsigned)(Rb * K + C) * 2u; }
    const size_t kstep = (size_t)(BK * 2);
    const size_t hstep = (size_t)HALF * K * 2;
    const size_t tstep = 2 * hstep;
    const unsigned ldsw = (unsigned)wid * 1024u;
    const int aoff = lds_byte(wr * 64 + fr, fq * 8), boff = lds_byte(wc * 32 + fr, fq * 8);
#define PG8_SA(b, h) (((b) * 2 + (h)) * HTB)
#define PG8_SB(b, h) ((4 + (b) * 2 + (h)) * HTB)
#define PG8_STAGE(bufoff, gbase, voff) do { _Pragma("unroll") for (int _i = 0; _i < 2; ++_i) \
        __builtin_amdgcn_global_load_lds((const unsigned*)((const char*)(gbase) + (voff)[_i]), (PG8_LAS unsigned*)(lds + (bufoff) + ldsw + _i * 8192), 16, 0, 0); } while (0)
#define PG8_LDA(dst, b, h) do { _Pragma("unroll") for (int m = 0; m < 4; ++m) _Pragma("unroll") for (int k = 0; k < 2; ++k) dst[m][k] = *(const PG8_LAS bf16x8*)(lds + PG8_SA(b, h) + aoff + m * 2048 + k * 1024); } while (0)
#define PG8_LDB(dst, b, h) do { _Pragma("unroll") for (int n = 0; n < 2; ++n) _Pragma("unroll") for (int k = 0; k < 2; ++k) dst[n][k] = *(const PG8_LAS bf16x8*)(lds + PG8_SB(b, h) + boff + n * 2048 + k * 1024); } while (0)
#define PG8_MMA(ai, bj, At, Bt) do { __builtin_amdgcn_s_setprio(1); _Pragma("unroll") for (int m = 0; m < 4; ++m) _Pragma("unroll") for (int n = 0; n < 2; ++n) _Pragma("unroll") for (int k = 0; k < 2; ++k) \
        acc[ai][bj][m][n] = __builtin_amdgcn_mfma_f32_16x16x32_bf16(Bt[n][k], At[m][k], acc[ai][bj][m][n], 0, 0, 0); __builtin_amdgcn_s_setprio(0); } while (0)
#define PG8_WAIT_V(n) asm volatile("s_waitcnt vmcnt(" #n ")" ::: "memory")
#define PG8_WAIT_L(n) asm volatile("s_waitcnt lgkmcnt(" #n ")" ::: "memory")
#define PG8_BAR __builtin_amdgcn_s_barrier()
#define PG8_SCHED __builtin_amdgcn_sched_barrier(0)
    Unit cur, nxt; int ui = 0;
    if (!S.next(0, cur)) return;
    f32x4 acc[2][2][4][2];
#pragma unroll
    for (int a = 0; a < 2; ++a)
#pragma unroll
        for (int b = 0; b < 2; ++b)
#pragma unroll
            for (int m = 0; m < 4; ++m)
#pragma unroll
                for (int n = 0; n < 2; ++n) acc[a][b][m][n] = (f32x4){0.f, 0.f, 0.f, 0.f};
    bf16x8 At[4][2], B0[2][2], B1[2][2];
    const char* cA = (const char*)g.A + (size_t)cur.pm * tstep; const char* cB = (const char*)g.Bt + (size_t)cur.pn * tstep;
    S.a_ready(cur);
    PG8_STAGE(PG8_SB(0, 0), cB, voffB); PG8_STAGE(PG8_SA(0, 0), cA, voffA); PG8_STAGE(PG8_SB(0, 1), cB + hstep, voffB); PG8_STAGE(PG8_SA(0, 1), cA + hstep, voffA);
    if (wr == 1) PG8_BAR;
    PG8_WAIT_V(4); PG8_BAR;
    PG8_STAGE(PG8_SB(1, 0), cB + kstep, voffB); PG8_STAGE(PG8_SA(1, 0), cA + kstep, voffA); PG8_STAGE(PG8_SB(1, 1), cB + hstep + kstep, voffB);
    PG8_WAIT_V(6); PG8_BAR;
    PG8_STAMP();
    for (;;) {
        const bool has_next = S.next(ui + 1, nxt);
        const char* nA = has_next ? (const char*)g.A + (size_t)nxt.pm * tstep : cA; const char* nB = has_next ? (const char*)g.Bt + (size_t)nxt.pn * tstep : cB;
        for (int t = 0; t < nt; t += 2) {
            const bool last = (t == nt - 2);
            const char* a1 = cA + (size_t)(t + 1) * kstep;
            const char* a2 = last ? nA : cA + (size_t)(t + 2) * kstep; const char* b2 = last ? nB : cB + (size_t)(t + 2) * kstep;
            const char* a3 = a2 + kstep; const char* b3 = b2 + kstep;
            if (last && has_next) S.a_ready(nxt);
            PG8_LDB(B0, 0, 0); PG8_SCHED; PG8_LDA(At, 0, 0); PG8_STAGE(PG8_SA(1, 1), a1 + hstep, voffA);
            PG8_WAIT_L(8); PG8_BAR; PG8_WAIT_L(0); PG8_MMA(0, 0, At, B0); PG8_BAR; PG8_SCHED;
            PG8_LDB(B1, 0, 1); PG8_STAGE(PG8_SB(0, 0), b2, voffB);
            PG8_BAR; PG8_WAIT_L(0); PG8_MMA(0, 1, At, B1); PG8_BAR;
            PG8_LDA(At, 0, 1); PG8_STAGE(PG8_SA(0, 0), a2, voffA);
            PG8_BAR; PG8_WAIT_L(0); PG8_MMA(1, 0, At, B0); PG8_BAR; PG8_SCHED;
            PG8_STAGE(PG8_SB(0, 1), b2 + hstep, voffB);
            PG8_WAIT_V(6); PG8_BAR; PG8_MMA(1, 1, At, B1); PG8_BAR;
            PG8_LDB(B0, 1, 0); PG8_SCHED; PG8_LDA(At, 1, 0); PG8_STAGE(PG8_SA(0, 1), a2 + hstep, voffA);
            PG8_WAIT_L(8); PG8_BAR; PG8_WAIT_L(0); PG8_MMA(0, 0, At, B0); PG8_BAR; PG8_SCHED;
            PG8_LDB(B1, 1, 1); PG8_STAGE(PG8_SB(1, 0), b3, voffB);
            PG8_BAR; PG8_WAIT_L(0); PG8_MMA(0, 1, At, B1); PG8_BAR;
            PG8_LDA(At, 1, 1); PG8_STAGE(PG8_SA(1, 0), a3, voffA);
            PG8_BAR; PG8_WAIT_L(0); PG8_MMA(1, 0, At, B0); PG8_BAR; PG8_SCHED;
            PG8_STAGE(PG8_SB(1, 1), b3 + hstep, voffB);
            PG8_WAIT_V(6); PG8_BAR; PG8_MMA(1, 1, At, B1); PG8_BAR;
        }
        PG8_STAMP();
        if constexpr (!Epi::AFTER_DRAIN) { E(acc, cur, wr, wc, fr, fq); S.done(cur); }
        PG8_STAMP();
        if (!has_next) break;
#pragma unroll
        for (int a = 0; a < 2; ++a)
#pragma unroll
            for (int b = 0; b < 2; ++b)
#pragma unroll
                for (int m = 0; m < 4; ++m)
#pragma unroll
                    for (int n = 0; n < 2; ++n) acc[a][b][m][n] = (f32x4){0.f, 0.f, 0.f, 0.f};
        cur = nxt; cA = nA; cB = nB; ++ui;
    }
    PG8_WAIT_V(0);
    if (wr == 0) PG8_BAR;
    PG8_BAR;
    if constexpr (Epi::AFTER_DRAIN) { E.fused(acc, cur, wr, wc, fr, fq, lds, wid, lane); S.done(cur); }
    PG8_STAMP();
    if (STAMP && wid == 0) { stamps[lane] = lane < nts ? (((unsigned long long)(unsigned)ts_hi << 32) | (unsigned)ts_lo) : 0ull;
        if (lane == 62) stamps[62] = rt_entry; if (lane == 63) stamps[63] = (unsigned long long)wall_clock64(); }
#undef PG8_STAMP
#undef PG8_SA
#undef PG8_SB
#undef PG8_STAGE
#undef PG8_LDA
#undef PG8_LDB
#undef PG8_MMA
#undef PG8_WAIT_V
#undef PG8_WAIT_L
#undef PG8_BAR
#undef PG8_SCHED
}
}


DI void phase_wconv(LAS unsigned char* lds, const float* __restrict__ src, bf16_t* __restrict__ dst, int K, int N, int Npad, int bid, int nb, float q8s = 0.f, int colmap = 0) {
    LAS float* tile = (LAS float*)lds;
    const int tid = tid_opaque();
    const int tk = K / 64, tn = Npad / 256, total = tk * tn;
    for (int t = bid; t < total; t += nb) {
        const int k0 = (t % tk) * 64, n0 = (t / tk) * 256;
        __syncthreads();
        {
            const int ty = tid >> 6, tx = tid & 63, n = n0 + tx * 4;
            f32x4 v[8];
#pragma unroll
            for (int i = 0; i < 8; ++i) {
                const int k = k0 + ty + 8 * i;
                v[i] = (f32x4){0.f, 0.f, 0.f, 0.f};
                if (colmap) { const int ns = (n >> 7) * 256 + (colmap == 1 ? 128 : 0) + (n & 127); v[i] = *(const f32x4*)(src + (size_t)k * (2 * N) + ns); }
                else if (n < N) v[i] = *(const f32x4*)(src + (size_t)k * N + n);
            }
#pragma unroll
            for (int i = 0; i < 8; ++i) { LAS float* pp = tile + (ty + 8 * i) * 257 + tx * 4; pp[0] = v[i][0]; pp[1] = v[i][1]; pp[2] = v[i][2]; pp[3] = v[i][3]; }
        }
        __syncthreads();
#pragma unroll
        for (int ps_ = 0; ps_ < 4; ++ps_) {
            const int n = (tid >> 3) + 64 * ps_, kc = tid & 7;
            float v[8];
#pragma unroll
            for (int j = 0; j < 8; ++j) { v[j] = tile[(kc * 8 + j) * 257 + n]; if (q8s > 0.f) v[j] = emu_q8(v[j], q8s); else if (q8s < 0.f && n0 + n >= C_ZC) v[j] = emu_q8(v[j], -q8s); }
            u32x4 w; w.x = pk2(v[0], v[1]); w.y = pk2(v[2], v[3]); w.z = pk2(v[4], v[5]); w.w = pk2(v[6], v[7]);
            *(u32x4*)(dst + (size_t)(n0 + n) * K + k0 + kc * 8) = w;
        }
    }
}

DI void phase_rmsnorm(const float* __restrict__ x, const float* __restrict__ gain, bf16_t* __restrict__ h, int bid, int nb, float q8s = 0.f) {
    const int tid = tid_opaque(); const int lane = tid & 63, wid = tid >> 6;
    for (int row = bid * 8 + wid; row < MTOK; row += nb * 8) {
        const float* xr = x + (size_t)row * DM;
        f32x4 v[16]; float ss = 0.f;
#pragma unroll
        for (int i = 0; i < 16; ++i) { v[i] = *(const f32x4*)(xr + (i * 64 + lane) * 4); ss += v[i][0] * v[i][0] + v[i][1] * v[i][1] + v[i][2] * v[i][2] + v[i][3] * v[i][3]; }
#pragma unroll
        for (int o = 32; o >= 1; o >>= 1) ss += __shfl_xor(ss, o);
        const float rstd = rsqrtf(ss * (1.0f / DM) + EPSN);
        bf16_t* hr = h + (size_t)row * DM;
#pragma unroll
        for (int i = 0; i < 16; ++i) { const f32x4 g = *(const f32x4*)(gain + (i * 64 + lane) * 4);
            float y0 = v[i][0] * rstd * g[0], y1 = v[i][1] * rstd * g[1], y2 = v[i][2] * rstd * g[2], y3 = v[i][3] * rstd * g[3];
            if (q8s > 0.f || (q8s < 0.f && (row & 4095) >= 256)) { const float qa = fabsf(q8s); y0 = emu_q8(y0, qa); y1 = emu_q8(y1, qa); y2 = emu_q8(y2, qa); y3 = emu_q8(y3, qa); }
            u32x2 w; w.x = pk2(y0, y1); w.y = pk2(y2, y3);
            *(u32x2*)(hr + (i * 64 + lane) * 4) = w; }
    }
}

DI void ld192(const bf16_t* p, int j8, float (&v)[24]) {
#pragma unroll
    for (int c = 0; c < 3; ++c) { const u32x4 w = *(const u32x4*)(p + (j8 + 8 * c) * 8);
        v[c * 8 + 0] = bflo(w.x); v[c * 8 + 1] = bfhi(w.x); v[c * 8 + 2] = bflo(w.y); v[c * 8 + 3] = bfhi(w.y);
        v[c * 8 + 4] = bflo(w.z); v[c * 8 + 5] = bfhi(w.z); v[c * 8 + 6] = bflo(w.w); v[c * 8 + 7] = bfhi(w.w); }
}
DI void st192(bf16_t* p, int j8, const float (&v)[24]) {
#pragma unroll
    for (int c = 0; c < 3; ++c) { u32x4 w; w.x = pk2(v[c * 8 + 0], v[c * 8 + 1]); w.y = pk2(v[c * 8 + 2], v[c * 8 + 3]); w.z = pk2(v[c * 8 + 4], v[c * 8 + 5]); w.w = pk2(v[c * 8 + 6], v[c * 8 + 7]);
        *(u32x4*)(p + (j8 + 8 * c) * 8) = w; }
}
DI float sum8(float s) { s += __shfl_xor(s, 1); s += __shfl_xor(s, 2); s += __shfl_xor(s, 4); return s; }

DI void phase_nsa_prep(const Params& P, int bid, int nb) {
    bf16_t* Y0 = (bf16_t*)(P.ws + OFF_Y0);
    bf16_t* KS = (bf16_t*)(P.ws + OFF_KS); bf16_t* KW = (bf16_t*)(P.ws + OFF_KW);
    bf16_t* ACK = (bf16_t*)(P.ws + OFF_ACK); bf16_t* ACV = (bf16_t*)(P.ws + OFF_ACV);
    const int tid = tid_opaque(), grp = (tid >> 3) & 15, j8 = tid & 7;
    for (int tok = bid * 4 + (tid >> 7); tok < MTOK; tok += nb * 4) {
        const int b = tok / SEQ, s = tok % SEQ;
        bf16_t* yr = Y0 + (size_t)tok * N1P;
        if (grp < 8) {
            const int g = grp & 3, br = grp >> 2;
            float v[24]; ld192(yr + (br ? C_KVW : C_KVS) + g * DK, j8, v);
            float ss = 0.f;
#pragma unroll
            for (int i = 0; i < 24; ++i) ss += v[i] * v[i];
            ss = sum8(ss);
            const float rstd = rsqrtf(ss * (1.0f / DK) + EPSN);
            const float* kn = P.nsa_k_norm + (br ? 2 : 1) * DK;
#pragma unroll
            for (int c = 0; c < 3; ++c)
#pragma unroll
                for (int e = 0; e < 8; ++e) v[c * 8 + e] *= rstd * kn[(j8 + 8 * c) * 8 + e];
            st192((br ? KW : KS) + ((size_t)(b * NG + g) * SEQ + s) * DK, j8, v);
        } else if (grp < 12) {
            const int g = grp - 8;
            float v[24]; ld192(yr + C_KVC + g * DK, j8, v);
#pragma unroll
            for (int k = 0; k < 2; ++k) {
                const int n = (s >> 4) - k, l = s - 16 * n;
                if (n >= 0 && n <= 254) {
                    float w[24];
#pragma unroll
                    for (int c = 0; c < 3; ++c)
#pragma unroll
                        for (int e = 0; e < 8; ++e) w[c * 8 + e] = v[c * 8 + e] + P.pe_k[l * DK + (j8 + 8 * c) * 8 + e];
                    st192(ACK + ((size_t)((b * NG + g) * 256 + n)) * 6144 + l * DK, j8, w);
                }
            }
        } else if (grp < 16) {
            const int g = grp - 12;
            const bf16_t* src = yr + C_KVC + NG * DK + g * DV;
            float v[16];
#pragma unroll
            for (int c = 0; c < 2; ++c) { const u32x4 w = *(const u32x4*)(src + (j8 + 8 * c) * 8);
                v[c * 8 + 0] = bflo(w.x); v[c * 8 + 1] = bfhi(w.x); v[c * 8 + 2] = bflo(w.y); v[c * 8 + 3] = bfhi(w.y);
                v[c * 8 + 4] = bflo(w.z); v[c * 8 + 5] = bfhi(w.z); v[c * 8 + 6] = bflo(w.w); v[c * 8 + 7] = bfhi(w.w); }
#pragma unroll
            for (int k = 0; k < 2; ++k) {
                const int n = (s >> 4) - k, l = s - 16 * n;
                if (n >= 0 && n <= 254) {
                    bf16_t* dst = ACV + ((size_t)((b * NG + g) * 256 + n)) * 4096 + l * DV;
#pragma unroll
                    for (int c = 0; c < 2; ++c) { float w[8];
#pragma unroll
                        for (int e = 0; e < 8; ++e) w[e] = v[c * 8 + e] + P.pe_v[l * DV + (j8 + 8 * c) * 8 + e];
                        u32x4 o; o.x = pk2(w[0], w[1]); o.y = pk2(w[2], w[3]); o.z = pk2(w[4], w[5]); o.w = pk2(w[6], w[7]);
                        *(u32x4*)(dst + (j8 + 8 * c) * 8) = o; }
                }
            }
        }
    }
    for (int i = bid * 512 + tid; i < 16 * (6144 + 4096) / 8; i += nb * 512) {
        const int per = (6144 + 4096) / 8, bg = i / per, c = i % per;
        const u32x4 z = {0u, 0u, 0u, 0u};
        if (c < 6144 / 8) *(u32x4*)(ACK + ((size_t)(bg * 256 + 255)) * 6144 + c * 8) = z;
        else *(u32x4*)(ACV + ((size_t)(bg * 256 + 255)) * 4096 + (c - 6144 / 8) * 8) = z;
    }
}

DI int swap23(int p) { return (p & ~0xC) | ((p & 4) << 1) | ((p & 8) >> 1); }
DI void phase_vt(LAS unsigned char* lds, const bf16_t* __restrict__ src, size_t src_stride, int col0, int col_step, int nhv, bf16_t* __restrict__ dst, int bid, int nb) {
    LAS bf16_t* tile = (LAS bf16_t*)lds;
    const int tid = tid_opaque();
    const int ntile = SEQ / 64, total = BATCH * nhv * ntile;
    for (int it = bid; it < total; it += nb) {
        const int mat = it / ntile, tt = it % ntile, b = mat / nhv, hv = mat % nhv;
        __syncthreads();
#pragma unroll
        for (int i = 0; i < 2; ++i) {
            const int q = tid + 512 * i, tok = q >> 4, ch = q & 15;
            const u32x4 w = *(const u32x4*)(src + (size_t)(b * SEQ + tt * 64 + tok) * src_stride + col0 + hv * col_step + ch * 8);
            *(LAS u32x4*)(tile + tok * 136 + ch * 8) = w;
        }
        __syncthreads();
        {
            const int dv = tid >> 2, kq = tid & 3;
            unsigned w[8];
#pragma unroll
            for (int e = 0; e < 8; ++e) {
                const int p0 = kq * 16 + 2 * e, p1 = p0 + 1;
                const int k0 = (p0 & ~15) | swap23(p0 & 15), k1 = (p1 & ~15) | swap23(p1 & 15);
                w[e] = (unsigned)tile[k0 * 136 + dv] | ((unsigned)tile[k1 * 136 + dv] << 16);
            }
            bf16_t* d = dst + ((size_t)mat * DV + dv) * SEQ + tt * 64 + kq * 16;
            u32x4 a = {w[0], w[1], w[2], w[3]}, c = {w[4], w[5], w[6], w[7]};
            *(u32x4*)d = a; *(u32x4*)(d + 8) = c;
        }
    }
}

DI void phase_cmp2(LAS unsigned char* lds, const Params& P, int bid, int nb) {
    LAS float* sk = (LAS float*)lds;
    LAS float* sv = sk + 192;
    LAS float* red = sv + 128;
    const float* HIDK = (const float*)(P.ws + OFF_HIDK); const float* HIDV = (const float*)(P.ws + OFF_HIDV);
    bf16_t* KC = (bf16_t*)(P.ws + OFF_KC); bf16_t* VTC = (bf16_t*)(P.ws + OFF_VTC);
    const int tid = tid_opaque(), lane = tid & 63, wid = tid >> 6;
    for (int m = bid; m < 4096; m += nb) {
        const int n = m & 255, bg = m >> 8;
        __syncthreads();
        if (tid < 192) { const float h = HIDK[(size_t)m * 256 + tid]; sk[tid] = h / (1.0f + __expf(-h)); }
        else if (tid < 320) { const float h = HIDV[(size_t)m * 256 + tid - 192]; sv[tid - 192] = h / (1.0f + __expf(-h)); }
        __syncthreads();
        float acc = 0.f;
        if (tid < 192) { for (int i = 0; i < 192; ++i) acc += sk[i] * P.w2_k[i * 192 + tid]; }
        else if (tid < 320) { const int j = tid - 192; for (int i = 0; i < 128; ++i) acc += sv[i] * P.w2_v[i * 128 + j]; }
        float ss = (tid < 192) ? acc * acc : 0.f;
#pragma unroll
        for (int o = 32; o >= 1; o >>= 1) ss += __shfl_xor(ss, o);
        if (lane == 0) red[wid] = ss;
        __syncthreads();
        const float tot = red[0] + red[1] + red[2];
        const float rstd = rsqrtf(tot * (1.0f / DK) + EPSN);
        if (tid < 192) { const float o = (n == 255) ? 0.f : acc * rstd * P.nsa_k_norm[tid];
            KC[(size_t)m * DK + tid] = (bf16_t)(pk2(o, 0.f) & 0xffffu); }
        else if (tid < 320) { const int j = tid - 192; const float o = (n == 255) ? 0.f : acc;
            const int pn = (n & ~15) | swap23(n & 15);
            VTC[((size_t)bg * DV + j) * 256 + pn] = (bf16_t)(pk2(o, 0.f) & 0xffffu); }
    }
}

DI void phase_mla_prep1(const Params& P, int bid, int nb) {
    const bf16_t* Y1 = (const bf16_t*)(P.ws + OFF_Y1);
    bf16_t* CQN = (bf16_t*)(P.ws + OFF_CQN); bf16_t* CKVN = (bf16_t*)(P.ws + OFF_CKVN); float* ROPE = (float*)(P.ws + OFF_ROPE);
    float* KPER = (float*)(P.ws + OFF_KPER); float* SSPE = (float*)(P.ws + OFF_SSPE);
    const int tid = tid_opaque(); const int lane = tid & 63, wid = tid >> 6;
    constexpr int TU = 4;
    for (int tok0 = (bid * 8 + wid) * TU; tok0 < MTOK; tok0 += nb * 8 * TU) {
        u32x4 wq[TU][3], wk[TU]; int pos[TU]; bf16_t kp1[TU], kp2[TU];
#pragma unroll
        for (int t = 0; t < TU; ++t) { const bf16_t* yr = Y1 + (size_t)(tok0 + t) * N3P;
#pragma unroll
            for (int c = 0; c < 3; ++c) wq[t][c] = *(const u32x4*)(yr + C3_CQ + (c * 64 + lane) * 8);
            wk[t] = *(const u32x4*)(yr + C3_CKV + lane * 8);
            pos[t] = P.pos[tok0 + t]; kp1[t] = yr[C3_KPE + (lane & 31)]; kp2[t] = yr[C3_KPE + 32 + (lane & 31)]; }
#pragma unroll
        for (int t = 0; t < TU; ++t) { const int tok = tok0 + t;
            {
                float v[24]; float ss = 0.f;
#pragma unroll
                for (int c = 0; c < 3; ++c) { const u32x4 w = wq[t][c];
                    v[c * 8 + 0] = bflo(w.x); v[c * 8 + 1] = bfhi(w.x); v[c * 8 + 2] = bflo(w.y); v[c * 8 + 3] = bfhi(w.y);
                    v[c * 8 + 4] = bflo(w.z); v[c * 8 + 5] = bfhi(w.z); v[c * 8 + 6] = bflo(w.w); v[c * 8 + 7] = bfhi(w.w); }
#pragma unroll
                for (int i = 0; i < 24; ++i) ss += v[i] * v[i];
#pragma unroll
                for (int o = 32; o >= 1; o >>= 1) ss += __shfl_xor(ss, o);
                const float rstd = rsqrtf(ss * (1.0f / QLORA) + EPSN);
#pragma unroll
                for (int c = 0; c < 3; ++c) { const float* g = P.mla_q_a_norm + (c * 64 + lane) * 8; const f32x4 g0 = *(const f32x4*)g, g1 = *(const f32x4*)(g + 4); u32x4 w;
                    w.x = pk2(v[c * 8 + 0] * rstd * g0[0], v[c * 8 + 1] * rstd * g0[1]); w.y = pk2(v[c * 8 + 2] * rstd * g0[2], v[c * 8 + 3] * rstd * g0[3]);
                    w.z = pk2(v[c * 8 + 4] * rstd * g1[0], v[c * 8 + 5] * rstd * g1[1]); w.w = pk2(v[c * 8 + 6] * rstd * g1[2], v[c * 8 + 7] * rstd * g1[3]);
                    *(u32x4*)(CQN + (size_t)tok * QLORA + (c * 64 + lane) * 8) = w; }
            }
            {
                float v[8]; float ss = 0.f; const u32x4 w0 = wk[t];
                v[0] = bflo(w0.x); v[1] = bfhi(w0.x); v[2] = bflo(w0.y); v[3] = bfhi(w0.y); v[4] = bflo(w0.z); v[5] = bfhi(w0.z); v[6] = bflo(w0.w); v[7] = bfhi(w0.w);
#pragma unroll
                for (int i = 0; i < 8; ++i) ss += v[i] * v[i];
#pragma unroll
                for (int o = 32; o >= 1; o >>= 1) ss += __shfl_xor(ss, o);
                const float rstd = rsqrtf(ss * (1.0f / KVLORA) + EPSN);
                const float* g = P.mla_kv_a_norm + lane * 8; const f32x4 g0 = *(const f32x4*)g, g1 = *(const f32x4*)(g + 4); u32x4 w;
                w.x = pk2(v[0] * rstd * g0[0], v[1] * rstd * g0[1]); w.y = pk2(v[2] * rstd * g0[2], v[3] * rstd * g0[3]);
                w.z = pk2(v[4] * rstd * g1[0], v[5] * rstd * g1[1]); w.w = pk2(v[6] * rstd * g1[2], v[7] * rstd * g1[3]);
                *(u32x4*)(CKVN + (size_t)tok * KVLORA + lane * 8) = w;
            }
            {
                const int i = lane & 31;
                const float invf = exp2f(-(float)i * (13.287712379549449f / 32.0f));
                const float ang = (float)pos[t] * invf;
                const double rev = (double)ang * 0.15915494309189533576888;
                const float fr = (float)(rev - __builtin_rint(rev));
                const float sn = __builtin_amdgcn_sinf(fr), cs = __builtin_amdgcn_cosf(fr);
                const float x1 = bf1(kp1[t]), x2 = bf1(kp2[t]);
                float ssp = x1 * x1 + x2 * x2;
#pragma unroll
                for (int o = 16; o >= 1; o >>= 1) ssp += __shfl_xor(ssp, o);
                const float a = x1 * P.mla_k_norm[128 + i], c = x2 * P.mla_k_norm[160 + i];
                if (lane < 32) { ROPE[(size_t)tok * 64 + i] = cs; ROPE[(size_t)tok * 64 + 32 + i] = sn;
                    KPER[(size_t)tok * 64 + i] = a * cs - c * sn; KPER[(size_t)tok * 64 + 32 + i] = c * cs + a * sn;
                    if (lane == 0) SSPE[tok] = ssp; }
            }
        }
    }
}

DI void phase_mla_prep2(const Params& P, int bid, int nb) {
    const bf16_t* KNM = (const bf16_t*)(P.ws + OFF_KNM); const bf16_t* Y1 = (const bf16_t*)(P.ws + OFF_Y1);
    bf16_t* KM = (bf16_t*)(P.ws + OFF_KM); const float* ROPE = (const float*)(P.ws + OFF_ROPE);
    const int tid = tid_opaque(), grp = tid >> 3, j8 = tid & 7;
    for (int tok = bid; tok < MTOK; tok += nb) {
        const int b = tok / SEQ, s = tok % SEQ;
        float cs[8], sn[8];
#pragma unroll
        for (int e = 0; e < 8; ++e) { const int i = (8 * j8 + e) & 31; cs[e] = ROPE[(size_t)tok * 64 + i]; sn[e] = ROPE[(size_t)tok * 64 + 32 + i]; }
        {
            const bf16_t* kn = KNM + (size_t)tok * (NH * 128) + grp * 128;
            const bf16_t* kp = Y1 + (size_t)tok * N3P + C3_KPE;
            float v[24];
#pragma unroll
            for (int c = 0; c < 2; ++c) { const u32x4 w = *(const u32x4*)(kn + (j8 + 8 * c) * 8);
                v[c * 8 + 0] = bflo(w.x); v[c * 8 + 1] = bfhi(w.x); v[c * 8 + 2] = bflo(w.y); v[c * 8 + 3] = bfhi(w.y);
                v[c * 8 + 4] = bflo(w.z); v[c * 8 + 5] = bfhi(w.z); v[c * 8 + 6] = bflo(w.w); v[c * 8 + 7] = bfhi(w.w); }
            { const u32x4 w = *(const u32x4*)(kp + j8 * 8);
                v[16] = bflo(w.x); v[17] = bfhi(w.x); v[18] = bflo(w.y); v[19] = bfhi(w.y); v[20] = bflo(w.z); v[21] = bfhi(w.z); v[22] = bflo(w.w); v[23] = bfhi(w.w); }
            float ss = 0.f;
#pragma unroll
            for (int i = 0; i < 24; ++i) ss += v[i] * v[i];
            ss = sum8(ss);
            const float rstd = rsqrtf(ss * (1.0f / DK) + EPSN);
#pragma unroll
            for (int c = 0; c < 3; ++c)
#pragma unroll
                for (int e = 0; e < 8; ++e) v[c * 8 + e] *= rstd * P.mla_k_norm[(j8 + 8 * c) * 8 + e];
#pragma unroll
            for (int e = 0; e < 8; ++e) { const float mine = v[16 + e], other = __shfl_xor(mine, 4);
                v[16 + e] = (j8 < 4) ? (mine * cs[e] - other * sn[e]) : (mine * cs[e] + other * sn[e]); }
            st192(KM + ((size_t)(b * NH + grp) * SEQ + s) * DK, j8, v);
        }
    }
}
#ifndef PROBE_TOPK
#define PROBE_TOPK 1
#endif
#ifndef PROBE_EPI
#define PROBE_EPI 1
#endif
#ifndef NO_CMP1
#define NO_CMP1 0
#endif
#ifndef NO_CMP2
#define NO_CMP2 0
#endif
#ifndef NO_SEL
#define NO_SEL 0
#endif
#ifndef NO_WIN
#define NO_WIN 0
#endif
#ifndef PROBE_SEL2
#define PROBE_SEL2 0
#endif
#ifndef PROBE_WIN2
#define PROBE_WIN2 0
#endif
#ifndef ATT_THR
#define ATT_THR 30.0f
#endif
#ifndef ATT_PS_LIMIT
#define ATT_PS_LIMIT (16.0f * 1073741824.0f)
#endif
#ifndef ATT_DEP_MLA
#define ATT_DEP_MLA 5
#endif
#ifndef ATT_DEP_NSA
#define ATT_DEP_NSA 4
#endif
#ifndef ATT_PRE_NSA
#define ATT_PRE_NSA 1
#endif
#ifndef ATT_SETPRIO
#define ATT_SETPRIO 0
#endif
#ifndef ATT_SPLIT_MLA
#define ATT_SPLIT_MLA 0
#endif
#ifndef ATT_SPLIT_NSA
#define ATT_SPLIT_NSA 0
#endif
#ifndef ATT_KA_NSA
#define ATT_KA_NSA 2
#endif
constexpr int KT_BYTES = 64 * 384, VT_BYTES = 128 * 128;
constexpr int L_K = 0, L_V = 2 * KT_BYTES, L_LUT = L_V + 2 * VT_BYTES, LUT_PITCH = 129, L_X = L_LUT + 64 * LUT_PITCH * 4 + 16  , L_IL = L_X + 16 * 16 * 64 * 2, L_END = L_IL + 16 * 16 * 4, L_QS = L_X, L_P3 = L_X + 16 * 64 * 4;
static_assert(L_END <= 151552, "attention LDS");
enum { MODE_MLA = 0, MODE_CMP1 = 1, MODE_CMP2 = 2, MODE_SEL = 3, MODE_WIN = 4, MODE_CMPX = 5 };
#define MFMA32(a, b, c) __builtin_amdgcn_mfma_f32_32x32x16_bf16((a), (b), (c), 0, 0, 0)

struct AttnLane {
    int tq;
    int tw0, tw1;
    const LAS float* lutrow;
    float lut_far;
    unsigned long long mk0, mk1;
    int tk;
    int curblk;
    float inv_l;
    int tokidx;
    mutable float carry;
};

template <int MODE> DI bool tile_act(int j, const AttnLane& A) {
    if (MODE == MODE_MLA) return 64 * j <= A.tw1;
    else if (MODE == MODE_CMP1 || MODE == MODE_CMP2 || MODE == MODE_CMPX) return 1024 * j + 31 <= A.tw1;
    else if (MODE == MODE_SEL) return (((A.mk0 | A.mk1) >> j) & 1ull) != 0ull;
    else return (64 * j <= A.tw1) && (64 * j + 63 >= A.tw0 - 511);
}

template <int MODE, int H>
DI bool half_init(f32x16& p, int j, int hi, float m_run, const AttnLane& A) {
    if (MODE == MODE_MLA) {
#pragma unroll
        for (int r = 0; r < 16; ++r) p[r] = 0.f;
        return true;
    } else if (MODE == MODE_WIN || MODE == MODE_SEL) {
        const int dq = A.tq - 64 * j - 32 * H - 4 * hi;
        const bool far = (A.tw0 - (64 * j + 32 * H + 31) >= 113);
        if (far) {
#pragma unroll
            for (int r = 0; r < 16; ++r) p[r] = 0.f;
            return true;
        } else {
#pragma unroll
            for (int r = 0; r < 16; ++r) { int d = dq - ((r & 3) + 8 * (r >> 2)); d = d < 0 ? 0 : (d > 127 ? 127 : d); p[r] = A.lutrow[d] - m_run; }
            return false;
        }
    } else {
        const int dq = A.tq - 31 - 1024 * j - 512 * H - 64 * hi;
        const bool far = (A.tw0 - 31 - 16 * (64 * j + 32 * H + 31) >= 113);
        if (far) {
#pragma unroll
            for (int r = 0; r < 16; ++r) p[r] = 0.f;
            return true;
        } else {
#pragma unroll
            for (int r = 0; r < 16; ++r) { int d = dq - 16 * ((r & 3) + 8 * (r >> 2)); d = d < 0 ? 0 : (d > 127 ? 127 : d); p[r] = A.lutrow[d] - m_run; }
            return false;
        }
    }
}
DI void half_fix(f32x16& p, bool zero_init, float m_run) {
    if (zero_init && __any(m_run != 0.f)) {
#pragma unroll
        for (int r = 0; r < 16; ++r) p[r] -= m_run;
    }
}
template <int MODE, int H>
DI void half_mask(f32x16& p, int j, int hi, const AttnLane& A) {
    const float NEG = -__builtin_inff();
    if (MODE == MODE_MLA) {
        if (64 * j + 32 * H + 31 > A.tw0) {
            const int dq = A.tq - 64 * j - 32 * H - 4 * hi;
#pragma unroll
            for (int r = 0; r < 16; ++r) p[r] = (dq - ((r & 3) + 8 * (r >> 2)) < 0) ? NEG : p[r];
        }
    } else if (MODE == MODE_WIN) {
        const int k0 = 64 * j + 32 * H;
        if (!(k0 + 31 <= A.tw0 && k0 >= A.tw1 - 511)) {
            const int dq = A.tq - k0 - 4 * hi;
#pragma unroll
            for (int r = 0; r < 16; ++r) p[r] = ((unsigned)(dq - ((r & 3) + 8 * (r >> 2))) >= 512u) ? NEG : p[r];
        }
    } else if (MODE == MODE_SEL) {
        if (j == A.curblk) {
            const int dq = A.tq - 64 * j - 32 * H - 4 * hi;
#pragma unroll
            for (int r = 0; r < 16; ++r) p[r] = (dq - ((r & 3) + 8 * (r >> 2)) < 0) ? NEG : p[r];
        }
    } else {
        if (A.tw0 - 31 - 16 * (64 * j + 32 * H + 31) < 0) {
            const int dq = A.tq - 31 - 1024 * j - 512 * H - 64 * hi;
#pragma unroll
            for (int r = 0; r < 16; ++r) p[r] = (dq - 16 * ((r & 3) + 8 * (r >> 2)) < 0) ? NEG : p[r];
        }
    }
}
template <int MODE>
DI void sel_zero(u32x4& wa, u32x4& wb, float& ps, int j, const AttnLane& A) {
    if (MODE == MODE_SEL) {
        const bool s0_ = ((A.mk0 >> j) & 1ull) != 0ull, s1_ = ((A.mk1 >> j) & 1ull) != 0ull; const bool sel = A.tk ? s1_ : s0_;
        const unsigned msk = sel ? 0xffffffffu : 0u;
        wa.x &= msk; wa.y &= msk; wa.z &= msk; wa.w &= msk; wb.x &= msk; wb.y &= msk; wb.z &= msk; wb.w &= msk;
        ps = sel ? ps : 0.f;
    }
}
template <int H, int DEP>
DI void half_qk(f32x16& p, const LAS unsigned char* kb, const int (&kbase)[4], const bf16x8 (&q)[12]) {
    bf16x8 f[DEP + 1];
#pragma unroll
    for (int d0 = 0; d0 < DEP; ++d0) f[d0] = *(const LAS bf16x8*)(kb + kbase[d0 & 3] + (d0 >> 2) * 128 + H * (32 * 384));
    __builtin_amdgcn_sched_barrier(0);
#pragma unroll
    for (int d0 = 0; d0 < 12; ++d0) {
        if (d0 + DEP < 12) { const int dn = d0 + DEP; f[dn % (DEP + 1)] = *(const LAS bf16x8*)(kb + kbase[dn & 3] + (dn >> 2) * 128 + H * (32 * 384)); }
        __builtin_amdgcn_sched_barrier(0);
        p = MFMA32(f[d0 % (DEP + 1)], q[d0], p);
        __builtin_amdgcn_sched_barrier(0);
    }
}
DI unsigned sm_pair(const f32x16& p, int e0, float& ps, float& mx) {
    const float a = __builtin_amdgcn_exp2f(p[e0]), b = __builtin_amdgcn_exp2f(p[e0 + 1]);
    ps += a + b; (void)mx;
    return pk2(a, b);
}
template <bool HASV>
DI void half_exact(f32x16& p, f32x16* pend, f32x16 (&o)[4], float& m_run, float& l_run, u32x4& wa, u32x4& wb, float& ps) {
    float mx = p[0];
#pragma unroll
    for (int r = 1; r < 16; ++r) mx = fmaxf(mx, p[r]);
    mx = fmaxf(mx, __shfl_xor(mx, 32));
    const float dl = fmaxf(mx, 0.f);
    const float alpha = __builtin_amdgcn_exp2f(-dl);
    m_run += dl; l_run *= alpha;
    if (HASV) {
#pragma unroll
        for (int d = 0; d < 4; ++d)
#pragma unroll
            for (int r = 0; r < 16; ++r) o[d][r] *= alpha;
    }
    if (pend) {
#pragma unroll
        for (int r = 0; r < 16; ++r) (*pend)[r] -= dl;
    }
    ps = 0.f; float dm = 0.f;
#pragma unroll
    for (int r = 0; r < 16; ++r) p[r] -= dl;
    wa.x = sm_pair(p, 0, ps, dm); wa.y = sm_pair(p, 2, ps, dm); wa.z = sm_pair(p, 4, ps, dm); wa.w = sm_pair(p, 6, ps, dm);
    wb.x = sm_pair(p, 8, ps, dm); wb.y = sm_pair(p, 10, ps, dm); wb.z = sm_pair(p, 12, ps, dm); wb.w = sm_pair(p, 14, ps, dm);
}

template <int MODE>
DI void attn_tile2(const LAS unsigned char* kb, const LAS unsigned char* vb, LAS unsigned char* lds, int j, int lane, const bf16x8 (&q)[12],
                   f32x16 (&o)[4], float& m_run, float& l_run, const AttnLane& A) {
    constexpr bool HASV = (MODE != MODE_CMP1);
    constexpr int DEP = (MODE == MODE_MLA) ? ATT_DEP_MLA : ATT_DEP_NSA;
    const int hi = lane >> 5, r32 = lane & 31;
    int kbase[4], vbase[4];
#pragma unroll
    for (int dd = 0; dd < 4; ++dd) { kbase[dd] = r32 * 384 + (((2 * dd + hi) ^ ((r32 >> 1) & 7)) << 4); vbase[dd] = r32 * 128 + (((2 * dd + hi) ^ ((r32 >> 1) & 7)) << 4); }
    f32x16 p0, p1;
    if (MODE == MODE_CMPX) {
        const bool z0_ = half_init<MODE, 0>(p0, j, hi, m_run, A), z1_ = half_init<MODE, 1>(p1, j, hi, m_run, A);
        {
            constexpr int KA = ATT_KA_NSA;
            bf16x8 fa[KA + 1], fb[KA + 1];
#pragma unroll
            for (int d0 = 0; d0 < KA; ++d0) { const LAS unsigned char* a_ = kb + kbase[d0 & 3] + (d0 >> 2) * 128; fa[d0] = *(const LAS bf16x8*)a_; fb[d0] = *(const LAS bf16x8*)(a_ + 32 * 384); }
            __builtin_amdgcn_sched_barrier(0);
#pragma unroll
            for (int d0 = 0; d0 < 12; ++d0) {
                if (d0 + KA < 12) { const int dn = d0 + KA; const LAS unsigned char* a_ = kb + kbase[dn & 3] + (dn >> 2) * 128;
                    fa[dn % (KA + 1)] = *(const LAS bf16x8*)a_; fb[dn % (KA + 1)] = *(const LAS bf16x8*)(a_ + 32 * 384); }
                __builtin_amdgcn_sched_barrier(0);
                p0 = MFMA32(fa[d0 % (KA + 1)], q[d0], p0);
                p1 = MFMA32(fb[d0 % (KA + 1)], q[d0], p1);
                __builtin_amdgcn_sched_barrier(0);
            }
        }
        half_fix(p0, z0_, m_run); half_fix(p1, z1_, m_run);
        half_mask<MODE, 0>(p0, j, hi, A); half_mask<MODE, 1>(p1, j, hi, A);
        LAS bf16_t* X = (LAS bf16_t*)(lds + L_X) + (A.tokidx * 16 + (lane & 15)) * 64;
#pragma unroll
        for (int h = 0; h < 2; ++h) {
            f32x16& p = h ? p1 : p0;
            float lmx = p[0];
#pragma unroll
            for (int r = 1; r < 16; ++r) lmx = fmaxf(lmx, p[r]);
            if (__any(lmx > ATT_THR)) {
                const float mx = fmaxf(lmx, __shfl_xor(lmx, 32));
                const float dl = fmaxf(mx, 0.f), alpha = __builtin_amdgcn_exp2f(-dl);
                m_run += dl; l_run *= alpha; A.carry *= alpha;
#pragma unroll
                for (int d = 0; d < 4; ++d)
#pragma unroll
                    for (int r = 0; r < 16; ++r) o[d][r] *= alpha;
#pragma unroll
                for (int r = 0; r < 16; ++r) p[r] -= dl;
                if (h == 0) {
#pragma unroll
                    for (int r = 0; r < 16; ++r) p1[r] -= dl;
                }
                const int qb = 16 * j + 8 * h;
                for (int a = hi; a < qb; a += 2) X[a] = (bf16_t)(pk2(bf1(X[a]) * alpha, 0.f) & 0xffffu);
            }
            float e[16]; float ps = 0.f;
#pragma unroll
            for (int r = 0; r < 16; ++r) { e[r] = __builtin_amdgcn_exp2f(p[r]); ps += e[r]; }
            l_run += ps;
            float y[4];
#pragma unroll
            for (int k = 0; k < 4; ++k) y[k] = __shfl_xor(e[4 * k + 3], 32);
#pragma unroll
            for (int k = 0; k < 4; ++k) { const float prev = hi ? y[k] : (k ? y[k > 0 ? k - 1 : 0] : A.carry);
                const float sblk = (e[4 * k] + e[4 * k + 1]) + (e[4 * k + 2] + e[4 * k + 3]) + prev;
                X[16 * j + 8 * h + 2 * k + hi] = (bf16_t)(pk2(sblk, 0.f) & 0xffffu); }
            if (!hi) A.carry = y[3];
            u32x4 wa, wb;
            wa.x = pk2(e[0], e[1]); wa.y = pk2(e[2], e[3]); wa.z = pk2(e[4], e[5]); wa.w = pk2(e[6], e[7]);
            wb.x = pk2(e[8], e[9]); wb.y = pk2(e[10], e[11]); wb.z = pk2(e[12], e[13]); wb.w = pk2(e[14], e[15]);
            const bf16x8 pba = __builtin_bit_cast(bf16x8, wa), pbb = __builtin_bit_cast(bf16x8, wb);
#pragma unroll
            for (int i = 0; i < 8; ++i) { const bf16x8 va = *(const LAS bf16x8*)(vb + vbase[2 * h + (i >> 2)] + (i & 3) * (32 * 128)); o[i & 3] = MFMA32(va, (i < 4) ? pba : pbb, o[i & 3]); }
        }
        return;
    }
    if (MODE == MODE_CMP2) {
        { const bool z_ = half_init<MODE, 0>(p0, j, hi, m_run, A); half_qk<0, DEP>(p0, kb, kbase, q); half_fix(p0, z_, m_run); half_mask<MODE, 0>(p0, j, hi, A); }
        { const bool z_ = half_init<MODE, 1>(p1, j, hi, m_run, A); half_qk<1, DEP>(p1, kb, kbase, q); half_fix(p1, z_, m_run); half_mask<MODE, 1>(p1, j, hi, A); }
        const float il = A.inv_l;
#pragma unroll
        for (int r = 0; r < 16; ++r) { p0[r] = __builtin_amdgcn_exp2f(p0[r]) * il; p1[r] = __builtin_amdgcn_exp2f(p1[r]) * il; }
        float v[16];
#pragma unroll
        for (int k = 0; k < 4; ++k) { v[k] = (p0[4 * k] + p0[4 * k + 1]) + (p0[4 * k + 2] + p0[4 * k + 3]); v[4 + k] = (p1[4 * k] + p1[4 * k + 1]) + (p1[4 * k + 2] + p1[4 * k + 3]);
            v[8 + k] = p0[4 * k + 3]; v[12 + k] = p1[4 * k + 3]; }
        { const bool up = (lane & 8) != 0;
#pragma unroll
          for (int i = 0; i < 8; ++i) { const float send = up ? v[i] : v[i + 8]; const float recv = __shfl_xor(send, 8); const float keep = up ? v[i + 8] : v[i]; v[i] = keep + recv; } }
        { const bool up = (lane & 4) != 0;
#pragma unroll
          for (int i = 0; i < 4; ++i) { const float send = up ? v[i] : v[i + 4]; const float recv = __shfl_xor(send, 4); const float keep = up ? v[i + 4] : v[i]; v[i] = keep + recv; } }
        { const bool up = (lane & 2) != 0;
#pragma unroll
          for (int i = 0; i < 2; ++i) { const float send = up ? v[i] : v[i + 2]; const float recv = __shfl_xor(send, 2); const float keep = up ? v[i + 2] : v[i]; v[i] = keep + recv; } }
        { const bool up = (lane & 1) != 0;
          const float send = up ? v[0] : v[1]; const float recv = __shfl_xor(send, 1); const float keep = up ? v[1] : v[0]; v[0] = keep + recv; }
        { const int idx = lane & 15, half = (idx >> 2) & 1, k = idx & 3, isp3 = idx >> 3;
          const int quad = 16 * j + 8 * half + 2 * k + hi;
          LAS float* dst = (LAS float*)(lds + (isp3 ? L_P3 : L_QS)) + A.tokidx * 64 + quad;
          *dst = v[0]; }
#pragma unroll
        for (int ks = 0; ks < 4; ++ks) {
            u32x4 w;
            if (ks == 0) { w.x = pk2(p0[0], p0[1]); w.y = pk2(p0[2], p0[3]); w.z = pk2(p0[4], p0[5]); w.w = pk2(p0[6], p0[7]); }
            else if (ks == 1) { w.x = pk2(p0[8], p0[9]); w.y = pk2(p0[10], p0[11]); w.z = pk2(p0[12], p0[13]); w.w = pk2(p0[14], p0[15]); }
            else if (ks == 2) { w.x = pk2(p1[0], p1[1]); w.y = pk2(p1[2], p1[3]); w.z = pk2(p1[4], p1[5]); w.w = pk2(p1[6], p1[7]); }
            else { w.x = pk2(p1[8], p1[9]); w.y = pk2(p1[10], p1[11]); w.z = pk2(p1[12], p1[13]); w.w = pk2(p1[14], p1[15]); }
            const bf16x8 pb = __builtin_bit_cast(bf16x8, w);
#pragma unroll
            for (int d = 0; d < 4; ++d) { const bf16x8 va = *(const LAS bf16x8*)(vb + vbase[ks] + d * (32 * 128)); o[d] = MFMA32(va, pb, o[d]); }
        }
        return;
    }
    u32x4 wa, wb; float ps = 0.f, mx = -__builtin_inff();
    if ((MODE == MODE_MLA && ATT_SPLIT_MLA) || (MODE != MODE_MLA && ATT_SPLIT_NSA)) {
    { const bool z_ = half_init<MODE, 0>(p0, j, hi, m_run, A);
    half_qk<0, DEP>(p0, kb, kbase, q);
    half_fix(p0, z_, m_run); }
    half_mask<MODE, 0>(p0, j, hi, A);
    const bool zs1_ = half_init<MODE, 1>(p1, j, hi, m_run, A);
    {
        bf16x8 f[DEP + 1];
#pragma unroll
        for (int d0 = 0; d0 < DEP; ++d0) f[d0] = *(const LAS bf16x8*)(kb + kbase[d0 & 3] + (d0 >> 2) * 128 + 32 * 384);
        __builtin_amdgcn_sched_barrier(0);
#pragma unroll
        for (int d0 = 0; d0 < 12; ++d0) {
            if (d0 + DEP < 12) { const int dn = d0 + DEP; f[dn % (DEP + 1)] = *(const LAS bf16x8*)(kb + kbase[dn & 3] + (dn >> 2) * 128 + 32 * 384); }
            __builtin_amdgcn_sched_barrier(0);
            p1 = MFMA32(f[d0 % (DEP + 1)], q[d0], p1);
            if (d0 == 0) wa.x = sm_pair(p0, 0, ps, mx); else if (d0 == 1) wa.y = sm_pair(p0, 2, ps, mx); else if (d0 == 2) wa.z = sm_pair(p0, 4, ps, mx); else if (d0 == 3) wa.w = sm_pair(p0, 6, ps, mx);
            else if (d0 == 4) wb.x = sm_pair(p0, 8, ps, mx); else if (d0 == 5) wb.y = sm_pair(p0, 10, ps, mx); else if (d0 == 6) wb.z = sm_pair(p0, 12, ps, mx); else if (d0 == 7) wb.w = sm_pair(p0, 14, ps, mx);
            __builtin_amdgcn_sched_barrier(0);
        }
    }
    half_fix(p1, zs1_, m_run);
    } else {
    const bool zc0_ = half_init<MODE, 0>(p0, j, hi, m_run, A);
    const bool zc1_ = half_init<MODE, 1>(p1, j, hi, m_run, A);
    {
        constexpr int KA = ATT_KA_NSA;
        bf16x8 fa[KA + 1], fb[KA + 1];
#pragma unroll
        for (int d0 = 0; d0 < KA; ++d0) { const LAS unsigned char* a_ = kb + kbase[d0 & 3] + (d0 >> 2) * 128; fa[d0] = *(const LAS bf16x8*)a_; fb[d0] = *(const LAS bf16x8*)(a_ + 32 * 384); }
        __builtin_amdgcn_sched_barrier(0);
#pragma unroll
        for (int d0 = 0; d0 < 12; ++d0) {
            if (d0 + KA < 12) { const int dn = d0 + KA; const LAS unsigned char* a_ = kb + kbase[dn & 3] + (dn >> 2) * 128;
                fa[dn % (KA + 1)] = *(const LAS bf16x8*)a_; fb[dn % (KA + 1)] = *(const LAS bf16x8*)(a_ + 32 * 384); }
            __builtin_amdgcn_sched_barrier(0);
            if (ATT_SETPRIO) __builtin_amdgcn_s_setprio(1);
            p0 = MFMA32(fa[d0 % (KA + 1)], q[d0], p0);
            p1 = MFMA32(fb[d0 % (KA + 1)], q[d0], p1);
            if (ATT_SETPRIO) __builtin_amdgcn_s_setprio(0);
            __builtin_amdgcn_sched_barrier(0);
        }
    }
    half_fix(p0, zc0_, m_run); half_fix(p1, zc1_, m_run);
    half_mask<MODE, 0>(p0, j, hi, A);
    wa.x = sm_pair(p0, 0, ps, mx); wa.y = sm_pair(p0, 2, ps, mx); wa.z = sm_pair(p0, 4, ps, mx); wa.w = sm_pair(p0, 6, ps, mx);
    wb.x = sm_pair(p0, 8, ps, mx); wb.y = sm_pair(p0, 10, ps, mx); wb.z = sm_pair(p0, 12, ps, mx); wb.w = sm_pair(p0, 14, ps, mx);
    }
    half_mask<MODE, 1>(p1, j, hi, A);
    if (__any(!(ps <= ATT_PS_LIMIT))) {
        half_exact<HASV>(p0, &p1, o, m_run, l_run, wa, wb, ps);
    }
    sel_zero<MODE>(wa, wb, ps, j, A);
    l_run += ps;
    u32x4 wc, wd; float ps1 = 0.f, mx1 = -__builtin_inff();
    if (HASV) {
        const bf16x8 pba = __builtin_bit_cast(bf16x8, wa), pbb = __builtin_bit_cast(bf16x8, wb);
        bf16x8 f[DEP + 1];
#pragma unroll
        for (int i = 0; i < DEP; ++i) f[i] = *(const LAS bf16x8*)(vb + vbase[i >> 2] + (i & 3) * (32 * 128));
        __builtin_amdgcn_sched_barrier(0);
#pragma unroll
        for (int i = 0; i < 8; ++i) {
            if (i + DEP < 8) { const int in_ = i + DEP; f[in_ % (DEP + 1)] = *(const LAS bf16x8*)(vb + vbase[in_ >> 2] + (in_ & 3) * (32 * 128)); }
            __builtin_amdgcn_sched_barrier(0);
            if (ATT_SETPRIO) __builtin_amdgcn_s_setprio(1);
            o[i & 3] = MFMA32(f[i % (DEP + 1)], (i < 4) ? pba : pbb, o[i & 3]);
            if (ATT_SETPRIO) __builtin_amdgcn_s_setprio(0);
            if (i == 0) wc.x = sm_pair(p1, 0, ps1, mx1); else if (i == 1) wc.y = sm_pair(p1, 2, ps1, mx1); else if (i == 2) wc.z = sm_pair(p1, 4, ps1, mx1); else if (i == 3) wc.w = sm_pair(p1, 6, ps1, mx1);
            else if (i == 4) wd.x = sm_pair(p1, 8, ps1, mx1); else if (i == 5) wd.y = sm_pair(p1, 10, ps1, mx1); else if (i == 6) wd.z = sm_pair(p1, 12, ps1, mx1); else wd.w = sm_pair(p1, 14, ps1, mx1);
            __builtin_amdgcn_sched_barrier(0);
        }
    } else {
        wc.x = sm_pair(p1, 0, ps1, mx1); wc.y = sm_pair(p1, 2, ps1, mx1); wc.z = sm_pair(p1, 4, ps1, mx1); wc.w = sm_pair(p1, 6, ps1, mx1);
        wd.x = sm_pair(p1, 8, ps1, mx1); wd.y = sm_pair(p1, 10, ps1, mx1); wd.z = sm_pair(p1, 12, ps1, mx1); wd.w = sm_pair(p1, 14, ps1, mx1);
    }
    if (__any(!(ps1 <= ATT_PS_LIMIT))) {
        half_exact<HASV>(p1, nullptr, o, m_run, l_run, wc, wd, ps1);
    }
    sel_zero<MODE>(wc, wd, ps1, j, A);
    l_run += ps1;
    if (HASV) {
        const bf16x8 pbc = __builtin_bit_cast(bf16x8, wc), pbd = __builtin_bit_cast(bf16x8, wd);
        bf16x8 f[DEP + 1];
#pragma unroll
        for (int i = 0; i < DEP; ++i) f[i] = *(const LAS bf16x8*)(vb + vbase[2 + (i >> 2)] + (i & 3) * (32 * 128));
        __builtin_amdgcn_sched_barrier(0);
#pragma unroll
        for (int i = 0; i < 8; ++i) {
            if (i + DEP < 8) { const int in_ = i + DEP; f[in_ % (DEP + 1)] = *(const LAS bf16x8*)(vb + vbase[2 + (in_ >> 2)] + (in_ & 3) * (32 * 128)); }
            __builtin_amdgcn_sched_barrier(0);
            if (ATT_SETPRIO) __builtin_amdgcn_s_setprio(1);
            o[i & 3] = MFMA32(f[i % (DEP + 1)], (i < 4) ? pbc : pbd, o[i & 3]);
            if (ATT_SETPRIO) __builtin_amdgcn_s_setprio(0);
            __builtin_amdgcn_sched_barrier(0);
        }
    }
}

template <int MODE>
DI void attn_pass2(LAS unsigned char* lds, const char* __restrict__ Kc, const char* __restrict__ Vc, int vt_stride, int j_lo, int j_hi,
                   const bf16x8 (&q)[12], f32x16 (&o)[4], float& m_run, float& l_run, const AttnLane& A) {
    if (j_lo >= j_hi) return;
    constexpr bool HASV = (MODE != MODE_CMP1);
    int tid = threadIdx.x; asm volatile("" : "+v"(tid));
    const int lane = tid & 63;
    const int wid_ = __builtin_amdgcn_readfirstlane(tid >> 6);
    constexpr bool PRE = (MODE == MODE_MLA) || ATT_PRE_NSA;
    unsigned kgo[3], vgo[2];
    if (PRE) {
#pragma unroll
        for (int i_ = 0; i_ < 3; ++i_) { const int pidx_ = (wid_ * 3 + i_) * 64 + lane, row_ = pidx_ / 24, cp_ = pidx_ % 24; kgo[i_] = (unsigned)(row_ * 384 + ((cp_ ^ ((row_ >> 1) & 7)) << 4)); }
#pragma unroll
        for (int i_ = 0; i_ < 2; ++i_) { const int pidx_ = (wid_ * 2 + i_) * 64 + lane, row_ = pidx_ >> 3, cp_ = pidx_ & 7; vgo[i_] = (unsigned)(row_ * vt_stride * 2 + ((cp_ ^ ((row_ >> 1) & 7)) << 4)); }
    }
#define ST_ISSUE(j, buf) do { int ln_ = lane; if (!PRE) asm volatile("" : "+v"(ln_)); \
        const char* kp_ = Kc + (size_t)(j) * KT_BYTES; LAS unsigned char* kb_ = lds + L_K + (buf) * KT_BYTES + wid_ * 3072; \
        _Pragma("unroll") for (int i_ = 0; i_ < 3; ++i_) { unsigned so_; if (PRE) so_ = kgo[i_]; else { const int pidx_ = (wid_ * 3 + i_) * 64 + ln_, row_ = pidx_ / 24, cp_ = pidx_ % 24; so_ = (unsigned)(row_ * 384 + ((cp_ ^ ((row_ >> 1) & 7)) << 4)); } \
            __builtin_amdgcn_global_load_lds((const unsigned*)(kp_ + so_), (LAS unsigned*)(kb_ + i_ * 1024), 16, 0, 0); } \
        if (HASV) { const char* vp_ = Vc + (size_t)(j) * 128; LAS unsigned char* vb_ = lds + L_V + (buf) * VT_BYTES + wid_ * 2048; \
            _Pragma("unroll") for (int i_ = 0; i_ < 2; ++i_) { unsigned so_; if (PRE) so_ = vgo[i_]; else { const int pidx_ = (wid_ * 2 + i_) * 64 + ln_, row_ = pidx_ >> 3, cp_ = pidx_ & 7; so_ = (unsigned)(row_ * vt_stride * 2 + ((cp_ ^ ((row_ >> 1) & 7)) << 4)); } \
                __builtin_amdgcn_global_load_lds((const unsigned*)(vp_ + so_), (LAS unsigned*)(vb_ + i_ * 1024), 16, 0, 0); } } } while (0)
    ST_ISSUE(j_lo, 0);
    asm volatile("s_waitcnt vmcnt(0)" ::: "memory");
    __syncthreads();
    for (int j = j_lo; j < j_hi; ++j) {
        const int cur = (j - j_lo) & 1;
        if (j + 1 < j_hi) ST_ISSUE(j + 1, cur ^ 1);
        if (tile_act<MODE>(j, A)) attn_tile2<MODE>(lds + L_K + cur * KT_BYTES, lds + L_V + cur * VT_BYTES, lds, j, lane, q, o, m_run, l_run, A);
        asm volatile("s_waitcnt vmcnt(0)" ::: "memory");
        __syncthreads();
    }
#undef ST_ISSUE
}

template <int MODE>
DI void attn_pass3(LAS unsigned char* lds, const char* __restrict__ Kc, const char* __restrict__ Vc, int vt_stride, int j_lo, int j_hi,
                   const bf16x8 (&q)[12], f32x16 (&o)[4], float& m_run, float& l_run, const AttnLane& A) {
    if (j_lo >= j_hi) return;
    constexpr bool HASV = (MODE != MODE_CMP1);
    constexpr int L3_V = 3 * KT_BYTES;
    int tid = threadIdx.x; asm volatile("" : "+v"(tid));
    const int lane = tid & 63;
    const int wid_ = __builtin_amdgcn_readfirstlane(tid >> 6);
    const int T = j_hi - j_lo;
#define ST3_ISSUE(j, slot) do { int ln_ = lane; asm volatile("" : "+v"(ln_)); \
        const char* kp_ = Kc + (size_t)(j) * KT_BYTES; LAS unsigned char* kb_ = lds + (slot) * KT_BYTES + wid_ * 3072; \
        _Pragma("unroll") for (int i_ = 0; i_ < 3; ++i_) { const int pidx_ = (wid_ * 3 + i_) * 64 + ln_, row_ = pidx_ / 24, cp_ = pidx_ % 24; \
            __builtin_amdgcn_global_load_lds((const unsigned*)(kp_ + (unsigned)(row_ * 384 + ((cp_ ^ ((row_ >> 1) & 7)) << 4))), (LAS unsigned*)(kb_ + i_ * 1024), 16, 0, 0); } \
        if (HASV) { const char* vp_ = Vc + (size_t)(j) * 128; LAS unsigned char* vb_ = lds + L3_V + (slot) * VT_BYTES + wid_ * 2048; \
            _Pragma("unroll") for (int i_ = 0; i_ < 2; ++i_) { const int pidx_ = (wid_ * 2 + i_) * 64 + ln_, row_ = pidx_ >> 3, cp_ = pidx_ & 7; \
                __builtin_amdgcn_global_load_lds((const unsigned*)(vp_ + (unsigned)(row_ * vt_stride * 2 + ((cp_ ^ ((row_ >> 1) & 7)) << 4))), (LAS unsigned*)(vb_ + i_ * 1024), 16, 0, 0); } } } while (0)
    ST3_ISSUE(j_lo, 0);
    if (T > 1) ST3_ISSUE(j_lo + 1, 1);
    int slot = 0;
    for (int t = 0; t < T; ++t) {
        const int j = j_lo + t;
        if (t + 1 < T) { if (HASV) asm volatile("s_waitcnt vmcnt(5)" ::: "memory"); else asm volatile("s_waitcnt vmcnt(3)" ::: "memory"); }
        else asm volatile("s_waitcnt vmcnt(0)" ::: "memory");
        asm volatile("" ::: "memory"); __builtin_amdgcn_s_barrier(); asm volatile("" ::: "memory");
        if (t + 2 < T) { const int s2 = (slot >= 1) ? slot - 1 : 2; ST3_ISSUE(j + 2, s2); }
        if (tile_act<MODE>(j, A)) attn_tile2<MODE>(lds + slot * KT_BYTES, lds + L3_V + slot * VT_BYTES, lds, j, lane, q, o, m_run, l_run, A);
        slot = (slot == 2) ? 0 : slot + 1;
    }
    asm volatile("" ::: "memory"); __builtin_amdgcn_s_barrier(); asm volatile("" ::: "memory");
#undef ST3_ISSUE
}

DI int t5_bucket(int n) {
    if (n < 16) return n;
    return 16 + (n >= 19) + (n >= 21) + (n >= 24) + (n >= 27) + (n >= 31) + (n >= 35) + (n >= 40) + (n >= 46) + (n >= 52) + (n >= 59) + (n >= 67) + (n >= 77) + (n >= 87) + (n >= 99) + (n >= 113);
}
DI float silu_f(float z) { return z * __builtin_amdgcn_rcpf(1.0f + __builtin_amdgcn_exp2f(-1.4426950408889634f * z)); }

constexpr int EPI_PITCH = 272, EPI_WAVE_BYTES = 32 * EPI_PITCH;
template <bool RMW, bool NSA, int Q8>
DI void attn_epilogue_t(LAS unsigned char* lds, int lane, int wid, const f32x16 (&o)[4], float scale,
                        const char* __restrict__ zbase, unsigned z0, char* __restrict__ obase, unsigned o0) {
    LAS unsigned char* sc = lds + wid * EPI_WAVE_BYTES;
    const int r32 = lane & 31, hi = lane >> 5;
#pragma unroll
    for (int h = 0; h < 2; ++h) {
#pragma unroll
        for (int dd = 0; dd < 2; ++dd)
#pragma unroll
            for (int kq = 0; kq < 4; ++kq) {
                f32x4 v; v[0] = o[2 * h + dd][4 * kq + 0] * scale; v[1] = o[2 * h + dd][4 * kq + 1] * scale; v[2] = o[2 * h + dd][4 * kq + 2] * scale; v[3] = o[2 * h + dd][4 * kq + 3] * scale;
                *(LAS f32x4*)(sc + r32 * EPI_PITCH + (32 * dd + 8 * kq + 4 * hi) * 4) = v;
            }
        asm volatile("" ::: "memory");
#pragma unroll
        for (int i = 0; i < 4; ++i) {
            const int rr = 8 * i + (lane >> 3), c8 = lane & 7;
            const f32x4 a = *(const LAS f32x4*)(sc + rr * EPI_PITCH + c8 * 32);
            const f32x4 b = *(const LAS f32x4*)(sc + rr * EPI_PITCH + c8 * 32 + 16);
            unsigned zoff, ooff;
            if (NSA) { zoff = z0 + (unsigned)((rr >> 4) * (N1P * 2) + (rr & 15) * 256); ooff = o0 + (unsigned)((rr >> 4) * (ZW8 * 2) + (rr & 15) * 256); }
            else     { zoff = z0 + (unsigned)(rr * (N3P * 2)); ooff = o0 + (unsigned)(rr * (ZW8 * 2)); }
            const unsigned cb = (unsigned)((64 * h + 8 * c8) * 2);
            const u32x4 zw = *(const u32x4*)(zbase + (zoff + cb));
            float v0 = a[0] * silu_f(bflo(zw.x)), v1 = a[1] * silu_f(bfhi(zw.x)), v2 = a[2] * silu_f(bflo(zw.y)), v3 = a[3] * silu_f(bfhi(zw.y));
            float v4 = b[0] * silu_f(bflo(zw.z)), v5 = b[1] * silu_f(bfhi(zw.z)), v6 = b[2] * silu_f(bflo(zw.w)), v7 = b[3] * silu_f(bfhi(zw.w));
            if (RMW) { const u32x4 pw = *(const u32x4*)(obase + (ooff + cb));
                v0 += bflo(pw.x); v1 += bfhi(pw.x); v2 += bflo(pw.y); v3 += bfhi(pw.y); v4 += bflo(pw.z); v5 += bfhi(pw.z); v6 += bflo(pw.w); v7 += bfhi(pw.w); }
            if (Q8) { v0 = emu_q8(v0, 64.0f); v1 = emu_q8(v1, 64.0f); v2 = emu_q8(v2, 64.0f); v3 = emu_q8(v3, 64.0f); v4 = emu_q8(v4, 64.0f); v5 = emu_q8(v5, 64.0f); v6 = emu_q8(v6, 64.0f); v7 = emu_q8(v7, 64.0f); }
            u32x4 w; w.x = pk2(v0, v1); w.y = pk2(v2, v3); w.z = pk2(v4, v5); w.w = pk2(v6, v7);
            *(u32x4*)(obase + (ooff + cb)) = w;
        }
        asm volatile("" ::: "memory");
    }
}

DI void phase_nsa_attn(LAS unsigned char* lds, const Params& P, int bid, int nb) {
    const char* Y0c = (const char*)(P.ws + OFF_Y0);
    const char* KSc = (const char*)(P.ws + OFF_KS); const char* KWc = (const char*)(P.ws + OFF_KW);
    const char* VTSc = (const char*)(P.ws + OFF_VTS); const char* VTWc = (const char*)(P.ws + OFF_VTW);
    const char* KCc = (const char*)(P.ws + OFF_KC); const char* VTCc = (const char*)(P.ws + OFF_VTC);
    char* ONc = (char*)(P.ws + OFF_O);
    LAS float* lut = (LAS float*)(lds + L_LUT);
    const int total = BATCH * NG * 256;
    {
        const int tid0 = tid_opaque();
        __syncthreads();
        for (int i = tid0; i < 64 * 128; i += 512) { const int hd = i >> 7, d = i & 127; lut[hd * LUT_PITCH + d] = (P.rel_bias[t5_bucket(d) * NH + hd] - P.rel_bias[31 * NH + hd]) * LOG2E; }
        __syncthreads();
    }
    for (int u = bid; u < total; u += nb) {
        int tid = threadIdx.x; asm volatile("" : "+v"(tid));
        const int lane = tid & 63, wid = __builtin_amdgcn_readfirstlane(tid >> 6);
        const int pair = u >> 8; int c = u & 255; if (pair & 1) c = 255 - c;
        const int b = pair >> 2, g = pair & 3, t0 = c * 16;
        __syncthreads();
        AttnLane A;
                const int r = lane & 15;
        A.tk = (lane >> 4) & 1;
        A.tw0 = t0 + 2 * wid; A.tw1 = A.tw0 + 1; A.tq = A.tw0 + A.tk;
        A.lutrow = lut + (g * NR + r) * LUT_PITCH; A.lut_far = A.lutrow[127];
        A.curblk = t0 >> 6; A.tokidx = 2 * wid + A.tk; A.mk0 = 0ull; A.mk1 = 0ull; A.inv_l = 0.f;
        const int hh = g * NR + r;
        const unsigned yoff = (unsigned)(b * SEQ + A.tq) * (unsigned)(N1P * 2);
        const unsigned ytok0 = (unsigned)(b * SEQ + A.tw0) * (unsigned)(N1P * 2);
        const unsigned otok0 = ((unsigned)(b * SEQ + A.tw0) * (unsigned)ZW8 + (unsigned)(g * NR * DV)) * 2u;
        bf16x8 q[12];
                {
            const unsigned qo = yoff + (unsigned)((C_Q + hh * DK + 8 * (lane >> 5)) * 2);
            float ss = 0.f;
#pragma unroll
            for (int d0 = 0; d0 < 12; ++d0) { q[d0] = *(const bf16x8*)(Y0c + (qo + 32u * d0));
                const u32x4 w = __builtin_bit_cast(u32x4, q[d0]);
                const float a0 = bflo(w.x), a1 = bfhi(w.x), a2 = bflo(w.y), a3 = bfhi(w.y), a4 = bflo(w.z), a5 = bfhi(w.z), a6 = bflo(w.w), a7 = bfhi(w.w);
                ss += (a0 * a0 + a1 * a1) + (a2 * a2 + a3 * a3) + (a4 * a4 + a5 * a5) + (a6 * a6 + a7 * a7); }
            ss += __shfl_xor(ss, 32);
            const float rstd = rsqrtf(ss * (1.0f / DK) + EPSN) * QSCALE;
#pragma unroll
            for (int d0 = 0; d0 < 12; ++d0) { const float* gn = P.nsa_q_norm + 16 * d0 + 8 * (lane >> 5); const f32x4 g0 = *(const f32x4*)gn, g1 = *(const f32x4*)(gn + 4);
                u32x4 w = __builtin_bit_cast(u32x4, q[d0]);
                w.x = pk2(bflo(w.x) * rstd * g0[0], bfhi(w.x) * rstd * g0[1]); w.y = pk2(bflo(w.y) * rstd * g0[2], bfhi(w.y) * rstd * g0[3]);
                w.z = pk2(bflo(w.z) * rstd * g1[0], bfhi(w.z) * rstd * g1[1]); w.w = pk2(bflo(w.w) * rstd * g1[2], bfhi(w.w) * rstd * g1[3]);
                q[d0] = __builtin_bit_cast(bf16x8, w); }
        }
        const int bg = b * NG + g;
        f32x16 o[4]; float m_run, l_run;
#define RESET_STATE() do { _Pragma("unroll") for (int d_ = 0; d_ < 4; ++d_) _Pragma("unroll") for (int r_ = 0; r_ < 16; ++r_) o[d_][r_] = 0.f; m_run = 0.f; l_run = 0.f; } while (0)
        const int nct = (t0 + 15 >= 31) ? (((t0 + 15 - 31) >> 4) / 64 + 1) : 0;
        RESET_STATE();
        A.carry = 0.f;
        if (!NO_CMP1) attn_pass2<MODE_CMPX>(lds, KCc + (size_t)bg * 256 * DK * 2, VTCc + (size_t)bg * DV * 256 * 2, 256, 0, nct, q, o, m_run, l_run, A);
        { const float lt = l_run + __shfl_xor(l_run, 32); const float il = lt > 0.f ? 1.0f / lt : 0.f;
          if (lane < 32) ((LAS float*)(lds + L_IL))[A.tokidx * 16 + r] = il;
          const float gv = bf1(*(const bf16_t*)(Y0c + (yoff + (unsigned)((C_G + 0 * NH + hh) * 2)))); const float sg = 1.0f / (1.0f + __expf(-gv));
          for (int prb_ = 0; prb_ < PROBE_EPI; ++prb_) { asm volatile("" ::: "memory"); attn_epilogue_t<false, true, 0>(lds, lane, wid, o, sg * il, Y0c, ytok0 + (unsigned)((C_ZC + g * NR * DV) * 2), ONc, otok0); } }
        __syncthreads();
        for (int prb_ = 0; prb_ < PROBE_TOPK; ++prb_) { asm volatile("" ::: "memory");
            const int cur = A.curblk;
            unsigned long long mk[2];
#pragma unroll
            for (int t = 0; t < 2; ++t) {
                const LAS bf16_t* X = (const LAS bf16_t*)(lds + L_X) + (2 * wid + t) * 16 * 64;
                const LAS float* IL = (const LAS float*)(lds + L_IL) + (2 * wid + t) * 16;
                const bool forced = (lane == 0) || (lane == cur) || (lane == cur - 1);
                const bool future = lane > cur;
                float v = 0.f;
                if (!forced && !future) {
#pragma unroll
                    for (int rr = 0; rr < 16; ++rr) v += IL[rr] * bf1(X[rr * 64 + lane]); }
                unsigned key = (__float_as_uint(v) & ~63u);
                if (forced) key = 0x7f800000u; else if (future) key = 0u;
                key |= (unsigned)(63 - lane);
                int rank = 0;
#pragma unroll
                for (int jp = 0; jp < 64; ++jp) { const unsigned kj = (unsigned)__builtin_amdgcn_readlane((int)key, jp); rank += (kj > key) ? 1 : 0; }
                mk[t] = __ballot(rank < 16 && !future);
            }
            A.mk0 = mk[0]; A.mk1 = mk[1];
        }
        RESET_STATE();
#if PROBE_SEL2
        attn_pass2<MODE_SEL>(lds, KSc + (size_t)bg * SEQ * DK * 2, VTSc + (size_t)bg * DV * SEQ * 2, SEQ, 0, A.curblk + 1, q, o, m_run, l_run, A);
#endif
        if (!NO_SEL) attn_pass2<MODE_SEL>(lds, KSc + (size_t)bg * SEQ * DK * 2, VTSc + (size_t)bg * DV * SEQ * 2, SEQ, 0, A.curblk + 1, q, o, m_run, l_run, A);
        { const float lt = l_run + __shfl_xor(l_run, 32); const float gv = bf1(*(const bf16_t*)(Y0c + (yoff + (unsigned)((C_G + 1 * NH + hh) * 2)))); const float sg = 1.0f / (1.0f + __expf(-gv));
          attn_epilogue_t<true, true, 0>(lds, lane, wid, o, sg / lt, Y0c, ytok0 + (unsigned)((C_ZS + g * NR * DV) * 2), ONc, otok0); }
        __syncthreads();
        RESET_STATE();
        { const int jl = (t0 - 511) > 0 ? (t0 - 511) >> 6 : 0, jh = ((t0 + 15) >> 6) + 1;
#if PROBE_WIN2
          attn_pass2<MODE_WIN>(lds, KWc + (size_t)bg * SEQ * DK * 2, VTWc + (size_t)bg * DV * SEQ * 2, SEQ, jl, jh, q, o, m_run, l_run, A);
#endif
          if (!NO_WIN) attn_pass2<MODE_WIN>(lds, KWc + (size_t)bg * SEQ * DK * 2, VTWc + (size_t)bg * DV * SEQ * 2, SEQ, jl, jh, q, o, m_run, l_run, A); }
        { const float lt = l_run + __shfl_xor(l_run, 32); const float gv = bf1(*(const bf16_t*)(Y0c + (yoff + (unsigned)((C_G + 2 * NH + hh) * 2)))); const float sg = 1.0f / (1.0f + __expf(-gv));
          attn_epilogue_t<true, true, (FP8EMU & 1)>(lds, lane, wid, o, sg / lt, Y0c, ytok0 + (unsigned)((C_ZW + g * NR * DV) * 2), ONc, otok0); }
#undef RESET_STATE
    }
}

DI void phase_mla_attn(LAS unsigned char* lds, const Params& P, int bid, int nb) {
    const char* QMc = (const char*)(P.ws + OFF_QM); const char* KMc = (const char*)(P.ws + OFF_KM); const char* VTMc = (const char*)(P.ws + OFF_VTM);
    const char* Y1c = (const char*)(P.ws + OFF_Y1); char* OMc = (char*)(P.ws + OFF_O);
    const int total = BATCH * NH * 16;
    for (int uu = 0; bid + (uu >> 1) * nb < total / 2; ++uu) {
        int tid = threadIdx.x; asm volatile("" : "+v"(tid));
        const int lane = tid & 63, wid = __builtin_amdgcn_readfirstlane(tid >> 6);
        const int item = bid + (uu >> 1) * nb, second = uu & 1;
        const int xcd = item & 7, tt = item >> 3, p = tt & 7, hl = (tt >> 3) & 3, rnd = tt >> 5;
        const int bh = rnd * 32 + xcd * 4 + hl, qb = second ? p : 15 - p, b = bh >> 6, h = bh & 63, t0 = qb * 256;
        AttnLane A;
        A.tk = 0;
        A.tw0 = t0 + 32 * wid; A.tw1 = A.tw0 + 31; A.tq = A.tw0 + (lane & 31);
        A.lutrow = nullptr; A.lut_far = 0.f; A.curblk = 0; A.tokidx = 0; A.mk0 = 0ull; A.mk1 = 0ull; A.inv_l = 0.f;         const unsigned trow = (unsigned)(b * SEQ + A.tq);
        bf16x8 q[12];
        {
            const unsigned qo = (trow * (unsigned)NQB + (unsigned)(h * DK + 8 * (lane >> 5))) * 2u;
            float ss = 0.f;
#pragma unroll
            for (int d0 = 0; d0 < 12; ++d0) { q[d0] = *(const bf16x8*)(QMc + (qo + 32u * d0));
                const u32x4 w = __builtin_bit_cast(u32x4, q[d0]);
                const float a0 = bflo(w.x), a1 = bfhi(w.x), a2 = bflo(w.y), a3 = bfhi(w.y), a4 = bflo(w.z), a5 = bfhi(w.z), a6 = bflo(w.w), a7 = bfhi(w.w);
                ss += (a0 * a0 + a1 * a1) + (a2 * a2 + a3 * a3) + (a4 * a4 + a5 * a5) + (a6 * a6 + a7 * a7); }
            ss += __shfl_xor(ss, 32);
            const float rstd = rsqrtf(ss * (1.0f / DK) + EPSN);
            const float* ropep = (const float*)(P.ws + OFF_ROPE) + (size_t)trow * 64;
#pragma unroll
            for (int d0 = 0; d0 < 8; ++d0) { const float* gn = P.mla_q_norm + 16 * d0 + 8 * (lane >> 5); const f32x4 g0 = *(const f32x4*)gn, g1 = *(const f32x4*)(gn + 4);
                const float sc = rstd * QSCALE;
                u32x4 w = __builtin_bit_cast(u32x4, q[d0]);
                w.x = pk2(bflo(w.x) * sc * g0[0], bfhi(w.x) * sc * g0[1]); w.y = pk2(bflo(w.y) * sc * g0[2], bfhi(w.y) * sc * g0[3]);
                w.z = pk2(bflo(w.z) * sc * g1[0], bfhi(w.z) * sc * g1[1]); w.w = pk2(bflo(w.w) * sc * g1[2], bfhi(w.w) * sc * g1[3]);
                q[d0] = __builtin_bit_cast(bf16x8, w); }
#pragma unroll
            for (int pr = 0; pr < 2; ++pr) {
                const int i0 = 16 * pr + 8 * (lane >> 5);
                const float* g1p = P.mla_q_norm + 128 + i0; const float* g2p = P.mla_q_norm + 160 + i0;
                const u32x4 w1 = __builtin_bit_cast(u32x4, q[8 + pr]), w2 = __builtin_bit_cast(u32x4, q[10 + pr]);
                float x1[8] = {bflo(w1.x), bfhi(w1.x), bflo(w1.y), bfhi(w1.y), bflo(w1.z), bfhi(w1.z), bflo(w1.w), bfhi(w1.w)};
                float x2[8] = {bflo(w2.x), bfhi(w2.x), bflo(w2.y), bfhi(w2.y), bflo(w2.z), bfhi(w2.z), bflo(w2.w), bfhi(w2.w)};
                float y1[8], y2[8];
#pragma unroll
                for (int e = 0; e < 8; ++e) { const float cs = ropep[i0 + e], sn = ropep[32 + i0 + e];
                    const float a = x1[e] * rstd * g1p[e], c = x2[e] * rstd * g2p[e];
                    y1[e] = (a * cs - c * sn) * QSCALE; y2[e] = (c * cs + a * sn) * QSCALE; }
                u32x4 o1, o2;
                o1.x = pk2(y1[0], y1[1]); o1.y = pk2(y1[2], y1[3]); o1.z = pk2(y1[4], y1[5]); o1.w = pk2(y1[6], y1[7]);
                o2.x = pk2(y2[0], y2[1]); o2.y = pk2(y2[2], y2[3]); o2.z = pk2(y2[4], y2[5]); o2.w = pk2(y2[6], y2[7]);
                q[8 + pr] = __builtin_bit_cast(bf16x8, o1); q[10 + pr] = __builtin_bit_cast(bf16x8, o2);
            }
        }
        f32x16 o[4]; float m_run = 0.f, l_run = 0.f;
#pragma unroll
        for (int d = 0; d < 4; ++d)
#pragma unroll
            for (int r = 0; r < 16; ++r) o[d][r] = 0.f;
        attn_pass2<MODE_MLA>(lds, KMc + (size_t)bh * SEQ * DK * 2, VTMc + (size_t)bh * DV * SEQ * 2, SEQ, 0, 4 * qb + 4, q, o, m_run, l_run, A);
        const float lt = l_run + __shfl_xor(l_run, 32);
        { const unsigned t0w = (unsigned)(b * SEQ + A.tw0);
          attn_epilogue_t<false, false, (FP8EMU & 2) ? 1 : 0>(lds, lane, wid, o, 1.0f / lt, Y1c, (t0w * (unsigned)N3P + (unsigned)(C3_Z + h * DV)) * 2u, OMc, (t0w * (unsigned)ZW8 + (unsigned)(h * DV)) * 2u); }
        __syncthreads();
    }
}
constexpr int LDS_KN_OFF = 135168, LDS_ST_OFF = LDS_KN_OFF + 16384, LDS_BYTES = LDS_ST_OFF + 16;
constexpr int NPHASE = 14;

template <int PH>
DI void run_phase(const Params& P, LAS unsigned char* lds, int bid, int nb) {
    unsigned char* ws = P.ws;
    if constexpr (PH == 0) {
        phase_wconv(lds, P.nsa_w_in, (bf16_t*)(ws + OFF_W1T), DM, N1, N1P, bid, nb, (FP8EMU & 4) ? 64.0f : 0.f);
        phase_wconv(lds, P.w1_k, (bf16_t*)(ws + OFF_W1K), 6144, 192, 256, bid, nb);
        phase_wconv(lds, P.w1_v, (bf16_t*)(ws + OFF_W1V), 4096, 128, 256, bid, nb);
        phase_rmsnorm(P.x, P.norm_w, (bf16_t*)(ws + OFF_H), bid, nb, (FP8EMU & 4) ? 16.0f : 0.f);
    } else if constexpr (PH == 1) {
        pg8::Gemm g{(const bf16_t*)(ws + OFF_H), (const bf16_t*)(ws + OFF_W1T), MTOK, N1P, DM};
        pg8::StaticOrder S; S.init(g.M, g.N, nb, bid);
        pg8::EpiStoreBf16 E{(bf16_t*)(ws + OFF_Y0), N1P};
        pg8::gemm_phase<pg8::EpiStoreBf16, pg8::StaticOrder, false>(lds, g, S, E, nullptr);
    } else if constexpr (PH == 2) {
        phase_nsa_prep(P, bid, nb);
        phase_vt(lds, (const bf16_t*)(ws + OFF_Y0), N1P, C_KVS + NG * DK, DV, NG, (bf16_t*)(ws + OFF_VTS), bid, nb);
        phase_vt(lds, (const bf16_t*)(ws + OFF_Y0), N1P, C_KVW + NG * DK, DV, NG, (bf16_t*)(ws + OFF_VTW), bid, nb);
    } else if constexpr (PH == 3) {
        if (bid < 16) {
            pg8::Gemm g{(const bf16_t*)(ws + OFF_ACK), (const bf16_t*)(ws + OFF_W1K), 4096, 256, 6144};
            pg8::StaticOrder S; S.init(g.M, g.N, 16, bid);
            pg8::EpiPlainF32 E{(float*)(ws + OFF_HIDK), 256};
            pg8::gemm_phase<pg8::EpiPlainF32, pg8::StaticOrder, false>(lds, g, S, E, nullptr);
        } else if (bid < 32) {
            pg8::Gemm g{(const bf16_t*)(ws + OFF_ACV), (const bf16_t*)(ws + OFF_W1V), 4096, 256, 4096};
            pg8::StaticOrder S; S.init(g.M, g.N, 16, bid - 16);
            pg8::EpiPlainF32 E{(float*)(ws + OFF_HIDV), 256};
            pg8::gemm_phase<pg8::EpiPlainF32, pg8::StaticOrder, false>(lds, g, S, E, nullptr);
        } else {
            phase_wconv(lds, P.nsa_w_out, (bf16_t*)(ws + OFF_W2T), ZW8, DM, DM, bid - 32, nb - 32, (FP8EMU & 1) ? 64.0f : 0.f);
            phase_wconv(lds, P.mla_w_in, (bf16_t*)(ws + OFF_W3T), DM, N3, N3P, bid - 32, nb - 32, (FP8EMU & 8) ? 64.0f : 0.f);
        }
    } else if constexpr (PH == 4) {
        phase_cmp2(lds, P, bid, nb);
    } else if constexpr (PH == 5) {
        { float* ss1 = (float*)(ws + OFF_SS1); for (int i = bid * 512 + (int)threadIdx.x; i < MTOK; i += nb * 512) ss1[i] = 0.f; }
        phase_nsa_attn(lds, P, bid, nb);
    } else if constexpr (PH == 6) {
        pg8::Gemm g{(const bf16_t*)(ws + OFF_O), (const bf16_t*)(ws + OFF_W2T), MTOK, DM, ZW8};
        pg8::StaticOrder S; S.init(g.M, g.N, nb, bid);
        pg8::EpiResNorm E{P.x, P.out, DM, P.norm_w + DM, (bf16_t*)(ws + OFF_H), (float*)(ws + OFF_SS1)};
        pg8::gemm_phase<pg8::EpiResNorm, pg8::StaticOrder, false>(lds, g, S, E, nullptr);
    } else if constexpr (PH == 7) {
        phase_rmsnorm(P.out, P.norm_w + DM, (bf16_t*)(ws + OFF_H), bid, nb, (FP8EMU & 8) ? 16.0f : 0.f);
    } else if constexpr (PH == 8) {
        pg8::Gemm g{(const bf16_t*)(ws + OFF_H), (const bf16_t*)(ws + OFF_W3T), MTOK, N3P, DM};
        pg8::StaticOrder S; S.init(g.M, g.N, nb, bid);
        pg8::EpiStoreBf16RowScale E{(bf16_t*)(ws + OFF_Y1), N3P, (const float*)(ws + OFF_SS1), 1.0f / DM};
        pg8::gemm_phase<pg8::EpiStoreBf16RowScale, pg8::StaticOrder, false>(lds, g, S, E, nullptr);
        __syncthreads();
        if (bid >= 64 && nb > 64) {
            phase_wconv(lds, P.mla_w_q_b, (bf16_t*)(ws + OFF_W4T), QLORA, NQB, NQB, bid - 64, nb - 64);
            phase_wconv(lds, P.mla_w_kv_b, (bf16_t*)(ws + OFF_W5K), KVLORA, NKVB / 2, NKVB / 2, bid - 64, nb - 64, 0.f, 2);
            phase_wconv(lds, P.mla_w_kv_b, (bf16_t*)(ws + OFF_W5V), KVLORA, NKVB / 2, NKVB / 2, bid - 64, nb - 64, 0.f, 1);
            phase_wconv(lds, P.mla_w_out, (bf16_t*)(ws + OFF_W6T), ZW8, DM, DM, bid - 64, nb - 64, (FP8EMU & 2) ? 64.0f : 0.f);
        } else if (nb <= 64) {
            phase_wconv(lds, P.mla_w_q_b, (bf16_t*)(ws + OFF_W4T), QLORA, NQB, NQB, bid, nb);
            phase_wconv(lds, P.mla_w_kv_b, (bf16_t*)(ws + OFF_W5K), KVLORA, NKVB / 2, NKVB / 2, bid, nb, 0.f, 2);
            phase_wconv(lds, P.mla_w_kv_b, (bf16_t*)(ws + OFF_W5V), KVLORA, NKVB / 2, NKVB / 2, bid, nb, 0.f, 1);
            phase_wconv(lds, P.mla_w_out, (bf16_t*)(ws + OFF_W6T), ZW8, DM, DM, bid, nb, (FP8EMU & 2) ? 64.0f : 0.f);
        }
    } else if constexpr (PH == 9) {
        phase_mla_prep1(P, bid, nb);
    } else if constexpr (PH == 10) {
        {
            pg8::Gemm g{(const bf16_t*)(ws + OFF_CQN), (const bf16_t*)(ws + OFF_W4T), MTOK, NQB, QLORA};
            pg8::StaticOrder S; S.init(g.M, g.N, nb, bid);
            pg8::EpiStoreBf16 E{(bf16_t*)(ws + OFF_QM), NQB};
            pg8::gemm_phase<pg8::EpiStoreBf16, pg8::StaticOrder, false>(lds, g, S, E, nullptr);
        }
        __syncthreads();
        {
            pg8::Gemm g{(const bf16_t*)(ws + OFF_CKVN), (const bf16_t*)(ws + OFF_W5K), MTOK, NKVB / 2, KVLORA};
            pg8::StaticOrder S; S.init(g.M, g.N, nb, bid);
            pg8::EpiKNorm E{(bf16_t*)(ws + OFF_KM), (const float*)(ws + OFF_SSPE), (const float*)(ws + OFF_KPER), P.mla_k_norm, (LAS float*)(lds + LDS_KN_OFF), 0u};
            pg8::gemm_phase<pg8::EpiKNorm, pg8::StaticOrder, false>(lds, g, S, E, nullptr);
        }
        __syncthreads();
        {
            pg8::Gemm g{(const bf16_t*)(ws + OFF_W5V), (const bf16_t*)(ws + OFF_CKVN), NKVB / 2, MTOK, KVLORA};
            pg8::StaticOrder S; S.init(g.M, g.N, nb, bid);
            pg8::EpiVT E{(bf16_t*)(ws + OFF_VTM)};
            pg8::gemm_phase<pg8::EpiVT, pg8::StaticOrder, false>(lds, g, S, E, nullptr);
        }
    } else if constexpr (PH == 11) {
    } else if constexpr (PH == 12) {
        phase_mla_attn(lds, P, bid, nb);
    } else if constexpr (PH == 13) {
        pg8::Gemm g{(const bf16_t*)(ws + OFF_O), (const bf16_t*)(ws + OFF_W6T), MTOK, DM, ZW8};
        pg8::StaticOrder S; S.init(g.M, g.N, nb, bid);
        pg8::EpiResF32 E{P.out, P.out, DM};
        pg8::gemm_phase<pg8::EpiResF32, pg8::StaticOrder, false>(lds, g, S, E, nullptr);
    }
}

#ifndef REP0
#define REP0 1
#endif
#ifndef REP1
#define REP1 1
#endif
#ifndef REP2
#define REP2 1
#endif
#ifndef REP3
#define REP3 1
#endif
#ifndef REP4
#define REP4 1
#endif
#ifndef REP5
#define REP5 1
#endif
#ifndef REP6
#define REP6 1
#endif
#ifndef REP7
#define REP7 1
#endif
#ifndef REP8
#define REP8 1
#endif
#ifndef REP9
#define REP9 1
#endif
#ifndef REP10
#define REP10 1
#endif
#ifndef REP11
#define REP11 1
#endif
#ifndef REP12
#define REP12 1
#endif
#ifndef REP13
#define REP13 1
#endif

__global__ __launch_bounds__(512, 2) void k_mega(Params P) {
    extern __shared__ __attribute__((aligned(16))) unsigned char shm[];
    LAS unsigned char* lds = (LAS unsigned char*)shm;
    volatile LAS unsigned* st = (volatile LAS unsigned*)(lds + LDS_ST_OFF);
    if (threadIdx.x == 0) { st[0] = 0u; st[1] = 0u; st[2] = 0u; st[3] = 0u; }
    __syncthreads();
    XcdBarrier bar = xcd_barrier_post((unsigned*)(P.ws + OFF_CTL), st);
    const int bid = (int)blockIdx.x, nb = (int)gridDim.x;
    for (int rep_ = 0; rep_ < REP0; ++rep_) run_phase<0>(P, lds, bid, nb);  xcd_barrier(bar);
    for (int rep_ = 0; rep_ < REP1; ++rep_) run_phase<1>(P, lds, bid, nb);  xcd_barrier(bar);
    for (int rep_ = 0; rep_ < REP2; ++rep_) run_phase<2>(P, lds, bid, nb);  xcd_barrier(bar);
    for (int rep_ = 0; rep_ < REP3; ++rep_) run_phase<3>(P, lds, bid, nb);  xcd_barrier(bar);
    for (int rep_ = 0; rep_ < REP4; ++rep_) run_phase<4>(P, lds, bid, nb);  xcd_barrier(bar);
    for (int rep_ = 0; rep_ < REP5; ++rep_) run_phase<5>(P, lds, bid, nb);  xcd_barrier(bar);
    for (int rep_ = 0; rep_ < REP6; ++rep_) run_phase<6>(P, lds, bid, nb);  xcd_barrier(bar);
    for (int rep_ = 0; rep_ < REP8; ++rep_) run_phase<8>(P, lds, bid, nb);  xcd_barrier(bar);
    for (int rep_ = 0; rep_ < REP9; ++rep_) run_phase<9>(P, lds, bid, nb);  xcd_barrier(bar);
    for (int rep_ = 0; rep_ < REP10; ++rep_) run_phase<10>(P, lds, bid, nb); xcd_barrier(bar);
    for (int rep_ = 0; rep_ < REP12; ++rep_) run_phase<12>(P, lds, bid, nb); xcd_barrier(bar);
    for (int rep_ = 0; rep_ < REP13; ++rep_) run_phase<13>(P, lds, bid, nb);
}

extern "C" void kernel_launch(void* const* d_in, const int* in_sizes, int n_in, void* d_out, int out_size, void* d_ws, size_t ws_size, hipStream_t stream) {
    (void)in_sizes; (void)n_in; (void)out_size;
    if (ws_size < WS_END) return;
    Params P{};
    P.x = (const float*)d_in[0]; P.pos = (const int*)d_in[1]; P.norm_w = (const float*)d_in[2]; P.rel_bias = (const float*)d_in[3];
    P.nsa_w_in = (const float*)d_in[4]; P.nsa_q_norm = (const float*)d_in[5]; P.nsa_k_norm = (const float*)d_in[6]; P.pe_k = (const float*)d_in[7];
    P.w1_k = (const float*)d_in[8]; P.w2_k = (const float*)d_in[9]; P.pe_v = (const float*)d_in[10]; P.w1_v = (const float*)d_in[11]; P.w2_v = (const float*)d_in[12];
    P.nsa_w_out = (const float*)d_in[13]; P.mla_w_in = (const float*)d_in[14]; P.mla_q_a_norm = (const float*)d_in[15]; P.mla_w_q_b = (const float*)d_in[16];
    P.mla_kv_a_norm = (const float*)d_in[17]; P.mla_w_kv_b = (const float*)d_in[18]; P.mla_q_norm = (const float*)d_in[19]; P.mla_k_norm = (const float*)d_in[20];
    P.mla_w_out = (const float*)d_in[21];
    P.out = (float*)d_out; P.ws = (unsigned char*)d_ws;
    static int grid = 0;
    if (!grid) {
        int dev = 0, cus = 0, per_cu = 0; (void)hipGetDevice(&dev);
        if (hipDeviceGetAttribute(&cus, hipDeviceAttributeMultiprocessorCount, dev) != hipSuccess || cus <= 0) cus = 256;
        (void)hipFuncSetAttribute((const void*)k_mega, hipFuncAttributeMaxDynamicSharedMemorySize, LDS_BYTES);
        if (hipOccupancyMaxActiveBlocksPerMultiprocessor(&per_cu, k_mega, 512, LDS_BYTES) != hipSuccess || per_cu < 1) per_cu = 1;
        grid = cus;
    }
    (void)hipMemsetAsync((unsigned char*)d_ws + OFF_CTL, 0, XCD_BAR_WORDS * sizeof(unsigned), stream);
    hipLaunchKernelGGL(k_mega, dim3(grid), dim3(512), LDS_BYTES, stream, P);
}
```

```cpp
#define ATT16 1
#include <hip/hip_runtime.h>
#include <stdint.h>
#include <stddef.h>

#define DI __device__ __forceinline__
#define LAS __attribute__((address_space(3)))
typedef unsigned short bf16_t;
typedef short bf16x8 __attribute__((ext_vector_type(8)));
typedef float f32x4 __attribute__((ext_vector_type(4)));
typedef float f32x16 __attribute__((ext_vector_type(16)));
typedef unsigned u32x4 __attribute__((ext_vector_type(4)));
typedef unsigned u32x2 __attribute__((ext_vector_type(2)));
typedef __bf16 bf2_t __attribute__((ext_vector_type(2)));
typedef float f2_t __attribute__((ext_vector_type(2)));

DI int tid_opaque() { int t = (int)threadIdx.x; asm volatile("" : "+v"(t)); return t; }
DI unsigned pk2(float a, float b) { f2_t f = {a, b}; bf2_t v = __builtin_convertvector(f, bf2_t); return __builtin_bit_cast(unsigned, v); }
DI float bflo(unsigned w) { return __uint_as_float(w << 16); }
DI float bfhi(unsigned w) { return __uint_as_float(w & 0xffff0000u); }
#ifndef FP8EMU
#define FP8EMU 0
#endif
DI float emu_q8(float x, float s) { float y = x * s; const float ay = fabsf(y);
    if (ay < 0.015625f) y = rintf(y * 512.0f) * (1.0f / 512.0f);
    else { unsigned u = __float_as_uint(y); u = (u + 0x0007FFFFu + ((u >> 20) & 1u)) & 0xFFF00000u; y = __uint_as_float(u); }
    y = fminf(fmaxf(y, -448.0f), 448.0f); return y / s; }
DI float bf1(bf16_t h) { return __uint_as_float(((unsigned)h) << 16); }

#ifndef ATT16
#define ATT16 0
#endif
DI int vt_key_of_pos(int p) {
#if ATT16
    return (p & ~31) | (((p >> 2) & 1) << 4) | (((p >> 3) & 3) << 2) | (p & 3);
#else
    return (p & ~0xC) | ((p & 4) << 1) | ((p & 8) >> 1);
#endif
}
DI int vt_pos_of_key(int k) {
#if ATT16
    return (k & ~31) | (((k >> 2) & 3) << 3) | (((k >> 4) & 1) << 2) | (k & 3);
#else
    return (k & ~0xC) | ((k & 4) << 1) | ((k & 8) >> 1);
#endif
}
constexpr int BATCH = 4, SEQ = 4096, DM = 4096, MTOK = BATCH * SEQ;
constexpr int NH = 64, NG = 4, NR = 16, DK = 192, DV = 128;
constexpr int N1 = 40896, N1P = 40960;
constexpr int C_Q = 0, C_KVC = 12288, C_KVS = 13568, C_KVW = 14848, C_ZC = 16128, C_ZS = 24320, C_ZW = 32512, C_G = 40704;
constexpr int N3 = 10304, N3P = 10496;
constexpr int C3_CQ = 0, C3_CKV = 1536, C3_KPE = 2048, C3_Z = 2112;
constexpr int QLORA = 1536, KVLORA = 512;
constexpr int NQB = 12288, NKVB = 16384, ZW8 = 8192;
constexpr float EPSN = 1e-6f;
constexpr float LOG2E = 1.4426950408889634f;
constexpr float QSCALE = 0.07216878364870322f * 1.4426950408889634f;

constexpr size_t SZ_W1T = (size_t)N1P * DM * 2, SZ_W2T = (size_t)DM * ZW8 * 2, SZ_W3T = (size_t)N3P * DM * 2, SZ_W4T = (size_t)NQB * QLORA * 2,
                 SZ_W5T = (size_t)NKVB * KVLORA * 2, SZ_W6T = (size_t)DM * ZW8 * 2;
constexpr size_t OFF_W1T = 0, OFF_W2T = OFF_W1T + SZ_W1T, OFF_W3T = OFF_W2T + SZ_W2T, OFF_W4T = OFF_W3T + SZ_W3T, OFF_W5T = OFF_W4T + SZ_W4T,
                 OFF_W6T = OFF_W5T + SZ_W5T, OFF_W1K = OFF_W6T + SZ_W6T;
constexpr size_t OFF_W5K = OFF_W5T, OFF_W5V = OFF_W5T + SZ_W5T / 2;
constexpr size_t SZ_W1K = (size_t)256 * 6144 * 2, SZ_W1V = (size_t)256 * 4096 * 2;
constexpr size_t OFF_W1V = OFF_W1K + SZ_W1K, OFF_CTL = OFF_W1V + SZ_W1V, OFF_H = OFF_CTL + 65536;
constexpr size_t SZ_H = (size_t)MTOK * DM * 2, SZ_KS = (size_t)BATCH * NG * SEQ * DK * 2, SZ_VTS = (size_t)BATCH * NG * DV * SEQ * 2,
                 SZ_ACK = (size_t)4096 * 6144 * 2, SZ_ACV = (size_t)4096 * 4096 * 2;
constexpr size_t OFF_KS = OFF_H + SZ_H, OFF_KW = OFF_KS + SZ_KS, OFF_VTS = OFF_KW + SZ_KS, OFF_VTW = OFF_VTS + SZ_VTS, OFF_ACK = OFF_VTW + SZ_VTS,
                 OFF_ACV = OFF_ACK + SZ_ACK, OFF_KC = OFF_ACV + SZ_ACV;
constexpr size_t SZ_KC = (size_t)16 * 256 * DK * 2, SZ_VTC = (size_t)16 * DV * 256 * 2, SZ_HID = (size_t)4096 * 256 * 4;
constexpr size_t OFF_VTC = OFF_KC + SZ_KC, OFF_HIDK = OFF_VTC + SZ_VTC, OFF_HIDV = OFF_HIDK + SZ_HID, OFF_Y0 = OFF_HIDV + SZ_HID;
constexpr size_t SZ_Y0 = (size_t)MTOK * N1P * 2, SZ_O = (size_t)MTOK * ZW8 * 2;
constexpr size_t OFF_O = OFF_Y0 + SZ_Y0, WS_END = OFF_O + SZ_O;
constexpr size_t OFF_SS1 = OFF_HIDK;
constexpr size_t OFF_KM = 0;
constexpr size_t SZ_KM = (size_t)BATCH * NH * SEQ * DK * 2;
static_assert(SZ_KM <= SZ_W1T + SZ_W2T, "KM alias");
constexpr size_t OFF_VTM = OFF_H;
constexpr size_t SZ_VTM = (size_t)BATCH * NH * DV * SEQ * 2;
constexpr size_t OFF_CKVN = OFF_VTM + SZ_VTM;
constexpr size_t SZ_CKVN = (size_t)MTOK * KVLORA * 2;
static_assert(OFF_CKVN + SZ_CKVN <= OFF_KC, "CKVN alias");
constexpr size_t OFF_Y1 = OFF_Y0, SZ_Y1 = (size_t)MTOK * N3P * 2;
constexpr size_t OFF_QM = OFF_Y1 + SZ_Y1, SZ_QM = (size_t)MTOK * NQB * 2;
constexpr size_t OFF_KVM = OFF_QM + SZ_QM, SZ_KVM = (size_t)MTOK * NKVB * 2;
constexpr size_t OFF_KNM = OFF_KVM;
constexpr size_t OFF_KPER = OFF_KVM, OFF_SSPE = OFF_KVM + (size_t)MTOK * 64 * 4;
constexpr size_t OFF_CQN = OFF_KVM + SZ_KVM, SZ_CQN = (size_t)MTOK * QLORA * 2;
constexpr size_t OFF_ROPE = OFF_CQN + SZ_CQN, SZ_ROPE = (size_t)MTOK * 64 * 4;
static_assert(OFF_ROPE + SZ_ROPE <= OFF_O, "layer-1 alias region");
static_assert(WS_END <= 2680160256ull, "workspace");

struct Params {
    const float* x; const int* pos; const float* norm_w; const float* rel_bias;
    const float* nsa_w_in; const float* nsa_q_norm; const float* nsa_k_norm; const float* pe_k; const float* w1_k; const float* w2_k;
    const float* pe_v; const float* w1_v; const float* w2_v; const float* nsa_w_out;
    const float* mla_w_in; const float* mla_q_a_norm; const float* mla_w_q_b; const float* mla_kv_a_norm; const float* mla_w_kv_b;
    const float* mla_q_norm; const float* mla_k_norm; const float* mla_w_out;
    float* out; unsigned char* ws;
};

#define XB_TMO      128
#define XB_XCNT(j)  (256  + 64 * (j))
#define XB_XSUB(j)  (1280 + 64 * (j))
#define XB_XGEN(j)  (2304 + 64 * (j))
#define XB_TOP      3328
#define XB_TOPGEN   3392
#define XCD_BAR_WORDS 3456
#define XB_SPIN_CAP (1u << 18)

__device__ __forceinline__ unsigned xb_ld(unsigned* p)              { return __hip_atomic_load(p, __ATOMIC_RELAXED, __HIP_MEMORY_SCOPE_AGENT); }
__device__ __forceinline__ unsigned xb_add(unsigned* p, unsigned v) { return __hip_atomic_fetch_add(p, v, __ATOMIC_RELAXED, __HIP_MEMORY_SCOPE_AGENT); }
__device__ __forceinline__ unsigned xb_xcc_id() { return (unsigned)__builtin_amdgcn_s_getreg((3 << 11) | 20) & 0xFu; }
#define XB_SPIN(cond, bar) do { unsigned _sp = 0; while (cond) { __builtin_amdgcn_s_sleep(1); \
    if ((++_sp & 255u) == 0u) { if (xb_ld(&(bar)[XB_TMO])) break; if (_sp > XB_SPIN_CAP) { atomicAdd(&(bar)[XB_TMO], 1u); break; } } } } while (0)

struct XcdBarrier {
    unsigned* bar; unsigned x;
    volatile LAS unsigned* st;
};

__device__ __forceinline__ XcdBarrier xcd_barrier_post(unsigned* bar, volatile LAS unsigned* st) {
    XcdBarrier b; b.bar = bar; b.x = xb_xcc_id(); b.st = st;
    if (threadIdx.x == 0) (void)xb_add(&bar[XB_XCNT(b.x)], 1u);
    return b;
}
__device__ __forceinline__ void xcd_barrier_complete(unsigned* bar, unsigned x, unsigned& nloc, unsigned& nx) {
    const unsigned G = gridDim.x * gridDim.y * gridDim.z;
    unsigned sum, cnt, mine, sp = 0u;
    for (;;) {
        sum = 0u; cnt = 0u; mine = 0u;
#pragma unroll
        for (unsigned j = 0; j < 16; ++j) { const unsigned c = xb_ld(&bar[XB_XCNT(j)]); sum += c; cnt += (c > 0u) ? 1u : 0u; mine = (j == x) ? c : mine; }
        if (sum == G) break;
        __builtin_amdgcn_s_sleep(1);
        if ((++sp & 255u) == 0u) { if (xb_ld(&bar[XB_TMO])) break; if (sp > XB_SPIN_CAP) { atomicAdd(&bar[XB_TMO], 1u); break; } }
    }
    nloc = mine > 0u ? mine : 1u; nx = cnt > 0u ? cnt : 1u;
}

__device__ __forceinline__ void xcd_barrier(const XcdBarrier& b) {
    asm volatile("s_waitcnt vmcnt(0)" ::: "memory");
    __syncthreads();
    if (threadIdx.x == 0) {
        unsigned* bar = b.bar;
        __builtin_amdgcn_s_waitcnt(0);
        unsigned nloc = b.st[0], nx = b.st[1];
        if (nloc == 0u) { xcd_barrier_complete(bar, b.x, nloc, nx); b.st[0] = nloc; b.st[1] = nx; }
        const unsigned old = xb_add(&bar[XB_XSUB(b.x)], 1u);
        const unsigned gen = old / nloc;
        if (old + 1u == (gen + 1u) * nloc) {
            __builtin_amdgcn_fence(__ATOMIC_RELEASE, "agent");
            asm volatile("s_waitcnt vmcnt(0)" ::: "memory");
            const unsigned og = xb_add(&bar[XB_TOP], 1u);
            const unsigned tg = og / nx;
            if (og + 1u == (tg + 1u) * nx) xb_add(&bar[XB_TOPGEN], 1u);
            else XB_SPIN(xb_ld(&bar[XB_TOPGEN]) == tg, bar);
            __builtin_amdgcn_fence(__ATOMIC_ACQUIRE, "agent");
            xb_add(&bar[XB_XGEN(b.x)], 1u);
            asm volatile("s_waitcnt vmcnt(0)" ::: "memory");
        } else {
            XB_SPIN(xb_ld(&bar[XB_XGEN(b.x)]) == gen, bar);
            __builtin_amdgcn_fence(__ATOMIC_ACQUIRE, "agent");
            asm volatile("s_waitcnt vmcnt(0)" ::: "memory");
        }
    }
    __syncthreads();
}

namespace pg8 {
#define PG8_LAS __attribute__((address_space(3)))
typedef unsigned short bf16_t;
typedef short bf16x8 __attribute__((ext_vector_type(8)));
typedef float f32x4 __attribute__((ext_vector_type(4)));
typedef unsigned u32x4 __attribute__((ext_vector_type(4)));
constexpr int BM = 256, BK = 64, HALF = 128, HTB = HALF * BK * 2  , STAGE_BYTES = 8 * HTB, NXCD = 8, WGM = 8;

__host__ __device__ __forceinline__ int lds_byte(int r, int c) { const int st = (r >> 4) * 2 + (c >> 5), rr = r & 15, cc = c & 31, ob = rr * 64 + cc * 2; return st * 1024 + (ob ^ (((ob >> 9) & 1) << 5)); }
__host__ __device__ __forceinline__ void stage_rc(int b, int& R, int& C) { const int st = b / 1024, sb = b % 1024, swz = sb ^ (((sb >> 9) & 1) << 5); R = (st >> 1) * 16 + swz / 64; C = (st & 1) * 32 + (swz % 64) / 2; }
__host__ __device__ __forceinline__ int perm32(int rho) { const int n = rho >> 4, i = rho & 15; return 8 * (i >> 2) + 4 * n + (i & 3); }

struct Unit { int pm, pn; };
struct Gemm { const bf16_t* A; const bf16_t* Bt; int M, N, K; };

struct StaticOrder {
    int nM, nN, nwg, G, c;
    __host__ __device__ void init(int M, int N, int G_, int c_) { nM = M / BM; nN = N / BM; nwg = nM * nN; G = G_; c = c_; }
    __host__ __device__ bool next(int i, Unit& u) const {
        const long L = (long)i * G + c; if (L >= nwg) return false;
        int wgid = (int)L; { const int q = nwg / NXCD, r = nwg % NXCD, xcd = wgid % NXCD, off = wgid / NXCD; wgid = (xcd < r ? xcd * (q + 1) : r * (q + 1) + (xcd - r) * q) + off; }
        const int nig = WGM * nN, gid = wgid / nig, fm = gid * WGM, gsz = (nM - fm) < WGM ? (nM - fm) : WGM;
        u.pm = fm + ((wgid % nig) % gsz); u.pn = (wgid % nig) / gsz; return true;
    }
    __device__ __forceinline__ void a_ready(const Unit&) const {}
    __device__ __forceinline__ void done(const Unit&) const {}
};
struct EpiStoreBf16 {
    static constexpr bool PERM = true, AFTER_DRAIN = false, SWAP23 = false;
    bf16_t* O; int ldc;
    __device__ __forceinline__ void operator()(const f32x4 (&acc)[2][2][4][2], const Unit& u, int wr, int wc, int fr, int fq) const {
        const int row0 = u.pm * BM + wr * 64 + fr; const int col0 = u.pn * BM + wc * 32 + 8 * fq;
#pragma unroll
        for (int ai = 0; ai < 2; ++ai)
#pragma unroll
            for (int m = 0; m < 4; ++m) { bf16_t* rowp = O + (size_t)(row0 + ai * HALF + m * 16) * ldc + col0;
#pragma unroll
                for (int bj = 0; bj < 2; ++bj) { const f32x4 v0 = acc[ai][bj][m][0], v1 = acc[ai][bj][m][1];
                    u32x4 w; w.x = pk2(v0[0], v0[1]); w.y = pk2(v0[2], v0[3]); w.z = pk2(v1[0], v1[1]); w.w = pk2(v1[2], v1[3]);
                    *(u32x4*)(rowp + bj * HALF) = w; } }
    }
};
struct EpiResF32 {
    static constexpr bool PERM = false, AFTER_DRAIN = false, SWAP23 = false;
    const float* base; float* out; int ldc;
    __device__ __forceinline__ void operator()(const f32x4 (&acc)[2][2][4][2], const Unit& u, int wr, int wc, int fr, int fq) const {
        const int row0 = u.pm * BM + wr * 64 + fr, col0 = u.pn * BM + wc * 32 + 4 * fq;
#pragma unroll
        for (int ai = 0; ai < 2; ++ai)
#pragma unroll
            for (int m = 0; m < 4; ++m) { const size_t off = (size_t)(row0 + ai * HALF + m * 16) * ldc + col0;
#pragma unroll
                for (int bj = 0; bj < 2; ++bj)
#pragma unroll
                    for (int n = 0; n < 2; ++n) { const f32x4 bs = *(const f32x4*)(base + off + bj * HALF + n * 16);
                        *(f32x4*)(out + off + bj * HALF + n * 16) = bs + acc[ai][bj][m][n]; } }
    }
};
struct EpiPlainF32 {
    static constexpr bool PERM = false, AFTER_DRAIN = false, SWAP23 = false;
    float* C; int ldc;
    __device__ __forceinline__ void operator()(const f32x4 (&acc)[2][2][4][2], const Unit& u, int wr, int wc, int fr, int fq) const {
        const int row0 = u.pm * BM + wr * 64 + fr, col0 = u.pn * BM + wc * 32 + 4 * fq;
#pragma unroll
        for (int ai = 0; ai < 2; ++ai)
#pragma unroll
            for (int m = 0; m < 4; ++m) { float* rowp = C + (size_t)(row0 + ai * HALF + m * 16) * ldc + col0;
#pragma unroll
                for (int bj = 0; bj < 2; ++bj)
#pragma unroll
                    for (int n = 0; n < 2; ++n) *(f32x4*)(rowp + bj * HALF + n * 16) = acc[ai][bj][m][n]; }
    }
};

struct EpiVT {
    static constexpr bool PERM = true, AFTER_DRAIN = false, SWAP23 = true;
    bf16_t* O;
    __device__ __forceinline__ void operator()(const f32x4 (&acc)[2][2][4][2], const Unit& u, int wr, int wc, int fr, int fq) const {
        const int row0 = u.pm * BM + wr * 64 + fr; const int colt = u.pn * BM; const int b = colt >> 12, pos0 = (colt & 4095) + wc * 32 + 8 * fq;
        bf16_t* base = O + (size_t)b * 8192 * 4096 + pos0;
#pragma unroll
        for (int ai = 0; ai < 2; ++ai)
#pragma unroll
            for (int m = 0; m < 4; ++m) { bf16_t* rowp = base + (size_t)(row0 + ai * HALF + m * 16) * 4096;
#pragma unroll
                for (int bj = 0; bj < 2; ++bj) { const f32x4 v0 = acc[ai][bj][m][0], v1 = acc[ai][bj][m][1];
                    u32x4 w; w.x = pk2(v0[0], v0[1]); w.y = pk2(v0[2], v0[3]); w.z = pk2(v1[0], v1[1]); w.w = pk2(v1[2], v1[3]);
                    *(u32x4*)(rowp + bj * HALF) = w; } }
    }
};

struct EpiKNorm {
    static constexpr bool PERM = true, AFTER_DRAIN = false, SWAP23 = false;
    bf16_t* KM; const float* sspe; const float* kper; const float* gain; PG8_LAS float* tab; mutable unsigned par;
    __device__ __forceinline__ void operator()(const f32x4 (&acc)[2][2][4][2], const Unit& u, int wr, int wc, int fr, int fq) const {
        PG8_LAS float* T = tab + par * 2048;
#pragma unroll
        for (int ai = 0; ai < 2; ++ai)
#pragma unroll
            for (int m = 0; m < 4; ++m) { const int row = ai * HALF + wr * 64 + m * 16 + fr;
#pragma unroll
                for (int bj = 0; bj < 2; ++bj) { const f32x4 x = acc[ai][bj][m][0], y = acc[ai][bj][m][1];
                    float ss = (x[0] * x[0] + x[1] * x[1]) + (x[2] * x[2] + x[3] * x[3]) + (y[0] * y[0] + y[1] * y[1]) + (y[2] * y[2] + y[3] * y[3]);
                    ss += __shfl_xor(ss, 16); ss += __shfl_xor(ss, 32);
                    if (fq == 0) T[row * 8 + bj * 4 + wc] = ss; } }
        asm volatile("s_waitcnt lgkmcnt(0)" ::: "memory"); __builtin_amdgcn_s_barrier(); asm volatile("" ::: "memory");
        const f32x4 g0 = *(const f32x4*)(gain + wc * 32 + 8 * fq), g1 = *(const f32x4*)(gain + wc * 32 + 8 * fq + 4);
        const int tok0 = u.pm * BM, b = tok0 >> 12;
#pragma unroll
        for (int ai = 0; ai < 2; ++ai)
#pragma unroll
            for (int m = 0; m < 4; ++m) { const int row = ai * HALF + wr * 64 + m * 16 + fr, tok = tok0 + row, s = tok & 4095;
                const float sp = sspe[tok]; const f32x4 kp = *(const f32x4*)(kper + (size_t)tok * 64 + wc * 16 + 4 * fq);
#pragma unroll
                for (int bj = 0; bj < 2; ++bj) { const f32x4 t = *(const PG8_LAS f32x4*)(T + row * 8 + bj * 4);
                    const float rstd = rsqrtf(((t[0] + t[1]) + (t[2] + t[3]) + sp) * (1.0f / 192.0f) + 1e-6f);
                    const int hd = 2 * u.pn + bj;
                    bf16_t* kb = KM + ((size_t)(b * 64 + hd) * 4096 + s) * 192;
                    const f32x4 x = acc[ai][bj][m][0], y = acc[ai][bj][m][1];
                    u32x4 w; w.x = pk2(x[0] * rstd * g0[0], x[1] * rstd * g0[1]); w.y = pk2(x[2] * rstd * g0[2], x[3] * rstd * g0[3]);
                    w.z = pk2(y[0] * rstd * g1[0], y[1] * rstd * g1[1]); w.w = pk2(y[2] * rstd * g1[2], y[3] * rstd * g1[3]);
                    *(u32x4*)(kb + wc * 32 + 8 * fq) = w;
                    u32x2 r; r.x = pk2(kp[0] * rstd, kp[1] * rstd); r.y = pk2(kp[2] * rstd, kp[3] * rstd);
                    *(u32x2*)(kb + 128 + wc * 16 + 4 * fq) = r; } }
        par ^= 1u;
    }
};

struct EpiResNorm {
    static constexpr bool PERM = false, AFTER_DRAIN = false, SWAP23 = false;
    const float* base; float* out; int ldc; const float* gain; bf16_t* xg; float* ss;
    __device__ __forceinline__ void operator()(const f32x4 (&acc)[2][2][4][2], const Unit& u, int wr, int wc, int fr, int fq) const {
        const int row0 = u.pm * BM + wr * 64 + fr, col0 = u.pn * BM + wc * 32 + 4 * fq;
        f32x4 gv[2][2];
#pragma unroll
        for (int bj = 0; bj < 2; ++bj)
#pragma unroll
            for (int n = 0; n < 2; ++n) gv[bj][n] = *(const f32x4*)(gain + col0 + bj * HALF + n * 16);
#pragma unroll
        for (int ai = 0; ai < 2; ++ai)
#pragma unroll
            for (int m = 0; m < 4; ++m) { const int row = row0 + ai * HALF + m * 16; const size_t off = (size_t)row * ldc + col0; float sq = 0.f;
#pragma unroll
                for (int bj = 0; bj < 2; ++bj)
#pragma unroll
                    for (int n = 0; n < 2; ++n) { const f32x4 bs = *(const f32x4*)(base + off + bj * HALF + n * 16); const f32x4 v = bs + acc[ai][bj][m][n];
                        *(f32x4*)(out + off + bj * HALF + n * 16) = v;
                        sq += (v[0] * v[0] + v[1] * v[1]) + (v[2] * v[2] + v[3] * v[3]);
                        const f32x4 g = gv[bj][n]; u32x2 w; w.x = pk2(v[0] * g[0], v[1] * g[1]); w.y = pk2(v[2] * g[2], v[3] * g[3]);
                        *(u32x2*)(xg + off + bj * HALF + n * 16) = w; }
                sq += __shfl_xor(sq, 16); sq += __shfl_xor(sq, 32);
                if (fq == 0) atomicAdd(ss + row, sq); }
    }
};
struct EpiStoreBf16RowScale {
    static constexpr bool PERM = true, AFTER_DRAIN = false, SWAP23 = false;
    bf16_t* O; int ldc; const float* ss; float inv_dim;
    __device__ __forceinline__ void operator()(const f32x4 (&acc)[2][2][4][2], const Unit& u, int wr, int wc, int fr, int fq) const {
        const int row0 = u.pm * BM + wr * 64 + fr; const int col0 = u.pn * BM + wc * 32 + 8 * fq;
#pragma unroll
        for (int ai = 0; ai < 2; ++ai)
#pragma unroll
            for (int m = 0; m < 4; ++m) { const int row = row0 + ai * HALF + m * 16; const float rs = rsqrtf(ss[row] * inv_dim + 1e-6f);
                bf16_t* rowp = O + (size_t)row * ldc + col0;
#pragma unroll
                for (int bj = 0; bj < 2; ++bj) { const f32x4 v0 = acc[ai][bj][m][0] * rs, v1 = acc[ai][bj][m][1] * rs;
                    u32x4 w; w.x = pk2(v0[0], v0[1]); w.y = pk2(v0[2], v0[3]); w.z = pk2(v1[0], v1[1]); w.w = pk2(v1[2], v1[3]);
                    *(u32x4*)(rowp + bj * HALF) = w; } }
    }
};
template <class Epi, class Sched, bool STAMP = false>
__device__ __forceinline__ void gemm_phase(PG8_LAS unsigned char* lds, const Gemm g, const Sched& S, const Epi& E, unsigned long long* stamps) {
    const int tid = tid_opaque(), wid = __builtin_amdgcn_readfirstlane(tid >> 6), lane = tid & 63, wr = wid >> 2, wc = wid & 3, fr = lane & 15, fq = lane >> 4;
    const int K = g.K, nt = K / BK;
    int ts_lo = 0, ts_hi = 0, nts = 0; const unsigned long long rt_entry = STAMP ? (unsigned long long)wall_clock64() : 0ull;
#define PG8_STAMP() do { if (STAMP && wid == 0 && nts < 64) { const unsigned long long _c = (unsigned long long)clock64(); \
        ts_lo = (lane == nts) ? (int)(unsigned)_c : ts_lo; ts_hi = (lane == nts) ? (int)(unsigned)(_c >> 32) : ts_hi; ++nts; } } while (0)
    PG8_STAMP();
    unsigned voffA[2], voffB[2];
#pragma unroll
    for (int i = 0; i < 2; ++i) { int R, C; stage_rc(tid * 16 + i * 8192, R, C); int Rb = Epi::PERM ? ((R & ~31) + perm32(R & 31)) : R; if (Epi::SWAP23) Rb = vt_key_of_pos(Rb);
        voffA[i] = (unsigned)(R * K + C) * 2u; voffB[i] = (unsigned)(Rb * K + C) * 2u; }
    const size_t kstep = (size_t)(BK * 2);
    const size_t hstep = (size_t)HALF * K * 2;
    const size_t tstep = 2 * hstep;
    const unsigned ldsw = (unsigned)wid * 1024u;
    const int aoff = lds_byte(wr * 64 + fr, fq * 8), boff = lds_byte(wc * 32 + fr, fq * 8);
#define PG8_SA(b, h) (((b) * 2 + (h)) * HTB)
#define PG8_SB(b, h) ((4 + (b) * 2 + (h)) * HTB)
#define PG8_STAGE(bufoff, gbase, voff) do { _Pragma("unroll") for (int _i = 0; _i < 2; ++_i) \
        __builtin_amdgcn_global_load_lds((const unsigned*)((const char*)(gbase) + (voff)[_i]), (PG8_LAS unsigned*)(lds + (bufoff) + ldsw + _i * 8192), 16, 0, 0); } while (0)
#define PG8_LDA(dst, b, h) do { _Pragma("unroll") for (int m = 0; m < 4; ++m) _Pragma("unroll") for (int k = 0; k < 2; ++k) dst[m][k] = *(const PG8_LAS bf16x8*)(lds + PG8_SA(b, h) + aoff + m * 2048 + k * 1024); } while (0)
#define PG8_LDB(dst, b, h) do { _Pragma("unroll") for (int n = 0; n < 2; ++n) _Pragma("unroll") for (int k = 0; k < 2; ++k) dst[n][k] = *(const PG8_LAS bf16x8*)(lds + PG8_SB(b, h) + boff + n * 2048 + k * 1024); } while (0)
#define PG8_MMA(ai, bj, At, Bt) do { __builtin_amdgcn_s_setprio(1); _Pragma("unroll") for (int m = 0; m < 4; ++m) _Pragma("unroll") for (int n = 0; n < 2; ++n) _Pragma("unroll") for (int k = 0; k < 2; ++k) \
        acc[ai][bj][m][n] = __builtin_amdgcn_mfma_f32_16x16x32_bf16(Bt[n][k], At[m][k], acc[ai][bj][m][n], 0, 0, 0); __builtin_amdgcn_s_setprio(0); } while (0)
#define PG8_WAIT_V(n) asm volatile("s_waitcnt vmcnt(" #n ")" ::: "memory")
#define PG8_WAIT_L(n) asm volatile("s_waitcnt lgkmcnt(" #n ")" ::: "memory")
#define PG8_BAR __builtin_amdgcn_s_barrier()
#define PG8_SCHED __builtin_amdgcn_sched_barrier(0)
    Unit cur, nxt; int ui = 0;
    if (!S.next(0, cur)) return;
    f32x4 acc[2][2][4][2];
#pragma unroll
    for (int a = 0; a < 2; ++a)
#pragma unroll
        for (int b = 0; b < 2; ++b)
#pragma unroll
            for (int m = 0; m < 4; ++m)
#pragma unroll
                for (int n = 0; n < 2; ++n) acc[a][b][m][n] = (f32x4){0.f, 0.f, 0.f, 0.f};
    bf16x8 At[4][2], B0[2][2], B1[2][2];
    const char* cA = (const char*)g.A + (size_t)cur.pm * tstep; const char* cB = (const char*)g.Bt + (size_t)cur.pn * tstep;
    S.a_ready(cur);
    PG8_STAGE(PG8_SB(0, 0), cB, voffB); PG8_STAGE(PG8_SA(0, 0), cA, voffA); PG8_STAGE(PG8_SB(0, 1), cB + hstep, voffB); PG8_STAGE(PG8_SA(0, 1), cA + hstep, voffA);
    if (wr == 1) PG8_BAR;
    PG8_WAIT_V(4); PG8_BAR;
    PG8_STAGE(PG8_SB(1, 0), cB + kstep, voffB); PG8_STAGE(PG8_SA(1, 0), cA + kstep, voffA); PG8_STAGE(PG8_SB(1, 1), cB + hstep + kstep, voffB);
    PG8_WAIT_V(6); PG8_BAR;
    PG8_STAMP();
    for (;;) {
        const bool has_next = S.next(ui + 1, nxt);
        const char* nA = has_next ? (const char*)g.A + (size_t)nxt.pm * tstep : cA; const char* nB = has_next ? (const char*)g.Bt + (size_t)nxt.pn * tstep : cB;
        for (int t = 0; t < nt; t += 2) {
            const bool last = (t == nt - 2);
            const char* a1 = cA + (size_t)(t + 1) * kstep;
            const char* a2 = last ? nA : cA + (size_t)(t + 2) * kstep; const char* b2 = last ? nB : cB + (size_t)(t + 2) * kstep;
            const char* a3 = a2 + kstep; const char* b3 = b2 + kstep;
            if (last && has_next) S.a_ready(nxt);
            PG8_LDB(B0, 0, 0); PG8_SCHED; PG8_LDA(At, 0, 0); PG8_STAGE(PG8_SA(1, 1), a1 + hstep, voffA);
            PG8_WAIT_L(8); PG8_BAR; PG8_WAIT_L(0); PG8_MMA(0, 0, At, B0); PG8_BAR; PG8_SCHED;
            PG8_LDB(B1, 0, 1); PG8_STAGE(PG8_SB(0, 0), b2, voffB);
            PG8_BAR; PG8_WAIT_L(0); PG8_MMA(0, 1, At, B1); PG8_BAR;
            PG8_LDA(At, 0, 1); PG8_STAGE(PG8_SA(0, 0), a2, voffA);
            PG8_BAR; PG8_WAIT_L(0); PG8_MMA(1, 0, At, B0); PG8_BAR; PG8_SCHED;
            PG8_STAGE(PG8_SB(0, 1), b2 + hstep, voffB);
            PG8_WAIT_V(6); PG8_BAR; PG8_MMA(1, 1, At, B1); PG8_BAR;
            PG8_LDB(B0, 1, 0); PG8_SCHED; PG8_LDA(At, 1, 0); PG8_STAGE(PG8_SA(0, 1), a2 + hstep, voffA);
            PG8_WAIT_L(8); PG8_BAR; PG8_WAIT_L(0); PG8_MMA(0, 0, At, B0); PG8_BAR; PG8_SCHED;
            PG8_LDB(B1, 1, 1); PG8_STAGE(PG8_SB(1, 0), b3, voffB);
            PG8_BAR; PG8_WAIT_L(0); PG8_MMA(0, 1, At, B1); PG8_BAR;
            PG8_LDA(At, 1, 1); PG8_STAGE(PG8_SA(1, 0), a3, voffA);
            PG8_BAR; PG8_WAIT_L(0); PG8_MMA(1, 0, At, B0); PG8_BAR; PG8_SCHED;
            PG8_STAGE(PG8_SB(1, 1), b3 + hstep, voffB);
            PG8_WAIT_V(6); PG8_BAR; PG8_MMA(1, 1, At, B1); PG8_BAR;
        }
        PG8_STAMP();
        if constexpr (!Epi::AFTER_DRAIN) { E(acc, cur, wr, wc, fr, fq); S.done(cur); }
        PG8_STAMP();
        if (!has_next) break;
#pragma unroll
        for (int a = 0; a < 2; ++a)
#pragma unroll
            for (int b = 0; b < 2; ++b)
#pragma unroll
                for (int m = 0; m < 4; ++m)
#pragma unroll
                    for (int n = 0; n < 2; ++n) acc[a][b][m][n] = (f32x4){0.f, 0.f, 0.f, 0.f};
        cur = nxt; cA = nA; cB = nB; ++ui;
    }
    PG8_WAIT_V(0);
    if (wr == 0) PG8_BAR;
    PG8_BAR;
    if constexpr (Epi::AFTER_DRAIN) { E.fused(acc, cur, wr, wc, fr, fq, lds, wid, lane); S.done(cur); }
    PG8_STAMP();
    if (STAMP && wid == 0) { stamps[lane] = lane < nts ? (((unsigned long long)(unsigned)ts_hi << 32) | (unsigned)ts_lo) : 0ull;
        if (lane == 62) stamps[62] = rt_entry; if (lane == 63) stamps[63] = (unsigned long long)wall_clock64(); }
#undef PG8_STAMP
#undef PG8_SA
#undef PG8_SB
#undef PG8_STAGE
#undef PG8_LDA
#undef PG8_LDB
#undef PG8_MMA
#undef PG8_WAIT_V
#undef PG8_WAIT_L
#undef PG8_BAR
#undef PG8_SCHED
}
}


DI void phase_wconv(LAS unsigned char* lds, const float* __restrict__ src, bf16_t* __restrict__ dst, int K, int N, int Npad, int bid, int nb, float q8s = 0.f, int colmap = 0) {
    LAS float* tile = (LAS float*)lds;
    const int tid = tid_opaque();
    const int tk = K / 64, tn = Npad / 256, total = tk * tn;
    for (int t = bid; t < total; t += nb) {
        const int k0 = (t % tk) * 64, n0 = (t / tk) * 256;
        __syncthreads();
        {
            const int ty = tid >> 6, tx = tid & 63, n = n0 + tx * 4;
            f32x4 v[8];
#pragma unroll
            for (int i = 0; i < 8; ++i) {
                const int k = k0 + ty + 8 * i;
                v[i] = (f32x4){0.f, 0.f, 0.f, 0.f};
                if (colmap) { const int ns = (n >> 7) * 256 + (colmap == 1 ? 128 : 0) + (n & 127); v[i] = *(const f32x4*)(src + (size_t)k * (2 * N) + ns); }
                else if (n < N) v[i] = *(const f32x4*)(src + (size_t)k * N + n);
            }
#pragma unroll
            for (int i = 0; i < 8; ++i) { LAS float* pp = tile + (ty + 8 * i) * 257 + tx * 4; pp[0] = v[i][0]; pp[1] = v[i][1]; pp[2] = v[i][2]; pp[3] = v[i][3]; }
        }
        __syncthreads();
#pragma unroll
        for (int ps_ = 0; ps_ < 4; ++ps_) {
            const int n = (tid >> 3) + 64 * ps_, kc = tid & 7;
            float v[8];
#pragma unroll
            for (int j = 0; j < 8; ++j) { v[j] = tile[(kc * 8 + j) * 257 + n]; if (q8s > 0.f) v[j] = emu_q8(v[j], q8s); else if (q8s < 0.f && n0 + n >= C_ZC) v[j] = emu_q8(v[j], -q8s); }
            u32x4 w; w.x = pk2(v[0], v[1]); w.y = pk2(v[2], v[3]); w.z = pk2(v[4], v[5]); w.w = pk2(v[6], v[7]);
            *(u32x4*)(dst + (size_t)(n0 + n) * K + k0 + kc * 8) = w;
        }
    }
}

DI void phase_rmsnorm(const float* __restrict__ x, const float* __restrict__ gain, bf16_t* __restrict__ h, int bid, int nb, float q8s = 0.f) {
    const int tid = tid_opaque(); const int lane = tid & 63, wid = tid >> 6;
    for (int row = bid * 8 + wid; row < MTOK; row += nb * 8) {
        const float* xr = x + (size_t)row * DM;
        f32x4 v[16]; float ss = 0.f;
#pragma unroll
        for (int i = 0; i < 16; ++i) { v[i] = *(const f32x4*)(xr + (i * 64 + lane) * 4); ss += v[i][0] * v[i][0] + v[i][1] * v[i][1] + v[i][2] * v[i][2] + v[i][3] * v[i][3]; }
#pragma unroll
        for (int o = 32; o >= 1; o >>= 1) ss += __shfl_xor(ss, o);
        const float rstd = rsqrtf(ss * (1.0f / DM) + EPSN);
        bf16_t* hr = h + (size_t)row * DM;
#pragma unroll
        for (int i = 0; i < 16; ++i) { const f32x4 g = *(const f32x4*)(gain + (i * 64 + lane) * 4);
            float y0 = v[i][0] * rstd * g[0], y1 = v[i][1] * rstd * g[1], y2 = v[i][2] * rstd * g[2], y3 = v[i][3] * rstd * g[3];
            if (q8s > 0.f || (q8s < 0.f && (row & 4095) >= 256)) { const float qa = fabsf(q8s); y0 = emu_q8(y0, qa); y1 = emu_q8(y1, qa); y2 = emu_q8(y2, qa); y3 = emu_q8(y3, qa); }
            u32x2 w; w.x = pk2(y0, y1); w.y = pk2(y2, y3);
            *(u32x2*)(hr + (i * 64 + lane) * 4) = w; }
    }
}

DI void ld192(const bf16_t* p, int j8, float (&v)[24]) {
#pragma unroll
    for (int c = 0; c < 3; ++c) { const u32x4 w = *(const u32x4*)(p + (j8 + 8 * c) * 8);
        v[c * 8 + 0] = bflo(w.x); v[c * 8 + 1] = bfhi(w.x); v[c * 8 + 2] = bflo(w.y); v[c * 8 + 3] = bfhi(w.y);
        v[c * 8 + 4] = bflo(w.z); v[c * 8 + 5] = bfhi(w.z); v[c * 8 + 6] = bflo(w.w); v[c * 8 + 7] = bfhi(w.w); }
}
DI void st192(bf16_t* p, int j8, const float (&v)[24]) {
#pragma unroll
    for (int c = 0; c < 3; ++c) { u32x4 w; w.x = pk2(v[c * 8 + 0], v[c * 8 + 1]); w.y = pk2(v[c * 8 + 2], v[c * 8 + 3]); w.z = pk2(v[c * 8 + 4], v[c * 8 + 5]); w.w = pk2(v[c * 8 + 6], v[c * 8 + 7]);
        *(u32x4*)(p + (j8 + 8 * c) * 8) = w; }
}
DI float sum8(float s) { s += __shfl_xor(s, 1); s += __shfl_xor(s, 2); s += __shfl_xor(s, 4); return s; }

DI void phase_nsa_prep(const Params& P, int bid, int nb) {
    bf16_t* Y0 = (bf16_t*)(P.ws + OFF_Y0);
    bf16_t* KS = (bf16_t*)(P.ws + OFF_KS); bf16_t* KW = (bf16_t*)(P.ws + OFF_KW);
    bf16_t* ACK = (bf16_t*)(P.ws + OFF_ACK); bf16_t* ACV = (bf16_t*)(P.ws + OFF_ACV);
    const int tid = tid_opaque(), grp = (tid >> 3) & 15, j8 = tid & 7;
    for (int tok = bid * 4 + (tid >> 7); tok < MTOK; tok += nb * 4) {
        const int b = tok / SEQ, s = tok % SEQ;
        bf16_t* yr = Y0 + (size_t)tok * N1P;
        if (grp < 8) {
            const int g = grp & 3, br = grp >> 2;
            float v[24]; ld192(yr + (br ? C_KVW : C_KVS) + g * DK, j8, v);
            float ss = 0.f;
#pragma unroll
            for (int i = 0; i < 24; ++i) ss += v[i] * v[i];
            ss = sum8(ss);
            const float rstd = rsqrtf(ss * (1.0f / DK) + EPSN);
            const float* kn = P.nsa_k_norm + (br ? 2 : 1) * DK;
#pragma unroll
            for (int c = 0; c < 3; ++c)
#pragma unroll
                for (int e = 0; e < 8; ++e) v[c * 8 + e] *= rstd * kn[(j8 + 8 * c) * 8 + e];
            st192((br ? KW : KS) + ((size_t)(b * NG + g) * SEQ + s) * DK, j8, v);
        } else if (grp < 12) {
            const int g = grp - 8;
            float v[24]; ld192(yr + C_KVC + g * DK, j8, v);
#pragma unroll
            for (int k = 0; k < 2; ++k) {
                const int n = (s >> 4) - k, l = s - 16 * n;
                if (n >= 0 && n <= 254) {
                    float w[24];
#pragma unroll
                    for (int c = 0; c < 3; ++c)
#pragma unroll
                        for (int e = 0; e < 8; ++e) w[c * 8 + e] = v[c * 8 + e] + P.pe_k[l * DK + (j8 + 8 * c) * 8 + e];
                    st192(ACK + ((size_t)((b * NG + g) * 256 + n)) * 6144 + l * DK, j8, w);
                }
            }
        } else if (grp < 16) {
            const int g = grp - 12;
            const bf16_t* src = yr + C_KVC + NG * DK + g * DV;
            float v[16];
#pragma unroll
            for (int c = 0; c < 2; ++c) { const u32x4 w = *(const u32x4*)(src + (j8 + 8 * c) * 8);
                v[c * 8 + 0] = bflo(w.x); v[c * 8 + 1] = bfhi(w.x); v[c * 8 + 2] = bflo(w.y); v[c * 8 + 3] = bfhi(w.y);
                v[c * 8 + 4] = bflo(w.z); v[c * 8 + 5] = bfhi(w.z); v[c * 8 + 6] = bflo(w.w); v[c * 8 + 7] = bfhi(w.w); }
#pragma unroll
            for (int k = 0; k < 2; ++k) {
                const int n = (s >> 4) - k, l = s - 16 * n;
                if (n >= 0 && n <= 254) {
                    bf16_t* dst = ACV + ((size_t)((b * NG + g) * 256 + n)) * 4096 + l * DV;
#pragma unroll
                    for (int c = 0; c < 2; ++c) { float w[8];
#pragma unroll
                        for (int e = 0; e < 8; ++e) w[e] = v[c * 8 + e] + P.pe_v[l * DV + (j8 + 8 * c) * 8 + e];
                        u32x4 o; o.x = pk2(w[0], w[1]); o.y = pk2(w[2], w[3]); o.z = pk2(w[4], w[5]); o.w = pk2(w[6], w[7]);
                        *(u32x4*)(dst + (j8 + 8 * c) * 8) = o; }
                }
            }
        }
    }
    for (int i = bid * 512 + tid; i < 16 * (6144 + 4096) / 8; i += nb * 512) {
        const int per = (6144 + 4096) / 8, bg = i / per, c = i % per;
        const u32x4 z = {0u, 0u, 0u, 0u};
        if (c < 6144 / 8) *(u32x4*)(ACK + ((size_t)(bg * 256 + 255)) * 6144 + c * 8) = z;
        else *(u32x4*)(ACV + ((size_t)(bg * 256 + 255)) * 4096 + (c - 6144 / 8) * 8) = z;
    }
}

DI int swap23(int p) { return (p & ~0xC) | ((p & 4) << 1) | ((p & 8) >> 1); }
DI void phase_vt(LAS unsigned char* lds, const bf16_t* __restrict__ src, size_t src_stride, int col0, int col_step, int nhv, bf16_t* __restrict__ dst, int bid, int nb) {
    LAS bf16_t* tile = (LAS bf16_t*)lds;
    const int tid = tid_opaque();
    const int ntile = SEQ / 64, total = BATCH * nhv * ntile;
    for (int it = bid; it < total; it += nb) {
        const int mat = it / ntile, tt = it % ntile, b = mat / nhv, hv = mat % nhv;
        __syncthreads();
#pragma unroll
        for (int i = 0; i < 2; ++i) {
            const int q = tid + 512 * i, tok = q >> 4, ch = q & 15;
            const u32x4 w = *(const u32x4*)(src + (size_t)(b * SEQ + tt * 64 + tok) * src_stride + col0 + hv * col_step + ch * 8);
            *(LAS u32x4*)(tile + tok * 136 + ch * 8) = w;
        }
        __syncthreads();
        {
            const int dv = tid >> 2, kq = tid & 3;
            unsigned w[8];
#pragma unroll
            for (int e = 0; e < 8; ++e) {
                const int p0 = kq * 16 + 2 * e, p1 = p0 + 1;
                const int k0 = vt_key_of_pos(p0), k1 = vt_key_of_pos(p1);
                w[e] = (unsigned)tile[k0 * 136 + dv] | ((unsigned)tile[k1 * 136 + dv] << 16);
            }
            bf16_t* d = dst + ((size_t)mat * DV + dv) * SEQ + tt * 64 + kq * 16;
            u32x4 a = {w[0], w[1], w[2], w[3]}, c = {w[4], w[5], w[6], w[7]};
            *(u32x4*)d = a; *(u32x4*)(d + 8) = c;
        }
    }
}

DI void phase_cmp2(LAS unsigned char* lds, const Params& P, int bid, int nb) {
    LAS float* sk = (LAS float*)lds;
    LAS float* sv = sk + 192;
    LAS float* red = sv + 128;
    const float* HIDK = (const float*)(P.ws + OFF_HIDK); const float* HIDV = (const float*)(P.ws + OFF_HIDV);
    bf16_t* KC = (bf16_t*)(P.ws + OFF_KC); bf16_t* VTC = (bf16_t*)(P.ws + OFF_VTC);
    const int tid = tid_opaque(), lane = tid & 63, wid = tid >> 6;
    for (int m = bid; m < 4096; m += nb) {
        const int n = m & 255, bg = m >> 8;
        __syncthreads();
        if (tid < 192) { const float h = HIDK[(size_t)m * 256 + tid]; sk[tid] = h / (1.0f + __expf(-h)); }
        else if (tid < 320) { const float h = HIDV[(size_t)m * 256 + tid - 192]; sv[tid - 192] = h / (1.0f + __expf(-h)); }
        __syncthreads();
        float acc = 0.f;
        if (tid < 192) { for (int i = 0; i < 192; ++i) acc += sk[i] * P.w2_k[i * 192 + tid]; }
        else if (tid < 320) { const int j = tid - 192; for (int i = 0; i < 128; ++i) acc += sv[i] * P.w2_v[i * 128 + j]; }
        float ss = (tid < 192) ? acc * acc : 0.f;
#pragma unroll
        for (int o = 32; o >= 1; o >>= 1) ss += __shfl_xor(ss, o);
        if (lane == 0) red[wid] = ss;
        __syncthreads();
        const float tot = red[0] + red[1] + red[2];
        const float rstd = rsqrtf(tot * (1.0f / DK) + EPSN);
        if (tid < 192) { const float o = (n == 255) ? 0.f : acc * rstd * P.nsa_k_norm[tid];
            KC[(size_t)m * DK + tid] = (bf16_t)(pk2(o, 0.f) & 0xffffu); }
        else if (tid < 320) { const int j = tid - 192; const float o = (n == 255) ? 0.f : acc;
            const int pn = vt_pos_of_key(n);
            VTC[((size_t)bg * DV + j) * 256 + pn] = (bf16_t)(pk2(o, 0.f) & 0xffffu); }
    }
}

DI void phase_mla_prep1(const Params& P, int bid, int nb) {
    const bf16_t* Y1 = (const bf16_t*)(P.ws + OFF_Y1);
    bf16_t* CQN = (bf16_t*)(P.ws + OFF_CQN); bf16_t* CKVN = (bf16_t*)(P.ws + OFF_CKVN); float* ROPE = (float*)(P.ws + OFF_ROPE);
    float* KPER = (float*)(P.ws + OFF_KPER); float* SSPE = (float*)(P.ws + OFF_SSPE);
    const int tid = tid_opaque(); const int lane = tid & 63, wid = tid >> 6;
    constexpr int TU = 4;
    for (int tok0 = (bid * 8 + wid) * TU; tok0 < MTOK; tok0 += nb * 8 * TU) {
        u32x4 wq[TU][3], wk[TU]; int pos[TU]; bf16_t kp1[TU], kp2[TU];
#pragma unroll
        for (int t = 0; t < TU; ++t) { const bf16_t* yr = Y1 + (size_t)(tok0 + t) * N3P;
#pragma unroll
            for (int c = 0; c < 3; ++c) wq[t][c] = *(const u32x4*)(yr + C3_CQ + (c * 64 + lane) * 8);
            wk[t] = *(const u32x4*)(yr + C3_CKV + lane * 8);
            pos[t] = P.pos[tok0 + t]; kp1[t] = yr[C3_KPE + (lane & 31)]; kp2[t] = yr[C3_KPE + 32 + (lane & 31)]; }
#pragma unroll
        for (int t = 0; t < TU; ++t) { const int tok = tok0 + t;
            {
                float v[24]; float ss = 0.f;
#pragma unroll
                for (int c = 0; c < 3; ++c) { const u32x4 w = wq[t][c];
                    v[c * 8 + 0] = bflo(w.x); v[c * 8 + 1] = bfhi(w.x); v[c * 8 + 2] = bflo(w.y); v[c * 8 + 3] = bfhi(w.y);
                    v[c * 8 + 4] = bflo(w.z); v[c * 8 + 5] = bfhi(w.z); v[c * 8 + 6] = bflo(w.w); v[c * 8 + 7] = bfhi(w.w); }
#pragma unroll
                for (int i = 0; i < 24; ++i) ss += v[i] * v[i];
#pragma unroll
                for (int o = 32; o >= 1; o >>= 1) ss += __shfl_xor(ss, o);
                const float rstd = rsqrtf(ss * (1.0f / QLORA) + EPSN);
#pragma unroll
                for (int c = 0; c < 3; ++c) { const float* g = P.mla_q_a_norm + (c * 64 + lane) * 8; const f32x4 g0 = *(const f32x4*)g, g1 = *(const f32x4*)(g + 4); u32x4 w;
                    w.x = pk2(v[c * 8 + 0] * rstd * g0[0], v[c * 8 + 1] * rstd * g0[1]); w.y = pk2(v[c * 8 + 2] * rstd * g0[2], v[c * 8 + 3] * rstd * g0[3]);
                    w.z = pk2(v[c * 8 + 4] * rstd * g1[0], v[c * 8 + 5] * rstd * g1[1]); w.w = pk2(v[c * 8 + 6] * rstd * g1[2], v[c * 8 + 7] * rstd * g1[3]);
                    *(u32x4*)(CQN + (size_t)tok * QLORA + (c * 64 + lane) * 8) = w; }
            }
            {
                float v[8]; float ss = 0.f; const u32x4 w0 = wk[t];
                v[0] = bflo(w0.x); v[1] = bfhi(w0.x); v[2] = bflo(w0.y); v[3] = bfhi(w0.y); v[4] = bflo(w0.z); v[5] = bfhi(w0.z); v[6] = bflo(w0.w); v[7] = bfhi(w0.w);
#pragma unroll
                for (int i = 0; i < 8; ++i) ss += v[i] * v[i];
#pragma unroll
                for (int o = 32; o >= 1; o >>= 1) ss += __shfl_xor(ss, o);
                const float rstd = rsqrtf(ss * (1.0f / KVLORA) + EPSN);
                const float* g = P.mla_kv_a_norm + lane * 8; const f32x4 g0 = *(const f32x4*)g, g1 = *(const f32x4*)(g + 4); u32x4 w;
                w.x = pk2(v[0] * rstd * g0[0], v[1] * rstd * g0[1]); w.y = pk2(v[2] * rstd * g0[2], v[3] * rstd * g0[3]);
                w.z = pk2(v[4] * rstd * g1[0], v[5] * rstd * g1[1]); w.w = pk2(v[6] * rstd * g1[2], v[7] * rstd * g1[3]);
                *(u32x4*)(CKVN + (size_t)tok * KVLORA + lane * 8) = w;
            }
            {
                const int i = lane & 31;
                const float invf = exp2f(-(float)i * (13.287712379549449f / 32.0f));
                const float ang = (float)pos[t] * invf;
                const double rev = (double)ang * 0.15915494309189533576888;
                const float fr = (float)(rev - __builtin_rint(rev));
                const float sn = __builtin_amdgcn_sinf(fr), cs = __builtin_amdgcn_cosf(fr);
                const float x1 = bf1(kp1[t]), x2 = bf1(kp2[t]);
                float ssp = x1 * x1 + x2 * x2;
#pragma unroll
                for (int o = 16; o >= 1; o >>= 1) ssp += __shfl_xor(ssp, o);
                const float a = x1 * P.mla_k_norm[128 + i], c = x2 * P.mla_k_norm[160 + i];
                if (lane < 32) { ROPE[(size_t)tok * 64 + i] = cs; ROPE[(size_t)tok * 64 + 32 + i] = sn;
                    KPER[(size_t)tok * 64 + i] = a * cs - c * sn; KPER[(size_t)tok * 64 + 32 + i] = c * cs + a * sn;
                    if (lane == 0) SSPE[tok] = ssp; }
            }
        }
    }
}

DI void phase_mla_prep2(const Params& P, int bid, int nb) {
    const bf16_t* KNM = (const bf16_t*)(P.ws + OFF_KNM); const bf16_t* Y1 = (const bf16_t*)(P.ws + OFF_Y1);
    bf16_t* KM = (bf16_t*)(P.ws + OFF_KM); const float* ROPE = (const float*)(P.ws + OFF_ROPE);
    const int tid = tid_opaque(), grp = tid >> 3, j8 = tid & 7;
    for (int tok = bid; tok < MTOK; tok += nb) {
        const int b = tok / SEQ, s = tok % SEQ;
        float cs[8], sn[8];
#pragma unroll
        for (int e = 0; e < 8; ++e) { const int i = (8 * j8 + e) & 31; cs[e] = ROPE[(size_t)tok * 64 + i]; sn[e] = ROPE[(size_t)tok * 64 + 32 + i]; }
        {
            const bf16_t* kn = KNM + (size_t)tok * (NH * 128) + grp * 128;
            const bf16_t* kp = Y1 + (size_t)tok * N3P + C3_KPE;
            float v[24];
#pragma unroll
            for (int c = 0; c < 2; ++c) { const u32x4 w = *(const u32x4*)(kn + (j8 + 8 * c) * 8);
                v[c * 8 + 0] = bflo(w.x); v[c * 8 + 1] = bfhi(w.x); v[c * 8 + 2] = bflo(w.y); v[c * 8 + 3] = bfhi(w.y);
                v[c * 8 + 4] = bflo(w.z); v[c * 8 + 5] = bfhi(w.z); v[c * 8 + 6] = bflo(w.w); v[c * 8 + 7] = bfhi(w.w); }
            { const u32x4 w = *(const u32x4*)(kp + j8 * 8);
                v[16] = bflo(w.x); v[17] = bfhi(w.x); v[18] = bflo(w.y); v[19] = bfhi(w.y); v[20] = bflo(w.z); v[21] = bfhi(w.z); v[22] = bflo(w.w); v[23] = bfhi(w.w); }
            float ss = 0.f;
#pragma unroll
            for (int i = 0; i < 24; ++i) ss += v[i] * v[i];
            ss = sum8(ss);
            const float rstd = rsqrtf(ss * (1.0f / DK) + EPSN);
#pragma unroll
            for (int c = 0; c < 3; ++c)
#pragma unroll
                for (int e = 0; e < 8; ++e) v[c * 8 + e] *= rstd * P.mla_k_norm[(j8 + 8 * c) * 8 + e];
#pragma unroll
            for (int e = 0; e < 8; ++e) { const float mine = v[16 + e], other = __shfl_xor(mine, 4);
                v[16 + e] = (j8 < 4) ? (mine * cs[e] - other * sn[e]) : (mine * cs[e] + other * sn[e]); }
            st192(KM + ((size_t)(b * NH + grp) * SEQ + s) * DK, j8, v);
        }
    }
}
#ifndef ATT_THR
#define ATT_THR 30.0f
#endif
#ifndef ATT3_KD
#define ATT3_KD 4
#endif
#ifndef ATT3_VD
#define ATT3_VD 4
#endif
#ifndef ATT_PS_LIMIT
#define ATT_PS_LIMIT (16.0f * 1073741824.0f)
#endif
constexpr int KT_BYTES = 64 * 384, VT_BYTES = 128 * 128;
constexpr int L_K = 0, L_V = 2 * KT_BYTES, L_LUT = L_V + 2 * VT_BYTES, LUT_PITCH = 129, L_X = L_LUT + 64 * LUT_PITCH * 4 + 16, L_IL = L_X + 16 * 16 * 64 * 2, L_END = L_IL + 16 * 16 * 4;
static_assert(L_END <= 151552, "attention LDS");
enum { MODE_MLA = 0, MODE_SEL = 3, MODE_WIN = 4, MODE_CMPX = 5 };
#define MFMA16(a, b, c) __builtin_amdgcn_mfma_f32_16x16x32_bf16((a), (b), (c), 0, 0, 0)

struct AttnLane3 {
    int tw0, tw1;
    int r16, g;
    const LAS float* lutrow;
    unsigned long long mk0, mk1;
    int curblk;
    int tokbase;
    mutable float carry[2];
};
template <int MODE> DI int tq_of(const AttnLane3& A, int qb) { return (MODE == MODE_MLA) ? A.tw0 + 16 * qb + A.r16 : A.tw0 + qb; }

template <int MODE, int QS>
DI void attn_tile3(const LAS unsigned char* kb, const LAS unsigned char* vb, LAS unsigned char* lds, int j, const bf16x8 (&q)[2][6], f32x4 (&o)[8][2], float (&m_run)[2], float (&l_run)[2], const AttnLane3& A) {
    constexpr bool Q0 = (QS & 1) != 0, Q1 = (QS & 2) != 0;
    const int r16 = A.r16, g = A.g, sw = (r16 >> 1) & 7;
    const int kb0 = r16 * 384 + ((g ^ sw) << 4), kb1 = r16 * 384 + (((g ^ sw) ^ 4) << 4);
    const int vb0 = r16 * 128 + ((g ^ sw) << 4), vb1 = r16 * 128 + (((g ^ sw) ^ 4) << 4);
    f32x4 s[4][2];
    bool zinit = true;
    if (MODE == MODE_WIN || MODE == MODE_SEL) zinit = (A.tw0 - (64 * j + 63) >= 113);
    else if (MODE == MODE_CMPX) zinit = (A.tw0 - 31 - 16 * (64 * j + 63) >= 113);
    if (zinit) {
#pragma unroll
        for (int k4 = 0; k4 < 4; ++k4) { s[k4][0] = (f32x4){0.f, 0.f, 0.f, 0.f}; s[k4][1] = (f32x4){0.f, 0.f, 0.f, 0.f}; }
    } else {
#pragma unroll
        for (int qb = 0; qb < 2; ++qb) { if ((qb == 0 && !Q0) || (qb == 1 && !Q1)) continue;
            const int tq = tq_of<MODE>(A, qb);
#pragma unroll
            for (int k4 = 0; k4 < 4; ++k4)
#pragma unroll
                for (int r = 0; r < 4; ++r) { int d;
                    if (MODE == MODE_CMPX) d = tq - 31 - 16 * (64 * j + 16 * k4 + 4 * g + r); else d = tq - (64 * j + 16 * k4 + 4 * g + r);
                    d = d < 0 ? 0 : (d > 127 ? 127 : d); s[k4][qb][r] = A.lutrow[d] - m_run[qb]; } }
    }
    {
        constexpr int KD = ATT3_KD;
        bf16x8 kf[KD + 1];
#pragma unroll
        for (int i = 0; i < KD; ++i) kf[i] = *(const LAS bf16x8*)(kb + (((i % 6) & 1) ? kb1 : kb0) + ((i % 6) >> 1) * 128 + (i / 6) * (16 * 384));
        __builtin_amdgcn_sched_barrier(0);
#pragma unroll
        for (int i = 0; i < 24; ++i) {
            if (i + KD < 24) { const int n_ = i + KD; kf[n_ % (KD + 1)] = *(const LAS bf16x8*)(kb + (((n_ % 6) & 1) ? kb1 : kb0) + ((n_ % 6) >> 1) * 128 + (n_ / 6) * (16 * 384)); }
            __builtin_amdgcn_sched_barrier(0);
            if (Q0) s[i / 6][0] = MFMA16(kf[i % (KD + 1)], q[0][i % 6], s[i / 6][0]);
            if (Q1) s[i / 6][1] = MFMA16(kf[i % (KD + 1)], q[1][i % 6], s[i / 6][1]);
            __builtin_amdgcn_sched_barrier(0);
        }
    }
    if (zinit && __any(m_run[0] != 0.f || m_run[1] != 0.f)) {
#pragma unroll
        for (int k4 = 0; k4 < 4; ++k4)
#pragma unroll
            for (int r = 0; r < 4; ++r) { s[k4][0][r] -= m_run[0]; s[k4][1][r] -= m_run[1]; }
    }
    {
        const float NEG = -__builtin_inff();
        bool need;
        if (MODE == MODE_MLA) need = (64 * j + 63 > A.tw0);
        else if (MODE == MODE_WIN) need = !(64 * j + 63 <= A.tw0 && 64 * j >= A.tw1 - 511);
        else if (MODE == MODE_SEL) need = (j == A.curblk);
        else need = (A.tw0 - 31 - 16 * (64 * j + 63) < 0);
        if (need) {
#pragma unroll
            for (int qb = 0; qb < 2; ++qb) { if ((qb == 0 && !Q0) || (qb == 1 && !Q1)) continue;
                const int tq = tq_of<MODE>(A, qb);
#pragma unroll
                for (int k4 = 0; k4 < 4; ++k4)
#pragma unroll
                    for (int r = 0; r < 4; ++r) { const int c = 64 * j + 16 * k4 + 4 * g + r; bool kill;
                        if (MODE == MODE_WIN) kill = (unsigned)(tq - c) >= 512u;
                        else if (MODE == MODE_CMPX) kill = (tq - 31 - 16 * c) < 0;
                        else kill = (tq - c) < 0;
                        s[k4][qb][r] = kill ? NEG : s[k4][qb][r]; } }
        }
    }
    u32x4 pw[2][2];
#pragma unroll
    for (int qb = 0; qb < 2; ++qb) { if ((qb == 0 && !Q0) || (qb == 1 && !Q1)) continue;
        if (MODE == MODE_CMPX) {
            float lmx = fmaxf(fmaxf(s[0][qb][0], s[0][qb][1]), fmaxf(s[0][qb][2], s[0][qb][3]));
#pragma unroll
            for (int k4 = 1; k4 < 4; ++k4) lmx = fmaxf(lmx, fmaxf(fmaxf(s[k4][qb][0], s[k4][qb][1]), fmaxf(s[k4][qb][2], s[k4][qb][3])));
            if (__any(lmx > ATT_THR)) {
                float mx = fmaxf(lmx, __shfl_xor(lmx, 16)); mx = fmaxf(mx, __shfl_xor(mx, 32));
                const float dl = fmaxf(mx, 0.f), alpha = __builtin_amdgcn_exp2f(-dl);
                m_run[qb] += dl; l_run[qb] *= alpha; A.carry[qb] *= alpha;
#pragma unroll
                for (int db = 0; db < 8; ++db) o[db][qb] *= alpha;
#pragma unroll
                for (int k4 = 0; k4 < 4; ++k4) s[k4][qb] -= dl;
                LAS bf16_t* X = (LAS bf16_t*)(lds + L_X) + ((A.tokbase + qb) * 16 + r16) * 64;
                for (int a = g; a < 16 * j; a += 4) X[a] = (bf16_t)(pk2(bf1(X[a]) * alpha, 0.f) & 0xffffu);
            }
        }
        float ps = 0.f; f32x4 e[4];
#pragma unroll
        for (int k4 = 0; k4 < 4; ++k4) { e[k4][0] = __builtin_amdgcn_exp2f(s[k4][qb][0]); e[k4][1] = __builtin_amdgcn_exp2f(s[k4][qb][1]); e[k4][2] = __builtin_amdgcn_exp2f(s[k4][qb][2]); e[k4][3] = __builtin_amdgcn_exp2f(s[k4][qb][3]);
            ps += (e[k4][0] + e[k4][1]) + (e[k4][2] + e[k4][3]); }
        if (MODE != MODE_CMPX) {
            if (__any(!(ps <= ATT_PS_LIMIT))) {
                float mx = fmaxf(fmaxf(s[0][qb][0], s[0][qb][1]), fmaxf(s[0][qb][2], s[0][qb][3]));
#pragma unroll
                for (int k4 = 1; k4 < 4; ++k4) mx = fmaxf(mx, fmaxf(fmaxf(s[k4][qb][0], s[k4][qb][1]), fmaxf(s[k4][qb][2], s[k4][qb][3])));
                mx = fmaxf(mx, __shfl_xor(mx, 16)); mx = fmaxf(mx, __shfl_xor(mx, 32));
                const float dl = fmaxf(mx, 0.f), alpha = __builtin_amdgcn_exp2f(-dl);
                m_run[qb] += dl; l_run[qb] *= alpha;
#pragma unroll
                for (int db = 0; db < 8; ++db) o[db][qb] *= alpha;
                ps = 0.f;
#pragma unroll
                for (int k4 = 0; k4 < 4; ++k4) { e[k4][0] = __builtin_amdgcn_exp2f(s[k4][qb][0] - dl); e[k4][1] = __builtin_amdgcn_exp2f(s[k4][qb][1] - dl); e[k4][2] = __builtin_amdgcn_exp2f(s[k4][qb][2] - dl); e[k4][3] = __builtin_amdgcn_exp2f(s[k4][qb][3] - dl);
                    ps += (e[k4][0] + e[k4][1]) + (e[k4][2] + e[k4][3]); }
            }
        } else {
            LAS bf16_t* X = (LAS bf16_t*)(lds + L_X) + ((A.tokbase + qb) * 16 + r16) * 64;
#pragma unroll
            for (int k4 = 0; k4 < 4; ++k4) {
                const float y = __shfl(e[k4][3], (r16 + 16 * g + 48) & 63);
                const float prev = g ? y : A.carry[qb];
                if (g == 0) A.carry[qb] = y;
                X[16 * j + 4 * k4 + g] = (bf16_t)(pk2((e[k4][0] + e[k4][1]) + (e[k4][2] + e[k4][3]) + prev, 0.f) & 0xffffu);
            }
        }
        l_run[qb] += ps;
        pw[0][qb].x = pk2(e[0][0], e[0][1]); pw[0][qb].y = pk2(e[0][2], e[0][3]); pw[0][qb].z = pk2(e[1][0], e[1][1]); pw[0][qb].w = pk2(e[1][2], e[1][3]);
        pw[1][qb].x = pk2(e[2][0], e[2][1]); pw[1][qb].y = pk2(e[2][2], e[2][3]); pw[1][qb].z = pk2(e[3][0], e[3][1]); pw[1][qb].w = pk2(e[3][2], e[3][3]);
    }
    {
        constexpr int VD = ATT3_VD;
        bf16x8 vf[VD + 1];
#pragma unroll
        for (int i = 0; i < VD; ++i) vf[i] = *(const LAS bf16x8*)(vb + ((i >> 3) ? vb1 : vb0) + (i & 7) * (16 * 128));
        __builtin_amdgcn_sched_barrier(0);
#pragma unroll
        for (int i = 0; i < 16; ++i) {
            if (i + VD < 16) { const int n_ = i + VD; vf[n_ % (VD + 1)] = *(const LAS bf16x8*)(vb + ((n_ >> 3) ? vb1 : vb0) + (n_ & 7) * (16 * 128)); }
            __builtin_amdgcn_sched_barrier(0);
            if (Q0) o[i & 7][0] = MFMA16(vf[i % (VD + 1)], __builtin_bit_cast(bf16x8, pw[i >> 3][0]), o[i & 7][0]);
            if (Q1) o[i & 7][1] = MFMA16(vf[i % (VD + 1)], __builtin_bit_cast(bf16x8, pw[i >> 3][1]), o[i & 7][1]);
            __builtin_amdgcn_sched_barrier(0);
        }
    }
}

template <int MODE>
DI void attn_pass3x(LAS unsigned char* lds, const char* __restrict__ Kc, const char* __restrict__ Vc, int vt_stride, int j_lo, int j_hi,
                    const bf16x8 (&q)[2][6], f32x4 (&o)[8][2], float (&m_run)[2], float (&l_run)[2], const AttnLane3& A) {
    if (j_lo >= j_hi) return;
    int tid = threadIdx.x; asm volatile("" : "+v"(tid));
    const int lane = tid & 63;
    const int wid_ = __builtin_amdgcn_readfirstlane(tid >> 6);
    unsigned kgo[3], vgo[2];
#pragma unroll
    for (int i_ = 0; i_ < 3; ++i_) { const int pidx_ = (wid_ * 3 + i_) * 64 + lane, row_ = pidx_ / 24, cp_ = pidx_ % 24; kgo[i_] = (unsigned)(row_ * 384 + ((cp_ ^ ((row_ >> 1) & 7)) << 4)); }
#pragma unroll
    for (int i_ = 0; i_ < 2; ++i_) { const int pidx_ = (wid_ * 2 + i_) * 64 + lane, row_ = pidx_ >> 3, cp_ = pidx_ & 7; vgo[i_] = (unsigned)(row_ * vt_stride * 2 + ((cp_ ^ ((row_ >> 1) & 7)) << 4)); }
#define ST_ISSUE(j, buf) do { const char* kp_ = Kc + (size_t)(j) * KT_BYTES; LAS unsigned char* kb_ = lds + L_K + (buf) * KT_BYTES + wid_ * 3072; \
        _Pragma("unroll") for (int i_ = 0; i_ < 3; ++i_) __builtin_amdgcn_global_load_lds((const unsigned*)(kp_ + kgo[i_]), (LAS unsigned*)(kb_ + i_ * 1024), 16, 0, 0); \
        const char* vp_ = Vc + (size_t)(j) * 128; LAS unsigned char* vb_ = lds + L_V + (buf) * VT_BYTES + wid_ * 2048; \
        _Pragma("unroll") for (int i_ = 0; i_ < 2; ++i_) __builtin_amdgcn_global_load_lds((const unsigned*)(vp_ + vgo[i_]), (LAS unsigned*)(vb_ + i_ * 1024), 16, 0, 0); } while (0)
    ST_ISSUE(j_lo, 0);
    asm volatile("s_waitcnt vmcnt(0)" ::: "memory");
    __syncthreads();
    for (int j = j_lo; j < j_hi; ++j) {
        const int cur = (j - j_lo) & 1;
        if (j + 1 < j_hi) ST_ISSUE(j + 1, cur ^ 1);
        const LAS unsigned char* kbp = lds + L_K + cur * KT_BYTES; const LAS unsigned char* vbp = lds + L_V + cur * VT_BYTES;
        if (MODE == MODE_SEL) {
            const bool a0 = ((A.mk0 >> j) & 1ull) != 0ull, a1 = ((A.mk1 >> j) & 1ull) != 0ull;
            if (a0 && a1) attn_tile3<MODE, 3>(kbp, vbp, lds, j, q, o, m_run, l_run, A);
            else if (a0) attn_tile3<MODE, 1>(kbp, vbp, lds, j, q, o, m_run, l_run, A);
            else if (a1) attn_tile3<MODE, 2>(kbp, vbp, lds, j, q, o, m_run, l_run, A);
        } else {
            bool act;
            if (MODE == MODE_MLA) act = 64 * j <= A.tw1;
            else if (MODE == MODE_CMPX) act = 1024 * j + 31 <= A.tw1;
            else act = (64 * j <= A.tw1) && (64 * j + 63 >= A.tw0 - 511);
            if (act) attn_tile3<MODE, 3>(kbp, vbp, lds, j, q, o, m_run, l_run, A);
        }
        asm volatile("s_waitcnt vmcnt(0)" ::: "memory");
        __syncthreads();
    }
#undef ST_ISSUE
}

DI int t5_bucket(int n) {
    if (n < 16) return n;
    return 16 + (n >= 19) + (n >= 21) + (n >= 24) + (n >= 27) + (n >= 31) + (n >= 35) + (n >= 40) + (n >= 46) + (n >= 52) + (n >= 59) + (n >= 67) + (n >= 77) + (n >= 87) + (n >= 99) + (n >= 113);
}
DI float silu_f(float z) { return z * __builtin_amdgcn_rcpf(1.0f + __builtin_amdgcn_exp2f(-1.4426950408889634f * z)); }

constexpr int EPI_PITCH = 272, EPI_WAVE_BYTES = 32 * EPI_PITCH;
template <bool RMW, bool NSA>
DI void attn_epilogue3(LAS unsigned char* lds, int lane, int wid, const f32x4 (&o)[8][2], float scale0, float scale1,
                       const char* __restrict__ zbase, unsigned z0, char* __restrict__ obase, unsigned o0) {
    LAS unsigned char* sc = lds + wid * EPI_WAVE_BYTES;
    const int r16 = lane & 15, g = lane >> 4;
#pragma unroll
    for (int h = 0; h < 2; ++h) {
#pragma unroll
        for (int d4 = 0; d4 < 4; ++d4) {
            *(LAS f32x4*)(sc + r16 * EPI_PITCH + (16 * d4 + 4 * g) * 4) = o[4 * h + d4][0] * scale0;
            *(LAS f32x4*)(sc + (16 + r16) * EPI_PITCH + (16 * d4 + 4 * g) * 4) = o[4 * h + d4][1] * scale1;
        }
        asm volatile("" ::: "memory");
#pragma unroll
        for (int i = 0; i < 4; ++i) {
            const int rr = 8 * i + (lane >> 3), c8 = lane & 7;
            const f32x4 a = *(const LAS f32x4*)(sc + rr * EPI_PITCH + c8 * 32);
            const f32x4 b = *(const LAS f32x4*)(sc + rr * EPI_PITCH + c8 * 32 + 16);
            unsigned zoff, ooff;
            if (NSA) { zoff = z0 + (unsigned)((rr >> 4) * (N1P * 2) + (rr & 15) * 256); ooff = o0 + (unsigned)((rr >> 4) * (ZW8 * 2) + (rr & 15) * 256); }
            else     { zoff = z0 + (unsigned)(rr * (N3P * 2)); ooff = o0 + (unsigned)(rr * (ZW8 * 2)); }
            const unsigned cb = (unsigned)((64 * h + 8 * c8) * 2);
            const u32x4 zw = *(const u32x4*)(zbase + (zoff + cb));
            float v0 = a[0] * silu_f(bflo(zw.x)), v1 = a[1] * silu_f(bfhi(zw.x)), v2 = a[2] * silu_f(bflo(zw.y)), v3 = a[3] * silu_f(bfhi(zw.y));
            float v4 = b[0] * silu_f(bflo(zw.z)), v5 = b[1] * silu_f(bfhi(zw.z)), v6 = b[2] * silu_f(bflo(zw.w)), v7 = b[3] * silu_f(bfhi(zw.w));
            if (RMW) { const u32x4 pv = *(const u32x4*)(obase + (ooff + cb));
                v0 += bflo(pv.x); v1 += bfhi(pv.x); v2 += bflo(pv.y); v3 += bfhi(pv.y); v4 += bflo(pv.z); v5 += bfhi(pv.z); v6 += bflo(pv.w); v7 += bfhi(pv.w); }
            u32x4 w; w.x = pk2(v0, v1); w.y = pk2(v2, v3); w.z = pk2(v4, v5); w.w = pk2(v6, v7);
            *(u32x4*)(obase + (ooff + cb)) = w;
        }
        asm volatile("" ::: "memory");
    }
}
DI float sum_g(float v) { v += __shfl_xor(v, 16); v += __shfl_xor(v, 32); return v; }

DI void phase_nsa_attn(LAS unsigned char* lds, const Params& P, int bid, int nb) {
    const char* Y0c = (const char*)(P.ws + OFF_Y0);
    const char* KSc = (const char*)(P.ws + OFF_KS); const char* KWc = (const char*)(P.ws + OFF_KW);
    const char* VTSc = (const char*)(P.ws + OFF_VTS); const char* VTWc = (const char*)(P.ws + OFF_VTW);
    const char* KCc = (const char*)(P.ws + OFF_KC); const char* VTCc = (const char*)(P.ws + OFF_VTC);
    char* ONc = (char*)(P.ws + OFF_O);
    LAS float* lut = (LAS float*)(lds + L_LUT);
    const int total = BATCH * NG * 256;
    {
        const int tid0 = tid_opaque();
        __syncthreads();
        for (int i = tid0; i < 64 * 128; i += 512) { const int hd = i >> 7, d = i & 127; lut[hd * LUT_PITCH + d] = (P.rel_bias[t5_bucket(d) * NH + hd] - P.rel_bias[31 * NH + hd]) * LOG2E; }
        __syncthreads();
    }
    for (int u = bid; u < total; u += nb) {
        int tid = threadIdx.x; asm volatile("" : "+v"(tid));
        const int lane = tid & 63, wid = __builtin_amdgcn_readfirstlane(tid >> 6);
        const int pair = u >> 8; int c = u & 255; if (pair & 1) c = 255 - c;
        const int b = pair >> 2, gg = pair & 3, t0 = c * 16;
        __syncthreads();
        AttnLane3 A;
        A.r16 = lane & 15; A.g = lane >> 4;
        A.tw0 = t0 + 2 * wid; A.tw1 = A.tw0 + 1;
        const int hh = gg * NR + A.r16;
        A.lutrow = lut + hh * LUT_PITCH;
        A.curblk = t0 >> 6; A.tokbase = 2 * wid; A.mk0 = 0ull; A.mk1 = 0ull; A.carry[0] = 0.f; A.carry[1] = 0.f;
        const unsigned ytok0 = (unsigned)(b * SEQ + A.tw0) * (unsigned)(N1P * 2);
        const unsigned otok0 = ((unsigned)(b * SEQ + A.tw0) * (unsigned)ZW8 + (unsigned)(gg * NR * DV)) * 2u;
        bf16x8 q[2][6];
#pragma unroll
        for (int qb = 0; qb < 2; ++qb) {
            const unsigned qo = ytok0 + (unsigned)(qb * (N1P * 2)) + (unsigned)((C_Q + hh * DK + 8 * A.g) * 2);
            float ss = 0.f;
#pragma unroll
            for (int ds = 0; ds < 6; ++ds) { q[qb][ds] = *(const bf16x8*)(Y0c + (qo + 64u * ds));
                const u32x4 w = __builtin_bit_cast(u32x4, q[qb][ds]);
                const float a0 = bflo(w.x), a1 = bfhi(w.x), a2 = bflo(w.y), a3 = bfhi(w.y), a4 = bflo(w.z), a5 = bfhi(w.z), a6 = bflo(w.w), a7 = bfhi(w.w);
                ss += (a0 * a0 + a1 * a1) + (a2 * a2 + a3 * a3) + (a4 * a4 + a5 * a5) + (a6 * a6 + a7 * a7); }
            ss = sum_g(ss);
            const float rstd = rsqrtf(ss * (1.0f / DK) + EPSN) * QSCALE;
#pragma unroll
            for (int ds = 0; ds < 6; ++ds) { const float* gn = P.nsa_q_norm + 32 * ds + 8 * A.g; const f32x4 g0 = *(const f32x4*)gn, g1 = *(const f32x4*)(gn + 4);
                u32x4 w = __builtin_bit_cast(u32x4, q[qb][ds]);
                w.x = pk2(bflo(w.x) * rstd * g0[0], bfhi(w.x) * rstd * g0[1]); w.y = pk2(bflo(w.y) * rstd * g0[2], bfhi(w.y) * rstd * g0[3]);
                w.z = pk2(bflo(w.z) * rstd * g1[0], bfhi(w.z) * rstd * g1[1]); w.w = pk2(bflo(w.w) * rstd * g1[2], bfhi(w.w) * rstd * g1[3]);
                q[qb][ds] = __builtin_bit_cast(bf16x8, w); }
        }
        const int bg = b * NG + gg;
        f32x4 o[8][2]; float m_run[2], l_run[2];
#define RESET_STATE() do { _Pragma("unroll") for (int d_ = 0; d_ < 8; ++d_) { o[d_][0] = (f32x4){0.f, 0.f, 0.f, 0.f}; o[d_][1] = (f32x4){0.f, 0.f, 0.f, 0.f}; } m_run[0] = 0.f; m_run[1] = 0.f; l_run[0] = 0.f; l_run[1] = 0.f; } while (0)
#define GATE_SIG(x, qb) (1.0f / (1.0f + __expf(-bf1(*(const bf16_t*)(Y0c + (ytok0 + (unsigned)((qb) * (N1P * 2)) + (unsigned)((C_G + (x) * NH + hh) * 2)))))))
        const int nct = (t0 + 15 >= 31) ? (((t0 + 15 - 31) >> 4) / 64 + 1) : 0;
        RESET_STATE();
        attn_pass3x<MODE_CMPX>(lds, KCc + (size_t)bg * 256 * DK * 2, VTCc + (size_t)bg * DV * 256 * 2, 256, 0, nct, q, o, m_run, l_run, A);
        { const float lt0 = sum_g(l_run[0]), lt1 = sum_g(l_run[1]); const float il0 = lt0 > 0.f ? 1.0f / lt0 : 0.f, il1 = lt1 > 0.f ? 1.0f / lt1 : 0.f;
          if (lane < 16) { ((LAS float*)(lds + L_IL))[(A.tokbase + 0) * 16 + A.r16] = il0; ((LAS float*)(lds + L_IL))[(A.tokbase + 1) * 16 + A.r16] = il1; }
          attn_epilogue3<false, true>(lds, lane, wid, o, GATE_SIG(0, 0) * il0, GATE_SIG(0, 1) * il1, Y0c, ytok0 + (unsigned)((C_ZC + gg * NR * DV) * 2), ONc, otok0); }
        __syncthreads();
        {
            const int cur = A.curblk;
            unsigned long long mk[2];
#pragma unroll
            for (int t = 0; t < 2; ++t) {
                const LAS bf16_t* X = (const LAS bf16_t*)(lds + L_X) + (2 * wid + t) * 16 * 64;
                const LAS float* IL = (const LAS float*)(lds + L_IL) + (2 * wid + t) * 16;
                const bool forced = (lane == 0) || (lane == cur) || (lane == cur - 1);
                const bool future = lane > cur;
                float v = 0.f;
                if (!forced && !future) {
#pragma unroll
                    for (int rr = 0; rr < 16; ++rr) v += IL[rr] * bf1(X[rr * 64 + lane]); }
                unsigned key = (__float_as_uint(v) & ~63u);
                if (forced) key = 0x7f800000u; else if (future) key = 0u;
                key |= (unsigned)(63 - lane);
                int rank = 0;
#pragma unroll
                for (int jp = 0; jp < 64; ++jp) { const unsigned kj = (unsigned)__builtin_amdgcn_readlane((int)key, jp); rank += (kj > key) ? 1 : 0; }
                mk[t] = __ballot(rank < 16 && !future);
            }
            A.mk0 = mk[0]; A.mk1 = mk[1];
        }
        RESET_STATE();
        attn_pass3x<MODE_SEL>(lds, KSc + (size_t)bg * SEQ * DK * 2, VTSc + (size_t)bg * DV * SEQ * 2, SEQ, 0, A.curblk + 1, q, o, m_run, l_run, A);
        { const float lt0 = sum_g(l_run[0]), lt1 = sum_g(l_run[1]);
          attn_epilogue3<true, true>(lds, lane, wid, o, GATE_SIG(1, 0) / lt0, GATE_SIG(1, 1) / lt1, Y0c, ytok0 + (unsigned)((C_ZS + gg * NR * DV) * 2), ONc, otok0); }
        __syncthreads();
        RESET_STATE();
        { const int jl = (t0 - 511) > 0 ? (t0 - 511) >> 6 : 0, jh = ((t0 + 15) >> 6) + 1;
          attn_pass3x<MODE_WIN>(lds, KWc + (size_t)bg * SEQ * DK * 2, VTWc + (size_t)bg * DV * SEQ * 2, SEQ, jl, jh, q, o, m_run, l_run, A); }
        { const float lt0 = sum_g(l_run[0]), lt1 = sum_g(l_run[1]);
          attn_epilogue3<true, true>(lds, lane, wid, o, GATE_SIG(2, 0) / lt0, GATE_SIG(2, 1) / lt1, Y0c, ytok0 + (unsigned)((C_ZW + gg * NR * DV) * 2), ONc, otok0); }
#undef RESET_STATE
#undef GATE_SIG
    }
}

DI void phase_mla_attn(LAS unsigned char* lds, const Params& P, int bid, int nb) {
    const char* QMc = (const char*)(P.ws + OFF_QM); const char* KMc = (const char*)(P.ws + OFF_KM); const char* VTMc = (const char*)(P.ws + OFF_VTM);
    const char* Y1c = (const char*)(P.ws + OFF_Y1); char* OMc = (char*)(P.ws + OFF_O);
    const int total = BATCH * NH * 16;
    for (int uu = 0; bid + (uu >> 1) * nb < total / 2; ++uu) {
        int tid = threadIdx.x; asm volatile("" : "+v"(tid));
        const int lane = tid & 63, wid = __builtin_amdgcn_readfirstlane(tid >> 6);
        const int item = bid + (uu >> 1) * nb, second = uu & 1;
        const int xcd = item & 7, tt = item >> 3, p = tt & 7, hl = (tt >> 3) & 3, rnd = tt >> 5;
        const int bh = rnd * 32 + xcd * 4 + hl, qblk = second ? p : 15 - p, b = bh >> 6, h = bh & 63, t0 = qblk * 256;
        AttnLane3 A;
        A.r16 = lane & 15; A.g = lane >> 4;
        A.tw0 = t0 + 32 * wid; A.tw1 = A.tw0 + 31;
        A.lutrow = nullptr; A.curblk = 0; A.tokbase = 0; A.mk0 = 0ull; A.mk1 = 0ull; A.carry[0] = 0.f; A.carry[1] = 0.f;
        bf16x8 q[2][6];
#pragma unroll
        for (int qb = 0; qb < 2; ++qb) {
            const unsigned trow = (unsigned)(b * SEQ + A.tw0 + 16 * qb + A.r16);
            const unsigned qo = (trow * (unsigned)NQB + (unsigned)(h * DK + 8 * A.g)) * 2u;
            float ss = 0.f;
#pragma unroll
            for (int ds = 0; ds < 6; ++ds) { q[qb][ds] = *(const bf16x8*)(QMc + (qo + 64u * ds));
                const u32x4 w = __builtin_bit_cast(u32x4, q[qb][ds]);
                const float a0 = bflo(w.x), a1 = bfhi(w.x), a2 = bflo(w.y), a3 = bfhi(w.y), a4 = bflo(w.z), a5 = bfhi(w.z), a6 = bflo(w.w), a7 = bfhi(w.w);
                ss += (a0 * a0 + a1 * a1) + (a2 * a2 + a3 * a3) + (a4 * a4 + a5 * a5) + (a6 * a6 + a7 * a7); }
            ss = sum_g(ss);
            const float rstd = rsqrtf(ss * (1.0f / DK) + EPSN);
            const float* ropep = (const float*)(P.ws + OFF_ROPE) + (size_t)trow * 64;
#pragma unroll
            for (int ds = 0; ds < 4; ++ds) { const float* gn = P.mla_q_norm + 32 * ds + 8 * A.g; const f32x4 g0 = *(const f32x4*)gn, g1 = *(const f32x4*)(gn + 4);
                const float sc = rstd * QSCALE;
                u32x4 w = __builtin_bit_cast(u32x4, q[qb][ds]);
                w.x = pk2(bflo(w.x) * sc * g0[0], bfhi(w.x) * sc * g0[1]); w.y = pk2(bflo(w.y) * sc * g0[2], bfhi(w.y) * sc * g0[3]);
                w.z = pk2(bflo(w.z) * sc * g1[0], bfhi(w.z) * sc * g1[1]); w.w = pk2(bflo(w.w) * sc * g1[2], bfhi(w.w) * sc * g1[3]);
                q[qb][ds] = __builtin_bit_cast(bf16x8, w); }
            {
                const int i0 = 8 * A.g;
                const float* g1p = P.mla_q_norm + 128 + i0; const float* g2p = P.mla_q_norm + 160 + i0;
                const u32x4 w1 = __builtin_bit_cast(u32x4, q[qb][4]), w2 = __builtin_bit_cast(u32x4, q[qb][5]);
                float x1[8] = {bflo(w1.x), bfhi(w1.x), bflo(w1.y), bfhi(w1.y), bflo(w1.z), bfhi(w1.z), bflo(w1.w), bfhi(w1.w)};
                float x2[8] = {bflo(w2.x), bfhi(w2.x), bflo(w2.y), bfhi(w2.y), bflo(w2.z), bfhi(w2.z), bflo(w2.w), bfhi(w2.w)};
                float y1[8], y2[8];
#pragma unroll
                for (int e = 0; e < 8; ++e) { const float cs = ropep[i0 + e], sn = ropep[32 + i0 + e];
                    const float a = x1[e] * rstd * g1p[e], c = x2[e] * rstd * g2p[e];
                    y1[e] = (a * cs - c * sn) * QSCALE; y2[e] = (c * cs + a * sn) * QSCALE; }
                u32x4 o1, o2;
                o1.x = pk2(y1[0], y1[1]); o1.y = pk2(y1[2], y1[3]); o1.z = pk2(y1[4], y1[5]); o1.w = pk2(y1[6], y1[7]);
                o2.x = pk2(y2[0], y2[1]); o2.y = pk2(y2[2], y2[3]); o2.z = pk2(y2[4], y2[5]); o2.w = pk2(y2[6], y2[7]);
                q[qb][4] = __builtin_bit_cast(bf16x8, o1); q[qb][5] = __builtin_bit_cast(bf16x8, o2);
            }
        }
        f32x4 o[8][2]; float m_run[2] = {0.f, 0.f}, l_run[2] = {0.f, 0.f};
#pragma unroll
        for (int d = 0; d < 8; ++d) { o[d][0] = (f32x4){0.f, 0.f, 0.f, 0.f}; o[d][1] = (f32x4){0.f, 0.f, 0.f, 0.f}; }
        attn_pass3x<MODE_MLA>(lds, KMc + (size_t)bh * SEQ * DK * 2, VTMc + (size_t)bh * DV * SEQ * 2, SEQ, 0, 4 * qblk + 4, q, o, m_run, l_run, A);
        const float lt0 = sum_g(l_run[0]), lt1 = sum_g(l_run[1]);
        { const unsigned t0w = (unsigned)(b * SEQ + A.tw0);
          attn_epilogue3<false, false>(lds, lane, wid, o, 1.0f / lt0, 1.0f / lt1, Y1c, (t0w * (unsigned)N3P + (unsigned)(C3_Z + h * DV)) * 2u, OMc, (t0w * (unsigned)ZW8 + (unsigned)(h * DV)) * 2u); }
        __syncthreads();
    }
}
constexpr int LDS_KN_OFF = 135168, LDS_ST_OFF = LDS_KN_OFF + 16384, LDS_BYTES = LDS_ST_OFF + 16;
constexpr int NPHASE = 14;

template <int PH>
DI void run_phase(const Params& P, LAS unsigned char* lds, int bid, int nb) {
    unsigned char* ws = P.ws;
    if constexpr (PH == 0) {
        phase_wconv(lds, P.nsa_w_in, (bf16_t*)(ws + OFF_W1T), DM, N1, N1P, bid, nb, (FP8EMU & 4) ? 64.0f : 0.f);
        phase_wconv(lds, P.w1_k, (bf16_t*)(ws + OFF_W1K), 6144, 192, 256, bid, nb);
        phase_wconv(lds, P.w1_v, (bf16_t*)(ws + OFF_W1V), 4096, 128, 256, bid, nb);
        phase_rmsnorm(P.x, P.norm_w, (bf16_t*)(ws + OFF_H), bid, nb, (FP8EMU & 4) ? 16.0f : 0.f);
    } else if constexpr (PH == 1) {
        pg8::Gemm g{(const bf16_t*)(ws + OFF_H), (const bf16_t*)(ws + OFF_W1T), MTOK, N1P, DM};
        pg8::StaticOrder S; S.init(g.M, g.N, nb, bid);
        pg8::EpiStoreBf16 E{(bf16_t*)(ws + OFF_Y0), N1P};
        pg8::gemm_phase<pg8::EpiStoreBf16, pg8::StaticOrder, false>(lds, g, S, E, nullptr);
    } else if constexpr (PH == 2) {
        phase_nsa_prep(P, bid, nb);
        phase_vt(lds, (const bf16_t*)(ws + OFF_Y0), N1P, C_KVS + NG * DK, DV, NG, (bf16_t*)(ws + OFF_VTS), bid, nb);
        phase_vt(lds, (const bf16_t*)(ws + OFF_Y0), N1P, C_KVW + NG * DK, DV, NG, (bf16_t*)(ws + OFF_VTW), bid, nb);
    } else if constexpr (PH == 3) {
        if (bid < 16) {
            pg8::Gemm g{(const bf16_t*)(ws + OFF_ACK), (const bf16_t*)(ws + OFF_W1K), 4096, 256, 6144};
            pg8::StaticOrder S; S.init(g.M, g.N, 16, bid);
            pg8::EpiPlainF32 E{(float*)(ws + OFF_HIDK), 256};
            pg8::gemm_phase<pg8::EpiPlainF32, pg8::StaticOrder, false>(lds, g, S, E, nullptr);
        } else if (bid < 32) {
            pg8::Gemm g{(const bf16_t*)(ws + OFF_ACV), (const bf16_t*)(ws + OFF_W1V), 4096, 256, 4096};
            pg8::StaticOrder S; S.init(g.M, g.N, 16, bid - 16);
            pg8::EpiPlainF32 E{(float*)(ws + OFF_HIDV), 256};
            pg8::gemm_phase<pg8::EpiPlainF32, pg8::StaticOrder, false>(lds, g, S, E, nullptr);
        } else {
            phase_wconv(lds, P.nsa_w_out, (bf16_t*)(ws + OFF_W2T), ZW8, DM, DM, bid - 32, nb - 32, (FP8EMU & 1) ? 64.0f : 0.f);
            phase_wconv(lds, P.mla_w_in, (bf16_t*)(ws + OFF_W3T), DM, N3, N3P, bid - 32, nb - 32, (FP8EMU & 8) ? 64.0f : 0.f);
        }
    } else if constexpr (PH == 4) {
        phase_cmp2(lds, P, bid, nb);
    } else if constexpr (PH == 5) {
        { float* ss1 = (float*)(ws + OFF_SS1); for (int i = bid * 512 + (int)threadIdx.x; i < MTOK; i += nb * 512) ss1[i] = 0.f; }
        phase_nsa_attn(lds, P, bid, nb);
    } else if constexpr (PH == 6) {
        pg8::Gemm g{(const bf16_t*)(ws + OFF_O), (const bf16_t*)(ws + OFF_W2T), MTOK, DM, ZW8};
        pg8::StaticOrder S; S.init(g.M, g.N, nb, bid);
        pg8::EpiResNorm E{P.x, P.out, DM, P.norm_w + DM, (bf16_t*)(ws + OFF_H), (float*)(ws + OFF_SS1)};
        pg8::gemm_phase<pg8::EpiResNorm, pg8::StaticOrder, false>(lds, g, S, E, nullptr);
    } else if constexpr (PH == 7) {
        phase_rmsnorm(P.out, P.norm_w + DM, (bf16_t*)(ws + OFF_H), bid, nb, (FP8EMU & 8) ? 16.0f : 0.f);
    } else if constexpr (PH == 8) {
        pg8::Gemm g{(const bf16_t*)(ws + OFF_H), (const bf16_t*)(ws + OFF_W3T), MTOK, N3P, DM};
        pg8::StaticOrder S; S.init(g.M, g.N, nb, bid);
        pg8::EpiStoreBf16RowScale E{(bf16_t*)(ws + OFF_Y1), N3P, (const float*)(ws + OFF_SS1), 1.0f / DM};
        pg8::gemm_phase<pg8::EpiStoreBf16RowScale, pg8::StaticOrder, false>(lds, g, S, E, nullptr);
        __syncthreads();
        if (bid >= 64 && nb > 64) {
            phase_wconv(lds, P.mla_w_q_b, (bf16_t*)(ws + OFF_W4T), QLORA, NQB, NQB, bid - 64, nb - 64);
            phase_wconv(lds, P.mla_w_kv_b, (bf16_t*)(ws + OFF_W5K), KVLORA, NKVB / 2, NKVB / 2, bid - 64, nb - 64, 0.f, 2);
            phase_wconv(lds, P.mla_w_kv_b, (bf16_t*)(ws + OFF_W5V), KVLORA, NKVB / 2, NKVB / 2, bid - 64, nb - 64, 0.f, 1);
            phase_wconv(lds, P.mla_w_out, (bf16_t*)(ws + OFF_W6T), ZW8, DM, DM, bid - 64, nb - 64, (FP8EMU & 2) ? 64.0f : 0.f);
        } else if (nb <= 64) {
            phase_wconv(lds, P.mla_w_q_b, (bf16_t*)(ws + OFF_W4T), QLORA, NQB, NQB, bid, nb);
            phase_wconv(lds, P.mla_w_kv_b, (bf16_t*)(ws + OFF_W5K), KVLORA, NKVB / 2, NKVB / 2, bid, nb, 0.f, 2);
            phase_wconv(lds, P.mla_w_kv_b, (bf16_t*)(ws + OFF_W5V), KVLORA, NKVB / 2, NKVB / 2, bid, nb, 0.f, 1);
            phase_wconv(lds, P.mla_w_out, (bf16_t*)(ws + OFF_W6T), ZW8, DM, DM, bid, nb, (FP8EMU & 2) ? 64.0f : 0.f);
        }
    } else if constexpr (PH == 9) {
        phase_mla_prep1(P, bid, nb);
    } else if constexpr (PH == 10) {
        {
            pg8::Gemm g{(const bf16_t*)(ws + OFF_CQN), (const bf16_t*)(ws + OFF_W4T), MTOK, NQB, QLORA};
            pg8::StaticOrder S; S.init(g.M, g.N, nb, bid);
            pg8::EpiStoreBf16 E{(bf16_t*)(ws + OFF_QM), NQB};
            pg8::gemm_phase<pg8::EpiStoreBf16, pg8::StaticOrder, false>(lds, g, S, E, nullptr);
        }
        __syncthreads();
        {
            pg8::Gemm g{(const bf16_t*)(ws + OFF_CKVN), (const bf16_t*)(ws + OFF_W5K), MTOK, NKVB / 2, KVLORA};
            pg8::StaticOrder S; S.init(g.M, g.N, nb, bid);
            pg8::EpiKNorm E{(bf16_t*)(ws + OFF_KM), (const float*)(ws + OFF_SSPE), (const float*)(ws + OFF_KPER), P.mla_k_norm, (LAS float*)(lds + LDS_KN_OFF), 0u};
            pg8::gemm_phase<pg8::EpiKNorm, pg8::StaticOrder, false>(lds, g, S, E, nullptr);
        }
        __syncthreads();
        {
            pg8::Gemm g{(const bf16_t*)(ws + OFF_W5V), (const bf16_t*)(ws + OFF_CKVN), NKVB / 2, MTOK, KVLORA};
            pg8::StaticOrder S; S.init(g.M, g.N, nb, bid);
            pg8::EpiVT E{(bf16_t*)(ws + OFF_VTM)};
            pg8::gemm_phase<pg8::EpiVT, pg8::StaticOrder, false>(lds, g, S, E, nullptr);
        }
    } else if constexpr (PH == 11) {
    } else if constexpr (PH == 12) {
        phase_mla_attn(lds, P, bid, nb);
    } else if constexpr (PH == 13) {
        pg8::Gemm g{(const bf16_t*)(ws + OFF_O), (const bf16_t*)(ws + OFF_W6T), MTOK, DM, ZW8};
        pg8::StaticOrder S; S.init(g.M, g.N, nb, bid);
        pg8::EpiResF32 E{P.out, P.out, DM};
        pg8::gemm_phase<pg8::EpiResF32, pg8::StaticOrder, false>(lds, g, S, E, nullptr);
    }
}

#ifndef REP0
#define REP0 1
#endif
#ifndef REP1
#define REP1 1
#endif
#ifndef REP2
#define REP2 1
#endif
#ifndef REP3
#define REP3 1
#endif
#ifndef REP4
#define REP4 1
#endif
#ifndef REP5
#define REP5 1
#endif
#ifndef REP6
#define REP6 1
#endif
#ifndef REP7
#define REP7 1
#endif
#ifndef REP8
#define REP8 1
#endif
#ifndef REP9
#define REP9 1
#endif
#ifndef REP10
#define REP10 1
#endif
#ifndef REP11
#define REP11 1
#endif
#ifndef REP12
#define REP12 1
#endif
#ifndef REP13
#define REP13 1
#endif

__global__ __launch_bounds__(512, 2) void k_mega(Params P) {
    extern __shared__ __attribute__((aligned(16))) unsigned char shm[];
    LAS unsigned char* lds = (LAS unsigned char*)shm;
    volatile LAS unsigned* st = (volatile LAS unsigned*)(lds + LDS_ST_OFF);
    if (threadIdx.x == 0) { st[0] = 0u; st[1] = 0u; st[2] = 0u; st[3] = 0u; }
    __syncthreads();
    XcdBarrier bar = xcd_barrier_post((unsigned*)(P.ws + OFF_CTL), st);
    const int bid = (int)blockIdx.x, nb = (int)gridDim.x;
    for (int rep_ = 0; rep_ < REP0; ++rep_) run_phase<0>(P, lds, bid, nb);  xcd_barrier(bar);
    for (int rep_ = 0; rep_ < REP1; ++rep_) run_phase<1>(P, lds, bid, nb);  xcd_barrier(bar);
    for (int rep_ = 0; rep_ < REP2; ++rep_) run_phase<2>(P, lds, bid, nb);  xcd_barrier(bar);
    for (int rep_ = 0; rep_ < REP3; ++rep_) run_phase<3>(P, lds, bid, nb);  xcd_barrier(bar);
    for (int rep_ = 0; rep_ < REP4; ++rep_) run_phase<4>(P, lds, bid, nb);  xcd_barrier(bar);
    for (int rep_ = 0; rep_ < REP5; ++rep_) run_phase<5>(P, lds, bid, nb);  xcd_barrier(bar);
    for (int rep_ = 0; rep_ < REP6; ++rep_) run_phase<6>(P, lds, bid, nb);  xcd_barrier(bar);
    for (int rep_ = 0; rep_ < REP8; ++rep_) run_phase<8>(P, lds, bid, nb);  xcd_barrier(bar);
    for (int rep_ = 0; rep_ < REP9; ++rep_) run_phase<9>(P, lds, bid, nb);  xcd_barrier(bar);
    for (int rep_ = 0; rep_ < REP10; ++rep_) run_phase<10>(P, lds, bid, nb); xcd_barrier(bar);
    for (int rep_ = 0; rep_ < REP12; ++rep_) run_phase<12>(P, lds, bid, nb); xcd_barrier(bar);
    for (int rep_ = 0; rep_ < REP13; ++rep_) run_phase<13>(P, lds, bid, nb);
}

extern "C" void kernel_launch(void* const* d_in, const int* in_sizes, int n_in, void* d_out, int out_size, void* d_ws, size_t ws_size, hipStream_t stream) {
    (void)in_sizes; (void)n_in; (void)out_size;
    if (ws_size < WS_END) return;
    Params P{};
    P.x = (const float*)d_in[0]; P.pos = (const int*)d_in[1]; P.norm_w = (const float*)d_in[2]; P.rel_bias = (const float*)d_in[3];
    P.nsa_w_in = (const float*)d_in[4]; P.nsa_q_norm = (const float*)d_in[5]; P.nsa_k_norm = (const float*)d_in[6]; P.pe_k = (const float*)d_in[7];
    P.w1_k = (const float*)d_in[8]; P.w2_k = (const float*)d_in[9]; P.pe_v = (const float*)d_in[10]; P.w1_v = (const float*)d_in[11]; P.w2_v = (const float*)d_in[12];
    P.nsa_w_out = (const float*)d_in[13]; P.mla_w_in = (const float*)d_in[14]; P.mla_q_a_norm = (const float*)d_in[15]; P.mla_w_q_b = (const float*)d_in[16];
    P.mla_kv_a_norm = (const float*)d_in[17]; P.mla_w_kv_b = (const float*)d_in[18]; P.mla_q_norm = (const float*)d_in[19]; P.mla_k_norm = (const float*)d_in[20];
    P.mla_w_out = (const float*)d_in[21];
    P.out = (float*)d_out; P.ws = (unsigned char*)d_ws;
    static int grid = 0;
    if (!grid) {
        int dev = 0, cus = 0, per_cu = 0; (void)hipGetDevice(&dev);
        if (hipDeviceGetAttribute(&cus, hipDeviceAttributeMultiprocessorCount, dev) != hipSuccess || cus <= 0) cus = 256;
        (void)hipFuncSetAttribute((const void*)k_mega, hipFuncAttributeMaxDynamicSharedMemorySize, LDS_BYTES);
        if (hipOccupancyMaxActiveBlocksPerMultiprocessor(&per_cu, k_mega, 512, LDS_BYTES) != hipSuccess || per_cu < 1) per_cu = 1;
        grid = cus;
    }
    (void)hipMemsetAsync((unsigned char*)d_ws + OFF_CTL, 0, XCD_BAR_WORDS * sizeof(unsigned), stream);
    hipLaunchKernelGGL(k_mega, dim3(grid), dim3(512), LDS_BYTES, stream, P);
}
```

```cpp
#define ATT16 1
#include <hip/hip_runtime.h>
#include <stdint.h>
#include <stddef.h>

#define DI __device__ __forceinline__
#define LAS __attribute__((address_space(3)))
typedef unsigned short bf16_t;
typedef short bf16x8 __attribute__((ext_vector_type(8)));
typedef float f32x4 __attribute__((ext_vector_type(4)));
typedef float f32x16 __attribute__((ext_vector_type(16)));
typedef unsigned u32x4 __attribute__((ext_vector_type(4)));
typedef unsigned u32x2 __attribute__((ext_vector_type(2)));
typedef __bf16 bf2_t __attribute__((ext_vector_type(2)));
typedef float f2_t __attribute__((ext_vector_type(2)));

DI int tid_opaque() { int t = (int)threadIdx.x; asm volatile("" : "+v"(t)); return t; }
DI unsigned pk2(float a, float b) { f2_t f = {a, b}; bf2_t v = __builtin_convertvector(f, bf2_t); return __builtin_bit_cast(unsigned, v); }
DI float bflo(unsigned w) { return __uint_as_float(w << 16); }
DI float bfhi(unsigned w) { return __uint_as_float(w & 0xffff0000u); }
#ifndef FP8EMU
#define FP8EMU 0
#endif
DI float emu_q8(float x, float s) { float y = x * s; const float ay = fabsf(y);
    if (ay < 0.015625f) y = rintf(y * 512.0f) * (1.0f / 512.0f);
    else { unsigned u = __float_as_uint(y); u = (u + 0x0007FFFFu + ((u >> 20) & 1u)) & 0xFFF00000u; y = __uint_as_float(u); }
    y = fminf(fmaxf(y, -448.0f), 448.0f); return y / s; }
DI float bf1(bf16_t h) { return __uint_as_float(((unsigned)h) << 16); }

#ifndef ATT16
#define ATT16 0
#endif
DI int vt_key_of_pos(int p) {
#if ATT16
    return (p & ~31) | (((p >> 2) & 1) << 4) | (((p >> 3) & 3) << 2) | (p & 3);
#else
    return (p & ~0xC) | ((p & 4) << 1) | ((p & 8) >> 1);
#endif
}
DI int vt_pos_of_key(int k) {
#if ATT16
    return (k & ~31) | (((k >> 2) & 3) << 3) | (((k >> 4) & 1) << 2) | (k & 3);
#else
    return (k & ~0xC) | ((k & 4) << 1) | ((k & 8) >> 1);
#endif
}
constexpr int BATCH = 4, SEQ = 4096, DM = 4096, MTOK = BATCH * SEQ;
constexpr int NH = 64, NG = 4, NR = 16, DK = 192, DV = 128;
constexpr int N1 = 40896, N1P = 40960;
constexpr int C_Q = 0, C_KVC = 12288, C_KVS = 13568, C_KVW = 14848, C_ZC = 16128, C_ZS = 24320, C_ZW = 32512, C_G = 40704;
constexpr int N3 = 10304, N3P = 10496;
constexpr int C3_CQ = 0, C3_CKV = 1536, C3_KPE = 2048, C3_Z = 2112;
constexpr int QLORA = 1536, KVLORA = 512;
constexpr int NQB = 12288, NKVB = 16384, ZW8 = 8192;
constexpr float EPSN = 1e-6f;
constexpr float LOG2E = 1.4426950408889634f;
constexpr float QSCALE = 0.07216878364870322f * 1.4426950408889634f;

constexpr size_t SZ_W1T = (size_t)N1P * DM * 2, SZ_W2T = (size_t)DM * ZW8 * 2, SZ_W3T = (size_t)N3P * DM * 2, SZ_W4T = (size_t)NQB * QLORA * 2,
                 SZ_W5T = (size_t)NKVB * KVLORA * 2, SZ_W6T = (size_t)DM * ZW8 * 2;
constexpr size_t OFF_W1T = 0, OFF_W2T = OFF_W1T + SZ_W1T, OFF_W3T = OFF_W2T + SZ_W2T, OFF_W4T = OFF_W3T + SZ_W3T, OFF_W5T = OFF_W4T + SZ_W4T,
                 OFF_W6T = OFF_W5T + SZ_W5T, OFF_W1K = OFF_W6T + SZ_W6T;
constexpr size_t OFF_W5K = OFF_W5T, OFF_W5V = OFF_W5T + SZ_W5T / 2;
constexpr size_t SZ_W1K = (size_t)256 * 6144 * 2, SZ_W1V = (size_t)256 * 4096 * 2;
constexpr size_t OFF_W1V = OFF_W1K + SZ_W1K, OFF_CTL = OFF_W1V + SZ_W1V, OFF_H = OFF_CTL + 65536;
constexpr size_t SZ_H = (size_t)MTOK * DM * 2, SZ_KS = (size_t)BATCH * NG * SEQ * DK * 2, SZ_VTS = (size_t)BATCH * NG * DV * SEQ * 2,
                 SZ_ACK = (size_t)4096 * 6144 * 2, SZ_ACV = (size_t)4096 * 4096 * 2;
constexpr size_t OFF_KS = OFF_H + SZ_H, OFF_KW = OFF_KS + SZ_KS, OFF_VTS = OFF_KW + SZ_KS, OFF_VTW = OFF_VTS + SZ_VTS, OFF_ACK = OFF_VTW + SZ_VTS,
                 OFF_ACV = OFF_ACK + SZ_ACK, OFF_KC = OFF_ACV + SZ_ACV;
constexpr size_t SZ_KC = (size_t)16 * 256 * DK * 2, SZ_VTC = (size_t)16 * DV * 256 * 2, SZ_HID = (size_t)4096 * 256 * 4;
constexpr size_t OFF_VTC = OFF_KC + SZ_KC, OFF_HIDK = OFF_VTC + SZ_VTC, OFF_HIDV = OFF_HIDK + SZ_HID, OFF_Y0 = OFF_HIDV + SZ_HID;
constexpr size_t SZ_Y0 = (size_t)MTOK * N1P * 2, SZ_O = (size_t)MTOK * ZW8 * 2;
constexpr size_t OFF_O = OFF_Y0 + SZ_Y0, WS_END = OFF_O + SZ_O;
constexpr size_t OFF_SS1 = OFF_HIDK;
constexpr size_t OFF_KM = 0;
constexpr size_t SZ_KM = (size_t)BATCH * NH * SEQ * DK * 2;
static_assert(SZ_KM <= SZ_W1T + SZ_W2T, "KM alias");
constexpr size_t OFF_VTM = OFF_H;
constexpr size_t SZ_VTM = (size_t)BATCH * NH * DV * SEQ * 2;
constexpr size_t OFF_CKVN = OFF_VTM + SZ_VTM;
constexpr size_t SZ_CKVN = (size_t)MTOK * KVLORA * 2;
static_assert(OFF_CKVN + SZ_CKVN <= OFF_KC, "CKVN alias");
constexpr size_t OFF_Y1 = OFF_Y0, SZ_Y1 = (size_t)MTOK * N3P * 2;
constexpr size_t OFF_QM = OFF_Y1 + SZ_Y1, SZ_QM = (size_t)MTOK * NQB * 2;
constexpr size_t OFF_KVM = OFF_QM + SZ_QM, SZ_KVM = (size_t)MTOK * NKVB * 2;
constexpr size_t OFF_KNM = OFF_KVM;
constexpr size_t OFF_KPER = OFF_KVM, OFF_SSPE = OFF_KVM + (size_t)MTOK * 64 * 4;
constexpr size_t OFF_CQN = OFF_KVM + SZ_KVM, SZ_CQN = (size_t)MTOK * QLORA * 2;
constexpr size_t OFF_ROPE = OFF_CQN + SZ_CQN, SZ_ROPE = (size_t)MTOK * 64 * 4;
static_assert(OFF_ROPE + SZ_ROPE <= OFF_O, "layer-1 alias region");
static_assert(WS_END <= 2680160256ull, "workspace");

struct Params {
    const float* x; const int* pos; const float* norm_w; const float* rel_bias;
    const float* nsa_w_in; const float* nsa_q_norm; const float* nsa_k_norm; const float* pe_k; const float* w1_k; const float* w2_k;
    const float* pe_v; const float* w1_v; const float* w2_v; const float* nsa_w_out;
    const float* mla_w_in; const float* mla_q_a_norm; const float* mla_w_q_b; const float* mla_kv_a_norm; const float* mla_w_kv_b;
    const float* mla_q_norm; const float* mla_k_norm; const float* mla_w_out;
    float* out; unsigned char* ws;
};

#define XB_TMO      128
#define XB_XCNT(j)  (256  + 64 * (j))
#define XB_XSUB(j)  (1280 + 64 * (j))
#define XB_XGEN(j)  (2304 + 64 * (j))
#define XB_TOP      3328
#define XB_TOPGEN   3392
#define XCD_BAR_WORDS 3456
#define XB_SPIN_CAP (1u << 18)

__device__ __forceinline__ unsigned xb_ld(unsigned* p)              { return __hip_atomic_load(p, __ATOMIC_RELAXED, __HIP_MEMORY_SCOPE_AGENT); }
__device__ __forceinline__ unsigned xb_add(unsigned* p, unsigned v) { return __hip_atomic_fetch_add(p, v, __ATOMIC_RELAXED, __HIP_MEMORY_SCOPE_AGENT); }
__device__ __forceinline__ unsigned xb_xcc_id() { return (unsigned)__builtin_amdgcn_s_getreg((3 << 11) | 20) & 0xFu; }
#define XB_SPIN(cond, bar) do { unsigned _sp = 0; while (cond) { __builtin_amdgcn_s_sleep(1); \
    if ((++_sp & 255u) == 0u) { if (xb_ld(&(bar)[XB_TMO])) break; if (_sp > XB_SPIN_CAP) { atomicAdd(&(bar)[XB_TMO], 1u); break; } } } } while (0)

struct XcdBarrier {
    unsigned* bar; unsigned x;
    volatile LAS unsigned* st;
};

__device__ __forceinline__ XcdBarrier xcd_barrier_post(unsigned* bar, volatile LAS unsigned* st) {
    XcdBarrier b; b.bar = bar; b.x = xb_xcc_id(); b.st = st;
    if (threadIdx.x == 0) (void)xb_add(&bar[XB_XCNT(b.x)], 1u);
    return b;
}
__device__ __forceinline__ void xcd_barrier_complete(unsigned* bar, unsigned x, unsigned& nloc, unsigned& nx) {
    const unsigned G = gridDim.x * gridDim.y * gridDim.z;
    unsigned sum, cnt, mine, sp = 0u;
    for (;;) {
        sum = 0u; cnt = 0u; mine = 0u;
#pragma unroll
        for (unsigned j = 0; j < 16; ++j) { const unsigned c = xb_ld(&bar[XB_XCNT(j)]); sum += c; cnt += (c > 0u) ? 1u : 0u; mine = (j == x) ? c : mine; }
        if (sum == G) break;
        __builtin_amdgcn_s_sleep(1);
        if ((++sp & 255u) == 0u) { if (xb_ld(&bar[XB_TMO])) break; if (sp > XB_SPIN_CAP) { atomicAdd(&bar[XB_TMO], 1u); break; } }
    }
    nloc = mine > 0u ? mine : 1u; nx = cnt > 0u ? cnt : 1u;
}

__device__ __forceinline__ void xcd_barrier(const XcdBarrier& b) {
    asm volatile("s_waitcnt vmcnt(0)" ::: "memory");
    __syncthreads();
    if (threadIdx.x == 0) {
        unsigned* bar = b.bar;
        __builtin_amdgcn_s_waitcnt(0);
        unsigned nloc = b.st[0], nx = b.st[1];
        if (nloc == 0u) { xcd_barrier_complete(bar, b.x, nloc, nx); b.st[0] = nloc; b.st[1] = nx; }
        const unsigned old = xb_add(&bar[XB_XSUB(b.x)], 1u);
        const unsigned gen = old / nloc;
        if (old + 1u == (gen + 1u) * nloc) {
            __builtin_amdgcn_fence(__ATOMIC_RELEASE, "agent");
            asm volatile("s_waitcnt vmcnt(0)" ::: "memory");
            const unsigned og = xb_add(&bar[XB_TOP], 1u);
            const unsigned tg = og / nx;
            if (og + 1u == (tg + 1u) * nx) xb_add(&bar[XB_TOPGEN], 1u);
            else XB_SPIN(xb_ld(&bar[XB_TOPGEN]) == tg, bar);
            __builtin_amdgcn_fence(__ATOMIC_ACQUIRE, "agent");
            xb_add(&bar[XB_XGEN(b.x)], 1u);
            asm volatile("s_waitcnt vmcnt(0)" ::: "memory");
        } else {
            XB_SPIN(xb_ld(&bar[XB_XGEN(b.x)]) == gen, bar);
            __builtin_amdgcn_fence(__ATOMIC_ACQUIRE, "agent");
            asm volatile("s_waitcnt vmcnt(0)" ::: "memory");
        }
    }
    __syncthreads();
}

namespace pg8 {
#define PG8_LAS __attribute__((address_space(3)))
typedef unsigned short bf16_t;
typedef short bf16x8 __attribute__((ext_vector_type(8)));
typedef float f32x4 __attribute__((ext_vector_type(4)));
typedef unsigned u32x4 __attribute__((ext_vector_type(4)));
constexpr int BM = 256, BK = 64, HALF = 128, HTB = HALF * BK * 2  , STAGE_BYTES = 8 * HTB, NXCD = 8, WGM = 8;

__host__ __device__ __forceinline__ int lds_byte(int r, int c) { const int st = (r >> 4) * 2 + (c >> 5), rr = r & 15, cc = c & 31, ob = rr * 64 + cc * 2; return st * 1024 + (ob ^ (((ob >> 9) & 1) << 5)); }
__host__ __device__ __forceinline__ void stage_rc(int b, int& R, int& C) { const int st = b / 1024, sb = b % 1024, swz = sb ^ (((sb >> 9) & 1) << 5); R = (st >> 1) * 16 + swz / 64; C = (st & 1) * 32 + (swz % 64) / 2; }
__host__ __device__ __forceinline__ int perm32(int rho) { const int n = rho >> 4, i = rho & 15; return 8 * (i >> 2) + 4 * n + (i & 3); }

struct Unit { int pm, pn; };
struct Gemm { const bf16_t* A; const bf16_t* Bt; int M, N, K; };

struct StaticOrder {
    int nM, nN, nwg, G, c;
    __host__ __device__ void init(int M, int N, int G_, int c_) { nM = M / BM; nN = N / BM; nwg = nM * nN; G = G_; c = c_; }
    __host__ __device__ bool next(int i, Unit& u) const {
        const long L = (long)i * G + c; if (L >= nwg) return false;
        int wgid = (int)L; { const int q = nwg / NXCD, r = nwg % NXCD, xcd = wgid % NXCD, off = wgid / NXCD; wgid = (xcd < r ? xcd * (q + 1) : r * (q + 1) + (xcd - r) * q) + off; }
        const int nig = WGM * nN, gid = wgid / nig, fm = gid * WGM, gsz = (nM - fm) < WGM ? (nM - fm) : WGM;
        u.pm = fm + ((wgid % nig) % gsz); u.pn = (wgid % nig) / gsz; return true;
    }
    __device__ __forceinline__ void a_ready(const Unit&) const {}
    __device__ __forceinline__ void done(const Unit&) const {}
};
struct EpiStoreBf16 {
    static constexpr bool PERM = true, AFTER_DRAIN = false, SWAP23 = false;
    bf16_t* O; int ldc;
    __device__ __forceinline__ void operator()(const f32x4 (&acc)[2][2][4][2], const Unit& u, int wr, int wc, int fr, int fq) const {
        const int row0 = u.pm * BM + wr * 64 + fr; const int col0 = u.pn * BM + wc * 32 + 8 * fq;
#pragma unroll
        for (int ai = 0; ai < 2; ++ai)
#pragma unroll
            for (int m = 0; m < 4; ++m) { bf16_t* rowp = O + (size_t)(row0 + ai * HALF + m * 16) * ldc + col0;
#pragma unroll
                for (int bj = 0; bj < 2; ++bj) { const f32x4 v0 = acc[ai][bj][m][0], v1 = acc[ai][bj][m][1];
                    u32x4 w; w.x = pk2(v0[0], v0[1]); w.y = pk2(v0[2], v0[3]); w.z = pk2(v1[0], v1[1]); w.w = pk2(v1[2], v1[3]);
                    *(u32x4*)(rowp + bj * HALF) = w; } }
    }
};
struct EpiResF32 {
    static constexpr bool PERM = false, AFTER_DRAIN = false, SWAP23 = false;
    const float* base; float* out; int ldc;
    __device__ __forceinline__ void operator()(const f32x4 (&acc)[2][2][4][2], const Unit& u, int wr, int wc, int fr, int fq) const {
        const int row0 = u.pm * BM + wr * 64 + fr, col0 = u.pn * BM + wc * 32 + 4 * fq;
#pragma unroll
        for (int ai = 0; ai < 2; ++ai)
#pragma unroll
            for (int m = 0; m < 4; ++m) { const size_t off = (size_t)(row0 + ai * HALF + m * 16) * ldc + col0;
#pragma unroll
                for (int bj = 0; bj < 2; ++bj)
#pragma unroll
                    for (int n = 0; n < 2; ++n) { const f32x4 bs = *(const f32x4*)(base + off + bj * HALF + n * 16);
                        *(f32x4*)(out + off + bj * HALF + n * 16) = bs + acc[ai][bj][m][n]; } }
    }
};
struct EpiPlainF32 {
    static constexpr bool PERM = false, AFTER_DRAIN = false, SWAP23 = false;
    float* C; int ldc;
    __device__ __forceinline__ void operator()(const f32x4 (&acc)[2][2][4][2], const Unit& u, int wr, int wc, int fr, int fq) const {
        const int row0 = u.pm * BM + wr * 64 + fr, col0 = u.pn * BM + wc * 32 + 4 * fq;
#pragma unroll
        for (int ai = 0; ai < 2; ++ai)
#pragma unroll
            for (int m = 0; m < 4; ++m) { float* rowp = C + (size_t)(row0 + ai * HALF + m * 16) * ldc + col0;
#pragma unroll
                for (int bj = 0; bj < 2; ++bj)
#pragma unroll
                    for (int n = 0; n < 2; ++n) *(f32x4*)(rowp + bj * HALF + n * 16) = acc[ai][bj][m][n]; }
    }
};

struct EpiVT {
    static constexpr bool PERM = true, AFTER_DRAIN = false, SWAP23 = true;
    bf16_t* O;
    __device__ __forceinline__ void operator()(const f32x4 (&acc)[2][2][4][2], const Unit& u, int wr, int wc, int fr, int fq) const {
        const int row0 = u.pm * BM + wr * 64 + fr; const int colt = u.pn * BM; const int b = colt >> 12, pos0 = (colt & 4095) + wc * 32 + 8 * fq;
        bf16_t* base = O + (size_t)b * 8192 * 4096 + pos0;
#pragma unroll
        for (int ai = 0; ai < 2; ++ai)
#pragma unroll
            for (int m = 0; m < 4; ++m) { bf16_t* rowp = base + (size_t)(row0 + ai * HALF + m * 16) * 4096;
#pragma unroll
                for (int bj = 0; bj < 2; ++bj) { const f32x4 v0 = acc[ai][bj][m][0], v1 = acc[ai][bj][m][1];
                    u32x4 w; w.x = pk2(v0[0], v0[1]); w.y = pk2(v0[2], v0[3]); w.z = pk2(v1[0], v1[1]); w.w = pk2(v1[2], v1[3]);
                    *(u32x4*)(rowp + bj * HALF) = w; } }
    }
};

struct EpiKNorm {
    static constexpr bool PERM = true, AFTER_DRAIN = false, SWAP23 = false;
    bf16_t* KM; const float* sspe; const float* kper; const float* gain; PG8_LAS float* tab; mutable unsigned par;
    __device__ __forceinline__ void operator()(const f32x4 (&acc)[2][2][4][2], const Unit& u, int wr, int wc, int fr, int fq) const {
        PG8_LAS float* T = tab + par * 2048;
#pragma unroll
        for (int ai = 0; ai < 2; ++ai)
#pragma unroll
            for (int m = 0; m < 4; ++m) { const int row = ai * HALF + wr * 64 + m * 16 + fr;
#pragma unroll
                for (int bj = 0; bj < 2; ++bj) { const f32x4 x = acc[ai][bj][m][0], y = acc[ai][bj][m][1];
                    float ss = (x[0] * x[0] + x[1] * x[1]) + (x[2] * x[2] + x[3] * x[3]) + (y[0] * y[0] + y[1] * y[1]) + (y[2] * y[2] + y[3] * y[3]);
                    ss += __shfl_xor(ss, 16); ss += __shfl_xor(ss, 32);
                    if (fq == 0) T[row * 8 + bj * 4 + wc] = ss; } }
        asm volatile("s_waitcnt lgkmcnt(0)" ::: "memory"); __builtin_amdgcn_s_barrier(); asm volatile("" ::: "memory");
        const f32x4 g0 = *(const f32x4*)(gain + wc * 32 + 8 * fq), g1 = *(const f32x4*)(gain + wc * 32 + 8 * fq + 4);
        const int tok0 = u.pm * BM, b = tok0 >> 12;
#pragma unroll
        for (int ai = 0; ai < 2; ++ai)
#pragma unroll
            for (int m = 0; m < 4; ++m) { const int row = ai * HALF + wr * 64 + m * 16 + fr, tok = tok0 + row, s = tok & 4095;
                const float sp = sspe[tok]; const f32x4 kp = *(const f32x4*)(kper + (size_t)tok * 64 + wc * 16 + 4 * fq);
#pragma unroll
                for (int bj = 0; bj < 2; ++bj) { const f32x4 t = *(const PG8_LAS f32x4*)(T + row * 8 + bj * 4);
                    const float rstd = rsqrtf(((t[0] + t[1]) + (t[2] + t[3]) + sp) * (1.0f / 192.0f) + 1e-6f);
                    const int hd = 2 * u.pn + bj;
                    bf16_t* kb = KM + ((size_t)(b * 64 + hd) * 4096 + s) * 192;
                    const f32x4 x = acc[ai][bj][m][0], y = acc[ai][bj][m][1];
                    u32x4 w; w.x = pk2(x[0] * rstd * g0[0], x[1] * rstd * g0[1]); w.y = pk2(x[2] * rstd * g0[2], x[3] * rstd * g0[3]);
                    w.z = pk2(y[0] * rstd * g1[0], y[1] * rstd * g1[1]); w.w = pk2(y[2] * rstd * g1[2], y[3] * rstd * g1[3]);
                    *(u32x4*)(kb + wc * 32 + 8 * fq) = w;
                    u32x2 r; r.x = pk2(kp[0] * rstd, kp[1] * rstd); r.y = pk2(kp[2] * rstd, kp[3] * rstd);
                    *(u32x2*)(kb + 128 + wc * 16 + 4 * fq) = r; } }
        par ^= 1u;
    }
};

struct EpiResNorm {
    static constexpr bool PERM = false, AFTER_DRAIN = false, SWAP23 = false;
    const float* base; float* out; int ldc; const float* gain; bf16_t* xg; float* ss;
    __device__ __forceinline__ void operator()(const f32x4 (&acc)[2][2][4][2], const Unit& u, int wr, int wc, int fr, int fq) const {
        const int row0 = u.pm * BM + wr * 64 + fr, col0 = u.pn * BM + wc * 32 + 4 * fq;
        f32x4 gv[2][2];
#pragma unroll
        for (int bj = 0; bj < 2; ++bj)
#pragma unroll
            for (int n = 0; n < 2; ++n) gv[bj][n] = *(const f32x4*)(gain + col0 + bj * HALF + n * 16);
#pragma unroll
        for (int ai = 0; ai < 2; ++ai)
#pragma unroll
            for (int m = 0; m < 4; ++m) { const int row = row0 + ai * HALF + m * 16; const size_t off = (size_t)row * ldc + col0; float sq = 0.f;
#pragma unroll
                for (int bj = 0; bj < 2; ++bj)
#pragma unroll
                    for (int n = 0; n < 2; ++n) { const f32x4 bs = *(const f32x4*)(base + off + bj * HALF + n * 16); const f32x4 v = bs + acc[ai][bj][m][n];
                        *(f32x4*)(out + off + bj * HALF + n * 16) = v;
                        sq += (v[0] * v[0] + v[1] * v[1]) + (v[2] * v[2] + v[3] * v[3]);
                        const f32x4 g = gv[bj][n]; u32x2 w; w.x = pk2(v[0] * g[0], v[1] * g[1]); w.y = pk2(v[2] * g[2], v[3] * g[3]);
                        *(u32x2*)(xg + off + bj * HALF + n * 16) = w; }
                sq += __shfl_xor(sq, 16); sq += __shfl_xor(sq, 32);
                if (fq == 0) atomicAdd(ss + row, sq); }
    }
};
struct EpiStoreBf16RowScale {
    static constexpr bool PERM = true, AFTER_DRAIN = false, SWAP23 = false;
    bf16_t* O; int ldc; const float* ss; float inv_dim;
    __device__ __forceinline__ void operator()(const f32x4 (&acc)[2][2][4][2], const Unit& u, int wr, int wc, int fr, int fq) const {
        const int row0 = u.pm * BM + wr * 64 + fr; const int col0 = u.pn * BM + wc * 32 + 8 * fq;
#pragma unroll
        for (int ai = 0; ai < 2; ++ai)
#pragma unroll
            for (int m = 0; m < 4; ++m) { const int row = row0 + ai * HALF + m * 16; const float rs = rsqrtf(ss[row] * inv_dim + 1e-6f);
                bf16_t* rowp = O + (size_t)row * ldc + col0;
#pragma unroll
                for (int bj = 0; bj < 2; ++bj) { const f32x4 v0 = acc[ai][bj][m][0] * rs, v1 = acc[ai][bj][m][1] * rs;
                    u32x4 w; w.x = pk2(v0[0], v0[1]); w.y = pk2(v0[2], v0[3]); w.z = pk2(v1[0], v1[1]); w.w = pk2(v1[2], v1[3]);
                    *(u32x4*)(rowp + bj * HALF) = w; } }
    }
};
template <class Epi, class Sched, bool STAMP = false>
__device__ __forceinline__ void gemm_phase(PG8_LAS unsigned char* lds, const Gemm g, const Sched& S, const Epi& E, unsigned long long* stamps) {
    const int tid = tid_opaque(), wid = __builtin_amdgcn_readfirstlane(tid >> 6), lane = tid & 63, wr = wid >> 2, wc = wid & 3, fr = lane & 15, fq = lane >> 4;
    const int K = g.K, nt = K / BK;
    int ts_lo = 0, ts_hi = 0, nts = 0; const unsigned long long rt_entry = STAMP ? (unsigned long long)wall_clock64() : 0ull;
#define PG8_STAMP() do { if (STAMP && wid == 0 && nts < 64) { const unsigned long long _c = (unsigned long long)clock64(); \
        ts_lo = (lane == nts) ? (int)(unsigned)_c : ts_lo; ts_hi = (lane == nts) ? (int)(unsigned)(_c >> 32) : ts_hi; ++nts; } } while (0)
    PG8_STAMP();
    unsigned voffA[2], voffB[2];
#pragma unroll
    for (int i = 0; i < 2; ++i) { int R, C; stage_rc(tid * 16 + i * 8192, R, C); int Rb = Epi::PERM ? ((R & ~31) + perm32(R & 31)) : R; if (Epi::SWAP23) Rb = vt_key_of_pos(Rb);
        voffA[i] = (unsigned)(R * K + C) * 2u; voffB[i] = (unsigned)(Rb * K + C) * 2u; }
    const size_t kstep = (size_t)(BK * 2);
    const size_t hstep = (size_t)HALF * K * 2;
    const size_t tstep = 2 * hstep;
    const unsigned ldsw = (unsigned)wid * 1024u;
    const int aoff = lds_byte(wr * 64 + fr, fq * 8), boff = lds_byte(wc * 32 + fr, fq * 8);
#define PG8_SA(b, h) (((b) * 2 + (h)) * HTB)
#define PG8_SB(b, h) ((4 + (b) * 2 + (h)) * HTB)
#define PG8_STAGE(bufoff, gbase, voff) do { _Pragma("unroll") for (int _i = 0; _i < 2; ++_i) \
        __builtin_amdgcn_global_load_lds((const unsigned*)((const char*)(gbase) + (voff)[_i]), (PG8_LAS unsigned*)(lds + (bufoff) + ldsw + _i * 8192), 16, 0, 0); } while (0)
#define PG8_LDA(dst, b, h) do { _Pragma("unroll") for (int m = 0; m < 4; ++m) _Pragma("unroll") for (int k = 0; k < 2; ++k) dst[m][k] = *(const PG8_LAS bf16x8*)(lds + PG8_SA(b, h) + aoff + m * 2048 + k * 1024); } while (0)
#define PG8_LDB(dst, b, h) do { _Pragma("unroll") for (int n = 0; n < 2; ++n) _Pragma("unroll") for (int k = 0; k < 2; ++k) dst[n][k] = *(const PG8_LAS bf16x8*)(lds + PG8_SB(b, h) + boff + n * 2048 + k * 1024); } while (0)
#define PG8_MMA(ai, bj, At, Bt) do { __builtin_amdgcn_s_setprio(1); _Pragma("unroll") for (int m = 0; m < 4; ++m) _Pragma("unroll") for (int n = 0; n < 2; ++n) _Pragma("unroll") for (int k = 0; k < 2; ++k) \
        acc[ai][bj][m][n] = __builtin_amdgcn_mfma_f32_16x16x32_bf16(Bt[n][k], At[m][k], acc[ai][bj][m][n], 0, 0, 0); __builtin_amdgcn_s_setprio(0); } while (0)
#define PG8_WAIT_V(n) asm volatile("s_waitcnt vmcnt(" #n ")" ::: "memory")
#define PG8_WAIT_L(n) asm volatile("s_waitcnt lgkmcnt(" #n ")" ::: "memory")
#define PG8_BAR __builtin_amdgcn_s_barrier()
#define PG8_SCHED __builtin_amdgcn_sched_barrier(0)
    Unit cur, nxt; int ui = 0;
    if (!S.next(0, cur)) return;
    f32x4 acc[2][2][4][2];
#pragma unroll
    for (int a = 0; a < 2; ++a)
#pragma unroll
        for (int b = 0; b < 2; ++b)
#pragma unroll
            for (int m = 0; m < 4; ++m)
#pragma unroll
                for (int n = 0; n < 2; ++n) acc[a][b][m][n] = (f32x4){0.f, 0.f, 0.f, 0.f};
    bf16x8 At[4][2], B0[2][2], B1[2][2];
    const char* cA = (const char*)g.A + (size_t)cur.pm * tstep; const char* cB = (const char*)g.Bt + (size_t)cur.pn * tstep;
    S.a_ready(cur);
    PG8_STAGE(PG8_SB(0, 0), cB, voffB); PG8_STAGE(PG8_SA(0, 0), cA, voffA); PG8_STAGE(PG8_SB(0, 1), cB + hstep, voffB); PG8_STAGE(PG8_SA(0, 1), cA + hstep, voffA);
    if (wr == 1) PG8_BAR;
    PG8_WAIT_V(4); PG8_BAR;
    PG8_STAGE(PG8_SB(1, 0), cB + kstep, voffB); PG8_STAGE(PG8_SA(1, 0), cA + kstep, voffA); PG8_STAGE(PG8_SB(1, 1), cB + hstep + kstep, voffB);
    PG8_WAIT_V(6); PG8_BAR;
    PG8_STAMP();
    for (;;) {
        const bool has_next = S.next(ui + 1, nxt);
        const char* nA = has_next ? (const char*)g.A + (size_t)nxt.pm * tstep : cA; const char* nB = has_next ? (const char*)g.Bt + (size_t)nxt.pn * tstep : cB;
        for (int t = 0; t < nt; t += 2) {
            const bool last = (t == nt - 2);
            const char* a1 = cA + (size_t)(t + 1) * kstep;
            const char* a2 = last ? nA : cA + (size_t)(t + 2) * kstep; const char* b2 = last ? nB : cB + (size_t)(t + 2) * kstep;
            const char* a3 = a2 + kstep; const char* b3 = b2 + kstep;
            if (last && has_next) S.a_ready(nxt);
            PG8_LDB(B0, 0, 0); PG8_SCHED; PG8_LDA(At, 0, 0); PG8_STAGE(PG8_SA(1, 1), a1 + hstep, voffA);
            PG8_WAIT_L(8); PG8_BAR; PG8_WAIT_L(0); PG8_MMA(0, 0, At, B0); PG8_BAR; PG8_SCHED;
            PG8_LDB(B1, 0, 1); PG8_STAGE(PG8_SB(0, 0), b2, voffB);
            PG8_BAR; PG8_WAIT_L(0); PG8_MMA(0, 1, At, B1); PG8_BAR;
            PG8_LDA(At, 0, 1); PG8_STAGE(PG8_SA(0, 0), a2, voffA);
            PG8_BAR; PG8_WAIT_L(0); PG8_MMA(1, 0, At, B0); PG8_BAR; PG8_SCHED;
            PG8_STAGE(PG8_SB(0, 1), b2 + hstep, voffB);
            PG8_WAIT_V(6); PG8_BAR; PG8_MMA(1, 1, At, B1); PG8_BAR;
            PG8_LDB(B0, 1, 0); PG8_SCHED; PG8_LDA(At, 1, 0); PG8_STAGE(PG8_SA(0, 1), a2 + hstep, voffA);
            PG8_WAIT_L(8); PG8_BAR; PG8_WAIT_L(0); PG8_MMA(0, 0, At, B0); PG8_BAR; PG8_SCHED;
            PG8_LDB(B1, 1, 1); PG8_STAGE(PG8_SB(1, 0), b3, voffB);
            PG8_BAR; PG8_WAIT_L(0); PG8_MMA(0, 1, At, B1); PG8_BAR;
            PG8_LDA(At, 1, 1); PG8_STAGE(PG8_SA(1, 0), a3, voffA);
            PG8_BAR; PG8_WAIT_L(0); PG8_MMA(1, 0, At, B0); PG8_BAR; PG8_SCHED;
            PG8_STAGE(PG8_SB(1, 1), b3 + hstep, voffB);
            PG8_WAIT_V(6); PG8_BAR; PG8_MMA(1, 1, At, B1); PG8_BAR;
        }
        PG8_STAMP();
        if constexpr (!Epi::AFTER_DRAIN) { E(acc, cur, wr, wc, fr, fq); S.done(cur); }
        PG8_STAMP();
        if (!has_next) break;
#pragma unroll
        for (int a = 0; a < 2; ++a)
#pragma unroll
            for (int b = 0; b < 2; ++b)
#pragma unroll
                for (int m = 0; m < 4; ++m)
#pragma unroll
                    for (int n = 0; n < 2; ++n) acc[a][b][m][n] = (f32x4){0.f, 0.f, 0.f, 0.f};
        cur = nxt; cA = nA; cB = nB; ++ui;
    }
    PG8_WAIT_V(0);
    if (wr == 0) PG8_BAR;
    PG8_BAR;
    if constexpr (Epi::AFTER_DRAIN) { E.fused(acc, cur, wr, wc, fr, fq, lds, wid, lane); S.done(cur); }
    PG8_STAMP();
    if (STAMP && wid == 0) { stamps[lane] = lane < nts ? (((unsigned long long)(unsigned)ts_hi << 32) | (unsigned)ts_lo) : 0ull;
        if (lane == 62) stamps[62] = rt_entry; if (lane == 63) stamps[63] = (unsigned long long)wall_clock64(); }
#undef PG8_STAMP
#undef PG8_SA
#undef PG8_SB
#undef PG8_STAGE
#undef PG8_LDA
#undef PG8_LDB
#undef PG8_MMA
#undef PG8_WAIT_V
#undef PG8_WAIT_L
#undef PG8_BAR
#undef PG8_SCHED
}
}


DI void phase_wconv(LAS unsigned char* lds, const float* __restrict__ src, bf16_t* __restrict__ dst, int K, int N, int Npad, int bid, int nb, float q8s = 0.f, int colmap = 0) {
    LAS float* tile = (LAS float*)lds;
    const int tid = tid_opaque();
    const int tk = K / 64, tn = Npad / 256, total = tk * tn;
    for (int t = bid; t < total; t += nb) {
        const int k0 = (t % tk) * 64, n0 = (t / tk) * 256;
        __syncthreads();
        {
            const int ty = tid >> 6, tx = tid & 63, n = n0 + tx * 4;
            f32x4 v[8];
#pragma unroll
            for (int i = 0; i < 8; ++i) {
                const int k = k0 + ty + 8 * i;
                v[i] = (f32x4){0.f, 0.f, 0.f, 0.f};
                if (colmap) { const int ns = (n >> 7) * 256 + (colmap == 1 ? 128 : 0) + (n & 127); v[i] = *(const f32x4*)(src + (size_t)k * (2 * N) + ns); }
                else if (n < N) v[i] = *(const f32x4*)(src + (size_t)k * N + n);
            }
#pragma unroll
            for (int i = 0; i < 8; ++i) { LAS float* pp = tile + (ty + 8 * i) * 257 + tx * 4; pp[0] = v[i][0]; pp[1] = v[i][1]; pp[2] = v[i][2]; pp[3] = v[i][3]; }
        }
        __syncthreads();
#pragma unroll
        for (int ps_ = 0; ps_ < 4; ++ps_) {
            const int n = (tid >> 3) + 64 * ps_, kc = tid & 7;
            float v[8];
#pragma unroll
            for (int j = 0; j < 8; ++j) { v[j] = tile[(kc * 8 + j) * 257 + n]; if (q8s > 0.f) v[j] = emu_q8(v[j], q8s); else if (q8s < 0.f && n0 + n >= C_ZC) v[j] = emu_q8(v[j], -q8s); }
            u32x4 w; w.x = pk2(v[0], v[1]); w.y = pk2(v[2], v[3]); w.z = pk2(v[4], v[5]); w.w = pk2(v[6], v[7]);
            *(u32x4*)(dst + (size_t)(n0 + n) * K + k0 + kc * 8) = w;
        }
    }
}

DI void phase_rmsnorm(const float* __restrict__ x, const float* __restrict__ gain, bf16_t* __restrict__ h, int bid, int nb, float q8s = 0.f) {
    const int tid = tid_opaque(); const int lane = tid & 63, wid = tid >> 6;
    for (int row = bid * 8 + wid; row < MTOK; row += nb * 8) {
        const float* xr = x + (size_t)row * DM;
        f32x4 v[16]; float ss = 0.f;
#pragma unroll
        for (int i = 0; i < 16; ++i) { v[i] = *(const f32x4*)(xr + (i * 64 + lane) * 4); ss += v[i][0] * v[i][0] + v[i][1] * v[i][1] + v[i][2] * v[i][2] + v[i][3] * v[i][3]; }
#pragma unroll
        for (int o = 32; o >= 1; o >>= 1) ss += __shfl_xor(ss, o);
        const float rstd = rsqrtf(ss * (1.0f / DM) + EPSN);
        bf16_t* hr = h + (size_t)row * DM;
#pragma unroll
        for (int i = 0; i < 16; ++i) { const f32x4 g = *(const f32x4*)(gain + (i * 64 + lane) * 4);
            float y0 = v[i][0] * rstd * g[0], y1 = v[i][1] * rstd * g[1], y2 = v[i][2] * rstd * g[2], y3 = v[i][3] * rstd * g[3];
            if (q8s > 0.f || (q8s < 0.f && (row & 4095) >= 256)) { const float qa = fabsf(q8s); y0 = emu_q8(y0, qa); y1 = emu_q8(y1, qa); y2 = emu_q8(y2, qa); y3 = emu_q8(y3, qa); }
            u32x2 w; w.x = pk2(y0, y1); w.y = pk2(y2, y3);
            *(u32x2*)(hr + (i * 64 + lane) * 4) = w; }
    }
}

DI void ld192(const bf16_t* p, int j8, float (&v)[24]) {
#pragma unroll
    for (int c = 0; c < 3; ++c) { const u32x4 w = *(const u32x4*)(p + (j8 + 8 * c) * 8);
        v[c * 8 + 0] = bflo(w.x); v[c * 8 + 1] = bfhi(w.x); v[c * 8 + 2] = bflo(w.y); v[c * 8 + 3] = bfhi(w.y);
        v[c * 8 + 4] = bflo(w.z); v[c * 8 + 5] = bfhi(w.z); v[c * 8 + 6] = bflo(w.w); v[c * 8 + 7] = bfhi(w.w); }
}
DI void st192(bf16_t* p, int j8, const float (&v)[24]) {
#pragma unroll
    for (int c = 0; c < 3; ++c) { u32x4 w; w.x = pk2(v[c * 8 + 0], v[c * 8 + 1]); w.y = pk2(v[c * 8 + 2], v[c * 8 + 3]); w.z = pk2(v[c * 8 + 4], v[c * 8 + 5]); w.w = pk2(v[c * 8 + 6], v[c * 8 + 7]);
        *(u32x4*)(p + (j8 + 8 * c) * 8) = w; }
}
DI float sum8(float s) { s += __shfl_xor(s, 1); s += __shfl_xor(s, 2); s += __shfl_xor(s, 4); return s; }

DI void phase_nsa_prep(const Params& P, int bid, int nb) {
    bf16_t* Y0 = (bf16_t*)(P.ws + OFF_Y0);
    bf16_t* KS = (bf16_t*)(P.ws + OFF_KS); bf16_t* KW = (bf16_t*)(P.ws + OFF_KW);
    bf16_t* ACK = (bf16_t*)(P.ws + OFF_ACK); bf16_t* ACV = (bf16_t*)(P.ws + OFF_ACV);
    const int tid = tid_opaque(), grp = (tid >> 3) & 15, j8 = tid & 7;
    for (int tok = bid * 4 + (tid >> 7); tok < MTOK; tok += nb * 4) {
        const int b = tok / SEQ, s = tok % SEQ;
        bf16_t* yr = Y0 + (size_t)tok * N1P;
        if (grp < 8) {
            const int g = grp & 3, br = grp >> 2;
            float v[24]; ld192(yr + (br ? C_KVW : C_KVS) + g * DK, j8, v);
            float ss = 0.f;
#pragma unroll
            for (int i = 0; i < 24; ++i) ss += v[i] * v[i];
            ss = sum8(ss);
            const float rstd = rsqrtf(ss * (1.0f / DK) + EPSN);
            const float* kn = P.nsa_k_norm + (br ? 2 : 1) * DK;
#pragma unroll
            for (int c = 0; c < 3; ++c)
#pragma unroll
                for (int e = 0; e < 8; ++e) v[c * 8 + e] *= rstd * kn[(j8 + 8 * c) * 8 + e];
            st192((br ? KW : KS) + ((size_t)(b * NG + g) * SEQ + s) * DK, j8, v);
        } else if (grp < 12) {
            const int g = grp - 8;
            float v[24]; ld192(yr + C_KVC + g * DK, j8, v);
#pragma unroll
            for (int k = 0; k < 2; ++k) {
                const int n = (s >> 4) - k, l = s - 16 * n;
                if (n >= 0 && n <= 254) {
                    float w[24];
#pragma unroll
                    for (int c = 0; c < 3; ++c)
#pragma unroll
                        for (int e = 0; e < 8; ++e) w[c * 8 + e] = v[c * 8 + e] + P.pe_k[l * DK + (j8 + 8 * c) * 8 + e];
                    st192(ACK + ((size_t)((b * NG + g) * 256 + n)) * 6144 + l * DK, j8, w);
                }
            }
        } else if (grp < 16) {
            const int g = grp - 12;
            const bf16_t* src = yr + C_KVC + NG * DK + g * DV;
            float v[16];
#pragma unroll
            for (int c = 0; c < 2; ++c) { const u32x4 w = *(const u32x4*)(src + (j8 + 8 * c) * 8);
                v[c * 8 + 0] = bflo(w.x); v[c * 8 + 1] = bfhi(w.x); v[c * 8 + 2] = bflo(w.y); v[c * 8 + 3] = bfhi(w.y);
                v[c * 8 + 4] = bflo(w.z); v[c * 8 + 5] = bfhi(w.z); v[c * 8 + 6] = bflo(w.w); v[c * 8 + 7] = bfhi(w.w); }
#pragma unroll
            for (int k = 0; k < 2; ++k) {
                const int n = (s >> 4) - k, l = s - 16 * n;
                if (n >= 0 && n <= 254) {
                    bf16_t* dst = ACV + ((size_t)((b * NG + g) * 256 + n)) * 4096 + l * DV;
#pragma unroll
                    for (int c = 0; c < 2; ++c) { float w[8];
#pragma unroll
                        for (int e = 0; e < 8; ++e) w[e] = v[c * 8 + e] + P.pe_v[l * DV + (j8 + 8 * c) * 8 + e];
                        u32x4 o; o.x = pk2(w[0], w[1]); o.y = pk2(w[2], w[3]); o.z = pk2(w[4], w[5]); o.w = pk2(w[6], w[7]);
                        *(u32x4*)(dst + (j8 + 8 * c) * 8) = o; }
                }
            }
        }
    }
    for (int i = bid * 512 + tid; i < 16 * (6144 + 4096) / 8; i += nb * 512) {
        const int per = (6144 + 4096) / 8, bg = i / per, c = i % per;
        const u32x4 z = {0u, 0u, 0u, 0u};
        if (c < 6144 / 8) *(u32x4*)(ACK + ((size_t)(bg * 256 + 255)) * 6144 + c * 8) = z;
        else *(u32x4*)(ACV + ((size_t)(bg * 256 + 255)) * 4096 + (c - 6144 / 8) * 8) = z;
    }
}

DI int swap23(int p) { return (p & ~0xC) | ((p & 4) << 1) | ((p & 8) >> 1); }
DI void phase_vt(LAS unsigned char* lds, const bf16_t* __restrict__ src, size_t src_stride, int col0, int col_step, int nhv, bf16_t* __restrict__ dst, int bid, int nb) {
    LAS bf16_t* tile = (LAS bf16_t*)lds;
    const int tid = tid_opaque();
    const int ntile = SEQ / 64, total = BATCH * nhv * ntile;
    for (int it = bid; it < total; it += nb) {
        const int mat = it / ntile, tt = it % ntile, b = mat / nhv, hv = mat % nhv;
        __syncthreads();
#pragma unroll
        for (int i = 0; i < 2; ++i) {
            const int q = tid + 512 * i, tok = q >> 4, ch = q & 15;
            const u32x4 w = *(const u32x4*)(src + (size_t)(b * SEQ + tt * 64 + tok) * src_stride + col0 + hv * col_step + ch * 8);
            *(LAS u32x4*)(tile + tok * 136 + ch * 8) = w;
        }
        __syncthreads();
        {
            const int dv = tid >> 2, kq = tid & 3;
            unsigned w[8];
#pragma unroll
            for (int e = 0; e < 8; ++e) {
                const int p0 = kq * 16 + 2 * e, p1 = p0 + 1;
                const int k0 = vt_key_of_pos(p0), k1 = vt_key_of_pos(p1);
                w[e] = (unsigned)tile[k0 * 136 + dv] | ((unsigned)tile[k1 * 136 + dv] << 16);
            }
            bf16_t* d = dst + ((size_t)mat * DV + dv) * SEQ + tt * 64 + kq * 16;
            u32x4 a = {w[0], w[1], w[2], w[3]}, c = {w[4], w[5], w[6], w[7]};
            *(u32x4*)d = a; *(u32x4*)(d + 8) = c;
        }
    }
}

DI void phase_cmp2(LAS unsigned char* lds, const Params& P, int bid, int nb) {
    LAS float* sk = (LAS float*)lds;
    LAS float* sv = sk + 192;
    LAS float* red = sv + 128;
    const float* HIDK = (const float*)(P.ws + OFF_HIDK); const float* HIDV = (const float*)(P.ws + OFF_HIDV);
    bf16_t* KC = (bf16_t*)(P.ws + OFF_KC); bf16_t* VTC = (bf16_t*)(P.ws + OFF_VTC);
    const int tid = tid_opaque(), lane = tid & 63, wid = tid >> 6;
    for (int m = bid; m < 4096; m += nb) {
        const int n = m & 255, bg = m >> 8;
        __syncthreads();
        if (tid < 192) { const float h = HIDK[(size_t)m * 256 + tid]; sk[tid] = h / (1.0f + __expf(-h)); }
        else if (tid < 320) { const float h = HIDV[(size_t)m * 256 + tid - 192]; sv[tid - 192] = h / (1.0f + __expf(-h)); }
        __syncthreads();
        float acc = 0.f;
        if (tid < 192) { for (int i = 0; i < 192; ++i) acc += sk[i] * P.w2_k[i * 192 + tid]; }
        else if (tid < 320) { const int j = tid - 192; for (int i = 0; i < 128; ++i) acc += sv[i] * P.w2_v[i * 128 + j]; }
        float ss = (tid < 192) ? acc * acc : 0.f;
#pragma unroll
        for (int o = 32; o >= 1; o >>= 1) ss += __shfl_xor(ss, o);
        if (lane == 0) red[wid] = ss;
        __syncthreads();
        const float tot = red[0] + red[1] + red[2];
        const float rstd = rsqrtf(tot * (1.0f / DK) + EPSN);
        if (tid < 192) { const float o = (n == 255) ? 0.f : acc * rstd * P.nsa_k_norm[tid];
            KC[(size_t)m * DK + tid] = (bf16_t)(pk2(o, 0.f) & 0xffffu); }
        else if (tid < 320) { const int j = tid - 192; const float o = (n == 255) ? 0.f : acc;
            const int pn = vt_pos_of_key(n);
            VTC[((size_t)bg * DV + j) * 256 + pn] = (bf16_t)(pk2(o, 0.f) & 0xffffu); }
    }
}

DI void phase_mla_prep1(const Params& P, int bid, int nb) {
    const bf16_t* Y1 = (const bf16_t*)(P.ws + OFF_Y1);
    bf16_t* CQN = (bf16_t*)(P.ws + OFF_CQN); bf16_t* CKVN = (bf16_t*)(P.ws + OFF_CKVN); float* ROPE = (float*)(P.ws + OFF_ROPE);
    float* KPER = (float*)(P.ws + OFF_KPER); float* SSPE = (float*)(P.ws + OFF_SSPE);
    const int tid = tid_opaque(); const int lane = tid & 63, wid = tid >> 6;
    constexpr int TU = 4;
    for (int tok0 = (bid * 8 + wid) * TU; tok0 < MTOK; tok0 += nb * 8 * TU) {
        u32x4 wq[TU][3], wk[TU]; int pos[TU]; bf16_t kp1[TU], kp2[TU];
#pragma unroll
        for (int t = 0; t < TU; ++t) { const bf16_t* yr = Y1 + (size_t)(tok0 + t) * N3P;
#pragma unroll
            for (int c = 0; c < 3; ++c) wq[t][c] = *(const u32x4*)(yr + C3_CQ + (c * 64 + lane) * 8);
            wk[t] = *(const u32x4*)(yr + C3_CKV + lane * 8);
            pos[t] = P.pos[tok0 + t]; kp1[t] = yr[C3_KPE + (lane & 31)]; kp2[t] = yr[C3_KPE + 32 + (lane & 31)]; }
#pragma unroll
        for (int t = 0; t < TU; ++t) { const int tok = tok0 + t;
            {
                float v[24]; float ss = 0.f;
#pragma unroll
                for (int c = 0; c < 3; ++c) { const u32x4 w = wq[t][c];
                    v[c * 8 + 0] = bflo(w.x); v[c * 8 + 1] = bfhi(w.x); v[c * 8 + 2] = bflo(w.y); v[c * 8 + 3] = bfhi(w.y);
                    v[c * 8 + 4] = bflo(w.z); v[c * 8 + 5] = bfhi(w.z); v[c * 8 + 6] = bflo(w.w); v[c * 8 + 7] = bfhi(w.w); }
#pragma unroll
                for (int i = 0; i < 24; ++i) ss += v[i] * v[i];
#pragma unroll
                for (int o = 32; o >= 1; o >>= 1) ss += __shfl_xor(ss, o);
                const float rstd = rsqrtf(ss * (1.0f / QLORA) + EPSN);
#pragma unroll
                for (int c = 0; c < 3; ++c) { const float* g = P.mla_q_a_norm + (c * 64 + lane) * 8; const f32x4 g0 = *(const f32x4*)g, g1 = *(const f32x4*)(g + 4); u32x4 w;
                    w.x = pk2(v[c * 8 + 0] * rstd * g0[0], v[c * 8 + 1] * rstd * g0[1]); w.y = pk2(v[c * 8 + 2] * rstd * g0[2], v[c * 8 + 3] * rstd * g0[3]);
                    w.z = pk2(v[c * 8 + 4] * rstd * g1[0], v[c * 8 + 5] * rstd * g1[1]); w.w = pk2(v[c * 8 + 6] * rstd * g1[2], v[c * 8 + 7] * rstd * g1[3]);
                    *(u32x4*)(CQN + (size_t)tok * QLORA + (c * 64 + lane) * 8) = w; }
            }
            {
                float v[8]; float ss = 0.f; const u32x4 w0 = wk[t];
                v[0] = bflo(w0.x); v[1] = bfhi(w0.x); v[2] = bflo(w0.y); v[3] = bfhi(w0.y); v[4] = bflo(w0.z); v[5] = bfhi(w0.z); v[6] = bflo(w0.w); v[7] = bfhi(w0.w);
#pragma unroll
                for (int i = 0; i < 8; ++i) ss += v[i] * v[i];
#pragma unroll
                for (int o = 32; o >= 1; o >>= 1) ss += __shfl_xor(ss, o);
                const float rstd = rsqrtf(ss * (1.0f / KVLORA) + EPSN);
                const float* g = P.mla_kv_a_norm + lane * 8; const f32x4 g0 = *(const f32x4*)g, g1 = *(const f32x4*)(g + 4); u32x4 w;
                w.x = pk2(v[0] * rstd * g0[0], v[1] * rstd * g0[1]); w.y = pk2(v[2] * rstd * g0[2], v[3] * rstd * g0[3]);
                w.z = pk2(v[4] * rstd * g1[0], v[5] * rstd * g1[1]); w.w = pk2(v[6] * rstd * g1[2], v[7] * rstd * g1[3]);
                *(u32x4*)(CKVN + (size_t)tok * KVLORA + lane * 8) = w;
            }
            {
                const int i = lane & 31;
                const float invf = exp2f(-(float)i * (13.287712379549449f / 32.0f));
                const float ang = (float)pos[t] * invf;
                const double rev = (double)ang * 0.15915494309189533576888;
                const float fr = (float)(rev - __builtin_rint(rev));
                const float sn = __builtin_amdgcn_sinf(fr), cs = __builtin_amdgcn_cosf(fr);
                const float x1 = bf1(kp1[t]), x2 = bf1(kp2[t]);
                float ssp = x1 * x1 + x2 * x2;
#pragma unroll
                for (int o = 16; o >= 1; o >>= 1) ssp += __shfl_xor(ssp, o);
                const float a = x1 * P.mla_k_norm[128 + i], c = x2 * P.mla_k_norm[160 + i];
                if (lane < 32) { ROPE[(size_t)tok * 64 + i] = cs; ROPE[(size_t)tok * 64 + 32 + i] = sn;
                    KPER[(size_t)tok * 64 + i] = a * cs - c * sn; KPER[(size_t)tok * 64 + 32 + i] = c * cs + a * sn;
                    if (lane == 0) SSPE[tok] = ssp; }
            }
        }
    }
}

DI void phase_mla_prep2(const Params& P, int bid, int nb) {
    const bf16_t* KNM = (const bf16_t*)(P.ws + OFF_KNM); const bf16_t* Y1 = (const bf16_t*)(P.ws + OFF_Y1);
    bf16_t* KM = (bf16_t*)(P.ws + OFF_KM); const float* ROPE = (const float*)(P.ws + OFF_ROPE);
    const int tid = tid_opaque(), grp = tid >> 3, j8 = tid & 7;
    for (int tok = bid; tok < MTOK; tok += nb) {
        const int b = tok / SEQ, s = tok % SEQ;
        float cs[8], sn[8];
#pragma unroll
        for (int e = 0; e < 8; ++e) { const int i = (8 * j8 + e) & 31; cs[e] = ROPE[(size_t)tok * 64 + i]; sn[e] = ROPE[(size_t)tok * 64 + 32 + i]; }
        {
            const bf16_t* kn = KNM + (size_t)tok * (NH * 128) + grp * 128;
            const bf16_t* kp = Y1 + (size_t)tok * N3P + C3_KPE;
            float v[24];
#pragma unroll
            for (int c = 0; c < 2; ++c) { const u32x4 w = *(const u32x4*)(kn + (j8 + 8 * c) * 8);
                v[c * 8 + 0] = bflo(w.x); v[c * 8 + 1] = bfhi(w.x); v[c * 8 + 2] = bflo(w.y); v[c * 8 + 3] = bfhi(w.y);
                v[c * 8 + 4] = bflo(w.z); v[c * 8 + 5] = bfhi(w.z); v[c * 8 + 6] = bflo(w.w); v[c * 8 + 7] = bfhi(w.w); }
            { const u32x4 w = *(const u32x4*)(kp + j8 * 8);
                v[16] = bflo(w.x); v[17] = bfhi(w.x); v[18] = bflo(w.y); v[19] = bfhi(w.y); v[20] = bflo(w.z); v[21] = bfhi(w.z); v[22] = bflo(w.w); v[23] = bfhi(w.w); }
            float ss = 0.f;
#pragma unroll
            for (int i = 0; i < 24; ++i) ss += v[i] * v[i];
            ss = sum8(ss);
            const float rstd = rsqrtf(ss * (1.0f / DK) + EPSN);
#pragma unroll
            for (int c = 0; c < 3; ++c)
#pragma unroll
                for (int e = 0; e < 8; ++e) v[c * 8 + e] *= rstd * P.mla_k_norm[(j8 + 8 * c) * 8 + e];
#pragma unroll
            for (int e = 0; e < 8; ++e) { const float mine = v[16 + e], other = __shfl_xor(mine, 4);
                v[16 + e] = (j8 < 4) ? (mine * cs[e] - other * sn[e]) : (mine * cs[e] + other * sn[e]); }
            st192(KM + ((size_t)(b * NH + grp) * SEQ + s) * DK, j8, v);
        }
    }
}
#ifndef ATT_THR
#define ATT_THR 30.0f
#endif
#ifndef PROBE3_CMP
#define PROBE3_CMP 1
#endif
#ifndef PROBE3_SEL
#define PROBE3_SEL 1
#endif
#ifndef PROBE3_WIN
#define PROBE3_WIN 1
#endif
#ifndef ATT3_KD
#define ATT3_KD 4
#endif
#ifndef ATT3_VD
#define ATT3_VD 4
#endif
#ifndef ATT_PS_LIMIT
#define ATT_PS_LIMIT (16.0f * 1073741824.0f)
#endif
constexpr int KT_BYTES = 64 * 384, VT_BYTES = 128 * 128;
constexpr int L_K = 0, L_V = 2 * KT_BYTES, L_LUT = L_V + 2 * VT_BYTES, LUT_PITCH = 129, L_X = L_LUT + 64 * LUT_PITCH * 4 + 16, L_IL = L_X + 16 * 16 * 64 * 2, L_END = L_IL + 16 * 16 * 4;
static_assert(L_END <= 151552, "attention LDS");
enum { MODE_MLA = 0, MODE_SEL = 3, MODE_WIN = 4, MODE_CMPX = 5 };
#define MFMA16(a, b, c) __builtin_amdgcn_mfma_f32_16x16x32_bf16((a), (b), (c), 0, 0, 0)

struct AttnLane3 {
    int tw0, tw1;
    int r16, g;
    const LAS float* lutrow;
    unsigned long long mk0, mk1;
    int curblk;
    int tokbase;
    mutable float carry[2];
};
template <int MODE> DI int tq_of(const AttnLane3& A, int qb) { return (MODE == MODE_MLA) ? A.tw0 + 16 * qb + A.r16 : A.tw0 + qb; }

template <int MODE, int QS>
DI void attn_tile3(const LAS unsigned char* kb, const LAS unsigned char* vb, LAS unsigned char* lds, int j, const bf16x8 (&q)[2][6], f32x4 (&o)[8][2], float (&m_run)[2], float (&l_run)[2], const AttnLane3& A) {
    constexpr bool Q0 = (QS & 1) != 0, Q1 = (QS & 2) != 0;
    const int r16 = A.r16, g = A.g, sw = (r16 >> 1) & 7;
    const int kb0 = r16 * 384 + ((g ^ sw) << 4), kb1 = r16 * 384 + (((g ^ sw) ^ 4) << 4);
    const int vb0 = r16 * 128 + ((g ^ sw) << 4), vb1 = r16 * 128 + (((g ^ sw) ^ 4) << 4);
    f32x4 s[4][2];
    bool zinit = true;
    if (MODE == MODE_WIN || MODE == MODE_SEL) zinit = (A.tw0 - (64 * j + 63) >= 113);
    else if (MODE == MODE_CMPX) zinit = (A.tw0 - 31 - 16 * (64 * j + 63) >= 113);
    if (zinit) {
#pragma unroll
        for (int k4 = 0; k4 < 4; ++k4) { s[k4][0] = (f32x4){0.f, 0.f, 0.f, 0.f}; s[k4][1] = (f32x4){0.f, 0.f, 0.f, 0.f}; }
    } else {
#pragma unroll
        for (int qb = 0; qb < 2; ++qb) { if ((qb == 0 && !Q0) || (qb == 1 && !Q1)) continue;
            const int tq = tq_of<MODE>(A, qb);
#pragma unroll
            for (int k4 = 0; k4 < 4; ++k4)
#pragma unroll
                for (int r = 0; r < 4; ++r) { int d;
                    if (MODE == MODE_CMPX) d = tq - 31 - 16 * (64 * j + 16 * k4 + 4 * g + r); else d = tq - (64 * j + 16 * k4 + 4 * g + r);
                    d = d < 0 ? 0 : (d > 127 ? 127 : d); s[k4][qb][r] = A.lutrow[d] - m_run[qb]; } }
    }
    {
        constexpr int KD = ATT3_KD;
        bf16x8 kf[KD + 1];
#pragma unroll
        for (int i = 0; i < KD; ++i) kf[i] = *(const LAS bf16x8*)(kb + (((i % 6) & 1) ? kb1 : kb0) + ((i % 6) >> 1) * 128 + (i / 6) * (16 * 384));
        __builtin_amdgcn_sched_barrier(0);
#pragma unroll
        for (int i = 0; i < 24; ++i) {
            if (i + KD < 24) { const int n_ = i + KD; kf[n_ % (KD + 1)] = *(const LAS bf16x8*)(kb + (((n_ % 6) & 1) ? kb1 : kb0) + ((n_ % 6) >> 1) * 128 + (n_ / 6) * (16 * 384)); }
            __builtin_amdgcn_sched_barrier(0);
            if (Q0) s[i / 6][0] = MFMA16(kf[i % (KD + 1)], q[0][i % 6], s[i / 6][0]);
            if (Q1) s[i / 6][1] = MFMA16(kf[i % (KD + 1)], q[1][i % 6], s[i / 6][1]);
            __builtin_amdgcn_sched_barrier(0);
        }
    }
    if (zinit && __any(m_run[0] != 0.f || m_run[1] != 0.f)) {
#pragma unroll
        for (int k4 = 0; k4 < 4; ++k4)
#pragma unroll
            for (int r = 0; r < 4; ++r) { s[k4][0][r] -= m_run[0]; s[k4][1][r] -= m_run[1]; }
    }
    {
        const float NEG = -__builtin_inff();
        bool need;
        if (MODE == MODE_MLA) need = (64 * j + 63 > A.tw0);
        else if (MODE == MODE_WIN) need = !(64 * j + 63 <= A.tw0 && 64 * j >= A.tw1 - 511);
        else if (MODE == MODE_SEL) need = (j == A.curblk);
        else need = (A.tw0 - 31 - 16 * (64 * j + 63) < 0);
        if (need) {
#pragma unroll
            for (int qb = 0; qb < 2; ++qb) { if ((qb == 0 && !Q0) || (qb == 1 && !Q1)) continue;
                const int tq = tq_of<MODE>(A, qb);
#pragma unroll
                for (int k4 = 0; k4 < 4; ++k4)
#pragma unroll
                    for (int r = 0; r < 4; ++r) { const int c = 64 * j + 16 * k4 + 4 * g + r; bool kill;
                        if (MODE == MODE_WIN) kill = (unsigned)(tq - c) >= 512u;
                        else if (MODE == MODE_CMPX) kill = (tq - 31 - 16 * c) < 0;
                        else kill = (tq - c) < 0;
                        s[k4][qb][r] = kill ? NEG : s[k4][qb][r]; } }
        }
    }
    u32x4 pw[2][2];
#pragma unroll
    for (int qb = 0; qb < 2; ++qb) { if ((qb == 0 && !Q0) || (qb == 1 && !Q1)) continue;
        if (MODE == MODE_CMPX) {
            float lmx = fmaxf(fmaxf(s[0][qb][0], s[0][qb][1]), fmaxf(s[0][qb][2], s[0][qb][3]));
#pragma unroll
            for (int k4 = 1; k4 < 4; ++k4) lmx = fmaxf(lmx, fmaxf(fmaxf(s[k4][qb][0], s[k4][qb][1]), fmaxf(s[k4][qb][2], s[k4][qb][3])));
            if (__any(lmx > ATT_THR)) {
                float mx = fmaxf(lmx, __shfl_xor(lmx, 16)); mx = fmaxf(mx, __shfl_xor(mx, 32));
                const float dl = fmaxf(mx, 0.f), alpha = __builtin_amdgcn_exp2f(-dl);
                m_run[qb] += dl; l_run[qb] *= alpha; A.carry[qb] *= alpha;
#pragma unroll
                for (int db = 0; db < 8; ++db) o[db][qb] *= alpha;
#pragma unroll
                for (int k4 = 0; k4 < 4; ++k4) s[k4][qb] -= dl;
                LAS bf16_t* X = (LAS bf16_t*)(lds + L_X) + ((A.tokbase + qb) * 16 + r16) * 64;
                for (int a = g; a < 16 * j; a += 4) X[a] = (bf16_t)(pk2(bf1(X[a]) * alpha, 0.f) & 0xffffu);
            }
        }
        float ps = 0.f; f32x4 e[4];
#pragma unroll
        for (int k4 = 0; k4 < 4; ++k4) { e[k4][0] = __builtin_amdgcn_exp2f(s[k4][qb][0]); e[k4][1] = __builtin_amdgcn_exp2f(s[k4][qb][1]); e[k4][2] = __builtin_amdgcn_exp2f(s[k4][qb][2]); e[k4][3] = __builtin_amdgcn_exp2f(s[k4][qb][3]);
            ps += (e[k4][0] + e[k4][1]) + (e[k4][2] + e[k4][3]); }
        if (MODE != MODE_CMPX) {
            if (__any(!(ps <= ATT_PS_LIMIT))) {
                float mx = fmaxf(fmaxf(s[0][qb][0], s[0][qb][1]), fmaxf(s[0][qb][2], s[0][qb][3]));
#pragma unroll
                for (int k4 = 1; k4 < 4; ++k4) mx = fmaxf(mx, fmaxf(fmaxf(s[k4][qb][0], s[k4][qb][1]), fmaxf(s[k4][qb][2], s[k4][qb][3])));
                mx = fmaxf(mx, __shfl_xor(mx, 16)); mx = fmaxf(mx, __shfl_xor(mx, 32));
                const float dl = fmaxf(mx, 0.f), alpha = __builtin_amdgcn_exp2f(-dl);
                m_run[qb] += dl; l_run[qb] *= alpha;
#pragma unroll
                for (int db = 0; db < 8; ++db) o[db][qb] *= alpha;
                ps = 0.f;
#pragma unroll
                for (int k4 = 0; k4 < 4; ++k4) { e[k4][0] = __builtin_amdgcn_exp2f(s[k4][qb][0] - dl); e[k4][1] = __builtin_amdgcn_exp2f(s[k4][qb][1] - dl); e[k4][2] = __builtin_amdgcn_exp2f(s[k4][qb][2] - dl); e[k4][3] = __builtin_amdgcn_exp2f(s[k4][qb][3] - dl);
                    ps += (e[k4][0] + e[k4][1]) + (e[k4][2] + e[k4][3]); }
            }
        } else {
            LAS bf16_t* X = (LAS bf16_t*)(lds + L_X) + ((A.tokbase + qb) * 16 + r16) * 64;
#pragma unroll
            for (int k4 = 0; k4 < 4; ++k4) {
                const float y = __shfl(e[k4][3], (r16 + 16 * g + 48) & 63);
                const float prev = g ? y : A.carry[qb];
                if (g == 0) A.carry[qb] = y;
                X[16 * j + 4 * k4 + g] = (bf16_t)(pk2((e[k4][0] + e[k4][1]) + (e[k4][2] + e[k4][3]) + prev, 0.f) & 0xffffu);
            }
        }
        l_run[qb] += ps;
        pw[0][qb].x = pk2(e[0][0], e[0][1]); pw[0][qb].y = pk2(e[0][2], e[0][3]); pw[0][qb].z = pk2(e[1][0], e[1][1]); pw[0][qb].w = pk2(e[1][2], e[1][3]);
        pw[1][qb].x = pk2(e[2][0], e[2][1]); pw[1][qb].y = pk2(e[2][2], e[2][3]); pw[1][qb].z = pk2(e[3][0], e[3][1]); pw[1][qb].w = pk2(e[3][2], e[3][3]);
    }
    {
        constexpr int VD = ATT3_VD;
        bf16x8 vf[VD + 1];
#pragma unroll
        for (int i = 0; i < VD; ++i) vf[i] = *(const LAS bf16x8*)(vb + ((i >> 3) ? vb1 : vb0) + (i & 7) * (16 * 128));
        __builtin_amdgcn_sched_barrier(0);
#pragma unroll
        for (int i = 0; i < 16; ++i) {
            if (i + VD < 16) { const int n_ = i + VD; vf[n_ % (VD + 1)] = *(const LAS bf16x8*)(vb + ((n_ >> 3) ? vb1 : vb0) + (n_ & 7) * (16 * 128)); }
            __builtin_amdgcn_sched_barrier(0);
            if (Q0) o[i & 7][0] = MFMA16(vf[i % (VD + 1)], __builtin_bit_cast(bf16x8, pw[i >> 3][0]), o[i & 7][0]);
            if (Q1) o[i & 7][1] = MFMA16(vf[i % (VD + 1)], __builtin_bit_cast(bf16x8, pw[i >> 3][1]), o[i & 7][1]);
            __builtin_amdgcn_sched_barrier(0);
        }
    }
}

template <int MODE>
DI void attn_pass3x(LAS unsigned char* lds, const char* __restrict__ Kc, const char* __restrict__ Vc, int vt_stride, int j_lo, int j_hi,
                    const bf16x8 (&q)[2][6], f32x4 (&o)[8][2], float (&m_run)[2], float (&l_run)[2], const AttnLane3& A) {
    if (j_lo >= j_hi) return;
    int tid = threadIdx.x; asm volatile("" : "+v"(tid));
    const int lane = tid & 63;
    const int wid_ = __builtin_amdgcn_readfirstlane(tid >> 6);
    unsigned kgo[3], vgo[2];
#pragma unroll
    for (int i_ = 0; i_ < 3; ++i_) { const int pidx_ = (wid_ * 3 + i_) * 64 + lane, row_ = pidx_ / 24, cp_ = pidx_ % 24; kgo[i_] = (unsigned)(row_ * 384 + ((cp_ ^ ((row_ >> 1) & 7)) << 4)); }
#pragma unroll
    for (int i_ = 0; i_ < 2; ++i_) { const int pidx_ = (wid_ * 2 + i_) * 64 + lane, row_ = pidx_ >> 3, cp_ = pidx_ & 7; vgo[i_] = (unsigned)(row_ * vt_stride * 2 + ((cp_ ^ ((row_ >> 1) & 7)) << 4)); }
#define ST_ISSUE(j, buf) do { const char* kp_ = Kc + (size_t)(j) * KT_BYTES; LAS unsigned char* kb_ = lds + L_K + (buf) * KT_BYTES + wid_ * 3072; \
        _Pragma("unroll") for (int i_ = 0; i_ < 3; ++i_) __builtin_amdgcn_global_load_lds((const unsigned*)(kp_ + kgo[i_]), (LAS unsigned*)(kb_ + i_ * 1024), 16, 0, 0); \
        const char* vp_ = Vc + (size_t)(j) * 128; LAS unsigned char* vb_ = lds + L_V + (buf) * VT_BYTES + wid_ * 2048; \
        _Pragma("unroll") for (int i_ = 0; i_ < 2; ++i_) __builtin_amdgcn_global_load_lds((const unsigned*)(vp_ + vgo[i_]), (LAS unsigned*)(vb_ + i_ * 1024), 16, 0, 0); } while (0)
    ST_ISSUE(j_lo, 0);
    asm volatile("s_waitcnt vmcnt(0)" ::: "memory");
    __syncthreads();
    for (int j = j_lo; j < j_hi; ++j) {
        const int cur = (j - j_lo) & 1;
        if (j + 1 < j_hi) ST_ISSUE(j + 1, cur ^ 1);
        const LAS unsigned char* kbp = lds + L_K + cur * KT_BYTES; const LAS unsigned char* vbp = lds + L_V + cur * VT_BYTES;
        if (MODE == MODE_SEL) {
            const bool a0 = ((A.mk0 >> j) & 1ull) != 0ull, a1 = ((A.mk1 >> j) & 1ull) != 0ull;
            if (a0 && a1) attn_tile3<MODE, 3>(kbp, vbp, lds, j, q, o, m_run, l_run, A);
            else if (a0) attn_tile3<MODE, 1>(kbp, vbp, lds, j, q, o, m_run, l_run, A);
            else if (a1) attn_tile3<MODE, 2>(kbp, vbp, lds, j, q, o, m_run, l_run, A);
        } else {
            bool act;
            if (MODE == MODE_MLA) act = 64 * j <= A.tw1;
            else if (MODE == MODE_CMPX) act = 1024 * j + 31 <= A.tw1;
            else act = (64 * j <= A.tw1) && (64 * j + 63 >= A.tw0 - 511);
            if (act) attn_tile3<MODE, 3>(kbp, vbp, lds, j, q, o, m_run, l_run, A);
        }
        asm volatile("s_waitcnt vmcnt(0)" ::: "memory");
        __syncthreads();
    }
#undef ST_ISSUE
}

DI int t5_bucket(int n) {
    if (n < 16) return n;
    return 16 + (n >= 19) + (n >= 21) + (n >= 24) + (n >= 27) + (n >= 31) + (n >= 35) + (n >= 40) + (n >= 46) + (n >= 52) + (n >= 59) + (n >= 67) + (n >= 77) + (n >= 87) + (n >= 99) + (n >= 113);
}
DI float silu_f(float z) { return z * __builtin_amdgcn_rcpf(1.0f + __builtin_amdgcn_exp2f(-1.4426950408889634f * z)); }

constexpr int EPI_PITCH = 272, EPI_WAVE_BYTES = 32 * EPI_PITCH;
template <bool RMW, bool NSA>
DI void attn_epilogue3(LAS unsigned char* lds, int lane, int wid, const f32x4 (&o)[8][2], float scale0, float scale1,
                       const char* __restrict__ zbase, unsigned z0, char* __restrict__ obase, unsigned o0) {
    LAS unsigned char* sc = lds + wid * EPI_WAVE_BYTES;
    const int r16 = lane & 15, g = lane >> 4;
#pragma unroll
    for (int h = 0; h < 2; ++h) {
#pragma unroll
        for (int d4 = 0; d4 < 4; ++d4) {
            *(LAS f32x4*)(sc + r16 * EPI_PITCH + (16 * d4 + 4 * g) * 4) = o[4 * h + d4][0] * scale0;
            *(LAS f32x4*)(sc + (16 + r16) * EPI_PITCH + (16 * d4 + 4 * g) * 4) = o[4 * h + d4][1] * scale1;
        }
        asm volatile("" ::: "memory");
#pragma unroll
        for (int i = 0; i < 4; ++i) {
            const int rr = 8 * i + (lane >> 3), c8 = lane & 7;
            const f32x4 a = *(const LAS f32x4*)(sc + rr * EPI_PITCH + c8 * 32);
            const f32x4 b = *(const LAS f32x4*)(sc + rr * EPI_PITCH + c8 * 32 + 16);
            unsigned zoff, ooff;
            if (NSA) { zoff = z0 + (unsigned)((rr >> 4) * (N1P * 2) + (rr & 15) * 256); ooff = o0 + (unsigned)((rr >> 4) * (ZW8 * 2) + (rr & 15) * 256); }
            else     { zoff = z0 + (unsigned)(rr * (N3P * 2)); ooff = o0 + (unsigned)(rr * (ZW8 * 2)); }
            const unsigned cb = (unsigned)((64 * h + 8 * c8) * 2);
            const u32x4 zw = *(const u32x4*)(zbase + (zoff + cb));
            float v0 = a[0] * silu_f(bflo(zw.x)), v1 = a[1] * silu_f(bfhi(zw.x)), v2 = a[2] * silu_f(bflo(zw.y)), v3 = a[3] * silu_f(bfhi(zw.y));
            float v4 = b[0] * silu_f(bflo(zw.z)), v5 = b[1] * silu_f(bfhi(zw.z)), v6 = b[2] * silu_f(bflo(zw.w)), v7 = b[3] * silu_f(bfhi(zw.w));
            if (RMW) { const u32x4 pv = *(const u32x4*)(obase + (ooff + cb));
                v0 += bflo(pv.x); v1 += bfhi(pv.x); v2 += bflo(pv.y); v3 += bfhi(pv.y); v4 += bflo(pv.z); v5 += bfhi(pv.z); v6 += bflo(pv.w); v7 += bfhi(pv.w); }
            u32x4 w; w.x = pk2(v0, v1); w.y = pk2(v2, v3); w.z = pk2(v4, v5); w.w = pk2(v6, v7);
            *(u32x4*)(obase + (ooff + cb)) = w;
        }
        asm volatile("" ::: "memory");
    }
}
DI float sum_g(float v) { v += __shfl_xor(v, 16); v += __shfl_xor(v, 32); return v; }

DI void phase_nsa_attn(LAS unsigned char* lds, const Params& P, int bid, int nb) {
    const char* Y0c = (const char*)(P.ws + OFF_Y0);
    const char* KSc = (const char*)(P.ws + OFF_KS); const char* KWc = (const char*)(P.ws + OFF_KW);
    const char* VTSc = (const char*)(P.ws + OFF_VTS); const char* VTWc = (const char*)(P.ws + OFF_VTW);
    const char* KCc = (const char*)(P.ws + OFF_KC); const char* VTCc = (const char*)(P.ws + OFF_VTC);
    char* ONc = (char*)(P.ws + OFF_O);
    LAS float* lut = (LAS float*)(lds + L_LUT);
    const int total = BATCH * NG * 256;
    {
        const int tid0 = tid_opaque();
        __syncthreads();
        for (int i = tid0; i < 64 * 128; i += 512) { const int hd = i >> 7, d = i & 127; lut[hd * LUT_PITCH + d] = (P.rel_bias[t5_bucket(d) * NH + hd] - P.rel_bias[31 * NH + hd]) * LOG2E; }
        __syncthreads();
    }
    for (int u = bid; u < total; u += nb) {
        int tid = threadIdx.x; asm volatile("" : "+v"(tid));
        const int lane = tid & 63, wid = __builtin_amdgcn_readfirstlane(tid >> 6);
        const int pair = u >> 8; int c = u & 255; if (pair & 1) c = 255 - c;
        const int b = pair >> 2, gg = pair & 3, t0 = c * 16;
        __syncthreads();
        AttnLane3 A;
        A.r16 = lane & 15; A.g = lane >> 4;
        A.tw0 = t0 + 2 * wid; A.tw1 = A.tw0 + 1;
        const int hh = gg * NR + A.r16;
        A.lutrow = lut + hh * LUT_PITCH;
        A.curblk = t0 >> 6; A.tokbase = 2 * wid; A.mk0 = 0ull; A.mk1 = 0ull; A.carry[0] = 0.f; A.carry[1] = 0.f;
        const unsigned ytok0 = (unsigned)(b * SEQ + A.tw0) * (unsigned)(N1P * 2);
        const unsigned otok0 = ((unsigned)(b * SEQ + A.tw0) * (unsigned)ZW8 + (unsigned)(gg * NR * DV)) * 2u;
        bf16x8 q[2][6];
#pragma unroll
        for (int qb = 0; qb < 2; ++qb) {
            const unsigned qo = ytok0 + (unsigned)(qb * (N1P * 2)) + (unsigned)((C_Q + hh * DK + 8 * A.g) * 2);
            float ss = 0.f;
#pragma unroll
            for (int ds = 0; ds < 6; ++ds) { q[qb][ds] = *(const bf16x8*)(Y0c + (qo + 64u * ds));
                const u32x4 w = __builtin_bit_cast(u32x4, q[qb][ds]);
                const float a0 = bflo(w.x), a1 = bfhi(w.x), a2 = bflo(w.y), a3 = bfhi(w.y), a4 = bflo(w.z), a5 = bfhi(w.z), a6 = bflo(w.w), a7 = bfhi(w.w);
                ss += (a0 * a0 + a1 * a1) + (a2 * a2 + a3 * a3) + (a4 * a4 + a5 * a5) + (a6 * a6 + a7 * a7); }
            ss = sum_g(ss);
            const float rstd = rsqrtf(ss * (1.0f / DK) + EPSN) * QSCALE;
#pragma unroll
            for (int ds = 0; ds < 6; ++ds) { const float* gn = P.nsa_q_norm + 32 * ds + 8 * A.g; const f32x4 g0 = *(const f32x4*)gn, g1 = *(const f32x4*)(gn + 4);
                u32x4 w = __builtin_bit_cast(u32x4, q[qb][ds]);
                w.x = pk2(bflo(w.x) * rstd * g0[0], bfhi(w.x) * rstd * g0[1]); w.y = pk2(bflo(w.y) * rstd * g0[2], bfhi(w.y) * rstd * g0[3]);
                w.z = pk2(bflo(w.z) * rstd * g1[0], bfhi(w.z) * rstd * g1[1]); w.w = pk2(bflo(w.w) * rstd * g1[2], bfhi(w.w) * rstd * g1[3]);
                q[qb][ds] = __builtin_bit_cast(bf16x8, w); }
        }
        const int bg = b * NG + gg;
        f32x4 o[8][2]; float m_run[2], l_run[2];
#define RESET_STATE() do { _Pragma("unroll") for (int d_ = 0; d_ < 8; ++d_) { o[d_][0] = (f32x4){0.f, 0.f, 0.f, 0.f}; o[d_][1] = (f32x4){0.f, 0.f, 0.f, 0.f}; } m_run[0] = 0.f; m_run[1] = 0.f; l_run[0] = 0.f; l_run[1] = 0.f; } while (0)
#define GATE_SIG(x, qb) (1.0f / (1.0f + __expf(-bf1(*(const bf16_t*)(Y0c + (ytok0 + (unsigned)((qb) * (N1P * 2)) + (unsigned)((C_G + (x) * NH + hh) * 2)))))))
        const int nct = (t0 + 15 >= 31) ? (((t0 + 15 - 31) >> 4) / 64 + 1) : 0;
        RESET_STATE();
        for (int prb_ = 0; prb_ < PROBE3_CMP; ++prb_) { A.carry[0] = 0.f; A.carry[1] = 0.f; attn_pass3x<MODE_CMPX>(lds, KCc + (size_t)bg * 256 * DK * 2, VTCc + (size_t)bg * DV * 256 * 2, 256, 0, nct, q, o, m_run, l_run, A); }
        { const float lt0 = sum_g(l_run[0]), lt1 = sum_g(l_run[1]); const float il0 = lt0 > 0.f ? 1.0f / lt0 : 0.f, il1 = lt1 > 0.f ? 1.0f / lt1 : 0.f;
          if (lane < 16) { ((LAS float*)(lds + L_IL))[(A.tokbase + 0) * 16 + A.r16] = il0; ((LAS float*)(lds + L_IL))[(A.tokbase + 1) * 16 + A.r16] = il1; }
          attn_epilogue3<false, true>(lds, lane, wid, o, GATE_SIG(0, 0) * il0, GATE_SIG(0, 1) * il1, Y0c, ytok0 + (unsigned)((C_ZC + gg * NR * DV) * 2), ONc, otok0); }
        __syncthreads();
        {
            const int cur = A.curblk;
            unsigned long long mk[2];
#pragma unroll
            for (int t = 0; t < 2; ++t) {
                const LAS bf16_t* X = (const LAS bf16_t*)(lds + L_X) + (2 * wid + t) * 16 * 64;
                const LAS float* IL = (const LAS float*)(lds + L_IL) + (2 * wid + t) * 16;
                const bool forced = (lane == 0) || (lane == cur) || (lane == cur - 1);
                const bool future = lane > cur;
                float v = 0.f;
                if (!forced && !future) {
#pragma unroll
                    for (int rr = 0; rr < 16; ++rr) v += IL[rr] * bf1(X[rr * 64 + lane]); }
                unsigned key = (__float_as_uint(v) & ~63u);
                if (forced) key = 0x7f800000u; else if (future) key = 0u;
                key |= (unsigned)(63 - lane);
                int rank = 0;
#pragma unroll
                for (int jp = 0; jp < 64; ++jp) { const unsigned kj = (unsigned)__builtin_amdgcn_readlane((int)key, jp); rank += (kj > key) ? 1 : 0; }
                mk[t] = __ballot(rank < 16 && !future);
            }
            A.mk0 = mk[0]; A.mk1 = mk[1];
        }
        RESET_STATE();
        for (int prb_ = 0; prb_ < PROBE3_SEL; ++prb_) attn_pass3x<MODE_SEL>(lds, KSc + (size_t)bg * SEQ * DK * 2, VTSc + (size_t)bg * DV * SEQ * 2, SEQ, 0, A.curblk + 1, q, o, m_run, l_run, A);
        { const float lt0 = sum_g(l_run[0]), lt1 = sum_g(l_run[1]);
          attn_epilogue3<true, true>(lds, lane, wid, o, GATE_SIG(1, 0) / lt0, GATE_SIG(1, 1) / lt1, Y0c, ytok0 + (unsigned)((C_ZS + gg * NR * DV) * 2), ONc, otok0); }
        __syncthreads();
        RESET_STATE();
        { const int jl = (t0 - 511) > 0 ? (t0 - 511) >> 6 : 0, jh = ((t0 + 15) >> 6) + 1;
          for (int prb_ = 0; prb_ < PROBE3_WIN; ++prb_) attn_pass3x<MODE_WIN>(lds, KWc + (size_t)bg * SEQ * DK * 2, VTWc + (size_t)bg * DV * SEQ * 2, SEQ, jl, jh, q, o, m_run, l_run, A); }
        { const float lt0 = sum_g(l_run[0]), lt1 = sum_g(l_run[1]);
          attn_epilogue3<true, true>(lds, lane, wid, o, GATE_SIG(2, 0) / lt0, GATE_SIG(2, 1) / lt1, Y0c, ytok0 + (unsigned)((C_ZW + gg * NR * DV) * 2), ONc, otok0); }
#undef RESET_STATE
#undef GATE_SIG
    }
}

DI void phase_mla_attn(LAS unsigned char* lds, const Params& P, int bid, int nb) {
    const char* QMc = (const char*)(P.ws + OFF_QM); const char* KMc = (const char*)(P.ws + OFF_KM); const char* VTMc = (const char*)(P.ws + OFF_VTM);
    const char* Y1c = (const char*)(P.ws + OFF_Y1); char* OMc = (char*)(P.ws + OFF_O);
    const int total = BATCH * NH * 16;
    for (int uu = 0; bid + (uu >> 1) * nb < total / 2; ++uu) {
        int tid = threadIdx.x; asm volatile("" : "+v"(tid));
        const int lane = tid & 63, wid = __builtin_amdgcn_readfirstlane(tid >> 6);
        const int item = bid + (uu >> 1) * nb, second = uu & 1;
        const int xcd = item & 7, tt = item >> 3, p = tt & 7, hl = (tt >> 3) & 3, rnd = tt >> 5;
        const int bh = rnd * 32 + xcd * 4 + hl, qblk = second ? p : 15 - p, b = bh >> 6, h = bh & 63, t0 = qblk * 256;
        AttnLane3 A;
        A.r16 = lane & 15; A.g = lane >> 4;
        A.tw0 = t0 + 32 * wid; A.tw1 = A.tw0 + 31;
        A.lutrow = nullptr; A.curblk = 0; A.tokbase = 0; A.mk0 = 0ull; A.mk1 = 0ull; A.carry[0] = 0.f; A.carry[1] = 0.f;
        bf16x8 q[2][6];
#pragma unroll
        for (int qb = 0; qb < 2; ++qb) {
            const unsigned trow = (unsigned)(b * SEQ + A.tw0 + 16 * qb + A.r16);
            const unsigned qo = (trow * (unsigned)NQB + (unsigned)(h * DK + 8 * A.g)) * 2u;
            float ss = 0.f;
#pragma unroll
            for (int ds = 0; ds < 6; ++ds) { q[qb][ds] = *(const bf16x8*)(QMc + (qo + 64u * ds));
                const u32x4 w = __builtin_bit_cast(u32x4, q[qb][ds]);
                const float a0 = bflo(w.x), a1 = bfhi(w.x), a2 = bflo(w.y), a3 = bfhi(w.y), a4 = bflo(w.z), a5 = bfhi(w.z), a6 = bflo(w.w), a7 = bfhi(w.w);
                ss += (a0 * a0 + a1 * a1) + (a2 * a2 + a3 * a3) + (a4 * a4 + a5 * a5) + (a6 * a6 + a7 * a7); }
            ss = sum_g(ss);
            const float rstd = rsqrtf(ss * (1.0f / DK) + EPSN);
            const float* ropep = (const float*)(P.ws + OFF_ROPE) + (size_t)trow * 64;
#pragma unroll
            for (int ds = 0; ds < 4; ++ds) { const float* gn = P.mla_q_norm + 32 * ds + 8 * A.g; const f32x4 g0 = *(const f32x4*)gn, g1 = *(const f32x4*)(gn + 4);
                const float sc = rstd * QSCALE;
                u32x4 w = __builtin_bit_cast(u32x4, q[qb][ds]);
                w.x = pk2(bflo(w.x) * sc * g0[0], bfhi(w.x) * sc * g0[1]); w.y = pk2(bflo(w.y) * sc * g0[2], bfhi(w.y) * sc * g0[3]);
                w.z = pk2(bflo(w.z) * sc * g1[0], bfhi(w.z) * sc * g1[1]); w.w = pk2(bflo(w.w) * sc * g1[2], bfhi(w.w) * sc * g1[3]);
                q[qb][ds] = __builtin_bit_cast(bf16x8, w); }
            {
                const int i0 = 8 * A.g;
                const float* g1p = P.mla_q_norm + 128 + i0; const float* g2p = P.mla_q_norm + 160 + i0;
                const u32x4 w1 = __builtin_bit_cast(u32x4, q[qb][4]), w2 = __builtin_bit_cast(u32x4, q[qb][5]);
                float x1[8] = {bflo(w1.x), bfhi(w1.x), bflo(w1.y), bfhi(w1.y), bflo(w1.z), bfhi(w1.z), bflo(w1.w), bfhi(w1.w)};
                float x2[8] = {bflo(w2.x), bfhi(w2.x), bflo(w2.y), bfhi(w2.y), bflo(w2.z), bfhi(w2.z), bflo(w2.w), bfhi(w2.w)};
                float y1[8], y2[8];
#pragma unroll
                for (int e = 0; e < 8; ++e) { const float cs = ropep[i0 + e], sn = ropep[32 + i0 + e];
                    const float a = x1[e] * rstd * g1p[e], c = x2[e] * rstd * g2p[e];
                    y1[e] = (a * cs - c * sn) * QSCALE; y2[e] = (c * cs + a * sn) * QSCALE; }
                u32x4 o1, o2;
                o1.x = pk2(y1[0], y1[1]); o1.y = pk2(y1[2], y1[3]); o1.z = pk2(y1[4], y1[5]); o1.w = pk2(y1[6], y1[7]);
                o2.x = pk2(y2[0], y2[1]); o2.y = pk2(y2[2], y2[3]); o2.z = pk2(y2[4], y2[5]); o2.w = pk2(y2[6], y2[7]);
                q[qb][4] = __builtin_bit_cast(bf16x8, o1); q[qb][5] = __builtin_bit_cast(bf16x8, o2);
            }
        }
        f32x4 o[8][2]; float m_run[2] = {0.f, 0.f}, l_run[2] = {0.f, 0.f};
#pragma unroll
        for (int d = 0; d < 8; ++d) { o[d][0] = (f32x4){0.f, 0.f, 0.f, 0.f}; o[d][1] = (f32x4){0.f, 0.f, 0.f, 0.f}; }
        attn_pass3x<MODE_MLA>(lds, KMc + (size_t)bh * SEQ * DK * 2, VTMc + (size_t)bh * DV * SEQ * 2, SEQ, 0, 4 * qblk + 4, q, o, m_run, l_run, A);
        const float lt0 = sum_g(l_run[0]), lt1 = sum_g(l_run[1]);
        { const unsigned t0w = (unsigned)(b * SEQ + A.tw0);
          attn_epilogue3<false, false>(lds, lane, wid, o, 1.0f / lt0, 1.0f / lt1, Y1c, (t0w * (unsigned)N3P + (unsigned)(C3_Z + h * DV)) * 2u, OMc, (t0w * (unsigned)ZW8 + (unsigned)(h * DV)) * 2u); }
        __syncthreads();
    }
}
constexpr int LDS_KN_OFF = 135168, LDS_ST_OFF = LDS_KN_OFF + 16384, LDS_BYTES = LDS_ST_OFF + 16;
constexpr int NPHASE = 14;

template <int PH>
DI void run_phase(const Params& P, LAS unsigned char* lds, int bid, int nb) {
    unsigned char* ws = P.ws;
    if constexpr (PH == 0) {
        phase_wconv(lds, P.nsa_w_in, (bf16_t*)(ws + OFF_W1T), DM, N1, N1P, bid, nb, (FP8EMU & 4) ? 64.0f : 0.f);
        phase_wconv(lds, P.w1_k, (bf16_t*)(ws + OFF_W1K), 6144, 192, 256, bid, nb);
        phase_wconv(lds, P.w1_v, (bf16_t*)(ws + OFF_W1V), 4096, 128, 256, bid, nb);
        phase_rmsnorm(P.x, P.norm_w, (bf16_t*)(ws + OFF_H), bid, nb, (FP8EMU & 4) ? 16.0f : 0.f);
    } else if constexpr (PH == 1) {
        pg8::Gemm g{(const bf16_t*)(ws + OFF_H), (const bf16_t*)(ws + OFF_W1T), MTOK, N1P, DM};
        pg8::StaticOrder S; S.init(g.M, g.N, nb, bid);
        pg8::EpiStoreBf16 E{(bf16_t*)(ws + OFF_Y0), N1P};
        pg8::gemm_phase<pg8::EpiStoreBf16, pg8::StaticOrder, false>(lds, g, S, E, nullptr);
    } else if constexpr (PH == 2) {
        phase_nsa_prep(P, bid, nb);
        phase_vt(lds, (const bf16_t*)(ws + OFF_Y0), N1P, C_KVS + NG * DK, DV, NG, (bf16_t*)(ws + OFF_VTS), bid, nb);
        phase_vt(lds, (const bf16_t*)(ws + OFF_Y0), N1P, C_KVW + NG * DK, DV, NG, (bf16_t*)(ws + OFF_VTW), bid, nb);
    } else if constexpr (PH == 3) {
        if (bid < 16) {
            pg8::Gemm g{(const bf16_t*)(ws + OFF_ACK), (const bf16_t*)(ws + OFF_W1K), 4096, 256, 6144};
            pg8::StaticOrder S; S.init(g.M, g.N, 16, bid);
            pg8::EpiPlainF32 E{(float*)(ws + OFF_HIDK), 256};
            pg8::gemm_phase<pg8::EpiPlainF32, pg8::StaticOrder, false>(lds, g, S, E, nullptr);
        } else if (bid < 32) {
            pg8::Gemm g{(const bf16_t*)(ws + OFF_ACV), (const bf16_t*)(ws + OFF_W1V), 4096, 256, 4096};
            pg8::StaticOrder S; S.init(g.M, g.N, 16, bid - 16);
            pg8::EpiPlainF32 E{(float*)(ws + OFF_HIDV), 256};
            pg8::gemm_phase<pg8::EpiPlainF32, pg8::StaticOrder, false>(lds, g, S, E, nullptr);
        } else {
            phase_wconv(lds, P.nsa_w_out, (bf16_t*)(ws + OFF_W2T), ZW8, DM, DM, bid - 32, nb - 32, (FP8EMU & 1) ? 64.0f : 0.f);
            phase_wconv(lds, P.mla_w_in, (bf16_t*)(ws + OFF_W3T), DM, N3, N3P, bid - 32, nb - 32, (FP8EMU & 8) ? 64.0f : 0.f);
        }
    } else if constexpr (PH == 4) {
        phase_cmp2(lds, P, bid, nb);
    } else if constexpr (PH == 5) {
        { float* ss1 = (float*)(ws + OFF_SS1); for (int i = bid * 512 + (int)threadIdx.x; i < MTOK; i += nb * 512) ss1[i] = 0.f; }
        phase_nsa_attn(lds, P, bid, nb);
    } else if constexpr (PH == 6) {
        pg8::Gemm g{(const bf16_t*)(ws + OFF_O), (const bf16_t*)(ws + OFF_W2T), MTOK, DM, ZW8};
        pg8::StaticOrder S; S.init(g.M, g.N, nb, bid);
        pg8::EpiResNorm E{P.x, P.out, DM, P.norm_w + DM, (bf16_t*)(ws + OFF_H), (float*)(ws + OFF_SS1)};
        pg8::gemm_phase<pg8::EpiResNorm, pg8::StaticOrder, false>(lds, g, S, E, nullptr);
    } else if constexpr (PH == 7) {
        phase_rmsnorm(P.out, P.norm_w + DM, (bf16_t*)(ws + OFF_H), bid, nb, (FP8EMU & 8) ? 16.0f : 0.f);
    } else if constexpr (PH == 8) {
        pg8::Gemm g{(const bf16_t*)(ws + OFF_H), (const bf16_t*)(ws + OFF_W3T), MTOK, N3P, DM};
        pg8::StaticOrder S; S.init(g.M, g.N, nb, bid);
        pg8::EpiStoreBf16RowScale E{(bf16_t*)(ws + OFF_Y1), N3P, (const float*)(ws + OFF_SS1), 1.0f / DM};
        pg8::gemm_phase<pg8::EpiStoreBf16RowScale, pg8::StaticOrder, false>(lds, g, S, E, nullptr);
        __syncthreads();
        if (bid >= 64 && nb > 64) {
            phase_wconv(lds, P.mla_w_q_b, (bf16_t*)(ws + OFF_W4T), QLORA, NQB, NQB, bid - 64, nb - 64);
            phase_wconv(lds, P.mla_w_kv_b, (bf16_t*)(ws + OFF_W5K), KVLORA, NKVB / 2, NKVB / 2, bid - 64, nb - 64, 0.f, 2);
            phase_wconv(lds, P.mla_w_kv_b, (bf16_t*)(ws + OFF_W5V), KVLORA, NKVB / 2, NKVB / 2, bid - 64, nb - 64, 0.f, 1);
            phase_wconv(lds, P.mla_w_out, (bf16_t*)(ws + OFF_W6T), ZW8, DM, DM, bid - 64, nb - 64, (FP8EMU & 2) ? 64.0f : 0.f);
        } else if (nb <= 64) {
            phase_wconv(lds, P.mla_w_q_b, (bf16_t*)(ws + OFF_W4T), QLORA, NQB, NQB, bid, nb);
            phase_wconv(lds, P.mla_w_kv_b, (bf16_t*)(ws + OFF_W5K), KVLORA, NKVB / 2, NKVB / 2, bid, nb, 0.f, 2);
            phase_wconv(lds, P.mla_w_kv_b, (bf16_t*)(ws + OFF_W5V), KVLORA, NKVB / 2, NKVB / 2, bid, nb, 0.f, 1);
            phase_wconv(lds, P.mla_w_out, (bf16_t*)(ws + OFF_W6T), ZW8, DM, DM, bid, nb, (FP8EMU & 2) ? 64.0f : 0.f);
        }
    } else if constexpr (PH == 9) {
        phase_mla_prep1(P, bid, nb);
    } else if constexpr (PH == 10) {
        {
            pg8::Gemm g{(const bf16_t*)(ws + OFF_CQN), (const bf16_t*)(ws + OFF_W4T), MTOK, NQB, QLORA};
            pg8::StaticOrder S; S.init(g.M, g.N, nb, bid);
            pg8::EpiStoreBf16 E{(bf16_t*)(ws + OFF_QM), NQB};
            pg8::gemm_phase<pg8::EpiStoreBf16, pg8::StaticOrder, false>(lds, g, S, E, nullptr);
        }
        __syncthreads();
        {
            pg8::Gemm g{(const bf16_t*)(ws + OFF_CKVN), (const bf16_t*)(ws + OFF_W5K), MTOK, NKVB / 2, KVLORA};
            pg8::StaticOrder S; S.init(g.M, g.N, nb, bid);
            pg8::EpiKNorm E{(bf16_t*)(ws + OFF_KM), (const float*)(ws + OFF_SSPE), (const float*)(ws + OFF_KPER), P.mla_k_norm, (LAS float*)(lds + LDS_KN_OFF), 0u};
            pg8::gemm_phase<pg8::EpiKNorm, pg8::StaticOrder, false>(lds, g, S, E, nullptr);
        }
        __syncthreads();
        {
            pg8::Gemm g{(const bf16_t*)(ws + OFF_W5V), (const bf16_t*)(ws + OFF_CKVN), NKVB / 2, MTOK, KVLORA};
            pg8::StaticOrder S; S.init(g.M, g.N, nb, bid);
            pg8::EpiVT E{(bf16_t*)(ws + OFF_VTM)};
            pg8::gemm_phase<pg8::EpiVT, pg8::StaticOrder, false>(lds, g, S, E, nullptr);
        }
    } else if constexpr (PH == 11) {
    } else if constexpr (PH == 12) {
        phase_mla_attn(lds, P, bid, nb);
    } else if constexpr (PH == 13) {
        pg8::Gemm g{(const bf16_t*)(ws + OFF_O), (const bf16_t*)(ws + OFF_W6T), MTOK, DM, ZW8};
        pg8::StaticOrder S; S.init(g.M, g.N, nb, bid);
        pg8::EpiResF32 E{P.out, P.out, DM};
        pg8::gemm_phase<pg8::EpiResF32, pg8::StaticOrder, false>(lds, g, S, E, nullptr);
    }
}

#ifndef REP0
#define REP0 1
#endif
#ifndef REP1
#define REP1 1
#endif
#ifndef REP2
#define REP2 1
#endif
#ifndef REP3
#define REP3 1
#endif
#ifndef REP4
#define REP4 1
#endif
#ifndef REP5
#define REP5 1
#endif
#ifndef REP6
#define REP6 1
#endif
#ifndef REP7
#define REP7 1
#endif
#ifndef REP8
#define REP8 1
#endif
#ifndef REP9
#define REP9 1
#endif
#ifndef REP10
#define REP10 1
#endif
#ifndef REP11
#define REP11 1
#endif
#ifndef REP12
#define REP12 1
#endif
#ifndef REP13
#define REP13 1
#endif

__global__ __launch_bounds__(512, 2) void k_mega(Params P) {
    extern __shared__ __attribute__((aligned(16))) unsigned char shm[];
    LAS unsigned char* lds = (LAS unsigned char*)shm;
    volatile LAS unsigned* st = (volatile LAS unsigned*)(lds + LDS_ST_OFF);
    if (threadIdx.x == 0) { st[0] = 0u; st[1] = 0u; st[2] = 0u; st[3] = 0u; }
    __syncthreads();
    XcdBarrier bar = xcd_barrier_post((unsigned*)(P.ws + OFF_CTL), st);
    const int bid = (int)blockIdx.x, nb = (int)gridDim.x;
    for (int rep_ = 0; rep_ < REP0; ++rep_) run_phase<0>(P, lds, bid, nb);  xcd_barrier(bar);
    for (int rep_ = 0; rep_ < REP1; ++rep_) run_phase<1>(P, lds, bid, nb);  xcd_barrier(bar);
    for (int rep_ = 0; rep_ < REP2; ++rep_) run_phase<2>(P, lds, bid, nb);  xcd_barrier(bar);
    for (int rep_ = 0; rep_ < REP3; ++rep_) run_phase<3>(P, lds, bid, nb);  xcd_barrier(bar);
    for (int rep_ = 0; rep_ < REP4; ++rep_) run_phase<4>(P, lds, bid, nb);  xcd_barrier(bar);
    for (int rep_ = 0; rep_ < REP5; ++rep_) run_phase<5>(P, lds, bid, nb);  xcd_barrier(bar);
    for (int rep_ = 0; rep_ < REP6; ++rep_) run_phase<6>(P, lds, bid, nb);  xcd_barrier(bar);
    for (int rep_ = 0; rep_ < REP8; ++rep_) run_phase<8>(P, lds, bid, nb);  xcd_barrier(bar);
    for (int rep_ = 0; rep_ < REP9; ++rep_) run_phase<9>(P, lds, bid, nb);  xcd_barrier(bar);
    for (int rep_ = 0; rep_ < REP10; ++rep_) run_phase<10>(P, lds, bid, nb); xcd_barrier(bar);
    for (int rep_ = 0; rep_ < REP12; ++rep_) run_phase<12>(P, lds, bid, nb); xcd_barrier(bar);
    for (int rep_ = 0; rep_ < REP13; ++rep_) run_phase<13>(P, lds, bid, nb);
}

extern "C" void kernel_launch(void* const* d_in, const int* in_sizes, int n_in, void* d_out, int out_size, void* d_ws, size_t ws_size, hipStream_t stream) {
    (void)in_sizes; (void)n_in; (void)out_size;
    if (ws_size < WS_END) return;
    Params P{};
    P.x = (const float*)d_in[0]; P.pos = (const int*)d_in[1]; P.norm_w = (const float*)d_in[2]; P.rel_bias = (const float*)d_in[3];
    P.nsa_w_in = (const float*)d_in[4]; P.nsa_q_norm = (const float*)d_in[5]; P.nsa_k_norm = (const float*)d_in[6]; P.pe_k = (const float*)d_in[7];
    P.w1_k = (const float*)d_in[8]; P.w2_k = (const float*)d_in[9]; P.pe_v = (const float*)d_in[10]; P.w1_v = (const float*)d_in[11]; P.w2_v = (const float*)d_in[12];
    P.nsa_w_out = (const float*)d_in[13]; P.mla_w_in = (const float*)d_in[14]; P.mla_q_a_norm = (const float*)d_in[15]; P.mla_w_q_b = (const float*)d_in[16];
    P.mla_kv_a_norm = (const float*)d_in[17]; P.mla_w_kv_b = (const float*)d_in[18]; P.mla_q_norm = (const float*)d_in[19]; P.mla_k_norm = (const float*)d_in[20];
    P.mla_w_out = (const float*)d_in[21];
    P.out = (float*)d_out; P.ws = (unsigned char*)d_ws;
    static int grid = 0;
    if (!grid) {
        int dev = 0, cus = 0, per_cu = 0; (void)hipGetDevice(&dev);
        if (hipDeviceGetAttribute(&cus, hipDeviceAttributeMultiprocessorCount, dev) != hipSuccess || cus <= 0) cus = 256;
        (void)hipFuncSetAttribute((const void*)k_mega, hipFuncAttributeMaxDynamicSharedMemorySize, LDS_BYTES);
        if (hipOccupancyMaxActiveBlocksPerMultiprocessor(&per_cu, k_mega, 512, LDS_BYTES) != hipSuccess || per_cu < 1) per_cu = 1;
        grid = cus;
    }
    (void)hipMemsetAsync((unsigned char*)d_ws + OFF_CTL, 0, XCD_BAR_WORDS * sizeof(unsigned), stream);
    hipLaunchKernelGGL(k_mega, dim3(grid), dim3(512), LDS_BYTES, stream, P);
}
```

```cpp
#define ATT16 1
#define USE_FP8Z 1
#include <hip/hip_runtime.h>
#include <stdint.h>
#include <stddef.h>

#define DI __device__ __forceinline__
#define LAS __attribute__((address_space(3)))
typedef unsigned short bf16_t;
typedef short bf16x8 __attribute__((ext_vector_type(8)));
typedef float f32x4 __attribute__((ext_vector_type(4)));
typedef float f32x16 __attribute__((ext_vector_type(16)));
typedef unsigned u32x4 __attribute__((ext_vector_type(4)));
typedef unsigned u32x2 __attribute__((ext_vector_type(2)));
typedef __bf16 bf2_t __attribute__((ext_vector_type(2)));
typedef float f2_t __attribute__((ext_vector_type(2)));

DI int tid_opaque() { int t = (int)threadIdx.x; asm volatile("" : "+v"(t)); return t; }
DI unsigned pk2(float a, float b) { f2_t f = {a, b}; bf2_t v = __builtin_convertvector(f, bf2_t); return __builtin_bit_cast(unsigned, v); }
DI unsigned pk4_fp8(float a, float b, float c, float d) { int w = 0; w = __builtin_amdgcn_cvt_pk_fp8_f32(a, b, w, false); w = __builtin_amdgcn_cvt_pk_fp8_f32(c, d, w, true); return (unsigned)w; }
DI float bflo(unsigned w) { return __uint_as_float(w << 16); }
DI float bfhi(unsigned w) { return __uint_as_float(w & 0xffff0000u); }
#ifndef FP8EMU
#define FP8EMU 0
#endif
DI float emu_q8(float x, float s) { float y = x * s; const float ay = fabsf(y);
    if (ay < 0.015625f) y = rintf(y * 512.0f) * (1.0f / 512.0f);
    else { unsigned u = __float_as_uint(y); u = (u + 0x0007FFFFu + ((u >> 20) & 1u)) & 0xFFF00000u; y = __uint_as_float(u); }
    y = fminf(fmaxf(y, -448.0f), 448.0f); return y / s; }
DI float bf1(bf16_t h) { return __uint_as_float(((unsigned)h) << 16); }

#ifndef ATT16
#define ATT16 0
#endif
DI int vt_key_of_pos(int p) {
#if ATT16
    return (p & ~31) | (((p >> 2) & 1) << 4) | (((p >> 3) & 3) << 2) | (p & 3);
#else
    return (p & ~0xC) | ((p & 4) << 1) | ((p & 8) >> 1);
#endif
}
DI int vt_pos_of_key(int k) {
#if ATT16
    return (k & ~31) | (((k >> 2) & 3) << 3) | (((k >> 4) & 1) << 2) | (k & 3);
#else
    return (k & ~0xC) | ((k & 4) << 1) | ((k & 8) >> 1);
#endif
}
constexpr int BATCH = 4, SEQ = 4096, DM = 4096, MTOK = BATCH * SEQ;
constexpr int NH = 64, NG = 4, NR = 16, DK = 192, DV = 128;
constexpr int N1 = 40896, N1P = 40960;
constexpr int C_Q = 0, C_KVC = 12288, C_KVS = 13568, C_KVW = 14848, C_ZC = 16128, C_ZS = 24320, C_ZW = 32512, C_G = 40704;
constexpr int N3 = 10304, N3P = 10496;
constexpr int C3_CQ = 0, C3_CKV = 1536, C3_KPE = 2048, C3_Z = 2112;
constexpr int QLORA = 1536, KVLORA = 512;
constexpr int NQB = 12288, NKVB = 16384, ZW8 = 8192;
constexpr float EPSN = 1e-6f;
constexpr float LOG2E = 1.4426950408889634f;
constexpr float QSCALE = 0.07216878364870322f * 1.4426950408889634f;

constexpr size_t SZ_W1T = (size_t)N1P * DM * 2, SZ_W2T = (size_t)DM * ZW8 * 2, SZ_W3T = (size_t)N3P * DM * 2, SZ_W4T = (size_t)NQB * QLORA * 2,
                 SZ_W5T = (size_t)NKVB * KVLORA * 2, SZ_W6T = (size_t)DM * ZW8 * 2;
constexpr size_t OFF_W1T = 0, OFF_W2T = OFF_W1T + SZ_W1T, OFF_W3T = OFF_W2T + SZ_W2T, OFF_W4T = OFF_W3T + SZ_W3T, OFF_W5T = OFF_W4T + SZ_W4T,
                 OFF_W6T = OFF_W5T + SZ_W5T, OFF_W1K = OFF_W6T + SZ_W6T;
constexpr size_t OFF_W5K = OFF_W5T, OFF_W5V = OFF_W5T + SZ_W5T / 2;
constexpr size_t SZ_W1K = (size_t)256 * 6144 * 2, SZ_W1V = (size_t)256 * 4096 * 2;
constexpr size_t OFF_W1V = OFF_W1K + SZ_W1K, OFF_CTL = OFF_W1V + SZ_W1V, OFF_H = OFF_CTL + 65536;
constexpr size_t SZ_H = (size_t)MTOK * DM * 2, SZ_KS = (size_t)BATCH * NG * SEQ * DK * 2, SZ_VTS = (size_t)BATCH * NG * DV * SEQ * 2,
                 SZ_ACK = (size_t)4096 * 6144 * 2, SZ_ACV = (size_t)4096 * 4096 * 2;
constexpr size_t OFF_KS = OFF_H + SZ_H, OFF_KW = OFF_KS + SZ_KS, OFF_VTS = OFF_KW + SZ_KS, OFF_VTW = OFF_VTS + SZ_VTS, OFF_ACK = OFF_VTW + SZ_VTS,
                 OFF_ACV = OFF_ACK + SZ_ACK, OFF_KC = OFF_ACV + SZ_ACV;
constexpr size_t SZ_KC = (size_t)16 * 256 * DK * 2, SZ_VTC = (size_t)16 * DV * 256 * 2, SZ_HID = (size_t)4096 * 256 * 4;
constexpr size_t OFF_VTC = OFF_KC + SZ_KC, OFF_HIDK = OFF_VTC + SZ_VTC, OFF_HIDV = OFF_HIDK + SZ_HID, OFF_Y0 = OFF_HIDV + SZ_HID;
constexpr size_t SZ_Y0 = (size_t)MTOK * N1P * 2, SZ_O = (size_t)MTOK * ZW8 * 2;
constexpr size_t OFF_O = OFF_Y0 + SZ_Y0, WS_END = OFF_O + SZ_O;
constexpr size_t OFF_SS1 = OFF_HIDK;
constexpr size_t OFF_A8 = OFF_O, OFF_B8 = OFF_O + (size_t)MTOK * DM;
constexpr int NZ8 = N1P - C_ZC;
constexpr size_t OFF_KM = 0;
constexpr size_t SZ_KM = (size_t)BATCH * NH * SEQ * DK * 2;
static_assert(SZ_KM <= SZ_W1T + SZ_W2T, "KM alias");
constexpr size_t OFF_VTM = OFF_H;
constexpr size_t SZ_VTM = (size_t)BATCH * NH * DV * SEQ * 2;
constexpr size_t OFF_CKVN = OFF_VTM + SZ_VTM;
constexpr size_t SZ_CKVN = (size_t)MTOK * KVLORA * 2;
static_assert(OFF_CKVN + SZ_CKVN <= OFF_KC, "CKVN alias");
constexpr size_t OFF_Y1 = OFF_Y0, SZ_Y1 = (size_t)MTOK * N3P * 2;
constexpr size_t OFF_QM = OFF_Y1 + SZ_Y1, SZ_QM = (size_t)MTOK * NQB * 2;
constexpr size_t OFF_KVM = OFF_QM + SZ_QM, SZ_KVM = (size_t)MTOK * NKVB * 2;
constexpr size_t OFF_KNM = OFF_KVM;
constexpr size_t OFF_KPER = OFF_KVM, OFF_SSPE = OFF_KVM + (size_t)MTOK * 64 * 4;
constexpr size_t OFF_CQN = OFF_KVM + SZ_KVM, SZ_CQN = (size_t)MTOK * QLORA * 2;
constexpr size_t OFF_ROPE = OFF_CQN + SZ_CQN, SZ_ROPE = (size_t)MTOK * 64 * 4;
static_assert(OFF_ROPE + SZ_ROPE <= OFF_O, "layer-1 alias region");
static_assert(WS_END <= 2680160256ull, "workspace");

struct Params {
    const float* x; const int* pos; const float* norm_w; const float* rel_bias;
    const float* nsa_w_in; const float* nsa_q_norm; const float* nsa_k_norm; const float* pe_k; const float* w1_k; const float* w2_k;
    const float* pe_v; const float* w1_v; const float* w2_v; const float* nsa_w_out;
    const float* mla_w_in; const float* mla_q_a_norm; const float* mla_w_q_b; const float* mla_kv_a_norm; const float* mla_w_kv_b;
    const float* mla_q_norm; const float* mla_k_norm; const float* mla_w_out;
    float* out; unsigned char* ws;
};

#define XB_TMO      128
#define XB_XCNT(j)  (256  + 64 * (j))
#define XB_XSUB(j)  (1280 + 64 * (j))
#define XB_XGEN(j)  (2304 + 64 * (j))
#define XB_TOP      3328
#define XB_TOPGEN   3392
#define XCD_BAR_WORDS 3456
#define XB_SPIN_CAP (1u << 18)

__device__ __forceinline__ unsigned xb_ld(unsigned* p)              { return __hip_atomic_load(p, __ATOMIC_RELAXED, __HIP_MEMORY_SCOPE_AGENT); }
__device__ __forceinline__ unsigned xb_add(unsigned* p, unsigned v) { return __hip_atomic_fetch_add(p, v, __ATOMIC_RELAXED, __HIP_MEMORY_SCOPE_AGENT); }
__device__ __forceinline__ unsigned xb_xcc_id() { return (unsigned)__builtin_amdgcn_s_getreg((3 << 11) | 20) & 0xFu; }
#define XB_SPIN(cond, bar) do { unsigned _sp = 0; while (cond) { __builtin_amdgcn_s_sleep(1); \
    if ((++_sp & 255u) == 0u) { if (xb_ld(&(bar)[XB_TMO])) break; if (_sp > XB_SPIN_CAP) { atomicAdd(&(bar)[XB_TMO], 1u); break; } } } } while (0)

struct XcdBarrier {
    unsigned* bar; unsigned x;
    volatile LAS unsigned* st;
};

__device__ __forceinline__ XcdBarrier xcd_barrier_post(unsigned* bar, volatile LAS unsigned* st) {
    XcdBarrier b; b.bar = bar; b.x = xb_xcc_id(); b.st = st;
    if (threadIdx.x == 0) (void)xb_add(&bar[XB_XCNT(b.x)], 1u);
    return b;
}
__device__ __forceinline__ void xcd_barrier_complete(unsigned* bar, unsigned x, unsigned& nloc, unsigned& nx) {
    const unsigned G = gridDim.x * gridDim.y * gridDim.z;
    unsigned sum, cnt, mine, sp = 0u;
    for (;;) {
        sum = 0u; cnt = 0u; mine = 0u;
#pragma unroll
        for (unsigned j = 0; j < 16; ++j) { const unsigned c = xb_ld(&bar[XB_XCNT(j)]); sum += c; cnt += (c > 0u) ? 1u : 0u; mine = (j == x) ? c : mine; }
        if (sum == G) break;
        __builtin_amdgcn_s_sleep(1);
        if ((++sp & 255u) == 0u) { if (xb_ld(&bar[XB_TMO])) break; if (sp > XB_SPIN_CAP) { atomicAdd(&bar[XB_TMO], 1u); break; } }
    }
    nloc = mine > 0u ? mine : 1u; nx = cnt > 0u ? cnt : 1u;
}

__device__ __forceinline__ void xcd_barrier(const XcdBarrier& b) {
    asm volatile("s_waitcnt vmcnt(0)" ::: "memory");
    __syncthreads();
    if (threadIdx.x == 0) {
        unsigned* bar = b.bar;
        __builtin_amdgcn_s_waitcnt(0);
        unsigned nloc = b.st[0], nx = b.st[1];
        if (nloc == 0u) { xcd_barrier_complete(bar, b.x, nloc, nx); b.st[0] = nloc; b.st[1] = nx; }
        const unsigned old = xb_add(&bar[XB_XSUB(b.x)], 1u);
        const unsigned gen = old / nloc;
        if (old + 1u == (gen + 1u) * nloc) {
            __builtin_amdgcn_fence(__ATOMIC_RELEASE, "agent");
            asm volatile("s_waitcnt vmcnt(0)" ::: "memory");
            const unsigned og = xb_add(&bar[XB_TOP], 1u);
            const unsigned tg = og / nx;
            if (og + 1u == (tg + 1u) * nx) xb_add(&bar[XB_TOPGEN], 1u);
            else XB_SPIN(xb_ld(&bar[XB_TOPGEN]) == tg, bar);
            __builtin_amdgcn_fence(__ATOMIC_ACQUIRE, "agent");
            xb_add(&bar[XB_XGEN(b.x)], 1u);
            asm volatile("s_waitcnt vmcnt(0)" ::: "memory");
        } else {
            XB_SPIN(xb_ld(&bar[XB_XGEN(b.x)]) == gen, bar);
            __builtin_amdgcn_fence(__ATOMIC_ACQUIRE, "agent");
            asm volatile("s_waitcnt vmcnt(0)" ::: "memory");
        }
    }
    __syncthreads();
}

namespace pg8 {
#define PG8_LAS __attribute__((address_space(3)))
typedef unsigned short bf16_t;
typedef short bf16x8 __attribute__((ext_vector_type(8)));
typedef float f32x4 __attribute__((ext_vector_type(4)));
typedef unsigned u32x4 __attribute__((ext_vector_type(4)));
typedef int i32x8_t __attribute__((ext_vector_type(8)));
typedef int i32x4_t __attribute__((ext_vector_type(4)));
constexpr int BM = 256, BK = 64, HALF = 128, HTB = HALF * BK * 2  , STAGE_BYTES = 8 * HTB, NXCD = 8, WGM = 8;

__host__ __device__ __forceinline__ int lds_byte(int r, int c) { const int st = (r >> 4) * 2 + (c >> 5), rr = r & 15, cc = c & 31, ob = rr * 64 + cc * 2; return st * 1024 + (ob ^ (((ob >> 9) & 1) << 5)); }
__host__ __device__ __forceinline__ void stage_rc(int b, int& R, int& C) { const int st = b / 1024, sb = b % 1024, swz = sb ^ (((sb >> 9) & 1) << 5); R = (st >> 1) * 16 + swz / 64; C = (st & 1) * 32 + (swz % 64) / 2; }
__host__ __device__ __forceinline__ int perm32(int rho) { const int n = rho >> 4, i = rho & 15; return 8 * (i >> 2) + 4 * n + (i & 3); }

struct Unit { int pm, pn; };
struct Gemm { const bf16_t* A; const bf16_t* Bt; int M, N, K; };

struct StaticOrder {
    int nM, nN, nwg, G, c;
    __host__ __device__ void init(int M, int N, int G_, int c_) { nM = M / BM; nN = N / BM; nwg = nM * nN; G = G_; c = c_; }
    __host__ __device__ bool next(int i, Unit& u) const {
        const long L = (long)i * G + c; if (L >= nwg) return false;
        int wgid = (int)L; { const int q = nwg / NXCD, r = nwg % NXCD, xcd = wgid % NXCD, off = wgid / NXCD; wgid = (xcd < r ? xcd * (q + 1) : r * (q + 1) + (xcd - r) * q) + off; }
        const int nig = WGM * nN, gid = wgid / nig, fm = gid * WGM, gsz = (nM - fm) < WGM ? (nM - fm) : WGM;
        u.pm = fm + ((wgid % nig) % gsz); u.pn = (wgid % nig) / gsz; return true;
    }
    __device__ __forceinline__ void a_ready(const Unit&) const {}
    __device__ __forceinline__ void done(const Unit&) const {}
};
struct EpiStoreBf16 {
    static constexpr bool PERM = true, AFTER_DRAIN = false, SWAP23 = false, FP8 = false;
    bf16_t* O; int ldc;
    __device__ __forceinline__ void operator()(const f32x4 (&acc)[2][2][4][2], const Unit& u, int wr, int wc, int fr, int fq) const {
        const int row0 = u.pm * BM + wr * 64 + fr; const int col0 = u.pn * BM + wc * 32 + 8 * fq;
#pragma unroll
        for (int ai = 0; ai < 2; ++ai)
#pragma unroll
            for (int m = 0; m < 4; ++m) { bf16_t* rowp = O + (size_t)(row0 + ai * HALF + m * 16) * ldc + col0;
#pragma unroll
                for (int bj = 0; bj < 2; ++bj) { const f32x4 v0 = acc[ai][bj][m][0], v1 = acc[ai][bj][m][1];
                    u32x4 w; w.x = pk2(v0[0], v0[1]); w.y = pk2(v0[2], v0[3]); w.z = pk2(v1[0], v1[1]); w.w = pk2(v1[2], v1[3]);
                    *(u32x4*)(rowp + bj * HALF) = w; } }
    }
};
struct EpiResF32 {
    static constexpr bool PERM = false, AFTER_DRAIN = false, SWAP23 = false, FP8 = false;
    const float* base; float* out; int ldc;
    __device__ __forceinline__ void operator()(const f32x4 (&acc)[2][2][4][2], const Unit& u, int wr, int wc, int fr, int fq) const {
        const int row0 = u.pm * BM + wr * 64 + fr, col0 = u.pn * BM + wc * 32 + 4 * fq;
#pragma unroll
        for (int ai = 0; ai < 2; ++ai)
#pragma unroll
            for (int m = 0; m < 4; ++m) { const size_t off = (size_t)(row0 + ai * HALF + m * 16) * ldc + col0;
#pragma unroll
                for (int bj = 0; bj < 2; ++bj)
#pragma unroll
                    for (int n = 0; n < 2; ++n) { const f32x4 bs = *(const f32x4*)(base + off + bj * HALF + n * 16);
                        *(f32x4*)(out + off + bj * HALF + n * 16) = bs + acc[ai][bj][m][n]; } }
    }
};
struct EpiPlainF32 {
    static constexpr bool PERM = false, AFTER_DRAIN = false, SWAP23 = false, FP8 = false;
    float* C; int ldc;
    __device__ __forceinline__ void operator()(const f32x4 (&acc)[2][2][4][2], const Unit& u, int wr, int wc, int fr, int fq) const {
        const int row0 = u.pm * BM + wr * 64 + fr, col0 = u.pn * BM + wc * 32 + 4 * fq;
#pragma unroll
        for (int ai = 0; ai < 2; ++ai)
#pragma unroll
            for (int m = 0; m < 4; ++m) { float* rowp = C + (size_t)(row0 + ai * HALF + m * 16) * ldc + col0;
#pragma unroll
                for (int bj = 0; bj < 2; ++bj)
#pragma unroll
                    for (int n = 0; n < 2; ++n) *(f32x4*)(rowp + bj * HALF + n * 16) = acc[ai][bj][m][n]; }
    }
};

struct EpiVT {
    static constexpr bool PERM = true, AFTER_DRAIN = false, SWAP23 = true, FP8 = false;
    bf16_t* O;
    __device__ __forceinline__ void operator()(const f32x4 (&acc)[2][2][4][2], const Unit& u, int wr, int wc, int fr, int fq) const {
        const int row0 = u.pm * BM + wr * 64 + fr; const int colt = u.pn * BM; const int b = colt >> 12, pos0 = (colt & 4095) + wc * 32 + 8 * fq;
        bf16_t* base = O + (size_t)b * 8192 * 4096 + pos0;
#pragma unroll
        for (int ai = 0; ai < 2; ++ai)
#pragma unroll
            for (int m = 0; m < 4; ++m) { bf16_t* rowp = base + (size_t)(row0 + ai * HALF + m * 16) * 4096;
#pragma unroll
                for (int bj = 0; bj < 2; ++bj) { const f32x4 v0 = acc[ai][bj][m][0], v1 = acc[ai][bj][m][1];
                    u32x4 w; w.x = pk2(v0[0], v0[1]); w.y = pk2(v0[2], v0[3]); w.z = pk2(v1[0], v1[1]); w.w = pk2(v1[2], v1[3]);
                    *(u32x4*)(rowp + bj * HALF) = w; } }
    }
};

struct EpiKNorm {
    static constexpr bool PERM = true, AFTER_DRAIN = false, SWAP23 = false, FP8 = false;
    bf16_t* KM; const float* sspe; const float* kper; const float* gain; PG8_LAS float* tab; mutable unsigned par;
    __device__ __forceinline__ void operator()(const f32x4 (&acc)[2][2][4][2], const Unit& u, int wr, int wc, int fr, int fq) const {
        PG8_LAS float* T = tab + par * 2048;
#pragma unroll
        for (int ai = 0; ai < 2; ++ai)
#pragma unroll
            for (int m = 0; m < 4; ++m) { const int row = ai * HALF + wr * 64 + m * 16 + fr;
#pragma unroll
                for (int bj = 0; bj < 2; ++bj) { const f32x4 x = acc[ai][bj][m][0], y = acc[ai][bj][m][1];
                    float ss = (x[0] * x[0] + x[1] * x[1]) + (x[2] * x[2] + x[3] * x[3]) + (y[0] * y[0] + y[1] * y[1]) + (y[2] * y[2] + y[3] * y[3]);
                    ss += __shfl_xor(ss, 16); ss += __shfl_xor(ss, 32);
                    if (fq == 0) T[row * 8 + bj * 4 + wc] = ss; } }
        asm volatile("s_waitcnt lgkmcnt(0)" ::: "memory"); __builtin_amdgcn_s_barrier(); asm volatile("" ::: "memory");
        const f32x4 g0 = *(const f32x4*)(gain + wc * 32 + 8 * fq), g1 = *(const f32x4*)(gain + wc * 32 + 8 * fq + 4);
        const int tok0 = u.pm * BM, b = tok0 >> 12;
#pragma unroll
        for (int ai = 0; ai < 2; ++ai)
#pragma unroll
            for (int m = 0; m < 4; ++m) { const int row = ai * HALF + wr * 64 + m * 16 + fr, tok = tok0 + row, s = tok & 4095;
                const float sp = sspe[tok]; const f32x4 kp = *(const f32x4*)(kper + (size_t)tok * 64 + wc * 16 + 4 * fq);
#pragma unroll
                for (int bj = 0; bj < 2; ++bj) { const f32x4 t = *(const PG8_LAS f32x4*)(T + row * 8 + bj * 4);
                    const float rstd = rsqrtf(((t[0] + t[1]) + (t[2] + t[3]) + sp) * (1.0f / 192.0f) + 1e-6f);
                    const int hd = 2 * u.pn + bj;
                    bf16_t* kb = KM + ((size_t)(b * 64 + hd) * 4096 + s) * 192;
                    const f32x4 x = acc[ai][bj][m][0], y = acc[ai][bj][m][1];
                    u32x4 w; w.x = pk2(x[0] * rstd * g0[0], x[1] * rstd * g0[1]); w.y = pk2(x[2] * rstd * g0[2], x[3] * rstd * g0[3]);
                    w.z = pk2(y[0] * rstd * g1[0], y[1] * rstd * g1[1]); w.w = pk2(y[2] * rstd * g1[2], y[3] * rstd * g1[3]);
                    *(u32x4*)(kb + wc * 32 + 8 * fq) = w;
                    u32x2 r; r.x = pk2(kp[0] * rstd, kp[1] * rstd); r.y = pk2(kp[2] * rstd, kp[3] * rstd);
                    *(u32x2*)(kb + 128 + wc * 16 + 4 * fq) = r; } }
        par ^= 1u;
    }
};

struct EpiResNorm {
    static constexpr bool PERM = false, AFTER_DRAIN = false, SWAP23 = false, FP8 = false;
    const float* base; float* out; int ldc; const float* gain; bf16_t* xg; float* ss;
    __device__ __forceinline__ void operator()(const f32x4 (&acc)[2][2][4][2], const Unit& u, int wr, int wc, int fr, int fq) const {
        const int row0 = u.pm * BM + wr * 64 + fr, col0 = u.pn * BM + wc * 32 + 4 * fq;
        f32x4 gv[2][2];
#pragma unroll
        for (int bj = 0; bj < 2; ++bj)
#pragma unroll
            for (int n = 0; n < 2; ++n) gv[bj][n] = *(const f32x4*)(gain + col0 + bj * HALF + n * 16);
#pragma unroll
        for (int ai = 0; ai < 2; ++ai)
#pragma unroll
            for (int m = 0; m < 4; ++m) { const int row = row0 + ai * HALF + m * 16; const size_t off = (size_t)row * ldc + col0; float sq = 0.f;
#pragma unroll
                for (int bj = 0; bj < 2; ++bj)
#pragma unroll
                    for (int n = 0; n < 2; ++n) { const f32x4 bs = *(const f32x4*)(base + off + bj * HALF + n * 16); const f32x4 v = bs + acc[ai][bj][m][n];
                        *(f32x4*)(out + off + bj * HALF + n * 16) = v;
                        sq += (v[0] * v[0] + v[1] * v[1]) + (v[2] * v[2] + v[3] * v[3]);
                        const f32x4 g = gv[bj][n]; u32x2 w; w.x = pk2(v[0] * g[0], v[1] * g[1]); w.y = pk2(v[2] * g[2], v[3] * g[3]);
                        *(u32x2*)(xg + off + bj * HALF + n * 16) = w; }
                sq += __shfl_xor(sq, 16); sq += __shfl_xor(sq, 32);
                if (fq == 0) atomicAdd(ss + row, sq); }
    }
};
struct EpiStoreBf16RowScale {
    static constexpr bool PERM = true, AFTER_DRAIN = false, SWAP23 = false, FP8 = false;
    bf16_t* O; int ldc; const float* ss; float inv_dim;
    __device__ __forceinline__ void operator()(const f32x4 (&acc)[2][2][4][2], const Unit& u, int wr, int wc, int fr, int fq) const {
        const int row0 = u.pm * BM + wr * 64 + fr; const int col0 = u.pn * BM + wc * 32 + 8 * fq;
#pragma unroll
        for (int ai = 0; ai < 2; ++ai)
#pragma unroll
            for (int m = 0; m < 4; ++m) { const int row = row0 + ai * HALF + m * 16; const float rs = rsqrtf(ss[row] * inv_dim + 1e-6f);
                bf16_t* rowp = O + (size_t)row * ldc + col0;
#pragma unroll
                for (int bj = 0; bj < 2; ++bj) { const f32x4 v0 = acc[ai][bj][m][0] * rs, v1 = acc[ai][bj][m][1] * rs;
                    u32x4 w; w.x = pk2(v0[0], v0[1]); w.y = pk2(v0[2], v0[3]); w.z = pk2(v1[0], v1[1]); w.w = pk2(v1[2], v1[3]);
                    *(u32x4*)(rowp + bj * HALF) = w; } }
    }
};

struct EpiStoreBf16Fp8 {
    static constexpr bool PERM = true, AFTER_DRAIN = false, SWAP23 = false, FP8 = true;
    bf16_t* O; int ldc; float scale;
    __device__ __forceinline__ void operator()(const f32x4 (&acc)[2][2][4][2], const Unit& u, int wr, int wc, int fr, int fq) const {
        const int row0 = u.pm * BM + wr * 64 + fr; const int col0 = u.pn * BM + wc * 32 + 8 * fq;
#pragma unroll
        for (int ai = 0; ai < 2; ++ai)
#pragma unroll
            for (int m = 0; m < 4; ++m) { bf16_t* rowp = O + (size_t)(row0 + ai * HALF + m * 16) * ldc + col0;
#pragma unroll
                for (int bj = 0; bj < 2; ++bj) { const f32x4 v0 = acc[ai][bj][m][0] * scale, v1 = acc[ai][bj][m][1] * scale;
                    u32x4 w; w.x = pk2(v0[0], v0[1]); w.y = pk2(v0[2], v0[3]); w.z = pk2(v1[0], v1[1]); w.w = pk2(v1[2], v1[3]);
                    *(u32x4*)(rowp + bj * HALF) = w; } }
    }
};

struct OrderBf16Part {
    int G, c;
    __device__ bool next(int i, Unit& u) const { const int L = i * G + c;
        if (L < 63 * 64) { u.pm = L & 63; u.pn = L >> 6; return true; }
        const int Lz = L - 63 * 64; if (Lz >= 97 * 4) return false;
        u.pm = 16 * (Lz & 3); u.pn = 63 + (Lz >> 2); return true; }
    __device__ __forceinline__ void a_ready(const Unit&) const {}
    __device__ __forceinline__ void done(const Unit&) const {}
};
struct OrderFp8Part {
    int G, c;
    __device__ bool next(int i, Unit& u) const { const int L = i * G + c; if (L >= 97 * 60) return false;
        const int r = L % 60; u.pm = r + r / 15 + 1; u.pn = L / 60; return true; }
    __device__ __forceinline__ void a_ready(const Unit&) const {}
    __device__ __forceinline__ void done(const Unit&) const {}
};
template <class Epi, class Sched, bool STAMP = false>
__device__ __forceinline__ void gemm_phase(PG8_LAS unsigned char* lds, const Gemm g, const Sched& S, const Epi& E, unsigned long long* stamps) {
    const int tid = tid_opaque(), wid = __builtin_amdgcn_readfirstlane(tid >> 6), lane = tid & 63, wr = wid >> 2, wc = wid & 3, fr = lane & 15, fq = lane >> 4;
    const int K = g.K, nt = K / BK;
    int ts_lo = 0, ts_hi = 0, nts = 0; const unsigned long long rt_entry = STAMP ? (unsigned long long)wall_clock64() : 0ull;
#define PG8_STAMP() do { if (STAMP && wid == 0 && nts < 64) { const unsigned long long _c = (unsigned long long)clock64(); \
        ts_lo = (lane == nts) ? (int)(unsigned)_c : ts_lo; ts_hi = (lane == nts) ? (int)(unsigned)(_c >> 32) : ts_hi; ++nts; } } while (0)
    PG8_STAMP();
    unsigned voffA[2], voffB[2];
#pragma unroll
    for (int i = 0; i < 2; ++i) { int R, C; stage_rc(tid * 16 + i * 8192, R, C); int Rb = Epi::PERM ? ((R & ~31) + perm32(R & 31)) : R; if (Epi::SWAP23) Rb = vt_key_of_pos(Rb);
        voffA[i] = (unsigned)(R * K + C) * 2u; voffB[i] = (unsigned)(Rb * K + C) * 2u; }
    const size_t kstep = (size_t)(BK * 2);
    const size_t hstep = (size_t)HALF * K * 2;
    const size_t tstep = 2 * hstep;
    const unsigned ldsw = (unsigned)wid * 1024u;
    const int aoff = lds_byte(wr * 64 + fr, fq * 8), boff = lds_byte(wc * 32 + fr, fq * 8);
#define PG8_SA(b, h) (((b) * 2 + (h)) * HTB)
#define PG8_SB(b, h) ((4 + (b) * 2 + (h)) * HTB)
#define PG8_STAGE(bufoff, gbase, voff) do { _Pragma("unroll") for (int _i = 0; _i < 2; ++_i) \
        __builtin_amdgcn_global_load_lds((const unsigned*)((const char*)(gbase) + (voff)[_i]), (PG8_LAS unsigned*)(lds + (bufoff) + ldsw + _i * 8192), 16, 0, 0); } while (0)
#define PG8_LDA(dst, b, h) do { if constexpr (Epi::FP8) { _Pragma("unroll") for (int m = 0; m < 4; ++m) { const PG8_LAS unsigned char* p_ = lds + PG8_SA(b, h) + aoff + m * 2048; \
            const i32x4_t lo_ = *(const PG8_LAS i32x4_t*)p_, hi_ = *(const PG8_LAS i32x4_t*)(p_ + 1024); dst##8[m] = __builtin_shufflevector(lo_, hi_, 0, 1, 2, 3, 4, 5, 6, 7); } } \
        else { _Pragma("unroll") for (int m = 0; m < 4; ++m) _Pragma("unroll") for (int k = 0; k < 2; ++k) dst[m][k] = *(const PG8_LAS bf16x8*)(lds + PG8_SA(b, h) + aoff + m * 2048 + k * 1024); } } while (0)
#define PG8_LDB(dst, b, h) do { if constexpr (Epi::FP8) { _Pragma("unroll") for (int n = 0; n < 2; ++n) { const PG8_LAS unsigned char* p_ = lds + PG8_SB(b, h) + boff + n * 2048; \
            const i32x4_t lo_ = *(const PG8_LAS i32x4_t*)p_, hi_ = *(const PG8_LAS i32x4_t*)(p_ + 1024); dst##8[n] = __builtin_shufflevector(lo_, hi_, 0, 1, 2, 3, 4, 5, 6, 7); } } \
        else { _Pragma("unroll") for (int n = 0; n < 2; ++n) _Pragma("unroll") for (int k = 0; k < 2; ++k) dst[n][k] = *(const PG8_LAS bf16x8*)(lds + PG8_SB(b, h) + boff + n * 2048 + k * 1024); } } while (0)
#define PG8_MMA(ai, bj, At, Bt) do { __builtin_amdgcn_s_setprio(1); \
        if constexpr (Epi::FP8) { \
            _Pragma("unroll") for (int m = 0; m < 4; ++m) _Pragma("unroll") for (int n = 0; n < 2; ++n) \
                asm volatile("v_mfma_scale_f32_16x16x128_f8f6f4 %0, %1, %2, %0, %3, %3 op_sel_hi:[0,0,0]" : "+v"(acc[ai][bj][m][n]) : "v"(Bt##8[n]), "v"(At##8[m]), "v"(fp8_scale_one)); \
        } else { \
            _Pragma("unroll") for (int m = 0; m < 4; ++m) _Pragma("unroll") for (int n = 0; n < 2; ++n) _Pragma("unroll") for (int k = 0; k < 2; ++k) \
                acc[ai][bj][m][n] = __builtin_amdgcn_mfma_f32_16x16x32_bf16(Bt[n][k], At[m][k], acc[ai][bj][m][n], 0, 0, 0); } \
        __builtin_amdgcn_s_setprio(0); } while (0)
#define PG8_WAIT_V(n) asm volatile("s_waitcnt vmcnt(" #n ")" ::: "memory")
#define PG8_WAIT_L(n) asm volatile("s_waitcnt lgkmcnt(" #n ")" ::: "memory")
#define PG8_BAR __builtin_amdgcn_s_barrier()
#define PG8_SCHED __builtin_amdgcn_sched_barrier(0)
    Unit cur, nxt; int ui = 0;
    if (!S.next(0, cur)) return;
    f32x4 acc[2][2][4][2];
#pragma unroll
    for (int a = 0; a < 2; ++a)
#pragma unroll
        for (int b = 0; b < 2; ++b)
#pragma unroll
            for (int m = 0; m < 4; ++m)
#pragma unroll
                for (int n = 0; n < 2; ++n) acc[a][b][m][n] = (f32x4){0.f, 0.f, 0.f, 0.f};
    bf16x8 At[4][2], B0[2][2], B1[2][2]; i32x8_t At8[4], B08[2], B18[2]; const int fp8_scale_one = 0x7f7f7f7f;
    const char* cA = (const char*)g.A + (size_t)cur.pm * tstep; const char* cB = (const char*)g.Bt + (size_t)cur.pn * tstep;
    S.a_ready(cur);
    PG8_STAGE(PG8_SB(0, 0), cB, voffB); PG8_STAGE(PG8_SA(0, 0), cA, voffA); PG8_STAGE(PG8_SB(0, 1), cB + hstep, voffB); PG8_STAGE(PG8_SA(0, 1), cA + hstep, voffA);
    if (wr == 1) PG8_BAR;
    PG8_WAIT_V(4); PG8_BAR;
    PG8_STAGE(PG8_SB(1, 0), cB + kstep, voffB); PG8_STAGE(PG8_SA(1, 0), cA + kstep, voffA); PG8_STAGE(PG8_SB(1, 1), cB + hstep + kstep, voffB);
    PG8_WAIT_V(6); PG8_BAR;
    PG8_STAMP();
    for (;;) {
        const bool has_next = S.next(ui + 1, nxt);
        const char* nA = has_next ? (const char*)g.A + (size_t)nxt.pm * tstep : cA; const char* nB = has_next ? (const char*)g.Bt + (size_t)nxt.pn * tstep : cB;
        for (int t = 0; t < nt; t += 2) {
            const bool last = (t == nt - 2);
            const char* a1 = cA + (size_t)(t + 1) * kstep;
            const char* a2 = last ? nA : cA + (size_t)(t + 2) * kstep; const char* b2 = last ? nB : cB + (size_t)(t + 2) * kstep;
            const char* a3 = a2 + kstep; const char* b3 = b2 + kstep;
            if (last && has_next) S.a_ready(nxt);
            PG8_LDB(B0, 0, 0); PG8_SCHED; PG8_LDA(At, 0, 0); PG8_STAGE(PG8_SA(1, 1), a1 + hstep, voffA);
            PG8_WAIT_L(8); PG8_BAR; PG8_WAIT_L(0); PG8_MMA(0, 0, At, B0); PG8_BAR; PG8_SCHED;
            PG8_LDB(B1, 0, 1); PG8_STAGE(PG8_SB(0, 0), b2, voffB);
            PG8_BAR; PG8_WAIT_L(0); PG8_MMA(0, 1, At, B1); PG8_BAR;
            PG8_LDA(At, 0, 1); PG8_STAGE(PG8_SA(0, 0), a2, voffA);
            PG8_BAR; PG8_WAIT_L(0); PG8_MMA(1, 0, At, B0); PG8_BAR; PG8_SCHED;
            PG8_STAGE(PG8_SB(0, 1), b2 + hstep, voffB);
            PG8_WAIT_V(6); PG8_BAR; PG8_MMA(1, 1, At, B1); PG8_BAR;
            PG8_LDB(B0, 1, 0); PG8_SCHED; PG8_LDA(At, 1, 0); PG8_STAGE(PG8_SA(0, 1), a2 + hstep, voffA);
            PG8_WAIT_L(8); PG8_BAR; PG8_WAIT_L(0); PG8_MMA(0, 0, At, B0); PG8_BAR; PG8_SCHED;
            PG8_LDB(B1, 1, 1); PG8_STAGE(PG8_SB(1, 0), b3, voffB);
            PG8_BAR; PG8_WAIT_L(0); PG8_MMA(0, 1, At, B1); PG8_BAR;
            PG8_LDA(At, 1, 1); PG8_STAGE(PG8_SA(1, 0), a3, voffA);
            PG8_BAR; PG8_WAIT_L(0); PG8_MMA(1, 0, At, B0); PG8_BAR; PG8_SCHED;
            PG8_STAGE(PG8_SB(1, 1), b3 + hstep, voffB);
            PG8_WAIT_V(6); PG8_BAR; PG8_MMA(1, 1, At, B1); PG8_BAR;
        }
        PG8_STAMP();
        if constexpr (Epi::FP8) asm volatile("s_nop 15\n\ts_nop 15" ::: "memory");
        if constexpr (!Epi::AFTER_DRAIN) { E(acc, cur, wr, wc, fr, fq); S.done(cur); }
        PG8_STAMP();
        if (!has_next) break;
#pragma unroll
        for (int a = 0; a < 2; ++a)
#pragma unroll
            for (int b = 0; b < 2; ++b)
#pragma unroll
                for (int m = 0; m < 4; ++m)
#pragma unroll
                    for (int n = 0; n < 2; ++n) acc[a][b][m][n] = (f32x4){0.f, 0.f, 0.f, 0.f};
        cur = nxt; cA = nA; cB = nB; ++ui;
    }
    PG8_WAIT_V(0);
    if (wr == 0) PG8_BAR;
    PG8_BAR;
    if constexpr (Epi::AFTER_DRAIN) { E.fused(acc, cur, wr, wc, fr, fq, lds, wid, lane); S.done(cur); }
    PG8_STAMP();
    if (STAMP && wid == 0) { stamps[lane] = lane < nts ? (((unsigned long long)(unsigned)ts_hi << 32) | (unsigned)ts_lo) : 0ull;
        if (lane == 62) stamps[62] = rt_entry; if (lane == 63) stamps[63] = (unsigned long long)wall_clock64(); }
#undef PG8_STAMP
#undef PG8_SA
#undef PG8_SB
#undef PG8_STAGE
#undef PG8_LDA
#undef PG8_LDB
#undef PG8_MMA
#undef PG8_WAIT_V
#undef PG8_WAIT_L
#undef PG8_BAR
#undef PG8_SCHED
}
}


DI void phase_wconv(LAS unsigned char* lds, const float* __restrict__ src, bf16_t* __restrict__ dst, int K, int N, int Npad, int bid, int nb, float q8s = 0.f, int colmap = 0, unsigned char* __restrict__ dst8 = nullptr, int n8_0 = 0) {
    LAS float* tile = (LAS float*)lds;
    const int tid = tid_opaque();
    const int tk = K / 64, tn = Npad / 256, total = tk * tn;
    for (int t = bid; t < total; t += nb) {
        const int k0 = (t % tk) * 64, n0 = (t / tk) * 256;
        __syncthreads();
        {
            const int ty = tid >> 6, tx = tid & 63, n = n0 + tx * 4;
            f32x4 v[8];
#pragma unroll
            for (int i = 0; i < 8; ++i) {
                const int k = k0 + ty + 8 * i;
                v[i] = (f32x4){0.f, 0.f, 0.f, 0.f};
                if (colmap) { const int ns = (n >> 7) * 256 + (colmap == 1 ? 128 : 0) + (n & 127); v[i] = *(const f32x4*)(src + (size_t)k * (2 * N) + ns); }
                else if (n < N) v[i] = *(const f32x4*)(src + (size_t)k * N + n);
            }
#pragma unroll
            for (int i = 0; i < 8; ++i) { LAS float* pp = tile + (ty + 8 * i) * 257 + tx * 4; pp[0] = v[i][0]; pp[1] = v[i][1]; pp[2] = v[i][2]; pp[3] = v[i][3]; }
        }
        __syncthreads();
#pragma unroll
        for (int ps_ = 0; ps_ < 4; ++ps_) {
            const int n = (tid >> 3) + 64 * ps_, kc = tid & 7;
            float v[8];
#pragma unroll
            for (int j = 0; j < 8; ++j) { v[j] = tile[(kc * 8 + j) * 257 + n]; if (q8s > 0.f) v[j] = emu_q8(v[j], q8s); else if (q8s < 0.f && n0 + n >= C_ZC) v[j] = emu_q8(v[j], -q8s); }
            u32x4 w; w.x = pk2(v[0], v[1]); w.y = pk2(v[2], v[3]); w.z = pk2(v[4], v[5]); w.w = pk2(v[6], v[7]);
            *(u32x4*)(dst + (size_t)(n0 + n) * K + k0 + kc * 8) = w;
            if (dst8 && n0 + n >= n8_0) { u32x2 b; b.x = pk4_fp8(v[0] * 64.0f, v[1] * 64.0f, v[2] * 64.0f, v[3] * 64.0f); b.y = pk4_fp8(v[4] * 64.0f, v[5] * 64.0f, v[6] * 64.0f, v[7] * 64.0f);
                *(u32x2*)(dst8 + (size_t)(n0 + n - n8_0) * K + k0 + kc * 8) = b; }
        }
    }
}

DI void phase_rmsnorm(const float* __restrict__ x, const float* __restrict__ gain, bf16_t* __restrict__ h, int bid, int nb, float q8s = 0.f, unsigned char* __restrict__ h8 = nullptr) {
    const int tid = tid_opaque(); const int lane = tid & 63, wid = tid >> 6;
    for (int row = bid * 8 + wid; row < MTOK; row += nb * 8) {
        const float* xr = x + (size_t)row * DM;
        f32x4 v[16]; float ss = 0.f;
#pragma unroll
        for (int i = 0; i < 16; ++i) { v[i] = *(const f32x4*)(xr + (i * 64 + lane) * 4); ss += v[i][0] * v[i][0] + v[i][1] * v[i][1] + v[i][2] * v[i][2] + v[i][3] * v[i][3]; }
#pragma unroll
        for (int o = 32; o >= 1; o >>= 1) ss += __shfl_xor(ss, o);
        const float rstd = rsqrtf(ss * (1.0f / DM) + EPSN);
        bf16_t* hr = h + (size_t)row * DM;
#pragma unroll
        for (int i = 0; i < 16; ++i) { const f32x4 g = *(const f32x4*)(gain + (i * 64 + lane) * 4);
            float y0 = v[i][0] * rstd * g[0], y1 = v[i][1] * rstd * g[1], y2 = v[i][2] * rstd * g[2], y3 = v[i][3] * rstd * g[3];
            if (q8s > 0.f || (q8s < 0.f && (row & 4095) >= 256)) { const float qa = fabsf(q8s); y0 = emu_q8(y0, qa); y1 = emu_q8(y1, qa); y2 = emu_q8(y2, qa); y3 = emu_q8(y3, qa); }
            u32x2 w; w.x = pk2(y0, y1); w.y = pk2(y2, y3);
            *(u32x2*)(hr + (i * 64 + lane) * 4) = w;
            if (h8) *(unsigned*)(h8 + (size_t)row * DM + (i * 64 + lane) * 4) = pk4_fp8(y0 * 16.0f, y1 * 16.0f, y2 * 16.0f, y3 * 16.0f); }
    }
}

DI void ld192(const bf16_t* p, int j8, float (&v)[24]) {
#pragma unroll
    for (int c = 0; c < 3; ++c) { const u32x4 w = *(const u32x4*)(p + (j8 + 8 * c) * 8);
        v[c * 8 + 0] = bflo(w.x); v[c * 8 + 1] = bfhi(w.x); v[c * 8 + 2] = bflo(w.y); v[c * 8 + 3] = bfhi(w.y);
        v[c * 8 + 4] = bflo(w.z); v[c * 8 + 5] = bfhi(w.z); v[c * 8 + 6] = bflo(w.w); v[c * 8 + 7] = bfhi(w.w); }
}
DI void st192(bf16_t* p, int j8, const float (&v)[24]) {
#pragma unroll
    for (int c = 0; c < 3; ++c) { u32x4 w; w.x = pk2(v[c * 8 + 0], v[c * 8 + 1]); w.y = pk2(v[c * 8 + 2], v[c * 8 + 3]); w.z = pk2(v[c * 8 + 4], v[c * 8 + 5]); w.w = pk2(v[c * 8 + 6], v[c * 8 + 7]);
        *(u32x4*)(p + (j8 + 8 * c) * 8) = w; }
}
DI float sum8(float s) { s += __shfl_xor(s, 1); s += __shfl_xor(s, 2); s += __shfl_xor(s, 4); return s; }

DI void phase_nsa_prep(const Params& P, int bid, int nb) {
    bf16_t* Y0 = (bf16_t*)(P.ws + OFF_Y0);
    bf16_t* KS = (bf16_t*)(P.ws + OFF_KS); bf16_t* KW = (bf16_t*)(P.ws + OFF_KW);
    bf16_t* ACK = (bf16_t*)(P.ws + OFF_ACK); bf16_t* ACV = (bf16_t*)(P.ws + OFF_ACV);
    const int tid = tid_opaque(), grp = (tid >> 3) & 15, j8 = tid & 7;
    for (int tok = bid * 4 + (tid >> 7); tok < MTOK; tok += nb * 4) {
        const int b = tok / SEQ, s = tok % SEQ;
        bf16_t* yr = Y0 + (size_t)tok * N1P;
        if (grp < 8) {
            const int g = grp & 3, br = grp >> 2;
            float v[24]; ld192(yr + (br ? C_KVW : C_KVS) + g * DK, j8, v);
            float ss = 0.f;
#pragma unroll
            for (int i = 0; i < 24; ++i) ss += v[i] * v[i];
            ss = sum8(ss);
            const float rstd = rsqrtf(ss * (1.0f / DK) + EPSN);
            const float* kn = P.nsa_k_norm + (br ? 2 : 1) * DK;
#pragma unroll
            for (int c = 0; c < 3; ++c)
#pragma unroll
                for (int e = 0; e < 8; ++e) v[c * 8 + e] *= rstd * kn[(j8 + 8 * c) * 8 + e];
            st192((br ? KW : KS) + ((size_t)(b * NG + g) * SEQ + s) * DK, j8, v);
        } else if (grp < 12) {
            const int g = grp - 8;
            float v[24]; ld192(yr + C_KVC + g * DK, j8, v);
#pragma unroll
            for (int k = 0; k < 2; ++k) {
                const int n = (s >> 4) - k, l = s - 16 * n;
                if (n >= 0 && n <= 254) {
                    float w[24];
#pragma unroll
                    for (int c = 0; c < 3; ++c)
#pragma unroll
                        for (int e = 0; e < 8; ++e) w[c * 8 + e] = v[c * 8 + e] + P.pe_k[l * DK + (j8 + 8 * c) * 8 + e];
                    st192(ACK + ((size_t)((b * NG + g) * 256 + n)) * 6144 + l * DK, j8, w);
                }
            }
        } else if (grp < 16) {
            const int g = grp - 12;
            const bf16_t* src = yr + C_KVC + NG * DK + g * DV;
            float v[16];
#pragma unroll
            for (int c = 0; c < 2; ++c) { const u32x4 w = *(const u32x4*)(src + (j8 + 8 * c) * 8);
                v[c * 8 + 0] = bflo(w.x); v[c * 8 + 1] = bfhi(w.x); v[c * 8 + 2] = bflo(w.y); v[c * 8 + 3] = bfhi(w.y);
                v[c * 8 + 4] = bflo(w.z); v[c * 8 + 5] = bfhi(w.z); v[c * 8 + 6] = bflo(w.w); v[c * 8 + 7] = bfhi(w.w); }
#pragma unroll
            for (int k = 0; k < 2; ++k) {
                const int n = (s >> 4) - k, l = s - 16 * n;
                if (n >= 0 && n <= 254) {
                    bf16_t* dst = ACV + ((size_t)((b * NG + g) * 256 + n)) * 4096 + l * DV;
#pragma unroll
                    for (int c = 0; c < 2; ++c) { float w[8];
#pragma unroll
                        for (int e = 0; e < 8; ++e) w[e] = v[c * 8 + e] + P.pe_v[l * DV + (j8 + 8 * c) * 8 + e];
                        u32x4 o; o.x = pk2(w[0], w[1]); o.y = pk2(w[2], w[3]); o.z = pk2(w[4], w[5]); o.w = pk2(w[6], w[7]);
                        *(u32x4*)(dst + (j8 + 8 * c) * 8) = o; }
                }
            }
        }
    }
    for (int i = bid * 512 + tid; i < 16 * (6144 + 4096) / 8; i += nb * 512) {
        const int per = (6144 + 4096) / 8, bg = i / per, c = i % per;
        const u32x4 z = {0u, 0u, 0u, 0u};
        if (c < 6144 / 8) *(u32x4*)(ACK + ((size_t)(bg * 256 + 255)) * 6144 + c * 8) = z;
        else *(u32x4*)(ACV + ((size_t)(bg * 256 + 255)) * 4096 + (c - 6144 / 8) * 8) = z;
    }
}

DI int swap23(int p) { return (p & ~0xC) | ((p & 4) << 1) | ((p & 8) >> 1); }
DI void phase_vt(LAS unsigned char* lds, const bf16_t* __restrict__ src, size_t src_stride, int col0, int col_step, int nhv, bf16_t* __restrict__ dst, int bid, int nb) {
    LAS bf16_t* tile = (LAS bf16_t*)lds;
    const int tid = tid_opaque();
    const int ntile = SEQ / 64, total = BATCH * nhv * ntile;
    for (int it = bid; it < total; it += nb) {
        const int mat = it / ntile, tt = it % ntile, b = mat / nhv, hv = mat % nhv;
        __syncthreads();
#pragma unroll
        for (int i = 0; i < 2; ++i) {
            const int q = tid + 512 * i, tok = q >> 4, ch = q & 15;
            const u32x4 w = *(const u32x4*)(src + (size_t)(b * SEQ + tt * 64 + tok) * src_stride + col0 + hv * col_step + ch * 8);
            *(LAS u32x4*)(tile + tok * 136 + ch * 8) = w;
        }
        __syncthreads();
        {
            const int dv = tid >> 2, kq = tid & 3;
            unsigned w[8];
#pragma unroll
            for (int e = 0; e < 8; ++e) {
                const int p0 = kq * 16 + 2 * e, p1 = p0 + 1;
                const int k0 = vt_key_of_pos(p0), k1 = vt_key_of_pos(p1);
                w[e] = (unsigned)tile[k0 * 136 + dv] | ((unsigned)tile[k1 * 136 + dv] << 16);
            }
            bf16_t* d = dst + ((size_t)mat * DV + dv) * SEQ + tt * 64 + kq * 16;
            u32x4 a = {w[0], w[1], w[2], w[3]}, c = {w[4], w[5], w[6], w[7]};
            *(u32x4*)d = a; *(u32x4*)(d + 8) = c;
        }
    }
}

DI void phase_cmp2(LAS unsigned char* lds, const Params& P, int bid, int nb) {
    LAS float* sk = (LAS float*)lds;
    LAS float* sv = sk + 192;
    LAS float* red = sv + 128;
    const float* HIDK = (const float*)(P.ws + OFF_HIDK); const float* HIDV = (const float*)(P.ws + OFF_HIDV);
    bf16_t* KC = (bf16_t*)(P.ws + OFF_KC); bf16_t* VTC = (bf16_t*)(P.ws + OFF_VTC);
    const int tid = tid_opaque(), lane = tid & 63, wid = tid >> 6;
    for (int m = bid; m < 4096; m += nb) {
        const int n = m & 255, bg = m >> 8;
        __syncthreads();
        if (tid < 192) { const float h = HIDK[(size_t)m * 256 + tid]; sk[tid] = h / (1.0f + __expf(-h)); }
        else if (tid < 320) { const float h = HIDV[(size_t)m * 256 + tid - 192]; sv[tid - 192] = h / (1.0f + __expf(-h)); }
        __syncthreads();
        float acc = 0.f;
        if (tid < 192) { for (int i = 0; i < 192; ++i) acc += sk[i] * P.w2_k[i * 192 + tid]; }
        else if (tid < 320) { const int j = tid - 192; for (int i = 0; i < 128; ++i) acc += sv[i] * P.w2_v[i * 128 + j]; }
        float ss = (tid < 192) ? acc * acc : 0.f;
#pragma unroll
        for (int o = 32; o >= 1; o >>= 1) ss += __shfl_xor(ss, o);
        if (lane == 0) red[wid] = ss;
        __syncthreads();
        const float tot = red[0] + red[1] + red[2];
        const float rstd = rsqrtf(tot * (1.0f / DK) + EPSN);
        if (tid < 192) { const float o = (n == 255) ? 0.f : acc * rstd * P.nsa_k_norm[tid];
            KC[(size_t)m * DK + tid] = (bf16_t)(pk2(o, 0.f) & 0xffffu); }
        else if (tid < 320) { const int j = tid - 192; const float o = (n == 255) ? 0.f : acc;
            const int pn = vt_pos_of_key(n);
            VTC[((size_t)bg * DV + j) * 256 + pn] = (bf16_t)(pk2(o, 0.f) & 0xffffu); }
    }
}

DI void phase_mla_prep1(const Params& P, int bid, int nb) {
    const bf16_t* Y1 = (const bf16_t*)(P.ws + OFF_Y1);
    bf16_t* CQN = (bf16_t*)(P.ws + OFF_CQN); bf16_t* CKVN = (bf16_t*)(P.ws + OFF_CKVN); float* ROPE = (float*)(P.ws + OFF_ROPE);
    float* KPER = (float*)(P.ws + OFF_KPER); float* SSPE = (float*)(P.ws + OFF_SSPE);
    const int tid = tid_opaque(); const int lane = tid & 63, wid = tid >> 6;
    constexpr int TU = 4;
    for (int tok0 = (bid * 8 + wid) * TU; tok0 < MTOK; tok0 += nb * 8 * TU) {
        u32x4 wq[TU][3], wk[TU]; int pos[TU]; bf16_t kp1[TU], kp2[TU];
#pragma unroll
        for (int t = 0; t < TU; ++t) { const bf16_t* yr = Y1 + (size_t)(tok0 + t) * N3P;
#pragma unroll
            for (int c = 0; c < 3; ++c) wq[t][c] = *(const u32x4*)(yr + C3_CQ + (c * 64 + lane) * 8);
            wk[t] = *(const u32x4*)(yr + C3_CKV + lane * 8);
            pos[t] = P.pos[tok0 + t]; kp1[t] = yr[C3_KPE + (lane & 31)]; kp2[t] = yr[C3_KPE + 32 + (lane & 31)]; }
#pragma unroll
        for (int t = 0; t < TU; ++t) { const int tok = tok0 + t;
            {
                float v[24]; float ss = 0.f;
#pragma unroll
                for (int c = 0; c < 3; ++c) { const u32x4 w = wq[t][c];
                    v[c * 8 + 0] = bflo(w.x); v[c * 8 + 1] = bfhi(w.x); v[c * 8 + 2] = bflo(w.y); v[c * 8 + 3] = bfhi(w.y);
                    v[c * 8 + 4] = bflo(w.z); v[c * 8 + 5] = bfhi(w.z); v[c * 8 + 6] = bflo(w.w); v[c * 8 + 7] = bfhi(w.w); }
#pragma unroll
                for (int i = 0; i < 24; ++i) ss += v[i] * v[i];
#pragma unroll
                for (int o = 32; o >= 1; o >>= 1) ss += __shfl_xor(ss, o);
                const float rstd = rsqrtf(ss * (1.0f / QLORA) + EPSN);
#pragma unroll
                for (int c = 0; c < 3; ++c) { const float* g = P.mla_q_a_norm + (c * 64 + lane) * 8; const f32x4 g0 = *(const f32x4*)g, g1 = *(const f32x4*)(g + 4); u32x4 w;
                    w.x = pk2(v[c * 8 + 0] * rstd * g0[0], v[c * 8 + 1] * rstd * g0[1]); w.y = pk2(v[c * 8 + 2] * rstd * g0[2], v[c * 8 + 3] * rstd * g0[3]);
                    w.z = pk2(v[c * 8 + 4] * rstd * g1[0], v[c * 8 + 5] * rstd * g1[1]); w.w = pk2(v[c * 8 + 6] * rstd * g1[2], v[c * 8 + 7] * rstd * g1[3]);
                    *(u32x4*)(CQN + (size_t)tok * QLORA + (c * 64 + lane) * 8) = w; }
            }
            {
                float v[8]; float ss = 0.f; const u32x4 w0 = wk[t];
                v[0] = bflo(w0.x); v[1] = bfhi(w0.x); v[2] = bflo(w0.y); v[3] = bfhi(w0.y); v[4] = bflo(w0.z); v[5] = bfhi(w0.z); v[6] = bflo(w0.w); v[7] = bfhi(w0.w);
#pragma unroll
                for (int i = 0; i < 8; ++i) ss += v[i] * v[i];
#pragma unroll
                for (int o = 32; o >= 1; o >>= 1) ss += __shfl_xor(ss, o);
                const float rstd = rsqrtf(ss * (1.0f / KVLORA) + EPSN);
                const float* g = P.mla_kv_a_norm + lane * 8; const f32x4 g0 = *(const f32x4*)g, g1 = *(const f32x4*)(g + 4); u32x4 w;
                w.x = pk2(v[0] * rstd * g0[0], v[1] * rstd * g0[1]); w.y = pk2(v[2] * rstd * g0[2], v[3] * rstd * g0[3]);
                w.z = pk2(v[4] * rstd * g1[0], v[5] * rstd * g1[1]); w.w = pk2(v[6] * rstd * g1[2], v[7] * rstd * g1[3]);
                *(u32x4*)(CKVN + (size_t)tok * KVLORA + lane * 8) = w;
            }
            {
                const int i = lane & 31;
                const float invf = exp2f(-(float)i * (13.287712379549449f / 32.0f));
                const float ang = (float)pos[t] * invf;
                const double rev = (double)ang * 0.15915494309189533576888;
                const float fr = (float)(rev - __builtin_rint(rev));
                const float sn = __builtin_amdgcn_sinf(fr), cs = __builtin_amdgcn_cosf(fr);
                const float x1 = bf1(kp1[t]), x2 = bf1(kp2[t]);
                float ssp = x1 * x1 + x2 * x2;
#pragma unroll
                for (int o = 16; o >= 1; o >>= 1) ssp += __shfl_xor(ssp, o);
                const float a = x1 * P.mla_k_norm[128 + i], c = x2 * P.mla_k_norm[160 + i];
                if (lane < 32) { ROPE[(size_t)tok * 64 + i] = cs; ROPE[(size_t)tok * 64 + 32 + i] = sn;
                    KPER[(size_t)tok * 64 + i] = a * cs - c * sn; KPER[(size_t)tok * 64 + 32 + i] = c * cs + a * sn;
                    if (lane == 0) SSPE[tok] = ssp; }
            }
        }
    }
}

DI void phase_mla_prep2(const Params& P, int bid, int nb) {
    const bf16_t* KNM = (const bf16_t*)(P.ws + OFF_KNM); const bf16_t* Y1 = (const bf16_t*)(P.ws + OFF_Y1);
    bf16_t* KM = (bf16_t*)(P.ws + OFF_KM); const float* ROPE = (const float*)(P.ws + OFF_ROPE);
    const int tid = tid_opaque(), grp = tid >> 3, j8 = tid & 7;
    for (int tok = bid; tok < MTOK; tok += nb) {
        const int b = tok / SEQ, s = tok % SEQ;
        float cs[8], sn[8];
#pragma unroll
        for (int e = 0; e < 8; ++e) { const int i = (8 * j8 + e) & 31; cs[e] = ROPE[(size_t)tok * 64 + i]; sn[e] = ROPE[(size_t)tok * 64 + 32 + i]; }
        {
            const bf16_t* kn = KNM + (size_t)tok * (NH * 128) + grp * 128;
            const bf16_t* kp = Y1 + (size_t)tok * N3P + C3_KPE;
            float v[24];
#pragma unroll
            for (int c = 0; c < 2; ++c) { const u32x4 w = *(const u32x4*)(kn + (j8 + 8 * c) * 8);
                v[c * 8 + 0] = bflo(w.x); v[c * 8 + 1] = bfhi(w.x); v[c * 8 + 2] = bflo(w.y); v[c * 8 + 3] = bfhi(w.y);
                v[c * 8 + 4] = bflo(w.z); v[c * 8 + 5] = bfhi(w.z); v[c * 8 + 6] = bflo(w.w); v[c * 8 + 7] = bfhi(w.w); }
            { const u32x4 w = *(const u32x4*)(kp + j8 * 8);
                v[16] = bflo(w.x); v[17] = bfhi(w.x); v[18] = bflo(w.y); v[19] = bfhi(w.y); v[20] = bflo(w.z); v[21] = bfhi(w.z); v[22] = bflo(w.w); v[23] = bfhi(w.w); }
            float ss = 0.f;
#pragma unroll
            for (int i = 0; i < 24; ++i) ss += v[i] * v[i];
            ss = sum8(ss);
            const float rstd = rsqrtf(ss * (1.0f / DK) + EPSN);
#pragma unroll
            for (int c = 0; c < 3; ++c)
#pragma unroll
                for (int e = 0; e < 8; ++e) v[c * 8 + e] *= rstd * P.mla_k_norm[(j8 + 8 * c) * 8 + e];
#pragma unroll
            for (int e = 0; e < 8; ++e) { const float mine = v[16 + e], other = __shfl_xor(mine, 4);
                v[16 + e] = (j8 < 4) ? (mine * cs[e] - other * sn[e]) : (mine * cs[e] + other * sn[e]); }
            st192(KM + ((size_t)(b * NH + grp) * SEQ + s) * DK, j8, v);
        }
    }
}
#ifndef ATT_THR
#define ATT_THR 30.0f
#endif
#ifndef ATT3_HOIST
#define ATT3_HOIST 1
#endif
#ifndef PROBE3_STORE2
#define PROBE3_STORE2 1
#endif
#ifndef PROBE3_UNITS
#define PROBE3_UNITS 1
#endif
#ifndef PROBE3_CMP
#define PROBE3_CMP 1
#endif
#ifndef PROBE3_SEL
#define PROBE3_SEL 1
#endif
#ifndef PROBE3_WIN
#define PROBE3_WIN 1
#endif
#ifndef ATT3_KD
#define ATT3_KD 4
#endif
#ifndef ATT3_VD
#define ATT3_VD 4
#endif
#ifndef ATT_PS_LIMIT
#define ATT_PS_LIMIT (16.0f * 1073741824.0f)
#endif
constexpr int KT_BYTES = 64 * 384, VT_BYTES = 128 * 128;
constexpr int L_K = 0, L_V = 2 * KT_BYTES, L_LUT = L_V + 2 * VT_BYTES, LUT_PITCH = 129, L_X = L_LUT + 64 * LUT_PITCH * 4 + 16, L_IL = L_X + 16 * 16 * 64 * 2, L_END = L_IL + 16 * 16 * 4;
static_assert(L_END <= 151552, "attention LDS");
enum { MODE_MLA = 0, MODE_SEL = 3, MODE_WIN = 4, MODE_CMPX = 5 };
#define MFMA16(a, b, c) __builtin_amdgcn_mfma_f32_16x16x32_bf16((a), (b), (c), 0, 0, 0)

struct AttnLane3 {
    int tw0, tw1;
    int r16, g;
    const LAS float* lutrow;
    unsigned long long mk0, mk1;
    int curblk;
    int tokbase;
    mutable float carry[2];
};
template <int MODE> DI int tq_of(const AttnLane3& A, int qb) { return (MODE == MODE_MLA) ? A.tw0 + 16 * qb + A.r16 : A.tw0 + qb; }

template <int MODE, int QS>
DI void attn_tile3(const LAS unsigned char* kb, const LAS unsigned char* vb, LAS unsigned char* lds, int j, const bf16x8 (&q)[2][6], f32x4 (&o)[8][2], float (&m_run)[2], float (&l_run)[2], const AttnLane3& A) {
    constexpr bool Q0 = (QS & 1) != 0, Q1 = (QS & 2) != 0;
    const int r16 = A.r16, g = A.g, sw = (r16 >> 1) & 7;
    const int kb0 = r16 * 384 + ((g ^ sw) << 4), kb1 = r16 * 384 + (((g ^ sw) ^ 4) << 4);
    const int vb0 = r16 * 128 + ((g ^ sw) << 4), vb1 = r16 * 128 + (((g ^ sw) ^ 4) << 4);
    f32x4 s[4][2];
    bool zinit = true;
    if (MODE == MODE_WIN || MODE == MODE_SEL) zinit = (A.tw0 - (64 * j + 63) >= 113);
    else if (MODE == MODE_CMPX) zinit = (A.tw0 - 31 - 16 * (64 * j + 63) >= 113);
    if (zinit) {
#pragma unroll
        for (int k4 = 0; k4 < 4; ++k4) { s[k4][0] = (f32x4){0.f, 0.f, 0.f, 0.f}; s[k4][1] = (f32x4){0.f, 0.f, 0.f, 0.f}; }
    } else {
#pragma unroll
        for (int qb = 0; qb < 2; ++qb) { if ((qb == 0 && !Q0) || (qb == 1 && !Q1)) continue;
            const int tq = tq_of<MODE>(A, qb);
#pragma unroll
            for (int k4 = 0; k4 < 4; ++k4)
#pragma unroll
                for (int r = 0; r < 4; ++r) { int d;
                    if (MODE == MODE_CMPX) d = tq - 31 - 16 * (64 * j + 16 * k4 + 4 * g + r); else d = tq - (64 * j + 16 * k4 + 4 * g + r);
                    d = d < 0 ? 0 : (d > 127 ? 127 : d); s[k4][qb][r] = A.lutrow[d] - m_run[qb]; } }
    }
    {
        constexpr int KD = ATT3_KD;
        bf16x8 kf[KD + 1];
#pragma unroll
        for (int i = 0; i < KD; ++i) kf[i] = *(const LAS bf16x8*)(kb + (((i % 6) & 1) ? kb1 : kb0) + ((i % 6) >> 1) * 128 + (i / 6) * (16 * 384));
        __builtin_amdgcn_sched_barrier(0);
#pragma unroll
        for (int i = 0; i < 24; ++i) {
            if (i + KD < 24) { const int n_ = i + KD; kf[n_ % (KD + 1)] = *(const LAS bf16x8*)(kb + (((n_ % 6) & 1) ? kb1 : kb0) + ((n_ % 6) >> 1) * 128 + (n_ / 6) * (16 * 384)); }
            __builtin_amdgcn_sched_barrier(0);
            if (Q0) s[i / 6][0] = MFMA16(kf[i % (KD + 1)], q[0][i % 6], s[i / 6][0]);
            if (Q1) s[i / 6][1] = MFMA16(kf[i % (KD + 1)], q[1][i % 6], s[i / 6][1]);
            __builtin_amdgcn_sched_barrier(0);
        }
    }
    if (zinit && __any(m_run[0] != 0.f || m_run[1] != 0.f)) {
#pragma unroll
        for (int k4 = 0; k4 < 4; ++k4)
#pragma unroll
            for (int r = 0; r < 4; ++r) { s[k4][0][r] -= m_run[0]; s[k4][1][r] -= m_run[1]; }
    }
    {
        const float NEG = -__builtin_inff();
        bool need;
        if (MODE == MODE_MLA) need = (64 * j + 63 > A.tw0);
        else if (MODE == MODE_WIN) need = !(64 * j + 63 <= A.tw0 && 64 * j >= A.tw1 - 511);
        else if (MODE == MODE_SEL) need = (j == A.curblk);
        else need = (A.tw0 - 31 - 16 * (64 * j + 63) < 0);
        if (need) {
#pragma unroll
            for (int qb = 0; qb < 2; ++qb) { if ((qb == 0 && !Q0) || (qb == 1 && !Q1)) continue;
                const int tq = tq_of<MODE>(A, qb);
#pragma unroll
                for (int k4 = 0; k4 < 4; ++k4)
#pragma unroll
                    for (int r = 0; r < 4; ++r) { const int c = 64 * j + 16 * k4 + 4 * g + r; bool kill;
                        if (MODE == MODE_WIN) kill = (unsigned)(tq - c) >= 512u;
                        else if (MODE == MODE_CMPX) kill = (tq - 31 - 16 * c) < 0;
                        else kill = (tq - c) < 0;
                        s[k4][qb][r] = kill ? NEG : s[k4][qb][r]; } }
        }
    }
    u32x4 pw[2][2];
#pragma unroll
    for (int qb = 0; qb < 2; ++qb) { if ((qb == 0 && !Q0) || (qb == 1 && !Q1)) continue;
        if (MODE == MODE_CMPX) {
            float lmx = fmaxf(fmaxf(s[0][qb][0], s[0][qb][1]), fmaxf(s[0][qb][2], s[0][qb][3]));
#pragma unroll
            for (int k4 = 1; k4 < 4; ++k4) lmx = fmaxf(lmx, fmaxf(fmaxf(s[k4][qb][0], s[k4][qb][1]), fmaxf(s[k4][qb][2], s[k4][qb][3])));
            if (__any(lmx > ATT_THR)) {
                float mx = fmaxf(lmx, __shfl_xor(lmx, 16)); mx = fmaxf(mx, __shfl_xor(mx, 32));
                const float dl = fmaxf(mx, 0.f), alpha = __builtin_amdgcn_exp2f(-dl);
                m_run[qb] += dl; l_run[qb] *= alpha; A.carry[qb] *= alpha;
#pragma unroll
                for (int db = 0; db < 8; ++db) o[db][qb] *= alpha;
#pragma unroll
                for (int k4 = 0; k4 < 4; ++k4) s[k4][qb] -= dl;
                LAS bf16_t* X = (LAS bf16_t*)(lds + L_X) + ((A.tokbase + qb) * 16 + r16) * 64;
                for (int a = g; a < 16 * j; a += 4) X[a] = (bf16_t)(pk2(bf1(X[a]) * alpha, 0.f) & 0xffffu);
            }
        }
        float ps = 0.f; f32x4 e[4];
#pragma unroll
        for (int k4 = 0; k4 < 4; ++k4) { e[k4][0] = __builtin_amdgcn_exp2f(s[k4][qb][0]); e[k4][1] = __builtin_amdgcn_exp2f(s[k4][qb][1]); e[k4][2] = __builtin_amdgcn_exp2f(s[k4][qb][2]); e[k4][3] = __builtin_amdgcn_exp2f(s[k4][qb][3]);
            ps += (e[k4][0] + e[k4][1]) + (e[k4][2] + e[k4][3]); }
        if (MODE != MODE_CMPX) {
            if (__any(!(ps <= ATT_PS_LIMIT))) {
                float mx = fmaxf(fmaxf(s[0][qb][0], s[0][qb][1]), fmaxf(s[0][qb][2], s[0][qb][3]));
#pragma unroll
                for (int k4 = 1; k4 < 4; ++k4) mx = fmaxf(mx, fmaxf(fmaxf(s[k4][qb][0], s[k4][qb][1]), fmaxf(s[k4][qb][2], s[k4][qb][3])));
                mx = fmaxf(mx, __shfl_xor(mx, 16)); mx = fmaxf(mx, __shfl_xor(mx, 32));
                const float dl = fmaxf(mx, 0.f), alpha = __builtin_amdgcn_exp2f(-dl);
                m_run[qb] += dl; l_run[qb] *= alpha;
#pragma unroll
                for (int db = 0; db < 8; ++db) o[db][qb] *= alpha;
                ps = 0.f;
#pragma unroll
                for (int k4 = 0; k4 < 4; ++k4) { e[k4][0] = __builtin_amdgcn_exp2f(s[k4][qb][0] - dl); e[k4][1] = __builtin_amdgcn_exp2f(s[k4][qb][1] - dl); e[k4][2] = __builtin_amdgcn_exp2f(s[k4][qb][2] - dl); e[k4][3] = __builtin_amdgcn_exp2f(s[k4][qb][3] - dl);
                    ps += (e[k4][0] + e[k4][1]) + (e[k4][2] + e[k4][3]); }
            }
        } else {
            LAS bf16_t* X = (LAS bf16_t*)(lds + L_X) + ((A.tokbase + qb) * 16 + r16) * 64;
#pragma unroll
            for (int k4 = 0; k4 < 4; ++k4) {
                const float y = __shfl(e[k4][3], (r16 + 16 * g + 48) & 63);
                const float prev = g ? y : A.carry[qb];
                if (g == 0) A.carry[qb] = y;
                X[16 * j + 4 * k4 + g] = (bf16_t)(pk2((e[k4][0] + e[k4][1]) + (e[k4][2] + e[k4][3]) + prev, 0.f) & 0xffffu);
            }
        }
        l_run[qb] += ps;
        pw[0][qb].x = pk2(e[0][0], e[0][1]); pw[0][qb].y = pk2(e[0][2], e[0][3]); pw[0][qb].z = pk2(e[1][0], e[1][1]); pw[0][qb].w = pk2(e[1][2], e[1][3]);
        pw[1][qb].x = pk2(e[2][0], e[2][1]); pw[1][qb].y = pk2(e[2][2], e[2][3]); pw[1][qb].z = pk2(e[3][0], e[3][1]); pw[1][qb].w = pk2(e[3][2], e[3][3]);
    }
    {
        constexpr int VD = ATT3_VD;
        bf16x8 vf[VD + 1];
#pragma unroll
        for (int i = 0; i < VD; ++i) vf[i] = *(const LAS bf16x8*)(vb + ((i >> 3) ? vb1 : vb0) + (i & 7) * (16 * 128));
        __builtin_amdgcn_sched_barrier(0);
#pragma unroll
        for (int i = 0; i < 16; ++i) {
            if (i + VD < 16) { const int n_ = i + VD; vf[n_ % (VD + 1)] = *(const LAS bf16x8*)(vb + ((n_ >> 3) ? vb1 : vb0) + (n_ & 7) * (16 * 128)); }
            __builtin_amdgcn_sched_barrier(0);
            if (Q0) o[i & 7][0] = MFMA16(vf[i % (VD + 1)], __builtin_bit_cast(bf16x8, pw[i >> 3][0]), o[i & 7][0]);
            if (Q1) o[i & 7][1] = MFMA16(vf[i % (VD + 1)], __builtin_bit_cast(bf16x8, pw[i >> 3][1]), o[i & 7][1]);
            __builtin_amdgcn_sched_barrier(0);
        }
    }
}

DI void attn_issue_first(LAS unsigned char* lds, const char* __restrict__ Kc, const char* __restrict__ Vc, int vt_stride, int j) {
    int tid = threadIdx.x; asm volatile("" : "+v"(tid));
    const int lane = tid & 63;
    const int wid_ = __builtin_amdgcn_readfirstlane(tid >> 6);
    const char* kp_ = Kc + (size_t)j * KT_BYTES; LAS unsigned char* kb_ = lds + L_K + wid_ * 3072;
#pragma unroll
    for (int i_ = 0; i_ < 3; ++i_) { const int pidx_ = (wid_ * 3 + i_) * 64 + lane, row_ = pidx_ / 24, cp_ = pidx_ % 24;
        __builtin_amdgcn_global_load_lds((const unsigned*)(kp_ + (unsigned)(row_ * 384 + ((cp_ ^ ((row_ >> 1) & 7)) << 4))), (LAS unsigned*)(kb_ + i_ * 1024), 16, 0, 0); }
    const char* vp_ = Vc + (size_t)j * 128; LAS unsigned char* vb_ = lds + L_V + wid_ * 2048;
#pragma unroll
    for (int i_ = 0; i_ < 2; ++i_) { const int pidx_ = (wid_ * 2 + i_) * 64 + lane, row_ = pidx_ >> 3, cp_ = pidx_ & 7;
        __builtin_amdgcn_global_load_lds((const unsigned*)(vp_ + (unsigned)(row_ * vt_stride * 2 + ((cp_ ^ ((row_ >> 1) & 7)) << 4))), (LAS unsigned*)(vb_ + i_ * 1024), 16, 0, 0); }
}

template <int MODE>
DI void attn_pass3x(LAS unsigned char* lds, const char* __restrict__ Kc, const char* __restrict__ Vc, int vt_stride, int j_lo, int j_hi,
                    const bf16x8 (&q)[2][6], f32x4 (&o)[8][2], float (&m_run)[2], float (&l_run)[2], const AttnLane3& A, bool first_issued = false) {
    if (j_lo >= j_hi) return;
    int tid = threadIdx.x; asm volatile("" : "+v"(tid));
    const int lane = tid & 63;
    const int wid_ = __builtin_amdgcn_readfirstlane(tid >> 6);
    unsigned kgo[3], vgo[2];
#pragma unroll
    for (int i_ = 0; i_ < 3; ++i_) { const int pidx_ = (wid_ * 3 + i_) * 64 + lane, row_ = pidx_ / 24, cp_ = pidx_ % 24; kgo[i_] = (unsigned)(row_ * 384 + ((cp_ ^ ((row_ >> 1) & 7)) << 4)); }
#pragma unroll
    for (int i_ = 0; i_ < 2; ++i_) { const int pidx_ = (wid_ * 2 + i_) * 64 + lane, row_ = pidx_ >> 3, cp_ = pidx_ & 7; vgo[i_] = (unsigned)(row_ * vt_stride * 2 + ((cp_ ^ ((row_ >> 1) & 7)) << 4)); }
#define ST_ISSUE(j, buf) do { const char* kp_ = Kc + (size_t)(j) * KT_BYTES; LAS unsigned char* kb_ = lds + L_K + (buf) * KT_BYTES + wid_ * 3072; \
        _Pragma("unroll") for (int i_ = 0; i_ < 3; ++i_) __builtin_amdgcn_global_load_lds((const unsigned*)(kp_ + kgo[i_]), (LAS unsigned*)(kb_ + i_ * 1024), 16, 0, 0); \
        const char* vp_ = Vc + (size_t)(j) * 128; LAS unsigned char* vb_ = lds + L_V + (buf) * VT_BYTES + wid_ * 2048; \
        _Pragma("unroll") for (int i_ = 0; i_ < 2; ++i_) __builtin_amdgcn_global_load_lds((const unsigned*)(vp_ + vgo[i_]), (LAS unsigned*)(vb_ + i_ * 1024), 16, 0, 0); } while (0)
    if (!first_issued) ST_ISSUE(j_lo, 0);
    asm volatile("s_waitcnt vmcnt(0)" ::: "memory");
    __syncthreads();
    for (int j = j_lo; j < j_hi; ++j) {
        const int cur = (j - j_lo) & 1;
        if (j + 1 < j_hi) ST_ISSUE(j + 1, cur ^ 1);
        const LAS unsigned char* kbp = lds + L_K + cur * KT_BYTES; const LAS unsigned char* vbp = lds + L_V + cur * VT_BYTES;
        if (MODE == MODE_SEL) {
            const bool a0 = ((A.mk0 >> j) & 1ull) != 0ull, a1 = ((A.mk1 >> j) & 1ull) != 0ull;
            if (a0 && a1) attn_tile3<MODE, 3>(kbp, vbp, lds, j, q, o, m_run, l_run, A);
            else if (a0) attn_tile3<MODE, 1>(kbp, vbp, lds, j, q, o, m_run, l_run, A);
            else if (a1) attn_tile3<MODE, 2>(kbp, vbp, lds, j, q, o, m_run, l_run, A);
        } else {
            bool act;
            if (MODE == MODE_MLA) act = 64 * j <= A.tw1;
            else if (MODE == MODE_CMPX) act = 1024 * j + 31 <= A.tw1;
            else act = (64 * j <= A.tw1) && (64 * j + 63 >= A.tw0 - 511);
            if (act) attn_tile3<MODE, 3>(kbp, vbp, lds, j, q, o, m_run, l_run, A);
        }
        asm volatile("s_waitcnt vmcnt(0)" ::: "memory");
        __syncthreads();
    }
#undef ST_ISSUE
}

DI int t5_bucket(int n) {
    if (n < 16) return n;
    return 16 + (n >= 19) + (n >= 21) + (n >= 24) + (n >= 27) + (n >= 31) + (n >= 35) + (n >= 40) + (n >= 46) + (n >= 52) + (n >= 59) + (n >= 67) + (n >= 77) + (n >= 87) + (n >= 99) + (n >= 113);
}
DI float silu_f(float z) { return z * __builtin_amdgcn_rcpf(1.0f + __builtin_amdgcn_exp2f(-1.4426950408889634f * z)); }

constexpr int EPI_PITCH = 272, EPI_WAVE_BYTES = 32 * EPI_PITCH;
template <bool RMW, bool NSA>
DI void attn_epilogue3(LAS unsigned char* lds, int lane, int wid, const f32x4 (&o)[8][2], float scale0, float scale1,
                       const char* __restrict__ zbase, unsigned z0, char* __restrict__ obase, unsigned o0, bool dostore = true) {
    LAS unsigned char* sc = lds + wid * EPI_WAVE_BYTES;
    const int r16 = lane & 15, g = lane >> 4;
#pragma unroll
    for (int h = 0; h < 2; ++h) {
#pragma unroll
        for (int d4 = 0; d4 < 4; ++d4) {
            *(LAS f32x4*)(sc + r16 * EPI_PITCH + (16 * d4 + 4 * g) * 4) = o[4 * h + d4][0] * scale0;
            *(LAS f32x4*)(sc + (16 + r16) * EPI_PITCH + (16 * d4 + 4 * g) * 4) = o[4 * h + d4][1] * scale1;
        }
        asm volatile("" ::: "memory");
#pragma unroll
        for (int i = 0; i < 4; ++i) {
            const int rr = 8 * i + (lane >> 3), c8 = lane & 7;
            const f32x4 a = *(const LAS f32x4*)(sc + rr * EPI_PITCH + c8 * 32);
            const f32x4 b = *(const LAS f32x4*)(sc + rr * EPI_PITCH + c8 * 32 + 16);
            unsigned zoff, ooff;
            if (NSA) { zoff = z0 + (unsigned)((rr >> 4) * (N1P * 2) + (rr & 15) * 256); ooff = o0 + (unsigned)((rr >> 4) * (ZW8 * 2) + (rr & 15) * 256); }
            else     { zoff = z0 + (unsigned)(rr * (N3P * 2)); ooff = o0 + (unsigned)(rr * (ZW8 * 2)); }
            const unsigned cb = (unsigned)((64 * h + 8 * c8) * 2);
            if (!dostore) continue;
            const u32x4 zw = *(const u32x4*)(zbase + (zoff + cb));
            float v0 = a[0] * silu_f(bflo(zw.x)), v1 = a[1] * silu_f(bfhi(zw.x)), v2 = a[2] * silu_f(bflo(zw.y)), v3 = a[3] * silu_f(bfhi(zw.y));
            float v4 = b[0] * silu_f(bflo(zw.z)), v5 = b[1] * silu_f(bfhi(zw.z)), v6 = b[2] * silu_f(bflo(zw.w)), v7 = b[3] * silu_f(bfhi(zw.w));
            if (RMW) { const u32x4 pv = *(const u32x4*)(obase + (ooff + cb));
                v0 += bflo(pv.x); v1 += bfhi(pv.x); v2 += bflo(pv.y); v3 += bfhi(pv.y); v4 += bflo(pv.z); v5 += bfhi(pv.z); v6 += bflo(pv.w); v7 += bfhi(pv.w); }
            u32x4 w; w.x = pk2(v0, v1); w.y = pk2(v2, v3); w.z = pk2(v4, v5); w.w = pk2(v6, v7);
            *(u32x4*)(obase + (ooff + cb)) = w;
        }
        asm volatile("" ::: "memory");
    }
}
DI float sum_g(float v) { v += __shfl_xor(v, 16); v += __shfl_xor(v, 32); return v; }

DI void phase_nsa_attn(LAS unsigned char* lds, const Params& P, int bid, int nb) {
    const char* Y0c = (const char*)(P.ws + OFF_Y0);
    const char* KSc = (const char*)(P.ws + OFF_KS); const char* KWc = (const char*)(P.ws + OFF_KW);
    const char* VTSc = (const char*)(P.ws + OFF_VTS); const char* VTWc = (const char*)(P.ws + OFF_VTW);
    const char* KCc = (const char*)(P.ws + OFF_KC); const char* VTCc = (const char*)(P.ws + OFF_VTC);
    char* ONc = (char*)(P.ws + OFF_O);
    LAS float* lut = (LAS float*)(lds + L_LUT);
    const int total = BATCH * NG * 256;
    {
        const int tid0 = tid_opaque();
        __syncthreads();
        for (int i = tid0; i < 64 * 128; i += 512) { const int hd = i >> 7, d = i & 127; lut[hd * LUT_PITCH + d] = (P.rel_bias[t5_bucket(d) * NH + hd] - P.rel_bias[31 * NH + hd]) * LOG2E; }
        __syncthreads();
    }
    for (int u_ = bid; u_ < total * PROBE3_UNITS; u_ += nb) {
        const int u = (u_ >= total) ? u_ - total : u_;
        int tid = threadIdx.x; asm volatile("" : "+v"(tid));
        const int lane = tid & 63, wid = __builtin_amdgcn_readfirstlane(tid >> 6);
        const int pair = u >> 8; int c = u & 255; if (pair & 1) c = 255 - c;
        const int b = pair >> 2, gg = pair & 3, t0 = c * 16;
        __syncthreads();
        AttnLane3 A;
        A.r16 = lane & 15; A.g = lane >> 4;
        A.tw0 = t0 + 2 * wid; A.tw1 = A.tw0 + 1;
        const int hh = gg * NR + A.r16;
        A.lutrow = lut + hh * LUT_PITCH;
        A.curblk = t0 >> 6; A.tokbase = 2 * wid; A.mk0 = 0ull; A.mk1 = 0ull; A.carry[0] = 0.f; A.carry[1] = 0.f;
        const unsigned ytok0 = (unsigned)(b * SEQ + A.tw0) * (unsigned)(N1P * 2);
        const unsigned otok0 = ((unsigned)(b * SEQ + A.tw0) * (unsigned)ZW8 + (unsigned)(gg * NR * DV)) * 2u;
        const int bg = b * NG + gg;
        const int nct = (t0 + 15 >= 31) ? (((t0 + 15 - 31) >> 4) / 64 + 1) : 0;
        if (ATT3_HOIST && nct > 0) attn_issue_first(lds, KCc + (size_t)bg * 256 * DK * 2, VTCc + (size_t)bg * DV * 256 * 2, 256, 0);
        bf16x8 q[2][6];
#pragma unroll
        for (int qb = 0; qb < 2; ++qb) {
            const unsigned qo = ytok0 + (unsigned)(qb * (N1P * 2)) + (unsigned)((C_Q + hh * DK + 8 * A.g) * 2);
            float ss = 0.f;
#pragma unroll
            for (int ds = 0; ds < 6; ++ds) { q[qb][ds] = *(const bf16x8*)(Y0c + (qo + 64u * ds));
                const u32x4 w = __builtin_bit_cast(u32x4, q[qb][ds]);
                const float a0 = bflo(w.x), a1 = bfhi(w.x), a2 = bflo(w.y), a3 = bfhi(w.y), a4 = bflo(w.z), a5 = bfhi(w.z), a6 = bflo(w.w), a7 = bfhi(w.w);
                ss += (a0 * a0 + a1 * a1) + (a2 * a2 + a3 * a3) + (a4 * a4 + a5 * a5) + (a6 * a6 + a7 * a7); }
            ss = sum_g(ss);
            const float rstd = rsqrtf(ss * (1.0f / DK) + EPSN) * QSCALE;
#pragma unroll
            for (int ds = 0; ds < 6; ++ds) { const float* gn = P.nsa_q_norm + 32 * ds + 8 * A.g; const f32x4 g0 = *(const f32x4*)gn, g1 = *(const f32x4*)(gn + 4);
                u32x4 w = __builtin_bit_cast(u32x4, q[qb][ds]);
                w.x = pk2(bflo(w.x) * rstd * g0[0], bfhi(w.x) * rstd * g0[1]); w.y = pk2(bflo(w.y) * rstd * g0[2], bfhi(w.y) * rstd * g0[3]);
                w.z = pk2(bflo(w.z) * rstd * g1[0], bfhi(w.z) * rstd * g1[1]); w.w = pk2(bflo(w.w) * rstd * g1[2], bfhi(w.w) * rstd * g1[3]);
                q[qb][ds] = __builtin_bit_cast(bf16x8, w); }
        }
        f32x4 o[8][2]; float m_run[2], l_run[2];
#define RESET_STATE() do { _Pragma("unroll") for (int d_ = 0; d_ < 8; ++d_) { o[d_][0] = (f32x4){0.f, 0.f, 0.f, 0.f}; o[d_][1] = (f32x4){0.f, 0.f, 0.f, 0.f}; } m_run[0] = 0.f; m_run[1] = 0.f; l_run[0] = 0.f; l_run[1] = 0.f; } while (0)
#define GATE_SIG(x, qb) (1.0f / (1.0f + __expf(-bf1(*(const bf16_t*)(Y0c + (ytok0 + (unsigned)((qb) * (N1P * 2)) + (unsigned)((C_G + (x) * NH + hh) * 2)))))))
        RESET_STATE();
        attn_pass3x<MODE_CMPX>(lds, KCc + (size_t)bg * 256 * DK * 2, VTCc + (size_t)bg * DV * 256 * 2, 256, 0, nct, q, o, m_run, l_run, A, ATT3_HOIST != 0);
        { const float lt0 = sum_g(l_run[0]), lt1 = sum_g(l_run[1]); const float il0 = lt0 > 0.f ? 1.0f / lt0 : 0.f, il1 = lt1 > 0.f ? 1.0f / lt1 : 0.f;
          if (lane < 16) { ((LAS float*)(lds + L_IL))[(A.tokbase + 0) * 16 + A.r16] = il0; ((LAS float*)(lds + L_IL))[(A.tokbase + 1) * 16 + A.r16] = il1; }
          attn_epilogue3<false, true>(lds, lane, wid, o, GATE_SIG(0, 0) * il0, GATE_SIG(0, 1) * il1, Y0c, ytok0 + (unsigned)((C_ZC + gg * NR * DV) * 2), ONc, otok0, PROBE3_STORE2 || u_ < total); }
        __syncthreads();
        if (ATT3_HOIST) attn_issue_first(lds, KSc + (size_t)bg * SEQ * DK * 2, VTSc + (size_t)bg * DV * SEQ * 2, SEQ, 0);
        {
            const int cur = A.curblk;
            unsigned long long mk[2];
#pragma unroll
            for (int t = 0; t < 2; ++t) {
                const LAS bf16_t* X = (const LAS bf16_t*)(lds + L_X) + (2 * wid + t) * 16 * 64;
                const LAS float* IL = (const LAS float*)(lds + L_IL) + (2 * wid + t) * 16;
                const bool forced = (lane == 0) || (lane == cur) || (lane == cur - 1);
                const bool future = lane > cur;
                float v = 0.f;
                if (!forced && !future) {
#pragma unroll
                    for (int rr = 0; rr < 16; ++rr) v += IL[rr] * bf1(X[rr * 64 + lane]); }
                unsigned key = (__float_as_uint(v) & ~63u);
                if (forced) key = 0x7f800000u; else if (future) key = 0u;
                key |= (unsigned)(63 - lane);
                int rank = 0;
#pragma unroll
                for (int jp = 0; jp < 64; ++jp) { const unsigned kj = (unsigned)__builtin_amdgcn_readlane((int)key, jp); rank += (kj > key) ? 1 : 0; }
                mk[t] = __ballot(rank < 16 && !future);
            }
            A.mk0 = mk[0]; A.mk1 = mk[1];
        }
        RESET_STATE();
        attn_pass3x<MODE_SEL>(lds, KSc + (size_t)bg * SEQ * DK * 2, VTSc + (size_t)bg * DV * SEQ * 2, SEQ, 0, A.curblk + 1, q, o, m_run, l_run, A, ATT3_HOIST != 0);
        { const float lt0 = sum_g(l_run[0]), lt1 = sum_g(l_run[1]);
          attn_epilogue3<true, true>(lds, lane, wid, o, GATE_SIG(1, 0) / lt0, GATE_SIG(1, 1) / lt1, Y0c, ytok0 + (unsigned)((C_ZS + gg * NR * DV) * 2), ONc, otok0, PROBE3_STORE2 || u_ < total); }
        __syncthreads();
        RESET_STATE();
        { const int jl = (t0 - 511) > 0 ? (t0 - 511) >> 6 : 0, jh = ((t0 + 15) >> 6) + 1;
          for (int prb_ = 0; prb_ < PROBE3_WIN; ++prb_) attn_pass3x<MODE_WIN>(lds, KWc + (size_t)bg * SEQ * DK * 2, VTWc + (size_t)bg * DV * SEQ * 2, SEQ, jl, jh, q, o, m_run, l_run, A); }
        { const float lt0 = sum_g(l_run[0]), lt1 = sum_g(l_run[1]);
          attn_epilogue3<true, true>(lds, lane, wid, o, GATE_SIG(2, 0) / lt0, GATE_SIG(2, 1) / lt1, Y0c, ytok0 + (unsigned)((C_ZW + gg * NR * DV) * 2), ONc, otok0, PROBE3_STORE2 || u_ < total); }
#undef RESET_STATE
#undef GATE_SIG
    }
}

DI void phase_mla_attn(LAS unsigned char* lds, const Params& P, int bid, int nb) {
    const char* QMc = (const char*)(P.ws + OFF_QM); const char* KMc = (const char*)(P.ws + OFF_KM); const char* VTMc = (const char*)(P.ws + OFF_VTM);
    const char* Y1c = (const char*)(P.ws + OFF_Y1); char* OMc = (char*)(P.ws + OFF_O);
    const int total = BATCH * NH * 16;
    for (int uu = 0; bid + (uu >> 1) * nb < total / 2; ++uu) {
        int tid = threadIdx.x; asm volatile("" : "+v"(tid));
        const int lane = tid & 63, wid = __builtin_amdgcn_readfirstlane(tid >> 6);
        const int item = bid + (uu >> 1) * nb, second = uu & 1;
        const int xcd = item & 7, tt = item >> 3, p = tt & 7, hl = (tt >> 3) & 3, rnd = tt >> 5;
        const int bh = rnd * 32 + xcd * 4 + hl, qblk = second ? p : 15 - p, b = bh >> 6, h = bh & 63, t0 = qblk * 256;
        AttnLane3 A;
        A.r16 = lane & 15; A.g = lane >> 4;
        A.tw0 = t0 + 32 * wid; A.tw1 = A.tw0 + 31;
        A.lutrow = nullptr; A.curblk = 0; A.tokbase = 0; A.mk0 = 0ull; A.mk1 = 0ull; A.carry[0] = 0.f; A.carry[1] = 0.f;
        bf16x8 q[2][6];
#pragma unroll
        for (int qb = 0; qb < 2; ++qb) {
            const unsigned trow = (unsigned)(b * SEQ + A.tw0 + 16 * qb + A.r16);
            const unsigned qo = (trow * (unsigned)NQB + (unsigned)(h * DK + 8 * A.g)) * 2u;
            float ss = 0.f;
#pragma unroll
            for (int ds = 0; ds < 6; ++ds) { q[qb][ds] = *(const bf16x8*)(QMc + (qo + 64u * ds));
                const u32x4 w = __builtin_bit_cast(u32x4, q[qb][ds]);
                const float a0 = bflo(w.x), a1 = bfhi(w.x), a2 = bflo(w.y), a3 = bfhi(w.y), a4 = bflo(w.z), a5 = bfhi(w.z), a6 = bflo(w.w), a7 = bfhi(w.w);
                ss += (a0 * a0 + a1 * a1) + (a2 * a2 + a3 * a3) + (a4 * a4 + a5 * a5) + (a6 * a6 + a7 * a7); }
            ss = sum_g(ss);
            const float rstd = rsqrtf(ss * (1.0f / DK) + EPSN);
            const float* ropep = (const float*)(P.ws + OFF_ROPE) + (size_t)trow * 64;
#pragma unroll
            for (int ds = 0; ds < 4; ++ds) { const float* gn = P.mla_q_norm + 32 * ds + 8 * A.g; const f32x4 g0 = *(const f32x4*)gn, g1 = *(const f32x4*)(gn + 4);
                const float sc = rstd * QSCALE;
                u32x4 w = __builtin_bit_cast(u32x4, q[qb][ds]);
                w.x = pk2(bflo(w.x) * sc * g0[0], bfhi(w.x) * sc * g0[1]); w.y = pk2(bflo(w.y) * sc * g0[2], bfhi(w.y) * sc * g0[3]);
                w.z = pk2(bflo(w.z) * sc * g1[0], bfhi(w.z) * sc * g1[1]); w.w = pk2(bflo(w.w) * sc * g1[2], bfhi(w.w) * sc * g1[3]);
                q[qb][ds] = __builtin_bit_cast(bf16x8, w); }
            {
                const int i0 = 8 * A.g;
                const float* g1p = P.mla_q_norm + 128 + i0; const float* g2p = P.mla_q_norm + 160 + i0;
                const u32x4 w1 = __builtin_bit_cast(u32x4, q[qb][4]), w2 = __builtin_bit_cast(u32x4, q[qb][5]);
                float x1[8] = {bflo(w1.x), bfhi(w1.x), bflo(w1.y), bfhi(w1.y), bflo(w1.z), bfhi(w1.z), bflo(w1.w), bfhi(w1.w)};
                float x2[8] = {bflo(w2.x), bfhi(w2.x), bflo(w2.y), bfhi(w2.y), bflo(w2.z), bfhi(w2.z), bflo(w2.w), bfhi(w2.w)};
                float y1[8], y2[8];
#pragma unroll
                for (int e = 0; e < 8; ++e) { const float cs = ropep[i0 + e], sn = ropep[32 + i0 + e];
                    const float a = x1[e] * rstd * g1p[e], c = x2[e] * rstd * g2p[e];
                    y1[e] = (a * cs - c * sn) * QSCALE; y2[e] = (c * cs + a * sn) * QSCALE; }
                u32x4 o1, o2;
                o1.x = pk2(y1[0], y1[1]); o1.y = pk2(y1[2], y1[3]); o1.z = pk2(y1[4], y1[5]); o1.w = pk2(y1[6], y1[7]);
                o2.x = pk2(y2[0], y2[1]); o2.y = pk2(y2[2], y2[3]); o2.z = pk2(y2[4], y2[5]); o2.w = pk2(y2[6], y2[7]);
                q[qb][4] = __builtin_bit_cast(bf16x8, o1); q[qb][5] = __builtin_bit_cast(bf16x8, o2);
            }
        }
        f32x4 o[8][2]; float m_run[2] = {0.f, 0.f}, l_run[2] = {0.f, 0.f};
#pragma unroll
        for (int d = 0; d < 8; ++d) { o[d][0] = (f32x4){0.f, 0.f, 0.f, 0.f}; o[d][1] = (f32x4){0.f, 0.f, 0.f, 0.f}; }
        attn_pass3x<MODE_MLA>(lds, KMc + (size_t)bh * SEQ * DK * 2, VTMc + (size_t)bh * DV * SEQ * 2, SEQ, 0, 4 * qblk + 4, q, o, m_run, l_run, A);
        const float lt0 = sum_g(l_run[0]), lt1 = sum_g(l_run[1]);
        { const unsigned t0w = (unsigned)(b * SEQ + A.tw0);
          attn_epilogue3<false, false>(lds, lane, wid, o, 1.0f / lt0, 1.0f / lt1, Y1c, (t0w * (unsigned)N3P + (unsigned)(C3_Z + h * DV)) * 2u, OMc, (t0w * (unsigned)ZW8 + (unsigned)(h * DV)) * 2u); }
        __syncthreads();
    }
}
constexpr int LDS_KN_OFF = 135168, LDS_ST_OFF = LDS_KN_OFF + 16384, LDS_BYTES = LDS_ST_OFF + 16;
constexpr int NPHASE = 14;

#ifndef USE_FP8Z
#define USE_FP8Z 0
#endif
#ifndef DUP5
#define DUP5 0
#endif
#ifndef P3_GEMM_REP
#define P3_GEMM_REP 1
#endif
#ifndef P3_WCONV_REP
#define P3_WCONV_REP 1
#endif
template <int PH>
DI void run_phase(const Params& P, LAS unsigned char* lds, int bid, int nb) {
    unsigned char* ws = P.ws;
    if constexpr (PH == 0) {
        phase_wconv(lds, P.nsa_w_in, (bf16_t*)(ws + OFF_W1T), DM, N1, N1P, bid, nb, (FP8EMU & 4) ? 64.0f : 0.f, 0, USE_FP8Z ? (unsigned char*)(ws + OFF_B8) : nullptr, C_ZC);
        phase_wconv(lds, P.w1_k, (bf16_t*)(ws + OFF_W1K), 6144, 192, 256, bid, nb);
        phase_wconv(lds, P.w1_v, (bf16_t*)(ws + OFF_W1V), 4096, 128, 256, bid, nb);
        phase_rmsnorm(P.x, P.norm_w, (bf16_t*)(ws + OFF_H), bid, nb, (FP8EMU & 4) ? 16.0f : 0.f, USE_FP8Z ? (unsigned char*)(ws + OFF_A8) : nullptr);
    } else if constexpr (PH == 1) {
        if (USE_FP8Z) {
            {
                pg8::Gemm g{(const bf16_t*)(ws + OFF_H), (const bf16_t*)(ws + OFF_W1T), MTOK, N1P, DM};
                pg8::OrderBf16Part S{nb, bid};
                pg8::EpiStoreBf16 E{(bf16_t*)(ws + OFF_Y0), N1P};
                pg8::gemm_phase<pg8::EpiStoreBf16, pg8::OrderBf16Part, false>(lds, g, S, E, nullptr);
            }
            __syncthreads();
            {
                pg8::Gemm g{(const bf16_t*)(ws + OFF_A8), (const bf16_t*)(ws + OFF_B8), MTOK, NZ8, DM / 2};
                pg8::OrderFp8Part S{nb, bid};
                pg8::EpiStoreBf16Fp8 E{(bf16_t*)(ws + OFF_Y0) + C_ZC, N1P, 1.0f / (16.0f * 64.0f)};
                pg8::gemm_phase<pg8::EpiStoreBf16Fp8, pg8::OrderFp8Part, false>(lds, g, S, E, nullptr);
            }
        } else {
        pg8::Gemm g{(const bf16_t*)(ws + OFF_H), (const bf16_t*)(ws + OFF_W1T), MTOK, N1P, DM};
        pg8::StaticOrder S; S.init(g.M, g.N, nb, bid);
        pg8::EpiStoreBf16 E{(bf16_t*)(ws + OFF_Y0), N1P};
        pg8::gemm_phase<pg8::EpiStoreBf16, pg8::StaticOrder, false>(lds, g, S, E, nullptr);
        }
    } else if constexpr (PH == 2) {
        phase_nsa_prep(P, bid, nb);
        phase_vt(lds, (const bf16_t*)(ws + OFF_Y0), N1P, C_KVS + NG * DK, DV, NG, (bf16_t*)(ws + OFF_VTS), bid, nb);
        phase_vt(lds, (const bf16_t*)(ws + OFF_Y0), N1P, C_KVW + NG * DK, DV, NG, (bf16_t*)(ws + OFF_VTW), bid, nb);
    } else if constexpr (PH == 3) {
        for (int p3g_ = 0; p3g_ < ((bid < 32) ? P3_GEMM_REP : P3_WCONV_REP); ++p3g_) { if (p3g_) __syncthreads();
        if (bid < 16) {
            pg8::Gemm g{(const bf16_t*)(ws + OFF_ACK), (const bf16_t*)(ws + OFF_W1K), 4096, 256, 6144};
            pg8::StaticOrder S; S.init(g.M, g.N, 16, bid);
            pg8::EpiPlainF32 E{(float*)(ws + OFF_HIDK), 256};
            pg8::gemm_phase<pg8::EpiPlainF32, pg8::StaticOrder, false>(lds, g, S, E, nullptr);
        } else if (bid < 32) {
            pg8::Gemm g{(const bf16_t*)(ws + OFF_ACV), (const bf16_t*)(ws + OFF_W1V), 4096, 256, 4096};
            pg8::StaticOrder S; S.init(g.M, g.N, 16, bid - 16);
            pg8::EpiPlainF32 E{(float*)(ws + OFF_HIDV), 256};
            pg8::gemm_phase<pg8::EpiPlainF32, pg8::StaticOrder, false>(lds, g, S, E, nullptr);
        } else {
            phase_wconv(lds, P.nsa_w_out, (bf16_t*)(ws + OFF_W2T), ZW8, DM, DM, bid - 32, nb - 32, (FP8EMU & 1) ? 64.0f : 0.f);
            phase_wconv(lds, P.mla_w_in, (bf16_t*)(ws + OFF_W3T), DM, N3, N3P, bid - 32, nb - 32, (FP8EMU & 8) ? 64.0f : 0.f);
        }
        }
    } else if constexpr (PH == 4) {
        phase_cmp2(lds, P, bid, nb);
    } else if constexpr (PH == 5) {
        { float* ss1 = (float*)(ws + OFF_SS1); for (int i = bid * 512 + (int)threadIdx.x; i < MTOK; i += nb * 512) ss1[i] = 0.f; }
        phase_nsa_attn(lds, P, bid, nb);
    } else if constexpr (PH == 6) {
        pg8::Gemm g{(const bf16_t*)(ws + OFF_O), (const bf16_t*)(ws + OFF_W2T), MTOK, DM, ZW8};
        pg8::StaticOrder S; S.init(g.M, g.N, nb, bid);
        pg8::EpiResNorm E{P.x, P.out, DM, P.norm_w + DM, (bf16_t*)(ws + OFF_H), (float*)(ws + OFF_SS1)};
        pg8::gemm_phase<pg8::EpiResNorm, pg8::StaticOrder, false>(lds, g, S, E, nullptr);
    } else if constexpr (PH == 7) {
        phase_rmsnorm(P.out, P.norm_w + DM, (bf16_t*)(ws + OFF_H), bid, nb, (FP8EMU & 8) ? 16.0f : 0.f);
    } else if constexpr (PH == 8) {
        pg8::Gemm g{(const bf16_t*)(ws + OFF_H), (const bf16_t*)(ws + OFF_W3T), MTOK, N3P, DM};
        pg8::StaticOrder S; S.init(g.M, g.N, nb, bid);
        pg8::EpiStoreBf16RowScale E{(bf16_t*)(ws + OFF_Y1), N3P, (const float*)(ws + OFF_SS1), 1.0f / DM};
        pg8::gemm_phase<pg8::EpiStoreBf16RowScale, pg8::StaticOrder, false>(lds, g, S, E, nullptr);
        __syncthreads();
        if (bid >= 64 && nb > 64) {
            phase_wconv(lds, P.mla_w_q_b, (bf16_t*)(ws + OFF_W4T), QLORA, NQB, NQB, bid - 64, nb - 64);
            phase_wconv(lds, P.mla_w_kv_b, (bf16_t*)(ws + OFF_W5K), KVLORA, NKVB / 2, NKVB / 2, bid - 64, nb - 64, 0.f, 2);
            phase_wconv(lds, P.mla_w_kv_b, (bf16_t*)(ws + OFF_W5V), KVLORA, NKVB / 2, NKVB / 2, bid - 64, nb - 64, 0.f, 1);
            phase_wconv(lds, P.mla_w_out, (bf16_t*)(ws + OFF_W6T), ZW8, DM, DM, bid - 64, nb - 64, (FP8EMU & 2) ? 64.0f : 0.f);
        } else if (nb <= 64) {
            phase_wconv(lds, P.mla_w_q_b, (bf16_t*)(ws + OFF_W4T), QLORA, NQB, NQB, bid, nb);
            phase_wconv(lds, P.mla_w_kv_b, (bf16_t*)(ws + OFF_W5K), KVLORA, NKVB / 2, NKVB / 2, bid, nb, 0.f, 2);
            phase_wconv(lds, P.mla_w_kv_b, (bf16_t*)(ws + OFF_W5V), KVLORA, NKVB / 2, NKVB / 2, bid, nb, 0.f, 1);
            phase_wconv(lds, P.mla_w_out, (bf16_t*)(ws + OFF_W6T), ZW8, DM, DM, bid, nb, (FP8EMU & 2) ? 64.0f : 0.f);
        }
    } else if constexpr (PH == 9) {
        phase_mla_prep1(P, bid, nb);
    } else if constexpr (PH == 10) {
        {
            pg8::Gemm g{(const bf16_t*)(ws + OFF_CQN), (const bf16_t*)(ws + OFF_W4T), MTOK, NQB, QLORA};
            pg8::StaticOrder S; S.init(g.M, g.N, nb, bid);
            pg8::EpiStoreBf16 E{(bf16_t*)(ws + OFF_QM), NQB};
            pg8::gemm_phase<pg8::EpiStoreBf16, pg8::StaticOrder, false>(lds, g, S, E, nullptr);
        }
        __syncthreads();
        {
            pg8::Gemm g{(const bf16_t*)(ws + OFF_CKVN), (const bf16_t*)(ws + OFF_W5K), MTOK, NKVB / 2, KVLORA};
            pg8::StaticOrder S; S.init(g.M, g.N, nb, bid);
            pg8::EpiKNorm E{(bf16_t*)(ws + OFF_KM), (const float*)(ws + OFF_SSPE), (const float*)(ws + OFF_KPER), P.mla_k_norm, (LAS float*)(lds + LDS_KN_OFF), 0u};
            pg8::gemm_phase<pg8::EpiKNorm, pg8::StaticOrder, false>(lds, g, S, E, nullptr);
        }
        __syncthreads();
        {
            pg8::Gemm g{(const bf16_t*)(ws + OFF_W5V), (const bf16_t*)(ws + OFF_CKVN), NKVB / 2, MTOK, KVLORA};
            pg8::StaticOrder S; S.init(g.M, g.N, nb, bid);
            pg8::EpiVT E{(bf16_t*)(ws + OFF_VTM)};
            pg8::gemm_phase<pg8::EpiVT, pg8::StaticOrder, false>(lds, g, S, E, nullptr);
        }
    } else if constexpr (PH == 11) {
    } else if constexpr (PH == 12) {
        phase_mla_attn(lds, P, bid, nb);
    } else if constexpr (PH == 13) {
        pg8::Gemm g{(const bf16_t*)(ws + OFF_O), (const bf16_t*)(ws + OFF_W6T), MTOK, DM, ZW8};
        pg8::StaticOrder S; S.init(g.M, g.N, nb, bid);
        pg8::EpiResF32 E{P.out, P.out, DM};
        pg8::gemm_phase<pg8::EpiResF32, pg8::StaticOrder, false>(lds, g, S, E, nullptr);
    }
}

#ifndef REP0
#define REP0 1
#endif
#ifndef REP1
#define REP1 1
#endif
#ifndef REP2
#define REP2 1
#endif
#ifndef REP3
#define REP3 1
#endif
#ifndef REP4
#define REP4 1
#endif
#ifndef REP5
#define REP5 1
#endif
#ifndef REP6
#define REP6 1
#endif
#ifndef REP7
#define REP7 1
#endif
#ifndef REP8
#define REP8 1
#endif
#ifndef REP9
#define REP9 1
#endif
#ifndef REP10
#define REP10 1
#endif
#ifndef REP11
#define REP11 1
#endif
#ifndef REP12
#define REP12 1
#endif
#ifndef REP13
#define REP13 1
#endif

__global__ __launch_bounds__(512, 2) void k_mega(Params P) {
    extern __shared__ __attribute__((aligned(16))) unsigned char shm[];
    LAS unsigned char* lds = (LAS unsigned char*)shm;
    volatile LAS unsigned* st = (volatile LAS unsigned*)(lds + LDS_ST_OFF);
    if (threadIdx.x == 0) { st[0] = 0u; st[1] = 0u; st[2] = 0u; st[3] = 0u; }
    __syncthreads();
    XcdBarrier bar = xcd_barrier_post((unsigned*)(P.ws + OFF_CTL), st);
    const int bid = (int)blockIdx.x, nb = (int)gridDim.x;
    for (int rep_ = 0; rep_ < REP0; ++rep_) run_phase<0>(P, lds, bid, nb);  xcd_barrier(bar);
    for (int rep_ = 0; rep_ < REP1; ++rep_) run_phase<1>(P, lds, bid, nb);  xcd_barrier(bar);
    for (int rep_ = 0; rep_ < REP2; ++rep_) run_phase<2>(P, lds, bid, nb);  xcd_barrier(bar);
    for (int rep_ = 0; rep_ < REP3; ++rep_) run_phase<3>(P, lds, bid, nb);  xcd_barrier(bar);
    for (int rep_ = 0; rep_ < REP4; ++rep_) run_phase<4>(P, lds, bid, nb);  xcd_barrier(bar);
    for (int rep_ = 0; rep_ < REP5; ++rep_) run_phase<5>(P, lds, bid, nb);
#if DUP5
    __syncthreads(); run_phase<5>(P, lds, bid, nb);
#endif
    xcd_barrier(bar);
    for (int rep_ = 0; rep_ < REP6; ++rep_) run_phase<6>(P, lds, bid, nb);  xcd_barrier(bar);
    for (int rep_ = 0; rep_ < REP8; ++rep_) run_phase<8>(P, lds, bid, nb);  xcd_barrier(bar);
    for (int rep_ = 0; rep_ < REP9; ++rep_) run_phase<9>(P, lds, bid, nb);  xcd_barrier(bar);
    for (int rep_ = 0; rep_ < REP10; ++rep_) run_phase<10>(P, lds, bid, nb); xcd_barrier(bar);
    for (int rep_ = 0; rep_ < REP12; ++rep_) run_phase<12>(P, lds, bid, nb); xcd_barrier(bar);
    for (int rep_ = 0; rep_ < REP13; ++rep_) run_phase<13>(P, lds, bid, nb);
}

extern "C" void kernel_launch(void* const* d_in, const int* in_sizes, int n_in, void* d_out, int out_size, void* d_ws, size_t ws_size, hipStream_t stream) {
    (void)in_sizes; (void)n_in; (void)out_size;
    if (ws_size < WS_END) return;
    Params P{};
    P.x = (const float*)d_in[0]; P.pos = (const int*)d_in[1]; P.norm_w = (const float*)d_in[2]; P.rel_bias = (const float*)d_in[3];
    P.nsa_w_in = (const float*)d_in[4]; P.nsa_q_norm = (const float*)d_in[5]; P.nsa_k_norm = (const float*)d_in[6]; P.pe_k = (const float*)d_in[7];
    P.w1_k = (const float*)d_in[8]; P.w2_k = (const float*)d_in[9]; P.pe_v = (const float*)d_in[10]; P.w1_v = (const float*)d_in[11]; P.w2_v = (const float*)d_in[12];
    P.nsa_w_out = (const float*)d_in[13]; P.mla_w_in = (const float*)d_in[14]; P.mla_q_a_norm = (const float*)d_in[15]; P.mla_w_q_b = (const float*)d_in[16];
    P.mla_kv_a_norm = (const float*)d_in[17]; P.mla_w_kv_b = (const float*)d_in[18]; P.mla_q_norm = (const float*)d_in[19]; P.mla_k_norm = (const float*)d_in[20];
    P.mla_w_out = (const float*)d_in[21];
    P.out = (float*)d_out; P.ws = (unsigned char*)d_ws;
    static int grid = 0;
    if (!grid) {
        int dev = 0, cus = 0, per_cu = 0; (void)hipGetDevice(&dev);
        if (hipDeviceGetAttribute(&cus, hipDeviceAttributeMultiprocessorCount, dev) != hipSuccess || cus <= 0) cus = 256;
        (void)hipFuncSetAttribute((const void*)k_mega, hipFuncAttributeMaxDynamicSharedMemorySize, LDS_BYTES);
        if (hipOccupancyMaxActiveBlocksPerMultiprocessor(&per_cu, k_mega, 512, LDS_BYTES) != hipSuccess || per_cu < 1) per_cu = 1;
        grid = cus;
    }
    (void)hipMemsetAsync((unsigned char*)d_ws + OFF_CTL, 0, XCD_BAR_WORDS * sizeof(unsigned), stream);
    hipLaunchKernelGGL(k_mega, dim3(grid), dim3(512), LDS_BYTES, stream, P);
}
```

```cpp
#define ATT16 1
#define USE_FP8Z 1
#define USE_FP8M 1
#define GEMM_NT 1
#include <hip/hip_runtime.h>
#include <stdint.h>
#include <stddef.h>

#define DI __device__ __forceinline__
#define LAS __attribute__((address_space(3)))
typedef unsigned short bf16_t;
typedef short bf16x8 __attribute__((ext_vector_type(8)));
typedef float f32x4 __attribute__((ext_vector_type(4)));
typedef float f32x16 __attribute__((ext_vector_type(16)));
typedef unsigned u32x4 __attribute__((ext_vector_type(4)));
typedef unsigned u32x2 __attribute__((ext_vector_type(2)));
typedef __bf16 bf2_t __attribute__((ext_vector_type(2)));
typedef float f2_t __attribute__((ext_vector_type(2)));

DI int tid_opaque() { int t = (int)threadIdx.x; asm volatile("" : "+v"(t)); return t; }
DI unsigned pk2(float a, float b) { f2_t f = {a, b}; bf2_t v = __builtin_convertvector(f, bf2_t); return __builtin_bit_cast(unsigned, v); }
DI unsigned pk4_fp8(float a, float b, float c, float d) { int w = 0; w = __builtin_amdgcn_cvt_pk_fp8_f32(a, b, w, false); w = __builtin_amdgcn_cvt_pk_fp8_f32(c, d, w, true); return (unsigned)w; }
DI float bflo(unsigned w) { return __uint_as_float(w << 16); }
DI float bfhi(unsigned w) { return __uint_as_float(w & 0xffff0000u); }
#ifndef GEMM_NT
#define GEMM_NT 0
#endif
#ifndef FP8EMU
#define FP8EMU 0
#endif
DI float emu_q8(float x, float s) { float y = x * s; const float ay = fabsf(y);
    if (ay < 0.015625f) y = rintf(y * 512.0f) * (1.0f / 512.0f);
    else { unsigned u = __float_as_uint(y); u = (u + 0x0007FFFFu + ((u >> 20) & 1u)) & 0xFFF00000u; y = __uint_as_float(u); }
    y = fminf(fmaxf(y, -448.0f), 448.0f); return y / s; }
DI float bf1(bf16_t h) { return __uint_as_float(((unsigned)h) << 16); }

#ifndef ATT16
#define ATT16 0
#endif
DI int vt_key_of_pos(int p) {
#if ATT16
    return (p & ~31) | (((p >> 2) & 1) << 4) | (((p >> 3) & 3) << 2) | (p & 3);
#else
    return (p & ~0xC) | ((p & 4) << 1) | ((p & 8) >> 1);
#endif
}
DI int vt_pos_of_key(int k) {
#if ATT16
    return (k & ~31) | (((k >> 2) & 3) << 3) | (((k >> 4) & 1) << 2) | (k & 3);
#else
    return (k & ~0xC) | ((k & 4) << 1) | ((k & 8) >> 1);
#endif
}
constexpr int BATCH = 4, SEQ = 4096, DM = 4096, MTOK = BATCH * SEQ;
constexpr int NH = 64, NG = 4, NR = 16, DK = 192, DV = 128;
constexpr int N1 = 40896, N1P = 40960;
constexpr int C_Q = 0, C_KVC = 12288, C_KVS = 13568, C_KVW = 14848, C_ZC = 16128, C_ZS = 24320, C_ZW = 32512, C_G = 40704;
constexpr int N3 = 10304, N3P = 10496;
constexpr int C3_CQ = 0, C3_CKV = 1536, C3_KPE = 2048, C3_Z = 2112;
constexpr int QLORA = 1536, KVLORA = 512;
constexpr int NQB = 12288, NKVB = 16384, ZW8 = 8192;
constexpr float EPSN = 1e-6f;
constexpr float LOG2E = 1.4426950408889634f;
constexpr float QSCALE = 0.07216878364870322f * 1.4426950408889634f;

constexpr size_t SZ_W1T = (size_t)N1P * DM * 2, SZ_W2T = (size_t)DM * ZW8 * 2, SZ_W3T = (size_t)N3P * DM * 2, SZ_W4T = (size_t)NQB * QLORA * 2,
                 SZ_W5T = (size_t)NKVB * KVLORA * 2, SZ_W6T = (size_t)DM * ZW8 * 2;
constexpr size_t OFF_W1T = 0, OFF_W2T = OFF_W1T + SZ_W1T, OFF_W3T = OFF_W2T + SZ_W2T, OFF_W4T = OFF_W3T + SZ_W3T, OFF_W5T = OFF_W4T + SZ_W4T,
                 OFF_W6T = OFF_W5T + SZ_W5T, OFF_W1K = OFF_W6T + SZ_W6T;
constexpr size_t OFF_W5K = OFF_W5T, OFF_W5V = OFF_W5T + SZ_W5T / 2;
constexpr size_t SZ_W1K = (size_t)256 * 6144 * 2, SZ_W1V = (size_t)256 * 4096 * 2;
constexpr size_t OFF_W1V = OFF_W1K + SZ_W1K, OFF_CTL = OFF_W1V + SZ_W1V, OFF_H = OFF_CTL + 65536;
constexpr size_t SZ_H = (size_t)MTOK * DM * 2, SZ_KS = (size_t)BATCH * NG * SEQ * DK * 2, SZ_VTS = (size_t)BATCH * NG * DV * SEQ * 2,
                 SZ_ACK = (size_t)4096 * 6144 * 2, SZ_ACV = (size_t)4096 * 4096 * 2;
constexpr size_t OFF_KS = OFF_H + SZ_H, OFF_KW = OFF_KS + SZ_KS, OFF_VTS = OFF_KW + SZ_KS, OFF_VTW = OFF_VTS + SZ_VTS, OFF_ACK = OFF_VTW + SZ_VTS,
                 OFF_ACV = OFF_ACK + SZ_ACK, OFF_KC = OFF_ACV + SZ_ACV;
constexpr size_t SZ_KC = (size_t)16 * 256 * DK * 2, SZ_VTC = (size_t)16 * DV * 256 * 2, SZ_HID = (size_t)4096 * 256 * 4;
constexpr size_t OFF_VTC = OFF_KC + SZ_KC, OFF_HIDK = OFF_VTC + SZ_VTC, OFF_HIDV = OFF_HIDK + SZ_HID, OFF_Y0 = OFF_HIDV + SZ_HID;
constexpr size_t SZ_Y0 = (size_t)MTOK * N1P * 2, SZ_O = (size_t)MTOK * ZW8 * 2;
constexpr size_t OFF_O = OFF_Y0 + SZ_Y0, WS_END = OFF_O + SZ_O;
constexpr size_t OFF_SS1 = OFF_HIDK;
constexpr size_t OFF_A8 = OFF_O, OFF_B8 = OFF_O + (size_t)MTOK * DM;
constexpr int NZ8 = N1P - C_ZC;
constexpr size_t OFF_B8M = OFF_W1T, OFF_A8M = OFF_W1T + (64ull << 20);
constexpr int C3_Z8 = 2304, NZ8M = 8192;
constexpr size_t OFF_KM = 0;
constexpr size_t SZ_KM = (size_t)BATCH * NH * SEQ * DK * 2;
static_assert(SZ_KM <= SZ_W1T + SZ_W2T, "KM alias");
constexpr size_t OFF_VTM = OFF_H;
constexpr size_t SZ_VTM = (size_t)BATCH * NH * DV * SEQ * 2;
constexpr size_t OFF_CKVN = OFF_VTM + SZ_VTM;
constexpr size_t SZ_CKVN = (size_t)MTOK * KVLORA * 2;
static_assert(OFF_CKVN + SZ_CKVN <= OFF_KC, "CKVN alias");
constexpr size_t OFF_Y1 = OFF_Y0, SZ_Y1 = (size_t)MTOK * N3P * 2;
constexpr size_t OFF_QM = OFF_Y1 + SZ_Y1, SZ_QM = (size_t)MTOK * NQB * 2;
constexpr size_t OFF_KVM = OFF_QM + SZ_QM, SZ_KVM = (size_t)MTOK * NKVB * 2;
constexpr size_t OFF_KNM = OFF_KVM;
constexpr size_t OFF_KPER = OFF_KVM, OFF_SSPE = OFF_KVM + (size_t)MTOK * 64 * 4;
constexpr size_t OFF_CQN = OFF_KVM + SZ_KVM, SZ_CQN = (size_t)MTOK * QLORA * 2;
constexpr size_t OFF_ROPE = OFF_CQN + SZ_CQN, SZ_ROPE = (size_t)MTOK * 64 * 4;
static_assert(OFF_ROPE + SZ_ROPE <= OFF_O, "layer-1 alias region");
static_assert(WS_END <= 2680160256ull, "workspace");

struct Params {
    const float* x; const int* pos; const float* norm_w; const float* rel_bias;
    const float* nsa_w_in; const float* nsa_q_norm; const float* nsa_k_norm; const float* pe_k; const float* w1_k; const float* w2_k;
    const float* pe_v; const float* w1_v; const float* w2_v; const float* nsa_w_out;
    const float* mla_w_in; const float* mla_q_a_norm; const float* mla_w_q_b; const float* mla_kv_a_norm; const float* mla_w_kv_b;
    const float* mla_q_norm; const float* mla_k_norm; const float* mla_w_out;
    float* out; unsigned char* ws;
};

#define XB_TMO      128
#define XB_XCNT(j)  (256  + 64 * (j))
#define XB_XSUB(j)  (1280 + 64 * (j))
#define XB_XGEN(j)  (2304 + 64 * (j))
#define XB_TOP      3328
#define XB_TOPGEN   3392
#define XCD_BAR_WORDS 3456
#define XB_SPIN_CAP (1u << 18)

__device__ __forceinline__ unsigned xb_ld(unsigned* p)              { return __hip_atomic_load(p, __ATOMIC_RELAXED, __HIP_MEMORY_SCOPE_AGENT); }
__device__ __forceinline__ unsigned xb_add(unsigned* p, unsigned v) { return __hip_atomic_fetch_add(p, v, __ATOMIC_RELAXED, __HIP_MEMORY_SCOPE_AGENT); }
__device__ __forceinline__ unsigned xb_xcc_id() { return (unsigned)__builtin_amdgcn_s_getreg((3 << 11) | 20) & 0xFu; }
#define XB_SPIN(cond, bar) do { unsigned _sp = 0; while (cond) { __builtin_amdgcn_s_sleep(1); \
    if ((++_sp & 255u) == 0u) { if (xb_ld(&(bar)[XB_TMO])) break; if (_sp > XB_SPIN_CAP) { atomicAdd(&(bar)[XB_TMO], 1u); break; } } } } while (0)

struct XcdBarrier {
    unsigned* bar; unsigned x;
    volatile LAS unsigned* st;
};

__device__ __forceinline__ XcdBarrier xcd_barrier_post(unsigned* bar, volatile LAS unsigned* st) {
    XcdBarrier b; b.bar = bar; b.x = xb_xcc_id(); b.st = st;
    if (threadIdx.x == 0) (void)xb_add(&bar[XB_XCNT(b.x)], 1u);
    return b;
}
__device__ __forceinline__ void xcd_barrier_complete(unsigned* bar, unsigned x, unsigned& nloc, unsigned& nx) {
    const unsigned G = gridDim.x * gridDim.y * gridDim.z;
    unsigned sum, cnt, mine, sp = 0u;
    for (;;) {
        sum = 0u; cnt = 0u; mine = 0u;
#pragma unroll
        for (unsigned j = 0; j < 16; ++j) { const unsigned c = xb_ld(&bar[XB_XCNT(j)]); sum += c; cnt += (c > 0u) ? 1u : 0u; mine = (j == x) ? c : mine; }
        if (sum == G) break;
        __builtin_amdgcn_s_sleep(1);
        if ((++sp & 255u) == 0u) { if (xb_ld(&bar[XB_TMO])) break; if (sp > XB_SPIN_CAP) { atomicAdd(&bar[XB_TMO], 1u); break; } }
    }
    nloc = mine > 0u ? mine : 1u; nx = cnt > 0u ? cnt : 1u;
}

__device__ __forceinline__ void xcd_barrier(const XcdBarrier& b) {
    asm volatile("s_waitcnt vmcnt(0)" ::: "memory");
    __syncthreads();
    if (threadIdx.x == 0) {
        unsigned* bar = b.bar;
        __builtin_amdgcn_s_waitcnt(0);
        unsigned nloc = b.st[0], nx = b.st[1];
        if (nloc == 0u) { xcd_barrier_complete(bar, b.x, nloc, nx); b.st[0] = nloc; b.st[1] = nx; }
        const unsigned old = xb_add(&bar[XB_XSUB(b.x)], 1u);
        const unsigned gen = old / nloc;
        if (old + 1u == (gen + 1u) * nloc) {
            __builtin_amdgcn_fence(__ATOMIC_RELEASE, "agent");
            asm volatile("s_waitcnt vmcnt(0)" ::: "memory");
            const unsigned og = xb_add(&bar[XB_TOP], 1u);
            const unsigned tg = og / nx;
            if (og + 1u == (tg + 1u) * nx) xb_add(&bar[XB_TOPGEN], 1u);
            else XB_SPIN(xb_ld(&bar[XB_TOPGEN]) == tg, bar);
            __builtin_amdgcn_fence(__ATOMIC_ACQUIRE, "agent");
            xb_add(&bar[XB_XGEN(b.x)], 1u);
            asm volatile("s_waitcnt vmcnt(0)" ::: "memory");
        } else {
            XB_SPIN(xb_ld(&bar[XB_XGEN(b.x)]) == gen, bar);
            __builtin_amdgcn_fence(__ATOMIC_ACQUIRE, "agent");
            asm volatile("s_waitcnt vmcnt(0)" ::: "memory");
        }
    }
    __syncthreads();
}

namespace pg8 {
#define PG8_LAS __attribute__((address_space(3)))
typedef unsigned short bf16_t;
typedef short bf16x8 __attribute__((ext_vector_type(8)));
typedef float f32x4 __attribute__((ext_vector_type(4)));
typedef unsigned u32x4 __attribute__((ext_vector_type(4)));
typedef int i32x8_t __attribute__((ext_vector_type(8)));
typedef int i32x4_t __attribute__((ext_vector_type(4)));
constexpr int BM = 256, BK = 64, HALF = 128, HTB = HALF * BK * 2  , STAGE_BYTES = 8 * HTB, NXCD = 8, WGM = 8;

__host__ __device__ __forceinline__ int lds_byte(int r, int c) { const int st = (r >> 4) * 2 + (c >> 5), rr = r & 15, cc = c & 31, ob = rr * 64 + cc * 2; return st * 1024 + (ob ^ (((ob >> 9) & 1) << 5)); }
__host__ __device__ __forceinline__ void stage_rc(int b, int& R, int& C) { const int st = b / 1024, sb = b % 1024, swz = sb ^ (((sb >> 9) & 1) << 5); R = (st >> 1) * 16 + swz / 64; C = (st & 1) * 32 + (swz % 64) / 2; }
__host__ __device__ __forceinline__ int perm32(int rho) { const int n = rho >> 4, i = rho & 15; return 8 * (i >> 2) + 4 * n + (i & 3); }

struct Unit { int pm, pn; };
struct Gemm { const bf16_t* A; const bf16_t* Bt; int M, N, K; };

struct StaticOrder {
    int nM, nN, nwg, G, c;
    __host__ __device__ void init(int M, int N, int G_, int c_) { nM = M / BM; nN = N / BM; nwg = nM * nN; G = G_; c = c_; }
    __host__ __device__ bool next(int i, Unit& u) const {
        const long L = (long)i * G + c; if (L >= nwg) return false;
        int wgid = (int)L; { const int q = nwg / NXCD, r = nwg % NXCD, xcd = wgid % NXCD, off = wgid / NXCD; wgid = (xcd < r ? xcd * (q + 1) : r * (q + 1) + (xcd - r) * q) + off; }
        const int nig = WGM * nN, gid = wgid / nig, fm = gid * WGM, gsz = (nM - fm) < WGM ? (nM - fm) : WGM;
        u.pm = fm + ((wgid % nig) % gsz); u.pn = (wgid % nig) / gsz; return true;
    }
    __device__ __forceinline__ void a_ready(const Unit&) const {}
    __device__ __forceinline__ void done(const Unit&) const {}
};
#if GEMM_NT
#define EPI_ST16(p, w) __builtin_nontemporal_store((w), (u32x4*)(p))
#else
#define EPI_ST16(p, w) (*(u32x4*)(p) = (w))
#endif
struct EpiStoreBf16 {
    static constexpr bool PERM = true, AFTER_DRAIN = false, SWAP23 = false, FP8 = false;
    bf16_t* O; int ldc;
    __device__ __forceinline__ void operator()(const f32x4 (&acc)[2][2][4][2], const Unit& u, int wr, int wc, int fr, int fq) const {
        const int row0 = u.pm * BM + wr * 64 + fr; const int col0 = u.pn * BM + wc * 32 + 8 * fq;
#pragma unroll
        for (int ai = 0; ai < 2; ++ai)
#pragma unroll
            for (int m = 0; m < 4; ++m) { bf16_t* rowp = O + (size_t)(row0 + ai * HALF + m * 16) * ldc + col0;
#pragma unroll
                for (int bj = 0; bj < 2; ++bj) { const f32x4 v0 = acc[ai][bj][m][0], v1 = acc[ai][bj][m][1];
                    u32x4 w; w.x = pk2(v0[0], v0[1]); w.y = pk2(v0[2], v0[3]); w.z = pk2(v1[0], v1[1]); w.w = pk2(v1[2], v1[3]);
                    EPI_ST16(rowp + bj * HALF, w); } }
    }
};
struct EpiResF32 {
    static constexpr bool PERM = false, AFTER_DRAIN = false, SWAP23 = false, FP8 = false;
    const float* base; float* out; int ldc;
    __device__ __forceinline__ void operator()(const f32x4 (&acc)[2][2][4][2], const Unit& u, int wr, int wc, int fr, int fq) const {
        const int row0 = u.pm * BM + wr * 64 + fr, col0 = u.pn * BM + wc * 32 + 4 * fq;
#pragma unroll
        for (int ai = 0; ai < 2; ++ai)
#pragma unroll
            for (int m = 0; m < 4; ++m) { const size_t off = (size_t)(row0 + ai * HALF + m * 16) * ldc + col0;
#pragma unroll
                for (int bj = 0; bj < 2; ++bj)
#pragma unroll
                    for (int n = 0; n < 2; ++n) { const f32x4 bs = *(const f32x4*)(base + off + bj * HALF + n * 16);
                        *(f32x4*)(out + off + bj * HALF + n * 16) = bs + acc[ai][bj][m][n]; } }
    }
};
struct EpiPlainF32 {
    static constexpr bool PERM = false, AFTER_DRAIN = false, SWAP23 = false, FP8 = false;
    float* C; int ldc;
    __device__ __forceinline__ void operator()(const f32x4 (&acc)[2][2][4][2], const Unit& u, int wr, int wc, int fr, int fq) const {
        const int row0 = u.pm * BM + wr * 64 + fr, col0 = u.pn * BM + wc * 32 + 4 * fq;
#pragma unroll
        for (int ai = 0; ai < 2; ++ai)
#pragma unroll
            for (int m = 0; m < 4; ++m) { float* rowp = C + (size_t)(row0 + ai * HALF + m * 16) * ldc + col0;
#pragma unroll
                for (int bj = 0; bj < 2; ++bj)
#pragma unroll
                    for (int n = 0; n < 2; ++n) *(f32x4*)(rowp + bj * HALF + n * 16) = acc[ai][bj][m][n]; }
    }
};

struct EpiVT {
    static constexpr bool PERM = true, AFTER_DRAIN = false, SWAP23 = true, FP8 = false;
    bf16_t* O;
    __device__ __forceinline__ void operator()(const f32x4 (&acc)[2][2][4][2], const Unit& u, int wr, int wc, int fr, int fq) const {
        const int row0 = u.pm * BM + wr * 64 + fr; const int colt = u.pn * BM; const int b = colt >> 12, pos0 = (colt & 4095) + wc * 32 + 8 * fq;
        bf16_t* base = O + (size_t)b * 8192 * 4096 + pos0;
#pragma unroll
        for (int ai = 0; ai < 2; ++ai)
#pragma unroll
            for (int m = 0; m < 4; ++m) { bf16_t* rowp = base + (size_t)(row0 + ai * HALF + m * 16) * 4096;
#pragma unroll
                for (int bj = 0; bj < 2; ++bj) { const f32x4 v0 = acc[ai][bj][m][0], v1 = acc[ai][bj][m][1];
                    u32x4 w; w.x = pk2(v0[0], v0[1]); w.y = pk2(v0[2], v0[3]); w.z = pk2(v1[0], v1[1]); w.w = pk2(v1[2], v1[3]);
                    EPI_ST16(rowp + bj * HALF, w); } }
    }
};

struct EpiKNorm {
    static constexpr bool PERM = true, AFTER_DRAIN = false, SWAP23 = false, FP8 = false;
    bf16_t* KM; const float* sspe; const float* kper; const float* gain; PG8_LAS float* tab; mutable unsigned par;
    __device__ __forceinline__ void operator()(const f32x4 (&acc)[2][2][4][2], const Unit& u, int wr, int wc, int fr, int fq) const {
        PG8_LAS float* T = tab + par * 2048;
#pragma unroll
        for (int ai = 0; ai < 2; ++ai)
#pragma unroll
            for (int m = 0; m < 4; ++m) { const int row = ai * HALF + wr * 64 + m * 16 + fr;
#pragma unroll
                for (int bj = 0; bj < 2; ++bj) { const f32x4 x = acc[ai][bj][m][0], y = acc[ai][bj][m][1];
                    float ss = (x[0] * x[0] + x[1] * x[1]) + (x[2] * x[2] + x[3] * x[3]) + (y[0] * y[0] + y[1] * y[1]) + (y[2] * y[2] + y[3] * y[3]);
                    ss += __shfl_xor(ss, 16); ss += __shfl_xor(ss, 32);
                    if (fq == 0) T[row * 8 + bj * 4 + wc] = ss; } }
        asm volatile("s_waitcnt lgkmcnt(0)" ::: "memory"); __builtin_amdgcn_s_barrier(); asm volatile("" ::: "memory");
        const f32x4 g0 = *(const f32x4*)(gain + wc * 32 + 8 * fq), g1 = *(const f32x4*)(gain + wc * 32 + 8 * fq + 4);
        const int tok0 = u.pm * BM, b = tok0 >> 12;
#pragma unroll
        for (int ai = 0; ai < 2; ++ai)
#pragma unroll
            for (int m = 0; m < 4; ++m) { const int row = ai * HALF + wr * 64 + m * 16 + fr, tok = tok0 + row, s = tok & 4095;
                const float sp = sspe[tok]; const f32x4 kp = *(const f32x4*)(kper + (size_t)tok * 64 + wc * 16 + 4 * fq);
#pragma unroll
                for (int bj = 0; bj < 2; ++bj) { const f32x4 t = *(const PG8_LAS f32x4*)(T + row * 8 + bj * 4);
                    const float rstd = rsqrtf(((t[0] + t[1]) + (t[2] + t[3]) + sp) * (1.0f / 192.0f) + 1e-6f);
                    const int hd = 2 * u.pn + bj;
                    bf16_t* kb = KM + ((size_t)(b * 64 + hd) * 4096 + s) * 192;
                    const f32x4 x = acc[ai][bj][m][0], y = acc[ai][bj][m][1];
                    u32x4 w; w.x = pk2(x[0] * rstd * g0[0], x[1] * rstd * g0[1]); w.y = pk2(x[2] * rstd * g0[2], x[3] * rstd * g0[3]);
                    w.z = pk2(y[0] * rstd * g1[0], y[1] * rstd * g1[1]); w.w = pk2(y[2] * rstd * g1[2], y[3] * rstd * g1[3]);
                    *(u32x4*)(kb + wc * 32 + 8 * fq) = w;
                    u32x2 r; r.x = pk2(kp[0] * rstd, kp[1] * rstd); r.y = pk2(kp[2] * rstd, kp[3] * rstd);
                    *(u32x2*)(kb + 128 + wc * 16 + 4 * fq) = r; } }
        par ^= 1u;
    }
};

struct EpiResNorm {
    static constexpr bool PERM = false, AFTER_DRAIN = false, SWAP23 = false, FP8 = false;
    const float* base; float* out; int ldc; const float* gain; bf16_t* xg; float* ss; unsigned char* x8;
    __device__ __forceinline__ void operator()(const f32x4 (&acc)[2][2][4][2], const Unit& u, int wr, int wc, int fr, int fq) const {
        const int row0 = u.pm * BM + wr * 64 + fr, col0 = u.pn * BM + wc * 32 + 4 * fq;
        f32x4 gv[2][2];
#pragma unroll
        for (int bj = 0; bj < 2; ++bj)
#pragma unroll
            for (int n = 0; n < 2; ++n) gv[bj][n] = *(const f32x4*)(gain + col0 + bj * HALF + n * 16);
#pragma unroll
        for (int ai = 0; ai < 2; ++ai)
#pragma unroll
            for (int m = 0; m < 4; ++m) { const int row = row0 + ai * HALF + m * 16; const size_t off = (size_t)row * ldc + col0; float sq = 0.f;
#pragma unroll
                for (int bj = 0; bj < 2; ++bj)
#pragma unroll
                    for (int n = 0; n < 2; ++n) { const f32x4 bs = *(const f32x4*)(base + off + bj * HALF + n * 16); const f32x4 v = bs + acc[ai][bj][m][n];
                        *(f32x4*)(out + off + bj * HALF + n * 16) = v;
                        sq += (v[0] * v[0] + v[1] * v[1]) + (v[2] * v[2] + v[3] * v[3]);
                        const f32x4 g = gv[bj][n]; u32x2 w; w.x = pk2(v[0] * g[0], v[1] * g[1]); w.y = pk2(v[2] * g[2], v[3] * g[3]);
                        *(u32x2*)(xg + off + bj * HALF + n * 16) = w;
                        if (x8) *(unsigned*)(x8 + off + bj * HALF + n * 16) = pk4_fp8(v[0] * g[0] * 16.0f, v[1] * g[1] * 16.0f, v[2] * g[2] * 16.0f, v[3] * g[3] * 16.0f); }
                sq += __shfl_xor(sq, 16); sq += __shfl_xor(sq, 32);
                if (fq == 0) atomicAdd(ss + row, sq); }
    }
};
struct EpiStoreBf16RowScale {
    static constexpr bool PERM = true, AFTER_DRAIN = false, SWAP23 = false, FP8 = false;
    bf16_t* O; int ldc; const float* ss; float inv_dim;
    __device__ __forceinline__ void operator()(const f32x4 (&acc)[2][2][4][2], const Unit& u, int wr, int wc, int fr, int fq) const {
        const int row0 = u.pm * BM + wr * 64 + fr; const int col0 = u.pn * BM + wc * 32 + 8 * fq;
#pragma unroll
        for (int ai = 0; ai < 2; ++ai)
#pragma unroll
            for (int m = 0; m < 4; ++m) { const int row = row0 + ai * HALF + m * 16; const float rs = rsqrtf(ss[row] * inv_dim + 1e-6f);
                bf16_t* rowp = O + (size_t)row * ldc + col0;
#pragma unroll
                for (int bj = 0; bj < 2; ++bj) { const f32x4 v0 = acc[ai][bj][m][0] * rs, v1 = acc[ai][bj][m][1] * rs;
                    u32x4 w; w.x = pk2(v0[0], v0[1]); w.y = pk2(v0[2], v0[3]); w.z = pk2(v1[0], v1[1]); w.w = pk2(v1[2], v1[3]);
                    EPI_ST16(rowp + bj * HALF, w); } }
    }
};

struct EpiStoreBf16Fp8 {
    static constexpr bool PERM = true, AFTER_DRAIN = false, SWAP23 = false, FP8 = true;
    bf16_t* O; int ldc; float scale;
    __device__ __forceinline__ void operator()(const f32x4 (&acc)[2][2][4][2], const Unit& u, int wr, int wc, int fr, int fq) const {
        const int row0 = u.pm * BM + wr * 64 + fr; const int col0 = u.pn * BM + wc * 32 + 8 * fq;
#pragma unroll
        for (int ai = 0; ai < 2; ++ai)
#pragma unroll
            for (int m = 0; m < 4; ++m) { bf16_t* rowp = O + (size_t)(row0 + ai * HALF + m * 16) * ldc + col0;
#pragma unroll
                for (int bj = 0; bj < 2; ++bj) { const f32x4 v0 = acc[ai][bj][m][0] * scale, v1 = acc[ai][bj][m][1] * scale;
                    u32x4 w; w.x = pk2(v0[0], v0[1]); w.y = pk2(v0[2], v0[3]); w.z = pk2(v1[0], v1[1]); w.w = pk2(v1[2], v1[3]);
                    EPI_ST16(rowp + bj * HALF, w); } }
    }
};

struct OrderBf16Part {
    int G, c, nq, nz;
    __device__ bool next(int i, Unit& u) const { const int L = i * G + c;
        if (L < nq * 64) { u.pm = L & 63; u.pn = L >> 6; return true; }
        const int Lz = L - nq * 64; if (Lz >= nz * 4) return false;
        u.pm = 16 * (Lz & 3); u.pn = nq + (Lz >> 2); return true; }
    __device__ __forceinline__ void a_ready(const Unit&) const {}
    __device__ __forceinline__ void done(const Unit&) const {}
};
struct OrderFp8Part {
    int G, c, nz, rot;
    __device__ bool next(int i, Unit& u) const { const int L = i * G + (G == 256 ? ((c + rot) & 255) : c); if (L >= nz * 60) return false;
        const int r = L % 60; u.pm = r + r / 15 + 1; u.pn = L / 60; return true; }
    __device__ __forceinline__ void a_ready(const Unit&) const {}
    __device__ __forceinline__ void done(const Unit&) const {}
};

struct EpiStoreBf16RowScaleFp8 {
    static constexpr bool PERM = true, AFTER_DRAIN = false, SWAP23 = false, FP8 = true;
    bf16_t* O; int ldc; const float* ss; float inv_dim, scale;
    __device__ __forceinline__ void operator()(const f32x4 (&acc)[2][2][4][2], const Unit& u, int wr, int wc, int fr, int fq) const {
        const int row0 = u.pm * BM + wr * 64 + fr; const int col0 = u.pn * BM + wc * 32 + 8 * fq;
#pragma unroll
        for (int ai = 0; ai < 2; ++ai)
#pragma unroll
            for (int m = 0; m < 4; ++m) { const int row = row0 + ai * HALF + m * 16; const float rs = rsqrtf(ss[row] * inv_dim + 1e-6f) * scale;
                bf16_t* rowp = O + (size_t)row * ldc + col0;
#pragma unroll
                for (int bj = 0; bj < 2; ++bj) { const f32x4 v0 = acc[ai][bj][m][0] * rs, v1 = acc[ai][bj][m][1] * rs;
                    u32x4 w; w.x = pk2(v0[0], v0[1]); w.y = pk2(v0[2], v0[3]); w.z = pk2(v1[0], v1[1]); w.w = pk2(v1[2], v1[3]);
                    EPI_ST16(rowp + bj * HALF, w); } }
    }
};
struct OrderTiles {
    int G, c, ncol;
    __device__ bool next(int i, Unit& u) const { const int L = i * G + c; if (L >= ncol * 64) return false; u.pm = L & 63; u.pn = L >> 6; return true; }
    __device__ __forceinline__ void a_ready(const Unit&) const {}
    __device__ __forceinline__ void done(const Unit&) const {}
};
template <class Epi, class Sched, bool STAMP = false>
__device__ __forceinline__ void gemm_phase(PG8_LAS unsigned char* lds, const Gemm g, const Sched& S, const Epi& E, unsigned long long* stamps) {
    const int tid = tid_opaque(), wid = __builtin_amdgcn_readfirstlane(tid >> 6), lane = tid & 63, wr = wid >> 2, wc = wid & 3, fr = lane & 15, fq = lane >> 4;
    const int K = g.K, nt = K / BK;
    int ts_lo = 0, ts_hi = 0, nts = 0; const unsigned long long rt_entry = STAMP ? (unsigned long long)wall_clock64() : 0ull;
#define PG8_STAMP() do { if (STAMP && wid == 0 && nts < 64) { const unsigned long long _c = (unsigned long long)clock64(); \
        ts_lo = (lane == nts) ? (int)(unsigned)_c : ts_lo; ts_hi = (lane == nts) ? (int)(unsigned)(_c >> 32) : ts_hi; ++nts; } } while (0)
    PG8_STAMP();
    unsigned voffA[2], voffB[2];
#pragma unroll
    for (int i = 0; i < 2; ++i) { int R, C; stage_rc(tid * 16 + i * 8192, R, C); int Rb = Epi::PERM ? ((R & ~31) + perm32(R & 31)) : R; if (Epi::SWAP23) Rb = vt_key_of_pos(Rb);
        voffA[i] = (unsigned)(R * K + C) * 2u; voffB[i] = (unsigned)(Rb * K + C) * 2u; }
    const size_t kstep = (size_t)(BK * 2);
    const size_t hstep = (size_t)HALF * K * 2;
    const size_t tstep = 2 * hstep;
    const unsigned ldsw = (unsigned)wid * 1024u;
    const int aoff = lds_byte(wr * 64 + fr, fq * 8), boff = lds_byte(wc * 32 + fr, fq * 8);
#define PG8_SA(b, h) (((b) * 2 + (h)) * HTB)
#define PG8_SB(b, h) ((4 + (b) * 2 + (h)) * HTB)
#define PG8_STAGE(bufoff, gbase, voff) do { _Pragma("unroll") for (int _i = 0; _i < 2; ++_i) \
        __builtin_amdgcn_global_load_lds((const unsigned*)((const char*)(gbase) + (voff)[_i]), (PG8_LAS unsigned*)(lds + (bufoff) + ldsw + _i * 8192), 16, 0, 0); } while (0)
#define PG8_LDA(dst, b, h) do { if constexpr (Epi::FP8) { _Pragma("unroll") for (int m = 0; m < 4; ++m) { const PG8_LAS unsigned char* p_ = lds + PG8_SA(b, h) + aoff + m * 2048; \
            const i32x4_t lo_ = *(const PG8_LAS i32x4_t*)p_, hi_ = *(const PG8_LAS i32x4_t*)(p_ + 1024); dst##8[m] = __builtin_shufflevector(lo_, hi_, 0, 1, 2, 3, 4, 5, 6, 7); } } \
        else { _Pragma("unroll") for (int m = 0; m < 4; ++m) _Pragma("unroll") for (int k = 0; k < 2; ++k) dst[m][k] = *(const PG8_LAS bf16x8*)(lds + PG8_SA(b, h) + aoff + m * 2048 + k * 1024); } } while (0)
#define PG8_LDB(dst, b, h) do { if constexpr (Epi::FP8) { _Pragma("unroll") for (int n = 0; n < 2; ++n) { const PG8_LAS unsigned char* p_ = lds + PG8_SB(b, h) + boff + n * 2048; \
            const i32x4_t lo_ = *(const PG8_LAS i32x4_t*)p_, hi_ = *(const PG8_LAS i32x4_t*)(p_ + 1024); dst##8[n] = __builtin_shufflevector(lo_, hi_, 0, 1, 2, 3, 4, 5, 6, 7); } } \
        else { _Pragma("unroll") for (int n = 0; n < 2; ++n) _Pragma("unroll") for (int k = 0; k < 2; ++k) dst[n][k] = *(const PG8_LAS bf16x8*)(lds + PG8_SB(b, h) + boff + n * 2048 + k * 1024); } } while (0)
#define PG8_MMA(ai, bj, At, Bt) do { __builtin_amdgcn_s_setprio(1); \
        if constexpr (Epi::FP8) { \
            _Pragma("unroll") for (int m = 0; m < 4; ++m) _Pragma("unroll") for (int n = 0; n < 2; ++n) \
                asm volatile("v_mfma_scale_f32_16x16x128_f8f6f4 %0, %1, %2, %0, %3, %3 op_sel_hi:[0,0,0]" : "+v"(acc[ai][bj][m][n]) : "v"(Bt##8[n]), "v"(At##8[m]), "v"(fp8_scale_one)); \
        } else { \
            _Pragma("unroll") for (int m = 0; m < 4; ++m) _Pragma("unroll") for (int n = 0; n < 2; ++n) _Pragma("unroll") for (int k = 0; k < 2; ++k) \
                acc[ai][bj][m][n] = __builtin_amdgcn_mfma_f32_16x16x32_bf16(Bt[n][k], At[m][k], acc[ai][bj][m][n], 0, 0, 0); } \
        __builtin_amdgcn_s_setprio(0); } while (0)
#define PG8_WAIT_V(n) asm volatile("s_waitcnt vmcnt(" #n ")" ::: "memory")
#define PG8_WAIT_L(n) asm volatile("s_waitcnt lgkmcnt(" #n ")" ::: "memory")
#define PG8_BAR __builtin_amdgcn_s_barrier()
#define PG8_SCHED __builtin_amdgcn_sched_barrier(0)
    Unit cur, nxt; int ui = 0;
    if (!S.next(0, cur)) return;
    f32x4 acc[2][2][4][2];
#pragma unroll
    for (int a = 0; a < 2; ++a)
#pragma unroll
        for (int b = 0; b < 2; ++b)
#pragma unroll
            for (int m = 0; m < 4; ++m)
#pragma unroll
                for (int n = 0; n < 2; ++n) acc[a][b][m][n] = (f32x4){0.f, 0.f, 0.f, 0.f};
    bf16x8 At[4][2], B0[2][2], B1[2][2]; i32x8_t At8[4], B08[2], B18[2]; const int fp8_scale_one = 0x7f7f7f7f;
    const char* cA = (const char*)g.A + (size_t)cur.pm * tstep; const char* cB = (const char*)g.Bt + (size_t)cur.pn * tstep;
    S.a_ready(cur);
    PG8_STAGE(PG8_SB(0, 0), cB, voffB); PG8_STAGE(PG8_SA(0, 0), cA, voffA); PG8_STAGE(PG8_SB(0, 1), cB + hstep, voffB); PG8_STAGE(PG8_SA(0, 1), cA + hstep, voffA);
    if (wr == 1) PG8_BAR;
    PG8_WAIT_V(4); PG8_BAR;
    PG8_STAGE(PG8_SB(1, 0), cB + kstep, voffB); PG8_STAGE(PG8_SA(1, 0), cA + kstep, voffA); PG8_STAGE(PG8_SB(1, 1), cB + hstep + kstep, voffB);
    PG8_WAIT_V(6); PG8_BAR;
    PG8_STAMP();
    for (;;) {
        const bool has_next = S.next(ui + 1, nxt);
        const char* nA = has_next ? (const char*)g.A + (size_t)nxt.pm * tstep : cA; const char* nB = has_next ? (const char*)g.Bt + (size_t)nxt.pn * tstep : cB;
        for (int t = 0; t < nt; t += 2) {
            const bool last = (t == nt - 2);
            const char* a1 = cA + (size_t)(t + 1) * kstep;
            const char* a2 = last ? nA : cA + (size_t)(t + 2) * kstep; const char* b2 = last ? nB : cB + (size_t)(t + 2) * kstep;
            const char* a3 = a2 + kstep; const char* b3 = b2 + kstep;
            if (last && has_next) S.a_ready(nxt);
            PG8_LDB(B0, 0, 0); PG8_SCHED; PG8_LDA(At, 0, 0); PG8_STAGE(PG8_SA(1, 1), a1 + hstep, voffA);
            PG8_WAIT_L(8); PG8_BAR; PG8_WAIT_L(0); PG8_MMA(0, 0, At, B0); PG8_BAR; PG8_SCHED;
            PG8_LDB(B1, 0, 1); PG8_STAGE(PG8_SB(0, 0), b2, voffB);
            PG8_BAR; PG8_WAIT_L(0); PG8_MMA(0, 1, At, B1); PG8_BAR;
            PG8_LDA(At, 0, 1); PG8_STAGE(PG8_SA(0, 0), a2, voffA);
            PG8_BAR; PG8_WAIT_L(0); PG8_MMA(1, 0, At, B0); PG8_BAR; PG8_SCHED;
            PG8_STAGE(PG8_SB(0, 1), b2 + hstep, voffB);
            PG8_WAIT_V(6); PG8_BAR; PG8_MMA(1, 1, At, B1); PG8_BAR;
            PG8_LDB(B0, 1, 0); PG8_SCHED; PG8_LDA(At, 1, 0); PG8_STAGE(PG8_SA(0, 1), a2 + hstep, voffA);
            PG8_WAIT_L(8); PG8_BAR; PG8_WAIT_L(0); PG8_MMA(0, 0, At, B0); PG8_BAR; PG8_SCHED;
            PG8_LDB(B1, 1, 1); PG8_STAGE(PG8_SB(1, 0), b3, voffB);
            PG8_BAR; PG8_WAIT_L(0); PG8_MMA(0, 1, At, B1); PG8_BAR;
            PG8_LDA(At, 1, 1); PG8_STAGE(PG8_SA(1, 0), a3, voffA);
            PG8_BAR; PG8_WAIT_L(0); PG8_MMA(1, 0, At, B0); PG8_BAR; PG8_SCHED;
            PG8_STAGE(PG8_SB(1, 1), b3 + hstep, voffB);
            PG8_WAIT_V(6); PG8_BAR; PG8_MMA(1, 1, At, B1); PG8_BAR;
        }
        PG8_STAMP();
        if constexpr (Epi::FP8) asm volatile("s_nop 15\n\ts_nop 15" ::: "memory");
        if constexpr (!Epi::AFTER_DRAIN) { E(acc, cur, wr, wc, fr, fq); S.done(cur); }
        PG8_STAMP();
        if (!has_next) break;
#pragma unroll
        for (int a = 0; a < 2; ++a)
#pragma unroll
            for (int b = 0; b < 2; ++b)
#pragma unroll
                for (int m = 0; m < 4; ++m)
#pragma unroll
                    for (int n = 0; n < 2; ++n) acc[a][b][m][n] = (f32x4){0.f, 0.f, 0.f, 0.f};
        cur = nxt; cA = nA; cB = nB; ++ui;
    }
    PG8_WAIT_V(0);
    if (wr == 0) PG8_BAR;
    PG8_BAR;
    if constexpr (Epi::AFTER_DRAIN) { E.fused(acc, cur, wr, wc, fr, fq, lds, wid, lane); S.done(cur); }
    PG8_STAMP();
    if (STAMP && wid == 0) { stamps[lane] = lane < nts ? (((unsigned long long)(unsigned)ts_hi << 32) | (unsigned)ts_lo) : 0ull;
        if (lane == 62) stamps[62] = rt_entry; if (lane == 63) stamps[63] = (unsigned long long)wall_clock64(); }
#undef PG8_STAMP
#undef PG8_SA
#undef PG8_SB
#undef PG8_STAGE
#undef PG8_LDA
#undef PG8_LDB
#undef PG8_MMA
#undef PG8_WAIT_V
#undef PG8_WAIT_L
#undef PG8_BAR
#undef PG8_SCHED
}
}


DI void phase_wconv(LAS unsigned char* lds, const float* __restrict__ src, bf16_t* __restrict__ dst, int K, int N, int Npad, int bid, int nb, float q8s = 0.f, int colmap = 0, unsigned char* __restrict__ dst8 = nullptr, int n8_0 = 0) {
    LAS float* tile = (LAS float*)lds;
    const int tid = tid_opaque();
    const int tk = K / 64, tn = Npad / 256, total = tk * tn;
    for (int t = bid; t < total; t += nb) {
        const int k0 = (t % tk) * 64, n0 = (t / tk) * 256;
        __syncthreads();
        {
            const int ty = tid >> 6, tx = tid & 63, n = n0 + tx * 4;
            f32x4 v[8];
#pragma unroll
            for (int i = 0; i < 8; ++i) {
                const int k = k0 + ty + 8 * i;
                v[i] = (f32x4){0.f, 0.f, 0.f, 0.f};
                if (colmap) { const int ns = (n >> 7) * 256 + (colmap == 1 ? 128 : 0) + (n & 127); v[i] = *(const f32x4*)(src + (size_t)k * (2 * N) + ns); }
                else if (n < N) v[i] = *(const f32x4*)(src + (size_t)k * N + n);
            }
#pragma unroll
            for (int i = 0; i < 8; ++i) { LAS float* pp = tile + (ty + 8 * i) * 257 + tx * 4; pp[0] = v[i][0]; pp[1] = v[i][1]; pp[2] = v[i][2]; pp[3] = v[i][3]; }
        }
        __syncthreads();
#pragma unroll
        for (int ps_ = 0; ps_ < 4; ++ps_) {
            const int n = (tid >> 3) + 64 * ps_, kc = tid & 7;
            float v[8];
#pragma unroll
            for (int j = 0; j < 8; ++j) { v[j] = tile[(kc * 8 + j) * 257 + n]; if (q8s > 0.f) v[j] = emu_q8(v[j], q8s); else if (q8s < 0.f && n0 + n >= C_ZC) v[j] = emu_q8(v[j], -q8s); }
            u32x4 w; w.x = pk2(v[0], v[1]); w.y = pk2(v[2], v[3]); w.z = pk2(v[4], v[5]); w.w = pk2(v[6], v[7]);
            *(u32x4*)(dst + (size_t)(n0 + n) * K + k0 + kc * 8) = w;
            if (dst8 && n0 + n >= n8_0) { u32x2 b; b.x = pk4_fp8(v[0] * 64.0f, v[1] * 64.0f, v[2] * 64.0f, v[3] * 64.0f); b.y = pk4_fp8(v[4] * 64.0f, v[5] * 64.0f, v[6] * 64.0f, v[7] * 64.0f);
                *(u32x2*)(dst8 + (size_t)(n0 + n - n8_0) * K + k0 + kc * 8) = b; }
        }
    }
}

DI void phase_rmsnorm(const float* __restrict__ x, const float* __restrict__ gain, bf16_t* __restrict__ h, int bid, int nb, float q8s = 0.f, unsigned char* __restrict__ h8 = nullptr) {
    const int tid = tid_opaque(); const int lane = tid & 63, wid = tid >> 6;
    for (int row = bid * 8 + wid; row < MTOK; row += nb * 8) {
        const float* xr = x + (size_t)row * DM;
        f32x4 v[16]; float ss = 0.f;
#pragma unroll
        for (int i = 0; i < 16; ++i) { v[i] = *(const f32x4*)(xr + (i * 64 + lane) * 4); ss += v[i][0] * v[i][0] + v[i][1] * v[i][1] + v[i][2] * v[i][2] + v[i][3] * v[i][3]; }
#pragma unroll
        for (int o = 32; o >= 1; o >>= 1) ss += __shfl_xor(ss, o);
        const float rstd = rsqrtf(ss * (1.0f / DM) + EPSN);
        bf16_t* hr = h + (size_t)row * DM;
#pragma unroll
        for (int i = 0; i < 16; ++i) { const f32x4 g = *(const f32x4*)(gain + (i * 64 + lane) * 4);
            float y0 = v[i][0] * rstd * g[0], y1 = v[i][1] * rstd * g[1], y2 = v[i][2] * rstd * g[2], y3 = v[i][3] * rstd * g[3];
            if (q8s > 0.f || (q8s < 0.f && (row & 4095) >= 256)) { const float qa = fabsf(q8s); y0 = emu_q8(y0, qa); y1 = emu_q8(y1, qa); y2 = emu_q8(y2, qa); y3 = emu_q8(y3, qa); }
            u32x2 w; w.x = pk2(y0, y1); w.y = pk2(y2, y3);
            *(u32x2*)(hr + (i * 64 + lane) * 4) = w;
            if (h8) *(unsigned*)(h8 + (size_t)row * DM + (i * 64 + lane) * 4) = pk4_fp8(y0 * 16.0f, y1 * 16.0f, y2 * 16.0f, y3 * 16.0f); }
    }
}

DI void ld192(const bf16_t* p, int j8, float (&v)[24]) {
#pragma unroll
    for (int c = 0; c < 3; ++c) { const u32x4 w = *(const u32x4*)(p + (j8 + 8 * c) * 8);
        v[c * 8 + 0] = bflo(w.x); v[c * 8 + 1] = bfhi(w.x); v[c * 8 + 2] = bflo(w.y); v[c * 8 + 3] = bfhi(w.y);
        v[c * 8 + 4] = bflo(w.z); v[c * 8 + 5] = bfhi(w.z); v[c * 8 + 6] = bflo(w.w); v[c * 8 + 7] = bfhi(w.w); }
}
DI void st192(bf16_t* p, int j8, const float (&v)[24]) {
#pragma unroll
    for (int c = 0; c < 3; ++c) { u32x4 w; w.x = pk2(v[c * 8 + 0], v[c * 8 + 1]); w.y = pk2(v[c * 8 + 2], v[c * 8 + 3]); w.z = pk2(v[c * 8 + 4], v[c * 8 + 5]); w.w = pk2(v[c * 8 + 6], v[c * 8 + 7]);
        *(u32x4*)(p + (j8 + 8 * c) * 8) = w; }
}
DI float sum8(float s) { s += __shfl_xor(s, 1); s += __shfl_xor(s, 2); s += __shfl_xor(s, 4); return s; }

DI void phase_nsa_prep(const Params& P, int bid, int nb) {
    bf16_t* Y0 = (bf16_t*)(P.ws + OFF_Y0);
    bf16_t* KS = (bf16_t*)(P.ws + OFF_KS); bf16_t* KW = (bf16_t*)(P.ws + OFF_KW);
    bf16_t* ACK = (bf16_t*)(P.ws + OFF_ACK); bf16_t* ACV = (bf16_t*)(P.ws + OFF_ACV);
    const int tid = tid_opaque(), grp = (tid >> 3) & 15, j8 = tid & 7;
    for (int tok = bid * 4 + (tid >> 7); tok < MTOK; tok += nb * 4) {
        const int b = tok / SEQ, s = tok % SEQ;
        bf16_t* yr = Y0 + (size_t)tok * N1P;
        if (grp < 8) {
            const int g = grp & 3, br = grp >> 2;
            float v[24]; ld192(yr + (br ? C_KVW : C_KVS) + g * DK, j8, v);
            float ss = 0.f;
#pragma unroll
            for (int i = 0; i < 24; ++i) ss += v[i] * v[i];
            ss = sum8(ss);
            const float rstd = rsqrtf(ss * (1.0f / DK) + EPSN);
            const float* kn = P.nsa_k_norm + (br ? 2 : 1) * DK;
#pragma unroll
            for (int c = 0; c < 3; ++c)
#pragma unroll
                for (int e = 0; e < 8; ++e) v[c * 8 + e] *= rstd * kn[(j8 + 8 * c) * 8 + e];
            st192((br ? KW : KS) + ((size_t)(b * NG + g) * SEQ + s) * DK, j8, v);
        } else if (grp < 12) {
            const int g = grp - 8;
            float v[24]; ld192(yr + C_KVC + g * DK, j8, v);
#pragma unroll
            for (int k = 0; k < 2; ++k) {
                const int n = (s >> 4) - k, l = s - 16 * n;
                if (n >= 0 && n <= 254) {
                    float w[24];
#pragma unroll
                    for (int c = 0; c < 3; ++c)
#pragma unroll
                        for (int e = 0; e < 8; ++e) w[c * 8 + e] = v[c * 8 + e] + P.pe_k[l * DK + (j8 + 8 * c) * 8 + e];
                    st192(ACK + ((size_t)((b * NG + g) * 256 + n)) * 6144 + l * DK, j8, w);
                }
            }
        } else if (grp < 16) {
            const int g = grp - 12;
            const bf16_t* src = yr + C_KVC + NG * DK + g * DV;
            float v[16];
#pragma unroll
            for (int c = 0; c < 2; ++c) { const u32x4 w = *(const u32x4*)(src + (j8 + 8 * c) * 8);
                v[c * 8 + 0] = bflo(w.x); v[c * 8 + 1] = bfhi(w.x); v[c * 8 + 2] = bflo(w.y); v[c * 8 + 3] = bfhi(w.y);
                v[c * 8 + 4] = bflo(w.z); v[c * 8 + 5] = bfhi(w.z); v[c * 8 + 6] = bflo(w.w); v[c * 8 + 7] = bfhi(w.w); }
#pragma unroll
            for (int k = 0; k < 2; ++k) {
                const int n = (s >> 4) - k, l = s - 16 * n;
                if (n >= 0 && n <= 254) {
                    bf16_t* dst = ACV + ((size_t)((b * NG + g) * 256 + n)) * 4096 + l * DV;
#pragma unroll
                    for (int c = 0; c < 2; ++c) { float w[8];
#pragma unroll
                        for (int e = 0; e < 8; ++e) w[e] = v[c * 8 + e] + P.pe_v[l * DV + (j8 + 8 * c) * 8 + e];
                        u32x4 o; o.x = pk2(w[0], w[1]); o.y = pk2(w[2], w[3]); o.z = pk2(w[4], w[5]); o.w = pk2(w[6], w[7]);
                        *(u32x4*)(dst + (j8 + 8 * c) * 8) = o; }
                }
            }
        }
    }
    for (int i = bid * 512 + tid; i < 16 * (6144 + 4096) / 8; i += nb * 512) {
        const int per = (6144 + 4096) / 8, bg = i / per, c = i % per;
        const u32x4 z = {0u, 0u, 0u, 0u};
        if (c < 6144 / 8) *(u32x4*)(ACK + ((size_t)(bg * 256 + 255)) * 6144 + c * 8) = z;
        else *(u32x4*)(ACV + ((size_t)(bg * 256 + 255)) * 4096 + (c - 6144 / 8) * 8) = z;
    }
}

DI int swap23(int p) { return (p & ~0xC) | ((p & 4) << 1) | ((p & 8) >> 1); }
DI void phase_vt(LAS unsigned char* lds, const bf16_t* __restrict__ src, size_t src_stride, int col0, int col_step, int nhv, bf16_t* __restrict__ dst, int bid, int nb) {
    LAS bf16_t* tile = (LAS bf16_t*)lds;
    const int tid = tid_opaque();
    const int ntile = SEQ / 64, total = BATCH * nhv * ntile;
    for (int it = bid; it < total; it += nb) {
        const int mat = it / ntile, tt = it % ntile, b = mat / nhv, hv = mat % nhv;
        __syncthreads();
#pragma unroll
        for (int i = 0; i < 2; ++i) {
            const int q = tid + 512 * i, tok = q >> 4, ch = q & 15;
            const u32x4 w = *(const u32x4*)(src + (size_t)(b * SEQ + tt * 64 + tok) * src_stride + col0 + hv * col_step + ch * 8);
            *(LAS u32x4*)(tile + tok * 136 + ch * 8) = w;
        }
        __syncthreads();
        {
            const int dv = tid >> 2, kq = tid & 3;
            unsigned w[8];
#pragma unroll
            for (int e = 0; e < 8; ++e) {
                const int p0 = kq * 16 + 2 * e, p1 = p0 + 1;
                const int k0 = vt_key_of_pos(p0), k1 = vt_key_of_pos(p1);
                w[e] = (unsigned)tile[k0 * 136 + dv] | ((unsigned)tile[k1 * 136 + dv] << 16);
            }
            bf16_t* d = dst + ((size_t)mat * DV + dv) * SEQ + tt * 64 + kq * 16;
            u32x4 a = {w[0], w[1], w[2], w[3]}, c = {w[4], w[5], w[6], w[7]};
            *(u32x4*)d = a; *(u32x4*)(d + 8) = c;
        }
    }
}

DI void phase_cmp2(LAS unsigned char* lds, const Params& P, int bid, int nb) {
    LAS float* sk = (LAS float*)lds;
    LAS float* sv = sk + 192;
    LAS float* red = sv + 128;
    const float* HIDK = (const float*)(P.ws + OFF_HIDK); const float* HIDV = (const float*)(P.ws + OFF_HIDV);
    bf16_t* KC = (bf16_t*)(P.ws + OFF_KC); bf16_t* VTC = (bf16_t*)(P.ws + OFF_VTC);
    const int tid = tid_opaque(), lane = tid & 63, wid = tid >> 6;
    for (int m = bid; m < 4096; m += nb) {
        const int n = m & 255, bg = m >> 8;
        __syncthreads();
        if (tid < 192) { const float h = HIDK[(size_t)m * 256 + tid]; sk[tid] = h / (1.0f + __expf(-h)); }
        else if (tid < 320) { const float h = HIDV[(size_t)m * 256 + tid - 192]; sv[tid - 192] = h / (1.0f + __expf(-h)); }
        __syncthreads();
        float acc = 0.f;
        if (tid < 192) { for (int i = 0; i < 192; ++i) acc += sk[i] * P.w2_k[i * 192 + tid]; }
        else if (tid < 320) { const int j = tid - 192; for (int i = 0; i < 128; ++i) acc += sv[i] * P.w2_v[i * 128 + j]; }
        float ss = (tid < 192) ? acc * acc : 0.f;
#pragma unroll
        for (int o = 32; o >= 1; o >>= 1) ss += __shfl_xor(ss, o);
        if (lane == 0) red[wid] = ss;
        __syncthreads();
        const float tot = red[0] + red[1] + red[2];
        const float rstd = rsqrtf(tot * (1.0f / DK) + EPSN);
        if (tid < 192) { const float o = (n == 255) ? 0.f : acc * rstd * P.nsa_k_norm[tid];
            KC[(size_t)m * DK + tid] = (bf16_t)(pk2(o, 0.f) & 0xffffu); }
        else if (tid < 320) { const int j = tid - 192; const float o = (n == 255) ? 0.f : acc;
            const int pn = vt_pos_of_key(n);
            VTC[((size_t)bg * DV + j) * 256 + pn] = (bf16_t)(pk2(o, 0.f) & 0xffffu); }
    }
}

DI void phase_mla_prep1(const Params& P, int bid, int nb) {
    const bf16_t* Y1 = (const bf16_t*)(P.ws + OFF_Y1);
    bf16_t* CQN = (bf16_t*)(P.ws + OFF_CQN); bf16_t* CKVN = (bf16_t*)(P.ws + OFF_CKVN); float* ROPE = (float*)(P.ws + OFF_ROPE);
    float* KPER = (float*)(P.ws + OFF_KPER); float* SSPE = (float*)(P.ws + OFF_SSPE);
    const int tid = tid_opaque(); const int lane = tid & 63, wid = tid >> 6;
    constexpr int TU = 4;
    for (int tok0 = (bid * 8 + wid) * TU; tok0 < MTOK; tok0 += nb * 8 * TU) {
        u32x4 wq[TU][3], wk[TU]; int pos[TU]; bf16_t kp1[TU], kp2[TU];
#pragma unroll
        for (int t = 0; t < TU; ++t) { const bf16_t* yr = Y1 + (size_t)(tok0 + t) * N3P;
#pragma unroll
            for (int c = 0; c < 3; ++c) wq[t][c] = *(const u32x4*)(yr + C3_CQ + (c * 64 + lane) * 8);
            wk[t] = *(const u32x4*)(yr + C3_CKV + lane * 8);
            pos[t] = P.pos[tok0 + t]; kp1[t] = yr[C3_KPE + (lane & 31)]; kp2[t] = yr[C3_KPE + 32 + (lane & 31)]; }
#pragma unroll
        for (int t = 0; t < TU; ++t) { const int tok = tok0 + t;
            {
                float v[24]; float ss = 0.f;
#pragma unroll
                for (int c = 0; c < 3; ++c) { const u32x4 w = wq[t][c];
                    v[c * 8 + 0] = bflo(w.x); v[c * 8 + 1] = bfhi(w.x); v[c * 8 + 2] = bflo(w.y); v[c * 8 + 3] = bfhi(w.y);
                    v[c * 8 + 4] = bflo(w.z); v[c * 8 + 5] = bfhi(w.z); v[c * 8 + 6] = bflo(w.w); v[c * 8 + 7] = bfhi(w.w); }
#pragma unroll
                for (int i = 0; i < 24; ++i) ss += v[i] * v[i];
#pragma unroll
                for (int o = 32; o >= 1; o >>= 1) ss += __shfl_xor(ss, o);
                const float rstd = rsqrtf(ss * (1.0f / QLORA) + EPSN);
#pragma unroll
                for (int c = 0; c < 3; ++c) { const float* g = P.mla_q_a_norm + (c * 64 + lane) * 8; const f32x4 g0 = *(const f32x4*)g, g1 = *(const f32x4*)(g + 4); u32x4 w;
                    w.x = pk2(v[c * 8 + 0] * rstd * g0[0], v[c * 8 + 1] * rstd * g0[1]); w.y = pk2(v[c * 8 + 2] * rstd * g0[2], v[c * 8 + 3] * rstd * g0[3]);
                    w.z = pk2(v[c * 8 + 4] * rstd * g1[0], v[c * 8 + 5] * rstd * g1[1]); w.w = pk2(v[c * 8 + 6] * rstd * g1[2], v[c * 8 + 7] * rstd * g1[3]);
                    *(u32x4*)(CQN + (size_t)tok * QLORA + (c * 64 + lane) * 8) = w; }
            }
            {
                float v[8]; float ss = 0.f; const u32x4 w0 = wk[t];
                v[0] = bflo(w0.x); v[1] = bfhi(w0.x); v[2] = bflo(w0.y); v[3] = bfhi(w0.y); v[4] = bflo(w0.z); v[5] = bfhi(w0.z); v[6] = bflo(w0.w); v[7] = bfhi(w0.w);
#pragma unroll
                for (int i = 0; i < 8; ++i) ss += v[i] * v[i];
#pragma unroll
                for (int o = 32; o >= 1; o >>= 1) ss += __shfl_xor(ss, o);
                const float rstd = rsqrtf(ss * (1.0f / KVLORA) + EPSN);
                const float* g = P.mla_kv_a_norm + lane * 8; const f32x4 g0 = *(const f32x4*)g, g1 = *(const f32x4*)(g + 4); u32x4 w;
                w.x = pk2(v[0] * rstd * g0[0], v[1] * rstd * g0[1]); w.y = pk2(v[2] * rstd * g0[2], v[3] * rstd * g0[3]);
                w.z = pk2(v[4] * rstd * g1[0], v[5] * rstd * g1[1]); w.w = pk2(v[6] * rstd * g1[2], v[7] * rstd * g1[3]);
                *(u32x4*)(CKVN + (size_t)tok * KVLORA + lane * 8) = w;
            }
            {
                const int i = lane & 31;
                const float invf = exp2f(-(float)i * (13.287712379549449f / 32.0f));
                const float ang = (float)pos[t] * invf;
                const double rev = (double)ang * 0.15915494309189533576888;
                const float fr = (float)(rev - __builtin_rint(rev));
                const float sn = __builtin_amdgcn_sinf(fr), cs = __builtin_amdgcn_cosf(fr);
                const float x1 = bf1(kp1[t]), x2 = bf1(kp2[t]);
                float ssp = x1 * x1 + x2 * x2;
#pragma unroll
                for (int o = 16; o >= 1; o >>= 1) ssp += __shfl_xor(ssp, o);
                const float a = x1 * P.mla_k_norm[128 + i], c = x2 * P.mla_k_norm[160 + i];
                if (lane < 32) { ROPE[(size_t)tok * 64 + i] = cs; ROPE[(size_t)tok * 64 + 32 + i] = sn;
                    KPER[(size_t)tok * 64 + i] = a * cs - c * sn; KPER[(size_t)tok * 64 + 32 + i] = c * cs + a * sn;
                    if (lane == 0) SSPE[tok] = ssp; }
            }
        }
    }
}

DI void phase_mla_prep2(const Params& P, int bid, int nb) {
    const bf16_t* KNM = (const bf16_t*)(P.ws + OFF_KNM); const bf16_t* Y1 = (const bf16_t*)(P.ws + OFF_Y1);
    bf16_t* KM = (bf16_t*)(P.ws + OFF_KM); const float* ROPE = (const float*)(P.ws + OFF_ROPE);
    const int tid = tid_opaque(), grp = tid >> 3, j8 = tid & 7;
    for (int tok = bid; tok < MTOK; tok += nb) {
        const int b = tok / SEQ, s = tok % SEQ;
        float cs[8], sn[8];
#pragma unroll
        for (int e = 0; e < 8; ++e) { const int i = (8 * j8 + e) & 31; cs[e] = ROPE[(size_t)tok * 64 + i]; sn[e] = ROPE[(size_t)tok * 64 + 32 + i]; }
        {
            const bf16_t* kn = KNM + (size_t)tok * (NH * 128) + grp * 128;
            const bf16_t* kp = Y1 + (size_t)tok * N3P + C3_KPE;
            float v[24];
#pragma unroll
            for (int c = 0; c < 2; ++c) { const u32x4 w = *(const u32x4*)(kn + (j8 + 8 * c) * 8);
                v[c * 8 + 0] = bflo(w.x); v[c * 8 + 1] = bfhi(w.x); v[c * 8 + 2] = bflo(w.y); v[c * 8 + 3] = bfhi(w.y);
                v[c * 8 + 4] = bflo(w.z); v[c * 8 + 5] = bfhi(w.z); v[c * 8 + 6] = bflo(w.w); v[c * 8 + 7] = bfhi(w.w); }
            { const u32x4 w = *(const u32x4*)(kp + j8 * 8);
                v[16] = bflo(w.x); v[17] = bfhi(w.x); v[18] = bflo(w.y); v[19] = bfhi(w.y); v[20] = bflo(w.z); v[21] = bfhi(w.z); v[22] = bflo(w.w); v[23] = bfhi(w.w); }
            float ss = 0.f;
#pragma unroll
            for (int i = 0; i < 24; ++i) ss += v[i] * v[i];
            ss = sum8(ss);
            const float rstd = rsqrtf(ss * (1.0f / DK) + EPSN);
#pragma unroll
            for (int c = 0; c < 3; ++c)
#pragma unroll
                for (int e = 0; e < 8; ++e) v[c * 8 + e] *= rstd * P.mla_k_norm[(j8 + 8 * c) * 8 + e];
#pragma unroll
            for (int e = 0; e < 8; ++e) { const float mine = v[16 + e], other = __shfl_xor(mine, 4);
                v[16 + e] = (j8 < 4) ? (mine * cs[e] - other * sn[e]) : (mine * cs[e] + other * sn[e]); }
            st192(KM + ((size_t)(b * NH + grp) * SEQ + s) * DK, j8, v);
        }
    }
}
#ifndef ATT_THR
#define ATT_THR 30.0f
#endif
#ifndef ATT3_HOIST
#define ATT3_HOIST 1
#endif
#ifndef PROBE3_STORE2
#define PROBE3_STORE2 1
#endif
#ifndef PROBE3_UNITS
#define PROBE3_UNITS 1
#endif
#ifndef PROBE3_CMP
#define PROBE3_CMP 1
#endif
#ifndef PROBE3_SEL
#define PROBE3_SEL 1
#endif
#ifndef PROBE3_WIN
#define PROBE3_WIN 1
#endif
#ifndef ATT3_KD
#define ATT3_KD 4
#endif
#ifndef ATT3_VD
#define ATT3_VD 4
#endif
#ifndef ATT_PS_LIMIT
#define ATT_PS_LIMIT (16.0f * 1073741824.0f)
#endif
constexpr int KT_BYTES = 64 * 384, VT_BYTES = 128 * 128;
constexpr int L_K = 0, L_V = 2 * KT_BYTES, L_LUT = L_V + 2 * VT_BYTES, LUT_PITCH = 129, L_X = L_LUT + 64 * LUT_PITCH * 4 + 16, L_IL = L_X + 16 * 16 * 64 * 2, L_END = L_IL + 16 * 16 * 4;
static_assert(L_END <= 151552, "attention LDS");
enum { MODE_MLA = 0, MODE_SEL = 3, MODE_WIN = 4, MODE_CMPX = 5 };
#define MFMA16(a, b, c) __builtin_amdgcn_mfma_f32_16x16x32_bf16((a), (b), (c), 0, 0, 0)

struct AttnLane3 {
    int tw0, tw1;
    int r16, g;
    const LAS float* lutrow;
    unsigned long long mk0, mk1;
    int curblk;
    int tokbase;
    mutable float carry[2];
};
template <int MODE> DI int tq_of(const AttnLane3& A, int qb) { return (MODE == MODE_MLA) ? A.tw0 + 16 * qb + A.r16 : A.tw0 + qb; }

template <int MODE, int QS>
DI void attn_tile3(const LAS unsigned char* kb, const LAS unsigned char* vb, LAS unsigned char* lds, int j, const bf16x8 (&q)[2][6], f32x4 (&o)[8][2], float (&m_run)[2], float (&l_run)[2], const AttnLane3& A) {
    constexpr bool Q0 = (QS & 1) != 0, Q1 = (QS & 2) != 0;
    const int r16 = A.r16, g = A.g, sw = (r16 >> 1) & 7;
    const int kb0 = r16 * 384 + ((g ^ sw) << 4), kb1 = r16 * 384 + (((g ^ sw) ^ 4) << 4);
    const int vb0 = r16 * 128 + ((g ^ sw) << 4), vb1 = r16 * 128 + (((g ^ sw) ^ 4) << 4);
    f32x4 s[4][2];
    bool zinit = true;
    if (MODE == MODE_WIN || MODE == MODE_SEL) zinit = (A.tw0 - (64 * j + 63) >= 113);
    else if (MODE == MODE_CMPX) zinit = (A.tw0 - 31 - 16 * (64 * j + 63) >= 113);
    if (zinit) {
#pragma unroll
        for (int k4 = 0; k4 < 4; ++k4) { s[k4][0] = (f32x4){0.f, 0.f, 0.f, 0.f}; s[k4][1] = (f32x4){0.f, 0.f, 0.f, 0.f}; }
    } else {
#pragma unroll
        for (int qb = 0; qb < 2; ++qb) { if ((qb == 0 && !Q0) || (qb == 1 && !Q1)) continue;
            const int tq = tq_of<MODE>(A, qb);
#pragma unroll
            for (int k4 = 0; k4 < 4; ++k4)
#pragma unroll
                for (int r = 0; r < 4; ++r) { int d;
                    if (MODE == MODE_CMPX) d = tq - 31 - 16 * (64 * j + 16 * k4 + 4 * g + r); else d = tq - (64 * j + 16 * k4 + 4 * g + r);
                    d = d < 0 ? 0 : (d > 127 ? 127 : d); s[k4][qb][r] = A.lutrow[d] - m_run[qb]; } }
    }
    {
        constexpr int KD = ATT3_KD;
        bf16x8 kf[KD + 1];
#pragma unroll
        for (int i = 0; i < KD; ++i) kf[i] = *(const LAS bf16x8*)(kb + (((i % 6) & 1) ? kb1 : kb0) + ((i % 6) >> 1) * 128 + (i / 6) * (16 * 384));
        __builtin_amdgcn_sched_barrier(0);
#pragma unroll
        for (int i = 0; i < 24; ++i) {
            if (i + KD < 24) { const int n_ = i + KD; kf[n_ % (KD + 1)] = *(const LAS bf16x8*)(kb + (((n_ % 6) & 1) ? kb1 : kb0) + ((n_ % 6) >> 1) * 128 + (n_ / 6) * (16 * 384)); }
            __builtin_amdgcn_sched_barrier(0);
            if (Q0) s[i / 6][0] = MFMA16(kf[i % (KD + 1)], q[0][i % 6], s[i / 6][0]);
            if (Q1) s[i / 6][1] = MFMA16(kf[i % (KD + 1)], q[1][i % 6], s[i / 6][1]);
            __builtin_amdgcn_sched_barrier(0);
        }
    }
    if (zinit && __any(m_run[0] != 0.f || m_run[1] != 0.f)) {
#pragma unroll
        for (int k4 = 0; k4 < 4; ++k4)
#pragma unroll
            for (int r = 0; r < 4; ++r) { s[k4][0][r] -= m_run[0]; s[k4][1][r] -= m_run[1]; }
    }
    {
        const float NEG = -__builtin_inff();
        bool need;
        if (MODE == MODE_MLA) need = (64 * j + 63 > A.tw0);
        else if (MODE == MODE_WIN) need = !(64 * j + 63 <= A.tw0 && 64 * j >= A.tw1 - 511);
        else if (MODE == MODE_SEL) need = (j == A.curblk);
        else need = (A.tw0 - 31 - 16 * (64 * j + 63) < 0);
        if (need) {
#pragma unroll
            for (int qb = 0; qb < 2; ++qb) { if ((qb == 0 && !Q0) || (qb == 1 && !Q1)) continue;
                const int tq = tq_of<MODE>(A, qb);
#pragma unroll
                for (int k4 = 0; k4 < 4; ++k4)
#pragma unroll
                    for (int r = 0; r < 4; ++r) { const int c = 64 * j + 16 * k4 + 4 * g + r; bool kill;
                        if (MODE == MODE_WIN) kill = (unsigned)(tq - c) >= 512u;
                        else if (MODE == MODE_CMPX) kill = (tq - 31 - 16 * c) < 0;
                        else kill = (tq - c) < 0;
                        s[k4][qb][r] = kill ? NEG : s[k4][qb][r]; } }
        }
    }
    u32x4 pw[2][2];
#pragma unroll
    for (int qb = 0; qb < 2; ++qb) { if ((qb == 0 && !Q0) || (qb == 1 && !Q1)) continue;
        if (MODE == MODE_CMPX) {
            float lmx = fmaxf(fmaxf(s[0][qb][0], s[0][qb][1]), fmaxf(s[0][qb][2], s[0][qb][3]));
#pragma unroll
            for (int k4 = 1; k4 < 4; ++k4) lmx = fmaxf(lmx, fmaxf(fmaxf(s[k4][qb][0], s[k4][qb][1]), fmaxf(s[k4][qb][2], s[k4][qb][3])));
            if (__any(lmx > ATT_THR)) {
                float mx = fmaxf(lmx, __shfl_xor(lmx, 16)); mx = fmaxf(mx, __shfl_xor(mx, 32));
                const float dl = fmaxf(mx, 0.f), alpha = __builtin_amdgcn_exp2f(-dl);
                m_run[qb] += dl; l_run[qb] *= alpha; A.carry[qb] *= alpha;
#pragma unroll
                for (int db = 0; db < 8; ++db) o[db][qb] *= alpha;
#pragma unroll
                for (int k4 = 0; k4 < 4; ++k4) s[k4][qb] -= dl;
                LAS bf16_t* X = (LAS bf16_t*)(lds + L_X) + ((A.tokbase + qb) * 16 + r16) * 64;
                for (int a = g; a < 16 * j; a += 4) X[a] = (bf16_t)(pk2(bf1(X[a]) * alpha, 0.f) & 0xffffu);
            }
        }
        float ps = 0.f; f32x4 e[4];
#pragma unroll
        for (int k4 = 0; k4 < 4; ++k4) { e[k4][0] = __builtin_amdgcn_exp2f(s[k4][qb][0]); e[k4][1] = __builtin_amdgcn_exp2f(s[k4][qb][1]); e[k4][2] = __builtin_amdgcn_exp2f(s[k4][qb][2]); e[k4][3] = __builtin_amdgcn_exp2f(s[k4][qb][3]);
            ps += (e[k4][0] + e[k4][1]) + (e[k4][2] + e[k4][3]); }
        if (MODE != MODE_CMPX) {
            if (__any(!(ps <= ATT_PS_LIMIT))) {
                float mx = fmaxf(fmaxf(s[0][qb][0], s[0][qb][1]), fmaxf(s[0][qb][2], s[0][qb][3]));
#pragma unroll
                for (int k4 = 1; k4 < 4; ++k4) mx = fmaxf(mx, fmaxf(fmaxf(s[k4][qb][0], s[k4][qb][1]), fmaxf(s[k4][qb][2], s[k4][qb][3])));
                mx = fmaxf(mx, __shfl_xor(mx, 16)); mx = fmaxf(mx, __shfl_xor(mx, 32));
                const float dl = fmaxf(mx, 0.f), alpha = __builtin_amdgcn_exp2f(-dl);
                m_run[qb] += dl; l_run[qb] *= alpha;
#pragma unroll
                for (int db = 0; db < 8; ++db) o[db][qb] *= alpha;
                ps = 0.f;
#pragma unroll
                for (int k4 = 0; k4 < 4; ++k4) { e[k4][0] = __builtin_amdgcn_exp2f(s[k4][qb][0] - dl); e[k4][1] = __builtin_amdgcn_exp2f(s[k4][qb][1] - dl); e[k4][2] = __builtin_amdgcn_exp2f(s[k4][qb][2] - dl); e[k4][3] = __builtin_amdgcn_exp2f(s[k4][qb][3] - dl);
                    ps += (e[k4][0] + e[k4][1]) + (e[k4][2] + e[k4][3]); }
            }
        } else {
            LAS bf16_t* X = (LAS bf16_t*)(lds + L_X) + ((A.tokbase + qb) * 16 + r16) * 64;
#pragma unroll
            for (int k4 = 0; k4 < 4; ++k4) {
                const float y = __shfl(e[k4][3], (r16 + 16 * g + 48) & 63);
                const float prev = g ? y : A.carry[qb];
                if (g == 0) A.carry[qb] = y;
                X[16 * j + 4 * k4 + g] = (bf16_t)(pk2((e[k4][0] + e[k4][1]) + (e[k4][2] + e[k4][3]) + prev, 0.f) & 0xffffu);
            }
        }
        l_run[qb] += ps;
        pw[0][qb].x = pk2(e[0][0], e[0][1]); pw[0][qb].y = pk2(e[0][2], e[0][3]); pw[0][qb].z = pk2(e[1][0], e[1][1]); pw[0][qb].w = pk2(e[1][2], e[1][3]);
        pw[1][qb].x = pk2(e[2][0], e[2][1]); pw[1][qb].y = pk2(e[2][2], e[2][3]); pw[1][qb].z = pk2(e[3][0], e[3][1]); pw[1][qb].w = pk2(e[3][2], e[3][3]);
    }
    {
        constexpr int VD = ATT3_VD;
        bf16x8 vf[VD + 1];
#pragma unroll
        for (int i = 0; i < VD; ++i) vf[i] = *(const LAS bf16x8*)(vb + ((i >> 3) ? vb1 : vb0) + (i & 7) * (16 * 128));
        __builtin_amdgcn_sched_barrier(0);
#pragma unroll
        for (int i = 0; i < 16; ++i) {
            if (i + VD < 16) { const int n_ = i + VD; vf[n_ % (VD + 1)] = *(const LAS bf16x8*)(vb + ((n_ >> 3) ? vb1 : vb0) + (n_ & 7) * (16 * 128)); }
            __builtin_amdgcn_sched_barrier(0);
            if (Q0) o[i & 7][0] = MFMA16(vf[i % (VD + 1)], __builtin_bit_cast(bf16x8, pw[i >> 3][0]), o[i & 7][0]);
            if (Q1) o[i & 7][1] = MFMA16(vf[i % (VD + 1)], __builtin_bit_cast(bf16x8, pw[i >> 3][1]), o[i & 7][1]);
            __builtin_amdgcn_sched_barrier(0);
        }
    }
}

DI void attn_issue_first(LAS unsigned char* lds, const char* __restrict__ Kc, const char* __restrict__ Vc, int vt_stride, int j) {
    int tid = threadIdx.x; asm volatile("" : "+v"(tid));
    const int lane = tid & 63;
    const int wid_ = __builtin_amdgcn_readfirstlane(tid >> 6);
    const char* kp_ = Kc + (size_t)j * KT_BYTES; LAS unsigned char* kb_ = lds + L_K + wid_ * 3072;
#pragma unroll
    for (int i_ = 0; i_ < 3; ++i_) { const int pidx_ = (wid_ * 3 + i_) * 64 + lane, row_ = pidx_ / 24, cp_ = pidx_ % 24;
        __builtin_amdgcn_global_load_lds((const unsigned*)(kp_ + (unsigned)(row_ * 384 + ((cp_ ^ ((row_ >> 1) & 7)) << 4))), (LAS unsigned*)(kb_ + i_ * 1024), 16, 0, 0); }
    const char* vp_ = Vc + (size_t)j * 128; LAS unsigned char* vb_ = lds + L_V + wid_ * 2048;
#pragma unroll
    for (int i_ = 0; i_ < 2; ++i_) { const int pidx_ = (wid_ * 2 + i_) * 64 + lane, row_ = pidx_ >> 3, cp_ = pidx_ & 7;
        __builtin_amdgcn_global_load_lds((const unsigned*)(vp_ + (unsigned)(row_ * vt_stride * 2 + ((cp_ ^ ((row_ >> 1) & 7)) << 4))), (LAS unsigned*)(vb_ + i_ * 1024), 16, 0, 0); }
}

template <int MODE>
DI void attn_pass3x(LAS unsigned char* lds, const char* __restrict__ Kc, const char* __restrict__ Vc, int vt_stride, int j_lo, int j_hi,
                    const bf16x8 (&q)[2][6], f32x4 (&o)[8][2], float (&m_run)[2], float (&l_run)[2], const AttnLane3& A, bool first_issued = false) {
    if (j_lo >= j_hi) return;
    int tid = threadIdx.x; asm volatile("" : "+v"(tid));
    const int lane = tid & 63;
    const int wid_ = __builtin_amdgcn_readfirstlane(tid >> 6);
    unsigned kgo[3], vgo[2];
#pragma unroll
    for (int i_ = 0; i_ < 3; ++i_) { const int pidx_ = (wid_ * 3 + i_) * 64 + lane, row_ = pidx_ / 24, cp_ = pidx_ % 24; kgo[i_] = (unsigned)(row_ * 384 + ((cp_ ^ ((row_ >> 1) & 7)) << 4)); }
#pragma unroll
    for (int i_ = 0; i_ < 2; ++i_) { const int pidx_ = (wid_ * 2 + i_) * 64 + lane, row_ = pidx_ >> 3, cp_ = pidx_ & 7; vgo[i_] = (unsigned)(row_ * vt_stride * 2 + ((cp_ ^ ((row_ >> 1) & 7)) << 4)); }
#define ST_ISSUE(j, buf) do { const char* kp_ = Kc + (size_t)(j) * KT_BYTES; LAS unsigned char* kb_ = lds + L_K + (buf) * KT_BYTES + wid_ * 3072; \
        _Pragma("unroll") for (int i_ = 0; i_ < 3; ++i_) __builtin_amdgcn_global_load_lds((const unsigned*)(kp_ + kgo[i_]), (LAS unsigned*)(kb_ + i_ * 1024), 16, 0, 0); \
        const char* vp_ = Vc + (size_t)(j) * 128; LAS unsigned char* vb_ = lds + L_V + (buf) * VT_BYTES + wid_ * 2048; \
        _Pragma("unroll") for (int i_ = 0; i_ < 2; ++i_) __builtin_amdgcn_global_load_lds((const unsigned*)(vp_ + vgo[i_]), (LAS unsigned*)(vb_ + i_ * 1024), 16, 0, 0); } while (0)
    if (!first_issued) ST_ISSUE(j_lo, 0);
    asm volatile("s_waitcnt vmcnt(0)" ::: "memory");
    __syncthreads();
    for (int j = j_lo; j < j_hi; ++j) {
        const int cur = (j - j_lo) & 1;
        if (j + 1 < j_hi) ST_ISSUE(j + 1, cur ^ 1);
        const LAS unsigned char* kbp = lds + L_K + cur * KT_BYTES; const LAS unsigned char* vbp = lds + L_V + cur * VT_BYTES;
        if (MODE == MODE_SEL) {
            const bool a0 = ((A.mk0 >> j) & 1ull) != 0ull, a1 = ((A.mk1 >> j) & 1ull) != 0ull;
            if (a0 && a1) attn_tile3<MODE, 3>(kbp, vbp, lds, j, q, o, m_run, l_run, A);
            else if (a0) attn_tile3<MODE, 1>(kbp, vbp, lds, j, q, o, m_run, l_run, A);
            else if (a1) attn_tile3<MODE, 2>(kbp, vbp, lds, j, q, o, m_run, l_run, A);
        } else {
            bool act;
            if (MODE == MODE_MLA) act = 64 * j <= A.tw1;
            else if (MODE == MODE_CMPX) act = 1024 * j + 31 <= A.tw1;
            else act = (64 * j <= A.tw1) && (64 * j + 63 >= A.tw0 - 511);
            if (act) attn_tile3<MODE, 3>(kbp, vbp, lds, j, q, o, m_run, l_run, A);
        }
        asm volatile("s_waitcnt vmcnt(0)" ::: "memory");
        __syncthreads();
    }
#undef ST_ISSUE
}

DI int t5_bucket(int n) {
    if (n < 16) return n;
    return 16 + (n >= 19) + (n >= 21) + (n >= 24) + (n >= 27) + (n >= 31) + (n >= 35) + (n >= 40) + (n >= 46) + (n >= 52) + (n >= 59) + (n >= 67) + (n >= 77) + (n >= 87) + (n >= 99) + (n >= 113);
}
DI float silu_f(float z) { return z * __builtin_amdgcn_rcpf(1.0f + __builtin_amdgcn_exp2f(-1.4426950408889634f * z)); }

constexpr int EPI_PITCH = 272, EPI_WAVE_BYTES = 32 * EPI_PITCH;
template <bool RMW, bool NSA>
DI void attn_epilogue3(LAS unsigned char* lds, int lane, int wid, const f32x4 (&o)[8][2], float scale0, float scale1,
                       const char* __restrict__ zbase, unsigned z0, char* __restrict__ obase, unsigned o0, bool dostore = true) {
    LAS unsigned char* sc = lds + wid * EPI_WAVE_BYTES;
    const int r16 = lane & 15, g = lane >> 4;
#pragma unroll
    for (int h = 0; h < 2; ++h) {
#pragma unroll
        for (int d4 = 0; d4 < 4; ++d4) {
            *(LAS f32x4*)(sc + r16 * EPI_PITCH + (16 * d4 + 4 * g) * 4) = o[4 * h + d4][0] * scale0;
            *(LAS f32x4*)(sc + (16 + r16) * EPI_PITCH + (16 * d4 + 4 * g) * 4) = o[4 * h + d4][1] * scale1;
        }
        asm volatile("" ::: "memory");
#pragma unroll
        for (int i = 0; i < 4; ++i) {
            const int rr = 8 * i + (lane >> 3), c8 = lane & 7;
            const f32x4 a = *(const LAS f32x4*)(sc + rr * EPI_PITCH + c8 * 32);
            const f32x4 b = *(const LAS f32x4*)(sc + rr * EPI_PITCH + c8 * 32 + 16);
            unsigned zoff, ooff;
            if (NSA) { zoff = z0 + (unsigned)((rr >> 4) * (N1P * 2) + (rr & 15) * 256); ooff = o0 + (unsigned)((rr >> 4) * (ZW8 * 2) + (rr & 15) * 256); }
            else     { zoff = z0 + (unsigned)(rr * (N3P * 2)); ooff = o0 + (unsigned)(rr * (ZW8 * 2)); }
            const unsigned cb = (unsigned)((64 * h + 8 * c8) * 2);
            if (!dostore) continue;
            const u32x4 zw = *(const u32x4*)(zbase + (zoff + cb));
            float v0 = a[0] * silu_f(bflo(zw.x)), v1 = a[1] * silu_f(bfhi(zw.x)), v2 = a[2] * silu_f(bflo(zw.y)), v3 = a[3] * silu_f(bfhi(zw.y));
            float v4 = b[0] * silu_f(bflo(zw.z)), v5 = b[1] * silu_f(bfhi(zw.z)), v6 = b[2] * silu_f(bflo(zw.w)), v7 = b[3] * silu_f(bfhi(zw.w));
            if (RMW) { const u32x4 pv = *(const u32x4*)(obase + (ooff + cb));
                v0 += bflo(pv.x); v1 += bfhi(pv.x); v2 += bflo(pv.y); v3 += bfhi(pv.y); v4 += bflo(pv.z); v5 += bfhi(pv.z); v6 += bflo(pv.w); v7 += bfhi(pv.w); }
            u32x4 w; w.x = pk2(v0, v1); w.y = pk2(v2, v3); w.z = pk2(v4, v5); w.w = pk2(v6, v7);
            *(u32x4*)(obase + (ooff + cb)) = w;
        }
        asm volatile("" ::: "memory");
    }
}
DI float sum_g(float v) { v += __shfl_xor(v, 16); v += __shfl_xor(v, 32); return v; }

DI void phase_nsa_attn(LAS unsigned char* lds, const Params& P, int bid, int nb) {
    const char* Y0c = (const char*)(P.ws + OFF_Y0);
    const char* KSc = (const char*)(P.ws + OFF_KS); const char* KWc = (const char*)(P.ws + OFF_KW);
    const char* VTSc = (const char*)(P.ws + OFF_VTS); const char* VTWc = (const char*)(P.ws + OFF_VTW);
    const char* KCc = (const char*)(P.ws + OFF_KC); const char* VTCc = (const char*)(P.ws + OFF_VTC);
    char* ONc = (char*)(P.ws + OFF_O);
    LAS float* lut = (LAS float*)(lds + L_LUT);
    const int total = BATCH * NG * 256;
    {
        const int tid0 = tid_opaque();
        __syncthreads();
        for (int i = tid0; i < 64 * 128; i += 512) { const int hd = i >> 7, d = i & 127; lut[hd * LUT_PITCH + d] = (P.rel_bias[t5_bucket(d) * NH + hd] - P.rel_bias[31 * NH + hd]) * LOG2E; }
        __syncthreads();
    }
    for (int u_ = bid; u_ < total * PROBE3_UNITS; u_ += nb) {
        const int u = (u_ >= total) ? u_ - total : u_;
        int tid = threadIdx.x; asm volatile("" : "+v"(tid));
        const int lane = tid & 63, wid = __builtin_amdgcn_readfirstlane(tid >> 6);
        const int pair = u >> 8; int c = u & 255; if (pair & 1) c = 255 - c;
        const int b = pair >> 2, gg = pair & 3, t0 = c * 16;
        __syncthreads();
        AttnLane3 A;
        A.r16 = lane & 15; A.g = lane >> 4;
        A.tw0 = t0 + 2 * wid; A.tw1 = A.tw0 + 1;
        const int hh = gg * NR + A.r16;
        A.lutrow = lut + hh * LUT_PITCH;
        A.curblk = t0 >> 6; A.tokbase = 2 * wid; A.mk0 = 0ull; A.mk1 = 0ull; A.carry[0] = 0.f; A.carry[1] = 0.f;
        const unsigned ytok0 = (unsigned)(b * SEQ + A.tw0) * (unsigned)(N1P * 2);
        const unsigned otok0 = ((unsigned)(b * SEQ + A.tw0) * (unsigned)ZW8 + (unsigned)(gg * NR * DV)) * 2u;
        const int bg = b * NG + gg;
        const int nct = (t0 + 15 >= 31) ? (((t0 + 15 - 31) >> 4) / 64 + 1) : 0;
        if (ATT3_HOIST && nct > 0) attn_issue_first(lds, KCc + (size_t)bg * 256 * DK * 2, VTCc + (size_t)bg * DV * 256 * 2, 256, 0);
        bf16x8 q[2][6];
#pragma unroll
        for (int qb = 0; qb < 2; ++qb) {
            const unsigned qo = ytok0 + (unsigned)(qb * (N1P * 2)) + (unsigned)((C_Q + hh * DK + 8 * A.g) * 2);
            float ss = 0.f;
#pragma unroll
            for (int ds = 0; ds < 6; ++ds) { q[qb][ds] = *(const bf16x8*)(Y0c + (qo + 64u * ds));
                const u32x4 w = __builtin_bit_cast(u32x4, q[qb][ds]);
                const float a0 = bflo(w.x), a1 = bfhi(w.x), a2 = bflo(w.y), a3 = bfhi(w.y), a4 = bflo(w.z), a5 = bfhi(w.z), a6 = bflo(w.w), a7 = bfhi(w.w);
                ss += (a0 * a0 + a1 * a1) + (a2 * a2 + a3 * a3) + (a4 * a4 + a5 * a5) + (a6 * a6 + a7 * a7); }
            ss = sum_g(ss);
            const float rstd = rsqrtf(ss * (1.0f / DK) + EPSN) * QSCALE;
#pragma unroll
            for (int ds = 0; ds < 6; ++ds) { const float* gn = P.nsa_q_norm + 32 * ds + 8 * A.g; const f32x4 g0 = *(const f32x4*)gn, g1 = *(const f32x4*)(gn + 4);
                u32x4 w = __builtin_bit_cast(u32x4, q[qb][ds]);
                w.x = pk2(bflo(w.x) * rstd * g0[0], bfhi(w.x) * rstd * g0[1]); w.y = pk2(bflo(w.y) * rstd * g0[2], bfhi(w.y) * rstd * g0[3]);
                w.z = pk2(bflo(w.z) * rstd * g1[0], bfhi(w.z) * rstd * g1[1]); w.w = pk2(bflo(w.w) * rstd * g1[2], bfhi(w.w) * rstd * g1[3]);
                q[qb][ds] = __builtin_bit_cast(bf16x8, w); }
        }
        f32x4 o[8][2]; float m_run[2], l_run[2];
#define RESET_STATE() do { _Pragma("unroll") for (int d_ = 0; d_ < 8; ++d_) { o[d_][0] = (f32x4){0.f, 0.f, 0.f, 0.f}; o[d_][1] = (f32x4){0.f, 0.f, 0.f, 0.f}; } m_run[0] = 0.f; m_run[1] = 0.f; l_run[0] = 0.f; l_run[1] = 0.f; } while (0)
#define GATE_SIG(x, qb) (1.0f / (1.0f + __expf(-bf1(*(const bf16_t*)(Y0c + (ytok0 + (unsigned)((qb) * (N1P * 2)) + (unsigned)((C_G + (x) * NH + hh) * 2)))))))
        RESET_STATE();
        attn_pass3x<MODE_CMPX>(lds, KCc + (size_t)bg * 256 * DK * 2, VTCc + (size_t)bg * DV * 256 * 2, 256, 0, nct, q, o, m_run, l_run, A, ATT3_HOIST != 0);
        { const float lt0 = sum_g(l_run[0]), lt1 = sum_g(l_run[1]); const float il0 = lt0 > 0.f ? 1.0f / lt0 : 0.f, il1 = lt1 > 0.f ? 1.0f / lt1 : 0.f;
          if (lane < 16) { ((LAS float*)(lds + L_IL))[(A.tokbase + 0) * 16 + A.r16] = il0; ((LAS float*)(lds + L_IL))[(A.tokbase + 1) * 16 + A.r16] = il1; }
          attn_epilogue3<false, true>(lds, lane, wid, o, GATE_SIG(0, 0) * il0, GATE_SIG(0, 1) * il1, Y0c, ytok0 + (unsigned)((C_ZC + gg * NR * DV) * 2), ONc, otok0, PROBE3_STORE2 || u_ < total); }
        __syncthreads();
        if (ATT3_HOIST) attn_issue_first(lds, KSc + (size_t)bg * SEQ * DK * 2, VTSc + (size_t)bg * DV * SEQ * 2, SEQ, 0);
        {
            const int cur = A.curblk;
            unsigned long long mk[2];
#pragma unroll
            for (int t = 0; t < 2; ++t) {
                const LAS bf16_t* X = (const LAS bf16_t*)(lds + L_X) + (2 * wid + t) * 16 * 64;
                const LAS float* IL = (const LAS float*)(lds + L_IL) + (2 * wid + t) * 16;
                const bool forced = (lane == 0) || (lane == cur) || (lane == cur - 1);
                const bool future = lane > cur;
                float v = 0.f;
                if (!forced && !future) {
#pragma unroll
                    for (int rr = 0; rr < 16; ++rr) v += IL[rr] * bf1(X[rr * 64 + lane]); }
                unsigned key = (__float_as_uint(v) & ~63u);
                if (forced) key = 0x7f800000u; else if (future) key = 0u;
                key |= (unsigned)(63 - lane);
                int rank = 0;
#pragma unroll
                for (int jp = 0; jp < 64; ++jp) { const unsigned kj = (unsigned)__builtin_amdgcn_readlane((int)key, jp); rank += (kj > key) ? 1 : 0; }
                mk[t] = __ballot(rank < 16 && !future);
            }
            A.mk0 = mk[0]; A.mk1 = mk[1];
        }
        RESET_STATE();
        attn_pass3x<MODE_SEL>(lds, KSc + (size_t)bg * SEQ * DK * 2, VTSc + (size_t)bg * DV * SEQ * 2, SEQ, 0, A.curblk + 1, q, o, m_run, l_run, A, ATT3_HOIST != 0);
        { const float lt0 = sum_g(l_run[0]), lt1 = sum_g(l_run[1]);
          attn_epilogue3<true, true>(lds, lane, wid, o, GATE_SIG(1, 0) / lt0, GATE_SIG(1, 1) / lt1, Y0c, ytok0 + (unsigned)((C_ZS + gg * NR * DV) * 2), ONc, otok0, PROBE3_STORE2 || u_ < total); }
        __syncthreads();
        RESET_STATE();
        { const int jl = (t0 - 511) > 0 ? (t0 - 511) >> 6 : 0, jh = ((t0 + 15) >> 6) + 1;
          for (int prb_ = 0; prb_ < PROBE3_WIN; ++prb_) attn_pass3x<MODE_WIN>(lds, KWc + (size_t)bg * SEQ * DK * 2, VTWc + (size_t)bg * DV * SEQ * 2, SEQ, jl, jh, q, o, m_run, l_run, A); }
        { const float lt0 = sum_g(l_run[0]), lt1 = sum_g(l_run[1]);
          attn_epilogue3<true, true>(lds, lane, wid, o, GATE_SIG(2, 0) / lt0, GATE_SIG(2, 1) / lt1, Y0c, ytok0 + (unsigned)((C_ZW + gg * NR * DV) * 2), ONc, otok0, PROBE3_STORE2 || u_ < total); }
#undef RESET_STATE
#undef GATE_SIG
    }
}

DI void phase_mla_attn(LAS unsigned char* lds, const Params& P, int bid, int nb) {
    const char* QMc = (const char*)(P.ws + OFF_QM); const char* KMc = (const char*)(P.ws + OFF_KM); const char* VTMc = (const char*)(P.ws + OFF_VTM);
    const char* Y1c = (const char*)(P.ws + OFF_Y1); char* OMc = (char*)(P.ws + OFF_O);
    const int total = BATCH * NH * 16;
    for (int uu = 0; bid + (uu >> 1) * nb < total / 2; ++uu) {
        int tid = threadIdx.x; asm volatile("" : "+v"(tid));
        const int lane = tid & 63, wid = __builtin_amdgcn_readfirstlane(tid >> 6);
        const int item = bid + (uu >> 1) * nb, second = uu & 1;
        const int xcd = item & 7, tt = item >> 3, p = tt & 7, hl = (tt >> 3) & 3, rnd = tt >> 5;
        const int bh = rnd * 32 + xcd * 4 + hl, qblk = second ? p : 15 - p, b = bh >> 6, h = bh & 63, t0 = qblk * 256;
        AttnLane3 A;
        A.r16 = lane & 15; A.g = lane >> 4;
        A.tw0 = t0 + 32 * wid; A.tw1 = A.tw0 + 31;
        A.lutrow = nullptr; A.curblk = 0; A.tokbase = 0; A.mk0 = 0ull; A.mk1 = 0ull; A.carry[0] = 0.f; A.carry[1] = 0.f;
        bf16x8 q[2][6];
#pragma unroll
        for (int qb = 0; qb < 2; ++qb) {
            const unsigned trow = (unsigned)(b * SEQ + A.tw0 + 16 * qb + A.r16);
            const unsigned qo = (trow * (unsigned)NQB + (unsigned)(h * DK + 8 * A.g)) * 2u;
            float ss = 0.f;
#pragma unroll
            for (int ds = 0; ds < 6; ++ds) { q[qb][ds] = *(const bf16x8*)(QMc + (qo + 64u * ds));
                const u32x4 w = __builtin_bit_cast(u32x4, q[qb][ds]);
                const float a0 = bflo(w.x), a1 = bfhi(w.x), a2 = bflo(w.y), a3 = bfhi(w.y), a4 = bflo(w.z), a5 = bfhi(w.z), a6 = bflo(w.w), a7 = bfhi(w.w);
                ss += (a0 * a0 + a1 * a1) + (a2 * a2 + a3 * a3) + (a4 * a4 + a5 * a5) + (a6 * a6 + a7 * a7); }
            ss = sum_g(ss);
            const float rstd = rsqrtf(ss * (1.0f / DK) + EPSN);
            const float* ropep = (const float*)(P.ws + OFF_ROPE) + (size_t)trow * 64;
#pragma unroll
            for (int ds = 0; ds < 4; ++ds) { const float* gn = P.mla_q_norm + 32 * ds + 8 * A.g; const f32x4 g0 = *(const f32x4*)gn, g1 = *(const f32x4*)(gn + 4);
                const float sc = rstd * QSCALE;
                u32x4 w = __builtin_bit_cast(u32x4, q[qb][ds]);
                w.x = pk2(bflo(w.x) * sc * g0[0], bfhi(w.x) * sc * g0[1]); w.y = pk2(bflo(w.y) * sc * g0[2], bfhi(w.y) * sc * g0[3]);
                w.z = pk2(bflo(w.z) * sc * g1[0], bfhi(w.z) * sc * g1[1]); w.w = pk2(bflo(w.w) * sc * g1[2], bfhi(w.w) * sc * g1[3]);
                q[qb][ds] = __builtin_bit_cast(bf16x8, w); }
            {
                const int i0 = 8 * A.g;
                const float* g1p = P.mla_q_norm + 128 + i0; const float* g2p = P.mla_q_norm + 160 + i0;
                const u32x4 w1 = __builtin_bit_cast(u32x4, q[qb][4]), w2 = __builtin_bit_cast(u32x4, q[qb][5]);
                float x1[8] = {bflo(w1.x), bfhi(w1.x), bflo(w1.y), bfhi(w1.y), bflo(w1.z), bfhi(w1.z), bflo(w1.w), bfhi(w1.w)};
                float x2[8] = {bflo(w2.x), bfhi(w2.x), bflo(w2.y), bfhi(w2.y), bflo(w2.z), bfhi(w2.z), bflo(w2.w), bfhi(w2.w)};
                float y1[8], y2[8];
#pragma unroll
                for (int e = 0; e < 8; ++e) { const float cs = ropep[i0 + e], sn = ropep[32 + i0 + e];
                    const float a = x1[e] * rstd * g1p[e], c = x2[e] * rstd * g2p[e];
                    y1[e] = (a * cs - c * sn) * QSCALE; y2[e] = (c * cs + a * sn) * QSCALE; }
                u32x4 o1, o2;
                o1.x = pk2(y1[0], y1[1]); o1.y = pk2(y1[2], y1[3]); o1.z = pk2(y1[4], y1[5]); o1.w = pk2(y1[6], y1[7]);
                o2.x = pk2(y2[0], y2[1]); o2.y = pk2(y2[2], y2[3]); o2.z = pk2(y2[4], y2[5]); o2.w = pk2(y2[6], y2[7]);
                q[qb][4] = __builtin_bit_cast(bf16x8, o1); q[qb][5] = __builtin_bit_cast(bf16x8, o2);
            }
        }
        f32x4 o[8][2]; float m_run[2] = {0.f, 0.f}, l_run[2] = {0.f, 0.f};
#pragma unroll
        for (int d = 0; d < 8; ++d) { o[d][0] = (f32x4){0.f, 0.f, 0.f, 0.f}; o[d][1] = (f32x4){0.f, 0.f, 0.f, 0.f}; }
        attn_pass3x<MODE_MLA>(lds, KMc + (size_t)bh * SEQ * DK * 2, VTMc + (size_t)bh * DV * SEQ * 2, SEQ, 0, 4 * qblk + 4, q, o, m_run, l_run, A);
        const float lt0 = sum_g(l_run[0]), lt1 = sum_g(l_run[1]);
        { const unsigned t0w = (unsigned)(b * SEQ + A.tw0);
          attn_epilogue3<false, false>(lds, lane, wid, o, 1.0f / lt0, 1.0f / lt1, Y1c, (t0w * (unsigned)N3P + (unsigned)(C3_Z + h * DV)) * 2u, OMc, (t0w * (unsigned)ZW8 + (unsigned)(h * DV)) * 2u); }
        __syncthreads();
    }
}
constexpr int LDS_KN_OFF = 135168, LDS_ST_OFF = LDS_KN_OFF + 16384, LDS_BYTES = LDS_ST_OFF + 16;
constexpr int NPHASE = 14;

#ifndef USE_FP8M
#define USE_FP8M 0
#endif
#ifndef USE_FP8Z
#define USE_FP8Z 0
#endif
#ifndef DUP5
#define DUP5 0
#endif
#ifndef P3_GEMM_REP
#define P3_GEMM_REP 1
#endif
#ifndef P3_WCONV_REP
#define P3_WCONV_REP 1
#endif
template <int PH>
DI void run_phase(const Params& P, LAS unsigned char* lds, int bid, int nb) {
    unsigned char* ws = P.ws;
    if constexpr (PH == 0) {
        phase_wconv(lds, P.nsa_w_in, (bf16_t*)(ws + OFF_W1T), DM, N1, N1P, bid, nb, (FP8EMU & 4) ? 64.0f : 0.f, 0, USE_FP8Z ? (unsigned char*)(ws + OFF_B8) : nullptr, C_ZC);
        phase_wconv(lds, P.w1_k, (bf16_t*)(ws + OFF_W1K), 6144, 192, 256, bid, nb);
        phase_wconv(lds, P.w1_v, (bf16_t*)(ws + OFF_W1V), 4096, 128, 256, bid, nb);
        phase_rmsnorm(P.x, P.norm_w, (bf16_t*)(ws + OFF_H), bid, nb, (FP8EMU & 4) ? 16.0f : 0.f, USE_FP8Z ? (unsigned char*)(ws + OFF_A8) : nullptr);
    } else if constexpr (PH == 1) {
        if (USE_FP8Z) {
            {
                pg8::Gemm g{(const bf16_t*)(ws + OFF_H), (const bf16_t*)(ws + OFF_W1T), MTOK, N1P, DM};
                pg8::OrderBf16Part S{nb, bid, 63, 97};
                pg8::EpiStoreBf16 E{(bf16_t*)(ws + OFF_Y0), N1P};
                pg8::gemm_phase<pg8::EpiStoreBf16, pg8::OrderBf16Part, false>(lds, g, S, E, nullptr);
            }
            __syncthreads();
            {
                pg8::Gemm g{(const bf16_t*)(ws + OFF_A8), (const bf16_t*)(ws + OFF_B8), MTOK, NZ8, DM / 2};
                pg8::OrderFp8Part S{nb, bid, 97, 188};
                pg8::EpiStoreBf16Fp8 E{(bf16_t*)(ws + OFF_Y0) + C_ZC, N1P, 1.0f / (16.0f * 64.0f)};
                pg8::gemm_phase<pg8::EpiStoreBf16Fp8, pg8::OrderFp8Part, false>(lds, g, S, E, nullptr);
            }
        } else {
        pg8::Gemm g{(const bf16_t*)(ws + OFF_H), (const bf16_t*)(ws + OFF_W1T), MTOK, N1P, DM};
        pg8::StaticOrder S; S.init(g.M, g.N, nb, bid);
        pg8::EpiStoreBf16 E{(bf16_t*)(ws + OFF_Y0), N1P};
        pg8::gemm_phase<pg8::EpiStoreBf16, pg8::StaticOrder, false>(lds, g, S, E, nullptr);
        }
    } else if constexpr (PH == 2) {
        phase_nsa_prep(P, bid, nb);
        phase_vt(lds, (const bf16_t*)(ws + OFF_Y0), N1P, C_KVS + NG * DK, DV, NG, (bf16_t*)(ws + OFF_VTS), bid, nb);
        phase_vt(lds, (const bf16_t*)(ws + OFF_Y0), N1P, C_KVW + NG * DK, DV, NG, (bf16_t*)(ws + OFF_VTW), bid, nb);
    } else if constexpr (PH == 3) {
        for (int p3g_ = 0; p3g_ < ((bid < 32) ? P3_GEMM_REP : P3_WCONV_REP); ++p3g_) { if (p3g_) __syncthreads();
        if (bid < 16) {
            pg8::Gemm g{(const bf16_t*)(ws + OFF_ACK), (const bf16_t*)(ws + OFF_W1K), 4096, 256, 6144};
            pg8::StaticOrder S; S.init(g.M, g.N, 16, bid);
            pg8::EpiPlainF32 E{(float*)(ws + OFF_HIDK), 256};
            pg8::gemm_phase<pg8::EpiPlainF32, pg8::StaticOrder, false>(lds, g, S, E, nullptr);
        } else if (bid < 32) {
            pg8::Gemm g{(const bf16_t*)(ws + OFF_ACV), (const bf16_t*)(ws + OFF_W1V), 4096, 256, 4096};
            pg8::StaticOrder S; S.init(g.M, g.N, 16, bid - 16);
            pg8::EpiPlainF32 E{(float*)(ws + OFF_HIDV), 256};
            pg8::gemm_phase<pg8::EpiPlainF32, pg8::StaticOrder, false>(lds, g, S, E, nullptr);
        } else {
            phase_wconv(lds, P.nsa_w_out, (bf16_t*)(ws + OFF_W2T), ZW8, DM, DM, bid - 32, nb - 32, (FP8EMU & 1) ? 64.0f : 0.f);
            phase_wconv(lds, P.mla_w_in, (bf16_t*)(ws + OFF_W3T), DM, N3, N3P, bid - 32, nb - 32, (FP8EMU & 8) ? 64.0f : 0.f, 0, USE_FP8M ? (unsigned char*)(ws + OFF_B8M) : nullptr, C3_Z8);
        }
        }
    } else if constexpr (PH == 4) {
        phase_cmp2(lds, P, bid, nb);
    } else if constexpr (PH == 5) {
        { float* ss1 = (float*)(ws + OFF_SS1); for (int i = bid * 512 + (int)threadIdx.x; i < MTOK; i += nb * 512) ss1[i] = 0.f; }
        phase_nsa_attn(lds, P, bid, nb);
    } else if constexpr (PH == 6) {
        pg8::Gemm g{(const bf16_t*)(ws + OFF_O), (const bf16_t*)(ws + OFF_W2T), MTOK, DM, ZW8};
        pg8::StaticOrder S; S.init(g.M, g.N, nb, bid);
        pg8::EpiResNorm E{P.x, P.out, DM, P.norm_w + DM, (bf16_t*)(ws + OFF_H), (float*)(ws + OFF_SS1), USE_FP8M ? (unsigned char*)(ws + OFF_A8M) : nullptr};
        pg8::gemm_phase<pg8::EpiResNorm, pg8::StaticOrder, false>(lds, g, S, E, nullptr);
    } else if constexpr (PH == 7) {
        phase_rmsnorm(P.out, P.norm_w + DM, (bf16_t*)(ws + OFF_H), bid, nb, (FP8EMU & 8) ? 16.0f : 0.f);
    } else if constexpr (PH == 8) {
        if (USE_FP8M) {
            {
                pg8::Gemm g{(const bf16_t*)(ws + OFF_H), (const bf16_t*)(ws + OFF_W3T), MTOK, N3P, DM};
                pg8::OrderBf16Part S{nb, bid, C3_Z8 / 256, NZ8M / 256};
                pg8::EpiStoreBf16RowScale E{(bf16_t*)(ws + OFF_Y1), N3P, (const float*)(ws + OFF_SS1), 1.0f / DM};
                pg8::gemm_phase<pg8::EpiStoreBf16RowScale, pg8::OrderBf16Part, false>(lds, g, S, E, nullptr);
            }
            __syncthreads();
            {
                pg8::Gemm g{(const bf16_t*)(ws + OFF_A8M), (const bf16_t*)(ws + OFF_B8M), MTOK, NZ8M, DM / 2};
                pg8::OrderFp8Part S{nb, bid, NZ8M / 256, 64};
                pg8::EpiStoreBf16RowScaleFp8 E{(bf16_t*)(ws + OFF_Y1) + C3_Z8, N3P, (const float*)(ws + OFF_SS1), 1.0f / DM, 1.0f / (16.0f * 64.0f)};
                pg8::gemm_phase<pg8::EpiStoreBf16RowScaleFp8, pg8::OrderFp8Part, false>(lds, g, S, E, nullptr);
            }
        } else {
        pg8::Gemm g{(const bf16_t*)(ws + OFF_H), (const bf16_t*)(ws + OFF_W3T), MTOK, N3P, DM};
        pg8::StaticOrder S; S.init(g.M, g.N, nb, bid);
        pg8::EpiStoreBf16RowScale E{(bf16_t*)(ws + OFF_Y1), N3P, (const float*)(ws + OFF_SS1), 1.0f / DM};
        pg8::gemm_phase<pg8::EpiStoreBf16RowScale, pg8::StaticOrder, false>(lds, g, S, E, nullptr);
        }
        __syncthreads();
        if (bid >= 64 && nb > 64) {
            phase_wconv(lds, P.mla_w_q_b, (bf16_t*)(ws + OFF_W4T), QLORA, NQB, NQB, bid - 64, nb - 64);
            phase_wconv(lds, P.mla_w_kv_b, (bf16_t*)(ws + OFF_W5K), KVLORA, NKVB / 2, NKVB / 2, bid - 64, nb - 64, 0.f, 2);
            phase_wconv(lds, P.mla_w_kv_b, (bf16_t*)(ws + OFF_W5V), KVLORA, NKVB / 2, NKVB / 2, bid - 64, nb - 64, 0.f, 1);
            phase_wconv(lds, P.mla_w_out, (bf16_t*)(ws + OFF_W6T), ZW8, DM, DM, bid - 64, nb - 64, (FP8EMU & 2) ? 64.0f : 0.f);
        } else if (nb <= 64) {
            phase_wconv(lds, P.mla_w_q_b, (bf16_t*)(ws + OFF_W4T), QLORA, NQB, NQB, bid, nb);
            phase_wconv(lds, P.mla_w_kv_b, (bf16_t*)(ws + OFF_W5K), KVLORA, NKVB / 2, NKVB / 2, bid, nb, 0.f, 2);
            phase_wconv(lds, P.mla_w_kv_b, (bf16_t*)(ws + OFF_W5V), KVLORA, NKVB / 2, NKVB / 2, bid, nb, 0.f, 1);
            phase_wconv(lds, P.mla_w_out, (bf16_t*)(ws + OFF_W6T), ZW8, DM, DM, bid, nb, (FP8EMU & 2) ? 64.0f : 0.f);
        }
    } else if constexpr (PH == 9) {
        phase_mla_prep1(P, bid, nb);
    } else if constexpr (PH == 10) {
        {
            pg8::Gemm g{(const bf16_t*)(ws + OFF_CQN), (const bf16_t*)(ws + OFF_W4T), MTOK, NQB, QLORA};
            pg8::StaticOrder S; S.init(g.M, g.N, nb, bid);
            pg8::EpiStoreBf16 E{(bf16_t*)(ws + OFF_QM), NQB};
            pg8::gemm_phase<pg8::EpiStoreBf16, pg8::StaticOrder, false>(lds, g, S, E, nullptr);
        }
        __syncthreads();
        {
            pg8::Gemm g{(const bf16_t*)(ws + OFF_CKVN), (const bf16_t*)(ws + OFF_W5K), MTOK, NKVB / 2, KVLORA};
            pg8::StaticOrder S; S.init(g.M, g.N, nb, bid);
            pg8::EpiKNorm E{(bf16_t*)(ws + OFF_KM), (const float*)(ws + OFF_SSPE), (const float*)(ws + OFF_KPER), P.mla_k_norm, (LAS float*)(lds + LDS_KN_OFF), 0u};
            pg8::gemm_phase<pg8::EpiKNorm, pg8::StaticOrder, false>(lds, g, S, E, nullptr);
        }
        __syncthreads();
        {
            pg8::Gemm g{(const bf16_t*)(ws + OFF_W5V), (const bf16_t*)(ws + OFF_CKVN), NKVB / 2, MTOK, KVLORA};
            pg8::StaticOrder S; S.init(g.M, g.N, nb, bid);
            pg8::EpiVT E{(bf16_t*)(ws + OFF_VTM)};
            pg8::gemm_phase<pg8::EpiVT, pg8::StaticOrder, false>(lds, g, S, E, nullptr);
        }
    } else if constexpr (PH == 11) {
    } else if constexpr (PH == 12) {
        phase_mla_attn(lds, P, bid, nb);
    } else if constexpr (PH == 13) {
        pg8::Gemm g{(const bf16_t*)(ws + OFF_O), (const bf16_t*)(ws + OFF_W6T), MTOK, DM, ZW8};
        pg8::StaticOrder S; S.init(g.M, g.N, nb, bid);
        pg8::EpiResF32 E{P.out, P.out, DM};
        pg8::gemm_phase<pg8::EpiResF32, pg8::StaticOrder, false>(lds, g, S, E, nullptr);
    }
}

#ifndef REP0
#define REP0 1
#endif
#ifndef REP1
#define REP1 1
#endif
#ifndef REP2
#define REP2 1
#endif
#ifndef REP3
#define REP3 1
#endif
#ifndef REP4
#define REP4 1
#endif
#ifndef REP5
#define REP5 1
#endif
#ifndef REP6
#define REP6 1
#endif
#ifndef REP7
#define REP7 1
#endif
#ifndef REP8
#define REP8 1
#endif
#ifndef REP9
#define REP9 1
#endif
#ifndef REP10
#define REP10 1
#endif
#ifndef REP11
#define REP11 1
#endif
#ifndef REP12
#define REP12 1
#endif
#ifndef REP13
#define REP13 1
#endif

__global__ __launch_bounds__(512, 2) void k_mega(Params P) {
    extern __shared__ __attribute__((aligned(16))) unsigned char shm[];
    LAS unsigned char* lds = (LAS unsigned char*)shm;
    volatile LAS unsigned* st = (volatile LAS unsigned*)(lds + LDS_ST_OFF);
    if (threadIdx.x == 0) { st[0] = 0u; st[1] = 0u; st[2] = 0u; st[3] = 0u; }
    __syncthreads();
    XcdBarrier bar = xcd_barrier_post((unsigned*)(P.ws + OFF_CTL), st);
    const int bid = (int)blockIdx.x, nb = (int)gridDim.x;
    for (int rep_ = 0; rep_ < REP0; ++rep_) run_phase<0>(P, lds, bid, nb);  xcd_barrier(bar);
    for (int rep_ = 0; rep_ < REP1; ++rep_) run_phase<1>(P, lds, bid, nb);  xcd_barrier(bar);
    for (int rep_ = 0; rep_ < REP2; ++rep_) run_phase<2>(P, lds, bid, nb);  xcd_barrier(bar);
    for (int rep_ = 0; rep_ < REP3; ++rep_) run_phase<3>(P, lds, bid, nb);  xcd_barrier(bar);
    for (int rep_ = 0; rep_ < REP4; ++rep_) run_phase<4>(P, lds, bid, nb);  xcd_barrier(bar);
    for (int rep_ = 0; rep_ < REP5; ++rep_) run_phase<5>(P, lds, bid, nb);
#if DUP5
    __syncthreads(); run_phase<5>(P, lds, bid, nb);
#endif
    xcd_barrier(bar);
    for (int rep_ = 0; rep_ < REP6; ++rep_) run_phase<6>(P, lds, bid, nb);  xcd_barrier(bar);
    for (int rep_ = 0; rep_ < REP8; ++rep_) run_phase<8>(P, lds, bid, nb);  xcd_barrier(bar);
    for (int rep_ = 0; rep_ < REP9; ++rep_) run_phase<9>(P, lds, bid, nb);  xcd_barrier(bar);
    for (int rep_ = 0; rep_ < REP10; ++rep_) run_phase<10>(P, lds, bid, nb); xcd_barrier(bar);
    for (int rep_ = 0; rep_ < REP12; ++rep_) run_phase<12>(P, lds, bid, nb); xcd_barrier(bar);
    for (int rep_ = 0; rep_ < REP13; ++rep_) run_phase<13>(P, lds, bid, nb);
}

extern "C" void kernel_launch(void* const* d_in, const int* in_sizes, int n_in, void* d_out, int out_size, void* d_ws, size_t ws_size, hipStream_t stream) {
    (void)in_sizes; (void)n_in; (void)out_size;
    if (ws_size < WS_END) return;
    Params P{};
    P.x = (const float*)d_in[0]; P.pos = (const int*)d_in[1]; P.norm_w = (const float*)d_in[2]; P.rel_bias = (const float*)d_in[3];
    P.nsa_w_in = (const float*)d_in[4]; P.nsa_q_norm = (const float*)d_in[5]; P.nsa_k_norm = (const float*)d_in[6]; P.pe_k = (const float*)d_in[7];
    P.w1_k = (const float*)d_in[8]; P.w2_k = (const float*)d_in[9]; P.pe_v = (const float*)d_in[10]; P.w1_v = (const float*)d_in[11]; P.w2_v = (const float*)d_in[12];
    P.nsa_w_out = (const float*)d_in[13]; P.mla_w_in = (const float*)d_in[14]; P.mla_q_a_norm = (const float*)d_in[15]; P.mla_w_q_b = (const float*)d_in[16];
    P.mla_kv_a_norm = (const float*)d_in[17]; P.mla_w_kv_b = (const float*)d_in[18]; P.mla_q_norm = (const float*)d_in[19]; P.mla_k_norm = (const float*)d_in[20];
    P.mla_w_out = (const float*)d_in[21];
    P.out = (float*)d_out; P.ws = (unsigned char*)d_ws;
    static int grid = 0;
    if (!grid) {
        int dev = 0, cus = 0, per_cu = 0; (void)hipGetDevice(&dev);
        if (hipDeviceGetAttribute(&cus, hipDeviceAttributeMultiprocessorCount, dev) != hipSuccess || cus <= 0) cus = 256;
        (void)hipFuncSetAttribute((const void*)k_mega, hipFuncAttributeMaxDynamicSharedMemorySize, LDS_BYTES);
        if (hipOccupancyMaxActiveBlocksPerMultiprocessor(&per_cu, k_mega, 512, LDS_BYTES) != hipSuccess || per_cu < 1) per_cu = 1;
        grid = cus;
    }
    (void)hipMemsetAsync((unsigned char*)d_ws + OFF_CTL, 0, XCD_BAR_WORDS * sizeof(unsigned), stream);
    hipLaunchKernelGGL(k_mega, dim3(grid), dim3(512), LDS_BYTES, stream, P);
}
```

```cpp
#define ATT16 1
#define USE_FP8Z 1
#define USE_FP8M 1
#define USE_FP8O 1
#define USE_FP8N 1
#define GEMM_NT 1
#include <hip/hip_runtime.h>
#include <stdint.h>
#include <stddef.h>

#define DI __device__ __forceinline__
#define LAS __attribute__((address_space(3)))
typedef unsigned short bf16_t;
typedef short bf16x8 __attribute__((ext_vector_type(8)));
typedef float f32x4 __attribute__((ext_vector_type(4)));
typedef float f32x16 __attribute__((ext_vector_type(16)));
typedef unsigned u32x4 __attribute__((ext_vector_type(4)));
typedef unsigned u32x2 __attribute__((ext_vector_type(2)));
typedef __bf16 bf2_t __attribute__((ext_vector_type(2)));
typedef float f2_t __attribute__((ext_vector_type(2)));

DI int tid_opaque() { int t = (int)threadIdx.x; asm volatile("" : "+v"(t)); return t; }
DI unsigned pk2(float a, float b) { f2_t f = {a, b}; bf2_t v = __builtin_convertvector(f, bf2_t); return __builtin_bit_cast(unsigned, v); }
DI unsigned pk4_fp8(float a, float b, float c, float d) { int w = 0; w = __builtin_amdgcn_cvt_pk_fp8_f32(a, b, w, false); w = __builtin_amdgcn_cvt_pk_fp8_f32(c, d, w, true); return (unsigned)w; }
DI float clamp_fp8(float v) { float r; asm("v_max_f32 %0, 0xc3e00000, %1\n\tv_min_f32 %0, 0x43e00000, %0" : "=v"(r) : "v"(v)); return r; }
DI unsigned pk4_fp8c(float a, float b, float c, float d) { return pk4_fp8(clamp_fp8(a), clamp_fp8(b), clamp_fp8(c), clamp_fp8(d)); }
DI float bflo(unsigned w) { return __uint_as_float(w << 16); }
DI float bfhi(unsigned w) { return __uint_as_float(w & 0xffff0000u); }
#ifndef USE_FP8N
#define USE_FP8N 0
#endif
#ifndef USE_FP8O
#define USE_FP8O 0
#endif
#ifndef GEMM_NT
#define GEMM_NT 0
#endif
#ifndef FP8EMU
#define FP8EMU 0
#endif
DI float emu_q8(float x, float s) { float y = x * s; const float ay = fabsf(y);
    if (ay < 0.015625f) y = rintf(y * 512.0f) * (1.0f / 512.0f);
    else { unsigned u = __float_as_uint(y); u = (u + 0x0007FFFFu + ((u >> 20) & 1u)) & 0xFFF00000u; y = __uint_as_float(u); }
    y = fminf(fmaxf(y, -448.0f), 448.0f); return y / s; }
DI float bf1(bf16_t h) { return __uint_as_float(((unsigned)h) << 16); }

#ifndef ATT16
#define ATT16 0
#endif
DI int vt_key_of_pos(int p) {
#if ATT16
    return (p & ~31) | (((p >> 2) & 1) << 4) | (((p >> 3) & 3) << 2) | (p & 3);
#else
    return (p & ~0xC) | ((p & 4) << 1) | ((p & 8) >> 1);
#endif
}
DI int vt_pos_of_key(int k) {
#if ATT16
    return (k & ~31) | (((k >> 2) & 3) << 3) | (((k >> 4) & 1) << 2) | (k & 3);
#else
    return (k & ~0xC) | ((k & 4) << 1) | ((k & 8) >> 1);
#endif
}
constexpr int BATCH = 4, SEQ = 4096, DM = 4096, MTOK = BATCH * SEQ;
constexpr int NH = 64, NG = 4, NR = 16, DK = 192, DV = 128;
constexpr int N1 = 40896, N1P = 40960;
constexpr int C_Q = 0, C_KVC = 12288, C_KVS = 13568, C_KVW = 14848, C_ZC = 16128, C_ZS = 24320, C_ZW = 32512, C_G = 40704;
constexpr int N3 = 10304, N3P = 10496;
constexpr int C3_CQ = 0, C3_CKV = 1536, C3_KPE = 2048, C3_Z = 2112;
constexpr int QLORA = 1536, KVLORA = 512;
constexpr int NQB = 12288, NKVB = 16384, ZW8 = 8192;
constexpr float EPSN = 1e-6f;
constexpr float LOG2E = 1.4426950408889634f;
constexpr float QSCALE = 0.07216878364870322f * 1.4426950408889634f;

constexpr size_t SZ_W1T = (size_t)N1P * DM * 2, SZ_W2T = (size_t)DM * ZW8 * 2, SZ_W3T = (size_t)N3P * DM * 2, SZ_W4T = (size_t)NQB * QLORA * 2,
                 SZ_W5T = (size_t)NKVB * KVLORA * 2, SZ_W6T = (size_t)DM * ZW8 * 2;
constexpr size_t OFF_W1T = 0, OFF_W2T = OFF_W1T + SZ_W1T, OFF_W3T = OFF_W2T + SZ_W2T, OFF_W4T = OFF_W3T + SZ_W3T, OFF_W5T = OFF_W4T + SZ_W4T,
                 OFF_W6T = OFF_W5T + SZ_W5T, OFF_W1K = OFF_W6T + SZ_W6T;
constexpr size_t OFF_W5K = OFF_W5T, OFF_W5V = OFF_W5T + SZ_W5T / 2;
constexpr size_t SZ_W1K = (size_t)256 * 6144 * 2, SZ_W1V = (size_t)256 * 4096 * 2;
constexpr size_t OFF_W1V = OFF_W1K + SZ_W1K, OFF_CTL = OFF_W1V + SZ_W1V, OFF_H = OFF_CTL + 65536;
constexpr size_t SZ_H = (size_t)MTOK * DM * 2, SZ_KS = (size_t)BATCH * NG * SEQ * DK * 2, SZ_VTS = (size_t)BATCH * NG * DV * SEQ * 2,
                 SZ_ACK = (size_t)4096 * 6144 * 2, SZ_ACV = (size_t)4096 * 4096 * 2;
constexpr size_t OFF_KS = OFF_H + SZ_H, OFF_KW = OFF_KS + SZ_KS, OFF_VTS = OFF_KW + SZ_KS, OFF_VTW = OFF_VTS + SZ_VTS, OFF_ACK = OFF_VTW + SZ_VTS,
                 OFF_ACV = OFF_ACK + SZ_ACK, OFF_KC = OFF_ACV + SZ_ACV;
constexpr size_t SZ_KC = (size_t)16 * 256 * DK * 2, SZ_VTC = (size_t)16 * DV * 256 * 2, SZ_HID = (size_t)4096 * 256 * 4;
constexpr size_t OFF_VTC = OFF_KC + SZ_KC, OFF_HIDK = OFF_VTC + SZ_VTC, OFF_HIDV = OFF_HIDK + SZ_HID, OFF_Y0 = OFF_HIDV + SZ_HID;
constexpr size_t SZ_Y0 = (size_t)MTOK * N1P * 2, SZ_O = (size_t)MTOK * ZW8 * 2;
constexpr size_t OFF_O = OFF_Y0 + SZ_Y0, WS_END = OFF_O + SZ_O;
constexpr size_t OFF_SS1 = OFF_HIDK;
constexpr size_t OFF_A8 = OFF_O, OFF_B8 = OFF_O + (size_t)MTOK * DM;
#ifndef F8_Q0
#define F8_Q0 0
#define F8_NQ 63
#endif
constexpr size_t OFF_B8M = OFF_W1T, OFF_A8M = OFF_W1T + (64ull << 20);
constexpr int C3_Z8 = 2304, NZ8M = 8192;
constexpr size_t OFF_W28 = OFF_W1T + (132ull << 20), OFF_O8N = OFF_W1T + (168ull << 20);
static_assert(OFF_O8N + (size_t)MTOK * ZW8 <= OFF_W1T + SZ_W1T, "fp8 NSA out-proj buffers");
constexpr float O8N_SCALE = 64.0f;
constexpr float O8_SCALE = 128.0f;
constexpr size_t OFF_KM = 0;
constexpr size_t SZ_KM = (size_t)BATCH * NH * SEQ * DK * 2;
static_assert(SZ_KM <= SZ_W1T + SZ_W2T, "KM alias");
constexpr size_t OFF_VTM = OFF_H;
constexpr size_t SZ_VTM = (size_t)BATCH * NH * DV * SEQ * 2;
constexpr size_t OFF_CKVN = OFF_VTM + SZ_VTM;
constexpr size_t SZ_CKVN = (size_t)MTOK * KVLORA * 2;
static_assert(OFF_CKVN + SZ_CKVN <= OFF_KC, "CKVN alias");
constexpr size_t OFF_Y1 = OFF_Y0, SZ_Y1 = (size_t)MTOK * N3P * 2;
constexpr size_t OFF_QM = OFF_Y1 + SZ_Y1, SZ_QM = (size_t)MTOK * NQB * 2;
constexpr size_t OFF_KVM = OFF_QM + SZ_QM, SZ_KVM = (size_t)MTOK * NKVB * 2;
constexpr size_t OFF_KNM = OFF_KVM;
constexpr size_t OFF_KPER = OFF_KVM, OFF_SSPE = OFF_KVM + (size_t)MTOK * 64 * 4;
constexpr size_t OFF_O8M = OFF_KVM + SZ_KVM / 2, OFF_W68 = OFF_O8M + (size_t)MTOK * ZW8;
static_assert(OFF_W68 + (size_t)DM * ZW8 <= OFF_KVM + SZ_KVM, "fp8 out-proj buffers");
constexpr size_t OFF_CQN = OFF_KVM + SZ_KVM, SZ_CQN = (size_t)MTOK * QLORA * 2;
constexpr size_t OFF_ROPE = OFF_CQN + SZ_CQN, SZ_ROPE = (size_t)MTOK * 64 * 4;
static_assert(OFF_ROPE + SZ_ROPE <= OFF_O, "layer-1 alias region");
static_assert(WS_END <= 2680160256ull, "workspace");

struct Params {
    const float* x; const int* pos; const float* norm_w; const float* rel_bias;
    const float* nsa_w_in; const float* nsa_q_norm; const float* nsa_k_norm; const float* pe_k; const float* w1_k; const float* w2_k;
    const float* pe_v; const float* w1_v; const float* w2_v; const float* nsa_w_out;
    const float* mla_w_in; const float* mla_q_a_norm; const float* mla_w_q_b; const float* mla_kv_a_norm; const float* mla_w_kv_b;
    const float* mla_q_norm; const float* mla_k_norm; const float* mla_w_out;
    float* out; unsigned char* ws;
};

#define XB_TMO      128
#define XB_XCNT(j)  (256  + 64 * (j))
#define XB_XSUB(j)  (1280 + 64 * (j))
#define XB_XGEN(j)  (2304 + 64 * (j))
#define XB_TOP      3328
#define XB_TOPGEN   3392
#define XCD_BAR_WORDS 3456
#define XB_SPIN_CAP (1u << 18)

__device__ __forceinline__ unsigned xb_ld(unsigned* p)              { return __hip_atomic_load(p, __ATOMIC_RELAXED, __HIP_MEMORY_SCOPE_AGENT); }
__device__ __forceinline__ unsigned xb_add(unsigned* p, unsigned v) { return __hip_atomic_fetch_add(p, v, __ATOMIC_RELAXED, __HIP_MEMORY_SCOPE_AGENT); }
__device__ __forceinline__ unsigned xb_xcc_id() { return (unsigned)__builtin_amdgcn_s_getreg((3 << 11) | 20) & 0xFu; }
#define XB_SPIN(cond, bar) do { unsigned _sp = 0; while (cond) { __builtin_amdgcn_s_sleep(1); \
    if ((++_sp & 255u) == 0u) { if (xb_ld(&(bar)[XB_TMO])) break; if (_sp > XB_SPIN_CAP) { atomicAdd(&(bar)[XB_TMO], 1u); break; } } } } while (0)

struct XcdBarrier {
    unsigned* bar; unsigned x;
    volatile LAS unsigned* st;
};

__device__ __forceinline__ XcdBarrier xcd_barrier_post(unsigned* bar, volatile LAS unsigned* st) {
    XcdBarrier b; b.bar = bar; b.x = xb_xcc_id(); b.st = st;
    if (threadIdx.x == 0) (void)xb_add(&bar[XB_XCNT(b.x)], 1u);
    return b;
}
__device__ __forceinline__ void xcd_barrier_complete(unsigned* bar, unsigned x, unsigned& nloc, unsigned& nx) {
    const unsigned G = gridDim.x * gridDim.y * gridDim.z;
    unsigned sum, cnt, mine, sp = 0u;
    for (;;) {
        sum = 0u; cnt = 0u; mine = 0u;
#pragma unroll
        for (unsigned j = 0; j < 16; ++j) { const unsigned c = xb_ld(&bar[XB_XCNT(j)]); sum += c; cnt += (c > 0u) ? 1u : 0u; mine = (j == x) ? c : mine; }
        if (sum == G) break;
        __builtin_amdgcn_s_sleep(1);
        if ((++sp & 255u) == 0u) { if (xb_ld(&bar[XB_TMO])) break; if (sp > XB_SPIN_CAP) { atomicAdd(&bar[XB_TMO], 1u); break; } }
    }
    nloc = mine > 0u ? mine : 1u; nx = cnt > 0u ? cnt : 1u;
}

__device__ __forceinline__ void xcd_barrier(const XcdBarrier& b) {
    asm volatile("s_waitcnt vmcnt(0)" ::: "memory");
    __syncthreads();
    if (threadIdx.x == 0) {
        unsigned* bar = b.bar;
        __builtin_amdgcn_s_waitcnt(0);
        unsigned nloc = b.st[0], nx = b.st[1];
        if (nloc == 0u) { xcd_barrier_complete(bar, b.x, nloc, nx); b.st[0] = nloc; b.st[1] = nx; }
        const unsigned old = xb_add(&bar[XB_XSUB(b.x)], 1u);
        const unsigned gen = old / nloc;
        if (old + 1u == (gen + 1u) * nloc) {
            __builtin_amdgcn_fence(__ATOMIC_RELEASE, "agent");
            asm volatile("s_waitcnt vmcnt(0)" ::: "memory");
            const unsigned og = xb_add(&bar[XB_TOP], 1u);
            const unsigned tg = og / nx;
            if (og + 1u == (tg + 1u) * nx) xb_add(&bar[XB_TOPGEN], 1u);
            else XB_SPIN(xb_ld(&bar[XB_TOPGEN]) == tg, bar);
            __builtin_amdgcn_fence(__ATOMIC_ACQUIRE, "agent");
            xb_add(&bar[XB_XGEN(b.x)], 1u);
            asm volatile("s_waitcnt vmcnt(0)" ::: "memory");
        } else {
            XB_SPIN(xb_ld(&bar[XB_XGEN(b.x)]) == gen, bar);
            __builtin_amdgcn_fence(__ATOMIC_ACQUIRE, "agent");
            asm volatile("s_waitcnt vmcnt(0)" ::: "memory");
        }
    }
    __syncthreads();
}

namespace pg8 {
#define PG8_LAS __attribute__((address_space(3)))
typedef unsigned short bf16_t;
typedef short bf16x8 __attribute__((ext_vector_type(8)));
typedef float f32x4 __attribute__((ext_vector_type(4)));
typedef unsigned u32x4 __attribute__((ext_vector_type(4)));
typedef int i32x8_t __attribute__((ext_vector_type(8)));
typedef int i32x4_t __attribute__((ext_vector_type(4)));
constexpr int BM = 256, BK = 64, HALF = 128, HTB = HALF * BK * 2  , STAGE_BYTES = 8 * HTB, NXCD = 8, WGM = 8;

__host__ __device__ __forceinline__ int lds_byte(int r, int c) { const int st = (r >> 4) * 2 + (c >> 5), rr = r & 15, cc = c & 31, ob = rr * 64 + cc * 2; return st * 1024 + (ob ^ (((ob >> 9) & 1) << 5)); }
__host__ __device__ __forceinline__ void stage_rc(int b, int& R, int& C) { const int st = b / 1024, sb = b % 1024, swz = sb ^ (((sb >> 9) & 1) << 5); R = (st >> 1) * 16 + swz / 64; C = (st & 1) * 32 + (swz % 64) / 2; }
__host__ __device__ __forceinline__ int perm32(int rho) { const int n = rho >> 4, i = rho & 15; return 8 * (i >> 2) + 4 * n + (i & 3); }

struct Unit { int pm, pn; };
struct Gemm { const bf16_t* A; const bf16_t* Bt; int M, N, K; };

struct StaticOrder {
    int nM, nN, nwg, G, c;
    __host__ __device__ void init(int M, int N, int G_, int c_) { nM = M / BM; nN = N / BM; nwg = nM * nN; G = G_; c = c_; }
    __host__ __device__ bool next(int i, Unit& u) const {
        const long L = (long)i * G + c; if (L >= nwg) return false;
        int wgid = (int)L; { const int q = nwg / NXCD, r = nwg % NXCD, xcd = wgid % NXCD, off = wgid / NXCD; wgid = (xcd < r ? xcd * (q + 1) : r * (q + 1) + (xcd - r) * q) + off; }
        const int nig = WGM * nN, gid = wgid / nig, fm = gid * WGM, gsz = (nM - fm) < WGM ? (nM - fm) : WGM;
        u.pm = fm + ((wgid % nig) % gsz); u.pn = (wgid % nig) / gsz; return true;
    }
    __device__ __forceinline__ void a_ready(const Unit&) const {}
    __device__ __forceinline__ void done(const Unit&) const {}
};
#if GEMM_NT
#define EPI_ST16(p, w) __builtin_nontemporal_store((w), (u32x4*)(p))
#else
#define EPI_ST16(p, w) (*(u32x4*)(p) = (w))
#endif
struct EpiStoreBf16 {
    static constexpr bool PERM = true, AFTER_DRAIN = false, SWAP23 = false, FP8 = false;
    bf16_t* O; int ldc;
    __device__ __forceinline__ void operator()(const f32x4 (&acc)[2][2][4][2], const Unit& u, int wr, int wc, int fr, int fq) const {
        const int row0 = u.pm * BM + wr * 64 + fr; const int col0 = u.pn * BM + wc * 32 + 8 * fq;
#pragma unroll
        for (int ai = 0; ai < 2; ++ai)
#pragma unroll
            for (int m = 0; m < 4; ++m) { bf16_t* rowp = O + (size_t)(row0 + ai * HALF + m * 16) * ldc + col0;
#pragma unroll
                for (int bj = 0; bj < 2; ++bj) { const f32x4 v0 = acc[ai][bj][m][0], v1 = acc[ai][bj][m][1];
                    u32x4 w; w.x = pk2(v0[0], v0[1]); w.y = pk2(v0[2], v0[3]); w.z = pk2(v1[0], v1[1]); w.w = pk2(v1[2], v1[3]);
                    EPI_ST16(rowp + bj * HALF, w); } }
    }
};
struct EpiResF32 {
    static constexpr bool PERM = false, AFTER_DRAIN = false, SWAP23 = false, FP8 = false;
    const float* base; float* out; int ldc;
    __device__ __forceinline__ void operator()(const f32x4 (&acc)[2][2][4][2], const Unit& u, int wr, int wc, int fr, int fq) const {
        const int row0 = u.pm * BM + wr * 64 + fr, col0 = u.pn * BM + wc * 32 + 4 * fq;
#pragma unroll
        for (int ai = 0; ai < 2; ++ai)
#pragma unroll
            for (int m = 0; m < 4; ++m) { const size_t off = (size_t)(row0 + ai * HALF + m * 16) * ldc + col0;
#pragma unroll
                for (int bj = 0; bj < 2; ++bj)
#pragma unroll
                    for (int n = 0; n < 2; ++n) { const f32x4 bs = *(const f32x4*)(base + off + bj * HALF + n * 16);
                        *(f32x4*)(out + off + bj * HALF + n * 16) = bs + acc[ai][bj][m][n]; } }
    }
};
struct EpiPlainF32 {
    static constexpr bool PERM = false, AFTER_DRAIN = false, SWAP23 = false, FP8 = false;
    float* C; int ldc;
    __device__ __forceinline__ void operator()(const f32x4 (&acc)[2][2][4][2], const Unit& u, int wr, int wc, int fr, int fq) const {
        const int row0 = u.pm * BM + wr * 64 + fr, col0 = u.pn * BM + wc * 32 + 4 * fq;
#pragma unroll
        for (int ai = 0; ai < 2; ++ai)
#pragma unroll
            for (int m = 0; m < 4; ++m) { float* rowp = C + (size_t)(row0 + ai * HALF + m * 16) * ldc + col0;
#pragma unroll
                for (int bj = 0; bj < 2; ++bj)
#pragma unroll
                    for (int n = 0; n < 2; ++n) *(f32x4*)(rowp + bj * HALF + n * 16) = acc[ai][bj][m][n]; }
    }
};

struct EpiVT {
    static constexpr bool PERM = true, AFTER_DRAIN = false, SWAP23 = true, FP8 = false;
    bf16_t* O;
    __device__ __forceinline__ void operator()(const f32x4 (&acc)[2][2][4][2], const Unit& u, int wr, int wc, int fr, int fq) const {
        const int row0 = u.pm * BM + wr * 64 + fr; const int colt = u.pn * BM; const int b = colt >> 12, pos0 = (colt & 4095) + wc * 32 + 8 * fq;
        bf16_t* base = O + (size_t)b * 8192 * 4096 + pos0;
#pragma unroll
        for (int ai = 0; ai < 2; ++ai)
#pragma unroll
            for (int m = 0; m < 4; ++m) { bf16_t* rowp = base + (size_t)(row0 + ai * HALF + m * 16) * 4096;
#pragma unroll
                for (int bj = 0; bj < 2; ++bj) { const f32x4 v0 = acc[ai][bj][m][0], v1 = acc[ai][bj][m][1];
                    u32x4 w; w.x = pk2(v0[0], v0[1]); w.y = pk2(v0[2], v0[3]); w.z = pk2(v1[0], v1[1]); w.w = pk2(v1[2], v1[3]);
                    EPI_ST16(rowp + bj * HALF, w); } }
    }
};

struct EpiKNorm {
    static constexpr bool PERM = true, AFTER_DRAIN = false, SWAP23 = false, FP8 = false;
    bf16_t* KM; const float* sspe; const float* kper; const float* gain; PG8_LAS float* tab; mutable unsigned par;
    __device__ __forceinline__ void operator()(const f32x4 (&acc)[2][2][4][2], const Unit& u, int wr, int wc, int fr, int fq) const {
        PG8_LAS float* T = tab + par * 2048;
#pragma unroll
        for (int ai = 0; ai < 2; ++ai)
#pragma unroll
            for (int m = 0; m < 4; ++m) { const int row = ai * HALF + wr * 64 + m * 16 + fr;
#pragma unroll
                for (int bj = 0; bj < 2; ++bj) { const f32x4 x = acc[ai][bj][m][0], y = acc[ai][bj][m][1];
                    float ss = (x[0] * x[0] + x[1] * x[1]) + (x[2] * x[2] + x[3] * x[3]) + (y[0] * y[0] + y[1] * y[1]) + (y[2] * y[2] + y[3] * y[3]);
                    ss += __shfl_xor(ss, 16); ss += __shfl_xor(ss, 32);
                    if (fq == 0) T[row * 8 + bj * 4 + wc] = ss; } }
        asm volatile("s_waitcnt lgkmcnt(0)" ::: "memory"); __builtin_amdgcn_s_barrier(); asm volatile("" ::: "memory");
        const f32x4 g0 = *(const f32x4*)(gain + wc * 32 + 8 * fq), g1 = *(const f32x4*)(gain + wc * 32 + 8 * fq + 4);
        const int tok0 = u.pm * BM, b = tok0 >> 12;
#pragma unroll
        for (int ai = 0; ai < 2; ++ai)
#pragma unroll
            for (int m = 0; m < 4; ++m) { const int row = ai * HALF + wr * 64 + m * 16 + fr, tok = tok0 + row, s = tok & 4095;
                const float sp = sspe[tok]; const f32x4 kp = *(const f32x4*)(kper + (size_t)tok * 64 + wc * 16 + 4 * fq);
#pragma unroll
                for (int bj = 0; bj < 2; ++bj) { const f32x4 t = *(const PG8_LAS f32x4*)(T + row * 8 + bj * 4);
                    const float rstd = rsqrtf(((t[0] + t[1]) + (t[2] + t[3]) + sp) * (1.0f / 192.0f) + 1e-6f);
                    const int hd = 2 * u.pn + bj;
                    bf16_t* kb = KM + ((size_t)(b * 64 + hd) * 4096 + s) * 192;
                    const f32x4 x = acc[ai][bj][m][0], y = acc[ai][bj][m][1];
                    u32x4 w; w.x = pk2(x[0] * rstd * g0[0], x[1] * rstd * g0[1]); w.y = pk2(x[2] * rstd * g0[2], x[3] * rstd * g0[3]);
                    w.z = pk2(y[0] * rstd * g1[0], y[1] * rstd * g1[1]); w.w = pk2(y[2] * rstd * g1[2], y[3] * rstd * g1[3]);
                    *(u32x4*)(kb + wc * 32 + 8 * fq) = w;
                    u32x2 r; r.x = pk2(kp[0] * rstd, kp[1] * rstd); r.y = pk2(kp[2] * rstd, kp[3] * rstd);
                    *(u32x2*)(kb + 128 + wc * 16 + 4 * fq) = r; } }
        par ^= 1u;
    }
};

template <bool F8_> struct EpiResNormT {
    static constexpr bool PERM = false, AFTER_DRAIN = false, SWAP23 = false, FP8 = F8_;
    const float* base; float* out; int ldc; const float* gain; bf16_t* xg; float* ss; unsigned char* x8; float scale;
    __device__ __forceinline__ void operator()(const f32x4 (&acc)[2][2][4][2], const Unit& u, int wr, int wc, int fr, int fq) const {
        const int row0 = u.pm * BM + wr * 64 + fr, col0 = u.pn * BM + wc * 32 + 4 * fq;
        f32x4 gv[2][2];
#pragma unroll
        for (int bj = 0; bj < 2; ++bj)
#pragma unroll
            for (int n = 0; n < 2; ++n) gv[bj][n] = *(const f32x4*)(gain + col0 + bj * HALF + n * 16);
#pragma unroll
        for (int ai = 0; ai < 2; ++ai)
#pragma unroll
            for (int m = 0; m < 4; ++m) { const int row = row0 + ai * HALF + m * 16; const size_t off = (size_t)row * ldc + col0; float sq = 0.f;
#pragma unroll
                for (int bj = 0; bj < 2; ++bj)
#pragma unroll
                    for (int n = 0; n < 2; ++n) { const f32x4 bs = *(const f32x4*)(base + off + bj * HALF + n * 16); const f32x4 v = F8_ ? bs + acc[ai][bj][m][n] * scale : bs + acc[ai][bj][m][n];
                        *(f32x4*)(out + off + bj * HALF + n * 16) = v;
                        sq += (v[0] * v[0] + v[1] * v[1]) + (v[2] * v[2] + v[3] * v[3]);
                        const f32x4 g = gv[bj][n]; u32x2 w; w.x = pk2(v[0] * g[0], v[1] * g[1]); w.y = pk2(v[2] * g[2], v[3] * g[3]);
                        *(u32x2*)(xg + off + bj * HALF + n * 16) = w;
                        if (x8) *(unsigned*)(x8 + off + bj * HALF + n * 16) = pk4_fp8(v[0] * g[0] * 16.0f, v[1] * g[1] * 16.0f, v[2] * g[2] * 16.0f, v[3] * g[3] * 16.0f); }
                sq += __shfl_xor(sq, 16); sq += __shfl_xor(sq, 32);
                if (fq == 0) atomicAdd(ss + row, sq); }
    }
};
using EpiResNorm = EpiResNormT<false>; using EpiResNormFp8 = EpiResNormT<true>;
struct EpiStoreBf16RowScale {
    static constexpr bool PERM = true, AFTER_DRAIN = false, SWAP23 = false, FP8 = false;
    bf16_t* O; int ldc; const float* ss; float inv_dim;
    __device__ __forceinline__ void operator()(const f32x4 (&acc)[2][2][4][2], const Unit& u, int wr, int wc, int fr, int fq) const {
        const int row0 = u.pm * BM + wr * 64 + fr; const int col0 = u.pn * BM + wc * 32 + 8 * fq;
#pragma unroll
        for (int ai = 0; ai < 2; ++ai)
#pragma unroll
            for (int m = 0; m < 4; ++m) { const int row = row0 + ai * HALF + m * 16; const float rs = rsqrtf(ss[row] * inv_dim + 1e-6f);
                bf16_t* rowp = O + (size_t)row * ldc + col0;
#pragma unroll
                for (int bj = 0; bj < 2; ++bj) { const f32x4 v0 = acc[ai][bj][m][0] * rs, v1 = acc[ai][bj][m][1] * rs;
                    u32x4 w; w.x = pk2(v0[0], v0[1]); w.y = pk2(v0[2], v0[3]); w.z = pk2(v1[0], v1[1]); w.w = pk2(v1[2], v1[3]);
                    EPI_ST16(rowp + bj * HALF, w); } }
    }
};

struct EpiStoreBf16Fp8 {
    static constexpr bool PERM = true, AFTER_DRAIN = false, SWAP23 = false, FP8 = true;
    bf16_t* O; int ldc; float scale;
    __device__ __forceinline__ void operator()(const f32x4 (&acc)[2][2][4][2], const Unit& u, int wr, int wc, int fr, int fq) const {
        const int row0 = u.pm * BM + wr * 64 + fr; const int col0 = u.pn * BM + wc * 32 + 8 * fq;
#pragma unroll
        for (int ai = 0; ai < 2; ++ai)
#pragma unroll
            for (int m = 0; m < 4; ++m) { bf16_t* rowp = O + (size_t)(row0 + ai * HALF + m * 16) * ldc + col0;
#pragma unroll
                for (int bj = 0; bj < 2; ++bj) { const f32x4 v0 = acc[ai][bj][m][0] * scale, v1 = acc[ai][bj][m][1] * scale;
                    u32x4 w; w.x = pk2(v0[0], v0[1]); w.y = pk2(v0[2], v0[3]); w.z = pk2(v1[0], v1[1]); w.w = pk2(v1[2], v1[3]);
                    EPI_ST16(rowp + bj * HALF, w); } }
    }
};

struct OrderBf16Part {
    int G, c, q0, nq, nz;
    __device__ bool next(int i, Unit& u) const { const int L = i * G + c;
        if (L < nq * 64) { u.pm = L & 63; u.pn = q0 + (L >> 6); return true; }
        const int Lz = L - nq * 64; if (Lz >= nz * 4) return false;
        const int j = Lz >> 2; u.pm = 16 * (Lz & 3); u.pn = j < q0 ? j : j + nq; return true; }
    __device__ __forceinline__ void a_ready(const Unit&) const {}
    __device__ __forceinline__ void done(const Unit&) const {}
};
struct OrderFp8Part {
    int G, c, q0, nq, nz, rot;
    __device__ bool next(int i, Unit& u) const { const int L = i * G + (G == 256 ? ((c + rot) & 255) : c); if (L >= nz * 60) return false;
        const int r = L % 60, j = L / 60; u.pm = r + r / 15 + 1; u.pn = j < q0 ? j : j + nq; return true; }
    __device__ __forceinline__ void a_ready(const Unit&) const {}
    __device__ __forceinline__ void done(const Unit&) const {}
};

struct EpiStoreBf16RowScaleFp8 {
    static constexpr bool PERM = true, AFTER_DRAIN = false, SWAP23 = false, FP8 = true;
    bf16_t* O; int ldc; const float* ss; float inv_dim, scale;
    __device__ __forceinline__ void operator()(const f32x4 (&acc)[2][2][4][2], const Unit& u, int wr, int wc, int fr, int fq) const {
        const int row0 = u.pm * BM + wr * 64 + fr; const int col0 = u.pn * BM + wc * 32 + 8 * fq;
#pragma unroll
        for (int ai = 0; ai < 2; ++ai)
#pragma unroll
            for (int m = 0; m < 4; ++m) { const int row = row0 + ai * HALF + m * 16; const float rs = rsqrtf(ss[row] * inv_dim + 1e-6f) * scale;
                bf16_t* rowp = O + (size_t)row * ldc + col0;
#pragma unroll
                for (int bj = 0; bj < 2; ++bj) { const f32x4 v0 = acc[ai][bj][m][0] * rs, v1 = acc[ai][bj][m][1] * rs;
                    u32x4 w; w.x = pk2(v0[0], v0[1]); w.y = pk2(v0[2], v0[3]); w.z = pk2(v1[0], v1[1]); w.w = pk2(v1[2], v1[3]);
                    EPI_ST16(rowp + bj * HALF, w); } }
    }
};
struct OrderTiles {
    int G, c, ncol;
    __device__ bool next(int i, Unit& u) const { const int L = i * G + c; if (L >= ncol * 64) return false; u.pm = L & 63; u.pn = L >> 6; return true; }
    __device__ __forceinline__ void a_ready(const Unit&) const {}
    __device__ __forceinline__ void done(const Unit&) const {}
};

struct EpiResF32Fp8 {
    static constexpr bool PERM = false, AFTER_DRAIN = false, SWAP23 = false, FP8 = true;
    const float* base; float* out; int ldc; float scale;
    __device__ __forceinline__ void operator()(const f32x4 (&acc)[2][2][4][2], const Unit& u, int wr, int wc, int fr, int fq) const {
        const int row0 = u.pm * BM + wr * 64 + fr, col0 = u.pn * BM + wc * 32 + 4 * fq;
#pragma unroll
        for (int ai = 0; ai < 2; ++ai)
#pragma unroll
            for (int m = 0; m < 4; ++m) { const size_t off = (size_t)(row0 + ai * HALF + m * 16) * ldc + col0;
#pragma unroll
                for (int bj = 0; bj < 2; ++bj)
#pragma unroll
                    for (int n = 0; n < 2; ++n) { const f32x4 bs = *(const f32x4*)(base + off + bj * HALF + n * 16);
                        *(f32x4*)(out + off + bj * HALF + n * 16) = bs + acc[ai][bj][m][n] * scale; } }
    }
};
template <class Epi, class Sched, bool STAMP = false>
__device__ __forceinline__ void gemm_phase(PG8_LAS unsigned char* lds, const Gemm g, const Sched& S, const Epi& E, unsigned long long* stamps) {
    const int tid = tid_opaque(), wid = __builtin_amdgcn_readfirstlane(tid >> 6), lane = tid & 63, wr = wid >> 2, wc = wid & 3, fr = lane & 15, fq = lane >> 4;
    const int K = g.K, nt = K / BK;
    int ts_lo = 0, ts_hi = 0, nts = 0; const unsigned long long rt_entry = STAMP ? (unsigned long long)wall_clock64() : 0ull;
#define PG8_STAMP() do { if (STAMP && wid == 0 && nts < 64) { const unsigned long long _c = (unsigned long long)clock64(); \
        ts_lo = (lane == nts) ? (int)(unsigned)_c : ts_lo; ts_hi = (lane == nts) ? (int)(unsigned)(_c >> 32) : ts_hi; ++nts; } } while (0)
    PG8_STAMP();
    unsigned voffA[2], voffB[2];
#pragma unroll
    for (int i = 0; i < 2; ++i) { int R, C; stage_rc(tid * 16 + i * 8192, R, C); int Rb = Epi::PERM ? ((R & ~31) + perm32(R & 31)) : R; if (Epi::SWAP23) Rb = vt_key_of_pos(Rb);
        voffA[i] = (unsigned)(R * K + C) * 2u; voffB[i] = (unsigned)(Rb * K + C) * 2u; }
    const size_t kstep = (size_t)(BK * 2);
    const size_t hstep = (size_t)HALF * K * 2;
    const size_t tstep = 2 * hstep;
    const unsigned ldsw = (unsigned)wid * 1024u;
    const int aoff = lds_byte(wr * 64 + fr, fq * 8), boff = lds_byte(wc * 32 + fr, fq * 8);
#define PG8_SA(b, h) (((b) * 2 + (h)) * HTB)
#define PG8_SB(b, h) ((4 + (b) * 2 + (h)) * HTB)
#define PG8_STAGE(bufoff, gbase, voff) do { _Pragma("unroll") for (int _i = 0; _i < 2; ++_i) \
        __builtin_amdgcn_global_load_lds((const unsigned*)((const char*)(gbase) + (voff)[_i]), (PG8_LAS unsigned*)(lds + (bufoff) + ldsw + _i * 8192), 16, 0, 0); } while (0)
#define PG8_LDA(dst, b, h) do { if constexpr (Epi::FP8) { _Pragma("unroll") for (int m = 0; m < 4; ++m) { const PG8_LAS unsigned char* p_ = lds + PG8_SA(b, h) + aoff + m * 2048; \
            const i32x4_t lo_ = *(const PG8_LAS i32x4_t*)p_, hi_ = *(const PG8_LAS i32x4_t*)(p_ + 1024); dst##8[m] = __builtin_shufflevector(lo_, hi_, 0, 1, 2, 3, 4, 5, 6, 7); } } \
        else { _Pragma("unroll") for (int m = 0; m < 4; ++m) _Pragma("unroll") for (int k = 0; k < 2; ++k) dst[m][k] = *(const PG8_LAS bf16x8*)(lds + PG8_SA(b, h) + aoff + m * 2048 + k * 1024); } } while (0)
#define PG8_LDB(dst, b, h) do { if constexpr (Epi::FP8) { _Pragma("unroll") for (int n = 0; n < 2; ++n) { const PG8_LAS unsigned char* p_ = lds + PG8_SB(b, h) + boff + n * 2048; \
            const i32x4_t lo_ = *(const PG8_LAS i32x4_t*)p_, hi_ = *(const PG8_LAS i32x4_t*)(p_ + 1024); dst##8[n] = __builtin_shufflevector(lo_, hi_, 0, 1, 2, 3, 4, 5, 6, 7); } } \
        else { _Pragma("unroll") for (int n = 0; n < 2; ++n) _Pragma("unroll") for (int k = 0; k < 2; ++k) dst[n][k] = *(const PG8_LAS bf16x8*)(lds + PG8_SB(b, h) + boff + n * 2048 + k * 1024); } } while (0)
#define PG8_MMA(ai, bj, At, Bt) do { __builtin_amdgcn_s_setprio(1); \
        if constexpr (Epi::FP8) { \
            _Pragma("unroll") for (int m = 0; m < 4; ++m) _Pragma("unroll") for (int n = 0; n < 2; ++n) \
                asm volatile("v_mfma_scale_f32_16x16x128_f8f6f4 %0, %1, %2, %0, %3, %3 op_sel_hi:[0,0,0]" : "+v"(acc[ai][bj][m][n]) : "v"(Bt##8[n]), "v"(At##8[m]), "v"(fp8_scale_one)); \
        } else { \
            _Pragma("unroll") for (int m = 0; m < 4; ++m) _Pragma("unroll") for (int n = 0; n < 2; ++n) _Pragma("unroll") for (int k = 0; k < 2; ++k) \
                acc[ai][bj][m][n] = __builtin_amdgcn_mfma_f32_16x16x32_bf16(Bt[n][k], At[m][k], acc[ai][bj][m][n], 0, 0, 0); } \
        __builtin_amdgcn_s_setprio(0); } while (0)
#define PG8_WAIT_V(n) asm volatile("s_waitcnt vmcnt(" #n ")" ::: "memory")
#define PG8_WAIT_L(n) asm volatile("s_waitcnt lgkmcnt(" #n ")" ::: "memory")
#define PG8_BAR __builtin_amdgcn_s_barrier()
#define PG8_SCHED __builtin_amdgcn_sched_barrier(0)
    Unit cur, nxt; int ui = 0;
    if (!S.next(0, cur)) return;
    f32x4 acc[2][2][4][2];
#pragma unroll
    for (int a = 0; a < 2; ++a)
#pragma unroll
        for (int b = 0; b < 2; ++b)
#pragma unroll
            for (int m = 0; m < 4; ++m)
#pragma unroll
                for (int n = 0; n < 2; ++n) acc[a][b][m][n] = (f32x4){0.f, 0.f, 0.f, 0.f};
    bf16x8 At[4][2], B0[2][2], B1[2][2]; i32x8_t At8[4], B08[2], B18[2]; const int fp8_scale_one = 0x7f7f7f7f;
    const char* cA = (const char*)g.A + (size_t)cur.pm * tstep; const char* cB = (const char*)g.Bt + (size_t)cur.pn * tstep;
    S.a_ready(cur);
    PG8_STAGE(PG8_SB(0, 0), cB, voffB); PG8_STAGE(PG8_SA(0, 0), cA, voffA); PG8_STAGE(PG8_SB(0, 1), cB + hstep, voffB); PG8_STAGE(PG8_SA(0, 1), cA + hstep, voffA);
    if (wr == 1) PG8_BAR;
    PG8_WAIT_V(4); PG8_BAR;
    PG8_STAGE(PG8_SB(1, 0), cB + kstep, voffB); PG8_STAGE(PG8_SA(1, 0), cA + kstep, voffA); PG8_STAGE(PG8_SB(1, 1), cB + hstep + kstep, voffB);
    PG8_WAIT_V(6); PG8_BAR;
    PG8_STAMP();
    for (;;) {
        const bool has_next = S.next(ui + 1, nxt);
        const char* nA = has_next ? (const char*)g.A + (size_t)nxt.pm * tstep : cA; const char* nB = has_next ? (const char*)g.Bt + (size_t)nxt.pn * tstep : cB;
        for (int t = 0; t < nt; t += 2) {
            const bool last = (t == nt - 2);
            const char* a1 = cA + (size_t)(t + 1) * kstep;
            const char* a2 = last ? nA : cA + (size_t)(t + 2) * kstep; const char* b2 = last ? nB : cB + (size_t)(t + 2) * kstep;
            const char* a3 = a2 + kstep; const char* b3 = b2 + kstep;
            if (last && has_next) S.a_ready(nxt);
            PG8_LDB(B0, 0, 0); PG8_SCHED; PG8_LDA(At, 0, 0); PG8_STAGE(PG8_SA(1, 1), a1 + hstep, voffA);
            PG8_WAIT_L(8); PG8_BAR; PG8_WAIT_L(0); PG8_MMA(0, 0, At, B0); PG8_BAR; PG8_SCHED;
            PG8_LDB(B1, 0, 1); PG8_STAGE(PG8_SB(0, 0), b2, voffB);
            PG8_BAR; PG8_WAIT_L(0); PG8_MMA(0, 1, At, B1); PG8_BAR;
            PG8_LDA(At, 0, 1); PG8_STAGE(PG8_SA(0, 0), a2, voffA);
            PG8_BAR; PG8_WAIT_L(0); PG8_MMA(1, 0, At, B0); PG8_BAR; PG8_SCHED;
            PG8_STAGE(PG8_SB(0, 1), b2 + hstep, voffB);
            PG8_WAIT_V(6); PG8_BAR; PG8_MMA(1, 1, At, B1); PG8_BAR;
            PG8_LDB(B0, 1, 0); PG8_SCHED; PG8_LDA(At, 1, 0); PG8_STAGE(PG8_SA(0, 1), a2 + hstep, voffA);
            PG8_WAIT_L(8); PG8_BAR; PG8_WAIT_L(0); PG8_MMA(0, 0, At, B0); PG8_BAR; PG8_SCHED;
            PG8_LDB(B1, 1, 1); PG8_STAGE(PG8_SB(1, 0), b3, voffB);
            PG8_BAR; PG8_WAIT_L(0); PG8_MMA(0, 1, At, B1); PG8_BAR;
            PG8_LDA(At, 1, 1); PG8_STAGE(PG8_SA(1, 0), a3, voffA);
            PG8_BAR; PG8_WAIT_L(0); PG8_MMA(1, 0, At, B0); PG8_BAR; PG8_SCHED;
            PG8_STAGE(PG8_SB(1, 1), b3 + hstep, voffB);
            PG8_WAIT_V(6); PG8_BAR; PG8_MMA(1, 1, At, B1); PG8_BAR;
        }
        PG8_STAMP();
        if constexpr (Epi::FP8) asm volatile("s_nop 15\n\ts_nop 15" ::: "memory");
        if constexpr (!Epi::AFTER_DRAIN) { E(acc, cur, wr, wc, fr, fq); S.done(cur); }
        PG8_STAMP();
        if (!has_next) break;
#pragma unroll
        for (int a = 0; a < 2; ++a)
#pragma unroll
            for (int b = 0; b < 2; ++b)
#pragma unroll
                for (int m = 0; m < 4; ++m)
#pragma unroll
                    for (int n = 0; n < 2; ++n) acc[a][b][m][n] = (f32x4){0.f, 0.f, 0.f, 0.f};
        cur = nxt; cA = nA; cB = nB; ++ui;
    }
    PG8_WAIT_V(0);
    if (wr == 0) PG8_BAR;
    PG8_BAR;
    if constexpr (Epi::AFTER_DRAIN) { E.fused(acc, cur, wr, wc, fr, fq, lds, wid, lane); S.done(cur); }
    PG8_STAMP();
    if (STAMP && wid == 0) { stamps[lane] = lane < nts ? (((unsigned long long)(unsigned)ts_hi << 32) | (unsigned)ts_lo) : 0ull;
        if (lane == 62) stamps[62] = rt_entry; if (lane == 63) stamps[63] = (unsigned long long)wall_clock64(); }
#undef PG8_STAMP
#undef PG8_SA
#undef PG8_SB
#undef PG8_STAGE
#undef PG8_LDA
#undef PG8_LDB
#undef PG8_MMA
#undef PG8_WAIT_V
#undef PG8_WAIT_L
#undef PG8_BAR
#undef PG8_SCHED
}
}


DI void phase_wconv(LAS unsigned char* lds, const float* __restrict__ src, bf16_t* __restrict__ dst, int K, int N, int Npad, int bid, int nb, float q8s = 0.f, int colmap = 0, unsigned char* __restrict__ dst8 = nullptr, int n8_0 = 0) {
    LAS float* tile = (LAS float*)lds;
    const int tid = tid_opaque();
    const int tk = K / 64, tn = Npad / 256, total = tk * tn;
    for (int t = bid; t < total; t += nb) {
        const int k0 = (t % tk) * 64, n0 = (t / tk) * 256;
        __syncthreads();
        {
            const int ty = tid >> 6, tx = tid & 63, n = n0 + tx * 4;
            f32x4 v[8];
#pragma unroll
            for (int i = 0; i < 8; ++i) {
                const int k = k0 + ty + 8 * i;
                v[i] = (f32x4){0.f, 0.f, 0.f, 0.f};
                if (colmap) { const int ns = (n >> 7) * 256 + (colmap == 1 ? 128 : 0) + (n & 127); v[i] = *(const f32x4*)(src + (size_t)k * (2 * N) + ns); }
                else if (n < N) v[i] = *(const f32x4*)(src + (size_t)k * N + n);
            }
#pragma unroll
            for (int i = 0; i < 8; ++i) { LAS float* pp = tile + (ty + 8 * i) * 257 + tx * 4; pp[0] = v[i][0]; pp[1] = v[i][1]; pp[2] = v[i][2]; pp[3] = v[i][3]; }
        }
        __syncthreads();
#pragma unroll
        for (int ps_ = 0; ps_ < 4; ++ps_) {
            const int n = (tid >> 3) + 64 * ps_, kc = tid & 7;
            float v[8];
#pragma unroll
            for (int j = 0; j < 8; ++j) { v[j] = tile[(kc * 8 + j) * 257 + n]; if (q8s > 0.f) v[j] = emu_q8(v[j], q8s); else if (q8s < 0.f && n0 + n >= C_ZC) v[j] = emu_q8(v[j], -q8s); }
            u32x4 w; w.x = pk2(v[0], v[1]); w.y = pk2(v[2], v[3]); w.z = pk2(v[4], v[5]); w.w = pk2(v[6], v[7]);
            *(u32x4*)(dst + (size_t)(n0 + n) * K + k0 + kc * 8) = w;
            if (dst8 && n0 + n >= n8_0) { u32x2 b; b.x = pk4_fp8(v[0] * 64.0f, v[1] * 64.0f, v[2] * 64.0f, v[3] * 64.0f); b.y = pk4_fp8(v[4] * 64.0f, v[5] * 64.0f, v[6] * 64.0f, v[7] * 64.0f);
                *(u32x2*)(dst8 + (size_t)(n0 + n - n8_0) * K + k0 + kc * 8) = b; }
        }
    }
}

DI void phase_rmsnorm(const float* __restrict__ x, const float* __restrict__ gain, bf16_t* __restrict__ h, int bid, int nb, float q8s = 0.f, unsigned char* __restrict__ h8 = nullptr) {
    const int tid = tid_opaque(); const int lane = tid & 63, wid = tid >> 6;
    for (int row = bid * 8 + wid; row < MTOK; row += nb * 8) {
        const float* xr = x + (size_t)row * DM;
        f32x4 v[16]; float ss = 0.f;
#pragma unroll
        for (int i = 0; i < 16; ++i) { v[i] = *(const f32x4*)(xr + (i * 64 + lane) * 4); ss += v[i][0] * v[i][0] + v[i][1] * v[i][1] + v[i][2] * v[i][2] + v[i][3] * v[i][3]; }
#pragma unroll
        for (int o = 32; o >= 1; o >>= 1) ss += __shfl_xor(ss, o);
        const float rstd = rsqrtf(ss * (1.0f / DM) + EPSN);
        bf16_t* hr = h + (size_t)row * DM;
#pragma unroll
        for (int i = 0; i < 16; ++i) { const f32x4 g = *(const f32x4*)(gain + (i * 64 + lane) * 4);
            float y0 = v[i][0] * rstd * g[0], y1 = v[i][1] * rstd * g[1], y2 = v[i][2] * rstd * g[2], y3 = v[i][3] * rstd * g[3];
            if (q8s > 0.f || (q8s < 0.f && (row & 4095) >= 256)) { const float qa = fabsf(q8s); y0 = emu_q8(y0, qa); y1 = emu_q8(y1, qa); y2 = emu_q8(y2, qa); y3 = emu_q8(y3, qa); }
            u32x2 w; w.x = pk2(y0, y1); w.y = pk2(y2, y3);
            *(u32x2*)(hr + (i * 64 + lane) * 4) = w;
            if (h8) *(unsigned*)(h8 + (size_t)row * DM + (i * 64 + lane) * 4) = pk4_fp8(y0 * 16.0f, y1 * 16.0f, y2 * 16.0f, y3 * 16.0f); }
    }
}

DI void ld192(const bf16_t* p, int j8, float (&v)[24]) {
#pragma unroll
    for (int c = 0; c < 3; ++c) { const u32x4 w = *(const u32x4*)(p + (j8 + 8 * c) * 8);
        v[c * 8 + 0] = bflo(w.x); v[c * 8 + 1] = bfhi(w.x); v[c * 8 + 2] = bflo(w.y); v[c * 8 + 3] = bfhi(w.y);
        v[c * 8 + 4] = bflo(w.z); v[c * 8 + 5] = bfhi(w.z); v[c * 8 + 6] = bflo(w.w); v[c * 8 + 7] = bfhi(w.w); }
}
DI void st192(bf16_t* p, int j8, const float (&v)[24]) {
#pragma unroll
    for (int c = 0; c < 3; ++c) { u32x4 w; w.x = pk2(v[c * 8 + 0], v[c * 8 + 1]); w.y = pk2(v[c * 8 + 2], v[c * 8 + 3]); w.z = pk2(v[c * 8 + 4], v[c * 8 + 5]); w.w = pk2(v[c * 8 + 6], v[c * 8 + 7]);
        *(u32x4*)(p + (j8 + 8 * c) * 8) = w; }
}
DI float sum8(float s) { s += __shfl_xor(s, 1); s += __shfl_xor(s, 2); s += __shfl_xor(s, 4); return s; }

DI void phase_nsa_prep(const Params& P, int bid, int nb) {
    bf16_t* Y0 = (bf16_t*)(P.ws + OFF_Y0);
    bf16_t* KS = (bf16_t*)(P.ws + OFF_KS); bf16_t* KW = (bf16_t*)(P.ws + OFF_KW);
    bf16_t* ACK = (bf16_t*)(P.ws + OFF_ACK); bf16_t* ACV = (bf16_t*)(P.ws + OFF_ACV);
    const int tid = tid_opaque(), grp = (tid >> 3) & 15, j8 = tid & 7;
    for (int tok = bid * 4 + (tid >> 7); tok < MTOK; tok += nb * 4) {
        const int b = tok / SEQ, s = tok % SEQ;
        bf16_t* yr = Y0 + (size_t)tok * N1P;
        if (grp < 8) {
            const int g = grp & 3, br = grp >> 2;
            float v[24]; ld192(yr + (br ? C_KVW : C_KVS) + g * DK, j8, v);
            float ss = 0.f;
#pragma unroll
            for (int i = 0; i < 24; ++i) ss += v[i] * v[i];
            ss = sum8(ss);
            const float rstd = rsqrtf(ss * (1.0f / DK) + EPSN);
            const float* kn = P.nsa_k_norm + (br ? 2 : 1) * DK;
#pragma unroll
            for (int c = 0; c < 3; ++c)
#pragma unroll
                for (int e = 0; e < 8; ++e) v[c * 8 + e] *= rstd * kn[(j8 + 8 * c) * 8 + e];
            st192((br ? KW : KS) + ((size_t)(b * NG + g) * SEQ + s) * DK, j8, v);
        } else if (grp < 12) {
            const int g = grp - 8;
            float v[24]; ld192(yr + C_KVC + g * DK, j8, v);
#pragma unroll
            for (int k = 0; k < 2; ++k) {
                const int n = (s >> 4) - k, l = s - 16 * n;
                if (n >= 0 && n <= 254) {
                    float w[24];
#pragma unroll
                    for (int c = 0; c < 3; ++c)
#pragma unroll
                        for (int e = 0; e < 8; ++e) w[c * 8 + e] = v[c * 8 + e] + P.pe_k[l * DK + (j8 + 8 * c) * 8 + e];
                    st192(ACK + ((size_t)((b * NG + g) * 256 + n)) * 6144 + l * DK, j8, w);
                }
            }
        } else if (grp < 16) {
            const int g = grp - 12;
            const bf16_t* src = yr + C_KVC + NG * DK + g * DV;
            float v[16];
#pragma unroll
            for (int c = 0; c < 2; ++c) { const u32x4 w = *(const u32x4*)(src + (j8 + 8 * c) * 8);
                v[c * 8 + 0] = bflo(w.x); v[c * 8 + 1] = bfhi(w.x); v[c * 8 + 2] = bflo(w.y); v[c * 8 + 3] = bfhi(w.y);
                v[c * 8 + 4] = bflo(w.z); v[c * 8 + 5] = bfhi(w.z); v[c * 8 + 6] = bflo(w.w); v[c * 8 + 7] = bfhi(w.w); }
#pragma unroll
            for (int k = 0; k < 2; ++k) {
                const int n = (s >> 4) - k, l = s - 16 * n;
                if (n >= 0 && n <= 254) {
                    bf16_t* dst = ACV + ((size_t)((b * NG + g) * 256 + n)) * 4096 + l * DV;
#pragma unroll
                    for (int c = 0; c < 2; ++c) { float w[8];
#pragma unroll
                        for (int e = 0; e < 8; ++e) w[e] = v[c * 8 + e] + P.pe_v[l * DV + (j8 + 8 * c) * 8 + e];
                        u32x4 o; o.x = pk2(w[0], w[1]); o.y = pk2(w[2], w[3]); o.z = pk2(w[4], w[5]); o.w = pk2(w[6], w[7]);
                        *(u32x4*)(dst + (j8 + 8 * c) * 8) = o; }
                }
            }
        }
    }
    for (int i = bid * 512 + tid; i < 16 * (6144 + 4096) / 8; i += nb * 512) {
        const int per = (6144 + 4096) / 8, bg = i / per, c = i % per;
        const u32x4 z = {0u, 0u, 0u, 0u};
        if (c < 6144 / 8) *(u32x4*)(ACK + ((size_t)(bg * 256 + 255)) * 6144 + c * 8) = z;
        else *(u32x4*)(ACV + ((size_t)(bg * 256 + 255)) * 4096 + (c - 6144 / 8) * 8) = z;
    }
}

DI int swap23(int p) { return (p & ~0xC) | ((p & 4) << 1) | ((p & 8) >> 1); }
DI void phase_vt(LAS unsigned char* lds, const bf16_t* __restrict__ src, size_t src_stride, int col0, int col_step, int nhv, bf16_t* __restrict__ dst, int bid, int nb) {
    LAS bf16_t* tile = (LAS bf16_t*)lds;
    const int tid = tid_opaque();
    const int ntile = SEQ / 64, total = BATCH * nhv * ntile;
    for (int it = bid; it < total; it += nb) {
        const int mat = it / ntile, tt = it % ntile, b = mat / nhv, hv = mat % nhv;
        __syncthreads();
#pragma unroll
        for (int i = 0; i < 2; ++i) {
            const int q = tid + 512 * i, tok = q >> 4, ch = q & 15;
            const u32x4 w = *(const u32x4*)(src + (size_t)(b * SEQ + tt * 64 + tok) * src_stride + col0 + hv * col_step + ch * 8);
            *(LAS u32x4*)(tile + tok * 136 + ch * 8) = w;
        }
        __syncthreads();
        {
            const int dv = tid >> 2, kq = tid & 3;
            unsigned w[8];
#pragma unroll
            for (int e = 0; e < 8; ++e) {
                const int p0 = kq * 16 + 2 * e, p1 = p0 + 1;
                const int k0 = vt_key_of_pos(p0), k1 = vt_key_of_pos(p1);
                w[e] = (unsigned)tile[k0 * 136 + dv] | ((unsigned)tile[k1 * 136 + dv] << 16);
            }
            bf16_t* d = dst + ((size_t)mat * DV + dv) * SEQ + tt * 64 + kq * 16;
            u32x4 a = {w[0], w[1], w[2], w[3]}, c = {w[4], w[5], w[6], w[7]};
            *(u32x4*)d = a; *(u32x4*)(d + 8) = c;
        }
    }
}

DI void phase_cmp2(LAS unsigned char* lds, const Params& P, int bid, int nb) {
    LAS float* sk = (LAS float*)lds;
    LAS float* sv = sk + 192;
    LAS float* red = sv + 128;
    const float* HIDK = (const float*)(P.ws + OFF_HIDK); const float* HIDV = (const float*)(P.ws + OFF_HIDV);
    bf16_t* KC = (bf16_t*)(P.ws + OFF_KC); bf16_t* VTC = (bf16_t*)(P.ws + OFF_VTC);
    const int tid = tid_opaque(), lane = tid & 63, wid = tid >> 6;
    for (int m = bid; m < 4096; m += nb) {
        const int n = m & 255, bg = m >> 8;
        __syncthreads();
        if (tid < 192) { const float h = HIDK[(size_t)m * 256 + tid]; sk[tid] = h / (1.0f + __expf(-h)); }
        else if (tid < 320) { const float h = HIDV[(size_t)m * 256 + tid - 192]; sv[tid - 192] = h / (1.0f + __expf(-h)); }
        __syncthreads();
        float acc = 0.f;
        if (tid < 192) { for (int i = 0; i < 192; ++i) acc += sk[i] * P.w2_k[i * 192 + tid]; }
        else if (tid < 320) { const int j = tid - 192; for (int i = 0; i < 128; ++i) acc += sv[i] * P.w2_v[i * 128 + j]; }
        float ss = (tid < 192) ? acc * acc : 0.f;
#pragma unroll
        for (int o = 32; o >= 1; o >>= 1) ss += __shfl_xor(ss, o);
        if (lane == 0) red[wid] = ss;
        __syncthreads();
        const float tot = red[0] + red[1] + red[2];
        const float rstd = rsqrtf(tot * (1.0f / DK) + EPSN);
        if (tid < 192) { const float o = (n == 255) ? 0.f : acc * rstd * P.nsa_k_norm[tid];
            KC[(size_t)m * DK + tid] = (bf16_t)(pk2(o, 0.f) & 0xffffu); }
        else if (tid < 320) { const int j = tid - 192; const float o = (n == 255) ? 0.f : acc;
            const int pn = vt_pos_of_key(n);
            VTC[((size_t)bg * DV + j) * 256 + pn] = (bf16_t)(pk2(o, 0.f) & 0xffffu); }
    }
}

DI void phase_mla_prep1(const Params& P, int bid, int nb) {
    const bf16_t* Y1 = (const bf16_t*)(P.ws + OFF_Y1);
    bf16_t* CQN = (bf16_t*)(P.ws + OFF_CQN); bf16_t* CKVN = (bf16_t*)(P.ws + OFF_CKVN); float* ROPE = (float*)(P.ws + OFF_ROPE);
    float* KPER = (float*)(P.ws + OFF_KPER); float* SSPE = (float*)(P.ws + OFF_SSPE);
    const int tid = tid_opaque(); const int lane = tid & 63, wid = tid >> 6;
    constexpr int TU = 4;
    for (int tok0 = (bid * 8 + wid) * TU; tok0 < MTOK; tok0 += nb * 8 * TU) {
        u32x4 wq[TU][3], wk[TU]; int pos[TU]; bf16_t kp1[TU], kp2[TU];
#pragma unroll
        for (int t = 0; t < TU; ++t) { const bf16_t* yr = Y1 + (size_t)(tok0 + t) * N3P;
#pragma unroll
            for (int c = 0; c < 3; ++c) wq[t][c] = *(const u32x4*)(yr + C3_CQ + (c * 64 + lane) * 8);
            wk[t] = *(const u32x4*)(yr + C3_CKV + lane * 8);
            pos[t] = P.pos[tok0 + t]; kp1[t] = yr[C3_KPE + (lane & 31)]; kp2[t] = yr[C3_KPE + 32 + (lane & 31)]; }
#pragma unroll
        for (int t = 0; t < TU; ++t) { const int tok = tok0 + t;
            {
                float v[24]; float ss = 0.f;
#pragma unroll
                for (int c = 0; c < 3; ++c) { const u32x4 w = wq[t][c];
                    v[c * 8 + 0] = bflo(w.x); v[c * 8 + 1] = bfhi(w.x); v[c * 8 + 2] = bflo(w.y); v[c * 8 + 3] = bfhi(w.y);
                    v[c * 8 + 4] = bflo(w.z); v[c * 8 + 5] = bfhi(w.z); v[c * 8 + 6] = bflo(w.w); v[c * 8 + 7] = bfhi(w.w); }
#pragma unroll
                for (int i = 0; i < 24; ++i) ss += v[i] * v[i];
#pragma unroll
                for (int o = 32; o >= 1; o >>= 1) ss += __shfl_xor(ss, o);
                const float rstd = rsqrtf(ss * (1.0f / QLORA) + EPSN);
#pragma unroll
                for (int c = 0; c < 3; ++c) { const float* g = P.mla_q_a_norm + (c * 64 + lane) * 8; const f32x4 g0 = *(const f32x4*)g, g1 = *(const f32x4*)(g + 4); u32x4 w;
                    w.x = pk2(v[c * 8 + 0] * rstd * g0[0], v[c * 8 + 1] * rstd * g0[1]); w.y = pk2(v[c * 8 + 2] * rstd * g0[2], v[c * 8 + 3] * rstd * g0[3]);
                    w.z = pk2(v[c * 8 + 4] * rstd * g1[0], v[c * 8 + 5] * rstd * g1[1]); w.w = pk2(v[c * 8 + 6] * rstd * g1[2], v[c * 8 + 7] * rstd * g1[3]);
                    *(u32x4*)(CQN + (size_t)tok * QLORA + (c * 64 + lane) * 8) = w; }
            }
            {
                float v[8]; float ss = 0.f; const u32x4 w0 = wk[t];
                v[0] = bflo(w0.x); v[1] = bfhi(w0.x); v[2] = bflo(w0.y); v[3] = bfhi(w0.y); v[4] = bflo(w0.z); v[5] = bfhi(w0.z); v[6] = bflo(w0.w); v[7] = bfhi(w0.w);
#pragma unroll
                for (int i = 0; i < 8; ++i) ss += v[i] * v[i];
#pragma unroll
                for (int o = 32; o >= 1; o >>= 1) ss += __shfl_xor(ss, o);
                const float rstd = rsqrtf(ss * (1.0f / KVLORA) + EPSN);
                const float* g = P.mla_kv_a_norm + lane * 8; const f32x4 g0 = *(const f32x4*)g, g1 = *(const f32x4*)(g + 4); u32x4 w;
                w.x = pk2(v[0] * rstd * g0[0], v[1] * rstd * g0[1]); w.y = pk2(v[2] * rstd * g0[2], v[3] * rstd * g0[3]);
                w.z = pk2(v[4] * rstd * g1[0], v[5] * rstd * g1[1]); w.w = pk2(v[6] * rstd * g1[2], v[7] * rstd * g1[3]);
                *(u32x4*)(CKVN + (size_t)tok * KVLORA + lane * 8) = w;
            }
            {
                const int i = lane & 31;
                const float invf = exp2f(-(float)i * (13.287712379549449f / 32.0f));
                const float ang = (float)pos[t] * invf;
                const double rev = (double)ang * 0.15915494309189533576888;
                const float fr = (float)(rev - __builtin_rint(rev));
                const float sn = __builtin_amdgcn_sinf(fr), cs = __builtin_amdgcn_cosf(fr);
                const float x1 = bf1(kp1[t]), x2 = bf1(kp2[t]);
                float ssp = x1 * x1 + x2 * x2;
#pragma unroll
                for (int o = 16; o >= 1; o >>= 1) ssp += __shfl_xor(ssp, o);
                const float a = x1 * P.mla_k_norm[128 + i], c = x2 * P.mla_k_norm[160 + i];
                if (lane < 32) { ROPE[(size_t)tok * 64 + i] = cs; ROPE[(size_t)tok * 64 + 32 + i] = sn;
                    KPER[(size_t)tok * 64 + i] = a * cs - c * sn; KPER[(size_t)tok * 64 + 32 + i] = c * cs + a * sn;
                    if (lane == 0) SSPE[tok] = ssp; }
            }
        }
    }
}

DI void phase_mla_prep2(const Params& P, int bid, int nb) {
    const bf16_t* KNM = (const bf16_t*)(P.ws + OFF_KNM); const bf16_t* Y1 = (const bf16_t*)(P.ws + OFF_Y1);
    bf16_t* KM = (bf16_t*)(P.ws + OFF_KM); const float* ROPE = (const float*)(P.ws + OFF_ROPE);
    const int tid = tid_opaque(), grp = tid >> 3, j8 = tid & 7;
    for (int tok = bid; tok < MTOK; tok += nb) {
        const int b = tok / SEQ, s = tok % SEQ;
        float cs[8], sn[8];
#pragma unroll
        for (int e = 0; e < 8; ++e) { const int i = (8 * j8 + e) & 31; cs[e] = ROPE[(size_t)tok * 64 + i]; sn[e] = ROPE[(size_t)tok * 64 + 32 + i]; }
        {
            const bf16_t* kn = KNM + (size_t)tok * (NH * 128) + grp * 128;
            const bf16_t* kp = Y1 + (size_t)tok * N3P + C3_KPE;
            float v[24];
#pragma unroll
            for (int c = 0; c < 2; ++c) { const u32x4 w = *(const u32x4*)(kn + (j8 + 8 * c) * 8);
                v[c * 8 + 0] = bflo(w.x); v[c * 8 + 1] = bfhi(w.x); v[c * 8 + 2] = bflo(w.y); v[c * 8 + 3] = bfhi(w.y);
                v[c * 8 + 4] = bflo(w.z); v[c * 8 + 5] = bfhi(w.z); v[c * 8 + 6] = bflo(w.w); v[c * 8 + 7] = bfhi(w.w); }
            { const u32x4 w = *(const u32x4*)(kp + j8 * 8);
                v[16] = bflo(w.x); v[17] = bfhi(w.x); v[18] = bflo(w.y); v[19] = bfhi(w.y); v[20] = bflo(w.z); v[21] = bfhi(w.z); v[22] = bflo(w.w); v[23] = bfhi(w.w); }
            float ss = 0.f;
#pragma unroll
            for (int i = 0; i < 24; ++i) ss += v[i] * v[i];
            ss = sum8(ss);
            const float rstd = rsqrtf(ss * (1.0f / DK) + EPSN);
#pragma unroll
            for (int c = 0; c < 3; ++c)
#pragma unroll
                for (int e = 0; e < 8; ++e) v[c * 8 + e] *= rstd * P.mla_k_norm[(j8 + 8 * c) * 8 + e];
#pragma unroll
            for (int e = 0; e < 8; ++e) { const float mine = v[16 + e], other = __shfl_xor(mine, 4);
                v[16 + e] = (j8 < 4) ? (mine * cs[e] - other * sn[e]) : (mine * cs[e] + other * sn[e]); }
            st192(KM + ((size_t)(b * NH + grp) * SEQ + s) * DK, j8, v);
        }
    }
}
#ifndef ATT_THR
#define ATT_THR 30.0f
#endif
#ifndef ATT3_HOIST
#define ATT3_HOIST 1
#endif
#ifndef PROBE3_STORE2
#define PROBE3_STORE2 1
#endif
#ifndef PROBE3_UNITS
#define PROBE3_UNITS 1
#endif
#ifndef PROBE3_CMP
#define PROBE3_CMP 1
#endif
#ifndef PROBE3_SEL
#define PROBE3_SEL 1
#endif
#ifndef PROBE3_WIN
#define PROBE3_WIN 1
#endif
#ifndef ATT3_KD
#define ATT3_KD 4
#endif
#ifndef ATT3_VD
#define ATT3_VD 4
#endif
#ifndef ATT_PS_LIMIT
#define ATT_PS_LIMIT (16.0f * 1073741824.0f)
#endif
constexpr int KT_BYTES = 64 * 384, VT_BYTES = 128 * 128;
constexpr int L_K = 0, L_V = 2 * KT_BYTES, L_LUT = L_V + 2 * VT_BYTES, LUT_PITCH = 129, L_X = L_LUT + 64 * LUT_PITCH * 4 + 16, L_IL = L_X + 16 * 16 * 64 * 2, L_END = L_IL + 16 * 16 * 4;
static_assert(L_END <= 151552, "attention LDS");
enum { MODE_MLA = 0, MODE_SEL = 3, MODE_WIN = 4, MODE_CMPX = 5 };
#define MFMA16(a, b, c) __builtin_amdgcn_mfma_f32_16x16x32_bf16((a), (b), (c), 0, 0, 0)

struct AttnLane3 {
    int tw0, tw1;
    int r16, g;
    const LAS float* lutrow;
    unsigned long long mk0, mk1;
    int curblk;
    int tokbase;
    mutable float carry[2];
};
template <int MODE> DI int tq_of(const AttnLane3& A, int qb) { return (MODE == MODE_MLA) ? A.tw0 + 16 * qb + A.r16 : A.tw0 + qb; }

template <int MODE, int QS>
DI void attn_tile3(const LAS unsigned char* kb, const LAS unsigned char* vb, LAS unsigned char* lds, int j, const bf16x8 (&q)[2][6], f32x4 (&o)[8][2], float (&m_run)[2], float (&l_run)[2], const AttnLane3& A) {
    constexpr bool Q0 = (QS & 1) != 0, Q1 = (QS & 2) != 0;
    const int r16 = A.r16, g = A.g, sw = (r16 >> 1) & 7;
    const int kb0 = r16 * 384 + ((g ^ sw) << 4), kb1 = r16 * 384 + (((g ^ sw) ^ 4) << 4);
    const int vb0 = r16 * 128 + ((g ^ sw) << 4), vb1 = r16 * 128 + (((g ^ sw) ^ 4) << 4);
    f32x4 s[4][2];
    bool zinit = true;
    if (MODE == MODE_WIN || MODE == MODE_SEL) zinit = (A.tw0 - (64 * j + 63) >= 113);
    else if (MODE == MODE_CMPX) zinit = (A.tw0 - 31 - 16 * (64 * j + 63) >= 113);
    if (zinit) {
#pragma unroll
        for (int k4 = 0; k4 < 4; ++k4) { s[k4][0] = (f32x4){0.f, 0.f, 0.f, 0.f}; s[k4][1] = (f32x4){0.f, 0.f, 0.f, 0.f}; }
    } else {
#pragma unroll
        for (int qb = 0; qb < 2; ++qb) { if ((qb == 0 && !Q0) || (qb == 1 && !Q1)) continue;
            const int tq = tq_of<MODE>(A, qb);
#pragma unroll
            for (int k4 = 0; k4 < 4; ++k4)
#pragma unroll
                for (int r = 0; r < 4; ++r) { int d;
                    if (MODE == MODE_CMPX) d = tq - 31 - 16 * (64 * j + 16 * k4 + 4 * g + r); else d = tq - (64 * j + 16 * k4 + 4 * g + r);
                    d = d < 0 ? 0 : (d > 127 ? 127 : d); s[k4][qb][r] = A.lutrow[d] - m_run[qb]; } }
    }
    {
        constexpr int KD = ATT3_KD;
        bf16x8 kf[KD + 1];
#pragma unroll
        for (int i = 0; i < KD; ++i) kf[i] = *(const LAS bf16x8*)(kb + (((i % 6) & 1) ? kb1 : kb0) + ((i % 6) >> 1) * 128 + (i / 6) * (16 * 384));
        __builtin_amdgcn_sched_barrier(0);
#pragma unroll
        for (int i = 0; i < 24; ++i) {
            if (i + KD < 24) { const int n_ = i + KD; kf[n_ % (KD + 1)] = *(const LAS bf16x8*)(kb + (((n_ % 6) & 1) ? kb1 : kb0) + ((n_ % 6) >> 1) * 128 + (n_ / 6) * (16 * 384)); }
            __builtin_amdgcn_sched_barrier(0);
            if (Q0) s[i / 6][0] = MFMA16(kf[i % (KD + 1)], q[0][i % 6], s[i / 6][0]);
            if (Q1) s[i / 6][1] = MFMA16(kf[i % (KD + 1)], q[1][i % 6], s[i / 6][1]);
            __builtin_amdgcn_sched_barrier(0);
        }
    }
    if (zinit && __any(m_run[0] != 0.f || m_run[1] != 0.f)) {
#pragma unroll
        for (int k4 = 0; k4 < 4; ++k4)
#pragma unroll
            for (int r = 0; r < 4; ++r) { s[k4][0][r] -= m_run[0]; s[k4][1][r] -= m_run[1]; }
    }
    {
        const float NEG = -__builtin_inff();
        bool need;
        if (MODE == MODE_MLA) need = (64 * j + 63 > A.tw0);
        else if (MODE == MODE_WIN) need = !(64 * j + 63 <= A.tw0 && 64 * j >= A.tw1 - 511);
        else if (MODE == MODE_SEL) need = (j == A.curblk);
        else need = (A.tw0 - 31 - 16 * (64 * j + 63) < 0);
        if (need) {
#pragma unroll
            for (int qb = 0; qb < 2; ++qb) { if ((qb == 0 && !Q0) || (qb == 1 && !Q1)) continue;
                const int tq = tq_of<MODE>(A, qb);
#pragma unroll
                for (int k4 = 0; k4 < 4; ++k4)
#pragma unroll
                    for (int r = 0; r < 4; ++r) { const int c = 64 * j + 16 * k4 + 4 * g + r; bool kill;
                        if (MODE == MODE_WIN) kill = (unsigned)(tq - c) >= 512u;
                        else if (MODE == MODE_CMPX) kill = (tq - 31 - 16 * c) < 0;
                        else kill = (tq - c) < 0;
                        s[k4][qb][r] = kill ? NEG : s[k4][qb][r]; } }
        }
    }
    u32x4 pw[2][2];
#pragma unroll
    for (int qb = 0; qb < 2; ++qb) { if ((qb == 0 && !Q0) || (qb == 1 && !Q1)) continue;
        if (MODE == MODE_CMPX) {
            float lmx = fmaxf(fmaxf(s[0][qb][0], s[0][qb][1]), fmaxf(s[0][qb][2], s[0][qb][3]));
#pragma unroll
            for (int k4 = 1; k4 < 4; ++k4) lmx = fmaxf(lmx, fmaxf(fmaxf(s[k4][qb][0], s[k4][qb][1]), fmaxf(s[k4][qb][2], s[k4][qb][3])));
            if (__any(lmx > ATT_THR)) {
                float mx = fmaxf(lmx, __shfl_xor(lmx, 16)); mx = fmaxf(mx, __shfl_xor(mx, 32));
                const float dl = fmaxf(mx, 0.f), alpha = __builtin_amdgcn_exp2f(-dl);
                m_run[qb] += dl; l_run[qb] *= alpha; A.carry[qb] *= alpha;
#pragma unroll
                for (int db = 0; db < 8; ++db) o[db][qb] *= alpha;
#pragma unroll
                for (int k4 = 0; k4 < 4; ++k4) s[k4][qb] -= dl;
                LAS bf16_t* X = (LAS bf16_t*)(lds + L_X) + ((A.tokbase + qb) * 16 + r16) * 64;
                for (int a = g; a < 16 * j; a += 4) X[a] = (bf16_t)(pk2(bf1(X[a]) * alpha, 0.f) & 0xffffu);
            }
        }
        float ps = 0.f; f32x4 e[4];
#pragma unroll
        for (int k4 = 0; k4 < 4; ++k4) { e[k4][0] = __builtin_amdgcn_exp2f(s[k4][qb][0]); e[k4][1] = __builtin_amdgcn_exp2f(s[k4][qb][1]); e[k4][2] = __builtin_amdgcn_exp2f(s[k4][qb][2]); e[k4][3] = __builtin_amdgcn_exp2f(s[k4][qb][3]);
            ps += (e[k4][0] + e[k4][1]) + (e[k4][2] + e[k4][3]); }
        if (MODE != MODE_CMPX) {
            if (__any(!(ps <= ATT_PS_LIMIT))) {
                float mx = fmaxf(fmaxf(s[0][qb][0], s[0][qb][1]), fmaxf(s[0][qb][2], s[0][qb][3]));
#pragma unroll
                for (int k4 = 1; k4 < 4; ++k4) mx = fmaxf(mx, fmaxf(fmaxf(s[k4][qb][0], s[k4][qb][1]), fmaxf(s[k4][qb][2], s[k4][qb][3])));
                mx = fmaxf(mx, __shfl_xor(mx, 16)); mx = fmaxf(mx, __shfl_xor(mx, 32));
                const float dl = fmaxf(mx, 0.f), alpha = __builtin_amdgcn_exp2f(-dl);
                m_run[qb] += dl; l_run[qb] *= alpha;
#pragma unroll
                for (int db = 0; db < 8; ++db) o[db][qb] *= alpha;
                ps = 0.f;
#pragma unroll
                for (int k4 = 0; k4 < 4; ++k4) { e[k4][0] = __builtin_amdgcn_exp2f(s[k4][qb][0] - dl); e[k4][1] = __builtin_amdgcn_exp2f(s[k4][qb][1] - dl); e[k4][2] = __builtin_amdgcn_exp2f(s[k4][qb][2] - dl); e[k4][3] = __builtin_amdgcn_exp2f(s[k4][qb][3] - dl);
                    ps += (e[k4][0] + e[k4][1]) + (e[k4][2] + e[k4][3]); }
            }
        } else {
            LAS bf16_t* X = (LAS bf16_t*)(lds + L_X) + ((A.tokbase + qb) * 16 + r16) * 64;
#pragma unroll
            for (int k4 = 0; k4 < 4; ++k4) {
                const float y = __shfl(e[k4][3], (r16 + 16 * g + 48) & 63);
                const float prev = g ? y : A.carry[qb];
                if (g == 0) A.carry[qb] = y;
                X[16 * j + 4 * k4 + g] = (bf16_t)(pk2((e[k4][0] + e[k4][1]) + (e[k4][2] + e[k4][3]) + prev, 0.f) & 0xffffu);
            }
        }
        l_run[qb] += ps;
        pw[0][qb].x = pk2(e[0][0], e[0][1]); pw[0][qb].y = pk2(e[0][2], e[0][3]); pw[0][qb].z = pk2(e[1][0], e[1][1]); pw[0][qb].w = pk2(e[1][2], e[1][3]);
        pw[1][qb].x = pk2(e[2][0], e[2][1]); pw[1][qb].y = pk2(e[2][2], e[2][3]); pw[1][qb].z = pk2(e[3][0], e[3][1]); pw[1][qb].w = pk2(e[3][2], e[3][3]);
    }
    {
        constexpr int VD = ATT3_VD;
        bf16x8 vf[VD + 1];
#pragma unroll
        for (int i = 0; i < VD; ++i) vf[i] = *(const LAS bf16x8*)(vb + ((i >> 3) ? vb1 : vb0) + (i & 7) * (16 * 128));
        __builtin_amdgcn_sched_barrier(0);
#pragma unroll
        for (int i = 0; i < 16; ++i) {
            if (i + VD < 16) { const int n_ = i + VD; vf[n_ % (VD + 1)] = *(const LAS bf16x8*)(vb + ((n_ >> 3) ? vb1 : vb0) + (n_ & 7) * (16 * 128)); }
            __builtin_amdgcn_sched_barrier(0);
            if (Q0) o[i & 7][0] = MFMA16(vf[i % (VD + 1)], __builtin_bit_cast(bf16x8, pw[i >> 3][0]), o[i & 7][0]);
            if (Q1) o[i & 7][1] = MFMA16(vf[i % (VD + 1)], __builtin_bit_cast(bf16x8, pw[i >> 3][1]), o[i & 7][1]);
            __builtin_amdgcn_sched_barrier(0);
        }
    }
}

DI void attn_issue_first(LAS unsigned char* lds, const char* __restrict__ Kc, const char* __restrict__ Vc, int vt_stride, int j) {
    int tid = threadIdx.x; asm volatile("" : "+v"(tid));
    const int lane = tid & 63;
    const int wid_ = __builtin_amdgcn_readfirstlane(tid >> 6);
    const char* kp_ = Kc + (size_t)j * KT_BYTES; LAS unsigned char* kb_ = lds + L_K + wid_ * 3072;
#pragma unroll
    for (int i_ = 0; i_ < 3; ++i_) { const int pidx_ = (wid_ * 3 + i_) * 64 + lane, row_ = pidx_ / 24, cp_ = pidx_ % 24;
        __builtin_amdgcn_global_load_lds((const unsigned*)(kp_ + (unsigned)(row_ * 384 + ((cp_ ^ ((row_ >> 1) & 7)) << 4))), (LAS unsigned*)(kb_ + i_ * 1024), 16, 0, 0); }
    const char* vp_ = Vc + (size_t)j * 128; LAS unsigned char* vb_ = lds + L_V + wid_ * 2048;
#pragma unroll
    for (int i_ = 0; i_ < 2; ++i_) { const int pidx_ = (wid_ * 2 + i_) * 64 + lane, row_ = pidx_ >> 3, cp_ = pidx_ & 7;
        __builtin_amdgcn_global_load_lds((const unsigned*)(vp_ + (unsigned)(row_ * vt_stride * 2 + ((cp_ ^ ((row_ >> 1) & 7)) << 4))), (LAS unsigned*)(vb_ + i_ * 1024), 16, 0, 0); }
}

template <int MODE>
DI void attn_pass3x(LAS unsigned char* lds, const char* __restrict__ Kc, const char* __restrict__ Vc, int vt_stride, int j_lo, int j_hi,
                    const bf16x8 (&q)[2][6], f32x4 (&o)[8][2], float (&m_run)[2], float (&l_run)[2], const AttnLane3& A, bool first_issued = false) {
    if (j_lo >= j_hi) return;
    int tid = threadIdx.x; asm volatile("" : "+v"(tid));
    const int lane = tid & 63;
    const int wid_ = __builtin_amdgcn_readfirstlane(tid >> 6);
    unsigned kgo[3], vgo[2];
#pragma unroll
    for (int i_ = 0; i_ < 3; ++i_) { const int pidx_ = (wid_ * 3 + i_) * 64 + lane, row_ = pidx_ / 24, cp_ = pidx_ % 24; kgo[i_] = (unsigned)(row_ * 384 + ((cp_ ^ ((row_ >> 1) & 7)) << 4)); }
#pragma unroll
    for (int i_ = 0; i_ < 2; ++i_) { const int pidx_ = (wid_ * 2 + i_) * 64 + lane, row_ = pidx_ >> 3, cp_ = pidx_ & 7; vgo[i_] = (unsigned)(row_ * vt_stride * 2 + ((cp_ ^ ((row_ >> 1) & 7)) << 4)); }
#define ST_ISSUE(j, buf) do { const char* kp_ = Kc + (size_t)(j) * KT_BYTES; LAS unsigned char* kb_ = lds + L_K + (buf) * KT_BYTES + wid_ * 3072; \
        _Pragma("unroll") for (int i_ = 0; i_ < 3; ++i_) __builtin_amdgcn_global_load_lds((const unsigned*)(kp_ + kgo[i_]), (LAS unsigned*)(kb_ + i_ * 1024), 16, 0, 0); \
        const char* vp_ = Vc + (size_t)(j) * 128; LAS unsigned char* vb_ = lds + L_V + (buf) * VT_BYTES + wid_ * 2048; \
        _Pragma("unroll") for (int i_ = 0; i_ < 2; ++i_) __builtin_amdgcn_global_load_lds((const unsigned*)(vp_ + vgo[i_]), (LAS unsigned*)(vb_ + i_ * 1024), 16, 0, 0); } while (0)
    if (!first_issued) ST_ISSUE(j_lo, 0);
    asm volatile("s_waitcnt vmcnt(0)" ::: "memory");
    __syncthreads();
    for (int j = j_lo; j < j_hi; ++j) {
        const int cur = (j - j_lo) & 1;
        if (j + 1 < j_hi) ST_ISSUE(j + 1, cur ^ 1);
        const LAS unsigned char* kbp = lds + L_K + cur * KT_BYTES; const LAS unsigned char* vbp = lds + L_V + cur * VT_BYTES;
        if (MODE == MODE_SEL) {
            const bool a0 = ((A.mk0 >> j) & 1ull) != 0ull, a1 = ((A.mk1 >> j) & 1ull) != 0ull;
            if (a0 && a1) attn_tile3<MODE, 3>(kbp, vbp, lds, j, q, o, m_run, l_run, A);
            else if (a0) attn_tile3<MODE, 1>(kbp, vbp, lds, j, q, o, m_run, l_run, A);
            else if (a1) attn_tile3<MODE, 2>(kbp, vbp, lds, j, q, o, m_run, l_run, A);
        } else {
            bool act;
            if (MODE == MODE_MLA) act = 64 * j <= A.tw1;
            else if (MODE == MODE_CMPX) act = 1024 * j + 31 <= A.tw1;
            else act = (64 * j <= A.tw1) && (64 * j + 63 >= A.tw0 - 511);
            if (act) attn_tile3<MODE, 3>(kbp, vbp, lds, j, q, o, m_run, l_run, A);
        }
        asm volatile("s_waitcnt vmcnt(0)" ::: "memory");
        __syncthreads();
    }
#undef ST_ISSUE
}

DI int t5_bucket(int n) {
    if (n < 16) return n;
    return 16 + (n >= 19) + (n >= 21) + (n >= 24) + (n >= 27) + (n >= 31) + (n >= 35) + (n >= 40) + (n >= 46) + (n >= 52) + (n >= 59) + (n >= 67) + (n >= 77) + (n >= 87) + (n >= 99) + (n >= 113);
}
DI float silu_f(float z) { return z * __builtin_amdgcn_rcpf(1.0f + __builtin_amdgcn_exp2f(-1.4426950408889634f * z)); }

constexpr int EPI_PITCH = 272, EPI_WAVE_BYTES = 32 * EPI_PITCH;
template <bool RMW, bool NSA, int F8 = 0>
DI void attn_epilogue3(LAS unsigned char* lds, int lane, int wid, const f32x4 (&o)[8][2], float scale0, float scale1,
                       const char* __restrict__ zbase, unsigned z0, char* __restrict__ obase, unsigned o0, bool dostore = true, char* __restrict__ o8base = nullptr, float o8s = O8_SCALE) {
    asm volatile("" : "+v"(lane));
    LAS unsigned char* sc = lds + wid * EPI_WAVE_BYTES;
    const int r16 = lane & 15, g = lane >> 4;
#pragma unroll
    for (int h = 0; h < 2; ++h) {
#pragma unroll
        for (int d4 = 0; d4 < 4; ++d4) {
            *(LAS f32x4*)(sc + r16 * EPI_PITCH + (16 * d4 + 4 * g) * 4) = o[4 * h + d4][0] * scale0;
            *(LAS f32x4*)(sc + (16 + r16) * EPI_PITCH + (16 * d4 + 4 * g) * 4) = o[4 * h + d4][1] * scale1;
        }
        asm volatile("" ::: "memory");
#pragma unroll
        for (int i = 0; i < 4; ++i) {
            const int rr = 8 * i + (lane >> 3), c8 = lane & 7;
            const f32x4 a = *(const LAS f32x4*)(sc + rr * EPI_PITCH + c8 * 32);
            const f32x4 b = *(const LAS f32x4*)(sc + rr * EPI_PITCH + c8 * 32 + 16);
            unsigned zoff, ooff;
            if (NSA) { zoff = z0 + (unsigned)((rr >> 4) * (N1P * 2) + (rr & 15) * 256); ooff = o0 + (unsigned)((rr >> 4) * (ZW8 * 2) + (rr & 15) * 256); }
            else     { zoff = z0 + (unsigned)(rr * (N3P * 2)); ooff = o0 + (unsigned)(rr * (ZW8 * 2)); }
            const unsigned cb = (unsigned)((64 * h + 8 * c8) * 2);
            if (!dostore) continue;
            const u32x4 zw = *(const u32x4*)(zbase + (zoff + cb));
            float v0 = a[0] * silu_f(bflo(zw.x)), v1 = a[1] * silu_f(bfhi(zw.x)), v2 = a[2] * silu_f(bflo(zw.y)), v3 = a[3] * silu_f(bfhi(zw.y));
            float v4 = b[0] * silu_f(bflo(zw.z)), v5 = b[1] * silu_f(bfhi(zw.z)), v6 = b[2] * silu_f(bflo(zw.w)), v7 = b[3] * silu_f(bfhi(zw.w));
            if (RMW) { const u32x4 pv = *(const u32x4*)(obase + (ooff + cb));
                v0 += bflo(pv.x); v1 += bfhi(pv.x); v2 += bflo(pv.y); v3 += bfhi(pv.y); v4 += bflo(pv.z); v5 += bfhi(pv.z); v6 += bflo(pv.w); v7 += bfhi(pv.w); }
            if (F8) { u32x2 w8; w8.x = pk4_fp8c(v0 * o8s, v1 * o8s, v2 * o8s, v3 * o8s); w8.y = pk4_fp8c(v4 * o8s, v5 * o8s, v6 * o8s, v7 * o8s);
                *(u32x2*)(o8base + ((ooff + cb) >> 1)) = w8; if (F8 == 1) continue; }
            u32x4 w; w.x = pk2(v0, v1); w.y = pk2(v2, v3); w.z = pk2(v4, v5); w.w = pk2(v6, v7);
            *(u32x4*)(obase + (ooff + cb)) = w;
        }
        asm volatile("" ::: "memory");
    }
}
DI float sum_g(float v) { v += __shfl_xor(v, 16); v += __shfl_xor(v, 32); return v; }

DI void phase_nsa_attn(LAS unsigned char* lds, const Params& P, int bid, int nb) {
    const char* Y0c = (const char*)(P.ws + OFF_Y0);
    const char* KSc = (const char*)(P.ws + OFF_KS); const char* KWc = (const char*)(P.ws + OFF_KW);
    const char* VTSc = (const char*)(P.ws + OFF_VTS); const char* VTWc = (const char*)(P.ws + OFF_VTW);
    const char* KCc = (const char*)(P.ws + OFF_KC); const char* VTCc = (const char*)(P.ws + OFF_VTC);
    char* ONc = (char*)(P.ws + OFF_O);
    LAS float* lut = (LAS float*)(lds + L_LUT);
    const int total = BATCH * NG * 256;
    {
        const int tid0 = tid_opaque();
        __syncthreads();
        for (int i = tid0; i < 64 * 128; i += 512) { const int hd = i >> 7, d = i & 127; lut[hd * LUT_PITCH + d] = (P.rel_bias[t5_bucket(d) * NH + hd] - P.rel_bias[31 * NH + hd]) * LOG2E; }
        __syncthreads();
    }
    for (int u_ = bid; u_ < total * PROBE3_UNITS; u_ += nb) {
        const int u = (u_ >= total) ? u_ - total : u_;
        int tid = threadIdx.x; asm volatile("" : "+v"(tid));
        const int lane = tid & 63, wid = __builtin_amdgcn_readfirstlane(tid >> 6);
        const int pair = u >> 8; int c = u & 255; if (pair & 1) c = 255 - c;
        const int b = pair >> 2, gg = pair & 3, t0 = c * 16;
        __syncthreads();
        AttnLane3 A;
        A.r16 = lane & 15; A.g = lane >> 4;
        A.tw0 = t0 + 2 * wid; A.tw1 = A.tw0 + 1;
        const int hh = gg * NR + A.r16;
        A.lutrow = lut + hh * LUT_PITCH;
        A.curblk = t0 >> 6; A.tokbase = 2 * wid; A.mk0 = 0ull; A.mk1 = 0ull; A.carry[0] = 0.f; A.carry[1] = 0.f;
        const unsigned ytok0 = (unsigned)(b * SEQ + A.tw0) * (unsigned)(N1P * 2);
        const unsigned otok0 = ((unsigned)(b * SEQ + A.tw0) * (unsigned)ZW8 + (unsigned)(gg * NR * DV)) * 2u;
        const int bg = b * NG + gg;
        const int nct = (t0 + 15 >= 31) ? (((t0 + 15 - 31) >> 4) / 64 + 1) : 0;
        if (ATT3_HOIST && nct > 0) attn_issue_first(lds, KCc + (size_t)bg * 256 * DK * 2, VTCc + (size_t)bg * DV * 256 * 2, 256, 0);
        bf16x8 q[2][6];
#pragma unroll
        for (int qb = 0; qb < 2; ++qb) {
            const unsigned qo = ytok0 + (unsigned)(qb * (N1P * 2)) + (unsigned)((C_Q + hh * DK + 8 * A.g) * 2);
            float ss = 0.f;
#pragma unroll
            for (int ds = 0; ds < 6; ++ds) { q[qb][ds] = *(const bf16x8*)(Y0c + (qo + 64u * ds));
                const u32x4 w = __builtin_bit_cast(u32x4, q[qb][ds]);
                const float a0 = bflo(w.x), a1 = bfhi(w.x), a2 = bflo(w.y), a3 = bfhi(w.y), a4 = bflo(w.z), a5 = bfhi(w.z), a6 = bflo(w.w), a7 = bfhi(w.w);
                ss += (a0 * a0 + a1 * a1) + (a2 * a2 + a3 * a3) + (a4 * a4 + a5 * a5) + (a6 * a6 + a7 * a7); }
            ss = sum_g(ss);
            const float rstd = rsqrtf(ss * (1.0f / DK) + EPSN) * QSCALE;
#pragma unroll
            for (int ds = 0; ds < 6; ++ds) { const float* gn = P.nsa_q_norm + 32 * ds + 8 * A.g; const f32x4 g0 = *(const f32x4*)gn, g1 = *(const f32x4*)(gn + 4);
                u32x4 w = __builtin_bit_cast(u32x4, q[qb][ds]);
                w.x = pk2(bflo(w.x) * rstd * g0[0], bfhi(w.x) * rstd * g0[1]); w.y = pk2(bflo(w.y) * rstd * g0[2], bfhi(w.y) * rstd * g0[3]);
                w.z = pk2(bflo(w.z) * rstd * g1[0], bfhi(w.z) * rstd * g1[1]); w.w = pk2(bflo(w.w) * rstd * g1[2], bfhi(w.w) * rstd * g1[3]);
                q[qb][ds] = __builtin_bit_cast(bf16x8, w); }
        }
        f32x4 o[8][2]; float m_run[2], l_run[2];
#define RESET_STATE() do { _Pragma("unroll") for (int d_ = 0; d_ < 8; ++d_) { o[d_][0] = (f32x4){0.f, 0.f, 0.f, 0.f}; o[d_][1] = (f32x4){0.f, 0.f, 0.f, 0.f}; } m_run[0] = 0.f; m_run[1] = 0.f; l_run[0] = 0.f; l_run[1] = 0.f; } while (0)
#define GATE_SIG(x, qb) (1.0f / (1.0f + __expf(-bf1(*(const bf16_t*)(Y0c + (ytok0 + (unsigned)((qb) * (N1P * 2)) + (unsigned)((C_G + (x) * NH + hh) * 2)))))))
        RESET_STATE();
        attn_pass3x<MODE_CMPX>(lds, KCc + (size_t)bg * 256 * DK * 2, VTCc + (size_t)bg * DV * 256 * 2, 256, 0, nct, q, o, m_run, l_run, A, ATT3_HOIST != 0);
        { const float lt0 = sum_g(l_run[0]), lt1 = sum_g(l_run[1]); const float il0 = lt0 > 0.f ? 1.0f / lt0 : 0.f, il1 = lt1 > 0.f ? 1.0f / lt1 : 0.f;
          if (lane < 16) { ((LAS float*)(lds + L_IL))[(A.tokbase + 0) * 16 + A.r16] = il0; ((LAS float*)(lds + L_IL))[(A.tokbase + 1) * 16 + A.r16] = il1; }
          attn_epilogue3<false, true>(lds, lane, wid, o, GATE_SIG(0, 0) * il0, GATE_SIG(0, 1) * il1, Y0c, ytok0 + (unsigned)((C_ZC + gg * NR * DV) * 2), ONc, otok0, PROBE3_STORE2 || u_ < total); }
        __syncthreads();
        if (ATT3_HOIST) attn_issue_first(lds, KSc + (size_t)bg * SEQ * DK * 2, VTSc + (size_t)bg * DV * SEQ * 2, SEQ, 0);
        {
            const int cur = A.curblk;
            unsigned long long mk[2];
#pragma unroll
            for (int t = 0; t < 2; ++t) {
                const LAS bf16_t* X = (const LAS bf16_t*)(lds + L_X) + (2 * wid + t) * 16 * 64;
                const LAS float* IL = (const LAS float*)(lds + L_IL) + (2 * wid + t) * 16;
                const bool forced = (lane == 0) || (lane == cur) || (lane == cur - 1);
                const bool future = lane > cur;
                float v = 0.f;
                if (!forced && !future) {
#pragma unroll
                    for (int rr = 0; rr < 16; ++rr) v += IL[rr] * bf1(X[rr * 64 + lane]); }
                unsigned key = (__float_as_uint(v) & ~63u);
                if (forced) key = 0x7f800000u; else if (future) key = 0u;
                key |= (unsigned)(63 - lane);
                int rank = 0;
#pragma unroll
                for (int jp = 0; jp < 64; ++jp) { const unsigned kj = (unsigned)__builtin_amdgcn_readlane((int)key, jp); rank += (kj > key) ? 1 : 0; }
                mk[t] = __ballot(rank < 16 && !future);
            }
            A.mk0 = mk[0]; A.mk1 = mk[1];
        }
        RESET_STATE();
        attn_pass3x<MODE_SEL>(lds, KSc + (size_t)bg * SEQ * DK * 2, VTSc + (size_t)bg * DV * SEQ * 2, SEQ, 0, A.curblk + 1, q, o, m_run, l_run, A, ATT3_HOIST != 0);
        { const float lt0 = sum_g(l_run[0]), lt1 = sum_g(l_run[1]);
          attn_epilogue3<true, true>(lds, lane, wid, o, GATE_SIG(1, 0) / lt0, GATE_SIG(1, 1) / lt1, Y0c, ytok0 + (unsigned)((C_ZS + gg * NR * DV) * 2), ONc, otok0, PROBE3_STORE2 || u_ < total); }
        __syncthreads();
        RESET_STATE();
        { const int jl = (t0 - 511) > 0 ? (t0 - 511) >> 6 : 0, jh = ((t0 + 15) >> 6) + 1;
          for (int prb_ = 0; prb_ < PROBE3_WIN; ++prb_) attn_pass3x<MODE_WIN>(lds, KWc + (size_t)bg * SEQ * DK * 2, VTWc + (size_t)bg * DV * SEQ * 2, SEQ, jl, jh, q, o, m_run, l_run, A); }
        { const float lt0 = sum_g(l_run[0]), lt1 = sum_g(l_run[1]);
          attn_epilogue3<true, true, USE_FP8N ? 2 : 0>(lds, lane, wid, o, GATE_SIG(2, 0) / lt0, GATE_SIG(2, 1) / lt1, Y0c, ytok0 + (unsigned)((C_ZW + gg * NR * DV) * 2), ONc, otok0, PROBE3_STORE2 || u_ < total, (char*)(P.ws + OFF_O8N), O8N_SCALE); }
#undef RESET_STATE
#undef GATE_SIG
    }
}

DI void phase_mla_attn(LAS unsigned char* lds, const Params& P, int bid, int nb) {
    const char* QMc = (const char*)(P.ws + OFF_QM); const char* KMc = (const char*)(P.ws + OFF_KM); const char* VTMc = (const char*)(P.ws + OFF_VTM);
    const char* Y1c = (const char*)(P.ws + OFF_Y1); char* OMc = (char*)(P.ws + OFF_O);
    const int total = BATCH * NH * 16;
    for (int uu = 0; bid + (uu >> 1) * nb < total / 2; ++uu) {
        int tid = threadIdx.x; asm volatile("" : "+v"(tid));
        const int lane = tid & 63, wid = __builtin_amdgcn_readfirstlane(tid >> 6);
        const int item = bid + (uu >> 1) * nb, second = uu & 1;
        const int xcd = item & 7, tt = item >> 3, p = tt & 7, hl = (tt >> 3) & 3, rnd = tt >> 5;
        const int bh = rnd * 32 + xcd * 4 + hl, qblk = second ? p : 15 - p, b = bh >> 6, h = bh & 63, t0 = qblk * 256;
        AttnLane3 A;
        A.r16 = lane & 15; A.g = lane >> 4;
        A.tw0 = t0 + 32 * wid; A.tw1 = A.tw0 + 31;
        A.lutrow = nullptr; A.curblk = 0; A.tokbase = 0; A.mk0 = 0ull; A.mk1 = 0ull; A.carry[0] = 0.f; A.carry[1] = 0.f;
        bf16x8 q[2][6];
#pragma unroll
        for (int qb = 0; qb < 2; ++qb) {
            const unsigned trow = (unsigned)(b * SEQ + A.tw0 + 16 * qb + A.r16);
            const unsigned qo = (trow * (unsigned)NQB + (unsigned)(h * DK + 8 * A.g)) * 2u;
            float ss = 0.f;
#pragma unroll
            for (int ds = 0; ds < 6; ++ds) { q[qb][ds] = *(const bf16x8*)(QMc + (qo + 64u * ds));
                const u32x4 w = __builtin_bit_cast(u32x4, q[qb][ds]);
                const float a0 = bflo(w.x), a1 = bfhi(w.x), a2 = bflo(w.y), a3 = bfhi(w.y), a4 = bflo(w.z), a5 = bfhi(w.z), a6 = bflo(w.w), a7 = bfhi(w.w);
                ss += (a0 * a0 + a1 * a1) + (a2 * a2 + a3 * a3) + (a4 * a4 + a5 * a5) + (a6 * a6 + a7 * a7); }
            ss = sum_g(ss);
            const float rstd = rsqrtf(ss * (1.0f / DK) + EPSN);
            const float* ropep = (const float*)(P.ws + OFF_ROPE) + (size_t)trow * 64;
#pragma unroll
            for (int ds = 0; ds < 4; ++ds) { const float* gn = P.mla_q_norm + 32 * ds + 8 * A.g; const f32x4 g0 = *(const f32x4*)gn, g1 = *(const f32x4*)(gn + 4);
                const float sc = rstd * QSCALE;
                u32x4 w = __builtin_bit_cast(u32x4, q[qb][ds]);
                w.x = pk2(bflo(w.x) * sc * g0[0], bfhi(w.x) * sc * g0[1]); w.y = pk2(bflo(w.y) * sc * g0[2], bfhi(w.y) * sc * g0[3]);
                w.z = pk2(bflo(w.z) * sc * g1[0], bfhi(w.z) * sc * g1[1]); w.w = pk2(bflo(w.w) * sc * g1[2], bfhi(w.w) * sc * g1[3]);
                q[qb][ds] = __builtin_bit_cast(bf16x8, w); }
            {
                const int i0 = 8 * A.g;
                const float* g1p = P.mla_q_norm + 128 + i0; const float* g2p = P.mla_q_norm + 160 + i0;
                const u32x4 w1 = __builtin_bit_cast(u32x4, q[qb][4]), w2 = __builtin_bit_cast(u32x4, q[qb][5]);
                float x1[8] = {bflo(w1.x), bfhi(w1.x), bflo(w1.y), bfhi(w1.y), bflo(w1.z), bfhi(w1.z), bflo(w1.w), bfhi(w1.w)};
                float x2[8] = {bflo(w2.x), bfhi(w2.x), bflo(w2.y), bfhi(w2.y), bflo(w2.z), bfhi(w2.z), bflo(w2.w), bfhi(w2.w)};
                float y1[8], y2[8];
#pragma unroll
                for (int e = 0; e < 8; ++e) { const float cs = ropep[i0 + e], sn = ropep[32 + i0 + e];
                    const float a = x1[e] * rstd * g1p[e], c = x2[e] * rstd * g2p[e];
                    y1[e] = (a * cs - c * sn) * QSCALE; y2[e] = (c * cs + a * sn) * QSCALE; }
                u32x4 o1, o2;
                o1.x = pk2(y1[0], y1[1]); o1.y = pk2(y1[2], y1[3]); o1.z = pk2(y1[4], y1[5]); o1.w = pk2(y1[6], y1[7]);
                o2.x = pk2(y2[0], y2[1]); o2.y = pk2(y2[2], y2[3]); o2.z = pk2(y2[4], y2[5]); o2.w = pk2(y2[6], y2[7]);
                q[qb][4] = __builtin_bit_cast(bf16x8, o1); q[qb][5] = __builtin_bit_cast(bf16x8, o2);
            }
        }
        f32x4 o[8][2]; float m_run[2] = {0.f, 0.f}, l_run[2] = {0.f, 0.f};
#pragma unroll
        for (int d = 0; d < 8; ++d) { o[d][0] = (f32x4){0.f, 0.f, 0.f, 0.f}; o[d][1] = (f32x4){0.f, 0.f, 0.f, 0.f}; }
        attn_pass3x<MODE_MLA>(lds, KMc + (size_t)bh * SEQ * DK * 2, VTMc + (size_t)bh * DV * SEQ * 2, SEQ, 0, 4 * qblk + 4, q, o, m_run, l_run, A);
        const float lt0 = sum_g(l_run[0]), lt1 = sum_g(l_run[1]);
        { const unsigned t0w = (unsigned)(b * SEQ + A.tw0);
          const unsigned zo_ = (t0w * (unsigned)N3P + (unsigned)(C3_Z + h * DV)) * 2u, oo_ = (t0w * (unsigned)ZW8 + (unsigned)(h * DV)) * 2u;
          if (USE_FP8O && qblk != 0) attn_epilogue3<false, false, 1>(lds, lane, wid, o, 1.0f / lt0, 1.0f / lt1, Y1c, zo_, OMc, oo_, true, (char*)(P.ws + OFF_O8M), O8_SCALE);
          else attn_epilogue3<false, false, 0>(lds, lane, wid, o, 1.0f / lt0, 1.0f / lt1, Y1c, zo_, OMc, oo_); }
        __syncthreads();
    }
}
constexpr int LDS_KN_OFF = 135168, LDS_ST_OFF = LDS_KN_OFF + 16384, LDS_BYTES = LDS_ST_OFF + 16;
constexpr int NPHASE = 14;

#ifndef USE_FP8M
#define USE_FP8M 0
#endif
#ifndef USE_FP8Z
#define USE_FP8Z 0
#endif
#ifndef DUP5
#define DUP5 0
#endif
#ifndef P3_GEMM_REP
#define P3_GEMM_REP 1
#endif
#ifndef P3_WCONV_REP
#define P3_WCONV_REP 1
#endif
template <int PH>
DI void run_phase(const Params& P, LAS unsigned char* lds, int bid, int nb) {
    unsigned char* ws = P.ws;
    if constexpr (PH == 0) {
        phase_wconv(lds, P.nsa_w_in, (bf16_t*)(ws + OFF_W1T), DM, N1, N1P, bid, nb, (FP8EMU & 4) ? 64.0f : 0.f, 0, USE_FP8Z ? (unsigned char*)(ws + OFF_B8) : nullptr, 0);
        phase_wconv(lds, P.w1_k, (bf16_t*)(ws + OFF_W1K), 6144, 192, 256, bid, nb);
        phase_wconv(lds, P.w1_v, (bf16_t*)(ws + OFF_W1V), 4096, 128, 256, bid, nb);
        phase_rmsnorm(P.x, P.norm_w, (bf16_t*)(ws + OFF_H), bid, nb, (FP8EMU & 4) ? 16.0f : 0.f, USE_FP8Z ? (unsigned char*)(ws + OFF_A8) : nullptr);
    } else if constexpr (PH == 1) {
        if (USE_FP8Z) {
            {
                pg8::Gemm g{(const bf16_t*)(ws + OFF_H), (const bf16_t*)(ws + OFF_W1T), MTOK, N1P, DM};
                pg8::OrderBf16Part S{nb, bid, F8_Q0, F8_NQ, N1P / 256 - F8_NQ};
                pg8::EpiStoreBf16 E{(bf16_t*)(ws + OFF_Y0), N1P};
                pg8::gemm_phase<pg8::EpiStoreBf16, pg8::OrderBf16Part, false>(lds, g, S, E, nullptr);
            }
            __syncthreads();
            {
                pg8::Gemm g{(const bf16_t*)(ws + OFF_A8), (const bf16_t*)(ws + OFF_B8), MTOK, N1P, DM / 2};
                pg8::OrderFp8Part S{nb, bid, F8_Q0, F8_NQ, N1P / 256 - F8_NQ, (256 - ((F8_NQ * 64 + (N1P / 256 - F8_NQ) * 4) & 255)) & 255};
                pg8::EpiStoreBf16Fp8 E{(bf16_t*)(ws + OFF_Y0), N1P, 1.0f / (16.0f * 64.0f)};
                pg8::gemm_phase<pg8::EpiStoreBf16Fp8, pg8::OrderFp8Part, false>(lds, g, S, E, nullptr);
            }
        } else {
        pg8::Gemm g{(const bf16_t*)(ws + OFF_H), (const bf16_t*)(ws + OFF_W1T), MTOK, N1P, DM};
        pg8::StaticOrder S; S.init(g.M, g.N, nb, bid);
        pg8::EpiStoreBf16 E{(bf16_t*)(ws + OFF_Y0), N1P};
        pg8::gemm_phase<pg8::EpiStoreBf16, pg8::StaticOrder, false>(lds, g, S, E, nullptr);
        }
    } else if constexpr (PH == 2) {
        phase_nsa_prep(P, bid, nb);
        phase_vt(lds, (const bf16_t*)(ws + OFF_Y0), N1P, C_KVS + NG * DK, DV, NG, (bf16_t*)(ws + OFF_VTS), bid, nb);
        phase_vt(lds, (const bf16_t*)(ws + OFF_Y0), N1P, C_KVW + NG * DK, DV, NG, (bf16_t*)(ws + OFF_VTW), bid, nb);
    } else if constexpr (PH == 3) {
        for (int p3g_ = 0; p3g_ < ((bid < 32) ? P3_GEMM_REP : P3_WCONV_REP); ++p3g_) { if (p3g_) __syncthreads();
        if (bid < 16) {
            pg8::Gemm g{(const bf16_t*)(ws + OFF_ACK), (const bf16_t*)(ws + OFF_W1K), 4096, 256, 6144};
            pg8::StaticOrder S; S.init(g.M, g.N, 16, bid);
            pg8::EpiPlainF32 E{(float*)(ws + OFF_HIDK), 256};
            pg8::gemm_phase<pg8::EpiPlainF32, pg8::StaticOrder, false>(lds, g, S, E, nullptr);
        } else if (bid < 32) {
            pg8::Gemm g{(const bf16_t*)(ws + OFF_ACV), (const bf16_t*)(ws + OFF_W1V), 4096, 256, 4096};
            pg8::StaticOrder S; S.init(g.M, g.N, 16, bid - 16);
            pg8::EpiPlainF32 E{(float*)(ws + OFF_HIDV), 256};
            pg8::gemm_phase<pg8::EpiPlainF32, pg8::StaticOrder, false>(lds, g, S, E, nullptr);
        } else {
            phase_wconv(lds, P.nsa_w_out, (bf16_t*)(ws + OFF_W2T), ZW8, DM, DM, bid - 32, nb - 32, (FP8EMU & 1) ? 64.0f : 0.f, 0, USE_FP8N ? (unsigned char*)(ws + OFF_W28) : nullptr, 0);
            phase_wconv(lds, P.mla_w_in, (bf16_t*)(ws + OFF_W3T), DM, N3, N3P, bid - 32, nb - 32, (FP8EMU & 8) ? 64.0f : 0.f, 0, USE_FP8M ? (unsigned char*)(ws + OFF_B8M) : nullptr, 0);
        }
        }
    } else if constexpr (PH == 4) {
        phase_cmp2(lds, P, bid, nb);
    } else if constexpr (PH == 5) {
        { float* ss1 = (float*)(ws + OFF_SS1); for (int i = bid * 512 + (int)threadIdx.x; i < MTOK; i += nb * 512) ss1[i] = 0.f; }
        phase_nsa_attn(lds, P, bid, nb);
    } else if constexpr (PH == 6) {
        if (USE_FP8N) {
            {
                pg8::Gemm g{(const bf16_t*)(ws + OFF_O), (const bf16_t*)(ws + OFF_W2T), MTOK, DM, ZW8};
                pg8::OrderBf16Part S{nb, bid, 0, 0, DM / 256};
                pg8::EpiResNorm E{P.x, P.out, DM, P.norm_w + DM, (bf16_t*)(ws + OFF_H), (float*)(ws + OFF_SS1), USE_FP8M ? (unsigned char*)(ws + OFF_A8M) : nullptr, 1.0f};
                pg8::gemm_phase<pg8::EpiResNorm, pg8::OrderBf16Part, false>(lds, g, S, E, nullptr);
            }
            __syncthreads();
            {
                pg8::Gemm g{(const bf16_t*)(ws + OFF_O8N), (const bf16_t*)(ws + OFF_W28), MTOK, DM, ZW8 / 2};
                pg8::OrderFp8Part S{nb, bid, 0, 0, DM / 256, 192};
                pg8::EpiResNormFp8 E{P.x, P.out, DM, P.norm_w + DM, (bf16_t*)(ws + OFF_H), (float*)(ws + OFF_SS1), USE_FP8M ? (unsigned char*)(ws + OFF_A8M) : nullptr, 1.0f / (O8N_SCALE * 64.0f)};
                pg8::gemm_phase<pg8::EpiResNormFp8, pg8::OrderFp8Part, false>(lds, g, S, E, nullptr);
            }
        } else {
        pg8::Gemm g{(const bf16_t*)(ws + OFF_O), (const bf16_t*)(ws + OFF_W2T), MTOK, DM, ZW8};
        pg8::StaticOrder S; S.init(g.M, g.N, nb, bid);
        pg8::EpiResNorm E{P.x, P.out, DM, P.norm_w + DM, (bf16_t*)(ws + OFF_H), (float*)(ws + OFF_SS1), USE_FP8M ? (unsigned char*)(ws + OFF_A8M) : nullptr, 1.0f};
        pg8::gemm_phase<pg8::EpiResNorm, pg8::StaticOrder, false>(lds, g, S, E, nullptr);
        }
    } else if constexpr (PH == 7) {
        phase_rmsnorm(P.out, P.norm_w + DM, (bf16_t*)(ws + OFF_H), bid, nb, (FP8EMU & 8) ? 16.0f : 0.f);
    } else if constexpr (PH == 8) {
        if (USE_FP8M) {
            {
                pg8::Gemm g{(const bf16_t*)(ws + OFF_H), (const bf16_t*)(ws + OFF_W3T), MTOK, N3P, DM};
                pg8::OrderBf16Part S{nb, bid, 0, C3_Z8 / 256, NZ8M / 256};
                pg8::EpiStoreBf16RowScale E{(bf16_t*)(ws + OFF_Y1), N3P, (const float*)(ws + OFF_SS1), 1.0f / DM};
                pg8::gemm_phase<pg8::EpiStoreBf16RowScale, pg8::OrderBf16Part, false>(lds, g, S, E, nullptr);
            }
            __syncthreads();
            {
                pg8::Gemm g{(const bf16_t*)(ws + OFF_A8M), (const bf16_t*)(ws + OFF_B8M), MTOK, N3P, DM / 2};
                pg8::OrderFp8Part S{nb, bid, 0, C3_Z8 / 256, NZ8M / 256, 64};
                pg8::EpiStoreBf16RowScaleFp8 E{(bf16_t*)(ws + OFF_Y1), N3P, (const float*)(ws + OFF_SS1), 1.0f / DM, 1.0f / (16.0f * 64.0f)};
                pg8::gemm_phase<pg8::EpiStoreBf16RowScaleFp8, pg8::OrderFp8Part, false>(lds, g, S, E, nullptr);
            }
        } else {
        pg8::Gemm g{(const bf16_t*)(ws + OFF_H), (const bf16_t*)(ws + OFF_W3T), MTOK, N3P, DM};
        pg8::StaticOrder S; S.init(g.M, g.N, nb, bid);
        pg8::EpiStoreBf16RowScale E{(bf16_t*)(ws + OFF_Y1), N3P, (const float*)(ws + OFF_SS1), 1.0f / DM};
        pg8::gemm_phase<pg8::EpiStoreBf16RowScale, pg8::StaticOrder, false>(lds, g, S, E, nullptr);
        }
        __syncthreads();
        if (bid >= 64 && nb > 64) {
            phase_wconv(lds, P.mla_w_q_b, (bf16_t*)(ws + OFF_W4T), QLORA, NQB, NQB, bid - 64, nb - 64);
            phase_wconv(lds, P.mla_w_kv_b, (bf16_t*)(ws + OFF_W5K), KVLORA, NKVB / 2, NKVB / 2, bid - 64, nb - 64, 0.f, 2);
            phase_wconv(lds, P.mla_w_kv_b, (bf16_t*)(ws + OFF_W5V), KVLORA, NKVB / 2, NKVB / 2, bid - 64, nb - 64, 0.f, 1);
            phase_wconv(lds, P.mla_w_out, (bf16_t*)(ws + OFF_W6T), ZW8, DM, DM, bid - 64, nb - 64, (FP8EMU & 2) ? 64.0f : 0.f, 0, USE_FP8O ? (unsigned char*)(ws + OFF_W68) : nullptr, 0);
        } else if (nb <= 64) {
            phase_wconv(lds, P.mla_w_q_b, (bf16_t*)(ws + OFF_W4T), QLORA, NQB, NQB, bid, nb);
            phase_wconv(lds, P.mla_w_kv_b, (bf16_t*)(ws + OFF_W5K), KVLORA, NKVB / 2, NKVB / 2, bid, nb, 0.f, 2);
            phase_wconv(lds, P.mla_w_kv_b, (bf16_t*)(ws + OFF_W5V), KVLORA, NKVB / 2, NKVB / 2, bid, nb, 0.f, 1);
            phase_wconv(lds, P.mla_w_out, (bf16_t*)(ws + OFF_W6T), ZW8, DM, DM, bid, nb, (FP8EMU & 2) ? 64.0f : 0.f, 0, USE_FP8O ? (unsigned char*)(ws + OFF_W68) : nullptr, 0);
        }
    } else if constexpr (PH == 9) {
        phase_mla_prep1(P, bid, nb);
    } else if constexpr (PH == 10) {
        {
            pg8::Gemm g{(const bf16_t*)(ws + OFF_CQN), (const bf16_t*)(ws + OFF_W4T), MTOK, NQB, QLORA};
            pg8::StaticOrder S; S.init(g.M, g.N, nb, bid);
            pg8::EpiStoreBf16 E{(bf16_t*)(ws + OFF_QM), NQB};
            pg8::gemm_phase<pg8::EpiStoreBf16, pg8::StaticOrder, false>(lds, g, S, E, nullptr);
        }
        __syncthreads();
        {
            pg8::Gemm g{(const bf16_t*)(ws + OFF_CKVN), (const bf16_t*)(ws + OFF_W5K), MTOK, NKVB / 2, KVLORA};
            pg8::StaticOrder S; S.init(g.M, g.N, nb, bid);
            pg8::EpiKNorm E{(bf16_t*)(ws + OFF_KM), (const float*)(ws + OFF_SSPE), (const float*)(ws + OFF_KPER), P.mla_k_norm, (LAS float*)(lds + LDS_KN_OFF), 0u};
            pg8::gemm_phase<pg8::EpiKNorm, pg8::StaticOrder, false>(lds, g, S, E, nullptr);
        }
        __syncthreads();
        {
            pg8::Gemm g{(const bf16_t*)(ws + OFF_W5V), (const bf16_t*)(ws + OFF_CKVN), NKVB / 2, MTOK, KVLORA};
            pg8::StaticOrder S; S.init(g.M, g.N, nb, bid);
            pg8::EpiVT E{(bf16_t*)(ws + OFF_VTM)};
            pg8::gemm_phase<pg8::EpiVT, pg8::StaticOrder, false>(lds, g, S, E, nullptr);
        }
    } else if constexpr (PH == 11) {
    } else if constexpr (PH == 12) {
        phase_mla_attn(lds, P, bid, nb);
    } else if constexpr (PH == 13) {
        if (USE_FP8O) {
            {
                pg8::Gemm g{(const bf16_t*)(ws + OFF_O), (const bf16_t*)(ws + OFF_W6T), MTOK, DM, ZW8};
                pg8::OrderBf16Part S{nb, bid, 0, 0, DM / 256};
                pg8::EpiResF32 E{P.out, P.out, DM};
                pg8::gemm_phase<pg8::EpiResF32, pg8::OrderBf16Part, false>(lds, g, S, E, nullptr);
            }
            __syncthreads();
            {
                pg8::Gemm g{(const bf16_t*)(ws + OFF_O8M), (const bf16_t*)(ws + OFF_W68), MTOK, DM, ZW8 / 2};
                pg8::OrderFp8Part S{nb, bid, 0, 0, DM / 256, 192};
                pg8::EpiResF32Fp8 E{P.out, P.out, DM, 1.0f / (O8_SCALE * 64.0f)};
                pg8::gemm_phase<pg8::EpiResF32Fp8, pg8::OrderFp8Part, false>(lds, g, S, E, nullptr);
            }
        } else {
        pg8::Gemm g{(const bf16_t*)(ws + OFF_O), (const bf16_t*)(ws + OFF_W6T), MTOK, DM, ZW8};
        pg8::StaticOrder S; S.init(g.M, g.N, nb, bid);
        pg8::EpiResF32 E{P.out, P.out, DM};
        pg8::gemm_phase<pg8::EpiResF32, pg8::StaticOrder, false>(lds, g, S, E, nullptr);
        }
    }
}

#ifndef REP0
#define REP0 1
#endif
#ifndef REP1
#define REP1 1
#endif
#ifndef REP2
#define REP2 1
#endif
#ifndef REP3
#define REP3 1
#endif
#ifndef REP4
#define REP4 1
#endif
#ifndef REP5
#define REP5 1
#endif
#ifndef REP6
#define REP6 1
#endif
#ifndef REP7
#define REP7 1
#endif
#ifndef REP8
#define REP8 1
#endif
#ifndef REP9
#define REP9 1
#endif
#ifndef REP10
#define REP10 1
#endif
#ifndef REP11
#define REP11 1
#endif
#ifndef REP12
#define REP12 1
#endif
#ifndef REP13
#define REP13 1
#endif

__global__ __launch_bounds__(512, 2) void k_mega(Params P) {
    extern __shared__ __attribute__((aligned(16))) unsigned char shm[];
    LAS unsigned char* lds = (LAS unsigned char*)shm;
    volatile LAS unsigned* st = (volatile LAS unsigned*)(lds + LDS_ST_OFF);
    if (threadIdx.x == 0) { st[0] = 0u; st[1] = 0u; st[2] = 0u; st[3] = 0u; }
    __syncthreads();
    XcdBarrier bar = xcd_barrier_post((unsigned*)(P.ws + OFF_CTL), st);
    const int bid = (int)blockIdx.x, nb = (int)gridDim.x;
    for (int rep_ = 0; rep_ < REP0; ++rep_) run_phase<0>(P, lds, bid, nb);  xcd_barrier(bar);
    for (int rep_ = 0; rep_ < REP1; ++rep_) run_phase<1>(P, lds, bid, nb);  xcd_barrier(bar);
    for (int rep_ = 0; rep_ < REP2; ++rep_) run_phase<2>(P, lds, bid, nb);  xcd_barrier(bar);
    for (int rep_ = 0; rep_ < REP3; ++rep_) run_phase<3>(P, lds, bid, nb);  xcd_barrier(bar);
    for (int rep_ = 0; rep_ < REP4; ++rep_) run_phase<4>(P, lds, bid, nb);  xcd_barrier(bar);
    for (int rep_ = 0; rep_ < REP5; ++rep_) run_phase<5>(P, lds, bid, nb);
#if DUP5
    __syncthreads(); run_phase<5>(P, lds, bid, nb);
#endif
    xcd_barrier(bar);
    for (int rep_ = 0; rep_ < REP6; ++rep_) run_phase<6>(P, lds, bid, nb);  xcd_barrier(bar);
    for (int rep_ = 0; rep_ < REP8; ++rep_) run_phase<8>(P, lds, bid, nb);  xcd_barrier(bar);
    for (int rep_ = 0; rep_ < REP9; ++rep_) run_phase<9>(P, lds, bid, nb);  xcd_barrier(bar);
    for (int rep_ = 0; rep_ < REP10; ++rep_) run_phase<10>(P, lds, bid, nb); xcd_barrier(bar);
    for (int rep_ = 0; rep_ < REP12; ++rep_) run_phase<12>(P, lds, bid, nb); xcd_barrier(bar);
    for (int rep_ = 0; rep_ < REP13; ++rep_) run_phase<13>(P, lds, bid, nb);
}

extern "C" void kernel_launch(void* const* d_in, const int* in_sizes, int n_in, void* d_out, int out_size, void* d_ws, size_t ws_size, hipStream_t stream) {
    (void)in_sizes; (void)n_in; (void)out_size;
    if (ws_size < WS_END) return;
    Params P{};
    P.x = (const float*)d_in[0]; P.pos = (const int*)d_in[1]; P.norm_w = (const float*)d_in[2]; P.rel_bias = (const float*)d_in[3];
    P.nsa_w_in = (const float*)d_in[4]; P.nsa_q_norm = (const float*)d_in[5]; P.nsa_k_norm = (const float*)d_in[6]; P.pe_k = (const float*)d_in[7];
    P.w1_k = (const float*)d_in[8]; P.w2_k = (const float*)d_in[9]; P.pe_v = (const float*)d_in[10]; P.w1_v = (const float*)d_in[11]; P.w2_v = (const float*)d_in[12];
    P.nsa_w_out = (const float*)d_in[13]; P.mla_w_in = (const float*)d_in[14]; P.mla_q_a_norm = (const float*)d_in[15]; P.mla_w_q_b = (const float*)d_in[16];
    P.mla_kv_a_norm = (const float*)d_in[17]; P.mla_w_kv_b = (const float*)d_in[18]; P.mla_q_norm = (const float*)d_in[19]; P.mla_k_norm = (const float*)d_in[20];
    P.mla_w_out = (const float*)d_in[21];
    P.out = (float*)d_out; P.ws = (unsigned char*)d_ws;
    static int grid = 0;
    if (!grid) {
        int dev = 0, cus = 0, per_cu = 0; (void)hipGetDevice(&dev);
        if (hipDeviceGetAttribute(&cus, hipDeviceAttributeMultiprocessorCount, dev) != hipSuccess || cus <= 0) cus = 256;
        (void)hipFuncSetAttribute((const void*)k_mega, hipFuncAttributeMaxDynamicSharedMemorySize, LDS_BYTES);
        if (hipOccupancyMaxActiveBlocksPerMultiprocessor(&per_cu, k_mega, 512, LDS_BYTES) != hipSuccess || per_cu < 1) per_cu = 1;
        grid = cus;
    }
    (void)hipMemsetAsync((unsigned char*)d_ws + OFF_CTL, 0, XCD_BAR_WORDS * sizeof(unsigned), stream);
    hipLaunchKernelGGL(k_mega, dim3(grid), dim3(512), LDS_BYTES, stream, P);
}
```

```cpp
#define ATT16 1
#define USE_FP8Z 1
#define USE_FP8M 1
#define USE_FP8O 1
#define USE_FP8N 1
#define USE_FP8Q 1
#define F8_Q0 0
#define F8_NQ 53
#define GEMM_NT 1
#include <hip/hip_runtime.h>
#include <stdint.h>
#include <stddef.h>

#define DI __device__ __forceinline__
#define LAS __attribute__((address_space(3)))
typedef unsigned short bf16_t;
typedef short bf16x8 __attribute__((ext_vector_type(8)));
typedef float f32x4 __attribute__((ext_vector_type(4)));
typedef float f32x16 __attribute__((ext_vector_type(16)));
typedef unsigned u32x4 __attribute__((ext_vector_type(4)));
typedef unsigned u32x2 __attribute__((ext_vector_type(2)));
typedef __bf16 bf2_t __attribute__((ext_vector_type(2)));
typedef float f2_t __attribute__((ext_vector_type(2)));

DI int tid_opaque() { int t = (int)threadIdx.x; asm volatile("" : "+v"(t)); return t; }
DI unsigned pk2(float a, float b) { f2_t f = {a, b}; bf2_t v = __builtin_convertvector(f, bf2_t); return __builtin_bit_cast(unsigned, v); }
DI unsigned pk4_fp8(float a, float b, float c, float d) { int w = 0; w = __builtin_amdgcn_cvt_pk_fp8_f32(a, b, w, false); w = __builtin_amdgcn_cvt_pk_fp8_f32(c, d, w, true); return (unsigned)w; }
DI float clamp_fp8(float v) { float r; asm("v_max_f32 %0, 0xc3e00000, %1\n\tv_min_f32 %0, 0x43e00000, %0" : "=v"(r) : "v"(v)); return r; }
DI unsigned pk4_fp8c(float a, float b, float c, float d) { return pk4_fp8(clamp_fp8(a), clamp_fp8(b), clamp_fp8(c), clamp_fp8(d)); }
DI float bflo(unsigned w) { return __uint_as_float(w << 16); }
DI float bfhi(unsigned w) { return __uint_as_float(w & 0xffff0000u); }
#ifndef USE_FP8Q
#define USE_FP8Q 0
#endif
#ifndef USE_FP8N
#define USE_FP8N 0
#endif
#ifndef USE_FP8O
#define USE_FP8O 0
#endif
#ifndef GEMM_STAG
#define GEMM_STAG 0
#endif
#ifndef GEMM_NT
#define GEMM_NT 0
#endif
#ifndef FP8EMU
#define FP8EMU 0
#endif
DI float emu_q8(float x, float s) { float y = x * s; const float ay = fabsf(y);
    if (ay < 0.015625f) y = rintf(y * 512.0f) * (1.0f / 512.0f);
    else { unsigned u = __float_as_uint(y); u = (u + 0x0007FFFFu + ((u >> 20) & 1u)) & 0xFFF00000u; y = __uint_as_float(u); }
    y = fminf(fmaxf(y, -448.0f), 448.0f); return y / s; }
DI float bf1(bf16_t h) { return __uint_as_float(((unsigned)h) << 16); }

#ifndef ATT16
#define ATT16 0
#endif
DI int vt_key_of_pos(int p) {
#if ATT16
    return (p & ~31) | (((p >> 2) & 1) << 4) | (((p >> 3) & 3) << 2) | (p & 3);
#else
    return (p & ~0xC) | ((p & 4) << 1) | ((p & 8) >> 1);
#endif
}
DI int vt_pos_of_key(int k) {
#if ATT16
    return (k & ~31) | (((k >> 2) & 3) << 3) | (((k >> 4) & 1) << 2) | (k & 3);
#else
    return (k & ~0xC) | ((k & 4) << 1) | ((k & 8) >> 1);
#endif
}
constexpr int BATCH = 4, SEQ = 4096, DM = 4096, MTOK = BATCH * SEQ;
constexpr int NH = 64, NG = 4, NR = 16, DK = 192, DV = 128;
constexpr int N1 = 40896, N1P = 40960;
constexpr int C_Q = 0, C_KVC = 12288, C_KVS = 13568, C_KVW = 14848, C_ZC = 16128, C_ZS = 24320, C_ZW = 32512, C_G = 40704;
constexpr int N3 = 10304, N3P = 10496;
constexpr int C3_CQ = 0, C3_CKV = 1536, C3_KPE = 2048, C3_Z = 2112;
constexpr int QLORA = 1536, KVLORA = 512;
constexpr int NQB = 12288, NKVB = 16384, ZW8 = 8192;
constexpr float EPSN = 1e-6f;
constexpr float LOG2E = 1.4426950408889634f;
constexpr float QSCALE = 0.07216878364870322f * 1.4426950408889634f;

constexpr size_t SZ_W1T = (size_t)N1P * DM * 2, SZ_W2T = (size_t)DM * ZW8 * 2, SZ_W3T = (size_t)N3P * DM * 2, SZ_W4T = (size_t)NQB * QLORA * 2,
                 SZ_W5T = (size_t)NKVB * KVLORA * 2, SZ_W6T = (size_t)DM * ZW8 * 2;
constexpr size_t OFF_W1T = 0, OFF_W2T = OFF_W1T + SZ_W1T, OFF_W3T = OFF_W2T + SZ_W2T, OFF_W4T = OFF_W3T + SZ_W3T, OFF_W5T = OFF_W4T + SZ_W4T,
                 OFF_W6T = OFF_W5T + SZ_W5T, OFF_W1K = OFF_W6T + SZ_W6T;
constexpr size_t OFF_W5K = OFF_W5T, OFF_W5V = OFF_W5T + SZ_W5T / 2;
constexpr size_t SZ_W1K = (size_t)256 * 6144 * 2, SZ_W1V = (size_t)256 * 4096 * 2;
constexpr size_t OFF_W1V = OFF_W1K + SZ_W1K, OFF_CTL = OFF_W1V + SZ_W1V, OFF_H = OFF_CTL + 65536;
constexpr size_t SZ_H = (size_t)MTOK * DM * 2, SZ_KS = (size_t)BATCH * NG * SEQ * DK * 2, SZ_VTS = (size_t)BATCH * NG * DV * SEQ * 2,
                 SZ_ACK = (size_t)4096 * 6144 * 2, SZ_ACV = (size_t)4096 * 4096 * 2;
constexpr size_t OFF_KS = OFF_H + SZ_H, OFF_KW = OFF_KS + SZ_KS, OFF_VTS = OFF_KW + SZ_KS, OFF_VTW = OFF_VTS + SZ_VTS, OFF_ACK = OFF_VTW + SZ_VTS,
                 OFF_ACV = OFF_ACK + SZ_ACK, OFF_KC = OFF_ACV + SZ_ACV;
constexpr size_t SZ_KC = (size_t)16 * 256 * DK * 2, SZ_VTC = (size_t)16 * DV * 256 * 2, SZ_HID = (size_t)4096 * 256 * 4;
constexpr size_t OFF_VTC = OFF_KC + SZ_KC, OFF_HIDK = OFF_VTC + SZ_VTC, OFF_HIDV = OFF_HIDK + SZ_HID, OFF_Y0 = OFF_HIDV + SZ_HID;
constexpr size_t SZ_Y0 = (size_t)MTOK * N1P * 2, SZ_O = (size_t)MTOK * ZW8 * 2;
constexpr size_t OFF_O = OFF_Y0 + SZ_Y0, WS_END = OFF_O + SZ_O;
constexpr size_t OFF_SS1 = OFF_HIDK;
constexpr size_t OFF_A8 = OFF_O, OFF_B8 = OFF_O + (size_t)MTOK * DM;
#ifndef F8_Q0
#define F8_Q0 0
#define F8_NQ 63
#endif
constexpr size_t OFF_B8M = OFF_W1T, OFF_A8M = OFF_W1T + (64ull << 20);
constexpr int C3_Z8 = 2304, NZ8M = 8192;
constexpr size_t OFF_W28 = OFF_W1T + (132ull << 20), OFF_O8N = OFF_W1T + (168ull << 20);
static_assert(OFF_O8N + (size_t)MTOK * ZW8 <= OFF_W1T + SZ_W1T, "fp8 NSA out-proj buffers");
constexpr float O8N_SCALE = 64.0f;
constexpr float O8_SCALE = 128.0f;
constexpr size_t OFF_KM = 0;
constexpr size_t SZ_KM = (size_t)BATCH * NH * SEQ * DK * 2;
static_assert(SZ_KM <= SZ_W1T + SZ_W2T, "KM alias");
constexpr size_t OFF_VTM = OFF_H;
constexpr size_t SZ_VTM = (size_t)BATCH * NH * DV * SEQ * 2;
constexpr size_t OFF_CKVN = OFF_VTM + SZ_VTM;
constexpr size_t SZ_CKVN = (size_t)MTOK * KVLORA * 2;
static_assert(OFF_CKVN + SZ_CKVN <= OFF_KC, "CKVN alias");
constexpr size_t OFF_Y1 = OFF_Y0, SZ_Y1 = (size_t)MTOK * N3P * 2;
constexpr size_t OFF_QM = OFF_Y1 + SZ_Y1, SZ_QM = (size_t)MTOK * NQB * 2;
constexpr size_t OFF_KVM = OFF_QM + SZ_QM, SZ_KVM = (size_t)MTOK * NKVB * 2;
constexpr size_t OFF_KNM = OFF_KVM;
constexpr size_t OFF_KPER = OFF_KVM, OFF_SSPE = OFF_KVM + (size_t)MTOK * 64 * 4;
constexpr size_t OFF_O8M = OFF_KVM + SZ_KVM / 2, OFF_W68 = OFF_O8M + (size_t)MTOK * ZW8;
constexpr size_t OFF_W48 = OFF_W68 + (size_t)DM * ZW8, OFF_CQN8 = OFF_W48 + (size_t)NQB * QLORA;
static_assert(OFF_CQN8 + (size_t)MTOK * QLORA <= OFF_KVM + SZ_KVM, "fp8 MLA buffers");
constexpr size_t OFF_CQN = OFF_KVM + SZ_KVM, SZ_CQN = (size_t)MTOK * QLORA * 2;
constexpr size_t OFF_ROPE = OFF_CQN + SZ_CQN, SZ_ROPE = (size_t)MTOK * 64 * 4;
static_assert(OFF_ROPE + SZ_ROPE <= OFF_O, "layer-1 alias region");
static_assert(WS_END <= 2680160256ull, "workspace");

struct Params {
    const float* x; const int* pos; const float* norm_w; const float* rel_bias;
    const float* nsa_w_in; const float* nsa_q_norm; const float* nsa_k_norm; const float* pe_k; const float* w1_k; const float* w2_k;
    const float* pe_v; const float* w1_v; const float* w2_v; const float* nsa_w_out;
    const float* mla_w_in; const float* mla_q_a_norm; const float* mla_w_q_b; const float* mla_kv_a_norm; const float* mla_w_kv_b;
    const float* mla_q_norm; const float* mla_k_norm; const float* mla_w_out;
    float* out; unsigned char* ws;
};

#define XB_TMO      128
#define XB_XCNT(j)  (256  + 64 * (j))
#define XB_XSUB(j)  (1280 + 64 * (j))
#define XB_XGEN(j)  (2304 + 64 * (j))
#define XB_TOP      3328
#define XB_TOPGEN   3392
#define XCD_BAR_WORDS 3456
#define XB_SPIN_CAP (1u << 18)

__device__ __forceinline__ unsigned xb_ld(unsigned* p)              { return __hip_atomic_load(p, __ATOMIC_RELAXED, __HIP_MEMORY_SCOPE_AGENT); }
__device__ __forceinline__ unsigned xb_add(unsigned* p, unsigned v) { return __hip_atomic_fetch_add(p, v, __ATOMIC_RELAXED, __HIP_MEMORY_SCOPE_AGENT); }
__device__ __forceinline__ unsigned xb_xcc_id() { return (unsigned)__builtin_amdgcn_s_getreg((3 << 11) | 20) & 0xFu; }
#define XB_SPIN(cond, bar) do { unsigned _sp = 0; while (cond) { __builtin_amdgcn_s_sleep(1); \
    if ((++_sp & 255u) == 0u) { if (xb_ld(&(bar)[XB_TMO])) break; if (_sp > XB_SPIN_CAP) { atomicAdd(&(bar)[XB_TMO], 1u); break; } } } } while (0)

struct XcdBarrier {
    unsigned* bar; unsigned x;
    volatile LAS unsigned* st;
};

__device__ __forceinline__ XcdBarrier xcd_barrier_post(unsigned* bar, volatile LAS unsigned* st) {
    XcdBarrier b; b.bar = bar; b.x = xb_xcc_id(); b.st = st;
    if (threadIdx.x == 0) (void)xb_add(&bar[XB_XCNT(b.x)], 1u);
    return b;
}
__device__ __forceinline__ void xcd_barrier_complete(unsigned* bar, unsigned x, unsigned& nloc, unsigned& nx) {
    const unsigned G = gridDim.x * gridDim.y * gridDim.z;
    unsigned sum, cnt, mine, sp = 0u;
    for (;;) {
        sum = 0u; cnt = 0u; mine = 0u;
#pragma unroll
        for (unsigned j = 0; j < 16; ++j) { const unsigned c = xb_ld(&bar[XB_XCNT(j)]); sum += c; cnt += (c > 0u) ? 1u : 0u; mine = (j == x) ? c : mine; }
        if (sum == G) break;
        __builtin_amdgcn_s_sleep(1);
        if ((++sp & 255u) == 0u) { if (xb_ld(&bar[XB_TMO])) break; if (sp > XB_SPIN_CAP) { atomicAdd(&bar[XB_TMO], 1u); break; } }
    }
    nloc = mine > 0u ? mine : 1u; nx = cnt > 0u ? cnt : 1u;
}

__device__ __forceinline__ void xcd_barrier(const XcdBarrier& b) {
    asm volatile("s_waitcnt vmcnt(0)" ::: "memory");
    __syncthreads();
    if (threadIdx.x == 0) {
        unsigned* bar = b.bar;
        __builtin_amdgcn_s_waitcnt(0);
        unsigned nloc = b.st[0], nx = b.st[1];
        if (nloc == 0u) { xcd_barrier_complete(bar, b.x, nloc, nx); b.st[0] = nloc; b.st[1] = nx; }
        const unsigned old = xb_add(&bar[XB_XSUB(b.x)], 1u);
        const unsigned gen = old / nloc;
        if (old + 1u == (gen + 1u) * nloc) {
            __builtin_amdgcn_fence(__ATOMIC_RELEASE, "agent");
            asm volatile("s_waitcnt vmcnt(0)" ::: "memory");
            const unsigned og = xb_add(&bar[XB_TOP], 1u);
            const unsigned tg = og / nx;
            if (og + 1u == (tg + 1u) * nx) xb_add(&bar[XB_TOPGEN], 1u);
            else XB_SPIN(xb_ld(&bar[XB_TOPGEN]) == tg, bar);
            __builtin_amdgcn_fence(__ATOMIC_ACQUIRE, "agent");
            xb_add(&bar[XB_XGEN(b.x)], 1u);
            asm volatile("s_waitcnt vmcnt(0)" ::: "memory");
        } else {
            XB_SPIN(xb_ld(&bar[XB_XGEN(b.x)]) == gen, bar);
            __builtin_amdgcn_fence(__ATOMIC_ACQUIRE, "agent");
            asm volatile("s_waitcnt vmcnt(0)" ::: "memory");
        }
    }
    __syncthreads();
}

namespace pg8 {
#define PG8_LAS __attribute__((address_space(3)))
typedef unsigned short bf16_t;
typedef short bf16x8 __attribute__((ext_vector_type(8)));
typedef float f32x4 __attribute__((ext_vector_type(4)));
typedef unsigned u32x4 __attribute__((ext_vector_type(4)));
typedef int i32x8_t __attribute__((ext_vector_type(8)));
typedef int i32x4_t __attribute__((ext_vector_type(4)));
constexpr int BM = 256, BK = 64, HALF = 128, HTB = HALF * BK * 2  , STAGE_BYTES = 8 * HTB, NXCD = 8, WGM = 8;

__host__ __device__ __forceinline__ int lds_byte(int r, int c) { const int st = (r >> 4) * 2 + (c >> 5), rr = r & 15, cc = c & 31, ob = rr * 64 + cc * 2; return st * 1024 + (ob ^ (((ob >> 9) & 1) << 5)); }
__host__ __device__ __forceinline__ void stage_rc(int b, int& R, int& C) { const int st = b / 1024, sb = b % 1024, swz = sb ^ (((sb >> 9) & 1) << 5); R = (st >> 1) * 16 + swz / 64; C = (st & 1) * 32 + (swz % 64) / 2; }
__host__ __device__ __forceinline__ int perm32(int rho) { const int n = rho >> 4, i = rho & 15; return 8 * (i >> 2) + 4 * n + (i & 3); }

struct Unit { int pm, pn; };
struct Gemm { const bf16_t* A; const bf16_t* Bt; int M, N, K; };

struct StaticOrder {
    int nM, nN, nwg, G, c;
    __host__ __device__ void init(int M, int N, int G_, int c_) { nM = M / BM; nN = N / BM; nwg = nM * nN; G = G_; c = c_; }
    __host__ __device__ bool next(int i, Unit& u) const {
        const long L = (long)i * G + c; if (L >= nwg) return false;
        int wgid = (int)L; { const int q = nwg / NXCD, r = nwg % NXCD, xcd = wgid % NXCD, off = wgid / NXCD; wgid = (xcd < r ? xcd * (q + 1) : r * (q + 1) + (xcd - r) * q) + off; }
        const int nig = WGM * nN, gid = wgid / nig, fm = gid * WGM, gsz = (nM - fm) < WGM ? (nM - fm) : WGM;
        u.pm = fm + ((wgid % nig) % gsz); u.pn = (wgid % nig) / gsz; return true;
    }
    __device__ __forceinline__ void a_ready(const Unit&) const {}
    __device__ __forceinline__ void done(const Unit&) const {}
};
#if GEMM_NT
#define EPI_ST16(p, w) __builtin_nontemporal_store((w), (u32x4*)(p))
#else
#define EPI_ST16(p, w) (*(u32x4*)(p) = (w))
#endif
struct EpiStoreBf16 {
    static constexpr bool PERM = true, AFTER_DRAIN = false, SWAP23 = false, FP8 = false;
    bf16_t* O; int ldc;
    __device__ __forceinline__ void operator()(const f32x4 (&acc)[2][2][4][2], const Unit& u, int wr, int wc, int fr, int fq) const {
        const int row0 = u.pm * BM + wr * 64 + fr; const int col0 = u.pn * BM + wc * 32 + 8 * fq;
#pragma unroll
        for (int ai = 0; ai < 2; ++ai)
#pragma unroll
            for (int m = 0; m < 4; ++m) { bf16_t* rowp = O + (size_t)(row0 + ai * HALF + m * 16) * ldc + col0;
#pragma unroll
                for (int bj = 0; bj < 2; ++bj) { const f32x4 v0 = acc[ai][bj][m][0], v1 = acc[ai][bj][m][1];
                    u32x4 w; w.x = pk2(v0[0], v0[1]); w.y = pk2(v0[2], v0[3]); w.z = pk2(v1[0], v1[1]); w.w = pk2(v1[2], v1[3]);
                    EPI_ST16(rowp + bj * HALF, w); } }
    }
};
struct EpiResF32 {
    static constexpr bool PERM = false, AFTER_DRAIN = false, SWAP23 = false, FP8 = false;
    const float* base; float* out; int ldc;
    __device__ __forceinline__ void operator()(const f32x4 (&acc)[2][2][4][2], const Unit& u, int wr, int wc, int fr, int fq) const {
        const int row0 = u.pm * BM + wr * 64 + fr, col0 = u.pn * BM + wc * 32 + 4 * fq;
#pragma unroll
        for (int ai = 0; ai < 2; ++ai)
#pragma unroll
            for (int m = 0; m < 4; ++m) { const size_t off = (size_t)(row0 + ai * HALF + m * 16) * ldc + col0;
#pragma unroll
                for (int bj = 0; bj < 2; ++bj)
#pragma unroll
                    for (int n = 0; n < 2; ++n) { const f32x4 bs = *(const f32x4*)(base + off + bj * HALF + n * 16);
                        *(f32x4*)(out + off + bj * HALF + n * 16) = bs + acc[ai][bj][m][n]; } }
    }
};
struct EpiPlainF32 {
    static constexpr bool PERM = false, AFTER_DRAIN = false, SWAP23 = false, FP8 = false;
    float* C; int ldc;
    __device__ __forceinline__ void operator()(const f32x4 (&acc)[2][2][4][2], const Unit& u, int wr, int wc, int fr, int fq) const {
        const int row0 = u.pm * BM + wr * 64 + fr, col0 = u.pn * BM + wc * 32 + 4 * fq;
#pragma unroll
        for (int ai = 0; ai < 2; ++ai)
#pragma unroll
            for (int m = 0; m < 4; ++m) { float* rowp = C + (size_t)(row0 + ai * HALF + m * 16) * ldc + col0;
#pragma unroll
                for (int bj = 0; bj < 2; ++bj)
#pragma unroll
                    for (int n = 0; n < 2; ++n) *(f32x4*)(rowp + bj * HALF + n * 16) = acc[ai][bj][m][n]; }
    }
};

struct EpiVT {
    static constexpr bool PERM = true, AFTER_DRAIN = false, SWAP23 = true, FP8 = false;
    bf16_t* O;
    __device__ __forceinline__ void operator()(const f32x4 (&acc)[2][2][4][2], const Unit& u, int wr, int wc, int fr, int fq) const {
        const int row0 = u.pm * BM + wr * 64 + fr; const int colt = u.pn * BM; const int b = colt >> 12, pos0 = (colt & 4095) + wc * 32 + 8 * fq;
        bf16_t* base = O + (size_t)b * 8192 * 4096 + pos0;
#pragma unroll
        for (int ai = 0; ai < 2; ++ai)
#pragma unroll
            for (int m = 0; m < 4; ++m) { bf16_t* rowp = base + (size_t)(row0 + ai * HALF + m * 16) * 4096;
#pragma unroll
                for (int bj = 0; bj < 2; ++bj) { const f32x4 v0 = acc[ai][bj][m][0], v1 = acc[ai][bj][m][1];
                    u32x4 w; w.x = pk2(v0[0], v0[1]); w.y = pk2(v0[2], v0[3]); w.z = pk2(v1[0], v1[1]); w.w = pk2(v1[2], v1[3]);
                    EPI_ST16(rowp + bj * HALF, w); } }
    }
};

struct EpiKNorm {
    static constexpr bool PERM = true, AFTER_DRAIN = false, SWAP23 = false, FP8 = false;
    bf16_t* KM; const float* sspe; const float* kper; const float* gain; PG8_LAS float* tab; mutable unsigned par;
    __device__ __forceinline__ void operator()(const f32x4 (&acc)[2][2][4][2], const Unit& u, int wr, int wc, int fr, int fq) const {
        PG8_LAS float* T = tab + par * 2048;
#pragma unroll
        for (int ai = 0; ai < 2; ++ai)
#pragma unroll
            for (int m = 0; m < 4; ++m) { const int row = ai * HALF + wr * 64 + m * 16 + fr;
#pragma unroll
                for (int bj = 0; bj < 2; ++bj) { const f32x4 x = acc[ai][bj][m][0], y = acc[ai][bj][m][1];
                    float ss = (x[0] * x[0] + x[1] * x[1]) + (x[2] * x[2] + x[3] * x[3]) + (y[0] * y[0] + y[1] * y[1]) + (y[2] * y[2] + y[3] * y[3]);
                    ss += __shfl_xor(ss, 16); ss += __shfl_xor(ss, 32);
                    if (fq == 0) T[row * 8 + bj * 4 + wc] = ss; } }
        asm volatile("s_waitcnt lgkmcnt(0)" ::: "memory"); __builtin_amdgcn_s_barrier(); asm volatile("" ::: "memory");
        const f32x4 g0 = *(const f32x4*)(gain + wc * 32 + 8 * fq), g1 = *(const f32x4*)(gain + wc * 32 + 8 * fq + 4);
        const int tok0 = u.pm * BM, b = tok0 >> 12;
#pragma unroll
        for (int ai = 0; ai < 2; ++ai)
#pragma unroll
            for (int m = 0; m < 4; ++m) { const int row = ai * HALF + wr * 64 + m * 16 + fr, tok = tok0 + row, s = tok & 4095;
                const float sp = sspe[tok]; const f32x4 kp = *(const f32x4*)(kper + (size_t)tok * 64 + wc * 16 + 4 * fq);
#pragma unroll
                for (int bj = 0; bj < 2; ++bj) { const f32x4 t = *(const PG8_LAS f32x4*)(T + row * 8 + bj * 4);
                    const float rstd = rsqrtf(((t[0] + t[1]) + (t[2] + t[3]) + sp) * (1.0f / 192.0f) + 1e-6f);
                    const int hd = 2 * u.pn + bj;
                    bf16_t* kb = KM + ((size_t)(b * 64 + hd) * 4096 + s) * 192;
                    const f32x4 x = acc[ai][bj][m][0], y = acc[ai][bj][m][1];
                    u32x4 w; w.x = pk2(x[0] * rstd * g0[0], x[1] * rstd * g0[1]); w.y = pk2(x[2] * rstd * g0[2], x[3] * rstd * g0[3]);
                    w.z = pk2(y[0] * rstd * g1[0], y[1] * rstd * g1[1]); w.w = pk2(y[2] * rstd * g1[2], y[3] * rstd * g1[3]);
                    *(u32x4*)(kb + wc * 32 + 8 * fq) = w;
                    u32x2 r; r.x = pk2(kp[0] * rstd, kp[1] * rstd); r.y = pk2(kp[2] * rstd, kp[3] * rstd);
                    *(u32x2*)(kb + 128 + wc * 16 + 4 * fq) = r; } }
        par ^= 1u;
    }
};

template <bool F8_> struct EpiResNormT {
    static constexpr bool PERM = false, AFTER_DRAIN = false, SWAP23 = false, FP8 = F8_;
    const float* base; float* out; int ldc; const float* gain; bf16_t* xg; float* ss; unsigned char* x8; float scale;
    __device__ __forceinline__ void operator()(const f32x4 (&acc)[2][2][4][2], const Unit& u, int wr, int wc, int fr, int fq) const {
        const int row0 = u.pm * BM + wr * 64 + fr, col0 = u.pn * BM + wc * 32 + 4 * fq;
        f32x4 gv[2][2];
#pragma unroll
        for (int bj = 0; bj < 2; ++bj)
#pragma unroll
            for (int n = 0; n < 2; ++n) gv[bj][n] = *(const f32x4*)(gain + col0 + bj * HALF + n * 16);
#pragma unroll
        for (int ai = 0; ai < 2; ++ai)
#pragma unroll
            for (int m = 0; m < 4; ++m) { const int row = row0 + ai * HALF + m * 16; const size_t off = (size_t)row * ldc + col0; float sq = 0.f;
#pragma unroll
                for (int bj = 0; bj < 2; ++bj)
#pragma unroll
                    for (int n = 0; n < 2; ++n) { const f32x4 bs = *(const f32x4*)(base + off + bj * HALF + n * 16); const f32x4 v = F8_ ? bs + acc[ai][bj][m][n] * scale : bs + acc[ai][bj][m][n];
                        *(f32x4*)(out + off + bj * HALF + n * 16) = v;
                        sq += (v[0] * v[0] + v[1] * v[1]) + (v[2] * v[2] + v[3] * v[3]);
                        const f32x4 g = gv[bj][n]; u32x2 w; w.x = pk2(v[0] * g[0], v[1] * g[1]); w.y = pk2(v[2] * g[2], v[3] * g[3]);
                        *(u32x2*)(xg + off + bj * HALF + n * 16) = w;
                        if (x8) *(unsigned*)(x8 + off + bj * HALF + n * 16) = pk4_fp8(v[0] * g[0] * 16.0f, v[1] * g[1] * 16.0f, v[2] * g[2] * 16.0f, v[3] * g[3] * 16.0f); }
                sq += __shfl_xor(sq, 16); sq += __shfl_xor(sq, 32);
                if (fq == 0) atomicAdd(ss + row, sq); }
    }
};
using EpiResNorm = EpiResNormT<false>; using EpiResNormFp8 = EpiResNormT<true>;
struct EpiStoreBf16RowScale {
    static constexpr bool PERM = true, AFTER_DRAIN = false, SWAP23 = false, FP8 = false;
    bf16_t* O; int ldc; const float* ss; float inv_dim;
    __device__ __forceinline__ void operator()(const f32x4 (&acc)[2][2][4][2], const Unit& u, int wr, int wc, int fr, int fq) const {
        const int row0 = u.pm * BM + wr * 64 + fr; const int col0 = u.pn * BM + wc * 32 + 8 * fq;
#pragma unroll
        for (int ai = 0; ai < 2; ++ai)
#pragma unroll
            for (int m = 0; m < 4; ++m) { const int row = row0 + ai * HALF + m * 16; const float rs = rsqrtf(ss[row] * inv_dim + 1e-6f);
                bf16_t* rowp = O + (size_t)row * ldc + col0;
#pragma unroll
                for (int bj = 0; bj < 2; ++bj) { const f32x4 v0 = acc[ai][bj][m][0] * rs, v1 = acc[ai][bj][m][1] * rs;
                    u32x4 w; w.x = pk2(v0[0], v0[1]); w.y = pk2(v0[2], v0[3]); w.z = pk2(v1[0], v1[1]); w.w = pk2(v1[2], v1[3]);
                    EPI_ST16(rowp + bj * HALF, w); } }
    }
};

struct EpiStoreBf16Fp8 {
    static constexpr bool PERM = true, AFTER_DRAIN = false, SWAP23 = false, FP8 = true;
    bf16_t* O; int ldc; float scale; int nostore = 0;
    __device__ __forceinline__ void operator()(const f32x4 (&acc)[2][2][4][2], const Unit& u, int wr, int wc, int fr, int fq) const {
        const int row0 = u.pm * BM + wr * 64 + fr; const int col0 = u.pn * BM + wc * 32 + 8 * fq;
#pragma unroll
        for (int ai = 0; ai < 2; ++ai)
#pragma unroll
            for (int m = 0; m < 4; ++m) { bf16_t* rowp = O + (size_t)(row0 + ai * HALF + m * 16) * ldc + col0;
#pragma unroll
                for (int bj = 0; bj < 2; ++bj) { const f32x4 v0 = acc[ai][bj][m][0] * scale, v1 = acc[ai][bj][m][1] * scale;
                    u32x4 w; w.x = pk2(v0[0], v0[1]); w.y = pk2(v0[2], v0[3]); w.z = pk2(v1[0], v1[1]); w.w = pk2(v1[2], v1[3]);
                    if (!nostore || w.x == 0x12345679u) EPI_ST16(rowp + bj * HALF, w); } }
    }
};

struct OrderBf16Part {
    int G, c, q0, nq, nz;
    __device__ bool next(int i, Unit& u) const { const int L = i * G + c;
        if (L < nq * 64) { u.pm = L & 63; u.pn = q0 + (L >> 6); return true; }
        const int Lz = L - nq * 64; if (Lz >= nz * 4) return false;
        const int j = Lz >> 2; u.pm = 16 * (Lz & 3); u.pn = j < q0 ? j : j + nq; return true; }
    __device__ __forceinline__ void a_ready(const Unit&) const {}
    __device__ __forceinline__ void done(const Unit&) const {}
};
struct OrderFp8Part {
    int G, c, q0, nq, nz, rot;
    __device__ bool next(int i, Unit& u) const { const int L = i * G + (G == 256 ? ((c + rot) & 255) : c); if (L >= nz * 60) return false;
        const int r = L % 60, j = L / 60; u.pm = r + r / 15 + 1; u.pn = j < q0 ? j : j + nq; return true; }
    __device__ __forceinline__ void a_ready(const Unit&) const {}
    __device__ __forceinline__ void done(const Unit&) const {}
};

struct EpiStoreBf16RowScaleFp8 {
    static constexpr bool PERM = true, AFTER_DRAIN = false, SWAP23 = false, FP8 = true;
    bf16_t* O; int ldc; const float* ss; float inv_dim, scale;
    __device__ __forceinline__ void operator()(const f32x4 (&acc)[2][2][4][2], const Unit& u, int wr, int wc, int fr, int fq) const {
        const int row0 = u.pm * BM + wr * 64 + fr; const int col0 = u.pn * BM + wc * 32 + 8 * fq;
#pragma unroll
        for (int ai = 0; ai < 2; ++ai)
#pragma unroll
            for (int m = 0; m < 4; ++m) { const int row = row0 + ai * HALF + m * 16; const float rs = rsqrtf(ss[row] * inv_dim + 1e-6f) * scale;
                bf16_t* rowp = O + (size_t)row * ldc + col0;
#pragma unroll
                for (int bj = 0; bj < 2; ++bj) { const f32x4 v0 = acc[ai][bj][m][0] * rs, v1 = acc[ai][bj][m][1] * rs;
                    u32x4 w; w.x = pk2(v0[0], v0[1]); w.y = pk2(v0[2], v0[3]); w.z = pk2(v1[0], v1[1]); w.w = pk2(v1[2], v1[3]);
                    EPI_ST16(rowp + bj * HALF, w); } }
    }
};
struct OrderTiles {
    int G, c, ncol;
    __device__ bool next(int i, Unit& u) const { const int L = i * G + c; if (L >= ncol * 64) return false; u.pm = L & 63; u.pn = L >> 6; return true; }
    __device__ __forceinline__ void a_ready(const Unit&) const {}
    __device__ __forceinline__ void done(const Unit&) const {}
};

struct EpiResF32Fp8 {
    static constexpr bool PERM = false, AFTER_DRAIN = false, SWAP23 = false, FP8 = true;
    const float* base; float* out; int ldc; float scale;
    __device__ __forceinline__ void operator()(const f32x4 (&acc)[2][2][4][2], const Unit& u, int wr, int wc, int fr, int fq) const {
        const int row0 = u.pm * BM + wr * 64 + fr, col0 = u.pn * BM + wc * 32 + 4 * fq;
#pragma unroll
        for (int ai = 0; ai < 2; ++ai)
#pragma unroll
            for (int m = 0; m < 4; ++m) { const size_t off = (size_t)(row0 + ai * HALF + m * 16) * ldc + col0;
#pragma unroll
                for (int bj = 0; bj < 2; ++bj)
#pragma unroll
                    for (int n = 0; n < 2; ++n) { const f32x4 bs = *(const f32x4*)(base + off + bj * HALF + n * 16);
                        *(f32x4*)(out + off + bj * HALF + n * 16) = bs + acc[ai][bj][m][n] * scale; } }
    }
};
template <class Epi, class Sched, bool STAMP = false>
__device__ __forceinline__ void gemm_phase(PG8_LAS unsigned char* lds, const Gemm g, const Sched& S, const Epi& E, unsigned long long* stamps, int stag = 0) {
    const int tid = tid_opaque(), wid = __builtin_amdgcn_readfirstlane(tid >> 6), lane = tid & 63, wr = wid >> 2, wc = wid & 3, fr = lane & 15, fq = lane >> 4;
    const int K = g.K, nt = K / BK;
    int ts_lo = 0, ts_hi = 0, nts = 0; const unsigned long long rt_entry = STAMP ? (unsigned long long)wall_clock64() : 0ull;
#define PG8_STAMP() do { if (STAMP && wid == 0 && nts < 64) { const unsigned long long _c = (unsigned long long)clock64(); \
        ts_lo = (lane == nts) ? (int)(unsigned)_c : ts_lo; ts_hi = (lane == nts) ? (int)(unsigned)(_c >> 32) : ts_hi; ++nts; } } while (0)
    PG8_STAMP();
    unsigned voffA[2], voffB[2];
#pragma unroll
    for (int i = 0; i < 2; ++i) { int R, C; stage_rc(tid * 16 + i * 8192, R, C); int Rb = Epi::PERM ? ((R & ~31) + perm32(R & 31)) : R; if (Epi::SWAP23) Rb = vt_key_of_pos(Rb);
        voffA[i] = (unsigned)(R * K + C) * 2u; voffB[i] = (unsigned)(Rb * K + C) * 2u; }
    const size_t kstep = (size_t)(BK * 2);
    const size_t hstep = (size_t)HALF * K * 2;
    const size_t tstep = 2 * hstep;
    const unsigned ldsw = (unsigned)wid * 1024u;
    const int aoff = lds_byte(wr * 64 + fr, fq * 8), boff = lds_byte(wc * 32 + fr, fq * 8);
#define PG8_SA(b, h) (((b) * 2 + (h)) * HTB)
#define PG8_SB(b, h) ((4 + (b) * 2 + (h)) * HTB)
#define PG8_STAGE(bufoff, gbase, voff) do { _Pragma("unroll") for (int _i = 0; _i < 2; ++_i) \
        __builtin_amdgcn_global_load_lds((const unsigned*)((const char*)(gbase) + (voff)[_i]), (PG8_LAS unsigned*)(lds + (bufoff) + ldsw + _i * 8192), 16, 0, 0); } while (0)
#define PG8_LDA(dst, b, h) do { if constexpr (Epi::FP8) { _Pragma("unroll") for (int m = 0; m < 4; ++m) { const PG8_LAS unsigned char* p_ = lds + PG8_SA(b, h) + aoff + m * 2048; \
            const i32x4_t lo_ = *(const PG8_LAS i32x4_t*)p_, hi_ = *(const PG8_LAS i32x4_t*)(p_ + 1024); dst##8[m] = __builtin_shufflevector(lo_, hi_, 0, 1, 2, 3, 4, 5, 6, 7); } } \
        else { _Pragma("unroll") for (int m = 0; m < 4; ++m) _Pragma("unroll") for (int k = 0; k < 2; ++k) dst[m][k] = *(const PG8_LAS bf16x8*)(lds + PG8_SA(b, h) + aoff + m * 2048 + k * 1024); } } while (0)
#define PG8_LDB(dst, b, h) do { if constexpr (Epi::FP8) { _Pragma("unroll") for (int n = 0; n < 2; ++n) { const PG8_LAS unsigned char* p_ = lds + PG8_SB(b, h) + boff + n * 2048; \
            const i32x4_t lo_ = *(const PG8_LAS i32x4_t*)p_, hi_ = *(const PG8_LAS i32x4_t*)(p_ + 1024); dst##8[n] = __builtin_shufflevector(lo_, hi_, 0, 1, 2, 3, 4, 5, 6, 7); } } \
        else { _Pragma("unroll") for (int n = 0; n < 2; ++n) _Pragma("unroll") for (int k = 0; k < 2; ++k) dst[n][k] = *(const PG8_LAS bf16x8*)(lds + PG8_SB(b, h) + boff + n * 2048 + k * 1024); } } while (0)
#define PG8_MMA(ai, bj, At, Bt) do { __builtin_amdgcn_s_setprio(1); \
        if constexpr (Epi::FP8) { \
            _Pragma("unroll") for (int m = 0; m < 4; ++m) _Pragma("unroll") for (int n = 0; n < 2; ++n) \
                asm volatile("v_mfma_scale_f32_16x16x128_f8f6f4 %0, %1, %2, %0, %3, %3 op_sel_hi:[0,0,0]" : "+v"(acc[ai][bj][m][n]) : "v"(Bt##8[n]), "v"(At##8[m]), "v"(fp8_scale_one)); \
        } else { \
            _Pragma("unroll") for (int m = 0; m < 4; ++m) _Pragma("unroll") for (int n = 0; n < 2; ++n) _Pragma("unroll") for (int k = 0; k < 2; ++k) \
                acc[ai][bj][m][n] = __builtin_amdgcn_mfma_f32_16x16x32_bf16(Bt[n][k], At[m][k], acc[ai][bj][m][n], 0, 0, 0); } \
        __builtin_amdgcn_s_setprio(0); } while (0)
#define PG8_WAIT_V(n) asm volatile("s_waitcnt vmcnt(" #n ")" ::: "memory")
#define PG8_WAIT_L(n) asm volatile("s_waitcnt lgkmcnt(" #n ")" ::: "memory")
#define PG8_BAR __builtin_amdgcn_s_barrier()
#define PG8_SCHED __builtin_amdgcn_sched_barrier(0)
    Unit cur, nxt; int ui = 0;
    if (!S.next(0, cur)) return;
    if (stag > 0) { const int n_ = (int)((blockIdx.x >> 3) & 7u) * stag; for (int i_ = 0; i_ < n_; ++i_) __builtin_amdgcn_s_sleep(37); }
    f32x4 acc[2][2][4][2];
#pragma unroll
    for (int a = 0; a < 2; ++a)
#pragma unroll
        for (int b = 0; b < 2; ++b)
#pragma unroll
            for (int m = 0; m < 4; ++m)
#pragma unroll
                for (int n = 0; n < 2; ++n) acc[a][b][m][n] = (f32x4){0.f, 0.f, 0.f, 0.f};
    bf16x8 At[4][2], B0[2][2], B1[2][2]; i32x8_t At8[4], B08[2], B18[2]; const int fp8_scale_one = 0x7f7f7f7f;
    const char* cA = (const char*)g.A + (size_t)cur.pm * tstep; const char* cB = (const char*)g.Bt + (size_t)cur.pn * tstep;
    S.a_ready(cur);
    PG8_STAGE(PG8_SB(0, 0), cB, voffB); PG8_STAGE(PG8_SA(0, 0), cA, voffA); PG8_STAGE(PG8_SB(0, 1), cB + hstep, voffB); PG8_STAGE(PG8_SA(0, 1), cA + hstep, voffA);
    if (wr == 1) PG8_BAR;
    PG8_WAIT_V(4); PG8_BAR;
    PG8_STAGE(PG8_SB(1, 0), cB + kstep, voffB); PG8_STAGE(PG8_SA(1, 0), cA + kstep, voffA); PG8_STAGE(PG8_SB(1, 1), cB + hstep + kstep, voffB);
    PG8_WAIT_V(6); PG8_BAR;
    PG8_STAMP();
    for (;;) {
        const bool has_next = S.next(ui + 1, nxt);
        const char* nA = has_next ? (const char*)g.A + (size_t)nxt.pm * tstep : cA; const char* nB = has_next ? (const char*)g.Bt + (size_t)nxt.pn * tstep : cB;
        for (int t = 0; t < nt; t += 2) {
            const bool last = (t == nt - 2);
            const char* a1 = cA + (size_t)(t + 1) * kstep;
            const char* a2 = last ? nA : cA + (size_t)(t + 2) * kstep; const char* b2 = last ? nB : cB + (size_t)(t + 2) * kstep;
            const char* a3 = a2 + kstep; const char* b3 = b2 + kstep;
            if (last && has_next) S.a_ready(nxt);
            PG8_LDB(B0, 0, 0); PG8_SCHED; PG8_LDA(At, 0, 0); PG8_STAGE(PG8_SA(1, 1), a1 + hstep, voffA);
            PG8_WAIT_L(8); PG8_BAR; PG8_WAIT_L(0); PG8_MMA(0, 0, At, B0); PG8_BAR; PG8_SCHED;
            PG8_LDB(B1, 0, 1); PG8_STAGE(PG8_SB(0, 0), b2, voffB);
            PG8_BAR; PG8_WAIT_L(0); PG8_MMA(0, 1, At, B1); PG8_BAR;
            PG8_LDA(At, 0, 1); PG8_STAGE(PG8_SA(0, 0), a2, voffA);
            PG8_BAR; PG8_WAIT_L(0); PG8_MMA(1, 0, At, B0); PG8_BAR; PG8_SCHED;
            PG8_STAGE(PG8_SB(0, 1), b2 + hstep, voffB);
            PG8_WAIT_V(6); PG8_BAR; PG8_MMA(1, 1, At, B1); PG8_BAR;
            PG8_LDB(B0, 1, 0); PG8_SCHED; PG8_LDA(At, 1, 0); PG8_STAGE(PG8_SA(0, 1), a2 + hstep, voffA);
            PG8_WAIT_L(8); PG8_BAR; PG8_WAIT_L(0); PG8_MMA(0, 0, At, B0); PG8_BAR; PG8_SCHED;
            PG8_LDB(B1, 1, 1); PG8_STAGE(PG8_SB(1, 0), b3, voffB);
            PG8_BAR; PG8_WAIT_L(0); PG8_MMA(0, 1, At, B1); PG8_BAR;
            PG8_LDA(At, 1, 1); PG8_STAGE(PG8_SA(1, 0), a3, voffA);
            PG8_BAR; PG8_WAIT_L(0); PG8_MMA(1, 0, At, B0); PG8_BAR; PG8_SCHED;
            PG8_STAGE(PG8_SB(1, 1), b3 + hstep, voffB);
            PG8_WAIT_V(6); PG8_BAR; PG8_MMA(1, 1, At, B1); PG8_BAR;
        }
        PG8_STAMP();
        if constexpr (Epi::FP8) asm volatile("s_nop 15\n\ts_nop 15" ::: "memory");
        if constexpr (!Epi::AFTER_DRAIN) { E(acc, cur, wr, wc, fr, fq); S.done(cur); }
        PG8_STAMP();
        if (!has_next) break;
#pragma unroll
        for (int a = 0; a < 2; ++a)
#pragma unroll
            for (int b = 0; b < 2; ++b)
#pragma unroll
                for (int m = 0; m < 4; ++m)
#pragma unroll
                    for (int n = 0; n < 2; ++n) acc[a][b][m][n] = (f32x4){0.f, 0.f, 0.f, 0.f};
        cur = nxt; cA = nA; cB = nB; ++ui;
    }
    PG8_WAIT_V(0);
    if (wr == 0) PG8_BAR;
    PG8_BAR;
    if constexpr (Epi::AFTER_DRAIN) { E.fused(acc, cur, wr, wc, fr, fq, lds, wid, lane); S.done(cur); }
    PG8_STAMP();
    if (STAMP && wid == 0) { stamps[lane] = lane < nts ? (((unsigned long long)(unsigned)ts_hi << 32) | (unsigned)ts_lo) : 0ull;
        if (lane == 62) stamps[62] = rt_entry; if (lane == 63) stamps[63] = (unsigned long long)wall_clock64(); }
#undef PG8_STAMP
#undef PG8_SA
#undef PG8_SB
#undef PG8_STAGE
#undef PG8_LDA
#undef PG8_LDB
#undef PG8_MMA
#undef PG8_WAIT_V
#undef PG8_WAIT_L
#undef PG8_BAR
#undef PG8_SCHED
}
}


DI void phase_wconv(LAS unsigned char* lds, const float* __restrict__ src, bf16_t* __restrict__ dst, int K, int N, int Npad, int bid, int nb, float q8s = 0.f, int colmap = 0, unsigned char* __restrict__ dst8 = nullptr, int n8_0 = 0, int n8_1 = 0) {
    LAS float* tile = (LAS float*)lds;
    const int tid = tid_opaque();
    const int tk = K / 64, tn = Npad / 256, total = tk * tn;
    for (int t = bid; t < total; t += nb) {
        const int k0 = (t % tk) * 64, n0 = (t / tk) * 256;
        __syncthreads();
        {
            const int ty = tid >> 6, tx = tid & 63, n = n0 + tx * 4;
            f32x4 v[8];
#pragma unroll
            for (int i = 0; i < 8; ++i) {
                const int k = k0 + ty + 8 * i;
                v[i] = (f32x4){0.f, 0.f, 0.f, 0.f};
                if (colmap) { const int ns = (n >> 7) * 256 + (colmap == 1 ? 128 : 0) + (n & 127); v[i] = *(const f32x4*)(src + (size_t)k * (2 * N) + ns); }
                else if (n < N) v[i] = *(const f32x4*)(src + (size_t)k * N + n);
            }
#pragma unroll
            for (int i = 0; i < 8; ++i) { LAS float* pp = tile + (ty + 8 * i) * 257 + tx * 4; pp[0] = v[i][0]; pp[1] = v[i][1]; pp[2] = v[i][2]; pp[3] = v[i][3]; }
        }
        __syncthreads();
#pragma unroll
        for (int ps_ = 0; ps_ < 4; ++ps_) {
            const int n = (tid >> 3) + 64 * ps_, kc = tid & 7;
            float v[8];
#pragma unroll
            for (int j = 0; j < 8; ++j) { v[j] = tile[(kc * 8 + j) * 257 + n]; if (q8s > 0.f) v[j] = emu_q8(v[j], q8s); else if (q8s < 0.f && n0 + n >= C_ZC) v[j] = emu_q8(v[j], -q8s); }
            u32x4 w; w.x = pk2(v[0], v[1]); w.y = pk2(v[2], v[3]); w.z = pk2(v[4], v[5]); w.w = pk2(v[6], v[7]);
            *(u32x4*)(dst + (size_t)(n0 + n) * K + k0 + kc * 8) = w;
            if (dst8 && (n0 + n < n8_0 || n0 + n >= n8_1)) { u32x2 b; b.x = pk4_fp8(v[0] * 64.0f, v[1] * 64.0f, v[2] * 64.0f, v[3] * 64.0f); b.y = pk4_fp8(v[4] * 64.0f, v[5] * 64.0f, v[6] * 64.0f, v[7] * 64.0f);
                *(u32x2*)(dst8 + (size_t)(n0 + n) * K + k0 + kc * 8) = b; }
        }
    }
}

DI void phase_rmsnorm(const float* __restrict__ x, const float* __restrict__ gain, bf16_t* __restrict__ h, int bid, int nb, float q8s = 0.f, unsigned char* __restrict__ h8 = nullptr) {
    const int tid = tid_opaque(); const int lane = tid & 63, wid = tid >> 6;
    for (int row = bid * 8 + wid; row < MTOK; row += nb * 8) {
        const float* xr = x + (size_t)row * DM;
        f32x4 v[16]; float ss = 0.f;
#pragma unroll
        for (int i = 0; i < 16; ++i) { v[i] = *(const f32x4*)(xr + (i * 64 + lane) * 4); ss += v[i][0] * v[i][0] + v[i][1] * v[i][1] + v[i][2] * v[i][2] + v[i][3] * v[i][3]; }
#pragma unroll
        for (int o = 32; o >= 1; o >>= 1) ss += __shfl_xor(ss, o);
        const float rstd = rsqrtf(ss * (1.0f / DM) + EPSN);
        bf16_t* hr = h + (size_t)row * DM;
#pragma unroll
        for (int i = 0; i < 16; ++i) { const f32x4 g = *(const f32x4*)(gain + (i * 64 + lane) * 4);
            float y0 = v[i][0] * rstd * g[0], y1 = v[i][1] * rstd * g[1], y2 = v[i][2] * rstd * g[2], y3 = v[i][3] * rstd * g[3];
            if (q8s > 0.f || (q8s < 0.f && (row & 4095) >= 256)) { const float qa = fabsf(q8s); y0 = emu_q8(y0, qa); y1 = emu_q8(y1, qa); y2 = emu_q8(y2, qa); y3 = emu_q8(y3, qa); }
            u32x2 w; w.x = pk2(y0, y1); w.y = pk2(y2, y3);
            *(u32x2*)(hr + (i * 64 + lane) * 4) = w;
            if (h8) *(unsigned*)(h8 + (size_t)row * DM + (i * 64 + lane) * 4) = pk4_fp8(y0 * 16.0f, y1 * 16.0f, y2 * 16.0f, y3 * 16.0f); }
    }
}

DI void ld192(const bf16_t* p, int j8, float (&v)[24]) {
#pragma unroll
    for (int c = 0; c < 3; ++c) { const u32x4 w = *(const u32x4*)(p + (j8 + 8 * c) * 8);
        v[c * 8 + 0] = bflo(w.x); v[c * 8 + 1] = bfhi(w.x); v[c * 8 + 2] = bflo(w.y); v[c * 8 + 3] = bfhi(w.y);
        v[c * 8 + 4] = bflo(w.z); v[c * 8 + 5] = bfhi(w.z); v[c * 8 + 6] = bflo(w.w); v[c * 8 + 7] = bfhi(w.w); }
}
DI void st192(bf16_t* p, int j8, const float (&v)[24]) {
#pragma unroll
    for (int c = 0; c < 3; ++c) { u32x4 w; w.x = pk2(v[c * 8 + 0], v[c * 8 + 1]); w.y = pk2(v[c * 8 + 2], v[c * 8 + 3]); w.z = pk2(v[c * 8 + 4], v[c * 8 + 5]); w.w = pk2(v[c * 8 + 6], v[c * 8 + 7]);
        *(u32x4*)(p + (j8 + 8 * c) * 8) = w; }
}
DI float sum8(float s) { s += __shfl_xor(s, 1); s += __shfl_xor(s, 2); s += __shfl_xor(s, 4); return s; }

DI void phase_nsa_prep(const Params& P, int bid, int nb) {
    bf16_t* Y0 = (bf16_t*)(P.ws + OFF_Y0);
    bf16_t* KS = (bf16_t*)(P.ws + OFF_KS); bf16_t* KW = (bf16_t*)(P.ws + OFF_KW);
    bf16_t* ACK = (bf16_t*)(P.ws + OFF_ACK); bf16_t* ACV = (bf16_t*)(P.ws + OFF_ACV);
    const int tid = tid_opaque(), grp = (tid >> 3) & 15, j8 = tid & 7;
    for (int tok = bid * 4 + (tid >> 7); tok < MTOK; tok += nb * 4) {
        const int b = tok / SEQ, s = tok % SEQ;
        bf16_t* yr = Y0 + (size_t)tok * N1P;
        if (grp < 8) {
            const int g = grp & 3, br = grp >> 2;
            float v[24]; ld192(yr + (br ? C_KVW : C_KVS) + g * DK, j8, v);
            float ss = 0.f;
#pragma unroll
            for (int i = 0; i < 24; ++i) ss += v[i] * v[i];
            ss = sum8(ss);
            const float rstd = rsqrtf(ss * (1.0f / DK) + EPSN);
            const float* kn = P.nsa_k_norm + (br ? 2 : 1) * DK;
#pragma unroll
            for (int c = 0; c < 3; ++c)
#pragma unroll
                for (int e = 0; e < 8; ++e) v[c * 8 + e] *= rstd * kn[(j8 + 8 * c) * 8 + e];
            st192((br ? KW : KS) + ((size_t)(b * NG + g) * SEQ + s) * DK, j8, v);
        } else if (grp < 12) {
            const int g = grp - 8;
            float v[24]; ld192(yr + C_KVC + g * DK, j8, v);
#pragma unroll
            for (int k = 0; k < 2; ++k) {
                const int n = (s >> 4) - k, l = s - 16 * n;
                if (n >= 0 && n <= 254) {
                    float w[24];
#pragma unroll
                    for (int c = 0; c < 3; ++c)
#pragma unroll
                        for (int e = 0; e < 8; ++e) w[c * 8 + e] = v[c * 8 + e] + P.pe_k[l * DK + (j8 + 8 * c) * 8 + e];
                    st192(ACK + ((size_t)((b * NG + g) * 256 + n)) * 6144 + l * DK, j8, w);
                }
            }
        } else if (grp < 16) {
            const int g = grp - 12;
            const bf16_t* src = yr + C_KVC + NG * DK + g * DV;
            float v[16];
#pragma unroll
            for (int c = 0; c < 2; ++c) { const u32x4 w = *(const u32x4*)(src + (j8 + 8 * c) * 8);
                v[c * 8 + 0] = bflo(w.x); v[c * 8 + 1] = bfhi(w.x); v[c * 8 + 2] = bflo(w.y); v[c * 8 + 3] = bfhi(w.y);
                v[c * 8 + 4] = bflo(w.z); v[c * 8 + 5] = bfhi(w.z); v[c * 8 + 6] = bflo(w.w); v[c * 8 + 7] = bfhi(w.w); }
#pragma unroll
            for (int k = 0; k < 2; ++k) {
                const int n = (s >> 4) - k, l = s - 16 * n;
                if (n >= 0 && n <= 254) {
                    bf16_t* dst = ACV + ((size_t)((b * NG + g) * 256 + n)) * 4096 + l * DV;
#pragma unroll
                    for (int c = 0; c < 2; ++c) { float w[8];
#pragma unroll
                        for (int e = 0; e < 8; ++e) w[e] = v[c * 8 + e] + P.pe_v[l * DV + (j8 + 8 * c) * 8 + e];
                        u32x4 o; o.x = pk2(w[0], w[1]); o.y = pk2(w[2], w[3]); o.z = pk2(w[4], w[5]); o.w = pk2(w[6], w[7]);
                        *(u32x4*)(dst + (j8 + 8 * c) * 8) = o; }
                }
            }
        }
    }
    for (int i = bid * 512 + tid; i < 16 * (6144 + 4096) / 8; i += nb * 512) {
        const int per = (6144 + 4096) / 8, bg = i / per, c = i % per;
        const u32x4 z = {0u, 0u, 0u, 0u};
        if (c < 6144 / 8) *(u32x4*)(ACK + ((size_t)(bg * 256 + 255)) * 6144 + c * 8) = z;
        else *(u32x4*)(ACV + ((size_t)(bg * 256 + 255)) * 4096 + (c - 6144 / 8) * 8) = z;
    }
}

DI int swap23(int p) { return (p & ~0xC) | ((p & 4) << 1) | ((p & 8) >> 1); }
DI void phase_vt(LAS unsigned char* lds, const bf16_t* __restrict__ src, size_t src_stride, int col0, int col_step, int nhv, bf16_t* __restrict__ dst, int bid, int nb) {
    LAS bf16_t* tile = (LAS bf16_t*)lds;
    const int tid = tid_opaque();
    const int ntile = SEQ / 64, total = BATCH * nhv * ntile;
    for (int it = bid; it < total; it += nb) {
        const int mat = it / ntile, tt = it % ntile, b = mat / nhv, hv = mat % nhv;
        __syncthreads();
#pragma unroll
        for (int i = 0; i < 2; ++i) {
            const int q = tid + 512 * i, tok = q >> 4, ch = q & 15;
            const u32x4 w = *(const u32x4*)(src + (size_t)(b * SEQ + tt * 64 + tok) * src_stride + col0 + hv * col_step + ch * 8);
            *(LAS u32x4*)(tile + tok * 136 + ch * 8) = w;
        }
        __syncthreads();
        {
            const int dv = tid >> 2, kq = tid & 3;
            unsigned w[8];
#pragma unroll
            for (int e = 0; e < 8; ++e) {
                const int p0 = kq * 16 + 2 * e, p1 = p0 + 1;
                const int k0 = vt_key_of_pos(p0), k1 = vt_key_of_pos(p1);
                w[e] = (unsigned)tile[k0 * 136 + dv] | ((unsigned)tile[k1 * 136 + dv] << 16);
            }
            bf16_t* d = dst + ((size_t)mat * DV + dv) * SEQ + tt * 64 + kq * 16;
            u32x4 a = {w[0], w[1], w[2], w[3]}, c = {w[4], w[5], w[6], w[7]};
            *(u32x4*)d = a; *(u32x4*)(d + 8) = c;
        }
    }
}

DI void phase_cmp2(LAS unsigned char* lds, const Params& P, int bid, int nb) {
    LAS float* sk = (LAS float*)lds;
    LAS float* sv = sk + 192;
    LAS float* red = sv + 128;
    const float* HIDK = (const float*)(P.ws + OFF_HIDK); const float* HIDV = (const float*)(P.ws + OFF_HIDV);
    bf16_t* KC = (bf16_t*)(P.ws + OFF_KC); bf16_t* VTC = (bf16_t*)(P.ws + OFF_VTC);
    const int tid = tid_opaque(), lane = tid & 63, wid = tid >> 6;
    for (int m = bid; m < 4096; m += nb) {
        const int n = m & 255, bg = m >> 8;
        __syncthreads();
        if (tid < 192) { const float h = HIDK[(size_t)m * 256 + tid]; sk[tid] = h / (1.0f + __expf(-h)); }
        else if (tid < 320) { const float h = HIDV[(size_t)m * 256 + tid - 192]; sv[tid - 192] = h / (1.0f + __expf(-h)); }
        __syncthreads();
        float acc = 0.f;
        if (tid < 192) { for (int i = 0; i < 192; ++i) acc += sk[i] * P.w2_k[i * 192 + tid]; }
        else if (tid < 320) { const int j = tid - 192; for (int i = 0; i < 128; ++i) acc += sv[i] * P.w2_v[i * 128 + j]; }
        float ss = (tid < 192) ? acc * acc : 0.f;
#pragma unroll
        for (int o = 32; o >= 1; o >>= 1) ss += __shfl_xor(ss, o);
        if (lane == 0) red[wid] = ss;
        __syncthreads();
        const float tot = red[0] + red[1] + red[2];
        const float rstd = rsqrtf(tot * (1.0f / DK) + EPSN);
        if (tid < 192) { const float o = (n == 255) ? 0.f : acc * rstd * P.nsa_k_norm[tid];
            KC[(size_t)m * DK + tid] = (bf16_t)(pk2(o, 0.f) & 0xffffu); }
        else if (tid < 320) { const int j = tid - 192; const float o = (n == 255) ? 0.f : acc;
            const int pn = vt_pos_of_key(n);
            VTC[((size_t)bg * DV + j) * 256 + pn] = (bf16_t)(pk2(o, 0.f) & 0xffffu); }
    }
}

DI void phase_mla_prep1(const Params& P, int bid, int nb) {
    const bf16_t* Y1 = (const bf16_t*)(P.ws + OFF_Y1);
    bf16_t* CQN = (bf16_t*)(P.ws + OFF_CQN); bf16_t* CKVN = (bf16_t*)(P.ws + OFF_CKVN); float* ROPE = (float*)(P.ws + OFF_ROPE);
    float* KPER = (float*)(P.ws + OFF_KPER); float* SSPE = (float*)(P.ws + OFF_SSPE);
    const int tid = tid_opaque(); const int lane = tid & 63, wid = tid >> 6;
    constexpr int TU = 4;
    for (int tok0 = (bid * 8 + wid) * TU; tok0 < MTOK; tok0 += nb * 8 * TU) {
        u32x4 wq[TU][3], wk[TU]; int pos[TU]; bf16_t kp1[TU], kp2[TU];
#pragma unroll
        for (int t = 0; t < TU; ++t) { const bf16_t* yr = Y1 + (size_t)(tok0 + t) * N3P;
#pragma unroll
            for (int c = 0; c < 3; ++c) wq[t][c] = *(const u32x4*)(yr + C3_CQ + (c * 64 + lane) * 8);
            wk[t] = *(const u32x4*)(yr + C3_CKV + lane * 8);
            pos[t] = P.pos[tok0 + t]; kp1[t] = yr[C3_KPE + (lane & 31)]; kp2[t] = yr[C3_KPE + 32 + (lane & 31)]; }
#pragma unroll
        for (int t = 0; t < TU; ++t) { const int tok = tok0 + t;
            {
                float v[24]; float ss = 0.f;
#pragma unroll
                for (int c = 0; c < 3; ++c) { const u32x4 w = wq[t][c];
                    v[c * 8 + 0] = bflo(w.x); v[c * 8 + 1] = bfhi(w.x); v[c * 8 + 2] = bflo(w.y); v[c * 8 + 3] = bfhi(w.y);
                    v[c * 8 + 4] = bflo(w.z); v[c * 8 + 5] = bfhi(w.z); v[c * 8 + 6] = bflo(w.w); v[c * 8 + 7] = bfhi(w.w); }
#pragma unroll
                for (int i = 0; i < 24; ++i) ss += v[i] * v[i];
#pragma unroll
                for (int o = 32; o >= 1; o >>= 1) ss += __shfl_xor(ss, o);
                const float rstd = rsqrtf(ss * (1.0f / QLORA) + EPSN);
#pragma unroll
                for (int c = 0; c < 3; ++c) { const float* g = P.mla_q_a_norm + (c * 64 + lane) * 8; const f32x4 g0 = *(const f32x4*)g, g1 = *(const f32x4*)(g + 4); u32x4 w;
                    w.x = pk2(v[c * 8 + 0] * rstd * g0[0], v[c * 8 + 1] * rstd * g0[1]); w.y = pk2(v[c * 8 + 2] * rstd * g0[2], v[c * 8 + 3] * rstd * g0[3]);
                    w.z = pk2(v[c * 8 + 4] * rstd * g1[0], v[c * 8 + 5] * rstd * g1[1]); w.w = pk2(v[c * 8 + 6] * rstd * g1[2], v[c * 8 + 7] * rstd * g1[3]);
                    *(u32x4*)(CQN + (size_t)tok * QLORA + (c * 64 + lane) * 8) = w;
                    if (USE_FP8Q) { const float r16 = rstd * 16.0f; u32x2 b;
                        b.x = pk4_fp8(v[c * 8 + 0] * r16 * g0[0], v[c * 8 + 1] * r16 * g0[1], v[c * 8 + 2] * r16 * g0[2], v[c * 8 + 3] * r16 * g0[3]);
                        b.y = pk4_fp8(v[c * 8 + 4] * r16 * g1[0], v[c * 8 + 5] * r16 * g1[1], v[c * 8 + 6] * r16 * g1[2], v[c * 8 + 7] * r16 * g1[3]);
                        *(u32x2*)((unsigned char*)(P.ws + OFF_CQN8) + (size_t)tok * QLORA + (c * 64 + lane) * 8) = b; } }
            }
            {
                float v[8]; float ss = 0.f; const u32x4 w0 = wk[t];
                v[0] = bflo(w0.x); v[1] = bfhi(w0.x); v[2] = bflo(w0.y); v[3] = bfhi(w0.y); v[4] = bflo(w0.z); v[5] = bfhi(w0.z); v[6] = bflo(w0.w); v[7] = bfhi(w0.w);
#pragma unroll
                for (int i = 0; i < 8; ++i) ss += v[i] * v[i];
#pragma unroll
                for (int o = 32; o >= 1; o >>= 1) ss += __shfl_xor(ss, o);
                const float rstd = rsqrtf(ss * (1.0f / KVLORA) + EPSN);
                const float* g = P.mla_kv_a_norm + lane * 8; const f32x4 g0 = *(const f32x4*)g, g1 = *(const f32x4*)(g + 4); u32x4 w;
                w.x = pk2(v[0] * rstd * g0[0], v[1] * rstd * g0[1]); w.y = pk2(v[2] * rstd * g0[2], v[3] * rstd * g0[3]);
                w.z = pk2(v[4] * rstd * g1[0], v[5] * rstd * g1[1]); w.w = pk2(v[6] * rstd * g1[2], v[7] * rstd * g1[3]);
                *(u32x4*)(CKVN + (size_t)tok * KVLORA + lane * 8) = w;
            }
            {
                const int i = lane & 31;
                const float invf = exp2f(-(float)i * (13.287712379549449f / 32.0f));
                const float ang = (float)pos[t] * invf;
                const double rev = (double)ang * 0.15915494309189533576888;
                const float fr = (float)(rev - __builtin_rint(rev));
                const float sn = __builtin_amdgcn_sinf(fr), cs = __builtin_amdgcn_cosf(fr);
                const float x1 = bf1(kp1[t]), x2 = bf1(kp2[t]);
                float ssp = x1 * x1 + x2 * x2;
#pragma unroll
                for (int o = 16; o >= 1; o >>= 1) ssp += __shfl_xor(ssp, o);
                const float a = x1 * P.mla_k_norm[128 + i], c = x2 * P.mla_k_norm[160 + i];
                if (lane < 32) { ROPE[(size_t)tok * 64 + i] = cs; ROPE[(size_t)tok * 64 + 32 + i] = sn;
                    KPER[(size_t)tok * 64 + i] = a * cs - c * sn; KPER[(size_t)tok * 64 + 32 + i] = c * cs + a * sn;
                    if (lane == 0) SSPE[tok] = ssp; }
            }
        }
    }
}

DI void phase_mla_prep2(const Params& P, int bid, int nb) {
    const bf16_t* KNM = (const bf16_t*)(P.ws + OFF_KNM); const bf16_t* Y1 = (const bf16_t*)(P.ws + OFF_Y1);
    bf16_t* KM = (bf16_t*)(P.ws + OFF_KM); const float* ROPE = (const float*)(P.ws + OFF_ROPE);
    const int tid = tid_opaque(), grp = tid >> 3, j8 = tid & 7;
    for (int tok = bid; tok < MTOK; tok += nb) {
        const int b = tok / SEQ, s = tok % SEQ;
        float cs[8], sn[8];
#pragma unroll
        for (int e = 0; e < 8; ++e) { const int i = (8 * j8 + e) & 31; cs[e] = ROPE[(size_t)tok * 64 + i]; sn[e] = ROPE[(size_t)tok * 64 + 32 + i]; }
        {
            const bf16_t* kn = KNM + (size_t)tok * (NH * 128) + grp * 128;
            const bf16_t* kp = Y1 + (size_t)tok * N3P + C3_KPE;
            float v[24];
#pragma unroll
            for (int c = 0; c < 2; ++c) { const u32x4 w = *(const u32x4*)(kn + (j8 + 8 * c) * 8);
                v[c * 8 + 0] = bflo(w.x); v[c * 8 + 1] = bfhi(w.x); v[c * 8 + 2] = bflo(w.y); v[c * 8 + 3] = bfhi(w.y);
                v[c * 8 + 4] = bflo(w.z); v[c * 8 + 5] = bfhi(w.z); v[c * 8 + 6] = bflo(w.w); v[c * 8 + 7] = bfhi(w.w); }
            { const u32x4 w = *(const u32x4*)(kp + j8 * 8);
                v[16] = bflo(w.x); v[17] = bfhi(w.x); v[18] = bflo(w.y); v[19] = bfhi(w.y); v[20] = bflo(w.z); v[21] = bfhi(w.z); v[22] = bflo(w.w); v[23] = bfhi(w.w); }
            float ss = 0.f;
#pragma unroll
            for (int i = 0; i < 24; ++i) ss += v[i] * v[i];
            ss = sum8(ss);
            const float rstd = rsqrtf(ss * (1.0f / DK) + EPSN);
#pragma unroll
            for (int c = 0; c < 3; ++c)
#pragma unroll
                for (int e = 0; e < 8; ++e) v[c * 8 + e] *= rstd * P.mla_k_norm[(j8 + 8 * c) * 8 + e];
#pragma unroll
            for (int e = 0; e < 8; ++e) { const float mine = v[16 + e], other = __shfl_xor(mine, 4);
                v[16 + e] = (j8 < 4) ? (mine * cs[e] - other * sn[e]) : (mine * cs[e] + other * sn[e]); }
            st192(KM + ((size_t)(b * NH + grp) * SEQ + s) * DK, j8, v);
        }
    }
}
#ifndef ATT_THR
#define ATT_THR 30.0f
#endif
#ifndef ATT3_HOIST
#define ATT3_HOIST 1
#endif
#ifndef PROBE3_STORE2
#define PROBE3_STORE2 1
#endif
#ifndef PROBE3_UNITS
#define PROBE3_UNITS 1
#endif
#ifndef PROBE3_CMP
#define PROBE3_CMP 1
#endif
#ifndef PROBE3_SEL
#define PROBE3_SEL 1
#endif
#ifndef PROBE3_WIN
#define PROBE3_WIN 1
#endif
#ifndef ATT3_KD
#define ATT3_KD 4
#endif
#ifndef ATT3_VD
#define ATT3_VD 4
#endif
#ifndef ATT_PS_LIMIT
#define ATT_PS_LIMIT (16.0f * 1073741824.0f)
#endif
constexpr int KT_BYTES = 64 * 384, VT_BYTES = 128 * 128;
constexpr int L_K = 0, L_V = 2 * KT_BYTES, L_LUT = L_V + 2 * VT_BYTES, LUT_PITCH = 129, L_X = L_LUT + 64 * LUT_PITCH * 4 + 16, L_IL = L_X + 16 * 16 * 64 * 2, L_END = L_IL + 16 * 16 * 4;
static_assert(L_END <= 151552, "attention LDS");
enum { MODE_MLA = 0, MODE_SEL = 3, MODE_WIN = 4, MODE_CMPX = 5 };
#define MFMA16(a, b, c) __builtin_amdgcn_mfma_f32_16x16x32_bf16((a), (b), (c), 0, 0, 0)

struct AttnLane3 {
    int tw0, tw1;
    int r16, g;
    const LAS float* lutrow;
    unsigned long long mk0, mk1;
    int curblk;
    int tokbase;
    mutable float carry[2];
};
template <int MODE> DI int tq_of(const AttnLane3& A, int qb) { return (MODE == MODE_MLA) ? A.tw0 + 16 * qb + A.r16 : A.tw0 + qb; }

template <int MODE, int QS>
DI void attn_tile3(const LAS unsigned char* kb, const LAS unsigned char* vb, LAS unsigned char* lds, int j, const bf16x8 (&q)[2][6], f32x4 (&o)[8][2], float (&m_run)[2], float (&l_run)[2], const AttnLane3& A) {
    constexpr bool Q0 = (QS & 1) != 0, Q1 = (QS & 2) != 0;
    const int r16 = A.r16, g = A.g, sw = (r16 >> 1) & 7;
    const int kb0 = r16 * 384 + ((g ^ sw) << 4), kb1 = r16 * 384 + (((g ^ sw) ^ 4) << 4);
    const int vb0 = r16 * 128 + ((g ^ sw) << 4), vb1 = r16 * 128 + (((g ^ sw) ^ 4) << 4);
    f32x4 s[4][2];
    bool zinit = true;
    if (MODE == MODE_WIN || MODE == MODE_SEL) zinit = (A.tw0 - (64 * j + 63) >= 113);
    else if (MODE == MODE_CMPX) zinit = (A.tw0 - 31 - 16 * (64 * j + 63) >= 113);
    if (zinit) {
#pragma unroll
        for (int k4 = 0; k4 < 4; ++k4) { s[k4][0] = (f32x4){0.f, 0.f, 0.f, 0.f}; s[k4][1] = (f32x4){0.f, 0.f, 0.f, 0.f}; }
    } else {
#pragma unroll
        for (int qb = 0; qb < 2; ++qb) { if ((qb == 0 && !Q0) || (qb == 1 && !Q1)) continue;
            const int tq = tq_of<MODE>(A, qb);
#pragma unroll
            for (int k4 = 0; k4 < 4; ++k4)
#pragma unroll
                for (int r = 0; r < 4; ++r) { int d;
                    if (MODE == MODE_CMPX) d = tq - 31 - 16 * (64 * j + 16 * k4 + 4 * g + r); else d = tq - (64 * j + 16 * k4 + 4 * g + r);
                    d = d < 0 ? 0 : (d > 127 ? 127 : d); s[k4][qb][r] = A.lutrow[d] - m_run[qb]; } }
    }
    {
        constexpr int KD = ATT3_KD;
        bf16x8 kf[KD + 1];
#pragma unroll
        for (int i = 0; i < KD; ++i) kf[i] = *(const LAS bf16x8*)(kb + (((i % 6) & 1) ? kb1 : kb0) + ((i % 6) >> 1) * 128 + (i / 6) * (16 * 384));
        __builtin_amdgcn_sched_barrier(0);
#pragma unroll
        for (int i = 0; i < 24; ++i) {
            if (i + KD < 24) { const int n_ = i + KD; kf[n_ % (KD + 1)] = *(const LAS bf16x8*)(kb + (((n_ % 6) & 1) ? kb1 : kb0) + ((n_ % 6) >> 1) * 128 + (n_ / 6) * (16 * 384)); }
            __builtin_amdgcn_sched_barrier(0);
            if (Q0) s[i / 6][0] = MFMA16(kf[i % (KD + 1)], q[0][i % 6], s[i / 6][0]);
            if (Q1) s[i / 6][1] = MFMA16(kf[i % (KD + 1)], q[1][i % 6], s[i / 6][1]);
            __builtin_amdgcn_sched_barrier(0);
        }
    }
    if (zinit && __any(m_run[0] != 0.f || m_run[1] != 0.f)) {
#pragma unroll
        for (int k4 = 0; k4 < 4; ++k4)
#pragma unroll
            for (int r = 0; r < 4; ++r) { s[k4][0][r] -= m_run[0]; s[k4][1][r] -= m_run[1]; }
    }
    {
        const float NEG = -__builtin_inff();
        bool need;
        if (MODE == MODE_MLA) need = (64 * j + 63 > A.tw0);
        else if (MODE == MODE_WIN) need = !(64 * j + 63 <= A.tw0 && 64 * j >= A.tw1 - 511);
        else if (MODE == MODE_SEL) need = (j == A.curblk);
        else need = (A.tw0 - 31 - 16 * (64 * j + 63) < 0);
        if (need) {
#pragma unroll
            for (int qb = 0; qb < 2; ++qb) { if ((qb == 0 && !Q0) || (qb == 1 && !Q1)) continue;
                const int tq = tq_of<MODE>(A, qb);
#pragma unroll
                for (int k4 = 0; k4 < 4; ++k4)
#pragma unroll
                    for (int r = 0; r < 4; ++r) { const int c = 64 * j + 16 * k4 + 4 * g + r; bool kill;
                        if (MODE == MODE_WIN) kill = (unsigned)(tq - c) >= 512u;
                        else if (MODE == MODE_CMPX) kill = (tq - 31 - 16 * c) < 0;
                        else kill = (tq - c) < 0;
                        s[k4][qb][r] = kill ? NEG : s[k4][qb][r]; } }
        }
    }
    u32x4 pw[2][2];
#pragma unroll
    for (int qb = 0; qb < 2; ++qb) { if ((qb == 0 && !Q0) || (qb == 1 && !Q1)) continue;
        if (MODE == MODE_CMPX) {
            float lmx = fmaxf(fmaxf(s[0][qb][0], s[0][qb][1]), fmaxf(s[0][qb][2], s[0][qb][3]));
#pragma unroll
            for (int k4 = 1; k4 < 4; ++k4) lmx = fmaxf(lmx, fmaxf(fmaxf(s[k4][qb][0], s[k4][qb][1]), fmaxf(s[k4][qb][2], s[k4][qb][3])));
            if (__any(lmx > ATT_THR)) {
                float mx = fmaxf(lmx, __shfl_xor(lmx, 16)); mx = fmaxf(mx, __shfl_xor(mx, 32));
                const float dl = fmaxf(mx, 0.f), alpha = __builtin_amdgcn_exp2f(-dl);
                m_run[qb] += dl; l_run[qb] *= alpha; A.carry[qb] *= alpha;
#pragma unroll
                for (int db = 0; db < 8; ++db) o[db][qb] *= alpha;
#pragma unroll
                for (int k4 = 0; k4 < 4; ++k4) s[k4][qb] -= dl;
                LAS bf16_t* X = (LAS bf16_t*)(lds + L_X) + ((A.tokbase + qb) * 16 + r16) * 64;
                for (int a = g; a < 16 * j; a += 4) X[a] = (bf16_t)(pk2(bf1(X[a]) * alpha, 0.f) & 0xffffu);
            }
        }
        float ps = 0.f; f32x4 e[4];
#pragma unroll
        for (int k4 = 0; k4 < 4; ++k4) { e[k4][0] = __builtin_amdgcn_exp2f(s[k4][qb][0]); e[k4][1] = __builtin_amdgcn_exp2f(s[k4][qb][1]); e[k4][2] = __builtin_amdgcn_exp2f(s[k4][qb][2]); e[k4][3] = __builtin_amdgcn_exp2f(s[k4][qb][3]);
            ps += (e[k4][0] + e[k4][1]) + (e[k4][2] + e[k4][3]); }
        if (MODE != MODE_CMPX) {
            if (__any(!(ps <= ATT_PS_LIMIT))) {
                float mx = fmaxf(fmaxf(s[0][qb][0], s[0][qb][1]), fmaxf(s[0][qb][2], s[0][qb][3]));
#pragma unroll
                for (int k4 = 1; k4 < 4; ++k4) mx = fmaxf(mx, fmaxf(fmaxf(s[k4][qb][0], s[k4][qb][1]), fmaxf(s[k4][qb][2], s[k4][qb][3])));
                mx = fmaxf(mx, __shfl_xor(mx, 16)); mx = fmaxf(mx, __shfl_xor(mx, 32));
                const float dl = fmaxf(mx, 0.f), alpha = __builtin_amdgcn_exp2f(-dl);
                m_run[qb] += dl; l_run[qb] *= alpha;
#pragma unroll
                for (int db = 0; db < 8; ++db) o[db][qb] *= alpha;
                ps = 0.f;
#pragma unroll
                for (int k4 = 0; k4 < 4; ++k4) { e[k4][0] = __builtin_amdgcn_exp2f(s[k4][qb][0] - dl); e[k4][1] = __builtin_amdgcn_exp2f(s[k4][qb][1] - dl); e[k4][2] = __builtin_amdgcn_exp2f(s[k4][qb][2] - dl); e[k4][3] = __builtin_amdgcn_exp2f(s[k4][qb][3] - dl);
                    ps += (e[k4][0] + e[k4][1]) + (e[k4][2] + e[k4][3]); }
            }
        } else {
            LAS bf16_t* X = (LAS bf16_t*)(lds + L_X) + ((A.tokbase + qb) * 16 + r16) * 64;
#pragma unroll
            for (int k4 = 0; k4 < 4; ++k4) {
                const float y = __shfl(e[k4][3], (r16 + 16 * g + 48) & 63);
                const float prev = g ? y : A.carry[qb];
                if (g == 0) A.carry[qb] = y;
                X[16 * j + 4 * k4 + g] = (bf16_t)(pk2((e[k4][0] + e[k4][1]) + (e[k4][2] + e[k4][3]) + prev, 0.f) & 0xffffu);
            }
        }
        l_run[qb] += ps;
        pw[0][qb].x = pk2(e[0][0], e[0][1]); pw[0][qb].y = pk2(e[0][2], e[0][3]); pw[0][qb].z = pk2(e[1][0], e[1][1]); pw[0][qb].w = pk2(e[1][2], e[1][3]);
        pw[1][qb].x = pk2(e[2][0], e[2][1]); pw[1][qb].y = pk2(e[2][2], e[2][3]); pw[1][qb].z = pk2(e[3][0], e[3][1]); pw[1][qb].w = pk2(e[3][2], e[3][3]);
    }
    {
        constexpr int VD = ATT3_VD;
        bf16x8 vf[VD + 1];
#pragma unroll
        for (int i = 0; i < VD; ++i) vf[i] = *(const LAS bf16x8*)(vb + ((i >> 3) ? vb1 : vb0) + (i & 7) * (16 * 128));
        __builtin_amdgcn_sched_barrier(0);
#pragma unroll
        for (int i = 0; i < 16; ++i) {
            if (i + VD < 16) { const int n_ = i + VD; vf[n_ % (VD + 1)] = *(const LAS bf16x8*)(vb + ((n_ >> 3) ? vb1 : vb0) + (n_ & 7) * (16 * 128)); }
            __builtin_amdgcn_sched_barrier(0);
            if (Q0) o[i & 7][0] = MFMA16(vf[i % (VD + 1)], __builtin_bit_cast(bf16x8, pw[i >> 3][0]), o[i & 7][0]);
            if (Q1) o[i & 7][1] = MFMA16(vf[i % (VD + 1)], __builtin_bit_cast(bf16x8, pw[i >> 3][1]), o[i & 7][1]);
            __builtin_amdgcn_sched_barrier(0);
        }
    }
}

DI void attn_issue_first(LAS unsigned char* lds, const char* __restrict__ Kc, const char* __restrict__ Vc, int vt_stride, int j) {
    int tid = threadIdx.x; asm volatile("" : "+v"(tid));
    const int lane = tid & 63;
    const int wid_ = __builtin_amdgcn_readfirstlane(tid >> 6);
    const char* kp_ = Kc + (size_t)j * KT_BYTES; LAS unsigned char* kb_ = lds + L_K + wid_ * 3072;
#pragma unroll
    for (int i_ = 0; i_ < 3; ++i_) { const int pidx_ = (wid_ * 3 + i_) * 64 + lane, row_ = pidx_ / 24, cp_ = pidx_ % 24;
        __builtin_amdgcn_global_load_lds((const unsigned*)(kp_ + (unsigned)(row_ * 384 + ((cp_ ^ ((row_ >> 1) & 7)) << 4))), (LAS unsigned*)(kb_ + i_ * 1024), 16, 0, 0); }
    const char* vp_ = Vc + (size_t)j * 128; LAS unsigned char* vb_ = lds + L_V + wid_ * 2048;
#pragma unroll
    for (int i_ = 0; i_ < 2; ++i_) { const int pidx_ = (wid_ * 2 + i_) * 64 + lane, row_ = pidx_ >> 3, cp_ = pidx_ & 7;
        __builtin_amdgcn_global_load_lds((const unsigned*)(vp_ + (unsigned)(row_ * vt_stride * 2 + ((cp_ ^ ((row_ >> 1) & 7)) << 4))), (LAS unsigned*)(vb_ + i_ * 1024), 16, 0, 0); }
}

template <int MODE>
DI void attn_pass3x(LAS unsigned char* lds, const char* __restrict__ Kc, const char* __restrict__ Vc, int vt_stride, int j_lo, int j_hi,
                    const bf16x8 (&q)[2][6], f32x4 (&o)[8][2], float (&m_run)[2], float (&l_run)[2], const AttnLane3& A, bool first_issued = false) {
    if (j_lo >= j_hi) return;
    int tid = threadIdx.x; asm volatile("" : "+v"(tid));
    const int lane = tid & 63;
    const int wid_ = __builtin_amdgcn_readfirstlane(tid >> 6);
    unsigned kgo[3], vgo[2];
#pragma unroll
    for (int i_ = 0; i_ < 3; ++i_) { const int pidx_ = (wid_ * 3 + i_) * 64 + lane, row_ = pidx_ / 24, cp_ = pidx_ % 24; kgo[i_] = (unsigned)(row_ * 384 + ((cp_ ^ ((row_ >> 1) & 7)) << 4)); }
#pragma unroll
    for (int i_ = 0; i_ < 2; ++i_) { const int pidx_ = (wid_ * 2 + i_) * 64 + lane, row_ = pidx_ >> 3, cp_ = pidx_ & 7; vgo[i_] = (unsigned)(row_ * vt_stride * 2 + ((cp_ ^ ((row_ >> 1) & 7)) << 4)); }
#define ST_ISSUE(j, buf) do { const char* kp_ = Kc + (size_t)(j) * KT_BYTES; LAS unsigned char* kb_ = lds + L_K + (buf) * KT_BYTES + wid_ * 3072; \
        _Pragma("unroll") for (int i_ = 0; i_ < 3; ++i_) __builtin_amdgcn_global_load_lds((const unsigned*)(kp_ + kgo[i_]), (LAS unsigned*)(kb_ + i_ * 1024), 16, 0, 0); \
        const char* vp_ = Vc + (size_t)(j) * 128; LAS unsigned char* vb_ = lds + L_V + (buf) * VT_BYTES + wid_ * 2048; \
        _Pragma("unroll") for (int i_ = 0; i_ < 2; ++i_) __builtin_amdgcn_global_load_lds((const unsigned*)(vp_ + vgo[i_]), (LAS unsigned*)(vb_ + i_ * 1024), 16, 0, 0); } while (0)
    if (!first_issued) ST_ISSUE(j_lo, 0);
    asm volatile("s_waitcnt vmcnt(0)" ::: "memory");
    __syncthreads();
    for (int j = j_lo; j < j_hi; ++j) {
        const int cur = (j - j_lo) & 1;
        if (j + 1 < j_hi) ST_ISSUE(j + 1, cur ^ 1);
        const LAS unsigned char* kbp = lds + L_K + cur * KT_BYTES; const LAS unsigned char* vbp = lds + L_V + cur * VT_BYTES;
        if (MODE == MODE_SEL) {
            const bool a0 = ((A.mk0 >> j) & 1ull) != 0ull, a1 = ((A.mk1 >> j) & 1ull) != 0ull;
            if (a0 && a1) attn_tile3<MODE, 3>(kbp, vbp, lds, j, q, o, m_run, l_run, A);
            else if (a0) attn_tile3<MODE, 1>(kbp, vbp, lds, j, q, o, m_run, l_run, A);
            else if (a1) attn_tile3<MODE, 2>(kbp, vbp, lds, j, q, o, m_run, l_run, A);
        } else {
            bool act;
            if (MODE == MODE_MLA) act = 64 * j <= A.tw1;
            else if (MODE == MODE_CMPX) act = 1024 * j + 31 <= A.tw1;
            else act = (64 * j <= A.tw1) && (64 * j + 63 >= A.tw0 - 511);
            if (act) attn_tile3<MODE, 3>(kbp, vbp, lds, j, q, o, m_run, l_run, A);
        }
        asm volatile("s_waitcnt vmcnt(0)" ::: "memory");
        __syncthreads();
    }
#undef ST_ISSUE
}

DI int t5_bucket(int n) {
    if (n < 16) return n;
    return 16 + (n >= 19) + (n >= 21) + (n >= 24) + (n >= 27) + (n >= 31) + (n >= 35) + (n >= 40) + (n >= 46) + (n >= 52) + (n >= 59) + (n >= 67) + (n >= 77) + (n >= 87) + (n >= 99) + (n >= 113);
}
DI float silu_f(float z) { return z * __builtin_amdgcn_rcpf(1.0f + __builtin_amdgcn_exp2f(-1.4426950408889634f * z)); }

constexpr int EPI_PITCH = 272, EPI_WAVE_BYTES = 32 * EPI_PITCH;
template <bool RMW, bool NSA, int F8 = 0>
DI void attn_epilogue3(LAS unsigned char* lds, int lane, int wid, const f32x4 (&o)[8][2], float scale0, float scale1,
                       const char* __restrict__ zbase, unsigned z0, char* __restrict__ obase, unsigned o0, bool dostore = true, char* __restrict__ o8base = nullptr, float o8s = O8_SCALE, bool both = true) {
    asm volatile("" : "+v"(lane));
    LAS unsigned char* sc = lds + wid * EPI_WAVE_BYTES;
    const int r16 = lane & 15, g = lane >> 4;
#pragma unroll
    for (int h = 0; h < 2; ++h) {
#pragma unroll
        for (int d4 = 0; d4 < 4; ++d4) {
            *(LAS f32x4*)(sc + r16 * EPI_PITCH + (16 * d4 + 4 * g) * 4) = o[4 * h + d4][0] * scale0;
            *(LAS f32x4*)(sc + (16 + r16) * EPI_PITCH + (16 * d4 + 4 * g) * 4) = o[4 * h + d4][1] * scale1;
        }
        asm volatile("" ::: "memory");
#pragma unroll
        for (int i = 0; i < 4; ++i) {
            const int rr = 8 * i + (lane >> 3), c8 = lane & 7;
            const f32x4 a = *(const LAS f32x4*)(sc + rr * EPI_PITCH + c8 * 32);
            const f32x4 b = *(const LAS f32x4*)(sc + rr * EPI_PITCH + c8 * 32 + 16);
            unsigned zoff, ooff;
            if (NSA) { zoff = z0 + (unsigned)((rr >> 4) * (N1P * 2) + (rr & 15) * 256); ooff = o0 + (unsigned)((rr >> 4) * (ZW8 * 2) + (rr & 15) * 256); }
            else     { zoff = z0 + (unsigned)(rr * (N3P * 2)); ooff = o0 + (unsigned)(rr * (ZW8 * 2)); }
            const unsigned cb = (unsigned)((64 * h + 8 * c8) * 2);
            if (!dostore) continue;
            const u32x4 zw = *(const u32x4*)(zbase + (zoff + cb));
            float v0 = a[0] * silu_f(bflo(zw.x)), v1 = a[1] * silu_f(bfhi(zw.x)), v2 = a[2] * silu_f(bflo(zw.y)), v3 = a[3] * silu_f(bfhi(zw.y));
            float v4 = b[0] * silu_f(bflo(zw.z)), v5 = b[1] * silu_f(bfhi(zw.z)), v6 = b[2] * silu_f(bflo(zw.w)), v7 = b[3] * silu_f(bfhi(zw.w));
            if (RMW) { const u32x4 pv = *(const u32x4*)(obase + (ooff + cb));
                v0 += bflo(pv.x); v1 += bfhi(pv.x); v2 += bflo(pv.y); v3 += bfhi(pv.y); v4 += bflo(pv.z); v5 += bfhi(pv.z); v6 += bflo(pv.w); v7 += bfhi(pv.w); }
            if (F8) { u32x2 w8; w8.x = pk4_fp8c(v0 * o8s, v1 * o8s, v2 * o8s, v3 * o8s); w8.y = pk4_fp8c(v4 * o8s, v5 * o8s, v6 * o8s, v7 * o8s);
                *(u32x2*)(o8base + ((ooff + cb) >> 1)) = w8; if (F8 == 1) continue; }
            u32x4 w; w.x = pk2(v0, v1); w.y = pk2(v2, v3); w.z = pk2(v4, v5); w.w = pk2(v6, v7);
            if (F8 != 2 || both) *(u32x4*)(obase + (ooff + cb)) = w;
        }
        asm volatile("" ::: "memory");
    }
}
DI float sum_g(float v) { v += __shfl_xor(v, 16); v += __shfl_xor(v, 32); return v; }

DI void phase_nsa_attn(LAS unsigned char* lds, const Params& P, int bid, int nb) {
    const char* Y0c = (const char*)(P.ws + OFF_Y0);
    const char* KSc = (const char*)(P.ws + OFF_KS); const char* KWc = (const char*)(P.ws + OFF_KW);
    const char* VTSc = (const char*)(P.ws + OFF_VTS); const char* VTWc = (const char*)(P.ws + OFF_VTW);
    const char* KCc = (const char*)(P.ws + OFF_KC); const char* VTCc = (const char*)(P.ws + OFF_VTC);
    char* ONc = (char*)(P.ws + OFF_O);
    LAS float* lut = (LAS float*)(lds + L_LUT);
    const int total = BATCH * NG * 256;
    {
        const int tid0 = tid_opaque();
        __syncthreads();
        for (int i = tid0; i < 64 * 128; i += 512) { const int hd = i >> 7, d = i & 127; lut[hd * LUT_PITCH + d] = (P.rel_bias[t5_bucket(d) * NH + hd] - P.rel_bias[31 * NH + hd]) * LOG2E; }
        __syncthreads();
    }
    for (int u_ = bid; u_ < total * PROBE3_UNITS; u_ += nb) {
        const int u = (u_ >= total) ? u_ - total : u_;
        int tid = threadIdx.x; asm volatile("" : "+v"(tid));
        const int lane = tid & 63, wid = __builtin_amdgcn_readfirstlane(tid >> 6);
        const int pair = u >> 8; int c = u & 255; if (pair & 1) c = 255 - c;
        const int b = pair >> 2, gg = pair & 3, t0 = c * 16;
        __syncthreads();
        AttnLane3 A;
        A.r16 = lane & 15; A.g = lane >> 4;
        A.tw0 = t0 + 2 * wid; A.tw1 = A.tw0 + 1;
        const int hh = gg * NR + A.r16;
        A.lutrow = lut + hh * LUT_PITCH;
        A.curblk = t0 >> 6; A.tokbase = 2 * wid; A.mk0 = 0ull; A.mk1 = 0ull; A.carry[0] = 0.f; A.carry[1] = 0.f;
        const unsigned ytok0 = (unsigned)(b * SEQ + A.tw0) * (unsigned)(N1P * 2);
        const unsigned otok0 = ((unsigned)(b * SEQ + A.tw0) * (unsigned)ZW8 + (unsigned)(gg * NR * DV)) * 2u;
        const int bg = b * NG + gg;
        const int nct = (t0 + 15 >= 31) ? (((t0 + 15 - 31) >> 4) / 64 + 1) : 0;
        if (ATT3_HOIST && nct > 0) attn_issue_first(lds, KCc + (size_t)bg * 256 * DK * 2, VTCc + (size_t)bg * DV * 256 * 2, 256, 0);
        bf16x8 q[2][6];
#pragma unroll
        for (int qb = 0; qb < 2; ++qb) {
            const unsigned qo = ytok0 + (unsigned)(qb * (N1P * 2)) + (unsigned)((C_Q + hh * DK + 8 * A.g) * 2);
            float ss = 0.f;
#pragma unroll
            for (int ds = 0; ds < 6; ++ds) { q[qb][ds] = *(const bf16x8*)(Y0c + (qo + 64u * ds));
                const u32x4 w = __builtin_bit_cast(u32x4, q[qb][ds]);
                const float a0 = bflo(w.x), a1 = bfhi(w.x), a2 = bflo(w.y), a3 = bfhi(w.y), a4 = bflo(w.z), a5 = bfhi(w.z), a6 = bflo(w.w), a7 = bfhi(w.w);
                ss += (a0 * a0 + a1 * a1) + (a2 * a2 + a3 * a3) + (a4 * a4 + a5 * a5) + (a6 * a6 + a7 * a7); }
            ss = sum_g(ss);
            const float rstd = rsqrtf(ss * (1.0f / DK) + EPSN) * QSCALE;
#pragma unroll
            for (int ds = 0; ds < 6; ++ds) { const float* gn = P.nsa_q_norm + 32 * ds + 8 * A.g; const f32x4 g0 = *(const f32x4*)gn, g1 = *(const f32x4*)(gn + 4);
                u32x4 w = __builtin_bit_cast(u32x4, q[qb][ds]);
                w.x = pk2(bflo(w.x) * rstd * g0[0], bfhi(w.x) * rstd * g0[1]); w.y = pk2(bflo(w.y) * rstd * g0[2], bfhi(w.y) * rstd * g0[3]);
                w.z = pk2(bflo(w.z) * rstd * g1[0], bfhi(w.z) * rstd * g1[1]); w.w = pk2(bflo(w.w) * rstd * g1[2], bfhi(w.w) * rstd * g1[3]);
                q[qb][ds] = __builtin_bit_cast(bf16x8, w); }
        }
        f32x4 o[8][2]; float m_run[2], l_run[2];
#define RESET_STATE() do { _Pragma("unroll") for (int d_ = 0; d_ < 8; ++d_) { o[d_][0] = (f32x4){0.f, 0.f, 0.f, 0.f}; o[d_][1] = (f32x4){0.f, 0.f, 0.f, 0.f}; } m_run[0] = 0.f; m_run[1] = 0.f; l_run[0] = 0.f; l_run[1] = 0.f; } while (0)
#define GATE_SIG(x, qb) (1.0f / (1.0f + __expf(-bf1(*(const bf16_t*)(Y0c + (ytok0 + (unsigned)((qb) * (N1P * 2)) + (unsigned)((C_G + (x) * NH + hh) * 2)))))))
        RESET_STATE();
        attn_pass3x<MODE_CMPX>(lds, KCc + (size_t)bg * 256 * DK * 2, VTCc + (size_t)bg * DV * 256 * 2, 256, 0, nct, q, o, m_run, l_run, A, ATT3_HOIST != 0);
        { const float lt0 = sum_g(l_run[0]), lt1 = sum_g(l_run[1]); const float il0 = lt0 > 0.f ? 1.0f / lt0 : 0.f, il1 = lt1 > 0.f ? 1.0f / lt1 : 0.f;
          if (lane < 16) { ((LAS float*)(lds + L_IL))[(A.tokbase + 0) * 16 + A.r16] = il0; ((LAS float*)(lds + L_IL))[(A.tokbase + 1) * 16 + A.r16] = il1; }
          attn_epilogue3<false, true>(lds, lane, wid, o, GATE_SIG(0, 0) * il0, GATE_SIG(0, 1) * il1, Y0c, ytok0 + (unsigned)((C_ZC + gg * NR * DV) * 2), ONc, otok0, PROBE3_STORE2 || u_ < total); }
        __syncthreads();
        if (ATT3_HOIST) attn_issue_first(lds, KSc + (size_t)bg * SEQ * DK * 2, VTSc + (size_t)bg * DV * SEQ * 2, SEQ, 0);
        {
            const int cur = A.curblk;
            unsigned long long mk[2];
#pragma unroll
            for (int t = 0; t < 2; ++t) {
                const LAS bf16_t* X = (const LAS bf16_t*)(lds + L_X) + (2 * wid + t) * 16 * 64;
                const LAS float* IL = (const LAS float*)(lds + L_IL) + (2 * wid + t) * 16;
                const bool forced = (lane == 0) || (lane == cur) || (lane == cur - 1);
                const bool future = lane > cur;
                float v = 0.f;
                if (!forced && !future) {
#pragma unroll
                    for (int rr = 0; rr < 16; ++rr) v += IL[rr] * bf1(X[rr * 64 + lane]); }
                unsigned key = (__float_as_uint(v) & ~63u);
                if (forced) key = 0x7f800000u; else if (future) key = 0u;
                key |= (unsigned)(63 - lane);
                int rank = 0;
#pragma unroll
                for (int jp = 0; jp < 64; ++jp) { const unsigned kj = (unsigned)__builtin_amdgcn_readlane((int)key, jp); rank += (kj > key) ? 1 : 0; }
                mk[t] = __ballot(rank < 16 && !future);
            }
            A.mk0 = mk[0]; A.mk1 = mk[1];
        }
        RESET_STATE();
        attn_pass3x<MODE_SEL>(lds, KSc + (size_t)bg * SEQ * DK * 2, VTSc + (size_t)bg * DV * SEQ * 2, SEQ, 0, A.curblk + 1, q, o, m_run, l_run, A, ATT3_HOIST != 0);
        { const float lt0 = sum_g(l_run[0]), lt1 = sum_g(l_run[1]);
          attn_epilogue3<true, true>(lds, lane, wid, o, GATE_SIG(1, 0) / lt0, GATE_SIG(1, 1) / lt1, Y0c, ytok0 + (unsigned)((C_ZS + gg * NR * DV) * 2), ONc, otok0, PROBE3_STORE2 || u_ < total); }
        __syncthreads();
        RESET_STATE();
        { const int jl = (t0 - 511) > 0 ? (t0 - 511) >> 6 : 0, jh = ((t0 + 15) >> 6) + 1;
          for (int prb_ = 0; prb_ < PROBE3_WIN; ++prb_) attn_pass3x<MODE_WIN>(lds, KWc + (size_t)bg * SEQ * DK * 2, VTWc + (size_t)bg * DV * SEQ * 2, SEQ, jl, jh, q, o, m_run, l_run, A); }
        { const float lt0 = sum_g(l_run[0]), lt1 = sum_g(l_run[1]);
          attn_epilogue3<true, true, USE_FP8N ? 2 : 0>(lds, lane, wid, o, GATE_SIG(2, 0) / lt0, GATE_SIG(2, 1) / lt1, Y0c, ytok0 + (unsigned)((C_ZW + gg * NR * DV) * 2), ONc, otok0, PROBE3_STORE2 || u_ < total, (char*)(P.ws + OFF_O8N), O8N_SCALE, t0 < 256); }
#undef RESET_STATE
#undef GATE_SIG
    }
}

DI void phase_mla_attn(LAS unsigned char* lds, const Params& P, int bid, int nb) {
    const char* QMc = (const char*)(P.ws + OFF_QM); const char* KMc = (const char*)(P.ws + OFF_KM); const char* VTMc = (const char*)(P.ws + OFF_VTM);
    const char* Y1c = (const char*)(P.ws + OFF_Y1); char* OMc = (char*)(P.ws + OFF_O);
    const int total = BATCH * NH * 16;
    for (int uu = 0; bid + (uu >> 1) * nb < total / 2; ++uu) {
        int tid = threadIdx.x; asm volatile("" : "+v"(tid));
        const int lane = tid & 63, wid = __builtin_amdgcn_readfirstlane(tid >> 6);
        const int item = bid + (uu >> 1) * nb, second = uu & 1;
        const int xcd = item & 7, tt = item >> 3, p = tt & 7, hl = (tt >> 3) & 3, rnd = tt >> 5;
        const int bh = rnd * 32 + xcd * 4 + hl, qblk = second ? p : 15 - p, b = bh >> 6, h = bh & 63, t0 = qblk * 256;
        AttnLane3 A;
        A.r16 = lane & 15; A.g = lane >> 4;
        A.tw0 = t0 + 32 * wid; A.tw1 = A.tw0 + 31;
        A.lutrow = nullptr; A.curblk = 0; A.tokbase = 0; A.mk0 = 0ull; A.mk1 = 0ull; A.carry[0] = 0.f; A.carry[1] = 0.f;
        bf16x8 q[2][6];
#pragma unroll
        for (int qb = 0; qb < 2; ++qb) {
            const unsigned trow = (unsigned)(b * SEQ + A.tw0 + 16 * qb + A.r16);
            const unsigned qo = (trow * (unsigned)NQB + (unsigned)(h * DK + 8 * A.g)) * 2u;
            float ss = 0.f;
#pragma unroll
            for (int ds = 0; ds < 6; ++ds) { q[qb][ds] = *(const bf16x8*)(QMc + (qo + 64u * ds));
                const u32x4 w = __builtin_bit_cast(u32x4, q[qb][ds]);
                const float a0 = bflo(w.x), a1 = bfhi(w.x), a2 = bflo(w.y), a3 = bfhi(w.y), a4 = bflo(w.z), a5 = bfhi(w.z), a6 = bflo(w.w), a7 = bfhi(w.w);
                ss += (a0 * a0 + a1 * a1) + (a2 * a2 + a3 * a3) + (a4 * a4 + a5 * a5) + (a6 * a6 + a7 * a7); }
            ss = sum_g(ss);
            const float rstd = rsqrtf(ss * (1.0f / DK) + EPSN);
            const float* ropep = (const float*)(P.ws + OFF_ROPE) + (size_t)trow * 64;
#pragma unroll
            for (int ds = 0; ds < 4; ++ds) { const float* gn = P.mla_q_norm + 32 * ds + 8 * A.g; const f32x4 g0 = *(const f32x4*)gn, g1 = *(const f32x4*)(gn + 4);
                const float sc = rstd * QSCALE;
                u32x4 w = __builtin_bit_cast(u32x4, q[qb][ds]);
                w.x = pk2(bflo(w.x) * sc * g0[0], bfhi(w.x) * sc * g0[1]); w.y = pk2(bflo(w.y) * sc * g0[2], bfhi(w.y) * sc * g0[3]);
                w.z = pk2(bflo(w.z) * sc * g1[0], bfhi(w.z) * sc * g1[1]); w.w = pk2(bflo(w.w) * sc * g1[2], bfhi(w.w) * sc * g1[3]);
                q[qb][ds] = __builtin_bit_cast(bf16x8, w); }
            {
                const int i0 = 8 * A.g;
                const float* g1p = P.mla_q_norm + 128 + i0; const float* g2p = P.mla_q_norm + 160 + i0;
                const u32x4 w1 = __builtin_bit_cast(u32x4, q[qb][4]), w2 = __builtin_bit_cast(u32x4, q[qb][5]);
                float x1[8] = {bflo(w1.x), bfhi(w1.x), bflo(w1.y), bfhi(w1.y), bflo(w1.z), bfhi(w1.z), bflo(w1.w), bfhi(w1.w)};
                float x2[8] = {bflo(w2.x), bfhi(w2.x), bflo(w2.y), bfhi(w2.y), bflo(w2.z), bfhi(w2.z), bflo(w2.w), bfhi(w2.w)};
                float y1[8], y2[8];
#pragma unroll
                for (int e = 0; e < 8; ++e) { const float cs = ropep[i0 + e], sn = ropep[32 + i0 + e];
                    const float a = x1[e] * rstd * g1p[e], c = x2[e] * rstd * g2p[e];
                    y1[e] = (a * cs - c * sn) * QSCALE; y2[e] = (c * cs + a * sn) * QSCALE; }
                u32x4 o1, o2;
                o1.x = pk2(y1[0], y1[1]); o1.y = pk2(y1[2], y1[3]); o1.z = pk2(y1[4], y1[5]); o1.w = pk2(y1[6], y1[7]);
                o2.x = pk2(y2[0], y2[1]); o2.y = pk2(y2[2], y2[3]); o2.z = pk2(y2[4], y2[5]); o2.w = pk2(y2[6], y2[7]);
                q[qb][4] = __builtin_bit_cast(bf16x8, o1); q[qb][5] = __builtin_bit_cast(bf16x8, o2);
            }
        }
        f32x4 o[8][2]; float m_run[2] = {0.f, 0.f}, l_run[2] = {0.f, 0.f};
#pragma unroll
        for (int d = 0; d < 8; ++d) { o[d][0] = (f32x4){0.f, 0.f, 0.f, 0.f}; o[d][1] = (f32x4){0.f, 0.f, 0.f, 0.f}; }
        attn_pass3x<MODE_MLA>(lds, KMc + (size_t)bh * SEQ * DK * 2, VTMc + (size_t)bh * DV * SEQ * 2, SEQ, 0, 4 * qblk + 4, q, o, m_run, l_run, A);
        const float lt0 = sum_g(l_run[0]), lt1 = sum_g(l_run[1]);
        { const unsigned t0w = (unsigned)(b * SEQ + A.tw0);
          const unsigned zo_ = (t0w * (unsigned)N3P + (unsigned)(C3_Z + h * DV)) * 2u, oo_ = (t0w * (unsigned)ZW8 + (unsigned)(h * DV)) * 2u;
          if (USE_FP8O && qblk != 0) attn_epilogue3<false, false, 1>(lds, lane, wid, o, 1.0f / lt0, 1.0f / lt1, Y1c, zo_, OMc, oo_, true, (char*)(P.ws + OFF_O8M), O8_SCALE);
          else attn_epilogue3<false, false, 0>(lds, lane, wid, o, 1.0f / lt0, 1.0f / lt1, Y1c, zo_, OMc, oo_); }
        __syncthreads();
    }
}
constexpr int LDS_KN_OFF = 135168, LDS_ST_OFF = LDS_KN_OFF + 16384, LDS_BYTES = LDS_ST_OFF + 16;
constexpr int NPHASE = 14;

#ifndef PROBE_G1F8
#define PROBE_G1F8 0
#endif
#ifndef PROBE_G1F8_NOSTORE
#define PROBE_G1F8_NOSTORE 0
#endif
#ifndef USE_FP8M
#define USE_FP8M 0
#endif
#ifndef USE_FP8Z
#define USE_FP8Z 0
#endif
#ifndef DUP5
#define DUP5 0
#endif
#ifndef P3_GEMM_REP
#define P3_GEMM_REP 1
#endif
#ifndef P3_WCONV_REP
#define P3_WCONV_REP 1
#endif
template <int PH>
DI void run_phase(const Params& P, LAS unsigned char* lds, int bid, int nb) {
    unsigned char* ws = P.ws;
    if constexpr (PH == 0) {
        phase_wconv(lds, P.nsa_w_in, (bf16_t*)(ws + OFF_W1T), DM, N1, N1P, bid, nb, (FP8EMU & 4) ? 64.0f : 0.f, 0, USE_FP8Z ? (unsigned char*)(ws + OFF_B8) : nullptr, F8_Q0 * 256, (F8_Q0 + F8_NQ) * 256);
        phase_wconv(lds, P.w1_k, (bf16_t*)(ws + OFF_W1K), 6144, 192, 256, bid, nb);
        phase_wconv(lds, P.w1_v, (bf16_t*)(ws + OFF_W1V), 4096, 128, 256, bid, nb);
        phase_rmsnorm(P.x, P.norm_w, (bf16_t*)(ws + OFF_H), bid, nb, (FP8EMU & 4) ? 16.0f : 0.f, USE_FP8Z ? (unsigned char*)(ws + OFF_A8) : nullptr);
    } else if constexpr (PH == 1) {
        if (USE_FP8Z) {
            {
                pg8::Gemm g{(const bf16_t*)(ws + OFF_H), (const bf16_t*)(ws + OFF_W1T), MTOK, N1P, DM};
                pg8::OrderBf16Part S{nb, bid, F8_Q0, F8_NQ, N1P / 256 - F8_NQ};
                pg8::EpiStoreBf16 E{(bf16_t*)(ws + OFF_Y0), N1P};
                pg8::gemm_phase<pg8::EpiStoreBf16, pg8::OrderBf16Part, false>(lds, g, S, E, nullptr, GEMM_STAG);
            }
            __syncthreads();
            {
                pg8::Gemm g{(const bf16_t*)(ws + OFF_A8), (const bf16_t*)(ws + OFF_B8), MTOK, N1P, DM / 2};
                pg8::OrderFp8Part S{nb, bid, F8_Q0, F8_NQ, N1P / 256 - F8_NQ, (256 - ((F8_NQ * 64 + (N1P / 256 - F8_NQ) * 4) & 255)) & 255};
                for (int pr_ = PROBE_G1F8; pr_ >= 0; --pr_) {
                pg8::EpiStoreBf16Fp8 E{(bf16_t*)(ws + OFF_Y0), N1P, 1.0f / (16.0f * 64.0f), (pr_ && PROBE_G1F8_NOSTORE) ? 1 : 0};
                pg8::gemm_phase<pg8::EpiStoreBf16Fp8, pg8::OrderFp8Part, false>(lds, g, S, E, nullptr);
                if (pr_) __syncthreads();
                }
            }
        } else {
        pg8::Gemm g{(const bf16_t*)(ws + OFF_H), (const bf16_t*)(ws + OFF_W1T), MTOK, N1P, DM};
        pg8::StaticOrder S; S.init(g.M, g.N, nb, bid);
        pg8::EpiStoreBf16 E{(bf16_t*)(ws + OFF_Y0), N1P};
        pg8::gemm_phase<pg8::EpiStoreBf16, pg8::StaticOrder, false>(lds, g, S, E, nullptr);
        }
    } else if constexpr (PH == 2) {
        phase_nsa_prep(P, bid, nb);
        phase_vt(lds, (const bf16_t*)(ws + OFF_Y0), N1P, C_KVS + NG * DK, DV, NG, (bf16_t*)(ws + OFF_VTS), bid, nb);
        phase_vt(lds, (const bf16_t*)(ws + OFF_Y0), N1P, C_KVW + NG * DK, DV, NG, (bf16_t*)(ws + OFF_VTW), bid, nb);
    } else if constexpr (PH == 3) {
        for (int p3g_ = 0; p3g_ < ((bid < 32) ? P3_GEMM_REP : P3_WCONV_REP); ++p3g_) { if (p3g_) __syncthreads();
        if (bid < 16) {
            pg8::Gemm g{(const bf16_t*)(ws + OFF_ACK), (const bf16_t*)(ws + OFF_W1K), 4096, 256, 6144};
            pg8::StaticOrder S; S.init(g.M, g.N, 16, bid);
            pg8::EpiPlainF32 E{(float*)(ws + OFF_HIDK), 256};
            pg8::gemm_phase<pg8::EpiPlainF32, pg8::StaticOrder, false>(lds, g, S, E, nullptr);
        } else if (bid < 32) {
            pg8::Gemm g{(const bf16_t*)(ws + OFF_ACV), (const bf16_t*)(ws + OFF_W1V), 4096, 256, 4096};
            pg8::StaticOrder S; S.init(g.M, g.N, 16, bid - 16);
            pg8::EpiPlainF32 E{(float*)(ws + OFF_HIDV), 256};
            pg8::gemm_phase<pg8::EpiPlainF32, pg8::StaticOrder, false>(lds, g, S, E, nullptr);
        } else {
            phase_wconv(lds, P.nsa_w_out, (bf16_t*)(ws + OFF_W2T), ZW8, DM, DM, bid - 32, nb - 32, (FP8EMU & 1) ? 64.0f : 0.f, 0, USE_FP8N ? (unsigned char*)(ws + OFF_W28) : nullptr, 0);
            phase_wconv(lds, P.mla_w_in, (bf16_t*)(ws + OFF_W3T), DM, N3, N3P, bid - 32, nb - 32, (FP8EMU & 8) ? 64.0f : 0.f, 0, USE_FP8M ? (unsigned char*)(ws + OFF_B8M) : nullptr, 0, C3_Z8);
        }
        }
    } else if constexpr (PH == 4) {
        phase_cmp2(lds, P, bid, nb);
    } else if constexpr (PH == 5) {
        { float* ss1 = (float*)(ws + OFF_SS1); for (int i = bid * 512 + (int)threadIdx.x; i < MTOK; i += nb * 512) ss1[i] = 0.f; }
        phase_nsa_attn(lds, P, bid, nb);
    } else if constexpr (PH == 6) {
        if (USE_FP8N) {
            {
                pg8::Gemm g{(const bf16_t*)(ws + OFF_O), (const bf16_t*)(ws + OFF_W2T), MTOK, DM, ZW8};
                pg8::OrderBf16Part S{nb, bid, 0, 0, DM / 256};
                pg8::EpiResNorm E{P.x, P.out, DM, P.norm_w + DM, (bf16_t*)(ws + OFF_H), (float*)(ws + OFF_SS1), USE_FP8M ? (unsigned char*)(ws + OFF_A8M) : nullptr, 1.0f};
                pg8::gemm_phase<pg8::EpiResNorm, pg8::OrderBf16Part, false>(lds, g, S, E, nullptr);
            }
            __syncthreads();
            {
                pg8::Gemm g{(const bf16_t*)(ws + OFF_O8N), (const bf16_t*)(ws + OFF_W28), MTOK, DM, ZW8 / 2};
                pg8::OrderFp8Part S{nb, bid, 0, 0, DM / 256, 192};
                pg8::EpiResNormFp8 E{P.x, P.out, DM, P.norm_w + DM, (bf16_t*)(ws + OFF_H), (float*)(ws + OFF_SS1), USE_FP8M ? (unsigned char*)(ws + OFF_A8M) : nullptr, 1.0f / (O8N_SCALE * 64.0f)};
                pg8::gemm_phase<pg8::EpiResNormFp8, pg8::OrderFp8Part, false>(lds, g, S, E, nullptr);
            }
        } else {
        pg8::Gemm g{(const bf16_t*)(ws + OFF_O), (const bf16_t*)(ws + OFF_W2T), MTOK, DM, ZW8};
        pg8::StaticOrder S; S.init(g.M, g.N, nb, bid);
        pg8::EpiResNorm E{P.x, P.out, DM, P.norm_w + DM, (bf16_t*)(ws + OFF_H), (float*)(ws + OFF_SS1), USE_FP8M ? (unsigned char*)(ws + OFF_A8M) : nullptr, 1.0f};
        pg8::gemm_phase<pg8::EpiResNorm, pg8::StaticOrder, false>(lds, g, S, E, nullptr);
        }
    } else if constexpr (PH == 7) {
        phase_rmsnorm(P.out, P.norm_w + DM, (bf16_t*)(ws + OFF_H), bid, nb, (FP8EMU & 8) ? 16.0f : 0.f);
    } else if constexpr (PH == 8) {
        if (USE_FP8M) {
            {
                pg8::Gemm g{(const bf16_t*)(ws + OFF_H), (const bf16_t*)(ws + OFF_W3T), MTOK, N3P, DM};
                pg8::OrderBf16Part S{nb, bid, 0, C3_Z8 / 256, NZ8M / 256};
                pg8::EpiStoreBf16RowScale E{(bf16_t*)(ws + OFF_Y1), N3P, (const float*)(ws + OFF_SS1), 1.0f / DM};
                pg8::gemm_phase<pg8::EpiStoreBf16RowScale, pg8::OrderBf16Part, false>(lds, g, S, E, nullptr);
            }
            __syncthreads();
            {
                pg8::Gemm g{(const bf16_t*)(ws + OFF_A8M), (const bf16_t*)(ws + OFF_B8M), MTOK, N3P, DM / 2};
                pg8::OrderFp8Part S{nb, bid, 0, C3_Z8 / 256, NZ8M / 256, 64};
                pg8::EpiStoreBf16RowScaleFp8 E{(bf16_t*)(ws + OFF_Y1), N3P, (const float*)(ws + OFF_SS1), 1.0f / DM, 1.0f / (16.0f * 64.0f)};
                pg8::gemm_phase<pg8::EpiStoreBf16RowScaleFp8, pg8::OrderFp8Part, false>(lds, g, S, E, nullptr);
            }
        } else {
        pg8::Gemm g{(const bf16_t*)(ws + OFF_H), (const bf16_t*)(ws + OFF_W3T), MTOK, N3P, DM};
        pg8::StaticOrder S; S.init(g.M, g.N, nb, bid);
        pg8::EpiStoreBf16RowScale E{(bf16_t*)(ws + OFF_Y1), N3P, (const float*)(ws + OFF_SS1), 1.0f / DM};
        pg8::gemm_phase<pg8::EpiStoreBf16RowScale, pg8::StaticOrder, false>(lds, g, S, E, nullptr);
        }
        __syncthreads();
        if (bid >= 64 && nb > 64) {
            phase_wconv(lds, P.mla_w_q_b, (bf16_t*)(ws + OFF_W4T), QLORA, NQB, NQB, bid - 64, nb - 64, 0.f, 0, USE_FP8Q ? (unsigned char*)(ws + OFF_W48) : nullptr, 0);
            phase_wconv(lds, P.mla_w_kv_b, (bf16_t*)(ws + OFF_W5K), KVLORA, NKVB / 2, NKVB / 2, bid - 64, nb - 64, 0.f, 2);
            phase_wconv(lds, P.mla_w_kv_b, (bf16_t*)(ws + OFF_W5V), KVLORA, NKVB / 2, NKVB / 2, bid - 64, nb - 64, 0.f, 1);
            phase_wconv(lds, P.mla_w_out, (bf16_t*)(ws + OFF_W6T), ZW8, DM, DM, bid - 64, nb - 64, (FP8EMU & 2) ? 64.0f : 0.f, 0, USE_FP8O ? (unsigned char*)(ws + OFF_W68) : nullptr, 0);
        } else if (nb <= 64) {
            phase_wconv(lds, P.mla_w_q_b, (bf16_t*)(ws + OFF_W4T), QLORA, NQB, NQB, bid, nb, 0.f, 0, USE_FP8Q ? (unsigned char*)(ws + OFF_W48) : nullptr, 0);
            phase_wconv(lds, P.mla_w_kv_b, (bf16_t*)(ws + OFF_W5K), KVLORA, NKVB / 2, NKVB / 2, bid, nb, 0.f, 2);
            phase_wconv(lds, P.mla_w_kv_b, (bf16_t*)(ws + OFF_W5V), KVLORA, NKVB / 2, NKVB / 2, bid, nb, 0.f, 1);
            phase_wconv(lds, P.mla_w_out, (bf16_t*)(ws + OFF_W6T), ZW8, DM, DM, bid, nb, (FP8EMU & 2) ? 64.0f : 0.f, 0, USE_FP8O ? (unsigned char*)(ws + OFF_W68) : nullptr, 0);
        }
    } else if constexpr (PH == 9) {
        phase_mla_prep1(P, bid, nb);
    } else if constexpr (PH == 10) {
        if (USE_FP8Q) {
            {
                pg8::Gemm g{(const bf16_t*)(ws + OFF_CQN), (const bf16_t*)(ws + OFF_W4T), MTOK, NQB, QLORA};
                pg8::OrderBf16Part S{nb, bid, 0, 0, NQB / 256};
                pg8::EpiStoreBf16 E{(bf16_t*)(ws + OFF_QM), NQB};
                pg8::gemm_phase<pg8::EpiStoreBf16, pg8::OrderBf16Part, false>(lds, g, S, E, nullptr);
            }
            __syncthreads();
            {
                pg8::Gemm g{(const bf16_t*)(ws + OFF_CQN8), (const bf16_t*)(ws + OFF_W48), MTOK, NQB, QLORA / 2};
                pg8::OrderFp8Part S{nb, bid, 0, 0, NQB / 256, 64};
                pg8::EpiStoreBf16Fp8 E{(bf16_t*)(ws + OFF_QM), NQB, 1.0f / (16.0f * 64.0f)};
                pg8::gemm_phase<pg8::EpiStoreBf16Fp8, pg8::OrderFp8Part, false>(lds, g, S, E, nullptr);
            }
        } else {
            pg8::Gemm g{(const bf16_t*)(ws + OFF_CQN), (const bf16_t*)(ws + OFF_W4T), MTOK, NQB, QLORA};
            pg8::StaticOrder S; S.init(g.M, g.N, nb, bid);
            pg8::EpiStoreBf16 E{(bf16_t*)(ws + OFF_QM), NQB};
            pg8::gemm_phase<pg8::EpiStoreBf16, pg8::StaticOrder, false>(lds, g, S, E, nullptr);
        }
        __syncthreads();
        {
            pg8::Gemm g{(const bf16_t*)(ws + OFF_CKVN), (const bf16_t*)(ws + OFF_W5K), MTOK, NKVB / 2, KVLORA};
            pg8::StaticOrder S; S.init(g.M, g.N, nb, bid);
            pg8::EpiKNorm E{(bf16_t*)(ws + OFF_KM), (const float*)(ws + OFF_SSPE), (const float*)(ws + OFF_KPER), P.mla_k_norm, (LAS float*)(lds + LDS_KN_OFF), 0u};
            pg8::gemm_phase<pg8::EpiKNorm, pg8::StaticOrder, false>(lds, g, S, E, nullptr);
        }
        __syncthreads();
        {
            pg8::Gemm g{(const bf16_t*)(ws + OFF_W5V), (const bf16_t*)(ws + OFF_CKVN), NKVB / 2, MTOK, KVLORA};
            pg8::StaticOrder S; S.init(g.M, g.N, nb, bid);
            pg8::EpiVT E{(bf16_t*)(ws + OFF_VTM)};
            pg8::gemm_phase<pg8::EpiVT, pg8::StaticOrder, false>(lds, g, S, E, nullptr);
        }
    } else if constexpr (PH == 11) {
    } else if constexpr (PH == 12) {
        phase_mla_attn(lds, P, bid, nb);
    } else if constexpr (PH == 13) {
        if (USE_FP8O) {
            {
                pg8::Gemm g{(const bf16_t*)(ws + OFF_O), (const bf16_t*)(ws + OFF_W6T), MTOK, DM, ZW8};
                pg8::OrderBf16Part S{nb, bid, 0, 0, DM / 256};
                pg8::EpiResF32 E{P.out, P.out, DM};
                pg8::gemm_phase<pg8::EpiResF32, pg8::OrderBf16Part, false>(lds, g, S, E, nullptr);
            }
            __syncthreads();
            {
                pg8::Gemm g{(const bf16_t*)(ws + OFF_O8M), (const bf16_t*)(ws + OFF_W68), MTOK, DM, ZW8 / 2};
                pg8::OrderFp8Part S{nb, bid, 0, 0, DM / 256, 192};
                pg8::EpiResF32Fp8 E{P.out, P.out, DM, 1.0f / (O8_SCALE * 64.0f)};
                pg8::gemm_phase<pg8::EpiResF32Fp8, pg8::OrderFp8Part, false>(lds, g, S, E, nullptr);
            }
        } else {
        pg8::Gemm g{(const bf16_t*)(ws + OFF_O), (const bf16_t*)(ws + OFF_W6T), MTOK, DM, ZW8};
        pg8::StaticOrder S; S.init(g.M, g.N, nb, bid);
        pg8::EpiResF32 E{P.out, P.out, DM};
        pg8::gemm_phase<pg8::EpiResF32, pg8::StaticOrder, false>(lds, g, S, E, nullptr);
        }
    }
}

#ifndef REP0
#define REP0 1
#endif
#ifndef REP1
#define REP1 1
#endif
#ifndef REP2
#define REP2 1
#endif
#ifndef REP3
#define REP3 1
#endif
#ifndef REP4
#define REP4 1
#endif
#ifndef REP5
#define REP5 1
#endif
#ifndef REP6
#define REP6 1
#endif
#ifndef REP7
#define REP7 1
#endif
#ifndef REP8
#define REP8 1
#endif
#ifndef REP9
#define REP9 1
#endif
#ifndef REP10
#define REP10 1
#endif
#ifndef REP11
#define REP11 1
#endif
#ifndef REP12
#define REP12 1
#endif
#ifndef REP13
#define REP13 1
#endif

__global__ __launch_bounds__(512, 2) void k_mega(Params P) {
    extern __shared__ __attribute__((aligned(16))) unsigned char shm[];
    LAS unsigned char* lds = (LAS unsigned char*)shm;
    volatile LAS unsigned* st = (volatile LAS unsigned*)(lds + LDS_ST_OFF);
    if (threadIdx.x == 0) { st[0] = 0u; st[1] = 0u; st[2] = 0u; st[3] = 0u; }
    __syncthreads();
    XcdBarrier bar = xcd_barrier_post((unsigned*)(P.ws + OFF_CTL), st);
    const int bid = (int)blockIdx.x, nb = (int)gridDim.x;
    for (int rep_ = 0; rep_ < REP0; ++rep_) run_phase<0>(P, lds, bid, nb);  xcd_barrier(bar);
    for (int rep_ = 0; rep_ < REP1; ++rep_) run_phase<1>(P, lds, bid, nb);  xcd_barrier(bar);
    for (int rep_ = 0; rep_ < REP2; ++rep_) run_phase<2>(P, lds, bid, nb);  xcd_barrier(bar);
    for (int rep_ = 0; rep_ < REP3; ++rep_) run_phase<3>(P, lds, bid, nb);  xcd_barrier(bar);
    for (int rep_ = 0; rep_ < REP4; ++rep_) run_phase<4>(P, lds, bid, nb);  xcd_barrier(bar);
    for (int rep_ = 0; rep_ < REP5; ++rep_) run_phase<5>(P, lds, bid, nb);
#if DUP5
    __syncthreads(); run_phase<5>(P, lds, bid, nb);
#endif
    xcd_barrier(bar);
    for (int rep_ = 0; rep_ < REP6; ++rep_) run_phase<6>(P, lds, bid, nb);  xcd_barrier(bar);
    for (int rep_ = 0; rep_ < REP8; ++rep_) run_phase<8>(P, lds, bid, nb);  xcd_barrier(bar);
    for (int rep_ = 0; rep_ < REP9; ++rep_) run_phase<9>(P, lds, bid, nb);  xcd_barrier(bar);
    for (int rep_ = 0; rep_ < REP10; ++rep_) run_phase<10>(P, lds, bid, nb); xcd_barrier(bar);
    for (int rep_ = 0; rep_ < REP12; ++rep_) run_phase<12>(P, lds, bid, nb); xcd_barrier(bar);
    for (int rep_ = 0; rep_ < REP13; ++rep_) run_phase<13>(P, lds, bid, nb);
}

extern "C" void kernel_launch(void* const* d_in, const int* in_sizes, int n_in, void* d_out, int out_size, void* d_ws, size_t ws_size, hipStream_t stream) {
    (void)in_sizes; (void)n_in; (void)out_size;
    if (ws_size < WS_END) return;
    Params P{};
    P.x = (const float*)d_in[0]; P.pos = (const int*)d_in[1]; P.norm_w = (const float*)d_in[2]; P.rel_bias = (const float*)d_in[3];
    P.nsa_w_in = (const float*)d_in[4]; P.nsa_q_norm = (const float*)d_in[5]; P.nsa_k_norm = (const float*)d_in[6]; P.pe_k = (const float*)d_in[7];
    P.w1_k = (const float*)d_in[8]; P.w2_k = (const float*)d_in[9]; P.pe_v = (const float*)d_in[10]; P.w1_v = (const float*)d_in[11]; P.w2_v = (const float*)d_in[12];
    P.nsa_w_out = (const float*)d_in[13]; P.mla_w_in = (const float*)d_in[14]; P.mla_q_a_norm = (const float*)d_in[15]; P.mla_w_q_b = (const float*)d_in[16];
    P.mla_kv_a_norm = (const float*)d_in[17]; P.mla_w_kv_b = (const float*)d_in[18]; P.mla_q_norm = (const float*)d_in[19]; P.mla_k_norm = (const float*)d_in[20];
    P.mla_w_out = (const float*)d_in[21];
    P.out = (float*)d_out; P.ws = (unsigned char*)d_ws;
    static int grid = 0;
    if (!grid) {
        int dev = 0, cus = 0, per_cu = 0; (void)hipGetDevice(&dev);
        if (hipDeviceGetAttribute(&cus, hipDeviceAttributeMultiprocessorCount, dev) != hipSuccess || cus <= 0) cus = 256;
        (void)hipFuncSetAttribute((const void*)k_mega, hipFuncAttributeMaxDynamicSharedMemorySize, LDS_BYTES);
        if (hipOccupancyMaxActiveBlocksPerMultiprocessor(&per_cu, k_mega, 512, LDS_BYTES) != hipSuccess || per_cu < 1) per_cu = 1;
        grid = cus;
    }
    (void)hipMemsetAsync((unsigned char*)d_ws + OFF_CTL, 0, XCD_BAR_WORDS * sizeof(unsigned), stream);
    hipLaunchKernelGGL(k_mega, dim3(grid), dim3(512), LDS_BYTES, stream, P);
}
```

```cpp
#define ATT16 1
#define USE_FP8Z 1
#define USE_FP8M 1
#define USE_FP8O 1
#define USE_FP8N 1
#define USE_FP8Q 1
#define F8_Q0 0
#define F8_NQ 53
#define GEMM_NT 1
#include <hip/hip_runtime.h>
#include <stdint.h>
#include <stddef.h>

#define DI __device__ __forceinline__
#define LAS __attribute__((address_space(3)))
typedef unsigned short bf16_t;
typedef short bf16x8 __attribute__((ext_vector_type(8)));
typedef float f32x4 __attribute__((ext_vector_type(4)));
typedef float f32x16 __attribute__((ext_vector_type(16)));
typedef unsigned u32x4 __attribute__((ext_vector_type(4)));
typedef unsigned u32x2 __attribute__((ext_vector_type(2)));
typedef __bf16 bf2_t __attribute__((ext_vector_type(2)));
typedef float f2_t __attribute__((ext_vector_type(2)));

DI int tid_opaque() { int t = (int)threadIdx.x; asm volatile("" : "+v"(t)); return t; }
DI unsigned pk2(float a, float b) { f2_t f = {a, b}; bf2_t v = __builtin_convertvector(f, bf2_t); return __builtin_bit_cast(unsigned, v); }
DI float clamp_fp8(float v) { float r; asm("v_max_f32 %0, 0xc3e00000, %1\n\tv_min_f32 %0, 0x43e00000, %0" : "=v"(r) : "v"(v)); return r; }
DI unsigned pk4_fp8(float a, float b, float c, float d) { a = clamp_fp8(a); b = clamp_fp8(b); c = clamp_fp8(c); d = clamp_fp8(d); int w = 0; w = __builtin_amdgcn_cvt_pk_fp8_f32(a, b, w, false); w = __builtin_amdgcn_cvt_pk_fp8_f32(c, d, w, true); return (unsigned)w; }
DI unsigned pk4_fp8c(float a, float b, float c, float d) { return pk4_fp8(a, b, c, d); }
DI float bflo(unsigned w) { return __uint_as_float(w << 16); }
DI float bfhi(unsigned w) { return __uint_as_float(w & 0xffff0000u); }
#ifndef USE_FP8KV
#define USE_FP8KV 0
#endif
#ifndef USE_FP8Q
#define USE_FP8Q 0
#endif
#ifndef USE_FP8N
#define USE_FP8N 0
#endif
#ifndef USE_FP8O
#define USE_FP8O 0
#endif
#ifndef GEMM_STAG
#define GEMM_STAG 0
#endif
#ifndef GEMM_NT
#define GEMM_NT 0
#endif
#ifndef FP8EMU
#define FP8EMU 0
#endif
DI float emu_q8(float x, float s) { float y = x * s; const float ay = fabsf(y);
    if (ay < 0.015625f) y = rintf(y * 512.0f) * (1.0f / 512.0f);
    else { unsigned u = __float_as_uint(y); u = (u + 0x0007FFFFu + ((u >> 20) & 1u)) & 0xFFF00000u; y = __uint_as_float(u); }
    y = fminf(fmaxf(y, -448.0f), 448.0f); return y / s; }
DI float bf1(bf16_t h) { return __uint_as_float(((unsigned)h) << 16); }

#ifndef ATT16
#define ATT16 0
#endif
DI int vt_key_of_pos(int p) {
#if ATT16
    return (p & ~31) | (((p >> 2) & 1) << 4) | (((p >> 3) & 3) << 2) | (p & 3);
#else
    return (p & ~0xC) | ((p & 4) << 1) | ((p & 8) >> 1);
#endif
}
DI int vt_pos_of_key(int k) {
#if ATT16
    return (k & ~31) | (((k >> 2) & 3) << 3) | (((k >> 4) & 1) << 2) | (k & 3);
#else
    return (k & ~0xC) | ((k & 4) << 1) | ((k & 8) >> 1);
#endif
}
constexpr int BATCH = 4, SEQ = 4096, DM = 4096, MTOK = BATCH * SEQ;
constexpr int NH = 64, NG = 4, NR = 16, DK = 192, DV = 128;
constexpr int N1 = 40896, N1P = 40960;
constexpr int C_Q = 0, C_KVC = 12288, C_KVS = 13568, C_KVW = 14848, C_ZC = 16128, C_ZS = 24320, C_ZW = 32512, C_G = 40704;
constexpr int N3 = 10304, N3P = 10496;
constexpr int C3_CQ = 0, C3_CKV = 1536, C3_KPE = 2048, C3_Z = 2112;
constexpr int QLORA = 1536, KVLORA = 512;
constexpr int NQB = 12288, NKVB = 16384, ZW8 = 8192;
constexpr float EPSN = 1e-6f;
constexpr float LOG2E = 1.4426950408889634f;
constexpr float QSCALE = 0.07216878364870322f * 1.4426950408889634f;

constexpr size_t SZ_W1T = (size_t)N1P * DM * 2, SZ_W2T = (size_t)DM * ZW8 * 2, SZ_W3T = (size_t)N3P * DM * 2, SZ_W4T = (size_t)NQB * QLORA * 2,
                 SZ_W5T = (size_t)NKVB * KVLORA * 2, SZ_W6T = (size_t)DM * ZW8 * 2;
constexpr size_t OFF_W1T = 0, OFF_W2T = OFF_W1T + SZ_W1T, OFF_W3T = OFF_W2T + SZ_W2T, OFF_W4T = OFF_W3T + SZ_W3T, OFF_W5T = OFF_W4T + SZ_W4T,
                 OFF_W6T = OFF_W5T + SZ_W5T, OFF_W1K = OFF_W6T + SZ_W6T;
constexpr size_t OFF_W5K = OFF_W5T, OFF_W5V = OFF_W5T + SZ_W5T / 2;
constexpr size_t SZ_W1K = (size_t)256 * 6144 * 2, SZ_W1V = (size_t)256 * 4096 * 2;
constexpr size_t OFF_W1V = OFF_W1K + SZ_W1K, OFF_CTL = OFF_W1V + SZ_W1V, OFF_H = OFF_CTL + 65536;
constexpr size_t SZ_H = (size_t)MTOK * DM * 2, SZ_KS = (size_t)BATCH * NG * SEQ * DK * 2, SZ_VTS = (size_t)BATCH * NG * DV * SEQ * 2,
                 SZ_ACK = (size_t)4096 * 6144 * 2, SZ_ACV = (size_t)4096 * 4096 * 2;
constexpr size_t OFF_KS = OFF_H + SZ_H, OFF_KW = OFF_KS + SZ_KS, OFF_VTS = OFF_KW + SZ_KS, OFF_VTW = OFF_VTS + SZ_VTS, OFF_ACK = OFF_VTW + SZ_VTS,
                 OFF_ACV = OFF_ACK + SZ_ACK, OFF_KC = OFF_ACV + SZ_ACV;
constexpr size_t SZ_KC = (size_t)16 * 256 * DK * 2, SZ_VTC = (size_t)16 * DV * 256 * 2, SZ_HID = (size_t)4096 * 256 * 4;
constexpr size_t OFF_VTC = OFF_KC + SZ_KC, OFF_HIDK = OFF_VTC + SZ_VTC, OFF_HIDV = OFF_HIDK + SZ_HID, OFF_Y0 = OFF_HIDV + SZ_HID;
constexpr size_t SZ_Y0 = (size_t)MTOK * N1P * 2, SZ_O = (size_t)MTOK * ZW8 * 2;
constexpr size_t OFF_O = OFF_Y0 + SZ_Y0, WS_END = OFF_O + SZ_O;
constexpr size_t OFF_SS1 = OFF_HIDK;
constexpr size_t OFF_A8 = OFF_O, OFF_B8 = OFF_O + (size_t)MTOK * DM;
#ifndef F8_Q0
#define F8_Q0 0
#define F8_NQ 63
#endif
constexpr size_t OFF_B8M = OFF_W1T, OFF_A8M = OFF_W1T + (64ull << 20);
constexpr int C3_Z8 = 2304, NZ8M = 8192;
constexpr size_t OFF_W28 = OFF_W1T + (132ull << 20), OFF_O8N = OFF_W1T + (168ull << 20);
static_assert(OFF_O8N + (size_t)MTOK * ZW8 <= OFF_W1T + SZ_W1T, "fp8 NSA out-proj buffers");
constexpr float O8N_SCALE = 64.0f;
constexpr float O8_SCALE = 128.0f;
constexpr size_t OFF_KM = 0;
constexpr size_t SZ_KM = (size_t)BATCH * NH * SEQ * DK * 2;
static_assert(SZ_KM <= SZ_W1T + SZ_W2T, "KM alias");
constexpr size_t OFF_VTM = OFF_H;
constexpr size_t SZ_VTM = (size_t)BATCH * NH * DV * SEQ * 2;
constexpr size_t OFF_CKVN = OFF_VTM + SZ_VTM;
constexpr size_t SZ_CKVN = (size_t)MTOK * KVLORA * 2;
static_assert(OFF_CKVN + SZ_CKVN <= OFF_KC, "CKVN alias");
constexpr size_t OFF_Y1 = OFF_Y0, SZ_Y1 = (size_t)MTOK * N3P * 2;
constexpr size_t OFF_QM = OFF_Y1 + SZ_Y1, SZ_QM = (size_t)MTOK * NQB * 2;
constexpr size_t OFF_KVM = OFF_QM + SZ_QM, SZ_KVM = (size_t)MTOK * NKVB * 2;
constexpr size_t OFF_KNM = OFF_KVM;
constexpr size_t OFF_KPER = OFF_KVM, OFF_SSPE = OFF_KVM + (size_t)MTOK * 64 * 4;
constexpr size_t OFF_O8M = OFF_KVM + SZ_KVM / 2, OFF_W68 = OFF_O8M + (size_t)MTOK * ZW8;
constexpr size_t OFF_W48 = OFF_W68 + (size_t)DM * ZW8, OFF_CQN8 = OFF_W48 + (size_t)NQB * QLORA;
constexpr size_t OFF_CKVN8 = OFF_CQN8 + (size_t)MTOK * QLORA, OFF_W5K8 = OFF_CKVN8 + (size_t)MTOK * KVLORA, OFF_W5V8 = OFF_W5K8 + (size_t)(NKVB / 2) * KVLORA;
static_assert(OFF_W5V8 + (size_t)(NKVB / 2) * KVLORA <= OFF_KVM + SZ_KVM, "fp8 MLA buffers");
constexpr size_t OFF_CQN = OFF_KVM + SZ_KVM, SZ_CQN = (size_t)MTOK * QLORA * 2;
constexpr size_t OFF_ROPE = OFF_CQN + SZ_CQN, SZ_ROPE = (size_t)MTOK * 64 * 4;
static_assert(OFF_ROPE + SZ_ROPE <= OFF_O, "layer-1 alias region");
static_assert(WS_END <= 2680160256ull, "workspace");

struct Params {
    const float* x; const int* pos; const float* norm_w; const float* rel_bias;
    const float* nsa_w_in; const float* nsa_q_norm; const float* nsa_k_norm; const float* pe_k; const float* w1_k; const float* w2_k;
    const float* pe_v; const float* w1_v; const float* w2_v; const float* nsa_w_out;
    const float* mla_w_in; const float* mla_q_a_norm; const float* mla_w_q_b; const float* mla_kv_a_norm; const float* mla_w_kv_b;
    const float* mla_q_norm; const float* mla_k_norm; const float* mla_w_out;
    float* out; unsigned char* ws;
};

#define XB_TMO      128
#define XB_XCNT(j)  (256  + 64 * (j))
#define XB_XSUB(j)  (1280 + 64 * (j))
#define XB_XGEN(j)  (2304 + 64 * (j))
#define XB_TOP      3328
#define XB_TOPGEN   3392
#define XCD_BAR_WORDS 3456
#define XB_SPIN_CAP (1u << 18)

__device__ __forceinline__ unsigned xb_ld(unsigned* p)              { return __hip_atomic_load(p, __ATOMIC_RELAXED, __HIP_MEMORY_SCOPE_AGENT); }
__device__ __forceinline__ unsigned xb_add(unsigned* p, unsigned v) { return __hip_atomic_fetch_add(p, v, __ATOMIC_RELAXED, __HIP_MEMORY_SCOPE_AGENT); }
__device__ __forceinline__ unsigned xb_xcc_id() { return (unsigned)__builtin_amdgcn_s_getreg((3 << 11) | 20) & 0xFu; }
#define XB_SPIN(cond, bar) do { unsigned _sp = 0; while (cond) { __builtin_amdgcn_s_sleep(1); \
    if ((++_sp & 255u) == 0u) { if (xb_ld(&(bar)[XB_TMO])) break; if (_sp > XB_SPIN_CAP) { atomicAdd(&(bar)[XB_TMO], 1u); break; } } } } while (0)

struct XcdBarrier {
    unsigned* bar; unsigned x;
    volatile LAS unsigned* st;
};

__device__ __forceinline__ XcdBarrier xcd_barrier_post(unsigned* bar, volatile LAS unsigned* st) {
    XcdBarrier b; b.bar = bar; b.x = xb_xcc_id(); b.st = st;
    if (threadIdx.x == 0) (void)xb_add(&bar[XB_XCNT(b.x)], 1u);
    return b;
}
__device__ __forceinline__ void xcd_barrier_complete(unsigned* bar, unsigned x, unsigned& nloc, unsigned& nx) {
    const unsigned G = gridDim.x * gridDim.y * gridDim.z;
    unsigned sum, cnt, mine, sp = 0u;
    for (;;) {
        sum = 0u; cnt = 0u; mine = 0u;
#pragma unroll
        for (unsigned j = 0; j < 16; ++j) { const unsigned c = xb_ld(&bar[XB_XCNT(j)]); sum += c; cnt += (c > 0u) ? 1u : 0u; mine = (j == x) ? c : mine; }
        if (sum == G) break;
        __builtin_amdgcn_s_sleep(1);
        if ((++sp & 255u) == 0u) { if (xb_ld(&bar[XB_TMO])) break; if (sp > XB_SPIN_CAP) { atomicAdd(&bar[XB_TMO], 1u); break; } }
    }
    nloc = mine > 0u ? mine : 1u; nx = cnt > 0u ? cnt : 1u;
}

__device__ __forceinline__ void xcd_barrier(const XcdBarrier& b) {
    asm volatile("s_waitcnt vmcnt(0)" ::: "memory");
    __syncthreads();
    if (threadIdx.x == 0) {
        unsigned* bar = b.bar;
        __builtin_amdgcn_s_waitcnt(0);
        unsigned nloc = b.st[0], nx = b.st[1];
        if (nloc == 0u) { xcd_barrier_complete(bar, b.x, nloc, nx); b.st[0] = nloc; b.st[1] = nx; }
        const unsigned old = xb_add(&bar[XB_XSUB(b.x)], 1u);
        const unsigned gen = old / nloc;
        if (old + 1u == (gen + 1u) * nloc) {
            __builtin_amdgcn_fence(__ATOMIC_RELEASE, "agent");
            asm volatile("s_waitcnt vmcnt(0)" ::: "memory");
            const unsigned og = xb_add(&bar[XB_TOP], 1u);
            const unsigned tg = og / nx;
            if (og + 1u == (tg + 1u) * nx) xb_add(&bar[XB_TOPGEN], 1u);
            else XB_SPIN(xb_ld(&bar[XB_TOPGEN]) == tg, bar);
            __builtin_amdgcn_fence(__ATOMIC_ACQUIRE, "agent");
            xb_add(&bar[XB_XGEN(b.x)], 1u);
            asm volatile("s_waitcnt vmcnt(0)" ::: "memory");
        } else {
            XB_SPIN(xb_ld(&bar[XB_XGEN(b.x)]) == gen, bar);
            __builtin_amdgcn_fence(__ATOMIC_ACQUIRE, "agent");
            asm volatile("s_waitcnt vmcnt(0)" ::: "memory");
        }
    }
    __syncthreads();
}

namespace pg8 {
#define PG8_LAS __attribute__((address_space(3)))
typedef unsigned short bf16_t;
typedef short bf16x8 __attribute__((ext_vector_type(8)));
typedef float f32x4 __attribute__((ext_vector_type(4)));
typedef unsigned u32x4 __attribute__((ext_vector_type(4)));
typedef int i32x8_t __attribute__((ext_vector_type(8)));
typedef int i32x4_t __attribute__((ext_vector_type(4)));
constexpr int BM = 256, BK = 64, HALF = 128, HTB = HALF * BK * 2  , STAGE_BYTES = 8 * HTB, NXCD = 8, WGM = 8;

__host__ __device__ __forceinline__ int lds_byte(int r, int c) { const int st = (r >> 4) * 2 + (c >> 5), rr = r & 15, cc = c & 31, ob = rr * 64 + cc * 2; return st * 1024 + (ob ^ (((ob >> 9) & 1) << 5)); }
__host__ __device__ __forceinline__ void stage_rc(int b, int& R, int& C) { const int st = b / 1024, sb = b % 1024, swz = sb ^ (((sb >> 9) & 1) << 5); R = (st >> 1) * 16 + swz / 64; C = (st & 1) * 32 + (swz % 64) / 2; }
__host__ __device__ __forceinline__ int perm32(int rho) { const int n = rho >> 4, i = rho & 15; return 8 * (i >> 2) + 4 * n + (i & 3); }

struct Unit { int pm, pn; };
struct Gemm { const bf16_t* A; const bf16_t* Bt; int M, N, K; };

struct StaticOrder {
    int nM, nN, nwg, G, c;
    __host__ __device__ void init(int M, int N, int G_, int c_) { nM = M / BM; nN = N / BM; nwg = nM * nN; G = G_; c = c_; }
    __host__ __device__ bool next(int i, Unit& u) const {
        const long L = (long)i * G + c; if (L >= nwg) return false;
        int wgid = (int)L; { const int q = nwg / NXCD, r = nwg % NXCD, xcd = wgid % NXCD, off = wgid / NXCD; wgid = (xcd < r ? xcd * (q + 1) : r * (q + 1) + (xcd - r) * q) + off; }
        const int nig = WGM * nN, gid = wgid / nig, fm = gid * WGM, gsz = (nM - fm) < WGM ? (nM - fm) : WGM;
        u.pm = fm + ((wgid % nig) % gsz); u.pn = (wgid % nig) / gsz; return true;
    }
    __device__ __forceinline__ void a_ready(const Unit&) const {}
    __device__ __forceinline__ void done(const Unit&) const {}
};
#if GEMM_NT
#define EPI_ST16(p, w) __builtin_nontemporal_store((w), (u32x4*)(p))
#else
#define EPI_ST16(p, w) (*(u32x4*)(p) = (w))
#endif
struct EpiStoreBf16 {
    static constexpr bool PERM = true, AFTER_DRAIN = false, SWAP23 = false, FP8 = false;
    bf16_t* O; int ldc;
    __device__ __forceinline__ void operator()(const f32x4 (&acc)[2][2][4][2], const Unit& u, int wr, int wc, int fr, int fq) const {
        const int row0 = u.pm * BM + wr * 64 + fr; const int col0 = u.pn * BM + wc * 32 + 8 * fq;
#pragma unroll
        for (int ai = 0; ai < 2; ++ai)
#pragma unroll
            for (int m = 0; m < 4; ++m) { bf16_t* rowp = O + (size_t)(row0 + ai * HALF + m * 16) * ldc + col0;
#pragma unroll
                for (int bj = 0; bj < 2; ++bj) { const f32x4 v0 = acc[ai][bj][m][0], v1 = acc[ai][bj][m][1];
                    u32x4 w; w.x = pk2(v0[0], v0[1]); w.y = pk2(v0[2], v0[3]); w.z = pk2(v1[0], v1[1]); w.w = pk2(v1[2], v1[3]);
                    EPI_ST16(rowp + bj * HALF, w); } }
    }
};
struct EpiResF32 {
    static constexpr bool PERM = false, AFTER_DRAIN = false, SWAP23 = false, FP8 = false;
    const float* base; float* out; int ldc;
    __device__ __forceinline__ void operator()(const f32x4 (&acc)[2][2][4][2], const Unit& u, int wr, int wc, int fr, int fq) const {
        const int row0 = u.pm * BM + wr * 64 + fr, col0 = u.pn * BM + wc * 32 + 4 * fq;
#pragma unroll
        for (int ai = 0; ai < 2; ++ai)
#pragma unroll
            for (int m = 0; m < 4; ++m) { const size_t off = (size_t)(row0 + ai * HALF + m * 16) * ldc + col0;
#pragma unroll
                for (int bj = 0; bj < 2; ++bj)
#pragma unroll
                    for (int n = 0; n < 2; ++n) { const f32x4 bs = *(const f32x4*)(base + off + bj * HALF + n * 16);
                        *(f32x4*)(out + off + bj * HALF + n * 16) = bs + acc[ai][bj][m][n]; } }
    }
};
struct EpiPlainF32 {
    static constexpr bool PERM = false, AFTER_DRAIN = false, SWAP23 = false, FP8 = false;
    float* C; int ldc;
    __device__ __forceinline__ void operator()(const f32x4 (&acc)[2][2][4][2], const Unit& u, int wr, int wc, int fr, int fq) const {
        const int row0 = u.pm * BM + wr * 64 + fr, col0 = u.pn * BM + wc * 32 + 4 * fq;
#pragma unroll
        for (int ai = 0; ai < 2; ++ai)
#pragma unroll
            for (int m = 0; m < 4; ++m) { float* rowp = C + (size_t)(row0 + ai * HALF + m * 16) * ldc + col0;
#pragma unroll
                for (int bj = 0; bj < 2; ++bj)
#pragma unroll
                    for (int n = 0; n < 2; ++n) *(f32x4*)(rowp + bj * HALF + n * 16) = acc[ai][bj][m][n]; }
    }
};

template <bool F8_> struct EpiVTT {
    static constexpr bool PERM = true, AFTER_DRAIN = false, SWAP23 = true, FP8 = F8_;
    bf16_t* O; float scale;
    __device__ __forceinline__ void operator()(const f32x4 (&acc)[2][2][4][2], const Unit& u, int wr, int wc, int fr, int fq) const {
        const int row0 = u.pm * BM + wr * 64 + fr; const int colt = u.pn * BM; const int b = colt >> 12, pos0 = (colt & 4095) + wc * 32 + 8 * fq;
        bf16_t* base = O + (size_t)b * 8192 * 4096 + pos0;
#pragma unroll
        for (int ai = 0; ai < 2; ++ai)
#pragma unroll
            for (int m = 0; m < 4; ++m) { bf16_t* rowp = base + (size_t)(row0 + ai * HALF + m * 16) * 4096;
#pragma unroll
                for (int bj = 0; bj < 2; ++bj) { const f32x4 v0 = F8_ ? acc[ai][bj][m][0] * scale : acc[ai][bj][m][0], v1 = F8_ ? acc[ai][bj][m][1] * scale : acc[ai][bj][m][1];
                    u32x4 w; w.x = pk2(v0[0], v0[1]); w.y = pk2(v0[2], v0[3]); w.z = pk2(v1[0], v1[1]); w.w = pk2(v1[2], v1[3]);
                    EPI_ST16(rowp + bj * HALF, w); } }
    }
};
using EpiVT = EpiVTT<false>; using EpiVTFp8 = EpiVTT<true>;

template <bool F8_> struct EpiKNormT {
    static constexpr bool PERM = true, AFTER_DRAIN = false, SWAP23 = false, FP8 = F8_;
    bf16_t* KM; const float* sspe; const float* kper; const float* gain; PG8_LAS float* tab; mutable unsigned par; float scale;
    __device__ __forceinline__ void operator()(const f32x4 (&acc)[2][2][4][2], const Unit& u, int wr, int wc, int fr, int fq) const {
        PG8_LAS float* T = tab + par * 2048;
#pragma unroll
        for (int ai = 0; ai < 2; ++ai)
#pragma unroll
            for (int m = 0; m < 4; ++m) { const int row = ai * HALF + wr * 64 + m * 16 + fr;
#pragma unroll
                for (int bj = 0; bj < 2; ++bj) { const f32x4 x = F8_ ? acc[ai][bj][m][0] * scale : acc[ai][bj][m][0], y = F8_ ? acc[ai][bj][m][1] * scale : acc[ai][bj][m][1];
                    float ss = (x[0] * x[0] + x[1] * x[1]) + (x[2] * x[2] + x[3] * x[3]) + (y[0] * y[0] + y[1] * y[1]) + (y[2] * y[2] + y[3] * y[3]);
                    ss += __shfl_xor(ss, 16); ss += __shfl_xor(ss, 32);
                    if (fq == 0) T[row * 8 + bj * 4 + wc] = ss; } }
        asm volatile("s_waitcnt lgkmcnt(0)" ::: "memory"); __builtin_amdgcn_s_barrier(); asm volatile("" ::: "memory");
        const f32x4 g0 = *(const f32x4*)(gain + wc * 32 + 8 * fq), g1 = *(const f32x4*)(gain + wc * 32 + 8 * fq + 4);
        const int tok0 = u.pm * BM, b = tok0 >> 12;
#pragma unroll
        for (int ai = 0; ai < 2; ++ai)
#pragma unroll
            for (int m = 0; m < 4; ++m) { const int row = ai * HALF + wr * 64 + m * 16 + fr, tok = tok0 + row, s = tok & 4095;
                const float sp = sspe[tok]; const f32x4 kp = *(const f32x4*)(kper + (size_t)tok * 64 + wc * 16 + 4 * fq);
#pragma unroll
                for (int bj = 0; bj < 2; ++bj) { const f32x4 t = *(const PG8_LAS f32x4*)(T + row * 8 + bj * 4);
                    const float rstd = rsqrtf(((t[0] + t[1]) + (t[2] + t[3]) + sp) * (1.0f / 192.0f) + 1e-6f);
                    const int hd = 2 * u.pn + bj;
                    bf16_t* kb = KM + ((size_t)(b * 64 + hd) * 4096 + s) * 192;
                    const f32x4 x = F8_ ? acc[ai][bj][m][0] * scale : acc[ai][bj][m][0], y = F8_ ? acc[ai][bj][m][1] * scale : acc[ai][bj][m][1];
                    u32x4 w; w.x = pk2(x[0] * rstd * g0[0], x[1] * rstd * g0[1]); w.y = pk2(x[2] * rstd * g0[2], x[3] * rstd * g0[3]);
                    w.z = pk2(y[0] * rstd * g1[0], y[1] * rstd * g1[1]); w.w = pk2(y[2] * rstd * g1[2], y[3] * rstd * g1[3]);
                    *(u32x4*)(kb + wc * 32 + 8 * fq) = w;
                    u32x2 r; r.x = pk2(kp[0] * rstd, kp[1] * rstd); r.y = pk2(kp[2] * rstd, kp[3] * rstd);
                    *(u32x2*)(kb + 128 + wc * 16 + 4 * fq) = r; } }
        par ^= 1u;
    }
};
using EpiKNorm = EpiKNormT<false>; using EpiKNormFp8 = EpiKNormT<true>;

template <bool F8_> struct EpiResNormT {
    static constexpr bool PERM = false, AFTER_DRAIN = false, SWAP23 = false, FP8 = F8_;
    const float* base; float* out; int ldc; const float* gain; bf16_t* xg; float* ss; unsigned char* x8; float scale;
    __device__ __forceinline__ void operator()(const f32x4 (&acc)[2][2][4][2], const Unit& u, int wr, int wc, int fr, int fq) const {
        const int row0 = u.pm * BM + wr * 64 + fr, col0 = u.pn * BM + wc * 32 + 4 * fq;
        f32x4 gv[2][2];
#pragma unroll
        for (int bj = 0; bj < 2; ++bj)
#pragma unroll
            for (int n = 0; n < 2; ++n) gv[bj][n] = *(const f32x4*)(gain + col0 + bj * HALF + n * 16);
#pragma unroll
        for (int ai = 0; ai < 2; ++ai)
#pragma unroll
            for (int m = 0; m < 4; ++m) { const int row = row0 + ai * HALF + m * 16; const size_t off = (size_t)row * ldc + col0; float sq = 0.f;
#pragma unroll
                for (int bj = 0; bj < 2; ++bj)
#pragma unroll
                    for (int n = 0; n < 2; ++n) { const f32x4 bs = *(const f32x4*)(base + off + bj * HALF + n * 16); const f32x4 v = F8_ ? bs + acc[ai][bj][m][n] * scale : bs + acc[ai][bj][m][n];
                        *(f32x4*)(out + off + bj * HALF + n * 16) = v;
                        sq += (v[0] * v[0] + v[1] * v[1]) + (v[2] * v[2] + v[3] * v[3]);
                        const f32x4 g = gv[bj][n]; u32x2 w; w.x = pk2(v[0] * g[0], v[1] * g[1]); w.y = pk2(v[2] * g[2], v[3] * g[3]);
                        *(u32x2*)(xg + off + bj * HALF + n * 16) = w;
                        if (x8) *(unsigned*)(x8 + off + bj * HALF + n * 16) = pk4_fp8(v[0] * g[0] * 16.0f, v[1] * g[1] * 16.0f, v[2] * g[2] * 16.0f, v[3] * g[3] * 16.0f); }
                sq += __shfl_xor(sq, 16); sq += __shfl_xor(sq, 32);
                if (fq == 0) atomicAdd(ss + row, sq); }
    }
};
using EpiResNorm = EpiResNormT<false>; using EpiResNormFp8 = EpiResNormT<true>;
struct EpiStoreBf16RowScale {
    static constexpr bool PERM = true, AFTER_DRAIN = false, SWAP23 = false, FP8 = false;
    bf16_t* O; int ldc; const float* ss; float inv_dim;
    __device__ __forceinline__ void operator()(const f32x4 (&acc)[2][2][4][2], const Unit& u, int wr, int wc, int fr, int fq) const {
        const int row0 = u.pm * BM + wr * 64 + fr; const int col0 = u.pn * BM + wc * 32 + 8 * fq;
#pragma unroll
        for (int ai = 0; ai < 2; ++ai)
#pragma unroll
            for (int m = 0; m < 4; ++m) { const int row = row0 + ai * HALF + m * 16; const float rs = rsqrtf(ss[row] * inv_dim + 1e-6f);
                bf16_t* rowp = O + (size_t)row * ldc + col0;
#pragma unroll
                for (int bj = 0; bj < 2; ++bj) { const f32x4 v0 = acc[ai][bj][m][0] * rs, v1 = acc[ai][bj][m][1] * rs;
                    u32x4 w; w.x = pk2(v0[0], v0[1]); w.y = pk2(v0[2], v0[3]); w.z = pk2(v1[0], v1[1]); w.w = pk2(v1[2], v1[3]);
                    EPI_ST16(rowp + bj * HALF, w); } }
    }
};

struct EpiStoreBf16Fp8 {
    static constexpr bool PERM = true, AFTER_DRAIN = false, SWAP23 = false, FP8 = true;
    bf16_t* O; int ldc; float scale; int nostore = 0;
    __device__ __forceinline__ void operator()(const f32x4 (&acc)[2][2][4][2], const Unit& u, int wr, int wc, int fr, int fq) const {
        const int row0 = u.pm * BM + wr * 64 + fr; const int col0 = u.pn * BM + wc * 32 + 8 * fq;
#pragma unroll
        for (int ai = 0; ai < 2; ++ai)
#pragma unroll
            for (int m = 0; m < 4; ++m) { bf16_t* rowp = O + (size_t)(row0 + ai * HALF + m * 16) * ldc + col0;
#pragma unroll
                for (int bj = 0; bj < 2; ++bj) { const f32x4 v0 = acc[ai][bj][m][0] * scale, v1 = acc[ai][bj][m][1] * scale;
                    u32x4 w; w.x = pk2(v0[0], v0[1]); w.y = pk2(v0[2], v0[3]); w.z = pk2(v1[0], v1[1]); w.w = pk2(v1[2], v1[3]);
                    if (!nostore || w.x == 0x12345679u) EPI_ST16(rowp + bj * HALF, w); } }
    }
};

struct OrderBf16Part {
    int G, c, q0, nq, nz;
    __device__ bool next(int i, Unit& u) const { const int L = i * G + c;
        if (L < nq * 64) { u.pm = L & 63; u.pn = q0 + (L >> 6); return true; }
        const int Lz = L - nq * 64; if (Lz >= nz * 4) return false;
        const int j = Lz >> 2; u.pm = 16 * (Lz & 3); u.pn = j < q0 ? j : j + nq; return true; }
    __device__ __forceinline__ void a_ready(const Unit&) const {}
    __device__ __forceinline__ void done(const Unit&) const {}
};
struct OrderFp8Part {
    int G, c, q0, nq, nz, rot;
    __device__ bool next(int i, Unit& u) const { const int L = i * G + (G == 256 ? ((c + rot) & 255) : c); if (L >= nz * 60) return false;
        const int r = L % 60, j = L / 60; u.pm = r + r / 15 + 1; u.pn = j < q0 ? j : j + nq; return true; }
    __device__ __forceinline__ void a_ready(const Unit&) const {}
    __device__ __forceinline__ void done(const Unit&) const {}
};

struct EpiStoreBf16RowScaleFp8 {
    static constexpr bool PERM = true, AFTER_DRAIN = false, SWAP23 = false, FP8 = true;
    bf16_t* O; int ldc; const float* ss; float inv_dim, scale;
    __device__ __forceinline__ void operator()(const f32x4 (&acc)[2][2][4][2], const Unit& u, int wr, int wc, int fr, int fq) const {
        const int row0 = u.pm * BM + wr * 64 + fr; const int col0 = u.pn * BM + wc * 32 + 8 * fq;
#pragma unroll
        for (int ai = 0; ai < 2; ++ai)
#pragma unroll
            for (int m = 0; m < 4; ++m) { const int row = row0 + ai * HALF + m * 16; const float rs = rsqrtf(ss[row] * inv_dim + 1e-6f) * scale;
                bf16_t* rowp = O + (size_t)row * ldc + col0;
#pragma unroll
                for (int bj = 0; bj < 2; ++bj) { const f32x4 v0 = acc[ai][bj][m][0] * rs, v1 = acc[ai][bj][m][1] * rs;
                    u32x4 w; w.x = pk2(v0[0], v0[1]); w.y = pk2(v0[2], v0[3]); w.z = pk2(v1[0], v1[1]); w.w = pk2(v1[2], v1[3]);
                    EPI_ST16(rowp + bj * HALF, w); } }
    }
};
struct OrderTiles {
    int G, c, ncol;
    __device__ bool next(int i, Unit& u) const { const int L = i * G + c; if (L >= ncol * 64) return false; u.pm = L & 63; u.pn = L >> 6; return true; }
    __device__ __forceinline__ void a_ready(const Unit&) const {}
    __device__ __forceinline__ void done(const Unit&) const {}
};

struct EpiResF32Fp8 {
    static constexpr bool PERM = false, AFTER_DRAIN = false, SWAP23 = false, FP8 = true;
    const float* base; float* out; int ldc; float scale;
    __device__ __forceinline__ void operator()(const f32x4 (&acc)[2][2][4][2], const Unit& u, int wr, int wc, int fr, int fq) const {
        const int row0 = u.pm * BM + wr * 64 + fr, col0 = u.pn * BM + wc * 32 + 4 * fq;
#pragma unroll
        for (int ai = 0; ai < 2; ++ai)
#pragma unroll
            for (int m = 0; m < 4; ++m) { const size_t off = (size_t)(row0 + ai * HALF + m * 16) * ldc + col0;
#pragma unroll
                for (int bj = 0; bj < 2; ++bj)
#pragma unroll
                    for (int n = 0; n < 2; ++n) { const f32x4 bs = *(const f32x4*)(base + off + bj * HALF + n * 16);
                        *(f32x4*)(out + off + bj * HALF + n * 16) = bs + acc[ai][bj][m][n] * scale; } }
    }
};

template <class Base> struct OrderSwap {
    Base B;
    __device__ bool next(int i, Unit& u) const { Unit t; if (!B.next(i, t)) return false; u.pm = t.pn; u.pn = t.pm; return true; }
    __device__ __forceinline__ void a_ready(const Unit&) const {}
    __device__ __forceinline__ void done(const Unit&) const {}
};
template <class Epi, class Sched, bool STAMP = false>
__device__ __forceinline__ void gemm_phase(PG8_LAS unsigned char* lds, const Gemm g, const Sched& S, const Epi& E, unsigned long long* stamps, int stag = 0) {
    const int tid = tid_opaque(), wid = __builtin_amdgcn_readfirstlane(tid >> 6), lane = tid & 63, wr = wid >> 2, wc = wid & 3, fr = lane & 15, fq = lane >> 4;
    const int K = g.K, nt = K / BK;
    int ts_lo = 0, ts_hi = 0, nts = 0; const unsigned long long rt_entry = STAMP ? (unsigned long long)wall_clock64() : 0ull;
#define PG8_STAMP() do { if (STAMP && wid == 0 && nts < 64) { const unsigned long long _c = (unsigned long long)clock64(); \
        ts_lo = (lane == nts) ? (int)(unsigned)_c : ts_lo; ts_hi = (lane == nts) ? (int)(unsigned)(_c >> 32) : ts_hi; ++nts; } } while (0)
    PG8_STAMP();
    unsigned voffA[2], voffB[2];
#pragma unroll
    for (int i = 0; i < 2; ++i) { int R, C; stage_rc(tid * 16 + i * 8192, R, C); int Rb = Epi::PERM ? ((R & ~31) + perm32(R & 31)) : R; if (Epi::SWAP23) Rb = vt_key_of_pos(Rb);
        voffA[i] = (unsigned)(R * K + C) * 2u; voffB[i] = (unsigned)(Rb * K + C) * 2u; }
    const size_t kstep = (size_t)(BK * 2);
    const size_t hstep = (size_t)HALF * K * 2;
    const size_t tstep = 2 * hstep;
    const unsigned ldsw = (unsigned)wid * 1024u;
    const int aoff = lds_byte(wr * 64 + fr, fq * 8), boff = lds_byte(wc * 32 + fr, fq * 8);
#define PG8_SA(b, h) (((b) * 2 + (h)) * HTB)
#define PG8_SB(b, h) ((4 + (b) * 2 + (h)) * HTB)
#define PG8_STAGE(bufoff, gbase, voff) do { _Pragma("unroll") for (int _i = 0; _i < 2; ++_i) \
        __builtin_amdgcn_global_load_lds((const unsigned*)((const char*)(gbase) + (voff)[_i]), (PG8_LAS unsigned*)(lds + (bufoff) + ldsw + _i * 8192), 16, 0, 0); } while (0)
#define PG8_LDA(dst, b, h) do { if constexpr (Epi::FP8) { _Pragma("unroll") for (int m = 0; m < 4; ++m) { const PG8_LAS unsigned char* p_ = lds + PG8_SA(b, h) + aoff + m * 2048; \
            const i32x4_t lo_ = *(const PG8_LAS i32x4_t*)p_, hi_ = *(const PG8_LAS i32x4_t*)(p_ + 1024); dst##8[m] = __builtin_shufflevector(lo_, hi_, 0, 1, 2, 3, 4, 5, 6, 7); } } \
        else { _Pragma("unroll") for (int m = 0; m < 4; ++m) _Pragma("unroll") for (int k = 0; k < 2; ++k) dst[m][k] = *(const PG8_LAS bf16x8*)(lds + PG8_SA(b, h) + aoff + m * 2048 + k * 1024); } } while (0)
#define PG8_LDB(dst, b, h) do { if constexpr (Epi::FP8) { _Pragma("unroll") for (int n = 0; n < 2; ++n) { const PG8_LAS unsigned char* p_ = lds + PG8_SB(b, h) + boff + n * 2048; \
            const i32x4_t lo_ = *(const PG8_LAS i32x4_t*)p_, hi_ = *(const PG8_LAS i32x4_t*)(p_ + 1024); dst##8[n] = __builtin_shufflevector(lo_, hi_, 0, 1, 2, 3, 4, 5, 6, 7); } } \
        else { _Pragma("unroll") for (int n = 0; n < 2; ++n) _Pragma("unroll") for (int k = 0; k < 2; ++k) dst[n][k] = *(const PG8_LAS bf16x8*)(lds + PG8_SB(b, h) + boff + n * 2048 + k * 1024); } } while (0)
#define PG8_MMA(ai, bj, At, Bt) do { __builtin_amdgcn_s_setprio(1); \
        if constexpr (Epi::FP8) { \
            _Pragma("unroll") for (int m = 0; m < 4; ++m) _Pragma("unroll") for (int n = 0; n < 2; ++n) \
                asm volatile("v_mfma_scale_f32_16x16x128_f8f6f4 %0, %1, %2, %0, %3, %3 op_sel_hi:[0,0,0]" : "+v"(acc[ai][bj][m][n]) : "v"(Bt##8[n]), "v"(At##8[m]), "v"(fp8_scale_one)); \
        } else { \
            _Pragma("unroll") for (int m = 0; m < 4; ++m) _Pragma("unroll") for (int n = 0; n < 2; ++n) _Pragma("unroll") for (int k = 0; k < 2; ++k) \
                acc[ai][bj][m][n] = __builtin_amdgcn_mfma_f32_16x16x32_bf16(Bt[n][k], At[m][k], acc[ai][bj][m][n], 0, 0, 0); } \
        __builtin_amdgcn_s_setprio(0); } while (0)
#define PG8_WAIT_V(n) asm volatile("s_waitcnt vmcnt(" #n ")" ::: "memory")
#define PG8_WAIT_L(n) asm volatile("s_waitcnt lgkmcnt(" #n ")" ::: "memory")
#define PG8_BAR __builtin_amdgcn_s_barrier()
#define PG8_SCHED __builtin_amdgcn_sched_barrier(0)
    Unit cur, nxt; int ui = 0;
    if (!S.next(0, cur)) return;
    if (stag > 0) { const int n_ = (int)((blockIdx.x >> 3) & 7u) * stag; for (int i_ = 0; i_ < n_; ++i_) __builtin_amdgcn_s_sleep(37); }
    f32x4 acc[2][2][4][2];
#pragma unroll
    for (int a = 0; a < 2; ++a)
#pragma unroll
        for (int b = 0; b < 2; ++b)
#pragma unroll
            for (int m = 0; m < 4; ++m)
#pragma unroll
                for (int n = 0; n < 2; ++n) acc[a][b][m][n] = (f32x4){0.f, 0.f, 0.f, 0.f};
    bf16x8 At[4][2], B0[2][2], B1[2][2]; i32x8_t At8[4], B08[2], B18[2]; const int fp8_scale_one = 0x7f7f7f7f;
    const char* cA = (const char*)g.A + (size_t)cur.pm * tstep; const char* cB = (const char*)g.Bt + (size_t)cur.pn * tstep;
    S.a_ready(cur);
    PG8_STAGE(PG8_SB(0, 0), cB, voffB); PG8_STAGE(PG8_SA(0, 0), cA, voffA); PG8_STAGE(PG8_SB(0, 1), cB + hstep, voffB); PG8_STAGE(PG8_SA(0, 1), cA + hstep, voffA);
    if (wr == 1) PG8_BAR;
    PG8_WAIT_V(4); PG8_BAR;
    PG8_STAGE(PG8_SB(1, 0), cB + kstep, voffB); PG8_STAGE(PG8_SA(1, 0), cA + kstep, voffA); PG8_STAGE(PG8_SB(1, 1), cB + hstep + kstep, voffB);
    PG8_WAIT_V(6); PG8_BAR;
    PG8_STAMP();
    for (;;) {
        const bool has_next = S.next(ui + 1, nxt);
        const char* nA = has_next ? (const char*)g.A + (size_t)nxt.pm * tstep : cA; const char* nB = has_next ? (const char*)g.Bt + (size_t)nxt.pn * tstep : cB;
        for (int t = 0; t < nt; t += 2) {
            const bool last = (t == nt - 2);
            const char* a1 = cA + (size_t)(t + 1) * kstep;
            const char* a2 = last ? nA : cA + (size_t)(t + 2) * kstep; const char* b2 = last ? nB : cB + (size_t)(t + 2) * kstep;
            const char* a3 = a2 + kstep; const char* b3 = b2 + kstep;
            if (last && has_next) S.a_ready(nxt);
            PG8_LDB(B0, 0, 0); PG8_SCHED; PG8_LDA(At, 0, 0); PG8_STAGE(PG8_SA(1, 1), a1 + hstep, voffA);
            PG8_WAIT_L(8); PG8_BAR; PG8_WAIT_L(0); PG8_MMA(0, 0, At, B0); PG8_BAR; PG8_SCHED;
            PG8_LDB(B1, 0, 1); PG8_STAGE(PG8_SB(0, 0), b2, voffB);
            PG8_BAR; PG8_WAIT_L(0); PG8_MMA(0, 1, At, B1); PG8_BAR;
            PG8_LDA(At, 0, 1); PG8_STAGE(PG8_SA(0, 0), a2, voffA);
            PG8_BAR; PG8_WAIT_L(0); PG8_MMA(1, 0, At, B0); PG8_BAR; PG8_SCHED;
            PG8_STAGE(PG8_SB(0, 1), b2 + hstep, voffB);
            PG8_WAIT_V(6); PG8_BAR; PG8_MMA(1, 1, At, B1); PG8_BAR;
            PG8_LDB(B0, 1, 0); PG8_SCHED; PG8_LDA(At, 1, 0); PG8_STAGE(PG8_SA(0, 1), a2 + hstep, voffA);
            PG8_WAIT_L(8); PG8_BAR; PG8_WAIT_L(0); PG8_MMA(0, 0, At, B0); PG8_BAR; PG8_SCHED;
            PG8_LDB(B1, 1, 1); PG8_STAGE(PG8_SB(1, 0), b3, voffB);
            PG8_BAR; PG8_WAIT_L(0); PG8_MMA(0, 1, At, B1); PG8_BAR;
            PG8_LDA(At, 1, 1); PG8_STAGE(PG8_SA(1, 0), a3, voffA);
            PG8_BAR; PG8_WAIT_L(0); PG8_MMA(1, 0, At, B0); PG8_BAR; PG8_SCHED;
            PG8_STAGE(PG8_SB(1, 1), b3 + hstep, voffB);
            PG8_WAIT_V(6); PG8_BAR; PG8_MMA(1, 1, At, B1); PG8_BAR;
        }
        PG8_STAMP();
        if constexpr (Epi::FP8) asm volatile("s_nop 15\n\ts_nop 15" ::: "memory");
        if constexpr (!Epi::AFTER_DRAIN) { E(acc, cur, wr, wc, fr, fq); S.done(cur); }
        PG8_STAMP();
        if (!has_next) break;
#pragma unroll
        for (int a = 0; a < 2; ++a)
#pragma unroll
            for (int b = 0; b < 2; ++b)
#pragma unroll
                for (int m = 0; m < 4; ++m)
#pragma unroll
                    for (int n = 0; n < 2; ++n) acc[a][b][m][n] = (f32x4){0.f, 0.f, 0.f, 0.f};
        cur = nxt; cA = nA; cB = nB; ++ui;
    }
    PG8_WAIT_V(0);
    if (wr == 0) PG8_BAR;
    PG8_BAR;
    if constexpr (Epi::AFTER_DRAIN) { E.fused(acc, cur, wr, wc, fr, fq, lds, wid, lane); S.done(cur); }
    PG8_STAMP();
    if (STAMP && wid == 0) { stamps[lane] = lane < nts ? (((unsigned long long)(unsigned)ts_hi << 32) | (unsigned)ts_lo) : 0ull;
        if (lane == 62) stamps[62] = rt_entry; if (lane == 63) stamps[63] = (unsigned long long)wall_clock64(); }
#undef PG8_STAMP
#undef PG8_SA
#undef PG8_SB
#undef PG8_STAGE
#undef PG8_LDA
#undef PG8_LDB
#undef PG8_MMA
#undef PG8_WAIT_V
#undef PG8_WAIT_L
#undef PG8_BAR
#undef PG8_SCHED
}
}


DI void phase_wconv(LAS unsigned char* lds, const float* __restrict__ src, bf16_t* __restrict__ dst, int K, int N, int Npad, int bid, int nb, float q8s = 0.f, int colmap = 0, unsigned char* __restrict__ dst8 = nullptr, int n8_0 = 0, int n8_1 = 0) {
    LAS float* tile = (LAS float*)lds;
    const int tid = tid_opaque();
    const int tk = K / 64, tn = Npad / 256, total = tk * tn;
    for (int t = bid; t < total; t += nb) {
        const int k0 = (t % tk) * 64, n0 = (t / tk) * 256;
        __syncthreads();
        {
            const int ty = tid >> 6, tx = tid & 63, n = n0 + tx * 4;
            f32x4 v[8];
#pragma unroll
            for (int i = 0; i < 8; ++i) {
                const int k = k0 + ty + 8 * i;
                v[i] = (f32x4){0.f, 0.f, 0.f, 0.f};
                if (colmap) { const int ns = (n >> 7) * 256 + (colmap == 1 ? 128 : 0) + (n & 127); v[i] = *(const f32x4*)(src + (size_t)k * (2 * N) + ns); }
                else if (n < N) v[i] = *(const f32x4*)(src + (size_t)k * N + n);
            }
#pragma unroll
            for (int i = 0; i < 8; ++i) { LAS float* pp = tile + (ty + 8 * i) * 257 + tx * 4; pp[0] = v[i][0]; pp[1] = v[i][1]; pp[2] = v[i][2]; pp[3] = v[i][3]; }
        }
        __syncthreads();
#pragma unroll
        for (int ps_ = 0; ps_ < 4; ++ps_) {
            const int n = (tid >> 3) + 64 * ps_, kc = tid & 7;
            float v[8];
#pragma unroll
            for (int j = 0; j < 8; ++j) { v[j] = tile[(kc * 8 + j) * 257 + n]; if (q8s > 0.f) v[j] = emu_q8(v[j], q8s); else if (q8s < 0.f && n0 + n >= C_ZC) v[j] = emu_q8(v[j], -q8s); }
            u32x4 w; w.x = pk2(v[0], v[1]); w.y = pk2(v[2], v[3]); w.z = pk2(v[4], v[5]); w.w = pk2(v[6], v[7]);
            *(u32x4*)(dst + (size_t)(n0 + n) * K + k0 + kc * 8) = w;
            if (dst8 && (n0 + n < n8_0 || n0 + n >= n8_1)) { u32x2 b; b.x = pk4_fp8(v[0] * 64.0f, v[1] * 64.0f, v[2] * 64.0f, v[3] * 64.0f); b.y = pk4_fp8(v[4] * 64.0f, v[5] * 64.0f, v[6] * 64.0f, v[7] * 64.0f);
                *(u32x2*)(dst8 + (size_t)(n0 + n) * K + k0 + kc * 8) = b; }
        }
    }
}

DI void phase_rmsnorm(const float* __restrict__ x, const float* __restrict__ gain, bf16_t* __restrict__ h, int bid, int nb, float q8s = 0.f, unsigned char* __restrict__ h8 = nullptr) {
    const int tid = tid_opaque(); const int lane = tid & 63, wid = tid >> 6;
    for (int row = bid * 8 + wid; row < MTOK; row += nb * 8) {
        const float* xr = x + (size_t)row * DM;
        f32x4 v[16]; float ss = 0.f;
#pragma unroll
        for (int i = 0; i < 16; ++i) { v[i] = *(const f32x4*)(xr + (i * 64 + lane) * 4); ss += v[i][0] * v[i][0] + v[i][1] * v[i][1] + v[i][2] * v[i][2] + v[i][3] * v[i][3]; }
#pragma unroll
        for (int o = 32; o >= 1; o >>= 1) ss += __shfl_xor(ss, o);
        const float rstd = rsqrtf(ss * (1.0f / DM) + EPSN);
        bf16_t* hr = h + (size_t)row * DM;
#pragma unroll
        for (int i = 0; i < 16; ++i) { const f32x4 g = *(const f32x4*)(gain + (i * 64 + lane) * 4);
            float y0 = v[i][0] * rstd * g[0], y1 = v[i][1] * rstd * g[1], y2 = v[i][2] * rstd * g[2], y3 = v[i][3] * rstd * g[3];
            if (q8s > 0.f || (q8s < 0.f && (row & 4095) >= 256)) { const float qa = fabsf(q8s); y0 = emu_q8(y0, qa); y1 = emu_q8(y1, qa); y2 = emu_q8(y2, qa); y3 = emu_q8(y3, qa); }
            u32x2 w; w.x = pk2(y0, y1); w.y = pk2(y2, y3);
            *(u32x2*)(hr + (i * 64 + lane) * 4) = w;
            if (h8) *(unsigned*)(h8 + (size_t)row * DM + (i * 64 + lane) * 4) = pk4_fp8(y0 * 16.0f, y1 * 16.0f, y2 * 16.0f, y3 * 16.0f); }
    }
}

DI void ld192(const bf16_t* p, int j8, float (&v)[24]) {
#pragma unroll
    for (int c = 0; c < 3; ++c) { const u32x4 w = *(const u32x4*)(p + (j8 + 8 * c) * 8);
        v[c * 8 + 0] = bflo(w.x); v[c * 8 + 1] = bfhi(w.x); v[c * 8 + 2] = bflo(w.y); v[c * 8 + 3] = bfhi(w.y);
        v[c * 8 + 4] = bflo(w.z); v[c * 8 + 5] = bfhi(w.z); v[c * 8 + 6] = bflo(w.w); v[c * 8 + 7] = bfhi(w.w); }
}
DI void st192(bf16_t* p, int j8, const float (&v)[24]) {
#pragma unroll
    for (int c = 0; c < 3; ++c) { u32x4 w; w.x = pk2(v[c * 8 + 0], v[c * 8 + 1]); w.y = pk2(v[c * 8 + 2], v[c * 8 + 3]); w.z = pk2(v[c * 8 + 4], v[c * 8 + 5]); w.w = pk2(v[c * 8 + 6], v[c * 8 + 7]);
        *(u32x4*)(p + (j8 + 8 * c) * 8) = w; }
}
DI float sum8(float s) { s += __shfl_xor(s, 1); s += __shfl_xor(s, 2); s += __shfl_xor(s, 4); return s; }

DI void phase_nsa_prep(const Params& P, int bid, int nb) {
    bf16_t* Y0 = (bf16_t*)(P.ws + OFF_Y0);
    bf16_t* KS = (bf16_t*)(P.ws + OFF_KS); bf16_t* KW = (bf16_t*)(P.ws + OFF_KW);
    bf16_t* ACK = (bf16_t*)(P.ws + OFF_ACK); bf16_t* ACV = (bf16_t*)(P.ws + OFF_ACV);
    const int tid = tid_opaque(), grp = (tid >> 3) & 15, j8 = tid & 7;
    for (int tok = bid * 4 + (tid >> 7); tok < MTOK; tok += nb * 4) {
        const int b = tok / SEQ, s = tok % SEQ;
        bf16_t* yr = Y0 + (size_t)tok * N1P;
        if (grp < 8) {
            const int g = grp & 3, br = grp >> 2;
            float v[24]; ld192(yr + (br ? C_KVW : C_KVS) + g * DK, j8, v);
            float ss = 0.f;
#pragma unroll
            for (int i = 0; i < 24; ++i) ss += v[i] * v[i];
            ss = sum8(ss);
            const float rstd = rsqrtf(ss * (1.0f / DK) + EPSN);
            const float* kn = P.nsa_k_norm + (br ? 2 : 1) * DK;
#pragma unroll
            for (int c = 0; c < 3; ++c)
#pragma unroll
                for (int e = 0; e < 8; ++e) v[c * 8 + e] *= rstd * kn[(j8 + 8 * c) * 8 + e];
            st192((br ? KW : KS) + ((size_t)(b * NG + g) * SEQ + s) * DK, j8, v);
        } else if (grp < 12) {
            const int g = grp - 8;
            float v[24]; ld192(yr + C_KVC + g * DK, j8, v);
#pragma unroll
            for (int k = 0; k < 2; ++k) {
                const int n = (s >> 4) - k, l = s - 16 * n;
                if (n >= 0 && n <= 254) {
                    float w[24];
#pragma unroll
                    for (int c = 0; c < 3; ++c)
#pragma unroll
                        for (int e = 0; e < 8; ++e) w[c * 8 + e] = v[c * 8 + e] + P.pe_k[l * DK + (j8 + 8 * c) * 8 + e];
                    st192(ACK + ((size_t)((b * NG + g) * 256 + n)) * 6144 + l * DK, j8, w);
                }
            }
        } else if (grp < 16) {
            const int g = grp - 12;
            const bf16_t* src = yr + C_KVC + NG * DK + g * DV;
            float v[16];
#pragma unroll
            for (int c = 0; c < 2; ++c) { const u32x4 w = *(const u32x4*)(src + (j8 + 8 * c) * 8);
                v[c * 8 + 0] = bflo(w.x); v[c * 8 + 1] = bfhi(w.x); v[c * 8 + 2] = bflo(w.y); v[c * 8 + 3] = bfhi(w.y);
                v[c * 8 + 4] = bflo(w.z); v[c * 8 + 5] = bfhi(w.z); v[c * 8 + 6] = bflo(w.w); v[c * 8 + 7] = bfhi(w.w); }
#pragma unroll
            for (int k = 0; k < 2; ++k) {
                const int n = (s >> 4) - k, l = s - 16 * n;
                if (n >= 0 && n <= 254) {
                    bf16_t* dst = ACV + ((size_t)((b * NG + g) * 256 + n)) * 4096 + l * DV;
#pragma unroll
                    for (int c = 0; c < 2; ++c) { float w[8];
#pragma unroll
                        for (int e = 0; e < 8; ++e) w[e] = v[c * 8 + e] + P.pe_v[l * DV + (j8 + 8 * c) * 8 + e];
                        u32x4 o; o.x = pk2(w[0], w[1]); o.y = pk2(w[2], w[3]); o.z = pk2(w[4], w[5]); o.w = pk2(w[6], w[7]);
                        *(u32x4*)(dst + (j8 + 8 * c) * 8) = o; }
                }
            }
        }
    }
    for (int i = bid * 512 + tid; i < 16 * (6144 + 4096) / 8; i += nb * 512) {
        const int per = (6144 + 4096) / 8, bg = i / per, c = i % per;
        const u32x4 z = {0u, 0u, 0u, 0u};
        if (c < 6144 / 8) *(u32x4*)(ACK + ((size_t)(bg * 256 + 255)) * 6144 + c * 8) = z;
        else *(u32x4*)(ACV + ((size_t)(bg * 256 + 255)) * 4096 + (c - 6144 / 8) * 8) = z;
    }
}

DI int swap23(int p) { return (p & ~0xC) | ((p & 4) << 1) | ((p & 8) >> 1); }
DI void phase_vt(LAS unsigned char* lds, const bf16_t* __restrict__ src, size_t src_stride, int col0, int col_step, int nhv, bf16_t* __restrict__ dst, int bid, int nb) {
    LAS bf16_t* tile = (LAS bf16_t*)lds;
    const int tid = tid_opaque();
    const int ntile = SEQ / 64, total = BATCH * nhv * ntile;
    for (int it = bid; it < total; it += nb) {
        const int mat = it / ntile, tt = it % ntile, b = mat / nhv, hv = mat % nhv;
        __syncthreads();
#pragma unroll
        for (int i = 0; i < 2; ++i) {
            const int q = tid + 512 * i, tok = q >> 4, ch = q & 15;
            const u32x4 w = *(const u32x4*)(src + (size_t)(b * SEQ + tt * 64 + tok) * src_stride + col0 + hv * col_step + ch * 8);
            *(LAS u32x4*)(tile + tok * 136 + ch * 8) = w;
        }
        __syncthreads();
        {
            const int dv = tid >> 2, kq = tid & 3;
            unsigned w[8];
#pragma unroll
            for (int e = 0; e < 8; ++e) {
                const int p0 = kq * 16 + 2 * e, p1 = p0 + 1;
                const int k0 = vt_key_of_pos(p0), k1 = vt_key_of_pos(p1);
                w[e] = (unsigned)tile[k0 * 136 + dv] | ((unsigned)tile[k1 * 136 + dv] << 16);
            }
            bf16_t* d = dst + ((size_t)mat * DV + dv) * SEQ + tt * 64 + kq * 16;
            u32x4 a = {w[0], w[1], w[2], w[3]}, c = {w[4], w[5], w[6], w[7]};
            *(u32x4*)d = a; *(u32x4*)(d + 8) = c;
        }
    }
}

DI void phase_cmp2(LAS unsigned char* lds, const Params& P, int bid, int nb) {
    LAS float* sk = (LAS float*)lds;
    LAS float* sv = sk + 192;
    LAS float* red = sv + 128;
    const float* HIDK = (const float*)(P.ws + OFF_HIDK); const float* HIDV = (const float*)(P.ws + OFF_HIDV);
    bf16_t* KC = (bf16_t*)(P.ws + OFF_KC); bf16_t* VTC = (bf16_t*)(P.ws + OFF_VTC);
    const int tid = tid_opaque(), lane = tid & 63, wid = tid >> 6;
    for (int m = bid; m < 4096; m += nb) {
        const int n = m & 255, bg = m >> 8;
        __syncthreads();
        if (tid < 192) { const float h = HIDK[(size_t)m * 256 + tid]; sk[tid] = h / (1.0f + __expf(-h)); }
        else if (tid < 320) { const float h = HIDV[(size_t)m * 256 + tid - 192]; sv[tid - 192] = h / (1.0f + __expf(-h)); }
        __syncthreads();
        float acc = 0.f;
        if (tid < 192) { for (int i = 0; i < 192; ++i) acc += sk[i] * P.w2_k[i * 192 + tid]; }
        else if (tid < 320) { const int j = tid - 192; for (int i = 0; i < 128; ++i) acc += sv[i] * P.w2_v[i * 128 + j]; }
        float ss = (tid < 192) ? acc * acc : 0.f;
#pragma unroll
        for (int o = 32; o >= 1; o >>= 1) ss += __shfl_xor(ss, o);
        if (lane == 0) red[wid] = ss;
        __syncthreads();
        const float tot = red[0] + red[1] + red[2];
        const float rstd = rsqrtf(tot * (1.0f / DK) + EPSN);
        if (tid < 192) { const float o = (n == 255) ? 0.f : acc * rstd * P.nsa_k_norm[tid];
            KC[(size_t)m * DK + tid] = (bf16_t)(pk2(o, 0.f) & 0xffffu); }
        else if (tid < 320) { const int j = tid - 192; const float o = (n == 255) ? 0.f : acc;
            const int pn = vt_pos_of_key(n);
            VTC[((size_t)bg * DV + j) * 256 + pn] = (bf16_t)(pk2(o, 0.f) & 0xffffu); }
    }
}

DI void phase_mla_prep1(const Params& P, int bid, int nb) {
    const bf16_t* Y1 = (const bf16_t*)(P.ws + OFF_Y1);
    bf16_t* CQN = (bf16_t*)(P.ws + OFF_CQN); bf16_t* CKVN = (bf16_t*)(P.ws + OFF_CKVN); float* ROPE = (float*)(P.ws + OFF_ROPE);
    float* KPER = (float*)(P.ws + OFF_KPER); float* SSPE = (float*)(P.ws + OFF_SSPE);
    const int tid = tid_opaque(); const int lane = tid & 63, wid = tid >> 6;
    constexpr int TU = 4;
    for (int tok0 = (bid * 8 + wid) * TU; tok0 < MTOK; tok0 += nb * 8 * TU) {
        u32x4 wq[TU][3], wk[TU]; int pos[TU]; bf16_t kp1[TU], kp2[TU];
#pragma unroll
        for (int t = 0; t < TU; ++t) { const bf16_t* yr = Y1 + (size_t)(tok0 + t) * N3P;
#pragma unroll
            for (int c = 0; c < 3; ++c) wq[t][c] = *(const u32x4*)(yr + C3_CQ + (c * 64 + lane) * 8);
            wk[t] = *(const u32x4*)(yr + C3_CKV + lane * 8);
            pos[t] = P.pos[tok0 + t]; kp1[t] = yr[C3_KPE + (lane & 31)]; kp2[t] = yr[C3_KPE + 32 + (lane & 31)]; }
#pragma unroll
        for (int t = 0; t < TU; ++t) { const int tok = tok0 + t;
            {
                float v[24]; float ss = 0.f;
#pragma unroll
                for (int c = 0; c < 3; ++c) { const u32x4 w = wq[t][c];
                    v[c * 8 + 0] = bflo(w.x); v[c * 8 + 1] = bfhi(w.x); v[c * 8 + 2] = bflo(w.y); v[c * 8 + 3] = bfhi(w.y);
                    v[c * 8 + 4] = bflo(w.z); v[c * 8 + 5] = bfhi(w.z); v[c * 8 + 6] = bflo(w.w); v[c * 8 + 7] = bfhi(w.w); }
#pragma unroll
                for (int i = 0; i < 24; ++i) ss += v[i] * v[i];
#pragma unroll
                for (int o = 32; o >= 1; o >>= 1) ss += __shfl_xor(ss, o);
                const float rstd = rsqrtf(ss * (1.0f / QLORA) + EPSN);
#pragma unroll
                for (int c = 0; c < 3; ++c) { const float* g = P.mla_q_a_norm + (c * 64 + lane) * 8; const f32x4 g0 = *(const f32x4*)g, g1 = *(const f32x4*)(g + 4); u32x4 w;
                    w.x = pk2(v[c * 8 + 0] * rstd * g0[0], v[c * 8 + 1] * rstd * g0[1]); w.y = pk2(v[c * 8 + 2] * rstd * g0[2], v[c * 8 + 3] * rstd * g0[3]);
                    w.z = pk2(v[c * 8 + 4] * rstd * g1[0], v[c * 8 + 5] * rstd * g1[1]); w.w = pk2(v[c * 8 + 6] * rstd * g1[2], v[c * 8 + 7] * rstd * g1[3]);
                    *(u32x4*)(CQN + (size_t)tok * QLORA + (c * 64 + lane) * 8) = w;
                    if (USE_FP8Q) { const float r16 = rstd * 16.0f; u32x2 b;
                        b.x = pk4_fp8(v[c * 8 + 0] * r16 * g0[0], v[c * 8 + 1] * r16 * g0[1], v[c * 8 + 2] * r16 * g0[2], v[c * 8 + 3] * r16 * g0[3]);
                        b.y = pk4_fp8(v[c * 8 + 4] * r16 * g1[0], v[c * 8 + 5] * r16 * g1[1], v[c * 8 + 6] * r16 * g1[2], v[c * 8 + 7] * r16 * g1[3]);
                        *(u32x2*)((unsigned char*)(P.ws + OFF_CQN8) + (size_t)tok * QLORA + (c * 64 + lane) * 8) = b; } }
            }
            {
                float v[8]; float ss = 0.f; const u32x4 w0 = wk[t];
                v[0] = bflo(w0.x); v[1] = bfhi(w0.x); v[2] = bflo(w0.y); v[3] = bfhi(w0.y); v[4] = bflo(w0.z); v[5] = bfhi(w0.z); v[6] = bflo(w0.w); v[7] = bfhi(w0.w);
#pragma unroll
                for (int i = 0; i < 8; ++i) ss += v[i] * v[i];
#pragma unroll
                for (int o = 32; o >= 1; o >>= 1) ss += __shfl_xor(ss, o);
                const float rstd = rsqrtf(ss * (1.0f / KVLORA) + EPSN);
                const float* g = P.mla_kv_a_norm + lane * 8; const f32x4 g0 = *(const f32x4*)g, g1 = *(const f32x4*)(g + 4); u32x4 w;
                w.x = pk2(v[0] * rstd * g0[0], v[1] * rstd * g0[1]); w.y = pk2(v[2] * rstd * g0[2], v[3] * rstd * g0[3]);
                w.z = pk2(v[4] * rstd * g1[0], v[5] * rstd * g1[1]); w.w = pk2(v[6] * rstd * g1[2], v[7] * rstd * g1[3]);
                *(u32x4*)(CKVN + (size_t)tok * KVLORA + lane * 8) = w;
                if (USE_FP8KV) { const float r16 = rstd * 16.0f; u32x2 b8;
                    b8.x = pk4_fp8(v[0] * r16 * g0[0], v[1] * r16 * g0[1], v[2] * r16 * g0[2], v[3] * r16 * g0[3]); b8.y = pk4_fp8(v[4] * r16 * g1[0], v[5] * r16 * g1[1], v[6] * r16 * g1[2], v[7] * r16 * g1[3]);
                    *(u32x2*)((unsigned char*)(P.ws + OFF_CKVN8) + (size_t)tok * KVLORA + lane * 8) = b8; }
            }
            {
                const int i = lane & 31;
                const float invf = exp2f(-(float)i * (13.287712379549449f / 32.0f));
                const float ang = (float)pos[t] * invf;
                const double rev = (double)ang * 0.15915494309189533576888;
                const float fr = (float)(rev - __builtin_rint(rev));
                const float sn = __builtin_amdgcn_sinf(fr), cs = __builtin_amdgcn_cosf(fr);
                const float x1 = bf1(kp1[t]), x2 = bf1(kp2[t]);
                float ssp = x1 * x1 + x2 * x2;
#pragma unroll
                for (int o = 16; o >= 1; o >>= 1) ssp += __shfl_xor(ssp, o);
                const float a = x1 * P.mla_k_norm[128 + i], c = x2 * P.mla_k_norm[160 + i];
                if (lane < 32) { ROPE[(size_t)tok * 64 + i] = cs; ROPE[(size_t)tok * 64 + 32 + i] = sn;
                    KPER[(size_t)tok * 64 + i] = a * cs - c * sn; KPER[(size_t)tok * 64 + 32 + i] = c * cs + a * sn;
                    if (lane == 0) SSPE[tok] = ssp; }
            }
        }
    }
}

DI void phase_mla_prep2(const Params& P, int bid, int nb) {
    const bf16_t* KNM = (const bf16_t*)(P.ws + OFF_KNM); const bf16_t* Y1 = (const bf16_t*)(P.ws + OFF_Y1);
    bf16_t* KM = (bf16_t*)(P.ws + OFF_KM); const float* ROPE = (const float*)(P.ws + OFF_ROPE);
    const int tid = tid_opaque(), grp = tid >> 3, j8 = tid & 7;
    for (int tok = bid; tok < MTOK; tok += nb) {
        const int b = tok / SEQ, s = tok % SEQ;
        float cs[8], sn[8];
#pragma unroll
        for (int e = 0; e < 8; ++e) { const int i = (8 * j8 + e) & 31; cs[e] = ROPE[(size_t)tok * 64 + i]; sn[e] = ROPE[(size_t)tok * 64 + 32 + i]; }
        {
            const bf16_t* kn = KNM + (size_t)tok * (NH * 128) + grp * 128;
            const bf16_t* kp = Y1 + (size_t)tok * N3P + C3_KPE;
            float v[24];
#pragma unroll
            for (int c = 0; c < 2; ++c) { const u32x4 w = *(const u32x4*)(kn + (j8 + 8 * c) * 8);
                v[c * 8 + 0] = bflo(w.x); v[c * 8 + 1] = bfhi(w.x); v[c * 8 + 2] = bflo(w.y); v[c * 8 + 3] = bfhi(w.y);
                v[c * 8 + 4] = bflo(w.z); v[c * 8 + 5] = bfhi(w.z); v[c * 8 + 6] = bflo(w.w); v[c * 8 + 7] = bfhi(w.w); }
            { const u32x4 w = *(const u32x4*)(kp + j8 * 8);
                v[16] = bflo(w.x); v[17] = bfhi(w.x); v[18] = bflo(w.y); v[19] = bfhi(w.y); v[20] = bflo(w.z); v[21] = bfhi(w.z); v[22] = bflo(w.w); v[23] = bfhi(w.w); }
            float ss = 0.f;
#pragma unroll
            for (int i = 0; i < 24; ++i) ss += v[i] * v[i];
            ss = sum8(ss);
            const float rstd = rsqrtf(ss * (1.0f / DK) + EPSN);
#pragma unroll
            for (int c = 0; c < 3; ++c)
#pragma unroll
                for (int e = 0; e < 8; ++e) v[c * 8 + e] *= rstd * P.mla_k_norm[(j8 + 8 * c) * 8 + e];
#pragma unroll
            for (int e = 0; e < 8; ++e) { const float mine = v[16 + e], other = __shfl_xor(mine, 4);
                v[16 + e] = (j8 < 4) ? (mine * cs[e] - other * sn[e]) : (mine * cs[e] + other * sn[e]); }
            st192(KM + ((size_t)(b * NH + grp) * SEQ + s) * DK, j8, v);
        }
    }
}
#ifndef ATT_THR
#define ATT_THR 30.0f
#endif
#ifndef ATT3_HOIST
#define ATT3_HOIST 1
#endif
#ifndef PROBE3_STORE2
#define PROBE3_STORE2 1
#endif
#ifndef PROBE3_UNITS
#define PROBE3_UNITS 1
#endif
#ifndef PROBE3_CMP
#define PROBE3_CMP 1
#endif
#ifndef PROBE3_SEL
#define PROBE3_SEL 1
#endif
#ifndef PROBE3_WIN
#define PROBE3_WIN 1
#endif
#ifndef ATT3_KD
#define ATT3_KD 4
#endif
#ifndef ATT3_VD
#define ATT3_VD 4
#endif
#ifndef ATT_PS_LIMIT
#define ATT_PS_LIMIT (16.0f * 1073741824.0f)
#endif
constexpr int KT_BYTES = 64 * 384, VT_BYTES = 128 * 128;
constexpr int L_K = 0, L_V = 2 * KT_BYTES, L_LUT = L_V + 2 * VT_BYTES, LUT_PITCH = 129, L_X = L_LUT + 64 * LUT_PITCH * 4 + 16, L_IL = L_X + 16 * 16 * 64 * 2, L_END = L_IL + 16 * 16 * 4;
static_assert(L_END <= 151552, "attention LDS");
enum { MODE_MLA = 0, MODE_SEL = 3, MODE_WIN = 4, MODE_CMPX = 5 };
#define MFMA16(a, b, c) __builtin_amdgcn_mfma_f32_16x16x32_bf16((a), (b), (c), 0, 0, 0)

struct AttnLane3 {
    int tw0, tw1;
    int r16, g;
    const LAS float* lutrow;
    unsigned long long mk0, mk1;
    int curblk;
    int tokbase;
    mutable float carry[2];
};
template <int MODE> DI int tq_of(const AttnLane3& A, int qb) { return (MODE == MODE_MLA) ? A.tw0 + 16 * qb + A.r16 : A.tw0 + qb; }

template <int MODE, int QS>
DI void attn_tile3(const LAS unsigned char* kb, const LAS unsigned char* vb, LAS unsigned char* lds, int j, const bf16x8 (&q)[2][6], f32x4 (&o)[8][2], float (&m_run)[2], float (&l_run)[2], const AttnLane3& A) {
    constexpr bool Q0 = (QS & 1) != 0, Q1 = (QS & 2) != 0;
    const int r16 = A.r16, g = A.g, sw = (r16 >> 1) & 7;
    const int kb0 = r16 * 384 + ((g ^ sw) << 4), kb1 = r16 * 384 + (((g ^ sw) ^ 4) << 4);
    const int vb0 = r16 * 128 + ((g ^ sw) << 4), vb1 = r16 * 128 + (((g ^ sw) ^ 4) << 4);
    f32x4 s[4][2];
    bool zinit = true;
    if (MODE == MODE_WIN || MODE == MODE_SEL) zinit = (A.tw0 - (64 * j + 63) >= 113);
    else if (MODE == MODE_CMPX) zinit = (A.tw0 - 31 - 16 * (64 * j + 63) >= 113);
    if (zinit) {
#pragma unroll
        for (int k4 = 0; k4 < 4; ++k4) { s[k4][0] = (f32x4){0.f, 0.f, 0.f, 0.f}; s[k4][1] = (f32x4){0.f, 0.f, 0.f, 0.f}; }
    } else {
#pragma unroll
        for (int qb = 0; qb < 2; ++qb) { if ((qb == 0 && !Q0) || (qb == 1 && !Q1)) continue;
            const int tq = tq_of<MODE>(A, qb);
#pragma unroll
            for (int k4 = 0; k4 < 4; ++k4)
#pragma unroll
                for (int r = 0; r < 4; ++r) { int d;
                    if (MODE == MODE_CMPX) d = tq - 31 - 16 * (64 * j + 16 * k4 + 4 * g + r); else d = tq - (64 * j + 16 * k4 + 4 * g + r);
                    d = d < 0 ? 0 : (d > 127 ? 127 : d); s[k4][qb][r] = A.lutrow[d] - m_run[qb]; } }
    }
    {
        constexpr int KD = ATT3_KD;
        bf16x8 kf[KD + 1];
#pragma unroll
        for (int i = 0; i < KD; ++i) kf[i] = *(const LAS bf16x8*)(kb + (((i % 6) & 1) ? kb1 : kb0) + ((i % 6) >> 1) * 128 + (i / 6) * (16 * 384));
        __builtin_amdgcn_sched_barrier(0);
#pragma unroll
        for (int i = 0; i < 24; ++i) {
            if (i + KD < 24) { const int n_ = i + KD; kf[n_ % (KD + 1)] = *(const LAS bf16x8*)(kb + (((n_ % 6) & 1) ? kb1 : kb0) + ((n_ % 6) >> 1) * 128 + (n_ / 6) * (16 * 384)); }
            __builtin_amdgcn_sched_barrier(0);
            if (Q0) s[i / 6][0] = MFMA16(kf[i % (KD + 1)], q[0][i % 6], s[i / 6][0]);
            if (Q1) s[i / 6][1] = MFMA16(kf[i % (KD + 1)], q[1][i % 6], s[i / 6][1]);
            __builtin_amdgcn_sched_barrier(0);
        }
    }
    if (zinit && __any(m_run[0] != 0.f || m_run[1] != 0.f)) {
#pragma unroll
        for (int k4 = 0; k4 < 4; ++k4)
#pragma unroll
            for (int r = 0; r < 4; ++r) { s[k4][0][r] -= m_run[0]; s[k4][1][r] -= m_run[1]; }
    }
    {
        const float NEG = -__builtin_inff();
        bool need;
        if (MODE == MODE_MLA) need = (64 * j + 63 > A.tw0);
        else if (MODE == MODE_WIN) need = !(64 * j + 63 <= A.tw0 && 64 * j >= A.tw1 - 511);
        else if (MODE == MODE_SEL) need = (j == A.curblk);
        else need = (A.tw0 - 31 - 16 * (64 * j + 63) < 0);
        if (need) {
#pragma unroll
            for (int qb = 0; qb < 2; ++qb) { if ((qb == 0 && !Q0) || (qb == 1 && !Q1)) continue;
                const int tq = tq_of<MODE>(A, qb);
#pragma unroll
                for (int k4 = 0; k4 < 4; ++k4)
#pragma unroll
                    for (int r = 0; r < 4; ++r) { const int c = 64 * j + 16 * k4 + 4 * g + r; bool kill;
                        if (MODE == MODE_WIN) kill = (unsigned)(tq - c) >= 512u;
                        else if (MODE == MODE_CMPX) kill = (tq - 31 - 16 * c) < 0;
                        else kill = (tq - c) < 0;
                        s[k4][qb][r] = kill ? NEG : s[k4][qb][r]; } }
        }
    }
    u32x4 pw[2][2];
#pragma unroll
    for (int qb = 0; qb < 2; ++qb) { if ((qb == 0 && !Q0) || (qb == 1 && !Q1)) continue;
        if (MODE == MODE_CMPX) {
            float lmx = fmaxf(fmaxf(s[0][qb][0], s[0][qb][1]), fmaxf(s[0][qb][2], s[0][qb][3]));
#pragma unroll
            for (int k4 = 1; k4 < 4; ++k4) lmx = fmaxf(lmx, fmaxf(fmaxf(s[k4][qb][0], s[k4][qb][1]), fmaxf(s[k4][qb][2], s[k4][qb][3])));
            if (__any(lmx > ATT_THR)) {
                float mx = fmaxf(lmx, __shfl_xor(lmx, 16)); mx = fmaxf(mx, __shfl_xor(mx, 32));
                const float dl = fmaxf(mx, 0.f), alpha = __builtin_amdgcn_exp2f(-dl);
                m_run[qb] += dl; l_run[qb] *= alpha; A.carry[qb] *= alpha;
#pragma unroll
                for (int db = 0; db < 8; ++db) o[db][qb] *= alpha;
#pragma unroll
                for (int k4 = 0; k4 < 4; ++k4) s[k4][qb] -= dl;
                LAS bf16_t* X = (LAS bf16_t*)(lds + L_X) + ((A.tokbase + qb) * 16 + r16) * 64;
                for (int a = g; a < 16 * j; a += 4) X[a] = (bf16_t)(pk2(bf1(X[a]) * alpha, 0.f) & 0xffffu);
            }
        }
        float ps = 0.f; f32x4 e[4];
#pragma unroll
        for (int k4 = 0; k4 < 4; ++k4) { e[k4][0] = __builtin_amdgcn_exp2f(s[k4][qb][0]); e[k4][1] = __builtin_amdgcn_exp2f(s[k4][qb][1]); e[k4][2] = __builtin_amdgcn_exp2f(s[k4][qb][2]); e[k4][3] = __builtin_amdgcn_exp2f(s[k4][qb][3]);
            ps += (e[k4][0] + e[k4][1]) + (e[k4][2] + e[k4][3]); }
        if (MODE != MODE_CMPX) {
            if (__any(!(ps <= ATT_PS_LIMIT))) {
                float mx = fmaxf(fmaxf(s[0][qb][0], s[0][qb][1]), fmaxf(s[0][qb][2], s[0][qb][3]));
#pragma unroll
                for (int k4 = 1; k4 < 4; ++k4) mx = fmaxf(mx, fmaxf(fmaxf(s[k4][qb][0], s[k4][qb][1]), fmaxf(s[k4][qb][2], s[k4][qb][3])));
                mx = fmaxf(mx, __shfl_xor(mx, 16)); mx = fmaxf(mx, __shfl_xor(mx, 32));
                const float dl = fmaxf(mx, 0.f), alpha = __builtin_amdgcn_exp2f(-dl);
                m_run[qb] += dl; l_run[qb] *= alpha;
#pragma unroll
                for (int db = 0; db < 8; ++db) o[db][qb] *= alpha;
                ps = 0.f;
#pragma unroll
                for (int k4 = 0; k4 < 4; ++k4) { e[k4][0] = __builtin_amdgcn_exp2f(s[k4][qb][0] - dl); e[k4][1] = __builtin_amdgcn_exp2f(s[k4][qb][1] - dl); e[k4][2] = __builtin_amdgcn_exp2f(s[k4][qb][2] - dl); e[k4][3] = __builtin_amdgcn_exp2f(s[k4][qb][3] - dl);
                    ps += (e[k4][0] + e[k4][1]) + (e[k4][2] + e[k4][3]); }
            }
        } else {
            LAS bf16_t* X = (LAS bf16_t*)(lds + L_X) + ((A.tokbase + qb) * 16 + r16) * 64;
#pragma unroll
            for (int k4 = 0; k4 < 4; ++k4) {
                const float y = __shfl(e[k4][3], (r16 + 16 * g + 48) & 63);
                const float prev = g ? y : A.carry[qb];
                if (g == 0) A.carry[qb] = y;
                X[16 * j + 4 * k4 + g] = (bf16_t)(pk2((e[k4][0] + e[k4][1]) + (e[k4][2] + e[k4][3]) + prev, 0.f) & 0xffffu);
            }
        }
        l_run[qb] += ps;
        pw[0][qb].x = pk2(e[0][0], e[0][1]); pw[0][qb].y = pk2(e[0][2], e[0][3]); pw[0][qb].z = pk2(e[1][0], e[1][1]); pw[0][qb].w = pk2(e[1][2], e[1][3]);
        pw[1][qb].x = pk2(e[2][0], e[2][1]); pw[1][qb].y = pk2(e[2][2], e[2][3]); pw[1][qb].z = pk2(e[3][0], e[3][1]); pw[1][qb].w = pk2(e[3][2], e[3][3]);
    }
    {
        constexpr int VD = ATT3_VD;
        bf16x8 vf[VD + 1];
#pragma unroll
        for (int i = 0; i < VD; ++i) vf[i] = *(const LAS bf16x8*)(vb + ((i >> 3) ? vb1 : vb0) + (i & 7) * (16 * 128));
        __builtin_amdgcn_sched_barrier(0);
#pragma unroll
        for (int i = 0; i < 16; ++i) {
            if (i + VD < 16) { const int n_ = i + VD; vf[n_ % (VD + 1)] = *(const LAS bf16x8*)(vb + ((n_ >> 3) ? vb1 : vb0) + (n_ & 7) * (16 * 128)); }
            __builtin_amdgcn_sched_barrier(0);
            if (Q0) o[i & 7][0] = MFMA16(vf[i % (VD + 1)], __builtin_bit_cast(bf16x8, pw[i >> 3][0]), o[i & 7][0]);
            if (Q1) o[i & 7][1] = MFMA16(vf[i % (VD + 1)], __builtin_bit_cast(bf16x8, pw[i >> 3][1]), o[i & 7][1]);
            __builtin_amdgcn_sched_barrier(0);
        }
    }
}

DI void attn_issue_first(LAS unsigned char* lds, const char* __restrict__ Kc, const char* __restrict__ Vc, int vt_stride, int j) {
    int tid = threadIdx.x; asm volatile("" : "+v"(tid));
    const int lane = tid & 63;
    const int wid_ = __builtin_amdgcn_readfirstlane(tid >> 6);
    const char* kp_ = Kc + (size_t)j * KT_BYTES; LAS unsigned char* kb_ = lds + L_K + wid_ * 3072;
#pragma unroll
    for (int i_ = 0; i_ < 3; ++i_) { const int pidx_ = (wid_ * 3 + i_) * 64 + lane, row_ = pidx_ / 24, cp_ = pidx_ % 24;
        __builtin_amdgcn_global_load_lds((const unsigned*)(kp_ + (unsigned)(row_ * 384 + ((cp_ ^ ((row_ >> 1) & 7)) << 4))), (LAS unsigned*)(kb_ + i_ * 1024), 16, 0, 0); }
    const char* vp_ = Vc + (size_t)j * 128; LAS unsigned char* vb_ = lds + L_V + wid_ * 2048;
#pragma unroll
    for (int i_ = 0; i_ < 2; ++i_) { const int pidx_ = (wid_ * 2 + i_) * 64 + lane, row_ = pidx_ >> 3, cp_ = pidx_ & 7;
        __builtin_amdgcn_global_load_lds((const unsigned*)(vp_ + (unsigned)(row_ * vt_stride * 2 + ((cp_ ^ ((row_ >> 1) & 7)) << 4))), (LAS unsigned*)(vb_ + i_ * 1024), 16, 0, 0); }
}

template <int MODE>
DI void attn_pass3x(LAS unsigned char* lds, const char* __restrict__ Kc, const char* __restrict__ Vc, int vt_stride, int j_lo, int j_hi,
                    const bf16x8 (&q)[2][6], f32x4 (&o)[8][2], float (&m_run)[2], float (&l_run)[2], const AttnLane3& A, bool first_issued = false) {
    if (j_lo >= j_hi) return;
    int tid = threadIdx.x; asm volatile("" : "+v"(tid));
    const int lane = tid & 63;
    const int wid_ = __builtin_amdgcn_readfirstlane(tid >> 6);
    unsigned kgo[3], vgo[2];
#pragma unroll
    for (int i_ = 0; i_ < 3; ++i_) { const int pidx_ = (wid_ * 3 + i_) * 64 + lane, row_ = pidx_ / 24, cp_ = pidx_ % 24; kgo[i_] = (unsigned)(row_ * 384 + ((cp_ ^ ((row_ >> 1) & 7)) << 4)); }
#pragma unroll
    for (int i_ = 0; i_ < 2; ++i_) { const int pidx_ = (wid_ * 2 + i_) * 64 + lane, row_ = pidx_ >> 3, cp_ = pidx_ & 7; vgo[i_] = (unsigned)(row_ * vt_stride * 2 + ((cp_ ^ ((row_ >> 1) & 7)) << 4)); }
#define ST_ISSUE(j, buf) do { const char* kp_ = Kc + (size_t)(j) * KT_BYTES; LAS unsigned char* kb_ = lds + L_K + (buf) * KT_BYTES + wid_ * 3072; \
        _Pragma("unroll") for (int i_ = 0; i_ < 3; ++i_) __builtin_amdgcn_global_load_lds((const unsigned*)(kp_ + kgo[i_]), (LAS unsigned*)(kb_ + i_ * 1024), 16, 0, 0); \
        const char* vp_ = Vc + (size_t)(j) * 128; LAS unsigned char* vb_ = lds + L_V + (buf) * VT_BYTES + wid_ * 2048; \
        _Pragma("unroll") for (int i_ = 0; i_ < 2; ++i_) __builtin_amdgcn_global_load_lds((const unsigned*)(vp_ + vgo[i_]), (LAS unsigned*)(vb_ + i_ * 1024), 16, 0, 0); } while (0)
    if (!first_issued) ST_ISSUE(j_lo, 0);
    asm volatile("s_waitcnt vmcnt(0)" ::: "memory");
    __syncthreads();
    for (int j = j_lo; j < j_hi; ++j) {
        const int cur = (j - j_lo) & 1;
        if (j + 1 < j_hi) ST_ISSUE(j + 1, cur ^ 1);
        const LAS unsigned char* kbp = lds + L_K + cur * KT_BYTES; const LAS unsigned char* vbp = lds + L_V + cur * VT_BYTES;
        if (MODE == MODE_SEL) {
            const bool a0 = ((A.mk0 >> j) & 1ull) != 0ull, a1 = ((A.mk1 >> j) & 1ull) != 0ull;
            if (a0 && a1) attn_tile3<MODE, 3>(kbp, vbp, lds, j, q, o, m_run, l_run, A);
            else if (a0) attn_tile3<MODE, 1>(kbp, vbp, lds, j, q, o, m_run, l_run, A);
            else if (a1) attn_tile3<MODE, 2>(kbp, vbp, lds, j, q, o, m_run, l_run, A);
        } else {
            bool act;
            if (MODE == MODE_MLA) act = 64 * j <= A.tw1;
            else if (MODE == MODE_CMPX) act = 1024 * j + 31 <= A.tw1;
            else act = (64 * j <= A.tw1) && (64 * j + 63 >= A.tw0 - 511);
            if (act) attn_tile3<MODE, 3>(kbp, vbp, lds, j, q, o, m_run, l_run, A);
        }
        asm volatile("s_waitcnt vmcnt(0)" ::: "memory");
        __syncthreads();
    }
#undef ST_ISSUE
}

DI int t5_bucket(int n) {
    if (n < 16) return n;
    return 16 + (n >= 19) + (n >= 21) + (n >= 24) + (n >= 27) + (n >= 31) + (n >= 35) + (n >= 40) + (n >= 46) + (n >= 52) + (n >= 59) + (n >= 67) + (n >= 77) + (n >= 87) + (n >= 99) + (n >= 113);
}
DI float silu_f(float z) { return z * __builtin_amdgcn_rcpf(1.0f + __builtin_amdgcn_exp2f(-1.4426950408889634f * z)); }

constexpr int EPI_PITCH = 272, EPI_WAVE_BYTES = 32 * EPI_PITCH;
template <bool RMW, bool NSA, int F8 = 0>
DI void attn_epilogue3(LAS unsigned char* lds, int lane, int wid, const f32x4 (&o)[8][2], float scale0, float scale1,
                       const char* __restrict__ zbase, unsigned z0, char* __restrict__ obase, unsigned o0, bool dostore = true, char* __restrict__ o8base = nullptr, float o8s = O8_SCALE, bool both = true) {
    asm volatile("" : "+v"(lane));
    LAS unsigned char* sc = lds + wid * EPI_WAVE_BYTES;
    const int r16 = lane & 15, g = lane >> 4;
#pragma unroll
    for (int h = 0; h < 2; ++h) {
#pragma unroll
        for (int d4 = 0; d4 < 4; ++d4) {
            *(LAS f32x4*)(sc + r16 * EPI_PITCH + (16 * d4 + 4 * g) * 4) = o[4 * h + d4][0] * scale0;
            *(LAS f32x4*)(sc + (16 + r16) * EPI_PITCH + (16 * d4 + 4 * g) * 4) = o[4 * h + d4][1] * scale1;
        }
        asm volatile("" ::: "memory");
#pragma unroll
        for (int i = 0; i < 4; ++i) {
            const int rr = 8 * i + (lane >> 3), c8 = lane & 7;
            const f32x4 a = *(const LAS f32x4*)(sc + rr * EPI_PITCH + c8 * 32);
            const f32x4 b = *(const LAS f32x4*)(sc + rr * EPI_PITCH + c8 * 32 + 16);
            unsigned zoff, ooff;
            if (NSA) { zoff = z0 + (unsigned)((rr >> 4) * (N1P * 2) + (rr & 15) * 256); ooff = o0 + (unsigned)((rr >> 4) * (ZW8 * 2) + (rr & 15) * 256); }
            else     { zoff = z0 + (unsigned)(rr * (N3P * 2)); ooff = o0 + (unsigned)(rr * (ZW8 * 2)); }
            const unsigned cb = (unsigned)((64 * h + 8 * c8) * 2);
            if (!dostore) continue;
            const u32x4 zw = *(const u32x4*)(zbase + (zoff + cb));
            float v0 = a[0] * silu_f(bflo(zw.x)), v1 = a[1] * silu_f(bfhi(zw.x)), v2 = a[2] * silu_f(bflo(zw.y)), v3 = a[3] * silu_f(bfhi(zw.y));
            float v4 = b[0] * silu_f(bflo(zw.z)), v5 = b[1] * silu_f(bfhi(zw.z)), v6 = b[2] * silu_f(bflo(zw.w)), v7 = b[3] * silu_f(bfhi(zw.w));
            if (RMW) { const u32x4 pv = *(const u32x4*)(obase + (ooff + cb));
                v0 += bflo(pv.x); v1 += bfhi(pv.x); v2 += bflo(pv.y); v3 += bfhi(pv.y); v4 += bflo(pv.z); v5 += bfhi(pv.z); v6 += bflo(pv.w); v7 += bfhi(pv.w); }
            if (F8) { u32x2 w8; w8.x = pk4_fp8c(v0 * o8s, v1 * o8s, v2 * o8s, v3 * o8s); w8.y = pk4_fp8c(v4 * o8s, v5 * o8s, v6 * o8s, v7 * o8s);
                *(u32x2*)(o8base + ((ooff + cb) >> 1)) = w8; if (F8 == 1) continue; }
            u32x4 w; w.x = pk2(v0, v1); w.y = pk2(v2, v3); w.z = pk2(v4, v5); w.w = pk2(v6, v7);
            if (F8 != 2 || both) *(u32x4*)(obase + (ooff + cb)) = w;
        }
        asm volatile("" ::: "memory");
    }
}
DI float sum_g(float v) { v += __shfl_xor(v, 16); v += __shfl_xor(v, 32); return v; }

DI void phase_nsa_attn(LAS unsigned char* lds, const Params& P, int bid, int nb) {
    const char* Y0c = (const char*)(P.ws + OFF_Y0);
    const char* KSc = (const char*)(P.ws + OFF_KS); const char* KWc = (const char*)(P.ws + OFF_KW);
    const char* VTSc = (const char*)(P.ws + OFF_VTS); const char* VTWc = (const char*)(P.ws + OFF_VTW);
    const char* KCc = (const char*)(P.ws + OFF_KC); const char* VTCc = (const char*)(P.ws + OFF_VTC);
    char* ONc = (char*)(P.ws + OFF_O);
    LAS float* lut = (LAS float*)(lds + L_LUT);
    const int total = BATCH * NG * 256;
    {
        const int tid0 = tid_opaque();
        __syncthreads();
        for (int i = tid0; i < 64 * 128; i += 512) { const int hd = i >> 7, d = i & 127; lut[hd * LUT_PITCH + d] = (P.rel_bias[t5_bucket(d) * NH + hd] - P.rel_bias[31 * NH + hd]) * LOG2E; }
        __syncthreads();
    }
    for (int u_ = bid; u_ < total * PROBE3_UNITS; u_ += nb) {
        const int u = (u_ >= total) ? u_ - total : u_;
        int tid = threadIdx.x; asm volatile("" : "+v"(tid));
        const int lane = tid & 63, wid = __builtin_amdgcn_readfirstlane(tid >> 6);
        const int pair = u >> 8; int c = u & 255; if (pair & 1) c = 255 - c;
        const int b = pair >> 2, gg = pair & 3, t0 = c * 16;
        __syncthreads();
        AttnLane3 A;
        A.r16 = lane & 15; A.g = lane >> 4;
        A.tw0 = t0 + 2 * wid; A.tw1 = A.tw0 + 1;
        const int hh = gg * NR + A.r16;
        A.lutrow = lut + hh * LUT_PITCH;
        A.curblk = t0 >> 6; A.tokbase = 2 * wid; A.mk0 = 0ull; A.mk1 = 0ull; A.carry[0] = 0.f; A.carry[1] = 0.f;
        const unsigned ytok0 = (unsigned)(b * SEQ + A.tw0) * (unsigned)(N1P * 2);
        const unsigned otok0 = ((unsigned)(b * SEQ + A.tw0) * (unsigned)ZW8 + (unsigned)(gg * NR * DV)) * 2u;
        const int bg = b * NG + gg;
        const int nct = (t0 + 15 >= 31) ? (((t0 + 15 - 31) >> 4) / 64 + 1) : 0;
        if (ATT3_HOIST && nct > 0) attn_issue_first(lds, KCc + (size_t)bg * 256 * DK * 2, VTCc + (size_t)bg * DV * 256 * 2, 256, 0);
        bf16x8 q[2][6];
#pragma unroll
        for (int qb = 0; qb < 2; ++qb) {
            const unsigned qo = ytok0 + (unsigned)(qb * (N1P * 2)) + (unsigned)((C_Q + hh * DK + 8 * A.g) * 2);
            float ss = 0.f;
#pragma unroll
            for (int ds = 0; ds < 6; ++ds) { q[qb][ds] = *(const bf16x8*)(Y0c + (qo + 64u * ds));
                const u32x4 w = __builtin_bit_cast(u32x4, q[qb][ds]);
                const float a0 = bflo(w.x), a1 = bfhi(w.x), a2 = bflo(w.y), a3 = bfhi(w.y), a4 = bflo(w.z), a5 = bfhi(w.z), a6 = bflo(w.w), a7 = bfhi(w.w);
                ss += (a0 * a0 + a1 * a1) + (a2 * a2 + a3 * a3) + (a4 * a4 + a5 * a5) + (a6 * a6 + a7 * a7); }
            ss = sum_g(ss);
            const float rstd = rsqrtf(ss * (1.0f / DK) + EPSN) * QSCALE;
#pragma unroll
            for (int ds = 0; ds < 6; ++ds) { const float* gn = P.nsa_q_norm + 32 * ds + 8 * A.g; const f32x4 g0 = *(const f32x4*)gn, g1 = *(const f32x4*)(gn + 4);
                u32x4 w = __builtin_bit_cast(u32x4, q[qb][ds]);
                w.x = pk2(bflo(w.x) * rstd * g0[0], bfhi(w.x) * rstd * g0[1]); w.y = pk2(bflo(w.y) * rstd * g0[2], bfhi(w.y) * rstd * g0[3]);
                w.z = pk2(bflo(w.z) * rstd * g1[0], bfhi(w.z) * rstd * g1[1]); w.w = pk2(bflo(w.w) * rstd * g1[2], bfhi(w.w) * rstd * g1[3]);
                q[qb][ds] = __builtin_bit_cast(bf16x8, w); }
        }
        f32x4 o[8][2]; float m_run[2], l_run[2];
#define RESET_STATE() do { _Pragma("unroll") for (int d_ = 0; d_ < 8; ++d_) { o[d_][0] = (f32x4){0.f, 0.f, 0.f, 0.f}; o[d_][1] = (f32x4){0.f, 0.f, 0.f, 0.f}; } m_run[0] = 0.f; m_run[1] = 0.f; l_run[0] = 0.f; l_run[1] = 0.f; } while (0)
#define GATE_SIG(x, qb) (1.0f / (1.0f + __expf(-bf1(*(const bf16_t*)(Y0c + (ytok0 + (unsigned)((qb) * (N1P * 2)) + (unsigned)((C_G + (x) * NH + hh) * 2)))))))
        RESET_STATE();
        attn_pass3x<MODE_CMPX>(lds, KCc + (size_t)bg * 256 * DK * 2, VTCc + (size_t)bg * DV * 256 * 2, 256, 0, nct, q, o, m_run, l_run, A, ATT3_HOIST != 0);
        { const float lt0 = sum_g(l_run[0]), lt1 = sum_g(l_run[1]); const float il0 = lt0 > 0.f ? 1.0f / lt0 : 0.f, il1 = lt1 > 0.f ? 1.0f / lt1 : 0.f;
          if (lane < 16) { ((LAS float*)(lds + L_IL))[(A.tokbase + 0) * 16 + A.r16] = il0; ((LAS float*)(lds + L_IL))[(A.tokbase + 1) * 16 + A.r16] = il1; }
          attn_epilogue3<false, true>(lds, lane, wid, o, GATE_SIG(0, 0) * il0, GATE_SIG(0, 1) * il1, Y0c, ytok0 + (unsigned)((C_ZC + gg * NR * DV) * 2), ONc, otok0, PROBE3_STORE2 || u_ < total); }
        __syncthreads();
        if (ATT3_HOIST) attn_issue_first(lds, KSc + (size_t)bg * SEQ * DK * 2, VTSc + (size_t)bg * DV * SEQ * 2, SEQ, 0);
        {
            const int cur = A.curblk;
            unsigned long long mk[2];
#pragma unroll
            for (int t = 0; t < 2; ++t) {
                const LAS bf16_t* X = (const LAS bf16_t*)(lds + L_X) + (2 * wid + t) * 16 * 64;
                const LAS float* IL = (const LAS float*)(lds + L_IL) + (2 * wid + t) * 16;
                const bool forced = (lane == 0) || (lane == cur) || (lane == cur - 1);
                const bool future = lane > cur;
                float v = 0.f;
                if (!forced && !future) {
#pragma unroll
                    for (int rr = 0; rr < 16; ++rr) v += IL[rr] * bf1(X[rr * 64 + lane]); }
                unsigned key = (__float_as_uint(v) & ~63u);
                if (forced) key = 0x7f800000u; else if (future) key = 0u;
                key |= (unsigned)(63 - lane);
                int rank = 0;
#pragma unroll
                for (int jp = 0; jp < 64; ++jp) { const unsigned kj = (unsigned)__builtin_amdgcn_readlane((int)key, jp); rank += (kj > key) ? 1 : 0; }
                mk[t] = __ballot(rank < 16 && !future);
            }
            A.mk0 = mk[0]; A.mk1 = mk[1];
        }
        RESET_STATE();
        attn_pass3x<MODE_SEL>(lds, KSc + (size_t)bg * SEQ * DK * 2, VTSc + (size_t)bg * DV * SEQ * 2, SEQ, 0, A.curblk + 1, q, o, m_run, l_run, A, ATT3_HOIST != 0);
        { const float lt0 = sum_g(l_run[0]), lt1 = sum_g(l_run[1]);
          attn_epilogue3<true, true>(lds, lane, wid, o, GATE_SIG(1, 0) / lt0, GATE_SIG(1, 1) / lt1, Y0c, ytok0 + (unsigned)((C_ZS + gg * NR * DV) * 2), ONc, otok0, PROBE3_STORE2 || u_ < total); }
        __syncthreads();
        RESET_STATE();
        { const int jl = (t0 - 511) > 0 ? (t0 - 511) >> 6 : 0, jh = ((t0 + 15) >> 6) + 1;
          for (int prb_ = 0; prb_ < PROBE3_WIN; ++prb_) attn_pass3x<MODE_WIN>(lds, KWc + (size_t)bg * SEQ * DK * 2, VTWc + (size_t)bg * DV * SEQ * 2, SEQ, jl, jh, q, o, m_run, l_run, A); }
        { const float lt0 = sum_g(l_run[0]), lt1 = sum_g(l_run[1]);
          attn_epilogue3<true, true, USE_FP8N ? 2 : 0>(lds, lane, wid, o, GATE_SIG(2, 0) / lt0, GATE_SIG(2, 1) / lt1, Y0c, ytok0 + (unsigned)((C_ZW + gg * NR * DV) * 2), ONc, otok0, PROBE3_STORE2 || u_ < total, (char*)(P.ws + OFF_O8N), O8N_SCALE, t0 < 256); }
#undef RESET_STATE
#undef GATE_SIG
    }
}

DI void phase_mla_attn(LAS unsigned char* lds, const Params& P, int bid, int nb) {
    const char* QMc = (const char*)(P.ws + OFF_QM); const char* KMc = (const char*)(P.ws + OFF_KM); const char* VTMc = (const char*)(P.ws + OFF_VTM);
    const char* Y1c = (const char*)(P.ws + OFF_Y1); char* OMc = (char*)(P.ws + OFF_O);
    const int total = BATCH * NH * 16;
    for (int uu = 0; bid + (uu >> 1) * nb < total / 2; ++uu) {
        int tid = threadIdx.x; asm volatile("" : "+v"(tid));
        const int lane = tid & 63, wid = __builtin_amdgcn_readfirstlane(tid >> 6);
        const int item = bid + (uu >> 1) * nb, second = uu & 1;
        const int xcd = item & 7, tt = item >> 3, p = tt & 7, hl = (tt >> 3) & 3, rnd = tt >> 5;
        const int bh = rnd * 32 + xcd * 4 + hl, qblk = second ? p : 15 - p, b = bh >> 6, h = bh & 63, t0 = qblk * 256;
        AttnLane3 A;
        A.r16 = lane & 15; A.g = lane >> 4;
        A.tw0 = t0 + 32 * wid; A.tw1 = A.tw0 + 31;
        A.lutrow = nullptr; A.curblk = 0; A.tokbase = 0; A.mk0 = 0ull; A.mk1 = 0ull; A.carry[0] = 0.f; A.carry[1] = 0.f;
        bf16x8 q[2][6];
#pragma unroll
        for (int qb = 0; qb < 2; ++qb) {
            const unsigned trow = (unsigned)(b * SEQ + A.tw0 + 16 * qb + A.r16);
            const unsigned qo = (trow * (unsigned)NQB + (unsigned)(h * DK + 8 * A.g)) * 2u;
            float ss = 0.f;
#pragma unroll
            for (int ds = 0; ds < 6; ++ds) { q[qb][ds] = *(const bf16x8*)(QMc + (qo + 64u * ds));
                const u32x4 w = __builtin_bit_cast(u32x4, q[qb][ds]);
                const float a0 = bflo(w.x), a1 = bfhi(w.x), a2 = bflo(w.y), a3 = bfhi(w.y), a4 = bflo(w.z), a5 = bfhi(w.z), a6 = bflo(w.w), a7 = bfhi(w.w);
                ss += (a0 * a0 + a1 * a1) + (a2 * a2 + a3 * a3) + (a4 * a4 + a5 * a5) + (a6 * a6 + a7 * a7); }
            ss = sum_g(ss);
            const float rstd = rsqrtf(ss * (1.0f / DK) + EPSN);
            const float* ropep = (const float*)(P.ws + OFF_ROPE) + (size_t)trow * 64;
#pragma unroll
            for (int ds = 0; ds < 4; ++ds) { const float* gn = P.mla_q_norm + 32 * ds + 8 * A.g; const f32x4 g0 = *(const f32x4*)gn, g1 = *(const f32x4*)(gn + 4);
                const float sc = rstd * QSCALE;
                u32x4 w = __builtin_bit_cast(u32x4, q[qb][ds]);
                w.x = pk2(bflo(w.x) * sc * g0[0], bfhi(w.x) * sc * g0[1]); w.y = pk2(bflo(w.y) * sc * g0[2], bfhi(w.y) * sc * g0[3]);
                w.z = pk2(bflo(w.z) * sc * g1[0], bfhi(w.z) * sc * g1[1]); w.w = pk2(bflo(w.w) * sc * g1[2], bfhi(w.w) * sc * g1[3]);
                q[qb][ds] = __builtin_bit_cast(bf16x8, w); }
            {
                const int i0 = 8 * A.g;
                const float* g1p = P.mla_q_norm + 128 + i0; const float* g2p = P.mla_q_norm + 160 + i0;
                const u32x4 w1 = __builtin_bit_cast(u32x4, q[qb][4]), w2 = __builtin_bit_cast(u32x4, q[qb][5]);
                float x1[8] = {bflo(w1.x), bfhi(w1.x), bflo(w1.y), bfhi(w1.y), bflo(w1.z), bfhi(w1.z), bflo(w1.w), bfhi(w1.w)};
                float x2[8] = {bflo(w2.x), bfhi(w2.x), bflo(w2.y), bfhi(w2.y), bflo(w2.z), bfhi(w2.z), bflo(w2.w), bfhi(w2.w)};
                float y1[8], y2[8];
#pragma unroll
                for (int e = 0; e < 8; ++e) { const float cs = ropep[i0 + e], sn = ropep[32 + i0 + e];
                    const float a = x1[e] * rstd * g1p[e], c = x2[e] * rstd * g2p[e];
                    y1[e] = (a * cs - c * sn) * QSCALE; y2[e] = (c * cs + a * sn) * QSCALE; }
                u32x4 o1, o2;
                o1.x = pk2(y1[0], y1[1]); o1.y = pk2(y1[2], y1[3]); o1.z = pk2(y1[4], y1[5]); o1.w = pk2(y1[6], y1[7]);
                o2.x = pk2(y2[0], y2[1]); o2.y = pk2(y2[2], y2[3]); o2.z = pk2(y2[4], y2[5]); o2.w = pk2(y2[6], y2[7]);
                q[qb][4] = __builtin_bit_cast(bf16x8, o1); q[qb][5] = __builtin_bit_cast(bf16x8, o2);
            }
        }
        f32x4 o[8][2]; float m_run[2] = {0.f, 0.f}, l_run[2] = {0.f, 0.f};
#pragma unroll
        for (int d = 0; d < 8; ++d) { o[d][0] = (f32x4){0.f, 0.f, 0.f, 0.f}; o[d][1] = (f32x4){0.f, 0.f, 0.f, 0.f}; }
        attn_pass3x<MODE_MLA>(lds, KMc + (size_t)bh * SEQ * DK * 2, VTMc + (size_t)bh * DV * SEQ * 2, SEQ, 0, 4 * qblk + 4, q, o, m_run, l_run, A);
        const float lt0 = sum_g(l_run[0]), lt1 = sum_g(l_run[1]);
        { const unsigned t0w = (unsigned)(b * SEQ + A.tw0);
          const unsigned zo_ = (t0w * (unsigned)N3P + (unsigned)(C3_Z + h * DV)) * 2u, oo_ = (t0w * (unsigned)ZW8 + (unsigned)(h * DV)) * 2u;
          if (USE_FP8O && qblk != 0) attn_epilogue3<false, false, 1>(lds, lane, wid, o, 1.0f / lt0, 1.0f / lt1, Y1c, zo_, OMc, oo_, true, (char*)(P.ws + OFF_O8M), O8_SCALE);
          else attn_epilogue3<false, false, 0>(lds, lane, wid, o, 1.0f / lt0, 1.0f / lt1, Y1c, zo_, OMc, oo_); }
        __syncthreads();
    }
}
constexpr int LDS_KN_OFF = 135168, LDS_ST_OFF = LDS_KN_OFF + 16384, LDS_BYTES = LDS_ST_OFF + 16;
constexpr int NPHASE = 14;

#ifndef PROBE_G1F8
#define PROBE_G1F8 0
#endif
#ifndef PROBE_G1F8_NOSTORE
#define PROBE_G1F8_NOSTORE 0
#endif
#ifndef USE_FP8M
#define USE_FP8M 0
#endif
#ifndef USE_FP8Z
#define USE_FP8Z 0
#endif
#ifndef DUP5
#define DUP5 0
#endif
#ifndef P3_GEMM_REP
#define P3_GEMM_REP 1
#endif
#ifndef P3_WCONV_REP
#define P3_WCONV_REP 1
#endif
template <int PH>
DI void run_phase(const Params& P, LAS unsigned char* lds, int bid, int nb) {
    unsigned char* ws = P.ws;
    if constexpr (PH == 0) {
        phase_wconv(lds, P.nsa_w_in, (bf16_t*)(ws + OFF_W1T), DM, N1, N1P, bid, nb, (FP8EMU & 4) ? 64.0f : 0.f, 0, USE_FP8Z ? (unsigned char*)(ws + OFF_B8) : nullptr, F8_Q0 * 256, (F8_Q0 + F8_NQ) * 256);
        phase_wconv(lds, P.w1_k, (bf16_t*)(ws + OFF_W1K), 6144, 192, 256, bid, nb);
        phase_wconv(lds, P.w1_v, (bf16_t*)(ws + OFF_W1V), 4096, 128, 256, bid, nb);
        phase_rmsnorm(P.x, P.norm_w, (bf16_t*)(ws + OFF_H), bid, nb, (FP8EMU & 4) ? 16.0f : 0.f, USE_FP8Z ? (unsigned char*)(ws + OFF_A8) : nullptr);
    } else if constexpr (PH == 1) {
        if (USE_FP8Z) {
            {
                pg8::Gemm g{(const bf16_t*)(ws + OFF_H), (const bf16_t*)(ws + OFF_W1T), MTOK, N1P, DM};
                pg8::OrderBf16Part S{nb, bid, F8_Q0, F8_NQ, N1P / 256 - F8_NQ};
                pg8::EpiStoreBf16 E{(bf16_t*)(ws + OFF_Y0), N1P};
                pg8::gemm_phase<pg8::EpiStoreBf16, pg8::OrderBf16Part, false>(lds, g, S, E, nullptr, GEMM_STAG);
            }
            __syncthreads();
            {
                pg8::Gemm g{(const bf16_t*)(ws + OFF_A8), (const bf16_t*)(ws + OFF_B8), MTOK, N1P, DM / 2};
                pg8::OrderFp8Part S{nb, bid, F8_Q0, F8_NQ, N1P / 256 - F8_NQ, (256 - ((F8_NQ * 64 + (N1P / 256 - F8_NQ) * 4) & 255)) & 255};
                for (int pr_ = PROBE_G1F8; pr_ >= 0; --pr_) {
                pg8::EpiStoreBf16Fp8 E{(bf16_t*)(ws + OFF_Y0), N1P, 1.0f / (16.0f * 64.0f), (pr_ && PROBE_G1F8_NOSTORE) ? 1 : 0};
                pg8::gemm_phase<pg8::EpiStoreBf16Fp8, pg8::OrderFp8Part, false>(lds, g, S, E, nullptr);
                if (pr_) __syncthreads();
                }
            }
        } else {
        pg8::Gemm g{(const bf16_t*)(ws + OFF_H), (const bf16_t*)(ws + OFF_W1T), MTOK, N1P, DM};
        pg8::StaticOrder S; S.init(g.M, g.N, nb, bid);
        pg8::EpiStoreBf16 E{(bf16_t*)(ws + OFF_Y0), N1P};
        pg8::gemm_phase<pg8::EpiStoreBf16, pg8::StaticOrder, false>(lds, g, S, E, nullptr);
        }
    } else if constexpr (PH == 2) {
        phase_nsa_prep(P, bid, nb);
        phase_vt(lds, (const bf16_t*)(ws + OFF_Y0), N1P, C_KVS + NG * DK, DV, NG, (bf16_t*)(ws + OFF_VTS), bid, nb);
        phase_vt(lds, (const bf16_t*)(ws + OFF_Y0), N1P, C_KVW + NG * DK, DV, NG, (bf16_t*)(ws + OFF_VTW), bid, nb);
    } else if constexpr (PH == 3) {
        for (int p3g_ = 0; p3g_ < ((bid < 32) ? P3_GEMM_REP : P3_WCONV_REP); ++p3g_) { if (p3g_) __syncthreads();
        if (bid < 16) {
            pg8::Gemm g{(const bf16_t*)(ws + OFF_ACK), (const bf16_t*)(ws + OFF_W1K), 4096, 256, 6144};
            pg8::StaticOrder S; S.init(g.M, g.N, 16, bid);
            pg8::EpiPlainF32 E{(float*)(ws + OFF_HIDK), 256};
            pg8::gemm_phase<pg8::EpiPlainF32, pg8::StaticOrder, false>(lds, g, S, E, nullptr);
        } else if (bid < 32) {
            pg8::Gemm g{(const bf16_t*)(ws + OFF_ACV), (const bf16_t*)(ws + OFF_W1V), 4096, 256, 4096};
            pg8::StaticOrder S; S.init(g.M, g.N, 16, bid - 16);
            pg8::EpiPlainF32 E{(float*)(ws + OFF_HIDV), 256};
            pg8::gemm_phase<pg8::EpiPlainF32, pg8::StaticOrder, false>(lds, g, S, E, nullptr);
        } else {
            phase_wconv(lds, P.nsa_w_out, (bf16_t*)(ws + OFF_W2T), ZW8, DM, DM, bid - 32, nb - 32, (FP8EMU & 1) ? 64.0f : 0.f, 0, USE_FP8N ? (unsigned char*)(ws + OFF_W28) : nullptr, 0);
            phase_wconv(lds, P.mla_w_in, (bf16_t*)(ws + OFF_W3T), DM, N3, N3P, bid - 32, nb - 32, (FP8EMU & 8) ? 64.0f : 0.f, 0, USE_FP8M ? (unsigned char*)(ws + OFF_B8M) : nullptr, 0, C3_Z8);
        }
        }
    } else if constexpr (PH == 4) {
        phase_cmp2(lds, P, bid, nb);
    } else if constexpr (PH == 5) {
        { float* ss1 = (float*)(ws + OFF_SS1); for (int i = bid * 512 + (int)threadIdx.x; i < MTOK; i += nb * 512) ss1[i] = 0.f; }
        phase_nsa_attn(lds, P, bid, nb);
    } else if constexpr (PH == 6) {
        if (USE_FP8N) {
            {
                pg8::Gemm g{(const bf16_t*)(ws + OFF_O), (const bf16_t*)(ws + OFF_W2T), MTOK, DM, ZW8};
                pg8::OrderBf16Part S{nb, bid, 0, 0, DM / 256};
                pg8::EpiResNorm E{P.x, P.out, DM, P.norm_w + DM, (bf16_t*)(ws + OFF_H), (float*)(ws + OFF_SS1), USE_FP8M ? (unsigned char*)(ws + OFF_A8M) : nullptr, 1.0f};
                pg8::gemm_phase<pg8::EpiResNorm, pg8::OrderBf16Part, false>(lds, g, S, E, nullptr);
            }
            __syncthreads();
            {
                pg8::Gemm g{(const bf16_t*)(ws + OFF_O8N), (const bf16_t*)(ws + OFF_W28), MTOK, DM, ZW8 / 2};
                pg8::OrderFp8Part S{nb, bid, 0, 0, DM / 256, 192};
                pg8::EpiResNormFp8 E{P.x, P.out, DM, P.norm_w + DM, (bf16_t*)(ws + OFF_H), (float*)(ws + OFF_SS1), USE_FP8M ? (unsigned char*)(ws + OFF_A8M) : nullptr, 1.0f / (O8N_SCALE * 64.0f)};
                pg8::gemm_phase<pg8::EpiResNormFp8, pg8::OrderFp8Part, false>(lds, g, S, E, nullptr);
            }
        } else {
        pg8::Gemm g{(const bf16_t*)(ws + OFF_O), (const bf16_t*)(ws + OFF_W2T), MTOK, DM, ZW8};
        pg8::StaticOrder S; S.init(g.M, g.N, nb, bid);
        pg8::EpiResNorm E{P.x, P.out, DM, P.norm_w + DM, (bf16_t*)(ws + OFF_H), (float*)(ws + OFF_SS1), USE_FP8M ? (unsigned char*)(ws + OFF_A8M) : nullptr, 1.0f};
        pg8::gemm_phase<pg8::EpiResNorm, pg8::StaticOrder, false>(lds, g, S, E, nullptr);
        }
    } else if constexpr (PH == 7) {
        phase_rmsnorm(P.out, P.norm_w + DM, (bf16_t*)(ws + OFF_H), bid, nb, (FP8EMU & 8) ? 16.0f : 0.f);
    } else if constexpr (PH == 8) {
        if (USE_FP8M) {
            {
                pg8::Gemm g{(const bf16_t*)(ws + OFF_H), (const bf16_t*)(ws + OFF_W3T), MTOK, N3P, DM};
                pg8::OrderBf16Part S{nb, bid, 0, C3_Z8 / 256, NZ8M / 256};
                pg8::EpiStoreBf16RowScale E{(bf16_t*)(ws + OFF_Y1), N3P, (const float*)(ws + OFF_SS1), 1.0f / DM};
                pg8::gemm_phase<pg8::EpiStoreBf16RowScale, pg8::OrderBf16Part, false>(lds, g, S, E, nullptr);
            }
            __syncthreads();
            {
                pg8::Gemm g{(const bf16_t*)(ws + OFF_A8M), (const bf16_t*)(ws + OFF_B8M), MTOK, N3P, DM / 2};
                pg8::OrderFp8Part S{nb, bid, 0, C3_Z8 / 256, NZ8M / 256, 64};
                pg8::EpiStoreBf16RowScaleFp8 E{(bf16_t*)(ws + OFF_Y1), N3P, (const float*)(ws + OFF_SS1), 1.0f / DM, 1.0f / (16.0f * 64.0f)};
                pg8::gemm_phase<pg8::EpiStoreBf16RowScaleFp8, pg8::OrderFp8Part, false>(lds, g, S, E, nullptr);
            }
        } else {
        pg8::Gemm g{(const bf16_t*)(ws + OFF_H), (const bf16_t*)(ws + OFF_W3T), MTOK, N3P, DM};
        pg8::StaticOrder S; S.init(g.M, g.N, nb, bid);
        pg8::EpiStoreBf16RowScale E{(bf16_t*)(ws + OFF_Y1), N3P, (const float*)(ws + OFF_SS1), 1.0f / DM};
        pg8::gemm_phase<pg8::EpiStoreBf16RowScale, pg8::StaticOrder, false>(lds, g, S, E, nullptr);
        }
        __syncthreads();
        if (bid >= 64 && nb > 64) {
            phase_wconv(lds, P.mla_w_q_b, (bf16_t*)(ws + OFF_W4T), QLORA, NQB, NQB, bid - 64, nb - 64, 0.f, 0, USE_FP8Q ? (unsigned char*)(ws + OFF_W48) : nullptr, 0);
            phase_wconv(lds, P.mla_w_kv_b, (bf16_t*)(ws + OFF_W5K), KVLORA, NKVB / 2, NKVB / 2, bid - 64, nb - 64, 0.f, 2, USE_FP8KV ? (unsigned char*)(ws + OFF_W5K8) : nullptr, 0);
            phase_wconv(lds, P.mla_w_kv_b, (bf16_t*)(ws + OFF_W5V), KVLORA, NKVB / 2, NKVB / 2, bid - 64, nb - 64, 0.f, 1, USE_FP8KV ? (unsigned char*)(ws + OFF_W5V8) : nullptr, 0);
            phase_wconv(lds, P.mla_w_out, (bf16_t*)(ws + OFF_W6T), ZW8, DM, DM, bid - 64, nb - 64, (FP8EMU & 2) ? 64.0f : 0.f, 0, USE_FP8O ? (unsigned char*)(ws + OFF_W68) : nullptr, 0);
        } else if (nb <= 64) {
            phase_wconv(lds, P.mla_w_q_b, (bf16_t*)(ws + OFF_W4T), QLORA, NQB, NQB, bid, nb, 0.f, 0, USE_FP8Q ? (unsigned char*)(ws + OFF_W48) : nullptr, 0);
            phase_wconv(lds, P.mla_w_kv_b, (bf16_t*)(ws + OFF_W5K), KVLORA, NKVB / 2, NKVB / 2, bid, nb, 0.f, 2, USE_FP8KV ? (unsigned char*)(ws + OFF_W5K8) : nullptr, 0);
            phase_wconv(lds, P.mla_w_kv_b, (bf16_t*)(ws + OFF_W5V), KVLORA, NKVB / 2, NKVB / 2, bid, nb, 0.f, 1, USE_FP8KV ? (unsigned char*)(ws + OFF_W5V8) : nullptr, 0);
            phase_wconv(lds, P.mla_w_out, (bf16_t*)(ws + OFF_W6T), ZW8, DM, DM, bid, nb, (FP8EMU & 2) ? 64.0f : 0.f, 0, USE_FP8O ? (unsigned char*)(ws + OFF_W68) : nullptr, 0);
        }
    } else if constexpr (PH == 9) {
        phase_mla_prep1(P, bid, nb);
    } else if constexpr (PH == 10) {
        if (USE_FP8Q) {
            {
                pg8::Gemm g{(const bf16_t*)(ws + OFF_CQN), (const bf16_t*)(ws + OFF_W4T), MTOK, NQB, QLORA};
                pg8::OrderBf16Part S{nb, bid, 0, 0, NQB / 256};
                pg8::EpiStoreBf16 E{(bf16_t*)(ws + OFF_QM), NQB};
                pg8::gemm_phase<pg8::EpiStoreBf16, pg8::OrderBf16Part, false>(lds, g, S, E, nullptr);
            }
            __syncthreads();
            {
                pg8::Gemm g{(const bf16_t*)(ws + OFF_CQN8), (const bf16_t*)(ws + OFF_W48), MTOK, NQB, QLORA / 2};
                pg8::OrderFp8Part S{nb, bid, 0, 0, NQB / 256, 64};
                pg8::EpiStoreBf16Fp8 E{(bf16_t*)(ws + OFF_QM), NQB, 1.0f / (16.0f * 64.0f)};
                pg8::gemm_phase<pg8::EpiStoreBf16Fp8, pg8::OrderFp8Part, false>(lds, g, S, E, nullptr);
            }
        } else {
            pg8::Gemm g{(const bf16_t*)(ws + OFF_CQN), (const bf16_t*)(ws + OFF_W4T), MTOK, NQB, QLORA};
            pg8::StaticOrder S; S.init(g.M, g.N, nb, bid);
            pg8::EpiStoreBf16 E{(bf16_t*)(ws + OFF_QM), NQB};
            pg8::gemm_phase<pg8::EpiStoreBf16, pg8::StaticOrder, false>(lds, g, S, E, nullptr);
        }
        __syncthreads();
        if (USE_FP8KV) {
            {
                pg8::Gemm g{(const bf16_t*)(ws + OFF_CKVN), (const bf16_t*)(ws + OFF_W5K), MTOK, NKVB / 2, KVLORA};
                pg8::OrderBf16Part S{nb, bid, 0, 0, NKVB / 512};
                pg8::EpiKNorm E{(bf16_t*)(ws + OFF_KM), (const float*)(ws + OFF_SSPE), (const float*)(ws + OFF_KPER), P.mla_k_norm, (LAS float*)(lds + LDS_KN_OFF), 0u, 1.0f};
                pg8::gemm_phase<pg8::EpiKNorm, pg8::OrderBf16Part, false>(lds, g, S, E, nullptr);
            }
            __syncthreads();
            {
                pg8::Gemm g{(const bf16_t*)(ws + OFF_W5V), (const bf16_t*)(ws + OFF_CKVN), NKVB / 2, MTOK, KVLORA};
                pg8::OrderSwap<pg8::OrderBf16Part> S{{nb, (bid + 128) & 255, 0, 0, NKVB / 512}};
                pg8::EpiVT E{(bf16_t*)(ws + OFF_VTM), 1.0f};
                pg8::gemm_phase<pg8::EpiVT, pg8::OrderSwap<pg8::OrderBf16Part>, false>(lds, g, S, E, nullptr);
            }
            __syncthreads();
            {
                pg8::Gemm g{(const bf16_t*)(ws + OFF_CKVN8), (const bf16_t*)(ws + OFF_W5K8), MTOK, NKVB / 2, KVLORA / 2};
                pg8::OrderFp8Part S{nb, bid, 0, 0, NKVB / 512, 0};
                pg8::EpiKNormFp8 E{(bf16_t*)(ws + OFF_KM), (const float*)(ws + OFF_SSPE), (const float*)(ws + OFF_KPER), P.mla_k_norm, (LAS float*)(lds + LDS_KN_OFF), 0u, 1.0f / (16.0f * 64.0f)};
                pg8::gemm_phase<pg8::EpiKNormFp8, pg8::OrderFp8Part, false>(lds, g, S, E, nullptr);
            }
            __syncthreads();
            {
                pg8::Gemm g{(const bf16_t*)(ws + OFF_W5V8), (const bf16_t*)(ws + OFF_CKVN8), NKVB / 2, MTOK, KVLORA / 2};
                pg8::OrderSwap<pg8::OrderFp8Part> S{{nb, bid, 0, 0, NKVB / 512, 128}};
                pg8::EpiVTFp8 E{(bf16_t*)(ws + OFF_VTM), 1.0f / (16.0f * 64.0f)};
                pg8::gemm_phase<pg8::EpiVTFp8, pg8::OrderSwap<pg8::OrderFp8Part>, false>(lds, g, S, E, nullptr);
            }
        } else {
        {
            pg8::Gemm g{(const bf16_t*)(ws + OFF_CKVN), (const bf16_t*)(ws + OFF_W5K), MTOK, NKVB / 2, KVLORA};
            pg8::StaticOrder S; S.init(g.M, g.N, nb, bid);
            pg8::EpiKNorm E{(bf16_t*)(ws + OFF_KM), (const float*)(ws + OFF_SSPE), (const float*)(ws + OFF_KPER), P.mla_k_norm, (LAS float*)(lds + LDS_KN_OFF), 0u, 1.0f};
            pg8::gemm_phase<pg8::EpiKNorm, pg8::StaticOrder, false>(lds, g, S, E, nullptr);
        }
        __syncthreads();
        {
            pg8::Gemm g{(const bf16_t*)(ws + OFF_W5V), (const bf16_t*)(ws + OFF_CKVN), NKVB / 2, MTOK, KVLORA};
            pg8::StaticOrder S; S.init(g.M, g.N, nb, bid);
            pg8::EpiVT E{(bf16_t*)(ws + OFF_VTM), 1.0f};
            pg8::gemm_phase<pg8::EpiVT, pg8::StaticOrder, false>(lds, g, S, E, nullptr);
        }
        }
    } else if constexpr (PH == 11) {
    } else if constexpr (PH == 12) {
        phase_mla_attn(lds, P, bid, nb);
    } else if constexpr (PH == 13) {
        if (USE_FP8O) {
            {
                pg8::Gemm g{(const bf16_t*)(ws + OFF_O), (const bf16_t*)(ws + OFF_W6T), MTOK, DM, ZW8};
                pg8::OrderBf16Part S{nb, bid, 0, 0, DM / 256};
                pg8::EpiResF32 E{P.out, P.out, DM};
                pg8::gemm_phase<pg8::EpiResF32, pg8::OrderBf16Part, false>(lds, g, S, E, nullptr);
            }
            __syncthreads();
            {
                pg8::Gemm g{(const bf16_t*)(ws + OFF_O8M), (const bf16_t*)(ws + OFF_W68), MTOK, DM, ZW8 / 2};
                pg8::OrderFp8Part S{nb, bid, 0, 0, DM / 256, 192};
                pg8::EpiResF32Fp8 E{P.out, P.out, DM, 1.0f / (O8_SCALE * 64.0f)};
                pg8::gemm_phase<pg8::EpiResF32Fp8, pg8::OrderFp8Part, false>(lds, g, S, E, nullptr);
            }
        } else {
        pg8::Gemm g{(const bf16_t*)(ws + OFF_O), (const bf16_t*)(ws + OFF_W6T), MTOK, DM, ZW8};
        pg8::StaticOrder S; S.init(g.M, g.N, nb, bid);
        pg8::EpiResF32 E{P.out, P.out, DM};
        pg8::gemm_phase<pg8::EpiResF32, pg8::StaticOrder, false>(lds, g, S, E, nullptr);
        }
    }
}

#ifndef REP0
#define REP0 1
#endif
#ifndef REP1
#define REP1 1
#endif
#ifndef REP2
#define REP2 1
#endif
#ifndef REP3
#define REP3 1
#endif
#ifndef REP4
#define REP4 1
#endif
#ifndef REP5
#define REP5 1
#endif
#ifndef REP6
#define REP6 1
#endif
#ifndef REP7
#define REP7 1
#endif
#ifndef REP8
#define REP8 1
#endif
#ifndef REP9
#define REP9 1
#endif
#ifndef REP10
#define REP10 1
#endif
#ifndef REP11
#define REP11 1
#endif
#ifndef REP12
#define REP12 1
#endif
#ifndef REP13
#define REP13 1
#endif

__global__ __launch_bounds__(512, 2) void k_mega(Params P) {
    extern __shared__ __attribute__((aligned(16))) unsigned char shm[];
    LAS unsigned char* lds = (LAS unsigned char*)shm;
    volatile LAS unsigned* st = (volatile LAS unsigned*)(lds + LDS_ST_OFF);
    if (threadIdx.x == 0) { st[0] = 0u; st[1] = 0u; st[2] = 0u; st[3] = 0u; }
    __syncthreads();
    XcdBarrier bar = xcd_barrier_post((unsigned*)(P.ws + OFF_CTL), st);
    const int bid = (int)blockIdx.x, nb = (int)gridDim.x;
    for (int rep_ = 0; rep_ < REP0; ++rep_) run_phase<0>(P, lds, bid, nb);  xcd_barrier(bar);
    for (int rep_ = 0; rep_ < REP1; ++rep_) run_phase<1>(P, lds, bid, nb);  xcd_barrier(bar);
    for (int rep_ = 0; rep_ < REP2; ++rep_) run_phase<2>(P, lds, bid, nb);  xcd_barrier(bar);
    for (int rep_ = 0; rep_ < REP3; ++rep_) run_phase<3>(P, lds, bid, nb);  xcd_barrier(bar);
    for (int rep_ = 0; rep_ < REP4; ++rep_) run_phase<4>(P, lds, bid, nb);  xcd_barrier(bar);
    for (int rep_ = 0; rep_ < REP5; ++rep_) run_phase<5>(P, lds, bid, nb);
#if DUP5
    __syncthreads(); run_phase<5>(P, lds, bid, nb);
#endif
    xcd_barrier(bar);
    for (int rep_ = 0; rep_ < REP6; ++rep_) run_phase<6>(P, lds, bid, nb);  xcd_barrier(bar);
    for (int rep_ = 0; rep_ < REP8; ++rep_) run_phase<8>(P, lds, bid, nb);  xcd_barrier(bar);
    for (int rep_ = 0; rep_ < REP9; ++rep_) run_phase<9>(P, lds, bid, nb);  xcd_barrier(bar);
    for (int rep_ = 0; rep_ < REP10; ++rep_) run_phase<10>(P, lds, bid, nb); xcd_barrier(bar);
    for (int rep_ = 0; rep_ < REP12; ++rep_) run_phase<12>(P, lds, bid, nb); xcd_barrier(bar);
    for (int rep_ = 0; rep_ < REP13; ++rep_) run_phase<13>(P, lds, bid, nb);
}

extern "C" void kernel_launch(void* const* d_in, const int* in_sizes, int n_in, void* d_out, int out_size, void* d_ws, size_t ws_size, hipStream_t stream) {
    (void)in_sizes; (void)n_in; (void)out_size;
    if (ws_size < WS_END) return;
    Params P{};
    P.x = (const float*)d_in[0]; P.pos = (const int*)d_in[1]; P.norm_w = (const float*)d_in[2]; P.rel_bias = (const float*)d_in[3];
    P.nsa_w_in = (const float*)d_in[4]; P.nsa_q_norm = (const float*)d_in[5]; P.nsa_k_norm = (const float*)d_in[6]; P.pe_k = (const float*)d_in[7];
    P.w1_k = (const float*)d_in[8]; P.w2_k = (const float*)d_in[9]; P.pe_v = (const float*)d_in[10]; P.w1_v = (const float*)d_in[11]; P.w2_v = (const float*)d_in[12];
    P.nsa_w_out = (const float*)d_in[13]; P.mla_w_in = (const float*)d_in[14]; P.mla_q_a_norm = (const float*)d_in[15]; P.mla_w_q_b = (const float*)d_in[16];
    P.mla_kv_a_norm = (const float*)d_in[17]; P.mla_w_kv_b = (const float*)d_in[18]; P.mla_q_norm = (const float*)d_in[19]; P.mla_k_norm = (const float*)d_in[20];
    P.mla_w_out = (const float*)d_in[21];
    P.out = (float*)d_out; P.ws = (unsigned char*)d_ws;
    static int grid = 0;
    if (!grid) {
        int dev = 0, cus = 0, per_cu = 0; (void)hipGetDevice(&dev);
        if (hipDeviceGetAttribute(&cus, hipDeviceAttributeMultiprocessorCount, dev) != hipSuccess || cus <= 0) cus = 256;
        (void)hipFuncSetAttribute((const void*)k_mega, hipFuncAttributeMaxDynamicSharedMemorySize, LDS_BYTES);
        if (hipOccupancyMaxActiveBlocksPerMultiprocessor(&per_cu, k_mega, 512, LDS_BYTES) != hipSuccess || per_cu < 1) per_cu = 1;
        grid = cus;
    }
    (void)hipMemsetAsync((unsigned char*)d_ws + OFF_CTL, 0, XCD_BAR_WORDS * sizeof(unsigned), stream);
    hipLaunchKernelGGL(k_mega, dim3(grid), dim3(512), LDS_BYTES, stream, P);
}
```

```cpp
#define ATT16 1
#define USE_FP8Z 1
#define USE_FP8M 1
#define USE_FP8O 1
#define USE_FP8N 1
#define USE_FP8Q 1
#define TAIL_IN_P6 0
#define F8_Q0 0
#define F8_NQ 53
#define GEMM_NT 0
#include <hip/hip_runtime.h>
#include <stdint.h>
#include <stddef.h>

#define DI __device__ __forceinline__
#define LAS __attribute__((address_space(3)))
typedef unsigned short bf16_t;
typedef short bf16x8 __attribute__((ext_vector_type(8)));
typedef float f32x4 __attribute__((ext_vector_type(4)));
typedef float f32x16 __attribute__((ext_vector_type(16)));
typedef unsigned u32x4 __attribute__((ext_vector_type(4)));
typedef unsigned u32x2 __attribute__((ext_vector_type(2)));
typedef __bf16 bf2_t __attribute__((ext_vector_type(2)));
typedef float f2_t __attribute__((ext_vector_type(2)));

DI int tid_opaque() { int t = (int)threadIdx.x; asm volatile("" : "+v"(t)); return t; }
DI unsigned pk2(float a, float b) { f2_t f = {a, b}; bf2_t v = __builtin_convertvector(f, bf2_t); return __builtin_bit_cast(unsigned, v); }
DI float clamp_fp8(float v) { float r; asm("v_max_f32 %0, 0xc3e00000, %1\n\tv_min_f32 %0, 0x43e00000, %0" : "=v"(r) : "v"(v)); return r; }
DI unsigned pk4_fp8(float a, float b, float c, float d) { a = clamp_fp8(a); b = clamp_fp8(b); c = clamp_fp8(c); d = clamp_fp8(d); int w = 0; w = __builtin_amdgcn_cvt_pk_fp8_f32(a, b, w, false); w = __builtin_amdgcn_cvt_pk_fp8_f32(c, d, w, true); return (unsigned)w; }
DI unsigned pk4_fp8c(float a, float b, float c, float d) { return pk4_fp8(a, b, c, d); }
DI float bflo(unsigned w) { return __uint_as_float(w << 16); }
DI float bfhi(unsigned w) { return __uint_as_float(w & 0xffff0000u); }
#ifndef USE_FP8KV
#define USE_FP8KV 0
#endif
#ifndef USE_FP8Q
#define USE_FP8Q 0
#endif
#ifndef USE_FP8N
#define USE_FP8N 0
#endif
#ifndef USE_FP8O
#define USE_FP8O 0
#endif
#ifndef GEMM_STAG
#define GEMM_STAG 0
#endif
#ifndef GEMM_NT
#define GEMM_NT 0
#endif
#ifndef FP8EMU
#define FP8EMU 0
#endif
DI float emu_q8(float x, float s) { float y = x * s; const float ay = fabsf(y);
    if (ay < 0.015625f) y = rintf(y * 512.0f) * (1.0f / 512.0f);
    else { unsigned u = __float_as_uint(y); u = (u + 0x0007FFFFu + ((u >> 20) & 1u)) & 0xFFF00000u; y = __uint_as_float(u); }
    y = fminf(fmaxf(y, -448.0f), 448.0f); return y / s; }
DI float bf1(bf16_t h) { return __uint_as_float(((unsigned)h) << 16); }

#ifndef ATT16
#define ATT16 0
#endif
DI int vt_key_of_pos(int p) {
#if ATT16
    return (p & ~31) | (((p >> 2) & 1) << 4) | (((p >> 3) & 3) << 2) | (p & 3);
#else
    return (p & ~0xC) | ((p & 4) << 1) | ((p & 8) >> 1);
#endif
}
DI int vt_pos_of_key(int k) {
#if ATT16
    return (k & ~31) | (((k >> 2) & 3) << 3) | (((k >> 4) & 1) << 2) | (k & 3);
#else
    return (k & ~0xC) | ((k & 4) << 1) | ((k & 8) >> 1);
#endif
}
constexpr int BATCH = 4, SEQ = 4096, DM = 4096, MTOK = BATCH * SEQ;
constexpr int NH = 64, NG = 4, NR = 16, DK = 192, DV = 128;
constexpr int N1 = 40896, N1P = 40960;
constexpr int C_Q = 0, C_KVC = 12288, C_KVS = 13568, C_KVW = 14848, C_ZC = 16128, C_ZS = 24320, C_ZW = 32512, C_G = 40704;
constexpr int N3 = 10304, N3P = 10496;
constexpr int C3_CQ = 0, C3_CKV = 1536, C3_KPE = 2048, C3_Z = 2112;
constexpr int QLORA = 1536, KVLORA = 512;
constexpr int NQB = 12288, NKVB = 16384, ZW8 = 8192;
constexpr float EPSN = 1e-6f;
constexpr float LOG2E = 1.4426950408889634f;
constexpr float QSCALE = 0.07216878364870322f * 1.4426950408889634f;

constexpr size_t SZ_W1T = (size_t)N1P * DM * 2, SZ_W2T = (size_t)DM * ZW8 * 2, SZ_W3T = (size_t)N3P * DM * 2, SZ_W4T = (size_t)NQB * QLORA * 2,
                 SZ_W5T = (size_t)NKVB * KVLORA * 2, SZ_W6T = (size_t)DM * ZW8 * 2;
constexpr size_t OFF_W1T = 0, OFF_W2T = OFF_W1T + SZ_W1T, OFF_W3T = OFF_W2T + SZ_W2T, OFF_W4T = OFF_W3T + SZ_W3T, OFF_W5T = OFF_W4T + SZ_W4T,
                 OFF_W6T = OFF_W5T + SZ_W5T, OFF_W1K = OFF_W6T + SZ_W6T;
constexpr size_t OFF_W5K = OFF_W5T, OFF_W5V = OFF_W5T + SZ_W5T / 2;
constexpr size_t SZ_W1K = (size_t)256 * 6144 * 2, SZ_W1V = (size_t)256 * 4096 * 2;
constexpr size_t OFF_W1V = OFF_W1K + SZ_W1K, OFF_CTL = OFF_W1V + SZ_W1V, OFF_H = OFF_CTL + 65536;
constexpr size_t SZ_H = (size_t)MTOK * DM * 2, SZ_KS = (size_t)BATCH * NG * SEQ * DK * 2, SZ_VTS = (size_t)BATCH * NG * DV * SEQ * 2,
                 SZ_ACK = (size_t)4096 * 6144 * 2, SZ_ACV = (size_t)4096 * 4096 * 2;
constexpr size_t OFF_KS = OFF_H + SZ_H, OFF_KW = OFF_KS + SZ_KS, OFF_VTS = OFF_KW + SZ_KS, OFF_VTW = OFF_VTS + SZ_VTS, OFF_ACK = OFF_VTW + SZ_VTS,
                 OFF_ACV = OFF_ACK + SZ_ACK, OFF_KC = OFF_ACV + SZ_ACV;
constexpr size_t SZ_KC = (size_t)16 * 256 * DK * 2, SZ_VTC = (size_t)16 * DV * 256 * 2, SZ_HID = (size_t)4096 * 256 * 4;
constexpr size_t OFF_VTC = OFF_KC + SZ_KC, OFF_HIDK = OFF_VTC + SZ_VTC, OFF_HIDV = OFF_HIDK + SZ_HID, OFF_Y0 = OFF_HIDV + SZ_HID;
constexpr size_t SZ_Y0 = (size_t)MTOK * N1P * 2, SZ_O = (size_t)MTOK * ZW8 * 2;
constexpr size_t OFF_O = OFF_Y0 + SZ_Y0, WS_END = OFF_O + SZ_O;
constexpr size_t OFF_SS1 = OFF_HIDK;
constexpr size_t OFF_A8 = OFF_O, OFF_B8 = OFF_O + (size_t)MTOK * DM;
#ifndef F8_Q0
#define F8_Q0 0
#define F8_NQ 63
#endif
constexpr size_t OFF_B8M = OFF_W1T, OFF_A8M = OFF_W1T + (64ull << 20);
constexpr int C3_Z8 = 2304, NZ8M = 8192;
constexpr size_t OFF_W28 = OFF_W1T + (132ull << 20), OFF_O8N = OFF_W1T + (168ull << 20);
static_assert(OFF_O8N + (size_t)MTOK * ZW8 <= OFF_W1T + SZ_W1T, "fp8 NSA out-proj buffers");
constexpr float O8N_SCALE = 64.0f;
constexpr float O8_SCALE = 128.0f;
constexpr size_t OFF_KM = 0;
constexpr size_t SZ_KM = (size_t)BATCH * NH * SEQ * DK * 2;
static_assert(SZ_KM <= SZ_W1T + SZ_W2T, "KM alias");
constexpr size_t OFF_VTM = OFF_H;
constexpr size_t SZ_VTM = (size_t)BATCH * NH * DV * SEQ * 2;
constexpr size_t OFF_CKVN = OFF_VTM + SZ_VTM;
constexpr size_t SZ_CKVN = (size_t)MTOK * KVLORA * 2;
static_assert(OFF_CKVN + SZ_CKVN <= OFF_KC, "CKVN alias");
constexpr size_t OFF_Y1 = OFF_Y0, SZ_Y1 = (size_t)MTOK * N3P * 2;
constexpr size_t OFF_QM = OFF_Y1 + SZ_Y1, SZ_QM = (size_t)MTOK * NQB * 2;
constexpr size_t OFF_KVM = OFF_QM + SZ_QM, SZ_KVM = (size_t)MTOK * NKVB * 2;
constexpr size_t OFF_KNM = OFF_KVM;
constexpr size_t OFF_KPER = OFF_KVM, OFF_SSPE = OFF_KVM + (size_t)MTOK * 64 * 4;
constexpr size_t OFF_O8M = OFF_KVM + SZ_KVM / 2, OFF_W68 = OFF_O8M + (size_t)MTOK * ZW8;
constexpr size_t OFF_W48 = OFF_W68 + (size_t)DM * ZW8, OFF_CQN8 = OFF_W48 + (size_t)NQB * QLORA;
constexpr size_t OFF_CKVN8 = OFF_CQN8 + (size_t)MTOK * QLORA, OFF_W5K8 = OFF_CKVN8 + (size_t)MTOK * KVLORA, OFF_W5V8 = OFF_W5K8 + (size_t)(NKVB / 2) * KVLORA;
static_assert(OFF_W5V8 + (size_t)(NKVB / 2) * KVLORA <= OFF_KVM + SZ_KVM, "fp8 MLA buffers");
constexpr size_t OFF_CQN = OFF_KVM + SZ_KVM, SZ_CQN = (size_t)MTOK * QLORA * 2;
constexpr size_t OFF_ROPE = OFF_CQN + SZ_CQN, SZ_ROPE = (size_t)MTOK * 64 * 4;
static_assert(OFF_ROPE + SZ_ROPE <= OFF_O, "layer-1 alias region");
static_assert(WS_END <= 2680160256ull, "workspace");

struct Params {
    const float* x; const int* pos; const float* norm_w; const float* rel_bias;
    const float* nsa_w_in; const float* nsa_q_norm; const float* nsa_k_norm; const float* pe_k; const float* w1_k; const float* w2_k;
    const float* pe_v; const float* w1_v; const float* w2_v; const float* nsa_w_out;
    const float* mla_w_in; const float* mla_q_a_norm; const float* mla_w_q_b; const float* mla_kv_a_norm; const float* mla_w_kv_b;
    const float* mla_q_norm; const float* mla_k_norm; const float* mla_w_out;
    float* out; unsigned char* ws;
};

#define XB_TMO      128
#define XB_XCNT(j)  (256  + 64 * (j))
#define XB_XSUB(j)  (1280 + 64 * (j))
#define XB_XGEN(j)  (2304 + 64 * (j))
#define XB_TOP      3328
#define XB_TOPGEN   3392
#define XCD_BAR_WORDS 3456
#define XB_SPIN_CAP (1u << 18)

__device__ __forceinline__ unsigned xb_ld(unsigned* p)              { return __hip_atomic_load(p, __ATOMIC_RELAXED, __HIP_MEMORY_SCOPE_AGENT); }
__device__ __forceinline__ unsigned xb_add(unsigned* p, unsigned v) { return __hip_atomic_fetch_add(p, v, __ATOMIC_RELAXED, __HIP_MEMORY_SCOPE_AGENT); }
__device__ __forceinline__ unsigned xb_xcc_id() { return (unsigned)__builtin_amdgcn_s_getreg((3 << 11) | 20) & 0xFu; }
#define XB_SPIN(cond, bar) do { unsigned _sp = 0; while (cond) { __builtin_amdgcn_s_sleep(1); \
    if ((++_sp & 255u) == 0u) { if (xb_ld(&(bar)[XB_TMO])) break; if (_sp > XB_SPIN_CAP) { atomicAdd(&(bar)[XB_TMO], 1u); break; } } } } while (0)

struct XcdBarrier {
    unsigned* bar; unsigned x;
    volatile LAS unsigned* st;
};

__device__ __forceinline__ XcdBarrier xcd_barrier_post(unsigned* bar, volatile LAS unsigned* st) {
    XcdBarrier b; b.bar = bar; b.x = xb_xcc_id(); b.st = st;
    if (threadIdx.x == 0) (void)xb_add(&bar[XB_XCNT(b.x)], 1u);
    return b;
}
__device__ __forceinline__ void xcd_barrier_complete(unsigned* bar, unsigned x, unsigned& nloc, unsigned& nx) {
    const unsigned G = gridDim.x * gridDim.y * gridDim.z;
    unsigned sum, cnt, mine, sp = 0u;
    for (;;) {
        sum = 0u; cnt = 0u; mine = 0u;
#pragma unroll
        for (unsigned j = 0; j < 16; ++j) { const unsigned c = xb_ld(&bar[XB_XCNT(j)]); sum += c; cnt += (c > 0u) ? 1u : 0u; mine = (j == x) ? c : mine; }
        if (sum == G) break;
        __builtin_amdgcn_s_sleep(1);
        if ((++sp & 255u) == 0u) { if (xb_ld(&bar[XB_TMO])) break; if (sp > XB_SPIN_CAP) { atomicAdd(&bar[XB_TMO], 1u); break; } }
    }
    nloc = mine > 0u ? mine : 1u; nx = cnt > 0u ? cnt : 1u;
}

__device__ __forceinline__ void xcd_barrier(const XcdBarrier& b) {
    asm volatile("s_waitcnt vmcnt(0)" ::: "memory");
    __syncthreads();
    if (threadIdx.x == 0) {
        unsigned* bar = b.bar;
        __builtin_amdgcn_s_waitcnt(0);
        unsigned nloc = b.st[0], nx = b.st[1];
        if (nloc == 0u) { xcd_barrier_complete(bar, b.x, nloc, nx); b.st[0] = nloc; b.st[1] = nx; }
        const unsigned old = xb_add(&bar[XB_XSUB(b.x)], 1u);
        const unsigned gen = old / nloc;
        if (old + 1u == (gen + 1u) * nloc) {
            __builtin_amdgcn_fence(__ATOMIC_RELEASE, "agent");
            asm volatile("s_waitcnt vmcnt(0)" ::: "memory");
            const unsigned og = xb_add(&bar[XB_TOP], 1u);
            const unsigned tg = og / nx;
            if (og + 1u == (tg + 1u) * nx) xb_add(&bar[XB_TOPGEN], 1u);
            else XB_SPIN(xb_ld(&bar[XB_TOPGEN]) == tg, bar);
            __builtin_amdgcn_fence(__ATOMIC_ACQUIRE, "agent");
            xb_add(&bar[XB_XGEN(b.x)], 1u);
            asm volatile("s_waitcnt vmcnt(0)" ::: "memory");
        } else {
            XB_SPIN(xb_ld(&bar[XB_XGEN(b.x)]) == gen, bar);
            __builtin_amdgcn_fence(__ATOMIC_ACQUIRE, "agent");
            asm volatile("s_waitcnt vmcnt(0)" ::: "memory");
        }
    }
    __syncthreads();
}

namespace pg8 {
#define PG8_LAS __attribute__((address_space(3)))
typedef unsigned short bf16_t;
typedef short bf16x8 __attribute__((ext_vector_type(8)));
typedef float f32x4 __attribute__((ext_vector_type(4)));
typedef unsigned u32x4 __attribute__((ext_vector_type(4)));
typedef int i32x8_t __attribute__((ext_vector_type(8)));
typedef int i32x4_t __attribute__((ext_vector_type(4)));
constexpr int BM = 256, BK = 64, HALF = 128, HTB = HALF * BK * 2  , STAGE_BYTES = 8 * HTB, NXCD = 8, WGM = 8;

__host__ __device__ __forceinline__ int lds_byte(int r, int c) { const int st = (r >> 4) * 2 + (c >> 5), rr = r & 15, cc = c & 31, ob = rr * 64 + cc * 2; return st * 1024 + (ob ^ (((ob >> 9) & 1) << 5)); }
__host__ __device__ __forceinline__ void stage_rc(int b, int& R, int& C) { const int st = b / 1024, sb = b % 1024, swz = sb ^ (((sb >> 9) & 1) << 5); R = (st >> 1) * 16 + swz / 64; C = (st & 1) * 32 + (swz % 64) / 2; }
__host__ __device__ __forceinline__ int perm32(int rho) { const int n = rho >> 4, i = rho & 15; return 8 * (i >> 2) + 4 * n + (i & 3); }

struct Unit { int pm, pn; };
struct Gemm { const bf16_t* A; const bf16_t* Bt; int M, N, K; };

struct StaticOrder {
    int nM, nN, nwg, G, c;
    __host__ __device__ void init(int M, int N, int G_, int c_) { nM = M / BM; nN = N / BM; nwg = nM * nN; G = G_; c = c_; }
    __host__ __device__ bool next(int i, Unit& u) const {
        const long L = (long)i * G + c; if (L >= nwg) return false;
        int wgid = (int)L; { const int q = nwg / NXCD, r = nwg % NXCD, xcd = wgid % NXCD, off = wgid / NXCD; wgid = (xcd < r ? xcd * (q + 1) : r * (q + 1) + (xcd - r) * q) + off; }
        const int nig = WGM * nN, gid = wgid / nig, fm = gid * WGM, gsz = (nM - fm) < WGM ? (nM - fm) : WGM;
        u.pm = fm + ((wgid % nig) % gsz); u.pn = (wgid % nig) / gsz; return true;
    }
    __device__ __forceinline__ void a_ready(const Unit&) const {}
    __device__ __forceinline__ void done(const Unit&) const {}
};
#if GEMM_NT
#define EPI_ST16(p, w) __builtin_nontemporal_store((w), (u32x4*)(p))
#else
#define EPI_ST16(p, w) (*(u32x4*)(p) = (w))
#endif
struct EpiStoreBf16 {
    static constexpr bool PERM = true, AFTER_DRAIN = false, SWAP23 = false, FP8 = false;
    bf16_t* O; int ldc;
    __device__ __forceinline__ void operator()(const f32x4 (&acc)[2][2][4][2], const Unit& u, int wr, int wc, int fr, int fq) const {
        const int row0 = u.pm * BM + wr * 64 + fr; const int col0 = u.pn * BM + wc * 32 + 8 * fq;
#pragma unroll
        for (int ai = 0; ai < 2; ++ai)
#pragma unroll
            for (int m = 0; m < 4; ++m) { bf16_t* rowp = O + (size_t)(row0 + ai * HALF + m * 16) * ldc + col0;
#pragma unroll
                for (int bj = 0; bj < 2; ++bj) { const f32x4 v0 = acc[ai][bj][m][0], v1 = acc[ai][bj][m][1];
                    u32x4 w; w.x = pk2(v0[0], v0[1]); w.y = pk2(v0[2], v0[3]); w.z = pk2(v1[0], v1[1]); w.w = pk2(v1[2], v1[3]);
                    EPI_ST16(rowp + bj * HALF, w); } }
    }
};
struct EpiResF32 {
    static constexpr bool PERM = false, AFTER_DRAIN = false, SWAP23 = false, FP8 = false;
    const float* base; float* out; int ldc;
    __device__ __forceinline__ void operator()(const f32x4 (&acc)[2][2][4][2], const Unit& u, int wr, int wc, int fr, int fq) const {
        const int row0 = u.pm * BM + wr * 64 + fr, col0 = u.pn * BM + wc * 32 + 4 * fq;
#pragma unroll
        for (int ai = 0; ai < 2; ++ai)
#pragma unroll
            for (int m = 0; m < 4; ++m) { const size_t off = (size_t)(row0 + ai * HALF + m * 16) * ldc + col0;
#pragma unroll
                for (int bj = 0; bj < 2; ++bj)
#pragma unroll
                    for (int n = 0; n < 2; ++n) { const f32x4 bs = *(const f32x4*)(base + off + bj * HALF + n * 16);
                        *(f32x4*)(out + off + bj * HALF + n * 16) = bs + acc[ai][bj][m][n]; } }
    }
};
struct EpiPlainF32 {
    static constexpr bool PERM = false, AFTER_DRAIN = false, SWAP23 = false, FP8 = false;
    float* C; int ldc;
    __device__ __forceinline__ void operator()(const f32x4 (&acc)[2][2][4][2], const Unit& u, int wr, int wc, int fr, int fq) const {
        const int row0 = u.pm * BM + wr * 64 + fr, col0 = u.pn * BM + wc * 32 + 4 * fq;
#pragma unroll
        for (int ai = 0; ai < 2; ++ai)
#pragma unroll
            for (int m = 0; m < 4; ++m) { float* rowp = C + (size_t)(row0 + ai * HALF + m * 16) * ldc + col0;
#pragma unroll
                for (int bj = 0; bj < 2; ++bj)
#pragma unroll
                    for (int n = 0; n < 2; ++n) *(f32x4*)(rowp + bj * HALF + n * 16) = acc[ai][bj][m][n]; }
    }
};

template <bool F8_> struct EpiVTT {
    static constexpr bool PERM = true, AFTER_DRAIN = false, SWAP23 = true, FP8 = F8_;
    bf16_t* O; float scale;
    __device__ __forceinline__ void operator()(const f32x4 (&acc)[2][2][4][2], const Unit& u, int wr, int wc, int fr, int fq) const {
        const int row0 = u.pm * BM + wr * 64 + fr; const int colt = u.pn * BM; const int b = colt >> 12, pos0 = (colt & 4095) + wc * 32 + 8 * fq;
        bf16_t* base = O + (size_t)b * 8192 * 4096 + pos0;
#pragma unroll
        for (int ai = 0; ai < 2; ++ai)
#pragma unroll
            for (int m = 0; m < 4; ++m) { bf16_t* rowp = base + (size_t)(row0 + ai * HALF + m * 16) * 4096;
#pragma unroll
                for (int bj = 0; bj < 2; ++bj) { const f32x4 v0 = F8_ ? acc[ai][bj][m][0] * scale : acc[ai][bj][m][0], v1 = F8_ ? acc[ai][bj][m][1] * scale : acc[ai][bj][m][1];
                    u32x4 w; w.x = pk2(v0[0], v0[1]); w.y = pk2(v0[2], v0[3]); w.z = pk2(v1[0], v1[1]); w.w = pk2(v1[2], v1[3]);
                    EPI_ST16(rowp + bj * HALF, w); } }
    }
};
using EpiVT = EpiVTT<false>; using EpiVTFp8 = EpiVTT<true>;

template <bool F8_> struct EpiKNormT {
    static constexpr bool PERM = true, AFTER_DRAIN = false, SWAP23 = false, FP8 = F8_;
    bf16_t* KM; const float* sspe; const float* kper; const float* gain; PG8_LAS float* tab; mutable unsigned par; float scale;
    __device__ __forceinline__ void operator()(const f32x4 (&acc)[2][2][4][2], const Unit& u, int wr, int wc, int fr, int fq) const {
        PG8_LAS float* T = tab + par * 2048;
#pragma unroll
        for (int ai = 0; ai < 2; ++ai)
#pragma unroll
            for (int m = 0; m < 4; ++m) { const int row = ai * HALF + wr * 64 + m * 16 + fr;
#pragma unroll
                for (int bj = 0; bj < 2; ++bj) { const f32x4 x = F8_ ? acc[ai][bj][m][0] * scale : acc[ai][bj][m][0], y = F8_ ? acc[ai][bj][m][1] * scale : acc[ai][bj][m][1];
                    float ss = (x[0] * x[0] + x[1] * x[1]) + (x[2] * x[2] + x[3] * x[3]) + (y[0] * y[0] + y[1] * y[1]) + (y[2] * y[2] + y[3] * y[3]);
                    ss += __shfl_xor(ss, 16); ss += __shfl_xor(ss, 32);
                    if (fq == 0) T[row * 8 + bj * 4 + wc] = ss; } }
        asm volatile("s_waitcnt lgkmcnt(0)" ::: "memory"); __builtin_amdgcn_s_barrier(); asm volatile("" ::: "memory");
        const f32x4 g0 = *(const f32x4*)(gain + wc * 32 + 8 * fq), g1 = *(const f32x4*)(gain + wc * 32 + 8 * fq + 4);
        const int tok0 = u.pm * BM, b = tok0 >> 12;
#pragma unroll
        for (int ai = 0; ai < 2; ++ai)
#pragma unroll
            for (int m = 0; m < 4; ++m) { const int row = ai * HALF + wr * 64 + m * 16 + fr, tok = tok0 + row, s = tok & 4095;
                const float sp = sspe[tok]; const f32x4 kp = *(const f32x4*)(kper + (size_t)tok * 64 + wc * 16 + 4 * fq);
#pragma unroll
                for (int bj = 0; bj < 2; ++bj) { const f32x4 t = *(const PG8_LAS f32x4*)(T + row * 8 + bj * 4);
                    const float rstd = rsqrtf(((t[0] + t[1]) + (t[2] + t[3]) + sp) * (1.0f / 192.0f) + 1e-6f);
                    const int hd = 2 * u.pn + bj;
                    bf16_t* kb = KM + ((size_t)(b * 64 + hd) * 4096 + s) * 192;
                    const f32x4 x = F8_ ? acc[ai][bj][m][0] * scale : acc[ai][bj][m][0], y = F8_ ? acc[ai][bj][m][1] * scale : acc[ai][bj][m][1];
                    u32x4 w; w.x = pk2(x[0] * rstd * g0[0], x[1] * rstd * g0[1]); w.y = pk2(x[2] * rstd * g0[2], x[3] * rstd * g0[3]);
                    w.z = pk2(y[0] * rstd * g1[0], y[1] * rstd * g1[1]); w.w = pk2(y[2] * rstd * g1[2], y[3] * rstd * g1[3]);
                    *(u32x4*)(kb + wc * 32 + 8 * fq) = w;
                    u32x2 r; r.x = pk2(kp[0] * rstd, kp[1] * rstd); r.y = pk2(kp[2] * rstd, kp[3] * rstd);
                    *(u32x2*)(kb + 128 + wc * 16 + 4 * fq) = r; } }
        par ^= 1u;
    }
};
using EpiKNorm = EpiKNormT<false>; using EpiKNormFp8 = EpiKNormT<true>;

template <bool F8_> struct EpiResNormT {
    static constexpr bool PERM = false, AFTER_DRAIN = false, SWAP23 = false, FP8 = F8_;
    const float* base; float* out; int ldc; const float* gain; bf16_t* xg; float* ss; unsigned char* x8; float scale;
    __device__ __forceinline__ void operator()(const f32x4 (&acc)[2][2][4][2], const Unit& u, int wr, int wc, int fr, int fq) const {
        const int row0 = u.pm * BM + wr * 64 + fr, col0 = u.pn * BM + wc * 32 + 4 * fq;
        f32x4 gv[2][2];
#pragma unroll
        for (int bj = 0; bj < 2; ++bj)
#pragma unroll
            for (int n = 0; n < 2; ++n) gv[bj][n] = *(const f32x4*)(gain + col0 + bj * HALF + n * 16);
#pragma unroll
        for (int ai = 0; ai < 2; ++ai)
#pragma unroll
            for (int m = 0; m < 4; ++m) { const int row = row0 + ai * HALF + m * 16; const size_t off = (size_t)row * ldc + col0; float sq = 0.f;
#pragma unroll
                for (int bj = 0; bj < 2; ++bj)
#pragma unroll
                    for (int n = 0; n < 2; ++n) { const f32x4 bs = *(const f32x4*)(base + off + bj * HALF + n * 16); const f32x4 v = F8_ ? bs + acc[ai][bj][m][n] * scale : bs + acc[ai][bj][m][n];
                        *(f32x4*)(out + off + bj * HALF + n * 16) = v;
                        sq += (v[0] * v[0] + v[1] * v[1]) + (v[2] * v[2] + v[3] * v[3]);
                        const f32x4 g = gv[bj][n]; u32x2 w; w.x = pk2(v[0] * g[0], v[1] * g[1]); w.y = pk2(v[2] * g[2], v[3] * g[3]);
                        *(u32x2*)(xg + off + bj * HALF + n * 16) = w;
                        if (x8) *(unsigned*)(x8 + off + bj * HALF + n * 16) = pk4_fp8(v[0] * g[0] * 16.0f, v[1] * g[1] * 16.0f, v[2] * g[2] * 16.0f, v[3] * g[3] * 16.0f); }
                sq += __shfl_xor(sq, 16); sq += __shfl_xor(sq, 32);
                if (fq == 0) atomicAdd(ss + row, sq); }
    }
};
using EpiResNorm = EpiResNormT<false>; using EpiResNormFp8 = EpiResNormT<true>;
struct EpiStoreBf16RowScale {
    static constexpr bool PERM = true, AFTER_DRAIN = false, SWAP23 = false, FP8 = false;
    bf16_t* O; int ldc; const float* ss; float inv_dim;
    __device__ __forceinline__ void operator()(const f32x4 (&acc)[2][2][4][2], const Unit& u, int wr, int wc, int fr, int fq) const {
        const int row0 = u.pm * BM + wr * 64 + fr; const int col0 = u.pn * BM + wc * 32 + 8 * fq;
#pragma unroll
        for (int ai = 0; ai < 2; ++ai)
#pragma unroll
            for (int m = 0; m < 4; ++m) { const int row = row0 + ai * HALF + m * 16; const float rs = rsqrtf(ss[row] * inv_dim + 1e-6f);
                bf16_t* rowp = O + (size_t)row * ldc + col0;
#pragma unroll
                for (int bj = 0; bj < 2; ++bj) { const f32x4 v0 = acc[ai][bj][m][0] * rs, v1 = acc[ai][bj][m][1] * rs;
                    u32x4 w; w.x = pk2(v0[0], v0[1]); w.y = pk2(v0[2], v0[3]); w.z = pk2(v1[0], v1[1]); w.w = pk2(v1[2], v1[3]);
                    EPI_ST16(rowp + bj * HALF, w); } }
    }
};

struct EpiStoreBf16Fp8 {
    static constexpr bool PERM = true, AFTER_DRAIN = false, SWAP23 = false, FP8 = true;
    bf16_t* O; int ldc; float scale; int nostore = 0;
    __device__ __forceinline__ void operator()(const f32x4 (&acc)[2][2][4][2], const Unit& u, int wr, int wc, int fr, int fq) const {
        const int row0 = u.pm * BM + wr * 64 + fr; const int col0 = u.pn * BM + wc * 32 + 8 * fq;
#pragma unroll
        for (int ai = 0; ai < 2; ++ai)
#pragma unroll
            for (int m = 0; m < 4; ++m) { bf16_t* rowp = O + (size_t)(row0 + ai * HALF + m * 16) * ldc + col0;
#pragma unroll
                for (int bj = 0; bj < 2; ++bj) { const f32x4 v0 = acc[ai][bj][m][0] * scale, v1 = acc[ai][bj][m][1] * scale;
                    u32x4 w; w.x = pk2(v0[0], v0[1]); w.y = pk2(v0[2], v0[3]); w.z = pk2(v1[0], v1[1]); w.w = pk2(v1[2], v1[3]);
                    if (!nostore || w.x == 0x12345679u) EPI_ST16(rowp + bj * HALF, w); } }
    }
};

struct OrderBf16Part {
    int G, c, q0, nq, nz;
    __device__ bool next(int i, Unit& u) const { const int L = i * G + c;
        if (L < nq * 64) { u.pm = L & 63; u.pn = q0 + (L >> 6); return true; }
        const int Lz = L - nq * 64; if (Lz >= nz * 4) return false;
        const int j = Lz >> 2; u.pm = 16 * (Lz & 3); u.pn = j < q0 ? j : j + nq; return true; }
    __device__ __forceinline__ void a_ready(const Unit&) const {}
    __device__ __forceinline__ void done(const Unit&) const {}
};
struct OrderFp8Part {
    int G, c, q0, nq, nz, rot;
    __device__ bool next(int i, Unit& u) const { const int L = i * G + (G == 256 ? ((c + rot) & 255) : c); if (L >= nz * 60) return false;
        const int r = L % 60, j = L / 60; u.pm = r + r / 15 + 1; u.pn = j < q0 ? j : j + nq; return true; }
    __device__ __forceinline__ void a_ready(const Unit&) const {}
    __device__ __forceinline__ void done(const Unit&) const {}
};

struct EpiStoreBf16RowScaleFp8 {
    static constexpr bool PERM = true, AFTER_DRAIN = false, SWAP23 = false, FP8 = true;
    bf16_t* O; int ldc; const float* ss; float inv_dim, scale;
    __device__ __forceinline__ void operator()(const f32x4 (&acc)[2][2][4][2], const Unit& u, int wr, int wc, int fr, int fq) const {
        const int row0 = u.pm * BM + wr * 64 + fr; const int col0 = u.pn * BM + wc * 32 + 8 * fq;
#pragma unroll
        for (int ai = 0; ai < 2; ++ai)
#pragma unroll
            for (int m = 0; m < 4; ++m) { const int row = row0 + ai * HALF + m * 16; const float rs = rsqrtf(ss[row] * inv_dim + 1e-6f) * scale;
                bf16_t* rowp = O + (size_t)row * ldc + col0;
#pragma unroll
                for (int bj = 0; bj < 2; ++bj) { const f32x4 v0 = acc[ai][bj][m][0] * rs, v1 = acc[ai][bj][m][1] * rs;
                    u32x4 w; w.x = pk2(v0[0], v0[1]); w.y = pk2(v0[2], v0[3]); w.z = pk2(v1[0], v1[1]); w.w = pk2(v1[2], v1[3]);
                    EPI_ST16(rowp + bj * HALF, w); } }
    }
};
struct OrderTiles {
    int G, c, ncol;
    __device__ bool next(int i, Unit& u) const { const int L = i * G + c; if (L >= ncol * 64) return false; u.pm = L & 63; u.pn = L >> 6; return true; }
    __device__ __forceinline__ void a_ready(const Unit&) const {}
    __device__ __forceinline__ void done(const Unit&) const {}
};

struct EpiResF32Fp8 {
    static constexpr bool PERM = false, AFTER_DRAIN = false, SWAP23 = false, FP8 = true;
    const float* base; float* out; int ldc; float scale;
    __device__ __forceinline__ void operator()(const f32x4 (&acc)[2][2][4][2], const Unit& u, int wr, int wc, int fr, int fq) const {
        const int row0 = u.pm * BM + wr * 64 + fr, col0 = u.pn * BM + wc * 32 + 4 * fq;
#pragma unroll
        for (int ai = 0; ai < 2; ++ai)
#pragma unroll
            for (int m = 0; m < 4; ++m) { const size_t off = (size_t)(row0 + ai * HALF + m * 16) * ldc + col0;
#pragma unroll
                for (int bj = 0; bj < 2; ++bj)
#pragma unroll
                    for (int n = 0; n < 2; ++n) { const f32x4 bs = *(const f32x4*)(base + off + bj * HALF + n * 16);
                        *(f32x4*)(out + off + bj * HALF + n * 16) = bs + acc[ai][bj][m][n] * scale; } }
    }
};

template <class Base> struct OrderSwap {
    Base B;
    __device__ bool next(int i, Unit& u) const { Unit t; if (!B.next(i, t)) return false; u.pm = t.pn; u.pn = t.pm; return true; }
    __device__ __forceinline__ void a_ready(const Unit&) const {}
    __device__ __forceinline__ void done(const Unit&) const {}
};

struct OrderFp8PartP8 {
    int G, c;
    __device__ bool next(int i, Unit& u) const { int L;
        if (G != 256) { L = i * G + c; if (L >= 1920) return false; }
        else if (i < 7) L = i * 256 + c;
        else { if (c < 192 || i > 8) return false; L = 1792 + (i - 7) * 64 + (c - 192); }
        const int r = L % 60, j = L / 60; u.pm = r + r / 15 + 1; u.pn = 9 + j; return true; }
    __device__ __forceinline__ void a_ready(const Unit&) const {}
    __device__ __forceinline__ void done(const Unit&) const {}
};
template <class Epi, class Sched, bool STAMP = false>
__device__ __forceinline__ void gemm_phase(PG8_LAS unsigned char* lds, const Gemm g, const Sched& S, const Epi& E, unsigned long long* stamps, int stag = 0) {
    const int tid = tid_opaque(), wid = __builtin_amdgcn_readfirstlane(tid >> 6), lane = tid & 63, wr = wid >> 2, wc = wid & 3, fr = lane & 15, fq = lane >> 4;
    const int K = g.K, nt = K / BK;
    int ts_lo = 0, ts_hi = 0, nts = 0; const unsigned long long rt_entry = STAMP ? (unsigned long long)wall_clock64() : 0ull;
#define PG8_STAMP() do { if (STAMP && wid == 0 && nts < 64) { const unsigned long long _c = (unsigned long long)clock64(); \
        ts_lo = (lane == nts) ? (int)(unsigned)_c : ts_lo; ts_hi = (lane == nts) ? (int)(unsigned)(_c >> 32) : ts_hi; ++nts; } } while (0)
    PG8_STAMP();
    unsigned voffA[2], voffB[2];
#pragma unroll
    for (int i = 0; i < 2; ++i) { int R, C; stage_rc(tid * 16 + i * 8192, R, C); int Rb = Epi::PERM ? ((R & ~31) + perm32(R & 31)) : R; if (Epi::SWAP23) Rb = vt_key_of_pos(Rb);
        voffA[i] = (unsigned)(R * K + C) * 2u; voffB[i] = (unsigned)(Rb * K + C) * 2u; }
    const size_t kstep = (size_t)(BK * 2);
    const size_t hstep = (size_t)HALF * K * 2;
    const size_t tstep = 2 * hstep;
    const unsigned ldsw = (unsigned)wid * 1024u;
    const int aoff = lds_byte(wr * 64 + fr, fq * 8), boff = lds_byte(wc * 32 + fr, fq * 8);
#define PG8_SA(b, h) (((b) * 2 + (h)) * HTB)
#define PG8_SB(b, h) ((4 + (b) * 2 + (h)) * HTB)
#define PG8_STAGE(bufoff, gbase, voff) do { _Pragma("unroll") for (int _i = 0; _i < 2; ++_i) \
        __builtin_amdgcn_global_load_lds((const unsigned*)((const char*)(gbase) + (voff)[_i]), (PG8_LAS unsigned*)(lds + (bufoff) + ldsw + _i * 8192), 16, 0, 0); } while (0)
#define PG8_LDA(dst, b, h) do { if constexpr (Epi::FP8) { _Pragma("unroll") for (int m = 0; m < 4; ++m) { const PG8_LAS unsigned char* p_ = lds + PG8_SA(b, h) + aoff + m * 2048; \
            const i32x4_t lo_ = *(const PG8_LAS i32x4_t*)p_, hi_ = *(const PG8_LAS i32x4_t*)(p_ + 1024); dst##8[m] = __builtin_shufflevector(lo_, hi_, 0, 1, 2, 3, 4, 5, 6, 7); } } \
        else { _Pragma("unroll") for (int m = 0; m < 4; ++m) _Pragma("unroll") for (int k = 0; k < 2; ++k) dst[m][k] = *(const PG8_LAS bf16x8*)(lds + PG8_SA(b, h) + aoff + m * 2048 + k * 1024); } } while (0)
#define PG8_LDB(dst, b, h) do { if constexpr (Epi::FP8) { _Pragma("unroll") for (int n = 0; n < 2; ++n) { const PG8_LAS unsigned char* p_ = lds + PG8_SB(b, h) + boff + n * 2048; \
            const i32x4_t lo_ = *(const PG8_LAS i32x4_t*)p_, hi_ = *(const PG8_LAS i32x4_t*)(p_ + 1024); dst##8[n] = __builtin_shufflevector(lo_, hi_, 0, 1, 2, 3, 4, 5, 6, 7); } } \
        else { _Pragma("unroll") for (int n = 0; n < 2; ++n) _Pragma("unroll") for (int k = 0; k < 2; ++k) dst[n][k] = *(const PG8_LAS bf16x8*)(lds + PG8_SB(b, h) + boff + n * 2048 + k * 1024); } } while (0)
#define PG8_MMA(ai, bj, At, Bt) do { __builtin_amdgcn_s_setprio(1); \
        if constexpr (Epi::FP8) { \
            _Pragma("unroll") for (int m = 0; m < 4; ++m) _Pragma("unroll") for (int n = 0; n < 2; ++n) \
                asm volatile("v_mfma_scale_f32_16x16x128_f8f6f4 %0, %1, %2, %0, %3, %3 op_sel_hi:[0,0,0]" : "+v"(acc[ai][bj][m][n]) : "v"(Bt##8[n]), "v"(At##8[m]), "v"(fp8_scale_one)); \
        } else { \
            _Pragma("unroll") for (int m = 0; m < 4; ++m) _Pragma("unroll") for (int n = 0; n < 2; ++n) _Pragma("unroll") for (int k = 0; k < 2; ++k) \
                acc[ai][bj][m][n] = __builtin_amdgcn_mfma_f32_16x16x32_bf16(Bt[n][k], At[m][k], acc[ai][bj][m][n], 0, 0, 0); } \
        __builtin_amdgcn_s_setprio(0); } while (0)
#define PG8_WAIT_V(n) asm volatile("s_waitcnt vmcnt(" #n ")" ::: "memory")
#define PG8_WAIT_L(n) asm volatile("s_waitcnt lgkmcnt(" #n ")" ::: "memory")
#define PG8_BAR __builtin_amdgcn_s_barrier()
#define PG8_SCHED __builtin_amdgcn_sched_barrier(0)
    Unit cur, nxt; int ui = 0;
    if (!S.next(0, cur)) return;
    if (stag > 0) { const int n_ = (int)((blockIdx.x >> 3) & 7u) * stag; for (int i_ = 0; i_ < n_; ++i_) __builtin_amdgcn_s_sleep(37); }
    f32x4 acc[2][2][4][2];
#pragma unroll
    for (int a = 0; a < 2; ++a)
#pragma unroll
        for (int b = 0; b < 2; ++b)
#pragma unroll
            for (int m = 0; m < 4; ++m)
#pragma unroll
                for (int n = 0; n < 2; ++n) acc[a][b][m][n] = (f32x4){0.f, 0.f, 0.f, 0.f};
    bf16x8 At[4][2], B0[2][2], B1[2][2]; i32x8_t At8[4], B08[2], B18[2]; const int fp8_scale_one = 0x7f7f7f7f;
    const char* cA = (const char*)g.A + (size_t)cur.pm * tstep; const char* cB = (const char*)g.Bt + (size_t)cur.pn * tstep;
    S.a_ready(cur);
    PG8_STAGE(PG8_SB(0, 0), cB, voffB); PG8_STAGE(PG8_SA(0, 0), cA, voffA); PG8_STAGE(PG8_SB(0, 1), cB + hstep, voffB); PG8_STAGE(PG8_SA(0, 1), cA + hstep, voffA);
    if (wr == 1) PG8_BAR;
    PG8_WAIT_V(4); PG8_BAR;
    PG8_STAGE(PG8_SB(1, 0), cB + kstep, voffB); PG8_STAGE(PG8_SA(1, 0), cA + kstep, voffA); PG8_STAGE(PG8_SB(1, 1), cB + hstep + kstep, voffB);
    PG8_WAIT_V(6); PG8_BAR;
    PG8_STAMP();
    for (;;) {
        const bool has_next = S.next(ui + 1, nxt);
        const char* nA = has_next ? (const char*)g.A + (size_t)nxt.pm * tstep : cA; const char* nB = has_next ? (const char*)g.Bt + (size_t)nxt.pn * tstep : cB;
        for (int t = 0; t < nt; t += 2) {
            const bool last = (t == nt - 2);
            const char* a1 = cA + (size_t)(t + 1) * kstep;
            const char* a2 = last ? nA : cA + (size_t)(t + 2) * kstep; const char* b2 = last ? nB : cB + (size_t)(t + 2) * kstep;
            const char* a3 = a2 + kstep; const char* b3 = b2 + kstep;
            if (last && has_next) S.a_ready(nxt);
            PG8_LDB(B0, 0, 0); PG8_SCHED; PG8_LDA(At, 0, 0); PG8_STAGE(PG8_SA(1, 1), a1 + hstep, voffA);
            PG8_WAIT_L(8); PG8_BAR; PG8_WAIT_L(0); PG8_MMA(0, 0, At, B0); PG8_BAR; PG8_SCHED;
            PG8_LDB(B1, 0, 1); PG8_STAGE(PG8_SB(0, 0), b2, voffB);
            PG8_BAR; PG8_WAIT_L(0); PG8_MMA(0, 1, At, B1); PG8_BAR;
            PG8_LDA(At, 0, 1); PG8_STAGE(PG8_SA(0, 0), a2, voffA);
            PG8_BAR; PG8_WAIT_L(0); PG8_MMA(1, 0, At, B0); PG8_BAR; PG8_SCHED;
            PG8_STAGE(PG8_SB(0, 1), b2 + hstep, voffB);
            PG8_WAIT_V(6); PG8_BAR; PG8_MMA(1, 1, At, B1); PG8_BAR;
            PG8_LDB(B0, 1, 0); PG8_SCHED; PG8_LDA(At, 1, 0); PG8_STAGE(PG8_SA(0, 1), a2 + hstep, voffA);
            PG8_WAIT_L(8); PG8_BAR; PG8_WAIT_L(0); PG8_MMA(0, 0, At, B0); PG8_BAR; PG8_SCHED;
            PG8_LDB(B1, 1, 1); PG8_STAGE(PG8_SB(1, 0), b3, voffB);
            PG8_BAR; PG8_WAIT_L(0); PG8_MMA(0, 1, At, B1); PG8_BAR;
            PG8_LDA(At, 1, 1); PG8_STAGE(PG8_SA(1, 0), a3, voffA);
            PG8_BAR; PG8_WAIT_L(0); PG8_MMA(1, 0, At, B0); PG8_BAR; PG8_SCHED;
            PG8_STAGE(PG8_SB(1, 1), b3 + hstep, voffB);
            PG8_WAIT_V(6); PG8_BAR; PG8_MMA(1, 1, At, B1); PG8_BAR;
        }
        PG8_STAMP();
        if constexpr (Epi::FP8) asm volatile("s_nop 15\n\ts_nop 15" ::: "memory");
        if constexpr (!Epi::AFTER_DRAIN) { E(acc, cur, wr, wc, fr, fq); S.done(cur); }
        PG8_STAMP();
        if (!has_next) break;
#pragma unroll
        for (int a = 0; a < 2; ++a)
#pragma unroll
            for (int b = 0; b < 2; ++b)
#pragma unroll
                for (int m = 0; m < 4; ++m)
#pragma unroll
                    for (int n = 0; n < 2; ++n) acc[a][b][m][n] = (f32x4){0.f, 0.f, 0.f, 0.f};
        cur = nxt; cA = nA; cB = nB; ++ui;
    }
    PG8_WAIT_V(0);
    if (wr == 0) PG8_BAR;
    PG8_BAR;
    if constexpr (Epi::AFTER_DRAIN) { E.fused(acc, cur, wr, wc, fr, fq, lds, wid, lane); S.done(cur); }
    PG8_STAMP();
    if (STAMP && wid == 0) { stamps[lane] = lane < nts ? (((unsigned long long)(unsigned)ts_hi << 32) | (unsigned)ts_lo) : 0ull;
        if (lane == 62) stamps[62] = rt_entry; if (lane == 63) stamps[63] = (unsigned long long)wall_clock64(); }
#undef PG8_STAMP
#undef PG8_SA
#undef PG8_SB
#undef PG8_STAGE
#undef PG8_LDA
#undef PG8_LDB
#undef PG8_MMA
#undef PG8_WAIT_V
#undef PG8_WAIT_L
#undef PG8_BAR
#undef PG8_SCHED
}
}


DI void phase_wconv(LAS unsigned char* lds, const float* __restrict__ src, bf16_t* __restrict__ dst, int K, int N, int Npad, int bid, int nb, float q8s = 0.f, int colmap = 0, unsigned char* __restrict__ dst8 = nullptr, int n8_0 = 0, int n8_1 = 0) {
    LAS float* tile = (LAS float*)lds;
    const int tid = tid_opaque();
    const int tk = K / 64, tn = Npad / 256, total = tk * tn;
    for (int t = bid; t < total; t += nb) {
        const int k0 = (t % tk) * 64, n0 = (t / tk) * 256;
        __syncthreads();
        {
            const int ty = tid >> 6, tx = tid & 63, n = n0 + tx * 4;
            f32x4 v[8];
#pragma unroll
            for (int i = 0; i < 8; ++i) {
                const int k = k0 + ty + 8 * i;
                v[i] = (f32x4){0.f, 0.f, 0.f, 0.f};
                if (colmap) { const int ns = (n >> 7) * 256 + (colmap == 1 ? 128 : 0) + (n & 127); v[i] = *(const f32x4*)(src + (size_t)k * (2 * N) + ns); }
                else if (n < N) v[i] = *(const f32x4*)(src + (size_t)k * N + n);
            }
#pragma unroll
            for (int i = 0; i < 8; ++i) { LAS float* pp = tile + (ty + 8 * i) * 257 + tx * 4; pp[0] = v[i][0]; pp[1] = v[i][1]; pp[2] = v[i][2]; pp[3] = v[i][3]; }
        }
        __syncthreads();
#pragma unroll
        for (int ps_ = 0; ps_ < 4; ++ps_) {
            const int n = (tid >> 3) + 64 * ps_, kc = tid & 7;
            float v[8];
#pragma unroll
            for (int j = 0; j < 8; ++j) { v[j] = tile[(kc * 8 + j) * 257 + n]; if (q8s > 0.f) v[j] = emu_q8(v[j], q8s); else if (q8s < 0.f && n0 + n >= C_ZC) v[j] = emu_q8(v[j], -q8s); }
            u32x4 w; w.x = pk2(v[0], v[1]); w.y = pk2(v[2], v[3]); w.z = pk2(v[4], v[5]); w.w = pk2(v[6], v[7]);
            *(u32x4*)(dst + (size_t)(n0 + n) * K + k0 + kc * 8) = w;
            if (dst8 && (n0 + n < n8_0 || n0 + n >= n8_1)) { u32x2 b; b.x = pk4_fp8(v[0] * 64.0f, v[1] * 64.0f, v[2] * 64.0f, v[3] * 64.0f); b.y = pk4_fp8(v[4] * 64.0f, v[5] * 64.0f, v[6] * 64.0f, v[7] * 64.0f);
                *(u32x2*)(dst8 + (size_t)(n0 + n) * K + k0 + kc * 8) = b; }
        }
    }
}

DI void phase_rmsnorm(const float* __restrict__ x, const float* __restrict__ gain, bf16_t* __restrict__ h, int bid, int nb, float q8s = 0.f, unsigned char* __restrict__ h8 = nullptr) {
    const int tid = tid_opaque(); const int lane = tid & 63, wid = tid >> 6;
    for (int row = bid * 8 + wid; row < MTOK; row += nb * 8) {
        const float* xr = x + (size_t)row * DM;
        f32x4 v[16]; float ss = 0.f;
#pragma unroll
        for (int i = 0; i < 16; ++i) { v[i] = *(const f32x4*)(xr + (i * 64 + lane) * 4); ss += v[i][0] * v[i][0] + v[i][1] * v[i][1] + v[i][2] * v[i][2] + v[i][3] * v[i][3]; }
#pragma unroll
        for (int o = 32; o >= 1; o >>= 1) ss += __shfl_xor(ss, o);
        const float rstd = rsqrtf(ss * (1.0f / DM) + EPSN);
        bf16_t* hr = h + (size_t)row * DM;
#pragma unroll
        for (int i = 0; i < 16; ++i) { const f32x4 g = *(const f32x4*)(gain + (i * 64 + lane) * 4);
            float y0 = v[i][0] * rstd * g[0], y1 = v[i][1] * rstd * g[1], y2 = v[i][2] * rstd * g[2], y3 = v[i][3] * rstd * g[3];
            if (q8s > 0.f || (q8s < 0.f && (row & 4095) >= 256)) { const float qa = fabsf(q8s); y0 = emu_q8(y0, qa); y1 = emu_q8(y1, qa); y2 = emu_q8(y2, qa); y3 = emu_q8(y3, qa); }
            u32x2 w; w.x = pk2(y0, y1); w.y = pk2(y2, y3);
            *(u32x2*)(hr + (i * 64 + lane) * 4) = w;
            if (h8) *(unsigned*)(h8 + (size_t)row * DM + (i * 64 + lane) * 4) = pk4_fp8(y0 * 16.0f, y1 * 16.0f, y2 * 16.0f, y3 * 16.0f); }
    }
}

DI void ld192(const bf16_t* p, int j8, float (&v)[24]) {
#pragma unroll
    for (int c = 0; c < 3; ++c) { const u32x4 w = *(const u32x4*)(p + (j8 + 8 * c) * 8);
        v[c * 8 + 0] = bflo(w.x); v[c * 8 + 1] = bfhi(w.x); v[c * 8 + 2] = bflo(w.y); v[c * 8 + 3] = bfhi(w.y);
        v[c * 8 + 4] = bflo(w.z); v[c * 8 + 5] = bfhi(w.z); v[c * 8 + 6] = bflo(w.w); v[c * 8 + 7] = bfhi(w.w); }
}
DI void st192(bf16_t* p, int j8, const float (&v)[24]) {
#pragma unroll
    for (int c = 0; c < 3; ++c) { u32x4 w; w.x = pk2(v[c * 8 + 0], v[c * 8 + 1]); w.y = pk2(v[c * 8 + 2], v[c * 8 + 3]); w.z = pk2(v[c * 8 + 4], v[c * 8 + 5]); w.w = pk2(v[c * 8 + 6], v[c * 8 + 7]);
        *(u32x4*)(p + (j8 + 8 * c) * 8) = w; }
}
DI float sum8(float s) { s += __shfl_xor(s, 1); s += __shfl_xor(s, 2); s += __shfl_xor(s, 4); return s; }

DI void phase_nsa_prep(const Params& P, int bid, int nb) {
    bf16_t* Y0 = (bf16_t*)(P.ws + OFF_Y0);
    bf16_t* KS = (bf16_t*)(P.ws + OFF_KS); bf16_t* KW = (bf16_t*)(P.ws + OFF_KW);
    bf16_t* ACK = (bf16_t*)(P.ws + OFF_ACK); bf16_t* ACV = (bf16_t*)(P.ws + OFF_ACV);
    const int tid = tid_opaque(), grp = (tid >> 3) & 15, j8 = tid & 7;
    for (int tok = bid * 4 + (tid >> 7); tok < MTOK; tok += nb * 4) {
        const int b = tok / SEQ, s = tok % SEQ;
        bf16_t* yr = Y0 + (size_t)tok * N1P;
        if (grp < 8) {
            const int g = grp & 3, br = grp >> 2;
            float v[24]; ld192(yr + (br ? C_KVW : C_KVS) + g * DK, j8, v);
            float ss = 0.f;
#pragma unroll
            for (int i = 0; i < 24; ++i) ss += v[i] * v[i];
            ss = sum8(ss);
            const float rstd = rsqrtf(ss * (1.0f / DK) + EPSN);
            const float* kn = P.nsa_k_norm + (br ? 2 : 1) * DK;
#pragma unroll
            for (int c = 0; c < 3; ++c)
#pragma unroll
                for (int e = 0; e < 8; ++e) v[c * 8 + e] *= rstd * kn[(j8 + 8 * c) * 8 + e];
            st192((br ? KW : KS) + ((size_t)(b * NG + g) * SEQ + s) * DK, j8, v);
        } else if (grp < 12) {
            const int g = grp - 8;
            float v[24]; ld192(yr + C_KVC + g * DK, j8, v);
#pragma unroll
            for (int k = 0; k < 2; ++k) {
                const int n = (s >> 4) - k, l = s - 16 * n;
                if (n >= 0 && n <= 254) {
                    float w[24];
#pragma unroll
                    for (int c = 0; c < 3; ++c)
#pragma unroll
                        for (int e = 0; e < 8; ++e) w[c * 8 + e] = v[c * 8 + e] + P.pe_k[l * DK + (j8 + 8 * c) * 8 + e];
                    st192(ACK + ((size_t)((b * NG + g) * 256 + n)) * 6144 + l * DK, j8, w);
                }
            }
        } else if (grp < 16) {
            const int g = grp - 12;
            const bf16_t* src = yr + C_KVC + NG * DK + g * DV;
            float v[16];
#pragma unroll
            for (int c = 0; c < 2; ++c) { const u32x4 w = *(const u32x4*)(src + (j8 + 8 * c) * 8);
                v[c * 8 + 0] = bflo(w.x); v[c * 8 + 1] = bfhi(w.x); v[c * 8 + 2] = bflo(w.y); v[c * 8 + 3] = bfhi(w.y);
                v[c * 8 + 4] = bflo(w.z); v[c * 8 + 5] = bfhi(w.z); v[c * 8 + 6] = bflo(w.w); v[c * 8 + 7] = bfhi(w.w); }
#pragma unroll
            for (int k = 0; k < 2; ++k) {
                const int n = (s >> 4) - k, l = s - 16 * n;
                if (n >= 0 && n <= 254) {
                    bf16_t* dst = ACV + ((size_t)((b * NG + g) * 256 + n)) * 4096 + l * DV;
#pragma unroll
                    for (int c = 0; c < 2; ++c) { float w[8];
#pragma unroll
                        for (int e = 0; e < 8; ++e) w[e] = v[c * 8 + e] + P.pe_v[l * DV + (j8 + 8 * c) * 8 + e];
                        u32x4 o; o.x = pk2(w[0], w[1]); o.y = pk2(w[2], w[3]); o.z = pk2(w[4], w[5]); o.w = pk2(w[6], w[7]);
                        *(u32x4*)(dst + (j8 + 8 * c) * 8) = o; }
                }
            }
        }
    }
    for (int i = bid * 512 + tid; i < 16 * (6144 + 4096) / 8; i += nb * 512) {
        const int per = (6144 + 4096) / 8, bg = i / per, c = i % per;
        const u32x4 z = {0u, 0u, 0u, 0u};
        if (c < 6144 / 8) *(u32x4*)(ACK + ((size_t)(bg * 256 + 255)) * 6144 + c * 8) = z;
        else *(u32x4*)(ACV + ((size_t)(bg * 256 + 255)) * 4096 + (c - 6144 / 8) * 8) = z;
    }
}

DI int swap23(int p) { return (p & ~0xC) | ((p & 4) << 1) | ((p & 8) >> 1); }
DI void phase_vt(LAS unsigned char* lds, const bf16_t* __restrict__ src, size_t src_stride, int col0, int col_step, int nhv, bf16_t* __restrict__ dst, int bid, int nb) {
    LAS bf16_t* tile = (LAS bf16_t*)lds;
    const int tid = tid_opaque();
    const int ntile = SEQ / 64, total = BATCH * nhv * ntile;
    for (int it = bid; it < total; it += nb) {
        const int mat = it / ntile, tt = it % ntile, b = mat / nhv, hv = mat % nhv;
        __syncthreads();
#pragma unroll
        for (int i = 0; i < 2; ++i) {
            const int q = tid + 512 * i, tok = q >> 4, ch = q & 15;
            const u32x4 w = *(const u32x4*)(src + (size_t)(b * SEQ + tt * 64 + tok) * src_stride + col0 + hv * col_step + ch * 8);
            *(LAS u32x4*)(tile + tok * 136 + ch * 8) = w;
        }
        __syncthreads();
        {
            const int dv = tid >> 2, kq = tid & 3;
            unsigned w[8];
#pragma unroll
            for (int e = 0; e < 8; ++e) {
                const int p0 = kq * 16 + 2 * e, p1 = p0 + 1;
                const int k0 = vt_key_of_pos(p0), k1 = vt_key_of_pos(p1);
                w[e] = (unsigned)tile[k0 * 136 + dv] | ((unsigned)tile[k1 * 136 + dv] << 16);
            }
            bf16_t* d = dst + ((size_t)mat * DV + dv) * SEQ + tt * 64 + kq * 16;
            u32x4 a = {w[0], w[1], w[2], w[3]}, c = {w[4], w[5], w[6], w[7]};
            *(u32x4*)d = a; *(u32x4*)(d + 8) = c;
        }
    }
}

DI void phase_cmp2(LAS unsigned char* lds, const Params& P, int bid, int nb) {
    LAS float* sk = (LAS float*)lds;
    LAS float* sv = sk + 192;
    LAS float* red = sv + 128;
    const float* HIDK = (const float*)(P.ws + OFF_HIDK); const float* HIDV = (const float*)(P.ws + OFF_HIDV);
    bf16_t* KC = (bf16_t*)(P.ws + OFF_KC); bf16_t* VTC = (bf16_t*)(P.ws + OFF_VTC);
    const int tid = tid_opaque(), lane = tid & 63, wid = tid >> 6;
    for (int m = bid; m < 4096; m += nb) {
        const int n = m & 255, bg = m >> 8;
        __syncthreads();
        if (tid < 192) { const float h = HIDK[(size_t)m * 256 + tid]; sk[tid] = h / (1.0f + __expf(-h)); }
        else if (tid < 320) { const float h = HIDV[(size_t)m * 256 + tid - 192]; sv[tid - 192] = h / (1.0f + __expf(-h)); }
        __syncthreads();
        float acc = 0.f;
        if (tid < 192) { for (int i = 0; i < 192; ++i) acc += sk[i] * P.w2_k[i * 192 + tid]; }
        else if (tid < 320) { const int j = tid - 192; for (int i = 0; i < 128; ++i) acc += sv[i] * P.w2_v[i * 128 + j]; }
        float ss = (tid < 192) ? acc * acc : 0.f;
#pragma unroll
        for (int o = 32; o >= 1; o >>= 1) ss += __shfl_xor(ss, o);
        if (lane == 0) red[wid] = ss;
        __syncthreads();
        const float tot = red[0] + red[1] + red[2];
        const float rstd = rsqrtf(tot * (1.0f / DK) + EPSN);
        if (tid < 192) { const float o = (n == 255) ? 0.f : acc * rstd * P.nsa_k_norm[tid];
            KC[(size_t)m * DK + tid] = (bf16_t)(pk2(o, 0.f) & 0xffffu); }
        else if (tid < 320) { const int j = tid - 192; const float o = (n == 255) ? 0.f : acc;
            const int pn = vt_pos_of_key(n);
            VTC[((size_t)bg * DV + j) * 256 + pn] = (bf16_t)(pk2(o, 0.f) & 0xffffu); }
    }
}

DI void phase_mla_prep1(const Params& P, int bid, int nb) {
    const bf16_t* Y1 = (const bf16_t*)(P.ws + OFF_Y1);
    bf16_t* CQN = (bf16_t*)(P.ws + OFF_CQN); bf16_t* CKVN = (bf16_t*)(P.ws + OFF_CKVN); float* ROPE = (float*)(P.ws + OFF_ROPE);
    float* KPER = (float*)(P.ws + OFF_KPER); float* SSPE = (float*)(P.ws + OFF_SSPE);
    const int tid = tid_opaque(); const int lane = tid & 63, wid = tid >> 6;
    constexpr int TU = 4;
    for (int tok0 = (bid * 8 + wid) * TU; tok0 < MTOK; tok0 += nb * 8 * TU) {
        u32x4 wq[TU][3], wk[TU]; int pos[TU]; bf16_t kp1[TU], kp2[TU];
#pragma unroll
        for (int t = 0; t < TU; ++t) { const bf16_t* yr = Y1 + (size_t)(tok0 + t) * N3P;
#pragma unroll
            for (int c = 0; c < 3; ++c) wq[t][c] = *(const u32x4*)(yr + C3_CQ + (c * 64 + lane) * 8);
            wk[t] = *(const u32x4*)(yr + C3_CKV + lane * 8);
            pos[t] = P.pos[tok0 + t]; kp1[t] = yr[C3_KPE + (lane & 31)]; kp2[t] = yr[C3_KPE + 32 + (lane & 31)]; }
#pragma unroll
        for (int t = 0; t < TU; ++t) { const int tok = tok0 + t;
            {
                float v[24]; float ss = 0.f;
#pragma unroll
                for (int c = 0; c < 3; ++c) { const u32x4 w = wq[t][c];
                    v[c * 8 + 0] = bflo(w.x); v[c * 8 + 1] = bfhi(w.x); v[c * 8 + 2] = bflo(w.y); v[c * 8 + 3] = bfhi(w.y);
                    v[c * 8 + 4] = bflo(w.z); v[c * 8 + 5] = bfhi(w.z); v[c * 8 + 6] = bflo(w.w); v[c * 8 + 7] = bfhi(w.w); }
#pragma unroll
                for (int i = 0; i < 24; ++i) ss += v[i] * v[i];
#pragma unroll
                for (int o = 32; o >= 1; o >>= 1) ss += __shfl_xor(ss, o);
                const float rstd = rsqrtf(ss * (1.0f / QLORA) + EPSN);
#pragma unroll
                for (int c = 0; c < 3; ++c) { const float* g = P.mla_q_a_norm + (c * 64 + lane) * 8; const f32x4 g0 = *(const f32x4*)g, g1 = *(const f32x4*)(g + 4); u32x4 w;
                    w.x = pk2(v[c * 8 + 0] * rstd * g0[0], v[c * 8 + 1] * rstd * g0[1]); w.y = pk2(v[c * 8 + 2] * rstd * g0[2], v[c * 8 + 3] * rstd * g0[3]);
                    w.z = pk2(v[c * 8 + 4] * rstd * g1[0], v[c * 8 + 5] * rstd * g1[1]); w.w = pk2(v[c * 8 + 6] * rstd * g1[2], v[c * 8 + 7] * rstd * g1[3]);
                    *(u32x4*)(CQN + (size_t)tok * QLORA + (c * 64 + lane) * 8) = w;
                    if (USE_FP8Q) { const float r16 = rstd * 16.0f; u32x2 b;
                        b.x = pk4_fp8(v[c * 8 + 0] * r16 * g0[0], v[c * 8 + 1] * r16 * g0[1], v[c * 8 + 2] * r16 * g0[2], v[c * 8 + 3] * r16 * g0[3]);
                        b.y = pk4_fp8(v[c * 8 + 4] * r16 * g1[0], v[c * 8 + 5] * r16 * g1[1], v[c * 8 + 6] * r16 * g1[2], v[c * 8 + 7] * r16 * g1[3]);
                        *(u32x2*)((unsigned char*)(P.ws + OFF_CQN8) + (size_t)tok * QLORA + (c * 64 + lane) * 8) = b; } }
            }
            {
                float v[8]; float ss = 0.f; const u32x4 w0 = wk[t];
                v[0] = bflo(w0.x); v[1] = bfhi(w0.x); v[2] = bflo(w0.y); v[3] = bfhi(w0.y); v[4] = bflo(w0.z); v[5] = bfhi(w0.z); v[6] = bflo(w0.w); v[7] = bfhi(w0.w);
#pragma unroll
                for (int i = 0; i < 8; ++i) ss += v[i] * v[i];
#pragma unroll
                for (int o = 32; o >= 1; o >>= 1) ss += __shfl_xor(ss, o);
                const float rstd = rsqrtf(ss * (1.0f / KVLORA) + EPSN);
                const float* g = P.mla_kv_a_norm + lane * 8; const f32x4 g0 = *(const f32x4*)g, g1 = *(const f32x4*)(g + 4); u32x4 w;
                w.x = pk2(v[0] * rstd * g0[0], v[1] * rstd * g0[1]); w.y = pk2(v[2] * rstd * g0[2], v[3] * rstd * g0[3]);
                w.z = pk2(v[4] * rstd * g1[0], v[5] * rstd * g1[1]); w.w = pk2(v[6] * rstd * g1[2], v[7] * rstd * g1[3]);
                *(u32x4*)(CKVN + (size_t)tok * KVLORA + lane * 8) = w;
                if (USE_FP8KV) { const float r16 = rstd * 16.0f; u32x2 b8;
                    b8.x = pk4_fp8(v[0] * r16 * g0[0], v[1] * r16 * g0[1], v[2] * r16 * g0[2], v[3] * r16 * g0[3]); b8.y = pk4_fp8(v[4] * r16 * g1[0], v[5] * r16 * g1[1], v[6] * r16 * g1[2], v[7] * r16 * g1[3]);
                    *(u32x2*)((unsigned char*)(P.ws + OFF_CKVN8) + (size_t)tok * KVLORA + lane * 8) = b8; }
            }
            {
                const int i = lane & 31;
                const float invf = exp2f(-(float)i * (13.287712379549449f / 32.0f));
                const float ang = (float)pos[t] * invf;
                const double rev = (double)ang * 0.15915494309189533576888;
                const float fr = (float)(rev - __builtin_rint(rev));
                const float sn = __builtin_amdgcn_sinf(fr), cs = __builtin_amdgcn_cosf(fr);
                const float x1 = bf1(kp1[t]), x2 = bf1(kp2[t]);
                float ssp = x1 * x1 + x2 * x2;
#pragma unroll
                for (int o = 16; o >= 1; o >>= 1) ssp += __shfl_xor(ssp, o);
                const float a = x1 * P.mla_k_norm[128 + i], c = x2 * P.mla_k_norm[160 + i];
                if (lane < 32) { ROPE[(size_t)tok * 64 + i] = cs; ROPE[(size_t)tok * 64 + 32 + i] = sn;
                    KPER[(size_t)tok * 64 + i] = a * cs - c * sn; KPER[(size_t)tok * 64 + 32 + i] = c * cs + a * sn;
                    if (lane == 0) SSPE[tok] = ssp; }
            }
        }
    }
}

DI void phase_mla_prep2(const Params& P, int bid, int nb) {
    const bf16_t* KNM = (const bf16_t*)(P.ws + OFF_KNM); const bf16_t* Y1 = (const bf16_t*)(P.ws + OFF_Y1);
    bf16_t* KM = (bf16_t*)(P.ws + OFF_KM); const float* ROPE = (const float*)(P.ws + OFF_ROPE);
    const int tid = tid_opaque(), grp = tid >> 3, j8 = tid & 7;
    for (int tok = bid; tok < MTOK; tok += nb) {
        const int b = tok / SEQ, s = tok % SEQ;
        float cs[8], sn[8];
#pragma unroll
        for (int e = 0; e < 8; ++e) { const int i = (8 * j8 + e) & 31; cs[e] = ROPE[(size_t)tok * 64 + i]; sn[e] = ROPE[(size_t)tok * 64 + 32 + i]; }
        {
            const bf16_t* kn = KNM + (size_t)tok * (NH * 128) + grp * 128;
            const bf16_t* kp = Y1 + (size_t)tok * N3P + C3_KPE;
            float v[24];
#pragma unroll
            for (int c = 0; c < 2; ++c) { const u32x4 w = *(const u32x4*)(kn + (j8 + 8 * c) * 8);
                v[c * 8 + 0] = bflo(w.x); v[c * 8 + 1] = bfhi(w.x); v[c * 8 + 2] = bflo(w.y); v[c * 8 + 3] = bfhi(w.y);
                v[c * 8 + 4] = bflo(w.z); v[c * 8 + 5] = bfhi(w.z); v[c * 8 + 6] = bflo(w.w); v[c * 8 + 7] = bfhi(w.w); }
            { const u32x4 w = *(const u32x4*)(kp + j8 * 8);
                v[16] = bflo(w.x); v[17] = bfhi(w.x); v[18] = bflo(w.y); v[19] = bfhi(w.y); v[20] = bflo(w.z); v[21] = bfhi(w.z); v[22] = bflo(w.w); v[23] = bfhi(w.w); }
            float ss = 0.f;
#pragma unroll
            for (int i = 0; i < 24; ++i) ss += v[i] * v[i];
            ss = sum8(ss);
            const float rstd = rsqrtf(ss * (1.0f / DK) + EPSN);
#pragma unroll
            for (int c = 0; c < 3; ++c)
#pragma unroll
                for (int e = 0; e < 8; ++e) v[c * 8 + e] *= rstd * P.mla_k_norm[(j8 + 8 * c) * 8 + e];
#pragma unroll
            for (int e = 0; e < 8; ++e) { const float mine = v[16 + e], other = __shfl_xor(mine, 4);
                v[16 + e] = (j8 < 4) ? (mine * cs[e] - other * sn[e]) : (mine * cs[e] + other * sn[e]); }
            st192(KM + ((size_t)(b * NH + grp) * SEQ + s) * DK, j8, v);
        }
    }
}
#ifndef ATT_THR
#define ATT_THR 30.0f
#endif
#ifndef ATT3_HOIST
#define ATT3_HOIST 1
#endif
#ifndef PROBE3_STORE2
#define PROBE3_STORE2 1
#endif
#ifndef PROBE3_UNITS
#define PROBE3_UNITS 1
#endif
#ifndef PROBE3_CMP
#define PROBE3_CMP 1
#endif
#ifndef PROBE3_SEL
#define PROBE3_SEL 1
#endif
#ifndef PROBE3_WIN
#define PROBE3_WIN 1
#endif
#ifndef ATT3_KD
#define ATT3_KD 4
#endif
#ifndef ATT3_VD
#define ATT3_VD 4
#endif
#ifndef ATT_PS_LIMIT
#define ATT_PS_LIMIT (16.0f * 1073741824.0f)
#endif
constexpr int KT_BYTES = 64 * 384, VT_BYTES = 128 * 128;
constexpr int L_K = 0, L_V = 2 * KT_BYTES, L_LUT = L_V + 2 * VT_BYTES, LUT_PITCH = 129, L_X = L_LUT + 64 * LUT_PITCH * 4 + 16, L_IL = L_X + 16 * 16 * 64 * 2, L_END = L_IL + 16 * 16 * 4;
static_assert(L_END <= 151552, "attention LDS");
enum { MODE_MLA = 0, MODE_SEL = 3, MODE_WIN = 4, MODE_CMPX = 5 };
#define MFMA16(a, b, c) __builtin_amdgcn_mfma_f32_16x16x32_bf16((a), (b), (c), 0, 0, 0)

struct AttnLane3 {
    int tw0, tw1;
    int r16, g;
    const LAS float* lutrow;
    unsigned long long mk0, mk1;
    int curblk;
    int tokbase;
    mutable float carry[2];
};
template <int MODE> DI int tq_of(const AttnLane3& A, int qb) { return (MODE == MODE_MLA) ? A.tw0 + 16 * qb + A.r16 : A.tw0 + qb; }

template <int MODE, int QS>
DI void attn_tile3(const LAS unsigned char* kb, const LAS unsigned char* vb, LAS unsigned char* lds, int j, const bf16x8 (&q)[2][6], f32x4 (&o)[8][2], float (&m_run)[2], float (&l_run)[2], const AttnLane3& A) {
    constexpr bool Q0 = (QS & 1) != 0, Q1 = (QS & 2) != 0;
    const int r16 = A.r16, g = A.g, sw = (r16 >> 1) & 7;
    const int kb0 = r16 * 384 + ((g ^ sw) << 4), kb1 = r16 * 384 + (((g ^ sw) ^ 4) << 4);
    const int vb0 = r16 * 128 + ((g ^ sw) << 4), vb1 = r16 * 128 + (((g ^ sw) ^ 4) << 4);
    f32x4 s[4][2];
    bool zinit = true;
    if (MODE == MODE_WIN || MODE == MODE_SEL) zinit = (A.tw0 - (64 * j + 63) >= 113);
    else if (MODE == MODE_CMPX) zinit = (A.tw0 - 31 - 16 * (64 * j + 63) >= 113);
    if (zinit) {
#pragma unroll
        for (int k4 = 0; k4 < 4; ++k4) { s[k4][0] = (f32x4){0.f, 0.f, 0.f, 0.f}; s[k4][1] = (f32x4){0.f, 0.f, 0.f, 0.f}; }
    } else {
#pragma unroll
        for (int qb = 0; qb < 2; ++qb) { if ((qb == 0 && !Q0) || (qb == 1 && !Q1)) continue;
            const int tq = tq_of<MODE>(A, qb);
#pragma unroll
            for (int k4 = 0; k4 < 4; ++k4)
#pragma unroll
                for (int r = 0; r < 4; ++r) { int d;
                    if (MODE == MODE_CMPX) d = tq - 31 - 16 * (64 * j + 16 * k4 + 4 * g + r); else d = tq - (64 * j + 16 * k4 + 4 * g + r);
                    d = d < 0 ? 0 : (d > 127 ? 127 : d); s[k4][qb][r] = A.lutrow[d] - m_run[qb]; } }
    }
    {
        constexpr int KD = ATT3_KD;
        bf16x8 kf[KD + 1];
#pragma unroll
        for (int i = 0; i < KD; ++i) kf[i] = *(const LAS bf16x8*)(kb + (((i % 6) & 1) ? kb1 : kb0) + ((i % 6) >> 1) * 128 + (i / 6) * (16 * 384));
        __builtin_amdgcn_sched_barrier(0);
#pragma unroll
        for (int i = 0; i < 24; ++i) {
            if (i + KD < 24) { const int n_ = i + KD; kf[n_ % (KD + 1)] = *(const LAS bf16x8*)(kb + (((n_ % 6) & 1) ? kb1 : kb0) + ((n_ % 6) >> 1) * 128 + (n_ / 6) * (16 * 384)); }
            __builtin_amdgcn_sched_barrier(0);
            if (Q0) s[i / 6][0] = MFMA16(kf[i % (KD + 1)], q[0][i % 6], s[i / 6][0]);
            if (Q1) s[i / 6][1] = MFMA16(kf[i % (KD + 1)], q[1][i % 6], s[i / 6][1]);
            __builtin_amdgcn_sched_barrier(0);
        }
    }
    if (zinit && __any(m_run[0] != 0.f || m_run[1] != 0.f)) {
#pragma unroll
        for (int k4 = 0; k4 < 4; ++k4)
#pragma unroll
            for (int r = 0; r < 4; ++r) { s[k4][0][r] -= m_run[0]; s[k4][1][r] -= m_run[1]; }
    }
    {
        const float NEG = -__builtin_inff();
        bool need;
        if (MODE == MODE_MLA) need = (64 * j + 63 > A.tw0);
        else if (MODE == MODE_WIN) need = !(64 * j + 63 <= A.tw0 && 64 * j >= A.tw1 - 511);
        else if (MODE == MODE_SEL) need = (j == A.curblk);
        else need = (A.tw0 - 31 - 16 * (64 * j + 63) < 0);
        if (need) {
#pragma unroll
            for (int qb = 0; qb < 2; ++qb) { if ((qb == 0 && !Q0) || (qb == 1 && !Q1)) continue;
                const int tq = tq_of<MODE>(A, qb);
#pragma unroll
                for (int k4 = 0; k4 < 4; ++k4)
#pragma unroll
                    for (int r = 0; r < 4; ++r) { const int c = 64 * j + 16 * k4 + 4 * g + r; bool kill;
                        if (MODE == MODE_WIN) kill = (unsigned)(tq - c) >= 512u;
                        else if (MODE == MODE_CMPX) kill = (tq - 31 - 16 * c) < 0;
                        else kill = (tq - c) < 0;
                        s[k4][qb][r] = kill ? NEG : s[k4][qb][r]; } }
        }
    }
    u32x4 pw[2][2];
#pragma unroll
    for (int qb = 0; qb < 2; ++qb) { if ((qb == 0 && !Q0) || (qb == 1 && !Q1)) continue;
        if (MODE == MODE_CMPX) {
            float lmx = fmaxf(fmaxf(s[0][qb][0], s[0][qb][1]), fmaxf(s[0][qb][2], s[0][qb][3]));
#pragma unroll
            for (int k4 = 1; k4 < 4; ++k4) lmx = fmaxf(lmx, fmaxf(fmaxf(s[k4][qb][0], s[k4][qb][1]), fmaxf(s[k4][qb][2], s[k4][qb][3])));
            if (__any(lmx > ATT_THR)) {
                float mx = fmaxf(lmx, __shfl_xor(lmx, 16)); mx = fmaxf(mx, __shfl_xor(mx, 32));
                const float dl = fmaxf(mx, 0.f), alpha = __builtin_amdgcn_exp2f(-dl);
                m_run[qb] += dl; l_run[qb] *= alpha; A.carry[qb] *= alpha;
#pragma unroll
                for (int db = 0; db < 8; ++db) o[db][qb] *= alpha;
#pragma unroll
                for (int k4 = 0; k4 < 4; ++k4) s[k4][qb] -= dl;
                LAS bf16_t* X = (LAS bf16_t*)(lds + L_X) + ((A.tokbase + qb) * 16 + r16) * 64;
                for (int a = g; a < 16 * j; a += 4) X[a] = (bf16_t)(pk2(bf1(X[a]) * alpha, 0.f) & 0xffffu);
            }
        }
        float ps = 0.f; f32x4 e[4];
#pragma unroll
        for (int k4 = 0; k4 < 4; ++k4) { e[k4][0] = __builtin_amdgcn_exp2f(s[k4][qb][0]); e[k4][1] = __builtin_amdgcn_exp2f(s[k4][qb][1]); e[k4][2] = __builtin_amdgcn_exp2f(s[k4][qb][2]); e[k4][3] = __builtin_amdgcn_exp2f(s[k4][qb][3]);
            ps += (e[k4][0] + e[k4][1]) + (e[k4][2] + e[k4][3]); }
        if (MODE != MODE_CMPX) {
            if (__any(!(ps <= ATT_PS_LIMIT))) {
                float mx = fmaxf(fmaxf(s[0][qb][0], s[0][qb][1]), fmaxf(s[0][qb][2], s[0][qb][3]));
#pragma unroll
                for (int k4 = 1; k4 < 4; ++k4) mx = fmaxf(mx, fmaxf(fmaxf(s[k4][qb][0], s[k4][qb][1]), fmaxf(s[k4][qb][2], s[k4][qb][3])));
                mx = fmaxf(mx, __shfl_xor(mx, 16)); mx = fmaxf(mx, __shfl_xor(mx, 32));
                const float dl = fmaxf(mx, 0.f), alpha = __builtin_amdgcn_exp2f(-dl);
                m_run[qb] += dl; l_run[qb] *= alpha;
#pragma unroll
                for (int db = 0; db < 8; ++db) o[db][qb] *= alpha;
                ps = 0.f;
#pragma unroll
                for (int k4 = 0; k4 < 4; ++k4) { e[k4][0] = __builtin_amdgcn_exp2f(s[k4][qb][0] - dl); e[k4][1] = __builtin_amdgcn_exp2f(s[k4][qb][1] - dl); e[k4][2] = __builtin_amdgcn_exp2f(s[k4][qb][2] - dl); e[k4][3] = __builtin_amdgcn_exp2f(s[k4][qb][3] - dl);
                    ps += (e[k4][0] + e[k4][1]) + (e[k4][2] + e[k4][3]); }
            }
        } else {
            LAS bf16_t* X = (LAS bf16_t*)(lds + L_X) + ((A.tokbase + qb) * 16 + r16) * 64;
#pragma unroll
            for (int k4 = 0; k4 < 4; ++k4) {
                const float y = __shfl(e[k4][3], (r16 + 16 * g + 48) & 63);
                const float prev = g ? y : A.carry[qb];
                if (g == 0) A.carry[qb] = y;
                X[16 * j + 4 * k4 + g] = (bf16_t)(pk2((e[k4][0] + e[k4][1]) + (e[k4][2] + e[k4][3]) + prev, 0.f) & 0xffffu);
            }
        }
        l_run[qb] += ps;
        pw[0][qb].x = pk2(e[0][0], e[0][1]); pw[0][qb].y = pk2(e[0][2], e[0][3]); pw[0][qb].z = pk2(e[1][0], e[1][1]); pw[0][qb].w = pk2(e[1][2], e[1][3]);
        pw[1][qb].x = pk2(e[2][0], e[2][1]); pw[1][qb].y = pk2(e[2][2], e[2][3]); pw[1][qb].z = pk2(e[3][0], e[3][1]); pw[1][qb].w = pk2(e[3][2], e[3][3]);
    }
    {
        constexpr int VD = ATT3_VD;
        bf16x8 vf[VD + 1];
#pragma unroll
        for (int i = 0; i < VD; ++i) vf[i] = *(const LAS bf16x8*)(vb + ((i >> 3) ? vb1 : vb0) + (i & 7) * (16 * 128));
        __builtin_amdgcn_sched_barrier(0);
#pragma unroll
        for (int i = 0; i < 16; ++i) {
            if (i + VD < 16) { const int n_ = i + VD; vf[n_ % (VD + 1)] = *(const LAS bf16x8*)(vb + ((n_ >> 3) ? vb1 : vb0) + (n_ & 7) * (16 * 128)); }
            __builtin_amdgcn_sched_barrier(0);
            if (Q0) o[i & 7][0] = MFMA16(vf[i % (VD + 1)], __builtin_bit_cast(bf16x8, pw[i >> 3][0]), o[i & 7][0]);
            if (Q1) o[i & 7][1] = MFMA16(vf[i % (VD + 1)], __builtin_bit_cast(bf16x8, pw[i >> 3][1]), o[i & 7][1]);
            __builtin_amdgcn_sched_barrier(0);
        }
    }
}

DI void attn_issue_first(LAS unsigned char* lds, const char* __restrict__ Kc, const char* __restrict__ Vc, int vt_stride, int j) {
    int tid = threadIdx.x; asm volatile("" : "+v"(tid));
    const int lane = tid & 63;
    const int wid_ = __builtin_amdgcn_readfirstlane(tid >> 6);
    const char* kp_ = Kc + (size_t)j * KT_BYTES; LAS unsigned char* kb_ = lds + L_K + wid_ * 3072;
#pragma unroll
    for (int i_ = 0; i_ < 3; ++i_) { const int pidx_ = (wid_ * 3 + i_) * 64 + lane, row_ = pidx_ / 24, cp_ = pidx_ % 24;
        __builtin_amdgcn_global_load_lds((const unsigned*)(kp_ + (unsigned)(row_ * 384 + ((cp_ ^ ((row_ >> 1) & 7)) << 4))), (LAS unsigned*)(kb_ + i_ * 1024), 16, 0, 0); }
    const char* vp_ = Vc + (size_t)j * 128; LAS unsigned char* vb_ = lds + L_V + wid_ * 2048;
#pragma unroll
    for (int i_ = 0; i_ < 2; ++i_) { const int pidx_ = (wid_ * 2 + i_) * 64 + lane, row_ = pidx_ >> 3, cp_ = pidx_ & 7;
        __builtin_amdgcn_global_load_lds((const unsigned*)(vp_ + (unsigned)(row_ * vt_stride * 2 + ((cp_ ^ ((row_ >> 1) & 7)) << 4))), (LAS unsigned*)(vb_ + i_ * 1024), 16, 0, 0); }
}

template <int MODE>
DI void attn_pass3x(LAS unsigned char* lds, const char* __restrict__ Kc, const char* __restrict__ Vc, int vt_stride, int j_lo, int j_hi,
                    const bf16x8 (&q)[2][6], f32x4 (&o)[8][2], float (&m_run)[2], float (&l_run)[2], const AttnLane3& A, bool first_issued = false) {
    if (j_lo >= j_hi) return;
    int tid = threadIdx.x; asm volatile("" : "+v"(tid));
    const int lane = tid & 63;
    const int wid_ = __builtin_amdgcn_readfirstlane(tid >> 6);
    unsigned kgo[3], vgo[2];
#pragma unroll
    for (int i_ = 0; i_ < 3; ++i_) { const int pidx_ = (wid_ * 3 + i_) * 64 + lane, row_ = pidx_ / 24, cp_ = pidx_ % 24; kgo[i_] = (unsigned)(row_ * 384 + ((cp_ ^ ((row_ >> 1) & 7)) << 4)); }
#pragma unroll
    for (int i_ = 0; i_ < 2; ++i_) { const int pidx_ = (wid_ * 2 + i_) * 64 + lane, row_ = pidx_ >> 3, cp_ = pidx_ & 7; vgo[i_] = (unsigned)(row_ * vt_stride * 2 + ((cp_ ^ ((row_ >> 1) & 7)) << 4)); }
#define ST_ISSUE(j, buf) do { const char* kp_ = Kc + (size_t)(j) * KT_BYTES; LAS unsigned char* kb_ = lds + L_K + (buf) * KT_BYTES + wid_ * 3072; \
        _Pragma("unroll") for (int i_ = 0; i_ < 3; ++i_) __builtin_amdgcn_global_load_lds((const unsigned*)(kp_ + kgo[i_]), (LAS unsigned*)(kb_ + i_ * 1024), 16, 0, 0); \
        const char* vp_ = Vc + (size_t)(j) * 128; LAS unsigned char* vb_ = lds + L_V + (buf) * VT_BYTES + wid_ * 2048; \
        _Pragma("unroll") for (int i_ = 0; i_ < 2; ++i_) __builtin_amdgcn_global_load_lds((const unsigned*)(vp_ + vgo[i_]), (LAS unsigned*)(vb_ + i_ * 1024), 16, 0, 0); } while (0)
    if (!first_issued) ST_ISSUE(j_lo, 0);
    asm volatile("s_waitcnt vmcnt(0)" ::: "memory");
    __syncthreads();
    for (int j = j_lo; j < j_hi; ++j) {
        const int cur = (j - j_lo) & 1;
        if (j + 1 < j_hi) ST_ISSUE(j + 1, cur ^ 1);
        const LAS unsigned char* kbp = lds + L_K + cur * KT_BYTES; const LAS unsigned char* vbp = lds + L_V + cur * VT_BYTES;
        if (MODE == MODE_SEL) {
            const bool a0 = ((A.mk0 >> j) & 1ull) != 0ull, a1 = ((A.mk1 >> j) & 1ull) != 0ull;
            if (a0 && a1) attn_tile3<MODE, 3>(kbp, vbp, lds, j, q, o, m_run, l_run, A);
            else if (a0) attn_tile3<MODE, 1>(kbp, vbp, lds, j, q, o, m_run, l_run, A);
            else if (a1) attn_tile3<MODE, 2>(kbp, vbp, lds, j, q, o, m_run, l_run, A);
        } else {
            bool act;
            if (MODE == MODE_MLA) act = 64 * j <= A.tw1;
            else if (MODE == MODE_CMPX) act = 1024 * j + 31 <= A.tw1;
            else act = (64 * j <= A.tw1) && (64 * j + 63 >= A.tw0 - 511);
            if (act) attn_tile3<MODE, 3>(kbp, vbp, lds, j, q, o, m_run, l_run, A);
        }
        asm volatile("s_waitcnt vmcnt(0)" ::: "memory");
        __syncthreads();
    }
#undef ST_ISSUE
}

DI int t5_bucket(int n) {
    if (n < 16) return n;
    return 16 + (n >= 19) + (n >= 21) + (n >= 24) + (n >= 27) + (n >= 31) + (n >= 35) + (n >= 40) + (n >= 46) + (n >= 52) + (n >= 59) + (n >= 67) + (n >= 77) + (n >= 87) + (n >= 99) + (n >= 113);
}
DI float silu_f(float z) { return z * __builtin_amdgcn_rcpf(1.0f + __builtin_amdgcn_exp2f(-1.4426950408889634f * z)); }

constexpr int EPI_PITCH = 272, EPI_WAVE_BYTES = 32 * EPI_PITCH;
template <bool RMW, bool NSA, int F8 = 0>
DI void attn_epilogue3(LAS unsigned char* lds, int lane, int wid, const f32x4 (&o)[8][2], float scale0, float scale1,
                       const char* __restrict__ zbase, unsigned z0, char* __restrict__ obase, unsigned o0, bool dostore = true, char* __restrict__ o8base = nullptr, float o8s = O8_SCALE, bool both = true) {
    asm volatile("" : "+v"(lane));
    LAS unsigned char* sc = lds + wid * EPI_WAVE_BYTES;
    const int r16 = lane & 15, g = lane >> 4;
#pragma unroll
    for (int h = 0; h < 2; ++h) {
#pragma unroll
        for (int d4 = 0; d4 < 4; ++d4) {
            *(LAS f32x4*)(sc + r16 * EPI_PITCH + (16 * d4 + 4 * g) * 4) = o[4 * h + d4][0] * scale0;
            *(LAS f32x4*)(sc + (16 + r16) * EPI_PITCH + (16 * d4 + 4 * g) * 4) = o[4 * h + d4][1] * scale1;
        }
        asm volatile("" ::: "memory");
#pragma unroll
        for (int i = 0; i < 4; ++i) {
            const int rr = 8 * i + (lane >> 3), c8 = lane & 7;
            const f32x4 a = *(const LAS f32x4*)(sc + rr * EPI_PITCH + c8 * 32);
            const f32x4 b = *(const LAS f32x4*)(sc + rr * EPI_PITCH + c8 * 32 + 16);
            unsigned zoff, ooff;
            if (NSA) { zoff = z0 + (unsigned)((rr >> 4) * (N1P * 2) + (rr & 15) * 256); ooff = o0 + (unsigned)((rr >> 4) * (ZW8 * 2) + (rr & 15) * 256); }
            else     { zoff = z0 + (unsigned)(rr * (N3P * 2)); ooff = o0 + (unsigned)(rr * (ZW8 * 2)); }
            const unsigned cb = (unsigned)((64 * h + 8 * c8) * 2);
            if (!dostore) continue;
            const u32x4 zw = *(const u32x4*)(zbase + (zoff + cb));
            float v0 = a[0] * silu_f(bflo(zw.x)), v1 = a[1] * silu_f(bfhi(zw.x)), v2 = a[2] * silu_f(bflo(zw.y)), v3 = a[3] * silu_f(bfhi(zw.y));
            float v4 = b[0] * silu_f(bflo(zw.z)), v5 = b[1] * silu_f(bfhi(zw.z)), v6 = b[2] * silu_f(bflo(zw.w)), v7 = b[3] * silu_f(bfhi(zw.w));
            if (RMW) { const u32x4 pv = *(const u32x4*)(obase + (ooff + cb));
                v0 += bflo(pv.x); v1 += bfhi(pv.x); v2 += bflo(pv.y); v3 += bfhi(pv.y); v4 += bflo(pv.z); v5 += bfhi(pv.z); v6 += bflo(pv.w); v7 += bfhi(pv.w); }
            if (F8) { u32x2 w8; w8.x = pk4_fp8c(v0 * o8s, v1 * o8s, v2 * o8s, v3 * o8s); w8.y = pk4_fp8c(v4 * o8s, v5 * o8s, v6 * o8s, v7 * o8s);
                *(u32x2*)(o8base + ((ooff + cb) >> 1)) = w8; if (F8 == 1) continue; }
            u32x4 w; w.x = pk2(v0, v1); w.y = pk2(v2, v3); w.z = pk2(v4, v5); w.w = pk2(v6, v7);
            if (F8 != 2 || both) *(u32x4*)(obase + (ooff + cb)) = w;
        }
        asm volatile("" ::: "memory");
    }
}
DI float sum_g(float v) { v += __shfl_xor(v, 16); v += __shfl_xor(v, 32); return v; }

DI void phase_nsa_attn(LAS unsigned char* lds, const Params& P, int bid, int nb) {
    const char* Y0c = (const char*)(P.ws + OFF_Y0);
    const char* KSc = (const char*)(P.ws + OFF_KS); const char* KWc = (const char*)(P.ws + OFF_KW);
    const char* VTSc = (const char*)(P.ws + OFF_VTS); const char* VTWc = (const char*)(P.ws + OFF_VTW);
    const char* KCc = (const char*)(P.ws + OFF_KC); const char* VTCc = (const char*)(P.ws + OFF_VTC);
    char* ONc = (char*)(P.ws + OFF_O);
    LAS float* lut = (LAS float*)(lds + L_LUT);
    const int total = BATCH * NG * 256;
    {
        const int tid0 = tid_opaque();
        __syncthreads();
        for (int i = tid0; i < 64 * 128; i += 512) { const int hd = i >> 7, d = i & 127; lut[hd * LUT_PITCH + d] = (P.rel_bias[t5_bucket(d) * NH + hd] - P.rel_bias[31 * NH + hd]) * LOG2E; }
        __syncthreads();
    }
    for (int u_ = bid; u_ < total * PROBE3_UNITS; u_ += nb) {
        const int u = (u_ >= total) ? u_ - total : u_;
        int tid = threadIdx.x; asm volatile("" : "+v"(tid));
        const int lane = tid & 63, wid = __builtin_amdgcn_readfirstlane(tid >> 6);
        const int pair = u >> 8; int c = u & 255; if (pair & 1) c = 255 - c;
        const int b = pair >> 2, gg = pair & 3, t0 = c * 16;
        __syncthreads();
        AttnLane3 A;
        A.r16 = lane & 15; A.g = lane >> 4;
        A.tw0 = t0 + 2 * wid; A.tw1 = A.tw0 + 1;
        const int hh = gg * NR + A.r16;
        A.lutrow = lut + hh * LUT_PITCH;
        A.curblk = t0 >> 6; A.tokbase = 2 * wid; A.mk0 = 0ull; A.mk1 = 0ull; A.carry[0] = 0.f; A.carry[1] = 0.f;
        const unsigned ytok0 = (unsigned)(b * SEQ + A.tw0) * (unsigned)(N1P * 2);
        const unsigned otok0 = ((unsigned)(b * SEQ + A.tw0) * (unsigned)ZW8 + (unsigned)(gg * NR * DV)) * 2u;
        const int bg = b * NG + gg;
        const int nct = (t0 + 15 >= 31) ? (((t0 + 15 - 31) >> 4) / 64 + 1) : 0;
        if (ATT3_HOIST && nct > 0) attn_issue_first(lds, KCc + (size_t)bg * 256 * DK * 2, VTCc + (size_t)bg * DV * 256 * 2, 256, 0);
        bf16x8 q[2][6];
#pragma unroll
        for (int qb = 0; qb < 2; ++qb) {
            const unsigned qo = ytok0 + (unsigned)(qb * (N1P * 2)) + (unsigned)((C_Q + hh * DK + 8 * A.g) * 2);
            float ss = 0.f;
#pragma unroll
            for (int ds = 0; ds < 6; ++ds) { q[qb][ds] = *(const bf16x8*)(Y0c + (qo + 64u * ds));
                const u32x4 w = __builtin_bit_cast(u32x4, q[qb][ds]);
                const float a0 = bflo(w.x), a1 = bfhi(w.x), a2 = bflo(w.y), a3 = bfhi(w.y), a4 = bflo(w.z), a5 = bfhi(w.z), a6 = bflo(w.w), a7 = bfhi(w.w);
                ss += (a0 * a0 + a1 * a1) + (a2 * a2 + a3 * a3) + (a4 * a4 + a5 * a5) + (a6 * a6 + a7 * a7); }
            ss = sum_g(ss);
            const float rstd = rsqrtf(ss * (1.0f / DK) + EPSN) * QSCALE;
#pragma unroll
            for (int ds = 0; ds < 6; ++ds) { const float* gn = P.nsa_q_norm + 32 * ds + 8 * A.g; const f32x4 g0 = *(const f32x4*)gn, g1 = *(const f32x4*)(gn + 4);
                u32x4 w = __builtin_bit_cast(u32x4, q[qb][ds]);
                w.x = pk2(bflo(w.x) * rstd * g0[0], bfhi(w.x) * rstd * g0[1]); w.y = pk2(bflo(w.y) * rstd * g0[2], bfhi(w.y) * rstd * g0[3]);
                w.z = pk2(bflo(w.z) * rstd * g1[0], bfhi(w.z) * rstd * g1[1]); w.w = pk2(bflo(w.w) * rstd * g1[2], bfhi(w.w) * rstd * g1[3]);
                q[qb][ds] = __builtin_bit_cast(bf16x8, w); }
        }
        f32x4 o[8][2]; float m_run[2], l_run[2];
#define RESET_STATE() do { _Pragma("unroll") for (int d_ = 0; d_ < 8; ++d_) { o[d_][0] = (f32x4){0.f, 0.f, 0.f, 0.f}; o[d_][1] = (f32x4){0.f, 0.f, 0.f, 0.f}; } m_run[0] = 0.f; m_run[1] = 0.f; l_run[0] = 0.f; l_run[1] = 0.f; } while (0)
#define GATE_SIG(x, qb) (1.0f / (1.0f + __expf(-bf1(*(const bf16_t*)(Y0c + (ytok0 + (unsigned)((qb) * (N1P * 2)) + (unsigned)((C_G + (x) * NH + hh) * 2)))))))
        RESET_STATE();
        attn_pass3x<MODE_CMPX>(lds, KCc + (size_t)bg * 256 * DK * 2, VTCc + (size_t)bg * DV * 256 * 2, 256, 0, nct, q, o, m_run, l_run, A, ATT3_HOIST != 0);
        { const float lt0 = sum_g(l_run[0]), lt1 = sum_g(l_run[1]); const float il0 = lt0 > 0.f ? 1.0f / lt0 : 0.f, il1 = lt1 > 0.f ? 1.0f / lt1 : 0.f;
          if (lane < 16) { ((LAS float*)(lds + L_IL))[(A.tokbase + 0) * 16 + A.r16] = il0; ((LAS float*)(lds + L_IL))[(A.tokbase + 1) * 16 + A.r16] = il1; }
          attn_epilogue3<false, true>(lds, lane, wid, o, GATE_SIG(0, 0) * il0, GATE_SIG(0, 1) * il1, Y0c, ytok0 + (unsigned)((C_ZC + gg * NR * DV) * 2), ONc, otok0, PROBE3_STORE2 || u_ < total); }
        __syncthreads();
        if (ATT3_HOIST) attn_issue_first(lds, KSc + (size_t)bg * SEQ * DK * 2, VTSc + (size_t)bg * DV * SEQ * 2, SEQ, 0);
        {
            const int cur = A.curblk;
            unsigned long long mk[2];
#pragma unroll
            for (int t = 0; t < 2; ++t) {
                const LAS bf16_t* X = (const LAS bf16_t*)(lds + L_X) + (2 * wid + t) * 16 * 64;
                const LAS float* IL = (const LAS float*)(lds + L_IL) + (2 * wid + t) * 16;
                const bool forced = (lane == 0) || (lane == cur) || (lane == cur - 1);
                const bool future = lane > cur;
                float v = 0.f;
                if (!forced && !future) {
#pragma unroll
                    for (int rr = 0; rr < 16; ++rr) v += IL[rr] * bf1(X[rr * 64 + lane]); }
                unsigned key = (__float_as_uint(v) & ~63u);
                if (forced) key = 0x7f800000u; else if (future) key = 0u;
                key |= (unsigned)(63 - lane);
                int rank = 0;
#pragma unroll
                for (int jp = 0; jp < 64; ++jp) { const unsigned kj = (unsigned)__builtin_amdgcn_readlane((int)key, jp); rank += (kj > key) ? 1 : 0; }
                mk[t] = __ballot(rank < 16 && !future);
            }
            A.mk0 = mk[0]; A.mk1 = mk[1];
        }
        RESET_STATE();
        attn_pass3x<MODE_SEL>(lds, KSc + (size_t)bg * SEQ * DK * 2, VTSc + (size_t)bg * DV * SEQ * 2, SEQ, 0, A.curblk + 1, q, o, m_run, l_run, A, ATT3_HOIST != 0);
        { const float lt0 = sum_g(l_run[0]), lt1 = sum_g(l_run[1]);
          attn_epilogue3<true, true>(lds, lane, wid, o, GATE_SIG(1, 0) / lt0, GATE_SIG(1, 1) / lt1, Y0c, ytok0 + (unsigned)((C_ZS + gg * NR * DV) * 2), ONc, otok0, PROBE3_STORE2 || u_ < total); }
        __syncthreads();
        RESET_STATE();
        { const int jl = (t0 - 511) > 0 ? (t0 - 511) >> 6 : 0, jh = ((t0 + 15) >> 6) + 1;
          for (int prb_ = 0; prb_ < PROBE3_WIN; ++prb_) attn_pass3x<MODE_WIN>(lds, KWc + (size_t)bg * SEQ * DK * 2, VTWc + (size_t)bg * DV * SEQ * 2, SEQ, jl, jh, q, o, m_run, l_run, A); }
        { const float lt0 = sum_g(l_run[0]), lt1 = sum_g(l_run[1]);
          attn_epilogue3<true, true, USE_FP8N ? 2 : 0>(lds, lane, wid, o, GATE_SIG(2, 0) / lt0, GATE_SIG(2, 1) / lt1, Y0c, ytok0 + (unsigned)((C_ZW + gg * NR * DV) * 2), ONc, otok0, PROBE3_STORE2 || u_ < total, (char*)(P.ws + OFF_O8N), O8N_SCALE, t0 < 256); }
#undef RESET_STATE
#undef GATE_SIG
    }
}

DI void phase_mla_attn(LAS unsigned char* lds, const Params& P, int bid, int nb) {
    const char* QMc = (const char*)(P.ws + OFF_QM); const char* KMc = (const char*)(P.ws + OFF_KM); const char* VTMc = (const char*)(P.ws + OFF_VTM);
    const char* Y1c = (const char*)(P.ws + OFF_Y1); char* OMc = (char*)(P.ws + OFF_O);
    const int total = BATCH * NH * 16;
    for (int uu = 0; bid + (uu >> 1) * nb < total / 2; ++uu) {
        int tid = threadIdx.x; asm volatile("" : "+v"(tid));
        const int lane = tid & 63, wid = __builtin_amdgcn_readfirstlane(tid >> 6);
        const int item = bid + (uu >> 1) * nb, second = uu & 1;
        const int xcd = item & 7, tt = item >> 3, p = tt & 7, hl = (tt >> 3) & 3, rnd = tt >> 5;
        const int bh = rnd * 32 + xcd * 4 + hl, qblk = second ? p : 15 - p, b = bh >> 6, h = bh & 63, t0 = qblk * 256;
        AttnLane3 A;
        A.r16 = lane & 15; A.g = lane >> 4;
        A.tw0 = t0 + 32 * wid; A.tw1 = A.tw0 + 31;
        A.lutrow = nullptr; A.curblk = 0; A.tokbase = 0; A.mk0 = 0ull; A.mk1 = 0ull; A.carry[0] = 0.f; A.carry[1] = 0.f;
        bf16x8 q[2][6];
#pragma unroll
        for (int qb = 0; qb < 2; ++qb) {
            const unsigned trow = (unsigned)(b * SEQ + A.tw0 + 16 * qb + A.r16);
            const unsigned qo = (trow * (unsigned)NQB + (unsigned)(h * DK + 8 * A.g)) * 2u;
            float ss = 0.f;
#pragma unroll
            for (int ds = 0; ds < 6; ++ds) { q[qb][ds] = *(const bf16x8*)(QMc + (qo + 64u * ds));
                const u32x4 w = __builtin_bit_cast(u32x4, q[qb][ds]);
                const float a0 = bflo(w.x), a1 = bfhi(w.x), a2 = bflo(w.y), a3 = bfhi(w.y), a4 = bflo(w.z), a5 = bfhi(w.z), a6 = bflo(w.w), a7 = bfhi(w.w);
                ss += (a0 * a0 + a1 * a1) + (a2 * a2 + a3 * a3) + (a4 * a4 + a5 * a5) + (a6 * a6 + a7 * a7); }
            ss = sum_g(ss);
            const float rstd = rsqrtf(ss * (1.0f / DK) + EPSN);
            const float* ropep = (const float*)(P.ws + OFF_ROPE) + (size_t)trow * 64;
#pragma unroll
            for (int ds = 0; ds < 4; ++ds) { const float* gn = P.mla_q_norm + 32 * ds + 8 * A.g; const f32x4 g0 = *(const f32x4*)gn, g1 = *(const f32x4*)(gn + 4);
                const float sc = rstd * QSCALE;
                u32x4 w = __builtin_bit_cast(u32x4, q[qb][ds]);
                w.x = pk2(bflo(w.x) * sc * g0[0], bfhi(w.x) * sc * g0[1]); w.y = pk2(bflo(w.y) * sc * g0[2], bfhi(w.y) * sc * g0[3]);
                w.z = pk2(bflo(w.z) * sc * g1[0], bfhi(w.z) * sc * g1[1]); w.w = pk2(bflo(w.w) * sc * g1[2], bfhi(w.w) * sc * g1[3]);
                q[qb][ds] = __builtin_bit_cast(bf16x8, w); }
            {
                const int i0 = 8 * A.g;
                const float* g1p = P.mla_q_norm + 128 + i0; const float* g2p = P.mla_q_norm + 160 + i0;
                const u32x4 w1 = __builtin_bit_cast(u32x4, q[qb][4]), w2 = __builtin_bit_cast(u32x4, q[qb][5]);
                float x1[8] = {bflo(w1.x), bfhi(w1.x), bflo(w1.y), bfhi(w1.y), bflo(w1.z), bfhi(w1.z), bflo(w1.w), bfhi(w1.w)};
                float x2[8] = {bflo(w2.x), bfhi(w2.x), bflo(w2.y), bfhi(w2.y), bflo(w2.z), bfhi(w2.z), bflo(w2.w), bfhi(w2.w)};
                float y1[8], y2[8];
#pragma unroll
                for (int e = 0; e < 8; ++e) { const float cs = ropep[i0 + e], sn = ropep[32 + i0 + e];
                    const float a = x1[e] * rstd * g1p[e], c = x2[e] * rstd * g2p[e];
                    y1[e] = (a * cs - c * sn) * QSCALE; y2[e] = (c * cs + a * sn) * QSCALE; }
                u32x4 o1, o2;
                o1.x = pk2(y1[0], y1[1]); o1.y = pk2(y1[2], y1[3]); o1.z = pk2(y1[4], y1[5]); o1.w = pk2(y1[6], y1[7]);
                o2.x = pk2(y2[0], y2[1]); o2.y = pk2(y2[2], y2[3]); o2.z = pk2(y2[4], y2[5]); o2.w = pk2(y2[6], y2[7]);
                q[qb][4] = __builtin_bit_cast(bf16x8, o1); q[qb][5] = __builtin_bit_cast(bf16x8, o2);
            }
        }
        f32x4 o[8][2]; float m_run[2] = {0.f, 0.f}, l_run[2] = {0.f, 0.f};
#pragma unroll
        for (int d = 0; d < 8; ++d) { o[d][0] = (f32x4){0.f, 0.f, 0.f, 0.f}; o[d][1] = (f32x4){0.f, 0.f, 0.f, 0.f}; }
        attn_pass3x<MODE_MLA>(lds, KMc + (size_t)bh * SEQ * DK * 2, VTMc + (size_t)bh * DV * SEQ * 2, SEQ, 0, 4 * qblk + 4, q, o, m_run, l_run, A);
        const float lt0 = sum_g(l_run[0]), lt1 = sum_g(l_run[1]);
        { const unsigned t0w = (unsigned)(b * SEQ + A.tw0);
          const unsigned zo_ = (t0w * (unsigned)N3P + (unsigned)(C3_Z + h * DV)) * 2u, oo_ = (t0w * (unsigned)ZW8 + (unsigned)(h * DV)) * 2u;
          if (USE_FP8O && qblk != 0) attn_epilogue3<false, false, 1>(lds, lane, wid, o, 1.0f / lt0, 1.0f / lt1, Y1c, zo_, OMc, oo_, true, (char*)(P.ws + OFF_O8M), O8_SCALE);
          else attn_epilogue3<false, false, 0>(lds, lane, wid, o, 1.0f / lt0, 1.0f / lt1, Y1c, zo_, OMc, oo_); }
        __syncthreads();
    }
}
constexpr int LDS_KN_OFF = 135168, LDS_ST_OFF = LDS_KN_OFF + 16384, LDS_BYTES = LDS_ST_OFF + 16;
constexpr int NPHASE = 14;

#ifndef PROBE_G1F8
#define PROBE_G1F8 0
#endif
#ifndef PROBE_G1F8_NOSTORE
#define PROBE_G1F8_NOSTORE 0
#endif
#ifndef TAIL_IN_P6
#define TAIL_IN_P6 USE_FP8N
#endif
#ifndef USE_FP8M
#define USE_FP8M 0
#endif
#ifndef USE_FP8Z
#define USE_FP8Z 0
#endif
#ifndef DUP5
#define DUP5 0
#endif
#ifndef P3_GEMM_REP
#define P3_GEMM_REP 1
#endif
#ifndef P3_WCONV_REP
#define P3_WCONV_REP 1
#endif
DI void tail_wconv(LAS unsigned char* lds, const Params& P, int bid, int nb) {
    unsigned char* ws = P.ws;
    if (bid >= 64 && nb > 64) {
        phase_wconv(lds, P.mla_w_q_b, (bf16_t*)(ws + OFF_W4T), QLORA, NQB, NQB, bid - 64, nb - 64, 0.f, 0, USE_FP8Q ? (unsigned char*)(ws + OFF_W48) : nullptr, 0);
        phase_wconv(lds, P.mla_w_kv_b, (bf16_t*)(ws + OFF_W5K), KVLORA, NKVB / 2, NKVB / 2, bid - 64, nb - 64, 0.f, 2, USE_FP8KV ? (unsigned char*)(ws + OFF_W5K8) : nullptr, 0);
        phase_wconv(lds, P.mla_w_kv_b, (bf16_t*)(ws + OFF_W5V), KVLORA, NKVB / 2, NKVB / 2, bid - 64, nb - 64, 0.f, 1, USE_FP8KV ? (unsigned char*)(ws + OFF_W5V8) : nullptr, 0);
        phase_wconv(lds, P.mla_w_out, (bf16_t*)(ws + OFF_W6T), ZW8, DM, DM, bid - 64, nb - 64, (FP8EMU & 2) ? 64.0f : 0.f, 0, USE_FP8O ? (unsigned char*)(ws + OFF_W68) : nullptr, 0);
    } else if (nb <= 64) {
        phase_wconv(lds, P.mla_w_q_b, (bf16_t*)(ws + OFF_W4T), QLORA, NQB, NQB, bid, nb, 0.f, 0, USE_FP8Q ? (unsigned char*)(ws + OFF_W48) : nullptr, 0);
        phase_wconv(lds, P.mla_w_kv_b, (bf16_t*)(ws + OFF_W5K), KVLORA, NKVB / 2, NKVB / 2, bid, nb, 0.f, 2, USE_FP8KV ? (unsigned char*)(ws + OFF_W5K8) : nullptr, 0);
        phase_wconv(lds, P.mla_w_kv_b, (bf16_t*)(ws + OFF_W5V), KVLORA, NKVB / 2, NKVB / 2, bid, nb, 0.f, 1, USE_FP8KV ? (unsigned char*)(ws + OFF_W5V8) : nullptr, 0);
        phase_wconv(lds, P.mla_w_out, (bf16_t*)(ws + OFF_W6T), ZW8, DM, DM, bid, nb, (FP8EMU & 2) ? 64.0f : 0.f, 0, USE_FP8O ? (unsigned char*)(ws + OFF_W68) : nullptr, 0);
    }
}
template <int PH>
DI void run_phase(const Params& P, LAS unsigned char* lds, int bid, int nb) {
    unsigned char* ws = P.ws;
    if constexpr (PH == 0) {
        phase_wconv(lds, P.nsa_w_in, (bf16_t*)(ws + OFF_W1T), DM, N1, N1P, bid, nb, (FP8EMU & 4) ? 64.0f : 0.f, 0, USE_FP8Z ? (unsigned char*)(ws + OFF_B8) : nullptr, F8_Q0 * 256, (F8_Q0 + F8_NQ) * 256);
        phase_wconv(lds, P.w1_k, (bf16_t*)(ws + OFF_W1K), 6144, 192, 256, bid, nb);
        phase_wconv(lds, P.w1_v, (bf16_t*)(ws + OFF_W1V), 4096, 128, 256, bid, nb);
        phase_rmsnorm(P.x, P.norm_w, (bf16_t*)(ws + OFF_H), bid, nb, (FP8EMU & 4) ? 16.0f : 0.f, USE_FP8Z ? (unsigned char*)(ws + OFF_A8) : nullptr);
    } else if constexpr (PH == 1) {
        if (USE_FP8Z) {
            {
                pg8::Gemm g{(const bf16_t*)(ws + OFF_H), (const bf16_t*)(ws + OFF_W1T), MTOK, N1P, DM};
                pg8::OrderBf16Part S{nb, bid, F8_Q0, F8_NQ, N1P / 256 - F8_NQ};
                pg8::EpiStoreBf16 E{(bf16_t*)(ws + OFF_Y0), N1P};
                pg8::gemm_phase<pg8::EpiStoreBf16, pg8::OrderBf16Part, false>(lds, g, S, E, nullptr, GEMM_STAG);
            }
            __syncthreads();
            {
                pg8::Gemm g{(const bf16_t*)(ws + OFF_A8), (const bf16_t*)(ws + OFF_B8), MTOK, N1P, DM / 2};
                pg8::OrderFp8Part S{nb, bid, F8_Q0, F8_NQ, N1P / 256 - F8_NQ, (256 - ((F8_NQ * 64 + (N1P / 256 - F8_NQ) * 4) & 255)) & 255};
                for (int pr_ = PROBE_G1F8; pr_ >= 0; --pr_) {
                pg8::EpiStoreBf16Fp8 E{(bf16_t*)(ws + OFF_Y0), N1P, 1.0f / (16.0f * 64.0f), (pr_ && PROBE_G1F8_NOSTORE) ? 1 : 0};
                pg8::gemm_phase<pg8::EpiStoreBf16Fp8, pg8::OrderFp8Part, false>(lds, g, S, E, nullptr);
                if (pr_) __syncthreads();
                }
            }
        } else {
        pg8::Gemm g{(const bf16_t*)(ws + OFF_H), (const bf16_t*)(ws + OFF_W1T), MTOK, N1P, DM};
        pg8::StaticOrder S; S.init(g.M, g.N, nb, bid);
        pg8::EpiStoreBf16 E{(bf16_t*)(ws + OFF_Y0), N1P};
        pg8::gemm_phase<pg8::EpiStoreBf16, pg8::StaticOrder, false>(lds, g, S, E, nullptr);
        }
    } else if constexpr (PH == 2) {
        phase_nsa_prep(P, bid, nb);
        phase_vt(lds, (const bf16_t*)(ws + OFF_Y0), N1P, C_KVS + NG * DK, DV, NG, (bf16_t*)(ws + OFF_VTS), bid, nb);
        phase_vt(lds, (const bf16_t*)(ws + OFF_Y0), N1P, C_KVW + NG * DK, DV, NG, (bf16_t*)(ws + OFF_VTW), bid, nb);
    } else if constexpr (PH == 3) {
        for (int p3g_ = 0; p3g_ < ((bid < 32) ? P3_GEMM_REP : P3_WCONV_REP); ++p3g_) { if (p3g_) __syncthreads();
        if (bid < 16) {
            pg8::Gemm g{(const bf16_t*)(ws + OFF_ACK), (const bf16_t*)(ws + OFF_W1K), 4096, 256, 6144};
            pg8::StaticOrder S; S.init(g.M, g.N, 16, bid);
            pg8::EpiPlainF32 E{(float*)(ws + OFF_HIDK), 256};
            pg8::gemm_phase<pg8::EpiPlainF32, pg8::StaticOrder, false>(lds, g, S, E, nullptr);
        } else if (bid < 32) {
            pg8::Gemm g{(const bf16_t*)(ws + OFF_ACV), (const bf16_t*)(ws + OFF_W1V), 4096, 256, 4096};
            pg8::StaticOrder S; S.init(g.M, g.N, 16, bid - 16);
            pg8::EpiPlainF32 E{(float*)(ws + OFF_HIDV), 256};
            pg8::gemm_phase<pg8::EpiPlainF32, pg8::StaticOrder, false>(lds, g, S, E, nullptr);
        } else {
            phase_wconv(lds, P.nsa_w_out, (bf16_t*)(ws + OFF_W2T), ZW8, DM, DM, bid - 32, nb - 32, (FP8EMU & 1) ? 64.0f : 0.f, 0, USE_FP8N ? (unsigned char*)(ws + OFF_W28) : nullptr, 0);
            phase_wconv(lds, P.mla_w_in, (bf16_t*)(ws + OFF_W3T), DM, N3, N3P, bid - 32, nb - 32, (FP8EMU & 8) ? 64.0f : 0.f, 0, USE_FP8M ? (unsigned char*)(ws + OFF_B8M) : nullptr, 0, C3_Z8);
        }
        }
    } else if constexpr (PH == 4) {
        phase_cmp2(lds, P, bid, nb);
    } else if constexpr (PH == 5) {
        { float* ss1 = (float*)(ws + OFF_SS1); for (int i = bid * 512 + (int)threadIdx.x; i < MTOK; i += nb * 512) ss1[i] = 0.f; }
        phase_nsa_attn(lds, P, bid, nb);
    } else if constexpr (PH == 6) {
        if (USE_FP8N) {
            {
                pg8::Gemm g{(const bf16_t*)(ws + OFF_O), (const bf16_t*)(ws + OFF_W2T), MTOK, DM, ZW8};
                pg8::OrderBf16Part S{nb, bid, 0, 0, DM / 256};
                pg8::EpiResNorm E{P.x, P.out, DM, P.norm_w + DM, (bf16_t*)(ws + OFF_H), (float*)(ws + OFF_SS1), USE_FP8M ? (unsigned char*)(ws + OFF_A8M) : nullptr, 1.0f};
                pg8::gemm_phase<pg8::EpiResNorm, pg8::OrderBf16Part, false>(lds, g, S, E, nullptr);
            }
            __syncthreads();
            {
                pg8::Gemm g{(const bf16_t*)(ws + OFF_O8N), (const bf16_t*)(ws + OFF_W28), MTOK, DM, ZW8 / 2};
                pg8::OrderFp8Part S{nb, bid, 0, 0, DM / 256, 192};
                pg8::EpiResNormFp8 E{P.x, P.out, DM, P.norm_w + DM, (bf16_t*)(ws + OFF_H), (float*)(ws + OFF_SS1), USE_FP8M ? (unsigned char*)(ws + OFF_A8M) : nullptr, 1.0f / (O8N_SCALE * 64.0f)};
                pg8::gemm_phase<pg8::EpiResNormFp8, pg8::OrderFp8Part, false>(lds, g, S, E, nullptr);
            }
            __syncthreads();
            if (TAIL_IN_P6) tail_wconv(lds, P, bid, nb);
        } else {
        pg8::Gemm g{(const bf16_t*)(ws + OFF_O), (const bf16_t*)(ws + OFF_W2T), MTOK, DM, ZW8};
        pg8::StaticOrder S; S.init(g.M, g.N, nb, bid);
        pg8::EpiResNorm E{P.x, P.out, DM, P.norm_w + DM, (bf16_t*)(ws + OFF_H), (float*)(ws + OFF_SS1), USE_FP8M ? (unsigned char*)(ws + OFF_A8M) : nullptr, 1.0f};
        pg8::gemm_phase<pg8::EpiResNorm, pg8::StaticOrder, false>(lds, g, S, E, nullptr);
        }
    } else if constexpr (PH == 7) {
        phase_rmsnorm(P.out, P.norm_w + DM, (bf16_t*)(ws + OFF_H), bid, nb, (FP8EMU & 8) ? 16.0f : 0.f);
    } else if constexpr (PH == 8) {
        if (USE_FP8M) {
            {
                pg8::Gemm g{(const bf16_t*)(ws + OFF_H), (const bf16_t*)(ws + OFF_W3T), MTOK, N3P, DM};
                pg8::OrderBf16Part S{nb, bid, 0, C3_Z8 / 256, NZ8M / 256};
                pg8::EpiStoreBf16RowScale E{(bf16_t*)(ws + OFF_Y1), N3P, (const float*)(ws + OFF_SS1), 1.0f / DM};
                pg8::gemm_phase<pg8::EpiStoreBf16RowScale, pg8::OrderBf16Part, false>(lds, g, S, E, nullptr);
            }
            __syncthreads();
            {
                pg8::Gemm g{(const bf16_t*)(ws + OFF_A8M), (const bf16_t*)(ws + OFF_B8M), MTOK, N3P, DM / 2};
                pg8::OrderFp8PartP8 S{nb, bid};
                pg8::EpiStoreBf16RowScaleFp8 E{(bf16_t*)(ws + OFF_Y1), N3P, (const float*)(ws + OFF_SS1), 1.0f / DM, 1.0f / (16.0f * 64.0f)};
                pg8::gemm_phase<pg8::EpiStoreBf16RowScaleFp8, pg8::OrderFp8PartP8, false>(lds, g, S, E, nullptr);
            }
        } else {
        pg8::Gemm g{(const bf16_t*)(ws + OFF_H), (const bf16_t*)(ws + OFF_W3T), MTOK, N3P, DM};
        pg8::StaticOrder S; S.init(g.M, g.N, nb, bid);
        pg8::EpiStoreBf16RowScale E{(bf16_t*)(ws + OFF_Y1), N3P, (const float*)(ws + OFF_SS1), 1.0f / DM};
        pg8::gemm_phase<pg8::EpiStoreBf16RowScale, pg8::StaticOrder, false>(lds, g, S, E, nullptr);
        }
        __syncthreads();
        if (!TAIL_IN_P6) tail_wconv(lds, P, bid, nb);
    } else if constexpr (PH == 9) {
        phase_mla_prep1(P, bid, nb);
    } else if constexpr (PH == 10) {
        if (USE_FP8Q) {
            {
                pg8::Gemm g{(const bf16_t*)(ws + OFF_CQN), (const bf16_t*)(ws + OFF_W4T), MTOK, NQB, QLORA};
                pg8::OrderBf16Part S{nb, bid, 0, 0, NQB / 256};
                pg8::EpiStoreBf16 E{(bf16_t*)(ws + OFF_QM), NQB};
                pg8::gemm_phase<pg8::EpiStoreBf16, pg8::OrderBf16Part, false>(lds, g, S, E, nullptr);
            }
            __syncthreads();
            {
                pg8::Gemm g{(const bf16_t*)(ws + OFF_CQN8), (const bf16_t*)(ws + OFF_W48), MTOK, NQB, QLORA / 2};
                pg8::OrderFp8Part S{nb, bid, 0, 0, NQB / 256, 64};
                pg8::EpiStoreBf16Fp8 E{(bf16_t*)(ws + OFF_QM), NQB, 1.0f / (16.0f * 64.0f)};
                pg8::gemm_phase<pg8::EpiStoreBf16Fp8, pg8::OrderFp8Part, false>(lds, g, S, E, nullptr);
            }
        } else {
            pg8::Gemm g{(const bf16_t*)(ws + OFF_CQN), (const bf16_t*)(ws + OFF_W4T), MTOK, NQB, QLORA};
            pg8::StaticOrder S; S.init(g.M, g.N, nb, bid);
            pg8::EpiStoreBf16 E{(bf16_t*)(ws + OFF_QM), NQB};
            pg8::gemm_phase<pg8::EpiStoreBf16, pg8::StaticOrder, false>(lds, g, S, E, nullptr);
        }
        __syncthreads();
        if (USE_FP8KV) {
            {
                pg8::Gemm g{(const bf16_t*)(ws + OFF_CKVN), (const bf16_t*)(ws + OFF_W5K), MTOK, NKVB / 2, KVLORA};
                pg8::OrderBf16Part S{nb, bid, 0, 0, NKVB / 512};
                pg8::EpiKNorm E{(bf16_t*)(ws + OFF_KM), (const float*)(ws + OFF_SSPE), (const float*)(ws + OFF_KPER), P.mla_k_norm, (LAS float*)(lds + LDS_KN_OFF), 0u, 1.0f};
                pg8::gemm_phase<pg8::EpiKNorm, pg8::OrderBf16Part, false>(lds, g, S, E, nullptr);
            }
            __syncthreads();
            {
                pg8::Gemm g{(const bf16_t*)(ws + OFF_W5V), (const bf16_t*)(ws + OFF_CKVN), NKVB / 2, MTOK, KVLORA};
                pg8::OrderSwap<pg8::OrderBf16Part> S{{nb, (bid + 128) & 255, 0, 0, NKVB / 512}};
                pg8::EpiVT E{(bf16_t*)(ws + OFF_VTM), 1.0f};
                pg8::gemm_phase<pg8::EpiVT, pg8::OrderSwap<pg8::OrderBf16Part>, false>(lds, g, S, E, nullptr);
            }
            __syncthreads();
            {
                pg8::Gemm g{(const bf16_t*)(ws + OFF_CKVN8), (const bf16_t*)(ws + OFF_W5K8), MTOK, NKVB / 2, KVLORA / 2};
                pg8::OrderFp8Part S{nb, bid, 0, 0, NKVB / 512, 0};
                pg8::EpiKNormFp8 E{(bf16_t*)(ws + OFF_KM), (const float*)(ws + OFF_SSPE), (const float*)(ws + OFF_KPER), P.mla_k_norm, (LAS float*)(lds + LDS_KN_OFF), 0u, 1.0f / (16.0f * 64.0f)};
                pg8::gemm_phase<pg8::EpiKNormFp8, pg8::OrderFp8Part, false>(lds, g, S, E, nullptr);
            }
            __syncthreads();
            {
                pg8::Gemm g{(const bf16_t*)(ws + OFF_W5V8), (const bf16_t*)(ws + OFF_CKVN8), NKVB / 2, MTOK, KVLORA / 2};
                pg8::OrderSwap<pg8::OrderFp8Part> S{{nb, bid, 0, 0, NKVB / 512, 128}};
                pg8::EpiVTFp8 E{(bf16_t*)(ws + OFF_VTM), 1.0f / (16.0f * 64.0f)};
                pg8::gemm_phase<pg8::EpiVTFp8, pg8::OrderSwap<pg8::OrderFp8Part>, false>(lds, g, S, E, nullptr);
            }
        } else {
        {
            pg8::Gemm g{(const bf16_t*)(ws + OFF_CKVN), (const bf16_t*)(ws + OFF_W5K), MTOK, NKVB / 2, KVLORA};
            pg8::StaticOrder S; S.init(g.M, g.N, nb, bid);
            pg8::EpiKNorm E{(bf16_t*)(ws + OFF_KM), (const float*)(ws + OFF_SSPE), (const float*)(ws + OFF_KPER), P.mla_k_norm, (LAS float*)(lds + LDS_KN_OFF), 0u, 1.0f};
            pg8::gemm_phase<pg8::EpiKNorm, pg8::StaticOrder, false>(lds, g, S, E, nullptr);
        }
        __syncthreads();
        {
            pg8::Gemm g{(const bf16_t*)(ws + OFF_W5V), (const bf16_t*)(ws + OFF_CKVN), NKVB / 2, MTOK, KVLORA};
            pg8::StaticOrder S; S.init(g.M, g.N, nb, bid);
            pg8::EpiVT E{(bf16_t*)(ws + OFF_VTM), 1.0f};
            pg8::gemm_phase<pg8::EpiVT, pg8::StaticOrder, false>(lds, g, S, E, nullptr);
        }
        }
    } else if constexpr (PH == 11) {
    } else if constexpr (PH == 12) {
        phase_mla_attn(lds, P, bid, nb);
    } else if constexpr (PH == 13) {
        if (USE_FP8O) {
            {
                pg8::Gemm g{(const bf16_t*)(ws + OFF_O), (const bf16_t*)(ws + OFF_W6T), MTOK, DM, ZW8};
                pg8::OrderBf16Part S{nb, bid, 0, 0, DM / 256};
                pg8::EpiResF32 E{P.out, P.out, DM};
                pg8::gemm_phase<pg8::EpiResF32, pg8::OrderBf16Part, false>(lds, g, S, E, nullptr);
            }
            __syncthreads();
            {
                pg8::Gemm g{(const bf16_t*)(ws + OFF_O8M), (const bf16_t*)(ws + OFF_W68), MTOK, DM, ZW8 / 2};
                pg8::OrderFp8Part S{nb, bid, 0, 0, DM / 256, 192};
                pg8::EpiResF32Fp8 E{P.out, P.out, DM, 1.0f / (O8_SCALE * 64.0f)};
                pg8::gemm_phase<pg8::EpiResF32Fp8, pg8::OrderFp8Part, false>(lds, g, S, E, nullptr);
            }
        } else {
        pg8::Gemm g{(const bf16_t*)(ws + OFF_O), (const bf16_t*)(ws + OFF_W6T), MTOK, DM, ZW8};
        pg8::StaticOrder S; S.init(g.M, g.N, nb, bid);
        pg8::EpiResF32 E{P.out, P.out, DM};
        pg8::gemm_phase<pg8::EpiResF32, pg8::StaticOrder, false>(lds, g, S, E, nullptr);
        }
    }
}

#ifndef REP0
#define REP0 1
#endif
#ifndef REP1
#define REP1 1
#endif
#ifndef REP2
#define REP2 1
#endif
#ifndef REP3
#define REP3 1
#endif
#ifndef REP4
#define REP4 1
#endif
#ifndef REP5
#define REP5 1
#endif
#ifndef REP6
#define REP6 1
#endif
#ifndef REP7
#define REP7 1
#endif
#ifndef REP8
#define REP8 1
#endif
#ifndef REP9
#define REP9 1
#endif
#ifndef REP10
#define REP10 1
#endif
#ifndef REP11
#define REP11 1
#endif
#ifndef REP12
#define REP12 1
#endif
#ifndef REP13
#define REP13 1
#endif

__global__ __launch_bounds__(512, 2) void k_mega(Params P) {
    extern __shared__ __attribute__((aligned(16))) unsigned char shm[];
    LAS unsigned char* lds = (LAS unsigned char*)shm;
    volatile LAS unsigned* st = (volatile LAS unsigned*)(lds + LDS_ST_OFF);
    if (threadIdx.x == 0) { st[0] = 0u; st[1] = 0u; st[2] = 0u; st[3] = 0u; }
    __syncthreads();
    XcdBarrier bar = xcd_barrier_post((unsigned*)(P.ws + OFF_CTL), st);
    const int bid = (int)blockIdx.x, nb = (int)gridDim.x;
    for (int rep_ = 0; rep_ < REP0; ++rep_) run_phase<0>(P, lds, bid, nb);  xcd_barrier(bar);
    for (int rep_ = 0; rep_ < REP1; ++rep_) run_phase<1>(P, lds, bid, nb);  xcd_barrier(bar);
    for (int rep_ = 0; rep_ < REP2; ++rep_) run_phase<2>(P, lds, bid, nb);  xcd_barrier(bar);
    for (int rep_ = 0; rep_ < REP3; ++rep_) run_phase<3>(P, lds, bid, nb);  xcd_barrier(bar);
    for (int rep_ = 0; rep_ < REP4; ++rep_) run_phase<4>(P, lds, bid, nb);  xcd_barrier(bar);
    for (int rep_ = 0; rep_ < REP5; ++rep_) run_phase<5>(P, lds, bid, nb);
#if DUP5
    __syncthreads(); run_phase<5>(P, lds, bid, nb);
#endif
    xcd_barrier(bar);
    for (int rep_ = 0; rep_ < REP6; ++rep_) run_phase<6>(P, lds, bid, nb);  xcd_barrier(bar);
    for (int rep_ = 0; rep_ < REP8; ++rep_) run_phase<8>(P, lds, bid, nb);  xcd_barrier(bar);
    for (int rep_ = 0; rep_ < REP9; ++rep_) run_phase<9>(P, lds, bid, nb);  xcd_barrier(bar);
    for (int rep_ = 0; rep_ < REP10; ++rep_) run_phase<10>(P, lds, bid, nb); xcd_barrier(bar);
    for (int rep_ = 0; rep_ < REP12; ++rep_) run_phase<12>(P, lds, bid, nb); xcd_barrier(bar);
    for (int rep_ = 0; rep_ < REP13; ++rep_) run_phase<13>(P, lds, bid, nb);
}

extern "C" void kernel_launch(void* const* d_in, const int* in_sizes, int n_in, void* d_out, int out_size, void* d_ws, size_t ws_size, hipStream_t stream) {
    (void)in_sizes; (void)n_in; (void)out_size;
    if (ws_size < WS_END) return;
    Params P{};
    P.x = (const float*)d_in[0]; P.pos = (const int*)d_in[1]; P.norm_w = (const float*)d_in[2]; P.rel_bias = (const float*)d_in[3];
    P.nsa_w_in = (const float*)d_in[4]; P.nsa_q_norm = (const float*)d_in[5]; P.nsa_k_norm = (const float*)d_in[6]; P.pe_k = (const float*)d_in[7];
    P.w1_k = (const float*)d_in[8]; P.w2_k = (const float*)d_in[9]; P.pe_v = (const float*)d_in[10]; P.w1_v = (const float*)d_in[11]; P.w2_v = (const float*)d_in[12];
    P.nsa_w_out = (const float*)d_in[13]; P.mla_w_in = (const float*)d_in[14]; P.mla_q_a_norm = (const float*)d_in[15]; P.mla_w_q_b = (const float*)d_in[16];
    P.mla_kv_a_norm = (const float*)d_in[17]; P.mla_w_kv_b = (const float*)d_in[18]; P.mla_q_norm = (const float*)d_in[19]; P.mla_k_norm = (const float*)d_in[20];
    P.mla_w_out = (const float*)d_in[21];
    P.out = (float*)d_out; P.ws = (unsigned char*)d_ws;
    static int grid = 0;
    if (!grid) {
        int dev = 0, cus = 0, per_cu = 0; (void)hipGetDevice(&dev);
        if (hipDeviceGetAttribute(&cus, hipDeviceAttributeMultiprocessorCount, dev) != hipSuccess || cus <= 0) cus = 256;
        (void)hipFuncSetAttribute((const void*)k_mega, hipFuncAttributeMaxDynamicSharedMemorySize, LDS_BYTES);
        if (hipOccupancyMaxActiveBlocksPerMultiprocessor(&per_cu, k_mega, 512, LDS_BYTES) != hipSuccess || per_cu < 1) per_cu = 1;
        grid = cus;
    }
    (void)hipMemsetAsync((unsigned char*)d_ws + OFF_CTL, 0, XCD_BAR_WORDS * sizeof(unsigned), stream);
    hipLaunchKernelGGL(k_mega, dim3(grid), dim3(512), LDS_BYTES, stream, P);
}
```

```cpp
#define ATT16 1
#define USE_FP8Z 1
#define USE_FP8M 1
#define USE_FP8O 1
#define USE_FP8N 1
#define USE_FP8Q 1
#define TAIL_IN_P6 0
#define F8_Q0 0
#define F8_NQ 53
#define VT_IN_P3 1
#define GEMM_NT 0
#include <hip/hip_runtime.h>
#include <stdint.h>
#include <stddef.h>

#define DI __device__ __forceinline__
#define LAS __attribute__((address_space(3)))
typedef unsigned short bf16_t;
typedef short bf16x8 __attribute__((ext_vector_type(8)));
typedef float f32x4 __attribute__((ext_vector_type(4)));
typedef float f32x16 __attribute__((ext_vector_type(16)));
typedef unsigned u32x4 __attribute__((ext_vector_type(4)));
typedef unsigned u32x2 __attribute__((ext_vector_type(2)));
typedef __bf16 bf2_t __attribute__((ext_vector_type(2)));
typedef float f2_t __attribute__((ext_vector_type(2)));

DI int tid_opaque() { int t = (int)threadIdx.x; asm volatile("" : "+v"(t)); return t; }
DI unsigned pk2(float a, float b) { f2_t f = {a, b}; bf2_t v = __builtin_convertvector(f, bf2_t); return __builtin_bit_cast(unsigned, v); }
DI float clamp_fp8(float v) { float r; asm("v_max_f32 %0, 0xc3e00000, %1\n\tv_min_f32 %0, 0x43e00000, %0" : "=v"(r) : "v"(v)); return r; }
DI unsigned pk4_fp8(float a, float b, float c, float d) { a = clamp_fp8(a); b = clamp_fp8(b); c = clamp_fp8(c); d = clamp_fp8(d); int w = 0; w = __builtin_amdgcn_cvt_pk_fp8_f32(a, b, w, false); w = __builtin_amdgcn_cvt_pk_fp8_f32(c, d, w, true); return (unsigned)w; }
DI unsigned pk4_fp8c(float a, float b, float c, float d) { return pk4_fp8(a, b, c, d); }
DI float bflo(unsigned w) { return __uint_as_float(w << 16); }
DI float bfhi(unsigned w) { return __uint_as_float(w & 0xffff0000u); }
#ifndef USE_FP8KV
#define USE_FP8KV 0
#endif
#ifndef USE_FP8Q
#define USE_FP8Q 0
#endif
#ifndef USE_FP8N
#define USE_FP8N 0
#endif
#ifndef USE_FP8O
#define USE_FP8O 0
#endif
#ifndef GEMM_STAG
#define GEMM_STAG 0
#endif
#ifndef GEMM_NT
#define GEMM_NT 0
#endif
#ifndef FP8EMU
#define FP8EMU 0
#endif
DI float emu_q8(float x, float s) { float y = x * s; const float ay = fabsf(y);
    if (ay < 0.015625f) y = rintf(y * 512.0f) * (1.0f / 512.0f);
    else { unsigned u = __float_as_uint(y); u = (u + 0x0007FFFFu + ((u >> 20) & 1u)) & 0xFFF00000u; y = __uint_as_float(u); }
    y = fminf(fmaxf(y, -448.0f), 448.0f); return y / s; }
DI float bf1(bf16_t h) { return __uint_as_float(((unsigned)h) << 16); }

#ifndef ATT16
#define ATT16 0
#endif
DI int vt_key_of_pos(int p) {
#if ATT16
    return (p & ~31) | (((p >> 2) & 1) << 4) | (((p >> 3) & 3) << 2) | (p & 3);
#else
    return (p & ~0xC) | ((p & 4) << 1) | ((p & 8) >> 1);
#endif
}
DI int vt_pos_of_key(int k) {
#if ATT16
    return (k & ~31) | (((k >> 2) & 3) << 3) | (((k >> 4) & 1) << 2) | (k & 3);
#else
    return (k & ~0xC) | ((k & 4) << 1) | ((k & 8) >> 1);
#endif
}
constexpr int BATCH = 4, SEQ = 4096, DM = 4096, MTOK = BATCH * SEQ;
constexpr int NH = 64, NG = 4, NR = 16, DK = 192, DV = 128;
constexpr int N1 = 40896, N1P = 40960;
constexpr int C_Q = 0, C_KVC = 12288, C_KVS = 13568, C_KVW = 14848, C_ZC = 16128, C_ZS = 24320, C_ZW = 32512, C_G = 40704;
constexpr int N3 = 10304, N3P = 10496;
constexpr int C3_CQ = 0, C3_CKV = 1536, C3_KPE = 2048, C3_Z = 2112;
constexpr int QLORA = 1536, KVLORA = 512;
constexpr int NQB = 12288, NKVB = 16384, ZW8 = 8192;
constexpr float EPSN = 1e-6f;
constexpr float LOG2E = 1.4426950408889634f;
constexpr float QSCALE = 0.07216878364870322f * 1.4426950408889634f;

constexpr size_t SZ_W1T = (size_t)N1P * DM * 2, SZ_W2T = (size_t)DM * ZW8 * 2, SZ_W3T = (size_t)N3P * DM * 2, SZ_W4T = (size_t)NQB * QLORA * 2,
                 SZ_W5T = (size_t)NKVB * KVLORA * 2, SZ_W6T = (size_t)DM * ZW8 * 2;
constexpr size_t OFF_W1T = 0, OFF_W2T = OFF_W1T + SZ_W1T, OFF_W3T = OFF_W2T + SZ_W2T, OFF_W4T = OFF_W3T + SZ_W3T, OFF_W5T = OFF_W4T + SZ_W4T,
                 OFF_W6T = OFF_W5T + SZ_W5T, OFF_W1K = OFF_W6T + SZ_W6T;
constexpr size_t OFF_W5K = OFF_W5T, OFF_W5V = OFF_W5T + SZ_W5T / 2;
constexpr size_t SZ_W1K = (size_t)256 * 6144 * 2, SZ_W1V = (size_t)256 * 4096 * 2;
constexpr size_t OFF_W1V = OFF_W1K + SZ_W1K, OFF_CTL = OFF_W1V + SZ_W1V, OFF_H = OFF_CTL + 65536;
constexpr size_t SZ_H = (size_t)MTOK * DM * 2, SZ_KS = (size_t)BATCH * NG * SEQ * DK * 2, SZ_VTS = (size_t)BATCH * NG * DV * SEQ * 2,
                 SZ_ACK = (size_t)4096 * 6144 * 2, SZ_ACV = (size_t)4096 * 4096 * 2;
constexpr size_t OFF_KS = OFF_H + SZ_H, OFF_KW = OFF_KS + SZ_KS, OFF_VTS = OFF_KW + SZ_KS, OFF_VTW = OFF_VTS + SZ_VTS, OFF_ACK = OFF_VTW + SZ_VTS,
                 OFF_ACV = OFF_ACK + SZ_ACK, OFF_KC = OFF_ACV + SZ_ACV;
constexpr size_t SZ_KC = (size_t)16 * 256 * DK * 2, SZ_VTC = (size_t)16 * DV * 256 * 2, SZ_HID = (size_t)4096 * 256 * 4;
constexpr size_t OFF_VTC = OFF_KC + SZ_KC, OFF_HIDK = OFF_VTC + SZ_VTC, OFF_HIDV = OFF_HIDK + SZ_HID, OFF_Y0 = OFF_HIDV + SZ_HID;
constexpr size_t SZ_Y0 = (size_t)MTOK * N1P * 2, SZ_O = (size_t)MTOK * ZW8 * 2;
constexpr size_t OFF_O = OFF_Y0 + SZ_Y0, WS_END = OFF_O + SZ_O;
constexpr size_t OFF_SS1 = OFF_HIDK;
constexpr size_t OFF_A8 = OFF_O, OFF_B8 = OFF_O + (size_t)MTOK * DM;
#ifndef F8_Q0
#define F8_Q0 0
#define F8_NQ 63
#endif
constexpr size_t OFF_B8M = OFF_W1T, OFF_A8M = OFF_W1T + (64ull << 20);
constexpr int C3_Z8 = 2304, NZ8M = 8192;
constexpr size_t OFF_W28 = OFF_W1T + (132ull << 20), OFF_O8N = OFF_W1T + (168ull << 20);
static_assert(OFF_O8N + (size_t)MTOK * ZW8 <= OFF_W1T + SZ_W1T, "fp8 NSA out-proj buffers");
constexpr float O8N_SCALE = 64.0f;
constexpr float O8_SCALE = 128.0f;
constexpr size_t OFF_KM = 0;
constexpr size_t SZ_KM = (size_t)BATCH * NH * SEQ * DK * 2;
static_assert(SZ_KM <= SZ_W1T + SZ_W2T, "KM alias");
constexpr size_t OFF_VTM = OFF_H;
constexpr size_t SZ_VTM = (size_t)BATCH * NH * DV * SEQ * 2;
constexpr size_t OFF_CKVN = OFF_VTM + SZ_VTM;
constexpr size_t SZ_CKVN = (size_t)MTOK * KVLORA * 2;
static_assert(OFF_CKVN + SZ_CKVN <= OFF_KC, "CKVN alias");
constexpr size_t OFF_Y1 = OFF_Y0, SZ_Y1 = (size_t)MTOK * N3P * 2;
constexpr size_t OFF_QM = OFF_Y1 + SZ_Y1, SZ_QM = (size_t)MTOK * NQB * 2;
constexpr size_t OFF_KVM = OFF_QM + SZ_QM, SZ_KVM = (size_t)MTOK * NKVB * 2;
constexpr size_t OFF_KNM = OFF_KVM;
constexpr size_t OFF_KPER = OFF_KVM, OFF_SSPE = OFF_KVM + (size_t)MTOK * 64 * 4;
constexpr size_t OFF_O8M = OFF_KVM + SZ_KVM / 2, OFF_W68 = OFF_O8M + (size_t)MTOK * ZW8;
constexpr size_t OFF_W48 = OFF_W68 + (size_t)DM * ZW8, OFF_CQN8 = OFF_W48 + (size_t)NQB * QLORA;
constexpr size_t OFF_CKVN8 = OFF_CQN8 + (size_t)MTOK * QLORA, OFF_W5K8 = OFF_CKVN8 + (size_t)MTOK * KVLORA, OFF_W5V8 = OFF_W5K8 + (size_t)(NKVB / 2) * KVLORA;
static_assert(OFF_W5V8 + (size_t)(NKVB / 2) * KVLORA <= OFF_KVM + SZ_KVM, "fp8 MLA buffers");
constexpr size_t OFF_CQN = OFF_KVM + SZ_KVM, SZ_CQN = (size_t)MTOK * QLORA * 2;
constexpr size_t OFF_ROPE = OFF_CQN + SZ_CQN, SZ_ROPE = (size_t)MTOK * 64 * 4;
static_assert(OFF_ROPE + SZ_ROPE <= OFF_O, "layer-1 alias region");
static_assert(WS_END <= 2680160256ull, "workspace");

struct Params {
    const float* x; const int* pos; const float* norm_w; const float* rel_bias;
    const float* nsa_w_in; const float* nsa_q_norm; const float* nsa_k_norm; const float* pe_k; const float* w1_k; const float* w2_k;
    const float* pe_v; const float* w1_v; const float* w2_v; const float* nsa_w_out;
    const float* mla_w_in; const float* mla_q_a_norm; const float* mla_w_q_b; const float* mla_kv_a_norm; const float* mla_w_kv_b;
    const float* mla_q_norm; const float* mla_k_norm; const float* mla_w_out;
    float* out; unsigned char* ws;
};

#define XB_TMO      128
#define XB_XCNT(j)  (256  + 64 * (j))
#define XB_XSUB(j)  (1280 + 64 * (j))
#define XB_XGEN(j)  (2304 + 64 * (j))
#define XB_TOP      3328
#define XB_TOPGEN   3392
#define XCD_BAR_WORDS 3456
#define XB_SPIN_CAP (1u << 18)

__device__ __forceinline__ unsigned xb_ld(unsigned* p)              { return __hip_atomic_load(p, __ATOMIC_RELAXED, __HIP_MEMORY_SCOPE_AGENT); }
__device__ __forceinline__ unsigned xb_add(unsigned* p, unsigned v) { return __hip_atomic_fetch_add(p, v, __ATOMIC_RELAXED, __HIP_MEMORY_SCOPE_AGENT); }
__device__ __forceinline__ unsigned xb_xcc_id() { return (unsigned)__builtin_amdgcn_s_getreg((3 << 11) | 20) & 0xFu; }
#define XB_SPIN(cond, bar) do { unsigned _sp = 0; while (cond) { __builtin_amdgcn_s_sleep(1); \
    if ((++_sp & 255u) == 0u) { if (xb_ld(&(bar)[XB_TMO])) break; if (_sp > XB_SPIN_CAP) { atomicAdd(&(bar)[XB_TMO], 1u); break; } } } } while (0)

struct XcdBarrier {
    unsigned* bar; unsigned x;
    volatile LAS unsigned* st;
};

__device__ __forceinline__ XcdBarrier xcd_barrier_post(unsigned* bar, volatile LAS unsigned* st) {
    XcdBarrier b; b.bar = bar; b.x = xb_xcc_id(); b.st = st;
    if (threadIdx.x == 0) (void)xb_add(&bar[XB_XCNT(b.x)], 1u);
    return b;
}
__device__ __forceinline__ void xcd_barrier_complete(unsigned* bar, unsigned x, unsigned& nloc, unsigned& nx) {
    const unsigned G = gridDim.x * gridDim.y * gridDim.z;
    unsigned sum, cnt, mine, sp = 0u;
    for (;;) {
        sum = 0u; cnt = 0u; mine = 0u;
#pragma unroll
        for (unsigned j = 0; j < 16; ++j) { const unsigned c = xb_ld(&bar[XB_XCNT(j)]); sum += c; cnt += (c > 0u) ? 1u : 0u; mine = (j == x) ? c : mine; }
        if (sum == G) break;
        __builtin_amdgcn_s_sleep(1);
        if ((++sp & 255u) == 0u) { if (xb_ld(&bar[XB_TMO])) break; if (sp > XB_SPIN_CAP) { atomicAdd(&bar[XB_TMO], 1u); break; } }
    }
    nloc = mine > 0u ? mine : 1u; nx = cnt > 0u ? cnt : 1u;
}

__device__ __forceinline__ void xcd_barrier(const XcdBarrier& b) {
    asm volatile("s_waitcnt vmcnt(0)" ::: "memory");
    __syncthreads();
    if (threadIdx.x == 0) {
        unsigned* bar = b.bar;
        __builtin_amdgcn_s_waitcnt(0);
        unsigned nloc = b.st[0], nx = b.st[1];
        if (nloc == 0u) { xcd_barrier_complete(bar, b.x, nloc, nx); b.st[0] = nloc; b.st[1] = nx; }
        const unsigned old = xb_add(&bar[XB_XSUB(b.x)], 1u);
        const unsigned gen = old / nloc;
        if (old + 1u == (gen + 1u) * nloc) {
            __builtin_amdgcn_fence(__ATOMIC_RELEASE, "agent");
            asm volatile("s_waitcnt vmcnt(0)" ::: "memory");
            const unsigned og = xb_add(&bar[XB_TOP], 1u);
            const unsigned tg = og / nx;
            if (og + 1u == (tg + 1u) * nx) xb_add(&bar[XB_TOPGEN], 1u);
            else XB_SPIN(xb_ld(&bar[XB_TOPGEN]) == tg, bar);
            __builtin_amdgcn_fence(__ATOMIC_ACQUIRE, "agent");
            xb_add(&bar[XB_XGEN(b.x)], 1u);
            asm volatile("s_waitcnt vmcnt(0)" ::: "memory");
        } else {
            XB_SPIN(xb_ld(&bar[XB_XGEN(b.x)]) == gen, bar);
            __builtin_amdgcn_fence(__ATOMIC_ACQUIRE, "agent");
            asm volatile("s_waitcnt vmcnt(0)" ::: "memory");
        }
    }
    __syncthreads();
}

namespace pg8 {
#define PG8_LAS __attribute__((address_space(3)))
typedef unsigned short bf16_t;
typedef short bf16x8 __attribute__((ext_vector_type(8)));
typedef float f32x4 __attribute__((ext_vector_type(4)));
typedef unsigned u32x4 __attribute__((ext_vector_type(4)));
typedef int i32x8_t __attribute__((ext_vector_type(8)));
typedef int i32x4_t __attribute__((ext_vector_type(4)));
constexpr int BM = 256, BK = 64, HALF = 128, HTB = HALF * BK * 2  , STAGE_BYTES = 8 * HTB, NXCD = 8, WGM = 8;

__host__ __device__ __forceinline__ int lds_byte(int r, int c) { const int st = (r >> 4) * 2 + (c >> 5), rr = r & 15, cc = c & 31, ob = rr * 64 + cc * 2; return st * 1024 + (ob ^ (((ob >> 9) & 1) << 5)); }
__host__ __device__ __forceinline__ void stage_rc(int b, int& R, int& C) { const int st = b / 1024, sb = b % 1024, swz = sb ^ (((sb >> 9) & 1) << 5); R = (st >> 1) * 16 + swz / 64; C = (st & 1) * 32 + (swz % 64) / 2; }
__host__ __device__ __forceinline__ int perm32(int rho) { const int n = rho >> 4, i = rho & 15; return 8 * (i >> 2) + 4 * n + (i & 3); }

struct Unit { int pm, pn; };
struct Gemm { const bf16_t* A; const bf16_t* Bt; int M, N, K; };

struct StaticOrder {
    int nM, nN, nwg, G, c;
    __host__ __device__ void init(int M, int N, int G_, int c_) { nM = M / BM; nN = N / BM; nwg = nM * nN; G = G_; c = c_; }
    __host__ __device__ bool next(int i, Unit& u) const {
        const long L = (long)i * G + c; if (L >= nwg) return false;
        int wgid = (int)L; { const int q = nwg / NXCD, r = nwg % NXCD, xcd = wgid % NXCD, off = wgid / NXCD; wgid = (xcd < r ? xcd * (q + 1) : r * (q + 1) + (xcd - r) * q) + off; }
        const int nig = WGM * nN, gid = wgid / nig, fm = gid * WGM, gsz = (nM - fm) < WGM ? (nM - fm) : WGM;
        u.pm = fm + ((wgid % nig) % gsz); u.pn = (wgid % nig) / gsz; return true;
    }
    __device__ __forceinline__ void a_ready(const Unit&) const {}
    __device__ __forceinline__ void done(const Unit&) const {}
};
#if GEMM_NT
#define EPI_ST16(p, w) __builtin_nontemporal_store((w), (u32x4*)(p))
#else
#define EPI_ST16(p, w) (*(u32x4*)(p) = (w))
#endif
struct EpiStoreBf16 {
    static constexpr bool PERM = true, AFTER_DRAIN = false, SWAP23 = false, FP8 = false;
    bf16_t* O; int ldc;
    __device__ __forceinline__ void operator()(const f32x4 (&acc)[2][2][4][2], const Unit& u, int wr, int wc, int fr, int fq) const {
        const int row0 = u.pm * BM + wr * 64 + fr; const int col0 = u.pn * BM + wc * 32 + 8 * fq;
#pragma unroll
        for (int ai = 0; ai < 2; ++ai)
#pragma unroll
            for (int m = 0; m < 4; ++m) { bf16_t* rowp = O + (size_t)(row0 + ai * HALF + m * 16) * ldc + col0;
#pragma unroll
                for (int bj = 0; bj < 2; ++bj) { const f32x4 v0 = acc[ai][bj][m][0], v1 = acc[ai][bj][m][1];
                    u32x4 w; w.x = pk2(v0[0], v0[1]); w.y = pk2(v0[2], v0[3]); w.z = pk2(v1[0], v1[1]); w.w = pk2(v1[2], v1[3]);
                    EPI_ST16(rowp + bj * HALF, w); } }
    }
};
struct EpiResF32 {
    static constexpr bool PERM = false, AFTER_DRAIN = false, SWAP23 = false, FP8 = false;
    const float* base; float* out; int ldc;
    __device__ __forceinline__ void operator()(const f32x4 (&acc)[2][2][4][2], const Unit& u, int wr, int wc, int fr, int fq) const {
        const int row0 = u.pm * BM + wr * 64 + fr, col0 = u.pn * BM + wc * 32 + 4 * fq;
#pragma unroll
        for (int ai = 0; ai < 2; ++ai)
#pragma unroll
            for (int m = 0; m < 4; ++m) { const size_t off = (size_t)(row0 + ai * HALF + m * 16) * ldc + col0;
#pragma unroll
                for (int bj = 0; bj < 2; ++bj)
#pragma unroll
                    for (int n = 0; n < 2; ++n) { const f32x4 bs = *(const f32x4*)(base + off + bj * HALF + n * 16);
                        *(f32x4*)(out + off + bj * HALF + n * 16) = bs + acc[ai][bj][m][n]; } }
    }
};
struct EpiPlainF32 {
    static constexpr bool PERM = false, AFTER_DRAIN = false, SWAP23 = false, FP8 = false;
    float* C; int ldc;
    __device__ __forceinline__ void operator()(const f32x4 (&acc)[2][2][4][2], const Unit& u, int wr, int wc, int fr, int fq) const {
        const int row0 = u.pm * BM + wr * 64 + fr, col0 = u.pn * BM + wc * 32 + 4 * fq;
#pragma unroll
        for (int ai = 0; ai < 2; ++ai)
#pragma unroll
            for (int m = 0; m < 4; ++m) { float* rowp = C + (size_t)(row0 + ai * HALF + m * 16) * ldc + col0;
#pragma unroll
                for (int bj = 0; bj < 2; ++bj)
#pragma unroll
                    for (int n = 0; n < 2; ++n) *(f32x4*)(rowp + bj * HALF + n * 16) = acc[ai][bj][m][n]; }
    }
};

template <bool F8_> struct EpiVTT {
    static constexpr bool PERM = true, AFTER_DRAIN = false, SWAP23 = true, FP8 = F8_;
    bf16_t* O; float scale;
    __device__ __forceinline__ void operator()(const f32x4 (&acc)[2][2][4][2], const Unit& u, int wr, int wc, int fr, int fq) const {
        const int row0 = u.pm * BM + wr * 64 + fr; const int colt = u.pn * BM; const int b = colt >> 12, pos0 = (colt & 4095) + wc * 32 + 8 * fq;
        bf16_t* base = O + (size_t)b * 8192 * 4096 + pos0;
#pragma unroll
        for (int ai = 0; ai < 2; ++ai)
#pragma unroll
            for (int m = 0; m < 4; ++m) { bf16_t* rowp = base + (size_t)(row0 + ai * HALF + m * 16) * 4096;
#pragma unroll
                for (int bj = 0; bj < 2; ++bj) { const f32x4 v0 = F8_ ? acc[ai][bj][m][0] * scale : acc[ai][bj][m][0], v1 = F8_ ? acc[ai][bj][m][1] * scale : acc[ai][bj][m][1];
                    u32x4 w; w.x = pk2(v0[0], v0[1]); w.y = pk2(v0[2], v0[3]); w.z = pk2(v1[0], v1[1]); w.w = pk2(v1[2], v1[3]);
                    EPI_ST16(rowp + bj * HALF, w); } }
    }
};
using EpiVT = EpiVTT<false>; using EpiVTFp8 = EpiVTT<true>;

template <bool F8_> struct EpiKNormT {
    static constexpr bool PERM = true, AFTER_DRAIN = false, SWAP23 = false, FP8 = F8_;
    bf16_t* KM; const float* sspe; const float* kper; const float* gain; PG8_LAS float* tab; mutable unsigned par; float scale;
    __device__ __forceinline__ void operator()(const f32x4 (&acc)[2][2][4][2], const Unit& u, int wr, int wc, int fr, int fq) const {
        PG8_LAS float* T = tab + par * 2048;
#pragma unroll
        for (int ai = 0; ai < 2; ++ai)
#pragma unroll
            for (int m = 0; m < 4; ++m) { const int row = ai * HALF + wr * 64 + m * 16 + fr;
#pragma unroll
                for (int bj = 0; bj < 2; ++bj) { const f32x4 x = F8_ ? acc[ai][bj][m][0] * scale : acc[ai][bj][m][0], y = F8_ ? acc[ai][bj][m][1] * scale : acc[ai][bj][m][1];
                    float ss = (x[0] * x[0] + x[1] * x[1]) + (x[2] * x[2] + x[3] * x[3]) + (y[0] * y[0] + y[1] * y[1]) + (y[2] * y[2] + y[3] * y[3]);
                    ss += __shfl_xor(ss, 16); ss += __shfl_xor(ss, 32);
                    if (fq == 0) T[row * 8 + bj * 4 + wc] = ss; } }
        asm volatile("s_waitcnt lgkmcnt(0)" ::: "memory"); __builtin_amdgcn_s_barrier(); asm volatile("" ::: "memory");
        const f32x4 g0 = *(const f32x4*)(gain + wc * 32 + 8 * fq), g1 = *(const f32x4*)(gain + wc * 32 + 8 * fq + 4);
        const int tok0 = u.pm * BM, b = tok0 >> 12;
#pragma unroll
        for (int ai = 0; ai < 2; ++ai)
#pragma unroll
            for (int m = 0; m < 4; ++m) { const int row = ai * HALF + wr * 64 + m * 16 + fr, tok = tok0 + row, s = tok & 4095;
                const float sp = sspe[tok]; const f32x4 kp = *(const f32x4*)(kper + (size_t)tok * 64 + wc * 16 + 4 * fq);
#pragma unroll
                for (int bj = 0; bj < 2; ++bj) { const f32x4 t = *(const PG8_LAS f32x4*)(T + row * 8 + bj * 4);
                    const float rstd = rsqrtf(((t[0] + t[1]) + (t[2] + t[3]) + sp) * (1.0f / 192.0f) + 1e-6f);
                    const int hd = 2 * u.pn + bj;
                    bf16_t* kb = KM + ((size_t)(b * 64 + hd) * 4096 + s) * 192;
                    const f32x4 x = F8_ ? acc[ai][bj][m][0] * scale : acc[ai][bj][m][0], y = F8_ ? acc[ai][bj][m][1] * scale : acc[ai][bj][m][1];
                    u32x4 w; w.x = pk2(x[0] * rstd * g0[0], x[1] * rstd * g0[1]); w.y = pk2(x[2] * rstd * g0[2], x[3] * rstd * g0[3]);
                    w.z = pk2(y[0] * rstd * g1[0], y[1] * rstd * g1[1]); w.w = pk2(y[2] * rstd * g1[2], y[3] * rstd * g1[3]);
                    *(u32x4*)(kb + wc * 32 + 8 * fq) = w;
                    u32x2 r; r.x = pk2(kp[0] * rstd, kp[1] * rstd); r.y = pk2(kp[2] * rstd, kp[3] * rstd);
                    *(u32x2*)(kb + 128 + wc * 16 + 4 * fq) = r; } }
        par ^= 1u;
    }
};
using EpiKNorm = EpiKNormT<false>; using EpiKNormFp8 = EpiKNormT<true>;

template <bool F8_> struct EpiResNormT {
    static constexpr bool PERM = false, AFTER_DRAIN = false, SWAP23 = false, FP8 = F8_;
    const float* base; float* out; int ldc; const float* gain; bf16_t* xg; float* ss; unsigned char* x8; float scale;
    __device__ __forceinline__ void operator()(const f32x4 (&acc)[2][2][4][2], const Unit& u, int wr, int wc, int fr, int fq) const {
        const int row0 = u.pm * BM + wr * 64 + fr, col0 = u.pn * BM + wc * 32 + 4 * fq;
        f32x4 gv[2][2];
#pragma unroll
        for (int bj = 0; bj < 2; ++bj)
#pragma unroll
            for (int n = 0; n < 2; ++n) gv[bj][n] = *(const f32x4*)(gain + col0 + bj * HALF + n * 16);
#pragma unroll
        for (int ai = 0; ai < 2; ++ai)
#pragma unroll
            for (int m = 0; m < 4; ++m) { const int row = row0 + ai * HALF + m * 16; const size_t off = (size_t)row * ldc + col0; float sq = 0.f;
#pragma unroll
                for (int bj = 0; bj < 2; ++bj)
#pragma unroll
                    for (int n = 0; n < 2; ++n) { const f32x4 bs = *(const f32x4*)(base + off + bj * HALF + n * 16); const f32x4 v = F8_ ? bs + acc[ai][bj][m][n] * scale : bs + acc[ai][bj][m][n];
                        *(f32x4*)(out + off + bj * HALF + n * 16) = v;
                        sq += (v[0] * v[0] + v[1] * v[1]) + (v[2] * v[2] + v[3] * v[3]);
                        const f32x4 g = gv[bj][n]; u32x2 w; w.x = pk2(v[0] * g[0], v[1] * g[1]); w.y = pk2(v[2] * g[2], v[3] * g[3]);
                        *(u32x2*)(xg + off + bj * HALF + n * 16) = w;
                        if (x8) *(unsigned*)(x8 + off + bj * HALF + n * 16) = pk4_fp8(v[0] * g[0] * 16.0f, v[1] * g[1] * 16.0f, v[2] * g[2] * 16.0f, v[3] * g[3] * 16.0f); }
                sq += __shfl_xor(sq, 16); sq += __shfl_xor(sq, 32);
                if (fq == 0) atomicAdd(ss + row, sq); }
    }
};
using EpiResNorm = EpiResNormT<false>; using EpiResNormFp8 = EpiResNormT<true>;
struct EpiStoreBf16RowScale {
    static constexpr bool PERM = true, AFTER_DRAIN = false, SWAP23 = false, FP8 = false;
    bf16_t* O; int ldc; const float* ss; float inv_dim;
    __device__ __forceinline__ void operator()(const f32x4 (&acc)[2][2][4][2], const Unit& u, int wr, int wc, int fr, int fq) const {
        const int row0 = u.pm * BM + wr * 64 + fr; const int col0 = u.pn * BM + wc * 32 + 8 * fq;
#pragma unroll
        for (int ai = 0; ai < 2; ++ai)
#pragma unroll
            for (int m = 0; m < 4; ++m) { const int row = row0 + ai * HALF + m * 16; const float rs = rsqrtf(ss[row] * inv_dim + 1e-6f);
                bf16_t* rowp = O + (size_t)row * ldc + col0;
#pragma unroll
                for (int bj = 0; bj < 2; ++bj) { const f32x4 v0 = acc[ai][bj][m][0] * rs, v1 = acc[ai][bj][m][1] * rs;
                    u32x4 w; w.x = pk2(v0[0], v0[1]); w.y = pk2(v0[2], v0[3]); w.z = pk2(v1[0], v1[1]); w.w = pk2(v1[2], v1[3]);
                    EPI_ST16(rowp + bj * HALF, w); } }
    }
};

struct EpiStoreBf16Fp8 {
    static constexpr bool PERM = true, AFTER_DRAIN = false, SWAP23 = false, FP8 = true;
    bf16_t* O; int ldc; float scale; int nostore = 0, rowmask = -1, rowoff = 0;
    __device__ __forceinline__ void operator()(const f32x4 (&acc)[2][2][4][2], const Unit& u, int wr, int wc, int fr, int fq) const {
        const int row0 = u.pm * BM + wr * 64 + fr; const int col0 = u.pn * BM + wc * 32 + 8 * fq;
#pragma unroll
        for (int ai = 0; ai < 2; ++ai)
#pragma unroll
            for (int m = 0; m < 4; ++m) { bf16_t* rowp = O + (size_t)(((row0 + ai * HALF + m * 16) & rowmask) + rowoff) * ldc + col0;
#pragma unroll
                for (int bj = 0; bj < 2; ++bj) { const f32x4 v0 = acc[ai][bj][m][0] * scale, v1 = acc[ai][bj][m][1] * scale;
                    u32x4 w; w.x = pk2(v0[0], v0[1]); w.y = pk2(v0[2], v0[3]); w.z = pk2(v1[0], v1[1]); w.w = pk2(v1[2], v1[3]);
                    if (nostore == 3) { bf16_t* pp = O + (size_t)((((ai * 4 + m) * 2 + bj) * 8 + (fr & 7)) % 64 + 256) * ldc + u.pn * BM + (wr * 4 + wc) * 64 % 256 + ((fr >> 3) * 4 + fq) * 8; EPI_ST16(pp, w); }
                    else if (nostore != 1 || w.x == 0x12345679u) EPI_ST16(rowp + bj * HALF, w); } }
    }
};

struct OrderBf16Part {
    int G, c, q0, nq, nz;
    __device__ bool next(int i, Unit& u) const { const int L = i * G + c;
        if (L < nq * 64) { u.pm = L & 63; u.pn = q0 + (L >> 6); return true; }
        const int Lz = L - nq * 64; if (Lz >= nz * 4) return false;
        const int j = Lz >> 2; u.pm = 16 * (Lz & 3); u.pn = j < q0 ? j : j + nq; return true; }
    __device__ __forceinline__ void a_ready(const Unit&) const {}
    __device__ __forceinline__ void done(const Unit&) const {}
};
struct OrderFp8Part {
    int G, c, q0, nq, nz, rot;
    __device__ bool next(int i, Unit& u) const { const int L = i * G + (G == 256 ? ((c + rot) & 255) : c); if (L >= nz * 60) return false;
        const int r = L % 60, j = L / 60; u.pm = r + r / 15 + 1; u.pn = j < q0 ? j : j + nq; return true; }
    __device__ __forceinline__ void a_ready(const Unit&) const {}
    __device__ __forceinline__ void done(const Unit&) const {}
};

struct EpiStoreBf16RowScaleFp8 {
    static constexpr bool PERM = true, AFTER_DRAIN = false, SWAP23 = false, FP8 = true;
    bf16_t* O; int ldc; const float* ss; float inv_dim, scale;
    __device__ __forceinline__ void operator()(const f32x4 (&acc)[2][2][4][2], const Unit& u, int wr, int wc, int fr, int fq) const {
        const int row0 = u.pm * BM + wr * 64 + fr; const int col0 = u.pn * BM + wc * 32 + 8 * fq;
#pragma unroll
        for (int ai = 0; ai < 2; ++ai)
#pragma unroll
            for (int m = 0; m < 4; ++m) { const int row = row0 + ai * HALF + m * 16; const float rs = rsqrtf(ss[row] * inv_dim + 1e-6f) * scale;
                bf16_t* rowp = O + (size_t)row * ldc + col0;
#pragma unroll
                for (int bj = 0; bj < 2; ++bj) { const f32x4 v0 = acc[ai][bj][m][0] * rs, v1 = acc[ai][bj][m][1] * rs;
                    u32x4 w; w.x = pk2(v0[0], v0[1]); w.y = pk2(v0[2], v0[3]); w.z = pk2(v1[0], v1[1]); w.w = pk2(v1[2], v1[3]);
                    EPI_ST16(rowp + bj * HALF, w); } }
    }
};
struct OrderTiles {
    int G, c, ncol;
    __device__ bool next(int i, Unit& u) const { const int L = i * G + c; if (L >= ncol * 64) return false; u.pm = L & 63; u.pn = L >> 6; return true; }
    __device__ __forceinline__ void a_ready(const Unit&) const {}
    __device__ __forceinline__ void done(const Unit&) const {}
};

struct EpiResF32Fp8 {
    static constexpr bool PERM = false, AFTER_DRAIN = false, SWAP23 = false, FP8 = true;
    const float* base; float* out; int ldc; float scale;
    __device__ __forceinline__ void operator()(const f32x4 (&acc)[2][2][4][2], const Unit& u, int wr, int wc, int fr, int fq) const {
        const int row0 = u.pm * BM + wr * 64 + fr, col0 = u.pn * BM + wc * 32 + 4 * fq;
#pragma unroll
        for (int ai = 0; ai < 2; ++ai)
#pragma unroll
            for (int m = 0; m < 4; ++m) { const size_t off = (size_t)(row0 + ai * HALF + m * 16) * ldc + col0;
#pragma unroll
                for (int bj = 0; bj < 2; ++bj)
#pragma unroll
                    for (int n = 0; n < 2; ++n) { const f32x4 bs = *(const f32x4*)(base + off + bj * HALF + n * 16);
                        *(f32x4*)(out + off + bj * HALF + n * 16) = bs + acc[ai][bj][m][n] * scale; } }
    }
};

template <class Base> struct OrderSwap {
    Base B;
    __device__ bool next(int i, Unit& u) const { Unit t; if (!B.next(i, t)) return false; u.pm = t.pn; u.pn = t.pm; return true; }
    __device__ __forceinline__ void a_ready(const Unit&) const {}
    __device__ __forceinline__ void done(const Unit&) const {}
};

struct OrderFp8PartP8 {
    int G, c;
    __device__ bool next(int i, Unit& u) const { int L;
        if (G != 256) { L = i * G + c; if (L >= 1920) return false; }
        else if (i < 7) L = i * 256 + c;
        else { if (c < 192 || i > 8) return false; L = 1792 + (i - 7) * 64 + (c - 192); }
        const int r = L % 60, j = L / 60; u.pm = r + r / 15 + 1; u.pn = 9 + j; return true; }
    __device__ __forceinline__ void a_ready(const Unit&) const {}
    __device__ __forceinline__ void done(const Unit&) const {}
};

struct EpiStoreBf16Fp8L {
    static constexpr bool PERM = true, AFTER_DRAIN = false, SWAP23 = false, FP8 = true, LINE128 = true;
    bf16_t* O; int ldc; float scale;
    __device__ __forceinline__ void operator()(const f32x4 (&acc)[2][2][4][2], const Unit& u, int wr, int wc, int fr, int fq) const {
        const int hi = fr >> 3;
        const int row0 = u.pm * BM + wr * 64 + (fr & 7); const int colA = u.pn * BM + wc * 64 + hi * 32 + 8 * fq, colB = u.pn * BM + wc * 64 + (hi ^ 1) * 32 + 8 * fq;
#pragma unroll
        for (int ai = 0; ai < 2; ++ai)
#pragma unroll
            for (int m = 0; m < 4; ++m) {
                const f32x4 a0 = acc[ai][0][m][0] * scale, a1 = acc[ai][0][m][1] * scale, b0 = acc[ai][1][m][0] * scale, b1 = acc[ai][1][m][1] * scale;
                u32x4 p0, p1, q1; p0.x = pk2(a0[0], a0[1]); p0.y = pk2(a0[2], a0[3]); p0.z = pk2(a1[0], a1[1]); p0.w = pk2(a1[2], a1[3]);
                p1.x = pk2(b0[0], b0[1]); p1.y = pk2(b0[2], b0[3]); p1.z = pk2(b1[0], b1[1]); p1.w = pk2(b1[2], b1[3]);
                q1.x = (unsigned)__builtin_amdgcn_update_dpp(0, (int)p1.x, 0x128, 0xf, 0xf, false); q1.y = (unsigned)__builtin_amdgcn_update_dpp(0, (int)p1.y, 0x128, 0xf, 0xf, false);
                q1.z = (unsigned)__builtin_amdgcn_update_dpp(0, (int)p1.z, 0x128, 0xf, 0xf, false); q1.w = (unsigned)__builtin_amdgcn_update_dpp(0, (int)p1.w, 0x128, 0xf, 0xf, false);
                u32x4 wa, wb; wa.x = hi ? q1.x : p0.x; wa.y = hi ? q1.y : p0.y; wa.z = hi ? q1.z : p0.z; wa.w = hi ? q1.w : p0.w;
                wb.x = hi ? p0.x : q1.x; wb.y = hi ? p0.y : q1.y; wb.z = hi ? p0.z : q1.z; wb.w = hi ? p0.w : q1.w;
                bf16_t* rp = O + (size_t)(row0 + ai * HALF + m * 16) * ldc;
                *(u32x4*)(rp + colA) = wa;
                *(u32x4*)(rp + (size_t)8 * ldc + colB) = wb; }
    }
};
template <class E_, class = void> struct line128 { static constexpr bool v = false; };
template <class E_> struct line128<E_, decltype((void)E_::LINE128)> { static constexpr bool v = E_::LINE128; };
template <class Epi, class Sched, bool STAMP = false>
__device__ __forceinline__ void gemm_phase(PG8_LAS unsigned char* lds, const Gemm g, const Sched& S, const Epi& E, unsigned long long* stamps, int stag = 0) {
    const int tid = tid_opaque(), wid = __builtin_amdgcn_readfirstlane(tid >> 6), lane = tid & 63, wr = wid >> 2, wc = wid & 3, fr = lane & 15, fq = lane >> 4;
    const int K = g.K, nt = K / BK;
    int ts_lo = 0, ts_hi = 0, nts = 0; const unsigned long long rt_entry = STAMP ? (unsigned long long)wall_clock64() : 0ull;
#define PG8_STAMP() do { if (STAMP && wid == 0 && nts < 64) { const unsigned long long _c = (unsigned long long)clock64(); \
        ts_lo = (lane == nts) ? (int)(unsigned)_c : ts_lo; ts_hi = (lane == nts) ? (int)(unsigned)(_c >> 32) : ts_hi; ++nts; } } while (0)
    PG8_STAMP();
    unsigned voffA[2], voffB[2];
#pragma unroll
    for (int i = 0; i < 2; ++i) { int R, C; stage_rc(tid * 16 + i * 8192, R, C); int Rb = Epi::PERM ? ((R & ~31) + perm32(R & 31)) : R; if (Epi::SWAP23) Rb = vt_key_of_pos(Rb);
        if (line128<Epi>::v) Rb = (R >> 5) * 64 + perm32(R & 31);
        voffA[i] = (unsigned)(R * K + C) * 2u; voffB[i] = (unsigned)(Rb * K + C) * 2u; }
    const size_t kstep = (size_t)(BK * 2);
    const size_t hstep = (size_t)HALF * K * 2;
    const size_t tstep = 2 * hstep;
    const size_t hstepB = line128<Epi>::v ? (size_t)32 * K * 2 : hstep;
    const unsigned ldsw = (unsigned)wid * 1024u;
    const int aoff = lds_byte(wr * 64 + fr, fq * 8), boff = lds_byte(wc * 32 + fr, fq * 8);
#define PG8_SA(b, h) (((b) * 2 + (h)) * HTB)
#define PG8_SB(b, h) ((4 + (b) * 2 + (h)) * HTB)
#define PG8_STAGE(bufoff, gbase, voff) do { _Pragma("unroll") for (int _i = 0; _i < 2; ++_i) \
        __builtin_amdgcn_global_load_lds((const unsigned*)((const char*)(gbase) + (voff)[_i]), (PG8_LAS unsigned*)(lds + (bufoff) + ldsw + _i * 8192), 16, 0, 0); } while (0)
#define PG8_LDA(dst, b, h) do { if constexpr (Epi::FP8) { _Pragma("unroll") for (int m = 0; m < 4; ++m) { const PG8_LAS unsigned char* p_ = lds + PG8_SA(b, h) + aoff + m * 2048; \
            const i32x4_t lo_ = *(const PG8_LAS i32x4_t*)p_, hi_ = *(const PG8_LAS i32x4_t*)(p_ + 1024); dst##8[m] = __builtin_shufflevector(lo_, hi_, 0, 1, 2, 3, 4, 5, 6, 7); } } \
        else { _Pragma("unroll") for (int m = 0; m < 4; ++m) _Pragma("unroll") for (int k = 0; k < 2; ++k) dst[m][k] = *(const PG8_LAS bf16x8*)(lds + PG8_SA(b, h) + aoff + m * 2048 + k * 1024); } } while (0)
#define PG8_LDB(dst, b, h) do { if constexpr (Epi::FP8) { _Pragma("unroll") for (int n = 0; n < 2; ++n) { const PG8_LAS unsigned char* p_ = lds + PG8_SB(b, h) + boff + n * 2048; \
            const i32x4_t lo_ = *(const PG8_LAS i32x4_t*)p_, hi_ = *(const PG8_LAS i32x4_t*)(p_ + 1024); dst##8[n] = __builtin_shufflevector(lo_, hi_, 0, 1, 2, 3, 4, 5, 6, 7); } } \
        else { _Pragma("unroll") for (int n = 0; n < 2; ++n) _Pragma("unroll") for (int k = 0; k < 2; ++k) dst[n][k] = *(const PG8_LAS bf16x8*)(lds + PG8_SB(b, h) + boff + n * 2048 + k * 1024); } } while (0)
#define PG8_MMA(ai, bj, At, Bt) do { __builtin_amdgcn_s_setprio(1); \
        if constexpr (Epi::FP8) { \
            _Pragma("unroll") for (int m = 0; m < 4; ++m) _Pragma("unroll") for (int n = 0; n < 2; ++n) \
                asm volatile("v_mfma_scale_f32_16x16x128_f8f6f4 %0, %1, %2, %0, %3, %3 op_sel_hi:[0,0,0]" : "+v"(acc[ai][bj][m][n]) : "v"(Bt##8[n]), "v"(At##8[m]), "v"(fp8_scale_one)); \
        } else { \
            _Pragma("unroll") for (int m = 0; m < 4; ++m) _Pragma("unroll") for (int n = 0; n < 2; ++n) _Pragma("unroll") for (int k = 0; k < 2; ++k) \
                acc[ai][bj][m][n] = __builtin_amdgcn_mfma_f32_16x16x32_bf16(Bt[n][k], At[m][k], acc[ai][bj][m][n], 0, 0, 0); } \
        __builtin_amdgcn_s_setprio(0); } while (0)
#define PG8_WAIT_V(n) asm volatile("s_waitcnt vmcnt(" #n ")" ::: "memory")
#define PG8_WAIT_L(n) asm volatile("s_waitcnt lgkmcnt(" #n ")" ::: "memory")
#define PG8_BAR __builtin_amdgcn_s_barrier()
#define PG8_SCHED __builtin_amdgcn_sched_barrier(0)
    Unit cur, nxt; int ui = 0;
    if (!S.next(0, cur)) return;
    if (stag > 0) { const int n_ = (int)((blockIdx.x >> 3) & 7u) * stag; for (int i_ = 0; i_ < n_; ++i_) __builtin_amdgcn_s_sleep(37); }
    f32x4 acc[2][2][4][2];
#pragma unroll
    for (int a = 0; a < 2; ++a)
#pragma unroll
        for (int b = 0; b < 2; ++b)
#pragma unroll
            for (int m = 0; m < 4; ++m)
#pragma unroll
                for (int n = 0; n < 2; ++n) acc[a][b][m][n] = (f32x4){0.f, 0.f, 0.f, 0.f};
    bf16x8 At[4][2], B0[2][2], B1[2][2]; i32x8_t At8[4], B08[2], B18[2]; const int fp8_scale_one = 0x7f7f7f7f;
    const char* cA = (const char*)g.A + (size_t)cur.pm * tstep; const char* cB = (const char*)g.Bt + (size_t)cur.pn * tstep;
    S.a_ready(cur);
    PG8_STAGE(PG8_SB(0, 0), cB, voffB); PG8_STAGE(PG8_SA(0, 0), cA, voffA); PG8_STAGE(PG8_SB(0, 1), cB + hstepB, voffB); PG8_STAGE(PG8_SA(0, 1), cA + hstep, voffA);
    if (wr == 1) PG8_BAR;
    PG8_WAIT_V(4); PG8_BAR;
    PG8_STAGE(PG8_SB(1, 0), cB + kstep, voffB); PG8_STAGE(PG8_SA(1, 0), cA + kstep, voffA); PG8_STAGE(PG8_SB(1, 1), cB + hstepB + kstep, voffB);
    PG8_WAIT_V(6); PG8_BAR;
    PG8_STAMP();
    for (;;) {
        const bool has_next = S.next(ui + 1, nxt);
        const char* nA = has_next ? (const char*)g.A + (size_t)nxt.pm * tstep : cA; const char* nB = has_next ? (const char*)g.Bt + (size_t)nxt.pn * tstep : cB;
        for (int t = 0; t < nt; t += 2) {
            const bool last = (t == nt - 2);
            const char* a1 = cA + (size_t)(t + 1) * kstep;
            const char* a2 = last ? nA : cA + (size_t)(t + 2) * kstep; const char* b2 = last ? nB : cB + (size_t)(t + 2) * kstep;
            const char* a3 = a2 + kstep; const char* b3 = b2 + kstep;
            if (last && has_next) S.a_ready(nxt);
            PG8_LDB(B0, 0, 0); PG8_SCHED; PG8_LDA(At, 0, 0); PG8_STAGE(PG8_SA(1, 1), a1 + hstep, voffA);
            PG8_WAIT_L(8); PG8_BAR; PG8_WAIT_L(0); PG8_MMA(0, 0, At, B0); PG8_BAR; PG8_SCHED;
            PG8_LDB(B1, 0, 1); PG8_STAGE(PG8_SB(0, 0), b2, voffB);
            PG8_BAR; PG8_WAIT_L(0); PG8_MMA(0, 1, At, B1); PG8_BAR;
            PG8_LDA(At, 0, 1); PG8_STAGE(PG8_SA(0, 0), a2, voffA);
            PG8_BAR; PG8_WAIT_L(0); PG8_MMA(1, 0, At, B0); PG8_BAR; PG8_SCHED;
            PG8_STAGE(PG8_SB(0, 1), b2 + hstepB, voffB);
            PG8_WAIT_V(6); PG8_BAR; PG8_MMA(1, 1, At, B1); PG8_BAR;
            PG8_LDB(B0, 1, 0); PG8_SCHED; PG8_LDA(At, 1, 0); PG8_STAGE(PG8_SA(0, 1), a2 + hstep, voffA);
            PG8_WAIT_L(8); PG8_BAR; PG8_WAIT_L(0); PG8_MMA(0, 0, At, B0); PG8_BAR; PG8_SCHED;
            PG8_LDB(B1, 1, 1); PG8_STAGE(PG8_SB(1, 0), b3, voffB);
            PG8_BAR; PG8_WAIT_L(0); PG8_MMA(0, 1, At, B1); PG8_BAR;
            PG8_LDA(At, 1, 1); PG8_STAGE(PG8_SA(1, 0), a3, voffA);
            PG8_BAR; PG8_WAIT_L(0); PG8_MMA(1, 0, At, B0); PG8_BAR; PG8_SCHED;
            PG8_STAGE(PG8_SB(1, 1), b3 + hstepB, voffB);
            PG8_WAIT_V(6); PG8_BAR; PG8_MMA(1, 1, At, B1); PG8_BAR;
        }
        PG8_STAMP();
        if constexpr (Epi::FP8) asm volatile("s_nop 15\n\ts_nop 15" ::: "memory");
        if constexpr (!Epi::AFTER_DRAIN) { E(acc, cur, wr, wc, fr, fq); S.done(cur); }
        PG8_STAMP();
        if (!has_next) break;
#pragma unroll
        for (int a = 0; a < 2; ++a)
#pragma unroll
            for (int b = 0; b < 2; ++b)
#pragma unroll
                for (int m = 0; m < 4; ++m)
#pragma unroll
                    for (int n = 0; n < 2; ++n) acc[a][b][m][n] = (f32x4){0.f, 0.f, 0.f, 0.f};
        cur = nxt; cA = nA; cB = nB; ++ui;
    }
    PG8_WAIT_V(0);
    if (wr == 0) PG8_BAR;
    PG8_BAR;
    if constexpr (Epi::AFTER_DRAIN) { E.fused(acc, cur, wr, wc, fr, fq, lds, wid, lane); S.done(cur); }
    PG8_STAMP();
    if (STAMP && wid == 0) { stamps[lane] = lane < nts ? (((unsigned long long)(unsigned)ts_hi << 32) | (unsigned)ts_lo) : 0ull;
        if (lane == 62) stamps[62] = rt_entry; if (lane == 63) stamps[63] = (unsigned long long)wall_clock64(); }
#undef PG8_STAMP
#undef PG8_SA
#undef PG8_SB
#undef PG8_STAGE
#undef PG8_LDA
#undef PG8_LDB
#undef PG8_MMA
#undef PG8_WAIT_V
#undef PG8_WAIT_L
#undef PG8_BAR
#undef PG8_SCHED
}
}


DI void phase_wconv(LAS unsigned char* lds, const float* __restrict__ src, bf16_t* __restrict__ dst, int K, int N, int Npad, int bid, int nb, float q8s = 0.f, int colmap = 0, unsigned char* __restrict__ dst8 = nullptr, int n8_0 = 0, int n8_1 = 0) {
    LAS float* tile = (LAS float*)lds;
    const int tid = tid_opaque();
    const int tk = K / 64, tn = Npad / 256, total = tk * tn;
    for (int t = bid; t < total; t += nb) {
        const int k0 = (t % tk) * 64, n0 = (t / tk) * 256;
        __syncthreads();
        {
            const int ty = tid >> 6, tx = tid & 63, n = n0 + tx * 4;
            f32x4 v[8];
#pragma unroll
            for (int i = 0; i < 8; ++i) {
                const int k = k0 + ty + 8 * i;
                v[i] = (f32x4){0.f, 0.f, 0.f, 0.f};
                if (colmap) { const int ns = (n >> 7) * 256 + (colmap == 1 ? 128 : 0) + (n & 127); v[i] = *(const f32x4*)(src + (size_t)k * (2 * N) + ns); }
                else if (n < N) v[i] = *(const f32x4*)(src + (size_t)k * N + n);
            }
#pragma unroll
            for (int i = 0; i < 8; ++i) { LAS float* pp = tile + (ty + 8 * i) * 257 + tx * 4; pp[0] = v[i][0]; pp[1] = v[i][1]; pp[2] = v[i][2]; pp[3] = v[i][3]; }
        }
        __syncthreads();
#pragma unroll
        for (int ps_ = 0; ps_ < 4; ++ps_) {
            const int n = (tid >> 3) + 64 * ps_, kc = tid & 7;
            float v[8];
#pragma unroll
            for (int j = 0; j < 8; ++j) { v[j] = tile[(kc * 8 + j) * 257 + n]; if (q8s > 0.f) v[j] = emu_q8(v[j], q8s); else if (q8s < 0.f && n0 + n >= C_ZC) v[j] = emu_q8(v[j], -q8s); }
            u32x4 w; w.x = pk2(v[0], v[1]); w.y = pk2(v[2], v[3]); w.z = pk2(v[4], v[5]); w.w = pk2(v[6], v[7]);
            *(u32x4*)(dst + (size_t)(n0 + n) * K + k0 + kc * 8) = w;
            if (dst8 && (n0 + n < n8_0 || n0 + n >= n8_1)) { u32x2 b; b.x = pk4_fp8(v[0] * 64.0f, v[1] * 64.0f, v[2] * 64.0f, v[3] * 64.0f); b.y = pk4_fp8(v[4] * 64.0f, v[5] * 64.0f, v[6] * 64.0f, v[7] * 64.0f);
                *(u32x2*)(dst8 + (size_t)(n0 + n) * K + k0 + kc * 8) = b; }
        }
    }
}

DI void phase_rmsnorm(const float* __restrict__ x, const float* __restrict__ gain, bf16_t* __restrict__ h, int bid, int nb, float q8s = 0.f, unsigned char* __restrict__ h8 = nullptr) {
    const int tid = tid_opaque(); const int lane = tid & 63, wid = tid >> 6;
    for (int row = bid * 8 + wid; row < MTOK; row += nb * 8) {
        const float* xr = x + (size_t)row * DM;
        f32x4 v[16]; float ss = 0.f;
#pragma unroll
        for (int i = 0; i < 16; ++i) { v[i] = *(const f32x4*)(xr + (i * 64 + lane) * 4); ss += v[i][0] * v[i][0] + v[i][1] * v[i][1] + v[i][2] * v[i][2] + v[i][3] * v[i][3]; }
#pragma unroll
        for (int o = 32; o >= 1; o >>= 1) ss += __shfl_xor(ss, o);
        const float rstd = rsqrtf(ss * (1.0f / DM) + EPSN);
        bf16_t* hr = h + (size_t)row * DM;
#pragma unroll
        for (int i = 0; i < 16; ++i) { const f32x4 g = *(const f32x4*)(gain + (i * 64 + lane) * 4);
            float y0 = v[i][0] * rstd * g[0], y1 = v[i][1] * rstd * g[1], y2 = v[i][2] * rstd * g[2], y3 = v[i][3] * rstd * g[3];
            if (q8s > 0.f || (q8s < 0.f && (row & 4095) >= 256)) { const float qa = fabsf(q8s); y0 = emu_q8(y0, qa); y1 = emu_q8(y1, qa); y2 = emu_q8(y2, qa); y3 = emu_q8(y3, qa); }
            u32x2 w; w.x = pk2(y0, y1); w.y = pk2(y2, y3);
            *(u32x2*)(hr + (i * 64 + lane) * 4) = w;
            if (h8) *(unsigned*)(h8 + (size_t)row * DM + (i * 64 + lane) * 4) = pk4_fp8(y0 * 16.0f, y1 * 16.0f, y2 * 16.0f, y3 * 16.0f); }
    }
}

DI void ld192(const bf16_t* p, int j8, float (&v)[24]) {
#pragma unroll
    for (int c = 0; c < 3; ++c) { const u32x4 w = *(const u32x4*)(p + (j8 + 8 * c) * 8);
        v[c * 8 + 0] = bflo(w.x); v[c * 8 + 1] = bfhi(w.x); v[c * 8 + 2] = bflo(w.y); v[c * 8 + 3] = bfhi(w.y);
        v[c * 8 + 4] = bflo(w.z); v[c * 8 + 5] = bfhi(w.z); v[c * 8 + 6] = bflo(w.w); v[c * 8 + 7] = bfhi(w.w); }
}
DI void st192(bf16_t* p, int j8, const float (&v)[24]) {
#pragma unroll
    for (int c = 0; c < 3; ++c) { u32x4 w; w.x = pk2(v[c * 8 + 0], v[c * 8 + 1]); w.y = pk2(v[c * 8 + 2], v[c * 8 + 3]); w.z = pk2(v[c * 8 + 4], v[c * 8 + 5]); w.w = pk2(v[c * 8 + 6], v[c * 8 + 7]);
        *(u32x4*)(p + (j8 + 8 * c) * 8) = w; }
}
DI float sum8(float s) { s += __shfl_xor(s, 1); s += __shfl_xor(s, 2); s += __shfl_xor(s, 4); return s; }

DI void phase_nsa_prep(const Params& P, int bid, int nb) {
    bf16_t* Y0 = (bf16_t*)(P.ws + OFF_Y0);
    bf16_t* KS = (bf16_t*)(P.ws + OFF_KS); bf16_t* KW = (bf16_t*)(P.ws + OFF_KW);
    bf16_t* ACK = (bf16_t*)(P.ws + OFF_ACK); bf16_t* ACV = (bf16_t*)(P.ws + OFF_ACV);
    const int tid = tid_opaque(), grp = (tid >> 3) & 15, j8 = tid & 7;
    for (int tok = bid * 4 + (tid >> 7); tok < MTOK; tok += nb * 4) {
        const int b = tok / SEQ, s = tok % SEQ;
        bf16_t* yr = Y0 + (size_t)tok * N1P;
        if (grp < 8) {
            const int g = grp & 3, br = grp >> 2;
            float v[24]; ld192(yr + (br ? C_KVW : C_KVS) + g * DK, j8, v);
            float ss = 0.f;
#pragma unroll
            for (int i = 0; i < 24; ++i) ss += v[i] * v[i];
            ss = sum8(ss);
            const float rstd = rsqrtf(ss * (1.0f / DK) + EPSN);
            const float* kn = P.nsa_k_norm + (br ? 2 : 1) * DK;
#pragma unroll
            for (int c = 0; c < 3; ++c)
#pragma unroll
                for (int e = 0; e < 8; ++e) v[c * 8 + e] *= rstd * kn[(j8 + 8 * c) * 8 + e];
            st192((br ? KW : KS) + ((size_t)(b * NG + g) * SEQ + s) * DK, j8, v);
        } else if (grp < 12) {
            const int g = grp - 8;
            float v[24]; ld192(yr + C_KVC + g * DK, j8, v);
#pragma unroll
            for (int k = 0; k < 2; ++k) {
                const int n = (s >> 4) - k, l = s - 16 * n;
                if (n >= 0 && n <= 254) {
                    float w[24];
#pragma unroll
                    for (int c = 0; c < 3; ++c)
#pragma unroll
                        for (int e = 0; e < 8; ++e) w[c * 8 + e] = v[c * 8 + e] + P.pe_k[l * DK + (j8 + 8 * c) * 8 + e];
                    st192(ACK + ((size_t)((b * NG + g) * 256 + n)) * 6144 + l * DK, j8, w);
                }
            }
        } else if (grp < 16) {
            const int g = grp - 12;
            const bf16_t* src = yr + C_KVC + NG * DK + g * DV;
            float v[16];
#pragma unroll
            for (int c = 0; c < 2; ++c) { const u32x4 w = *(const u32x4*)(src + (j8 + 8 * c) * 8);
                v[c * 8 + 0] = bflo(w.x); v[c * 8 + 1] = bfhi(w.x); v[c * 8 + 2] = bflo(w.y); v[c * 8 + 3] = bfhi(w.y);
                v[c * 8 + 4] = bflo(w.z); v[c * 8 + 5] = bfhi(w.z); v[c * 8 + 6] = bflo(w.w); v[c * 8 + 7] = bfhi(w.w); }
#pragma unroll
            for (int k = 0; k < 2; ++k) {
                const int n = (s >> 4) - k, l = s - 16 * n;
                if (n >= 0 && n <= 254) {
                    bf16_t* dst = ACV + ((size_t)((b * NG + g) * 256 + n)) * 4096 + l * DV;
#pragma unroll
                    for (int c = 0; c < 2; ++c) { float w[8];
#pragma unroll
                        for (int e = 0; e < 8; ++e) w[e] = v[c * 8 + e] + P.pe_v[l * DV + (j8 + 8 * c) * 8 + e];
                        u32x4 o; o.x = pk2(w[0], w[1]); o.y = pk2(w[2], w[3]); o.z = pk2(w[4], w[5]); o.w = pk2(w[6], w[7]);
                        *(u32x4*)(dst + (j8 + 8 * c) * 8) = o; }
                }
            }
        }
    }
    for (int i = bid * 512 + tid; i < 16 * (6144 + 4096) / 8; i += nb * 512) {
        const int per = (6144 + 4096) / 8, bg = i / per, c = i % per;
        const u32x4 z = {0u, 0u, 0u, 0u};
        if (c < 6144 / 8) *(u32x4*)(ACK + ((size_t)(bg * 256 + 255)) * 6144 + c * 8) = z;
        else *(u32x4*)(ACV + ((size_t)(bg * 256 + 255)) * 4096 + (c - 6144 / 8) * 8) = z;
    }
}

DI int swap23(int p) { return (p & ~0xC) | ((p & 4) << 1) | ((p & 8) >> 1); }
DI void phase_vt(LAS unsigned char* lds, const bf16_t* __restrict__ src, size_t src_stride, int col0, int col_step, int nhv, bf16_t* __restrict__ dst, int bid, int nb) {
    LAS bf16_t* tile = (LAS bf16_t*)lds;
    const int tid = tid_opaque();
    const int ntile = SEQ / 64, total = BATCH * nhv * ntile;
    for (int it = bid; it < total; it += nb) {
        const int mat = it / ntile, tt = it % ntile, b = mat / nhv, hv = mat % nhv;
        __syncthreads();
#pragma unroll
        for (int i = 0; i < 2; ++i) {
            const int q = tid + 512 * i, tok = q >> 4, ch = q & 15;
            const u32x4 w = *(const u32x4*)(src + (size_t)(b * SEQ + tt * 64 + tok) * src_stride + col0 + hv * col_step + ch * 8);
            *(LAS u32x4*)(tile + tok * 136 + ch * 8) = w;
        }
        __syncthreads();
        {
            const int dv = tid >> 2, kq = tid & 3;
            unsigned w[8];
#pragma unroll
            for (int e = 0; e < 8; ++e) {
                const int p0 = kq * 16 + 2 * e, p1 = p0 + 1;
                const int k0 = vt_key_of_pos(p0), k1 = vt_key_of_pos(p1);
                w[e] = (unsigned)tile[k0 * 136 + dv] | ((unsigned)tile[k1 * 136 + dv] << 16);
            }
            bf16_t* d = dst + ((size_t)mat * DV + dv) * SEQ + tt * 64 + kq * 16;
            u32x4 a = {w[0], w[1], w[2], w[3]}, c = {w[4], w[5], w[6], w[7]};
            *(u32x4*)d = a; *(u32x4*)(d + 8) = c;
        }
    }
}

DI void phase_cmp2(LAS unsigned char* lds, const Params& P, int bid, int nb) {
    LAS float* sk = (LAS float*)lds;
    LAS float* sv = sk + 192;
    LAS float* red = sv + 128;
    const float* HIDK = (const float*)(P.ws + OFF_HIDK); const float* HIDV = (const float*)(P.ws + OFF_HIDV);
    bf16_t* KC = (bf16_t*)(P.ws + OFF_KC); bf16_t* VTC = (bf16_t*)(P.ws + OFF_VTC);
    const int tid = tid_opaque(), lane = tid & 63, wid = tid >> 6;
    for (int m = bid; m < 4096; m += nb) {
        const int n = m & 255, bg = m >> 8;
        __syncthreads();
        if (tid < 192) { const float h = HIDK[(size_t)m * 256 + tid]; sk[tid] = h / (1.0f + __expf(-h)); }
        else if (tid < 320) { const float h = HIDV[(size_t)m * 256 + tid - 192]; sv[tid - 192] = h / (1.0f + __expf(-h)); }
        __syncthreads();
        float acc = 0.f;
        if (tid < 192) { for (int i = 0; i < 192; ++i) acc += sk[i] * P.w2_k[i * 192 + tid]; }
        else if (tid < 320) { const int j = tid - 192; for (int i = 0; i < 128; ++i) acc += sv[i] * P.w2_v[i * 128 + j]; }
        float ss = (tid < 192) ? acc * acc : 0.f;
#pragma unroll
        for (int o = 32; o >= 1; o >>= 1) ss += __shfl_xor(ss, o);
        if (lane == 0) red[wid] = ss;
        __syncthreads();
        const float tot = red[0] + red[1] + red[2];
        const float rstd = rsqrtf(tot * (1.0f / DK) + EPSN);
        if (tid < 192) { const float o = (n == 255) ? 0.f : acc * rstd * P.nsa_k_norm[tid];
            KC[(size_t)m * DK + tid] = (bf16_t)(pk2(o, 0.f) & 0xffffu); }
        else if (tid < 320) { const int j = tid - 192; const float o = (n == 255) ? 0.f : acc;
            const int pn = vt_pos_of_key(n);
            VTC[((size_t)bg * DV + j) * 256 + pn] = (bf16_t)(pk2(o, 0.f) & 0xffffu); }
    }
}

DI void phase_mla_prep1(const Params& P, int bid, int nb) {
    const bf16_t* Y1 = (const bf16_t*)(P.ws + OFF_Y1);
    bf16_t* CQN = (bf16_t*)(P.ws + OFF_CQN); bf16_t* CKVN = (bf16_t*)(P.ws + OFF_CKVN); float* ROPE = (float*)(P.ws + OFF_ROPE);
    float* KPER = (float*)(P.ws + OFF_KPER); float* SSPE = (float*)(P.ws + OFF_SSPE);
    const int tid = tid_opaque(); const int lane = tid & 63, wid = tid >> 6;
    constexpr int TU = 4;
    for (int tok0 = (bid * 8 + wid) * TU; tok0 < MTOK; tok0 += nb * 8 * TU) {
        u32x4 wq[TU][3], wk[TU]; int pos[TU]; bf16_t kp1[TU], kp2[TU];
#pragma unroll
        for (int t = 0; t < TU; ++t) { const bf16_t* yr = Y1 + (size_t)(tok0 + t) * N3P;
#pragma unroll
            for (int c = 0; c < 3; ++c) wq[t][c] = *(const u32x4*)(yr + C3_CQ + (c * 64 + lane) * 8);
            wk[t] = *(const u32x4*)(yr + C3_CKV + lane * 8);
            pos[t] = P.pos[tok0 + t]; kp1[t] = yr[C3_KPE + (lane & 31)]; kp2[t] = yr[C3_KPE + 32 + (lane & 31)]; }
#pragma unroll
        for (int t = 0; t < TU; ++t) { const int tok = tok0 + t;
            {
                float v[24]; float ss = 0.f;
#pragma unroll
                for (int c = 0; c < 3; ++c) { const u32x4 w = wq[t][c];
                    v[c * 8 + 0] = bflo(w.x); v[c * 8 + 1] = bfhi(w.x); v[c * 8 + 2] = bflo(w.y); v[c * 8 + 3] = bfhi(w.y);
                    v[c * 8 + 4] = bflo(w.z); v[c * 8 + 5] = bfhi(w.z); v[c * 8 + 6] = bflo(w.w); v[c * 8 + 7] = bfhi(w.w); }
#pragma unroll
                for (int i = 0; i < 24; ++i) ss += v[i] * v[i];
#pragma unroll
                for (int o = 32; o >= 1; o >>= 1) ss += __shfl_xor(ss, o);
                const float rstd = rsqrtf(ss * (1.0f / QLORA) + EPSN);
#pragma unroll
                for (int c = 0; c < 3; ++c) { const float* g = P.mla_q_a_norm + (c * 64 + lane) * 8; const f32x4 g0 = *(const f32x4*)g, g1 = *(const f32x4*)(g + 4); u32x4 w;
                    w.x = pk2(v[c * 8 + 0] * rstd * g0[0], v[c * 8 + 1] * rstd * g0[1]); w.y = pk2(v[c * 8 + 2] * rstd * g0[2], v[c * 8 + 3] * rstd * g0[3]);
                    w.z = pk2(v[c * 8 + 4] * rstd * g1[0], v[c * 8 + 5] * rstd * g1[1]); w.w = pk2(v[c * 8 + 6] * rstd * g1[2], v[c * 8 + 7] * rstd * g1[3]);
                    *(u32x4*)(CQN + (size_t)tok * QLORA + (c * 64 + lane) * 8) = w;
                    if (USE_FP8Q) { const float r16 = rstd * 16.0f; u32x2 b;
                        b.x = pk4_fp8(v[c * 8 + 0] * r16 * g0[0], v[c * 8 + 1] * r16 * g0[1], v[c * 8 + 2] * r16 * g0[2], v[c * 8 + 3] * r16 * g0[3]);
                        b.y = pk4_fp8(v[c * 8 + 4] * r16 * g1[0], v[c * 8 + 5] * r16 * g1[1], v[c * 8 + 6] * r16 * g1[2], v[c * 8 + 7] * r16 * g1[3]);
                        *(u32x2*)((unsigned char*)(P.ws + OFF_CQN8) + (size_t)tok * QLORA + (c * 64 + lane) * 8) = b; } }
            }
            {
                float v[8]; float ss = 0.f; const u32x4 w0 = wk[t];
                v[0] = bflo(w0.x); v[1] = bfhi(w0.x); v[2] = bflo(w0.y); v[3] = bfhi(w0.y); v[4] = bflo(w0.z); v[5] = bfhi(w0.z); v[6] = bflo(w0.w); v[7] = bfhi(w0.w);
#pragma unroll
                for (int i = 0; i < 8; ++i) ss += v[i] * v[i];
#pragma unroll
                for (int o = 32; o >= 1; o >>= 1) ss += __shfl_xor(ss, o);
                const float rstd = rsqrtf(ss * (1.0f / KVLORA) + EPSN);
                const float* g = P.mla_kv_a_norm + lane * 8; const f32x4 g0 = *(const f32x4*)g, g1 = *(const f32x4*)(g + 4); u32x4 w;
                w.x = pk2(v[0] * rstd * g0[0], v[1] * rstd * g0[1]); w.y = pk2(v[2] * rstd * g0[2], v[3] * rstd * g0[3]);
                w.z = pk2(v[4] * rstd * g1[0], v[5] * rstd * g1[1]); w.w = pk2(v[6] * rstd * g1[2], v[7] * rstd * g1[3]);
                *(u32x4*)(CKVN + (size_t)tok * KVLORA + lane * 8) = w;
                if (USE_FP8KV) { const float r16 = rstd * 16.0f; u32x2 b8;
                    b8.x = pk4_fp8(v[0] * r16 * g0[0], v[1] * r16 * g0[1], v[2] * r16 * g0[2], v[3] * r16 * g0[3]); b8.y = pk4_fp8(v[4] * r16 * g1[0], v[5] * r16 * g1[1], v[6] * r16 * g1[2], v[7] * r16 * g1[3]);
                    *(u32x2*)((unsigned char*)(P.ws + OFF_CKVN8) + (size_t)tok * KVLORA + lane * 8) = b8; }
            }
            {
                const int i = lane & 31;
                const float invf = exp2f(-(float)i * (13.287712379549449f / 32.0f));
                const float ang = (float)pos[t] * invf;
                const double rev = (double)ang * 0.15915494309189533576888;
                const float fr = (float)(rev - __builtin_rint(rev));
                const float sn = __builtin_amdgcn_sinf(fr), cs = __builtin_amdgcn_cosf(fr);
                const float x1 = bf1(kp1[t]), x2 = bf1(kp2[t]);
                float ssp = x1 * x1 + x2 * x2;
#pragma unroll
                for (int o = 16; o >= 1; o >>= 1) ssp += __shfl_xor(ssp, o);
                const float a = x1 * P.mla_k_norm[128 + i], c = x2 * P.mla_k_norm[160 + i];
                if (lane < 32) { ROPE[(size_t)tok * 64 + i] = cs; ROPE[(size_t)tok * 64 + 32 + i] = sn;
                    KPER[(size_t)tok * 64 + i] = a * cs - c * sn; KPER[(size_t)tok * 64 + 32 + i] = c * cs + a * sn;
                    if (lane == 0) SSPE[tok] = ssp; }
            }
        }
    }
}

DI void phase_mla_prep2(const Params& P, int bid, int nb) {
    const bf16_t* KNM = (const bf16_t*)(P.ws + OFF_KNM); const bf16_t* Y1 = (const bf16_t*)(P.ws + OFF_Y1);
    bf16_t* KM = (bf16_t*)(P.ws + OFF_KM); const float* ROPE = (const float*)(P.ws + OFF_ROPE);
    const int tid = tid_opaque(), grp = tid >> 3, j8 = tid & 7;
    for (int tok = bid; tok < MTOK; tok += nb) {
        const int b = tok / SEQ, s = tok % SEQ;
        float cs[8], sn[8];
#pragma unroll
        for (int e = 0; e < 8; ++e) { const int i = (8 * j8 + e) & 31; cs[e] = ROPE[(size_t)tok * 64 + i]; sn[e] = ROPE[(size_t)tok * 64 + 32 + i]; }
        {
            const bf16_t* kn = KNM + (size_t)tok * (NH * 128) + grp * 128;
            const bf16_t* kp = Y1 + (size_t)tok * N3P + C3_KPE;
            float v[24];
#pragma unroll
            for (int c = 0; c < 2; ++c) { const u32x4 w = *(const u32x4*)(kn + (j8 + 8 * c) * 8);
                v[c * 8 + 0] = bflo(w.x); v[c * 8 + 1] = bfhi(w.x); v[c * 8 + 2] = bflo(w.y); v[c * 8 + 3] = bfhi(w.y);
                v[c * 8 + 4] = bflo(w.z); v[c * 8 + 5] = bfhi(w.z); v[c * 8 + 6] = bflo(w.w); v[c * 8 + 7] = bfhi(w.w); }
            { const u32x4 w = *(const u32x4*)(kp + j8 * 8);
                v[16] = bflo(w.x); v[17] = bfhi(w.x); v[18] = bflo(w.y); v[19] = bfhi(w.y); v[20] = bflo(w.z); v[21] = bfhi(w.z); v[22] = bflo(w.w); v[23] = bfhi(w.w); }
            float ss = 0.f;
#pragma unroll
            for (int i = 0; i < 24; ++i) ss += v[i] * v[i];
            ss = sum8(ss);
            const float rstd = rsqrtf(ss * (1.0f / DK) + EPSN);
#pragma unroll
            for (int c = 0; c < 3; ++c)
#pragma unroll
                for (int e = 0; e < 8; ++e) v[c * 8 + e] *= rstd * P.mla_k_norm[(j8 + 8 * c) * 8 + e];
#pragma unroll
            for (int e = 0; e < 8; ++e) { const float mine = v[16 + e], other = __shfl_xor(mine, 4);
                v[16 + e] = (j8 < 4) ? (mine * cs[e] - other * sn[e]) : (mine * cs[e] + other * sn[e]); }
            st192(KM + ((size_t)(b * NH + grp) * SEQ + s) * DK, j8, v);
        }
    }
}
#ifndef ATT_THR
#define ATT_THR 30.0f
#endif
#ifndef ATT3_HOIST
#define ATT3_HOIST 1
#endif
#ifndef PROBE3_STORE2
#define PROBE3_STORE2 1
#endif
#ifndef PROBE3_UNITS
#define PROBE3_UNITS 1
#endif
#ifndef PROBE3_CMP
#define PROBE3_CMP 1
#endif
#ifndef PROBE3_SEL
#define PROBE3_SEL 1
#endif
#ifndef PROBE3_WIN
#define PROBE3_WIN 1
#endif
#ifndef ATT3_KD
#define ATT3_KD 4
#endif
#ifndef ATT3_VD
#define ATT3_VD 4
#endif
#ifndef ATT_PS_LIMIT
#define ATT_PS_LIMIT (16.0f * 1073741824.0f)
#endif
constexpr int KT_BYTES = 64 * 384, VT_BYTES = 128 * 128;
constexpr int L_K = 0, L_V = 2 * KT_BYTES, L_LUT = L_V + 2 * VT_BYTES, LUT_PITCH = 129, L_X = L_LUT + 64 * LUT_PITCH * 4 + 16, L_IL = L_X + 16 * 16 * 64 * 2, L_END = L_IL + 16 * 16 * 4;
static_assert(L_END <= 151552, "attention LDS");
enum { MODE_MLA = 0, MODE_SEL = 3, MODE_WIN = 4, MODE_CMPX = 5 };
#define MFMA16(a, b, c) __builtin_amdgcn_mfma_f32_16x16x32_bf16((a), (b), (c), 0, 0, 0)

struct AttnLane3 {
    int tw0, tw1;
    int r16, g;
    const LAS float* lutrow;
    unsigned long long mk0, mk1;
    int curblk;
    int tokbase;
    mutable float carry[2];
};
template <int MODE> DI int tq_of(const AttnLane3& A, int qb) { return (MODE == MODE_MLA) ? A.tw0 + 16 * qb + A.r16 : A.tw0 + qb; }

template <int MODE, int QS>
DI void attn_tile3(const LAS unsigned char* kb, const LAS unsigned char* vb, LAS unsigned char* lds, int j, const bf16x8 (&q)[2][6], f32x4 (&o)[8][2], float (&m_run)[2], float (&l_run)[2], const AttnLane3& A) {
    constexpr bool Q0 = (QS & 1) != 0, Q1 = (QS & 2) != 0;
    const int r16 = A.r16, g = A.g, sw = (r16 >> 1) & 7;
    const int kb0 = r16 * 384 + ((g ^ sw) << 4), kb1 = r16 * 384 + (((g ^ sw) ^ 4) << 4);
    const int vb0 = r16 * 128 + ((g ^ sw) << 4), vb1 = r16 * 128 + (((g ^ sw) ^ 4) << 4);
    f32x4 s[4][2];
    bool zinit = true;
    if (MODE == MODE_WIN || MODE == MODE_SEL) zinit = (A.tw0 - (64 * j + 63) >= 113);
    else if (MODE == MODE_CMPX) zinit = (A.tw0 - 31 - 16 * (64 * j + 63) >= 113);
    if (zinit) {
#pragma unroll
        for (int k4 = 0; k4 < 4; ++k4) { s[k4][0] = (f32x4){0.f, 0.f, 0.f, 0.f}; s[k4][1] = (f32x4){0.f, 0.f, 0.f, 0.f}; }
    } else {
#pragma unroll
        for (int qb = 0; qb < 2; ++qb) { if ((qb == 0 && !Q0) || (qb == 1 && !Q1)) continue;
            const int tq = tq_of<MODE>(A, qb);
#pragma unroll
            for (int k4 = 0; k4 < 4; ++k4)
#pragma unroll
                for (int r = 0; r < 4; ++r) { int d;
                    if (MODE == MODE_CMPX) d = tq - 31 - 16 * (64 * j + 16 * k4 + 4 * g + r); else d = tq - (64 * j + 16 * k4 + 4 * g + r);
                    d = d < 0 ? 0 : (d > 127 ? 127 : d); s[k4][qb][r] = A.lutrow[d] - m_run[qb]; } }
    }
    {
        constexpr int KD = ATT3_KD;
        bf16x8 kf[KD + 1];
#pragma unroll
        for (int i = 0; i < KD; ++i) kf[i] = *(const LAS bf16x8*)(kb + (((i % 6) & 1) ? kb1 : kb0) + ((i % 6) >> 1) * 128 + (i / 6) * (16 * 384));
        __builtin_amdgcn_sched_barrier(0);
#pragma unroll
        for (int i = 0; i < 24; ++i) {
            if (i + KD < 24) { const int n_ = i + KD; kf[n_ % (KD + 1)] = *(const LAS bf16x8*)(kb + (((n_ % 6) & 1) ? kb1 : kb0) + ((n_ % 6) >> 1) * 128 + (n_ / 6) * (16 * 384)); }
            __builtin_amdgcn_sched_barrier(0);
            if (Q0) s[i / 6][0] = MFMA16(kf[i % (KD + 1)], q[0][i % 6], s[i / 6][0]);
            if (Q1) s[i / 6][1] = MFMA16(kf[i % (KD + 1)], q[1][i % 6], s[i / 6][1]);
            __builtin_amdgcn_sched_barrier(0);
        }
    }
    if (zinit && __any(m_run[0] != 0.f || m_run[1] != 0.f)) {
#pragma unroll
        for (int k4 = 0; k4 < 4; ++k4)
#pragma unroll
            for (int r = 0; r < 4; ++r) { s[k4][0][r] -= m_run[0]; s[k4][1][r] -= m_run[1]; }
    }
    {
        const float NEG = -__builtin_inff();
        bool need;
        if (MODE == MODE_MLA) need = (64 * j + 63 > A.tw0);
        else if (MODE == MODE_WIN) need = !(64 * j + 63 <= A.tw0 && 64 * j >= A.tw1 - 511);
        else if (MODE == MODE_SEL) need = (j == A.curblk);
        else need = (A.tw0 - 31 - 16 * (64 * j + 63) < 0);
        if (need) {
#pragma unroll
            for (int qb = 0; qb < 2; ++qb) { if ((qb == 0 && !Q0) || (qb == 1 && !Q1)) continue;
                const int tq = tq_of<MODE>(A, qb);
#pragma unroll
                for (int k4 = 0; k4 < 4; ++k4)
#pragma unroll
                    for (int r = 0; r < 4; ++r) { const int c = 64 * j + 16 * k4 + 4 * g + r; bool kill;
                        if (MODE == MODE_WIN) kill = (unsigned)(tq - c) >= 512u;
                        else if (MODE == MODE_CMPX) kill = (tq - 31 - 16 * c) < 0;
                        else kill = (tq - c) < 0;
                        s[k4][qb][r] = kill ? NEG : s[k4][qb][r]; } }
        }
    }
    u32x4 pw[2][2];
#pragma unroll
    for (int qb = 0; qb < 2; ++qb) { if ((qb == 0 && !Q0) || (qb == 1 && !Q1)) continue;
        if (MODE == MODE_CMPX) {
            float lmx = fmaxf(fmaxf(s[0][qb][0], s[0][qb][1]), fmaxf(s[0][qb][2], s[0][qb][3]));
#pragma unroll
            for (int k4 = 1; k4 < 4; ++k4) lmx = fmaxf(lmx, fmaxf(fmaxf(s[k4][qb][0], s[k4][qb][1]), fmaxf(s[k4][qb][2], s[k4][qb][3])));
            if (__any(lmx > ATT_THR)) {
                float mx = fmaxf(lmx, __shfl_xor(lmx, 16)); mx = fmaxf(mx, __shfl_xor(mx, 32));
                const float dl = fmaxf(mx, 0.f), alpha = __builtin_amdgcn_exp2f(-dl);
                m_run[qb] += dl; l_run[qb] *= alpha; A.carry[qb] *= alpha;
#pragma unroll
                for (int db = 0; db < 8; ++db) o[db][qb] *= alpha;
#pragma unroll
                for (int k4 = 0; k4 < 4; ++k4) s[k4][qb] -= dl;
                LAS bf16_t* X = (LAS bf16_t*)(lds + L_X) + ((A.tokbase + qb) * 16 + r16) * 64;
                for (int a = g; a < 16 * j; a += 4) X[a] = (bf16_t)(pk2(bf1(X[a]) * alpha, 0.f) & 0xffffu);
            }
        }
        float ps = 0.f; f32x4 e[4];
#pragma unroll
        for (int k4 = 0; k4 < 4; ++k4) { e[k4][0] = __builtin_amdgcn_exp2f(s[k4][qb][0]); e[k4][1] = __builtin_amdgcn_exp2f(s[k4][qb][1]); e[k4][2] = __builtin_amdgcn_exp2f(s[k4][qb][2]); e[k4][3] = __builtin_amdgcn_exp2f(s[k4][qb][3]);
            ps += (e[k4][0] + e[k4][1]) + (e[k4][2] + e[k4][3]); }
        if (MODE != MODE_CMPX) {
            if (__any(!(ps <= ATT_PS_LIMIT))) {
                float mx = fmaxf(fmaxf(s[0][qb][0], s[0][qb][1]), fmaxf(s[0][qb][2], s[0][qb][3]));
#pragma unroll
                for (int k4 = 1; k4 < 4; ++k4) mx = fmaxf(mx, fmaxf(fmaxf(s[k4][qb][0], s[k4][qb][1]), fmaxf(s[k4][qb][2], s[k4][qb][3])));
                mx = fmaxf(mx, __shfl_xor(mx, 16)); mx = fmaxf(mx, __shfl_xor(mx, 32));
                const float dl = fmaxf(mx, 0.f), alpha = __builtin_amdgcn_exp2f(-dl);
                m_run[qb] += dl; l_run[qb] *= alpha;
#pragma unroll
                for (int db = 0; db < 8; ++db) o[db][qb] *= alpha;
                ps = 0.f;
#pragma unroll
                for (int k4 = 0; k4 < 4; ++k4) { e[k4][0] = __builtin_amdgcn_exp2f(s[k4][qb][0] - dl); e[k4][1] = __builtin_amdgcn_exp2f(s[k4][qb][1] - dl); e[k4][2] = __builtin_amdgcn_exp2f(s[k4][qb][2] - dl); e[k4][3] = __builtin_amdgcn_exp2f(s[k4][qb][3] - dl);
                    ps += (e[k4][0] + e[k4][1]) + (e[k4][2] + e[k4][3]); }
            }
        } else {
            LAS bf16_t* X = (LAS bf16_t*)(lds + L_X) + ((A.tokbase + qb) * 16 + r16) * 64;
#pragma unroll
            for (int k4 = 0; k4 < 4; ++k4) {
                const float y = __shfl(e[k4][3], (r16 + 16 * g + 48) & 63);
                const float prev = g ? y : A.carry[qb];
                if (g == 0) A.carry[qb] = y;
                X[16 * j + 4 * k4 + g] = (bf16_t)(pk2((e[k4][0] + e[k4][1]) + (e[k4][2] + e[k4][3]) + prev, 0.f) & 0xffffu);
            }
        }
        l_run[qb] += ps;
        pw[0][qb].x = pk2(e[0][0], e[0][1]); pw[0][qb].y = pk2(e[0][2], e[0][3]); pw[0][qb].z = pk2(e[1][0], e[1][1]); pw[0][qb].w = pk2(e[1][2], e[1][3]);
        pw[1][qb].x = pk2(e[2][0], e[2][1]); pw[1][qb].y = pk2(e[2][2], e[2][3]); pw[1][qb].z = pk2(e[3][0], e[3][1]); pw[1][qb].w = pk2(e[3][2], e[3][3]);
    }
    {
        constexpr int VD = ATT3_VD;
        bf16x8 vf[VD + 1];
#pragma unroll
        for (int i = 0; i < VD; ++i) vf[i] = *(const LAS bf16x8*)(vb + ((i >> 3) ? vb1 : vb0) + (i & 7) * (16 * 128));
        __builtin_amdgcn_sched_barrier(0);
#pragma unroll
        for (int i = 0; i < 16; ++i) {
            if (i + VD < 16) { const int n_ = i + VD; vf[n_ % (VD + 1)] = *(const LAS bf16x8*)(vb + ((n_ >> 3) ? vb1 : vb0) + (n_ & 7) * (16 * 128)); }
            __builtin_amdgcn_sched_barrier(0);
            if (Q0) o[i & 7][0] = MFMA16(vf[i % (VD + 1)], __builtin_bit_cast(bf16x8, pw[i >> 3][0]), o[i & 7][0]);
            if (Q1) o[i & 7][1] = MFMA16(vf[i % (VD + 1)], __builtin_bit_cast(bf16x8, pw[i >> 3][1]), o[i & 7][1]);
            __builtin_amdgcn_sched_barrier(0);
        }
    }
}

DI void attn_issue_first(LAS unsigned char* lds, const char* __restrict__ Kc, const char* __restrict__ Vc, int vt_stride, int j) {
    int tid = threadIdx.x; asm volatile("" : "+v"(tid));
    const int lane = tid & 63;
    const int wid_ = __builtin_amdgcn_readfirstlane(tid >> 6);
    const char* kp_ = Kc + (size_t)j * KT_BYTES; LAS unsigned char* kb_ = lds + L_K + wid_ * 3072;
#pragma unroll
    for (int i_ = 0; i_ < 3; ++i_) { const int pidx_ = (wid_ * 3 + i_) * 64 + lane, row_ = pidx_ / 24, cp_ = pidx_ % 24;
        __builtin_amdgcn_global_load_lds((const unsigned*)(kp_ + (unsigned)(row_ * 384 + ((cp_ ^ ((row_ >> 1) & 7)) << 4))), (LAS unsigned*)(kb_ + i_ * 1024), 16, 0, 0); }
    const char* vp_ = Vc + (size_t)j * 128; LAS unsigned char* vb_ = lds + L_V + wid_ * 2048;
#pragma unroll
    for (int i_ = 0; i_ < 2; ++i_) { const int pidx_ = (wid_ * 2 + i_) * 64 + lane, row_ = pidx_ >> 3, cp_ = pidx_ & 7;
        __builtin_amdgcn_global_load_lds((const unsigned*)(vp_ + (unsigned)(row_ * vt_stride * 2 + ((cp_ ^ ((row_ >> 1) & 7)) << 4))), (LAS unsigned*)(vb_ + i_ * 1024), 16, 0, 0); }
}

template <int MODE>
DI void attn_pass3x(LAS unsigned char* lds, const char* __restrict__ Kc, const char* __restrict__ Vc, int vt_stride, int j_lo, int j_hi,
                    const bf16x8 (&q)[2][6], f32x4 (&o)[8][2], float (&m_run)[2], float (&l_run)[2], const AttnLane3& A, bool first_issued = false) {
    if (j_lo >= j_hi) return;
    int tid = threadIdx.x; asm volatile("" : "+v"(tid));
    const int lane = tid & 63;
    const int wid_ = __builtin_amdgcn_readfirstlane(tid >> 6);
    unsigned kgo[3], vgo[2];
#pragma unroll
    for (int i_ = 0; i_ < 3; ++i_) { const int pidx_ = (wid_ * 3 + i_) * 64 + lane, row_ = pidx_ / 24, cp_ = pidx_ % 24; kgo[i_] = (unsigned)(row_ * 384 + ((cp_ ^ ((row_ >> 1) & 7)) << 4)); }
#pragma unroll
    for (int i_ = 0; i_ < 2; ++i_) { const int pidx_ = (wid_ * 2 + i_) * 64 + lane, row_ = pidx_ >> 3, cp_ = pidx_ & 7; vgo[i_] = (unsigned)(row_ * vt_stride * 2 + ((cp_ ^ ((row_ >> 1) & 7)) << 4)); }
#define ST_ISSUE(j, buf) do { const char* kp_ = Kc + (size_t)(j) * KT_BYTES; LAS unsigned char* kb_ = lds + L_K + (buf) * KT_BYTES + wid_ * 3072; \
        _Pragma("unroll") for (int i_ = 0; i_ < 3; ++i_) __builtin_amdgcn_global_load_lds((const unsigned*)(kp_ + kgo[i_]), (LAS unsigned*)(kb_ + i_ * 1024), 16, 0, 0); \
        const char* vp_ = Vc + (size_t)(j) * 128; LAS unsigned char* vb_ = lds + L_V + (buf) * VT_BYTES + wid_ * 2048; \
        _Pragma("unroll") for (int i_ = 0; i_ < 2; ++i_) __builtin_amdgcn_global_load_lds((const unsigned*)(vp_ + vgo[i_]), (LAS unsigned*)(vb_ + i_ * 1024), 16, 0, 0); } while (0)
    if (!first_issued) ST_ISSUE(j_lo, 0);
    asm volatile("s_waitcnt vmcnt(0)" ::: "memory");
    __syncthreads();
    for (int j = j_lo; j < j_hi; ++j) {
        const int cur = (j - j_lo) & 1;
        if (j + 1 < j_hi) ST_ISSUE(j + 1, cur ^ 1);
        const LAS unsigned char* kbp = lds + L_K + cur * KT_BYTES; const LAS unsigned char* vbp = lds + L_V + cur * VT_BYTES;
        if (MODE == MODE_SEL) {
            const bool a0 = ((A.mk0 >> j) & 1ull) != 0ull, a1 = ((A.mk1 >> j) & 1ull) != 0ull;
            if (a0 && a1) attn_tile3<MODE, 3>(kbp, vbp, lds, j, q, o, m_run, l_run, A);
            else if (a0) attn_tile3<MODE, 1>(kbp, vbp, lds, j, q, o, m_run, l_run, A);
            else if (a1) attn_tile3<MODE, 2>(kbp, vbp, lds, j, q, o, m_run, l_run, A);
        } else {
            bool act;
            if (MODE == MODE_MLA) act = 64 * j <= A.tw1;
            else if (MODE == MODE_CMPX) act = 1024 * j + 31 <= A.tw1;
            else act = (64 * j <= A.tw1) && (64 * j + 63 >= A.tw0 - 511);
            if (act) attn_tile3<MODE, 3>(kbp, vbp, lds, j, q, o, m_run, l_run, A);
        }
        asm volatile("s_waitcnt vmcnt(0)" ::: "memory");
        __syncthreads();
    }
#undef ST_ISSUE
}

DI int t5_bucket(int n) {
    if (n < 16) return n;
    return 16 + (n >= 19) + (n >= 21) + (n >= 24) + (n >= 27) + (n >= 31) + (n >= 35) + (n >= 40) + (n >= 46) + (n >= 52) + (n >= 59) + (n >= 67) + (n >= 77) + (n >= 87) + (n >= 99) + (n >= 113);
}
DI float silu_f(float z) { return z * __builtin_amdgcn_rcpf(1.0f + __builtin_amdgcn_exp2f(-1.4426950408889634f * z)); }

constexpr int EPI_PITCH = 272, EPI_WAVE_BYTES = 32 * EPI_PITCH;
template <bool RMW, bool NSA, int F8 = 0>
DI void attn_epilogue3(LAS unsigned char* lds, int lane, int wid, const f32x4 (&o)[8][2], float scale0, float scale1,
                       const char* __restrict__ zbase, unsigned z0, char* __restrict__ obase, unsigned o0, bool dostore = true, char* __restrict__ o8base = nullptr, float o8s = O8_SCALE, bool both = true) {
    asm volatile("" : "+v"(lane));
    LAS unsigned char* sc = lds + wid * EPI_WAVE_BYTES;
    const int r16 = lane & 15, g = lane >> 4;
#pragma unroll
    for (int h = 0; h < 2; ++h) {
#pragma unroll
        for (int d4 = 0; d4 < 4; ++d4) {
            *(LAS f32x4*)(sc + r16 * EPI_PITCH + (16 * d4 + 4 * g) * 4) = o[4 * h + d4][0] * scale0;
            *(LAS f32x4*)(sc + (16 + r16) * EPI_PITCH + (16 * d4 + 4 * g) * 4) = o[4 * h + d4][1] * scale1;
        }
        asm volatile("" ::: "memory");
#pragma unroll
        for (int i = 0; i < 4; ++i) {
            const int rr = 8 * i + (lane >> 3), c8 = lane & 7;
            const f32x4 a = *(const LAS f32x4*)(sc + rr * EPI_PITCH + c8 * 32);
            const f32x4 b = *(const LAS f32x4*)(sc + rr * EPI_PITCH + c8 * 32 + 16);
            unsigned zoff, ooff;
            if (NSA) { zoff = z0 + (unsigned)((rr >> 4) * (N1P * 2) + (rr & 15) * 256); ooff = o0 + (unsigned)((rr >> 4) * (ZW8 * 2) + (rr & 15) * 256); }
            else     { zoff = z0 + (unsigned)(rr * (N3P * 2)); ooff = o0 + (unsigned)(rr * (ZW8 * 2)); }
            const unsigned cb = (unsigned)((64 * h + 8 * c8) * 2);
            if (!dostore) continue;
            const u32x4 zw = *(const u32x4*)(zbase + (zoff + cb));
            float v0 = a[0] * silu_f(bflo(zw.x)), v1 = a[1] * silu_f(bfhi(zw.x)), v2 = a[2] * silu_f(bflo(zw.y)), v3 = a[3] * silu_f(bfhi(zw.y));
            float v4 = b[0] * silu_f(bflo(zw.z)), v5 = b[1] * silu_f(bfhi(zw.z)), v6 = b[2] * silu_f(bflo(zw.w)), v7 = b[3] * silu_f(bfhi(zw.w));
            if (RMW) { const u32x4 pv = *(const u32x4*)(obase + (ooff + cb));
                v0 += bflo(pv.x); v1 += bfhi(pv.x); v2 += bflo(pv.y); v3 += bfhi(pv.y); v4 += bflo(pv.z); v5 += bfhi(pv.z); v6 += bflo(pv.w); v7 += bfhi(pv.w); }
            if (F8) { u32x2 w8; w8.x = pk4_fp8c(v0 * o8s, v1 * o8s, v2 * o8s, v3 * o8s); w8.y = pk4_fp8c(v4 * o8s, v5 * o8s, v6 * o8s, v7 * o8s);
                *(u32x2*)(o8base + ((ooff + cb) >> 1)) = w8; if (F8 == 1) continue; }
            u32x4 w; w.x = pk2(v0, v1); w.y = pk2(v2, v3); w.z = pk2(v4, v5); w.w = pk2(v6, v7);
            if (F8 != 2 || both) *(u32x4*)(obase + (ooff + cb)) = w;
        }
        asm volatile("" ::: "memory");
    }
}
DI float sum_g(float v) { v += __shfl_xor(v, 16); v += __shfl_xor(v, 32); return v; }

DI void phase_nsa_attn(LAS unsigned char* lds, const Params& P, int bid, int nb) {
    const char* Y0c = (const char*)(P.ws + OFF_Y0);
    const char* KSc = (const char*)(P.ws + OFF_KS); const char* KWc = (const char*)(P.ws + OFF_KW);
    const char* VTSc = (const char*)(P.ws + OFF_VTS); const char* VTWc = (const char*)(P.ws + OFF_VTW);
    const char* KCc = (const char*)(P.ws + OFF_KC); const char* VTCc = (const char*)(P.ws + OFF_VTC);
    char* ONc = (char*)(P.ws + OFF_O);
    LAS float* lut = (LAS float*)(lds + L_LUT);
    const int total = BATCH * NG * 256;
    {
        const int tid0 = tid_opaque();
        __syncthreads();
        for (int i = tid0; i < 64 * 128; i += 512) { const int hd = i >> 7, d = i & 127; lut[hd * LUT_PITCH + d] = (P.rel_bias[t5_bucket(d) * NH + hd] - P.rel_bias[31 * NH + hd]) * LOG2E; }
        __syncthreads();
    }
    for (int u_ = bid; u_ < total * PROBE3_UNITS; u_ += nb) {
        const int u = (u_ >= total) ? u_ - total : u_;
        int tid = threadIdx.x; asm volatile("" : "+v"(tid));
        const int lane = tid & 63, wid = __builtin_amdgcn_readfirstlane(tid >> 6);
        const int pair = u >> 8; int c = u & 255; if (pair & 1) c = 255 - c;
        const int b = pair >> 2, gg = pair & 3, t0 = c * 16;
        __syncthreads();
        AttnLane3 A;
        A.r16 = lane & 15; A.g = lane >> 4;
        A.tw0 = t0 + 2 * wid; A.tw1 = A.tw0 + 1;
        const int hh = gg * NR + A.r16;
        A.lutrow = lut + hh * LUT_PITCH;
        A.curblk = t0 >> 6; A.tokbase = 2 * wid; A.mk0 = 0ull; A.mk1 = 0ull; A.carry[0] = 0.f; A.carry[1] = 0.f;
        const unsigned ytok0 = (unsigned)(b * SEQ + A.tw0) * (unsigned)(N1P * 2);
        const unsigned otok0 = ((unsigned)(b * SEQ + A.tw0) * (unsigned)ZW8 + (unsigned)(gg * NR * DV)) * 2u;
        const int bg = b * NG + gg;
        const int nct = (t0 + 15 >= 31) ? (((t0 + 15 - 31) >> 4) / 64 + 1) : 0;
        if (ATT3_HOIST && nct > 0) attn_issue_first(lds, KCc + (size_t)bg * 256 * DK * 2, VTCc + (size_t)bg * DV * 256 * 2, 256, 0);
        bf16x8 q[2][6];
#pragma unroll
        for (int qb = 0; qb < 2; ++qb) {
            const unsigned qo = ytok0 + (unsigned)(qb * (N1P * 2)) + (unsigned)((C_Q + hh * DK + 8 * A.g) * 2);
            float ss = 0.f;
#pragma unroll
            for (int ds = 0; ds < 6; ++ds) { q[qb][ds] = *(const bf16x8*)(Y0c + (qo + 64u * ds));
                const u32x4 w = __builtin_bit_cast(u32x4, q[qb][ds]);
                const float a0 = bflo(w.x), a1 = bfhi(w.x), a2 = bflo(w.y), a3 = bfhi(w.y), a4 = bflo(w.z), a5 = bfhi(w.z), a6 = bflo(w.w), a7 = bfhi(w.w);
                ss += (a0 * a0 + a1 * a1) + (a2 * a2 + a3 * a3) + (a4 * a4 + a5 * a5) + (a6 * a6 + a7 * a7); }
            ss = sum_g(ss);
            const float rstd = rsqrtf(ss * (1.0f / DK) + EPSN) * QSCALE;
#pragma unroll
            for (int ds = 0; ds < 6; ++ds) { const float* gn = P.nsa_q_norm + 32 * ds + 8 * A.g; const f32x4 g0 = *(const f32x4*)gn, g1 = *(const f32x4*)(gn + 4);
                u32x4 w = __builtin_bit_cast(u32x4, q[qb][ds]);
                w.x = pk2(bflo(w.x) * rstd * g0[0], bfhi(w.x) * rstd * g0[1]); w.y = pk2(bflo(w.y) * rstd * g0[2], bfhi(w.y) * rstd * g0[3]);
                w.z = pk2(bflo(w.z) * rstd * g1[0], bfhi(w.z) * rstd * g1[1]); w.w = pk2(bflo(w.w) * rstd * g1[2], bfhi(w.w) * rstd * g1[3]);
                q[qb][ds] = __builtin_bit_cast(bf16x8, w); }
        }
        f32x4 o[8][2]; float m_run[2], l_run[2];
#define RESET_STATE() do { _Pragma("unroll") for (int d_ = 0; d_ < 8; ++d_) { o[d_][0] = (f32x4){0.f, 0.f, 0.f, 0.f}; o[d_][1] = (f32x4){0.f, 0.f, 0.f, 0.f}; } m_run[0] = 0.f; m_run[1] = 0.f; l_run[0] = 0.f; l_run[1] = 0.f; } while (0)
#define GATE_SIG(x, qb) (1.0f / (1.0f + __expf(-bf1(*(const bf16_t*)(Y0c + (ytok0 + (unsigned)((qb) * (N1P * 2)) + (unsigned)((C_G + (x) * NH + hh) * 2)))))))
        RESET_STATE();
        attn_pass3x<MODE_CMPX>(lds, KCc + (size_t)bg * 256 * DK * 2, VTCc + (size_t)bg * DV * 256 * 2, 256, 0, nct, q, o, m_run, l_run, A, ATT3_HOIST != 0);
        { const float lt0 = sum_g(l_run[0]), lt1 = sum_g(l_run[1]); const float il0 = lt0 > 0.f ? 1.0f / lt0 : 0.f, il1 = lt1 > 0.f ? 1.0f / lt1 : 0.f;
          if (lane < 16) { ((LAS float*)(lds + L_IL))[(A.tokbase + 0) * 16 + A.r16] = il0; ((LAS float*)(lds + L_IL))[(A.tokbase + 1) * 16 + A.r16] = il1; }
          attn_epilogue3<false, true>(lds, lane, wid, o, GATE_SIG(0, 0) * il0, GATE_SIG(0, 1) * il1, Y0c, ytok0 + (unsigned)((C_ZC + gg * NR * DV) * 2), ONc, otok0, PROBE3_STORE2 || u_ < total); }
        __syncthreads();
        if (ATT3_HOIST) attn_issue_first(lds, KSc + (size_t)bg * SEQ * DK * 2, VTSc + (size_t)bg * DV * SEQ * 2, SEQ, 0);
        {
            const int cur = A.curblk;
            unsigned long long mk[2];
#pragma unroll
            for (int t = 0; t < 2; ++t) {
                const LAS bf16_t* X = (const LAS bf16_t*)(lds + L_X) + (2 * wid + t) * 16 * 64;
                const LAS float* IL = (const LAS float*)(lds + L_IL) + (2 * wid + t) * 16;
                const bool forced = (lane == 0) || (lane == cur) || (lane == cur - 1);
                const bool future = lane > cur;
                float v = 0.f;
                if (!forced && !future) {
#pragma unroll
                    for (int rr = 0; rr < 16; ++rr) v += IL[rr] * bf1(X[rr * 64 + lane]); }
                unsigned key = (__float_as_uint(v) & ~63u);
                if (forced) key = 0x7f800000u; else if (future) key = 0u;
                key |= (unsigned)(63 - lane);
                int rank = 0;
#pragma unroll
                for (int jp = 0; jp < 64; ++jp) { const unsigned kj = (unsigned)__builtin_amdgcn_readlane((int)key, jp); rank += (kj > key) ? 1 : 0; }
                mk[t] = __ballot(rank < 16 && !future);
            }
            A.mk0 = mk[0]; A.mk1 = mk[1];
        }
        RESET_STATE();
        attn_pass3x<MODE_SEL>(lds, KSc + (size_t)bg * SEQ * DK * 2, VTSc + (size_t)bg * DV * SEQ * 2, SEQ, 0, A.curblk + 1, q, o, m_run, l_run, A, ATT3_HOIST != 0);
        { const float lt0 = sum_g(l_run[0]), lt1 = sum_g(l_run[1]);
          attn_epilogue3<true, true>(lds, lane, wid, o, GATE_SIG(1, 0) / lt0, GATE_SIG(1, 1) / lt1, Y0c, ytok0 + (unsigned)((C_ZS + gg * NR * DV) * 2), ONc, otok0, PROBE3_STORE2 || u_ < total); }
        __syncthreads();
        RESET_STATE();
        { const int jl = (t0 - 511) > 0 ? (t0 - 511) >> 6 : 0, jh = ((t0 + 15) >> 6) + 1;
          for (int prb_ = 0; prb_ < PROBE3_WIN; ++prb_) attn_pass3x<MODE_WIN>(lds, KWc + (size_t)bg * SEQ * DK * 2, VTWc + (size_t)bg * DV * SEQ * 2, SEQ, jl, jh, q, o, m_run, l_run, A); }
        { const float lt0 = sum_g(l_run[0]), lt1 = sum_g(l_run[1]);
          attn_epilogue3<true, true, USE_FP8N ? 2 : 0>(lds, lane, wid, o, GATE_SIG(2, 0) / lt0, GATE_SIG(2, 1) / lt1, Y0c, ytok0 + (unsigned)((C_ZW + gg * NR * DV) * 2), ONc, otok0, PROBE3_STORE2 || u_ < total, (char*)(P.ws + OFF_O8N), O8N_SCALE, t0 < 256); }
#undef RESET_STATE
#undef GATE_SIG
    }
}

DI void phase_mla_attn(LAS unsigned char* lds, const Params& P, int bid, int nb) {
    const char* QMc = (const char*)(P.ws + OFF_QM); const char* KMc = (const char*)(P.ws + OFF_KM); const char* VTMc = (const char*)(P.ws + OFF_VTM);
    const char* Y1c = (const char*)(P.ws + OFF_Y1); char* OMc = (char*)(P.ws + OFF_O);
    const int total = BATCH * NH * 16;
    for (int uu = 0; bid + (uu >> 1) * nb < total / 2; ++uu) {
        int tid = threadIdx.x; asm volatile("" : "+v"(tid));
        const int lane = tid & 63, wid = __builtin_amdgcn_readfirstlane(tid >> 6);
        const int item = bid + (uu >> 1) * nb, second = uu & 1;
        const int xcd = item & 7, tt = item >> 3, p = tt & 7, hl = (tt >> 3) & 3, rnd = tt >> 5;
        const int bh = rnd * 32 + xcd * 4 + hl, qblk = second ? p : 15 - p, b = bh >> 6, h = bh & 63, t0 = qblk * 256;
        AttnLane3 A;
        A.r16 = lane & 15; A.g = lane >> 4;
        A.tw0 = t0 + 32 * wid; A.tw1 = A.tw0 + 31;
        A.lutrow = nullptr; A.curblk = 0; A.tokbase = 0; A.mk0 = 0ull; A.mk1 = 0ull; A.carry[0] = 0.f; A.carry[1] = 0.f;
        bf16x8 q[2][6];
#pragma unroll
        for (int qb = 0; qb < 2; ++qb) {
            const unsigned trow = (unsigned)(b * SEQ + A.tw0 + 16 * qb + A.r16);
            const unsigned qo = (trow * (unsigned)NQB + (unsigned)(h * DK + 8 * A.g)) * 2u;
            float ss = 0.f;
#pragma unroll
            for (int ds = 0; ds < 6; ++ds) { q[qb][ds] = *(const bf16x8*)(QMc + (qo + 64u * ds));
                const u32x4 w = __builtin_bit_cast(u32x4, q[qb][ds]);
                const float a0 = bflo(w.x), a1 = bfhi(w.x), a2 = bflo(w.y), a3 = bfhi(w.y), a4 = bflo(w.z), a5 = bfhi(w.z), a6 = bflo(w.w), a7 = bfhi(w.w);
                ss += (a0 * a0 + a1 * a1) + (a2 * a2 + a3 * a3) + (a4 * a4 + a5 * a5) + (a6 * a6 + a7 * a7); }
            ss = sum_g(ss);
            const float rstd = rsqrtf(ss * (1.0f / DK) + EPSN);
            const float* ropep = (const float*)(P.ws + OFF_ROPE) + (size_t)trow * 64;
#pragma unroll
            for (int ds = 0; ds < 4; ++ds) { const float* gn = P.mla_q_norm + 32 * ds + 8 * A.g; const f32x4 g0 = *(const f32x4*)gn, g1 = *(const f32x4*)(gn + 4);
                const float sc = rstd * QSCALE;
                u32x4 w = __builtin_bit_cast(u32x4, q[qb][ds]);
                w.x = pk2(bflo(w.x) * sc * g0[0], bfhi(w.x) * sc * g0[1]); w.y = pk2(bflo(w.y) * sc * g0[2], bfhi(w.y) * sc * g0[3]);
                w.z = pk2(bflo(w.z) * sc * g1[0], bfhi(w.z) * sc * g1[1]); w.w = pk2(bflo(w.w) * sc * g1[2], bfhi(w.w) * sc * g1[3]);
                q[qb][ds] = __builtin_bit_cast(bf16x8, w); }
            {
                const int i0 = 8 * A.g;
                const float* g1p = P.mla_q_norm + 128 + i0; const float* g2p = P.mla_q_norm + 160 + i0;
                const u32x4 w1 = __builtin_bit_cast(u32x4, q[qb][4]), w2 = __builtin_bit_cast(u32x4, q[qb][5]);
                float x1[8] = {bflo(w1.x), bfhi(w1.x), bflo(w1.y), bfhi(w1.y), bflo(w1.z), bfhi(w1.z), bflo(w1.w), bfhi(w1.w)};
                float x2[8] = {bflo(w2.x), bfhi(w2.x), bflo(w2.y), bfhi(w2.y), bflo(w2.z), bfhi(w2.z), bflo(w2.w), bfhi(w2.w)};
                float y1[8], y2[8];
#pragma unroll
                for (int e = 0; e < 8; ++e) { const float cs = ropep[i0 + e], sn = ropep[32 + i0 + e];
                    const float a = x1[e] * rstd * g1p[e], c = x2[e] * rstd * g2p[e];
                    y1[e] = (a * cs - c * sn) * QSCALE; y2[e] = (c * cs + a * sn) * QSCALE; }
                u32x4 o1, o2;
                o1.x = pk2(y1[0], y1[1]); o1.y = pk2(y1[2], y1[3]); o1.z = pk2(y1[4], y1[5]); o1.w = pk2(y1[6], y1[7]);
                o2.x = pk2(y2[0], y2[1]); o2.y = pk2(y2[2], y2[3]); o2.z = pk2(y2[4], y2[5]); o2.w = pk2(y2[6], y2[7]);
                q[qb][4] = __builtin_bit_cast(bf16x8, o1); q[qb][5] = __builtin_bit_cast(bf16x8, o2);
            }
        }
        f32x4 o[8][2]; float m_run[2] = {0.f, 0.f}, l_run[2] = {0.f, 0.f};
#pragma unroll
        for (int d = 0; d < 8; ++d) { o[d][0] = (f32x4){0.f, 0.f, 0.f, 0.f}; o[d][1] = (f32x4){0.f, 0.f, 0.f, 0.f}; }
        attn_pass3x<MODE_MLA>(lds, KMc + (size_t)bh * SEQ * DK * 2, VTMc + (size_t)bh * DV * SEQ * 2, SEQ, 0, 4 * qblk + 4, q, o, m_run, l_run, A);
        const float lt0 = sum_g(l_run[0]), lt1 = sum_g(l_run[1]);
        { const unsigned t0w = (unsigned)(b * SEQ + A.tw0);
          const unsigned zo_ = (t0w * (unsigned)N3P + (unsigned)(C3_Z + h * DV)) * 2u, oo_ = (t0w * (unsigned)ZW8 + (unsigned)(h * DV)) * 2u;
          if (USE_FP8O && qblk != 0) attn_epilogue3<false, false, 1>(lds, lane, wid, o, 1.0f / lt0, 1.0f / lt1, Y1c, zo_, OMc, oo_, true, (char*)(P.ws + OFF_O8M), O8_SCALE);
          else attn_epilogue3<false, false, 0>(lds, lane, wid, o, 1.0f / lt0, 1.0f / lt1, Y1c, zo_, OMc, oo_); }
        __syncthreads();
    }
}
constexpr int LDS_KN_OFF = 135168, LDS_ST_OFF = LDS_KN_OFF + 16384, LDS_BYTES = LDS_ST_OFF + 16;
constexpr int NPHASE = 14;

#ifndef PROBE_G1F8
#define PROBE_G1F8 0
#endif
#ifndef PROBE_G1F8_NOSTORE
#define PROBE_G1F8_NOSTORE 0
#endif
#ifndef TAIL_IN_P6
#define TAIL_IN_P6 USE_FP8N
#endif
#ifndef EPI_LINE128
#define EPI_LINE128 0
#endif
#ifndef VT_IN_P3
#define VT_IN_P3 0
#endif
#ifndef USE_FP8M
#define USE_FP8M 0
#endif
#ifndef USE_FP8Z
#define USE_FP8Z 0
#endif
#ifndef DUP5
#define DUP5 0
#endif
#ifndef P3_GEMM_REP
#define P3_GEMM_REP 1
#endif
#ifndef P3_WCONV_REP
#define P3_WCONV_REP 1
#endif
DI void tail_wconv(LAS unsigned char* lds, const Params& P, int bid, int nb) {
    unsigned char* ws = P.ws;
    if (bid >= 64 && nb > 64) {
        phase_wconv(lds, P.mla_w_q_b, (bf16_t*)(ws + OFF_W4T), QLORA, NQB, NQB, bid - 64, nb - 64, 0.f, 0, USE_FP8Q ? (unsigned char*)(ws + OFF_W48) : nullptr, 0);
        phase_wconv(lds, P.mla_w_kv_b, (bf16_t*)(ws + OFF_W5K), KVLORA, NKVB / 2, NKVB / 2, bid - 64, nb - 64, 0.f, 2, USE_FP8KV ? (unsigned char*)(ws + OFF_W5K8) : nullptr, 0);
        phase_wconv(lds, P.mla_w_kv_b, (bf16_t*)(ws + OFF_W5V), KVLORA, NKVB / 2, NKVB / 2, bid - 64, nb - 64, 0.f, 1, USE_FP8KV ? (unsigned char*)(ws + OFF_W5V8) : nullptr, 0);
        phase_wconv(lds, P.mla_w_out, (bf16_t*)(ws + OFF_W6T), ZW8, DM, DM, bid - 64, nb - 64, (FP8EMU & 2) ? 64.0f : 0.f, 0, USE_FP8O ? (unsigned char*)(ws + OFF_W68) : nullptr, 0);
    } else if (nb <= 64) {
        phase_wconv(lds, P.mla_w_q_b, (bf16_t*)(ws + OFF_W4T), QLORA, NQB, NQB, bid, nb, 0.f, 0, USE_FP8Q ? (unsigned char*)(ws + OFF_W48) : nullptr, 0);
        phase_wconv(lds, P.mla_w_kv_b, (bf16_t*)(ws + OFF_W5K), KVLORA, NKVB / 2, NKVB / 2, bid, nb, 0.f, 2, USE_FP8KV ? (unsigned char*)(ws + OFF_W5K8) : nullptr, 0);
        phase_wconv(lds, P.mla_w_kv_b, (bf16_t*)(ws + OFF_W5V), KVLORA, NKVB / 2, NKVB / 2, bid, nb, 0.f, 1, USE_FP8KV ? (unsigned char*)(ws + OFF_W5V8) : nullptr, 0);
        phase_wconv(lds, P.mla_w_out, (bf16_t*)(ws + OFF_W6T), ZW8, DM, DM, bid, nb, (FP8EMU & 2) ? 64.0f : 0.f, 0, USE_FP8O ? (unsigned char*)(ws + OFF_W68) : nullptr, 0);
    }
}
template <int PH>
DI void run_phase(const Params& P, LAS unsigned char* lds, int bid, int nb) {
    unsigned char* ws = P.ws;
    if constexpr (PH == 0) {
        phase_wconv(lds, P.nsa_w_in, (bf16_t*)(ws + OFF_W1T), DM, N1, N1P, bid, nb, (FP8EMU & 4) ? 64.0f : 0.f, 0, USE_FP8Z ? (unsigned char*)(ws + OFF_B8) : nullptr, F8_Q0 * 256, (F8_Q0 + F8_NQ) * 256);
        phase_wconv(lds, P.w1_k, (bf16_t*)(ws + OFF_W1K), 6144, 192, 256, bid, nb);
        phase_wconv(lds, P.w1_v, (bf16_t*)(ws + OFF_W1V), 4096, 128, 256, bid, nb);
        phase_rmsnorm(P.x, P.norm_w, (bf16_t*)(ws + OFF_H), bid, nb, (FP8EMU & 4) ? 16.0f : 0.f, USE_FP8Z ? (unsigned char*)(ws + OFF_A8) : nullptr);
    } else if constexpr (PH == 1) {
        if (USE_FP8Z) {
            {
                pg8::Gemm g{(const bf16_t*)(ws + OFF_H), (const bf16_t*)(ws + OFF_W1T), MTOK, N1P, DM};
                pg8::OrderBf16Part S{nb, bid, F8_Q0, F8_NQ, N1P / 256 - F8_NQ};
                pg8::EpiStoreBf16 E{(bf16_t*)(ws + OFF_Y0), N1P};
                pg8::gemm_phase<pg8::EpiStoreBf16, pg8::OrderBf16Part, false>(lds, g, S, E, nullptr, GEMM_STAG);
            }
            __syncthreads();
            {
                pg8::Gemm g{(const bf16_t*)(ws + OFF_A8), (const bf16_t*)(ws + OFF_B8), MTOK, N1P, DM / 2};
                pg8::OrderFp8Part S{nb, bid, F8_Q0, F8_NQ, N1P / 256 - F8_NQ, (256 - ((F8_NQ * 64 + (N1P / 256 - F8_NQ) * 4) & 255)) & 255};
#if EPI_LINE128
                pg8::EpiStoreBf16Fp8L E{(bf16_t*)(ws + OFF_Y0), N1P, 1.0f / (16.0f * 64.0f)};
                pg8::gemm_phase<pg8::EpiStoreBf16Fp8L, pg8::OrderFp8Part, false>(lds, g, S, E, nullptr);
#else
                pg8::EpiStoreBf16Fp8 E{(bf16_t*)(ws + OFF_Y0), N1P, 1.0f / (16.0f * 64.0f)};
                pg8::gemm_phase<pg8::EpiStoreBf16Fp8, pg8::OrderFp8Part, false>(lds, g, S, E, nullptr);
#endif
            }
        } else {
        pg8::Gemm g{(const bf16_t*)(ws + OFF_H), (const bf16_t*)(ws + OFF_W1T), MTOK, N1P, DM};
        pg8::StaticOrder S; S.init(g.M, g.N, nb, bid);
        pg8::EpiStoreBf16 E{(bf16_t*)(ws + OFF_Y0), N1P};
        pg8::gemm_phase<pg8::EpiStoreBf16, pg8::StaticOrder, false>(lds, g, S, E, nullptr);
        }
    } else if constexpr (PH == 2) {
        phase_nsa_prep(P, bid, nb);
        if (!VT_IN_P3 || nb <= 32) {
        phase_vt(lds, (const bf16_t*)(ws + OFF_Y0), N1P, C_KVS + NG * DK, DV, NG, (bf16_t*)(ws + OFF_VTS), bid, nb);
        phase_vt(lds, (const bf16_t*)(ws + OFF_Y0), N1P, C_KVW + NG * DK, DV, NG, (bf16_t*)(ws + OFF_VTW), bid, nb);
        }
    } else if constexpr (PH == 3) {
        for (int p3g_ = 0; p3g_ < ((bid < 32) ? P3_GEMM_REP : P3_WCONV_REP); ++p3g_) { if (p3g_) __syncthreads();
        if (bid < 16) {
            pg8::Gemm g{(const bf16_t*)(ws + OFF_ACK), (const bf16_t*)(ws + OFF_W1K), 4096, 256, 6144};
            pg8::StaticOrder S; S.init(g.M, g.N, 16, bid);
            pg8::EpiPlainF32 E{(float*)(ws + OFF_HIDK), 256};
            pg8::gemm_phase<pg8::EpiPlainF32, pg8::StaticOrder, false>(lds, g, S, E, nullptr);
        } else if (bid < 32) {
            pg8::Gemm g{(const bf16_t*)(ws + OFF_ACV), (const bf16_t*)(ws + OFF_W1V), 4096, 256, 4096};
            pg8::StaticOrder S; S.init(g.M, g.N, 16, bid - 16);
            pg8::EpiPlainF32 E{(float*)(ws + OFF_HIDV), 256};
            pg8::gemm_phase<pg8::EpiPlainF32, pg8::StaticOrder, false>(lds, g, S, E, nullptr);
        } else {
            if (VT_IN_P3 && p3g_ == 0) {
                phase_vt(lds, (const bf16_t*)(ws + OFF_Y0), N1P, C_KVS + NG * DK, DV, NG, (bf16_t*)(ws + OFF_VTS), bid - 32, nb - 32);
                phase_vt(lds, (const bf16_t*)(ws + OFF_Y0), N1P, C_KVW + NG * DK, DV, NG, (bf16_t*)(ws + OFF_VTW), bid - 32, nb - 32);
                __syncthreads();
            }
            phase_wconv(lds, P.nsa_w_out, (bf16_t*)(ws + OFF_W2T), ZW8, DM, DM, bid - 32, nb - 32, (FP8EMU & 1) ? 64.0f : 0.f, 0, USE_FP8N ? (unsigned char*)(ws + OFF_W28) : nullptr, 0);
            phase_wconv(lds, P.mla_w_in, (bf16_t*)(ws + OFF_W3T), DM, N3, N3P, bid - 32, nb - 32, (FP8EMU & 8) ? 64.0f : 0.f, 0, USE_FP8M ? (unsigned char*)(ws + OFF_B8M) : nullptr, 0, C3_Z8);
        }
        }
    } else if constexpr (PH == 4) {
        phase_cmp2(lds, P, bid, nb);
    } else if constexpr (PH == 5) {
        { float* ss1 = (float*)(ws + OFF_SS1); for (int i = bid * 512 + (int)threadIdx.x; i < MTOK; i += nb * 512) ss1[i] = 0.f; }
        phase_nsa_attn(lds, P, bid, nb);
    } else if constexpr (PH == 6) {
        if (USE_FP8N) {
            {
                pg8::Gemm g{(const bf16_t*)(ws + OFF_O), (const bf16_t*)(ws + OFF_W2T), MTOK, DM, ZW8};
                pg8::OrderBf16Part S{nb, bid, 0, 0, DM / 256};
                pg8::EpiResNorm E{P.x, P.out, DM, P.norm_w + DM, (bf16_t*)(ws + OFF_H), (float*)(ws + OFF_SS1), USE_FP8M ? (unsigned char*)(ws + OFF_A8M) : nullptr, 1.0f};
                pg8::gemm_phase<pg8::EpiResNorm, pg8::OrderBf16Part, false>(lds, g, S, E, nullptr);
            }
            __syncthreads();
            {
                pg8::Gemm g{(const bf16_t*)(ws + OFF_O8N), (const bf16_t*)(ws + OFF_W28), MTOK, DM, ZW8 / 2};
                pg8::OrderFp8Part S{nb, bid, 0, 0, DM / 256, 192};
                pg8::EpiResNormFp8 E{P.x, P.out, DM, P.norm_w + DM, (bf16_t*)(ws + OFF_H), (float*)(ws + OFF_SS1), USE_FP8M ? (unsigned char*)(ws + OFF_A8M) : nullptr, 1.0f / (O8N_SCALE * 64.0f)};
                pg8::gemm_phase<pg8::EpiResNormFp8, pg8::OrderFp8Part, false>(lds, g, S, E, nullptr);
            }
            __syncthreads();
            if (TAIL_IN_P6) tail_wconv(lds, P, bid, nb);
        } else {
        pg8::Gemm g{(const bf16_t*)(ws + OFF_O), (const bf16_t*)(ws + OFF_W2T), MTOK, DM, ZW8};
        pg8::StaticOrder S; S.init(g.M, g.N, nb, bid);
        pg8::EpiResNorm E{P.x, P.out, DM, P.norm_w + DM, (bf16_t*)(ws + OFF_H), (float*)(ws + OFF_SS1), USE_FP8M ? (unsigned char*)(ws + OFF_A8M) : nullptr, 1.0f};
        pg8::gemm_phase<pg8::EpiResNorm, pg8::StaticOrder, false>(lds, g, S, E, nullptr);
        }
    } else if constexpr (PH == 7) {
        phase_rmsnorm(P.out, P.norm_w + DM, (bf16_t*)(ws + OFF_H), bid, nb, (FP8EMU & 8) ? 16.0f : 0.f);
    } else if constexpr (PH == 8) {
        if (USE_FP8M) {
            {
                pg8::Gemm g{(const bf16_t*)(ws + OFF_H), (const bf16_t*)(ws + OFF_W3T), MTOK, N3P, DM};
                pg8::OrderBf16Part S{nb, bid, 0, C3_Z8 / 256, NZ8M / 256};
                pg8::EpiStoreBf16RowScale E{(bf16_t*)(ws + OFF_Y1), N3P, (const float*)(ws + OFF_SS1), 1.0f / DM};
                pg8::gemm_phase<pg8::EpiStoreBf16RowScale, pg8::OrderBf16Part, false>(lds, g, S, E, nullptr);
            }
            __syncthreads();
            {
                pg8::Gemm g{(const bf16_t*)(ws + OFF_A8M), (const bf16_t*)(ws + OFF_B8M), MTOK, N3P, DM / 2};
                pg8::OrderFp8PartP8 S{nb, bid};
                pg8::EpiStoreBf16RowScaleFp8 E{(bf16_t*)(ws + OFF_Y1), N3P, (const float*)(ws + OFF_SS1), 1.0f / DM, 1.0f / (16.0f * 64.0f)};
                pg8::gemm_phase<pg8::EpiStoreBf16RowScaleFp8, pg8::OrderFp8PartP8, false>(lds, g, S, E, nullptr);
            }
        } else {
        pg8::Gemm g{(const bf16_t*)(ws + OFF_H), (const bf16_t*)(ws + OFF_W3T), MTOK, N3P, DM};
        pg8::StaticOrder S; S.init(g.M, g.N, nb, bid);
        pg8::EpiStoreBf16RowScale E{(bf16_t*)(ws + OFF_Y1), N3P, (const float*)(ws + OFF_SS1), 1.0f / DM};
        pg8::gemm_phase<pg8::EpiStoreBf16RowScale, pg8::StaticOrder, false>(lds, g, S, E, nullptr);
        }
        __syncthreads();
        if (!TAIL_IN_P6) tail_wconv(lds, P, bid, nb);
    } else if constexpr (PH == 9) {
        phase_mla_prep1(P, bid, nb);
    } else if constexpr (PH == 10) {
        if (USE_FP8Q) {
            {
                pg8::Gemm g{(const bf16_t*)(ws + OFF_CQN), (const bf16_t*)(ws + OFF_W4T), MTOK, NQB, QLORA};
                pg8::OrderBf16Part S{nb, bid, 0, 0, NQB / 256};
                pg8::EpiStoreBf16 E{(bf16_t*)(ws + OFF_QM), NQB};
                pg8::gemm_phase<pg8::EpiStoreBf16, pg8::OrderBf16Part, false>(lds, g, S, E, nullptr);
            }
            __syncthreads();
            {
                pg8::Gemm g{(const bf16_t*)(ws + OFF_CQN8), (const bf16_t*)(ws + OFF_W48), MTOK, NQB, QLORA / 2};
                pg8::OrderFp8Part S{nb, bid, 0, 0, NQB / 256, 64};
                pg8::EpiStoreBf16Fp8 E{(bf16_t*)(ws + OFF_QM), NQB, 1.0f / (16.0f * 64.0f)};
                pg8::gemm_phase<pg8::EpiStoreBf16Fp8, pg8::OrderFp8Part, false>(lds, g, S, E, nullptr);
            }
        } else {
            pg8::Gemm g{(const bf16_t*)(ws + OFF_CQN), (const bf16_t*)(ws + OFF_W4T), MTOK, NQB, QLORA};
            pg8::StaticOrder S; S.init(g.M, g.N, nb, bid);
            pg8::EpiStoreBf16 E{(bf16_t*)(ws + OFF_QM), NQB};
            pg8::gemm_phase<pg8::EpiStoreBf16, pg8::StaticOrder, false>(lds, g, S, E, nullptr);
        }
        __syncthreads();
        if (USE_FP8KV) {
            {
                pg8::Gemm g{(const bf16_t*)(ws + OFF_CKVN), (const bf16_t*)(ws + OFF_W5K), MTOK, NKVB / 2, KVLORA};
                pg8::OrderBf16Part S{nb, bid, 0, 0, NKVB / 512};
                pg8::EpiKNorm E{(bf16_t*)(ws + OFF_KM), (const float*)(ws + OFF_SSPE), (const float*)(ws + OFF_KPER), P.mla_k_norm, (LAS float*)(lds + LDS_KN_OFF), 0u, 1.0f};
                pg8::gemm_phase<pg8::EpiKNorm, pg8::OrderBf16Part, false>(lds, g, S, E, nullptr);
            }
            __syncthreads();
            {
                pg8::Gemm g{(const bf16_t*)(ws + OFF_W5V), (const bf16_t*)(ws + OFF_CKVN), NKVB / 2, MTOK, KVLORA};
                pg8::OrderSwap<pg8::OrderBf16Part> S{{nb, (bid + 128) & 255, 0, 0, NKVB / 512}};
                pg8::EpiVT E{(bf16_t*)(ws + OFF_VTM), 1.0f};
                pg8::gemm_phase<pg8::EpiVT, pg8::OrderSwap<pg8::OrderBf16Part>, false>(lds, g, S, E, nullptr);
            }
            __syncthreads();
            {
                pg8::Gemm g{(const bf16_t*)(ws + OFF_CKVN8), (const bf16_t*)(ws + OFF_W5K8), MTOK, NKVB / 2, KVLORA / 2};
                pg8::OrderFp8Part S{nb, bid, 0, 0, NKVB / 512, 0};
                pg8::EpiKNormFp8 E{(bf16_t*)(ws + OFF_KM), (const float*)(ws + OFF_SSPE), (const float*)(ws + OFF_KPER), P.mla_k_norm, (LAS float*)(lds + LDS_KN_OFF), 0u, 1.0f / (16.0f * 64.0f)};
                pg8::gemm_phase<pg8::EpiKNormFp8, pg8::OrderFp8Part, false>(lds, g, S, E, nullptr);
            }
            __syncthreads();
            {
                pg8::Gemm g{(const bf16_t*)(ws + OFF_W5V8), (const bf16_t*)(ws + OFF_CKVN8), NKVB / 2, MTOK, KVLORA / 2};
                pg8::OrderSwap<pg8::OrderFp8Part> S{{nb, bid, 0, 0, NKVB / 512, 128}};
                pg8::EpiVTFp8 E{(bf16_t*)(ws + OFF_VTM), 1.0f / (16.0f * 64.0f)};
                pg8::gemm_phase<pg8::EpiVTFp8, pg8::OrderSwap<pg8::OrderFp8Part>, false>(lds, g, S, E, nullptr);
            }
        } else {
        {
            pg8::Gemm g{(const bf16_t*)(ws + OFF_CKVN), (const bf16_t*)(ws + OFF_W5K), MTOK, NKVB / 2, KVLORA};
            pg8::StaticOrder S; S.init(g.M, g.N, nb, bid);
            pg8::EpiKNorm E{(bf16_t*)(ws + OFF_KM), (const float*)(ws + OFF_SSPE), (const float*)(ws + OFF_KPER), P.mla_k_norm, (LAS float*)(lds + LDS_KN_OFF), 0u, 1.0f};
            pg8::gemm_phase<pg8::EpiKNorm, pg8::StaticOrder, false>(lds, g, S, E, nullptr);
        }
        __syncthreads();
        {
            pg8::Gemm g{(const bf16_t*)(ws + OFF_W5V), (const bf16_t*)(ws + OFF_CKVN), NKVB / 2, MTOK, KVLORA};
            pg8::StaticOrder S; S.init(g.M, g.N, nb, bid);
            pg8::EpiVT E{(bf16_t*)(ws + OFF_VTM), 1.0f};
            pg8::gemm_phase<pg8::EpiVT, pg8::StaticOrder, false>(lds, g, S, E, nullptr);
        }
        }
    } else if constexpr (PH == 11) {
    } else if constexpr (PH == 12) {
        phase_mla_attn(lds, P, bid, nb);
    } else if constexpr (PH == 13) {
        if (USE_FP8O) {
            {
                pg8::Gemm g{(const bf16_t*)(ws + OFF_O), (const bf16_t*)(ws + OFF_W6T), MTOK, DM, ZW8};
                pg8::OrderBf16Part S{nb, bid, 0, 0, DM / 256};
                pg8::EpiResF32 E{P.out, P.out, DM};
                pg8::gemm_phase<pg8::EpiResF32, pg8::OrderBf16Part, false>(lds, g, S, E, nullptr);
            }
            __syncthreads();
            {
                pg8::Gemm g{(const bf16_t*)(ws + OFF_O8M), (const bf16_t*)(ws + OFF_W68), MTOK, DM, ZW8 / 2};
                pg8::OrderFp8Part S{nb, bid, 0, 0, DM / 256, 192};
                pg8::EpiResF32Fp8 E{P.out, P.out, DM, 1.0f / (O8_SCALE * 64.0f)};
                pg8::gemm_phase<pg8::EpiResF32Fp8, pg8::OrderFp8Part, false>(lds, g, S, E, nullptr);
            }
        } else {
        pg8::Gemm g{(const bf16_t*)(ws + OFF_O), (const bf16_t*)(ws + OFF_W6T), MTOK, DM, ZW8};
        pg8::StaticOrder S; S.init(g.M, g.N, nb, bid);
        pg8::EpiResF32 E{P.out, P.out, DM};
        pg8::gemm_phase<pg8::EpiResF32, pg8::StaticOrder, false>(lds, g, S, E, nullptr);
        }
    }
}

#ifndef REP0
#define REP0 1
#endif
#ifndef REP1
#define REP1 1
#endif
#ifndef REP2
#define REP2 1
#endif
#ifndef REP3
#define REP3 1
#endif
#ifndef REP4
#define REP4 1
#endif
#ifndef REP5
#define REP5 1
#endif
#ifndef REP6
#define REP6 1
#endif
#ifndef REP7
#define REP7 1
#endif
#ifndef REP8
#define REP8 1
#endif
#ifndef REP9
#define REP9 1
#endif
#ifndef REP10
#define REP10 1
#endif
#ifndef REP11
#define REP11 1
#endif
#ifndef REP12
#define REP12 1
#endif
#ifndef REP13
#define REP13 1
#endif

__global__ __launch_bounds__(512, 2) void k_mega(Params P) {
    extern __shared__ __attribute__((aligned(16))) unsigned char shm[];
    LAS unsigned char* lds = (LAS unsigned char*)shm;
    volatile LAS unsigned* st = (volatile LAS unsigned*)(lds + LDS_ST_OFF);
    if (threadIdx.x == 0) { st[0] = 0u; st[1] = 0u; st[2] = 0u; st[3] = 0u; }
    __syncthreads();
    XcdBarrier bar = xcd_barrier_post((unsigned*)(P.ws + OFF_CTL), st);
    const int bid = (int)blockIdx.x, nb = (int)gridDim.x;
    for (int rep_ = 0; rep_ < REP0; ++rep_) run_phase<0>(P, lds, bid, nb);  xcd_barrier(bar);
    for (int rep_ = 0; rep_ < REP1; ++rep_) run_phase<1>(P, lds, bid, nb);  xcd_barrier(bar);
    for (int rep_ = 0; rep_ < REP2; ++rep_) run_phase<2>(P, lds, bid, nb);  xcd_barrier(bar);
    for (int rep_ = 0; rep_ < REP3; ++rep_) run_phase<3>(P, lds, bid, nb);  xcd_barrier(bar);
    for (int rep_ = 0; rep_ < REP4; ++rep_) run_phase<4>(P, lds, bid, nb);  xcd_barrier(bar);
    for (int rep_ = 0; rep_ < REP5; ++rep_) run_phase<5>(P, lds, bid, nb);
#if DUP5
    __syncthreads(); run_phase<5>(P, lds, bid, nb);
#endif
    xcd_barrier(bar);
    for (int rep_ = 0; rep_ < REP6; ++rep_) run_phase<6>(P, lds, bid, nb);  xcd_barrier(bar);
    for (int rep_ = 0; rep_ < REP8; ++rep_) run_phase<8>(P, lds, bid, nb);  xcd_barrier(bar);
    for (int rep_ = 0; rep_ < REP9; ++rep_) run_phase<9>(P, lds, bid, nb);  xcd_barrier(bar);
    for (int rep_ = 0; rep_ < REP10; ++rep_) run_phase<10>(P, lds, bid, nb); xcd_barrier(bar);
    for (int rep_ = 0; rep_ < REP12; ++rep_) run_phase<12>(P, lds, bid, nb); xcd_barrier(bar);
    for (int rep_ = 0; rep_ < REP13; ++rep_) run_phase<13>(P, lds, bid, nb);
}

extern "C" void kernel_launch(void* const* d_in, const int* in_sizes, int n_in, void* d_out, int out_size, void* d_ws, size_t ws_size, hipStream_t stream) {
    (void)in_sizes; (void)n_in; (void)out_size;
    if (ws_size < WS_END) return;
    Params P{};
    P.x = (const float*)d_in[0]; P.pos = (const int*)d_in[1]; P.norm_w = (const float*)d_in[2]; P.rel_bias = (const float*)d_in[3];
    P.nsa_w_in = (const float*)d_in[4]; P.nsa_q_norm = (const float*)d_in[5]; P.nsa_k_norm = (const float*)d_in[6]; P.pe_k = (const float*)d_in[7];
    P.w1_k = (const float*)d_in[8]; P.w2_k = (const float*)d_in[9]; P.pe_v = (const float*)d_in[10]; P.w1_v = (const float*)d_in[11]; P.w2_v = (const float*)d_in[12];
    P.nsa_w_out = (const float*)d_in[13]; P.mla_w_in = (const float*)d_in[14]; P.mla_q_a_norm = (const float*)d_in[15]; P.mla_w_q_b = (const float*)d_in[16];
    P.mla_kv_a_norm = (const float*)d_in[17]; P.mla_w_kv_b = (const float*)d_in[18]; P.mla_q_norm = (const float*)d_in[19]; P.mla_k_norm = (const float*)d_in[20];
    P.mla_w_out = (const float*)d_in[21];
    P.out = (float*)d_out; P.ws = (unsigned char*)d_ws;
    static int grid = 0;
    if (!grid) {
        int dev = 0, cus = 0, per_cu = 0; (void)hipGetDevice(&dev);
        if (hipDeviceGetAttribute(&cus, hipDeviceAttributeMultiprocessorCount, dev) != hipSuccess || cus <= 0) cus = 256;
        (void)hipFuncSetAttribute((const void*)k_mega, hipFuncAttributeMaxDynamicSharedMemorySize, LDS_BYTES);
        if (hipOccupancyMaxActiveBlocksPerMultiprocessor(&per_cu, k_mega, 512, LDS_BYTES) != hipSuccess || per_cu < 1) per_cu = 1;
        grid = cus;
    }
    (void)hipMemsetAsync((unsigned char*)d_ws + OFF_CTL, 0, XCD_BAR_WORDS * sizeof(unsigned), stream);
    hipLaunchKernelGGL(k_mega, dim3(grid), dim3(512), LDS_BYTES, stream, P);
}
```

```cpp
#define ATT16 1
#define USE_FP8Z 1
#define USE_FP8M 1
#define USE_FP8O 1
#define USE_FP8N 1
#define USE_FP8Q 1
#define TAIL_IN_P6 0
#define F8_Q0 0
#define F8_NQ 53
#define VT_IN_P3 1
#define EPI_HOIST 2
#define GEMM_NT 0
#include <hip/hip_runtime.h>
#include <stdint.h>
#include <stddef.h>

#define DI __device__ __forceinline__
#define LAS __attribute__((address_space(3)))
typedef unsigned short bf16_t;
typedef short bf16x8 __attribute__((ext_vector_type(8)));
typedef float f32x4 __attribute__((ext_vector_type(4)));
typedef float f32x16 __attribute__((ext_vector_type(16)));
typedef unsigned u32x4 __attribute__((ext_vector_type(4)));
typedef unsigned u32x2 __attribute__((ext_vector_type(2)));
typedef __bf16 bf2_t __attribute__((ext_vector_type(2)));
typedef float f2_t __attribute__((ext_vector_type(2)));

DI int tid_opaque() { int t = (int)threadIdx.x; asm volatile("" : "+v"(t)); return t; }
DI unsigned pk2(float a, float b) { f2_t f = {a, b}; bf2_t v = __builtin_convertvector(f, bf2_t); return __builtin_bit_cast(unsigned, v); }
DI float clamp_fp8(float v) { float r; asm("v_max_f32 %0, 0xc3e00000, %1\n\tv_min_f32 %0, 0x43e00000, %0" : "=v"(r) : "v"(v)); return r; }
DI unsigned pk4_fp8(float a, float b, float c, float d) { a = clamp_fp8(a); b = clamp_fp8(b); c = clamp_fp8(c); d = clamp_fp8(d); int w = 0; w = __builtin_amdgcn_cvt_pk_fp8_f32(a, b, w, false); w = __builtin_amdgcn_cvt_pk_fp8_f32(c, d, w, true); return (unsigned)w; }
DI unsigned pk4_fp8c(float a, float b, float c, float d) { return pk4_fp8(a, b, c, d); }
DI float bflo(unsigned w) { return __uint_as_float(w << 16); }
DI float bfhi(unsigned w) { return __uint_as_float(w & 0xffff0000u); }
#ifndef USE_FP8KV
#define USE_FP8KV 0
#endif
#ifndef USE_FP8Q
#define USE_FP8Q 0
#endif
#ifndef USE_FP8N
#define USE_FP8N 0
#endif
#ifndef USE_FP8O
#define USE_FP8O 0
#endif
#ifndef GEMM_STAG
#define GEMM_STAG 0
#endif
#ifndef GEMM_NT
#define GEMM_NT 0
#endif
#ifndef FP8EMU
#define FP8EMU 0
#endif
DI float emu_q8(float x, float s) { float y = x * s; const float ay = fabsf(y);
    if (ay < 0.015625f) y = rintf(y * 512.0f) * (1.0f / 512.0f);
    else { unsigned u = __float_as_uint(y); u = (u + 0x0007FFFFu + ((u >> 20) & 1u)) & 0xFFF00000u; y = __uint_as_float(u); }
    y = fminf(fmaxf(y, -448.0f), 448.0f); return y / s; }
DI float bf1(bf16_t h) { return __uint_as_float(((unsigned)h) << 16); }

#ifndef ATT16
#define ATT16 0
#endif
DI int vt_key_of_pos(int p) {
#if ATT16
    return (p & ~31) | (((p >> 2) & 1) << 4) | (((p >> 3) & 3) << 2) | (p & 3);
#else
    return (p & ~0xC) | ((p & 4) << 1) | ((p & 8) >> 1);
#endif
}
DI int vt_pos_of_key(int k) {
#if ATT16
    return (k & ~31) | (((k >> 2) & 3) << 3) | (((k >> 4) & 1) << 2) | (k & 3);
#else
    return (k & ~0xC) | ((k & 4) << 1) | ((k & 8) >> 1);
#endif
}
constexpr int BATCH = 4, SEQ = 4096, DM = 4096, MTOK = BATCH * SEQ;
constexpr int NH = 64, NG = 4, NR = 16, DK = 192, DV = 128;
constexpr int N1 = 40896, N1P = 40960;
constexpr int C_Q = 0, C_KVC = 12288, C_KVS = 13568, C_KVW = 14848, C_ZC = 16128, C_ZS = 24320, C_ZW = 32512, C_G = 40704;
constexpr int N3 = 10304, N3P = 10496;
constexpr int C3_CQ = 0, C3_CKV = 1536, C3_KPE = 2048, C3_Z = 2112;
constexpr int QLORA = 1536, KVLORA = 512;
constexpr int NQB = 12288, NKVB = 16384, ZW8 = 8192;
constexpr float EPSN = 1e-6f;
constexpr float LOG2E = 1.4426950408889634f;
constexpr float QSCALE = 0.07216878364870322f * 1.4426950408889634f;

constexpr size_t SZ_W1T = (size_t)N1P * DM * 2, SZ_W2T = (size_t)DM * ZW8 * 2, SZ_W3T = (size_t)N3P * DM * 2, SZ_W4T = (size_t)NQB * QLORA * 2,
                 SZ_W5T = (size_t)NKVB * KVLORA * 2, SZ_W6T = (size_t)DM * ZW8 * 2;
constexpr size_t OFF_W1T = 0, OFF_W2T = OFF_W1T + SZ_W1T, OFF_W3T = OFF_W2T + SZ_W2T, OFF_W4T = OFF_W3T + SZ_W3T, OFF_W5T = OFF_W4T + SZ_W4T,
                 OFF_W6T = OFF_W5T + SZ_W5T, OFF_W1K = OFF_W6T + SZ_W6T;
constexpr size_t OFF_W5K = OFF_W5T, OFF_W5V = OFF_W5T + SZ_W5T / 2;
constexpr size_t SZ_W1K = (size_t)256 * 6144 * 2, SZ_W1V = (size_t)256 * 4096 * 2;
constexpr size_t OFF_W1V = OFF_W1K + SZ_W1K, OFF_CTL = OFF_W1V + SZ_W1V, OFF_H = OFF_CTL + 65536;
constexpr size_t SZ_H = (size_t)MTOK * DM * 2, SZ_KS = (size_t)BATCH * NG * SEQ * DK * 2, SZ_VTS = (size_t)BATCH * NG * DV * SEQ * 2,
                 SZ_ACK = (size_t)4096 * 6144 * 2, SZ_ACV = (size_t)4096 * 4096 * 2;
constexpr size_t OFF_KS = OFF_H + SZ_H, OFF_KW = OFF_KS + SZ_KS, OFF_VTS = OFF_KW + SZ_KS, OFF_VTW = OFF_VTS + SZ_VTS, OFF_ACK = OFF_VTW + SZ_VTS,
                 OFF_ACV = OFF_ACK + SZ_ACK, OFF_KC = OFF_ACV + SZ_ACV;
constexpr size_t SZ_KC = (size_t)16 * 256 * DK * 2, SZ_VTC = (size_t)16 * DV * 256 * 2, SZ_HID = (size_t)4096 * 256 * 4;
constexpr size_t OFF_VTC = OFF_KC + SZ_KC, OFF_HIDK = OFF_VTC + SZ_VTC, OFF_HIDV = OFF_HIDK + SZ_HID, OFF_Y0 = OFF_HIDV + SZ_HID;
constexpr size_t SZ_Y0 = (size_t)MTOK * N1P * 2, SZ_O = (size_t)MTOK * ZW8 * 2;
constexpr size_t OFF_O = OFF_Y0 + SZ_Y0, WS_END = OFF_O + SZ_O;
constexpr size_t OFF_SS1 = OFF_HIDK;
constexpr size_t OFF_A8 = OFF_O, OFF_B8 = OFF_O + (size_t)MTOK * DM;
#ifndef F8_Q0
#define F8_Q0 0
#define F8_NQ 63
#endif
constexpr size_t OFF_B8M = OFF_W1T, OFF_A8M = OFF_W1T + (64ull << 20);
constexpr int C3_Z8 = 2304, NZ8M = 8192;
constexpr size_t OFF_W28 = OFF_W1T + (132ull << 20), OFF_O8N = OFF_W1T + (168ull << 20);
static_assert(OFF_O8N + (size_t)MTOK * ZW8 <= OFF_W1T + SZ_W1T, "fp8 NSA out-proj buffers");
constexpr float O8N_SCALE = 64.0f;
constexpr float O8_SCALE = 128.0f;
constexpr size_t OFF_KM = 0;
constexpr size_t SZ_KM = (size_t)BATCH * NH * SEQ * DK * 2;
static_assert(SZ_KM <= SZ_W1T + SZ_W2T, "KM alias");
constexpr size_t OFF_VTM = OFF_H;
constexpr size_t SZ_VTM = (size_t)BATCH * NH * DV * SEQ * 2;
constexpr size_t OFF_CKVN = OFF_VTM + SZ_VTM;
constexpr size_t SZ_CKVN = (size_t)MTOK * KVLORA * 2;
static_assert(OFF_CKVN + SZ_CKVN <= OFF_KC, "CKVN alias");
constexpr size_t OFF_Y1 = OFF_Y0, SZ_Y1 = (size_t)MTOK * N3P * 2;
constexpr size_t OFF_QM = OFF_Y1 + SZ_Y1, SZ_QM = (size_t)MTOK * NQB * 2;
constexpr size_t OFF_KVM = OFF_QM + SZ_QM, SZ_KVM = (size_t)MTOK * NKVB * 2;
constexpr size_t OFF_KNM = OFF_KVM;
constexpr size_t OFF_KPER = OFF_KVM, OFF_SSPE = OFF_KVM + (size_t)MTOK * 64 * 4;
constexpr size_t OFF_O8M = OFF_KVM + SZ_KVM / 2, OFF_W68 = OFF_O8M + (size_t)MTOK * ZW8;
constexpr size_t OFF_W48 = OFF_W68 + (size_t)DM * ZW8, OFF_CQN8 = OFF_W48 + (size_t)NQB * QLORA;
constexpr size_t OFF_CKVN8 = OFF_CQN8 + (size_t)MTOK * QLORA, OFF_W5K8 = OFF_CKVN8 + (size_t)MTOK * KVLORA, OFF_W5V8 = OFF_W5K8 + (size_t)(NKVB / 2) * KVLORA;
static_assert(OFF_W5V8 + (size_t)(NKVB / 2) * KVLORA <= OFF_KVM + SZ_KVM, "fp8 MLA buffers");
constexpr size_t OFF_CQN = OFF_KVM + SZ_KVM, SZ_CQN = (size_t)MTOK * QLORA * 2;
constexpr size_t OFF_ROPE = OFF_CQN + SZ_CQN, SZ_ROPE = (size_t)MTOK * 64 * 4;
static_assert(OFF_ROPE + SZ_ROPE <= OFF_O, "layer-1 alias region");
static_assert(WS_END <= 2680160256ull, "workspace");

struct Params {
    const float* x; const int* pos; const float* norm_w; const float* rel_bias;
    const float* nsa_w_in; const float* nsa_q_norm; const float* nsa_k_norm; const float* pe_k; const float* w1_k; const float* w2_k;
    const float* pe_v; const float* w1_v; const float* w2_v; const float* nsa_w_out;
    const float* mla_w_in; const float* mla_q_a_norm; const float* mla_w_q_b; const float* mla_kv_a_norm; const float* mla_w_kv_b;
    const float* mla_q_norm; const float* mla_k_norm; const float* mla_w_out;
    float* out; unsigned char* ws;
};

#define XB_TMO      128
#define XB_XCNT(j)  (256  + 64 * (j))
#define XB_XSUB(j)  (1280 + 64 * (j))
#define XB_XGEN(j)  (2304 + 64 * (j))
#define XB_TOP      3328
#define XB_TOPGEN   3392
#define XCD_BAR_WORDS 3456
#define XB_SPIN_CAP (1u << 18)

__device__ __forceinline__ unsigned xb_ld(unsigned* p)              { return __hip_atomic_load(p, __ATOMIC_RELAXED, __HIP_MEMORY_SCOPE_AGENT); }
__device__ __forceinline__ unsigned xb_add(unsigned* p, unsigned v) { return __hip_atomic_fetch_add(p, v, __ATOMIC_RELAXED, __HIP_MEMORY_SCOPE_AGENT); }
__device__ __forceinline__ unsigned xb_xcc_id() { return (unsigned)__builtin_amdgcn_s_getreg((3 << 11) | 20) & 0xFu; }
#define XB_SPIN(cond, bar) do { unsigned _sp = 0; while (cond) { __builtin_amdgcn_s_sleep(1); \
    if ((++_sp & 255u) == 0u) { if (xb_ld(&(bar)[XB_TMO])) break; if (_sp > XB_SPIN_CAP) { atomicAdd(&(bar)[XB_TMO], 1u); break; } } } } while (0)

struct XcdBarrier {
    unsigned* bar; unsigned x;
    volatile LAS unsigned* st;
};

__device__ __forceinline__ XcdBarrier xcd_barrier_post(unsigned* bar, volatile LAS unsigned* st) {
    XcdBarrier b; b.bar = bar; b.x = xb_xcc_id(); b.st = st;
    if (threadIdx.x == 0) (void)xb_add(&bar[XB_XCNT(b.x)], 1u);
    return b;
}
__device__ __forceinline__ void xcd_barrier_complete(unsigned* bar, unsigned x, unsigned& nloc, unsigned& nx) {
    const unsigned G = gridDim.x * gridDim.y * gridDim.z;
    unsigned sum, cnt, mine, sp = 0u;
    for (;;) {
        sum = 0u; cnt = 0u; mine = 0u;
#pragma unroll
        for (unsigned j = 0; j < 16; ++j) { const unsigned c = xb_ld(&bar[XB_XCNT(j)]); sum += c; cnt += (c > 0u) ? 1u : 0u; mine = (j == x) ? c : mine; }
        if (sum == G) break;
        __builtin_amdgcn_s_sleep(1);
        if ((++sp & 255u) == 0u) { if (xb_ld(&bar[XB_TMO])) break; if (sp > XB_SPIN_CAP) { atomicAdd(&bar[XB_TMO], 1u); break; } }
    }
    nloc = mine > 0u ? mine : 1u; nx = cnt > 0u ? cnt : 1u;
}

__device__ __forceinline__ void xcd_barrier(const XcdBarrier& b) {
    asm volatile("s_waitcnt vmcnt(0)" ::: "memory");
    __syncthreads();
    if (threadIdx.x == 0) {
        unsigned* bar = b.bar;
        __builtin_amdgcn_s_waitcnt(0);
        unsigned nloc = b.st[0], nx = b.st[1];
        if (nloc == 0u) { xcd_barrier_complete(bar, b.x, nloc, nx); b.st[0] = nloc; b.st[1] = nx; }
        const unsigned old = xb_add(&bar[XB_XSUB(b.x)], 1u);
        const unsigned gen = old / nloc;
        if (old + 1u == (gen + 1u) * nloc) {
            __builtin_amdgcn_fence(__ATOMIC_RELEASE, "agent");
            asm volatile("s_waitcnt vmcnt(0)" ::: "memory");
            const unsigned og = xb_add(&bar[XB_TOP], 1u);
            const unsigned tg = og / nx;
            if (og + 1u == (tg + 1u) * nx) xb_add(&bar[XB_TOPGEN], 1u);
            else XB_SPIN(xb_ld(&bar[XB_TOPGEN]) == tg, bar);
            __builtin_amdgcn_fence(__ATOMIC_ACQUIRE, "agent");
            xb_add(&bar[XB_XGEN(b.x)], 1u);
            asm volatile("s_waitcnt vmcnt(0)" ::: "memory");
        } else {
            XB_SPIN(xb_ld(&bar[XB_XGEN(b.x)]) == gen, bar);
            __builtin_amdgcn_fence(__ATOMIC_ACQUIRE, "agent");
            asm volatile("s_waitcnt vmcnt(0)" ::: "memory");
        }
    }
    __syncthreads();
}

namespace pg8 {
#define PG8_LAS __attribute__((address_space(3)))
typedef unsigned short bf16_t;
typedef short bf16x8 __attribute__((ext_vector_type(8)));
typedef float f32x4 __attribute__((ext_vector_type(4)));
typedef unsigned u32x4 __attribute__((ext_vector_type(4)));
typedef int i32x8_t __attribute__((ext_vector_type(8)));
typedef int i32x4_t __attribute__((ext_vector_type(4)));
constexpr int BM = 256, BK = 64, HALF = 128, HTB = HALF * BK * 2  , STAGE_BYTES = 8 * HTB, NXCD = 8, WGM = 8;

__host__ __device__ __forceinline__ int lds_byte(int r, int c) { const int st = (r >> 4) * 2 + (c >> 5), rr = r & 15, cc = c & 31, ob = rr * 64 + cc * 2; return st * 1024 + (ob ^ (((ob >> 9) & 1) << 5)); }
__host__ __device__ __forceinline__ void stage_rc(int b, int& R, int& C) { const int st = b / 1024, sb = b % 1024, swz = sb ^ (((sb >> 9) & 1) << 5); R = (st >> 1) * 16 + swz / 64; C = (st & 1) * 32 + (swz % 64) / 2; }
__host__ __device__ __forceinline__ int perm32(int rho) { const int n = rho >> 4, i = rho & 15; return 8 * (i >> 2) + 4 * n + (i & 3); }

struct Unit { int pm, pn; };
struct Gemm { const bf16_t* A; const bf16_t* Bt; int M, N, K; };

struct StaticOrder {
    int nM, nN, nwg, G, c;
    __host__ __device__ void init(int M, int N, int G_, int c_) { nM = M / BM; nN = N / BM; nwg = nM * nN; G = G_; c = c_; }
    __host__ __device__ bool next(int i, Unit& u) const {
        const long L = (long)i * G + c; if (L >= nwg) return false;
        int wgid = (int)L; { const int q = nwg / NXCD, r = nwg % NXCD, xcd = wgid % NXCD, off = wgid / NXCD; wgid = (xcd < r ? xcd * (q + 1) : r * (q + 1) + (xcd - r) * q) + off; }
        const int nig = WGM * nN, gid = wgid / nig, fm = gid * WGM, gsz = (nM - fm) < WGM ? (nM - fm) : WGM;
        u.pm = fm + ((wgid % nig) % gsz); u.pn = (wgid % nig) / gsz; return true;
    }
    __device__ __forceinline__ void a_ready(const Unit&) const {}
    __device__ __forceinline__ void done(const Unit&) const {}
};
#if GEMM_NT
#define EPI_ST16(p, w) __builtin_nontemporal_store((w), (u32x4*)(p))
#else
#define EPI_ST16(p, w) (*(u32x4*)(p) = (w))
#endif
struct EpiStoreBf16 {
    static constexpr bool PERM = true, AFTER_DRAIN = false, SWAP23 = false, FP8 = false;
    bf16_t* O; int ldc;
    __device__ __forceinline__ void operator()(const f32x4 (&acc)[2][2][4][2], const Unit& u, int wr, int wc, int fr, int fq) const {
        const int row0 = u.pm * BM + wr * 64 + fr; const int col0 = u.pn * BM + wc * 32 + 8 * fq;
#pragma unroll
        for (int ai = 0; ai < 2; ++ai)
#pragma unroll
            for (int m = 0; m < 4; ++m) { bf16_t* rowp = O + (size_t)(row0 + ai * HALF + m * 16) * ldc + col0;
#pragma unroll
                for (int bj = 0; bj < 2; ++bj) { const f32x4 v0 = acc[ai][bj][m][0], v1 = acc[ai][bj][m][1];
                    u32x4 w; w.x = pk2(v0[0], v0[1]); w.y = pk2(v0[2], v0[3]); w.z = pk2(v1[0], v1[1]); w.w = pk2(v1[2], v1[3]);
                    EPI_ST16(rowp + bj * HALF, w); } }
    }
};
struct EpiResF32 {
    static constexpr bool PERM = false, AFTER_DRAIN = false, SWAP23 = false, FP8 = false;
    const float* base; float* out; int ldc;
    __device__ __forceinline__ void operator()(const f32x4 (&acc)[2][2][4][2], const Unit& u, int wr, int wc, int fr, int fq) const {
        const int row0 = u.pm * BM + wr * 64 + fr, col0 = u.pn * BM + wc * 32 + 4 * fq;
#pragma unroll
        for (int ai = 0; ai < 2; ++ai)
#pragma unroll
            for (int m = 0; m < 4; ++m) { const size_t off = (size_t)(row0 + ai * HALF + m * 16) * ldc + col0;
#pragma unroll
                for (int bj = 0; bj < 2; ++bj)
#pragma unroll
                    for (int n = 0; n < 2; ++n) { const f32x4 bs = *(const f32x4*)(base + off + bj * HALF + n * 16);
                        *(f32x4*)(out + off + bj * HALF + n * 16) = bs + acc[ai][bj][m][n]; } }
    }
};
struct EpiPlainF32 {
    static constexpr bool PERM = false, AFTER_DRAIN = false, SWAP23 = false, FP8 = false;
    float* C; int ldc;
    __device__ __forceinline__ void operator()(const f32x4 (&acc)[2][2][4][2], const Unit& u, int wr, int wc, int fr, int fq) const {
        const int row0 = u.pm * BM + wr * 64 + fr, col0 = u.pn * BM + wc * 32 + 4 * fq;
#pragma unroll
        for (int ai = 0; ai < 2; ++ai)
#pragma unroll
            for (int m = 0; m < 4; ++m) { float* rowp = C + (size_t)(row0 + ai * HALF + m * 16) * ldc + col0;
#pragma unroll
                for (int bj = 0; bj < 2; ++bj)
#pragma unroll
                    for (int n = 0; n < 2; ++n) *(f32x4*)(rowp + bj * HALF + n * 16) = acc[ai][bj][m][n]; }
    }
};

template <bool F8_> struct EpiVTT {
    static constexpr bool PERM = true, AFTER_DRAIN = false, SWAP23 = true, FP8 = F8_;
    bf16_t* O; float scale;
    __device__ __forceinline__ void operator()(const f32x4 (&acc)[2][2][4][2], const Unit& u, int wr, int wc, int fr, int fq) const {
        const int row0 = u.pm * BM + wr * 64 + fr; const int colt = u.pn * BM; const int b = colt >> 12, pos0 = (colt & 4095) + wc * 32 + 8 * fq;
        bf16_t* base = O + (size_t)b * 8192 * 4096 + pos0;
#pragma unroll
        for (int ai = 0; ai < 2; ++ai)
#pragma unroll
            for (int m = 0; m < 4; ++m) { bf16_t* rowp = base + (size_t)(row0 + ai * HALF + m * 16) * 4096;
#pragma unroll
                for (int bj = 0; bj < 2; ++bj) { const f32x4 v0 = F8_ ? acc[ai][bj][m][0] * scale : acc[ai][bj][m][0], v1 = F8_ ? acc[ai][bj][m][1] * scale : acc[ai][bj][m][1];
                    u32x4 w; w.x = pk2(v0[0], v0[1]); w.y = pk2(v0[2], v0[3]); w.z = pk2(v1[0], v1[1]); w.w = pk2(v1[2], v1[3]);
                    EPI_ST16(rowp + bj * HALF, w); } }
    }
};
using EpiVT = EpiVTT<false>; using EpiVTFp8 = EpiVTT<true>;

template <bool F8_> struct EpiKNormT {
    static constexpr bool PERM = true, AFTER_DRAIN = false, SWAP23 = false, FP8 = F8_;
    bf16_t* KM; const float* sspe; const float* kper; const float* gain; PG8_LAS float* tab; mutable unsigned par; float scale;
    __device__ __forceinline__ void operator()(const f32x4 (&acc)[2][2][4][2], const Unit& u, int wr, int wc, int fr, int fq) const {
        PG8_LAS float* T = tab + par * 2048;
#pragma unroll
        for (int ai = 0; ai < 2; ++ai)
#pragma unroll
            for (int m = 0; m < 4; ++m) { const int row = ai * HALF + wr * 64 + m * 16 + fr;
#pragma unroll
                for (int bj = 0; bj < 2; ++bj) { const f32x4 x = F8_ ? acc[ai][bj][m][0] * scale : acc[ai][bj][m][0], y = F8_ ? acc[ai][bj][m][1] * scale : acc[ai][bj][m][1];
                    float ss = (x[0] * x[0] + x[1] * x[1]) + (x[2] * x[2] + x[3] * x[3]) + (y[0] * y[0] + y[1] * y[1]) + (y[2] * y[2] + y[3] * y[3]);
                    ss += __shfl_xor(ss, 16); ss += __shfl_xor(ss, 32);
                    if (fq == 0) T[row * 8 + bj * 4 + wc] = ss; } }
        asm volatile("s_waitcnt lgkmcnt(0)" ::: "memory"); __builtin_amdgcn_s_barrier(); asm volatile("" ::: "memory");
        const f32x4 g0 = *(const f32x4*)(gain + wc * 32 + 8 * fq), g1 = *(const f32x4*)(gain + wc * 32 + 8 * fq + 4);
        const int tok0 = u.pm * BM, b = tok0 >> 12;
#pragma unroll
        for (int ai = 0; ai < 2; ++ai)
#pragma unroll
            for (int m = 0; m < 4; ++m) { const int row = ai * HALF + wr * 64 + m * 16 + fr, tok = tok0 + row, s = tok & 4095;
                const float sp = sspe[tok]; const f32x4 kp = *(const f32x4*)(kper + (size_t)tok * 64 + wc * 16 + 4 * fq);
#pragma unroll
                for (int bj = 0; bj < 2; ++bj) { const f32x4 t = *(const PG8_LAS f32x4*)(T + row * 8 + bj * 4);
                    const float rstd = rsqrtf(((t[0] + t[1]) + (t[2] + t[3]) + sp) * (1.0f / 192.0f) + 1e-6f);
                    const int hd = 2 * u.pn + bj;
                    bf16_t* kb = KM + ((size_t)(b * 64 + hd) * 4096 + s) * 192;
                    const f32x4 x = F8_ ? acc[ai][bj][m][0] * scale : acc[ai][bj][m][0], y = F8_ ? acc[ai][bj][m][1] * scale : acc[ai][bj][m][1];
                    u32x4 w; w.x = pk2(x[0] * rstd * g0[0], x[1] * rstd * g0[1]); w.y = pk2(x[2] * rstd * g0[2], x[3] * rstd * g0[3]);
                    w.z = pk2(y[0] * rstd * g1[0], y[1] * rstd * g1[1]); w.w = pk2(y[2] * rstd * g1[2], y[3] * rstd * g1[3]);
                    *(u32x4*)(kb + wc * 32 + 8 * fq) = w;
                    u32x2 r; r.x = pk2(kp[0] * rstd, kp[1] * rstd); r.y = pk2(kp[2] * rstd, kp[3] * rstd);
                    *(u32x2*)(kb + 128 + wc * 16 + 4 * fq) = r; } }
        par ^= 1u;
    }
};
using EpiKNorm = EpiKNormT<false>; using EpiKNormFp8 = EpiKNormT<true>;

template <bool F8_> struct EpiResNormT {
    static constexpr bool PERM = false, AFTER_DRAIN = false, SWAP23 = false, FP8 = F8_;
    const float* base; float* out; int ldc; const float* gain; bf16_t* xg; float* ss; unsigned char* x8; float scale;
    __device__ __forceinline__ void operator()(const f32x4 (&acc)[2][2][4][2], const Unit& u, int wr, int wc, int fr, int fq) const {
        const int row0 = u.pm * BM + wr * 64 + fr, col0 = u.pn * BM + wc * 32 + 4 * fq;
        f32x4 gv[2][2];
#pragma unroll
        for (int bj = 0; bj < 2; ++bj)
#pragma unroll
            for (int n = 0; n < 2; ++n) gv[bj][n] = *(const f32x4*)(gain + col0 + bj * HALF + n * 16);
#pragma unroll
        for (int ai = 0; ai < 2; ++ai)
#pragma unroll
            for (int m = 0; m < 4; ++m) { const int row = row0 + ai * HALF + m * 16; const size_t off = (size_t)row * ldc + col0; float sq = 0.f;
#pragma unroll
                for (int bj = 0; bj < 2; ++bj)
#pragma unroll
                    for (int n = 0; n < 2; ++n) { const f32x4 bs = *(const f32x4*)(base + off + bj * HALF + n * 16); const f32x4 v = F8_ ? bs + acc[ai][bj][m][n] * scale : bs + acc[ai][bj][m][n];
                        *(f32x4*)(out + off + bj * HALF + n * 16) = v;
                        sq += (v[0] * v[0] + v[1] * v[1]) + (v[2] * v[2] + v[3] * v[3]);
                        const f32x4 g = gv[bj][n]; u32x2 w; w.x = pk2(v[0] * g[0], v[1] * g[1]); w.y = pk2(v[2] * g[2], v[3] * g[3]);
                        *(u32x2*)(xg + off + bj * HALF + n * 16) = w;
                        if (x8) *(unsigned*)(x8 + off + bj * HALF + n * 16) = pk4_fp8(v[0] * g[0] * 16.0f, v[1] * g[1] * 16.0f, v[2] * g[2] * 16.0f, v[3] * g[3] * 16.0f); }
                sq += __shfl_xor(sq, 16); sq += __shfl_xor(sq, 32);
                if (fq == 0) atomicAdd(ss + row, sq); }
    }
};
using EpiResNorm = EpiResNormT<false>; using EpiResNormFp8 = EpiResNormT<true>;
struct EpiStoreBf16RowScale {
    static constexpr bool PERM = true, AFTER_DRAIN = false, SWAP23 = false, FP8 = false;
    bf16_t* O; int ldc; const float* ss; float inv_dim;
    __device__ __forceinline__ void operator()(const f32x4 (&acc)[2][2][4][2], const Unit& u, int wr, int wc, int fr, int fq) const {
        const int row0 = u.pm * BM + wr * 64 + fr; const int col0 = u.pn * BM + wc * 32 + 8 * fq;
#pragma unroll
        for (int ai = 0; ai < 2; ++ai)
#pragma unroll
            for (int m = 0; m < 4; ++m) { const int row = row0 + ai * HALF + m * 16; const float rs = rsqrtf(ss[row] * inv_dim + 1e-6f);
                bf16_t* rowp = O + (size_t)row * ldc + col0;
#pragma unroll
                for (int bj = 0; bj < 2; ++bj) { const f32x4 v0 = acc[ai][bj][m][0] * rs, v1 = acc[ai][bj][m][1] * rs;
                    u32x4 w; w.x = pk2(v0[0], v0[1]); w.y = pk2(v0[2], v0[3]); w.z = pk2(v1[0], v1[1]); w.w = pk2(v1[2], v1[3]);
                    EPI_ST16(rowp + bj * HALF, w); } }
    }
};

struct EpiStoreBf16Fp8 {
    static constexpr bool PERM = true, AFTER_DRAIN = false, SWAP23 = false, FP8 = true;
    bf16_t* O; int ldc; float scale; int nostore = 0, rowmask = -1, rowoff = 0;
    __device__ __forceinline__ void operator()(const f32x4 (&acc)[2][2][4][2], const Unit& u, int wr, int wc, int fr, int fq) const {
        const int row0 = u.pm * BM + wr * 64 + fr; const int col0 = u.pn * BM + wc * 32 + 8 * fq;
#pragma unroll
        for (int ai = 0; ai < 2; ++ai)
#pragma unroll
            for (int m = 0; m < 4; ++m) { bf16_t* rowp = O + (size_t)(((row0 + ai * HALF + m * 16) & rowmask) + rowoff) * ldc + col0;
#pragma unroll
                for (int bj = 0; bj < 2; ++bj) { const f32x4 v0 = acc[ai][bj][m][0] * scale, v1 = acc[ai][bj][m][1] * scale;
                    u32x4 w; w.x = pk2(v0[0], v0[1]); w.y = pk2(v0[2], v0[3]); w.z = pk2(v1[0], v1[1]); w.w = pk2(v1[2], v1[3]);
                    if (nostore == 3) { bf16_t* pp = O + (size_t)((((ai * 4 + m) * 2 + bj) * 8 + (fr & 7)) % 64 + 256) * ldc + u.pn * BM + (wr * 4 + wc) * 64 % 256 + ((fr >> 3) * 4 + fq) * 8; EPI_ST16(pp, w); }
                    else if (nostore != 1 || w.x == 0x12345679u) EPI_ST16(rowp + bj * HALF, w); } }
    }
};

struct OrderBf16Part {
    int G, c, q0, nq, nz;
    __device__ bool next(int i, Unit& u) const { const int L = i * G + c;
        if (L < nq * 64) { u.pm = L & 63; u.pn = q0 + (L >> 6); return true; }
        const int Lz = L - nq * 64; if (Lz >= nz * 4) return false;
        const int j = Lz >> 2; u.pm = 16 * (Lz & 3); u.pn = j < q0 ? j : j + nq; return true; }
    __device__ __forceinline__ void a_ready(const Unit&) const {}
    __device__ __forceinline__ void done(const Unit&) const {}
};
struct OrderFp8Part {
    int G, c, q0, nq, nz, rot;
    __device__ bool next(int i, Unit& u) const { const int L = i * G + (G == 256 ? ((c + rot) & 255) : c); if (L >= nz * 60) return false;
        const int r = L % 60, j = L / 60; u.pm = r + r / 15 + 1; u.pn = j < q0 ? j : j + nq; return true; }
    __device__ __forceinline__ void a_ready(const Unit&) const {}
    __device__ __forceinline__ void done(const Unit&) const {}
};

struct EpiStoreBf16RowScaleFp8 {
    static constexpr bool PERM = true, AFTER_DRAIN = false, SWAP23 = false, FP8 = true;
    bf16_t* O; int ldc; const float* ss; float inv_dim, scale;
    __device__ __forceinline__ void operator()(const f32x4 (&acc)[2][2][4][2], const Unit& u, int wr, int wc, int fr, int fq) const {
        const int row0 = u.pm * BM + wr * 64 + fr; const int col0 = u.pn * BM + wc * 32 + 8 * fq;
#pragma unroll
        for (int ai = 0; ai < 2; ++ai)
#pragma unroll
            for (int m = 0; m < 4; ++m) { const int row = row0 + ai * HALF + m * 16; const float rs = rsqrtf(ss[row] * inv_dim + 1e-6f) * scale;
                bf16_t* rowp = O + (size_t)row * ldc + col0;
#pragma unroll
                for (int bj = 0; bj < 2; ++bj) { const f32x4 v0 = acc[ai][bj][m][0] * rs, v1 = acc[ai][bj][m][1] * rs;
                    u32x4 w; w.x = pk2(v0[0], v0[1]); w.y = pk2(v0[2], v0[3]); w.z = pk2(v1[0], v1[1]); w.w = pk2(v1[2], v1[3]);
                    EPI_ST16(rowp + bj * HALF, w); } }
    }
};
struct OrderTiles {
    int G, c, ncol;
    __device__ bool next(int i, Unit& u) const { const int L = i * G + c; if (L >= ncol * 64) return false; u.pm = L & 63; u.pn = L >> 6; return true; }
    __device__ __forceinline__ void a_ready(const Unit&) const {}
    __device__ __forceinline__ void done(const Unit&) const {}
};

struct EpiResF32Fp8 {
    static constexpr bool PERM = false, AFTER_DRAIN = false, SWAP23 = false, FP8 = true;
    const float* base; float* out; int ldc; float scale;
    __device__ __forceinline__ void operator()(const f32x4 (&acc)[2][2][4][2], const Unit& u, int wr, int wc, int fr, int fq) const {
        const int row0 = u.pm * BM + wr * 64 + fr, col0 = u.pn * BM + wc * 32 + 4 * fq;
#pragma unroll
        for (int ai = 0; ai < 2; ++ai)
#pragma unroll
            for (int m = 0; m < 4; ++m) { const size_t off = (size_t)(row0 + ai * HALF + m * 16) * ldc + col0;
#pragma unroll
                for (int bj = 0; bj < 2; ++bj)
#pragma unroll
                    for (int n = 0; n < 2; ++n) { const f32x4 bs = *(const f32x4*)(base + off + bj * HALF + n * 16);
                        *(f32x4*)(out + off + bj * HALF + n * 16) = bs + acc[ai][bj][m][n] * scale; } }
    }
};

template <class Base> struct OrderSwap {
    Base B;
    __device__ bool next(int i, Unit& u) const { Unit t; if (!B.next(i, t)) return false; u.pm = t.pn; u.pn = t.pm; return true; }
    __device__ __forceinline__ void a_ready(const Unit&) const {}
    __device__ __forceinline__ void done(const Unit&) const {}
};

struct OrderFp8PartP8 {
    int G, c;
    __device__ bool next(int i, Unit& u) const { int L;
        if (G != 256) { L = i * G + c; if (L >= 1920) return false; }
        else if (i < 7) L = i * 256 + c;
        else { if (c < 192 || i > 8) return false; L = 1792 + (i - 7) * 64 + (c - 192); }
        const int r = L % 60, j = L / 60; u.pm = r + r / 15 + 1; u.pn = 9 + j; return true; }
    __device__ __forceinline__ void a_ready(const Unit&) const {}
    __device__ __forceinline__ void done(const Unit&) const {}
};

struct EpiStoreBf16Fp8L {
    static constexpr bool PERM = true, AFTER_DRAIN = false, SWAP23 = false, FP8 = true, LINE128 = true;
    bf16_t* O; int ldc; float scale;
    __device__ __forceinline__ void operator()(const f32x4 (&acc)[2][2][4][2], const Unit& u, int wr, int wc, int fr, int fq) const {
        const int hi = fr >> 3;
        const int row0 = u.pm * BM + wr * 64 + (fr & 7); const int colA = u.pn * BM + wc * 64 + hi * 32 + 8 * fq, colB = u.pn * BM + wc * 64 + (hi ^ 1) * 32 + 8 * fq;
#pragma unroll
        for (int ai = 0; ai < 2; ++ai)
#pragma unroll
            for (int m = 0; m < 4; ++m) {
                const f32x4 a0 = acc[ai][0][m][0] * scale, a1 = acc[ai][0][m][1] * scale, b0 = acc[ai][1][m][0] * scale, b1 = acc[ai][1][m][1] * scale;
                u32x4 p0, p1, q1; p0.x = pk2(a0[0], a0[1]); p0.y = pk2(a0[2], a0[3]); p0.z = pk2(a1[0], a1[1]); p0.w = pk2(a1[2], a1[3]);
                p1.x = pk2(b0[0], b0[1]); p1.y = pk2(b0[2], b0[3]); p1.z = pk2(b1[0], b1[1]); p1.w = pk2(b1[2], b1[3]);
                q1.x = (unsigned)__builtin_amdgcn_update_dpp(0, (int)p1.x, 0x128, 0xf, 0xf, false); q1.y = (unsigned)__builtin_amdgcn_update_dpp(0, (int)p1.y, 0x128, 0xf, 0xf, false);
                q1.z = (unsigned)__builtin_amdgcn_update_dpp(0, (int)p1.z, 0x128, 0xf, 0xf, false); q1.w = (unsigned)__builtin_amdgcn_update_dpp(0, (int)p1.w, 0x128, 0xf, 0xf, false);
                u32x4 wa, wb; wa.x = hi ? q1.x : p0.x; wa.y = hi ? q1.y : p0.y; wa.z = hi ? q1.z : p0.z; wa.w = hi ? q1.w : p0.w;
                wb.x = hi ? p0.x : q1.x; wb.y = hi ? p0.y : q1.y; wb.z = hi ? p0.z : q1.z; wb.w = hi ? p0.w : q1.w;
                bf16_t* rp = O + (size_t)(row0 + ai * HALF + m * 16) * ldc;
                *(u32x4*)(rp + colA) = wa;
                *(u32x4*)(rp + (size_t)8 * ldc + colB) = wb; }
    }
};
template <class E_, class = void> struct line128 { static constexpr bool v = false; };
template <class E_> struct line128<E_, decltype((void)E_::LINE128)> { static constexpr bool v = E_::LINE128; };
template <class Epi, class Sched, bool STAMP = false>
__device__ __forceinline__ void gemm_phase(PG8_LAS unsigned char* lds, const Gemm g, const Sched& S, const Epi& E, unsigned long long* stamps, int stag = 0) {
    const int tid = tid_opaque(), wid = __builtin_amdgcn_readfirstlane(tid >> 6), lane = tid & 63, wr = wid >> 2, wc = wid & 3, fr = lane & 15, fq = lane >> 4;
    const int K = g.K, nt = K / BK;
    int ts_lo = 0, ts_hi = 0, nts = 0; const unsigned long long rt_entry = STAMP ? (unsigned long long)wall_clock64() : 0ull;
#define PG8_STAMP() do { if (STAMP && wid == 0 && nts < 64) { const unsigned long long _c = (unsigned long long)clock64(); \
        ts_lo = (lane == nts) ? (int)(unsigned)_c : ts_lo; ts_hi = (lane == nts) ? (int)(unsigned)(_c >> 32) : ts_hi; ++nts; } } while (0)
    PG8_STAMP();
    unsigned voffA[2], voffB[2];
#pragma unroll
    for (int i = 0; i < 2; ++i) { int R, C; stage_rc(tid * 16 + i * 8192, R, C); int Rb = Epi::PERM ? ((R & ~31) + perm32(R & 31)) : R; if (Epi::SWAP23) Rb = vt_key_of_pos(Rb);
        if (line128<Epi>::v) Rb = (R >> 5) * 64 + perm32(R & 31);
        voffA[i] = (unsigned)(R * K + C) * 2u; voffB[i] = (unsigned)(Rb * K + C) * 2u; }
    const size_t kstep = (size_t)(BK * 2);
    const size_t hstep = (size_t)HALF * K * 2;
    const size_t tstep = 2 * hstep;
    const size_t hstepB = line128<Epi>::v ? (size_t)32 * K * 2 : hstep;
    const unsigned ldsw = (unsigned)wid * 1024u;
    const int aoff = lds_byte(wr * 64 + fr, fq * 8), boff = lds_byte(wc * 32 + fr, fq * 8);
#define PG8_SA(b, h) (((b) * 2 + (h)) * HTB)
#define PG8_SB(b, h) ((4 + (b) * 2 + (h)) * HTB)
#define PG8_STAGE(bufoff, gbase, voff) do { _Pragma("unroll") for (int _i = 0; _i < 2; ++_i) \
        __builtin_amdgcn_global_load_lds((const unsigned*)((const char*)(gbase) + (voff)[_i]), (PG8_LAS unsigned*)(lds + (bufoff) + ldsw + _i * 8192), 16, 0, 0); } while (0)
#define PG8_LDA(dst, b, h) do { if constexpr (Epi::FP8) { _Pragma("unroll") for (int m = 0; m < 4; ++m) { const PG8_LAS unsigned char* p_ = lds + PG8_SA(b, h) + aoff + m * 2048; \
            const i32x4_t lo_ = *(const PG8_LAS i32x4_t*)p_, hi_ = *(const PG8_LAS i32x4_t*)(p_ + 1024); dst##8[m] = __builtin_shufflevector(lo_, hi_, 0, 1, 2, 3, 4, 5, 6, 7); } } \
        else { _Pragma("unroll") for (int m = 0; m < 4; ++m) _Pragma("unroll") for (int k = 0; k < 2; ++k) dst[m][k] = *(const PG8_LAS bf16x8*)(lds + PG8_SA(b, h) + aoff + m * 2048 + k * 1024); } } while (0)
#define PG8_LDB(dst, b, h) do { if constexpr (Epi::FP8) { _Pragma("unroll") for (int n = 0; n < 2; ++n) { const PG8_LAS unsigned char* p_ = lds + PG8_SB(b, h) + boff + n * 2048; \
            const i32x4_t lo_ = *(const PG8_LAS i32x4_t*)p_, hi_ = *(const PG8_LAS i32x4_t*)(p_ + 1024); dst##8[n] = __builtin_shufflevector(lo_, hi_, 0, 1, 2, 3, 4, 5, 6, 7); } } \
        else { _Pragma("unroll") for (int n = 0; n < 2; ++n) _Pragma("unroll") for (int k = 0; k < 2; ++k) dst[n][k] = *(const PG8_LAS bf16x8*)(lds + PG8_SB(b, h) + boff + n * 2048 + k * 1024); } } while (0)
#define PG8_MMA(ai, bj, At, Bt) do { __builtin_amdgcn_s_setprio(1); \
        if constexpr (Epi::FP8) { \
            _Pragma("unroll") for (int m = 0; m < 4; ++m) _Pragma("unroll") for (int n = 0; n < 2; ++n) \
                asm volatile("v_mfma_scale_f32_16x16x128_f8f6f4 %0, %1, %2, %0, %3, %3 op_sel_hi:[0,0,0]" : "+v"(acc[ai][bj][m][n]) : "v"(Bt##8[n]), "v"(At##8[m]), "v"(fp8_scale_one)); \
        } else { \
            _Pragma("unroll") for (int m = 0; m < 4; ++m) _Pragma("unroll") for (int n = 0; n < 2; ++n) _Pragma("unroll") for (int k = 0; k < 2; ++k) \
                acc[ai][bj][m][n] = __builtin_amdgcn_mfma_f32_16x16x32_bf16(Bt[n][k], At[m][k], acc[ai][bj][m][n], 0, 0, 0); } \
        __builtin_amdgcn_s_setprio(0); } while (0)
#define PG8_WAIT_V(n) asm volatile("s_waitcnt vmcnt(" #n ")" ::: "memory")
#define PG8_WAIT_L(n) asm volatile("s_waitcnt lgkmcnt(" #n ")" ::: "memory")
#define PG8_BAR __builtin_amdgcn_s_barrier()
#define PG8_SCHED __builtin_amdgcn_sched_barrier(0)
    Unit cur, nxt; int ui = 0;
    if (!S.next(0, cur)) return;
    if (stag > 0) { const int n_ = (int)((blockIdx.x >> 3) & 7u) * stag; for (int i_ = 0; i_ < n_; ++i_) __builtin_amdgcn_s_sleep(37); }
    f32x4 acc[2][2][4][2];
#pragma unroll
    for (int a = 0; a < 2; ++a)
#pragma unroll
        for (int b = 0; b < 2; ++b)
#pragma unroll
            for (int m = 0; m < 4; ++m)
#pragma unroll
                for (int n = 0; n < 2; ++n) acc[a][b][m][n] = (f32x4){0.f, 0.f, 0.f, 0.f};
    bf16x8 At[4][2], B0[2][2], B1[2][2]; i32x8_t At8[4], B08[2], B18[2]; const int fp8_scale_one = 0x7f7f7f7f;
    const char* cA = (const char*)g.A + (size_t)cur.pm * tstep; const char* cB = (const char*)g.Bt + (size_t)cur.pn * tstep;
    S.a_ready(cur);
    PG8_STAGE(PG8_SB(0, 0), cB, voffB); PG8_STAGE(PG8_SA(0, 0), cA, voffA); PG8_STAGE(PG8_SB(0, 1), cB + hstepB, voffB); PG8_STAGE(PG8_SA(0, 1), cA + hstep, voffA);
    if (wr == 1) PG8_BAR;
    PG8_WAIT_V(4); PG8_BAR;
    PG8_STAGE(PG8_SB(1, 0), cB + kstep, voffB); PG8_STAGE(PG8_SA(1, 0), cA + kstep, voffA); PG8_STAGE(PG8_SB(1, 1), cB + hstepB + kstep, voffB);
    PG8_WAIT_V(6); PG8_BAR;
    PG8_STAMP();
    for (;;) {
        const bool has_next = S.next(ui + 1, nxt);
        const char* nA = has_next ? (const char*)g.A + (size_t)nxt.pm * tstep : cA; const char* nB = has_next ? (const char*)g.Bt + (size_t)nxt.pn * tstep : cB;
        for (int t = 0; t < nt; t += 2) {
            const bool last = (t == nt - 2);
            const char* a1 = cA + (size_t)(t + 1) * kstep;
            const char* a2 = last ? nA : cA + (size_t)(t + 2) * kstep; const char* b2 = last ? nB : cB + (size_t)(t + 2) * kstep;
            const char* a3 = a2 + kstep; const char* b3 = b2 + kstep;
            if (last && has_next) S.a_ready(nxt);
            PG8_LDB(B0, 0, 0); PG8_SCHED; PG8_LDA(At, 0, 0); PG8_STAGE(PG8_SA(1, 1), a1 + hstep, voffA);
            PG8_WAIT_L(8); PG8_BAR; PG8_WAIT_L(0); PG8_MMA(0, 0, At, B0); PG8_BAR; PG8_SCHED;
            PG8_LDB(B1, 0, 1); PG8_STAGE(PG8_SB(0, 0), b2, voffB);
            PG8_BAR; PG8_WAIT_L(0); PG8_MMA(0, 1, At, B1); PG8_BAR;
            PG8_LDA(At, 0, 1); PG8_STAGE(PG8_SA(0, 0), a2, voffA);
            PG8_BAR; PG8_WAIT_L(0); PG8_MMA(1, 0, At, B0); PG8_BAR; PG8_SCHED;
            PG8_STAGE(PG8_SB(0, 1), b2 + hstepB, voffB);
            PG8_WAIT_V(6); PG8_BAR; PG8_MMA(1, 1, At, B1); PG8_BAR;
            PG8_LDB(B0, 1, 0); PG8_SCHED; PG8_LDA(At, 1, 0); PG8_STAGE(PG8_SA(0, 1), a2 + hstep, voffA);
            PG8_WAIT_L(8); PG8_BAR; PG8_WAIT_L(0); PG8_MMA(0, 0, At, B0); PG8_BAR; PG8_SCHED;
            PG8_LDB(B1, 1, 1); PG8_STAGE(PG8_SB(1, 0), b3, voffB);
            PG8_BAR; PG8_WAIT_L(0); PG8_MMA(0, 1, At, B1); PG8_BAR;
            PG8_LDA(At, 1, 1); PG8_STAGE(PG8_SA(1, 0), a3, voffA);
            PG8_BAR; PG8_WAIT_L(0); PG8_MMA(1, 0, At, B0); PG8_BAR; PG8_SCHED;
            PG8_STAGE(PG8_SB(1, 1), b3 + hstepB, voffB);
            PG8_WAIT_V(6); PG8_BAR; PG8_MMA(1, 1, At, B1); PG8_BAR;
        }
        PG8_STAMP();
        if constexpr (Epi::FP8) asm volatile("s_nop 15\n\ts_nop 15" ::: "memory");
        if constexpr (!Epi::AFTER_DRAIN) { E(acc, cur, wr, wc, fr, fq); S.done(cur); }
        PG8_STAMP();
        if (!has_next) break;
#pragma unroll
        for (int a = 0; a < 2; ++a)
#pragma unroll
            for (int b = 0; b < 2; ++b)
#pragma unroll
                for (int m = 0; m < 4; ++m)
#pragma unroll
                    for (int n = 0; n < 2; ++n) acc[a][b][m][n] = (f32x4){0.f, 0.f, 0.f, 0.f};
        cur = nxt; cA = nA; cB = nB; ++ui;
    }
    PG8_WAIT_V(0);
    if (wr == 0) PG8_BAR;
    PG8_BAR;
    if constexpr (Epi::AFTER_DRAIN) { E.fused(acc, cur, wr, wc, fr, fq, lds, wid, lane); S.done(cur); }
    PG8_STAMP();
    if (STAMP && wid == 0) { stamps[lane] = lane < nts ? (((unsigned long long)(unsigned)ts_hi << 32) | (unsigned)ts_lo) : 0ull;
        if (lane == 62) stamps[62] = rt_entry; if (lane == 63) stamps[63] = (unsigned long long)wall_clock64(); }
#undef PG8_STAMP
#undef PG8_SA
#undef PG8_SB
#undef PG8_STAGE
#undef PG8_LDA
#undef PG8_LDB
#undef PG8_MMA
#undef PG8_WAIT_V
#undef PG8_WAIT_L
#undef PG8_BAR
#undef PG8_SCHED
}
}


DI void phase_wconv(LAS unsigned char* lds, const float* __restrict__ src, bf16_t* __restrict__ dst, int K, int N, int Npad, int bid, int nb, float q8s = 0.f, int colmap = 0, unsigned char* __restrict__ dst8 = nullptr, int n8_0 = 0, int n8_1 = 0) {
    LAS float* tile = (LAS float*)lds;
    const int tid = tid_opaque();
    const int tk = K / 64, tn = Npad / 256, total = tk * tn;
    for (int t = bid; t < total; t += nb) {
        const int k0 = (t % tk) * 64, n0 = (t / tk) * 256;
        __syncthreads();
        {
            const int ty = tid >> 6, tx = tid & 63, n = n0 + tx * 4;
            f32x4 v[8];
#pragma unroll
            for (int i = 0; i < 8; ++i) {
                const int k = k0 + ty + 8 * i;
                v[i] = (f32x4){0.f, 0.f, 0.f, 0.f};
                if (colmap) { const int ns = (n >> 7) * 256 + (colmap == 1 ? 128 : 0) + (n & 127); v[i] = *(const f32x4*)(src + (size_t)k * (2 * N) + ns); }
                else if (n < N) v[i] = *(const f32x4*)(src + (size_t)k * N + n);
            }
#pragma unroll
            for (int i = 0; i < 8; ++i) { LAS float* pp = tile + (ty + 8 * i) * 257 + tx * 4; pp[0] = v[i][0]; pp[1] = v[i][1]; pp[2] = v[i][2]; pp[3] = v[i][3]; }
        }
        __syncthreads();
#pragma unroll
        for (int ps_ = 0; ps_ < 4; ++ps_) {
            const int n = (tid >> 3) + 64 * ps_, kc = tid & 7;
            float v[8];
#pragma unroll
            for (int j = 0; j < 8; ++j) { v[j] = tile[(kc * 8 + j) * 257 + n]; if (q8s > 0.f) v[j] = emu_q8(v[j], q8s); else if (q8s < 0.f && n0 + n >= C_ZC) v[j] = emu_q8(v[j], -q8s); }
            u32x4 w; w.x = pk2(v[0], v[1]); w.y = pk2(v[2], v[3]); w.z = pk2(v[4], v[5]); w.w = pk2(v[6], v[7]);
            *(u32x4*)(dst + (size_t)(n0 + n) * K + k0 + kc * 8) = w;
            if (dst8 && (n0 + n < n8_0 || n0 + n >= n8_1)) { u32x2 b; b.x = pk4_fp8(v[0] * 64.0f, v[1] * 64.0f, v[2] * 64.0f, v[3] * 64.0f); b.y = pk4_fp8(v[4] * 64.0f, v[5] * 64.0f, v[6] * 64.0f, v[7] * 64.0f);
                *(u32x2*)(dst8 + (size_t)(n0 + n) * K + k0 + kc * 8) = b; }
        }
    }
}

DI void phase_rmsnorm(const float* __restrict__ x, const float* __restrict__ gain, bf16_t* __restrict__ h, int bid, int nb, float q8s = 0.f, unsigned char* __restrict__ h8 = nullptr) {
    const int tid = tid_opaque(); const int lane = tid & 63, wid = tid >> 6;
    for (int row = bid * 8 + wid; row < MTOK; row += nb * 8) {
        const float* xr = x + (size_t)row * DM;
        f32x4 v[16]; float ss = 0.f;
#pragma unroll
        for (int i = 0; i < 16; ++i) { v[i] = *(const f32x4*)(xr + (i * 64 + lane) * 4); ss += v[i][0] * v[i][0] + v[i][1] * v[i][1] + v[i][2] * v[i][2] + v[i][3] * v[i][3]; }
#pragma unroll
        for (int o = 32; o >= 1; o >>= 1) ss += __shfl_xor(ss, o);
        const float rstd = rsqrtf(ss * (1.0f / DM) + EPSN);
        bf16_t* hr = h + (size_t)row * DM;
#pragma unroll
        for (int i = 0; i < 16; ++i) { const f32x4 g = *(const f32x4*)(gain + (i * 64 + lane) * 4);
            float y0 = v[i][0] * rstd * g[0], y1 = v[i][1] * rstd * g[1], y2 = v[i][2] * rstd * g[2], y3 = v[i][3] * rstd * g[3];
            if (q8s > 0.f || (q8s < 0.f && (row & 4095) >= 256)) { const float qa = fabsf(q8s); y0 = emu_q8(y0, qa); y1 = emu_q8(y1, qa); y2 = emu_q8(y2, qa); y3 = emu_q8(y3, qa); }
            u32x2 w; w.x = pk2(y0, y1); w.y = pk2(y2, y3);
            *(u32x2*)(hr + (i * 64 + lane) * 4) = w;
            if (h8) *(unsigned*)(h8 + (size_t)row * DM + (i * 64 + lane) * 4) = pk4_fp8(y0 * 16.0f, y1 * 16.0f, y2 * 16.0f, y3 * 16.0f); }
    }
}

DI void ld192(const bf16_t* p, int j8, float (&v)[24]) {
#pragma unroll
    for (int c = 0; c < 3; ++c) { const u32x4 w = *(const u32x4*)(p + (j8 + 8 * c) * 8);
        v[c * 8 + 0] = bflo(w.x); v[c * 8 + 1] = bfhi(w.x); v[c * 8 + 2] = bflo(w.y); v[c * 8 + 3] = bfhi(w.y);
        v[c * 8 + 4] = bflo(w.z); v[c * 8 + 5] = bfhi(w.z); v[c * 8 + 6] = bflo(w.w); v[c * 8 + 7] = bfhi(w.w); }
}
DI void st192(bf16_t* p, int j8, const float (&v)[24]) {
#pragma unroll
    for (int c = 0; c < 3; ++c) { u32x4 w; w.x = pk2(v[c * 8 + 0], v[c * 8 + 1]); w.y = pk2(v[c * 8 + 2], v[c * 8 + 3]); w.z = pk2(v[c * 8 + 4], v[c * 8 + 5]); w.w = pk2(v[c * 8 + 6], v[c * 8 + 7]);
        *(u32x4*)(p + (j8 + 8 * c) * 8) = w; }
}
DI float sum8(float s) { s += __shfl_xor(s, 1); s += __shfl_xor(s, 2); s += __shfl_xor(s, 4); return s; }

template <int PART = -1>
DI void phase_nsa_prep(const Params& P, int bid, int nb) {
    bf16_t* Y0 = (bf16_t*)(P.ws + OFF_Y0);
    bf16_t* KS = (bf16_t*)(P.ws + OFF_KS); bf16_t* KW = (bf16_t*)(P.ws + OFF_KW);
    bf16_t* ACK = (bf16_t*)(P.ws + OFF_ACK); bf16_t* ACV = (bf16_t*)(P.ws + OFF_ACV);
    const int tid = tid_opaque(), grp = PART < 0 ? (tid >> 3) & 15 : ((tid >> 3) & 7) + 8 * PART, j8 = tid & 7;
    constexpr int TPP = PART < 0 ? 4 : 8;
    for (int tok = bid * TPP + (PART < 0 ? (tid >> 7) : (tid >> 6)); tok < MTOK; tok += nb * TPP) {
        const int b = tok / SEQ, s = tok % SEQ;
        bf16_t* yr = Y0 + (size_t)tok * N1P;
        if (grp < 8) {
            const int g = grp & 3, br = grp >> 2;
            float v[24]; ld192(yr + (br ? C_KVW : C_KVS) + g * DK, j8, v);
            float ss = 0.f;
#pragma unroll
            for (int i = 0; i < 24; ++i) ss += v[i] * v[i];
            ss = sum8(ss);
            const float rstd = rsqrtf(ss * (1.0f / DK) + EPSN);
            const float* kn = P.nsa_k_norm + (br ? 2 : 1) * DK;
#pragma unroll
            for (int c = 0; c < 3; ++c)
#pragma unroll
                for (int e = 0; e < 8; ++e) v[c * 8 + e] *= rstd * kn[(j8 + 8 * c) * 8 + e];
            st192((br ? KW : KS) + ((size_t)(b * NG + g) * SEQ + s) * DK, j8, v);
        } else if (grp < 12) {
            const int g = grp - 8;
            float v[24]; ld192(yr + C_KVC + g * DK, j8, v);
#pragma unroll
            for (int k = 0; k < 2; ++k) {
                const int n = (s >> 4) - k, l = s - 16 * n;
                if (n >= 0 && n <= 254) {
                    float w[24];
#pragma unroll
                    for (int c = 0; c < 3; ++c)
#pragma unroll
                        for (int e = 0; e < 8; ++e) w[c * 8 + e] = v[c * 8 + e] + P.pe_k[l * DK + (j8 + 8 * c) * 8 + e];
                    st192(ACK + ((size_t)((b * NG + g) * 256 + n)) * 6144 + l * DK, j8, w);
                }
            }
        } else if (grp < 16) {
            const int g = grp - 12;
            const bf16_t* src = yr + C_KVC + NG * DK + g * DV;
            float v[16];
#pragma unroll
            for (int c = 0; c < 2; ++c) { const u32x4 w = *(const u32x4*)(src + (j8 + 8 * c) * 8);
                v[c * 8 + 0] = bflo(w.x); v[c * 8 + 1] = bfhi(w.x); v[c * 8 + 2] = bflo(w.y); v[c * 8 + 3] = bfhi(w.y);
                v[c * 8 + 4] = bflo(w.z); v[c * 8 + 5] = bfhi(w.z); v[c * 8 + 6] = bflo(w.w); v[c * 8 + 7] = bfhi(w.w); }
#pragma unroll
            for (int k = 0; k < 2; ++k) {
                const int n = (s >> 4) - k, l = s - 16 * n;
                if (n >= 0 && n <= 254) {
                    bf16_t* dst = ACV + ((size_t)((b * NG + g) * 256 + n)) * 4096 + l * DV;
#pragma unroll
                    for (int c = 0; c < 2; ++c) { float w[8];
#pragma unroll
                        for (int e = 0; e < 8; ++e) w[e] = v[c * 8 + e] + P.pe_v[l * DV + (j8 + 8 * c) * 8 + e];
                        u32x4 o; o.x = pk2(w[0], w[1]); o.y = pk2(w[2], w[3]); o.z = pk2(w[4], w[5]); o.w = pk2(w[6], w[7]);
                        *(u32x4*)(dst + (j8 + 8 * c) * 8) = o; }
                }
            }
        }
    }
    if (PART != 0)
    for (int i = bid * 512 + tid; i < 16 * (6144 + 4096) / 8; i += nb * 512) {
        const int per = (6144 + 4096) / 8, bg = i / per, c = i % per;
        const u32x4 z = {0u, 0u, 0u, 0u};
        if (c < 6144 / 8) *(u32x4*)(ACK + ((size_t)(bg * 256 + 255)) * 6144 + c * 8) = z;
        else *(u32x4*)(ACV + ((size_t)(bg * 256 + 255)) * 4096 + (c - 6144 / 8) * 8) = z;
    }
}

DI int swap23(int p) { return (p & ~0xC) | ((p & 4) << 1) | ((p & 8) >> 1); }
DI void phase_vt(LAS unsigned char* lds, const bf16_t* __restrict__ src, size_t src_stride, int col0, int col_step, int nhv, bf16_t* __restrict__ dst, int bid, int nb) {
    LAS bf16_t* tile = (LAS bf16_t*)lds;
    const int tid = tid_opaque();
    const int ntile = SEQ / 64, total = BATCH * nhv * ntile;
    for (int it = bid; it < total; it += nb) {
        const int mat = it / ntile, tt = it % ntile, b = mat / nhv, hv = mat % nhv;
        __syncthreads();
#pragma unroll
        for (int i = 0; i < 2; ++i) {
            const int q = tid + 512 * i, tok = q >> 4, ch = q & 15;
            const u32x4 w = *(const u32x4*)(src + (size_t)(b * SEQ + tt * 64 + tok) * src_stride + col0 + hv * col_step + ch * 8);
            *(LAS u32x4*)(tile + tok * 136 + ch * 8) = w;
        }
        __syncthreads();
        {
            const int dv = tid >> 2, kq = tid & 3;
            unsigned w[8];
#pragma unroll
            for (int e = 0; e < 8; ++e) {
                const int p0 = kq * 16 + 2 * e, p1 = p0 + 1;
                const int k0 = vt_key_of_pos(p0), k1 = vt_key_of_pos(p1);
                w[e] = (unsigned)tile[k0 * 136 + dv] | ((unsigned)tile[k1 * 136 + dv] << 16);
            }
            bf16_t* d = dst + ((size_t)mat * DV + dv) * SEQ + tt * 64 + kq * 16;
            u32x4 a = {w[0], w[1], w[2], w[3]}, c = {w[4], w[5], w[6], w[7]};
            *(u32x4*)d = a; *(u32x4*)(d + 8) = c;
        }
    }
}

DI void phase_cmp2(LAS unsigned char* lds, const Params& P, int bid, int nb) {
    LAS float* sk = (LAS float*)lds;
    LAS float* sv = sk + 192;
    LAS float* red = sv + 128;
    const float* HIDK = (const float*)(P.ws + OFF_HIDK); const float* HIDV = (const float*)(P.ws + OFF_HIDV);
    bf16_t* KC = (bf16_t*)(P.ws + OFF_KC); bf16_t* VTC = (bf16_t*)(P.ws + OFF_VTC);
    const int tid = tid_opaque(), lane = tid & 63, wid = tid >> 6;
    for (int m = bid; m < 4096; m += nb) {
        const int n = m & 255, bg = m >> 8;
        __syncthreads();
        if (tid < 192) { const float h = HIDK[(size_t)m * 256 + tid]; sk[tid] = h / (1.0f + __expf(-h)); }
        else if (tid < 320) { const float h = HIDV[(size_t)m * 256 + tid - 192]; sv[tid - 192] = h / (1.0f + __expf(-h)); }
        __syncthreads();
        float acc = 0.f;
        if (tid < 192) { for (int i = 0; i < 192; ++i) acc += sk[i] * P.w2_k[i * 192 + tid]; }
        else if (tid < 320) { const int j = tid - 192; for (int i = 0; i < 128; ++i) acc += sv[i] * P.w2_v[i * 128 + j]; }
        float ss = (tid < 192) ? acc * acc : 0.f;
#pragma unroll
        for (int o = 32; o >= 1; o >>= 1) ss += __shfl_xor(ss, o);
        if (lane == 0) red[wid] = ss;
        __syncthreads();
        const float tot = red[0] + red[1] + red[2];
        const float rstd = rsqrtf(tot * (1.0f / DK) + EPSN);
        if (tid < 192) { const float o = (n == 255) ? 0.f : acc * rstd * P.nsa_k_norm[tid];
            KC[(size_t)m * DK + tid] = (bf16_t)(pk2(o, 0.f) & 0xffffu); }
        else if (tid < 320) { const int j = tid - 192; const float o = (n == 255) ? 0.f : acc;
            const int pn = vt_pos_of_key(n);
            VTC[((size_t)bg * DV + j) * 256 + pn] = (bf16_t)(pk2(o, 0.f) & 0xffffu); }
    }
}

DI void phase_mla_prep1(const Params& P, int bid, int nb) {
    const bf16_t* Y1 = (const bf16_t*)(P.ws + OFF_Y1);
    bf16_t* CQN = (bf16_t*)(P.ws + OFF_CQN); bf16_t* CKVN = (bf16_t*)(P.ws + OFF_CKVN); float* ROPE = (float*)(P.ws + OFF_ROPE);
    float* KPER = (float*)(P.ws + OFF_KPER); float* SSPE = (float*)(P.ws + OFF_SSPE);
    const int tid = tid_opaque(); const int lane = tid & 63, wid = tid >> 6;
    constexpr int TU = 4;
    for (int tok0 = (bid * 8 + wid) * TU; tok0 < MTOK; tok0 += nb * 8 * TU) {
        u32x4 wq[TU][3], wk[TU]; int pos[TU]; bf16_t kp1[TU], kp2[TU];
#pragma unroll
        for (int t = 0; t < TU; ++t) { const bf16_t* yr = Y1 + (size_t)(tok0 + t) * N3P;
#pragma unroll
            for (int c = 0; c < 3; ++c) wq[t][c] = *(const u32x4*)(yr + C3_CQ + (c * 64 + lane) * 8);
            wk[t] = *(const u32x4*)(yr + C3_CKV + lane * 8);
            pos[t] = P.pos[tok0 + t]; kp1[t] = yr[C3_KPE + (lane & 31)]; kp2[t] = yr[C3_KPE + 32 + (lane & 31)]; }
#pragma unroll
        for (int t = 0; t < TU; ++t) { const int tok = tok0 + t;
            {
                float v[24]; float ss = 0.f;
#pragma unroll
                for (int c = 0; c < 3; ++c) { const u32x4 w = wq[t][c];
                    v[c * 8 + 0] = bflo(w.x); v[c * 8 + 1] = bfhi(w.x); v[c * 8 + 2] = bflo(w.y); v[c * 8 + 3] = bfhi(w.y);
                    v[c * 8 + 4] = bflo(w.z); v[c * 8 + 5] = bfhi(w.z); v[c * 8 + 6] = bflo(w.w); v[c * 8 + 7] = bfhi(w.w); }
#pragma unroll
                for (int i = 0; i < 24; ++i) ss += v[i] * v[i];
#pragma unroll
                for (int o = 32; o >= 1; o >>= 1) ss += __shfl_xor(ss, o);
                const float rstd = rsqrtf(ss * (1.0f / QLORA) + EPSN);
#pragma unroll
                for (int c = 0; c < 3; ++c) { const float* g = P.mla_q_a_norm + (c * 64 + lane) * 8; const f32x4 g0 = *(const f32x4*)g, g1 = *(const f32x4*)(g + 4); u32x4 w;
                    w.x = pk2(v[c * 8 + 0] * rstd * g0[0], v[c * 8 + 1] * rstd * g0[1]); w.y = pk2(v[c * 8 + 2] * rstd * g0[2], v[c * 8 + 3] * rstd * g0[3]);
                    w.z = pk2(v[c * 8 + 4] * rstd * g1[0], v[c * 8 + 5] * rstd * g1[1]); w.w = pk2(v[c * 8 + 6] * rstd * g1[2], v[c * 8 + 7] * rstd * g1[3]);
                    *(u32x4*)(CQN + (size_t)tok * QLORA + (c * 64 + lane) * 8) = w;
                    if (USE_FP8Q) { const float r16 = rstd * 16.0f; u32x2 b;
                        b.x = pk4_fp8(v[c * 8 + 0] * r16 * g0[0], v[c * 8 + 1] * r16 * g0[1], v[c * 8 + 2] * r16 * g0[2], v[c * 8 + 3] * r16 * g0[3]);
                        b.y = pk4_fp8(v[c * 8 + 4] * r16 * g1[0], v[c * 8 + 5] * r16 * g1[1], v[c * 8 + 6] * r16 * g1[2], v[c * 8 + 7] * r16 * g1[3]);
                        *(u32x2*)((unsigned char*)(P.ws + OFF_CQN8) + (size_t)tok * QLORA + (c * 64 + lane) * 8) = b; } }
            }
            {
                float v[8]; float ss = 0.f; const u32x4 w0 = wk[t];
                v[0] = bflo(w0.x); v[1] = bfhi(w0.x); v[2] = bflo(w0.y); v[3] = bfhi(w0.y); v[4] = bflo(w0.z); v[5] = bfhi(w0.z); v[6] = bflo(w0.w); v[7] = bfhi(w0.w);
#pragma unroll
                for (int i = 0; i < 8; ++i) ss += v[i] * v[i];
#pragma unroll
                for (int o = 32; o >= 1; o >>= 1) ss += __shfl_xor(ss, o);
                const float rstd = rsqrtf(ss * (1.0f / KVLORA) + EPSN);
                const float* g = P.mla_kv_a_norm + lane * 8; const f32x4 g0 = *(const f32x4*)g, g1 = *(const f32x4*)(g + 4); u32x4 w;
                w.x = pk2(v[0] * rstd * g0[0], v[1] * rstd * g0[1]); w.y = pk2(v[2] * rstd * g0[2], v[3] * rstd * g0[3]);
                w.z = pk2(v[4] * rstd * g1[0], v[5] * rstd * g1[1]); w.w = pk2(v[6] * rstd * g1[2], v[7] * rstd * g1[3]);
                *(u32x4*)(CKVN + (size_t)tok * KVLORA + lane * 8) = w;
                if (USE_FP8KV) { const float r16 = rstd * 16.0f; u32x2 b8;
                    b8.x = pk4_fp8(v[0] * r16 * g0[0], v[1] * r16 * g0[1], v[2] * r16 * g0[2], v[3] * r16 * g0[3]); b8.y = pk4_fp8(v[4] * r16 * g1[0], v[5] * r16 * g1[1], v[6] * r16 * g1[2], v[7] * r16 * g1[3]);
                    *(u32x2*)((unsigned char*)(P.ws + OFF_CKVN8) + (size_t)tok * KVLORA + lane * 8) = b8; }
            }
            {
                const int i = lane & 31;
                const float invf = exp2f(-(float)i * (13.287712379549449f / 32.0f));
                const float ang = (float)pos[t] * invf;
                const double rev = (double)ang * 0.15915494309189533576888;
                const float fr = (float)(rev - __builtin_rint(rev));
                const float sn = __builtin_amdgcn_sinf(fr), cs = __builtin_amdgcn_cosf(fr);
                const float x1 = bf1(kp1[t]), x2 = bf1(kp2[t]);
                float ssp = x1 * x1 + x2 * x2;
#pragma unroll
                for (int o = 16; o >= 1; o >>= 1) ssp += __shfl_xor(ssp, o);
                const float a = x1 * P.mla_k_norm[128 + i], c = x2 * P.mla_k_norm[160 + i];
                if (lane < 32) { ROPE[(size_t)tok * 64 + i] = cs; ROPE[(size_t)tok * 64 + 32 + i] = sn;
                    KPER[(size_t)tok * 64 + i] = a * cs - c * sn; KPER[(size_t)tok * 64 + 32 + i] = c * cs + a * sn;
                    if (lane == 0) SSPE[tok] = ssp; }
            }
        }
    }
}

DI void phase_mla_prep2(const Params& P, int bid, int nb) {
    const bf16_t* KNM = (const bf16_t*)(P.ws + OFF_KNM); const bf16_t* Y1 = (const bf16_t*)(P.ws + OFF_Y1);
    bf16_t* KM = (bf16_t*)(P.ws + OFF_KM); const float* ROPE = (const float*)(P.ws + OFF_ROPE);
    const int tid = tid_opaque(), grp = tid >> 3, j8 = tid & 7;
    for (int tok = bid; tok < MTOK; tok += nb) {
        const int b = tok / SEQ, s = tok % SEQ;
        float cs[8], sn[8];
#pragma unroll
        for (int e = 0; e < 8; ++e) { const int i = (8 * j8 + e) & 31; cs[e] = ROPE[(size_t)tok * 64 + i]; sn[e] = ROPE[(size_t)tok * 64 + 32 + i]; }
        {
            const bf16_t* kn = KNM + (size_t)tok * (NH * 128) + grp * 128;
            const bf16_t* kp = Y1 + (size_t)tok * N3P + C3_KPE;
            float v[24];
#pragma unroll
            for (int c = 0; c < 2; ++c) { const u32x4 w = *(const u32x4*)(kn + (j8 + 8 * c) * 8);
                v[c * 8 + 0] = bflo(w.x); v[c * 8 + 1] = bfhi(w.x); v[c * 8 + 2] = bflo(w.y); v[c * 8 + 3] = bfhi(w.y);
                v[c * 8 + 4] = bflo(w.z); v[c * 8 + 5] = bfhi(w.z); v[c * 8 + 6] = bflo(w.w); v[c * 8 + 7] = bfhi(w.w); }
            { const u32x4 w = *(const u32x4*)(kp + j8 * 8);
                v[16] = bflo(w.x); v[17] = bfhi(w.x); v[18] = bflo(w.y); v[19] = bfhi(w.y); v[20] = bflo(w.z); v[21] = bfhi(w.z); v[22] = bflo(w.w); v[23] = bfhi(w.w); }
            float ss = 0.f;
#pragma unroll
            for (int i = 0; i < 24; ++i) ss += v[i] * v[i];
            ss = sum8(ss);
            const float rstd = rsqrtf(ss * (1.0f / DK) + EPSN);
#pragma unroll
            for (int c = 0; c < 3; ++c)
#pragma unroll
                for (int e = 0; e < 8; ++e) v[c * 8 + e] *= rstd * P.mla_k_norm[(j8 + 8 * c) * 8 + e];
#pragma unroll
            for (int e = 0; e < 8; ++e) { const float mine = v[16 + e], other = __shfl_xor(mine, 4);
                v[16 + e] = (j8 < 4) ? (mine * cs[e] - other * sn[e]) : (mine * cs[e] + other * sn[e]); }
            st192(KM + ((size_t)(b * NH + grp) * SEQ + s) * DK, j8, v);
        }
    }
}
#ifndef ATT_THR
#define ATT_THR 30.0f
#endif
#ifndef ATT3_HOIST
#define ATT3_HOIST 1
#endif
#ifndef PROBE3_STORE2
#define PROBE3_STORE2 1
#endif
#ifndef PROBE3_UNITS
#define PROBE3_UNITS 1
#endif
#ifndef PROBE3_CMP
#define PROBE3_CMP 1
#endif
#ifndef PROBE3_SEL
#define PROBE3_SEL 1
#endif
#ifndef PROBE3_WIN
#define PROBE3_WIN 1
#endif
#ifndef EPI_HOIST
#define EPI_HOIST 0
#endif
#ifndef ATT3_KD
#define ATT3_KD 4
#endif
#ifndef ATT3_VD
#define ATT3_VD 4
#endif
#ifndef ATT_PS_LIMIT
#define ATT_PS_LIMIT (16.0f * 1073741824.0f)
#endif
constexpr int KT_BYTES = 64 * 384, VT_BYTES = 128 * 128;
constexpr int L_K = 0, L_V = 2 * KT_BYTES, L_LUT = L_V + 2 * VT_BYTES, LUT_PITCH = 129, L_X = L_LUT + 64 * LUT_PITCH * 4 + 16, L_IL = L_X + 16 * 16 * 64 * 2, L_END = L_IL + 16 * 16 * 4;
static_assert(L_END <= 151552, "attention LDS");
enum { MODE_MLA = 0, MODE_SEL = 3, MODE_WIN = 4, MODE_CMPX = 5 };
#define MFMA16(a, b, c) __builtin_amdgcn_mfma_f32_16x16x32_bf16((a), (b), (c), 0, 0, 0)

struct AttnLane3 {
    int tw0, tw1;
    int r16, g;
    const LAS float* lutrow;
    unsigned long long mk0, mk1;
    int curblk;
    int tokbase;
    mutable float carry[2];
};
template <int MODE> DI int tq_of(const AttnLane3& A, int qb) { return (MODE == MODE_MLA) ? A.tw0 + 16 * qb + A.r16 : A.tw0 + qb; }

template <int MODE, int QS>
DI void attn_tile3(const LAS unsigned char* kb, const LAS unsigned char* vb, LAS unsigned char* lds, int j, const bf16x8 (&q)[2][6], f32x4 (&o)[8][2], float (&m_run)[2], float (&l_run)[2], const AttnLane3& A) {
    constexpr bool Q0 = (QS & 1) != 0, Q1 = (QS & 2) != 0;
    const int r16 = A.r16, g = A.g, sw = (r16 >> 1) & 7;
    const int kb0 = r16 * 384 + ((g ^ sw) << 4), kb1 = r16 * 384 + (((g ^ sw) ^ 4) << 4);
    const int vb0 = r16 * 128 + ((g ^ sw) << 4), vb1 = r16 * 128 + (((g ^ sw) ^ 4) << 4);
    f32x4 s[4][2];
    bool zinit = true;
    if (MODE == MODE_WIN || MODE == MODE_SEL) zinit = (A.tw0 - (64 * j + 63) >= 113);
    else if (MODE == MODE_CMPX) zinit = (A.tw0 - 31 - 16 * (64 * j + 63) >= 113);
    if (zinit) {
#pragma unroll
        for (int k4 = 0; k4 < 4; ++k4) { s[k4][0] = (f32x4){0.f, 0.f, 0.f, 0.f}; s[k4][1] = (f32x4){0.f, 0.f, 0.f, 0.f}; }
    } else {
#pragma unroll
        for (int qb = 0; qb < 2; ++qb) { if ((qb == 0 && !Q0) || (qb == 1 && !Q1)) continue;
            const int tq = tq_of<MODE>(A, qb);
#pragma unroll
            for (int k4 = 0; k4 < 4; ++k4)
#pragma unroll
                for (int r = 0; r < 4; ++r) { int d;
                    if (MODE == MODE_CMPX) d = tq - 31 - 16 * (64 * j + 16 * k4 + 4 * g + r); else d = tq - (64 * j + 16 * k4 + 4 * g + r);
                    d = d < 0 ? 0 : (d > 127 ? 127 : d); s[k4][qb][r] = A.lutrow[d] - m_run[qb]; } }
    }
    {
        constexpr int KD = ATT3_KD;
        bf16x8 kf[KD + 1];
#pragma unroll
        for (int i = 0; i < KD; ++i) kf[i] = *(const LAS bf16x8*)(kb + (((i % 6) & 1) ? kb1 : kb0) + ((i % 6) >> 1) * 128 + (i / 6) * (16 * 384));
        __builtin_amdgcn_sched_barrier(0);
#pragma unroll
        for (int i = 0; i < 24; ++i) {
            if (i + KD < 24) { const int n_ = i + KD; kf[n_ % (KD + 1)] = *(const LAS bf16x8*)(kb + (((n_ % 6) & 1) ? kb1 : kb0) + ((n_ % 6) >> 1) * 128 + (n_ / 6) * (16 * 384)); }
            __builtin_amdgcn_sched_barrier(0);
            if (Q0) s[i / 6][0] = MFMA16(kf[i % (KD + 1)], q[0][i % 6], s[i / 6][0]);
            if (Q1) s[i / 6][1] = MFMA16(kf[i % (KD + 1)], q[1][i % 6], s[i / 6][1]);
            __builtin_amdgcn_sched_barrier(0);
        }
    }
    if (zinit && __any(m_run[0] != 0.f || m_run[1] != 0.f)) {
#pragma unroll
        for (int k4 = 0; k4 < 4; ++k4)
#pragma unroll
            for (int r = 0; r < 4; ++r) { s[k4][0][r] -= m_run[0]; s[k4][1][r] -= m_run[1]; }
    }
    {
        const float NEG = -__builtin_inff();
        bool need;
        if (MODE == MODE_MLA) need = (64 * j + 63 > A.tw0);
        else if (MODE == MODE_WIN) need = !(64 * j + 63 <= A.tw0 && 64 * j >= A.tw1 - 511);
        else if (MODE == MODE_SEL) need = (j == A.curblk);
        else need = (A.tw0 - 31 - 16 * (64 * j + 63) < 0);
        if (need) {
#pragma unroll
            for (int qb = 0; qb < 2; ++qb) { if ((qb == 0 && !Q0) || (qb == 1 && !Q1)) continue;
                const int tq = tq_of<MODE>(A, qb);
#pragma unroll
                for (int k4 = 0; k4 < 4; ++k4)
#pragma unroll
                    for (int r = 0; r < 4; ++r) { const int c = 64 * j + 16 * k4 + 4 * g + r; bool kill;
                        if (MODE == MODE_WIN) kill = (unsigned)(tq - c) >= 512u;
                        else if (MODE == MODE_CMPX) kill = (tq - 31 - 16 * c) < 0;
                        else kill = (tq - c) < 0;
                        s[k4][qb][r] = kill ? NEG : s[k4][qb][r]; } }
        }
    }
    u32x4 pw[2][2];
#pragma unroll
    for (int qb = 0; qb < 2; ++qb) { if ((qb == 0 && !Q0) || (qb == 1 && !Q1)) continue;
        if (MODE == MODE_CMPX) {
            float lmx = fmaxf(fmaxf(s[0][qb][0], s[0][qb][1]), fmaxf(s[0][qb][2], s[0][qb][3]));
#pragma unroll
            for (int k4 = 1; k4 < 4; ++k4) lmx = fmaxf(lmx, fmaxf(fmaxf(s[k4][qb][0], s[k4][qb][1]), fmaxf(s[k4][qb][2], s[k4][qb][3])));
            if (__any(lmx > ATT_THR)) {
                float mx = fmaxf(lmx, __shfl_xor(lmx, 16)); mx = fmaxf(mx, __shfl_xor(mx, 32));
                const float dl = fmaxf(mx, 0.f), alpha = __builtin_amdgcn_exp2f(-dl);
                m_run[qb] += dl; l_run[qb] *= alpha; A.carry[qb] *= alpha;
#pragma unroll
                for (int db = 0; db < 8; ++db) o[db][qb] *= alpha;
#pragma unroll
                for (int k4 = 0; k4 < 4; ++k4) s[k4][qb] -= dl;
                LAS bf16_t* X = (LAS bf16_t*)(lds + L_X) + ((A.tokbase + qb) * 16 + r16) * 64;
                for (int a = g; a < 16 * j; a += 4) X[a] = (bf16_t)(pk2(bf1(X[a]) * alpha, 0.f) & 0xffffu);
            }
        }
        float ps = 0.f; f32x4 e[4];
#pragma unroll
        for (int k4 = 0; k4 < 4; ++k4) { e[k4][0] = __builtin_amdgcn_exp2f(s[k4][qb][0]); e[k4][1] = __builtin_amdgcn_exp2f(s[k4][qb][1]); e[k4][2] = __builtin_amdgcn_exp2f(s[k4][qb][2]); e[k4][3] = __builtin_amdgcn_exp2f(s[k4][qb][3]);
            ps += (e[k4][0] + e[k4][1]) + (e[k4][2] + e[k4][3]); }
        if (MODE != MODE_CMPX) {
            if (__any(!(ps <= ATT_PS_LIMIT))) {
                float mx = fmaxf(fmaxf(s[0][qb][0], s[0][qb][1]), fmaxf(s[0][qb][2], s[0][qb][3]));
#pragma unroll
                for (int k4 = 1; k4 < 4; ++k4) mx = fmaxf(mx, fmaxf(fmaxf(s[k4][qb][0], s[k4][qb][1]), fmaxf(s[k4][qb][2], s[k4][qb][3])));
                mx = fmaxf(mx, __shfl_xor(mx, 16)); mx = fmaxf(mx, __shfl_xor(mx, 32));
                const float dl = fmaxf(mx, 0.f), alpha = __builtin_amdgcn_exp2f(-dl);
                m_run[qb] += dl; l_run[qb] *= alpha;
#pragma unroll
                for (int db = 0; db < 8; ++db) o[db][qb] *= alpha;
                ps = 0.f;
#pragma unroll
                for (int k4 = 0; k4 < 4; ++k4) { e[k4][0] = __builtin_amdgcn_exp2f(s[k4][qb][0] - dl); e[k4][1] = __builtin_amdgcn_exp2f(s[k4][qb][1] - dl); e[k4][2] = __builtin_amdgcn_exp2f(s[k4][qb][2] - dl); e[k4][3] = __builtin_amdgcn_exp2f(s[k4][qb][3] - dl);
                    ps += (e[k4][0] + e[k4][1]) + (e[k4][2] + e[k4][3]); }
            }
        } else {
            LAS bf16_t* X = (LAS bf16_t*)(lds + L_X) + ((A.tokbase + qb) * 16 + r16) * 64;
#pragma unroll
            for (int k4 = 0; k4 < 4; ++k4) {
                const float y = __shfl(e[k4][3], (r16 + 16 * g + 48) & 63);
                const float prev = g ? y : A.carry[qb];
                if (g == 0) A.carry[qb] = y;
                X[16 * j + 4 * k4 + g] = (bf16_t)(pk2((e[k4][0] + e[k4][1]) + (e[k4][2] + e[k4][3]) + prev, 0.f) & 0xffffu);
            }
        }
        l_run[qb] += ps;
        pw[0][qb].x = pk2(e[0][0], e[0][1]); pw[0][qb].y = pk2(e[0][2], e[0][3]); pw[0][qb].z = pk2(e[1][0], e[1][1]); pw[0][qb].w = pk2(e[1][2], e[1][3]);
        pw[1][qb].x = pk2(e[2][0], e[2][1]); pw[1][qb].y = pk2(e[2][2], e[2][3]); pw[1][qb].z = pk2(e[3][0], e[3][1]); pw[1][qb].w = pk2(e[3][2], e[3][3]);
    }
    {
        constexpr int VD = ATT3_VD;
        bf16x8 vf[VD + 1];
#pragma unroll
        for (int i = 0; i < VD; ++i) vf[i] = *(const LAS bf16x8*)(vb + ((i >> 3) ? vb1 : vb0) + (i & 7) * (16 * 128));
        __builtin_amdgcn_sched_barrier(0);
#pragma unroll
        for (int i = 0; i < 16; ++i) {
            if (i + VD < 16) { const int n_ = i + VD; vf[n_ % (VD + 1)] = *(const LAS bf16x8*)(vb + ((n_ >> 3) ? vb1 : vb0) + (n_ & 7) * (16 * 128)); }
            __builtin_amdgcn_sched_barrier(0);
            if (Q0) o[i & 7][0] = MFMA16(vf[i % (VD + 1)], __builtin_bit_cast(bf16x8, pw[i >> 3][0]), o[i & 7][0]);
            if (Q1) o[i & 7][1] = MFMA16(vf[i % (VD + 1)], __builtin_bit_cast(bf16x8, pw[i >> 3][1]), o[i & 7][1]);
            __builtin_amdgcn_sched_barrier(0);
        }
    }
}

DI void attn_issue_first(LAS unsigned char* lds, const char* __restrict__ Kc, const char* __restrict__ Vc, int vt_stride, int j) {
    int tid = threadIdx.x; asm volatile("" : "+v"(tid));
    const int lane = tid & 63;
    const int wid_ = __builtin_amdgcn_readfirstlane(tid >> 6);
    const char* kp_ = Kc + (size_t)j * KT_BYTES; LAS unsigned char* kb_ = lds + L_K + wid_ * 3072;
#pragma unroll
    for (int i_ = 0; i_ < 3; ++i_) { const int pidx_ = (wid_ * 3 + i_) * 64 + lane, row_ = pidx_ / 24, cp_ = pidx_ % 24;
        __builtin_amdgcn_global_load_lds((const unsigned*)(kp_ + (unsigned)(row_ * 384 + ((cp_ ^ ((row_ >> 1) & 7)) << 4))), (LAS unsigned*)(kb_ + i_ * 1024), 16, 0, 0); }
    const char* vp_ = Vc + (size_t)j * 128; LAS unsigned char* vb_ = lds + L_V + wid_ * 2048;
#pragma unroll
    for (int i_ = 0; i_ < 2; ++i_) { const int pidx_ = (wid_ * 2 + i_) * 64 + lane, row_ = pidx_ >> 3, cp_ = pidx_ & 7;
        __builtin_amdgcn_global_load_lds((const unsigned*)(vp_ + (unsigned)(row_ * vt_stride * 2 + ((cp_ ^ ((row_ >> 1) & 7)) << 4))), (LAS unsigned*)(vb_ + i_ * 1024), 16, 0, 0); }
}

template <int MODE>
DI void attn_pass3x(LAS unsigned char* lds, const char* __restrict__ Kc, const char* __restrict__ Vc, int vt_stride, int j_lo, int j_hi,
                    const bf16x8 (&q)[2][6], f32x4 (&o)[8][2], float (&m_run)[2], float (&l_run)[2], const AttnLane3& A, bool first_issued = false) {
    if (j_lo >= j_hi) return;
    int tid = threadIdx.x; asm volatile("" : "+v"(tid));
    const int lane = tid & 63;
    const int wid_ = __builtin_amdgcn_readfirstlane(tid >> 6);
    unsigned kgo[3], vgo[2];
#pragma unroll
    for (int i_ = 0; i_ < 3; ++i_) { const int pidx_ = (wid_ * 3 + i_) * 64 + lane, row_ = pidx_ / 24, cp_ = pidx_ % 24; kgo[i_] = (unsigned)(row_ * 384 + ((cp_ ^ ((row_ >> 1) & 7)) << 4)); }
#pragma unroll
    for (int i_ = 0; i_ < 2; ++i_) { const int pidx_ = (wid_ * 2 + i_) * 64 + lane, row_ = pidx_ >> 3, cp_ = pidx_ & 7; vgo[i_] = (unsigned)(row_ * vt_stride * 2 + ((cp_ ^ ((row_ >> 1) & 7)) << 4)); }
#define ST_ISSUE(j, buf) do { const char* kp_ = Kc + (size_t)(j) * KT_BYTES; LAS unsigned char* kb_ = lds + L_K + (buf) * KT_BYTES + wid_ * 3072; \
        _Pragma("unroll") for (int i_ = 0; i_ < 3; ++i_) __builtin_amdgcn_global_load_lds((const unsigned*)(kp_ + kgo[i_]), (LAS unsigned*)(kb_ + i_ * 1024), 16, 0, 0); \
        const char* vp_ = Vc + (size_t)(j) * 128; LAS unsigned char* vb_ = lds + L_V + (buf) * VT_BYTES + wid_ * 2048; \
        _Pragma("unroll") for (int i_ = 0; i_ < 2; ++i_) __builtin_amdgcn_global_load_lds((const unsigned*)(vp_ + vgo[i_]), (LAS unsigned*)(vb_ + i_ * 1024), 16, 0, 0); } while (0)
    if (!first_issued) ST_ISSUE(j_lo, 0);
    asm volatile("s_waitcnt vmcnt(0)" ::: "memory");
    __syncthreads();
    for (int j = j_lo; j < j_hi; ++j) {
        const int cur = (j - j_lo) & 1;
        if (j + 1 < j_hi) ST_ISSUE(j + 1, cur ^ 1);
        const LAS unsigned char* kbp = lds + L_K + cur * KT_BYTES; const LAS unsigned char* vbp = lds + L_V + cur * VT_BYTES;
        if (MODE == MODE_SEL) {
            const bool a0 = ((A.mk0 >> j) & 1ull) != 0ull, a1 = ((A.mk1 >> j) & 1ull) != 0ull;
            if (a0 && a1) attn_tile3<MODE, 3>(kbp, vbp, lds, j, q, o, m_run, l_run, A);
            else if (a0) attn_tile3<MODE, 1>(kbp, vbp, lds, j, q, o, m_run, l_run, A);
            else if (a1) attn_tile3<MODE, 2>(kbp, vbp, lds, j, q, o, m_run, l_run, A);
        } else {
            bool act;
            if (MODE == MODE_MLA) act = 64 * j <= A.tw1;
            else if (MODE == MODE_CMPX) act = 1024 * j + 31 <= A.tw1;
            else act = (64 * j <= A.tw1) && (64 * j + 63 >= A.tw0 - 511);
            if (act) attn_tile3<MODE, 3>(kbp, vbp, lds, j, q, o, m_run, l_run, A);
        }
        asm volatile("s_waitcnt vmcnt(0)" ::: "memory");
        __syncthreads();
    }
#undef ST_ISSUE
}

DI int t5_bucket(int n) {
    if (n < 16) return n;
    return 16 + (n >= 19) + (n >= 21) + (n >= 24) + (n >= 27) + (n >= 31) + (n >= 35) + (n >= 40) + (n >= 46) + (n >= 52) + (n >= 59) + (n >= 67) + (n >= 77) + (n >= 87) + (n >= 99) + (n >= 113);
}
DI float silu_f(float z) { return z * __builtin_amdgcn_rcpf(1.0f + __builtin_amdgcn_exp2f(-1.4426950408889634f * z)); }

constexpr int EPI_PITCH = 272, EPI_WAVE_BYTES = 32 * EPI_PITCH;
template <bool RMW, bool NSA, int F8 = 0>
DI void attn_epilogue3(LAS unsigned char* lds, int lane, int wid, const f32x4 (&o)[8][2], float scale0, float scale1,
                       const char* __restrict__ zbase, unsigned z0, char* __restrict__ obase, unsigned o0, bool dostore = true, char* __restrict__ o8base = nullptr, float o8s = O8_SCALE, bool both = true) {
    asm volatile("" : "+v"(lane));
    LAS unsigned char* sc = lds + wid * EPI_WAVE_BYTES;
    const int r16 = lane & 15, g = lane >> 4;
#if EPI_HOIST
    u32x4 zwh[2][4], pvh[2][4];
    if (dostore) {
#pragma unroll
        for (int h = 0; h < 2; ++h)
#pragma unroll
            for (int i = 0; i < 4; ++i) {
                const int rr = 8 * i + (lane >> 3), c8 = lane & 7;
                unsigned zoff, ooff;
                if (NSA) { zoff = z0 + (unsigned)((rr >> 4) * (N1P * 2) + (rr & 15) * 256); ooff = o0 + (unsigned)((rr >> 4) * (ZW8 * 2) + (rr & 15) * 256); }
                else     { zoff = z0 + (unsigned)(rr * (N3P * 2)); ooff = o0 + (unsigned)(rr * (ZW8 * 2)); }
                const unsigned cb = (unsigned)((64 * h + 8 * c8) * 2);
                zwh[h][i] = *(const u32x4*)(zbase + (zoff + cb));
                if (RMW && EPI_HOIST >= 2) pvh[h][i] = *(const u32x4*)(obase + (ooff + cb));
            }
    }
#endif
#pragma unroll
    for (int h = 0; h < 2; ++h) {
#pragma unroll
        for (int d4 = 0; d4 < 4; ++d4) {
            *(LAS f32x4*)(sc + r16 * EPI_PITCH + (16 * d4 + 4 * g) * 4) = o[4 * h + d4][0] * scale0;
            *(LAS f32x4*)(sc + (16 + r16) * EPI_PITCH + (16 * d4 + 4 * g) * 4) = o[4 * h + d4][1] * scale1;
        }
        asm volatile("" ::: "memory");
#pragma unroll
        for (int i = 0; i < 4; ++i) {
            const int rr = 8 * i + (lane >> 3), c8 = lane & 7;
            const f32x4 a = *(const LAS f32x4*)(sc + rr * EPI_PITCH + c8 * 32);
            const f32x4 b = *(const LAS f32x4*)(sc + rr * EPI_PITCH + c8 * 32 + 16);
            unsigned zoff, ooff;
            if (NSA) { zoff = z0 + (unsigned)((rr >> 4) * (N1P * 2) + (rr & 15) * 256); ooff = o0 + (unsigned)((rr >> 4) * (ZW8 * 2) + (rr & 15) * 256); }
            else     { zoff = z0 + (unsigned)(rr * (N3P * 2)); ooff = o0 + (unsigned)(rr * (ZW8 * 2)); }
            const unsigned cb = (unsigned)((64 * h + 8 * c8) * 2);
            if (!dostore) continue;
#if EPI_HOIST
            const u32x4 zw = zwh[h][i];
#else
            const u32x4 zw = *(const u32x4*)(zbase + (zoff + cb));
#endif
            float v0 = a[0] * silu_f(bflo(zw.x)), v1 = a[1] * silu_f(bfhi(zw.x)), v2 = a[2] * silu_f(bflo(zw.y)), v3 = a[3] * silu_f(bfhi(zw.y));
            float v4 = b[0] * silu_f(bflo(zw.z)), v5 = b[1] * silu_f(bfhi(zw.z)), v6 = b[2] * silu_f(bflo(zw.w)), v7 = b[3] * silu_f(bfhi(zw.w));
            if (RMW) {
#if EPI_HOIST >= 2
                const u32x4 pv = pvh[h][i];
#else
                const u32x4 pv = *(const u32x4*)(obase + (ooff + cb));
#endif
                v0 += bflo(pv.x); v1 += bfhi(pv.x); v2 += bflo(pv.y); v3 += bfhi(pv.y); v4 += bflo(pv.z); v5 += bfhi(pv.z); v6 += bflo(pv.w); v7 += bfhi(pv.w); }
            if (F8) { u32x2 w8; w8.x = pk4_fp8c(v0 * o8s, v1 * o8s, v2 * o8s, v3 * o8s); w8.y = pk4_fp8c(v4 * o8s, v5 * o8s, v6 * o8s, v7 * o8s);
                *(u32x2*)(o8base + ((ooff + cb) >> 1)) = w8; if (F8 == 1) continue; }
            u32x4 w; w.x = pk2(v0, v1); w.y = pk2(v2, v3); w.z = pk2(v4, v5); w.w = pk2(v6, v7);
            if (F8 != 2 || both) *(u32x4*)(obase + (ooff + cb)) = w;
        }
        asm volatile("" ::: "memory");
    }
}
DI float sum_g(float v) { v += __shfl_xor(v, 16); v += __shfl_xor(v, 32); return v; }

DI void phase_nsa_attn(LAS unsigned char* lds, const Params& P, int bid, int nb) {
    const char* Y0c = (const char*)(P.ws + OFF_Y0);
    const char* KSc = (const char*)(P.ws + OFF_KS); const char* KWc = (const char*)(P.ws + OFF_KW);
    const char* VTSc = (const char*)(P.ws + OFF_VTS); const char* VTWc = (const char*)(P.ws + OFF_VTW);
    const char* KCc = (const char*)(P.ws + OFF_KC); const char* VTCc = (const char*)(P.ws + OFF_VTC);
    char* ONc = (char*)(P.ws + OFF_O);
    LAS float* lut = (LAS float*)(lds + L_LUT);
    const int total = BATCH * NG * 256;
    {
        const int tid0 = tid_opaque();
        __syncthreads();
        for (int i = tid0; i < 64 * 128; i += 512) { const int hd = i >> 7, d = i & 127; lut[hd * LUT_PITCH + d] = (P.rel_bias[t5_bucket(d) * NH + hd] - P.rel_bias[31 * NH + hd]) * LOG2E; }
        __syncthreads();
    }
    for (int u_ = bid; u_ < total * PROBE3_UNITS; u_ += nb) {
        const int u = (u_ >= total) ? u_ - total : u_;
        int tid = threadIdx.x; asm volatile("" : "+v"(tid));
        const int lane = tid & 63, wid = __builtin_amdgcn_readfirstlane(tid >> 6);
        const int pair = u >> 8; int c = u & 255; if (pair & 1) c = 255 - c;
        const int b = pair >> 2, gg = pair & 3, t0 = c * 16;
        __syncthreads();
        AttnLane3 A;
        A.r16 = lane & 15; A.g = lane >> 4;
        A.tw0 = t0 + 2 * wid; A.tw1 = A.tw0 + 1;
        const int hh = gg * NR + A.r16;
        A.lutrow = lut + hh * LUT_PITCH;
        A.curblk = t0 >> 6; A.tokbase = 2 * wid; A.mk0 = 0ull; A.mk1 = 0ull; A.carry[0] = 0.f; A.carry[1] = 0.f;
        const unsigned ytok0 = (unsigned)(b * SEQ + A.tw0) * (unsigned)(N1P * 2);
        const unsigned otok0 = ((unsigned)(b * SEQ + A.tw0) * (unsigned)ZW8 + (unsigned)(gg * NR * DV)) * 2u;
        const int bg = b * NG + gg;
        const int nct = (t0 + 15 >= 31) ? (((t0 + 15 - 31) >> 4) / 64 + 1) : 0;
        if (ATT3_HOIST && nct > 0) attn_issue_first(lds, KCc + (size_t)bg * 256 * DK * 2, VTCc + (size_t)bg * DV * 256 * 2, 256, 0);
        bf16x8 q[2][6];
#pragma unroll
        for (int qb = 0; qb < 2; ++qb) {
            const unsigned qo = ytok0 + (unsigned)(qb * (N1P * 2)) + (unsigned)((C_Q + hh * DK + 8 * A.g) * 2);
            float ss = 0.f;
#pragma unroll
            for (int ds = 0; ds < 6; ++ds) { q[qb][ds] = *(const bf16x8*)(Y0c + (qo + 64u * ds));
                const u32x4 w = __builtin_bit_cast(u32x4, q[qb][ds]);
                const float a0 = bflo(w.x), a1 = bfhi(w.x), a2 = bflo(w.y), a3 = bfhi(w.y), a4 = bflo(w.z), a5 = bfhi(w.z), a6 = bflo(w.w), a7 = bfhi(w.w);
                ss += (a0 * a0 + a1 * a1) + (a2 * a2 + a3 * a3) + (a4 * a4 + a5 * a5) + (a6 * a6 + a7 * a7); }
            ss = sum_g(ss);
            const float rstd = rsqrtf(ss * (1.0f / DK) + EPSN) * QSCALE;
#pragma unroll
            for (int ds = 0; ds < 6; ++ds) { const float* gn = P.nsa_q_norm + 32 * ds + 8 * A.g; const f32x4 g0 = *(const f32x4*)gn, g1 = *(const f32x4*)(gn + 4);
                u32x4 w = __builtin_bit_cast(u32x4, q[qb][ds]);
                w.x = pk2(bflo(w.x) * rstd * g0[0], bfhi(w.x) * rstd * g0[1]); w.y = pk2(bflo(w.y) * rstd * g0[2], bfhi(w.y) * rstd * g0[3]);
                w.z = pk2(bflo(w.z) * rstd * g1[0], bfhi(w.z) * rstd * g1[1]); w.w = pk2(bflo(w.w) * rstd * g1[2], bfhi(w.w) * rstd * g1[3]);
                q[qb][ds] = __builtin_bit_cast(bf16x8, w); }
        }
        f32x4 o[8][2]; float m_run[2], l_run[2];
#define RESET_STATE() do { _Pragma("unroll") for (int d_ = 0; d_ < 8; ++d_) { o[d_][0] = (f32x4){0.f, 0.f, 0.f, 0.f}; o[d_][1] = (f32x4){0.f, 0.f, 0.f, 0.f}; } m_run[0] = 0.f; m_run[1] = 0.f; l_run[0] = 0.f; l_run[1] = 0.f; } while (0)
#define GATE_SIG(x, qb) (1.0f / (1.0f + __expf(-bf1(*(const bf16_t*)(Y0c + (ytok0 + (unsigned)((qb) * (N1P * 2)) + (unsigned)((C_G + (x) * NH + hh) * 2)))))))
        RESET_STATE();
        attn_pass3x<MODE_CMPX>(lds, KCc + (size_t)bg * 256 * DK * 2, VTCc + (size_t)bg * DV * 256 * 2, 256, 0, nct, q, o, m_run, l_run, A, ATT3_HOIST != 0);
        { const float lt0 = sum_g(l_run[0]), lt1 = sum_g(l_run[1]); const float il0 = lt0 > 0.f ? 1.0f / lt0 : 0.f, il1 = lt1 > 0.f ? 1.0f / lt1 : 0.f;
          if (lane < 16) { ((LAS float*)(lds + L_IL))[(A.tokbase + 0) * 16 + A.r16] = il0; ((LAS float*)(lds + L_IL))[(A.tokbase + 1) * 16 + A.r16] = il1; }
          attn_epilogue3<false, true>(lds, lane, wid, o, GATE_SIG(0, 0) * il0, GATE_SIG(0, 1) * il1, Y0c, ytok0 + (unsigned)((C_ZC + gg * NR * DV) * 2), ONc, otok0, PROBE3_STORE2 || u_ < total); }
        __syncthreads();
        if (ATT3_HOIST) attn_issue_first(lds, KSc + (size_t)bg * SEQ * DK * 2, VTSc + (size_t)bg * DV * SEQ * 2, SEQ, 0);
        {
            const int cur = A.curblk;
            unsigned long long mk[2];
#pragma unroll
            for (int t = 0; t < 2; ++t) {
                const LAS bf16_t* X = (const LAS bf16_t*)(lds + L_X) + (2 * wid + t) * 16 * 64;
                const LAS float* IL = (const LAS float*)(lds + L_IL) + (2 * wid + t) * 16;
                const bool forced = (lane == 0) || (lane == cur) || (lane == cur - 1);
                const bool future = lane > cur;
                float v = 0.f;
                if (!forced && !future) {
#pragma unroll
                    for (int rr = 0; rr < 16; ++rr) v += IL[rr] * bf1(X[rr * 64 + lane]); }
                unsigned key = (__float_as_uint(v) & ~63u);
                if (forced) key = 0x7f800000u; else if (future) key = 0u;
                key |= (unsigned)(63 - lane);
                int rank = 0;
#pragma unroll
                for (int jp = 0; jp < 64; ++jp) { const unsigned kj = (unsigned)__builtin_amdgcn_readlane((int)key, jp); rank += (kj > key) ? 1 : 0; }
                mk[t] = __ballot(rank < 16 && !future);
            }
            A.mk0 = mk[0]; A.mk1 = mk[1];
        }
        RESET_STATE();
        attn_pass3x<MODE_SEL>(lds, KSc + (size_t)bg * SEQ * DK * 2, VTSc + (size_t)bg * DV * SEQ * 2, SEQ, 0, A.curblk + 1, q, o, m_run, l_run, A, ATT3_HOIST != 0);
        { const float lt0 = sum_g(l_run[0]), lt1 = sum_g(l_run[1]);
          attn_epilogue3<true, true>(lds, lane, wid, o, GATE_SIG(1, 0) / lt0, GATE_SIG(1, 1) / lt1, Y0c, ytok0 + (unsigned)((C_ZS + gg * NR * DV) * 2), ONc, otok0, PROBE3_STORE2 || u_ < total); }
        __syncthreads();
        RESET_STATE();
        { const int jl = (t0 - 511) > 0 ? (t0 - 511) >> 6 : 0, jh = ((t0 + 15) >> 6) + 1;
          for (int prb_ = 0; prb_ < PROBE3_WIN; ++prb_) attn_pass3x<MODE_WIN>(lds, KWc + (size_t)bg * SEQ * DK * 2, VTWc + (size_t)bg * DV * SEQ * 2, SEQ, jl, jh, q, o, m_run, l_run, A); }
        { const float lt0 = sum_g(l_run[0]), lt1 = sum_g(l_run[1]);
          attn_epilogue3<true, true, USE_FP8N ? 2 : 0>(lds, lane, wid, o, GATE_SIG(2, 0) / lt0, GATE_SIG(2, 1) / lt1, Y0c, ytok0 + (unsigned)((C_ZW + gg * NR * DV) * 2), ONc, otok0, PROBE3_STORE2 || u_ < total, (char*)(P.ws + OFF_O8N), O8N_SCALE, t0 < 256); }
#undef RESET_STATE
#undef GATE_SIG
    }
}

DI void phase_mla_attn(LAS unsigned char* lds, const Params& P, int bid, int nb) {
    const char* QMc = (const char*)(P.ws + OFF_QM); const char* KMc = (const char*)(P.ws + OFF_KM); const char* VTMc = (const char*)(P.ws + OFF_VTM);
    const char* Y1c = (const char*)(P.ws + OFF_Y1); char* OMc = (char*)(P.ws + OFF_O);
    const int total = BATCH * NH * 16;
    for (int uu = 0; bid + (uu >> 1) * nb < total / 2; ++uu) {
        int tid = threadIdx.x; asm volatile("" : "+v"(tid));
        const int lane = tid & 63, wid = __builtin_amdgcn_readfirstlane(tid >> 6);
        const int item = bid + (uu >> 1) * nb, second = uu & 1;
        const int xcd = item & 7, tt = item >> 3, p = tt & 7, hl = (tt >> 3) & 3, rnd = tt >> 5;
        const int bh = rnd * 32 + xcd * 4 + hl, qblk = second ? p : 15 - p, b = bh >> 6, h = bh & 63, t0 = qblk * 256;
        AttnLane3 A;
        A.r16 = lane & 15; A.g = lane >> 4;
        A.tw0 = t0 + 32 * wid; A.tw1 = A.tw0 + 31;
        A.lutrow = nullptr; A.curblk = 0; A.tokbase = 0; A.mk0 = 0ull; A.mk1 = 0ull; A.carry[0] = 0.f; A.carry[1] = 0.f;
        bf16x8 q[2][6];
#pragma unroll
        for (int qb = 0; qb < 2; ++qb) {
            const unsigned trow = (unsigned)(b * SEQ + A.tw0 + 16 * qb + A.r16);
            const unsigned qo = (trow * (unsigned)NQB + (unsigned)(h * DK + 8 * A.g)) * 2u;
            float ss = 0.f;
#pragma unroll
            for (int ds = 0; ds < 6; ++ds) { q[qb][ds] = *(const bf16x8*)(QMc + (qo + 64u * ds));
                const u32x4 w = __builtin_bit_cast(u32x4, q[qb][ds]);
                const float a0 = bflo(w.x), a1 = bfhi(w.x), a2 = bflo(w.y), a3 = bfhi(w.y), a4 = bflo(w.z), a5 = bfhi(w.z), a6 = bflo(w.w), a7 = bfhi(w.w);
                ss += (a0 * a0 + a1 * a1) + (a2 * a2 + a3 * a3) + (a4 * a4 + a5 * a5) + (a6 * a6 + a7 * a7); }
            ss = sum_g(ss);
            const float rstd = rsqrtf(ss * (1.0f / DK) + EPSN);
            const float* ropep = (const float*)(P.ws + OFF_ROPE) + (size_t)trow * 64;
#pragma unroll
            for (int ds = 0; ds < 4; ++ds) { const float* gn = P.mla_q_norm + 32 * ds + 8 * A.g; const f32x4 g0 = *(const f32x4*)gn, g1 = *(const f32x4*)(gn + 4);
                const float sc = rstd * QSCALE;
                u32x4 w = __builtin_bit_cast(u32x4, q[qb][ds]);
                w.x = pk2(bflo(w.x) * sc * g0[0], bfhi(w.x) * sc * g0[1]); w.y = pk2(bflo(w.y) * sc * g0[2], bfhi(w.y) * sc * g0[3]);
                w.z = pk2(bflo(w.z) * sc * g1[0], bfhi(w.z) * sc * g1[1]); w.w = pk2(bflo(w.w) * sc * g1[2], bfhi(w.w) * sc * g1[3]);
                q[qb][ds] = __builtin_bit_cast(bf16x8, w); }
            {
                const int i0 = 8 * A.g;
                const float* g1p = P.mla_q_norm + 128 + i0; const float* g2p = P.mla_q_norm + 160 + i0;
                const u32x4 w1 = __builtin_bit_cast(u32x4, q[qb][4]), w2 = __builtin_bit_cast(u32x4, q[qb][5]);
                float x1[8] = {bflo(w1.x), bfhi(w1.x), bflo(w1.y), bfhi(w1.y), bflo(w1.z), bfhi(w1.z), bflo(w1.w), bfhi(w1.w)};
                float x2[8] = {bflo(w2.x), bfhi(w2.x), bflo(w2.y), bfhi(w2.y), bflo(w2.z), bfhi(w2.z), bflo(w2.w), bfhi(w2.w)};
                float y1[8], y2[8];
#pragma unroll
                for (int e = 0; e < 8; ++e) { const float cs = ropep[i0 + e], sn = ropep[32 + i0 + e];
                    const float a = x1[e] * rstd * g1p[e], c = x2[e] * rstd * g2p[e];
                    y1[e] = (a * cs - c * sn) * QSCALE; y2[e] = (c * cs + a * sn) * QSCALE; }
                u32x4 o1, o2;
                o1.x = pk2(y1[0], y1[1]); o1.y = pk2(y1[2], y1[3]); o1.z = pk2(y1[4], y1[5]); o1.w = pk2(y1[6], y1[7]);
                o2.x = pk2(y2[0], y2[1]); o2.y = pk2(y2[2], y2[3]); o2.z = pk2(y2[4], y2[5]); o2.w = pk2(y2[6], y2[7]);
                q[qb][4] = __builtin_bit_cast(bf16x8, o1); q[qb][5] = __builtin_bit_cast(bf16x8, o2);
            }
        }
        f32x4 o[8][2]; float m_run[2] = {0.f, 0.f}, l_run[2] = {0.f, 0.f};
#pragma unroll
        for (int d = 0; d < 8; ++d) { o[d][0] = (f32x4){0.f, 0.f, 0.f, 0.f}; o[d][1] = (f32x4){0.f, 0.f, 0.f, 0.f}; }
        attn_pass3x<MODE_MLA>(lds, KMc + (size_t)bh * SEQ * DK * 2, VTMc + (size_t)bh * DV * SEQ * 2, SEQ, 0, 4 * qblk + 4, q, o, m_run, l_run, A);
        const float lt0 = sum_g(l_run[0]), lt1 = sum_g(l_run[1]);
        { const unsigned t0w = (unsigned)(b * SEQ + A.tw0);
          const unsigned zo_ = (t0w * (unsigned)N3P + (unsigned)(C3_Z + h * DV)) * 2u, oo_ = (t0w * (unsigned)ZW8 + (unsigned)(h * DV)) * 2u;
          if (USE_FP8O && qblk != 0) attn_epilogue3<false, false, 1>(lds, lane, wid, o, 1.0f / lt0, 1.0f / lt1, Y1c, zo_, OMc, oo_, true, (char*)(P.ws + OFF_O8M), O8_SCALE);
          else attn_epilogue3<false, false, 0>(lds, lane, wid, o, 1.0f / lt0, 1.0f / lt1, Y1c, zo_, OMc, oo_); }
        __syncthreads();
    }
}
constexpr int LDS_KN_OFF = 135168, LDS_ST_OFF = LDS_KN_OFF + 16384, LDS_BYTES = LDS_ST_OFF + 16;
constexpr int NPHASE = 14;

#ifndef PROBE_G1F8
#define PROBE_G1F8 0
#endif
#ifndef PROBE_G1F8_NOSTORE
#define PROBE_G1F8_NOSTORE 0
#endif
#ifndef TAIL_IN_P6
#define TAIL_IN_P6 USE_FP8N
#endif
#ifndef EPI_LINE128
#define EPI_LINE128 0
#endif
#ifndef KS_IN_P3
#define KS_IN_P3 0
#endif
#ifndef VT_IN_P3
#define VT_IN_P3 0
#endif
#ifndef USE_FP8M
#define USE_FP8M 0
#endif
#ifndef USE_FP8Z
#define USE_FP8Z 0
#endif
#ifndef DUP5
#define DUP5 0
#endif
#ifndef P3_GEMM_REP
#define P3_GEMM_REP 1
#endif
#ifndef P3_WCONV_REP
#define P3_WCONV_REP 1
#endif
DI void tail_wconv(LAS unsigned char* lds, const Params& P, int bid, int nb) {
    unsigned char* ws = P.ws;
    if (bid >= 64 && nb > 64) {
        phase_wconv(lds, P.mla_w_q_b, (bf16_t*)(ws + OFF_W4T), QLORA, NQB, NQB, bid - 64, nb - 64, 0.f, 0, USE_FP8Q ? (unsigned char*)(ws + OFF_W48) : nullptr, 0);
        phase_wconv(lds, P.mla_w_kv_b, (bf16_t*)(ws + OFF_W5K), KVLORA, NKVB / 2, NKVB / 2, bid - 64, nb - 64, 0.f, 2, USE_FP8KV ? (unsigned char*)(ws + OFF_W5K8) : nullptr, 0);
        phase_wconv(lds, P.mla_w_kv_b, (bf16_t*)(ws + OFF_W5V), KVLORA, NKVB / 2, NKVB / 2, bid - 64, nb - 64, 0.f, 1, USE_FP8KV ? (unsigned char*)(ws + OFF_W5V8) : nullptr, 0);
        phase_wconv(lds, P.mla_w_out, (bf16_t*)(ws + OFF_W6T), ZW8, DM, DM, bid - 64, nb - 64, (FP8EMU & 2) ? 64.0f : 0.f, 0, USE_FP8O ? (unsigned char*)(ws + OFF_W68) : nullptr, 0);
    } else if (nb <= 64) {
        phase_wconv(lds, P.mla_w_q_b, (bf16_t*)(ws + OFF_W4T), QLORA, NQB, NQB, bid, nb, 0.f, 0, USE_FP8Q ? (unsigned char*)(ws + OFF_W48) : nullptr, 0);
        phase_wconv(lds, P.mla_w_kv_b, (bf16_t*)(ws + OFF_W5K), KVLORA, NKVB / 2, NKVB / 2, bid, nb, 0.f, 2, USE_FP8KV ? (unsigned char*)(ws + OFF_W5K8) : nullptr, 0);
        phase_wconv(lds, P.mla_w_kv_b, (bf16_t*)(ws + OFF_W5V), KVLORA, NKVB / 2, NKVB / 2, bid, nb, 0.f, 1, USE_FP8KV ? (unsigned char*)(ws + OFF_W5V8) : nullptr, 0);
        phase_wconv(lds, P.mla_w_out, (bf16_t*)(ws + OFF_W6T), ZW8, DM, DM, bid, nb, (FP8EMU & 2) ? 64.0f : 0.f, 0, USE_FP8O ? (unsigned char*)(ws + OFF_W68) : nullptr, 0);
    }
}
template <int PH>
DI void run_phase(const Params& P, LAS unsigned char* lds, int bid, int nb) {
    unsigned char* ws = P.ws;
    if constexpr (PH == 0) {
        phase_wconv(lds, P.nsa_w_in, (bf16_t*)(ws + OFF_W1T), DM, N1, N1P, bid, nb, (FP8EMU & 4) ? 64.0f : 0.f, 0, USE_FP8Z ? (unsigned char*)(ws + OFF_B8) : nullptr, F8_Q0 * 256, (F8_Q0 + F8_NQ) * 256);
        phase_wconv(lds, P.w1_k, (bf16_t*)(ws + OFF_W1K), 6144, 192, 256, bid, nb);
        phase_wconv(lds, P.w1_v, (bf16_t*)(ws + OFF_W1V), 4096, 128, 256, bid, nb);
        phase_rmsnorm(P.x, P.norm_w, (bf16_t*)(ws + OFF_H), bid, nb, (FP8EMU & 4) ? 16.0f : 0.f, USE_FP8Z ? (unsigned char*)(ws + OFF_A8) : nullptr);
    } else if constexpr (PH == 1) {
        if (USE_FP8Z) {
            {
                pg8::Gemm g{(const bf16_t*)(ws + OFF_H), (const bf16_t*)(ws + OFF_W1T), MTOK, N1P, DM};
                pg8::OrderBf16Part S{nb, bid, F8_Q0, F8_NQ, N1P / 256 - F8_NQ};
                pg8::EpiStoreBf16 E{(bf16_t*)(ws + OFF_Y0), N1P};
                pg8::gemm_phase<pg8::EpiStoreBf16, pg8::OrderBf16Part, false>(lds, g, S, E, nullptr, GEMM_STAG);
            }
            __syncthreads();
            {
                pg8::Gemm g{(const bf16_t*)(ws + OFF_A8), (const bf16_t*)(ws + OFF_B8), MTOK, N1P, DM / 2};
                pg8::OrderFp8Part S{nb, bid, F8_Q0, F8_NQ, N1P / 256 - F8_NQ, (256 - ((F8_NQ * 64 + (N1P / 256 - F8_NQ) * 4) & 255)) & 255};
#if EPI_LINE128
                pg8::EpiStoreBf16Fp8L E{(bf16_t*)(ws + OFF_Y0), N1P, 1.0f / (16.0f * 64.0f)};
                pg8::gemm_phase<pg8::EpiStoreBf16Fp8L, pg8::OrderFp8Part, false>(lds, g, S, E, nullptr);
#else
                pg8::EpiStoreBf16Fp8 E{(bf16_t*)(ws + OFF_Y0), N1P, 1.0f / (16.0f * 64.0f)};
                pg8::gemm_phase<pg8::EpiStoreBf16Fp8, pg8::OrderFp8Part, false>(lds, g, S, E, nullptr);
#endif
            }
        } else {
        pg8::Gemm g{(const bf16_t*)(ws + OFF_H), (const bf16_t*)(ws + OFF_W1T), MTOK, N1P, DM};
        pg8::StaticOrder S; S.init(g.M, g.N, nb, bid);
        pg8::EpiStoreBf16 E{(bf16_t*)(ws + OFF_Y0), N1P};
        pg8::gemm_phase<pg8::EpiStoreBf16, pg8::StaticOrder, false>(lds, g, S, E, nullptr);
        }
    } else if constexpr (PH == 2) {
        if (KS_IN_P3 && nb > 32) phase_nsa_prep<1>(P, bid, nb); else phase_nsa_prep<-1>(P, bid, nb);
        if (!VT_IN_P3 || nb <= 32) {
        phase_vt(lds, (const bf16_t*)(ws + OFF_Y0), N1P, C_KVS + NG * DK, DV, NG, (bf16_t*)(ws + OFF_VTS), bid, nb);
        phase_vt(lds, (const bf16_t*)(ws + OFF_Y0), N1P, C_KVW + NG * DK, DV, NG, (bf16_t*)(ws + OFF_VTW), bid, nb);
        }
    } else if constexpr (PH == 3) {
        for (int p3g_ = 0; p3g_ < ((bid < 32) ? P3_GEMM_REP : P3_WCONV_REP); ++p3g_) { if (p3g_) __syncthreads();
        if (bid < 16) {
            pg8::Gemm g{(const bf16_t*)(ws + OFF_ACK), (const bf16_t*)(ws + OFF_W1K), 4096, 256, 6144};
            pg8::StaticOrder S; S.init(g.M, g.N, 16, bid);
            pg8::EpiPlainF32 E{(float*)(ws + OFF_HIDK), 256};
            pg8::gemm_phase<pg8::EpiPlainF32, pg8::StaticOrder, false>(lds, g, S, E, nullptr);
        } else if (bid < 32) {
            pg8::Gemm g{(const bf16_t*)(ws + OFF_ACV), (const bf16_t*)(ws + OFF_W1V), 4096, 256, 4096};
            pg8::StaticOrder S; S.init(g.M, g.N, 16, bid - 16);
            pg8::EpiPlainF32 E{(float*)(ws + OFF_HIDV), 256};
            pg8::gemm_phase<pg8::EpiPlainF32, pg8::StaticOrder, false>(lds, g, S, E, nullptr);
        } else {
            if (KS_IN_P3 && p3g_ == 0) phase_nsa_prep<0>(P, bid - 32, nb - 32);
            if (VT_IN_P3 && p3g_ == 0) {
                phase_vt(lds, (const bf16_t*)(ws + OFF_Y0), N1P, C_KVS + NG * DK, DV, NG, (bf16_t*)(ws + OFF_VTS), bid - 32, nb - 32);
                phase_vt(lds, (const bf16_t*)(ws + OFF_Y0), N1P, C_KVW + NG * DK, DV, NG, (bf16_t*)(ws + OFF_VTW), bid - 32, nb - 32);
                __syncthreads();
            }
            phase_wconv(lds, P.nsa_w_out, (bf16_t*)(ws + OFF_W2T), ZW8, DM, DM, bid - 32, nb - 32, (FP8EMU & 1) ? 64.0f : 0.f, 0, USE_FP8N ? (unsigned char*)(ws + OFF_W28) : nullptr, 0);
            phase_wconv(lds, P.mla_w_in, (bf16_t*)(ws + OFF_W3T), DM, N3, N3P, bid - 32, nb - 32, (FP8EMU & 8) ? 64.0f : 0.f, 0, USE_FP8M ? (unsigned char*)(ws + OFF_B8M) : nullptr, 0, C3_Z8);
        }
        }
    } else if constexpr (PH == 4) {
        phase_cmp2(lds, P, bid, nb);
    } else if constexpr (PH == 5) {
        { float* ss1 = (float*)(ws + OFF_SS1); for (int i = bid * 512 + (int)threadIdx.x; i < MTOK; i += nb * 512) ss1[i] = 0.f; }
        phase_nsa_attn(lds, P, bid, nb);
    } else if constexpr (PH == 6) {
        if (USE_FP8N) {
            {
                pg8::Gemm g{(const bf16_t*)(ws + OFF_O), (const bf16_t*)(ws + OFF_W2T), MTOK, DM, ZW8};
                pg8::OrderBf16Part S{nb, bid, 0, 0, DM / 256};
                pg8::EpiResNorm E{P.x, P.out, DM, P.norm_w + DM, (bf16_t*)(ws + OFF_H), (float*)(ws + OFF_SS1), USE_FP8M ? (unsigned char*)(ws + OFF_A8M) : nullptr, 1.0f};
                pg8::gemm_phase<pg8::EpiResNorm, pg8::OrderBf16Part, false>(lds, g, S, E, nullptr);
            }
            __syncthreads();
            {
                pg8::Gemm g{(const bf16_t*)(ws + OFF_O8N), (const bf16_t*)(ws + OFF_W28), MTOK, DM, ZW8 / 2};
                pg8::OrderFp8Part S{nb, bid, 0, 0, DM / 256, 192};
                pg8::EpiResNormFp8 E{P.x, P.out, DM, P.norm_w + DM, (bf16_t*)(ws + OFF_H), (float*)(ws + OFF_SS1), USE_FP8M ? (unsigned char*)(ws + OFF_A8M) : nullptr, 1.0f / (O8N_SCALE * 64.0f)};
                pg8::gemm_phase<pg8::EpiResNormFp8, pg8::OrderFp8Part, false>(lds, g, S, E, nullptr);
            }
            __syncthreads();
            if (TAIL_IN_P6) tail_wconv(lds, P, bid, nb);
        } else {
        pg8::Gemm g{(const bf16_t*)(ws + OFF_O), (const bf16_t*)(ws + OFF_W2T), MTOK, DM, ZW8};
        pg8::StaticOrder S; S.init(g.M, g.N, nb, bid);
        pg8::EpiResNorm E{P.x, P.out, DM, P.norm_w + DM, (bf16_t*)(ws + OFF_H), (float*)(ws + OFF_SS1), USE_FP8M ? (unsigned char*)(ws + OFF_A8M) : nullptr, 1.0f};
        pg8::gemm_phase<pg8::EpiResNorm, pg8::StaticOrder, false>(lds, g, S, E, nullptr);
        }
    } else if constexpr (PH == 7) {
        phase_rmsnorm(P.out, P.norm_w + DM, (bf16_t*)(ws + OFF_H), bid, nb, (FP8EMU & 8) ? 16.0f : 0.f);
    } else if constexpr (PH == 8) {
        if (USE_FP8M) {
            {
                pg8::Gemm g{(const bf16_t*)(ws + OFF_H), (const bf16_t*)(ws + OFF_W3T), MTOK, N3P, DM};
                pg8::OrderBf16Part S{nb, bid, 0, C3_Z8 / 256, NZ8M / 256};
                pg8::EpiStoreBf16RowScale E{(bf16_t*)(ws + OFF_Y1), N3P, (const float*)(ws + OFF_SS1), 1.0f / DM};
                pg8::gemm_phase<pg8::EpiStoreBf16RowScale, pg8::OrderBf16Part, false>(lds, g, S, E, nullptr);
            }
            __syncthreads();
            {
                pg8::Gemm g{(const bf16_t*)(ws + OFF_A8M), (const bf16_t*)(ws + OFF_B8M), MTOK, N3P, DM / 2};
                pg8::OrderFp8PartP8 S{nb, bid};
                pg8::EpiStoreBf16RowScaleFp8 E{(bf16_t*)(ws + OFF_Y1), N3P, (const float*)(ws + OFF_SS1), 1.0f / DM, 1.0f / (16.0f * 64.0f)};
                pg8::gemm_phase<pg8::EpiStoreBf16RowScaleFp8, pg8::OrderFp8PartP8, false>(lds, g, S, E, nullptr);
            }
        } else {
        pg8::Gemm g{(const bf16_t*)(ws + OFF_H), (const bf16_t*)(ws + OFF_W3T), MTOK, N3P, DM};
        pg8::StaticOrder S; S.init(g.M, g.N, nb, bid);
        pg8::EpiStoreBf16RowScale E{(bf16_t*)(ws + OFF_Y1), N3P, (const float*)(ws + OFF_SS1), 1.0f / DM};
        pg8::gemm_phase<pg8::EpiStoreBf16RowScale, pg8::StaticOrder, false>(lds, g, S, E, nullptr);
        }
        __syncthreads();
        if (!TAIL_IN_P6) tail_wconv(lds, P, bid, nb);
    } else if constexpr (PH == 9) {
        phase_mla_prep1(P, bid, nb);
    } else if constexpr (PH == 10) {
        if (USE_FP8Q) {
            {
                pg8::Gemm g{(const bf16_t*)(ws + OFF_CQN), (const bf16_t*)(ws + OFF_W4T), MTOK, NQB, QLORA};
                pg8::OrderBf16Part S{nb, bid, 0, 0, NQB / 256};
                pg8::EpiStoreBf16 E{(bf16_t*)(ws + OFF_QM), NQB};
                pg8::gemm_phase<pg8::EpiStoreBf16, pg8::OrderBf16Part, false>(lds, g, S, E, nullptr);
            }
            __syncthreads();
            {
                pg8::Gemm g{(const bf16_t*)(ws + OFF_CQN8), (const bf16_t*)(ws + OFF_W48), MTOK, NQB, QLORA / 2};
                pg8::OrderFp8Part S{nb, bid, 0, 0, NQB / 256, 64};
                pg8::EpiStoreBf16Fp8 E{(bf16_t*)(ws + OFF_QM), NQB, 1.0f / (16.0f * 64.0f)};
                pg8::gemm_phase<pg8::EpiStoreBf16Fp8, pg8::OrderFp8Part, false>(lds, g, S, E, nullptr);
            }
        } else {
            pg8::Gemm g{(const bf16_t*)(ws + OFF_CQN), (const bf16_t*)(ws + OFF_W4T), MTOK, NQB, QLORA};
            pg8::StaticOrder S; S.init(g.M, g.N, nb, bid);
            pg8::EpiStoreBf16 E{(bf16_t*)(ws + OFF_QM), NQB};
            pg8::gemm_phase<pg8::EpiStoreBf16, pg8::StaticOrder, false>(lds, g, S, E, nullptr);
        }
        __syncthreads();
        if (USE_FP8KV) {
            {
                pg8::Gemm g{(const bf16_t*)(ws + OFF_CKVN), (const bf16_t*)(ws + OFF_W5K), MTOK, NKVB / 2, KVLORA};
                pg8::OrderBf16Part S{nb, bid, 0, 0, NKVB / 512};
                pg8::EpiKNorm E{(bf16_t*)(ws + OFF_KM), (const float*)(ws + OFF_SSPE), (const float*)(ws + OFF_KPER), P.mla_k_norm, (LAS float*)(lds + LDS_KN_OFF), 0u, 1.0f};
                pg8::gemm_phase<pg8::EpiKNorm, pg8::OrderBf16Part, false>(lds, g, S, E, nullptr);
            }
            __syncthreads();
            {
                pg8::Gemm g{(const bf16_t*)(ws + OFF_W5V), (const bf16_t*)(ws + OFF_CKVN), NKVB / 2, MTOK, KVLORA};
                pg8::OrderSwap<pg8::OrderBf16Part> S{{nb, (bid + 128) & 255, 0, 0, NKVB / 512}};
                pg8::EpiVT E{(bf16_t*)(ws + OFF_VTM), 1.0f};
                pg8::gemm_phase<pg8::EpiVT, pg8::OrderSwap<pg8::OrderBf16Part>, false>(lds, g, S, E, nullptr);
            }
            __syncthreads();
            {
                pg8::Gemm g{(const bf16_t*)(ws + OFF_CKVN8), (const bf16_t*)(ws + OFF_W5K8), MTOK, NKVB / 2, KVLORA / 2};
                pg8::OrderFp8Part S{nb, bid, 0, 0, NKVB / 512, 0};
                pg8::EpiKNormFp8 E{(bf16_t*)(ws + OFF_KM), (const float*)(ws + OFF_SSPE), (const float*)(ws + OFF_KPER), P.mla_k_norm, (LAS float*)(lds + LDS_KN_OFF), 0u, 1.0f / (16.0f * 64.0f)};
                pg8::gemm_phase<pg8::EpiKNormFp8, pg8::OrderFp8Part, false>(lds, g, S, E, nullptr);
            }
            __syncthreads();
            {
                pg8::Gemm g{(const bf16_t*)(ws + OFF_W5V8), (const bf16_t*)(ws + OFF_CKVN8), NKVB / 2, MTOK, KVLORA / 2};
                pg8::OrderSwap<pg8::OrderFp8Part> S{{nb, bid, 0, 0, NKVB / 512, 128}};
                pg8::EpiVTFp8 E{(bf16_t*)(ws + OFF_VTM), 1.0f / (16.0f * 64.0f)};
                pg8::gemm_phase<pg8::EpiVTFp8, pg8::OrderSwap<pg8::OrderFp8Part>, false>(lds, g, S, E, nullptr);
            }
        } else {
        {
            pg8::Gemm g{(const bf16_t*)(ws + OFF_CKVN), (const bf16_t*)(ws + OFF_W5K), MTOK, NKVB / 2, KVLORA};
            pg8::StaticOrder S; S.init(g.M, g.N, nb, bid);
            pg8::EpiKNorm E{(bf16_t*)(ws + OFF_KM), (const float*)(ws + OFF_SSPE), (const float*)(ws + OFF_KPER), P.mla_k_norm, (LAS float*)(lds + LDS_KN_OFF), 0u, 1.0f};
            pg8::gemm_phase<pg8::EpiKNorm, pg8::StaticOrder, false>(lds, g, S, E, nullptr);
        }
        __syncthreads();
        {
            pg8::Gemm g{(const bf16_t*)(ws + OFF_W5V), (const bf16_t*)(ws + OFF_CKVN), NKVB / 2, MTOK, KVLORA};
            pg8::StaticOrder S; S.init(g.M, g.N, nb, bid);
            pg8::EpiVT E{(bf16_t*)(ws + OFF_VTM), 1.0f};
            pg8::gemm_phase<pg8::EpiVT, pg8::StaticOrder, false>(lds, g, S, E, nullptr);
        }
        }
    } else if constexpr (PH == 11) {
    } else if constexpr (PH == 12) {
        phase_mla_attn(lds, P, bid, nb);
    } else if constexpr (PH == 13) {
        if (USE_FP8O) {
            {
                pg8::Gemm g{(const bf16_t*)(ws + OFF_O), (const bf16_t*)(ws + OFF_W6T), MTOK, DM, ZW8};
                pg8::OrderBf16Part S{nb, bid, 0, 0, DM / 256};
                pg8::EpiResF32 E{P.out, P.out, DM};
                pg8::gemm_phase<pg8::EpiResF32, pg8::OrderBf16Part, false>(lds, g, S, E, nullptr);
            }
            __syncthreads();
            {
                pg8::Gemm g{(const bf16_t*)(ws + OFF_O8M), (const bf16_t*)(ws + OFF_W68), MTOK, DM, ZW8 / 2};
                pg8::OrderFp8Part S{nb, bid, 0, 0, DM / 256, 192};
                pg8::EpiResF32Fp8 E{P.out, P.out, DM, 1.0f / (O8_SCALE * 64.0f)};
                pg8::gemm_phase<pg8::EpiResF32Fp8, pg8::OrderFp8Part, false>(lds, g, S, E, nullptr);
            }
        } else {
        pg8::Gemm g{(const bf16_t*)(ws + OFF_O), (const bf16_t*)(ws + OFF_W6T), MTOK, DM, ZW8};
        pg8::StaticOrder S; S.init(g.M, g.N, nb, bid);
        pg8::EpiResF32 E{P.out, P.out, DM};
        pg8::gemm_phase<pg8::EpiResF32, pg8::StaticOrder, false>(lds, g, S, E, nullptr);
        }
    }
}

#ifndef REP0
#define REP0 1
#endif
#ifndef REP1
#define REP1 1
#endif
#ifndef REP2
#define REP2 1
#endif
#ifndef REP3
#define REP3 1
#endif
#ifndef REP4
#define REP4 1
#endif
#ifndef REP5
#define REP5 1
#endif
#ifndef REP6
#define REP6 1
#endif
#ifndef REP7
#define REP7 1
#endif
#ifndef REP8
#define REP8 1
#endif
#ifndef REP9
#define REP9 1
#endif
#ifndef REP10
#define REP10 1
#endif
#ifndef REP11
#define REP11 1
#endif
#ifndef REP12
#define REP12 1
#endif
#ifndef REP13
#define REP13 1
#endif

__global__ __launch_bounds__(512, 2) void k_mega(Params P) {
    extern __shared__ __attribute__((aligned(16))) unsigned char shm[];
    LAS unsigned char* lds = (LAS unsigned char*)shm;
    volatile LAS unsigned* st = (volatile LAS unsigned*)(lds + LDS_ST_OFF);
    if (threadIdx.x == 0) { st[0] = 0u; st[1] = 0u; st[2] = 0u; st[3] = 0u; }
    __syncthreads();
    XcdBarrier bar = xcd_barrier_post((unsigned*)(P.ws + OFF_CTL), st);
    const int bid = (int)blockIdx.x, nb = (int)gridDim.x;
    for (int rep_ = 0; rep_ < REP0; ++rep_) run_phase<0>(P, lds, bid, nb);  xcd_barrier(bar);
    for (int rep_ = 0; rep_ < REP1; ++rep_) run_phase<1>(P, lds, bid, nb);  xcd_barrier(bar);
    for (int rep_ = 0; rep_ < REP2; ++rep_) run_phase<2>(P, lds, bid, nb);  xcd_barrier(bar);
    for (int rep_ = 0; rep_ < REP3; ++rep_) run_phase<3>(P, lds, bid, nb);  xcd_barrier(bar);
    for (int rep_ = 0; rep_ < REP4; ++rep_) run_phase<4>(P, lds, bid, nb);  xcd_barrier(bar);
    for (int rep_ = 0; rep_ < REP5; ++rep_) run_phase<5>(P, lds, bid, nb);
#if DUP5
    __syncthreads(); run_phase<5>(P, lds, bid, nb);
#endif
    xcd_barrier(bar);
    for (int rep_ = 0; rep_ < REP6; ++rep_) run_phase<6>(P, lds, bid, nb);  xcd_barrier(bar);
    for (int rep_ = 0; rep_ < REP8; ++rep_) run_phase<8>(P, lds, bid, nb);  xcd_barrier(bar);
    for (int rep_ = 0; rep_ < REP9; ++rep_) run_phase<9>(P, lds, bid, nb);  xcd_barrier(bar);
    for (int rep_ = 0; rep_ < REP10; ++rep_) run_phase<10>(P, lds, bid, nb); xcd_barrier(bar);
    for (int rep_ = 0; rep_ < REP12; ++rep_) run_phase<12>(P, lds, bid, nb); xcd_barrier(bar);
    for (int rep_ = 0; rep_ < REP13; ++rep_) run_phase<13>(P, lds, bid, nb);
}

extern "C" void kernel_launch(void* const* d_in, const int* in_sizes, int n_in, void* d_out, int out_size, void* d_ws, size_t ws_size, hipStream_t stream) {
    (void)in_sizes; (void)n_in; (void)out_size;
    if (ws_size < WS_END) return;
    Params P{};
    P.x = (const float*)d_in[0]; P.pos = (const int*)d_in[1]; P.norm_w = (const float*)d_in[2]; P.rel_bias = (const float*)d_in[3];
    P.nsa_w_in = (const float*)d_in[4]; P.nsa_q_norm = (const float*)d_in[5]; P.nsa_k_norm = (const float*)d_in[6]; P.pe_k = (const float*)d_in[7];
    P.w1_k = (const float*)d_in[8]; P.w2_k = (const float*)d_in[9]; P.pe_v = (const float*)d_in[10]; P.w1_v = (const float*)d_in[11]; P.w2_v = (const float*)d_in[12];
    P.nsa_w_out = (const float*)d_in[13]; P.mla_w_in = (const float*)d_in[14]; P.mla_q_a_norm = (const float*)d_in[15]; P.mla_w_q_b = (const float*)d_in[16];
    P.mla_kv_a_norm = (const float*)d_in[17]; P.mla_w_kv_b = (const float*)d_in[18]; P.mla_q_norm = (const float*)d_in[19]; P.mla_k_norm = (const float*)d_in[20];
    P.mla_w_out = (const float*)d_in[21];
    P.out = (float*)d_out; P.ws = (unsigned char*)d_ws;
    static int grid = 0;
    if (!grid) {
        int dev = 0, cus = 0, per_cu = 0; (void)hipGetDevice(&dev);
        if (hipDeviceGetAttribute(&cus, hipDeviceAttributeMultiprocessorCount, dev) != hipSuccess || cus <= 0) cus = 256;
        (void)hipFuncSetAttribute((const void*)k_mega, hipFuncAttributeMaxDynamicSharedMemorySize, LDS_BYTES);
        if (hipOccupancyMaxActiveBlocksPerMultiprocessor(&per_cu, k_mega, 512, LDS_BYTES) != hipSuccess || per_cu < 1) per_cu = 1;
        grid = cus;
    }
    (void)hipMemsetAsync((unsigned char*)d_ws + OFF_CTL, 0, XCD_BAR_WORDS * sizeof(unsigned), stream);
    hipLaunchKernelGGL(k_mega, dim3(grid), dim3(512), LDS_BYTES, stream, P);
}
```
